# Optimizing an MI355X kernel written in HIP

```python
import math
import jax, jax.numpy as jnp
from jax import lax
import numpy as np

D_MODEL = 1024
BATCH = 32
SEQ = 2048
DEPTH = 2

GRID_W = 64
CTX_LEN = 256

BRANCH_W = D_MODEL // 2
N_BRANCH = 3
M_HEADS = 4
M_DV = BRANCH_W // M_HEADS
M_DQK = M_DV // 2
M_CHUNK = 128
M_INIT = -1e30
POOL_GROUPS = 4
POOL_GC = BRANCH_W // POOL_GROUPS
POOL_WINDOWS = (2, 4, 8, 16)
NA_HEADS = 8
NA_DH = BRANCH_W // NA_HEADS
NA_KH = 8
NA_KW = 16
N_EXPERTS = 16
EXPERT_FF = D_MODEL
EC_FACTOR = 2
ROPE_BASE = 10000.0
RMS_EPS = 1e-6
N_MOD = 6
SPLIT_SIZES = (M_HEADS * M_DQK, M_HEADS * M_DQK, M_HEADS * M_DV, M_HEADS * M_DV, 4 * M_HEADS,
               POOL_GROUPS * POOL_GC, NA_HEADS * NA_DH, NA_HEADS * NA_DH, NA_HEADS * NA_DH,
               N_BRANCH * D_MODEL)
PROJ_W = sum(SPLIT_SIZES)

kernel_name = 'hybrid_mlstm_pool_natten_ecmoe_dit'


def rmsnorm(x, g):
    xf = x.astype(jnp.float32)
    y = xf * lax.rsqrt(jnp.mean(xf * xf, axis=-1, keepdims=True) + RMS_EPS)
    return (y * g.astype(jnp.float32)).astype(x.dtype)


def modulate(h, shift, scale):
    return h * (1 + scale) + shift


def rope_tables(n_tokens, dtype):
    t = jnp.arange(n_tokens)
    row = (t // GRID_W).astype(jnp.float32)
    col = (t % GRID_W).astype(jnp.float32)
    half = M_DQK // 2
    inv = ROPE_BASE ** (-jnp.arange(0, half, 2, dtype=jnp.float32) / half)
    ar = row[:, None] * inv[None, :]
    ac = col[:, None] * inv[None, :]
    return tuple(a.astype(dtype) for a in (jnp.cos(ar), jnp.sin(ar), jnp.cos(ac), jnp.sin(ac)))


def _rotate(x, cos, sin):
    x1, x2 = jnp.split(x, 2, axis=-1)
    cos = cos[:, None, :]
    sin = sin[:, None, :]
    return jnp.concatenate([x1 * cos - x2 * sin, x2 * cos + x1 * sin], axis=-1)


def rope_2d(x, tabs):
    cr, sr, cc, sc = tabs
    xr, xc = jnp.split(x, 2, axis=-1)
    return jnp.concatenate([_rotate(xr, cr, sr), _rotate(xc, cc, sc)], axis=-1)


def mlstm_scan(q, k, v, li, lf, state):
    B, T, H, _ = q.shape
    dv = v.shape[-1]
    L = M_CHUNK
    N = T // L

    def chunks(a):
        a = a.reshape((B, N, L, H) + a.shape[3:])
        return jnp.moveaxis(a, (1, 3), (0, 2))

    tril = jnp.tril(jnp.ones((L, L), dtype=bool))

    def step(carry, inp):
        C, n, m = carry
        qc, kc, vc, ic, fc = inp
        b = jnp.cumsum(fc, axis=-1)
        dmat = jnp.where(tril, b[..., :, None] - b[..., None, :] + ic[..., None, :], -jnp.inf)
        g = b + m[..., None]
        mt = jnp.maximum(g, dmat.max(-1))
        sc = jnp.einsum('bhtd,bhsd->bhts', qc, kc) * jnp.exp(dmat - mt[..., None])
        inter = jnp.exp(g - mt)
        num = inter[..., None] * jnp.einsum('bhvd,bhtd->bhtv', C, qc) + jnp.einsum('bhts,bhsv->bhtv', sc, vc)
        den = inter * jnp.einsum('bhd,bhtd->bht', n, qc) + sc.sum(-1)
        h = num / jnp.maximum(jnp.abs(den), jnp.exp(-mt))[..., None]
        bl = b[..., -1]
        w = bl[..., None] - b + ic
        m_new = jnp.maximum(bl + m, w.max(-1))
        decay = jnp.exp(bl + m - m_new)
        ws = jnp.exp(w - m_new[..., None])
        C_new = decay[..., None, None] * C + jnp.einsum('bhs,bhsv,bhsd->bhvd', ws, vc, kc)
        n_new = decay[..., None] * n + jnp.einsum('bhs,bhsd->bhd', ws, kc)
        return (C_new, n_new, m_new), h

    xs = (chunks(q), chunks(k), chunks(v), chunks(li), chunks(lf))
    state, h = lax.scan(step, state, xs)
    h = jnp.moveaxis(h, (0, 2), (1, 3)).reshape(B, T, H, dv)
    return state, h


def head_rms(h):
    return h * lax.rsqrt(jnp.mean(h * h, axis=-1, keepdims=True) + RMS_EPS)


def mlstm_branch(ctx_parts, lat_parts, gate_bias, need_ctx):
    f32 = jnp.float32
    qscale = M_DQK ** -0.5

    def prep(parts):
        q, k, v, o, gt = parts
        q = q.astype(f32) * qscale
        k = k.astype(f32)
        v = v.astype(f32)
        gt = gt.astype(f32) + gate_bias.astype(f32)
        fwd = (q, k, v, gt[..., 0, :], jax.nn.log_sigmoid(gt[..., 1, :]))
        bwd = tuple(jnp.flip(a, axis=1) for a in (q, k, v, gt[..., 2, :], jax.nn.log_sigmoid(gt[..., 3, :])))
        return fwd, bwd

    c_f, c_b = prep(ctx_parts)
    l_f, l_b = prep(lat_parts)
    B = l_f[0].shape[0]
    st0 = (jnp.zeros((B, M_HEADS, M_DV, M_DQK), f32), jnp.zeros((B, M_HEADS, M_DQK), f32),
           jnp.full((B, M_HEADS), M_INIT, f32))
    st_f, hc_f = mlstm_scan(*c_f, st0)
    _, hl_f = mlstm_scan(*l_f, st_f)
    st_b, hc_b = mlstm_scan(*c_b, st0)
    _, hl_b = mlstm_scan(*l_b, st_b)

    def finish(h_f, h_b_rev, o):
        h = head_rms(h_f + jnp.flip(h_b_rev, axis=1))
        return jax.nn.sigmoid(o) * h.reshape(o.shape).astype(o.dtype)

    out_l = finish(hl_f, hl_b, lat_parts[3])
    out_c = finish(hc_f, hc_b, ctx_parts[3]) if need_ctx else None
    return out_l, out_c


def pool_branch(u, pool_w, pool_scale):
    B, T, _ = u.shape
    uf = u.astype(jnp.float32).reshape(B, T, POOL_GROUPS, POOL_GC)
    csum = jnp.concatenate([jnp.zeros((B, 1, POOL_GROUPS, POOL_GC), jnp.float32),
                            jnp.cumsum(uf, axis=1)], axis=1)
    t = jnp.arange(T)
    outs = []
    for gi, w in enumerate(POOL_WINDOWS):
        lo = jnp.clip(t - w // 2, 0, T - 1)
        hi = jnp.clip(t - w // 2 + w - 1, 0, T - 1)
        cnt = (hi - lo + 1).astype(jnp.float32)[:, None]
        cg = csum[:, :, gi]
        mean = (cg[:, hi + 1] - cg[:, lo]) / cnt
        outs.append(jnp.einsum('btc,cd->btd', (mean - uf[:, :, gi]).astype(u.dtype), pool_w[gi]))
    return jnp.concatenate(outs, axis=-1) * pool_scale


def na_latent(q, k, v, k_ctx, v_ctx, rpb):
    B, S, H, dh = q.shape
    rows = S // GRID_W
    kh = min(NA_KH, rows)
    f32 = jnp.float32
    scale = dh ** -0.5

    def grid(a):
        return a.reshape(B, rows, GRID_W, H, dh).transpose(1, 0, 3, 2, 4)

    qg, kg, vg = grid(q), grid(k), grid(v)
    kc = k_ctx.transpose(0, 2, 1, 3)
    vc = v_ctx.transpose(0, 2, 1, 3)
    cols = jnp.arange(GRID_W)
    cs = jnp.clip(cols - NA_KW // 2, 0, GRID_W - NA_KW)
    colmask = (cols[None, :] >= cs[:, None]) & (cols[None, :] < cs[:, None] + NA_KW)
    mask = jnp.tile(colmask, (1, kh))
    dc_idx = jnp.clip(cols[None, :] - cols[:, None] + NA_KW - 1, 0, 2 * NA_KW - 2)
    n_loc = kh * GRID_W

    def row_fn(r):
        rs = jnp.clip(r - kh // 2, 0, rows - kh)
        qr = qg[r]
        kr = jnp.moveaxis(lax.dynamic_slice_in_dim(kg, rs, kh, axis=0), 0, 2).reshape(B, H, n_loc, dh)
        vr = jnp.moveaxis(lax.dynamic_slice_in_dim(vg, rs, kh, axis=0), 0, 2).reshape(B, H, n_loc, dh)
        dr_idx = rs + jnp.arange(kh) - r + NA_KH - 1
        bias = rpb[:, dr_idx][:, :, dc_idx]
        bias = bias.transpose(0, 2, 1, 3).reshape(H, GRID_W, n_loc).astype(f32)
        s_loc = jnp.einsum('bhqd,bhkd->bhqk', qr, kr, preferred_element_type=f32) * scale + bias
        s_loc = jnp.where(mask, s_loc, -jnp.inf)
        s_ctx = jnp.einsum('bhqd,bhkd->bhqk', qr, kc, preferred_element_type=f32) * scale
        p = jax.nn.softmax(jnp.concatenate([s_loc, s_ctx], axis=-1), axis=-1).astype(v.dtype)
        return (jnp.einsum('bhqk,bhkd->bhqd', p[..., :n_loc], vr)
                + jnp.einsum('bhqk,bhkd->bhqd', p[..., n_loc:], vc))

    out = lax.map(row_fn, jnp.arange(rows))
    return out.transpose(1, 0, 3, 2, 4).reshape(B, S, H * dh)


def na_context(q, k, v):
    B, T, H, dh = q.shape
    s = jnp.einsum('bqhd,bkhd->bhqk', q, k, preferred_element_type=jnp.float32) * dh ** -0.5
    p = jax.nn.softmax(s, axis=-1).astype(v.dtype)
    return jnp.einsum('bhqk,bkhd->bqhd', p, v).reshape(B, T, H * dh)


def merge_branches(branches, bg, w_branch, w_out):
    D = w_out.shape[0]
    acc = None
    for bi, br in enumerate(branches):
        term = jax.nn.sigmoid(bg[..., bi * D:(bi + 1) * D]) * (br @ w_branch[bi])
        acc = term if acc is None else acc + term
    return acc @ w_out


def mixer(h_lat, h_ctx, w_in, gate_bias, pool_w, pool_scale, rpb, w_branch, w_out, tabs, need_ctx):
    split_at = [int(s) for s in np.cumsum(SPLIT_SIZES)[:-1]]

    def project(h):
        B, T, _ = h.shape
        qm, km, vm, om, gm, pu, qn, kn, vn, bg = jnp.split(h @ w_in, split_at, axis=-1)
        return (qm.reshape(B, T, M_HEADS, M_DQK), km.reshape(B, T, M_HEADS, M_DQK),
                vm.reshape(B, T, M_HEADS, M_DV), om, gm.reshape(B, T, 4, M_HEADS), pu,
                qn.reshape(B, T, NA_HEADS, NA_DH), kn.reshape(B, T, NA_HEADS, NA_DH),
                vn.reshape(B, T, NA_HEADS, NA_DH), bg)

    qm_l, km_l, vm_l, om_l, gm_l, pu_l, qn_l, kn_l, vn_l, bg_l = project(h_lat)
    qm_c, km_c, vm_c, om_c, gm_c, pu_c, qn_c, kn_c, vn_c, bg_c = project(h_ctx)
    qm_l = rope_2d(qm_l, tabs)
    km_l = rope_2d(km_l, tabs)
    m_l, m_c = mlstm_branch((qm_c, km_c, vm_c, om_c, gm_c), (qm_l, km_l, vm_l, om_l, gm_l),
                            gate_bias, need_ctx)
    p_l = pool_branch(pu_l, pool_w, pool_scale)
    n_l = na_latent(qn_l, kn_l, vn_l, kn_c, vn_c, rpb)
    y_l = merge_branches((m_l, p_l, n_l), bg_l, w_branch, w_out)
    y_c = None
    if need_ctx:
        p_c = pool_branch(pu_c, pool_w, pool_scale)
        n_c = na_context(qn_c, kn_c, vn_c)
        y_c = merge_branches((m_c, p_c, n_c), bg_c, w_branch, w_out)
    return y_l, y_c


def ec_moe(h, w_router, w_gate, w_up, w_down):
    B, T, D = h.shape
    cap = EC_FACTOR * T // N_EXPERTS
    aff = jax.nn.softmax(jnp.einsum('btd,de->bte', h, w_router, preferred_element_type=jnp.float32), axis=-1)
    gate, idx = lax.top_k(jnp.swapaxes(aff, 1, 2), cap)
    xe = jax.vmap(lambda hb, ib: hb[ib])(h, idx)
    hid = jax.nn.silu(jnp.einsum('becd,edf->becf', xe, w_gate)) * jnp.einsum('becd,edf->becf', xe, w_up)
    ye = jnp.einsum('becf,efd->becd', hid, w_down) * gate[..., None].astype(h.dtype)
    return jax.vmap(lambda ib, yb: jnp.zeros((T, D), yb.dtype).at[ib.reshape(-1)].add(yb.reshape(-1, D)))(idx, ye)


def setup_inputs(seed: int = 0) -> dict:
    key = jax.random.key(seed)
    ks = jax.random.split(key, 20)
    f32 = jnp.float32

    def nrm(k, shape, scale):
        return jax.random.normal(k, shape, f32) * scale

    D = D_MODEL
    lin = jnp.linspace(3.0, 6.0, M_HEADS, dtype=f32)
    gb_base = jnp.zeros((4, M_HEADS), f32).at[1].set(lin).at[3].set(lin)
    return {
        'x': nrm(ks[0], (BATCH, SEQ, D), 1.0),
        'c': nrm(ks[1], (BATCH, D), 1.0),
        'ctx': nrm(ks[2], (BATCH, CTX_LEN, D), 1.0),
        'c_ctx': nrm(ks[3], (D,), 1.0),
        'norm_gain': 1.0 + nrm(ks[4], (DEPTH, 4, D), 0.05),
        'ada_w': nrm(ks[5], (DEPTH, D, N_MOD * D), 0.5 * D ** -0.5),
        'ada_b': nrm(ks[6], (DEPTH, N_MOD * D), 0.02),
        'w_in': nrm(ks[7], (DEPTH, D, PROJ_W), D ** -0.5),
        'mlstm_gate_bias': gb_base[None] + nrm(ks[8], (DEPTH, 4, M_HEADS), 0.1),
        'pool_w': nrm(ks[9], (DEPTH, POOL_GROUPS, POOL_GC, POOL_GC), POOL_GC ** -0.5),
        'pool_scale': 1.0 + nrm(ks[10], (DEPTH, BRANCH_W), 0.1),
        'na_rpb': nrm(ks[11], (DEPTH, NA_HEADS, 2 * NA_KH - 1, 2 * NA_KW - 1), 0.1),
        'w_branch': nrm(ks[12], (DEPTH, N_BRANCH, BRANCH_W, D), BRANCH_W ** -0.5),
        'w_out': nrm(ks[13], (DEPTH, D, D), D ** -0.5),
        'router_w': nrm(ks[14], (DEPTH, D, N_EXPERTS), D ** -0.5),
        'w_gate': nrm(ks[15], (DEPTH, N_EXPERTS, D, EXPERT_FF), D ** -0.5),
        'w_up': nrm(ks[16], (DEPTH, N_EXPERTS, D, EXPERT_FF), D ** -0.5),
        'w_down': nrm(ks[17], (DEPTH, N_EXPERTS, EXPERT_FF, D), EXPERT_FF ** -0.5),
    }


def reference(x, c, ctx, c_ctx, norm_gain, ada_w, ada_b, w_in, mlstm_gate_bias, pool_w, pool_scale,
              na_rpb, w_branch, w_out, router_w, w_gate, w_up, w_down):
    S = x.shape[1]
    tabs = rope_tables(S, x.dtype)
    for l in range(DEPTH):
        need_ctx = l < DEPTH - 1
        g = norm_gain[l]
        mod_l = jnp.split((jax.nn.silu(c) @ ada_w[l] + ada_b[l])[:, None, :], N_MOD, axis=-1)
        mod_c = jnp.split(jax.nn.silu(c_ctx) @ ada_w[l] + ada_b[l], N_MOD, axis=-1)
        h_l = modulate(rmsnorm(x, g[0]), mod_l[0], mod_l[1])
        h_c = modulate(rmsnorm(ctx, g[0]), mod_c[0], mod_c[1])
        y_l, y_c = mixer(h_l, h_c, w_in[l], mlstm_gate_bias[l], pool_w[l], pool_scale[l], na_rpb[l],
                         w_branch[l], w_out[l], tabs, need_ctx)
        x = x + mod_l[2] * rmsnorm(y_l, g[1])
        h2 = modulate(rmsnorm(x, g[2]), mod_l[3], mod_l[4])
        x = x + mod_l[5] * rmsnorm(ec_moe(h2, router_w[l], w_gate[l], w_up[l], w_down[l]), g[3])
        if need_ctx:
            ctx = ctx + mod_c[2] * rmsnorm(y_c, g[1])
            h2c = modulate(rmsnorm(ctx, g[2]), mod_c[3], mod_c[4])
            ctx = ctx + mod_c[5] * rmsnorm(ec_moe(h2c, router_w[l], w_gate[l], w_up[l], w_down[l]), g[3])
    return x
```

```cpp
#ifdef CPU_EMU
#include "emu.h"
#define DYN_LDS(p) char* p = emu_blk->smem
#define WAIT_V(n)
#define WAIT_L(n)
#define HIDE(v)
#define CBAR()
#else
#include <hip/hip_runtime.h>
#define DYN_LDS(p) extern __shared__ __attribute__((aligned(16))) char p[]
#define WAIT_V(n) asm volatile("s_waitcnt vmcnt(" #n ")" ::: "memory")
#define WAIT_L(n) asm volatile("s_waitcnt lgkmcnt(" #n ")" ::: "memory")
#define HIDE(v) asm volatile("" : "+v"(v))
#define CBAR() asm volatile("" ::: "memory")
#endif
#include <stdint.h>
#include <stddef.h>

#ifndef CFG_B
#define CFG_B 32
#define CFG_ROWS 32
#define CFG_CTX 256
#define CFG_G 16
#endif
#ifndef MK_ONE_LAUNCH
#define MK_ONE_LAUNCH 1
#endif

#define DEV __device__ __forceinline__
typedef short s16x4 __attribute__((ext_vector_type(4)));
#ifdef CPU_EMU
#define TR16(ptr) emu_tr16((const void*)(ptr))
#else
typedef __attribute__((address_space(3))) s16x4 lds_s16x4;
#define TR16(ptr) __builtin_amdgcn_ds_read_tr16_b64_v4i16((lds_s16x4*)(ptr))
#endif
#ifdef CPU_EMU
#define TID() (threadIdx.x)
#else
#define TID() ({ int t_ = threadIdx.x; asm volatile("" : "+v"(t_)); t_; })
#endif

typedef unsigned short bf16_t;
typedef short bf16x8 __attribute__((ext_vector_type(8)));
typedef float f32x4 __attribute__((ext_vector_type(4)));
typedef unsigned u32x2 __attribute__((ext_vector_type(2)));
typedef unsigned u32x4 __attribute__((ext_vector_type(4)));

namespace {
constexpr int D = 1024, NB = CFG_B, ROWS = CFG_ROWS, SEQ = ROWS * 64, CTX = CFG_CTX, G = CFG_G, NG = NB / G;
constexpr int RL = G * SEQ, RC = NB * CTX, RMAX = RL > RC ? RL : RC;
constexpr int PWA = 3840, NBG = 3072, PWT = PWA + NBG, PWSRC = 6672, C_SPLIT = 3600;
constexpr int C_QM = 0, C_KM = 256, C_VM = 512, C_OM = 1024, C_GM = 1536, C_PU = 1552, C_QN = 2064, C_KN = 2576, C_VN = 3088;
constexpr int NTBL = SEQ / 128, NTBC = CTX / 128;
constexpr int ilog2(int x) { return x <= 1 ? 0 : 1 + ilog2(x >> 1); }
constexpr int LGSEQ = ilog2(SEQ), LGCTX = ilog2(CTX);
static_assert((1 << LGSEQ) == SEQ && (1 << LGCTX) == CTX, "sequence lengths must be powers of two");
constexpr int cdiv(int a, int b) { return (a + b - 1) / b; }
constexpr int RPE_L = cdiv(G * (SEQ / 8), 256) * 256, RPE_C = cdiv(NB * (CTX / 8), 256) * 256, RPE_MAX = RPE_L > RPE_C ? RPE_L : RPE_C;
constexpr int NSLOT = 16 * RPE_MAX;
constexpr int NTHREADS = 512;
constexpr int GT_MAXU = 10;
constexpr int LDS_BYTES = 131072 + 256 + GT_MAXU * 1024;
constexpr int NST_L = G * 4 * 2 * NTBL, NST_C = NB * 4 * 2 * NTBC, NST = NST_L > NST_C ? NST_L : NST_C;
constexpr int NCI = NB * 4 * 2;
constexpr float RMS_EPS = 1e-6f;

struct WsLayout { size_t bar, WinT, WbT, WoT, WguT, WdT, mod, rope, ctxs, PROJc, CiC, Cin_, Cim, H, PROJa, Sst, Cin, Mb, Pb, Nb, Sn, Ssc, Cn, Cm, aff, slot_token, slot_gate, token_slots, HID, YE, BG, MERGED, Y, total; };
constexpr size_t al(size_t x) { return (x + 255) / 256 * 256; }
constexpr size_t smax(size_t a, size_t b) { return a > b ? a : b; }
constexpr WsLayout make_layout() {
    WsLayout L{}; size_t o = 0;
    L.bar = o; o += al(16384);
    L.WinT = o; o += al((size_t)2 * PWT * 1024 * 2);
    L.WbT = o; o += al((size_t)2 * 3 * 1024 * 512 * 2);
    L.WoT = o; o += al((size_t)2 * 1024 * 1024 * 2);
    L.WguT = o; o += al((size_t)2 * 16 * 2048 * 1024 * 2);
    L.WdT = o; o += al((size_t)2 * 16 * 1024 * 1024 * 2);
    L.mod = o; o += al((size_t)2 * (NB + 1) * 6144 * 4);
    L.rope = o; o += al((size_t)(ROWS + 64) * 16 * 2 * 4);
    L.ctxs = o; o += al((size_t)NB * CTX * 1024 * 4);
    L.PROJc = o; o += al((size_t)RC * PWA * 2);
    L.CiC = o; o += al((size_t)NCI * 8192 * 4);
    L.Cin_ = o; o += al((size_t)NCI * 64 * 4);
    L.Cim = o; o += al((size_t)NCI * 4 * 4);
    L.H = o; o += al((size_t)RMAX * 1024 * 2);
    const size_t x0 = o;
    L.PROJa = o; o += al((size_t)RMAX * PWA * 2);
    L.Sst = o; o += al((size_t)NST * 8192 * 4);
    L.Cin = o; o += al((size_t)NST * 8192 * 2);
    const size_t hid = al((size_t)NSLOT * 1024 * 2);
    o = x0 + smax(o - x0, 2 * hid);
    L.BG = x0; L.HID = x0; L.YE = x0 + hid;
    L.Mb = o; o += al((size_t)RMAX * 512 * 2);
    L.Pb = o; o += al((size_t)RMAX * 512 * 2);
    L.Nb = o; o += al((size_t)RMAX * 512 * 2);
    L.MERGED = L.H; L.Y = L.Mb;
    L.Sn = o; o += al((size_t)NST * 64 * 4);
    L.Ssc = o; o += al((size_t)NST * 4 * 4);
    L.Cn = o; o += al((size_t)NST * 64 * 4);
    L.Cm = o; o += al((size_t)NST * 4 * 4);
    L.aff = o; o += al((size_t)RMAX * 16 * 4);
    L.slot_token = o; o += al((size_t)NSLOT * 4);
    L.slot_gate = o; o += al((size_t)NSLOT * 4);
    L.token_slots = o; o += al((size_t)RMAX * 16 * 4);
    L.total = o;
    return L;
}
constexpr WsLayout WSL = make_layout();
static_assert((size_t)RMAX * NBG * 2 <= (size_t)RMAX * PWA * 2, "BG overlay must fit in PROJa");

struct Params {
    const float *x, *c, *ctx, *c_ctx, *norm_gain, *ada_w, *ada_b, *w_in, *gate_bias, *pool_w, *pool_scale, *rpb, *w_branch, *w_out, *router_w, *w_gate, *w_up, *w_down;
    float* out;
    char* ws;
#ifdef CPU_EMU
#define WSF(T, name) __device__ __host__ __forceinline__ T* name() const { return (T*)(ws + WSL.name); }
#else
#if defined(__HIP_DEVICE_COMPILE__)
#define WSF(T, name) __device__ __host__ __forceinline__ T* name() const { char* w_ = ws; asm volatile("" : "+s"(w_)); return (T*)(__attribute__((address_space(1))) T*)(w_ + WSL.name); }
#else
#define WSF(T, name) __device__ __host__ __forceinline__ T* name() const { return (T*)(ws + WSL.name); }
#endif
#endif
    WSF(unsigned, bar) WSF(bf16_t, WinT) WSF(bf16_t, WbT) WSF(bf16_t, WoT) WSF(bf16_t, WguT) WSF(bf16_t, WdT)
    WSF(float, mod) WSF(float, rope) WSF(float, ctxs) WSF(bf16_t, PROJc) WSF(float, CiC) WSF(float, Cin_) WSF(float, Cim)
    WSF(bf16_t, H) WSF(bf16_t, PROJa) WSF(float, Sst) WSF(bf16_t, Cin) WSF(bf16_t, Mb) WSF(bf16_t, Pb) WSF(bf16_t, Nb)
    WSF(float, Sn) WSF(float, Ssc) WSF(float, Cn) WSF(float, Cm) WSF(float, aff) WSF(int, slot_token) WSF(float, slot_gate) WSF(int, token_slots)
    WSF(bf16_t, HID) WSF(bf16_t, YE) WSF(bf16_t, BG) WSF(bf16_t, MERGED) WSF(bf16_t, Y)
#undef WSF
};

struct SetDesc { int is_ctx, nrows, samp0, nsamp, lgseq, ntb, cap, rpe; };
DEV SetDesc make_set(int is_ctx, int grp) {
    SetDesc s;
    s.is_ctx = is_ctx;
    if (is_ctx) { s.nrows = RC; s.samp0 = 0; s.nsamp = NB; s.lgseq = LGCTX; s.ntb = NTBC; s.cap = CTX / 8; s.rpe = RPE_C; }
    else { s.nrows = RL; s.samp0 = grp * G; s.nsamp = G; s.lgseq = LGSEQ; s.ntb = NTBL; s.cap = SEQ / 8; s.rpe = RPE_L; }
    return s;
}

#ifdef CPU_EMU
#define GAS
#else
#define GAS __attribute__((address_space(1)))
#endif
template <class T> DEV T ldg(const T* p) { return *(const GAS T*)p; }
template <class T> DEV void stg(T* p, const T& v) { *(GAS T*)p = v; }
DEV float bf2f(bf16_t v) { return __uint_as_float(((unsigned)v) << 16); }
DEV bf16_t f2bf(float f) { unsigned u = __float_as_uint(f); u += 0x7FFFu + ((u >> 16) & 1u); return (bf16_t)(u >> 16); }
#if defined(__HIP_DEVICE_COMPILE__)
typedef __bf16 bf16n2 __attribute__((ext_vector_type(2)));
typedef float f32n2 __attribute__((ext_vector_type(2)));
DEV unsigned pack2(float lo, float hi) { f32n2 v = {lo, hi}; bf16n2 r = __builtin_convertvector(v, bf16n2); return __builtin_bit_cast(unsigned, r); }
#else
DEV unsigned pack2(float lo, float hi) { return (unsigned)f2bf(lo) | ((unsigned)f2bf(hi) << 16); }
#endif
DEV float lo16(unsigned u) { return __uint_as_float(u << 16); }
DEV float hi16(unsigned u) { return __uint_as_float(u & 0xFFFF0000u); }
#if defined(__HIP_DEVICE_COMPILE__)
DEV float frcp(float x) { return __builtin_amdgcn_rcpf(x); }
#else
DEV float frcp(float x) { return 1.0f / x; }
#endif
#if defined(__HIP_DEVICE_COMPILE__)
DEV float sigmoidf_(float x) { return __builtin_amdgcn_rcpf(1.0f + __expf(-x)); }
#else
DEV float sigmoidf_(float x) { return 1.0f / (1.0f + __expf(-x)); }
#endif
DEV float logsigmoidf_(float x) { return fminf(x, 0.0f) - __logf(1.0f + __expf(-fabsf(x))); }
template <int M> DEV float shx(float v) {
#if defined(__HIP_DEVICE_COMPILE__)
    const unsigned u = __builtin_bit_cast(unsigned, v);
    if constexpr (M == 1) return __builtin_bit_cast(float, __builtin_amdgcn_update_dpp(u, u, 0xB1, 0xF, 0xF, false));
    else if constexpr (M == 2) return __builtin_bit_cast(float, __builtin_amdgcn_update_dpp(u, u, 0x4E, 0xF, 0xF, false));
    else if constexpr (M == 4) { const unsigned t = __builtin_amdgcn_update_dpp(u, u, 0x141, 0xF, 0xF, false);
        return __builtin_bit_cast(float, __builtin_amdgcn_update_dpp(t, t, 0x1B, 0xF, 0xF, false)); }
    else if constexpr (M == 8) return __builtin_bit_cast(float, __builtin_amdgcn_update_dpp(u, u, 0x128, 0xF, 0xF, false));
    else if constexpr (M == 16) { const auto r = __builtin_amdgcn_permlane16_swap(u, u, false, false); return __builtin_bit_cast(float, (threadIdx.x & 16) ? r[0] : r[1]); }
    else { const auto r = __builtin_amdgcn_permlane32_swap(u, u, false, false); return __builtin_bit_cast(float, (threadIdx.x & 32) ? r[0] : r[1]); }
#else
    return __shfl_xor(v, M);
#endif
}
DEV float wave_sum(float v) { v += shx<32>(v); v += shx<16>(v); v += shx<8>(v); v += shx<4>(v); v += shx<2>(v); v += shx<1>(v); return v; }
DEV bf16x8 mk8(u32x2 lo, u32x2 hi) { u32x4 v = {lo.x, lo.y, hi.x, hi.y}; return __builtin_bit_cast(bf16x8, v); }
DEV bf16x8 mk8(u32x4 v) { return __builtin_bit_cast(bf16x8, v); }
DEV bf16x8 mk8(s16x4 lo, s16x4 hi) { return __builtin_shufflevector(lo, hi, 0, 1, 2, 3, 4, 5, 6, 7); }
DEV f32x4 mfma16(bf16x8 a, bf16x8 b, f32x4 c) { return __builtin_amdgcn_mfma_f32_16x16x32_bf16(a, b, c, 0, 0, 0); }
DEV void store8bf(bf16_t* o, f32x4 a, f32x4 b) { u32x4 v = {pack2(a[0], a[1]), pack2(a[2], a[3]), pack2(b[0], b[1]), pack2(b[2], b[3])}; stg((u32x4*)o, v); }

#ifndef CPU_EMU
#define XB_TMO      128
#define XB_XCNT(j)  (256  + 64 * (j))
#define XB_XSUB(j)  (1280 + 64 * (j))
#define XB_XGEN(j)  (2304 + 64 * (j))
#define XB_TOP      3328
#define XB_TOPGEN   3392
#define XCD_BAR_WORDS 3456
#define XB_SPIN_CAP (1u << 18)
#define LAS __attribute__((address_space(3)))
__device__ __forceinline__ unsigned xb_ld(unsigned* p)              { return __hip_atomic_load(p, __ATOMIC_RELAXED, __HIP_MEMORY_SCOPE_AGENT); }
__device__ __forceinline__ unsigned xb_add(unsigned* p, unsigned v) { return __hip_atomic_fetch_add(p, v, __ATOMIC_RELAXED, __HIP_MEMORY_SCOPE_AGENT); }
__device__ __forceinline__ unsigned xb_xcc_id() { return (unsigned)__builtin_amdgcn_s_getreg((3 << 11) | 20) & 0xFu; }
#define XB_SPIN(cond, bar) do { unsigned _sp = 0; while (cond) { __builtin_amdgcn_s_sleep(1); \
    if ((++_sp & 255u) == 0u) { if (xb_ld(&(bar)[XB_TMO])) break; if (_sp > XB_SPIN_CAP) { atomicAdd(&(bar)[XB_TMO], 1u); break; } } } } while (0)
struct XcdBarrier { unsigned* bar; unsigned x; volatile LAS unsigned* st; };
__device__ __forceinline__ XcdBarrier xcd_barrier_post(unsigned* bar, volatile LAS unsigned* st) {
    XcdBarrier b; b.bar = bar; b.x = xb_xcc_id(); b.st = st;
    if (threadIdx.x == 0) (void)xb_add(&bar[XB_XCNT(b.x)], 1u);
    return b;
}
__device__ __forceinline__ void xcd_barrier_complete(unsigned* bar, unsigned x, unsigned& nloc, unsigned& nx) {
    const unsigned Gd = gridDim.x * gridDim.y * gridDim.z;
    unsigned sum, cnt, mine, sp = 0u;
    for (;;) {
        sum = 0u; cnt = 0u; mine = 0u;
#pragma unroll
        for (unsigned j = 0; j < 16; ++j) { const unsigned c = xb_ld(&bar[XB_XCNT(j)]); sum += c; cnt += (c > 0u) ? 1u : 0u; mine = (j == x) ? c : mine; }
        if (sum == Gd) break;
        __builtin_amdgcn_s_sleep(1);
        if ((++sp & 255u) == 0u) { if (xb_ld(&bar[XB_TMO])) break; if (sp > XB_SPIN_CAP) { atomicAdd(&bar[XB_TMO], 1u); break; } }
    }
    nloc = mine > 0u ? mine : 1u; nx = cnt > 0u ? cnt : 1u;
}
__device__ __forceinline__ void xcd_barrier(const XcdBarrier& b) {
    asm volatile("s_waitcnt vmcnt(0)" ::: "memory");
    __syncthreads();
    if (threadIdx.x == 0) {
        unsigned* bar = b.bar;
        unsigned bx = b.x; asm volatile("" : "+s"(bx));
        __builtin_amdgcn_s_waitcnt(0);
        unsigned nloc = b.st[0], nx = b.st[1];
        if (nloc == 0u) { xcd_barrier_complete(bar, bx, nloc, nx); b.st[0] = nloc; b.st[1] = nx; }
        const unsigned old = xb_add(&bar[XB_XSUB(bx)], 1u);
        const unsigned gen = old / nloc;
        if (old + 1u == (gen + 1u) * nloc) {
            __builtin_amdgcn_fence(__ATOMIC_RELEASE, "agent");
            asm volatile("s_waitcnt vmcnt(0)" ::: "memory");
            const unsigned og = xb_add(&bar[XB_TOP], 1u);
            const unsigned tg = og / nx;
            if (og + 1u == (tg + 1u) * nx) xb_add(&bar[XB_TOPGEN], 1u);
            else XB_SPIN(xb_ld(&bar[XB_TOPGEN]) == tg, bar);
            __builtin_amdgcn_fence(__ATOMIC_ACQUIRE, "agent");
            xb_add(&bar[XB_XGEN(bx)], 1u);
            asm volatile("s_waitcnt vmcnt(0)" ::: "memory");
        } else {
            XB_SPIN(xb_ld(&bar[XB_XGEN(bx)]) == gen, bar);
            __builtin_amdgcn_fence(__ATOMIC_ACQUIRE, "agent");
            asm volatile("s_waitcnt vmcnt(0)" ::: "memory");
        }
    }
    __syncthreads();
}
#endif

constexpr int BK = 64, HALF = 128, HT_BYTES = HALF * BK * 2;
DEV int lds_byte(int r, int c) { int st = (r >> 4) * 2 + (c >> 5), rr = r & 15, cc = c & 31, ob = rr * 64 + cc * 2; return st * 1024 + (ob ^ (((ob >> 9) & 1) << 5)); }
DEV void stage_rc(int b, int& Rr, int& Cc) { int st = b / 1024, sb = b % 1024, swz = sb ^ (((sb >> 9) & 1) << 5); Rr = (st >> 1) * 16 + swz / 64; Cc = (st & 1) * 32 + (swz % 64) / 2; }
DEV int perm32(int rho) { const int n = rho >> 4, i = rho & 15; return 8 * (i >> 2) + 4 * n + (i & 3); }

DEV bool tile_order(int i, int nM, int nN, int& pm, int& pn) {
    const int nwg = nM * nN; const int L = i * (int)gridDim.x + (int)blockIdx.x; if (L >= nwg) return false;
    int wgid = L; { const int q = nwg / 8, r = nwg % 8, xcd = wgid % 8, off = wgid / 8; wgid = (xcd < r ? xcd * (q + 1) : r * (q + 1) + (xcd - r) * q) + off; }
    const int nig = 8 * nN, gid = wgid / nig, fm = gid * 8, gsz = (nM - fm) < 8 ? (nM - fm) : 8;
    pm = fm + ((wgid % nig) % gsz); pn = (wgid % nig) / gsz; return true;
}
#define GLDS16(src, dst) __builtin_amdgcn_global_load_lds((const unsigned*)(src), (unsigned*)(dst), 16, 0, 0)

#define BAR __builtin_amdgcn_s_barrier()
#define SCHED __builtin_amdgcn_sched_barrier(0)
struct GUnit { int pm, pn, aux; };
template <bool GATHER, int LDA_, int LDB_, int K_, class Sched, class Epi>
DEV void gemm_stream(char* shm, const Sched& S, const Epi& epi) {
#define SA(b, h) (shm + ((b) * 2 + (h)) * HT_BYTES)
#define SB(b, h) (shm + (4 + (b) * 2 + (h)) * HT_BYTES)
#define STG_B(P, bp) do { GLDS16((bp) + voffB, (P) + ldsb0); GLDS16((bp) + voffB + 64 * LDB_, (P) + ldsb0 + 8192); } while (0)
#define STG_A(P, ap, h, gv) do { if (GATHER) { GLDS16((ap) + gv[h][0], (P) + ldsb0); GLDS16((ap) + gv[h][1], (P) + ldsb0 + 8192); } \
    else { GLDS16((ap) + voffA + (h) * 128 * LDA_, (P) + ldsb0); GLDS16((ap) + voffA + ((h) * 128 + 64) * LDA_, (P) + ldsb0 + 8192); } } while (0)
#define LDA(dst, b, h) _Pragma("unroll") for (int m = 0; m < 4; ++m) _Pragma("unroll") for (int k = 0; k < 2; ++k) \
    dst[m][k] = *reinterpret_cast<const bf16x8*>(SA(b, h) + aoff + m * 2048 + k * 1024)
#define LDB(dst, b, h) _Pragma("unroll") for (int n = 0; n < 2; ++n) _Pragma("unroll") for (int k = 0; k < 2; ++k) \
    dst[n][k] = *reinterpret_cast<const bf16x8*>(SB(b, h) + boff + n * 2048 + k * 1024)
#define MMA(ai, bj, At_, Bx_) do { __builtin_amdgcn_s_setprio(1); \
    _Pragma("unroll") for (int m = 0; m < 4; ++m) _Pragma("unroll") for (int n = 0; n < 2; ++n) _Pragma("unroll") for (int k = 0; k < 2; ++k) \
      acc[ai][bj][m][n] = mfma16(Bx_[n][k], At_[m][k], acc[ai][bj][m][n]); \
    __builtin_amdgcn_s_setprio(0); } while (0)
    constexpr int nt = K_ / BK;
    const int tid = TID();
    const int wid = __builtin_amdgcn_readfirstlane(tid >> 6), lane = tid & 63, wr = wid >> 2, wc = wid & 3, fr = lane & 15, fq = lane >> 4;
    const int ldsb0 = tid * 16;
    int Rr0, Cc0; stage_rc(tid * 16, Rr0, Cc0);
    const int voffA = Rr0 * LDA_ + Cc0;
    const int voffB = ((Rr0 & ~31) + perm32(Rr0 & 31)) * LDB_ + Cc0;
    const int aoff = lds_byte(wr * 64 + fr, fq * 8), boff = lds_byte(wc * 32 + fr, fq * 8);
    GUnit cur, nxt; int ui = 0;
    if (!S.next(0, cur)) return;
    int gc[2][2] = {{0, 0}, {0, 0}};
    int* gtab = (int*)(shm + 131072 + 256);
    if (GATHER) {
        __syncthreads();
        { GUnit u; for (int i = 0; i < GT_MAXU && S.next(i, u); ++i) { if (tid < 256) gtab[i * 256 + tid] = ldg(S.ridx(u) + tid) * LDA_; } }
        __syncthreads();
#pragma unroll
        for (int h = 0; h < 2; ++h)
#pragma unroll
            for (int i = 0; i < 2; ++i) gc[h][i] = gtab[h * 128 + i * 64 + Rr0] + Cc0;
    }
    f32x4 acc[2][2][4][2];
#pragma unroll
    for (int a = 0; a < 2; ++a)
#pragma unroll
        for (int b = 0; b < 2; ++b)
#pragma unroll
            for (int m = 0; m < 4; ++m)
#pragma unroll
                for (int n = 0; n < 2; ++n) acc[a][b][m][n] = (f32x4){0.f, 0.f, 0.f, 0.f};
    bf16x8 At[4][2], B0[2][2], B1[2][2];
    const bf16_t* cA = S.a_base(cur); const bf16_t* cB = S.b_base(cur);
    STG_B(SB(0, 0), cB); STG_A(SA(0, 0), cA, 0, gc); STG_B(SB(0, 1), cB + 128 * LDB_); STG_A(SA(0, 1), cA, 1, gc);
    if (wr == 1) BAR;
    WAIT_V(4); BAR;
    STG_B(SB(1, 0), cB + BK); STG_A(SA(1, 0), cA + BK, 0, gc); STG_B(SB(1, 1), cB + 128 * LDB_ + BK);
    WAIT_V(6); BAR;
    for (;;) {
        const bool has_next = S.next(ui + 1, nxt);
        const bf16_t* nA = has_next ? S.a_base(nxt) : cA; const bf16_t* nB = has_next ? S.b_base(nxt) : cB;
#pragma unroll 1
        for (int t = 0; t < nt; t += 2) {
            const bool last = (t == nt - 2);
            const bf16_t* a1 = cA + (t + 1) * BK;
            const bf16_t* a2 = last ? nA : cA + (t + 2) * BK; const bf16_t* b2 = last ? nB : cB + (t + 2) * BK;
            const bf16_t* a3 = a2 + BK; const bf16_t* b3 = b2 + BK;
            LDB(B0, 0, 0); SCHED; LDA(At, 0, 0); STG_A(SA(1, 1), a1, 1, gc);
            if (GATHER && last && has_next) {
#pragma unroll
                for (int h = 0; h < 2; ++h)
#pragma unroll
                    for (int i = 0; i < 2; ++i) gc[h][i] = gtab[(ui + 1) * 256 + h * 128 + i * 64 + Rr0] + Cc0; }
            WAIT_L(8); BAR; WAIT_L(0); MMA(0, 0, At, B0); BAR; SCHED;
            LDB(B1, 0, 1); STG_B(SB(0, 0), b2);
            BAR; WAIT_L(0); MMA(0, 1, At, B1); BAR;
            LDA(At, 0, 1); STG_A(SA(0, 0), a2, 0, gc);
            BAR; WAIT_L(0); MMA(1, 0, At, B0); BAR; SCHED;
            STG_B(SB(0, 1), b2 + 128 * LDB_);
            WAIT_V(6); BAR; MMA(1, 1, At, B1); BAR;
            LDB(B0, 1, 0); SCHED; LDA(At, 1, 0); STG_A(SA(0, 1), a2, 1, gc);
            WAIT_L(8); BAR; WAIT_L(0); MMA(0, 0, At, B0); BAR; SCHED;
            LDB(B1, 1, 1); STG_B(SB(1, 0), b3);
            BAR; WAIT_L(0); MMA(0, 1, At, B1); BAR;
            LDA(At, 1, 1); STG_A(SA(1, 0), a3, 0, gc);
            BAR; WAIT_L(0); MMA(1, 0, At, B0); BAR; SCHED;
            STG_B(SB(1, 1), b3 + 128 * LDB_);
            WAIT_V(6); BAR; MMA(1, 1, At, B1); BAR;
        }
        {
            const int tz = TID(); const int wz = tz >> 6, lz = tz & 63, wrz = wz >> 2, wcz = wz & 3, frz = lz & 15, fqz = lz >> 4;
            epi(cur, acc, wrz * 64 + frz, wcz * 32 + 8 * fqz);
        }
        if (!has_next) break;
#pragma unroll
        for (int a = 0; a < 2; ++a)
#pragma unroll
            for (int b = 0; b < 2; ++b)
#pragma unroll
                for (int m = 0; m < 4; ++m)
#pragma unroll
                    for (int n = 0; n < 2; ++n) acc[a][b][m][n] = (f32x4){0.f, 0.f, 0.f, 0.f};
        cur = nxt; cA = nA; cB = nB; ++ui;
    }
    WAIT_V(0);
    if (wr == 0) BAR;
    BAR;
#undef SA
#undef SB
#undef STG_A
#undef STG_B
#undef LDA
#undef LDB
#undef MMA
}

constexpr int J_IN = 16 * 27, J_WB = 2 * 8 * 4, J_WO = 16 * 4, J_GU = 16 * 2 * 64, J_DN = 16 * 64, J_FOLD = 8 * 16, J_PAD = 1;
constexpr int N_MODJOBS = 2 * 96;

constexpr int J_BIG = J_IN + J_WB + J_WO + J_GU + J_DN;
struct WJob { const float* src; bf16_t* dst; int ldsrc, lddst, nvalid, k0, n0, mode, gu_which; };
DEV WJob wjob_decode(const Params& p, int l, int j) {
    WJob w; w.ldsrc = 1024; w.lddst = 1024; w.nvalid = 256; w.mode = 0; w.gu_which = 0;
    if (j < J_IN) { const int kt = j / 27, nb = j % 27; w.k0 = kt * 64; w.n0 = nb * 256; w.src = p.w_in + (size_t)l * 1024 * PWSRC; w.ldsrc = PWSRC; w.nvalid = PWSRC - w.n0; w.dst = p.WinT() + (size_t)l * PWT * 1024; w.mode = 3; }
    else if ((j -= J_IN) < J_WB) { const int bi = (j / 32) * 2, jj = j % 32, kt = jj / 4, nb = jj % 4; w.k0 = kt * 64; w.n0 = nb * 256;
        w.src = p.w_branch + ((size_t)l * 3 + bi) * 512 * 1024; w.dst = p.WbT() + ((size_t)l * 3 + bi) * 1024 * 512; w.lddst = 512; }
    else if ((j -= J_WB) < J_WO) { const int kt = j / 4, nb = j % 4; w.k0 = kt * 64; w.n0 = nb * 256; w.src = p.w_out + (size_t)l * 1024 * 1024; w.dst = p.WoT() + (size_t)l * 1024 * 1024; }
    else if ((j -= J_WO) < J_GU) { const int e = j / 128, jj = j % 128; w.gu_which = jj / 64; const int j3 = jj % 64, kt = j3 / 4, nb = j3 % 4; w.k0 = kt * 64; w.n0 = nb * 256;
        w.src = (w.gu_which ? p.w_up : p.w_gate) + ((size_t)l * 16 + e) * 1024 * 1024; w.dst = p.WguT() + ((size_t)l * 16 + e) * 2048 * 1024; w.mode = 1; }
    else { j -= J_GU; const int e = j / 64, jj = j % 64, kt = jj / 4, nb = jj % 4; w.k0 = kt * 64; w.n0 = nb * 256;
        w.src = p.w_down + ((size_t)l * 16 + e) * 1024 * 1024; w.dst = p.WdT() + ((size_t)l * 16 + e) * 1024 * 1024; }
    return w;
}
constexpr int WT_LD = 260;
DEV void wjob_load(const WJob& w, int tid, f32x4 (&vv)[8]) {
#pragma unroll
    for (int i = 0; i < 8; ++i) { const int idx = i * 512 + tid, r = idx >> 6, c = (idx & 63) * 4; int col = w.n0 + c; col = col > w.ldsrc - 4 ? w.ldsrc - 4 : col;
        vv[i] = ldg((const f32x4*)(w.src + (size_t)(w.k0 + r) * w.ldsrc + col)); }
}
DEV void wjob_finish(const WJob& w, int tid, const f32x4 (&vv)[8], float* tile) {
    __syncthreads();
#pragma unroll
    for (int i = 0; i < 8; ++i) { const int idx = i * 512 + tid, r = idx >> 6, c = (idx & 63) * 4; *(f32x4*)(tile + r * WT_LD + c) = vv[i]; }
    __syncthreads();
#pragma unroll
    for (int q = 0; q < 4; ++q) {
        const int item = q * 512 + tid, nrow = item >> 3, kc = (item & 7) * 8;
        float v[8];
#pragma unroll
        for (int jj = 0; jj < 8; ++jj) v[jj] = tile[(kc + jj) * WT_LD + nrow];
        const int n = w.n0 + nrow;
        int drow = n;
        if (w.mode == 1) drow = (n >> 7) * 256 + w.gu_which * 128 + (n & 127);
        if (w.mode == 3) drow = n + (n >= C_SPLIT ? (PWA - C_SPLIT) : 0);
        if (nrow < w.nvalid) { u32x4 o = {pack2(v[0], v[1]), pack2(v[2], v[3]), pack2(v[4], v[5]), pack2(v[6], v[7])};
            stg((u32x4*)(w.dst + (size_t)drow * w.lddst + w.k0 + kc), o); }
    }
}
DEV void pro_small_job(const Params& p, int l, int j, char* shm) {
    float* tile = (float*)shm;
    const int tid = TID();
    if (j < J_FOLD) {
        const int kt = j / 16, ntl = j % 16, k0 = kt * 64, n0 = ntl * 64; const int fg = k0 / 128;
        const float* wb1 = p.w_branch + ((size_t)l * 3 + 1) * 512 * 1024;
        const float* pw = p.pool_w + ((size_t)l * 4 + fg) * 128 * 128; const float* ps = p.pool_scale + (size_t)l * 512 + fg * 128;
        const int c = tid & 63, rq = tid >> 6;
        float accv[8];
#pragma unroll
        for (int i = 0; i < 8; ++i) accv[i] = 0.f;
        for (int d = 0; d < 128; ++d) { const float wv = ldg(wb1 + (size_t)(fg * 128 + d) * 1024 + n0 + c) * ldg(ps + d);
#pragma unroll
            for (int i = 0; i < 8; ++i) accv[i] += ldg(pw + (size_t)(k0 - fg * 128 + rq * 8 + i) * 128 + d) * wv; }
        __syncthreads();
#pragma unroll
        for (int i = 0; i < 8; ++i) tile[(rq * 8 + i) * WT_LD + c] = accv[i];
        __syncthreads();
        const int nrow = tid >> 3, kc = (tid & 7) * 8; float v[8];
#pragma unroll
        for (int jj = 0; jj < 8; ++jj) v[jj] = tile[(kc + jj) * WT_LD + nrow];
        u32x4 o = {pack2(v[0], v[1]), pack2(v[2], v[3]), pack2(v[4], v[5]), pack2(v[6], v[7])};
        stg((u32x4*)(p.WbT() + ((size_t)l * 3 + 1) * 1024 * 512 + (size_t)(n0 + nrow) * 512 + k0 + kc), o);
    } else {
        bf16_t* d0 = p.WinT() + (size_t)l * PWT * 1024 + (size_t)C_SPLIT * 1024;
        for (int i = tid; i < (PWA - C_SPLIT) * 1024 / 8; i += NTHREADS) stg((u32x4*)(d0 + (size_t)i * 8), (u32x4){0u, 0u, 0u, 0u});
    }
}

DEV void pro_mod_job(const Params& p, int job, char* shm) {
    float* sv = (float*)shm;
    const int tid = TID(), l = job / 96, col0 = (job % 96) * 64;
    const int c = tid & 63, kp = tid >> 6;
    float acc[NB + 1];
#pragma unroll
    for (int v = 0; v <= NB; ++v) acc[v] = 0.f;
    for (int half = 0; half < 2; ++half) {
        __syncthreads();
        for (int idx = tid; idx < (NB + 1) * 512; idx += 512) { const int v = idx >> 9, k = idx & 511;
            const float s = (v < NB) ? ldg(p.c + (size_t)v * 1024 + half * 512 + k) : ldg(p.c_ctx + half * 512 + k);
            sv[idx] = s * sigmoidf_(s); }
        __syncthreads();
        for (int kk = 0; kk < 64; ++kk) { const int k = kp * 64 + kk;
            const float w = ldg(p.ada_w + ((size_t)l * 1024 + half * 512 + k) * 6144 + col0 + c);
#pragma unroll
            for (int v = 0; v <= NB; ++v) acc[v] += sv[v * 512 + k] * w; }
    }
    __syncthreads();
    float* red = (float*)shm;
#pragma unroll
    for (int v = 0; v <= NB; ++v) red[(kp * (NB + 1) + v) * 64 + c] = acc[v];
    __syncthreads();
    for (int idx = tid; idx < (NB + 1) * 64; idx += 512) { const int v = idx >> 6, cc = idx & 63; float s = 0.f;
#pragma unroll
        for (int q = 0; q < 8; ++q) s += red[(q * (NB + 1) + v) * 64 + cc];
        stg(p.mod() + ((size_t)l * (NB + 1) + v) * 6144 + col0 + cc, s + ldg(p.ada_b + (size_t)l * 6144 + col0 + cc)); }
}

DEV void phase_prologue(const Params& p, char* shm) {
    const int tid = TID();
    const int nsmall = N_MODJOBS + 1 + 2 * (J_FOLD + J_PAD);
    for (int job = blockIdx.x; job < nsmall; job += gridDim.x) {
        if (job < N_MODJOBS) pro_mod_job(p, job, shm);
        else if (job == N_MODJOBS) {
            for (int idx = tid; idx < (ROWS + 64) * 16; idx += NTHREADS) { const int pos = idx >> 4, i = idx & 15;
                const float pv = (float)(pos < ROWS ? pos : pos - ROWS);
                const float inv = powf(10000.0f, -(float)(2 * i) / 32.0f);
                const float a = pv * inv; stg(p.rope() + idx * 2, cosf(a)); stg(p.rope() + idx * 2 + 1, sinf(a)); }
        } else { const int sj = job - N_MODJOBS - 1; pro_small_job(p, sj / (J_FOLD + J_PAD), sj % (J_FOLD + J_PAD), shm); }
    }
    float* tile = (float*)shm;
    const int nbig = 2 * J_BIG;
    int job = blockIdx.x;
    if (job >= nbig) return;
    WJob wc = wjob_decode(p, job / J_BIG, job % J_BIG), wn = wc;
    f32x4 vc[8], vn[8];
    wjob_load(wc, tid, vc);
    for (; job < nbig; job += gridDim.x) {
        const int jn = job + gridDim.x;
        if (jn < nbig) { wn = wjob_decode(p, jn / J_BIG, jn % J_BIG); wjob_load(wn, tid, vn); }
        wjob_finish(wc, tid, vc, tile);
        wc = wn;
#pragma unroll
        for (int i = 0; i < 8; ++i) vc[i] = vn[i];
    }
}

DEV const float* xsrc_base(const Params& p, const SetDesc& sd, int layer) {
    return (sd.is_ctx ? (layer == 0 ? p.ctx : (const float*)p.ctxs()) : (layer == 0 ? p.x : (const float*)p.out)) + (((size_t)sd.samp0) << sd.lgseq) * 1024;
}
DEV float* xdst_base(const Params& p, const SetDesc& sd) { return (sd.is_ctx ? p.ctxs() : p.out) + (((size_t)sd.samp0) << sd.lgseq) * 1024; }
DEV const float* mod_row(const Params& p, const SetDesc& sd, int layer, int row) {
    return p.mod() + ((size_t)layer * (NB + 1) + (sd.is_ctx ? NB : sd.samp0 + (row >> sd.lgseq))) * 6144;
}
DEV bf16_t* proj_buf(const Params& p, const SetDesc& sd) { return sd.is_ctx ? p.PROJc() : p.PROJa(); }

DEV void stage_params(float* par, const float* v0, const float* v1, const float* v2, const float* v3, const float* v4) {
    const int tid = TID();
    const float* src[5] = {v0, v1, v2, v3, v4};
#pragma unroll
    for (int k = 0; k < 5; ++k) if (src[k]) { for (int i = tid; i < 1024; i += NTHREADS) par[k * 1024 + i] = ldg(src[k] + i); }
}
DEV void phase_norm1(const Params& p, const SetDesc& sd, int layer, char* shm) {
    const int tid = TID(), lane = tid & 63, wv = tid >> 6;
    const float* g0 = p.norm_gain + ((size_t)layer * 4 + 0) * 1024;
    const float* xb = xsrc_base(p, sd, layer);
    const int stride = 8; const int rpb_ = (sd.nrows + (int)gridDim.x - 1) / (int)gridDim.x; const int row_end = min(sd.nrows, ((int)blockIdx.x + 1) * rpb_);
    int row = (int)blockIdx.x * rpb_ + wv;
    float* par = (float*)shm;
    __syncthreads();
    { const float* mdb = mod_row(p, sd, layer, min((int)blockIdx.x * rpb_, sd.nrows - 1)); stage_params(par, g0, mdb, mdb + 1024, nullptr, nullptr); }
    __syncthreads();
    f32x4 cur[4], nxt[4];
    if (row < row_end) {
#pragma unroll
        for (int i = 0; i < 4; ++i) cur[i] = ldg((const f32x4*)(xb + (size_t)row * 1024 + (i >> 1) * 512 + lane * 8 + (i & 1) * 4)); }
    for (; row < row_end; row += stride) {
        const int rn = row + stride;
        if (rn < row_end) {
#pragma unroll
            for (int i = 0; i < 4; ++i) nxt[i] = ldg((const f32x4*)(xb + (size_t)rn * 1024 + (i >> 1) * 512 + lane * 8 + (i & 1) * 4)); }
        const float* md = mod_row(p, sd, layer, row);
        float ss = 0.f;
#pragma unroll
        for (int i = 0; i < 4; ++i)
#pragma unroll
            for (int j = 0; j < 4; ++j) ss += cur[i][j] * cur[i][j];
        ss = wave_sum(ss);
        const float rstd = rsqrtf(ss * (1.0f / 1024.0f) + RMS_EPS);
#pragma unroll
        for (int hlf = 0; hlf < 2; ++hlf) { const int c0 = hlf * 512 + lane * 8; float o[8];
#pragma unroll
            for (int j = 0; j < 8; ++j) o[j] = cur[hlf * 2 + (j >> 2)][j & 3] * rstd * par[c0 + j] * (1.0f + par[2048 + c0 + j]) + par[1024 + c0 + j];
            u32x4 ov = {pack2(o[0], o[1]), pack2(o[2], o[3]), pack2(o[4], o[5]), pack2(o[6], o[7])};
            stg((u32x4*)(p.H() + (size_t)row * 1024 + c0), ov); }
#pragma unroll
        for (int i = 0; i < 4; ++i) cur[i] = nxt[i];
    }
}

struct SchedPlain {
    const bf16_t* A; const bf16_t* Bt; int nM, nN, lda256, ldb256;
    DEV bool next(int i, GUnit& u) const { u.aux = 0; return tile_order(i, nM, nN, u.pm, u.pn); }
    DEV const bf16_t* a_base(const GUnit& u) const { return A + (size_t)u.pm * lda256; }
    DEV const bf16_t* b_base(const GUnit& u) const { return Bt + (size_t)u.pn * ldb256; }
    DEV const int* ridx(const GUnit&) const { return nullptr; }
};
DEV void phase_proj_a(const Params& p, const SetDesc& sd, int layer, char* shm) {
    SchedPlain S; S.A = p.H(); S.Bt = p.WinT() + (size_t)layer * PWT * 1024; S.nM = sd.nrows / 256; S.nN = PWA / 256; S.lda256 = 256 * 1024; S.ldb256 = 256 * 1024;
    bf16_t* pb = proj_buf(p, sd);
    gemm_stream<false, 1024, 1024, 1024>(shm, S, [=](const GUnit& u, const f32x4 (&acc)[2][2][4][2], int r0, int c0) {
#pragma unroll
        for (int ai = 0; ai < 2; ++ai)
#pragma unroll
            for (int m = 0; m < 4; ++m) { bf16_t* o = pb + ((size_t)u.pm * 256 + r0 + ai * 128 + m * 16) * PWA + u.pn * 256 + c0;
                store8bf(o, acc[ai][0][m][0], acc[ai][0][m][1]); store8bf(o + 128, acc[ai][1][m][0], acc[ai][1][m][1]); } });
}
DEV f32x4 sig4(f32x4 v) { f32x4 r; r[0] = sigmoidf_(v[0]); r[1] = sigmoidf_(v[1]); r[2] = sigmoidf_(v[2]); r[3] = sigmoidf_(v[3]); return r; }
DEV void phase_proj_b(const Params& p, const SetDesc& sd, int layer, char* shm) {
    SchedPlain S; S.A = p.H(); S.Bt = p.WinT() + (size_t)layer * PWT * 1024 + (size_t)PWA * 1024; S.nM = sd.nrows / 256; S.nN = NBG / 256; S.lda256 = 256 * 1024; S.ldb256 = 256 * 1024;
    bf16_t* bg = p.BG();
    gemm_stream<false, 1024, 1024, 1024>(shm, S, [=](const GUnit& u, const f32x4 (&acc)[2][2][4][2], int r0, int c0) {
#pragma unroll
        for (int ai = 0; ai < 2; ++ai)
#pragma unroll
            for (int m = 0; m < 4; ++m) { bf16_t* o = bg + ((size_t)u.pm * 256 + r0 + ai * 128 + m * 16) * NBG + u.pn * 256 + c0;
                store8bf(o, sig4(acc[ai][0][m][0]), sig4(acc[ai][0][m][1])); store8bf(o + 128, sig4(acc[ai][1][m][0]), sig4(acc[ai][1][m][1])); } });
}

DEV void gate_scan(const bf16_t* prow, int h, const float* gbias, float* ga, float* gb, float* gpm, float* gtot, float* tmp) {
    const int tid = TID(), lane = tid & 63, w = tid >> 6;
    float b = 0.f, a = 0.f, pm = 0.f; int d = 0, tok = 0;
    if (tid < 256) {
        d = tid >> 7; const int i = tid & 127; tok = d ? 127 - i : i;
        const float gi = bf2f(ldg(prow + (size_t)tok * PWA + C_GM + (2 * d) * 4 + h)) + ldg(gbias + (2 * d) * 4 + h);
        const float gf = bf2f(ldg(prow + (size_t)tok * PWA + C_GM + (2 * d + 1) * 4 + h)) + ldg(gbias + (2 * d + 1) * 4 + h);
        b = logsigmoidf_(gf);
#pragma unroll
        for (int o = 1; o < 64; o <<= 1) { const float t = __shfl_up(b, o); if (lane >= o) b += t; }
        if (lane == 63) tmp[w] = b;
        a = gi;
    }
    __syncthreads();
    if (tid < 256) {
        if (w & 1) b += tmp[w - 1];
        a -= b; pm = a;
#pragma unroll
        for (int o = 1; o < 64; o <<= 1) { const float t = __shfl_up(pm, o); if (lane >= o) pm = fmaxf(pm, t); }
        if (lane == 63) tmp[8 + w] = pm;
    }
    __syncthreads();
    if (tid < 256) {
        if (w & 1) pm = fmaxf(pm, tmp[8 + w - 1]);
        ga[d * 128 + tok] = a; gb[d * 128 + tok] = b; gpm[d * 128 + tok] = pm;
        if ((tid & 127) == 127) { gtot[d * 2] = b; gtot[d * 2 + 1] = pm; }
    }
    __syncthreads();
}

DEV void load_rope_chunk(const bf16_t* hp, int cidx, bool latent, int tl, const float* rope, float scale, float* o) {
    const u32x4 m = ldg((const u32x4*)(hp + cidx * 8));
    float x[8] = {lo16(m.x), hi16(m.x), lo16(m.y), hi16(m.y), lo16(m.z), hi16(m.z), lo16(m.w), hi16(m.w)};
    if (latent) {
        const u32x4 q = ldg((const u32x4*)(hp + (cidx ^ 2) * 8));
        const float y[8] = {lo16(q.x), hi16(q.x), lo16(q.y), hi16(q.y), lo16(q.z), hi16(q.z), lo16(q.w), hi16(q.w)};
        const int pos = (cidx < 4) ? (tl >> 6) : (ROWS + (tl & 63));
        const float* tb = rope + ((size_t)pos * 16 + (cidx & 1) * 8) * 2;
        const bool first = (cidx & 2) == 0;
#pragma unroll
        for (int j = 0; j < 8; ++j) { const float cs = ldg(tb + j * 2), sn = ldg(tb + j * 2 + 1);
            x[j] = first ? (x[j] * cs - y[j] * sn) : (x[j] * cs + y[j] * sn); }
    }
#pragma unroll
    for (int j = 0; j < 8; ++j) o[j] = x[j] * scale;
}

DEV int st_index(const SetDesc& sd, int sl, int h, int dir, int tb) { return ((sl * 4 + h) * 2 + dir) * sd.ntb + tb; }

constexpr int V_LD = 144, K_LD = 72, KS_LD = 80;
DEV void mlstm_stepA_task(const Params& p, const SetDesc& sd, int layer, int task, char* shm) {
    const int tid = TID(), lane = tid & 63, w = tid >> 6, fr = lane & 15, fq = lane >> 4, tq4 = (lane & 15) >> 2, tp4 = lane & 3;
    const int tb = task % sd.ntb, h = (task / sd.ntb) & 3, sl = task / (sd.ntb * 4);
    const int row0 = (sl << sd.lgseq) + tb * 128; const bool latent = !sd.is_ctx; const int tl0 = tb * 128;
    bf16_t* Vs = (bf16_t*)shm;
    bf16_t* Ksc = (bf16_t*)(shm + 128 * V_LD * 2);
    float* ga = (float*)(shm + 128 * V_LD * 2 + 2 * 128 * KS_LD * 2); float* gb = ga + 256; float* gpm = gb + 256; float* gtot = gpm + 256; float* tmp = gtot + 8;
    const bf16_t* prow = proj_buf(p, sd) + (size_t)row0 * PWA;
    __syncthreads();
    gate_scan(prow, h, p.gate_bias + (size_t)layer * 16, ga, gb, gpm, gtot, tmp);
    {
        const int s = tid & 127, cpi = tid >> 7, cp = (cpi & 1) + (cpi >> 1) * 4;
        const bf16_t* hp = prow + (size_t)s * PWA + C_KM + h * 64;
        float k1[8], k2[8];
        load_rope_chunk(hp, cp, latent, tl0 + s, p.rope(), 1.0f, k1);
        load_rope_chunk(hp, cp + 2, latent, tl0 + s, p.rope(), 1.0f, k2);
#pragma unroll
        for (int dir = 0; dir < 2; ++dir) { const float ws = __expf(ga[dir * 128 + s] - gtot[dir * 2 + 1]);
            u32x4 o1 = {pack2(k1[0] * ws, k1[1] * ws), pack2(k1[2] * ws, k1[3] * ws), pack2(k1[4] * ws, k1[5] * ws), pack2(k1[6] * ws, k1[7] * ws)};
            u32x4 o2 = {pack2(k2[0] * ws, k2[1] * ws), pack2(k2[2] * ws, k2[3] * ws), pack2(k2[4] * ws, k2[5] * ws), pack2(k2[6] * ws, k2[7] * ws)};
            *(u32x4*)(Ksc + (dir * 128 + s) * KS_LD + cp * 8) = o1; *(u32x4*)(Ksc + (dir * 128 + s) * KS_LD + (cp + 2) * 8) = o2; }
    }
#pragma unroll
    for (int it = 0; it < 4; ++it) { const int item = tid + it * 512, s = item >> 4, ch = item & 15;
        *(u32x4*)(Vs + s * V_LD + ch * 8) = ldg((const u32x4*)(prow + (size_t)s * PWA + C_VM + h * 128 + ch * 8)); }
    __syncthreads();
    f32x4 acc[2][4];
#pragma unroll
    for (int dir = 0; dir < 2; ++dir)
#pragma unroll
        for (int n = 0; n < 4; ++n) acc[dir][n] = (f32x4){0.f, 0.f, 0.f, 0.f};
#pragma unroll
    for (int ks = 0; ks < 4; ++ks) {
        const bf16_t* vp = Vs + (32 * ks + 4 * fq + tq4) * V_LD + w * 16 + 4 * tp4;
        const bf16x8 af = mk8(TR16(vp), TR16(vp + 16 * V_LD));
#pragma unroll
        for (int dir = 0; dir < 2; ++dir)
#pragma unroll
            for (int n = 0; n < 4; ++n) { const bf16_t* kp = Ksc + (dir * 128 + 32 * ks + 4 * fq + tq4) * KS_LD + n * 16 + 4 * tp4;
                const bf16x8 bfv = mk8(TR16(kp), TR16(kp + 16 * KS_LD));
                acc[dir][n] = mfma16(af, bfv, acc[dir][n]); }
    }
#pragma unroll
    for (int dir = 0; dir < 2; ++dir) { float* So = p.Sst() + (size_t)st_index(sd, sl, h, dir, tb) * 8192;
#pragma unroll
        for (int n = 0; n < 4; ++n)
#pragma unroll
            for (int r = 0; r < 4; ++r) stg(So + (w * 16 + fq * 4 + r) * 64 + n * 16 + fr, (float)acc[dir][n][r]); }
    if (tid < 128) { const int dir = tid >> 6, dd = tid & 63; float sm = 0.f;
        for (int i = 0; i < 128; ++i) sm += bf2f(Ksc[(dir * 128 + i) * KS_LD + dd]);
        stg(p.Sn() + (size_t)st_index(sd, sl, h, dir, tb) * 64 + dd, sm); }
    if (tid < 2) { float* sc = p.Ssc() + (size_t)st_index(sd, sl, h, tid, tb) * 4; stg(sc, gtot[tid * 2]); stg(sc + 1, gtot[tid * 2] + gtot[tid * 2 + 1]); }
}

template <int GI> DEV void pool_group(const Params& p, const SetDesc& sd, const bf16_t* pb) {
    constexpr int W = 2 << GI;
    const int nitems = sd.nrows * 16; const int T = 1 << sd.lgseq;
    for (int item = blockIdx.x * NTHREADS + TID(); item < nitems; item += gridDim.x * NTHREADS) {
        const int row = item >> 4, ch = GI * 128 + (item & 15) * 8;
        const int tt = row & (T - 1);
        u32x4 mv[W]; int cnt = 0; bool okv[W];
#pragma unroll
        for (int q = 0; q < W; ++q) { const int t2 = tt - W / 2 + q; const bool ok = (t2 >= 0) && (t2 < T); cnt += ok ? 1 : 0; okv[q] = ok;
            mv[q] = ldg((const u32x4*)(pb + (size_t)(ok ? (row - W / 2 + q) : row) * PWA + C_PU + ch)); }
        float s[8];
#pragma unroll
        for (int j = 0; j < 8; ++j) s[j] = 0.f;
#pragma unroll
        for (int q = 0; q < W; ++q) { u32x4 m = mv[q]; if (!okv[q]) m = (u32x4){0u, 0u, 0u, 0u};
            s[0] += lo16(m.x); s[1] += hi16(m.x); s[2] += lo16(m.y); s[3] += hi16(m.y); s[4] += lo16(m.z); s[5] += hi16(m.z); s[6] += lo16(m.w); s[7] += hi16(m.w); }
        const float inv = frcp((float)cnt);
        const u32x4 m = mv[W / 2];
        const float u[8] = {lo16(m.x), hi16(m.x), lo16(m.y), hi16(m.y), lo16(m.z), hi16(m.z), lo16(m.w), hi16(m.w)};
        u32x4 o = {pack2(s[0] * inv - u[0], s[1] * inv - u[1]), pack2(s[2] * inv - u[2], s[3] * inv - u[3]), pack2(s[4] * inv - u[4], s[5] * inv - u[5]), pack2(s[6] * inv - u[6], s[7] * inv - u[7])};
        stg((u32x4*)(p.Pb() + (size_t)row * 512 + ch), o);
    }
}
DEV void phase_pool(const Params& p, const SetDesc& sd) {
    const bf16_t* pb = proj_buf(p, sd);
    pool_group<0>(p, sd, pb); pool_group<1>(p, sd, pb); pool_group<2>(p, sd, pb); pool_group<3>(p, sd, pb);
}

template <int NC> DEV void mlstm_stepB_run(const Params& p, const SetDesc& sd, int task) {
    const int tid = TID();
    const int q = task & 3, dir = (task >> 2) & 1, h = (task >> 3) & 3, sl = task >> 5;
    const int ci = ((sd.samp0 + sl) * 4 + h) * 2 + dir;
    const int eoff = q * 2048 + tid * 4;
    float zr = 0.f; HIDE(zr);
    f32x4 C = {zr, zr, zr, zr}; float nv = 0.f; float m = -1e30f;
    f32x4 Sv[NC]; float blv[NC], mlv[NC], snv[NC];
#pragma unroll
    for (int c = 0; c < NC; ++c) { const int tb = dir ? NC - 1 - c : c; const size_t si = st_index(sd, sl, h, dir, tb);
        Sv[c] = ldg((const f32x4*)(p.Sst() + si * 8192 + eoff)); blv[c] = ldg(p.Ssc() + si * 4); mlv[c] = ldg(p.Ssc() + si * 4 + 1);
        snv[c] = (q == 0 && tid < 64) ? ldg(p.Sn() + si * 64 + tid) : 0.f; }
    if (!sd.is_ctx) { C = ldg((const f32x4*)(p.CiC() + (size_t)ci * 8192 + eoff)); if (q == 0 && tid < 64) nv = ldg(p.Cin_() + (size_t)ci * 64 + tid); m = ldg(p.Cim() + (size_t)ci * 4); }
#pragma unroll
    for (int c = 0; c < NC; ++c) {
        const int tb = dir ? NC - 1 - c : c; const size_t si = st_index(sd, sl, h, dir, tb);
        u32x2 o = {pack2(C[0], C[1]), pack2(C[2], C[3])};
        stg((u32x2*)(p.Cin() + si * 8192 + eoff), o);
        if (q == 0 && tid < 64) stg(p.Cn() + si * 64 + tid, nv);
        if (q == 0 && tid == 0) stg(p.Cm() + si * 4, m);
        const float mn = fmaxf(blv[c] + m, mlv[c]);
        const float dc = __expf(blv[c] + m - mn), wsn = __expf(mlv[c] - mn);
        C = C * dc + Sv[c] * wsn;
        nv = nv * dc + snv[c] * wsn;
        m = mn;
    }
    if (sd.is_ctx) { stg((f32x4*)(p.CiC() + (size_t)ci * 8192 + eoff), C); if (q == 0 && tid < 64) stg(p.Cin_() + (size_t)ci * 64 + tid, nv); if (q == 0 && tid == 0) stg(p.Cim() + (size_t)ci * 4, m); }
}
DEV void mlstm_stepB_task(const Params& p, const SetDesc& sd, int task) {
    if (sd.is_ctx) mlstm_stepB_run<NTBC>(p, sd, task); else mlstm_stepB_run<NTBL>(p, sd, task);
}

constexpr int NA_KLD = 136, NA_VLD = 144;
DEV void na_task(const Params& p, const SetDesc& sd, int layer, int sl, int rq2  , int hp, char* shm) {
    const int tid = TID(), lane = tid & 63, w = tid >> 6, tq = lane & 15, fq = lane >> 4, tq4 = (lane & 15) >> 2, tp4 = lane & 3;
    const int hh = w >> 2, g = w & 3, head = hp * 2 + hh;
    const bool ctxq = sd.is_ctx;
    bf16_t* Ks = (bf16_t*)shm;
    bf16_t* Vs = (bf16_t*)(shm + 128 * NA_KLD * 2);
    float* rpbs = (float*)(shm + 128 * NA_KLD * 2 + 128 * NA_VLD * 2);
    const int sample = sd.samp0 + sl;
    const bf16_t* pq = proj_buf(p, sd) + ((size_t)sl << sd.lgseq) * PWA;
    const bf16_t* pc = p.PROJc() + (size_t)sample * CTX * PWA;
    const int qcol = g * 16 + tq;
    int rqv[2], rsv[2], qtok[2];
#pragma unroll
    for (int u = 0; u < 2; ++u) { rqv[u] = 2 * rq2 + u; qtok[u] = rqv[u] * 64 + qcol; int r_ = rqv[u] - 4; rsv[u] = r_ < 0 ? 0 : (r_ > ROWS - 8 ? ROWS - 8 : r_); }
    const int nloc = ctxq ? 0 : (rsv[1] + 8 - rsv[0]);
    const int nstage = nloc + CTX / 64;
    __syncthreads();
    if (!ctxq) for (int i = tid; i < 2 * 465; i += NTHREADS) rpbs[i] = ldg(p.rpb + ((size_t)layer * 8 + hp * 2 + i / 465) * 465 + i % 465);
    bf16x8 qf[2][2];
#pragma unroll
    for (int u = 0; u < 2; ++u)
#pragma unroll
        for (int ks = 0; ks < 2; ++ks) qf[u][ks] = mk8(ldg((const u32x4*)(pq + (size_t)qtok[u] * PWA + C_QN + head * 64 + ks * 32 + fq * 8)));
    float m_run[2] = {-1e30f, -1e30f}, l_run[2] = {0.f, 0.f};
    f32x4 acc[2][4];
#pragma unroll
    for (int u = 0; u < 2; ++u)
#pragma unroll
        for (int mt = 0; mt < 4; ++mt) acc[u][mt] = (f32x4){0.f, 0.f, 0.f, 0.f};
    int cs = qcol - 8; cs = cs < 0 ? 0 : (cs > 48 ? 48 : cs);
    const int kc0 = (g == 0) ? 0 : (g == 1) ? 8 : (g == 2) ? 24 : 32;
    const int npair = (nstage + 1) >> 1;
    u32x4 kreg[4], vreg[4];
#define NA_SRC_ROWS(stg) (((stg) < nloc) ? (pq + (size_t)((rsv[0] + (stg)) * 64) * PWA) : (pc + (size_t)((((stg) < nstage ? (stg) : nstage - 1) - nloc) * 64) * PWA))
#define NA_FETCH(sp_) do { _Pragma("unroll") for (int it = 0; it < 4; ++it) { const int item = tid + it * 512, key2 = item >> 4, ch = item & 15; \
        const bf16_t* kb_ = NA_SRC_ROWS(2 * (sp_) + (key2 >> 6)); const bf16_t* src = kb_ + (size_t)(key2 & 63) * PWA + hp * 128 + ch * 8; \
        kreg[it] = ldg((const u32x4*)(src + C_KN)); vreg[it] = ldg((const u32x4*)(src + C_VN)); } } while (0)
    NA_FETCH(0);
    for (int sp = 0; sp < npair; ++sp) {
        __syncthreads();
#pragma unroll
        for (int it = 0; it < 4; ++it) { const int item = tid + it * 512, key2 = item >> 4, ch = item & 15;
            *(u32x4*)(Ks + key2 * NA_KLD + ch * 8) = kreg[it]; *(u32x4*)(Vs + key2 * NA_VLD + ch * 8) = vreg[it]; }
        if (sp + 1 < npair) NA_FETCH(sp + 1);
        __syncthreads();
#pragma unroll
        for (int sub = 0; sub < 2; ++sub) {
        const int st = 2 * sp + sub;
        if (st >= nstage) continue;
        const bool local = st < nloc;
        const bf16_t* Ksb = Ks + sub * 64 * NA_KLD; const bf16_t* Vsb = Vs + sub * 64 * NA_VLD;
        if (local) {
            const int kr = rsv[0] + st;
            f32x4 sa[2][2];
#pragma unroll
            for (int kt = 0; kt < 2; ++kt) { sa[0][kt] = (f32x4){0.f, 0.f, 0.f, 0.f}; sa[1][kt] = (f32x4){0.f, 0.f, 0.f, 0.f};
#pragma unroll
                for (int ks = 0; ks < 2; ++ks) { const bf16x8 kf = *(const bf16x8*)(Ksb + (kc0 + kt * 16 + tq) * NA_KLD + hh * 64 + ks * 32 + fq * 8);
                    sa[0][kt] = mfma16(kf, qf[0][ks], sa[0][kt]); sa[1][kt] = mfma16(kf, qf[1][ks], sa[1][kt]); } }
            float alpha[2]; bf16x8 pf[2];
#pragma unroll
            for (int u = 0; u < 2; ++u) {
                const bool act = (kr >= rsv[u]) && (kr < rsv[u] + 8);
                if (!act) { alpha[u] = 1.0f; pf[u] = mk8((u32x4){0u, 0u, 0u, 0u}); continue; }
                const int dr = kr - rqv[u] + 7;
                float sc[8]; float mx = -1e30f; float bs[8];
#pragma unroll
                for (int kt = 0; kt < 2; ++kt)
#pragma unroll
                    for (int r = 0; r < 4; ++r) { const int kcol = kc0 + kt * 16 + fq * 4 + r; int dc = kcol - qcol + 15; dc = dc < 0 ? 0 : (dc > 30 ? 30 : dc);
                        bs[kt * 4 + r] = rpbs[hh * 465 + dr * 31 + dc]; }
#ifndef CPU_EMU
                asm volatile("" : "+v"(bs[0]), "+v"(bs[1]), "+v"(bs[2]), "+v"(bs[3]), "+v"(bs[4]), "+v"(bs[5]), "+v"(bs[6]), "+v"(bs[7]));
#endif
#pragma unroll
                for (int kt = 0; kt < 2; ++kt)
#pragma unroll
                    for (int r = 0; r < 4; ++r) { const int kcol = kc0 + kt * 16 + fq * 4 + r; const bool valid = (kcol >= cs) && (kcol < cs + 16);
                        const float v = valid ? (sa[u][kt][r] * 0.125f + bs[kt * 4 + r]) : -1e30f; sc[kt * 4 + r] = v; mx = fmaxf(mx, v); }
                mx = fmaxf(mx, shx<16>(mx)); mx = fmaxf(mx, shx<32>(mx));
                const float mn = fmaxf(m_run[u], mx); alpha[u] = __expf(m_run[u] - mn); m_run[u] = mn;
                float ps = 0.f; float pv[8];
#pragma unroll
                for (int j = 0; j < 8; ++j) { pv[j] = __expf(sc[j] - mn); ps += pv[j]; }
                ps += shx<16>(ps); ps += shx<32>(ps);
                l_run[u] = l_run[u] * alpha[u] + ps;
                u32x4 pk = {pack2(pv[0], pv[1]), pack2(pv[2], pv[3]), pack2(pv[4], pv[5]), pack2(pv[6], pv[7])};
                pf[u] = mk8(pk);
            }
#pragma unroll
            for (int mt = 0; mt < 4; ++mt) {
                const bf16_t* vp = Vsb + (kc0 + 4 * fq + tq4) * NA_VLD + hh * 64 + mt * 16 + 4 * tp4;
                const bf16x8 vf = mk8(TR16(vp), TR16(vp + 16 * NA_VLD));
                acc[0][mt] = mfma16(vf, pf[0], acc[0][mt] * alpha[0]); acc[1][mt] = mfma16(vf, pf[1], acc[1][mt] * alpha[1]); }
        } else {
            f32x4 sa[2][4];
#pragma unroll
            for (int kt = 0; kt < 4; ++kt) { sa[0][kt] = (f32x4){0.f, 0.f, 0.f, 0.f}; sa[1][kt] = (f32x4){0.f, 0.f, 0.f, 0.f};
#pragma unroll
                for (int ks = 0; ks < 2; ++ks) { const bf16x8 kf = *(const bf16x8*)(Ksb + (kt * 16 + tq) * NA_KLD + hh * 64 + ks * 32 + fq * 8);
                    sa[0][kt] = mfma16(kf, qf[0][ks], sa[0][kt]); sa[1][kt] = mfma16(kf, qf[1][ks], sa[1][kt]); } }
            float alpha[2]; bf16x8 pf[2][2];
#pragma unroll
            for (int u = 0; u < 2; ++u) {
                float mx = -1e30f;
#pragma unroll
                for (int kt = 0; kt < 4; ++kt)
#pragma unroll
                    for (int r = 0; r < 4; ++r) { sa[u][kt][r] *= 0.125f; mx = fmaxf(mx, sa[u][kt][r]); }
                mx = fmaxf(mx, shx<16>(mx)); mx = fmaxf(mx, shx<32>(mx));
                const float mn = fmaxf(m_run[u], mx); alpha[u] = __expf(m_run[u] - mn); m_run[u] = mn;
                float ps = 0.f;
#pragma unroll
                for (int kt = 0; kt < 4; ++kt)
#pragma unroll
                    for (int r = 0; r < 4; ++r) { sa[u][kt][r] = __expf(sa[u][kt][r] - mn); ps += sa[u][kt][r]; }
                ps += shx<16>(ps); ps += shx<32>(ps);
                l_run[u] = l_run[u] * alpha[u] + ps;
#pragma unroll
                for (int h2 = 0; h2 < 2; ++h2) {
                    u32x4 pk = {pack2(sa[u][2 * h2][0], sa[u][2 * h2][1]), pack2(sa[u][2 * h2][2], sa[u][2 * h2][3]), pack2(sa[u][2 * h2 + 1][0], sa[u][2 * h2 + 1][1]), pack2(sa[u][2 * h2 + 1][2], sa[u][2 * h2 + 1][3])};
                    pf[u][h2] = mk8(pk); }
            }
#pragma unroll
            for (int mt = 0; mt < 4; ++mt) { acc[0][mt] = acc[0][mt] * alpha[0]; acc[1][mt] = acc[1][mt] * alpha[1]; }
#pragma unroll
            for (int h2 = 0; h2 < 2; ++h2)
#pragma unroll
                for (int mt = 0; mt < 4; ++mt) { const bf16_t* vp = Vsb + (32 * h2 + 4 * fq + tq4) * NA_VLD + hh * 64 + mt * 16 + 4 * tp4;
                    const bf16x8 vf = mk8(TR16(vp), TR16(vp + 16 * NA_VLD));
                    acc[0][mt] = mfma16(vf, pf[0][h2], acc[0][mt]); acc[1][mt] = mfma16(vf, pf[1][h2], acc[1][mt]); }
        }
        }
    }
#undef NA_FETCH
#undef NA_SRC_ROWS
#pragma unroll
    for (int u = 0; u < 2; ++u) {
        const float il = frcp(l_run[u]);
        const size_t orow = ((size_t)sl << sd.lgseq) + qtok[u];
#pragma unroll
        for (int mt = 0; mt < 4; ++mt) { u32x2 o = {pack2(acc[u][mt][0] * il, acc[u][mt][1] * il), pack2(acc[u][mt][2] * il, acc[u][mt][3] * il)};
            stg((u32x2*)(p.Nb() + orow * 512 + head * 64 + mt * 16 + fq * 4), o); }
    }
}

DEV void mlstm_stepC_task(const Params& p, const SetDesc& sd, int layer, int task, char* shm) {
    const int tid = TID(), lane = tid & 63, w = tid >> 6, tq = lane & 15, fq = lane >> 4, tq4 = (lane & 15) >> 2, tp4 = lane & 3;
    const int tb = task % sd.ntb, h = (task / sd.ntb) & 3, sl = task / (sd.ntb * 4);
    const int row0 = (sl << sd.lgseq) + tb * 128; const bool latent = !sd.is_ctx; const int tl0 = tb * 128;
    bf16_t* Ks = (bf16_t*)shm;
    bf16_t* Vs = (bf16_t*)(shm + 128 * K_LD * 2);
    bf16_t* Cs = (bf16_t*)(shm + 128 * K_LD * 2 + 128 * V_LD * 2);
    float* ga = (float*)(shm + 128 * K_LD * 2 * 3 + 128 * V_LD * 2); float* gb = ga + 256; float* gpm = gb + 256; float* gtot = gpm + 256; float* tmp = gtot + 8;
    float* nvs = tmp + 16;
    float* cms = nvs + 128;
    const bf16_t* prow = proj_buf(p, sd) + (size_t)row0 * PWA;
    __syncthreads();
    gate_scan(prow, h, p.gate_bias + (size_t)layer * 16, ga, gb, gpm, gtot, tmp);
    {
        const int s = tid & 127, cpi = tid >> 7, cp = (cpi & 1) + (cpi >> 1) * 4;
        const bf16_t* hp = prow + (size_t)s * PWA + C_KM + h * 64;
        float k1[8], k2[8];
        load_rope_chunk(hp, cp, latent, tl0 + s, p.rope(), 1.0f, k1);
        load_rope_chunk(hp, cp + 2, latent, tl0 + s, p.rope(), 1.0f, k2);
        u32x4 o1 = {pack2(k1[0], k1[1]), pack2(k1[2], k1[3]), pack2(k1[4], k1[5]), pack2(k1[6], k1[7])};
        u32x4 o2 = {pack2(k2[0], k2[1]), pack2(k2[2], k2[3]), pack2(k2[4], k2[5]), pack2(k2[6], k2[7])};
        *(u32x4*)(Ks + s * K_LD + cp * 8) = o1; *(u32x4*)(Ks + s * K_LD + (cp + 2) * 8) = o2;
    }
#pragma unroll
    for (int it = 0; it < 4; ++it) { const int item = tid + it * 512, s = item >> 4, ch = item & 15;
        *(u32x4*)(Vs + s * V_LD + ch * 8) = ldg((const u32x4*)(prow + (size_t)s * PWA + C_VM + h * 128 + ch * 8)); }
#pragma unroll
    for (int it = 0; it < 4; ++it) { const int item = tid + it * 512, dir = item >> 10, rem = item & 1023, v = rem >> 3, ch = rem & 7;
        *(u32x4*)(Cs + (dir * 128 + v) * K_LD + ch * 8) = ldg((const u32x4*)(p.Cin() + (size_t)st_index(sd, sl, h, dir, tb) * 8192 + v * 64 + ch * 8)); }
    if (tid < 128) nvs[tid] = ldg(p.Cn() + (size_t)st_index(sd, sl, h, tid >> 6, tb) * 64 + (tid & 63));
    if (tid < 2) cms[tid] = ldg(p.Cm() + (size_t)st_index(sd, sl, h, tid, tb) * 4);
    bf16x8 qf[2]; float qv[2][8];
    {
        const int t = w * 16 + tq; const bf16_t* hp = prow + (size_t)t * PWA + C_QM + h * 64;
#pragma unroll
        for (int ks = 0; ks < 2; ++ks) { load_rope_chunk(hp, ks * 4 + fq, latent, tl0 + t, p.rope(), 0.125f, qv[ks]);
            u32x4 o = {pack2(qv[ks][0], qv[ks][1]), pack2(qv[ks][2], qv[ks][3]), pack2(qv[ks][4], qv[ks][5]), pack2(qv[ks][6], qv[ks][7])}; qf[ks] = mk8(o); }
    }
    __syncthreads();
    const int t = w * 16 + tq;
    f32x4 hsum[8];
#pragma unroll
    for (int mt = 0; mt < 8; ++mt) hsum[mt] = (f32x4){0.f, 0.f, 0.f, 0.f};
#pragma unroll
    for (int dir = 0; dir < 2; ++dir) {
        const float m_in = cms[dir];
        const float Mt = fmaxf(m_in, gpm[dir * 128 + t]);
        const float inter = __expf(m_in - Mt);
        const float mtot = gb[dir * 128 + t] + Mt;
        f32x4 acc[8];
#pragma unroll
        for (int mt = 0; mt < 8; ++mt) { acc[mt] = (f32x4){0.f, 0.f, 0.f, 0.f};
#pragma unroll
            for (int ks = 0; ks < 2; ++ks) { const bf16x8 cf = *(const bf16x8*)(Cs + (dir * 128 + mt * 16 + tq) * K_LD + ks * 32 + fq * 8);
                acc[mt] = mfma16(cf, qf[ks], acc[mt]); }
            acc[mt] = acc[mt] * inter; }
        float qn = 0.f;
#pragma unroll
        for (int ks = 0; ks < 2; ++ks)
#pragma unroll
            for (int j = 0; j < 8; ++j) qn += bf2f(f2bf(qv[ks][j])) * nvs[dir * 64 + ks * 32 + fq * 8 + j];
        qn += shx<16>(qn); qn += shx<32>(qn);
        float den = inter * qn;
        const int u_lo = dir == 0 ? 0 : (w >> 1), u_hi = dir == 0 ? (w >> 1) : 3;
        float rsum = 0.f;
        for (int u = u_lo; u <= u_hi; ++u) {
            unsigned pk[4];
#pragma unroll
            for (int kt = 0; kt < 2; ++kt) { f32x4 sa = {0.f, 0.f, 0.f, 0.f}; const int sb = 32 * u + 16 * kt;
#pragma unroll
                for (int ks = 0; ks < 2; ++ks) { const bf16x8 kf = *(const bf16x8*)(Ks + (sb + tq) * K_LD + ks * 32 + fq * 8); sa = mfma16(kf, qf[ks], sa); }
                float pv[4]; float gv4[4];
#pragma unroll
                for (int r = 0; r < 4; ++r) gv4[r] = ga[dir * 128 + sb + fq * 4 + r];
#ifndef CPU_EMU
                asm volatile("" : "+v"(gv4[0]), "+v"(gv4[1]), "+v"(gv4[2]), "+v"(gv4[3]));
#endif
#pragma unroll
                for (int r = 0; r < 4; ++r) { const int s = sb + fq * 4 + r; const bool valid = dir == 0 ? (s <= t) : (s >= t);
                    pv[r] = valid ? sa[r] * __expf(gv4[r] - Mt) : 0.f; pv[r] = bf2f(f2bf(pv[r])); rsum += pv[r]; }
                pk[kt * 2] = pack2(pv[0], pv[1]); pk[kt * 2 + 1] = pack2(pv[2], pv[3]); }
            u32x4 pkv = {pk[0], pk[1], pk[2], pk[3]}; const bf16x8 pf = mk8(pkv);
#pragma unroll
            for (int mt = 0; mt < 8; ++mt) { const bf16_t* vp = Vs + (32 * u + 4 * fq + tq4) * V_LD + mt * 16 + 4 * tp4;
                const bf16x8 vf = mk8(TR16(vp), TR16(vp + 16 * V_LD));
                acc[mt] = mfma16(vf, pf, acc[mt]); }
        }
        rsum += shx<16>(rsum); rsum += shx<32>(rsum);
        den += rsum;
        const float dn = frcp(fmaxf(fabsf(den), __expf(-mtot)));
#pragma unroll
        for (int mt = 0; mt < 8; ++mt) hsum[mt] = hsum[mt] + acc[mt] * dn;
    }
    float ss = 0.f;
#pragma unroll
    for (int mt = 0; mt < 8; ++mt)
#pragma unroll
        for (int r = 0; r < 4; ++r) ss += hsum[mt][r] * hsum[mt][r];
    ss += shx<16>(ss); ss += shx<32>(ss);
    const float rstd = rsqrtf(ss * (1.0f / 128.0f) + RMS_EPS);
#pragma unroll
    for (int mt = 0; mt < 8; ++mt) { const int v = mt * 16 + fq * 4;
        const u32x2 om = ldg((const u32x2*)(prow + (size_t)t * PWA + C_OM + h * 128 + v));
        u32x2 o = {pack2(hsum[mt][0] * rstd * sigmoidf_(lo16(om.x)), hsum[mt][1] * rstd * sigmoidf_(hi16(om.x))),
                   pack2(hsum[mt][2] * rstd * sigmoidf_(lo16(om.y)), hsum[mt][3] * rstd * sigmoidf_(hi16(om.y)))};
        stg((u32x2*)(p.Mb() + (size_t)(row0 + t) * 512 + h * 128 + v), o); }
}

struct SchedMerge {
    const bf16_t* Mb; const bf16_t* Pb; const bf16_t* Nb; const bf16_t* Wb; int nM;
    DEV bool next(int i, GUnit& u) const { u.aux = i % 3; return tile_order(i / 3, nM, 4, u.pm, u.pn); }
    DEV const bf16_t* a_base(const GUnit& u) const { return (u.aux == 0 ? Mb : (u.aux == 1 ? Pb : Nb)) + (size_t)u.pm * 256 * 512; }
    DEV const bf16_t* b_base(const GUnit& u) const { return Wb + ((size_t)u.aux * 1024 + u.pn * 256) * 512; }
    DEV const int* ridx(const GUnit&) const { return nullptr; }
};
DEV void phase_merge(const Params& p, const SetDesc& sd, int layer, char* shm) {
    SchedMerge S; S.Mb = p.Mb(); S.Pb = p.Pb(); S.Nb = p.Nb(); S.Wb = p.WbT() + (size_t)layer * 3 * 1024 * 512; S.nM = sd.nrows / 256;
    const bf16_t* bgb = p.BG(); bf16_t* mgb = p.MERGED();
    gemm_stream<false, 512, 512, 512>(shm, S, [=](const GUnit& u, const f32x4 (&acc)[2][2][4][2], int r0, int c0) {
#pragma unroll
        for (int ai = 0; ai < 2; ++ai) {
            u32x4 gm[4][2], pr[4][2];
#pragma unroll
            for (int m = 0; m < 4; ++m)
#pragma unroll
                for (int hf = 0; hf < 2; ++hf) { const size_t r = (size_t)u.pm * 256 + r0 + ai * 128 + m * 16;
                    gm[m][hf] = ldg((const u32x4*)(bgb + r * NBG + u.aux * 1024 + u.pn * 256 + c0 + hf * 128));
                    if (u.aux > 0) pr[m][hf] = ldg((const u32x4*)(mgb + r * 1024 + u.pn * 256 + c0 + hf * 128)); else pr[m][hf] = (u32x4){0u, 0u, 0u, 0u}; }
#pragma unroll
            for (int m = 0; m < 4; ++m)
#pragma unroll
                for (int hf = 0; hf < 2; ++hf) { const size_t r = (size_t)u.pm * 256 + r0 + ai * 128 + m * 16;
                    const f32x4 x0 = acc[ai][hf][m][0], x1 = acc[ai][hf][m][1]; const u32x4 g = gm[m][hf], q = pr[m][hf];
                    u32x4 ov = {pack2(x0[0] * lo16(g.x) + lo16(q.x), x0[1] * hi16(g.x) + hi16(q.x)), pack2(x0[2] * lo16(g.y) + lo16(q.y), x0[3] * hi16(g.y) + hi16(q.y)),
                                pack2(x1[0] * lo16(g.z) + lo16(q.z), x1[1] * hi16(g.z) + hi16(q.z)), pack2(x1[2] * lo16(g.w) + lo16(q.w), x1[3] * hi16(g.w) + hi16(q.w))};
                    stg((u32x4*)(mgb + r * 1024 + u.pn * 256 + c0 + hf * 128), ov); }
        } });
}
DEV void phase_outproj(const Params& p, const SetDesc& sd, int layer, char* shm) {
    SchedPlain S; S.A = p.MERGED(); S.Bt = p.WoT() + (size_t)layer * 1024 * 1024; S.nM = sd.nrows / 256; S.nN = 4; S.lda256 = 256 * 1024; S.ldb256 = 256 * 1024;
    bf16_t* yb = p.Y();
    gemm_stream<false, 1024, 1024, 1024>(shm, S, [=](const GUnit& u, const f32x4 (&acc)[2][2][4][2], int r0, int c0) {
#pragma unroll
        for (int ai = 0; ai < 2; ++ai)
#pragma unroll
            for (int m = 0; m < 4; ++m) { bf16_t* o = yb + ((size_t)u.pm * 256 + r0 + ai * 128 + m * 16) * 1024 + u.pn * 256 + c0;
                store8bf(o, acc[ai][0][m][0], acc[ai][0][m][1]); store8bf(o + 128, acc[ai][1][m][0], acc[ai][1][m][1]); } });
}

DEV void phase_postmix(const Params& p, const SetDesc& sd, int layer, char* shm) {
    const int tid = TID(), lane = tid & 63, wv = tid >> 6;
    float* wr_s = (float*)shm;
    __syncthreads();
    for (int i = tid; i < 1024 * 16; i += NTHREADS) { const int c = i >> 4, e = i & 15, ln = (c & 511) >> 3, j = c & 7, hf = c >> 9;
        wr_s[((((hf * 8 + j) * 4 + (e >> 2)) * 64 + ln) << 2) + (e & 3)] = ldg(p.router_w + (size_t)layer * 1024 * 16 + i); }
    __syncthreads();
    const float* g1 = p.norm_gain + ((size_t)layer * 4 + 1) * 1024; const float* g2 = p.norm_gain + ((size_t)layer * 4 + 2) * 1024;
    float* par = (float*)(shm + 65536);
    { const int rpb0_ = (sd.nrows + (int)gridDim.x - 1) / (int)gridDim.x; const float* mdb = mod_row(p, sd, layer, min((int)blockIdx.x * rpb0_, sd.nrows - 1));
      stage_params(par, g1, g2, mdb + 2048, mdb + 3072, mdb + 4096); }
    __syncthreads();
    const float* xb = xsrc_base(p, sd, layer); float* xdb = xdst_base(p, sd);
    const int stride = 8; const int rpb_ = (sd.nrows + (int)gridDim.x - 1) / (int)gridDim.x; const int row_end = min(sd.nrows, ((int)blockIdx.x + 1) * rpb_);
    int row = (int)blockIdx.x * rpb_ + wv;
    u32x4 ycur[2], ynxt[2]; f32x4 xcur[4], xnxt[4];
    if (row < row_end) {
#pragma unroll
        for (int i = 0; i < 2; ++i) ycur[i] = ldg((const u32x4*)(p.Y() + (size_t)row * 1024 + i * 512 + lane * 8));
#pragma unroll
        for (int i = 0; i < 4; ++i) xcur[i] = ldg((const f32x4*)(xb + (size_t)row * 1024 + (i >> 1) * 512 + lane * 8 + (i & 1) * 4)); }
    for (; row < row_end; row += stride) {
        int ln = lane; HIDE(ln);
        const int rn = row + stride;
        if (rn < row_end) {
#pragma unroll
            for (int i = 0; i < 2; ++i) ynxt[i] = ldg((const u32x4*)(p.Y() + (size_t)rn * 1024 + i * 512 + ln * 8));
#pragma unroll
            for (int i = 0; i < 4; ++i) xnxt[i] = ldg((const f32x4*)(xb + (size_t)rn * 1024 + (i >> 1) * 512 + ln * 8 + (i & 1) * 4)); }
        float* xd = xdb + (size_t)row * 1024;
        const float* md = mod_row(p, sd, layer, row);
        float y[16]; float ss = 0.f;
#pragma unroll
        for (int hlf = 0; hlf < 2; ++hlf) { const u32x4 m = ycur[hlf];
            const float t8[8] = {lo16(m.x), hi16(m.x), lo16(m.y), hi16(m.y), lo16(m.z), hi16(m.z), lo16(m.w), hi16(m.w)};
#pragma unroll
            for (int j = 0; j < 8; ++j) { y[hlf * 8 + j] = t8[j]; ss += t8[j] * t8[j]; } }
        ss = wave_sum(ss);
        const float rstd = rsqrtf(ss * (1.0f / 1024.0f) + RMS_EPS);
        float xn[16]; float ss2 = 0.f;
#pragma unroll
        for (int hlf = 0; hlf < 2; ++hlf)
#pragma unroll
            for (int q = 0; q < 2; ++q) { const int c0 = hlf * 512 + ln * 8 + q * 4; const f32x4 xo = xcur[hlf * 2 + q]; f32x4 xw;
#pragma unroll
                for (int j = 0; j < 4; ++j) { const float v = xo[j] + par[2048 + c0 + j] * (y[hlf * 8 + q * 4 + j] * rstd * par[c0 + j]); xw[j] = v; xn[hlf * 8 + q * 4 + j] = v; ss2 += v * v; }
                stg((f32x4*)(xd + c0), xw); }
        ss2 = wave_sum(ss2);
        const float rstd2 = rsqrtf(ss2 * (1.0f / 1024.0f) + RMS_EPS);
        float lg[16];
#pragma unroll
        for (int e = 0; e < 16; ++e) lg[e] = 0.f;
#pragma unroll
        for (int hlf = 0; hlf < 2; ++hlf) { const int c0 = hlf * 512 + ln * 8; float o[8];
#pragma unroll
            for (int j = 0; j < 8; ++j) { o[j] = xn[hlf * 8 + j] * rstd2 * par[1024 + c0 + j] * (1.0f + par[4096 + c0 + j]) + par[3072 + c0 + j];
#pragma unroll
                for (int eq = 0; eq < 4; ++eq) { const f32x4 w4 = *(const f32x4*)(wr_s + ((((hlf * 8 + j) * 4 + eq) * 64 + ln) << 2));
#pragma unroll
                    for (int e = 0; e < 4; ++e) lg[eq * 4 + e] += o[j] * w4[e]; } }
            u32x4 ov = {pack2(o[0], o[1]), pack2(o[2], o[3]), pack2(o[4], o[5]), pack2(o[6], o[7])};
            stg((u32x4*)(p.H() + (size_t)row * 1024 + c0), ov); }
        float r8[8], r4[4], r2[2], r1;
        { const bool b = (lane & 32) != 0;
#pragma unroll
          for (int i = 0; i < 8; ++i) { const float keep = b ? lg[i + 8] : lg[i], send = b ? lg[i] : lg[i + 8]; r8[i] = keep + shx<32>(send); } }
        { const bool b = (lane & 16) != 0;
#pragma unroll
          for (int i = 0; i < 4; ++i) { const float keep = b ? r8[i + 4] : r8[i], send = b ? r8[i] : r8[i + 4]; r4[i] = keep + shx<16>(send); } }
        { const bool b = (lane & 8) != 0;
#pragma unroll
          for (int i = 0; i < 2; ++i) { const float keep = b ? r4[i + 2] : r4[i], send = b ? r4[i] : r4[i + 2]; r2[i] = keep + shx<8>(send); } }
        { const bool b = (lane & 4) != 0; const float keep = b ? r2[1] : r2[0], send = b ? r2[0] : r2[1]; r1 = keep + shx<4>(send); }
        r1 += shx<2>(r1); r1 += shx<1>(r1);
        float mx = r1;
        mx = fmaxf(mx, shx<4>(mx)); mx = fmaxf(mx, shx<8>(mx)); mx = fmaxf(mx, shx<16>(mx)); mx = fmaxf(mx, shx<32>(mx));
        const float ex = __expf(r1 - mx);
        float se = ex;
        se += shx<4>(se); se += shx<8>(se); se += shx<16>(se); se += shx<32>(se);
        if ((lane & 3) == 0) { const int e = ((lane >> 5) & 1) * 8 + ((lane >> 4) & 1) * 4 + ((lane >> 3) & 1) * 2 + ((lane >> 2) & 1);
            stg(p.aff() + (size_t)row * 16 + e, ex * frcp(se)); }
#pragma unroll
        for (int i = 0; i < 2; ++i) ycur[i] = ynxt[i];
#pragma unroll
        for (int i = 0; i < 4; ++i) xcur[i] = xnxt[i];
    }
}

DEV unsigned shxu(unsigned v, int m) {
    const float f = __uint_as_float(v); float r;
    switch (m) { case 1: r = shx<1>(f); break; case 2: r = shx<2>(f); break; case 4: r = shx<4>(f); break; case 8: r = shx<8>(f); break; case 16: r = shx<16>(f); break; default: r = shx<32>(f); break; }
    return __float_as_uint(r);
}
#define TK_CX(a_, b_, desc_) do { const unsigned long long x_ = key[a_], y_ = key[b_]; const bool sw_ = (desc_) ? (x_ < y_) : (x_ > y_); key[a_] = sw_ ? y_ : x_; key[b_] = sw_ ? x_ : y_; } while (0)
DEV void topk_task(const Params& p, const SetDesc& sd, int task, char* shm) {
    const int tid = TID();
    const int e = task & 15, sl = task >> 4;
    unsigned long long* buf = (unsigned long long*)shm;
    const int T = 1 << sd.lgseq, cap = sd.cap;
    const int rbase = sl << sd.lgseq;
    const bool active = tid * 4 < T;
    unsigned long long key[4];
    __syncthreads();
#pragma unroll
    for (int m = 0; m < 4; ++m) { const int i = tid * 4 + m; const float a = active ? ldg(p.aff() + (size_t)(rbase + i) * 16 + e) : 0.f;
        key[m] = ((unsigned long long)__float_as_uint(a) << 32) | (unsigned)(0xFFFFFFFFu - (unsigned)i); }
    for (int k = 2; k <= T; k <<= 1) {
        const bool desc4 = ((tid * 4) & k) == 0;
        for (int j = k >> 1; j >= 4; j >>= 1) {
            const int tj = j >> 2;
            unsigned long long pk[4];
            if (tj < 64) {
#pragma unroll
                for (int m = 0; m < 4; ++m) { const unsigned lo = shxu((unsigned)key[m], tj), hi = shxu((unsigned)(key[m] >> 32), tj); pk[m] = ((unsigned long long)hi << 32) | lo; }
            } else {
                __syncthreads();
                if (active) {
#pragma unroll
                    for (int m = 0; m < 4; ++m) buf[tid * 4 + m] = key[m]; }
                __syncthreads();
#pragma unroll
                for (int m = 0; m < 4; ++m) pk[m] = active ? buf[(tid ^ tj) * 4 + m] : 0ull;
            }
            const bool lower = (tid & tj) == 0; const bool takemax = desc4 == lower;
#pragma unroll
            for (int m = 0; m < 4; ++m) { const unsigned long long x = key[m], y = pk[m]; key[m] = takemax ? (x > y ? x : y) : (x < y ? x : y); }
        }
        if (k >= 4) { TK_CX(0, 2, desc4); TK_CX(1, 3, desc4); TK_CX(0, 1, desc4); TK_CX(2, 3, desc4); }
        else { TK_CX(0, 1, true); TK_CX(2, 3, false); }
    }
    const int sbase = e * sd.rpe + sl * cap;
    if (active) {
#pragma unroll
        for (int m = 0; m < 4; ++m) { const int i = tid * 4 + m; const unsigned long long kv = key[m]; const int tok = (int)(0xFFFFFFFFu - (unsigned)(kv & 0xFFFFFFFFu));
            const int row = rbase + tok;
            if (i < cap) { stg(p.slot_token() + sbase + i, row); stg(p.slot_gate() + sbase + i, __uint_as_float((unsigned)(kv >> 32))); stg(p.token_slots() + (size_t)row * 16 + e, sbase + i); }
            else stg(p.token_slots() + (size_t)row * 16 + e, -1); } }
    if (sl == 0) { const int used = sd.nsamp * cap;
        for (int i = used + tid; i < sd.rpe; i += NTHREADS) { stg(p.slot_token() + e * sd.rpe + i, 0); stg(p.slot_gate() + e * sd.rpe + i, 0.f); } }
}
#undef TK_CX

struct SchedMoe {
    const bf16_t* A; const int* st; const bf16_t* W; int nRT, rpe, nN, wstride;
    DEV bool next(int i, GUnit& u) const { int pmx, pn; if (!tile_order(i, 16 * nRT, nN, pmx, pn)) return false; u.pm = pmx % nRT; u.aux = pmx / nRT; u.pn = pn; return true; }
    DEV int slot0(const GUnit& u) const { return u.aux * rpe + u.pm * 256; }
    DEV const bf16_t* a_base(const GUnit& u) const { return st ? A : A + (size_t)slot0(u) * 1024; }
    DEV const int* ridx(const GUnit& u) const { return st + slot0(u); }
    DEV const bf16_t* b_base(const GUnit& u) const { return W + (size_t)u.aux * wstride + (size_t)u.pn * 256 * 1024; }
};
DEV void phase_moe_gu(const Params& p, const SetDesc& sd, int layer, char* shm) {
    SchedMoe S; S.A = p.H(); S.st = p.slot_token(); S.W = p.WguT() + (size_t)layer * 16 * 2048 * 1024; S.nRT = sd.rpe / 256; S.rpe = sd.rpe; S.nN = 8; S.wstride = 2048 * 1024;
    bf16_t* hb = p.HID();
    gemm_stream<true, 1024, 1024, 1024>(shm, S, [=](const GUnit& u, const f32x4 (&acc)[2][2][4][2], int r0, int c0) {
#pragma unroll
        for (int ai = 0; ai < 2; ++ai)
#pragma unroll
            for (int m = 0; m < 4; ++m) { f32x4 h0, h1; const f32x4 a0 = acc[ai][0][m][0], a1 = acc[ai][0][m][1], b0 = acc[ai][1][m][0], b1 = acc[ai][1][m][1];
#pragma unroll
                for (int j = 0; j < 4; ++j) { h0[j] = a0[j] * sigmoidf_(a0[j]) * b0[j]; h1[j] = a1[j] * sigmoidf_(a1[j]) * b1[j]; }
                store8bf(hb + ((size_t)S.slot0(u) + r0 + ai * 128 + m * 16) * 1024 + u.pn * 128 + c0, h0, h1); } });
}
DEV void phase_moe_down(const Params& p, const SetDesc& sd, int layer, char* shm) {
    SchedMoe S; S.A = p.HID(); S.st = nullptr; S.W = p.WdT() + (size_t)layer * 16 * 1024 * 1024; S.nRT = sd.rpe / 256; S.rpe = sd.rpe; S.nN = 4; S.wstride = 1024 * 1024;
    bf16_t* yb = p.YE(); const float* gt = p.slot_gate();
    gemm_stream<false, 1024, 1024, 1024>(shm, S, [=](const GUnit& u, const f32x4 (&acc)[2][2][4][2], int r0, int c0) {
        float gv[2][4];
#pragma unroll
        for (int ai = 0; ai < 2; ++ai)
#pragma unroll
            for (int m = 0; m < 4; ++m) gv[ai][m] = ldg(gt + (size_t)S.slot0(u) + r0 + ai * 128 + m * 16);
#pragma unroll
        for (int ai = 0; ai < 2; ++ai)
#pragma unroll
            for (int m = 0; m < 4; ++m) { const size_t sl = (size_t)S.slot0(u) + r0 + ai * 128 + m * 16; const float g = gv[ai][m];
                bf16_t* o = yb + sl * 1024 + u.pn * 256 + c0; store8bf(o, acc[ai][0][m][0] * g, acc[ai][0][m][1] * g); store8bf(o + 128, acc[ai][1][m][0] * g, acc[ai][1][m][1] * g); } });
}

DEV void compact4(const int (&sl)[16], int (&c)[4], int& n) {
    n = 0; c[0] = -1; c[1] = -1; c[2] = -1; c[3] = -1;
#pragma unroll
    for (int e = 0; e < 16; ++e) if (sl[e] >= 0) { c[0] = (n == 0) ? sl[e] : c[0]; c[1] = (n == 1) ? sl[e] : c[1]; c[2] = (n == 2) ? sl[e] : c[2]; c[3] = (n == 3) ? sl[e] : c[3]; ++n; }
}
DEV void phase_combine(const Params& p, const SetDesc& sd, int layer, char* shm) {
    const int tid = TID(), lane = tid & 63, wv = tid >> 6;
    const float* g3 = p.norm_gain + ((size_t)layer * 4 + 3) * 1024;
    float* xdb = xdst_base(p, sd);
    const int stride = 8; const int rpb_ = (sd.nrows + (int)gridDim.x - 1) / (int)gridDim.x; const int row_end = min(sd.nrows, ((int)blockIdx.x + 1) * rpb_);
    int row = __builtin_amdgcn_readfirstlane((int)blockIdx.x * rpb_ + wv);
    float* par = (float*)shm;
    __syncthreads();
    { const float* mdb = mod_row(p, sd, layer, min((int)blockIdx.x * rpb_, sd.nrows - 1)); stage_params(par, g3, mdb + 5120, nullptr, nullptr, nullptr); }
    __syncthreads();
    int raw[16]; int cc[4], cn[4]; int nc = 0, nn = 0;
    u32x4 mc[4][2], mn[4][2]; f32x4 xc[4], xn[4];
#define CMB_SLOTS(r_) do { _Pragma("unroll") for (int e = 0; e < 16; ++e) raw[e] = ldg(p.token_slots() + (size_t)(r_) * 16 + e); } while (0)
#define CMB_DATA(r_, c_, n_, m_, x_) do { _Pragma("unroll") for (int k = 0; k < 4; ++k) { \
            if (k < (n_)) { const bf16_t* yr = p.YE() + (size_t)(c_)[k] * 1024 + lane * 8; (m_)[k][0] = ldg((const u32x4*)yr); (m_)[k][1] = ldg((const u32x4*)(yr + 512)); } \
            else { (m_)[k][0] = (u32x4){0u, 0u, 0u, 0u}; (m_)[k][1] = (u32x4){0u, 0u, 0u, 0u}; } } \
        _Pragma("unroll") for (int i = 0; i < 4; ++i) (x_)[i] = ldg((const f32x4*)(xdb + (size_t)(r_) * 1024 + (i >> 1) * 512 + lane * 8 + (i & 1) * 4)); } while (0)
    if (row < row_end) { CMB_SLOTS(row); compact4(raw, cc, nc); CMB_DATA(row, cc, nc, mc, xc); if (row + stride < row_end) CMB_SLOTS(row + stride); }
    for (; row < row_end; row += stride) {
        const int rn = row + stride;
        if (rn < row_end) { compact4(raw, cn, nn); CMB_DATA(rn, cn, nn, mn, xn); if (rn + stride < row_end) CMB_SLOTS(rn + stride); }
        float* xd = xdb + (size_t)row * 1024;
        float y[16];
#pragma unroll
        for (int j = 0; j < 16; ++j) y[j] = 0.f;
        if (nc <= 4) {
#pragma unroll
            for (int k = 0; k < 4; ++k)
                if (k < nc) {
#pragma unroll
                    for (int hlf = 0; hlf < 2; ++hlf) { const u32x4 m = mc[k][hlf];
                        y[hlf * 8 + 0] += lo16(m.x); y[hlf * 8 + 1] += hi16(m.x); y[hlf * 8 + 2] += lo16(m.y); y[hlf * 8 + 3] += hi16(m.y);
                        y[hlf * 8 + 4] += lo16(m.z); y[hlf * 8 + 5] += hi16(m.z); y[hlf * 8 + 6] += lo16(m.w); y[hlf * 8 + 7] += hi16(m.w); } }
        } else {
            for (int e = 0; e < 16; ++e) { const int sl_ = ldg(p.token_slots() + (size_t)row * 16 + e);
                if (sl_ >= 0) { const bf16_t* yr = p.YE() + (size_t)sl_ * 1024 + lane * 8;
#pragma unroll
                    for (int hlf = 0; hlf < 2; ++hlf) { const u32x4 m = ldg((const u32x4*)(yr + hlf * 512));
                        y[hlf * 8 + 0] += lo16(m.x); y[hlf * 8 + 1] += hi16(m.x); y[hlf * 8 + 2] += lo16(m.y); y[hlf * 8 + 3] += hi16(m.y);
                        y[hlf * 8 + 4] += lo16(m.z); y[hlf * 8 + 5] += hi16(m.z); y[hlf * 8 + 6] += lo16(m.w); y[hlf * 8 + 7] += hi16(m.w); } } }
        }
        float ss = 0.f;
#pragma unroll
        for (int j = 0; j < 16; ++j) ss += y[j] * y[j];
        ss = wave_sum(ss);
        const float rstd = rsqrtf(ss * (1.0f / 1024.0f) + RMS_EPS);
#pragma unroll
        for (int hlf = 0; hlf < 2; ++hlf)
#pragma unroll
            for (int q = 0; q < 2; ++q) { const int c0 = hlf * 512 + lane * 8 + q * 4; f32x4 xv = xc[hlf * 2 + q];
#pragma unroll
                for (int j = 0; j < 4; ++j) xv[j] += par[1024 + c0 + j] * (y[hlf * 8 + q * 4 + j] * rstd * par[c0 + j]);
                stg((f32x4*)(xd + c0), xv); }
        nc = nn;
#pragma unroll
        for (int k = 0; k < 4; ++k) { cc[k] = cn[k]; mc[k][0] = mn[k][0]; mc[k][1] = mn[k][1]; }
#pragma unroll
        for (int i = 0; i < 4; ++i) xc[i] = xn[i];
    }
#undef CMB_SLOTS
#undef CMB_DATA
}

template <int PH> DEV void do_phase(const Params& p, int layer, int is_ctx, int grp, char* shm) {
    const SetDesc sd = make_set(is_ctx, grp);
    if constexpr (PH == -1) phase_prologue(p, shm);
    if constexpr (PH == 0) phase_norm1(p, sd, layer, shm);
    if constexpr (PH == 1) phase_proj_a(p, sd, layer, shm);
    if constexpr (PH == 2) { for (int t = blockIdx.x; t < sd.nsamp * 4 * sd.ntb; t += gridDim.x) mlstm_stepA_task(p, sd, layer, t, shm); if (!(is_ctx && layer == 1)) phase_pool(p, sd); }
    if constexpr (PH == 3) {
        for (int t = blockIdx.x; t < sd.nsamp * 32; t += gridDim.x) mlstm_stepB_task(p, sd, t);
        if (!(is_ctx && layer == 1)) {
            const int nq = (is_ctx ? (CTX / 64) : ROWS) / 2;
            for (int t = blockIdx.x; t < sd.nsamp * nq * 4; t += gridDim.x) na_task(p, sd, layer, t / (nq * 4), (t >> 2) % nq, t & 3, shm);
        }
    }
    if constexpr (PH == 4) { for (int t = blockIdx.x; t < sd.nsamp * 4 * sd.ntb; t += gridDim.x) mlstm_stepC_task(p, sd, layer, t, shm); }
    if constexpr (PH == 5) phase_proj_b(p, sd, layer, shm);
    if constexpr (PH == 6) phase_merge(p, sd, layer, shm);
    if constexpr (PH == 7) phase_outproj(p, sd, layer, shm);
    if constexpr (PH == 8) phase_postmix(p, sd, layer, shm);
    if constexpr (PH == 9) { for (int t = blockIdx.x; t < sd.nsamp * 16; t += gridDim.x) topk_task(p, sd, t, shm); }
    if constexpr (PH == 10) phase_moe_gu(p, sd, layer, shm);
    if constexpr (PH == 11) phase_moe_down(p, sd, layer, shm);
    if constexpr (PH == 12) phase_combine(p, sd, layer, shm);
}

#ifndef CPU_EMU
template <int PH> __global__ void __launch_bounds__(NTHREADS, 2) k_phase(Params p, int layer, int is_ctx, int grp) {
    DYN_LDS(shm);
    do_phase<PH>(p, layer, is_ctx, grp, shm);
}
#ifndef DBL_MASK
#define DBL_MASK 0
#endif
#define RUNPH(PH) do { do_phase<PH>(p, layer, is_ctx, grp, shm); xcd_barrier(bar); if ((DBL_MASK >> (PH)) & 1) { do_phase<PH>(p, layer, is_ctx, grp, shm); xcd_barrier(bar); } } while (0)
__global__ void __launch_bounds__(NTHREADS, 2) k_mega(Params p) {
    DYN_LDS(shm);
    uint4* xbw = (uint4*)(shm + 131072);
    if (threadIdx.x == 0) *xbw = make_uint4(0u, 0u, 0u, 0u);
    __syncthreads();
    XcdBarrier bar = xcd_barrier_post(p.bar(), (volatile LAS unsigned*)xbw);
    do_phase<-1>(p, 0, 0, 0, shm);
    xcd_barrier(bar);
    for (int layer = 0; layer < 2; ++layer)
        for (int si = 0; si <= NG; ++si) {
            const int is_ctx = si == 0 ? 1 : 0, grp = si == 0 ? 0 : si - 1;
            RUNPH(0); RUNPH(1); RUNPH(2);
            if (is_ctx && layer == 1) { do_phase<3>(p, layer, is_ctx, grp, shm); continue; }
            RUNPH(3); RUNPH(4); RUNPH(5); RUNPH(6); RUNPH(7); RUNPH(8); RUNPH(9); RUNPH(10); RUNPH(11);
            do_phase<12>(p, layer, is_ctx, grp, shm);
        }
}
#endif
}

static Params make_params(void* const* d_in, void* d_out, void* d_ws) {
    Params p{};
    p.x = (const float*)d_in[0]; p.c = (const float*)d_in[1]; p.ctx = (const float*)d_in[2]; p.c_ctx = (const float*)d_in[3];
    p.norm_gain = (const float*)d_in[4]; p.ada_w = (const float*)d_in[5]; p.ada_b = (const float*)d_in[6]; p.w_in = (const float*)d_in[7];
    p.gate_bias = (const float*)d_in[8]; p.pool_w = (const float*)d_in[9]; p.pool_scale = (const float*)d_in[10]; p.rpb = (const float*)d_in[11];
    p.w_branch = (const float*)d_in[12]; p.w_out = (const float*)d_in[13]; p.router_w = (const float*)d_in[14];
    p.w_gate = (const float*)d_in[15]; p.w_up = (const float*)d_in[16]; p.w_down = (const float*)d_in[17];
    p.out = (float*)d_out; p.ws = (char*)d_ws;
    return p;
}

#ifdef CPU_EMU
int emu_cfg_B = CFG_B, emu_cfg_ROWS = CFG_ROWS, emu_cfg_CTX = CFG_CTX;
const char* g_dumpdir = "data";
static void* g_ws = nullptr;
static void dump_buf(const char* name, int layer, int is_ctx, int grp, const void* ptr, size_t bytes) {
    char nm[512]; snprintf(nm, sizeof nm, "%s/d_L%d_%s%d_%s.bin", g_dumpdir, layer, is_ctx ? "c" : "g", grp, name);
    FILE* f = fopen(nm, "wb"); fwrite(ptr, 1, bytes, f); fclose(f);
}
static void emu_hook(const Params& p, int layer, int is_ctx, int grp, int ph) {
    const size_t Rn = is_ctx ? RC : RL;
    if (ph == 0) dump_buf("H", layer, is_ctx, grp, p.H(), Rn * 1024 * 2);
    if (ph == 1) dump_buf("PROJ", layer, is_ctx, grp, is_ctx ? p.PROJc() : p.PROJa(), Rn * PWA * 2);
    if (ph == 2) dump_buf("Pb", layer, is_ctx, grp, p.Pb(), Rn * 512 * 2);
    if (ph == 3) dump_buf("Nb", layer, is_ctx, grp, p.Nb(), Rn * 512 * 2);
    if (ph == 4) dump_buf("Mb", layer, is_ctx, grp, p.Mb(), Rn * 512 * 2);
    if (ph == 5) dump_buf("BG", layer, is_ctx, grp, p.BG(), Rn * NBG * 2);
    if (ph == 6) dump_buf("MERGED", layer, is_ctx, grp, p.MERGED(), Rn * 1024 * 2);
    if (ph == 7) dump_buf("Y", layer, is_ctx, grp, p.Y(), Rn * 1024 * 2);
    if (ph == 8) { dump_buf("H2", layer, is_ctx, grp, p.H(), Rn * 1024 * 2); dump_buf("aff", layer, is_ctx, grp, p.aff(), Rn * 16 * 4); }
}
void emu_dump(const char* dir) {
    char nm[512]; snprintf(nm, sizeof nm, "%s/d_mod.bin", dir);
    FILE* f = fopen(nm, "wb"); fwrite((char*)g_ws + WSL.mod, 1, (size_t)2 * (NB + 1) * 6144 * 4, f); fclose(f);
    snprintf(nm, sizeof nm, "%s/d_ctxs.bin", dir);
    f = fopen(nm, "wb"); fwrite((char*)g_ws + WSL.ctxs, 1, (size_t)NB * CTX * 1024 * 4, f); fclose(f);
}
template <int PH> static void emu_run_phase(const Params& p, int layer, int is_ctx, int grp, int nblocks) {
    emu_launch_lambda([=]() { do_phase<PH>(p, layer, is_ctx, grp, emu_blk->smem); }, nblocks, NTHREADS, LDS_BYTES);
    if (PH >= 0) emu_hook(p, layer, is_ctx, grp, PH);
    printf("phase %d layer %d ctx %d grp %d done\n", PH, layer, is_ctx, grp); fflush(stdout);
}
#define LAUNCH_PHASE(PH) emu_run_phase<PH>(p, layer, is_ctx, grp, nblocks)
#else
#define LAUNCH_PHASE(PH) hipLaunchKernelGGL((k_phase<PH>), dim3(nblocks), dim3(NTHREADS), LDS_BYTES, stream, p, layer, is_ctx, grp)
#define SETATTR(PH) (void)hipFuncSetAttribute((const void*)k_phase<PH>, hipFuncAttributeMaxDynamicSharedMemorySize, LDS_BYTES)
#endif

extern "C" void kernel_launch(void* const* d_in, const int* in_sizes, int n_in, void* d_out, int out_size, void* d_ws, size_t ws_size, hipStream_t stream) {
    (void)in_sizes; (void)n_in; (void)out_size;
    if (ws_size < WSL.total) return;
    Params p = make_params(d_in, d_out, d_ws);
#ifdef CPU_EMU
    g_ws = d_ws;
    memset(d_ws, 0xFF, WSL.total);
    const int nblocks = 16;
#else
    const int nblocks = 256;
#if MK_ONE_LAUNCH
    static int grid = 0;
    if (!grid) {
        (void)hipFuncSetAttribute((const void*)k_mega, hipFuncAttributeMaxDynamicSharedMemorySize, LDS_BYTES);
        int dev = 0, cus = 0, per_cu = 0;
        (void)hipGetDevice(&dev);
        (void)hipDeviceGetAttribute(&cus, hipDeviceAttributeMultiprocessorCount, dev);
        (void)hipOccupancyMaxActiveBlocksPerMultiprocessor(&per_cu, (const void*)k_mega, NTHREADS, LDS_BYTES);
        if (per_cu > 1) per_cu = 1;
        grid = cus * per_cu;
        if (grid > 256) grid = 256;
    }
    if (grid <= 0) return;
    (void)hipMemsetAsync(p.bar(), 0, 16384, stream);
    hipLaunchKernelGGL(k_mega, dim3(grid), dim3(NTHREADS), LDS_BYTES, stream, p);
    return;
#else
    static bool attr_done = false;
    if (!attr_done) { SETATTR(-1); SETATTR(0); SETATTR(1); SETATTR(2); SETATTR(3); SETATTR(4); SETATTR(5); SETATTR(6); SETATTR(7); SETATTR(8); SETATTR(9); SETATTR(10); SETATTR(11); SETATTR(12); attr_done = true; }
#endif
#endif
    { const int layer = 0, is_ctx = 0, grp = 0; LAUNCH_PHASE(-1); }
    for (int layer = 0; layer < 2; ++layer)
        for (int si = 0; si <= NG; ++si) {
            const int is_ctx = si == 0 ? 1 : 0, grp = si == 0 ? 0 : si - 1;
            LAUNCH_PHASE(0); LAUNCH_PHASE(1); LAUNCH_PHASE(2); LAUNCH_PHASE(3);
            if (is_ctx && layer == 1) continue;
            LAUNCH_PHASE(4); LAUNCH_PHASE(5); LAUNCH_PHASE(6); LAUNCH_PHASE(7); LAUNCH_PHASE(8); LAUNCH_PHASE(9); LAUNCH_PHASE(10); LAUNCH_PHASE(11); LAUNCH_PHASE(12);
        }
}
```

```cpp
#ifdef CPU_EMU
#include "emu.h"
#define DYN_LDS(p) char* p = emu_blk->smem
#define WAIT_V(n)
#define WAIT_L(n)
#define HIDE(v)
#define CBAR()
#else
#include <hip/hip_runtime.h>
#define DYN_LDS(p) extern __shared__ __attribute__((aligned(16))) char p[]
#define WAIT_V(n) asm volatile("s_waitcnt vmcnt(" #n ")" ::: "memory")
#define WAIT_L(n) asm volatile("s_waitcnt lgkmcnt(" #n ")" ::: "memory")
#define HIDE(v) asm volatile("" : "+v"(v))
#define CBAR() asm volatile("" ::: "memory")
#endif
#include <stdint.h>
#include <stddef.h>

#ifndef CFG_B
#define CFG_B 32
#define CFG_ROWS 32
#define CFG_CTX 256
#define CFG_G 16
#endif
#ifndef MK_ONE_LAUNCH
#define MK_ONE_LAUNCH 1
#endif

#define DEV __device__ __forceinline__
typedef short s16x4 __attribute__((ext_vector_type(4)));
#ifdef CPU_EMU
#define TR16(ptr) emu_tr16((const void*)(ptr))
#else
typedef __attribute__((address_space(3))) s16x4 lds_s16x4;
#define TR16(ptr) __builtin_amdgcn_ds_read_tr16_b64_v4i16((lds_s16x4*)(ptr))
#endif
#ifdef CPU_EMU
#define TID() (threadIdx.x)
#else
#define TID() ({ int t_ = threadIdx.x; asm volatile("" : "+v"(t_)); t_; })
#endif

typedef unsigned short bf16_t;
typedef short bf16x8 __attribute__((ext_vector_type(8)));
typedef float f32x4 __attribute__((ext_vector_type(4)));
typedef unsigned u32x2 __attribute__((ext_vector_type(2)));
typedef unsigned u32x4 __attribute__((ext_vector_type(4)));

namespace {
constexpr int D = 1024, NB = CFG_B, ROWS = CFG_ROWS, SEQ = ROWS * 64, CTX = CFG_CTX, G = CFG_G, NG = NB / G;
constexpr int RL = G * SEQ, RC = NB * CTX, RMAX = RL > RC ? RL : RC;
constexpr int PWA = 3840, NBG = 3072, PWT = PWA + NBG, PWSRC = 6672, C_SPLIT = 3600;
constexpr int C_QM = 0, C_KM = 256, C_VM = 512, C_OM = 1024, C_GM = 1536, C_PU = 1552, C_QN = 2064, C_KN = 2576, C_VN = 3088;
constexpr int NTBL = SEQ / 128, NTBC = CTX / 128;
constexpr int ilog2(int x) { return x <= 1 ? 0 : 1 + ilog2(x >> 1); }
constexpr int LGSEQ = ilog2(SEQ), LGCTX = ilog2(CTX);
static_assert((1 << LGSEQ) == SEQ && (1 << LGCTX) == CTX, "sequence lengths must be powers of two");
constexpr int cdiv(int a, int b) { return (a + b - 1) / b; }
constexpr int RPE_L = cdiv(G * (SEQ / 8), 256) * 256, RPE_C = cdiv(NB * (CTX / 8), 256) * 256, RPE_MAX = RPE_L > RPE_C ? RPE_L : RPE_C;
constexpr int NSLOT = 16 * RPE_MAX;
constexpr int NTHREADS = 512;
constexpr int GT_MAXU = 10;
constexpr int LDS_BYTES = 131072 + 256 + GT_MAXU * 1024;
constexpr int NST_L = G * 4 * 2 * NTBL, NST_C = NB * 4 * 2 * NTBC, NST = NST_L > NST_C ? NST_L : NST_C;
constexpr int NCI = NB * 4 * 2;
constexpr float RMS_EPS = 1e-6f;

struct WsLayout { size_t bar, WinT, WbT, WoT, WguT, WdT, mod, rope, ctxs, PROJc, CiC, Cin_, Cim, H, PROJa, Sst, Cin, Mb, Pb, Nb, Sn, Ssc, Cn, Cm, aff, slot_token, slot_gate, token_slots, HID, YE, BG, MERGED, Y, total; };
constexpr size_t al(size_t x) { return (x + 255) / 256 * 256; }
constexpr size_t smax(size_t a, size_t b) { return a > b ? a : b; }
constexpr WsLayout make_layout() {
    WsLayout L{}; size_t o = 0;
    L.bar = o; o += al(65536);
    L.WinT = o; o += al((size_t)2 * PWT * 1024 * 2);
    L.WbT = o; o += al((size_t)2 * 3 * 1024 * 512 * 2);
    L.WoT = o; o += al((size_t)2 * 1024 * 1024 * 2);
    L.WguT = o; o += al((size_t)2 * 16 * 2048 * 1024 * 2);
    L.WdT = o; o += al((size_t)2 * 16 * 1024 * 1024 * 2);
    L.mod = o; o += al((size_t)2 * (NB + 1) * 6144 * 4);
    L.rope = o; o += al((size_t)(ROWS + 64) * 16 * 2 * 4);
    L.ctxs = o; o += al((size_t)NB * CTX * 1024 * 4);
    L.PROJc = o; o += al((size_t)RC * PWA * 2);
    L.CiC = o; o += al((size_t)NCI * 8192 * 4);
    L.Cin_ = o; o += al((size_t)NCI * 64 * 4);
    L.Cim = o; o += al((size_t)NCI * 4 * 4);
    L.H = o; o += al((size_t)RMAX * 1024 * 2);
    const size_t x0 = o;
    L.PROJa = o; o += al((size_t)RMAX * PWA * 2);
    L.Sst = o; o += al((size_t)NST * 8192 * 4);
    L.Cin = o; o += al((size_t)NST * 8192 * 2);
    const size_t hid = al((size_t)NSLOT * 1024 * 2);
    o = x0 + smax(o - x0, 2 * hid);
    L.BG = x0; L.HID = x0; L.YE = x0 + hid;
    L.Mb = o; o += al((size_t)RMAX * 512 * 2);
    L.Pb = o; o += al((size_t)RMAX * 512 * 2);
    L.Nb = o; o += al((size_t)RMAX * 512 * 2);
    L.MERGED = L.H; L.Y = L.Mb;
    L.Sn = o; o += al((size_t)NST * 64 * 4);
    L.Ssc = o; o += al((size_t)NST * 4 * 4);
    L.Cn = o; o += al((size_t)NST * 64 * 4);
    L.Cm = o; o += al((size_t)NST * 4 * 4);
    L.aff = o; o += al((size_t)RMAX * 16 * 4);
    L.slot_token = o; o += al((size_t)NSLOT * 4);
    L.slot_gate = o; o += al((size_t)NSLOT * 4);
    L.token_slots = o; o += al((size_t)RMAX * 16 * 4);
    L.total = o;
    return L;
}
constexpr WsLayout WSL = make_layout();
static_assert((size_t)RMAX * NBG * 2 <= (size_t)RMAX * PWA * 2, "BG overlay must fit in PROJa");

struct Params {
    const float *x, *c, *ctx, *c_ctx, *norm_gain, *ada_w, *ada_b, *w_in, *gate_bias, *pool_w, *pool_scale, *rpb, *w_branch, *w_out, *router_w, *w_gate, *w_up, *w_down;
    float* out;
    char* ws;
#ifdef CPU_EMU
#define WSF(T, name) __device__ __host__ __forceinline__ T* name() const { return (T*)(ws + WSL.name); }
#else
#if defined(__HIP_DEVICE_COMPILE__)
#define WSF(T, name) __device__ __host__ __forceinline__ T* name() const { char* w_ = ws; asm volatile("" : "+s"(w_)); return (T*)(__attribute__((address_space(1))) T*)(w_ + WSL.name); }
#else
#define WSF(T, name) __device__ __host__ __forceinline__ T* name() const { return (T*)(ws + WSL.name); }
#endif
#endif
    WSF(unsigned, bar) WSF(bf16_t, WinT) WSF(bf16_t, WbT) WSF(bf16_t, WoT) WSF(bf16_t, WguT) WSF(bf16_t, WdT)
    WSF(float, mod) WSF(float, rope) WSF(float, ctxs) WSF(bf16_t, PROJc) WSF(float, CiC) WSF(float, Cin_) WSF(float, Cim)
    WSF(bf16_t, H) WSF(bf16_t, PROJa) WSF(float, Sst) WSF(bf16_t, Cin) WSF(bf16_t, Mb) WSF(bf16_t, Pb) WSF(bf16_t, Nb)
    WSF(float, Sn) WSF(float, Ssc) WSF(float, Cn) WSF(float, Cm) WSF(float, aff) WSF(int, slot_token) WSF(float, slot_gate) WSF(int, token_slots)
    WSF(bf16_t, HID) WSF(bf16_t, YE) WSF(bf16_t, BG) WSF(bf16_t, MERGED) WSF(bf16_t, Y)
#undef WSF
};

struct SetDesc { int is_ctx, nrows, samp0, nsamp, lgseq, ntb, cap, rpe; };
DEV SetDesc make_set(int is_ctx, int grp) {
    SetDesc s;
    s.is_ctx = is_ctx;
    if (is_ctx) { s.nrows = RC; s.samp0 = 0; s.nsamp = NB; s.lgseq = LGCTX; s.ntb = NTBC; s.cap = CTX / 8; s.rpe = RPE_C; }
    else { s.nrows = RL; s.samp0 = grp * G; s.nsamp = G; s.lgseq = LGSEQ; s.ntb = NTBL; s.cap = SEQ / 8; s.rpe = RPE_L; }
    return s;
}

#ifdef CPU_EMU
#define GAS
#else
#define GAS __attribute__((address_space(1)))
#endif
template <class T> DEV T ldg(const T* p) { return *(const GAS T*)p; }
template <class T> DEV void stg(T* p, const T& v) { *(GAS T*)p = v; }
DEV float bf2f(bf16_t v) { return __uint_as_float(((unsigned)v) << 16); }
DEV bf16_t f2bf(float f) { unsigned u = __float_as_uint(f); u += 0x7FFFu + ((u >> 16) & 1u); return (bf16_t)(u >> 16); }
#if defined(__HIP_DEVICE_COMPILE__)
typedef __bf16 bf16n2 __attribute__((ext_vector_type(2)));
typedef float f32n2 __attribute__((ext_vector_type(2)));
DEV unsigned pack2(float lo, float hi) { f32n2 v = {lo, hi}; bf16n2 r = __builtin_convertvector(v, bf16n2); return __builtin_bit_cast(unsigned, r); }
#else
DEV unsigned pack2(float lo, float hi) { return (unsigned)f2bf(lo) | ((unsigned)f2bf(hi) << 16); }
#endif
DEV float lo16(unsigned u) { return __uint_as_float(u << 16); }
DEV float hi16(unsigned u) { return __uint_as_float(u & 0xFFFF0000u); }
#if defined(__HIP_DEVICE_COMPILE__)
DEV float frcp(float x) { return __builtin_amdgcn_rcpf(x); }
#else
DEV float frcp(float x) { return 1.0f / x; }
#endif
#if defined(__HIP_DEVICE_COMPILE__)
DEV float sigmoidf_(float x) { return __builtin_amdgcn_rcpf(1.0f + __expf(-x)); }
#else
DEV float sigmoidf_(float x) { return 1.0f / (1.0f + __expf(-x)); }
#endif
DEV float logsigmoidf_(float x) { return fminf(x, 0.0f) - __logf(1.0f + __expf(-fabsf(x))); }
template <int M> DEV float shx(float v) {
#if defined(__HIP_DEVICE_COMPILE__)
    const unsigned u = __builtin_bit_cast(unsigned, v);
    if constexpr (M == 1) return __builtin_bit_cast(float, __builtin_amdgcn_update_dpp(u, u, 0xB1, 0xF, 0xF, false));
    else if constexpr (M == 2) return __builtin_bit_cast(float, __builtin_amdgcn_update_dpp(u, u, 0x4E, 0xF, 0xF, false));
    else if constexpr (M == 4) { const unsigned t = __builtin_amdgcn_update_dpp(u, u, 0x141, 0xF, 0xF, false);
        return __builtin_bit_cast(float, __builtin_amdgcn_update_dpp(t, t, 0x1B, 0xF, 0xF, false)); }
    else if constexpr (M == 8) return __builtin_bit_cast(float, __builtin_amdgcn_update_dpp(u, u, 0x128, 0xF, 0xF, false));
    else if constexpr (M == 16) { const auto r = __builtin_amdgcn_permlane16_swap(u, u, false, false); return __builtin_bit_cast(float, (threadIdx.x & 16) ? r[0] : r[1]); }
    else { const auto r = __builtin_amdgcn_permlane32_swap(u, u, false, false); return __builtin_bit_cast(float, (threadIdx.x & 32) ? r[0] : r[1]); }
#else
    return __shfl_xor(v, M);
#endif
}
DEV float wave_sum(float v) { v += shx<32>(v); v += shx<16>(v); v += shx<8>(v); v += shx<4>(v); v += shx<2>(v); v += shx<1>(v); return v; }
DEV bf16x8 mk8(u32x2 lo, u32x2 hi) { u32x4 v = {lo.x, lo.y, hi.x, hi.y}; return __builtin_bit_cast(bf16x8, v); }
DEV bf16x8 mk8(u32x4 v) { return __builtin_bit_cast(bf16x8, v); }
DEV bf16x8 mk8(s16x4 lo, s16x4 hi) { return __builtin_shufflevector(lo, hi, 0, 1, 2, 3, 4, 5, 6, 7); }
DEV f32x4 mfma16(bf16x8 a, bf16x8 b, f32x4 c) { return __builtin_amdgcn_mfma_f32_16x16x32_bf16(a, b, c, 0, 0, 0); }
DEV void store8bf(bf16_t* o, f32x4 a, f32x4 b) { u32x4 v = {pack2(a[0], a[1]), pack2(a[2], a[3]), pack2(b[0], b[1]), pack2(b[2], b[3])}; stg((u32x4*)o, v); }

#ifndef CPU_EMU
#define XB_TMO      128
#define XB_XCNT(j)  (256  + 64 * (j))
#define XB_XSUB(j)  (1280 + 64 * (j))
#define XB_XGEN(j)  (2304 + 64 * (j))
#define XB_TOP      3328
#define XB_TOPGEN   3392
#define XCD_BAR_WORDS 3456
#define XB_SPIN_CAP (1u << 18)
#define LAS __attribute__((address_space(3)))
__device__ __forceinline__ unsigned xb_ld(unsigned* p)              { return __hip_atomic_load(p, __ATOMIC_RELAXED, __HIP_MEMORY_SCOPE_AGENT); }
__device__ __forceinline__ unsigned xb_add(unsigned* p, unsigned v) { return __hip_atomic_fetch_add(p, v, __ATOMIC_RELAXED, __HIP_MEMORY_SCOPE_AGENT); }
__device__ __forceinline__ unsigned xb_xcc_id() { return (unsigned)__builtin_amdgcn_s_getreg((3 << 11) | 20) & 0xFu; }
#define XB_SPIN(cond, bar) do { unsigned _sp = 0; while (cond) { __builtin_amdgcn_s_sleep(1); \
    if ((++_sp & 255u) == 0u) { if (xb_ld(&(bar)[XB_TMO])) break; if (_sp > XB_SPIN_CAP) { atomicAdd(&(bar)[XB_TMO], 1u); break; } } } } while (0)
struct XcdBarrier { unsigned* bar; unsigned x; volatile LAS unsigned* st; };
__device__ __forceinline__ XcdBarrier xcd_barrier_post(unsigned* bar, volatile LAS unsigned* st) {
    XcdBarrier b; b.bar = bar; b.x = xb_xcc_id(); b.st = st;
    if (threadIdx.x == 0) (void)xb_add(&bar[XB_XCNT(b.x)], 1u);
    return b;
}
__device__ __forceinline__ void xcd_barrier_complete(unsigned* bar, unsigned x, unsigned& nloc, unsigned& nx) {
    const unsigned Gd = gridDim.x * gridDim.y * gridDim.z;
    unsigned sum, cnt, mine, sp = 0u;
    for (;;) {
        sum = 0u; cnt = 0u; mine = 0u;
#pragma unroll
        for (unsigned j = 0; j < 16; ++j) { const unsigned c = xb_ld(&bar[XB_XCNT(j)]); sum += c; cnt += (c > 0u) ? 1u : 0u; mine = (j == x) ? c : mine; }
        if (sum == Gd) break;
        __builtin_amdgcn_s_sleep(1);
        if ((++sp & 255u) == 0u) { if (xb_ld(&bar[XB_TMO])) break; if (sp > XB_SPIN_CAP) { atomicAdd(&bar[XB_TMO], 1u); break; } }
    }
    nloc = mine > 0u ? mine : 1u; nx = cnt > 0u ? cnt : 1u;
}
__device__ __forceinline__ void xcd_barrier(const XcdBarrier& b) {
    asm volatile("s_waitcnt vmcnt(0)" ::: "memory");
    __syncthreads();
    if (threadIdx.x == 0) {
        unsigned* bar = b.bar;
        unsigned bx = b.x; asm volatile("" : "+s"(bx));
        __builtin_amdgcn_s_waitcnt(0);
        unsigned nloc = b.st[0], nx = b.st[1];
        if (nloc == 0u) { xcd_barrier_complete(bar, bx, nloc, nx); b.st[0] = nloc; b.st[1] = nx; }
        const unsigned old = xb_add(&bar[XB_XSUB(bx)], 1u);
        const unsigned gen = old / nloc;
        if (old + 1u == (gen + 1u) * nloc) {
            __builtin_amdgcn_fence(__ATOMIC_RELEASE, "agent");
            asm volatile("s_waitcnt vmcnt(0)" ::: "memory");
            const unsigned og = xb_add(&bar[XB_TOP], 1u);
            const unsigned tg = og / nx;
            if (og + 1u == (tg + 1u) * nx) xb_add(&bar[XB_TOPGEN], 1u);
            else XB_SPIN(xb_ld(&bar[XB_TOPGEN]) == tg, bar);
            __builtin_amdgcn_fence(__ATOMIC_ACQUIRE, "agent");
            xb_add(&bar[XB_XGEN(bx)], 1u);
            asm volatile("s_waitcnt vmcnt(0)" ::: "memory");
        } else {
            XB_SPIN(xb_ld(&bar[XB_XGEN(bx)]) == gen, bar);
            __builtin_amdgcn_fence(__ATOMIC_ACQUIRE, "agent");
            asm volatile("s_waitcnt vmcnt(0)" ::: "memory");
        }
    }
    __syncthreads();
}
#endif

constexpr int BK = 64, HALF = 128, HT_BYTES = HALF * BK * 2;
DEV int lds_byte(int r, int c) { int st = (r >> 4) * 2 + (c >> 5), rr = r & 15, cc = c & 31, ob = rr * 64 + cc * 2; return st * 1024 + (ob ^ (((ob >> 9) & 1) << 5)); }
DEV void stage_rc(int b, int& Rr, int& Cc) { int st = b / 1024, sb = b % 1024, swz = sb ^ (((sb >> 9) & 1) << 5); Rr = (st >> 1) * 16 + swz / 64; Cc = (st & 1) * 32 + (swz % 64) / 2; }
DEV int perm32(int rho) { const int n = rho >> 4, i = rho & 15; return 8 * (i >> 2) + 4 * n + (i & 3); }

DEV bool tile_order(int i, int nM, int nN, int& pm, int& pn) {
    const int nwg = nM * nN; const int L = i * (int)gridDim.x + (int)blockIdx.x; if (L >= nwg) return false;
    int wgid = L; { const int q = nwg / 8, r = nwg % 8, xcd = wgid % 8, off = wgid / 8; wgid = (xcd < r ? xcd * (q + 1) : r * (q + 1) + (xcd - r) * q) + off; }
    const int nig = 8 * nN, gid = wgid / nig, fm = gid * 8, gsz = (nM - fm) < 8 ? (nM - fm) : 8;
    pm = fm + ((wgid % nig) % gsz); pn = (wgid % nig) / gsz; return true;
}
#define GLDS16(src, dst) __builtin_amdgcn_global_load_lds((const unsigned*)(src), (unsigned*)(dst), 16, 0, 0)

#define BAR __builtin_amdgcn_s_barrier()
#define SCHED __builtin_amdgcn_sched_barrier(0)
struct GUnit { int pm, pn, aux; };
template <bool GATHER, int LDA_, int LDB_, int K_, class Sched, class Epi>
DEV void gemm_stream(char* shm, const Sched& S, const Epi& epi) {
#define SA(b, h) (shm + ((b) * 2 + (h)) * HT_BYTES)
#define SB(b, h) (shm + (4 + (b) * 2 + (h)) * HT_BYTES)
#define STG_B(P, bp) do { GLDS16((bp) + voffB, (P) + ldsb0); GLDS16((bp) + voffB + 64 * LDB_, (P) + ldsb0 + 8192); } while (0)
#define STG_A(P, ap, h, gv) do { if (GATHER) { GLDS16((ap) + gv[h][0], (P) + ldsb0); GLDS16((ap) + gv[h][1], (P) + ldsb0 + 8192); } \
    else { GLDS16((ap) + voffA + (h) * 128 * LDA_, (P) + ldsb0); GLDS16((ap) + voffA + ((h) * 128 + 64) * LDA_, (P) + ldsb0 + 8192); } } while (0)
#define LDA(dst, b, h) _Pragma("unroll") for (int m = 0; m < 4; ++m) _Pragma("unroll") for (int k = 0; k < 2; ++k) \
    dst[m][k] = *reinterpret_cast<const bf16x8*>(SA(b, h) + aoff + m * 2048 + k * 1024)
#define LDB(dst, b, h) _Pragma("unroll") for (int n = 0; n < 2; ++n) _Pragma("unroll") for (int k = 0; k < 2; ++k) \
    dst[n][k] = *reinterpret_cast<const bf16x8*>(SB(b, h) + boff + n * 2048 + k * 1024)
#define MMA(ai, bj, At_, Bx_) do { __builtin_amdgcn_s_setprio(1); \
    _Pragma("unroll") for (int m = 0; m < 4; ++m) _Pragma("unroll") for (int n = 0; n < 2; ++n) _Pragma("unroll") for (int k = 0; k < 2; ++k) \
      acc[ai][bj][m][n] = mfma16(Bx_[n][k], At_[m][k], acc[ai][bj][m][n]); \
    __builtin_amdgcn_s_setprio(0); } while (0)
    constexpr int nt = K_ / BK;
    const int tid = TID();
    const int wid = __builtin_amdgcn_readfirstlane(tid >> 6), lane = tid & 63, wr = wid >> 2, wc = wid & 3, fr = lane & 15, fq = lane >> 4;
    const int ldsb0 = tid * 16;
    int Rr0, Cc0; stage_rc(tid * 16, Rr0, Cc0);
    const int voffA = Rr0 * LDA_ + Cc0;
    const int voffB = ((Rr0 & ~31) + perm32(Rr0 & 31)) * LDB_ + Cc0;
    const int aoff = lds_byte(wr * 64 + fr, fq * 8), boff = lds_byte(wc * 32 + fr, fq * 8);
    GUnit cur, nxt; int ui = 0;
    if (!S.next(0, cur)) return;
    int gc[2][2] = {{0, 0}, {0, 0}};
    int* gtab = (int*)(shm + 131072 + 256);
    if (GATHER) {
        __syncthreads();
        { GUnit u; for (int i = 0; i < GT_MAXU && S.next(i, u); ++i) { if (tid < 256) gtab[i * 256 + tid] = ldg(S.ridx(u) + tid) * LDA_; } }
        __syncthreads();
#pragma unroll
        for (int h = 0; h < 2; ++h)
#pragma unroll
            for (int i = 0; i < 2; ++i) gc[h][i] = gtab[h * 128 + i * 64 + Rr0] + Cc0;
    }
    f32x4 acc[2][2][4][2];
#pragma unroll
    for (int a = 0; a < 2; ++a)
#pragma unroll
        for (int b = 0; b < 2; ++b)
#pragma unroll
            for (int m = 0; m < 4; ++m)
#pragma unroll
                for (int n = 0; n < 2; ++n) acc[a][b][m][n] = (f32x4){0.f, 0.f, 0.f, 0.f};
    bf16x8 At[4][2], B0[2][2], B1[2][2];
    const bf16_t* cA = S.a_base(cur); const bf16_t* cB = S.b_base(cur);
    STG_B(SB(0, 0), cB); STG_A(SA(0, 0), cA, 0, gc); STG_B(SB(0, 1), cB + 128 * LDB_); STG_A(SA(0, 1), cA, 1, gc);
    if (wr == 1) BAR;
    WAIT_V(4); BAR;
    STG_B(SB(1, 0), cB + BK); STG_A(SA(1, 0), cA + BK, 0, gc); STG_B(SB(1, 1), cB + 128 * LDB_ + BK);
    WAIT_V(6); BAR;
    for (;;) {
        const bool has_next = S.next(ui + 1, nxt);
        const bf16_t* nA = has_next ? S.a_base(nxt) : cA; const bf16_t* nB = has_next ? S.b_base(nxt) : cB;
#pragma unroll 1
        for (int t = 0; t < nt; t += 2) {
            const bool last = (t == nt - 2);
            const bf16_t* a1 = cA + (t + 1) * BK;
            const bf16_t* a2 = last ? nA : cA + (t + 2) * BK; const bf16_t* b2 = last ? nB : cB + (t + 2) * BK;
            const bf16_t* a3 = a2 + BK; const bf16_t* b3 = b2 + BK;
            LDB(B0, 0, 0); SCHED; LDA(At, 0, 0); STG_A(SA(1, 1), a1, 1, gc);
            if (GATHER && last && has_next) {
#pragma unroll
                for (int h = 0; h < 2; ++h)
#pragma unroll
                    for (int i = 0; i < 2; ++i) gc[h][i] = gtab[(ui + 1) * 256 + h * 128 + i * 64 + Rr0] + Cc0; }
            WAIT_L(8); BAR; WAIT_L(0); MMA(0, 0, At, B0); BAR; SCHED;
            LDB(B1, 0, 1); STG_B(SB(0, 0), b2);
            BAR; WAIT_L(0); MMA(0, 1, At, B1); BAR;
            LDA(At, 0, 1); STG_A(SA(0, 0), a2, 0, gc);
            BAR; WAIT_L(0); MMA(1, 0, At, B0); BAR; SCHED;
            STG_B(SB(0, 1), b2 + 128 * LDB_);
            WAIT_V(6); BAR; MMA(1, 1, At, B1); BAR;
            LDB(B0, 1, 0); SCHED; LDA(At, 1, 0); STG_A(SA(0, 1), a2, 1, gc);
            WAIT_L(8); BAR; WAIT_L(0); MMA(0, 0, At, B0); BAR; SCHED;
            LDB(B1, 1, 1); STG_B(SB(1, 0), b3);
            BAR; WAIT_L(0); MMA(0, 1, At, B1); BAR;
            LDA(At, 1, 1); STG_A(SA(1, 0), a3, 0, gc);
            BAR; WAIT_L(0); MMA(1, 0, At, B0); BAR; SCHED;
            STG_B(SB(1, 1), b3 + 128 * LDB_);
            WAIT_V(6); BAR; MMA(1, 1, At, B1); BAR;
        }
        {
            const int tz = TID(); const int wz = tz >> 6, lz = tz & 63, wrz = wz >> 2, wcz = wz & 3, frz = lz & 15, fqz = lz >> 4;
            epi(cur, acc, wrz * 64 + frz, wcz * 32 + 8 * fqz);
        }
        if (!has_next) break;
#pragma unroll
        for (int a = 0; a < 2; ++a)
#pragma unroll
            for (int b = 0; b < 2; ++b)
#pragma unroll
                for (int m = 0; m < 4; ++m)
#pragma unroll
                    for (int n = 0; n < 2; ++n) acc[a][b][m][n] = (f32x4){0.f, 0.f, 0.f, 0.f};
        cur = nxt; cA = nA; cB = nB; ++ui;
    }
    WAIT_V(0);
    if (wr == 0) BAR;
    BAR;
#undef SA
#undef SB
#undef STG_A
#undef STG_B
#undef LDA
#undef LDB
#undef MMA
}

constexpr int J_IN = 16 * 27, J_WB = 2 * 8 * 4, J_WO = 16 * 4, J_GU = 16 * 2 * 64, J_DN = 16 * 64, J_FOLD = 8 * 16, J_PAD = 1;
constexpr int N_MODJOBS = 2 * 96;

constexpr int J_BIG = J_IN + J_WB + J_WO + J_GU + J_DN;
struct WJob { const float* src; bf16_t* dst; int ldsrc, lddst, nvalid, k0, n0, mode, gu_which; };
DEV WJob wjob_decode(const Params& p, int l, int j) {
    WJob w; w.ldsrc = 1024; w.lddst = 1024; w.nvalid = 256; w.mode = 0; w.gu_which = 0;
    if (j < J_IN) { const int kt = j / 27, nb = j % 27; w.k0 = kt * 64; w.n0 = nb * 256; w.src = p.w_in + (size_t)l * 1024 * PWSRC; w.ldsrc = PWSRC; w.nvalid = PWSRC - w.n0; w.dst = p.WinT() + (size_t)l * PWT * 1024; w.mode = 3; }
    else if ((j -= J_IN) < J_WB) { const int bi = (j / 32) * 2, jj = j % 32, kt = jj / 4, nb = jj % 4; w.k0 = kt * 64; w.n0 = nb * 256;
        w.src = p.w_branch + ((size_t)l * 3 + bi) * 512 * 1024; w.dst = p.WbT() + ((size_t)l * 3 + bi) * 1024 * 512; w.lddst = 512; }
    else if ((j -= J_WB) < J_WO) { const int kt = j / 4, nb = j % 4; w.k0 = kt * 64; w.n0 = nb * 256; w.src = p.w_out + (size_t)l * 1024 * 1024; w.dst = p.WoT() + (size_t)l * 1024 * 1024; }
    else if ((j -= J_WO) < J_GU) { const int e = j / 128, jj = j % 128; w.gu_which = jj / 64; const int j3 = jj % 64, kt = j3 / 4, nb = j3 % 4; w.k0 = kt * 64; w.n0 = nb * 256;
        w.src = (w.gu_which ? p.w_up : p.w_gate) + ((size_t)l * 16 + e) * 1024 * 1024; w.dst = p.WguT() + ((size_t)l * 16 + e) * 2048 * 1024; w.mode = 1; }
    else { j -= J_GU; const int e = j / 64, jj = j % 64, kt = jj / 4, nb = jj % 4; w.k0 = kt * 64; w.n0 = nb * 256;
        w.src = p.w_down + ((size_t)l * 16 + e) * 1024 * 1024; w.dst = p.WdT() + ((size_t)l * 16 + e) * 1024 * 1024; }
    return w;
}
constexpr int WT_LD = 260;
DEV void wjob_load(const WJob& w, int tid, f32x4 (&vv)[8]) {
#pragma unroll
    for (int i = 0; i < 8; ++i) { const int idx = i * 512 + tid, r = idx >> 6, c = (idx & 63) * 4; int col = w.n0 + c; col = col > w.ldsrc - 4 ? w.ldsrc - 4 : col;
        vv[i] = ldg((const f32x4*)(w.src + (size_t)(w.k0 + r) * w.ldsrc + col)); }
}
DEV void wjob_finish(const WJob& w, int tid, const f32x4 (&vv)[8], float* tile) {
    __syncthreads();
#pragma unroll
    for (int i = 0; i < 8; ++i) { const int idx = i * 512 + tid, r = idx >> 6, c = (idx & 63) * 4; *(f32x4*)(tile + r * WT_LD + c) = vv[i]; }
    __syncthreads();
#pragma unroll
    for (int q = 0; q < 4; ++q) {
        const int item = q * 512 + tid, nrow = item >> 3, kc = (item & 7) * 8;
        float v[8];
#pragma unroll
        for (int jj = 0; jj < 8; ++jj) v[jj] = tile[(kc + jj) * WT_LD + nrow];
        const int n = w.n0 + nrow;
        int drow = n;
        if (w.mode == 1) drow = (n >> 7) * 256 + w.gu_which * 128 + (n & 127);
        if (w.mode == 3) drow = n + (n >= C_SPLIT ? (PWA - C_SPLIT) : 0);
        if (nrow < w.nvalid) { u32x4 o = {pack2(v[0], v[1]), pack2(v[2], v[3]), pack2(v[4], v[5]), pack2(v[6], v[7])};
            stg((u32x4*)(w.dst + (size_t)drow * w.lddst + w.k0 + kc), o); }
    }
}
DEV void pro_small_job(const Params& p, int l, int j, char* shm) {
    float* tile = (float*)shm;
    const int tid = TID();
    if (j < J_FOLD) {
        const int kt = j / 16, ntl = j % 16, k0 = kt * 64, n0 = ntl * 64; const int fg = k0 / 128;
        const float* wb1 = p.w_branch + ((size_t)l * 3 + 1) * 512 * 1024;
        const float* pw = p.pool_w + ((size_t)l * 4 + fg) * 128 * 128; const float* ps = p.pool_scale + (size_t)l * 512 + fg * 128;
        const int c = tid & 63, rq = tid >> 6;
        float accv[8];
#pragma unroll
        for (int i = 0; i < 8; ++i) accv[i] = 0.f;
        for (int d = 0; d < 128; ++d) { const float wv = ldg(wb1 + (size_t)(fg * 128 + d) * 1024 + n0 + c) * ldg(ps + d);
#pragma unroll
            for (int i = 0; i < 8; ++i) accv[i] += ldg(pw + (size_t)(k0 - fg * 128 + rq * 8 + i) * 128 + d) * wv; }
        __syncthreads();
#pragma unroll
        for (int i = 0; i < 8; ++i) tile[(rq * 8 + i) * WT_LD + c] = accv[i];
        __syncthreads();
        const int nrow = tid >> 3, kc = (tid & 7) * 8; float v[8];
#pragma unroll
        for (int jj = 0; jj < 8; ++jj) v[jj] = tile[(kc + jj) * WT_LD + nrow];
        u32x4 o = {pack2(v[0], v[1]), pack2(v[2], v[3]), pack2(v[4], v[5]), pack2(v[6], v[7])};
        stg((u32x4*)(p.WbT() + ((size_t)l * 3 + 1) * 1024 * 512 + (size_t)(n0 + nrow) * 512 + k0 + kc), o);
    } else {
        bf16_t* d0 = p.WinT() + (size_t)l * PWT * 1024 + (size_t)C_SPLIT * 1024;
        for (int i = tid; i < (PWA - C_SPLIT) * 1024 / 8; i += NTHREADS) stg((u32x4*)(d0 + (size_t)i * 8), (u32x4){0u, 0u, 0u, 0u});
    }
}

DEV void pro_mod_job(const Params& p, int job, char* shm) {
    float* sv = (float*)shm;
    const int tid = TID(), l = job / 96, col0 = (job % 96) * 64;
    const int c = tid & 63, kp = tid >> 6;
    float acc[NB + 1];
#pragma unroll
    for (int v = 0; v <= NB; ++v) acc[v] = 0.f;
    for (int half = 0; half < 2; ++half) {
        __syncthreads();
        for (int idx = tid; idx < (NB + 1) * 512; idx += 512) { const int v = idx >> 9, k = idx & 511;
            const float s = (v < NB) ? ldg(p.c + (size_t)v * 1024 + half * 512 + k) : ldg(p.c_ctx + half * 512 + k);
            sv[idx] = s * sigmoidf_(s); }
        __syncthreads();
        for (int kk = 0; kk < 64; ++kk) { const int k = kp * 64 + kk;
            const float w = ldg(p.ada_w + ((size_t)l * 1024 + half * 512 + k) * 6144 + col0 + c);
#pragma unroll
            for (int v = 0; v <= NB; ++v) acc[v] += sv[v * 512 + k] * w; }
    }
    __syncthreads();
    float* red = (float*)shm;
#pragma unroll
    for (int v = 0; v <= NB; ++v) red[(kp * (NB + 1) + v) * 64 + c] = acc[v];
    __syncthreads();
    for (int idx = tid; idx < (NB + 1) * 64; idx += 512) { const int v = idx >> 6, cc = idx & 63; float s = 0.f;
#pragma unroll
        for (int q = 0; q < 8; ++q) s += red[(q * (NB + 1) + v) * 64 + cc];
        stg(p.mod() + ((size_t)l * (NB + 1) + v) * 6144 + col0 + cc, s + ldg(p.ada_b + (size_t)l * 6144 + col0 + cc)); }
}

DEV void phase_prologue(const Params& p, char* shm) {
    const int tid = TID();
    const int nsmall = N_MODJOBS + 1 + 2 * (J_FOLD + J_PAD);
    for (int job = blockIdx.x; job < nsmall; job += gridDim.x) {
        if (job < N_MODJOBS) pro_mod_job(p, job, shm);
        else if (job == N_MODJOBS) {
            for (int idx = tid; idx < (ROWS + 64) * 16; idx += NTHREADS) { const int pos = idx >> 4, i = idx & 15;
                const float pv = (float)(pos < ROWS ? pos : pos - ROWS);
                const float inv = powf(10000.0f, -(float)(2 * i) / 32.0f);
                const float a = pv * inv; stg(p.rope() + idx * 2, cosf(a)); stg(p.rope() + idx * 2 + 1, sinf(a)); }
        } else { const int sj = job - N_MODJOBS - 1; pro_small_job(p, sj / (J_FOLD + J_PAD), sj % (J_FOLD + J_PAD), shm); }
    }
    float* tile = (float*)shm;
    const int nbig = 2 * J_BIG;
    int job = blockIdx.x;
    if (job >= nbig) return;
    WJob wc = wjob_decode(p, job / J_BIG, job % J_BIG), wn = wc;
    f32x4 vc[8], vn[8];
    wjob_load(wc, tid, vc);
    for (; job < nbig; job += gridDim.x) {
        const int jn = job + gridDim.x;
        if (jn < nbig) { wn = wjob_decode(p, jn / J_BIG, jn % J_BIG); wjob_load(wn, tid, vn); }
        wjob_finish(wc, tid, vc, tile);
        wc = wn;
#pragma unroll
        for (int i = 0; i < 8; ++i) vc[i] = vn[i];
    }
}

DEV const float* xsrc_base(const Params& p, const SetDesc& sd, int layer) {
    return (sd.is_ctx ? (layer == 0 ? p.ctx : (const float*)p.ctxs()) : (layer == 0 ? p.x : (const float*)p.out)) + (((size_t)sd.samp0) << sd.lgseq) * 1024;
}
DEV float* xdst_base(const Params& p, const SetDesc& sd) { return (sd.is_ctx ? p.ctxs() : p.out) + (((size_t)sd.samp0) << sd.lgseq) * 1024; }
DEV const float* mod_row(const Params& p, const SetDesc& sd, int layer, int row) {
    return p.mod() + ((size_t)layer * (NB + 1) + (sd.is_ctx ? NB : sd.samp0 + (row >> sd.lgseq))) * 6144;
}
DEV bf16_t* proj_buf(const Params& p, const SetDesc& sd) { return sd.is_ctx ? p.PROJc() : p.PROJa(); }

DEV void stage_params(float* par, const float* v0, const float* v1, const float* v2, const float* v3, const float* v4) {
    const int tid = TID();
    const float* src[5] = {v0, v1, v2, v3, v4};
#pragma unroll
    for (int k = 0; k < 5; ++k) if (src[k]) { for (int i = tid; i < 1024; i += NTHREADS) par[k * 1024 + i] = ldg(src[k] + i); }
}
DEV void phase_norm1(const Params& p, const SetDesc& sd, int layer, char* shm) {
    const int tid = TID(), lane = tid & 63, wv = tid >> 6;
    const float* g0 = p.norm_gain + ((size_t)layer * 4 + 0) * 1024;
    const float* xb = xsrc_base(p, sd, layer);
    const int stride = 8; const int rpb_ = (sd.nrows + (int)gridDim.x - 1) / (int)gridDim.x; const int row_end = min(sd.nrows, ((int)blockIdx.x + 1) * rpb_);
    int row = (int)blockIdx.x * rpb_ + wv;
    float* par = (float*)shm;
    __syncthreads();
    { const float* mdb = mod_row(p, sd, layer, min((int)blockIdx.x * rpb_, sd.nrows - 1)); stage_params(par, g0, mdb, mdb + 1024, nullptr, nullptr); }
    __syncthreads();
    f32x4 cur[4], nxt[4];
    if (row < row_end) {
#pragma unroll
        for (int i = 0; i < 4; ++i) cur[i] = ldg((const f32x4*)(xb + (size_t)row * 1024 + (i >> 1) * 512 + lane * 8 + (i & 1) * 4)); }
    for (; row < row_end; row += stride) {
        const int rn = row + stride;
        if (rn < row_end) {
#pragma unroll
            for (int i = 0; i < 4; ++i) nxt[i] = ldg((const f32x4*)(xb + (size_t)rn * 1024 + (i >> 1) * 512 + lane * 8 + (i & 1) * 4)); }
        const float* md = mod_row(p, sd, layer, row);
        float ss = 0.f;
#pragma unroll
        for (int i = 0; i < 4; ++i)
#pragma unroll
            for (int j = 0; j < 4; ++j) ss += cur[i][j] * cur[i][j];
        ss = wave_sum(ss);
        const float rstd = rsqrtf(ss * (1.0f / 1024.0f) + RMS_EPS);
#pragma unroll
        for (int hlf = 0; hlf < 2; ++hlf) { const int c0 = hlf * 512 + lane * 8; float o[8];
#pragma unroll
            for (int j = 0; j < 8; ++j) o[j] = cur[hlf * 2 + (j >> 2)][j & 3] * rstd * par[c0 + j] * (1.0f + par[2048 + c0 + j]) + par[1024 + c0 + j];
            u32x4 ov = {pack2(o[0], o[1]), pack2(o[2], o[3]), pack2(o[4], o[5]), pack2(o[6], o[7])};
            stg((u32x4*)(p.H() + (size_t)row * 1024 + c0), ov); }
#pragma unroll
        for (int i = 0; i < 4; ++i) cur[i] = nxt[i];
    }
}

struct SchedPlain {
    const bf16_t* A; const bf16_t* Bt; int nM, nN, lda256, ldb256;
    DEV bool next(int i, GUnit& u) const { u.aux = 0; return tile_order(i, nM, nN, u.pm, u.pn); }
    DEV const bf16_t* a_base(const GUnit& u) const { return A + (size_t)u.pm * lda256; }
    DEV const bf16_t* b_base(const GUnit& u) const { return Bt + (size_t)u.pn * ldb256; }
    DEV const int* ridx(const GUnit&) const { return nullptr; }
};
DEV void phase_proj_a(const Params& p, const SetDesc& sd, int layer, char* shm) {
    SchedPlain S; S.A = p.H(); S.Bt = p.WinT() + (size_t)layer * PWT * 1024; S.nM = sd.nrows / 256; S.nN = PWA / 256; S.lda256 = 256 * 1024; S.ldb256 = 256 * 1024;
    bf16_t* pb = proj_buf(p, sd);
    gemm_stream<false, 1024, 1024, 1024>(shm, S, [=](const GUnit& u, const f32x4 (&acc)[2][2][4][2], int r0, int c0) {
#pragma unroll
        for (int ai = 0; ai < 2; ++ai)
#pragma unroll
            for (int m = 0; m < 4; ++m) { bf16_t* o = pb + ((size_t)u.pm * 256 + r0 + ai * 128 + m * 16) * PWA + u.pn * 256 + c0;
                store8bf(o, acc[ai][0][m][0], acc[ai][0][m][1]); store8bf(o + 128, acc[ai][1][m][0], acc[ai][1][m][1]); } });
}
DEV f32x4 sig4(f32x4 v) { f32x4 r; r[0] = sigmoidf_(v[0]); r[1] = sigmoidf_(v[1]); r[2] = sigmoidf_(v[2]); r[3] = sigmoidf_(v[3]); return r; }
DEV void phase_proj_b(const Params& p, const SetDesc& sd, int layer, char* shm) {
    SchedPlain S; S.A = p.H(); S.Bt = p.WinT() + (size_t)layer * PWT * 1024 + (size_t)PWA * 1024; S.nM = sd.nrows / 256; S.nN = NBG / 256; S.lda256 = 256 * 1024; S.ldb256 = 256 * 1024;
    bf16_t* bg = p.BG();
    gemm_stream<false, 1024, 1024, 1024>(shm, S, [=](const GUnit& u, const f32x4 (&acc)[2][2][4][2], int r0, int c0) {
#pragma unroll
        for (int ai = 0; ai < 2; ++ai)
#pragma unroll
            for (int m = 0; m < 4; ++m) { bf16_t* o = bg + ((size_t)u.pm * 256 + r0 + ai * 128 + m * 16) * NBG + u.pn * 256 + c0;
                store8bf(o, sig4(acc[ai][0][m][0]), sig4(acc[ai][0][m][1])); store8bf(o + 128, sig4(acc[ai][1][m][0]), sig4(acc[ai][1][m][1])); } });
}

DEV void gate_scan(const bf16_t* prow, int h, const float* gbias, float* ga, float* gb, float* gpm, float* gtot, float* tmp) {
    const int tid = TID(), lane = tid & 63, w = tid >> 6;
    float b = 0.f, a = 0.f, pm = 0.f; int d = 0, tok = 0;
    if (tid < 256) {
        d = tid >> 7; const int i = tid & 127; tok = d ? 127 - i : i;
        const float gi = bf2f(ldg(prow + (size_t)tok * PWA + C_GM + (2 * d) * 4 + h)) + ldg(gbias + (2 * d) * 4 + h);
        const float gf = bf2f(ldg(prow + (size_t)tok * PWA + C_GM + (2 * d + 1) * 4 + h)) + ldg(gbias + (2 * d + 1) * 4 + h);
        b = logsigmoidf_(gf);
#pragma unroll
        for (int o = 1; o < 64; o <<= 1) { const float t = __shfl_up(b, o); if (lane >= o) b += t; }
        if (lane == 63) tmp[w] = b;
        a = gi;
    }
    __syncthreads();
    if (tid < 256) {
        if (w & 1) b += tmp[w - 1];
        a -= b; pm = a;
#pragma unroll
        for (int o = 1; o < 64; o <<= 1) { const float t = __shfl_up(pm, o); if (lane >= o) pm = fmaxf(pm, t); }
        if (lane == 63) tmp[8 + w] = pm;
    }
    __syncthreads();
    if (tid < 256) {
        if (w & 1) pm = fmaxf(pm, tmp[8 + w - 1]);
        ga[d * 128 + tok] = a; gb[d * 128 + tok] = b; gpm[d * 128 + tok] = pm;
        if ((tid & 127) == 127) { gtot[d * 2] = b; gtot[d * 2 + 1] = pm; }
    }
    __syncthreads();
}

DEV void load_rope_chunk(const bf16_t* hp, int cidx, bool latent, int tl, const float* rope, float scale, float* o) {
    const u32x4 m = ldg((const u32x4*)(hp + cidx * 8));
    float x[8] = {lo16(m.x), hi16(m.x), lo16(m.y), hi16(m.y), lo16(m.z), hi16(m.z), lo16(m.w), hi16(m.w)};
    if (latent) {
        const u32x4 q = ldg((const u32x4*)(hp + (cidx ^ 2) * 8));
        const float y[8] = {lo16(q.x), hi16(q.x), lo16(q.y), hi16(q.y), lo16(q.z), hi16(q.z), lo16(q.w), hi16(q.w)};
        const int pos = (cidx < 4) ? (tl >> 6) : (ROWS + (tl & 63));
        const float* tb = rope + ((size_t)pos * 16 + (cidx & 1) * 8) * 2;
        const bool first = (cidx & 2) == 0;
#pragma unroll
        for (int j = 0; j < 8; ++j) { const float cs = ldg(tb + j * 2), sn = ldg(tb + j * 2 + 1);
            x[j] = first ? (x[j] * cs - y[j] * sn) : (x[j] * cs + y[j] * sn); }
    }
#pragma unroll
    for (int j = 0; j < 8; ++j) o[j] = x[j] * scale;
}

DEV int st_index(const SetDesc& sd, int sl, int h, int dir, int tb) { return ((sl * 4 + h) * 2 + dir) * sd.ntb + tb; }

constexpr int V_LD = 144, K_LD = 72, KS_LD = 80;
DEV void mlstm_stepA_task(const Params& p, const SetDesc& sd, int layer, int task, char* shm) {
    const int tid = TID(), lane = tid & 63, w = tid >> 6, fr = lane & 15, fq = lane >> 4, tq4 = (lane & 15) >> 2, tp4 = lane & 3;
    const int tb = task % sd.ntb, h = (task / sd.ntb) & 3, sl = task / (sd.ntb * 4);
    const int row0 = (sl << sd.lgseq) + tb * 128; const bool latent = !sd.is_ctx; const int tl0 = tb * 128;
    bf16_t* Vs = (bf16_t*)shm;
    bf16_t* Ksc = (bf16_t*)(shm + 128 * V_LD * 2);
    float* ga = (float*)(shm + 128 * V_LD * 2 + 2 * 128 * KS_LD * 2); float* gb = ga + 256; float* gpm = gb + 256; float* gtot = gpm + 256; float* tmp = gtot + 8;
    const bf16_t* prow = proj_buf(p, sd) + (size_t)row0 * PWA;
    __syncthreads();
    gate_scan(prow, h, p.gate_bias + (size_t)layer * 16, ga, gb, gpm, gtot, tmp);
    {
        const int s = tid & 127, cpi = tid >> 7, cp = (cpi & 1) + (cpi >> 1) * 4;
        const bf16_t* hp = prow + (size_t)s * PWA + C_KM + h * 64;
        float k1[8], k2[8];
        load_rope_chunk(hp, cp, latent, tl0 + s, p.rope(), 1.0f, k1);
        load_rope_chunk(hp, cp + 2, latent, tl0 + s, p.rope(), 1.0f, k2);
#pragma unroll
        for (int dir = 0; dir < 2; ++dir) { const float ws = __expf(ga[dir * 128 + s] - gtot[dir * 2 + 1]);
            u32x4 o1 = {pack2(k1[0] * ws, k1[1] * ws), pack2(k1[2] * ws, k1[3] * ws), pack2(k1[4] * ws, k1[5] * ws), pack2(k1[6] * ws, k1[7] * ws)};
            u32x4 o2 = {pack2(k2[0] * ws, k2[1] * ws), pack2(k2[2] * ws, k2[3] * ws), pack2(k2[4] * ws, k2[5] * ws), pack2(k2[6] * ws, k2[7] * ws)};
            *(u32x4*)(Ksc + (dir * 128 + s) * KS_LD + cp * 8) = o1; *(u32x4*)(Ksc + (dir * 128 + s) * KS_LD + (cp + 2) * 8) = o2; }
    }
#pragma unroll
    for (int it = 0; it < 4; ++it) { const int item = tid + it * 512, s = item >> 4, ch = item & 15;
        *(u32x4*)(Vs + s * V_LD + ch * 8) = ldg((const u32x4*)(prow + (size_t)s * PWA + C_VM + h * 128 + ch * 8)); }
    __syncthreads();
    f32x4 acc[2][4];
#pragma unroll
    for (int dir = 0; dir < 2; ++dir)
#pragma unroll
        for (int n = 0; n < 4; ++n) acc[dir][n] = (f32x4){0.f, 0.f, 0.f, 0.f};
#pragma unroll
    for (int ks = 0; ks < 4; ++ks) {
        const bf16_t* vp = Vs + (32 * ks + 4 * fq + tq4) * V_LD + w * 16 + 4 * tp4;
        const bf16x8 af = mk8(TR16(vp), TR16(vp + 16 * V_LD));
#pragma unroll
        for (int dir = 0; dir < 2; ++dir)
#pragma unroll
            for (int n = 0; n < 4; ++n) { const bf16_t* kp = Ksc + (dir * 128 + 32 * ks + 4 * fq + tq4) * KS_LD + n * 16 + 4 * tp4;
                const bf16x8 bfv = mk8(TR16(kp), TR16(kp + 16 * KS_LD));
                acc[dir][n] = mfma16(af, bfv, acc[dir][n]); }
    }
#pragma unroll
    for (int dir = 0; dir < 2; ++dir) { float* So = p.Sst() + (size_t)st_index(sd, sl, h, dir, tb) * 8192;
#pragma unroll
        for (int n = 0; n < 4; ++n)
#pragma unroll
            for (int r = 0; r < 4; ++r) stg(So + (w * 16 + fq * 4 + r) * 64 + n * 16 + fr, (float)acc[dir][n][r]); }
    if (tid < 128) { const int dir = tid >> 6, dd = tid & 63; float sm = 0.f;
        for (int i = 0; i < 128; ++i) sm += bf2f(Ksc[(dir * 128 + i) * KS_LD + dd]);
        stg(p.Sn() + (size_t)st_index(sd, sl, h, dir, tb) * 64 + dd, sm); }
    if (tid < 2) { float* sc = p.Ssc() + (size_t)st_index(sd, sl, h, tid, tb) * 4; stg(sc, gtot[tid * 2]); stg(sc + 1, gtot[tid * 2] + gtot[tid * 2 + 1]); }
}

template <int GI> DEV void pool_group(const Params& p, const SetDesc& sd, const bf16_t* pb) {
    constexpr int W = 2 << GI;
    const int nitems = sd.nrows * 16; const int T = 1 << sd.lgseq;
    for (int item = blockIdx.x * NTHREADS + TID(); item < nitems; item += gridDim.x * NTHREADS) {
        const int row = item >> 4, ch = GI * 128 + (item & 15) * 8;
        const int tt = row & (T - 1);
        u32x4 mv[W]; int cnt = 0; bool okv[W];
#pragma unroll
        for (int q = 0; q < W; ++q) { const int t2 = tt - W / 2 + q; const bool ok = (t2 >= 0) && (t2 < T); cnt += ok ? 1 : 0; okv[q] = ok;
            mv[q] = ldg((const u32x4*)(pb + (size_t)(ok ? (row - W / 2 + q) : row) * PWA + C_PU + ch)); }
        float s[8];
#pragma unroll
        for (int j = 0; j < 8; ++j) s[j] = 0.f;
#pragma unroll
        for (int q = 0; q < W; ++q) { u32x4 m = mv[q]; if (!okv[q]) m = (u32x4){0u, 0u, 0u, 0u};
            s[0] += lo16(m.x); s[1] += hi16(m.x); s[2] += lo16(m.y); s[3] += hi16(m.y); s[4] += lo16(m.z); s[5] += hi16(m.z); s[6] += lo16(m.w); s[7] += hi16(m.w); }
        const float inv = frcp((float)cnt);
        const u32x4 m = mv[W / 2];
        const float u[8] = {lo16(m.x), hi16(m.x), lo16(m.y), hi16(m.y), lo16(m.z), hi16(m.z), lo16(m.w), hi16(m.w)};
        u32x4 o = {pack2(s[0] * inv - u[0], s[1] * inv - u[1]), pack2(s[2] * inv - u[2], s[3] * inv - u[3]), pack2(s[4] * inv - u[4], s[5] * inv - u[5]), pack2(s[6] * inv - u[6], s[7] * inv - u[7])};
        stg((u32x4*)(p.Pb() + (size_t)row * 512 + ch), o);
    }
}
DEV void phase_pool(const Params& p, const SetDesc& sd) {
    const bf16_t* pb = proj_buf(p, sd);
    pool_group<0>(p, sd, pb); pool_group<1>(p, sd, pb); pool_group<2>(p, sd, pb); pool_group<3>(p, sd, pb);
}

template <int NC> DEV void mlstm_stepB_run(const Params& p, const SetDesc& sd, int task) {
    const int tid = TID();
    const int q = task & 3, dir = (task >> 2) & 1, h = (task >> 3) & 3, sl = task >> 5;
    const int ci = ((sd.samp0 + sl) * 4 + h) * 2 + dir;
    const int eoff = q * 2048 + tid * 4;
    float zr = 0.f; HIDE(zr);
    f32x4 C = {zr, zr, zr, zr}; float nv = 0.f; float m = -1e30f;
    f32x4 Sv[NC]; float blv[NC], mlv[NC], snv[NC];
#pragma unroll
    for (int c = 0; c < NC; ++c) { const int tb = dir ? NC - 1 - c : c; const size_t si = st_index(sd, sl, h, dir, tb);
        Sv[c] = ldg((const f32x4*)(p.Sst() + si * 8192 + eoff)); blv[c] = ldg(p.Ssc() + si * 4); mlv[c] = ldg(p.Ssc() + si * 4 + 1);
        snv[c] = (q == 0 && tid < 64) ? ldg(p.Sn() + si * 64 + tid) : 0.f; }
    if (!sd.is_ctx) { C = ldg((const f32x4*)(p.CiC() + (size_t)ci * 8192 + eoff)); if (q == 0 && tid < 64) nv = ldg(p.Cin_() + (size_t)ci * 64 + tid); m = ldg(p.Cim() + (size_t)ci * 4); }
#pragma unroll
    for (int c = 0; c < NC; ++c) {
        const int tb = dir ? NC - 1 - c : c; const size_t si = st_index(sd, sl, h, dir, tb);
        u32x2 o = {pack2(C[0], C[1]), pack2(C[2], C[3])};
        stg((u32x2*)(p.Cin() + si * 8192 + eoff), o);
        if (q == 0 && tid < 64) stg(p.Cn() + si * 64 + tid, nv);
        if (q == 0 && tid == 0) stg(p.Cm() + si * 4, m);
        const float mn = fmaxf(blv[c] + m, mlv[c]);
        const float dc = __expf(blv[c] + m - mn), wsn = __expf(mlv[c] - mn);
        C = C * dc + Sv[c] * wsn;
        nv = nv * dc + snv[c] * wsn;
        m = mn;
    }
    if (sd.is_ctx) { stg((f32x4*)(p.CiC() + (size_t)ci * 8192 + eoff), C); if (q == 0 && tid < 64) stg(p.Cin_() + (size_t)ci * 64 + tid, nv); if (q == 0 && tid == 0) stg(p.Cim() + (size_t)ci * 4, m); }
}
DEV void mlstm_stepB_task(const Params& p, const SetDesc& sd, int task) {
    if (sd.is_ctx) mlstm_stepB_run<NTBC>(p, sd, task); else mlstm_stepB_run<NTBL>(p, sd, task);
}

constexpr int NA_KLD = 136, NA_VLD = 144;
DEV void na_task(const Params& p, const SetDesc& sd, int layer, int sl, int rq2  , int hp, char* shm) {
    const int tid = TID(), lane = tid & 63, w = tid >> 6, tq = lane & 15, fq = lane >> 4, tq4 = (lane & 15) >> 2, tp4 = lane & 3;
    const int hh = w >> 2, g = w & 3, head = hp * 2 + hh;
    const bool ctxq = sd.is_ctx;
    bf16_t* Ks = (bf16_t*)shm;
    bf16_t* Vs = (bf16_t*)(shm + 128 * NA_KLD * 2);
    float* rpbs = (float*)(shm + 128 * NA_KLD * 2 + 128 * NA_VLD * 2);
    const int sample = sd.samp0 + sl;
    const bf16_t* pq = proj_buf(p, sd) + ((size_t)sl << sd.lgseq) * PWA;
    const bf16_t* pc = p.PROJc() + (size_t)sample * CTX * PWA;
    const int qcol = g * 16 + tq;
    int rqv[2], rsv[2], qtok[2];
#pragma unroll
    for (int u = 0; u < 2; ++u) { rqv[u] = 2 * rq2 + u; qtok[u] = rqv[u] * 64 + qcol; int r_ = rqv[u] - 4; rsv[u] = r_ < 0 ? 0 : (r_ > ROWS - 8 ? ROWS - 8 : r_); }
    const int nloc = ctxq ? 0 : (rsv[1] + 8 - rsv[0]);
    const int nstage = nloc + CTX / 64;
    __syncthreads();
    if (!ctxq) for (int i = tid; i < 2 * 465; i += NTHREADS) rpbs[i] = ldg(p.rpb + ((size_t)layer * 8 + hp * 2 + i / 465) * 465 + i % 465);
    bf16x8 qf[2][2];
#pragma unroll
    for (int u = 0; u < 2; ++u)
#pragma unroll
        for (int ks = 0; ks < 2; ++ks) qf[u][ks] = mk8(ldg((const u32x4*)(pq + (size_t)qtok[u] * PWA + C_QN + head * 64 + ks * 32 + fq * 8)));
    float m_run[2] = {-1e30f, -1e30f}, l_run[2] = {0.f, 0.f};
    f32x4 acc[2][4];
#pragma unroll
    for (int u = 0; u < 2; ++u)
#pragma unroll
        for (int mt = 0; mt < 4; ++mt) acc[u][mt] = (f32x4){0.f, 0.f, 0.f, 0.f};
    int cs = qcol - 8; cs = cs < 0 ? 0 : (cs > 48 ? 48 : cs);
    const int kc0 = (g == 0) ? 0 : (g == 1) ? 8 : (g == 2) ? 24 : 32;
    const int npair = (nstage + 1) >> 1;
    u32x4 kreg[4], vreg[4];
#define NA_SRC_ROWS(stg) (((stg) < nloc) ? (pq + (size_t)((rsv[0] + (stg)) * 64) * PWA) : (pc + (size_t)((((stg) < nstage ? (stg) : nstage - 1) - nloc) * 64) * PWA))
#define NA_FETCH(sp_) do { _Pragma("unroll") for (int it = 0; it < 4; ++it) { const int item = tid + it * 512, key2 = item >> 4, ch = item & 15; \
        const bf16_t* kb_ = NA_SRC_ROWS(2 * (sp_) + (key2 >> 6)); const bf16_t* src = kb_ + (size_t)(key2 & 63) * PWA + hp * 128 + ch * 8; \
        kreg[it] = ldg((const u32x4*)(src + C_KN)); vreg[it] = ldg((const u32x4*)(src + C_VN)); } } while (0)
    NA_FETCH(0);
    for (int sp = 0; sp < npair; ++sp) {
        __syncthreads();
#pragma unroll
        for (int it = 0; it < 4; ++it) { const int item = tid + it * 512, key2 = item >> 4, ch = item & 15;
            *(u32x4*)(Ks + key2 * NA_KLD + ch * 8) = kreg[it]; *(u32x4*)(Vs + key2 * NA_VLD + ch * 8) = vreg[it]; }
        if (sp + 1 < npair) NA_FETCH(sp + 1);
        __syncthreads();
#pragma unroll
        for (int sub = 0; sub < 2; ++sub) {
        const int st = 2 * sp + sub;
        if (st >= nstage) continue;
        const bool local = st < nloc;
        const bf16_t* Ksb = Ks + sub * 64 * NA_KLD; const bf16_t* Vsb = Vs + sub * 64 * NA_VLD;
        if (local) {
            const int kr = rsv[0] + st;
            f32x4 sa[2][2];
#pragma unroll
            for (int kt = 0; kt < 2; ++kt) { sa[0][kt] = (f32x4){0.f, 0.f, 0.f, 0.f}; sa[1][kt] = (f32x4){0.f, 0.f, 0.f, 0.f};
#pragma unroll
                for (int ks = 0; ks < 2; ++ks) { const bf16x8 kf = *(const bf16x8*)(Ksb + (kc0 + kt * 16 + tq) * NA_KLD + hh * 64 + ks * 32 + fq * 8);
                    sa[0][kt] = mfma16(kf, qf[0][ks], sa[0][kt]); sa[1][kt] = mfma16(kf, qf[1][ks], sa[1][kt]); } }
            float alpha[2]; bf16x8 pf[2];
#pragma unroll
            for (int u = 0; u < 2; ++u) {
                const bool act = (kr >= rsv[u]) && (kr < rsv[u] + 8);
                if (!act) { alpha[u] = 1.0f; pf[u] = mk8((u32x4){0u, 0u, 0u, 0u}); continue; }
                const int dr = kr - rqv[u] + 7;
                float sc[8]; float mx = -1e30f; float bs[8];
#pragma unroll
                for (int kt = 0; kt < 2; ++kt)
#pragma unroll
                    for (int r = 0; r < 4; ++r) { const int kcol = kc0 + kt * 16 + fq * 4 + r; int dc = kcol - qcol + 15; dc = dc < 0 ? 0 : (dc > 30 ? 30 : dc);
                        bs[kt * 4 + r] = rpbs[hh * 465 + dr * 31 + dc]; }
#ifndef CPU_EMU
                asm volatile("" : "+v"(bs[0]), "+v"(bs[1]), "+v"(bs[2]), "+v"(bs[3]), "+v"(bs[4]), "+v"(bs[5]), "+v"(bs[6]), "+v"(bs[7]));
#endif
#pragma unroll
                for (int kt = 0; kt < 2; ++kt)
#pragma unroll
                    for (int r = 0; r < 4; ++r) { const int kcol = kc0 + kt * 16 + fq * 4 + r; const bool valid = (kcol >= cs) && (kcol < cs + 16);
                        const float v = valid ? (sa[u][kt][r] * 0.125f + bs[kt * 4 + r]) : -1e30f; sc[kt * 4 + r] = v; mx = fmaxf(mx, v); }
                mx = fmaxf(mx, shx<16>(mx)); mx = fmaxf(mx, shx<32>(mx));
                const float mn = fmaxf(m_run[u], mx); alpha[u] = __expf(m_run[u] - mn); m_run[u] = mn;
                float ps = 0.f; float pv[8];
#pragma unroll
                for (int j = 0; j < 8; ++j) { pv[j] = __expf(sc[j] - mn); ps += pv[j]; }
                ps += shx<16>(ps); ps += shx<32>(ps);
                l_run[u] = l_run[u] * alpha[u] + ps;
                u32x4 pk = {pack2(pv[0], pv[1]), pack2(pv[2], pv[3]), pack2(pv[4], pv[5]), pack2(pv[6], pv[7])};
                pf[u] = mk8(pk);
            }
#pragma unroll
            for (int mt = 0; mt < 4; ++mt) {
                const bf16_t* vp = Vsb + (kc0 + 4 * fq + tq4) * NA_VLD + hh * 64 + mt * 16 + 4 * tp4;
                const bf16x8 vf = mk8(TR16(vp), TR16(vp + 16 * NA_VLD));
                acc[0][mt] = mfma16(vf, pf[0], acc[0][mt] * alpha[0]); acc[1][mt] = mfma16(vf, pf[1], acc[1][mt] * alpha[1]); }
        } else {
            f32x4 sa[2][4];
#pragma unroll
            for (int kt = 0; kt < 4; ++kt) { sa[0][kt] = (f32x4){0.f, 0.f, 0.f, 0.f}; sa[1][kt] = (f32x4){0.f, 0.f, 0.f, 0.f};
#pragma unroll
                for (int ks = 0; ks < 2; ++ks) { const bf16x8 kf = *(const bf16x8*)(Ksb + (kt * 16 + tq) * NA_KLD + hh * 64 + ks * 32 + fq * 8);
                    sa[0][kt] = mfma16(kf, qf[0][ks], sa[0][kt]); sa[1][kt] = mfma16(kf, qf[1][ks], sa[1][kt]); } }
            float alpha[2]; bf16x8 pf[2][2];
#pragma unroll
            for (int u = 0; u < 2; ++u) {
                float mx = -1e30f;
#pragma unroll
                for (int kt = 0; kt < 4; ++kt)
#pragma unroll
                    for (int r = 0; r < 4; ++r) { sa[u][kt][r] *= 0.125f; mx = fmaxf(mx, sa[u][kt][r]); }
                mx = fmaxf(mx, shx<16>(mx)); mx = fmaxf(mx, shx<32>(mx));
                const float mn = fmaxf(m_run[u], mx); alpha[u] = __expf(m_run[u] - mn); m_run[u] = mn;
                float ps = 0.f;
#pragma unroll
                for (int kt = 0; kt < 4; ++kt)
#pragma unroll
                    for (int r = 0; r < 4; ++r) { sa[u][kt][r] = __expf(sa[u][kt][r] - mn); ps += sa[u][kt][r]; }
                ps += shx<16>(ps); ps += shx<32>(ps);
                l_run[u] = l_run[u] * alpha[u] + ps;
#pragma unroll
                for (int h2 = 0; h2 < 2; ++h2) {
                    u32x4 pk = {pack2(sa[u][2 * h2][0], sa[u][2 * h2][1]), pack2(sa[u][2 * h2][2], sa[u][2 * h2][3]), pack2(sa[u][2 * h2 + 1][0], sa[u][2 * h2 + 1][1]), pack2(sa[u][2 * h2 + 1][2], sa[u][2 * h2 + 1][3])};
                    pf[u][h2] = mk8(pk); }
            }
#pragma unroll
            for (int mt = 0; mt < 4; ++mt) { acc[0][mt] = acc[0][mt] * alpha[0]; acc[1][mt] = acc[1][mt] * alpha[1]; }
#pragma unroll
            for (int h2 = 0; h2 < 2; ++h2)
#pragma unroll
                for (int mt = 0; mt < 4; ++mt) { const bf16_t* vp = Vsb + (32 * h2 + 4 * fq + tq4) * NA_VLD + hh * 64 + mt * 16 + 4 * tp4;
                    const bf16x8 vf = mk8(TR16(vp), TR16(vp + 16 * NA_VLD));
                    acc[0][mt] = mfma16(vf, pf[0][h2], acc[0][mt]); acc[1][mt] = mfma16(vf, pf[1][h2], acc[1][mt]); }
        }
        }
    }
#undef NA_FETCH
#undef NA_SRC_ROWS
#pragma unroll
    for (int u = 0; u < 2; ++u) {
        const float il = frcp(l_run[u]);
        const size_t orow = ((size_t)sl << sd.lgseq) + qtok[u];
#pragma unroll
        for (int mt = 0; mt < 4; ++mt) { u32x2 o = {pack2(acc[u][mt][0] * il, acc[u][mt][1] * il), pack2(acc[u][mt][2] * il, acc[u][mt][3] * il)};
            stg((u32x2*)(p.Nb() + orow * 512 + head * 64 + mt * 16 + fq * 4), o); }
    }
}

DEV void mlstm_stepC_task(const Params& p, const SetDesc& sd, int layer, int task, char* shm) {
    const int tid = TID(), lane = tid & 63, w = tid >> 6, tq = lane & 15, fq = lane >> 4, tq4 = (lane & 15) >> 2, tp4 = lane & 3;
    const int tb = task % sd.ntb, h = (task / sd.ntb) & 3, sl = task / (sd.ntb * 4);
    const int row0 = (sl << sd.lgseq) + tb * 128; const bool latent = !sd.is_ctx; const int tl0 = tb * 128;
    bf16_t* Ks = (bf16_t*)shm;
    bf16_t* Vs = (bf16_t*)(shm + 128 * K_LD * 2);
    bf16_t* Cs = (bf16_t*)(shm + 128 * K_LD * 2 + 128 * V_LD * 2);
    float* ga = (float*)(shm + 128 * K_LD * 2 * 3 + 128 * V_LD * 2); float* gb = ga + 256; float* gpm = gb + 256; float* gtot = gpm + 256; float* tmp = gtot + 8;
    float* nvs = tmp + 16;
    float* cms = nvs + 128;
    const bf16_t* prow = proj_buf(p, sd) + (size_t)row0 * PWA;
    __syncthreads();
    gate_scan(prow, h, p.gate_bias + (size_t)layer * 16, ga, gb, gpm, gtot, tmp);
    {
        const int s = tid & 127, cpi = tid >> 7, cp = (cpi & 1) + (cpi >> 1) * 4;
        const bf16_t* hp = prow + (size_t)s * PWA + C_KM + h * 64;
        float k1[8], k2[8];
        load_rope_chunk(hp, cp, latent, tl0 + s, p.rope(), 1.0f, k1);
        load_rope_chunk(hp, cp + 2, latent, tl0 + s, p.rope(), 1.0f, k2);
        u32x4 o1 = {pack2(k1[0], k1[1]), pack2(k1[2], k1[3]), pack2(k1[4], k1[5]), pack2(k1[6], k1[7])};
        u32x4 o2 = {pack2(k2[0], k2[1]), pack2(k2[2], k2[3]), pack2(k2[4], k2[5]), pack2(k2[6], k2[7])};
        *(u32x4*)(Ks + s * K_LD + cp * 8) = o1; *(u32x4*)(Ks + s * K_LD + (cp + 2) * 8) = o2;
    }
#pragma unroll
    for (int it = 0; it < 4; ++it) { const int item = tid + it * 512, s = item >> 4, ch = item & 15;
        *(u32x4*)(Vs + s * V_LD + ch * 8) = ldg((const u32x4*)(prow + (size_t)s * PWA + C_VM + h * 128 + ch * 8)); }
#pragma unroll
    for (int it = 0; it < 4; ++it) { const int item = tid + it * 512, dir = item >> 10, rem = item & 1023, v = rem >> 3, ch = rem & 7;
        *(u32x4*)(Cs + (dir * 128 + v) * K_LD + ch * 8) = ldg((const u32x4*)(p.Cin() + (size_t)st_index(sd, sl, h, dir, tb) * 8192 + v * 64 + ch * 8)); }
    if (tid < 128) nvs[tid] = ldg(p.Cn() + (size_t)st_index(sd, sl, h, tid >> 6, tb) * 64 + (tid & 63));
    if (tid < 2) cms[tid] = ldg(p.Cm() + (size_t)st_index(sd, sl, h, tid, tb) * 4);
    bf16x8 qf[2]; float qv[2][8];
    {
        const int t = w * 16 + tq; const bf16_t* hp = prow + (size_t)t * PWA + C_QM + h * 64;
#pragma unroll
        for (int ks = 0; ks < 2; ++ks) { load_rope_chunk(hp, ks * 4 + fq, latent, tl0 + t, p.rope(), 0.125f, qv[ks]);
            u32x4 o = {pack2(qv[ks][0], qv[ks][1]), pack2(qv[ks][2], qv[ks][3]), pack2(qv[ks][4], qv[ks][5]), pack2(qv[ks][6], qv[ks][7])}; qf[ks] = mk8(o); }
    }
    __syncthreads();
    const int t = w * 16 + tq;
    f32x4 hsum[8];
#pragma unroll
    for (int mt = 0; mt < 8; ++mt) hsum[mt] = (f32x4){0.f, 0.f, 0.f, 0.f};
#pragma unroll
    for (int dir = 0; dir < 2; ++dir) {
        const float m_in = cms[dir];
        const float Mt = fmaxf(m_in, gpm[dir * 128 + t]);
        const float inter = __expf(m_in - Mt);
        const float mtot = gb[dir * 128 + t] + Mt;
        f32x4 acc[8];
#pragma unroll
        for (int mt = 0; mt < 8; ++mt) { acc[mt] = (f32x4){0.f, 0.f, 0.f, 0.f};
#pragma unroll
            for (int ks = 0; ks < 2; ++ks) { const bf16x8 cf = *(const bf16x8*)(Cs + (dir * 128 + mt * 16 + tq) * K_LD + ks * 32 + fq * 8);
                acc[mt] = mfma16(cf, qf[ks], acc[mt]); }
            acc[mt] = acc[mt] * inter; }
        float qn = 0.f;
#pragma unroll
        for (int ks = 0; ks < 2; ++ks)
#pragma unroll
            for (int j = 0; j < 8; ++j) qn += bf2f(f2bf(qv[ks][j])) * nvs[dir * 64 + ks * 32 + fq * 8 + j];
        qn += shx<16>(qn); qn += shx<32>(qn);
        float den = inter * qn;
        const int u_lo = dir == 0 ? 0 : (w >> 1), u_hi = dir == 0 ? (w >> 1) : 3;
        float rsum = 0.f;
        for (int u = u_lo; u <= u_hi; ++u) {
            unsigned pk[4];
#pragma unroll
            for (int kt = 0; kt < 2; ++kt) { f32x4 sa = {0.f, 0.f, 0.f, 0.f}; const int sb = 32 * u + 16 * kt;
#pragma unroll
                for (int ks = 0; ks < 2; ++ks) { const bf16x8 kf = *(const bf16x8*)(Ks + (sb + tq) * K_LD + ks * 32 + fq * 8); sa = mfma16(kf, qf[ks], sa); }
                float pv[4]; float gv4[4];
#pragma unroll
                for (int r = 0; r < 4; ++r) gv4[r] = ga[dir * 128 + sb + fq * 4 + r];
#ifndef CPU_EMU
                asm volatile("" : "+v"(gv4[0]), "+v"(gv4[1]), "+v"(gv4[2]), "+v"(gv4[3]));
#endif
#pragma unroll
                for (int r = 0; r < 4; ++r) { const int s = sb + fq * 4 + r; const bool valid = dir == 0 ? (s <= t) : (s >= t);
                    pv[r] = valid ? sa[r] * __expf(gv4[r] - Mt) : 0.f; pv[r] = bf2f(f2bf(pv[r])); rsum += pv[r]; }
                pk[kt * 2] = pack2(pv[0], pv[1]); pk[kt * 2 + 1] = pack2(pv[2], pv[3]); }
            u32x4 pkv = {pk[0], pk[1], pk[2], pk[3]}; const bf16x8 pf = mk8(pkv);
#pragma unroll
            for (int mt = 0; mt < 8; ++mt) { const bf16_t* vp = Vs + (32 * u + 4 * fq + tq4) * V_LD + mt * 16 + 4 * tp4;
                const bf16x8 vf = mk8(TR16(vp), TR16(vp + 16 * V_LD));
                acc[mt] = mfma16(vf, pf, acc[mt]); }
        }
        rsum += shx<16>(rsum); rsum += shx<32>(rsum);
        den += rsum;
        const float dn = frcp(fmaxf(fabsf(den), __expf(-mtot)));
#pragma unroll
        for (int mt = 0; mt < 8; ++mt) hsum[mt] = hsum[mt] + acc[mt] * dn;
    }
    float ss = 0.f;
#pragma unroll
    for (int mt = 0; mt < 8; ++mt)
#pragma unroll
        for (int r = 0; r < 4; ++r) ss += hsum[mt][r] * hsum[mt][r];
    ss += shx<16>(ss); ss += shx<32>(ss);
    const float rstd = rsqrtf(ss * (1.0f / 128.0f) + RMS_EPS);
#pragma unroll
    for (int mt = 0; mt < 8; ++mt) { const int v = mt * 16 + fq * 4;
        const u32x2 om = ldg((const u32x2*)(prow + (size_t)t * PWA + C_OM + h * 128 + v));
        u32x2 o = {pack2(hsum[mt][0] * rstd * sigmoidf_(lo16(om.x)), hsum[mt][1] * rstd * sigmoidf_(hi16(om.x))),
                   pack2(hsum[mt][2] * rstd * sigmoidf_(lo16(om.y)), hsum[mt][3] * rstd * sigmoidf_(hi16(om.y)))};
        stg((u32x2*)(p.Mb() + (size_t)(row0 + t) * 512 + h * 128 + v), o); }
}

struct SchedMerge {
    const bf16_t* Mb; const bf16_t* Pb; const bf16_t* Nb; const bf16_t* Wb; int nM;
    DEV bool next(int i, GUnit& u) const { u.aux = i % 3; return tile_order(i / 3, nM, 4, u.pm, u.pn); }
    DEV const bf16_t* a_base(const GUnit& u) const { return (u.aux == 0 ? Mb : (u.aux == 1 ? Pb : Nb)) + (size_t)u.pm * 256 * 512; }
    DEV const bf16_t* b_base(const GUnit& u) const { return Wb + ((size_t)u.aux * 1024 + u.pn * 256) * 512; }
    DEV const int* ridx(const GUnit&) const { return nullptr; }
};
DEV void phase_merge(const Params& p, const SetDesc& sd, int layer, char* shm) {
    SchedMerge S; S.Mb = p.Mb(); S.Pb = p.Pb(); S.Nb = p.Nb(); S.Wb = p.WbT() + (size_t)layer * 3 * 1024 * 512; S.nM = sd.nrows / 256;
    const bf16_t* bgb = p.BG(); bf16_t* mgb = p.MERGED();
    gemm_stream<false, 512, 512, 512>(shm, S, [=](const GUnit& u, const f32x4 (&acc)[2][2][4][2], int r0, int c0) {
#pragma unroll
        for (int ai = 0; ai < 2; ++ai) {
            u32x4 gm[4][2], pr[4][2];
#pragma unroll
            for (int m = 0; m < 4; ++m)
#pragma unroll
                for (int hf = 0; hf < 2; ++hf) { const size_t r = (size_t)u.pm * 256 + r0 + ai * 128 + m * 16;
                    gm[m][hf] = ldg((const u32x4*)(bgb + r * NBG + u.aux * 1024 + u.pn * 256 + c0 + hf * 128));
                    if (u.aux > 0) pr[m][hf] = ldg((const u32x4*)(mgb + r * 1024 + u.pn * 256 + c0 + hf * 128)); else pr[m][hf] = (u32x4){0u, 0u, 0u, 0u}; }
#pragma unroll
            for (int m = 0; m < 4; ++m)
#pragma unroll
                for (int hf = 0; hf < 2; ++hf) { const size_t r = (size_t)u.pm * 256 + r0 + ai * 128 + m * 16;
                    const f32x4 x0 = acc[ai][hf][m][0], x1 = acc[ai][hf][m][1]; const u32x4 g = gm[m][hf], q = pr[m][hf];
                    u32x4 ov = {pack2(x0[0] * lo16(g.x) + lo16(q.x), x0[1] * hi16(g.x) + hi16(q.x)), pack2(x0[2] * lo16(g.y) + lo16(q.y), x0[3] * hi16(g.y) + hi16(q.y)),
                                pack2(x1[0] * lo16(g.z) + lo16(q.z), x1[1] * hi16(g.z) + hi16(q.z)), pack2(x1[2] * lo16(g.w) + lo16(q.w), x1[3] * hi16(g.w) + hi16(q.w))};
                    stg((u32x4*)(mgb + r * 1024 + u.pn * 256 + c0 + hf * 128), ov); }
        } });
}
DEV void phase_outproj(const Params& p, const SetDesc& sd, int layer, char* shm) {
    SchedPlain S; S.A = p.MERGED(); S.Bt = p.WoT() + (size_t)layer * 1024 * 1024; S.nM = sd.nrows / 256; S.nN = 4; S.lda256 = 256 * 1024; S.ldb256 = 256 * 1024;
    bf16_t* yb = p.Y();
    gemm_stream<false, 1024, 1024, 1024>(shm, S, [=](const GUnit& u, const f32x4 (&acc)[2][2][4][2], int r0, int c0) {
#pragma unroll
        for (int ai = 0; ai < 2; ++ai)
#pragma unroll
            for (int m = 0; m < 4; ++m) { bf16_t* o = yb + ((size_t)u.pm * 256 + r0 + ai * 128 + m * 16) * 1024 + u.pn * 256 + c0;
                store8bf(o, acc[ai][0][m][0], acc[ai][0][m][1]); store8bf(o + 128, acc[ai][1][m][0], acc[ai][1][m][1]); } });
}

DEV void phase_postmix(const Params& p, const SetDesc& sd, int layer, char* shm) {
    const int tid = TID(), lane = tid & 63, wv = tid >> 6;
    float* wr_s = (float*)shm;
    __syncthreads();
    for (int i = tid; i < 1024 * 16; i += NTHREADS) { const int c = i >> 4, e = i & 15, ln = (c & 511) >> 3, j = c & 7, hf = c >> 9;
        wr_s[((((hf * 8 + j) * 4 + (e >> 2)) * 64 + ln) << 2) + (e & 3)] = ldg(p.router_w + (size_t)layer * 1024 * 16 + i); }
    __syncthreads();
    const float* g1 = p.norm_gain + ((size_t)layer * 4 + 1) * 1024; const float* g2 = p.norm_gain + ((size_t)layer * 4 + 2) * 1024;
    float* par = (float*)(shm + 65536);
    { const int rpb0_ = (sd.nrows + (int)gridDim.x - 1) / (int)gridDim.x; const float* mdb = mod_row(p, sd, layer, min((int)blockIdx.x * rpb0_, sd.nrows - 1));
      stage_params(par, g1, g2, mdb + 2048, mdb + 3072, mdb + 4096); }
    __syncthreads();
    const float* xb = xsrc_base(p, sd, layer); float* xdb = xdst_base(p, sd);
    const int stride = 8; const int rpb_ = (sd.nrows + (int)gridDim.x - 1) / (int)gridDim.x; const int row_end = min(sd.nrows, ((int)blockIdx.x + 1) * rpb_);
    int row = (int)blockIdx.x * rpb_ + wv;
    u32x4 ycur[2], ynxt[2]; f32x4 xcur[4], xnxt[4];
    if (row < row_end) {
#pragma unroll
        for (int i = 0; i < 2; ++i) ycur[i] = ldg((const u32x4*)(p.Y() + (size_t)row * 1024 + i * 512 + lane * 8));
#pragma unroll
        for (int i = 0; i < 4; ++i) xcur[i] = ldg((const f32x4*)(xb + (size_t)row * 1024 + (i >> 1) * 512 + lane * 8 + (i & 1) * 4)); }
    for (; row < row_end; row += stride) {
        int ln = lane; HIDE(ln);
        const int rn = row + stride;
        if (rn < row_end) {
#pragma unroll
            for (int i = 0; i < 2; ++i) ynxt[i] = ldg((const u32x4*)(p.Y() + (size_t)rn * 1024 + i * 512 + ln * 8));
#pragma unroll
            for (int i = 0; i < 4; ++i) xnxt[i] = ldg((const f32x4*)(xb + (size_t)rn * 1024 + (i >> 1) * 512 + ln * 8 + (i & 1) * 4)); }
        float* xd = xdb + (size_t)row * 1024;
        const float* md = mod_row(p, sd, layer, row);
        float y[16]; float ss = 0.f;
#pragma unroll
        for (int hlf = 0; hlf < 2; ++hlf) { const u32x4 m = ycur[hlf];
            const float t8[8] = {lo16(m.x), hi16(m.x), lo16(m.y), hi16(m.y), lo16(m.z), hi16(m.z), lo16(m.w), hi16(m.w)};
#pragma unroll
            for (int j = 0; j < 8; ++j) { y[hlf * 8 + j] = t8[j]; ss += t8[j] * t8[j]; } }
        ss = wave_sum(ss);
        const float rstd = rsqrtf(ss * (1.0f / 1024.0f) + RMS_EPS);
        float xn[16]; float ss2 = 0.f;
#pragma unroll
        for (int hlf = 0; hlf < 2; ++hlf)
#pragma unroll
            for (int q = 0; q < 2; ++q) { const int c0 = hlf * 512 + ln * 8 + q * 4; const f32x4 xo = xcur[hlf * 2 + q]; f32x4 xw;
#pragma unroll
                for (int j = 0; j < 4; ++j) { const float v = xo[j] + par[2048 + c0 + j] * (y[hlf * 8 + q * 4 + j] * rstd * par[c0 + j]); xw[j] = v; xn[hlf * 8 + q * 4 + j] = v; ss2 += v * v; }
                stg((f32x4*)(xd + c0), xw); }
        ss2 = wave_sum(ss2);
        const float rstd2 = rsqrtf(ss2 * (1.0f / 1024.0f) + RMS_EPS);
        float lg[16];
#pragma unroll
        for (int e = 0; e < 16; ++e) lg[e] = 0.f;
#pragma unroll
        for (int hlf = 0; hlf < 2; ++hlf) { const int c0 = hlf * 512 + ln * 8; float o[8];
#pragma unroll
            for (int j = 0; j < 8; ++j) { o[j] = xn[hlf * 8 + j] * rstd2 * par[1024 + c0 + j] * (1.0f + par[4096 + c0 + j]) + par[3072 + c0 + j];
#pragma unroll
                for (int eq = 0; eq < 4; ++eq) { const f32x4 w4 = *(const f32x4*)(wr_s + ((((hlf * 8 + j) * 4 + eq) * 64 + ln) << 2));
#pragma unroll
                    for (int e = 0; e < 4; ++e) lg[eq * 4 + e] += o[j] * w4[e]; } }
            u32x4 ov = {pack2(o[0], o[1]), pack2(o[2], o[3]), pack2(o[4], o[5]), pack2(o[6], o[7])};
            stg((u32x4*)(p.H() + (size_t)row * 1024 + c0), ov); }
        float r8[8], r4[4], r2[2], r1;
        { const bool b = (lane & 32) != 0;
#pragma unroll
          for (int i = 0; i < 8; ++i) { const float keep = b ? lg[i + 8] : lg[i], send = b ? lg[i] : lg[i + 8]; r8[i] = keep + shx<32>(send); } }
        { const bool b = (lane & 16) != 0;
#pragma unroll
          for (int i = 0; i < 4; ++i) { const float keep = b ? r8[i + 4] : r8[i], send = b ? r8[i] : r8[i + 4]; r4[i] = keep + shx<16>(send); } }
        { const bool b = (lane & 8) != 0;
#pragma unroll
          for (int i = 0; i < 2; ++i) { const float keep = b ? r4[i + 2] : r4[i], send = b ? r4[i] : r4[i + 2]; r2[i] = keep + shx<8>(send); } }
        { const bool b = (lane & 4) != 0; const float keep = b ? r2[1] : r2[0], send = b ? r2[0] : r2[1]; r1 = keep + shx<4>(send); }
        r1 += shx<2>(r1); r1 += shx<1>(r1);
        float mx = r1;
        mx = fmaxf(mx, shx<4>(mx)); mx = fmaxf(mx, shx<8>(mx)); mx = fmaxf(mx, shx<16>(mx)); mx = fmaxf(mx, shx<32>(mx));
        const float ex = __expf(r1 - mx);
        float se = ex;
        se += shx<4>(se); se += shx<8>(se); se += shx<16>(se); se += shx<32>(se);
        if ((lane & 3) == 0) { const int e = ((lane >> 5) & 1) * 8 + ((lane >> 4) & 1) * 4 + ((lane >> 3) & 1) * 2 + ((lane >> 2) & 1);
            stg(p.aff() + (size_t)row * 16 + e, ex * frcp(se)); }
#pragma unroll
        for (int i = 0; i < 2; ++i) ycur[i] = ynxt[i];
#pragma unroll
        for (int i = 0; i < 4; ++i) xcur[i] = xnxt[i];
    }
}

DEV unsigned shxu(unsigned v, int m) {
    const float f = __uint_as_float(v); float r;
    switch (m) { case 1: r = shx<1>(f); break; case 2: r = shx<2>(f); break; case 4: r = shx<4>(f); break; case 8: r = shx<8>(f); break; case 16: r = shx<16>(f); break; default: r = shx<32>(f); break; }
    return __float_as_uint(r);
}
#define TK_CX(a_, b_, desc_) do { const unsigned long long x_ = key[a_], y_ = key[b_]; const bool sw_ = (desc_) ? (x_ < y_) : (x_ > y_); key[a_] = sw_ ? y_ : x_; key[b_] = sw_ ? x_ : y_; } while (0)
DEV void topk_task(const Params& p, const SetDesc& sd, int task, char* shm) {
    const int tid = TID();
    const int e = task & 15, sl = task >> 4;
    unsigned long long* buf = (unsigned long long*)shm;
    const int T = 1 << sd.lgseq, cap = sd.cap;
    const int rbase = sl << sd.lgseq;
    const bool active = tid * 4 < T;
    unsigned long long key[4];
    __syncthreads();
#pragma unroll
    for (int m = 0; m < 4; ++m) { const int i = tid * 4 + m; const float a = active ? ldg(p.aff() + (size_t)(rbase + i) * 16 + e) : 0.f;
        key[m] = ((unsigned long long)__float_as_uint(a) << 32) | (unsigned)(0xFFFFFFFFu - (unsigned)i); }
    for (int k = 2; k <= T; k <<= 1) {
        const bool desc4 = ((tid * 4) & k) == 0;
        for (int j = k >> 1; j >= 4; j >>= 1) {
            const int tj = j >> 2;
            unsigned long long pk[4];
            if (tj < 64) {
#pragma unroll
                for (int m = 0; m < 4; ++m) { const unsigned lo = shxu((unsigned)key[m], tj), hi = shxu((unsigned)(key[m] >> 32), tj); pk[m] = ((unsigned long long)hi << 32) | lo; }
            } else {
                __syncthreads();
                if (active) {
#pragma unroll
                    for (int m = 0; m < 4; ++m) buf[tid * 4 + m] = key[m]; }
                __syncthreads();
#pragma unroll
                for (int m = 0; m < 4; ++m) pk[m] = active ? buf[(tid ^ tj) * 4 + m] : 0ull;
            }
            const bool lower = (tid & tj) == 0; const bool takemax = desc4 == lower;
#pragma unroll
            for (int m = 0; m < 4; ++m) { const unsigned long long x = key[m], y = pk[m]; key[m] = takemax ? (x > y ? x : y) : (x < y ? x : y); }
        }
        if (k >= 4) { TK_CX(0, 2, desc4); TK_CX(1, 3, desc4); TK_CX(0, 1, desc4); TK_CX(2, 3, desc4); }
        else { TK_CX(0, 1, true); TK_CX(2, 3, false); }
    }
    const int sbase = e * sd.rpe + sl * cap;
    if (active) {
#pragma unroll
        for (int m = 0; m < 4; ++m) { const int i = tid * 4 + m; const unsigned long long kv = key[m]; const int tok = (int)(0xFFFFFFFFu - (unsigned)(kv & 0xFFFFFFFFu));
            const int row = rbase + tok;
            if (i < cap) { stg(p.slot_token() + sbase + i, row); stg(p.slot_gate() + sbase + i, __uint_as_float((unsigned)(kv >> 32))); stg(p.token_slots() + (size_t)row * 16 + e, sbase + i); }
            else stg(p.token_slots() + (size_t)row * 16 + e, -1); } }
    if (sl == 0) { const int used = sd.nsamp * cap;
        for (int i = used + tid; i < sd.rpe; i += NTHREADS) { stg(p.slot_token() + e * sd.rpe + i, 0); stg(p.slot_gate() + e * sd.rpe + i, 0.f); } }
}
#undef TK_CX

struct SchedMoe {
    const bf16_t* A; const int* st; const bf16_t* W; int nRT, rpe, nN, wstride;
    DEV bool next(int i, GUnit& u) const { int pmx, pn; if (!tile_order(i, 16 * nRT, nN, pmx, pn)) return false; u.pm = pmx % nRT; u.aux = pmx / nRT; u.pn = pn; return true; }
    DEV int slot0(const GUnit& u) const { return u.aux * rpe + u.pm * 256; }
    DEV const bf16_t* a_base(const GUnit& u) const { return st ? A : A + (size_t)slot0(u) * 1024; }
    DEV const int* ridx(const GUnit& u) const { return st + slot0(u); }
    DEV const bf16_t* b_base(const GUnit& u) const { return W + (size_t)u.aux * wstride + (size_t)u.pn * 256 * 1024; }
};
DEV void phase_moe_gu(const Params& p, const SetDesc& sd, int layer, char* shm) {
    SchedMoe S; S.A = p.H(); S.st = p.slot_token(); S.W = p.WguT() + (size_t)layer * 16 * 2048 * 1024; S.nRT = sd.rpe / 256; S.rpe = sd.rpe; S.nN = 8; S.wstride = 2048 * 1024;
    bf16_t* hb = p.HID();
    gemm_stream<true, 1024, 1024, 1024>(shm, S, [=](const GUnit& u, const f32x4 (&acc)[2][2][4][2], int r0, int c0) {
#pragma unroll
        for (int ai = 0; ai < 2; ++ai)
#pragma unroll
            for (int m = 0; m < 4; ++m) { f32x4 h0, h1; const f32x4 a0 = acc[ai][0][m][0], a1 = acc[ai][0][m][1], b0 = acc[ai][1][m][0], b1 = acc[ai][1][m][1];
#pragma unroll
                for (int j = 0; j < 4; ++j) { h0[j] = a0[j] * sigmoidf_(a0[j]) * b0[j]; h1[j] = a1[j] * sigmoidf_(a1[j]) * b1[j]; }
                store8bf(hb + ((size_t)S.slot0(u) + r0 + ai * 128 + m * 16) * 1024 + u.pn * 128 + c0, h0, h1); } });
}
DEV void phase_moe_down(const Params& p, const SetDesc& sd, int layer, char* shm) {
    SchedMoe S; S.A = p.HID(); S.st = nullptr; S.W = p.WdT() + (size_t)layer * 16 * 1024 * 1024; S.nRT = sd.rpe / 256; S.rpe = sd.rpe; S.nN = 4; S.wstride = 1024 * 1024;
    bf16_t* yb = p.YE(); const float* gt = p.slot_gate();
    gemm_stream<false, 1024, 1024, 1024>(shm, S, [=](const GUnit& u, const f32x4 (&acc)[2][2][4][2], int r0, int c0) {
        float gv[2][4];
#pragma unroll
        for (int ai = 0; ai < 2; ++ai)
#pragma unroll
            for (int m = 0; m < 4; ++m) gv[ai][m] = ldg(gt + (size_t)S.slot0(u) + r0 + ai * 128 + m * 16);
#pragma unroll
        for (int ai = 0; ai < 2; ++ai)
#pragma unroll
            for (int m = 0; m < 4; ++m) { const size_t sl = (size_t)S.slot0(u) + r0 + ai * 128 + m * 16; const float g = gv[ai][m];
                bf16_t* o = yb + sl * 1024 + u.pn * 256 + c0; store8bf(o, acc[ai][0][m][0] * g, acc[ai][0][m][1] * g); store8bf(o + 128, acc[ai][1][m][0] * g, acc[ai][1][m][1] * g); } });
}

DEV void compact4(const int (&sl)[16], int (&c)[4], int& n) {
    n = 0; c[0] = -1; c[1] = -1; c[2] = -1; c[3] = -1;
#pragma unroll
    for (int e = 0; e < 16; ++e) if (sl[e] >= 0) { c[0] = (n == 0) ? sl[e] : c[0]; c[1] = (n == 1) ? sl[e] : c[1]; c[2] = (n == 2) ? sl[e] : c[2]; c[3] = (n == 3) ? sl[e] : c[3]; ++n; }
}
DEV void phase_combine(const Params& p, const SetDesc& sd, int layer, char* shm) {
    const int tid = TID(), lane = tid & 63, wv = tid >> 6;
    const float* g3 = p.norm_gain + ((size_t)layer * 4 + 3) * 1024;
    float* xdb = xdst_base(p, sd);
    const int stride = 8; const int rpb_ = (sd.nrows + (int)gridDim.x - 1) / (int)gridDim.x; const int row_end = min(sd.nrows, ((int)blockIdx.x + 1) * rpb_);
    int row = __builtin_amdgcn_readfirstlane((int)blockIdx.x * rpb_ + wv);
    float* par = (float*)shm;
    __syncthreads();
    { const float* mdb = mod_row(p, sd, layer, min((int)blockIdx.x * rpb_, sd.nrows - 1)); stage_params(par, g3, mdb + 5120, nullptr, nullptr, nullptr); }
    __syncthreads();
    int raw[16]; int cc[4], cn[4]; int nc = 0, nn = 0;
    u32x4 mc[4][2], mn[4][2]; f32x4 xc[4], xn[4];
#define CMB_SLOTS(r_) do { _Pragma("unroll") for (int e = 0; e < 16; ++e) raw[e] = ldg(p.token_slots() + (size_t)(r_) * 16 + e); } while (0)
#define CMB_DATA(r_, c_, n_, m_, x_) do { _Pragma("unroll") for (int k = 0; k < 4; ++k) { \
            if (k < (n_)) { const bf16_t* yr = p.YE() + (size_t)(c_)[k] * 1024 + lane * 8; (m_)[k][0] = ldg((const u32x4*)yr); (m_)[k][1] = ldg((const u32x4*)(yr + 512)); } \
            else { (m_)[k][0] = (u32x4){0u, 0u, 0u, 0u}; (m_)[k][1] = (u32x4){0u, 0u, 0u, 0u}; } } \
        _Pragma("unroll") for (int i = 0; i < 4; ++i) (x_)[i] = ldg((const f32x4*)(xdb + (size_t)(r_) * 1024 + (i >> 1) * 512 + lane * 8 + (i & 1) * 4)); } while (0)
    if (row < row_end) { CMB_SLOTS(row); compact4(raw, cc, nc); CMB_DATA(row, cc, nc, mc, xc); if (row + stride < row_end) CMB_SLOTS(row + stride); }
    for (; row < row_end; row += stride) {
        const int rn = row + stride;
        if (rn < row_end) { compact4(raw, cn, nn); CMB_DATA(rn, cn, nn, mn, xn); if (rn + stride < row_end) CMB_SLOTS(rn + stride); }
        float* xd = xdb + (size_t)row * 1024;
        float y[16];
#pragma unroll
        for (int j = 0; j < 16; ++j) y[j] = 0.f;
        if (nc <= 4) {
#pragma unroll
            for (int k = 0; k < 4; ++k)
                if (k < nc) {
#pragma unroll
                    for (int hlf = 0; hlf < 2; ++hlf) { const u32x4 m = mc[k][hlf];
                        y[hlf * 8 + 0] += lo16(m.x); y[hlf * 8 + 1] += hi16(m.x); y[hlf * 8 + 2] += lo16(m.y); y[hlf * 8 + 3] += hi16(m.y);
                        y[hlf * 8 + 4] += lo16(m.z); y[hlf * 8 + 5] += hi16(m.z); y[hlf * 8 + 6] += lo16(m.w); y[hlf * 8 + 7] += hi16(m.w); } }
        } else {
            for (int e = 0; e < 16; ++e) { const int sl_ = ldg(p.token_slots() + (size_t)row * 16 + e);
                if (sl_ >= 0) { const bf16_t* yr = p.YE() + (size_t)sl_ * 1024 + lane * 8;
#pragma unroll
                    for (int hlf = 0; hlf < 2; ++hlf) { const u32x4 m = ldg((const u32x4*)(yr + hlf * 512));
                        y[hlf * 8 + 0] += lo16(m.x); y[hlf * 8 + 1] += hi16(m.x); y[hlf * 8 + 2] += lo16(m.y); y[hlf * 8 + 3] += hi16(m.y);
                        y[hlf * 8 + 4] += lo16(m.z); y[hlf * 8 + 5] += hi16(m.z); y[hlf * 8 + 6] += lo16(m.w); y[hlf * 8 + 7] += hi16(m.w); } } }
        }
        float ss = 0.f;
#pragma unroll
        for (int j = 0; j < 16; ++j) ss += y[j] * y[j];
        ss = wave_sum(ss);
        const float rstd = rsqrtf(ss * (1.0f / 1024.0f) + RMS_EPS);
#pragma unroll
        for (int hlf = 0; hlf < 2; ++hlf)
#pragma unroll
            for (int q = 0; q < 2; ++q) { const int c0 = hlf * 512 + lane * 8 + q * 4; f32x4 xv = xc[hlf * 2 + q];
#pragma unroll
                for (int j = 0; j < 4; ++j) xv[j] += par[1024 + c0 + j] * (y[hlf * 8 + q * 4 + j] * rstd * par[c0 + j]);
                stg((f32x4*)(xd + c0), xv); }
        nc = nn;
#pragma unroll
        for (int k = 0; k < 4; ++k) { cc[k] = cn[k]; mc[k][0] = mn[k][0]; mc[k][1] = mn[k][1]; }
#pragma unroll
        for (int i = 0; i < 4; ++i) xc[i] = xn[i];
    }
#undef CMB_SLOTS
#undef CMB_DATA
}

constexpr int WQ_WORD0 = 4096;
template <class F> DEV void wq_run(const Params& p, int qidx, int ntasks, char* shm, F&& task) {
    unsigned* ctr = p.bar() + WQ_WORD0 + 64 * qidx;
    volatile int* slot = (volatile int*)(shm + 131072 + 64);
    const int tid = TID();
    int cur = blockIdx.x;
    while (cur < ntasks) {
        unsigned pend = 0u;
        if (tid == 0) pend = atomicAdd(ctr, 1u);
        task(cur);
        __syncthreads();
        if (tid == 0) *slot = (int)gridDim.x + (int)pend;
        __syncthreads();
        cur = *slot;
    }
}

template <int PH> DEV void do_phase(const Params& p, int layer, int is_ctx, int grp, char* shm) {
    const SetDesc sd = make_set(is_ctx, grp);
    if constexpr (PH == -1) phase_prologue(p, shm);
    if constexpr (PH == 0) phase_norm1(p, sd, layer, shm);
    if constexpr (PH == 1) phase_proj_a(p, sd, layer, shm);
    const int qbase = ((layer * 3 + (is_ctx ? 0 : grp + 1)) * 13 + (PH < 0 ? 0 : PH)) * 2;
    if constexpr (PH == 2) { wq_run(p, qbase, sd.nsamp * 4 * sd.ntb, shm, [&](int t) { mlstm_stepA_task(p, sd, layer, t, shm); }); if (!(is_ctx && layer == 1)) phase_pool(p, sd); }
    if constexpr (PH == 3) {
        for (int t = blockIdx.x; t < sd.nsamp * 32; t += gridDim.x) mlstm_stepB_task(p, sd, t);
        if (!(is_ctx && layer == 1)) {
            const int nq = (is_ctx ? (CTX / 64) : ROWS) / 2;
            wq_run(p, qbase, sd.nsamp * nq * 4, shm, [&](int t) { na_task(p, sd, layer, t / (nq * 4), (t >> 2) % nq, t & 3, shm); });
        }
    }
    if constexpr (PH == 4) { wq_run(p, qbase, sd.nsamp * 4 * sd.ntb, shm, [&](int t) { mlstm_stepC_task(p, sd, layer, t, shm); }); }
    if constexpr (PH == 5) phase_proj_b(p, sd, layer, shm);
    if constexpr (PH == 6) phase_merge(p, sd, layer, shm);
    if constexpr (PH == 7) phase_outproj(p, sd, layer, shm);
    if constexpr (PH == 8) phase_postmix(p, sd, layer, shm);
    if constexpr (PH == 9) { for (int t = blockIdx.x; t < sd.nsamp * 16; t += gridDim.x) topk_task(p, sd, t, shm); }
    if constexpr (PH == 10) phase_moe_gu(p, sd, layer, shm);
    if constexpr (PH == 11) phase_moe_down(p, sd, layer, shm);
    if constexpr (PH == 12) phase_combine(p, sd, layer, shm);
}

#ifndef CPU_EMU
template <int PH> __global__ void __launch_bounds__(NTHREADS, 2) k_phase(Params p, int layer, int is_ctx, int grp) {
    DYN_LDS(shm);
    do_phase<PH>(p, layer, is_ctx, grp, shm);
}
#ifndef DBL_MASK
#define DBL_MASK 0
#endif
#define RUNPH(PH) do { do_phase<PH>(p, layer, is_ctx, grp, shm); xcd_barrier(bar); if ((DBL_MASK >> (PH)) & 1) { do_phase<PH>(p, layer, is_ctx, grp, shm); xcd_barrier(bar); } } while (0)
__global__ void __launch_bounds__(NTHREADS, 2) k_mega(Params p) {
    DYN_LDS(shm);
    uint4* xbw = (uint4*)(shm + 131072);
    if (threadIdx.x == 0) *xbw = make_uint4(0u, 0u, 0u, 0u);
    __syncthreads();
    XcdBarrier bar = xcd_barrier_post(p.bar(), (volatile LAS unsigned*)xbw);
    do_phase<-1>(p, 0, 0, 0, shm);
    xcd_barrier(bar);
    for (int layer = 0; layer < 2; ++layer)
        for (int si = 0; si <= NG; ++si) {
            const int is_ctx = si == 0 ? 1 : 0, grp = si == 0 ? 0 : si - 1;
            RUNPH(0); RUNPH(1); RUNPH(2);
            if (is_ctx && layer == 1) { do_phase<3>(p, layer, is_ctx, grp, shm); continue; }
            RUNPH(3); RUNPH(4); RUNPH(5); RUNPH(6); RUNPH(7); RUNPH(8); RUNPH(9); RUNPH(10); RUNPH(11);
            do_phase<12>(p, layer, is_ctx, grp, shm);
        }
}
#endif
}

static Params make_params(void* const* d_in, void* d_out, void* d_ws) {
    Params p{};
    p.x = (const float*)d_in[0]; p.c = (const float*)d_in[1]; p.ctx = (const float*)d_in[2]; p.c_ctx = (const float*)d_in[3];
    p.norm_gain = (const float*)d_in[4]; p.ada_w = (const float*)d_in[5]; p.ada_b = (const float*)d_in[6]; p.w_in = (const float*)d_in[7];
    p.gate_bias = (const float*)d_in[8]; p.pool_w = (const float*)d_in[9]; p.pool_scale = (const float*)d_in[10]; p.rpb = (const float*)d_in[11];
    p.w_branch = (const float*)d_in[12]; p.w_out = (const float*)d_in[13]; p.router_w = (const float*)d_in[14];
    p.w_gate = (const float*)d_in[15]; p.w_up = (const float*)d_in[16]; p.w_down = (const float*)d_in[17];
    p.out = (float*)d_out; p.ws = (char*)d_ws;
    return p;
}

#ifdef CPU_EMU
int emu_cfg_B = CFG_B, emu_cfg_ROWS = CFG_ROWS, emu_cfg_CTX = CFG_CTX;
const char* g_dumpdir = "data";
static void* g_ws = nullptr;
static void dump_buf(const char* name, int layer, int is_ctx, int grp, const void* ptr, size_t bytes) {
    char nm[512]; snprintf(nm, sizeof nm, "%s/d_L%d_%s%d_%s.bin", g_dumpdir, layer, is_ctx ? "c" : "g", grp, name);
    FILE* f = fopen(nm, "wb"); fwrite(ptr, 1, bytes, f); fclose(f);
}
static void emu_hook(const Params& p, int layer, int is_ctx, int grp, int ph) {
    const size_t Rn = is_ctx ? RC : RL;
    if (ph == 0) dump_buf("H", layer, is_ctx, grp, p.H(), Rn * 1024 * 2);
    if (ph == 1) dump_buf("PROJ", layer, is_ctx, grp, is_ctx ? p.PROJc() : p.PROJa(), Rn * PWA * 2);
    if (ph == 2) dump_buf("Pb", layer, is_ctx, grp, p.Pb(), Rn * 512 * 2);
    if (ph == 3) dump_buf("Nb", layer, is_ctx, grp, p.Nb(), Rn * 512 * 2);
    if (ph == 4) dump_buf("Mb", layer, is_ctx, grp, p.Mb(), Rn * 512 * 2);
    if (ph == 5) dump_buf("BG", layer, is_ctx, grp, p.BG(), Rn * NBG * 2);
    if (ph == 6) dump_buf("MERGED", layer, is_ctx, grp, p.MERGED(), Rn * 1024 * 2);
    if (ph == 7) dump_buf("Y", layer, is_ctx, grp, p.Y(), Rn * 1024 * 2);
    if (ph == 8) { dump_buf("H2", layer, is_ctx, grp, p.H(), Rn * 1024 * 2); dump_buf("aff", layer, is_ctx, grp, p.aff(), Rn * 16 * 4); }
}
void emu_dump(const char* dir) {
    char nm[512]; snprintf(nm, sizeof nm, "%s/d_mod.bin", dir);
    FILE* f = fopen(nm, "wb"); fwrite((char*)g_ws + WSL.mod, 1, (size_t)2 * (NB + 1) * 6144 * 4, f); fclose(f);
    snprintf(nm, sizeof nm, "%s/d_ctxs.bin", dir);
    f = fopen(nm, "wb"); fwrite((char*)g_ws + WSL.ctxs, 1, (size_t)NB * CTX * 1024 * 4, f); fclose(f);
}
template <int PH> static void emu_run_phase(const Params& p, int layer, int is_ctx, int grp, int nblocks) {
    emu_launch_lambda([=]() { do_phase<PH>(p, layer, is_ctx, grp, emu_blk->smem); }, nblocks, NTHREADS, LDS_BYTES);
    if (PH >= 0) emu_hook(p, layer, is_ctx, grp, PH);
    printf("phase %d layer %d ctx %d grp %d done\n", PH, layer, is_ctx, grp); fflush(stdout);
}
#define LAUNCH_PHASE(PH) emu_run_phase<PH>(p, layer, is_ctx, grp, nblocks)
#else
#define LAUNCH_PHASE(PH) hipLaunchKernelGGL((k_phase<PH>), dim3(nblocks), dim3(NTHREADS), LDS_BYTES, stream, p, layer, is_ctx, grp)
#define SETATTR(PH) (void)hipFuncSetAttribute((const void*)k_phase<PH>, hipFuncAttributeMaxDynamicSharedMemorySize, LDS_BYTES)
#endif

extern "C" void kernel_launch(void* const* d_in, const int* in_sizes, int n_in, void* d_out, int out_size, void* d_ws, size_t ws_size, hipStream_t stream) {
    (void)in_sizes; (void)n_in; (void)out_size;
    if (ws_size < WSL.total) return;
    Params p = make_params(d_in, d_out, d_ws);
#ifdef CPU_EMU
    g_ws = d_ws;
    memset(d_ws, 0xFF, WSL.total);
    memset((char*)d_ws + WSL.bar, 0, 65536);
    const int nblocks = 16;
#else
    const int nblocks = 256;
#if MK_ONE_LAUNCH
    static int grid = 0;
    if (!grid) {
        (void)hipFuncSetAttribute((const void*)k_mega, hipFuncAttributeMaxDynamicSharedMemorySize, LDS_BYTES);
        int dev = 0, cus = 0, per_cu = 0;
        (void)hipGetDevice(&dev);
        (void)hipDeviceGetAttribute(&cus, hipDeviceAttributeMultiprocessorCount, dev);
        (void)hipOccupancyMaxActiveBlocksPerMultiprocessor(&per_cu, (const void*)k_mega, NTHREADS, LDS_BYTES);
        if (per_cu > 1) per_cu = 1;
        grid = cus * per_cu;
        if (grid > 256) grid = 256;
    }
    if (grid <= 0) return;
    (void)hipMemsetAsync(p.bar(), 0, 65536, stream);
    hipLaunchKernelGGL(k_mega, dim3(grid), dim3(NTHREADS), LDS_BYTES, stream, p);
    return;
#else
    static bool attr_done = false;
    if (!attr_done) { SETATTR(-1); SETATTR(0); SETATTR(1); SETATTR(2); SETATTR(3); SETATTR(4); SETATTR(5); SETATTR(6); SETATTR(7); SETATTR(8); SETATTR(9); SETATTR(10); SETATTR(11); SETATTR(12); attr_done = true; }
#endif
#endif
    { const int layer = 0, is_ctx = 0, grp = 0; LAUNCH_PHASE(-1); }
    for (int layer = 0; layer < 2; ++layer)
        for (int si = 0; si <= NG; ++si) {
            const int is_ctx = si == 0 ? 1 : 0, grp = si == 0 ? 0 : si - 1;
            LAUNCH_PHASE(0); LAUNCH_PHASE(1); LAUNCH_PHASE(2); LAUNCH_PHASE(3);
            if (is_ctx && layer == 1) continue;
            LAUNCH_PHASE(4); LAUNCH_PHASE(5); LAUNCH_PHASE(6); LAUNCH_PHASE(7); LAUNCH_PHASE(8); LAUNCH_PHASE(9); LAUNCH_PHASE(10); LAUNCH_PHASE(11); LAUNCH_PHASE(12);
        }
}
```

```cpp
#ifdef CPU_EMU
#include "emu.h"
#define DYN_LDS(p) char* p = emu_blk->smem
#define WAIT_V(n)
#define WAIT_L(n)
#define HIDE(v)
#define CBAR()
#else
#include <hip/hip_runtime.h>
#define DYN_LDS(p) extern __shared__ __attribute__((aligned(16))) char p[]
#define WAIT_V(n) asm volatile("s_waitcnt vmcnt(" #n ")" ::: "memory")
#define WAIT_L(n) asm volatile("s_waitcnt lgkmcnt(" #n ")" ::: "memory")
#define HIDE(v) asm volatile("" : "+v"(v))
#define CBAR() asm volatile("" ::: "memory")
#endif
#include <stdint.h>
#include <stddef.h>

#ifndef CFG_B
#define CFG_B 32
#define CFG_ROWS 32
#define CFG_CTX 256
#define CFG_G 16
#endif
#ifndef MK_ONE_LAUNCH
#define MK_ONE_LAUNCH 1
#endif

#define DEV __device__ __forceinline__
typedef short s16x4 __attribute__((ext_vector_type(4)));
#ifdef CPU_EMU
#define TR16(ptr) emu_tr16((const void*)(ptr))
#else
typedef __attribute__((address_space(3))) s16x4 lds_s16x4;
#define TR16(ptr) __builtin_amdgcn_ds_read_tr16_b64_v4i16((lds_s16x4*)(ptr))
#endif
#ifdef CPU_EMU
#define TID() (threadIdx.x)
#else
#define TID() ({ int t_ = threadIdx.x; asm volatile("" : "+v"(t_)); t_; })
#endif

typedef unsigned short bf16_t;
typedef short bf16x8 __attribute__((ext_vector_type(8)));
typedef float f32x4 __attribute__((ext_vector_type(4)));
typedef unsigned u32x2 __attribute__((ext_vector_type(2)));
typedef unsigned u32x4 __attribute__((ext_vector_type(4)));

namespace {
constexpr int D = 1024, NB = CFG_B, ROWS = CFG_ROWS, SEQ = ROWS * 64, CTX = CFG_CTX, G = CFG_G, NG = NB / G;
constexpr int RL = G * SEQ, RC = NB * CTX, RMAX = RL > RC ? RL : RC;
constexpr int PWA = 3840, NBG = 3072, PWT = PWA + NBG, PWSRC = 6672, C_SPLIT = 3600;
constexpr int C_QM = 0, C_KM = 256, C_VM = 512, C_OM = 1024, C_GM = 1536, C_PU = 1552, C_QN = 2064, C_KN = 2576, C_VN = 3088;
constexpr int NTBL = SEQ / 128, NTBC = CTX / 128;
constexpr int ilog2(int x) { return x <= 1 ? 0 : 1 + ilog2(x >> 1); }
constexpr int LGSEQ = ilog2(SEQ), LGCTX = ilog2(CTX);
static_assert((1 << LGSEQ) == SEQ && (1 << LGCTX) == CTX, "sequence lengths must be powers of two");
constexpr int cdiv(int a, int b) { return (a + b - 1) / b; }
constexpr int RPE_L = cdiv(G * (SEQ / 8), 256) * 256, RPE_C = cdiv(NB * (CTX / 8), 256) * 256, RPE_MAX = RPE_L > RPE_C ? RPE_L : RPE_C;
constexpr int NSLOT = 16 * RPE_MAX;
constexpr int NTHREADS = 512;
constexpr int GT_MAXU = 10;
constexpr int LDS_BYTES = 131072 + 256 + GT_MAXU * 1024;
constexpr int NST_L = G * 4 * 2 * NTBL, NST_C = NB * 4 * 2 * NTBC, NST = NST_L > NST_C ? NST_L : NST_C;
constexpr int NCI = NB * 4 * 2;
constexpr float RMS_EPS = 1e-6f;

struct WsLayout { size_t bar, WinT, WbT, WoT, WguT, WdT, mod, rope, ctxs, PROJc, CiC, Cin_, Cim, H, PROJa, Sst, Cin, Mb, Pb, Nb, Sn, Ssc, Cn, Cm, aff, slot_token, slot_gate, token_slots, HID, YE, BG, MERGED, Y, total; };
constexpr size_t al(size_t x) { return (x + 255) / 256 * 256; }
constexpr size_t smax(size_t a, size_t b) { return a > b ? a : b; }
constexpr WsLayout make_layout() {
    WsLayout L{}; size_t o = 0;
    L.bar = o; o += al(65536);
    L.WinT = o; o += al((size_t)2 * PWT * 1024 * 2);
    L.WbT = o; o += al((size_t)2 * 3 * 1024 * 512 * 2);
    L.WoT = o; o += al((size_t)2 * 1024 * 1024 * 2);
    L.WguT = o; o += al((size_t)2 * 16 * 2048 * 1024 * 2);
    L.WdT = o; o += al((size_t)2 * 16 * 1024 * 1024 * 2);
    L.mod = o; o += al((size_t)2 * (NB + 1) * 6144 * 4);
    L.rope = o; o += al((size_t)(ROWS + 64) * 16 * 2 * 4);
    L.ctxs = o; o += al((size_t)NB * CTX * 1024 * 4);
    L.PROJc = o; o += al((size_t)RC * PWA * 2);
    L.CiC = o; o += al((size_t)NCI * 8192 * 4);
    L.Cin_ = o; o += al((size_t)NCI * 64 * 4);
    L.Cim = o; o += al((size_t)NCI * 4 * 4);
    L.H = o; o += al((size_t)RMAX * 1024 * 2);
    const size_t x0 = o;
    L.PROJa = o; o += al((size_t)RMAX * PWA * 2);
    L.Sst = o; o += al((size_t)NST * 8192 * 4);
    L.Cin = o; o += al((size_t)NST * 8192 * 2);
    const size_t hid = al((size_t)NSLOT * 1024 * 2);
    o = x0 + smax(o - x0, 2 * hid);
    L.BG = x0; L.HID = x0; L.YE = x0 + hid;
    L.Mb = o; o += al((size_t)RMAX * 512 * 2);
    L.Pb = o; o += al((size_t)RMAX * 512 * 2);
    L.Nb = o; o += al((size_t)RMAX * 512 * 2);
    L.MERGED = L.H; L.Y = L.Mb;
    L.Sn = o; o += al((size_t)NST * 64 * 4);
    L.Ssc = o; o += al((size_t)NST * 4 * 4);
    L.Cn = o; o += al((size_t)NST * 64 * 4);
    L.Cm = o; o += al((size_t)NST * 4 * 4);
    L.aff = o; o += al((size_t)RMAX * 16 * 4);
    L.slot_token = o; o += al((size_t)NSLOT * 4);
    L.slot_gate = o; o += al((size_t)NSLOT * 4);
    L.token_slots = o; o += al((size_t)RMAX * 16 * 4);
    L.total = o;
    return L;
}
constexpr WsLayout WSL = make_layout();
static_assert((size_t)RMAX * NBG * 2 <= (size_t)RMAX * PWA * 2, "BG overlay must fit in PROJa");

struct Params {
    const float *x, *c, *ctx, *c_ctx, *norm_gain, *ada_w, *ada_b, *w_in, *gate_bias, *pool_w, *pool_scale, *rpb, *w_branch, *w_out, *router_w, *w_gate, *w_up, *w_down;
    float* out;
    char* ws;
#ifdef CPU_EMU
#define WSF(T, name) __device__ __host__ __forceinline__ T* name() const { return (T*)(ws + WSL.name); }
#else
#if defined(__HIP_DEVICE_COMPILE__)
#define WSF(T, name) __device__ __host__ __forceinline__ T* name() const { char* w_ = ws; asm volatile("" : "+s"(w_)); return (T*)(__attribute__((address_space(1))) T*)(w_ + WSL.name); }
#else
#define WSF(T, name) __device__ __host__ __forceinline__ T* name() const { return (T*)(ws + WSL.name); }
#endif
#endif
    WSF(unsigned, bar) WSF(bf16_t, WinT) WSF(bf16_t, WbT) WSF(bf16_t, WoT) WSF(bf16_t, WguT) WSF(bf16_t, WdT)
    WSF(float, mod) WSF(float, rope) WSF(float, ctxs) WSF(bf16_t, PROJc) WSF(float, CiC) WSF(float, Cin_) WSF(float, Cim)
    WSF(bf16_t, H) WSF(bf16_t, PROJa) WSF(float, Sst) WSF(bf16_t, Cin) WSF(bf16_t, Mb) WSF(bf16_t, Pb) WSF(bf16_t, Nb)
    WSF(float, Sn) WSF(float, Ssc) WSF(float, Cn) WSF(float, Cm) WSF(float, aff) WSF(int, slot_token) WSF(float, slot_gate) WSF(int, token_slots)
    WSF(bf16_t, HID) WSF(bf16_t, YE) WSF(bf16_t, BG) WSF(bf16_t, MERGED) WSF(bf16_t, Y)
#undef WSF
};

struct SetDesc { int is_ctx, nrows, samp0, nsamp, lgseq, ntb, cap, rpe; };
DEV SetDesc make_set(int is_ctx, int grp) {
    SetDesc s;
    s.is_ctx = is_ctx;
    if (is_ctx) { s.nrows = RC; s.samp0 = 0; s.nsamp = NB; s.lgseq = LGCTX; s.ntb = NTBC; s.cap = CTX / 8; s.rpe = RPE_C; }
    else { s.nrows = RL; s.samp0 = grp * G; s.nsamp = G; s.lgseq = LGSEQ; s.ntb = NTBL; s.cap = SEQ / 8; s.rpe = RPE_L; }
    return s;
}

#ifdef CPU_EMU
#define GAS
#else
#define GAS __attribute__((address_space(1)))
#endif
template <class T> DEV T ldg(const T* p) { return *(const GAS T*)p; }
template <class T> DEV void stg(T* p, const T& v) { *(GAS T*)p = v; }
DEV float bf2f(bf16_t v) { return __uint_as_float(((unsigned)v) << 16); }
DEV bf16_t f2bf(float f) { unsigned u = __float_as_uint(f); u += 0x7FFFu + ((u >> 16) & 1u); return (bf16_t)(u >> 16); }
#if defined(__HIP_DEVICE_COMPILE__)
typedef __bf16 bf16n2 __attribute__((ext_vector_type(2)));
typedef float f32n2 __attribute__((ext_vector_type(2)));
DEV unsigned pack2(float lo, float hi) { f32n2 v = {lo, hi}; bf16n2 r = __builtin_convertvector(v, bf16n2); return __builtin_bit_cast(unsigned, r); }
#else
DEV unsigned pack2(float lo, float hi) { return (unsigned)f2bf(lo) | ((unsigned)f2bf(hi) << 16); }
#endif
DEV float lo16(unsigned u) { return __uint_as_float(u << 16); }
DEV float hi16(unsigned u) { return __uint_as_float(u & 0xFFFF0000u); }
#if defined(__HIP_DEVICE_COMPILE__)
DEV float frcp(float x) { return __builtin_amdgcn_rcpf(x); }
#else
DEV float frcp(float x) { return 1.0f / x; }
#endif
#if defined(__HIP_DEVICE_COMPILE__)
DEV float sigmoidf_(float x) { return __builtin_amdgcn_rcpf(1.0f + __expf(-x)); }
#else
DEV float sigmoidf_(float x) { return 1.0f / (1.0f + __expf(-x)); }
#endif
DEV float logsigmoidf_(float x) { return fminf(x, 0.0f) - __logf(1.0f + __expf(-fabsf(x))); }
template <int M> DEV float shx(float v) {
#if defined(__HIP_DEVICE_COMPILE__)
    const unsigned u = __builtin_bit_cast(unsigned, v);
    if constexpr (M == 1) return __builtin_bit_cast(float, __builtin_amdgcn_update_dpp(u, u, 0xB1, 0xF, 0xF, false));
    else if constexpr (M == 2) return __builtin_bit_cast(float, __builtin_amdgcn_update_dpp(u, u, 0x4E, 0xF, 0xF, false));
    else if constexpr (M == 4) { const unsigned t = __builtin_amdgcn_update_dpp(u, u, 0x141, 0xF, 0xF, false);
        return __builtin_bit_cast(float, __builtin_amdgcn_update_dpp(t, t, 0x1B, 0xF, 0xF, false)); }
    else if constexpr (M == 8) return __builtin_bit_cast(float, __builtin_amdgcn_update_dpp(u, u, 0x128, 0xF, 0xF, false));
    else if constexpr (M == 16) { const auto r = __builtin_amdgcn_permlane16_swap(u, u, false, false); return __builtin_bit_cast(float, (threadIdx.x & 16) ? r[0] : r[1]); }
    else { const auto r = __builtin_amdgcn_permlane32_swap(u, u, false, false); return __builtin_bit_cast(float, (threadIdx.x & 32) ? r[0] : r[1]); }
#else
    return __shfl_xor(v, M);
#endif
}
DEV float wave_sum(float v) { v += shx<32>(v); v += shx<16>(v); v += shx<8>(v); v += shx<4>(v); v += shx<2>(v); v += shx<1>(v); return v; }
DEV bf16x8 mk8(u32x2 lo, u32x2 hi) { u32x4 v = {lo.x, lo.y, hi.x, hi.y}; return __builtin_bit_cast(bf16x8, v); }
DEV bf16x8 mk8(u32x4 v) { return __builtin_bit_cast(bf16x8, v); }
DEV bf16x8 mk8(s16x4 lo, s16x4 hi) { return __builtin_shufflevector(lo, hi, 0, 1, 2, 3, 4, 5, 6, 7); }
DEV f32x4 mfma16(bf16x8 a, bf16x8 b, f32x4 c) { return __builtin_amdgcn_mfma_f32_16x16x32_bf16(a, b, c, 0, 0, 0); }
DEV unsigned f8enc1(float x) {
    const unsigned sgn = x < 0.f ? 0x80u : 0u; float a = x < 0.f ? -x : x; if (!(a < 448.f)) a = 448.f;
    if (a < 0.015625f) { const int q = (int)(a * 512.f + 0.5f); const float r = a * 512.f; int qq = q; if ((float)q - r == 0.5f && (q & 1)) qq = q - 1; return sgn | (unsigned)qq; }
    int e = 0; float m = a; while (m >= 2.f) { m *= 0.5f; ++e; } while (m < 1.f) { m *= 2.f; --e; }
    const float r = (m - 1.f) * 8.f; int q = (int)(r + 0.5f); if ((float)q - r == 0.5f && (q & 1)) --q;
    if (q == 8) { q = 0; ++e; }
    return sgn | (unsigned)((e + 7) << 3) | (unsigned)q;
}
#if defined(__HIP_DEVICE_COMPILE__)
DEV unsigned f8pack4(float a, float b, float c, float d) {
    a = __builtin_amdgcn_fmed3f(a, -448.f, 448.f); b = __builtin_amdgcn_fmed3f(b, -448.f, 448.f); c = __builtin_amdgcn_fmed3f(c, -448.f, 448.f); d = __builtin_amdgcn_fmed3f(d, -448.f, 448.f);
    int w = 0; w = __builtin_amdgcn_cvt_pk_fp8_f32(a, b, w, false); w = __builtin_amdgcn_cvt_pk_fp8_f32(c, d, w, true); return (unsigned)w; }
#else
DEV unsigned f8pack4(float a, float b, float c, float d) { return f8enc1(a) | (f8enc1(b) << 8) | (f8enc1(c) << 16) | (f8enc1(d) << 24); }
#endif
#ifdef CPU_EMU
DEV f32x4 mfma_f8(bf16x8 a0, bf16x8 a1, bf16x8 b0, bf16x8 b1, f32x4 c) { return emu_mfma_f8(a0, a1, b0, b1, c); }
#else
typedef int i32x4 __attribute__((ext_vector_type(4)));
typedef int i32x8 __attribute__((ext_vector_type(8)));
DEV f32x4 mfma_f8(bf16x8 a0, bf16x8 a1, bf16x8 b0, bf16x8 b1, f32x4 c) {
    const i32x8 A = __builtin_shufflevector(__builtin_bit_cast(i32x4, a0), __builtin_bit_cast(i32x4, a1), 0, 1, 2, 3, 4, 5, 6, 7);
    const i32x8 B = __builtin_shufflevector(__builtin_bit_cast(i32x4, b0), __builtin_bit_cast(i32x4, b1), 0, 1, 2, 3, 4, 5, 6, 7);
    return __builtin_amdgcn_mfma_scale_f32_16x16x128_f8f6f4(A, B, c, 0, 0, 0, 0, 0, 0);
}
#endif
constexpr float F8_WSCALE = 64.0f, F8_WINV = 1.0f / 64.0f;
DEV void store8bf(bf16_t* o, f32x4 a, f32x4 b) { u32x4 v = {pack2(a[0], a[1]), pack2(a[2], a[3]), pack2(b[0], b[1]), pack2(b[2], b[3])}; stg((u32x4*)o, v); }

#ifndef CPU_EMU
#define XB_TMO      128
#define XB_XCNT(j)  (256  + 64 * (j))
#define XB_XSUB(j)  (1280 + 64 * (j))
#define XB_XGEN(j)  (2304 + 64 * (j))
#define XB_TOP      3328
#define XB_TOPGEN   3392
#define XCD_BAR_WORDS 3456
#define XB_SPIN_CAP (1u << 18)
#define LAS __attribute__((address_space(3)))
__device__ __forceinline__ unsigned xb_ld(unsigned* p)              { return __hip_atomic_load(p, __ATOMIC_RELAXED, __HIP_MEMORY_SCOPE_AGENT); }
__device__ __forceinline__ unsigned xb_add(unsigned* p, unsigned v) { return __hip_atomic_fetch_add(p, v, __ATOMIC_RELAXED, __HIP_MEMORY_SCOPE_AGENT); }
__device__ __forceinline__ unsigned xb_xcc_id() { return (unsigned)__builtin_amdgcn_s_getreg((3 << 11) | 20) & 0xFu; }
#define XB_SPIN(cond, bar) do { unsigned _sp = 0; while (cond) { __builtin_amdgcn_s_sleep(1); \
    if ((++_sp & 255u) == 0u) { if (xb_ld(&(bar)[XB_TMO])) break; if (_sp > XB_SPIN_CAP) { atomicAdd(&(bar)[XB_TMO], 1u); break; } } } } while (0)
struct XcdBarrier { unsigned* bar; unsigned x; volatile LAS unsigned* st; };
__device__ __forceinline__ XcdBarrier xcd_barrier_post(unsigned* bar, volatile LAS unsigned* st) {
    XcdBarrier b; b.bar = bar; b.x = xb_xcc_id(); b.st = st;
    if (threadIdx.x == 0) (void)xb_add(&bar[XB_XCNT(b.x)], 1u);
    return b;
}
__device__ __forceinline__ void xcd_barrier_complete(unsigned* bar, unsigned x, unsigned& nloc, unsigned& nx) {
    const unsigned Gd = gridDim.x * gridDim.y * gridDim.z;
    unsigned sum, cnt, mine, sp = 0u;
    for (;;) {
        sum = 0u; cnt = 0u; mine = 0u;
#pragma unroll
        for (unsigned j = 0; j < 16; ++j) { const unsigned c = xb_ld(&bar[XB_XCNT(j)]); sum += c; cnt += (c > 0u) ? 1u : 0u; mine = (j == x) ? c : mine; }
        if (sum == Gd) break;
        __builtin_amdgcn_s_sleep(1);
        if ((++sp & 255u) == 0u) { if (xb_ld(&bar[XB_TMO])) break; if (sp > XB_SPIN_CAP) { atomicAdd(&bar[XB_TMO], 1u); break; } }
    }
    nloc = mine > 0u ? mine : 1u; nx = cnt > 0u ? cnt : 1u;
}
__device__ __forceinline__ void xcd_barrier(const XcdBarrier& b) {
    asm volatile("s_waitcnt vmcnt(0)" ::: "memory");
    __syncthreads();
    if (threadIdx.x == 0) {
        unsigned* bar = b.bar;
        unsigned bx = b.x; asm volatile("" : "+s"(bx));
        __builtin_amdgcn_s_waitcnt(0);
        unsigned nloc = b.st[0], nx = b.st[1];
        if (nloc == 0u) { xcd_barrier_complete(bar, bx, nloc, nx); b.st[0] = nloc; b.st[1] = nx; }
        const unsigned old = xb_add(&bar[XB_XSUB(bx)], 1u);
        const unsigned gen = old / nloc;
        if (old + 1u == (gen + 1u) * nloc) {
            __builtin_amdgcn_fence(__ATOMIC_RELEASE, "agent");
            asm volatile("s_waitcnt vmcnt(0)" ::: "memory");
            const unsigned og = xb_add(&bar[XB_TOP], 1u);
            const unsigned tg = og / nx;
            if (og + 1u == (tg + 1u) * nx) xb_add(&bar[XB_TOPGEN], 1u);
            else XB_SPIN(xb_ld(&bar[XB_TOPGEN]) == tg, bar);
            __builtin_amdgcn_fence(__ATOMIC_ACQUIRE, "agent");
            xb_add(&bar[XB_XGEN(bx)], 1u);
            asm volatile("s_waitcnt vmcnt(0)" ::: "memory");
        } else {
            XB_SPIN(xb_ld(&bar[XB_XGEN(bx)]) == gen, bar);
            __builtin_amdgcn_fence(__ATOMIC_ACQUIRE, "agent");
            asm volatile("s_waitcnt vmcnt(0)" ::: "memory");
        }
    }
    __syncthreads();
}
#endif

constexpr int BK = 64, HALF = 128, HT_BYTES = HALF * BK * 2;
DEV int lds_byte(int r, int c) { int st = (r >> 4) * 2 + (c >> 5), rr = r & 15, cc = c & 31, ob = rr * 64 + cc * 2; return st * 1024 + (ob ^ (((ob >> 9) & 1) << 5)); }
DEV void stage_rc(int b, int& Rr, int& Cc) { int st = b / 1024, sb = b % 1024, swz = sb ^ (((sb >> 9) & 1) << 5); Rr = (st >> 1) * 16 + swz / 64; Cc = (st & 1) * 32 + (swz % 64) / 2; }
DEV int perm32(int rho) { const int n = rho >> 4, i = rho & 15; return 8 * (i >> 2) + 4 * n + (i & 3); }

DEV bool tile_order(int i, int nM, int nN, int& pm, int& pn) {
    const int nwg = nM * nN; const int L = i * (int)gridDim.x + (int)blockIdx.x; if (L >= nwg) return false;
    int wgid = L; { const int q = nwg / 8, r = nwg % 8, xcd = wgid % 8, off = wgid / 8; wgid = (xcd < r ? xcd * (q + 1) : r * (q + 1) + (xcd - r) * q) + off; }
    const int nig = 8 * nN, gid = wgid / nig, fm = gid * 8, gsz = (nM - fm) < 8 ? (nM - fm) : 8;
    pm = fm + ((wgid % nig) % gsz); pn = (wgid % nig) / gsz; return true;
}
#ifdef CPU_EMU
#define GLDS16(src, dst) __builtin_amdgcn_global_load_lds((const unsigned*)(src), (unsigned*)((dst) + (TID() & 63) * 16), 16, 0, 0)
#else
#define GLDS16(src, dst) __builtin_amdgcn_global_load_lds((const unsigned*)(src), (unsigned*)(dst), 16, 0, 0)
#endif

#define BAR __builtin_amdgcn_s_barrier()
#define SCHED __builtin_amdgcn_sched_barrier(0)
struct GUnit { int pm, pn, aux; };
template <bool GATHER, int LDA_, int LDB_, int K_, bool F8 = false, class Sched, class Epi>
DEV void gemm_stream(char* shm, const Sched& S, const Epi& epi) {
#define SA(b, h) (shm + ((b) * 2 + (h)) * HT_BYTES)
#define SB(b, h) (shm + (4 + (b) * 2 + (h)) * HT_BYTES)
#define STG_B(P, bp) do { GLDS16((bp) + voffB, (P) + ldsb0); GLDS16((bp) + voffB + 64 * LDB_, (P) + ldsb0 + 8192); } while (0)
#define STG_A(P, ap, h, gv) do { if (GATHER) { GLDS16((ap) + gv[h][0], (P) + ldsb0); GLDS16((ap) + gv[h][1], (P) + ldsb0 + 8192); } \
    else { GLDS16((ap) + voffA + (h) * 128 * LDA_, (P) + ldsb0); GLDS16((ap) + voffA + ((h) * 128 + 64) * LDA_, (P) + ldsb0 + 8192); } } while (0)
#define LDA(dst, b, h) _Pragma("unroll") for (int m = 0; m < 4; ++m) _Pragma("unroll") for (int k = 0; k < 2; ++k) \
    dst[m][k] = *reinterpret_cast<const bf16x8*>(SA(b, h) + aoff + m * 2048 + k * 1024)
#define LDB(dst, b, h) _Pragma("unroll") for (int n = 0; n < 2; ++n) _Pragma("unroll") for (int k = 0; k < 2; ++k) \
    dst[n][k] = *reinterpret_cast<const bf16x8*>(SB(b, h) + boff + n * 2048 + k * 1024)
#define MMA(ai, bj, At_, Bx_) do { __builtin_amdgcn_s_setprio(1); \
    if constexpr (F8) { _Pragma("unroll") for (int m = 0; m < 4; ++m) _Pragma("unroll") for (int n = 0; n < 2; ++n) \
      acc[ai][bj][m][n] = mfma_f8(Bx_[n][0], Bx_[n][1], At_[m][0], At_[m][1], acc[ai][bj][m][n]); } \
    else { _Pragma("unroll") for (int m = 0; m < 4; ++m) _Pragma("unroll") for (int n = 0; n < 2; ++n) _Pragma("unroll") for (int k = 0; k < 2; ++k) \
      acc[ai][bj][m][n] = mfma16(Bx_[n][k], At_[m][k], acc[ai][bj][m][n]); } \
    __builtin_amdgcn_s_setprio(0); } while (0)
    constexpr int nt = K_ / BK;
    const int tid = TID();
    const int wid = __builtin_amdgcn_readfirstlane(tid >> 6), lane = tid & 63, wr = wid >> 2, wc = wid & 3, fr = lane & 15, fq = lane >> 4;
    const int ldsb0 = wid * 1024;
    int Rr0, Cc0; stage_rc(tid * 16, Rr0, Cc0);
    const int voffA = Rr0 * LDA_ + Cc0;
    const int voffB = ((Rr0 & ~31) + perm32(Rr0 & 31)) * LDB_ + Cc0;
    const int aoff = lds_byte(wr * 64 + fr, fq * 8), boff = lds_byte(wc * 32 + fr, fq * 8);
    GUnit cur, nxt; int ui = 0;
    if (!S.next(0, cur)) return;
    int gc[2][2] = {{0, 0}, {0, 0}};
    int* gtab = (int*)(shm + 131072 + 256);
    if (GATHER) {
        __syncthreads();
        { GUnit u; for (int i = 0; i < GT_MAXU && S.next(i, u); ++i) { if (tid < 256) gtab[i * 256 + tid] = S.grow(u, tid) * LDA_; } }
        __syncthreads();
#pragma unroll
        for (int h = 0; h < 2; ++h)
#pragma unroll
            for (int i = 0; i < 2; ++i) gc[h][i] = gtab[h * 128 + i * 64 + Rr0] + Cc0;
    }
    f32x4 acc[2][2][4][2];
#pragma unroll
    for (int a = 0; a < 2; ++a)
#pragma unroll
        for (int b = 0; b < 2; ++b)
#pragma unroll
            for (int m = 0; m < 4; ++m)
#pragma unroll
                for (int n = 0; n < 2; ++n) acc[a][b][m][n] = (f32x4){0.f, 0.f, 0.f, 0.f};
    bf16x8 At[4][2], B0[2][2], B1[2][2];
    const bf16_t* cA = S.a_base(cur); const bf16_t* cB = S.b_base(cur);
    STG_B(SB(0, 0), cB); STG_A(SA(0, 0), cA, 0, gc); STG_B(SB(0, 1), cB + 128 * LDB_); STG_A(SA(0, 1), cA, 1, gc);
    if (wr == 1) BAR;
    WAIT_V(4); BAR;
    STG_B(SB(1, 0), cB + BK); STG_A(SA(1, 0), cA + BK, 0, gc); STG_B(SB(1, 1), cB + 128 * LDB_ + BK);
    WAIT_V(6); BAR;
    for (;;) {
        const bool has_next = S.next(ui + 1, nxt);
        const bf16_t* nA = has_next ? S.a_base(nxt) : cA; const bf16_t* nB = has_next ? S.b_base(nxt) : cB;
#pragma unroll 1
        for (int t = 0; t < nt; t += 2) {
            const bool last = (t == nt - 2);
            const bf16_t* a1 = cA + (t + 1) * BK;
            const bf16_t* a2 = last ? nA : cA + (t + 2) * BK; const bf16_t* b2 = last ? nB : cB + (t + 2) * BK;
            const bf16_t* a3 = a2 + BK; const bf16_t* b3 = b2 + BK;
            LDB(B0, 0, 0); SCHED; LDA(At, 0, 0); STG_A(SA(1, 1), a1, 1, gc);
            if (GATHER && last && has_next) {
#pragma unroll
                for (int h = 0; h < 2; ++h)
#pragma unroll
                    for (int i = 0; i < 2; ++i) gc[h][i] = gtab[(ui + 1) * 256 + h * 128 + i * 64 + Rr0] + Cc0; }
            WAIT_L(8); BAR; WAIT_L(0); MMA(0, 0, At, B0); BAR; SCHED;
            LDB(B1, 0, 1); STG_B(SB(0, 0), b2);
            BAR; WAIT_L(0); MMA(0, 1, At, B1); BAR;
            LDA(At, 0, 1); STG_A(SA(0, 0), a2, 0, gc);
            BAR; WAIT_L(0); MMA(1, 0, At, B0); BAR; SCHED;
            STG_B(SB(0, 1), b2 + 128 * LDB_);
            WAIT_V(6); BAR; MMA(1, 1, At, B1); BAR;
            LDB(B0, 1, 0); SCHED; LDA(At, 1, 0); STG_A(SA(0, 1), a2, 1, gc);
            WAIT_L(8); BAR; WAIT_L(0); MMA(0, 0, At, B0); BAR; SCHED;
            LDB(B1, 1, 1); STG_B(SB(1, 0), b3);
            BAR; WAIT_L(0); MMA(0, 1, At, B1); BAR;
            LDA(At, 1, 1); STG_A(SA(1, 0), a3, 0, gc);
            BAR; WAIT_L(0); MMA(1, 0, At, B0); BAR; SCHED;
            STG_B(SB(1, 1), b3 + 128 * LDB_);
            WAIT_V(6); BAR; MMA(1, 1, At, B1); BAR;
        }
        {
            const int tz = TID(); const int wz = tz >> 6, lz = tz & 63, wrz = wz >> 2, wcz = wz & 3, frz = lz & 15, fqz = lz >> 4;
            epi(cur, acc, wrz * 64 + frz, wcz * 32 + 8 * fqz);
        }
        if (!has_next) break;
#pragma unroll
        for (int a = 0; a < 2; ++a)
#pragma unroll
            for (int b = 0; b < 2; ++b)
#pragma unroll
                for (int m = 0; m < 4; ++m)
#pragma unroll
                    for (int n = 0; n < 2; ++n) acc[a][b][m][n] = (f32x4){0.f, 0.f, 0.f, 0.f};
        cur = nxt; cA = nA; cB = nB; ++ui;
    }
    WAIT_V(0);
    if (wr == 0) BAR;
    BAR;
#undef SA
#undef SB
#undef STG_A
#undef STG_B
#undef LDA
#undef LDB
#undef MMA
}

constexpr int J_IN = 16 * 27, J_WB = 2 * 8 * 4, J_WO = 16 * 4, J_GU = 16 * 2 * 64, J_DN = 16 * 64, J_FOLD = 8 * 16, J_PAD = 1;
constexpr int N_MODJOBS = 2 * 96;

constexpr int J_BIG = J_IN + J_WB + J_WO + J_GU + J_DN;
struct WJob { const float* src; bf16_t* dst; int ldsrc, lddst, nvalid, k0, n0, mode, gu_which, f8; };
DEV WJob wjob_decode(const Params& p, int l, int j) {
    WJob w; w.ldsrc = 1024; w.lddst = 1024; w.nvalid = 256; w.mode = 0; w.gu_which = 0; w.f8 = 0;
    if (j < J_IN) { const int kt = j / 27, nb = j % 27; w.k0 = kt * 64; w.n0 = nb * 256; w.src = p.w_in + (size_t)l * 1024 * PWSRC; w.ldsrc = PWSRC; w.nvalid = PWSRC - w.n0; w.dst = p.WinT() + (size_t)l * PWT * 1024; w.mode = 3; }
    else if ((j -= J_IN) < J_WB) { const int bi = (j / 32) * 2, jj = j % 32, kt = jj / 4, nb = jj % 4; w.k0 = kt * 64; w.n0 = nb * 256;
        w.src = p.w_branch + ((size_t)l * 3 + bi) * 512 * 1024; w.dst = p.WbT() + ((size_t)l * 3 + bi) * 1024 * 512; w.lddst = 512; }
    else if ((j -= J_WB) < J_WO) { const int kt = j / 4, nb = j % 4; w.k0 = kt * 64; w.n0 = nb * 256; w.src = p.w_out + (size_t)l * 1024 * 1024; w.dst = p.WoT() + (size_t)l * 1024 * 1024; }
    else if ((j -= J_WO) < J_GU) { const int e = j / 128, jj = j % 128; w.gu_which = jj / 64; const int j3 = jj % 64, kt = j3 / 4, nb = j3 % 4; w.k0 = kt * 64; w.n0 = nb * 256;
        w.src = (w.gu_which ? p.w_up : p.w_gate) + ((size_t)l * 16 + e) * 1024 * 1024; w.dst = p.WguT() + ((size_t)l * 16 + e) * 2048 * 512; w.mode = 1; w.f8 = 1; }
    else { j -= J_GU; const int e = j / 64, jj = j % 64, kt = jj / 4, nb = jj % 4; w.k0 = kt * 64; w.n0 = nb * 256;
        w.src = p.w_down + ((size_t)l * 16 + e) * 1024 * 1024; w.dst = p.WdT() + ((size_t)l * 16 + e) * 1024 * 512; w.f8 = 1; }
    return w;
}
constexpr int WT_LD = 260;
DEV void wjob_load(const WJob& w, int tid, f32x4 (&vv)[8]) {
#pragma unroll
    for (int i = 0; i < 8; ++i) { const int idx = i * 512 + tid, r = idx >> 6, c = (idx & 63) * 4; int col = w.n0 + c; col = col > w.ldsrc - 4 ? w.ldsrc - 4 : col;
        vv[i] = ldg((const f32x4*)(w.src + (size_t)(w.k0 + r) * w.ldsrc + col)); }
}
DEV void wjob_finish(const WJob& w, int tid, const f32x4 (&vv)[8], float* tile) {
    __syncthreads();
#pragma unroll
    for (int i = 0; i < 8; ++i) { const int idx = i * 512 + tid, r = idx >> 6, c = (idx & 63) * 4; *(f32x4*)(tile + r * WT_LD + c) = vv[i]; }
    __syncthreads();
#pragma unroll
    for (int q = 0; q < 4; ++q) {
        const int item = q * 512 + tid, nrow = item >> 3, kc = (item & 7) * 8;
        float v[8];
#pragma unroll
        for (int jj = 0; jj < 8; ++jj) v[jj] = tile[(kc + jj) * WT_LD + nrow];
        const int n = w.n0 + nrow;
        int drow = n;
        if (w.mode == 1) drow = (n >> 7) * 256 + w.gu_which * 128 + (n & 127);
        if (w.mode == 3) drow = n + (n >= C_SPLIT ? (PWA - C_SPLIT) : 0);
        if (w.f8) { const u32x2 o = {f8pack4(v[0] * F8_WSCALE, v[1] * F8_WSCALE, v[2] * F8_WSCALE, v[3] * F8_WSCALE), f8pack4(v[4] * F8_WSCALE, v[5] * F8_WSCALE, v[6] * F8_WSCALE, v[7] * F8_WSCALE)};
            stg((u32x2*)((unsigned char*)w.dst + (size_t)drow * 1024 + w.k0 + kc), o); }
        else if (nrow < w.nvalid) { u32x4 o = {pack2(v[0], v[1]), pack2(v[2], v[3]), pack2(v[4], v[5]), pack2(v[6], v[7])};
            stg((u32x4*)(w.dst + (size_t)drow * w.lddst + w.k0 + kc), o); }
    }
}
DEV void pro_small_job(const Params& p, int l, int j, char* shm) {
    float* tile = (float*)shm;
    const int tid = TID();
    if (j < J_FOLD) {
        const int kt = j / 16, ntl = j % 16, k0 = kt * 64, n0 = ntl * 64; const int fg = k0 / 128;
        const float* wb1 = p.w_branch + ((size_t)l * 3 + 1) * 512 * 1024;
        const float* pw = p.pool_w + ((size_t)l * 4 + fg) * 128 * 128; const float* ps = p.pool_scale + (size_t)l * 512 + fg * 128;
        const int c = tid & 63, rq = tid >> 6;
        float accv[8];
#pragma unroll
        for (int i = 0; i < 8; ++i) accv[i] = 0.f;
        for (int d = 0; d < 128; ++d) { const float wv = ldg(wb1 + (size_t)(fg * 128 + d) * 1024 + n0 + c) * ldg(ps + d);
#pragma unroll
            for (int i = 0; i < 8; ++i) accv[i] += ldg(pw + (size_t)(k0 - fg * 128 + rq * 8 + i) * 128 + d) * wv; }
        __syncthreads();
#pragma unroll
        for (int i = 0; i < 8; ++i) tile[(rq * 8 + i) * WT_LD + c] = accv[i];
        __syncthreads();
        const int nrow = tid >> 3, kc = (tid & 7) * 8; float v[8];
#pragma unroll
        for (int jj = 0; jj < 8; ++jj) v[jj] = tile[(kc + jj) * WT_LD + nrow];
        u32x4 o = {pack2(v[0], v[1]), pack2(v[2], v[3]), pack2(v[4], v[5]), pack2(v[6], v[7])};
        stg((u32x4*)(p.WbT() + ((size_t)l * 3 + 1) * 1024 * 512 + (size_t)(n0 + nrow) * 512 + k0 + kc), o);
    } else {
        bf16_t* d0 = p.WinT() + (size_t)l * PWT * 1024 + (size_t)C_SPLIT * 1024;
        for (int i = tid; i < (PWA - C_SPLIT) * 1024 / 8; i += NTHREADS) stg((u32x4*)(d0 + (size_t)i * 8), (u32x4){0u, 0u, 0u, 0u});
    }
}

DEV void pro_mod_job(const Params& p, int job, char* shm) {
    float* sv = (float*)shm;
    const int tid = TID(), l = job / 96, col0 = (job % 96) * 64;
    const int c = tid & 63, kp = tid >> 6;
    float acc[NB + 1];
#pragma unroll
    for (int v = 0; v <= NB; ++v) acc[v] = 0.f;
    for (int half = 0; half < 2; ++half) {
        __syncthreads();
        for (int idx = tid; idx < (NB + 1) * 512; idx += 512) { const int v = idx >> 9, k = idx & 511;
            const float s = (v < NB) ? ldg(p.c + (size_t)v * 1024 + half * 512 + k) : ldg(p.c_ctx + half * 512 + k);
            sv[idx] = s * sigmoidf_(s); }
        __syncthreads();
        for (int kk = 0; kk < 64; ++kk) { const int k = kp * 64 + kk;
            const float w = ldg(p.ada_w + ((size_t)l * 1024 + half * 512 + k) * 6144 + col0 + c);
#pragma unroll
            for (int v = 0; v <= NB; ++v) acc[v] += sv[v * 512 + k] * w; }
    }
    __syncthreads();
    float* red = (float*)shm;
#pragma unroll
    for (int v = 0; v <= NB; ++v) red[(kp * (NB + 1) + v) * 64 + c] = acc[v];
    __syncthreads();
    for (int idx = tid; idx < (NB + 1) * 64; idx += 512) { const int v = idx >> 6, cc = idx & 63; float s = 0.f;
#pragma unroll
        for (int q = 0; q < 8; ++q) s += red[(q * (NB + 1) + v) * 64 + cc];
        stg(p.mod() + ((size_t)l * (NB + 1) + v) * 6144 + col0 + cc, s + ldg(p.ada_b + (size_t)l * 6144 + col0 + cc)); }
}

DEV void phase_prologue(const Params& p, char* shm) {
    const int tid = TID();
    const int nsmall = N_MODJOBS + 1 + 2 * (J_FOLD + J_PAD);
    for (int job = blockIdx.x; job < nsmall; job += gridDim.x) {
        if (job < N_MODJOBS) pro_mod_job(p, job, shm);
        else if (job == N_MODJOBS) {
            for (int idx = tid; idx < (ROWS + 64) * 16; idx += NTHREADS) { const int pos = idx >> 4, i = idx & 15;
                const float pv = (float)(pos < ROWS ? pos : pos - ROWS);
                const float inv = powf(10000.0f, -(float)(2 * i) / 32.0f);
                const float a = pv * inv; stg(p.rope() + idx * 2, cosf(a)); stg(p.rope() + idx * 2 + 1, sinf(a)); }
        } else { const int sj = job - N_MODJOBS - 1; pro_small_job(p, sj / (J_FOLD + J_PAD), sj % (J_FOLD + J_PAD), shm); }
    }
    float* tile = (float*)shm;
    const int nbig = 2 * J_BIG;
    int job = blockIdx.x;
    if (job >= nbig) return;
    WJob wc = wjob_decode(p, job / J_BIG, job % J_BIG), wn = wc;
    f32x4 vc[8], vn[8];
    wjob_load(wc, tid, vc);
    for (; job < nbig; job += gridDim.x) {
        const int jn = job + gridDim.x;
        if (jn < nbig) { wn = wjob_decode(p, jn / J_BIG, jn % J_BIG); wjob_load(wn, tid, vn); }
        wjob_finish(wc, tid, vc, tile);
        wc = wn;
#pragma unroll
        for (int i = 0; i < 8; ++i) vc[i] = vn[i];
    }
}

DEV const float* xsrc_base(const Params& p, const SetDesc& sd, int layer) {
    return (sd.is_ctx ? (layer == 0 ? p.ctx : (const float*)p.ctxs()) : (layer == 0 ? p.x : (const float*)p.out)) + (((size_t)sd.samp0) << sd.lgseq) * 1024;
}
DEV float* xdst_base(const Params& p, const SetDesc& sd) { return (sd.is_ctx ? p.ctxs() : p.out) + (((size_t)sd.samp0) << sd.lgseq) * 1024; }
DEV const float* mod_row(const Params& p, const SetDesc& sd, int layer, int row) {
    return p.mod() + ((size_t)layer * (NB + 1) + (sd.is_ctx ? NB : sd.samp0 + (row >> sd.lgseq))) * 6144;
}
DEV bf16_t* proj_buf(const Params& p, const SetDesc& sd) { return sd.is_ctx ? p.PROJc() : p.PROJa(); }

DEV void stage_params(float* par, const float* v0, const float* v1, const float* v2, const float* v3, const float* v4) {
    const int tid = TID();
    const float* src[5] = {v0, v1, v2, v3, v4};
#pragma unroll
    for (int k = 0; k < 5; ++k) if (src[k]) { for (int i = tid; i < 1024; i += NTHREADS) par[k * 1024 + i] = ldg(src[k] + i); }
}
DEV void phase_norm1(const Params& p, const SetDesc& sd, int layer, char* shm) {
    const int tid = TID(), lane = tid & 63, wv = tid >> 6;
    const float* g0 = p.norm_gain + ((size_t)layer * 4 + 0) * 1024;
    const float* xb = xsrc_base(p, sd, layer);
    const int stride = 8; const int rpb_ = (sd.nrows + (int)gridDim.x - 1) / (int)gridDim.x; const int row_end = min(sd.nrows, ((int)blockIdx.x + 1) * rpb_);
    int row = (int)blockIdx.x * rpb_ + wv;
    float* par = (float*)shm;
    __syncthreads();
    { const float* mdb = mod_row(p, sd, layer, min((int)blockIdx.x * rpb_, sd.nrows - 1)); stage_params(par, g0, mdb, mdb + 1024, nullptr, nullptr); }
    __syncthreads();
    f32x4 cur[4], nxt[4];
    if (row < row_end) {
#pragma unroll
        for (int i = 0; i < 4; ++i) cur[i] = ldg((const f32x4*)(xb + (size_t)row * 1024 + (i >> 1) * 512 + lane * 8 + (i & 1) * 4)); }
    for (; row < row_end; row += stride) {
        const int rn = row + stride;
        if (rn < row_end) {
#pragma unroll
            for (int i = 0; i < 4; ++i) nxt[i] = ldg((const f32x4*)(xb + (size_t)rn * 1024 + (i >> 1) * 512 + lane * 8 + (i & 1) * 4)); }
        const float* md = mod_row(p, sd, layer, row);
        float ss = 0.f;
#pragma unroll
        for (int i = 0; i < 4; ++i)
#pragma unroll
            for (int j = 0; j < 4; ++j) ss += cur[i][j] * cur[i][j];
        ss = wave_sum(ss);
        const float rstd = rsqrtf(ss * (1.0f / 1024.0f) + RMS_EPS);
#pragma unroll
        for (int hlf = 0; hlf < 2; ++hlf) { const int c0 = hlf * 512 + lane * 8; float o[8];
#pragma unroll
            for (int j = 0; j < 8; ++j) o[j] = cur[hlf * 2 + (j >> 2)][j & 3] * rstd * par[c0 + j] * (1.0f + par[2048 + c0 + j]) + par[1024 + c0 + j];
            u32x4 ov = {pack2(o[0], o[1]), pack2(o[2], o[3]), pack2(o[4], o[5]), pack2(o[6], o[7])};
            stg((u32x4*)(p.H() + (size_t)row * 1024 + c0), ov); }
#pragma unroll
        for (int i = 0; i < 4; ++i) cur[i] = nxt[i];
    }
}

struct SchedPlain {
    const bf16_t* A; const bf16_t* Bt; int nM, nN, lda256, ldb256;
    DEV bool next(int i, GUnit& u) const { u.aux = 0; return tile_order(i, nM, nN, u.pm, u.pn); }
    DEV const bf16_t* a_base(const GUnit& u) const { return A + (size_t)u.pm * lda256; }
    DEV const bf16_t* b_base(const GUnit& u) const { return Bt + (size_t)u.pn * ldb256; }
    DEV int grow(const GUnit&, int) const { return 0; }
};
DEV void phase_proj_a(const Params& p, const SetDesc& sd, int layer, char* shm) {
    SchedPlain S; S.A = p.H(); S.Bt = p.WinT() + (size_t)layer * PWT * 1024; S.nM = sd.nrows / 256; S.nN = PWA / 256; S.lda256 = 256 * 1024; S.ldb256 = 256 * 1024;
    bf16_t* pb = proj_buf(p, sd);
    gemm_stream<false, 1024, 1024, 1024>(shm, S, [=](const GUnit& u, const f32x4 (&acc)[2][2][4][2], int r0, int c0) {
#pragma unroll
        for (int ai = 0; ai < 2; ++ai)
#pragma unroll
            for (int m = 0; m < 4; ++m) { bf16_t* o = pb + ((size_t)u.pm * 256 + r0 + ai * 128 + m * 16) * PWA + u.pn * 256 + c0;
                store8bf(o, acc[ai][0][m][0], acc[ai][0][m][1]); store8bf(o + 128, acc[ai][1][m][0], acc[ai][1][m][1]); } });
}
DEV f32x4 sig4(f32x4 v) { f32x4 r; r[0] = sigmoidf_(v[0]); r[1] = sigmoidf_(v[1]); r[2] = sigmoidf_(v[2]); r[3] = sigmoidf_(v[3]); return r; }
DEV void phase_proj_b(const Params& p, const SetDesc& sd, int layer, char* shm) {
    SchedPlain S; S.A = p.H(); S.Bt = p.WinT() + (size_t)layer * PWT * 1024 + (size_t)PWA * 1024; S.nM = sd.nrows / 256; S.nN = NBG / 256; S.lda256 = 256 * 1024; S.ldb256 = 256 * 1024;
    bf16_t* bg = p.BG();
    gemm_stream<false, 1024, 1024, 1024>(shm, S, [=](const GUnit& u, const f32x4 (&acc)[2][2][4][2], int r0, int c0) {
#pragma unroll
        for (int ai = 0; ai < 2; ++ai)
#pragma unroll
            for (int m = 0; m < 4; ++m) { bf16_t* o = bg + ((size_t)u.pm * 256 + r0 + ai * 128 + m * 16) * NBG + u.pn * 256 + c0;
                store8bf(o, sig4(acc[ai][0][m][0]), sig4(acc[ai][0][m][1])); store8bf(o + 128, sig4(acc[ai][1][m][0]), sig4(acc[ai][1][m][1])); } });
}

DEV void gate_scan(const bf16_t* prow, int h, const float* gbias, float* ga, float* gb, float* gpm, float* gtot, float* tmp) {
    const int tid = TID(), lane = tid & 63, w = tid >> 6;
    float b = 0.f, a = 0.f, pm = 0.f; int d = 0, tok = 0;
    if (tid < 256) {
        d = tid >> 7; const int i = tid & 127; tok = d ? 127 - i : i;
        const float gi = bf2f(ldg(prow + (size_t)tok * PWA + C_GM + (2 * d) * 4 + h)) + ldg(gbias + (2 * d) * 4 + h);
        const float gf = bf2f(ldg(prow + (size_t)tok * PWA + C_GM + (2 * d + 1) * 4 + h)) + ldg(gbias + (2 * d + 1) * 4 + h);
        b = logsigmoidf_(gf);
#pragma unroll
        for (int o = 1; o < 64; o <<= 1) { const float t = __shfl_up(b, o); if (lane >= o) b += t; }
        if (lane == 63) tmp[w] = b;
        a = gi;
    }
    __syncthreads();
    if (tid < 256) {
        if (w & 1) b += tmp[w - 1];
        a -= b; pm = a;
#pragma unroll
        for (int o = 1; o < 64; o <<= 1) { const float t = __shfl_up(pm, o); if (lane >= o) pm = fmaxf(pm, t); }
        if (lane == 63) tmp[8 + w] = pm;
    }
    __syncthreads();
    if (tid < 256) {
        if (w & 1) pm = fmaxf(pm, tmp[8 + w - 1]);
        ga[d * 128 + tok] = a; gb[d * 128 + tok] = b; gpm[d * 128 + tok] = pm;
        if ((tid & 127) == 127) { gtot[d * 2] = b; gtot[d * 2 + 1] = pm; }
    }
    __syncthreads();
}

DEV void load_rope_chunk(const bf16_t* hp, int cidx, bool latent, int tl, const float* rope, float scale, float* o) {
    const u32x4 m = ldg((const u32x4*)(hp + cidx * 8));
    float x[8] = {lo16(m.x), hi16(m.x), lo16(m.y), hi16(m.y), lo16(m.z), hi16(m.z), lo16(m.w), hi16(m.w)};
    if (latent) {
        const u32x4 q = ldg((const u32x4*)(hp + (cidx ^ 2) * 8));
        const float y[8] = {lo16(q.x), hi16(q.x), lo16(q.y), hi16(q.y), lo16(q.z), hi16(q.z), lo16(q.w), hi16(q.w)};
        const int pos = (cidx < 4) ? (tl >> 6) : (ROWS + (tl & 63));
        const float* tb = rope + ((size_t)pos * 16 + (cidx & 1) * 8) * 2;
        const bool first = (cidx & 2) == 0;
#pragma unroll
        for (int j = 0; j < 8; ++j) { const float cs = ldg(tb + j * 2), sn = ldg(tb + j * 2 + 1);
            x[j] = first ? (x[j] * cs - y[j] * sn) : (x[j] * cs + y[j] * sn); }
    }
#pragma unroll
    for (int j = 0; j < 8; ++j) o[j] = x[j] * scale;
}

DEV int st_index(const SetDesc& sd, int sl, int h, int dir, int tb) { return ((sl * 4 + h) * 2 + dir) * sd.ntb + tb; }

constexpr int V_LD = 144, K_LD = 72, KS_LD = 80;
DEV void mlstm_stepA_task(const Params& p, const SetDesc& sd, int layer, int task, char* shm) {
    const int tid = TID(), lane = tid & 63, w = tid >> 6, fr = lane & 15, fq = lane >> 4, tq4 = (lane & 15) >> 2, tp4 = lane & 3;
    const int tb = task % sd.ntb, h = (task / sd.ntb) & 3, sl = task / (sd.ntb * 4);
    const int row0 = (sl << sd.lgseq) + tb * 128; const bool latent = !sd.is_ctx; const int tl0 = tb * 128;
    bf16_t* Vs = (bf16_t*)shm;
    bf16_t* Ksc = (bf16_t*)(shm + 128 * V_LD * 2);
    float* ga = (float*)(shm + 128 * V_LD * 2 + 2 * 128 * KS_LD * 2); float* gb = ga + 256; float* gpm = gb + 256; float* gtot = gpm + 256; float* tmp = gtot + 8;
    const bf16_t* prow = proj_buf(p, sd) + (size_t)row0 * PWA;
    __syncthreads();
    gate_scan(prow, h, p.gate_bias + (size_t)layer * 16, ga, gb, gpm, gtot, tmp);
    {
        const int s = tid & 127, cpi = tid >> 7, cp = (cpi & 1) + (cpi >> 1) * 4;
        const bf16_t* hp = prow + (size_t)s * PWA + C_KM + h * 64;
        float k1[8], k2[8];
        load_rope_chunk(hp, cp, latent, tl0 + s, p.rope(), 1.0f, k1);
        load_rope_chunk(hp, cp + 2, latent, tl0 + s, p.rope(), 1.0f, k2);
#pragma unroll
        for (int dir = 0; dir < 2; ++dir) { const float ws = __expf(ga[dir * 128 + s] - gtot[dir * 2 + 1]);
            u32x4 o1 = {pack2(k1[0] * ws, k1[1] * ws), pack2(k1[2] * ws, k1[3] * ws), pack2(k1[4] * ws, k1[5] * ws), pack2(k1[6] * ws, k1[7] * ws)};
            u32x4 o2 = {pack2(k2[0] * ws, k2[1] * ws), pack2(k2[2] * ws, k2[3] * ws), pack2(k2[4] * ws, k2[5] * ws), pack2(k2[6] * ws, k2[7] * ws)};
            *(u32x4*)(Ksc + (dir * 128 + s) * KS_LD + cp * 8) = o1; *(u32x4*)(Ksc + (dir * 128 + s) * KS_LD + (cp + 2) * 8) = o2; }
    }
#pragma unroll
    for (int it = 0; it < 4; ++it) { const int item = tid + it * 512, s = item >> 4, ch = item & 15;
        *(u32x4*)(Vs + s * V_LD + ch * 8) = ldg((const u32x4*)(prow + (size_t)s * PWA + C_VM + h * 128 + ch * 8)); }
    __syncthreads();
    f32x4 acc[2][4];
#pragma unroll
    for (int dir = 0; dir < 2; ++dir)
#pragma unroll
        for (int n = 0; n < 4; ++n) acc[dir][n] = (f32x4){0.f, 0.f, 0.f, 0.f};
#pragma unroll
    for (int ks = 0; ks < 4; ++ks) {
        const bf16_t* vp = Vs + (32 * ks + 4 * fq + tq4) * V_LD + w * 16 + 4 * tp4;
        const bf16x8 af = mk8(TR16(vp), TR16(vp + 16 * V_LD));
#pragma unroll
        for (int dir = 0; dir < 2; ++dir)
#pragma unroll
            for (int n = 0; n < 4; ++n) { const bf16_t* kp = Ksc + (dir * 128 + 32 * ks + 4 * fq + tq4) * KS_LD + n * 16 + 4 * tp4;
                const bf16x8 bfv = mk8(TR16(kp), TR16(kp + 16 * KS_LD));
                acc[dir][n] = mfma16(af, bfv, acc[dir][n]); }
    }
#pragma unroll
    for (int dir = 0; dir < 2; ++dir) { float* So = p.Sst() + (size_t)st_index(sd, sl, h, dir, tb) * 8192;
#pragma unroll
        for (int n = 0; n < 4; ++n)
#pragma unroll
            for (int r = 0; r < 4; ++r) stg(So + (w * 16 + fq * 4 + r) * 64 + n * 16 + fr, (float)acc[dir][n][r]); }
    if (tid < 128) { const int dir = tid >> 6, dd = tid & 63; float sm = 0.f;
        for (int i = 0; i < 128; ++i) sm += bf2f(Ksc[(dir * 128 + i) * KS_LD + dd]);
        stg(p.Sn() + (size_t)st_index(sd, sl, h, dir, tb) * 64 + dd, sm); }
    if (tid < 2) { float* sc = p.Ssc() + (size_t)st_index(sd, sl, h, tid, tb) * 4; stg(sc, gtot[tid * 2]); stg(sc + 1, gtot[tid * 2] + gtot[tid * 2 + 1]); }
}

template <int GI> DEV void pool_group(const Params& p, const SetDesc& sd, const bf16_t* pb) {
    constexpr int W = 2 << GI;
    const int nitems = sd.nrows * 16; const int T = 1 << sd.lgseq;
    for (int item = blockIdx.x * NTHREADS + TID(); item < nitems; item += gridDim.x * NTHREADS) {
        const int row = item >> 4, ch = GI * 128 + (item & 15) * 8;
        const int tt = row & (T - 1);
        u32x4 mv[W]; int cnt = 0; bool okv[W];
#pragma unroll
        for (int q = 0; q < W; ++q) { const int t2 = tt - W / 2 + q; const bool ok = (t2 >= 0) && (t2 < T); cnt += ok ? 1 : 0; okv[q] = ok;
            mv[q] = ldg((const u32x4*)(pb + (size_t)(ok ? (row - W / 2 + q) : row) * PWA + C_PU + ch)); }
        float s[8];
#pragma unroll
        for (int j = 0; j < 8; ++j) s[j] = 0.f;
#pragma unroll
        for (int q = 0; q < W; ++q) { u32x4 m = mv[q]; if (!okv[q]) m = (u32x4){0u, 0u, 0u, 0u};
            s[0] += lo16(m.x); s[1] += hi16(m.x); s[2] += lo16(m.y); s[3] += hi16(m.y); s[4] += lo16(m.z); s[5] += hi16(m.z); s[6] += lo16(m.w); s[7] += hi16(m.w); }
        const float inv = frcp((float)cnt);
        const u32x4 m = mv[W / 2];
        const float u[8] = {lo16(m.x), hi16(m.x), lo16(m.y), hi16(m.y), lo16(m.z), hi16(m.z), lo16(m.w), hi16(m.w)};
        u32x4 o = {pack2(s[0] * inv - u[0], s[1] * inv - u[1]), pack2(s[2] * inv - u[2], s[3] * inv - u[3]), pack2(s[4] * inv - u[4], s[5] * inv - u[5]), pack2(s[6] * inv - u[6], s[7] * inv - u[7])};
        stg((u32x4*)(p.Pb() + (size_t)row * 512 + ch), o);
    }
}
DEV void phase_pool(const Params& p, const SetDesc& sd) {
    const bf16_t* pb = proj_buf(p, sd);
    pool_group<0>(p, sd, pb); pool_group<1>(p, sd, pb); pool_group<2>(p, sd, pb); pool_group<3>(p, sd, pb);
}

template <int NC> DEV void mlstm_stepB_run(const Params& p, const SetDesc& sd, int task) {
    const int tid = TID();
    const int q = task & 3, dir = (task >> 2) & 1, h = (task >> 3) & 3, sl = task >> 5;
    const int ci = ((sd.samp0 + sl) * 4 + h) * 2 + dir;
    const int eoff = q * 2048 + tid * 4;
    float zr = 0.f; HIDE(zr);
    f32x4 C = {zr, zr, zr, zr}; float nv = 0.f; float m = -1e30f;
    f32x4 Sv[NC]; float blv[NC], mlv[NC], snv[NC];
#pragma unroll
    for (int c = 0; c < NC; ++c) { const int tb = dir ? NC - 1 - c : c; const size_t si = st_index(sd, sl, h, dir, tb);
        Sv[c] = ldg((const f32x4*)(p.Sst() + si * 8192 + eoff)); blv[c] = ldg(p.Ssc() + si * 4); mlv[c] = ldg(p.Ssc() + si * 4 + 1);
        snv[c] = (q == 0 && tid < 64) ? ldg(p.Sn() + si * 64 + tid) : 0.f; }
    if (!sd.is_ctx) { C = ldg((const f32x4*)(p.CiC() + (size_t)ci * 8192 + eoff)); if (q == 0 && tid < 64) nv = ldg(p.Cin_() + (size_t)ci * 64 + tid); m = ldg(p.Cim() + (size_t)ci * 4); }
#pragma unroll
    for (int c = 0; c < NC; ++c) {
        const int tb = dir ? NC - 1 - c : c; const size_t si = st_index(sd, sl, h, dir, tb);
        u32x2 o = {pack2(C[0], C[1]), pack2(C[2], C[3])};
        stg((u32x2*)(p.Cin() + si * 8192 + eoff), o);
        if (q == 0 && tid < 64) stg(p.Cn() + si * 64 + tid, nv);
        if (q == 0 && tid == 0) stg(p.Cm() + si * 4, m);
        const float mn = fmaxf(blv[c] + m, mlv[c]);
        const float dc = __expf(blv[c] + m - mn), wsn = __expf(mlv[c] - mn);
        C = C * dc + Sv[c] * wsn;
        nv = nv * dc + snv[c] * wsn;
        m = mn;
    }
    if (sd.is_ctx) { stg((f32x4*)(p.CiC() + (size_t)ci * 8192 + eoff), C); if (q == 0 && tid < 64) stg(p.Cin_() + (size_t)ci * 64 + tid, nv); if (q == 0 && tid == 0) stg(p.Cim() + (size_t)ci * 4, m); }
}
DEV void mlstm_stepB_task(const Params& p, const SetDesc& sd, int task) {
    if (sd.is_ctx) mlstm_stepB_run<NTBC>(p, sd, task); else mlstm_stepB_run<NTBL>(p, sd, task);
}

constexpr int NA_KLD = 136, NA_VLD = 144;
DEV void na_task(const Params& p, const SetDesc& sd, int layer, int sl, int rq2  , int hp, char* shm) {
    const int tid = TID(), lane = tid & 63, w = tid >> 6, tq = lane & 15, fq = lane >> 4, tq4 = (lane & 15) >> 2, tp4 = lane & 3;
    const int hh = w >> 2, g = w & 3, head = hp * 2 + hh;
    const bool ctxq = sd.is_ctx;
    bf16_t* Ks = (bf16_t*)shm;
    bf16_t* Vs = (bf16_t*)(shm + 128 * NA_KLD * 2);
    float* rpbs = (float*)(shm + 128 * NA_KLD * 2 + 128 * NA_VLD * 2);
    const int sample = sd.samp0 + sl;
    const bf16_t* pq = proj_buf(p, sd) + ((size_t)sl << sd.lgseq) * PWA;
    const bf16_t* pc = p.PROJc() + (size_t)sample * CTX * PWA;
    const int qcol = g * 16 + tq;
    int rqv[2], rsv[2], qtok[2];
#pragma unroll
    for (int u = 0; u < 2; ++u) { rqv[u] = 2 * rq2 + u; qtok[u] = rqv[u] * 64 + qcol; int r_ = rqv[u] - 4; rsv[u] = r_ < 0 ? 0 : (r_ > ROWS - 8 ? ROWS - 8 : r_); }
    const int nloc = ctxq ? 0 : (rsv[1] + 8 - rsv[0]);
    const int nstage = nloc + CTX / 64;
    __syncthreads();
    if (!ctxq) for (int i = tid; i < 2 * 465; i += NTHREADS) rpbs[i] = ldg(p.rpb + ((size_t)layer * 8 + hp * 2 + i / 465) * 465 + i % 465);
    bf16x8 qf[2][2];
#pragma unroll
    for (int u = 0; u < 2; ++u)
#pragma unroll
        for (int ks = 0; ks < 2; ++ks) qf[u][ks] = mk8(ldg((const u32x4*)(pq + (size_t)qtok[u] * PWA + C_QN + head * 64 + ks * 32 + fq * 8)));
    float m_run[2] = {-1e30f, -1e30f}, l_run[2] = {0.f, 0.f};
    f32x4 acc[2][4];
#pragma unroll
    for (int u = 0; u < 2; ++u)
#pragma unroll
        for (int mt = 0; mt < 4; ++mt) acc[u][mt] = (f32x4){0.f, 0.f, 0.f, 0.f};
    int cs = qcol - 8; cs = cs < 0 ? 0 : (cs > 48 ? 48 : cs);
    const int kc0 = (g == 0) ? 0 : (g == 1) ? 8 : (g == 2) ? 24 : 32;
    const int npair = (nstage + 1) >> 1;
    u32x4 kreg[4], vreg[4];
#define NA_SRC_ROWS(stg) (((stg) < nloc) ? (pq + (size_t)((rsv[0] + (stg)) * 64) * PWA) : (pc + (size_t)((((stg) < nstage ? (stg) : nstage - 1) - nloc) * 64) * PWA))
#define NA_FETCH(sp_) do { _Pragma("unroll") for (int it = 0; it < 4; ++it) { const int item = tid + it * 512, key2 = item >> 4, ch = item & 15; \
        const bf16_t* kb_ = NA_SRC_ROWS(2 * (sp_) + (key2 >> 6)); const bf16_t* src = kb_ + (size_t)(key2 & 63) * PWA + hp * 128 + ch * 8; \
        kreg[it] = ldg((const u32x4*)(src + C_KN)); vreg[it] = ldg((const u32x4*)(src + C_VN)); } } while (0)
    NA_FETCH(0);
    for (int sp = 0; sp < npair; ++sp) {
        __syncthreads();
#pragma unroll
        for (int it = 0; it < 4; ++it) { const int item = tid + it * 512, key2 = item >> 4, ch = item & 15;
            *(u32x4*)(Ks + key2 * NA_KLD + ch * 8) = kreg[it]; *(u32x4*)(Vs + key2 * NA_VLD + ch * 8) = vreg[it]; }
        if (sp + 1 < npair) NA_FETCH(sp + 1);
        __syncthreads();
#pragma unroll
        for (int sub = 0; sub < 2; ++sub) {
        const int st = 2 * sp + sub;
        if (st >= nstage) continue;
        const bool local = st < nloc;
        const bf16_t* Ksb = Ks + sub * 64 * NA_KLD; const bf16_t* Vsb = Vs + sub * 64 * NA_VLD;
        if (local) {
            const int kr = rsv[0] + st;
            f32x4 sa[2][2];
#pragma unroll
            for (int kt = 0; kt < 2; ++kt) { sa[0][kt] = (f32x4){0.f, 0.f, 0.f, 0.f}; sa[1][kt] = (f32x4){0.f, 0.f, 0.f, 0.f};
#pragma unroll
                for (int ks = 0; ks < 2; ++ks) { const bf16x8 kf = *(const bf16x8*)(Ksb + (kc0 + kt * 16 + tq) * NA_KLD + hh * 64 + ks * 32 + fq * 8);
                    sa[0][kt] = mfma16(kf, qf[0][ks], sa[0][kt]); sa[1][kt] = mfma16(kf, qf[1][ks], sa[1][kt]); } }
            float alpha[2]; bf16x8 pf[2];
#pragma unroll
            for (int u = 0; u < 2; ++u) {
                const bool act = (kr >= rsv[u]) && (kr < rsv[u] + 8);
                if (!act) { alpha[u] = 1.0f; pf[u] = mk8((u32x4){0u, 0u, 0u, 0u}); continue; }
                const int dr = kr - rqv[u] + 7;
                float sc[8]; float mx = -1e30f; float bs[8];
#pragma unroll
                for (int kt = 0; kt < 2; ++kt)
#pragma unroll
                    for (int r = 0; r < 4; ++r) { const int kcol = kc0 + kt * 16 + fq * 4 + r; int dc = kcol - qcol + 15; dc = dc < 0 ? 0 : (dc > 30 ? 30 : dc);
                        bs[kt * 4 + r] = rpbs[hh * 465 + dr * 31 + dc]; }
#ifndef CPU_EMU
                asm volatile("" : "+v"(bs[0]), "+v"(bs[1]), "+v"(bs[2]), "+v"(bs[3]), "+v"(bs[4]), "+v"(bs[5]), "+v"(bs[6]), "+v"(bs[7]));
#endif
#pragma unroll
                for (int kt = 0; kt < 2; ++kt)
#pragma unroll
                    for (int r = 0; r < 4; ++r) { const int kcol = kc0 + kt * 16 + fq * 4 + r; const bool valid = (kcol >= cs) && (kcol < cs + 16);
                        const float v = valid ? (sa[u][kt][r] * 0.125f + bs[kt * 4 + r]) : -1e30f; sc[kt * 4 + r] = v; mx = fmaxf(mx, v); }
                mx = fmaxf(mx, shx<16>(mx)); mx = fmaxf(mx, shx<32>(mx));
                const float mn = fmaxf(m_run[u], mx); alpha[u] = __expf(m_run[u] - mn); m_run[u] = mn;
                float ps = 0.f; float pv[8];
#pragma unroll
                for (int j = 0; j < 8; ++j) { pv[j] = __expf(sc[j] - mn); ps += pv[j]; }
                ps += shx<16>(ps); ps += shx<32>(ps);
                l_run[u] = l_run[u] * alpha[u] + ps;
                u32x4 pk = {pack2(pv[0], pv[1]), pack2(pv[2], pv[3]), pack2(pv[4], pv[5]), pack2(pv[6], pv[7])};
                pf[u] = mk8(pk);
            }
#pragma unroll
            for (int mt = 0; mt < 4; ++mt) {
                const bf16_t* vp = Vsb + (kc0 + 4 * fq + tq4) * NA_VLD + hh * 64 + mt * 16 + 4 * tp4;
                const bf16x8 vf = mk8(TR16(vp), TR16(vp + 16 * NA_VLD));
                acc[0][mt] = mfma16(vf, pf[0], acc[0][mt] * alpha[0]); acc[1][mt] = mfma16(vf, pf[1], acc[1][mt] * alpha[1]); }
        } else {
            f32x4 sa[2][4];
#pragma unroll
            for (int kt = 0; kt < 4; ++kt) { sa[0][kt] = (f32x4){0.f, 0.f, 0.f, 0.f}; sa[1][kt] = (f32x4){0.f, 0.f, 0.f, 0.f};
#pragma unroll
                for (int ks = 0; ks < 2; ++ks) { const bf16x8 kf = *(const bf16x8*)(Ksb + (kt * 16 + tq) * NA_KLD + hh * 64 + ks * 32 + fq * 8);
                    sa[0][kt] = mfma16(kf, qf[0][ks], sa[0][kt]); sa[1][kt] = mfma16(kf, qf[1][ks], sa[1][kt]); } }
            float alpha[2]; bf16x8 pf[2][2];
#pragma unroll
            for (int u = 0; u < 2; ++u) {
                float mx = -1e30f;
#pragma unroll
                for (int kt = 0; kt < 4; ++kt)
#pragma unroll
                    for (int r = 0; r < 4; ++r) { sa[u][kt][r] *= 0.125f; mx = fmaxf(mx, sa[u][kt][r]); }
                mx = fmaxf(mx, shx<16>(mx)); mx = fmaxf(mx, shx<32>(mx));
                const float mn = fmaxf(m_run[u], mx); alpha[u] = __expf(m_run[u] - mn); m_run[u] = mn;
                float ps = 0.f;
#pragma unroll
                for (int kt = 0; kt < 4; ++kt)
#pragma unroll
                    for (int r = 0; r < 4; ++r) { sa[u][kt][r] = __expf(sa[u][kt][r] - mn); ps += sa[u][kt][r]; }
                ps += shx<16>(ps); ps += shx<32>(ps);
                l_run[u] = l_run[u] * alpha[u] + ps;
#pragma unroll
                for (int h2 = 0; h2 < 2; ++h2) {
                    u32x4 pk = {pack2(sa[u][2 * h2][0], sa[u][2 * h2][1]), pack2(sa[u][2 * h2][2], sa[u][2 * h2][3]), pack2(sa[u][2 * h2 + 1][0], sa[u][2 * h2 + 1][1]), pack2(sa[u][2 * h2 + 1][2], sa[u][2 * h2 + 1][3])};
                    pf[u][h2] = mk8(pk); }
            }
#pragma unroll
            for (int mt = 0; mt < 4; ++mt) { acc[0][mt] = acc[0][mt] * alpha[0]; acc[1][mt] = acc[1][mt] * alpha[1]; }
#pragma unroll
            for (int h2 = 0; h2 < 2; ++h2)
#pragma unroll
                for (int mt = 0; mt < 4; ++mt) { const bf16_t* vp = Vsb + (32 * h2 + 4 * fq + tq4) * NA_VLD + hh * 64 + mt * 16 + 4 * tp4;
                    const bf16x8 vf = mk8(TR16(vp), TR16(vp + 16 * NA_VLD));
                    acc[0][mt] = mfma16(vf, pf[0][h2], acc[0][mt]); acc[1][mt] = mfma16(vf, pf[1][h2], acc[1][mt]); }
        }
        }
    }
#undef NA_FETCH
#undef NA_SRC_ROWS
#pragma unroll
    for (int u = 0; u < 2; ++u) {
        const float il = frcp(l_run[u]);
        const size_t orow = ((size_t)sl << sd.lgseq) + qtok[u];
#pragma unroll
        for (int mt = 0; mt < 4; ++mt) { u32x2 o = {pack2(acc[u][mt][0] * il, acc[u][mt][1] * il), pack2(acc[u][mt][2] * il, acc[u][mt][3] * il)};
            stg((u32x2*)(p.Nb() + orow * 512 + head * 64 + mt * 16 + fq * 4), o); }
    }
}

DEV void mlstm_stepC_task(const Params& p, const SetDesc& sd, int layer, int task, char* shm) {
    const int tid = TID(), lane = tid & 63, w = tid >> 6, tq = lane & 15, fq = lane >> 4, tq4 = (lane & 15) >> 2, tp4 = lane & 3;
    const int tb = task % sd.ntb, h = (task / sd.ntb) & 3, sl = task / (sd.ntb * 4);
    const int row0 = (sl << sd.lgseq) + tb * 128; const bool latent = !sd.is_ctx; const int tl0 = tb * 128;
    bf16_t* Ks = (bf16_t*)shm;
    bf16_t* Vs = (bf16_t*)(shm + 128 * K_LD * 2);
    bf16_t* Cs = (bf16_t*)(shm + 128 * K_LD * 2 + 128 * V_LD * 2);
    float* ga = (float*)(shm + 128 * K_LD * 2 * 3 + 128 * V_LD * 2); float* gb = ga + 256; float* gpm = gb + 256; float* gtot = gpm + 256; float* tmp = gtot + 8;
    float* nvs = tmp + 16;
    float* cms = nvs + 128;
    const bf16_t* prow = proj_buf(p, sd) + (size_t)row0 * PWA;
    __syncthreads();
    gate_scan(prow, h, p.gate_bias + (size_t)layer * 16, ga, gb, gpm, gtot, tmp);
    {
        const int s = tid & 127, cpi = tid >> 7, cp = (cpi & 1) + (cpi >> 1) * 4;
        const bf16_t* hp = prow + (size_t)s * PWA + C_KM + h * 64;
        float k1[8], k2[8];
        load_rope_chunk(hp, cp, latent, tl0 + s, p.rope(), 1.0f, k1);
        load_rope_chunk(hp, cp + 2, latent, tl0 + s, p.rope(), 1.0f, k2);
        u32x4 o1 = {pack2(k1[0], k1[1]), pack2(k1[2], k1[3]), pack2(k1[4], k1[5]), pack2(k1[6], k1[7])};
        u32x4 o2 = {pack2(k2[0], k2[1]), pack2(k2[2], k2[3]), pack2(k2[4], k2[5]), pack2(k2[6], k2[7])};
        *(u32x4*)(Ks + s * K_LD + cp * 8) = o1; *(u32x4*)(Ks + s * K_LD + (cp + 2) * 8) = o2;
    }
#pragma unroll
    for (int it = 0; it < 4; ++it) { const int item = tid + it * 512, s = item >> 4, ch = item & 15;
        *(u32x4*)(Vs + s * V_LD + ch * 8) = ldg((const u32x4*)(prow + (size_t)s * PWA + C_VM + h * 128 + ch * 8)); }
#pragma unroll
    for (int it = 0; it < 4; ++it) { const int item = tid + it * 512, dir = item >> 10, rem = item & 1023, v = rem >> 3, ch = rem & 7;
        *(u32x4*)(Cs + (dir * 128 + v) * K_LD + ch * 8) = ldg((const u32x4*)(p.Cin() + (size_t)st_index(sd, sl, h, dir, tb) * 8192 + v * 64 + ch * 8)); }
    if (tid < 128) nvs[tid] = ldg(p.Cn() + (size_t)st_index(sd, sl, h, tid >> 6, tb) * 64 + (tid & 63));
    if (tid < 2) cms[tid] = ldg(p.Cm() + (size_t)st_index(sd, sl, h, tid, tb) * 4);
    bf16x8 qf[2]; float qv[2][8];
    {
        const int t = w * 16 + tq; const bf16_t* hp = prow + (size_t)t * PWA + C_QM + h * 64;
#pragma unroll
        for (int ks = 0; ks < 2; ++ks) { load_rope_chunk(hp, ks * 4 + fq, latent, tl0 + t, p.rope(), 0.125f, qv[ks]);
            u32x4 o = {pack2(qv[ks][0], qv[ks][1]), pack2(qv[ks][2], qv[ks][3]), pack2(qv[ks][4], qv[ks][5]), pack2(qv[ks][6], qv[ks][7])}; qf[ks] = mk8(o); }
    }
    __syncthreads();
    const int t = w * 16 + tq;
    f32x4 hsum[8];
#pragma unroll
    for (int mt = 0; mt < 8; ++mt) hsum[mt] = (f32x4){0.f, 0.f, 0.f, 0.f};
#pragma unroll
    for (int dir = 0; dir < 2; ++dir) {
        const float m_in = cms[dir];
        const float Mt = fmaxf(m_in, gpm[dir * 128 + t]);
        const float inter = __expf(m_in - Mt);
        const float mtot = gb[dir * 128 + t] + Mt;
        f32x4 acc[8];
#pragma unroll
        for (int mt = 0; mt < 8; ++mt) { acc[mt] = (f32x4){0.f, 0.f, 0.f, 0.f};
#pragma unroll
            for (int ks = 0; ks < 2; ++ks) { const bf16x8 cf = *(const bf16x8*)(Cs + (dir * 128 + mt * 16 + tq) * K_LD + ks * 32 + fq * 8);
                acc[mt] = mfma16(cf, qf[ks], acc[mt]); }
            acc[mt] = acc[mt] * inter; }
        float qn = 0.f;
#pragma unroll
        for (int ks = 0; ks < 2; ++ks)
#pragma unroll
            for (int j = 0; j < 8; ++j) qn += bf2f(f2bf(qv[ks][j])) * nvs[dir * 64 + ks * 32 + fq * 8 + j];
        qn += shx<16>(qn); qn += shx<32>(qn);
        float den = inter * qn;
        const int u_lo = dir == 0 ? 0 : (w >> 1), u_hi = dir == 0 ? (w >> 1) : 3;
        float rsum = 0.f;
        for (int u = u_lo; u <= u_hi; ++u) {
            unsigned pk[4];
#pragma unroll
            for (int kt = 0; kt < 2; ++kt) { f32x4 sa = {0.f, 0.f, 0.f, 0.f}; const int sb = 32 * u + 16 * kt;
#pragma unroll
                for (int ks = 0; ks < 2; ++ks) { const bf16x8 kf = *(const bf16x8*)(Ks + (sb + tq) * K_LD + ks * 32 + fq * 8); sa = mfma16(kf, qf[ks], sa); }
                float pv[4]; float gv4[4];
#pragma unroll
                for (int r = 0; r < 4; ++r) gv4[r] = ga[dir * 128 + sb + fq * 4 + r];
#ifndef CPU_EMU
                asm volatile("" : "+v"(gv4[0]), "+v"(gv4[1]), "+v"(gv4[2]), "+v"(gv4[3]));
#endif
#pragma unroll
                for (int r = 0; r < 4; ++r) { const int s = sb + fq * 4 + r; const bool valid = dir == 0 ? (s <= t) : (s >= t);
                    pv[r] = valid ? sa[r] * __expf(gv4[r] - Mt) : 0.f; pv[r] = bf2f(f2bf(pv[r])); rsum += pv[r]; }
                pk[kt * 2] = pack2(pv[0], pv[1]); pk[kt * 2 + 1] = pack2(pv[2], pv[3]); }
            u32x4 pkv = {pk[0], pk[1], pk[2], pk[3]}; const bf16x8 pf = mk8(pkv);
#pragma unroll
            for (int mt = 0; mt < 8; ++mt) { const bf16_t* vp = Vs + (32 * u + 4 * fq + tq4) * V_LD + mt * 16 + 4 * tp4;
                const bf16x8 vf = mk8(TR16(vp), TR16(vp + 16 * V_LD));
                acc[mt] = mfma16(vf, pf, acc[mt]); }
        }
        rsum += shx<16>(rsum); rsum += shx<32>(rsum);
        den += rsum;
        const float dn = frcp(fmaxf(fabsf(den), __expf(-mtot)));
#pragma unroll
        for (int mt = 0; mt < 8; ++mt) hsum[mt] = hsum[mt] + acc[mt] * dn;
    }
    float ss = 0.f;
#pragma unroll
    for (int mt = 0; mt < 8; ++mt)
#pragma unroll
        for (int r = 0; r < 4; ++r) ss += hsum[mt][r] * hsum[mt][r];
    ss += shx<16>(ss); ss += shx<32>(ss);
    const float rstd = rsqrtf(ss * (1.0f / 128.0f) + RMS_EPS);
#pragma unroll
    for (int mt = 0; mt < 8; ++mt) { const int v = mt * 16 + fq * 4;
        const u32x2 om = ldg((const u32x2*)(prow + (size_t)t * PWA + C_OM + h * 128 + v));
        u32x2 o = {pack2(hsum[mt][0] * rstd * sigmoidf_(lo16(om.x)), hsum[mt][1] * rstd * sigmoidf_(hi16(om.x))),
                   pack2(hsum[mt][2] * rstd * sigmoidf_(lo16(om.y)), hsum[mt][3] * rstd * sigmoidf_(hi16(om.y)))};
        stg((u32x2*)(p.Mb() + (size_t)(row0 + t) * 512 + h * 128 + v), o); }
}

struct SchedMerge {
    const bf16_t* Mb; const bf16_t* Pb; const bf16_t* Nb; const bf16_t* Wb; int nM;
    DEV bool next(int i, GUnit& u) const { u.aux = i % 3; return tile_order(i / 3, nM, 4, u.pm, u.pn); }
    DEV const bf16_t* a_base(const GUnit& u) const { return (u.aux == 0 ? Mb : (u.aux == 1 ? Pb : Nb)) + (size_t)u.pm * 256 * 512; }
    DEV const bf16_t* b_base(const GUnit& u) const { return Wb + ((size_t)u.aux * 1024 + u.pn * 256) * 512; }
    DEV int grow(const GUnit&, int) const { return 0; }
};
DEV void phase_merge(const Params& p, const SetDesc& sd, int layer, char* shm) {
    SchedMerge S; S.Mb = p.Mb(); S.Pb = p.Pb(); S.Nb = p.Nb(); S.Wb = p.WbT() + (size_t)layer * 3 * 1024 * 512; S.nM = sd.nrows / 256;
    const bf16_t* bgb = p.BG(); bf16_t* mgb = p.MERGED();
    gemm_stream<false, 512, 512, 512>(shm, S, [=](const GUnit& u, const f32x4 (&acc)[2][2][4][2], int r0, int c0) {
#pragma unroll
        for (int ai = 0; ai < 2; ++ai) {
            u32x4 gm[4][2], pr[4][2];
#pragma unroll
            for (int m = 0; m < 4; ++m)
#pragma unroll
                for (int hf = 0; hf < 2; ++hf) { const size_t r = (size_t)u.pm * 256 + r0 + ai * 128 + m * 16;
                    gm[m][hf] = ldg((const u32x4*)(bgb + r * NBG + u.aux * 1024 + u.pn * 256 + c0 + hf * 128));
                    if (u.aux > 0) pr[m][hf] = ldg((const u32x4*)(mgb + r * 1024 + u.pn * 256 + c0 + hf * 128)); else pr[m][hf] = (u32x4){0u, 0u, 0u, 0u}; }
#pragma unroll
            for (int m = 0; m < 4; ++m)
#pragma unroll
                for (int hf = 0; hf < 2; ++hf) { const size_t r = (size_t)u.pm * 256 + r0 + ai * 128 + m * 16;
                    const f32x4 x0 = acc[ai][hf][m][0], x1 = acc[ai][hf][m][1]; const u32x4 g = gm[m][hf], q = pr[m][hf];
                    u32x4 ov = {pack2(x0[0] * lo16(g.x) + lo16(q.x), x0[1] * hi16(g.x) + hi16(q.x)), pack2(x0[2] * lo16(g.y) + lo16(q.y), x0[3] * hi16(g.y) + hi16(q.y)),
                                pack2(x1[0] * lo16(g.z) + lo16(q.z), x1[1] * hi16(g.z) + hi16(q.z)), pack2(x1[2] * lo16(g.w) + lo16(q.w), x1[3] * hi16(g.w) + hi16(q.w))};
                    stg((u32x4*)(mgb + r * 1024 + u.pn * 256 + c0 + hf * 128), ov); }
        } });
}
DEV void phase_outproj(const Params& p, const SetDesc& sd, int layer, char* shm) {
    SchedPlain S; S.A = p.MERGED(); S.Bt = p.WoT() + (size_t)layer * 1024 * 1024; S.nM = sd.nrows / 256; S.nN = 4; S.lda256 = 256 * 1024; S.ldb256 = 256 * 1024;
    bf16_t* yb = p.Y();
    gemm_stream<false, 1024, 1024, 1024>(shm, S, [=](const GUnit& u, const f32x4 (&acc)[2][2][4][2], int r0, int c0) {
#pragma unroll
        for (int ai = 0; ai < 2; ++ai)
#pragma unroll
            for (int m = 0; m < 4; ++m) { bf16_t* o = yb + ((size_t)u.pm * 256 + r0 + ai * 128 + m * 16) * 1024 + u.pn * 256 + c0;
                store8bf(o, acc[ai][0][m][0], acc[ai][0][m][1]); store8bf(o + 128, acc[ai][1][m][0], acc[ai][1][m][1]); } });
}

DEV void phase_postmix(const Params& p, const SetDesc& sd, int layer, char* shm) {
    const int tid = TID(), lane = tid & 63, wv = tid >> 6;
    float* wr_s = (float*)shm;
    __syncthreads();
    for (int i = tid; i < 1024 * 16; i += NTHREADS) { const int c = i >> 4, e = i & 15, ln = (c & 511) >> 3, j = c & 7, hf = c >> 9;
        wr_s[((((hf * 8 + j) * 4 + (e >> 2)) * 64 + ln) << 2) + (e & 3)] = ldg(p.router_w + (size_t)layer * 1024 * 16 + i); }
    __syncthreads();
    const float* g1 = p.norm_gain + ((size_t)layer * 4 + 1) * 1024; const float* g2 = p.norm_gain + ((size_t)layer * 4 + 2) * 1024;
    float* par = (float*)(shm + 65536);
    { const int rpb0_ = (sd.nrows + (int)gridDim.x - 1) / (int)gridDim.x; const float* mdb = mod_row(p, sd, layer, min((int)blockIdx.x * rpb0_, sd.nrows - 1));
      stage_params(par, g1, g2, mdb + 2048, mdb + 3072, mdb + 4096); }
    __syncthreads();
    const float* xb = xsrc_base(p, sd, layer); float* xdb = xdst_base(p, sd);
    const int stride = 8; const int rpb_ = (sd.nrows + (int)gridDim.x - 1) / (int)gridDim.x; const int row_end = min(sd.nrows, ((int)blockIdx.x + 1) * rpb_);
    int row = (int)blockIdx.x * rpb_ + wv;
    u32x4 ycur[2], ynxt[2]; f32x4 xcur[4], xnxt[4];
    if (row < row_end) {
#pragma unroll
        for (int i = 0; i < 2; ++i) ycur[i] = ldg((const u32x4*)(p.Y() + (size_t)row * 1024 + i * 512 + lane * 8));
#pragma unroll
        for (int i = 0; i < 4; ++i) xcur[i] = ldg((const f32x4*)(xb + (size_t)row * 1024 + (i >> 1) * 512 + lane * 8 + (i & 1) * 4)); }
    for (; row < row_end; row += stride) {
        int ln = lane; HIDE(ln);
        const int rn = row + stride;
        if (rn < row_end) {
#pragma unroll
            for (int i = 0; i < 2; ++i) ynxt[i] = ldg((const u32x4*)(p.Y() + (size_t)rn * 1024 + i * 512 + ln * 8));
#pragma unroll
            for (int i = 0; i < 4; ++i) xnxt[i] = ldg((const f32x4*)(xb + (size_t)rn * 1024 + (i >> 1) * 512 + ln * 8 + (i & 1) * 4)); }
        float* xd = xdb + (size_t)row * 1024;
        const float* md = mod_row(p, sd, layer, row);
        float y[16]; float ss = 0.f;
#pragma unroll
        for (int hlf = 0; hlf < 2; ++hlf) { const u32x4 m = ycur[hlf];
            const float t8[8] = {lo16(m.x), hi16(m.x), lo16(m.y), hi16(m.y), lo16(m.z), hi16(m.z), lo16(m.w), hi16(m.w)};
#pragma unroll
            for (int j = 0; j < 8; ++j) { y[hlf * 8 + j] = t8[j]; ss += t8[j] * t8[j]; } }
        ss = wave_sum(ss);
        const float rstd = rsqrtf(ss * (1.0f / 1024.0f) + RMS_EPS);
        float xn[16]; float ss2 = 0.f;
#pragma unroll
        for (int hlf = 0; hlf < 2; ++hlf)
#pragma unroll
            for (int q = 0; q < 2; ++q) { const int c0 = hlf * 512 + ln * 8 + q * 4; const f32x4 xo = xcur[hlf * 2 + q]; f32x4 xw;
#pragma unroll
                for (int j = 0; j < 4; ++j) { const float v = xo[j] + par[2048 + c0 + j] * (y[hlf * 8 + q * 4 + j] * rstd * par[c0 + j]); xw[j] = v; xn[hlf * 8 + q * 4 + j] = v; ss2 += v * v; }
                stg((f32x4*)(xd + c0), xw); }
        ss2 = wave_sum(ss2);
        const float rstd2 = rsqrtf(ss2 * (1.0f / 1024.0f) + RMS_EPS);
        float lg[16];
#pragma unroll
        for (int e = 0; e < 16; ++e) lg[e] = 0.f;
#pragma unroll
        for (int hlf = 0; hlf < 2; ++hlf) { const int c0 = hlf * 512 + ln * 8; float o[8];
#pragma unroll
            for (int j = 0; j < 8; ++j) { o[j] = xn[hlf * 8 + j] * rstd2 * par[1024 + c0 + j] * (1.0f + par[4096 + c0 + j]) + par[3072 + c0 + j];
#pragma unroll
                for (int eq = 0; eq < 4; ++eq) { const f32x4 w4 = *(const f32x4*)(wr_s + ((((hlf * 8 + j) * 4 + eq) * 64 + ln) << 2));
#pragma unroll
                    for (int e = 0; e < 4; ++e) lg[eq * 4 + e] += o[j] * w4[e]; } }
            const u32x2 ov = {f8pack4(o[0], o[1], o[2], o[3]), f8pack4(o[4], o[5], o[6], o[7])};
            stg((u32x2*)((unsigned char*)p.H() + (size_t)row * 1024 + c0), ov); }
        float r8[8], r4[4], r2[2], r1;
        { const bool b = (lane & 32) != 0;
#pragma unroll
          for (int i = 0; i < 8; ++i) { const float keep = b ? lg[i + 8] : lg[i], send = b ? lg[i] : lg[i + 8]; r8[i] = keep + shx<32>(send); } }
        { const bool b = (lane & 16) != 0;
#pragma unroll
          for (int i = 0; i < 4; ++i) { const float keep = b ? r8[i + 4] : r8[i], send = b ? r8[i] : r8[i + 4]; r4[i] = keep + shx<16>(send); } }
        { const bool b = (lane & 8) != 0;
#pragma unroll
          for (int i = 0; i < 2; ++i) { const float keep = b ? r4[i + 2] : r4[i], send = b ? r4[i] : r4[i + 2]; r2[i] = keep + shx<8>(send); } }
        { const bool b = (lane & 4) != 0; const float keep = b ? r2[1] : r2[0], send = b ? r2[0] : r2[1]; r1 = keep + shx<4>(send); }
        r1 += shx<2>(r1); r1 += shx<1>(r1);
        float mx = r1;
        mx = fmaxf(mx, shx<4>(mx)); mx = fmaxf(mx, shx<8>(mx)); mx = fmaxf(mx, shx<16>(mx)); mx = fmaxf(mx, shx<32>(mx));
        const float ex = __expf(r1 - mx);
        float se = ex;
        se += shx<4>(se); se += shx<8>(se); se += shx<16>(se); se += shx<32>(se);
        if ((lane & 3) == 0) { const int e = ((lane >> 5) & 1) * 8 + ((lane >> 4) & 1) * 4 + ((lane >> 3) & 1) * 2 + ((lane >> 2) & 1);
            stg(p.aff() + (size_t)row * 16 + e, ex * frcp(se)); }
#pragma unroll
        for (int i = 0; i < 2; ++i) ycur[i] = ynxt[i];
#pragma unroll
        for (int i = 0; i < 4; ++i) xcur[i] = xnxt[i];
    }
}

DEV unsigned shxu(unsigned v, int m) {
    const float f = __uint_as_float(v); float r;
    switch (m) { case 1: r = shx<1>(f); break; case 2: r = shx<2>(f); break; case 4: r = shx<4>(f); break; case 8: r = shx<8>(f); break; case 16: r = shx<16>(f); break; default: r = shx<32>(f); break; }
    return __float_as_uint(r);
}
#define TK_CX(a_, b_, desc_) do { const unsigned long long x_ = key[a_], y_ = key[b_]; const bool sw_ = (desc_) ? (x_ < y_) : (x_ > y_); key[a_] = sw_ ? y_ : x_; key[b_] = sw_ ? x_ : y_; } while (0)
DEV void topk_task(const Params& p, const SetDesc& sd, int task, char* shm) {
    const int tid = TID();
    const int e = task & 15, sl = task >> 4;
    unsigned long long* buf = (unsigned long long*)shm;
    const int T = 1 << sd.lgseq, cap = sd.cap;
    const int rbase = sl << sd.lgseq;
    const bool active = tid * 4 < T;
    unsigned long long key[4];
    __syncthreads();
#pragma unroll
    for (int m = 0; m < 4; ++m) { const int i = tid * 4 + m; const float a = active ? ldg(p.aff() + (size_t)(rbase + i) * 16 + e) : 0.f;
        key[m] = ((unsigned long long)__float_as_uint(a) << 32) | (unsigned)(0xFFFFFFFFu - (unsigned)i); }
    for (int k = 2; k <= T; k <<= 1) {
        const bool desc4 = ((tid * 4) & k) == 0;
        for (int j = k >> 1; j >= 4; j >>= 1) {
            const int tj = j >> 2;
            unsigned long long pk[4];
            if (tj < 64) {
#pragma unroll
                for (int m = 0; m < 4; ++m) { const unsigned lo = shxu((unsigned)key[m], tj), hi = shxu((unsigned)(key[m] >> 32), tj); pk[m] = ((unsigned long long)hi << 32) | lo; }
            } else {
                __syncthreads();
                if (active) {
#pragma unroll
                    for (int m = 0; m < 4; ++m) buf[tid * 4 + m] = key[m]; }
                __syncthreads();
#pragma unroll
                for (int m = 0; m < 4; ++m) pk[m] = active ? buf[(tid ^ tj) * 4 + m] : 0ull;
            }
            const bool lower = (tid & tj) == 0; const bool takemax = desc4 == lower;
#pragma unroll
            for (int m = 0; m < 4; ++m) { const unsigned long long x = key[m], y = pk[m]; key[m] = takemax ? (x > y ? x : y) : (x < y ? x : y); }
        }
        if (k >= 4) { TK_CX(0, 2, desc4); TK_CX(1, 3, desc4); TK_CX(0, 1, desc4); TK_CX(2, 3, desc4); }
        else { TK_CX(0, 1, true); TK_CX(2, 3, false); }
    }
    const int sbase = e * sd.rpe + sl * cap;
    if (active) {
#pragma unroll
        for (int m = 0; m < 4; ++m) { const int i = tid * 4 + m; const unsigned long long kv = key[m]; const int tok = (int)(0xFFFFFFFFu - (unsigned)(kv & 0xFFFFFFFFu));
            const int row = rbase + tok;
            if (i < cap) { stg(p.slot_token() + sbase + i, row); stg(p.slot_gate() + sbase + i, __uint_as_float((unsigned)(kv >> 32))); stg(p.token_slots() + (size_t)row * 16 + e, sbase + i); }
            else stg(p.token_slots() + (size_t)row * 16 + e, -1); } }
    if (sl == 0) { const int used = sd.nsamp * cap;
        for (int i = used + tid; i < sd.rpe; i += NTHREADS) { stg(p.slot_token() + e * sd.rpe + i, 0); stg(p.slot_gate() + e * sd.rpe + i, 0.f); } }
}
#undef TK_CX

struct SchedMoe {
    const bf16_t* A; const int* st; const bf16_t* W; int nRT, rpe, nN, wstride;
    DEV bool next(int i, GUnit& u) const { int pmx, pn; if (!tile_order(i, 16 * nRT, nN, pmx, pn)) return false; u.pm = pmx % nRT; u.aux = pmx / nRT; u.pn = pn; return true; }
    DEV int slot0(const GUnit& u) const { return u.aux * rpe + u.pm * 256; }
    DEV const bf16_t* a_base(const GUnit&) const { return A; }
    DEV int grow(const GUnit& u, int i) const { return st ? ldg(st + slot0(u) + i) : slot0(u) + i; }
    DEV const bf16_t* b_base(const GUnit& u) const { return W + (size_t)u.aux * wstride + (size_t)u.pn * 256 * 512; }
};
DEV void phase_moe_gu(const Params& p, const SetDesc& sd, int layer, char* shm) {
    SchedMoe S; S.A = p.H(); S.st = p.slot_token(); S.W = p.WguT() + (size_t)layer * 16 * 2048 * 512; S.nRT = sd.rpe / 256; S.rpe = sd.rpe; S.nN = 8; S.wstride = 2048 * 512;
    unsigned char* hb = (unsigned char*)p.HID();
    gemm_stream<true, 512, 512, 512, true>(shm, S, [=](const GUnit& u, const f32x4 (&acc)[2][2][4][2], int r0, int c0) {
#pragma unroll
        for (int ai = 0; ai < 2; ++ai)
#pragma unroll
            for (int m = 0; m < 4; ++m) { f32x4 h0, h1; const f32x4 a0 = acc[ai][0][m][0] * F8_WINV, a1 = acc[ai][0][m][1] * F8_WINV, b0 = acc[ai][1][m][0] * F8_WINV, b1 = acc[ai][1][m][1] * F8_WINV;
#pragma unroll
                for (int j = 0; j < 4; ++j) { h0[j] = a0[j] * sigmoidf_(a0[j]) * b0[j]; h1[j] = a1[j] * sigmoidf_(a1[j]) * b1[j]; }
                const u32x2 hv = {f8pack4(h0[0], h0[1], h0[2], h0[3]), f8pack4(h1[0], h1[1], h1[2], h1[3])};
                stg((u32x2*)(hb + ((size_t)S.slot0(u) + r0 + ai * 128 + m * 16) * 1024 + u.pn * 128 + c0), hv); } });
}
DEV void phase_moe_down(const Params& p, const SetDesc& sd, int layer, char* shm) {
    SchedMoe S; S.A = p.HID(); S.st = nullptr; S.W = p.WdT() + (size_t)layer * 16 * 1024 * 512; S.nRT = sd.rpe / 256; S.rpe = sd.rpe; S.nN = 4; S.wstride = 1024 * 512;
    bf16_t* yb = p.YE(); const float* gt = p.slot_gate();
    gemm_stream<true, 512, 512, 512, true>(shm, S, [=](const GUnit& u, const f32x4 (&acc)[2][2][4][2], int r0, int c0) {
#pragma unroll
        for (int ai = 0; ai < 2; ++ai) {
            float gv[4];
#pragma unroll
            for (int m = 0; m < 4; ++m) gv[m] = ldg(gt + (size_t)S.slot0(u) + r0 + ai * 128 + m * 16) * F8_WINV;
#pragma unroll
            for (int m = 0; m < 4; ++m) { const size_t sl = (size_t)S.slot0(u) + r0 + ai * 128 + m * 16; const float g = gv[m];
                bf16_t* o = yb + sl * 1024 + u.pn * 256 + c0; store8bf(o, acc[ai][0][m][0] * g, acc[ai][0][m][1] * g); store8bf(o + 128, acc[ai][1][m][0] * g, acc[ai][1][m][1] * g); } } });
}

DEV void compact4(const int (&sl)[16], int (&c)[4], int& n) {
    n = 0; c[0] = -1; c[1] = -1; c[2] = -1; c[3] = -1;
#pragma unroll
    for (int e = 0; e < 16; ++e) if (sl[e] >= 0) { c[0] = (n == 0) ? sl[e] : c[0]; c[1] = (n == 1) ? sl[e] : c[1]; c[2] = (n == 2) ? sl[e] : c[2]; c[3] = (n == 3) ? sl[e] : c[3]; ++n; }
}
DEV void phase_combine(const Params& p, const SetDesc& sd, int layer, char* shm) {
    const int tid = TID(), lane = tid & 63, wv = tid >> 6;
    const float* g3 = p.norm_gain + ((size_t)layer * 4 + 3) * 1024;
    float* xdb = xdst_base(p, sd);
    const int stride = 8; const int rpb_ = (sd.nrows + (int)gridDim.x - 1) / (int)gridDim.x; const int row_end = min(sd.nrows, ((int)blockIdx.x + 1) * rpb_);
    int row = __builtin_amdgcn_readfirstlane((int)blockIdx.x * rpb_ + wv);
    float* par = (float*)shm;
    __syncthreads();
    { const float* mdb = mod_row(p, sd, layer, min((int)blockIdx.x * rpb_, sd.nrows - 1)); stage_params(par, g3, mdb + 5120, nullptr, nullptr, nullptr); }
    __syncthreads();
    int raw[16]; int cc[4], cn[4]; int nc = 0, nn = 0;
    u32x4 mc[4][2], mn[4][2]; f32x4 xc[4], xn[4];
#define CMB_SLOTS(r_) do { _Pragma("unroll") for (int e = 0; e < 16; ++e) raw[e] = ldg(p.token_slots() + (size_t)(r_) * 16 + e); } while (0)
#define CMB_DATA(r_, c_, n_, m_, x_) do { _Pragma("unroll") for (int k = 0; k < 4; ++k) { \
            if (k < (n_)) { const bf16_t* yr = p.YE() + (size_t)(c_)[k] * 1024 + lane * 8; (m_)[k][0] = ldg((const u32x4*)yr); (m_)[k][1] = ldg((const u32x4*)(yr + 512)); } \
            else { (m_)[k][0] = (u32x4){0u, 0u, 0u, 0u}; (m_)[k][1] = (u32x4){0u, 0u, 0u, 0u}; } } \
        _Pragma("unroll") for (int i = 0; i < 4; ++i) (x_)[i] = ldg((const f32x4*)(xdb + (size_t)(r_) * 1024 + (i >> 1) * 512 + lane * 8 + (i & 1) * 4)); } while (0)
    if (row < row_end) { CMB_SLOTS(row); compact4(raw, cc, nc); CMB_DATA(row, cc, nc, mc, xc); if (row + stride < row_end) CMB_SLOTS(row + stride); }
    for (; row < row_end; row += stride) {
        const int rn = row + stride;
        if (rn < row_end) { compact4(raw, cn, nn); CMB_DATA(rn, cn, nn, mn, xn); if (rn + stride < row_end) CMB_SLOTS(rn + stride); }
        float* xd = xdb + (size_t)row * 1024;
        float y[16];
#pragma unroll
        for (int j = 0; j < 16; ++j) y[j] = 0.f;
        if (nc <= 4) {
#pragma unroll
            for (int k = 0; k < 4; ++k)
                if (k < nc) {
#pragma unroll
                    for (int hlf = 0; hlf < 2; ++hlf) { const u32x4 m = mc[k][hlf];
                        y[hlf * 8 + 0] += lo16(m.x); y[hlf * 8 + 1] += hi16(m.x); y[hlf * 8 + 2] += lo16(m.y); y[hlf * 8 + 3] += hi16(m.y);
                        y[hlf * 8 + 4] += lo16(m.z); y[hlf * 8 + 5] += hi16(m.z); y[hlf * 8 + 6] += lo16(m.w); y[hlf * 8 + 7] += hi16(m.w); } }
        } else {
            for (int e = 0; e < 16; ++e) { const int sl_ = ldg(p.token_slots() + (size_t)row * 16 + e);
                if (sl_ >= 0) { const bf16_t* yr = p.YE() + (size_t)sl_ * 1024 + lane * 8;
#pragma unroll
                    for (int hlf = 0; hlf < 2; ++hlf) { const u32x4 m = ldg((const u32x4*)(yr + hlf * 512));
                        y[hlf * 8 + 0] += lo16(m.x); y[hlf * 8 + 1] += hi16(m.x); y[hlf * 8 + 2] += lo16(m.y); y[hlf * 8 + 3] += hi16(m.y);
                        y[hlf * 8 + 4] += lo16(m.z); y[hlf * 8 + 5] += hi16(m.z); y[hlf * 8 + 6] += lo16(m.w); y[hlf * 8 + 7] += hi16(m.w); } } }
        }
        float ss = 0.f;
#pragma unroll
        for (int j = 0; j < 16; ++j) ss += y[j] * y[j];
        ss = wave_sum(ss);
        const float rstd = rsqrtf(ss * (1.0f / 1024.0f) + RMS_EPS);
#pragma unroll
        for (int hlf = 0; hlf < 2; ++hlf)
#pragma unroll
            for (int q = 0; q < 2; ++q) { const int c0 = hlf * 512 + lane * 8 + q * 4; f32x4 xv = xc[hlf * 2 + q];
#pragma unroll
                for (int j = 0; j < 4; ++j) xv[j] += par[1024 + c0 + j] * (y[hlf * 8 + q * 4 + j] * rstd * par[c0 + j]);
                stg((f32x4*)(xd + c0), xv); }
        nc = nn;
#pragma unroll
        for (int k = 0; k < 4; ++k) { cc[k] = cn[k]; mc[k][0] = mn[k][0]; mc[k][1] = mn[k][1]; }
#pragma unroll
        for (int i = 0; i < 4; ++i) xc[i] = xn[i];
    }
#undef CMB_SLOTS
#undef CMB_DATA
}

constexpr int WQ_WORD0 = 4096;
template <class F> DEV void wq_run(const Params& p, int qidx, int ntasks, char* shm, F&& task) {
    unsigned* ctr = p.bar() + WQ_WORD0 + 64 * qidx;
    volatile int* slot = (volatile int*)(shm + 131072 + 64);
    const int tid = TID();
    int cur = blockIdx.x;
    while (cur < ntasks) {
        unsigned pend = 0u;
        if (tid == 0) pend = atomicAdd(ctr, 1u);
        task(cur);
        __syncthreads();
        if (tid == 0) *slot = (int)gridDim.x + (int)pend;
        __syncthreads();
        cur = *slot;
    }
}

template <int PH> DEV void do_phase(const Params& p, int layer, int is_ctx, int grp, char* shm) {
    const SetDesc sd = make_set(is_ctx, grp);
    if constexpr (PH == -1) phase_prologue(p, shm);
    if constexpr (PH == 0) phase_norm1(p, sd, layer, shm);
    if constexpr (PH == 1) phase_proj_a(p, sd, layer, shm);
    const int qbase = ((layer * 3 + (is_ctx ? 0 : grp + 1)) * 13 + (PH < 0 ? 0 : PH)) * 2;
    if constexpr (PH == 2) { wq_run(p, qbase, sd.nsamp * 4 * sd.ntb, shm, [&](int t) { mlstm_stepA_task(p, sd, layer, t, shm); }); if (!(is_ctx && layer == 1)) phase_pool(p, sd); }
    if constexpr (PH == 3) {
        for (int t = blockIdx.x; t < sd.nsamp * 32; t += gridDim.x) mlstm_stepB_task(p, sd, t);
        if (!(is_ctx && layer == 1)) {
            const int nq = (is_ctx ? (CTX / 64) : ROWS) / 2;
            wq_run(p, qbase, sd.nsamp * nq * 4, shm, [&](int t) { na_task(p, sd, layer, t / (nq * 4), (t >> 2) % nq, t & 3, shm); });
        }
    }
    if constexpr (PH == 4) { wq_run(p, qbase, sd.nsamp * 4 * sd.ntb, shm, [&](int t) { mlstm_stepC_task(p, sd, layer, t, shm); }); }
    if constexpr (PH == 5) phase_proj_b(p, sd, layer, shm);
    if constexpr (PH == 6) phase_merge(p, sd, layer, shm);
    if constexpr (PH == 7) phase_outproj(p, sd, layer, shm);
    if constexpr (PH == 8) phase_postmix(p, sd, layer, shm);
    if constexpr (PH == 9) { for (int t = blockIdx.x; t < sd.nsamp * 16; t += gridDim.x) topk_task(p, sd, t, shm); }
    if constexpr (PH == 10) phase_moe_gu(p, sd, layer, shm);
    if constexpr (PH == 11) phase_moe_down(p, sd, layer, shm);
    if constexpr (PH == 12) phase_combine(p, sd, layer, shm);
}

#ifndef CPU_EMU
template <int PH> __global__ void __launch_bounds__(NTHREADS, 2) k_phase(Params p, int layer, int is_ctx, int grp) {
    DYN_LDS(shm);
    do_phase<PH>(p, layer, is_ctx, grp, shm);
}
#ifndef DBL_MASK
#define DBL_MASK 0
#endif
#define RUNPH(PH) do { do_phase<PH>(p, layer, is_ctx, grp, shm); xcd_barrier(bar); if ((DBL_MASK >> (PH)) & 1) { do_phase<PH>(p, layer, is_ctx, grp, shm); xcd_barrier(bar); } } while (0)
__global__ void __launch_bounds__(NTHREADS, 2) k_mega(Params p) {
    DYN_LDS(shm);
    uint4* xbw = (uint4*)(shm + 131072);
    if (threadIdx.x == 0) *xbw = make_uint4(0u, 0u, 0u, 0u);
    __syncthreads();
    XcdBarrier bar = xcd_barrier_post(p.bar(), (volatile LAS unsigned*)xbw);
    do_phase<-1>(p, 0, 0, 0, shm);
    xcd_barrier(bar);
    for (int layer = 0; layer < 2; ++layer)
        for (int si = 0; si <= NG; ++si) {
            const int is_ctx = si == 0 ? 1 : 0, grp = si == 0 ? 0 : si - 1;
            RUNPH(0); RUNPH(1); RUNPH(2);
            if (is_ctx && layer == 1) { do_phase<3>(p, layer, is_ctx, grp, shm); continue; }
            RUNPH(3); RUNPH(4); RUNPH(5); RUNPH(6); RUNPH(7); RUNPH(8); RUNPH(9); RUNPH(10); RUNPH(11);
            do_phase<12>(p, layer, is_ctx, grp, shm);
        }
}
#endif
}

static Params make_params(void* const* d_in, void* d_out, void* d_ws) {
    Params p{};
    p.x = (const float*)d_in[0]; p.c = (const float*)d_in[1]; p.ctx = (const float*)d_in[2]; p.c_ctx = (const float*)d_in[3];
    p.norm_gain = (const float*)d_in[4]; p.ada_w = (const float*)d_in[5]; p.ada_b = (const float*)d_in[6]; p.w_in = (const float*)d_in[7];
    p.gate_bias = (const float*)d_in[8]; p.pool_w = (const float*)d_in[9]; p.pool_scale = (const float*)d_in[10]; p.rpb = (const float*)d_in[11];
    p.w_branch = (const float*)d_in[12]; p.w_out = (const float*)d_in[13]; p.router_w = (const float*)d_in[14];
    p.w_gate = (const float*)d_in[15]; p.w_up = (const float*)d_in[16]; p.w_down = (const float*)d_in[17];
    p.out = (float*)d_out; p.ws = (char*)d_ws;
    return p;
}

#ifdef CPU_EMU
int emu_cfg_B = CFG_B, emu_cfg_ROWS = CFG_ROWS, emu_cfg_CTX = CFG_CTX;
const char* g_dumpdir = "data";
static void* g_ws = nullptr;
static void dump_buf(const char* name, int layer, int is_ctx, int grp, const void* ptr, size_t bytes) {
    char nm[512]; snprintf(nm, sizeof nm, "%s/d_L%d_%s%d_%s.bin", g_dumpdir, layer, is_ctx ? "c" : "g", grp, name);
    FILE* f = fopen(nm, "wb"); fwrite(ptr, 1, bytes, f); fclose(f);
}
static void emu_hook(const Params& p, int layer, int is_ctx, int grp, int ph) {
    const size_t Rn = is_ctx ? RC : RL;
    if (ph == 0) dump_buf("H", layer, is_ctx, grp, p.H(), Rn * 1024 * 2);
    if (ph == 1) dump_buf("PROJ", layer, is_ctx, grp, is_ctx ? p.PROJc() : p.PROJa(), Rn * PWA * 2);
    if (ph == 2) dump_buf("Pb", layer, is_ctx, grp, p.Pb(), Rn * 512 * 2);
    if (ph == 3) dump_buf("Nb", layer, is_ctx, grp, p.Nb(), Rn * 512 * 2);
    if (ph == 4) dump_buf("Mb", layer, is_ctx, grp, p.Mb(), Rn * 512 * 2);
    if (ph == 5) dump_buf("BG", layer, is_ctx, grp, p.BG(), Rn * NBG * 2);
    if (ph == 6) dump_buf("MERGED", layer, is_ctx, grp, p.MERGED(), Rn * 1024 * 2);
    if (ph == 7) dump_buf("Y", layer, is_ctx, grp, p.Y(), Rn * 1024 * 2);
    if (ph == 8) { dump_buf("H2", layer, is_ctx, grp, p.H(), Rn * 1024 * 2); dump_buf("aff", layer, is_ctx, grp, p.aff(), Rn * 16 * 4); }
}
void emu_dump(const char* dir) {
    char nm[512]; snprintf(nm, sizeof nm, "%s/d_mod.bin", dir);
    FILE* f = fopen(nm, "wb"); fwrite((char*)g_ws + WSL.mod, 1, (size_t)2 * (NB + 1) * 6144 * 4, f); fclose(f);
    snprintf(nm, sizeof nm, "%s/d_ctxs.bin", dir);
    f = fopen(nm, "wb"); fwrite((char*)g_ws + WSL.ctxs, 1, (size_t)NB * CTX * 1024 * 4, f); fclose(f);
}
template <int PH> static void emu_run_phase(const Params& p, int layer, int is_ctx, int grp, int nblocks) {
    emu_launch_lambda([=]() { do_phase<PH>(p, layer, is_ctx, grp, emu_blk->smem); }, nblocks, NTHREADS, LDS_BYTES);
    if (PH >= 0) emu_hook(p, layer, is_ctx, grp, PH);
    printf("phase %d layer %d ctx %d grp %d done\n", PH, layer, is_ctx, grp); fflush(stdout);
}
#define LAUNCH_PHASE(PH) emu_run_phase<PH>(p, layer, is_ctx, grp, nblocks)
#else
#define LAUNCH_PHASE(PH) hipLaunchKernelGGL((k_phase<PH>), dim3(nblocks), dim3(NTHREADS), LDS_BYTES, stream, p, layer, is_ctx, grp)
#define SETATTR(PH) (void)hipFuncSetAttribute((const void*)k_phase<PH>, hipFuncAttributeMaxDynamicSharedMemorySize, LDS_BYTES)
#endif

extern "C" void kernel_launch(void* const* d_in, const int* in_sizes, int n_in, void* d_out, int out_size, void* d_ws, size_t ws_size, hipStream_t stream) {
    (void)in_sizes; (void)n_in; (void)out_size;
    if (ws_size < WSL.total) return;
    Params p = make_params(d_in, d_out, d_ws);
#ifdef CPU_EMU
    g_ws = d_ws;
    memset(d_ws, 0xFF, WSL.total);
    memset((char*)d_ws + WSL.bar, 0, 65536);
    const int nblocks = 16;
#else
    const int nblocks = 256;
#if MK_ONE_LAUNCH
    static int grid = 0;
    if (!grid) {
        (void)hipFuncSetAttribute((const void*)k_mega, hipFuncAttributeMaxDynamicSharedMemorySize, LDS_BYTES);
        int dev = 0, cus = 0, per_cu = 0;
        (void)hipGetDevice(&dev);
        (void)hipDeviceGetAttribute(&cus, hipDeviceAttributeMultiprocessorCount, dev);
        (void)hipOccupancyMaxActiveBlocksPerMultiprocessor(&per_cu, (const void*)k_mega, NTHREADS, LDS_BYTES);
        if (per_cu > 1) per_cu = 1;
        grid = cus * per_cu;
        if (grid > 256) grid = 256;
    }
    if (grid <= 0) return;
    (void)hipMemsetAsync(p.bar(), 0, 65536, stream);
    hipLaunchKernelGGL(k_mega, dim3(grid), dim3(NTHREADS), LDS_BYTES, stream, p);
    return;
#else
    static bool attr_done = false;
    if (!attr_done) { SETATTR(-1); SETATTR(0); SETATTR(1); SETATTR(2); SETATTR(3); SETATTR(4); SETATTR(5); SETATTR(6); SETATTR(7); SETATTR(8); SETATTR(9); SETATTR(10); SETATTR(11); SETATTR(12); attr_done = true; }
#endif
#endif
    { const int layer = 0, is_ctx = 0, grp = 0; LAUNCH_PHASE(-1); }
    for (int layer = 0; layer < 2; ++layer)
        for (int si = 0; si <= NG; ++si) {
            const int is_ctx = si == 0 ? 1 : 0, grp = si == 0 ? 0 : si - 1;
            LAUNCH_PHASE(0); LAUNCH_PHASE(1); LAUNCH_PHASE(2); LAUNCH_PHASE(3);
            if (is_ctx && layer == 1) continue;
            LAUNCH_PHASE(4); LAUNCH_PHASE(5); LAUNCH_PHASE(6); LAUNCH_PHASE(7); LAUNCH_PHASE(8); LAUNCH_PHASE(9); LAUNCH_PHASE(10); LAUNCH_PHASE(11); LAUNCH_PHASE(12);
        }
}
```

```cpp
#ifdef CPU_EMU
#include "emu.h"
#define DYN_LDS(p) char* p = emu_blk->smem
#define WAIT_V(n)
#define WAIT_L(n)
#define HIDE(v)
#define CBAR()
#else
#include <hip/hip_runtime.h>
#define DYN_LDS(p) extern __shared__ __attribute__((aligned(16))) char p[]
#define WAIT_V(n) asm volatile("s_waitcnt vmcnt(" #n ")" ::: "memory")
#define WAIT_L(n) asm volatile("s_waitcnt lgkmcnt(" #n ")" ::: "memory")
#define HIDE(v) asm volatile("" : "+v"(v))
#define CBAR() asm volatile("" ::: "memory")
#endif
#include <stdint.h>
#include <stddef.h>

#ifndef CFG_B
#define CFG_B 32
#define CFG_ROWS 32
#define CFG_CTX 256
#define CFG_G 16
#endif
#ifndef MK_ONE_LAUNCH
#define MK_ONE_LAUNCH 1
#endif

#define DEV __device__ __forceinline__
typedef short s16x4 __attribute__((ext_vector_type(4)));
#ifdef CPU_EMU
#define TR16(ptr) emu_tr16((const void*)(ptr))
#else
typedef __attribute__((address_space(3))) s16x4 lds_s16x4;
#define TR16(ptr) __builtin_amdgcn_ds_read_tr16_b64_v4i16((lds_s16x4*)(ptr))
#endif
#ifdef CPU_EMU
#define TID() (threadIdx.x)
#else
#define TID() ({ int t_ = threadIdx.x; asm volatile("" : "+v"(t_)); t_; })
#endif

typedef unsigned short bf16_t;
typedef short bf16x8 __attribute__((ext_vector_type(8)));
typedef float f32x4 __attribute__((ext_vector_type(4)));
typedef unsigned u32x2 __attribute__((ext_vector_type(2)));
typedef unsigned u32x4 __attribute__((ext_vector_type(4)));

namespace {
constexpr int D = 1024, NB = CFG_B, ROWS = CFG_ROWS, SEQ = ROWS * 64, CTX = CFG_CTX, G = CFG_G, NG = NB / G;
constexpr int RL = G * SEQ, RC = NB * CTX, RMAX = RL > RC ? RL : RC;
constexpr int PWA = 3840, NBG = 3072, PWT = PWA + NBG, PWSRC = 6672, C_SPLIT = 3600;
constexpr int C_QM = 0, C_KM = 256, C_VM = 512, C_OM = 1024, C_GM = 1536, C_PU = 1552, C_QN = 2064, C_KN = 2576, C_VN = 3088;
constexpr int NTBL = SEQ / 128, NTBC = CTX / 128;
constexpr int ilog2(int x) { return x <= 1 ? 0 : 1 + ilog2(x >> 1); }
constexpr int LGSEQ = ilog2(SEQ), LGCTX = ilog2(CTX);
static_assert((1 << LGSEQ) == SEQ && (1 << LGCTX) == CTX, "sequence lengths must be powers of two");
constexpr int cdiv(int a, int b) { return (a + b - 1) / b; }
constexpr int RPE_L = cdiv(G * (SEQ / 8), 256) * 256, RPE_C = cdiv(NB * (CTX / 8), 256) * 256, RPE_MAX = RPE_L > RPE_C ? RPE_L : RPE_C;
constexpr int NSLOT = 16 * RPE_MAX;
constexpr int NTHREADS = 512;
constexpr int GT_MAXU = 10;
constexpr int LDS_BYTES = 131072 + 256 + GT_MAXU * 1024;
constexpr int NST_L = G * 4 * 2 * NTBL, NST_C = NB * 4 * 2 * NTBC, NST = NST_L > NST_C ? NST_L : NST_C;
constexpr int NCI = NB * 4 * 2;
constexpr float RMS_EPS = 1e-6f;

struct WsLayout { size_t bar, WinT, WbT, WoT, WguT, WdT, mod, rope, ctxs, PROJc, CiC, Cin_, Cim, H, H8, PROJa, Sst, Cin, Mb, Pb, Nb, Sn, Ssc, Cn, Cm, aff, slot_token, slot_gate, token_slots, HID, YE, BG, MERGED, Y, total; };
constexpr size_t al(size_t x) { return (x + 255) / 256 * 256; }
constexpr size_t smax(size_t a, size_t b) { return a > b ? a : b; }
constexpr WsLayout make_layout() {
    WsLayout L{}; size_t o = 0;
    L.bar = o; o += al(65536);
    L.WinT = o; o += al((size_t)2 * PWT * 1024 * 2);
    L.WbT = o; o += al((size_t)2 * 3 * 1024 * 512 * 2);
    L.WoT = o; o += al((size_t)2 * 1024 * 1024 * 2);
    L.WguT = o; o += al((size_t)2 * 16 * 2048 * 1024 * 2);
    L.WdT = o; o += al((size_t)2 * 16 * 1024 * 1024 * 2);
    L.mod = o; o += al((size_t)2 * (NB + 1) * 6144 * 4);
    L.rope = o; o += al((size_t)(ROWS + 64) * 16 * 2 * 4);
    L.ctxs = o; o += al((size_t)NB * CTX * 1024 * 4);
    L.PROJc = o; o += al((size_t)RC * PWA * 2);
    L.CiC = o; o += al((size_t)NCI * 8192 * 4);
    L.Cin_ = o; o += al((size_t)NCI * 64 * 4);
    L.Cim = o; o += al((size_t)NCI * 4 * 4);
    L.H = o; o += al((size_t)RMAX * 1024 * 2);
    L.H8 = o; o += al((size_t)RMAX * 1024);
    const size_t x0 = o;
    L.PROJa = o; o += al((size_t)RMAX * PWA * 2);
    L.Sst = o; o += al((size_t)NST * 8192 * 4);
    L.Cin = o; o += al((size_t)NST * 8192 * 2);
    const size_t hid = al((size_t)NSLOT * 1024 * 2);
    o = x0 + smax(o - x0, 2 * hid);
    L.BG = x0; L.HID = x0; L.YE = x0 + hid;
    L.Mb = o; o += al((size_t)RMAX * 512 * 2);
    L.Pb = o; o += al((size_t)RMAX * 512 * 2);
    L.Nb = o; o += al((size_t)RMAX * 512 * 2);
    L.MERGED = L.H; L.Y = L.Mb;
    L.Sn = o; o += al((size_t)NST * 64 * 4);
    L.Ssc = o; o += al((size_t)NST * 4 * 4);
    L.Cn = o; o += al((size_t)NST * 64 * 4);
    L.Cm = o; o += al((size_t)NST * 4 * 4);
    L.aff = o; o += al((size_t)RMAX * 16 * 4);
    L.slot_token = o; o += al((size_t)NSLOT * 4);
    L.slot_gate = o; o += al((size_t)NSLOT * 4);
    L.token_slots = o; o += al((size_t)RMAX * 16 * 4);
    L.total = o;
    return L;
}
constexpr WsLayout WSL = make_layout();
static_assert((size_t)RMAX * NBG * 2 <= (size_t)RMAX * PWA * 2, "BG overlay must fit in PROJa");
static_assert(CFG_B != 32 || WSL.total <= ((size_t)1 << 30), "workspace budget");

struct Params {
    const float *x, *c, *ctx, *c_ctx, *norm_gain, *ada_w, *ada_b, *w_in, *gate_bias, *pool_w, *pool_scale, *rpb, *w_branch, *w_out, *router_w, *w_gate, *w_up, *w_down;
    float* out;
    char* ws;
#ifdef CPU_EMU
#define WSF(T, name) __device__ __host__ __forceinline__ T* name() const { return (T*)(ws + WSL.name); }
#else
#if defined(__HIP_DEVICE_COMPILE__)
#define WSF(T, name) __device__ __host__ __forceinline__ T* name() const { char* w_ = ws; asm volatile("" : "+s"(w_)); return (T*)(__attribute__((address_space(1))) T*)(w_ + WSL.name); }
#else
#define WSF(T, name) __device__ __host__ __forceinline__ T* name() const { return (T*)(ws + WSL.name); }
#endif
#endif
    WSF(unsigned, bar) WSF(bf16_t, WinT) WSF(bf16_t, WbT) WSF(bf16_t, WoT) WSF(bf16_t, WguT) WSF(bf16_t, WdT)
    WSF(float, mod) WSF(float, rope) WSF(float, ctxs) WSF(bf16_t, PROJc) WSF(float, CiC) WSF(float, Cin_) WSF(float, Cim)
    WSF(bf16_t, H) WSF(unsigned char, H8) WSF(bf16_t, PROJa) WSF(float, Sst) WSF(bf16_t, Cin) WSF(bf16_t, Mb) WSF(bf16_t, Pb) WSF(bf16_t, Nb)
    WSF(float, Sn) WSF(float, Ssc) WSF(float, Cn) WSF(float, Cm) WSF(float, aff) WSF(int, slot_token) WSF(float, slot_gate) WSF(int, token_slots)
    WSF(bf16_t, HID) WSF(bf16_t, YE) WSF(bf16_t, BG) WSF(bf16_t, MERGED) WSF(bf16_t, Y)
#undef WSF
};

struct SetDesc { int is_ctx, nrows, samp0, nsamp, lgseq, ntb, cap, rpe; };
DEV SetDesc make_set(int is_ctx, int grp) {
    SetDesc s;
    s.is_ctx = is_ctx;
    if (is_ctx) { s.nrows = RC; s.samp0 = 0; s.nsamp = NB; s.lgseq = LGCTX; s.ntb = NTBC; s.cap = CTX / 8; s.rpe = RPE_C; }
    else { s.nrows = RL; s.samp0 = grp * G; s.nsamp = G; s.lgseq = LGSEQ; s.ntb = NTBL; s.cap = SEQ / 8; s.rpe = RPE_L; }
    return s;
}

#ifdef CPU_EMU
#define GAS
#else
#define GAS __attribute__((address_space(1)))
#endif
template <class T> DEV T ldg(const T* p) { return *(const GAS T*)p; }
template <class T> DEV void stg(T* p, const T& v) { *(GAS T*)p = v; }
DEV float bf2f(bf16_t v) { return __uint_as_float(((unsigned)v) << 16); }
DEV bf16_t f2bf(float f) { unsigned u = __float_as_uint(f); u += 0x7FFFu + ((u >> 16) & 1u); return (bf16_t)(u >> 16); }
#if defined(__HIP_DEVICE_COMPILE__)
typedef __bf16 bf16n2 __attribute__((ext_vector_type(2)));
typedef float f32n2 __attribute__((ext_vector_type(2)));
DEV unsigned pack2(float lo, float hi) { f32n2 v = {lo, hi}; bf16n2 r = __builtin_convertvector(v, bf16n2); return __builtin_bit_cast(unsigned, r); }
#else
DEV unsigned pack2(float lo, float hi) { return (unsigned)f2bf(lo) | ((unsigned)f2bf(hi) << 16); }
#endif
DEV float lo16(unsigned u) { return __uint_as_float(u << 16); }
DEV float hi16(unsigned u) { return __uint_as_float(u & 0xFFFF0000u); }
#if defined(__HIP_DEVICE_COMPILE__)
DEV float frcp(float x) { return __builtin_amdgcn_rcpf(x); }
#else
DEV float frcp(float x) { return 1.0f / x; }
#endif
#if defined(__HIP_DEVICE_COMPILE__)
DEV float sigmoidf_(float x) { return __builtin_amdgcn_rcpf(1.0f + __expf(-x)); }
#else
DEV float sigmoidf_(float x) { return 1.0f / (1.0f + __expf(-x)); }
#endif
DEV float logsigmoidf_(float x) { return fminf(x, 0.0f) - __logf(1.0f + __expf(-fabsf(x))); }
template <int M> DEV float shx(float v) {
#if defined(__HIP_DEVICE_COMPILE__)
    const unsigned u = __builtin_bit_cast(unsigned, v);
    if constexpr (M == 1) return __builtin_bit_cast(float, __builtin_amdgcn_update_dpp(u, u, 0xB1, 0xF, 0xF, false));
    else if constexpr (M == 2) return __builtin_bit_cast(float, __builtin_amdgcn_update_dpp(u, u, 0x4E, 0xF, 0xF, false));
    else if constexpr (M == 4) { const unsigned t = __builtin_amdgcn_update_dpp(u, u, 0x141, 0xF, 0xF, false);
        return __builtin_bit_cast(float, __builtin_amdgcn_update_dpp(t, t, 0x1B, 0xF, 0xF, false)); }
    else if constexpr (M == 8) return __builtin_bit_cast(float, __builtin_amdgcn_update_dpp(u, u, 0x128, 0xF, 0xF, false));
    else if constexpr (M == 16) { const auto r = __builtin_amdgcn_permlane16_swap(u, u, false, false); return __builtin_bit_cast(float, (threadIdx.x & 16) ? r[0] : r[1]); }
    else { const auto r = __builtin_amdgcn_permlane32_swap(u, u, false, false); return __builtin_bit_cast(float, (threadIdx.x & 32) ? r[0] : r[1]); }
#else
    return __shfl_xor(v, M);
#endif
}
DEV float wave_sum(float v) { v += shx<32>(v); v += shx<16>(v); v += shx<8>(v); v += shx<4>(v); v += shx<2>(v); v += shx<1>(v); return v; }
DEV bf16x8 mk8(u32x2 lo, u32x2 hi) { u32x4 v = {lo.x, lo.y, hi.x, hi.y}; return __builtin_bit_cast(bf16x8, v); }
DEV bf16x8 mk8(u32x4 v) { return __builtin_bit_cast(bf16x8, v); }
DEV bf16x8 mk8(s16x4 lo, s16x4 hi) { return __builtin_shufflevector(lo, hi, 0, 1, 2, 3, 4, 5, 6, 7); }
DEV f32x4 mfma16(bf16x8 a, bf16x8 b, f32x4 c) { return __builtin_amdgcn_mfma_f32_16x16x32_bf16(a, b, c, 0, 0, 0); }
DEV unsigned f8enc1(float x) {
    const unsigned sgn = x < 0.f ? 0x80u : 0u; float a = x < 0.f ? -x : x; if (!(a < 448.f)) a = 448.f;
    if (a < 0.015625f) { const int q = (int)(a * 512.f + 0.5f); const float r = a * 512.f; int qq = q; if ((float)q - r == 0.5f && (q & 1)) qq = q - 1; return sgn | (unsigned)qq; }
    int e = 0; float m = a; while (m >= 2.f) { m *= 0.5f; ++e; } while (m < 1.f) { m *= 2.f; --e; }
    const float r = (m - 1.f) * 8.f; int q = (int)(r + 0.5f); if ((float)q - r == 0.5f && (q & 1)) --q;
    if (q == 8) { q = 0; ++e; }
    return sgn | (unsigned)((e + 7) << 3) | (unsigned)q;
}
#if defined(__HIP_DEVICE_COMPILE__)
DEV unsigned f8pack4(float a, float b, float c, float d) {
    a = __builtin_amdgcn_fmed3f(a, -448.f, 448.f); b = __builtin_amdgcn_fmed3f(b, -448.f, 448.f); c = __builtin_amdgcn_fmed3f(c, -448.f, 448.f); d = __builtin_amdgcn_fmed3f(d, -448.f, 448.f);
    int w = 0; w = __builtin_amdgcn_cvt_pk_fp8_f32(a, b, w, false); w = __builtin_amdgcn_cvt_pk_fp8_f32(c, d, w, true); return (unsigned)w; }
#else
DEV unsigned f8pack4(float a, float b, float c, float d) { return f8enc1(a) | (f8enc1(b) << 8) | (f8enc1(c) << 16) | (f8enc1(d) << 24); }
#endif
#ifdef CPU_EMU
DEV f32x4 mfma_f8(bf16x8 a0, bf16x8 a1, bf16x8 b0, bf16x8 b1, f32x4 c) { return emu_mfma_f8(a0, a1, b0, b1, c); }
#else
typedef int i32x4 __attribute__((ext_vector_type(4)));
typedef int i32x8 __attribute__((ext_vector_type(8)));
DEV f32x4 mfma_f8(bf16x8 a0, bf16x8 a1, bf16x8 b0, bf16x8 b1, f32x4 c) {
    const i32x8 A = __builtin_shufflevector(__builtin_bit_cast(i32x4, a0), __builtin_bit_cast(i32x4, a1), 0, 1, 2, 3, 4, 5, 6, 7);
    const i32x8 B = __builtin_shufflevector(__builtin_bit_cast(i32x4, b0), __builtin_bit_cast(i32x4, b1), 0, 1, 2, 3, 4, 5, 6, 7);
    return __builtin_amdgcn_mfma_scale_f32_16x16x128_f8f6f4(A, B, c, 0, 0, 0, 0, 0, 0);
}
#endif
constexpr float F8_WSCALE = 64.0f, F8_WINV = 1.0f / 64.0f;
DEV void store8bf(bf16_t* o, f32x4 a, f32x4 b) { u32x4 v = {pack2(a[0], a[1]), pack2(a[2], a[3]), pack2(b[0], b[1]), pack2(b[2], b[3])}; stg((u32x4*)o, v); }

#ifndef CPU_EMU
#define XB_TMO      128
#define XB_XCNT(j)  (256  + 64 * (j))
#define XB_XSUB(j)  (1280 + 64 * (j))
#define XB_XGEN(j)  (2304 + 64 * (j))
#define XB_TOP      3328
#define XB_TOPGEN   3392
#define XCD_BAR_WORDS 3456
#define XB_SPIN_CAP (1u << 18)
#define LAS __attribute__((address_space(3)))
__device__ __forceinline__ unsigned xb_ld(unsigned* p)              { return __hip_atomic_load(p, __ATOMIC_RELAXED, __HIP_MEMORY_SCOPE_AGENT); }
__device__ __forceinline__ unsigned xb_add(unsigned* p, unsigned v) { return __hip_atomic_fetch_add(p, v, __ATOMIC_RELAXED, __HIP_MEMORY_SCOPE_AGENT); }
__device__ __forceinline__ unsigned xb_xcc_id() { return (unsigned)__builtin_amdgcn_s_getreg((3 << 11) | 20) & 0xFu; }
#define XB_SPIN(cond, bar) do { unsigned _sp = 0; while (cond) { __builtin_amdgcn_s_sleep(1); \
    if ((++_sp & 255u) == 0u) { if (xb_ld(&(bar)[XB_TMO])) break; if (_sp > XB_SPIN_CAP) { atomicAdd(&(bar)[XB_TMO], 1u); break; } } } } while (0)
struct XcdBarrier { unsigned* bar; unsigned x; volatile LAS unsigned* st; };
__device__ __forceinline__ XcdBarrier xcd_barrier_post(unsigned* bar, volatile LAS unsigned* st) {
    XcdBarrier b; b.bar = bar; b.x = xb_xcc_id(); b.st = st;
    if (threadIdx.x == 0) (void)xb_add(&bar[XB_XCNT(b.x)], 1u);
    return b;
}
__device__ __forceinline__ void xcd_barrier_complete(unsigned* bar, unsigned x, unsigned& nloc, unsigned& nx) {
    const unsigned Gd = gridDim.x * gridDim.y * gridDim.z;
    unsigned sum, cnt, mine, sp = 0u;
    for (;;) {
        sum = 0u; cnt = 0u; mine = 0u;
#pragma unroll
        for (unsigned j = 0; j < 16; ++j) { const unsigned c = xb_ld(&bar[XB_XCNT(j)]); sum += c; cnt += (c > 0u) ? 1u : 0u; mine = (j == x) ? c : mine; }
        if (sum == Gd) break;
        __builtin_amdgcn_s_sleep(1);
        if ((++sp & 255u) == 0u) { if (xb_ld(&bar[XB_TMO])) break; if (sp > XB_SPIN_CAP) { atomicAdd(&bar[XB_TMO], 1u); break; } }
    }
    nloc = mine > 0u ? mine : 1u; nx = cnt > 0u ? cnt : 1u;
}
__device__ __forceinline__ void xcd_barrier(const XcdBarrier& b) {
    asm volatile("s_waitcnt vmcnt(0)" ::: "memory");
    __syncthreads();
    if (threadIdx.x == 0) {
        unsigned* bar = b.bar;
        unsigned bx = b.x; asm volatile("" : "+s"(bx));
        __builtin_amdgcn_s_waitcnt(0);
        unsigned nloc = b.st[0], nx = b.st[1];
        if (nloc == 0u) { xcd_barrier_complete(bar, bx, nloc, nx); b.st[0] = nloc; b.st[1] = nx; }
        const unsigned old = xb_add(&bar[XB_XSUB(bx)], 1u);
        const unsigned gen = old / nloc;
        if (old + 1u == (gen + 1u) * nloc) {
            __builtin_amdgcn_fence(__ATOMIC_RELEASE, "agent");
            asm volatile("s_waitcnt vmcnt(0)" ::: "memory");
            const unsigned og = xb_add(&bar[XB_TOP], 1u);
            const unsigned tg = og / nx;
            if (og + 1u == (tg + 1u) * nx) xb_add(&bar[XB_TOPGEN], 1u);
            else XB_SPIN(xb_ld(&bar[XB_TOPGEN]) == tg, bar);
            __builtin_amdgcn_fence(__ATOMIC_ACQUIRE, "agent");
            xb_add(&bar[XB_XGEN(bx)], 1u);
            asm volatile("s_waitcnt vmcnt(0)" ::: "memory");
        } else {
            XB_SPIN(xb_ld(&bar[XB_XGEN(bx)]) == gen, bar);
            __builtin_amdgcn_fence(__ATOMIC_ACQUIRE, "agent");
            asm volatile("s_waitcnt vmcnt(0)" ::: "memory");
        }
    }
    __syncthreads();
}
#endif

constexpr int BK = 64, HALF = 128, HT_BYTES = HALF * BK * 2;
DEV int lds_byte(int r, int c) { int st = (r >> 4) * 2 + (c >> 5), rr = r & 15, cc = c & 31, ob = rr * 64 + cc * 2; return st * 1024 + (ob ^ (((ob >> 9) & 1) << 5)); }
DEV void stage_rc(int b, int& Rr, int& Cc) { int st = b / 1024, sb = b % 1024, swz = sb ^ (((sb >> 9) & 1) << 5); Rr = (st >> 1) * 16 + swz / 64; Cc = (st & 1) * 32 + (swz % 64) / 2; }
DEV int perm32(int rho) { const int n = rho >> 4, i = rho & 15; return 8 * (i >> 2) + 4 * n + (i & 3); }

DEV bool tile_order(int i, int nM, int nN, int& pm, int& pn) {
    const int nwg = nM * nN; const int L = i * (int)gridDim.x + (int)blockIdx.x; if (L >= nwg) return false;
    int wgid = L; { const int q = nwg / 8, r = nwg % 8, xcd = wgid % 8, off = wgid / 8; wgid = (xcd < r ? xcd * (q + 1) : r * (q + 1) + (xcd - r) * q) + off; }
    const int nig = 8 * nN, gid = wgid / nig, fm = gid * 8, gsz = (nM - fm) < 8 ? (nM - fm) : 8;
    pm = fm + ((wgid % nig) % gsz); pn = (wgid % nig) / gsz; return true;
}
#ifdef CPU_EMU
#define GLDS16(src, dst) __builtin_amdgcn_global_load_lds((const unsigned*)(src), (unsigned*)((dst) + (TID() & 63) * 16), 16, 0, 0)
#else
#define GLDS16(src, dst) __builtin_amdgcn_global_load_lds((const unsigned*)(src), (unsigned*)(dst), 16, 0, 0)
#endif

#define BAR __builtin_amdgcn_s_barrier()
#define SCHED __builtin_amdgcn_sched_barrier(0)
struct GUnit { int pm, pn, aux; };
template <bool GATHER, int LDA_, int LDB_, int K_, bool F8 = false, class Sched, class Epi>
DEV void gemm_stream(char* shm, const Sched& S, const Epi& epi) {
#define SA(b, h) (shm + ((b) * 2 + (h)) * HT_BYTES)
#define SB(b, h) (shm + (4 + (b) * 2 + (h)) * HT_BYTES)
#define STG_B(P, bp) do { GLDS16((bp) + voffB, (P) + ldsb0); GLDS16((bp) + voffB + 64 * LDB_, (P) + ldsb0 + 8192); } while (0)
#define STG_A(P, ap, h, gv) do { if (GATHER) { GLDS16((ap) + gv[h][0], (P) + ldsb0); GLDS16((ap) + gv[h][1], (P) + ldsb0 + 8192); } \
    else { GLDS16((ap) + voffA + (h) * 128 * LDA_, (P) + ldsb0); GLDS16((ap) + voffA + ((h) * 128 + 64) * LDA_, (P) + ldsb0 + 8192); } } while (0)
#define LDA(dst, b, h) _Pragma("unroll") for (int m = 0; m < 4; ++m) _Pragma("unroll") for (int k = 0; k < 2; ++k) \
    dst[m][k] = *reinterpret_cast<const bf16x8*>(SA(b, h) + aoff + m * 2048 + k * 1024)
#define LDB(dst, b, h) _Pragma("unroll") for (int n = 0; n < 2; ++n) _Pragma("unroll") for (int k = 0; k < 2; ++k) \
    dst[n][k] = *reinterpret_cast<const bf16x8*>(SB(b, h) + boff + n * 2048 + k * 1024)
#define MMA(ai, bj, At_, Bx_) do { __builtin_amdgcn_s_setprio(1); \
    if constexpr (F8) { _Pragma("unroll") for (int m = 0; m < 4; ++m) _Pragma("unroll") for (int n = 0; n < 2; ++n) \
      acc[ai][bj][m][n] = mfma_f8(Bx_[n][0], Bx_[n][1], At_[m][0], At_[m][1], acc[ai][bj][m][n]); } \
    else { _Pragma("unroll") for (int m = 0; m < 4; ++m) _Pragma("unroll") for (int n = 0; n < 2; ++n) _Pragma("unroll") for (int k = 0; k < 2; ++k) \
      acc[ai][bj][m][n] = mfma16(Bx_[n][k], At_[m][k], acc[ai][bj][m][n]); } \
    __builtin_amdgcn_s_setprio(0); } while (0)
    constexpr int nt = K_ / BK;
    const int tid = TID();
    const int wid = __builtin_amdgcn_readfirstlane(tid >> 6), lane = tid & 63, wr = wid >> 2, wc = wid & 3, fr = lane & 15, fq = lane >> 4;
    const int ldsb0 = wid * 1024;
    int Rr0, Cc0; stage_rc(tid * 16, Rr0, Cc0);
    const int voffA = Rr0 * LDA_ + Cc0;
    const int voffB = ((Rr0 & ~31) + perm32(Rr0 & 31)) * LDB_ + Cc0;
    const int aoff = lds_byte(wr * 64 + fr, fq * 8), boff = lds_byte(wc * 32 + fr, fq * 8);
    GUnit cur, nxt; int ui = 0;
    if (!S.next(0, cur)) return;
    int gc[2][2] = {{0, 0}, {0, 0}};
    int* gtab = (int*)(shm + 131072 + 256);
    if (GATHER) {
        __syncthreads();
        { GUnit u; for (int i = 0; i < GT_MAXU && S.next(i, u); ++i) { if (tid < 256) gtab[i * 256 + tid] = S.grow(u, tid) * LDA_; } }
        __syncthreads();
#pragma unroll
        for (int h = 0; h < 2; ++h)
#pragma unroll
            for (int i = 0; i < 2; ++i) gc[h][i] = gtab[h * 128 + i * 64 + Rr0] + Cc0;
    }
    f32x4 acc[2][2][4][2];
#pragma unroll
    for (int a = 0; a < 2; ++a)
#pragma unroll
        for (int b = 0; b < 2; ++b)
#pragma unroll
            for (int m = 0; m < 4; ++m)
#pragma unroll
                for (int n = 0; n < 2; ++n) acc[a][b][m][n] = (f32x4){0.f, 0.f, 0.f, 0.f};
    bf16x8 At[4][2], B0[2][2], B1[2][2];
    const bf16_t* cA = S.a_base(cur); const bf16_t* cB = S.b_base(cur);
    STG_B(SB(0, 0), cB); STG_A(SA(0, 0), cA, 0, gc); STG_B(SB(0, 1), cB + 128 * LDB_); STG_A(SA(0, 1), cA, 1, gc);
    if (wr == 1) BAR;
    WAIT_V(4); BAR;
    STG_B(SB(1, 0), cB + BK); STG_A(SA(1, 0), cA + BK, 0, gc); STG_B(SB(1, 1), cB + 128 * LDB_ + BK);
    WAIT_V(6); BAR;
    for (;;) {
        const bool has_next = S.next(ui + 1, nxt);
        const bf16_t* nA = has_next ? S.a_base(nxt) : cA; const bf16_t* nB = has_next ? S.b_base(nxt) : cB;
#pragma unroll 1
        for (int t = 0; t < nt; t += 2) {
            const bool last = (t == nt - 2);
            const bf16_t* a1 = cA + (t + 1) * BK;
            const bf16_t* a2 = last ? nA : cA + (t + 2) * BK; const bf16_t* b2 = last ? nB : cB + (t + 2) * BK;
            const bf16_t* a3 = a2 + BK; const bf16_t* b3 = b2 + BK;
            LDB(B0, 0, 0); SCHED; LDA(At, 0, 0); STG_A(SA(1, 1), a1, 1, gc);
            if (GATHER && last && has_next) {
#pragma unroll
                for (int h = 0; h < 2; ++h)
#pragma unroll
                    for (int i = 0; i < 2; ++i) gc[h][i] = gtab[(ui + 1) * 256 + h * 128 + i * 64 + Rr0] + Cc0; }
            WAIT_L(8); BAR; WAIT_L(0); MMA(0, 0, At, B0); BAR; SCHED;
            LDB(B1, 0, 1); STG_B(SB(0, 0), b2);
            BAR; WAIT_L(0); MMA(0, 1, At, B1); BAR;
            LDA(At, 0, 1); STG_A(SA(0, 0), a2, 0, gc);
            BAR; WAIT_L(0); MMA(1, 0, At, B0); BAR; SCHED;
            STG_B(SB(0, 1), b2 + 128 * LDB_);
            WAIT_V(6); BAR; MMA(1, 1, At, B1); BAR;
            LDB(B0, 1, 0); SCHED; LDA(At, 1, 0); STG_A(SA(0, 1), a2, 1, gc);
            WAIT_L(8); BAR; WAIT_L(0); MMA(0, 0, At, B0); BAR; SCHED;
            LDB(B1, 1, 1); STG_B(SB(1, 0), b3);
            BAR; WAIT_L(0); MMA(0, 1, At, B1); BAR;
            LDA(At, 1, 1); STG_A(SA(1, 0), a3, 0, gc);
            BAR; WAIT_L(0); MMA(1, 0, At, B0); BAR; SCHED;
            STG_B(SB(1, 1), b3 + 128 * LDB_);
            WAIT_V(6); BAR; MMA(1, 1, At, B1); BAR;
        }
        {
            const int tz = TID(); const int wz = tz >> 6, lz = tz & 63, wrz = wz >> 2, wcz = wz & 3, frz = lz & 15, fqz = lz >> 4;
            epi(cur, acc, wrz * 64 + frz, wcz * 32 + 8 * fqz);
        }
        if (!has_next) break;
#pragma unroll
        for (int a = 0; a < 2; ++a)
#pragma unroll
            for (int b = 0; b < 2; ++b)
#pragma unroll
                for (int m = 0; m < 4; ++m)
#pragma unroll
                    for (int n = 0; n < 2; ++n) acc[a][b][m][n] = (f32x4){0.f, 0.f, 0.f, 0.f};
        cur = nxt; cA = nA; cB = nB; ++ui;
    }
    WAIT_V(0);
    if (wr == 0) BAR;
    BAR;
#undef SA
#undef SB
#undef STG_A
#undef STG_B
#undef LDA
#undef LDB
#undef MMA
}

constexpr int J_IN = 16 * 27, J_WB = 2 * 8 * 4, J_WO = 16 * 4, J_GU = 16 * 2 * 64, J_DN = 16 * 64, J_FOLD = 8 * 16, J_PAD = 1;
constexpr int N_MODJOBS = 2 * 96;

constexpr int J_BIG = J_IN + J_WB + J_WO + J_GU + J_DN;
struct WJob { const float* src; bf16_t* dst; int ldsrc, lddst, nvalid, k0, n0, mode, gu_which, f8; };
DEV WJob wjob_decode(const Params& p, int l, int j) {
    WJob w; w.ldsrc = 1024; w.lddst = 1024; w.nvalid = 256; w.mode = 0; w.gu_which = 0; w.f8 = 0;
    if (j < J_IN) { const int kt = j / 27, nb = j % 27; w.k0 = kt * 64; w.n0 = nb * 256; w.src = p.w_in + (size_t)l * 1024 * PWSRC; w.ldsrc = PWSRC; w.nvalid = PWSRC - w.n0; w.dst = p.WinT() + (size_t)l * PWT * 1024; w.mode = 3; }
    else if ((j -= J_IN) < J_WB) { const int bi = (j / 32) * 2, jj = j % 32, kt = jj / 4, nb = jj % 4; w.k0 = kt * 64; w.n0 = nb * 256;
        w.src = p.w_branch + ((size_t)l * 3 + bi) * 512 * 1024; w.dst = p.WbT() + ((size_t)l * 3 + bi) * 1024 * 512; w.lddst = 512; }
    else if ((j -= J_WB) < J_WO) { const int kt = j / 4, nb = j % 4; w.k0 = kt * 64; w.n0 = nb * 256; w.src = p.w_out + (size_t)l * 1024 * 1024; w.dst = p.WoT() + (size_t)l * 1024 * 1024; }
    else if ((j -= J_WO) < J_GU) { const int e = j / 128, jj = j % 128; w.gu_which = jj / 64; const int j3 = jj % 64, kt = j3 / 4, nb = j3 % 4; w.k0 = kt * 64; w.n0 = nb * 256;
        w.src = (w.gu_which ? p.w_up : p.w_gate) + ((size_t)l * 16 + e) * 1024 * 1024; w.dst = p.WguT() + ((size_t)l * 16 + e) * 2048 * 512; w.mode = 1; w.f8 = 1; }
    else { j -= J_GU; const int e = j / 64, jj = j % 64, kt = jj / 4, nb = jj % 4; w.k0 = kt * 64; w.n0 = nb * 256;
        w.src = p.w_down + ((size_t)l * 16 + e) * 1024 * 1024; w.dst = p.WdT() + ((size_t)l * 16 + e) * 1024 * 512; w.f8 = 1; }
    return w;
}
constexpr int WT_LD = 260;
DEV void wjob_load(const WJob& w, int tid, f32x4 (&vv)[8]) {
#pragma unroll
    for (int i = 0; i < 8; ++i) { const int idx = i * 512 + tid, r = idx >> 6, c = (idx & 63) * 4; int col = w.n0 + c; col = col > w.ldsrc - 4 ? w.ldsrc - 4 : col;
        vv[i] = ldg((const f32x4*)(w.src + (size_t)(w.k0 + r) * w.ldsrc + col)); }
}
DEV void wjob_finish(const WJob& w, int tid, const f32x4 (&vv)[8], float* tile) {
    __syncthreads();
#pragma unroll
    for (int i = 0; i < 8; ++i) { const int idx = i * 512 + tid, r = idx >> 6, c = (idx & 63) * 4; *(f32x4*)(tile + r * WT_LD + c) = vv[i]; }
    __syncthreads();
#pragma unroll
    for (int q = 0; q < 4; ++q) {
        const int item = q * 512 + tid, nrow = item >> 3, kc = (item & 7) * 8;
        float v[8];
#pragma unroll
        for (int jj = 0; jj < 8; ++jj) v[jj] = tile[(kc + jj) * WT_LD + nrow];
        const int n = w.n0 + nrow;
        int drow = n;
        if (w.mode == 1) drow = (n >> 7) * 256 + w.gu_which * 128 + (n & 127);
        if (w.mode == 3) drow = n + (n >= C_SPLIT ? (PWA - C_SPLIT) : 0);
        if (w.f8 || (w.mode == 3 && n >= C_SPLIT)) { const u32x2 o = {f8pack4(v[0] * F8_WSCALE, v[1] * F8_WSCALE, v[2] * F8_WSCALE, v[3] * F8_WSCALE), f8pack4(v[4] * F8_WSCALE, v[5] * F8_WSCALE, v[6] * F8_WSCALE, v[7] * F8_WSCALE)};
            if (nrow < w.nvalid) stg((u32x2*)((unsigned char*)(w.dst + (w.f8 ? 0 : (size_t)PWA * 1024)) + (size_t)(w.f8 ? drow : n - C_SPLIT) * 1024 + w.k0 + kc), o); }
        else if (nrow < w.nvalid) { u32x4 o = {pack2(v[0], v[1]), pack2(v[2], v[3]), pack2(v[4], v[5]), pack2(v[6], v[7])};
            stg((u32x4*)(w.dst + (size_t)drow * w.lddst + w.k0 + kc), o); }
    }
}
DEV void pro_small_job(const Params& p, int l, int j, char* shm) {
    float* tile = (float*)shm;
    const int tid = TID();
    if (j < J_FOLD) {
        const int kt = j / 16, ntl = j % 16, k0 = kt * 64, n0 = ntl * 64; const int fg = k0 / 128;
        const float* wb1 = p.w_branch + ((size_t)l * 3 + 1) * 512 * 1024;
        const float* pw = p.pool_w + ((size_t)l * 4 + fg) * 128 * 128; const float* ps = p.pool_scale + (size_t)l * 512 + fg * 128;
        const int c = tid & 63, rq = tid >> 6;
        float accv[8];
#pragma unroll
        for (int i = 0; i < 8; ++i) accv[i] = 0.f;
        for (int d = 0; d < 128; ++d) { const float wv = ldg(wb1 + (size_t)(fg * 128 + d) * 1024 + n0 + c) * ldg(ps + d);
#pragma unroll
            for (int i = 0; i < 8; ++i) accv[i] += ldg(pw + (size_t)(k0 - fg * 128 + rq * 8 + i) * 128 + d) * wv; }
        __syncthreads();
#pragma unroll
        for (int i = 0; i < 8; ++i) tile[(rq * 8 + i) * WT_LD + c] = accv[i];
        __syncthreads();
        const int nrow = tid >> 3, kc = (tid & 7) * 8; float v[8];
#pragma unroll
        for (int jj = 0; jj < 8; ++jj) v[jj] = tile[(kc + jj) * WT_LD + nrow];
        u32x4 o = {pack2(v[0], v[1]), pack2(v[2], v[3]), pack2(v[4], v[5]), pack2(v[6], v[7])};
        stg((u32x4*)(p.WbT() + ((size_t)l * 3 + 1) * 1024 * 512 + (size_t)(n0 + nrow) * 512 + k0 + kc), o);
    } else {
        bf16_t* d0 = p.WinT() + (size_t)l * PWT * 1024 + (size_t)C_SPLIT * 1024;
        for (int i = tid; i < (PWA - C_SPLIT) * 1024 / 8; i += NTHREADS) stg((u32x4*)(d0 + (size_t)i * 8), (u32x4){0u, 0u, 0u, 0u});
    }
}

DEV void pro_mod_job(const Params& p, int job, char* shm) {
    float* sv = (float*)shm;
    const int tid = TID(), l = job / 96, col0 = (job % 96) * 64;
    const int c = tid & 63, kp = tid >> 6;
    float acc[NB + 1];
#pragma unroll
    for (int v = 0; v <= NB; ++v) acc[v] = 0.f;
    for (int half = 0; half < 2; ++half) {
        __syncthreads();
        for (int idx = tid; idx < (NB + 1) * 512; idx += 512) { const int v = idx >> 9, k = idx & 511;
            const float s = (v < NB) ? ldg(p.c + (size_t)v * 1024 + half * 512 + k) : ldg(p.c_ctx + half * 512 + k);
            sv[idx] = s * sigmoidf_(s); }
        __syncthreads();
        for (int kk = 0; kk < 64; ++kk) { const int k = kp * 64 + kk;
            const float w = ldg(p.ada_w + ((size_t)l * 1024 + half * 512 + k) * 6144 + col0 + c);
#pragma unroll
            for (int v = 0; v <= NB; ++v) acc[v] += sv[v * 512 + k] * w; }
    }
    __syncthreads();
    float* red = (float*)shm;
#pragma unroll
    for (int v = 0; v <= NB; ++v) red[(kp * (NB + 1) + v) * 64 + c] = acc[v];
    __syncthreads();
    for (int idx = tid; idx < (NB + 1) * 64; idx += 512) { const int v = idx >> 6, cc = idx & 63; float s = 0.f;
#pragma unroll
        for (int q = 0; q < 8; ++q) s += red[(q * (NB + 1) + v) * 64 + cc];
        stg(p.mod() + ((size_t)l * (NB + 1) + v) * 6144 + col0 + cc, s + ldg(p.ada_b + (size_t)l * 6144 + col0 + cc)); }
}

DEV void phase_prologue(const Params& p, char* shm) {
    const int tid = TID();
    const int nsmall = N_MODJOBS + 1 + 2 * (J_FOLD + J_PAD);
    for (int job = blockIdx.x; job < nsmall; job += gridDim.x) {
        if (job < N_MODJOBS) pro_mod_job(p, job, shm);
        else if (job == N_MODJOBS) {
            for (int idx = tid; idx < (ROWS + 64) * 16; idx += NTHREADS) { const int pos = idx >> 4, i = idx & 15;
                const float pv = (float)(pos < ROWS ? pos : pos - ROWS);
                const float inv = powf(10000.0f, -(float)(2 * i) / 32.0f);
                const float a = pv * inv; stg(p.rope() + idx * 2, cosf(a)); stg(p.rope() + idx * 2 + 1, sinf(a)); }
        } else { const int sj = job - N_MODJOBS - 1; pro_small_job(p, sj / (J_FOLD + J_PAD), sj % (J_FOLD + J_PAD), shm); }
    }
    float* tile = (float*)shm;
    const int nbig = 2 * J_BIG;
    int job = blockIdx.x;
    if (job >= nbig) return;
    WJob wc = wjob_decode(p, job / J_BIG, job % J_BIG), wn = wc;
    f32x4 vc[8], vn[8];
    wjob_load(wc, tid, vc);
    for (; job < nbig; job += gridDim.x) {
        const int jn = job + gridDim.x;
        if (jn < nbig) { wn = wjob_decode(p, jn / J_BIG, jn % J_BIG); wjob_load(wn, tid, vn); }
        wjob_finish(wc, tid, vc, tile);
        wc = wn;
#pragma unroll
        for (int i = 0; i < 8; ++i) vc[i] = vn[i];
    }
}

DEV const float* xsrc_base(const Params& p, const SetDesc& sd, int layer) {
    return (sd.is_ctx ? (layer == 0 ? p.ctx : (const float*)p.ctxs()) : (layer == 0 ? p.x : (const float*)p.out)) + (((size_t)sd.samp0) << sd.lgseq) * 1024;
}
DEV float* xdst_base(const Params& p, const SetDesc& sd) { return (sd.is_ctx ? p.ctxs() : p.out) + (((size_t)sd.samp0) << sd.lgseq) * 1024; }
DEV const float* mod_row(const Params& p, const SetDesc& sd, int layer, int row) {
    return p.mod() + ((size_t)layer * (NB + 1) + (sd.is_ctx ? NB : sd.samp0 + (row >> sd.lgseq))) * 6144;
}
DEV bf16_t* proj_buf(const Params& p, const SetDesc& sd) { return sd.is_ctx ? p.PROJc() : p.PROJa(); }

DEV void stage_params(float* par, const float* v0, const float* v1, const float* v2, const float* v3, const float* v4) {
    const int tid = TID();
    const float* src[5] = {v0, v1, v2, v3, v4};
#pragma unroll
    for (int k = 0; k < 5; ++k) if (src[k]) { for (int i = tid; i < 1024; i += NTHREADS) par[k * 1024 + i] = ldg(src[k] + i); }
}
DEV void phase_norm1(const Params& p, const SetDesc& sd, int layer, char* shm) {
    const int tid = TID(), lane = tid & 63, wv = tid >> 6;
    const float* g0 = p.norm_gain + ((size_t)layer * 4 + 0) * 1024;
    const float* xb = xsrc_base(p, sd, layer);
    const int stride = 8; const int rpb_ = (sd.nrows + (int)gridDim.x - 1) / (int)gridDim.x; const int row_end = min(sd.nrows, ((int)blockIdx.x + 1) * rpb_);
    int row = (int)blockIdx.x * rpb_ + wv;
    float* par = (float*)shm;
    __syncthreads();
    { const float* mdb = mod_row(p, sd, layer, min((int)blockIdx.x * rpb_, sd.nrows - 1)); stage_params(par, g0, mdb, mdb + 1024, nullptr, nullptr); }
    __syncthreads();
    f32x4 cur[4], nxt[4];
    if (row < row_end) {
#pragma unroll
        for (int i = 0; i < 4; ++i) cur[i] = ldg((const f32x4*)(xb + (size_t)row * 1024 + (i >> 1) * 512 + lane * 8 + (i & 1) * 4)); }
    for (; row < row_end; row += stride) {
        const int rn = row + stride;
        if (rn < row_end) {
#pragma unroll
            for (int i = 0; i < 4; ++i) nxt[i] = ldg((const f32x4*)(xb + (size_t)rn * 1024 + (i >> 1) * 512 + lane * 8 + (i & 1) * 4)); }
        const float* md = mod_row(p, sd, layer, row);
        float ss = 0.f;
#pragma unroll
        for (int i = 0; i < 4; ++i)
#pragma unroll
            for (int j = 0; j < 4; ++j) ss += cur[i][j] * cur[i][j];
        ss = wave_sum(ss);
        const float rstd = rsqrtf(ss * (1.0f / 1024.0f) + RMS_EPS);
#pragma unroll
        for (int hlf = 0; hlf < 2; ++hlf) { const int c0 = hlf * 512 + lane * 8; float o[8];
#pragma unroll
            for (int j = 0; j < 8; ++j) o[j] = cur[hlf * 2 + (j >> 2)][j & 3] * rstd * par[c0 + j] * (1.0f + par[2048 + c0 + j]) + par[1024 + c0 + j];
            u32x4 ov = {pack2(o[0], o[1]), pack2(o[2], o[3]), pack2(o[4], o[5]), pack2(o[6], o[7])};
            stg((u32x4*)(p.H() + (size_t)row * 1024 + c0), ov);
            const u32x2 o8 = {f8pack4(o[0], o[1], o[2], o[3]), f8pack4(o[4], o[5], o[6], o[7])};
            stg((u32x2*)(p.H8() + (size_t)row * 1024 + c0), o8); }
#pragma unroll
        for (int i = 0; i < 4; ++i) cur[i] = nxt[i];
    }
}

struct SchedPlain {
    const bf16_t* A; const bf16_t* Bt; int nM, nN, lda256, ldb256;
    DEV bool next(int i, GUnit& u) const { u.aux = 0; return tile_order(i, nM, nN, u.pm, u.pn); }
    DEV const bf16_t* a_base(const GUnit& u) const { return A + (size_t)u.pm * lda256; }
    DEV const bf16_t* b_base(const GUnit& u) const { return Bt + (size_t)u.pn * ldb256; }
    DEV int grow(const GUnit&, int) const { return 0; }
};
struct SchedPlainT : SchedPlain {
    DEV const bf16_t* a_base(const GUnit&) const { return A; }
    DEV int grow(const GUnit& u, int i) const { return u.pm * 256 + i; }
};
DEV void phase_proj_a(const Params& p, const SetDesc& sd, int layer, char* shm) {
    SchedPlain S; S.A = p.H(); S.Bt = p.WinT() + (size_t)layer * PWT * 1024; S.nM = sd.nrows / 256; S.nN = PWA / 256; S.lda256 = 256 * 1024; S.ldb256 = 256 * 1024;
    bf16_t* pb = proj_buf(p, sd);
    gemm_stream<false, 1024, 1024, 1024>(shm, S, [=](const GUnit& u, const f32x4 (&acc)[2][2][4][2], int r0, int c0) {
#pragma unroll
        for (int ai = 0; ai < 2; ++ai)
#pragma unroll
            for (int m = 0; m < 4; ++m) { bf16_t* o = pb + ((size_t)u.pm * 256 + r0 + ai * 128 + m * 16) * PWA + u.pn * 256 + c0;
                store8bf(o, acc[ai][0][m][0], acc[ai][0][m][1]); store8bf(o + 128, acc[ai][1][m][0], acc[ai][1][m][1]); } });
}
DEV f32x4 sig4(f32x4 v) { f32x4 r; r[0] = sigmoidf_(v[0]); r[1] = sigmoidf_(v[1]); r[2] = sigmoidf_(v[2]); r[3] = sigmoidf_(v[3]); return r; }
DEV void phase_proj_b(const Params& p, const SetDesc& sd, int layer, char* shm) {
    SchedPlainT S; S.A = (const bf16_t*)p.H8(); S.Bt = p.WinT() + (size_t)layer * PWT * 1024 + (size_t)PWA * 1024; S.nM = sd.nrows / 256; S.nN = NBG / 256; S.lda256 = 256 * 512; S.ldb256 = 256 * 512;
    bf16_t* bg = p.BG();
    gemm_stream<true, 512, 512, 512, true>(shm, S, [=](const GUnit& u, const f32x4 (&acc)[2][2][4][2], int r0, int c0) {
#pragma unroll
        for (int ai = 0; ai < 2; ++ai)
#pragma unroll
            for (int m = 0; m < 4; ++m) { bf16_t* o = bg + ((size_t)u.pm * 256 + r0 + ai * 128 + m * 16) * NBG + u.pn * 256 + c0;
                store8bf(o, sig4(acc[ai][0][m][0] * F8_WINV), sig4(acc[ai][0][m][1] * F8_WINV)); store8bf(o + 128, sig4(acc[ai][1][m][0] * F8_WINV), sig4(acc[ai][1][m][1] * F8_WINV)); } });
}

DEV void gate_scan(const bf16_t* prow, int h, const float* gbias, float* ga, float* gb, float* gpm, float* gtot, float* tmp) {
    const int tid = TID(), lane = tid & 63, w = tid >> 6;
    float b = 0.f, a = 0.f, pm = 0.f; int d = 0, tok = 0;
    if (tid < 256) {
        d = tid >> 7; const int i = tid & 127; tok = d ? 127 - i : i;
        const float gi = bf2f(ldg(prow + (size_t)tok * PWA + C_GM + (2 * d) * 4 + h)) + ldg(gbias + (2 * d) * 4 + h);
        const float gf = bf2f(ldg(prow + (size_t)tok * PWA + C_GM + (2 * d + 1) * 4 + h)) + ldg(gbias + (2 * d + 1) * 4 + h);
        b = logsigmoidf_(gf);
#pragma unroll
        for (int o = 1; o < 64; o <<= 1) { const float t = __shfl_up(b, o); if (lane >= o) b += t; }
        if (lane == 63) tmp[w] = b;
        a = gi;
    }
    __syncthreads();
    if (tid < 256) {
        if (w & 1) b += tmp[w - 1];
        a -= b; pm = a;
#pragma unroll
        for (int o = 1; o < 64; o <<= 1) { const float t = __shfl_up(pm, o); if (lane >= o) pm = fmaxf(pm, t); }
        if (lane == 63) tmp[8 + w] = pm;
    }
    __syncthreads();
    if (tid < 256) {
        if (w & 1) pm = fmaxf(pm, tmp[8 + w - 1]);
        ga[d * 128 + tok] = a; gb[d * 128 + tok] = b; gpm[d * 128 + tok] = pm;
        if ((tid & 127) == 127) { gtot[d * 2] = b; gtot[d * 2 + 1] = pm; }
    }
    __syncthreads();
}

DEV void load_rope_chunk(const bf16_t* hp, int cidx, bool latent, int tl, const float* rope, float scale, float* o) {
    const u32x4 m = ldg((const u32x4*)(hp + cidx * 8));
    float x[8] = {lo16(m.x), hi16(m.x), lo16(m.y), hi16(m.y), lo16(m.z), hi16(m.z), lo16(m.w), hi16(m.w)};
    if (latent) {
        const u32x4 q = ldg((const u32x4*)(hp + (cidx ^ 2) * 8));
        const float y[8] = {lo16(q.x), hi16(q.x), lo16(q.y), hi16(q.y), lo16(q.z), hi16(q.z), lo16(q.w), hi16(q.w)};
        const int pos = (cidx < 4) ? (tl >> 6) : (ROWS + (tl & 63));
        const float* tb = rope + ((size_t)pos * 16 + (cidx & 1) * 8) * 2;
        const bool first = (cidx & 2) == 0;
#pragma unroll
        for (int j = 0; j < 8; ++j) { const float cs = ldg(tb + j * 2), sn = ldg(tb + j * 2 + 1);
            x[j] = first ? (x[j] * cs - y[j] * sn) : (x[j] * cs + y[j] * sn); }
    }
#pragma unroll
    for (int j = 0; j < 8; ++j) o[j] = x[j] * scale;
}

DEV int st_index(const SetDesc& sd, int sl, int h, int dir, int tb) { return ((sl * 4 + h) * 2 + dir) * sd.ntb + tb; }

constexpr int V_LD = 144, K_LD = 72, KS_LD = 80;
DEV void mlstm_stepA_task(const Params& p, const SetDesc& sd, int layer, int task, char* shm) {
    const int tid = TID(), lane = tid & 63, w = tid >> 6, fr = lane & 15, fq = lane >> 4, tq4 = (lane & 15) >> 2, tp4 = lane & 3;
    const int tb = task % sd.ntb, h = (task / sd.ntb) & 3, sl = task / (sd.ntb * 4);
    const int row0 = (sl << sd.lgseq) + tb * 128; const bool latent = !sd.is_ctx; const int tl0 = tb * 128;
    bf16_t* Vs = (bf16_t*)shm;
    bf16_t* Ksc = (bf16_t*)(shm + 128 * V_LD * 2);
    float* ga = (float*)(shm + 128 * V_LD * 2 + 2 * 128 * KS_LD * 2); float* gb = ga + 256; float* gpm = gb + 256; float* gtot = gpm + 256; float* tmp = gtot + 8;
    const bf16_t* prow = proj_buf(p, sd) + (size_t)row0 * PWA;
    __syncthreads();
    gate_scan(prow, h, p.gate_bias + (size_t)layer * 16, ga, gb, gpm, gtot, tmp);
    {
        const int s = tid & 127, cpi = tid >> 7, cp = (cpi & 1) + (cpi >> 1) * 4;
        const bf16_t* hp = prow + (size_t)s * PWA + C_KM + h * 64;
        float k1[8], k2[8];
        load_rope_chunk(hp, cp, latent, tl0 + s, p.rope(), 1.0f, k1);
        load_rope_chunk(hp, cp + 2, latent, tl0 + s, p.rope(), 1.0f, k2);
#pragma unroll
        for (int dir = 0; dir < 2; ++dir) { const float ws = __expf(ga[dir * 128 + s] - gtot[dir * 2 + 1]);
            u32x4 o1 = {pack2(k1[0] * ws, k1[1] * ws), pack2(k1[2] * ws, k1[3] * ws), pack2(k1[4] * ws, k1[5] * ws), pack2(k1[6] * ws, k1[7] * ws)};
            u32x4 o2 = {pack2(k2[0] * ws, k2[1] * ws), pack2(k2[2] * ws, k2[3] * ws), pack2(k2[4] * ws, k2[5] * ws), pack2(k2[6] * ws, k2[7] * ws)};
            *(u32x4*)(Ksc + (dir * 128 + s) * KS_LD + cp * 8) = o1; *(u32x4*)(Ksc + (dir * 128 + s) * KS_LD + (cp + 2) * 8) = o2; }
    }
#pragma unroll
    for (int it = 0; it < 4; ++it) { const int item = tid + it * 512, s = item >> 4, ch = item & 15;
        *(u32x4*)(Vs + s * V_LD + ch * 8) = ldg((const u32x4*)(prow + (size_t)s * PWA + C_VM + h * 128 + ch * 8)); }
    __syncthreads();
    f32x4 acc[2][4];
#pragma unroll
    for (int dir = 0; dir < 2; ++dir)
#pragma unroll
        for (int n = 0; n < 4; ++n) acc[dir][n] = (f32x4){0.f, 0.f, 0.f, 0.f};
#pragma unroll
    for (int ks = 0; ks < 4; ++ks) {
        const bf16_t* vp = Vs + (32 * ks + 4 * fq + tq4) * V_LD + w * 16 + 4 * tp4;
        const bf16x8 af = mk8(TR16(vp), TR16(vp + 16 * V_LD));
#pragma unroll
        for (int dir = 0; dir < 2; ++dir)
#pragma unroll
            for (int n = 0; n < 4; ++n) { const bf16_t* kp = Ksc + (dir * 128 + 32 * ks + 4 * fq + tq4) * KS_LD + n * 16 + 4 * tp4;
                const bf16x8 bfv = mk8(TR16(kp), TR16(kp + 16 * KS_LD));
                acc[dir][n] = mfma16(af, bfv, acc[dir][n]); }
    }
#pragma unroll
    for (int dir = 0; dir < 2; ++dir) { float* So = p.Sst() + (size_t)st_index(sd, sl, h, dir, tb) * 8192;
#pragma unroll
        for (int n = 0; n < 4; ++n)
#pragma unroll
            for (int r = 0; r < 4; ++r) stg(So + (w * 16 + fq * 4 + r) * 64 + n * 16 + fr, (float)acc[dir][n][r]); }
    if (tid < 128) { const int dir = tid >> 6, dd = tid & 63; float sm = 0.f;
        for (int i = 0; i < 128; ++i) sm += bf2f(Ksc[(dir * 128 + i) * KS_LD + dd]);
        stg(p.Sn() + (size_t)st_index(sd, sl, h, dir, tb) * 64 + dd, sm); }
    if (tid < 2) { float* sc = p.Ssc() + (size_t)st_index(sd, sl, h, tid, tb) * 4; stg(sc, gtot[tid * 2]); stg(sc + 1, gtot[tid * 2] + gtot[tid * 2 + 1]); }
}

template <int GI> DEV void pool_group(const Params& p, const SetDesc& sd, const bf16_t* pb) {
    constexpr int W = 2 << GI;
    const int nitems = sd.nrows * 16; const int T = 1 << sd.lgseq;
    for (int item = blockIdx.x * NTHREADS + TID(); item < nitems; item += gridDim.x * NTHREADS) {
        const int row = item >> 4, ch = GI * 128 + (item & 15) * 8;
        const int tt = row & (T - 1);
        u32x4 mv[W]; int cnt = 0; bool okv[W];
#pragma unroll
        for (int q = 0; q < W; ++q) { const int t2 = tt - W / 2 + q; const bool ok = (t2 >= 0) && (t2 < T); cnt += ok ? 1 : 0; okv[q] = ok;
            mv[q] = ldg((const u32x4*)(pb + (size_t)(ok ? (row - W / 2 + q) : row) * PWA + C_PU + ch)); }
        float s[8];
#pragma unroll
        for (int j = 0; j < 8; ++j) s[j] = 0.f;
#pragma unroll
        for (int q = 0; q < W; ++q) { u32x4 m = mv[q]; if (!okv[q]) m = (u32x4){0u, 0u, 0u, 0u};
            s[0] += lo16(m.x); s[1] += hi16(m.x); s[2] += lo16(m.y); s[3] += hi16(m.y); s[4] += lo16(m.z); s[5] += hi16(m.z); s[6] += lo16(m.w); s[7] += hi16(m.w); }
        const float inv = frcp((float)cnt);
        const u32x4 m = mv[W / 2];
        const float u[8] = {lo16(m.x), hi16(m.x), lo16(m.y), hi16(m.y), lo16(m.z), hi16(m.z), lo16(m.w), hi16(m.w)};
        u32x4 o = {pack2(s[0] * inv - u[0], s[1] * inv - u[1]), pack2(s[2] * inv - u[2], s[3] * inv - u[3]), pack2(s[4] * inv - u[4], s[5] * inv - u[5]), pack2(s[6] * inv - u[6], s[7] * inv - u[7])};
        stg((u32x4*)(p.Pb() + (size_t)row * 512 + ch), o);
    }
}
DEV void phase_pool(const Params& p, const SetDesc& sd) {
    const bf16_t* pb = proj_buf(p, sd);
    pool_group<0>(p, sd, pb); pool_group<1>(p, sd, pb); pool_group<2>(p, sd, pb); pool_group<3>(p, sd, pb);
}

template <int NC> DEV void mlstm_stepB_run(const Params& p, const SetDesc& sd, int task) {
    const int tid = TID();
    const int q = task & 3, dir = (task >> 2) & 1, h = (task >> 3) & 3, sl = task >> 5;
    const int ci = ((sd.samp0 + sl) * 4 + h) * 2 + dir;
    const int eoff = q * 2048 + tid * 4;
    float zr = 0.f; HIDE(zr);
    f32x4 C = {zr, zr, zr, zr}; float nv = 0.f; float m = -1e30f;
    f32x4 Sv[NC]; float blv[NC], mlv[NC], snv[NC];
#pragma unroll
    for (int c = 0; c < NC; ++c) { const int tb = dir ? NC - 1 - c : c; const size_t si = st_index(sd, sl, h, dir, tb);
        Sv[c] = ldg((const f32x4*)(p.Sst() + si * 8192 + eoff)); blv[c] = ldg(p.Ssc() + si * 4); mlv[c] = ldg(p.Ssc() + si * 4 + 1);
        snv[c] = (q == 0 && tid < 64) ? ldg(p.Sn() + si * 64 + tid) : 0.f; }
    if (!sd.is_ctx) { C = ldg((const f32x4*)(p.CiC() + (size_t)ci * 8192 + eoff)); if (q == 0 && tid < 64) nv = ldg(p.Cin_() + (size_t)ci * 64 + tid); m = ldg(p.Cim() + (size_t)ci * 4); }
#pragma unroll
    for (int c = 0; c < NC; ++c) {
        const int tb = dir ? NC - 1 - c : c; const size_t si = st_index(sd, sl, h, dir, tb);
        u32x2 o = {pack2(C[0], C[1]), pack2(C[2], C[3])};
        stg((u32x2*)(p.Cin() + si * 8192 + eoff), o);
        if (q == 0 && tid < 64) stg(p.Cn() + si * 64 + tid, nv);
        if (q == 0 && tid == 0) stg(p.Cm() + si * 4, m);
        const float mn = fmaxf(blv[c] + m, mlv[c]);
        const float dc = __expf(blv[c] + m - mn), wsn = __expf(mlv[c] - mn);
        C = C * dc + Sv[c] * wsn;
        nv = nv * dc + snv[c] * wsn;
        m = mn;
    }
    if (sd.is_ctx) { stg((f32x4*)(p.CiC() + (size_t)ci * 8192 + eoff), C); if (q == 0 && tid < 64) stg(p.Cin_() + (size_t)ci * 64 + tid, nv); if (q == 0 && tid == 0) stg(p.Cim() + (size_t)ci * 4, m); }
}
DEV void mlstm_stepB_task(const Params& p, const SetDesc& sd, int task) {
    if (sd.is_ctx) mlstm_stepB_run<NTBC>(p, sd, task); else mlstm_stepB_run<NTBL>(p, sd, task);
}

constexpr int NA_KLD = 136, NA_VLD = 144;
DEV void na_task(const Params& p, const SetDesc& sd, int layer, int sl, int rq2  , int hp, char* shm) {
    const int tid = TID(), lane = tid & 63, w = tid >> 6, tq = lane & 15, fq = lane >> 4, tq4 = (lane & 15) >> 2, tp4 = lane & 3;
    const int hh = w >> 2, g = w & 3, head = hp * 2 + hh;
    const bool ctxq = sd.is_ctx;
    bf16_t* Ks = (bf16_t*)shm;
    bf16_t* Vs = (bf16_t*)(shm + 128 * NA_KLD * 2);
    float* rpbs = (float*)(shm + 128 * NA_KLD * 2 + 128 * NA_VLD * 2);
    const int sample = sd.samp0 + sl;
    const bf16_t* pq = proj_buf(p, sd) + ((size_t)sl << sd.lgseq) * PWA;
    const bf16_t* pc = p.PROJc() + (size_t)sample * CTX * PWA;
    const int qcol = g * 16 + tq;
    int rqv[2], rsv[2], qtok[2];
#pragma unroll
    for (int u = 0; u < 2; ++u) { rqv[u] = 2 * rq2 + u; qtok[u] = rqv[u] * 64 + qcol; int r_ = rqv[u] - 4; rsv[u] = r_ < 0 ? 0 : (r_ > ROWS - 8 ? ROWS - 8 : r_); }
    const int nloc = ctxq ? 0 : (rsv[1] + 8 - rsv[0]);
    const int nstage = nloc + CTX / 64;
    __syncthreads();
    if (!ctxq) for (int i = tid; i < 2 * 465; i += NTHREADS) rpbs[i] = ldg(p.rpb + ((size_t)layer * 8 + hp * 2 + i / 465) * 465 + i % 465);
    bf16x8 qf[2][2];
#pragma unroll
    for (int u = 0; u < 2; ++u)
#pragma unroll
        for (int ks = 0; ks < 2; ++ks) qf[u][ks] = mk8(ldg((const u32x4*)(pq + (size_t)qtok[u] * PWA + C_QN + head * 64 + ks * 32 + fq * 8)));
    float m_run[2] = {-1e30f, -1e30f}, l_run[2] = {0.f, 0.f};
    f32x4 acc[2][4];
#pragma unroll
    for (int u = 0; u < 2; ++u)
#pragma unroll
        for (int mt = 0; mt < 4; ++mt) acc[u][mt] = (f32x4){0.f, 0.f, 0.f, 0.f};
    int cs = qcol - 8; cs = cs < 0 ? 0 : (cs > 48 ? 48 : cs);
    const int kc0 = (g == 0) ? 0 : (g == 1) ? 8 : (g == 2) ? 24 : 32;
    const int npair = (nstage + 1) >> 1;
    u32x4 kreg[4], vreg[4];
#define NA_SRC_ROWS(stg) (((stg) < nloc) ? (pq + (size_t)((rsv[0] + (stg)) * 64) * PWA) : (pc + (size_t)((((stg) < nstage ? (stg) : nstage - 1) - nloc) * 64) * PWA))
#define NA_FETCH(sp_) do { _Pragma("unroll") for (int it = 0; it < 4; ++it) { const int item = tid + it * 512, key2 = item >> 4, ch = item & 15; \
        const bf16_t* kb_ = NA_SRC_ROWS(2 * (sp_) + (key2 >> 6)); const bf16_t* src = kb_ + (size_t)(key2 & 63) * PWA + hp * 128 + ch * 8; \
        kreg[it] = ldg((const u32x4*)(src + C_KN)); vreg[it] = ldg((const u32x4*)(src + C_VN)); } } while (0)
    NA_FETCH(0);
    for (int sp = 0; sp < npair; ++sp) {
        __syncthreads();
#pragma unroll
        for (int it = 0; it < 4; ++it) { const int item = tid + it * 512, key2 = item >> 4, ch = item & 15;
            *(u32x4*)(Ks + key2 * NA_KLD + ch * 8) = kreg[it]; *(u32x4*)(Vs + key2 * NA_VLD + ch * 8) = vreg[it]; }
        if (sp + 1 < npair) NA_FETCH(sp + 1);
        __syncthreads();
#pragma unroll
        for (int sub = 0; sub < 2; ++sub) {
        const int st = 2 * sp + sub;
        if (st >= nstage) continue;
        const bool local = st < nloc;
        const bf16_t* Ksb = Ks + sub * 64 * NA_KLD; const bf16_t* Vsb = Vs + sub * 64 * NA_VLD;
        if (local) {
            const int kr = rsv[0] + st;
            f32x4 sa[2][2];
#pragma unroll
            for (int kt = 0; kt < 2; ++kt) { sa[0][kt] = (f32x4){0.f, 0.f, 0.f, 0.f}; sa[1][kt] = (f32x4){0.f, 0.f, 0.f, 0.f};
#pragma unroll
                for (int ks = 0; ks < 2; ++ks) { const bf16x8 kf = *(const bf16x8*)(Ksb + (kc0 + kt * 16 + tq) * NA_KLD + hh * 64 + ks * 32 + fq * 8);
                    sa[0][kt] = mfma16(kf, qf[0][ks], sa[0][kt]); sa[1][kt] = mfma16(kf, qf[1][ks], sa[1][kt]); } }
            float alpha[2]; bf16x8 pf[2];
#pragma unroll
            for (int u = 0; u < 2; ++u) {
                const bool act = (kr >= rsv[u]) && (kr < rsv[u] + 8);
                if (!act) { alpha[u] = 1.0f; pf[u] = mk8((u32x4){0u, 0u, 0u, 0u}); continue; }
                const int dr = kr - rqv[u] + 7;
                float sc[8]; float mx = -1e30f; float bs[8];
#pragma unroll
                for (int kt = 0; kt < 2; ++kt)
#pragma unroll
                    for (int r = 0; r < 4; ++r) { const int kcol = kc0 + kt * 16 + fq * 4 + r; int dc = kcol - qcol + 15; dc = dc < 0 ? 0 : (dc > 30 ? 30 : dc);
                        bs[kt * 4 + r] = rpbs[hh * 465 + dr * 31 + dc]; }
#ifndef CPU_EMU
                asm volatile("" : "+v"(bs[0]), "+v"(bs[1]), "+v"(bs[2]), "+v"(bs[3]), "+v"(bs[4]), "+v"(bs[5]), "+v"(bs[6]), "+v"(bs[7]));
#endif
#pragma unroll
                for (int kt = 0; kt < 2; ++kt)
#pragma unroll
                    for (int r = 0; r < 4; ++r) { const int kcol = kc0 + kt * 16 + fq * 4 + r; const bool valid = (kcol >= cs) && (kcol < cs + 16);
                        const float v = valid ? (sa[u][kt][r] * 0.125f + bs[kt * 4 + r]) : -1e30f; sc[kt * 4 + r] = v; mx = fmaxf(mx, v); }
                mx = fmaxf(mx, shx<16>(mx)); mx = fmaxf(mx, shx<32>(mx));
                const float mn = fmaxf(m_run[u], mx); alpha[u] = __expf(m_run[u] - mn); m_run[u] = mn;
                float ps = 0.f; float pv[8];
#pragma unroll
                for (int j = 0; j < 8; ++j) { pv[j] = __expf(sc[j] - mn); ps += pv[j]; }
                ps += shx<16>(ps); ps += shx<32>(ps);
                l_run[u] = l_run[u] * alpha[u] + ps;
                u32x4 pk = {pack2(pv[0], pv[1]), pack2(pv[2], pv[3]), pack2(pv[4], pv[5]), pack2(pv[6], pv[7])};
                pf[u] = mk8(pk);
            }
#pragma unroll
            for (int mt = 0; mt < 4; ++mt) {
                const bf16_t* vp = Vsb + (kc0 + 4 * fq + tq4) * NA_VLD + hh * 64 + mt * 16 + 4 * tp4;
                const bf16x8 vf = mk8(TR16(vp), TR16(vp + 16 * NA_VLD));
                acc[0][mt] = mfma16(vf, pf[0], acc[0][mt] * alpha[0]); acc[1][mt] = mfma16(vf, pf[1], acc[1][mt] * alpha[1]); }
        } else {
            f32x4 sa[2][4];
#pragma unroll
            for (int kt = 0; kt < 4; ++kt) { sa[0][kt] = (f32x4){0.f, 0.f, 0.f, 0.f}; sa[1][kt] = (f32x4){0.f, 0.f, 0.f, 0.f};
#pragma unroll
                for (int ks = 0; ks < 2; ++ks) { const bf16x8 kf = *(const bf16x8*)(Ksb + (kt * 16 + tq) * NA_KLD + hh * 64 + ks * 32 + fq * 8);
                    sa[0][kt] = mfma16(kf, qf[0][ks], sa[0][kt]); sa[1][kt] = mfma16(kf, qf[1][ks], sa[1][kt]); } }
            float alpha[2]; bf16x8 pf[2][2];
#pragma unroll
            for (int u = 0; u < 2; ++u) {
                float mx = -1e30f;
#pragma unroll
                for (int kt = 0; kt < 4; ++kt)
#pragma unroll
                    for (int r = 0; r < 4; ++r) { sa[u][kt][r] *= 0.125f; mx = fmaxf(mx, sa[u][kt][r]); }
                mx = fmaxf(mx, shx<16>(mx)); mx = fmaxf(mx, shx<32>(mx));
                const float mn = fmaxf(m_run[u], mx); alpha[u] = __expf(m_run[u] - mn); m_run[u] = mn;
                float ps = 0.f;
#pragma unroll
                for (int kt = 0; kt < 4; ++kt)
#pragma unroll
                    for (int r = 0; r < 4; ++r) { sa[u][kt][r] = __expf(sa[u][kt][r] - mn); ps += sa[u][kt][r]; }
                ps += shx<16>(ps); ps += shx<32>(ps);
                l_run[u] = l_run[u] * alpha[u] + ps;
#pragma unroll
                for (int h2 = 0; h2 < 2; ++h2) {
                    u32x4 pk = {pack2(sa[u][2 * h2][0], sa[u][2 * h2][1]), pack2(sa[u][2 * h2][2], sa[u][2 * h2][3]), pack2(sa[u][2 * h2 + 1][0], sa[u][2 * h2 + 1][1]), pack2(sa[u][2 * h2 + 1][2], sa[u][2 * h2 + 1][3])};
                    pf[u][h2] = mk8(pk); }
            }
#pragma unroll
            for (int mt = 0; mt < 4; ++mt) { acc[0][mt] = acc[0][mt] * alpha[0]; acc[1][mt] = acc[1][mt] * alpha[1]; }
#pragma unroll
            for (int h2 = 0; h2 < 2; ++h2)
#pragma unroll
                for (int mt = 0; mt < 4; ++mt) { const bf16_t* vp = Vsb + (32 * h2 + 4 * fq + tq4) * NA_VLD + hh * 64 + mt * 16 + 4 * tp4;
                    const bf16x8 vf = mk8(TR16(vp), TR16(vp + 16 * NA_VLD));
                    acc[0][mt] = mfma16(vf, pf[0][h2], acc[0][mt]); acc[1][mt] = mfma16(vf, pf[1][h2], acc[1][mt]); }
        }
        }
    }
#undef NA_FETCH
#undef NA_SRC_ROWS
#pragma unroll
    for (int u = 0; u < 2; ++u) {
        const float il = frcp(l_run[u]);
        const size_t orow = ((size_t)sl << sd.lgseq) + qtok[u];
#pragma unroll
        for (int mt = 0; mt < 4; ++mt) { u32x2 o = {pack2(acc[u][mt][0] * il, acc[u][mt][1] * il), pack2(acc[u][mt][2] * il, acc[u][mt][3] * il)};
            stg((u32x2*)(p.Nb() + orow * 512 + head * 64 + mt * 16 + fq * 4), o); }
    }
}

DEV void mlstm_stepC_task(const Params& p, const SetDesc& sd, int layer, int task, char* shm) {
    const int tid = TID(), lane = tid & 63, w = tid >> 6, tq = lane & 15, fq = lane >> 4, tq4 = (lane & 15) >> 2, tp4 = lane & 3;
    const int tb = task % sd.ntb, h = (task / sd.ntb) & 3, sl = task / (sd.ntb * 4);
    const int row0 = (sl << sd.lgseq) + tb * 128; const bool latent = !sd.is_ctx; const int tl0 = tb * 128;
    bf16_t* Ks = (bf16_t*)shm;
    bf16_t* Vs = (bf16_t*)(shm + 128 * K_LD * 2);
    bf16_t* Cs = (bf16_t*)(shm + 128 * K_LD * 2 + 128 * V_LD * 2);
    float* ga = (float*)(shm + 128 * K_LD * 2 * 3 + 128 * V_LD * 2); float* gb = ga + 256; float* gpm = gb + 256; float* gtot = gpm + 256; float* tmp = gtot + 8;
    float* nvs = tmp + 16;
    float* cms = nvs + 128;
    const bf16_t* prow = proj_buf(p, sd) + (size_t)row0 * PWA;
    __syncthreads();
    gate_scan(prow, h, p.gate_bias + (size_t)layer * 16, ga, gb, gpm, gtot, tmp);
    {
        const int s = tid & 127, cpi = tid >> 7, cp = (cpi & 1) + (cpi >> 1) * 4;
        const bf16_t* hp = prow + (size_t)s * PWA + C_KM + h * 64;
        float k1[8], k2[8];
        load_rope_chunk(hp, cp, latent, tl0 + s, p.rope(), 1.0f, k1);
        load_rope_chunk(hp, cp + 2, latent, tl0 + s, p.rope(), 1.0f, k2);
        u32x4 o1 = {pack2(k1[0], k1[1]), pack2(k1[2], k1[3]), pack2(k1[4], k1[5]), pack2(k1[6], k1[7])};
        u32x4 o2 = {pack2(k2[0], k2[1]), pack2(k2[2], k2[3]), pack2(k2[4], k2[5]), pack2(k2[6], k2[7])};
        *(u32x4*)(Ks + s * K_LD + cp * 8) = o1; *(u32x4*)(Ks + s * K_LD + (cp + 2) * 8) = o2;
    }
#pragma unroll
    for (int it = 0; it < 4; ++it) { const int item = tid + it * 512, s = item >> 4, ch = item & 15;
        *(u32x4*)(Vs + s * V_LD + ch * 8) = ldg((const u32x4*)(prow + (size_t)s * PWA + C_VM + h * 128 + ch * 8)); }
#pragma unroll
    for (int it = 0; it < 4; ++it) { const int item = tid + it * 512, dir = item >> 10, rem = item & 1023, v = rem >> 3, ch = rem & 7;
        *(u32x4*)(Cs + (dir * 128 + v) * K_LD + ch * 8) = ldg((const u32x4*)(p.Cin() + (size_t)st_index(sd, sl, h, dir, tb) * 8192 + v * 64 + ch * 8)); }
    if (tid < 128) nvs[tid] = ldg(p.Cn() + (size_t)st_index(sd, sl, h, tid >> 6, tb) * 64 + (tid & 63));
    if (tid < 2) cms[tid] = ldg(p.Cm() + (size_t)st_index(sd, sl, h, tid, tb) * 4);
    bf16x8 qf[2]; float qv[2][8];
    {
        const int t = w * 16 + tq; const bf16_t* hp = prow + (size_t)t * PWA + C_QM + h * 64;
#pragma unroll
        for (int ks = 0; ks < 2; ++ks) { load_rope_chunk(hp, ks * 4 + fq, latent, tl0 + t, p.rope(), 0.125f, qv[ks]);
            u32x4 o = {pack2(qv[ks][0], qv[ks][1]), pack2(qv[ks][2], qv[ks][3]), pack2(qv[ks][4], qv[ks][5]), pack2(qv[ks][6], qv[ks][7])}; qf[ks] = mk8(o); }
    }
    __syncthreads();
    const int t = w * 16 + tq;
    f32x4 hsum[8];
#pragma unroll
    for (int mt = 0; mt < 8; ++mt) hsum[mt] = (f32x4){0.f, 0.f, 0.f, 0.f};
#pragma unroll
    for (int dir = 0; dir < 2; ++dir) {
        const float m_in = cms[dir];
        const float Mt = fmaxf(m_in, gpm[dir * 128 + t]);
        const float inter = __expf(m_in - Mt);
        const float mtot = gb[dir * 128 + t] + Mt;
        f32x4 acc[8];
#pragma unroll
        for (int mt = 0; mt < 8; ++mt) { acc[mt] = (f32x4){0.f, 0.f, 0.f, 0.f};
#pragma unroll
            for (int ks = 0; ks < 2; ++ks) { const bf16x8 cf = *(const bf16x8*)(Cs + (dir * 128 + mt * 16 + tq) * K_LD + ks * 32 + fq * 8);
                acc[mt] = mfma16(cf, qf[ks], acc[mt]); }
            acc[mt] = acc[mt] * inter; }
        float qn = 0.f;
#pragma unroll
        for (int ks = 0; ks < 2; ++ks)
#pragma unroll
            for (int j = 0; j < 8; ++j) qn += bf2f(f2bf(qv[ks][j])) * nvs[dir * 64 + ks * 32 + fq * 8 + j];
        qn += shx<16>(qn); qn += shx<32>(qn);
        float den = inter * qn;
        const int u_lo = dir == 0 ? 0 : (w >> 1), u_hi = dir == 0 ? (w >> 1) : 3;
        float rsum = 0.f;
        for (int u = u_lo; u <= u_hi; ++u) {
            unsigned pk[4];
#pragma unroll
            for (int kt = 0; kt < 2; ++kt) { f32x4 sa = {0.f, 0.f, 0.f, 0.f}; const int sb = 32 * u + 16 * kt;
#pragma unroll
                for (int ks = 0; ks < 2; ++ks) { const bf16x8 kf = *(const bf16x8*)(Ks + (sb + tq) * K_LD + ks * 32 + fq * 8); sa = mfma16(kf, qf[ks], sa); }
                float pv[4]; float gv4[4];
#pragma unroll
                for (int r = 0; r < 4; ++r) gv4[r] = ga[dir * 128 + sb + fq * 4 + r];
#ifndef CPU_EMU
                asm volatile("" : "+v"(gv4[0]), "+v"(gv4[1]), "+v"(gv4[2]), "+v"(gv4[3]));
#endif
#pragma unroll
                for (int r = 0; r < 4; ++r) { const int s = sb + fq * 4 + r; const bool valid = dir == 0 ? (s <= t) : (s >= t);
                    pv[r] = valid ? sa[r] * __expf(gv4[r] - Mt) : 0.f; pv[r] = bf2f(f2bf(pv[r])); rsum += pv[r]; }
                pk[kt * 2] = pack2(pv[0], pv[1]); pk[kt * 2 + 1] = pack2(pv[2], pv[3]); }
            u32x4 pkv = {pk[0], pk[1], pk[2], pk[3]}; const bf16x8 pf = mk8(pkv);
#pragma unroll
            for (int mt = 0; mt < 8; ++mt) { const bf16_t* vp = Vs + (32 * u + 4 * fq + tq4) * V_LD + mt * 16 + 4 * tp4;
                const bf16x8 vf = mk8(TR16(vp), TR16(vp + 16 * V_LD));
                acc[mt] = mfma16(vf, pf, acc[mt]); }
        }
        rsum += shx<16>(rsum); rsum += shx<32>(rsum);
        den += rsum;
        const float dn = frcp(fmaxf(fabsf(den), __expf(-mtot)));
#pragma unroll
        for (int mt = 0; mt < 8; ++mt) hsum[mt] = hsum[mt] + acc[mt] * dn;
    }
    float ss = 0.f;
#pragma unroll
    for (int mt = 0; mt < 8; ++mt)
#pragma unroll
        for (int r = 0; r < 4; ++r) ss += hsum[mt][r] * hsum[mt][r];
    ss += shx<16>(ss); ss += shx<32>(ss);
    const float rstd = rsqrtf(ss * (1.0f / 128.0f) + RMS_EPS);
#pragma unroll
    for (int mt = 0; mt < 8; ++mt) { const int v = mt * 16 + fq * 4;
        const u32x2 om = ldg((const u32x2*)(prow + (size_t)t * PWA + C_OM + h * 128 + v));
        u32x2 o = {pack2(hsum[mt][0] * rstd * sigmoidf_(lo16(om.x)), hsum[mt][1] * rstd * sigmoidf_(hi16(om.x))),
                   pack2(hsum[mt][2] * rstd * sigmoidf_(lo16(om.y)), hsum[mt][3] * rstd * sigmoidf_(hi16(om.y)))};
        stg((u32x2*)(p.Mb() + (size_t)(row0 + t) * 512 + h * 128 + v), o); }
}

struct SchedMerge {
    const bf16_t* Mb; const bf16_t* Pb; const bf16_t* Nb; const bf16_t* Wb; int nM;
    DEV bool next(int i, GUnit& u) const { u.aux = i % 3; return tile_order(i / 3, nM, 4, u.pm, u.pn); }
    DEV const bf16_t* a_base(const GUnit& u) const { return (u.aux == 0 ? Mb : (u.aux == 1 ? Pb : Nb)) + (size_t)u.pm * 256 * 512; }
    DEV const bf16_t* b_base(const GUnit& u) const { return Wb + ((size_t)u.aux * 1024 + u.pn * 256) * 512; }
    DEV int grow(const GUnit&, int) const { return 0; }
};
DEV void phase_merge(const Params& p, const SetDesc& sd, int layer, char* shm) {
    SchedMerge S; S.Mb = p.Mb(); S.Pb = p.Pb(); S.Nb = p.Nb(); S.Wb = p.WbT() + (size_t)layer * 3 * 1024 * 512; S.nM = sd.nrows / 256;
    const bf16_t* bgb = p.BG(); bf16_t* mgb = p.MERGED();
    gemm_stream<false, 512, 512, 512>(shm, S, [=](const GUnit& u, const f32x4 (&acc)[2][2][4][2], int r0, int c0) {
#pragma unroll
        for (int ai = 0; ai < 2; ++ai) {
            u32x4 gm[4][2], pr[4][2];
#pragma unroll
            for (int m = 0; m < 4; ++m)
#pragma unroll
                for (int hf = 0; hf < 2; ++hf) { const size_t r = (size_t)u.pm * 256 + r0 + ai * 128 + m * 16;
                    gm[m][hf] = ldg((const u32x4*)(bgb + r * NBG + u.aux * 1024 + u.pn * 256 + c0 + hf * 128));
                    if (u.aux > 0) pr[m][hf] = ldg((const u32x4*)(mgb + r * 1024 + u.pn * 256 + c0 + hf * 128)); else pr[m][hf] = (u32x4){0u, 0u, 0u, 0u}; }
#pragma unroll
            for (int m = 0; m < 4; ++m)
#pragma unroll
                for (int hf = 0; hf < 2; ++hf) { const size_t r = (size_t)u.pm * 256 + r0 + ai * 128 + m * 16;
                    const f32x4 x0 = acc[ai][hf][m][0], x1 = acc[ai][hf][m][1]; const u32x4 g = gm[m][hf], q = pr[m][hf];
                    u32x4 ov = {pack2(x0[0] * lo16(g.x) + lo16(q.x), x0[1] * hi16(g.x) + hi16(q.x)), pack2(x0[2] * lo16(g.y) + lo16(q.y), x0[3] * hi16(g.y) + hi16(q.y)),
                                pack2(x1[0] * lo16(g.z) + lo16(q.z), x1[1] * hi16(g.z) + hi16(q.z)), pack2(x1[2] * lo16(g.w) + lo16(q.w), x1[3] * hi16(g.w) + hi16(q.w))};
                    stg((u32x4*)(mgb + r * 1024 + u.pn * 256 + c0 + hf * 128), ov); }
        } });
}
DEV void phase_outproj(const Params& p, const SetDesc& sd, int layer, char* shm) {
    SchedPlain S; S.A = p.MERGED(); S.Bt = p.WoT() + (size_t)layer * 1024 * 1024; S.nM = sd.nrows / 256; S.nN = 4; S.lda256 = 256 * 1024; S.ldb256 = 256 * 1024;
    bf16_t* yb = p.Y();
    gemm_stream<false, 1024, 1024, 1024>(shm, S, [=](const GUnit& u, const f32x4 (&acc)[2][2][4][2], int r0, int c0) {
#pragma unroll
        for (int ai = 0; ai < 2; ++ai)
#pragma unroll
            for (int m = 0; m < 4; ++m) { bf16_t* o = yb + ((size_t)u.pm * 256 + r0 + ai * 128 + m * 16) * 1024 + u.pn * 256 + c0;
                store8bf(o, acc[ai][0][m][0], acc[ai][0][m][1]); store8bf(o + 128, acc[ai][1][m][0], acc[ai][1][m][1]); } });
}

DEV void phase_postmix(const Params& p, const SetDesc& sd, int layer, char* shm) {
    const int tid = TID(), lane = tid & 63, wv = tid >> 6;
    float* wr_s = (float*)shm;
    __syncthreads();
    for (int i = tid; i < 1024 * 16; i += NTHREADS) { const int c = i >> 4, e = i & 15, ln = (c & 511) >> 3, j = c & 7, hf = c >> 9;
        wr_s[((((hf * 8 + j) * 4 + (e >> 2)) * 64 + ln) << 2) + (e & 3)] = ldg(p.router_w + (size_t)layer * 1024 * 16 + i); }
    __syncthreads();
    const float* g1 = p.norm_gain + ((size_t)layer * 4 + 1) * 1024; const float* g2 = p.norm_gain + ((size_t)layer * 4 + 2) * 1024;
    float* par = (float*)(shm + 65536);
    { const int rpb0_ = (sd.nrows + (int)gridDim.x - 1) / (int)gridDim.x; const float* mdb = mod_row(p, sd, layer, min((int)blockIdx.x * rpb0_, sd.nrows - 1));
      stage_params(par, g1, g2, mdb + 2048, mdb + 3072, mdb + 4096); }
    __syncthreads();
    const float* xb = xsrc_base(p, sd, layer); float* xdb = xdst_base(p, sd);
    const int stride = 8; const int rpb_ = (sd.nrows + (int)gridDim.x - 1) / (int)gridDim.x; const int row_end = min(sd.nrows, ((int)blockIdx.x + 1) * rpb_);
    int row = (int)blockIdx.x * rpb_ + wv;
    u32x4 ycur[2], ynxt[2]; f32x4 xcur[4], xnxt[4];
    if (row < row_end) {
#pragma unroll
        for (int i = 0; i < 2; ++i) ycur[i] = ldg((const u32x4*)(p.Y() + (size_t)row * 1024 + i * 512 + lane * 8));
#pragma unroll
        for (int i = 0; i < 4; ++i) xcur[i] = ldg((const f32x4*)(xb + (size_t)row * 1024 + (i >> 1) * 512 + lane * 8 + (i & 1) * 4)); }
    for (; row < row_end; row += stride) {
        int ln = lane; HIDE(ln);
        const int rn = row + stride;
        if (rn < row_end) {
#pragma unroll
            for (int i = 0; i < 2; ++i) ynxt[i] = ldg((const u32x4*)(p.Y() + (size_t)rn * 1024 + i * 512 + ln * 8));
#pragma unroll
            for (int i = 0; i < 4; ++i) xnxt[i] = ldg((const f32x4*)(xb + (size_t)rn * 1024 + (i >> 1) * 512 + ln * 8 + (i & 1) * 4)); }
        float* xd = xdb + (size_t)row * 1024;
        const float* md = mod_row(p, sd, layer, row);
        float y[16]; float ss = 0.f;
#pragma unroll
        for (int hlf = 0; hlf < 2; ++hlf) { const u32x4 m = ycur[hlf];
            const float t8[8] = {lo16(m.x), hi16(m.x), lo16(m.y), hi16(m.y), lo16(m.z), hi16(m.z), lo16(m.w), hi16(m.w)};
#pragma unroll
            for (int j = 0; j < 8; ++j) { y[hlf * 8 + j] = t8[j]; ss += t8[j] * t8[j]; } }
        ss = wave_sum(ss);
        const float rstd = rsqrtf(ss * (1.0f / 1024.0f) + RMS_EPS);
        float xn[16]; float ss2 = 0.f;
#pragma unroll
        for (int hlf = 0; hlf < 2; ++hlf)
#pragma unroll
            for (int q = 0; q < 2; ++q) { const int c0 = hlf * 512 + ln * 8 + q * 4; const f32x4 xo = xcur[hlf * 2 + q]; f32x4 xw;
#pragma unroll
                for (int j = 0; j < 4; ++j) { const float v = xo[j] + par[2048 + c0 + j] * (y[hlf * 8 + q * 4 + j] * rstd * par[c0 + j]); xw[j] = v; xn[hlf * 8 + q * 4 + j] = v; ss2 += v * v; }
                stg((f32x4*)(xd + c0), xw); }
        ss2 = wave_sum(ss2);
        const float rstd2 = rsqrtf(ss2 * (1.0f / 1024.0f) + RMS_EPS);
        float lg[16];
#pragma unroll
        for (int e = 0; e < 16; ++e) lg[e] = 0.f;
#pragma unroll
        for (int hlf = 0; hlf < 2; ++hlf) { const int c0 = hlf * 512 + ln * 8; float o[8];
#pragma unroll
            for (int j = 0; j < 8; ++j) { o[j] = xn[hlf * 8 + j] * rstd2 * par[1024 + c0 + j] * (1.0f + par[4096 + c0 + j]) + par[3072 + c0 + j];
#pragma unroll
                for (int eq = 0; eq < 4; ++eq) { const f32x4 w4 = *(const f32x4*)(wr_s + ((((hlf * 8 + j) * 4 + eq) * 64 + ln) << 2));
#pragma unroll
                    for (int e = 0; e < 4; ++e) lg[eq * 4 + e] += o[j] * w4[e]; } }
            const u32x2 ov = {f8pack4(o[0], o[1], o[2], o[3]), f8pack4(o[4], o[5], o[6], o[7])};
            stg((u32x2*)((unsigned char*)p.H() + (size_t)row * 1024 + c0), ov); }
        float r8[8], r4[4], r2[2], r1;
        { const bool b = (lane & 32) != 0;
#pragma unroll
          for (int i = 0; i < 8; ++i) { const float keep = b ? lg[i + 8] : lg[i], send = b ? lg[i] : lg[i + 8]; r8[i] = keep + shx<32>(send); } }
        { const bool b = (lane & 16) != 0;
#pragma unroll
          for (int i = 0; i < 4; ++i) { const float keep = b ? r8[i + 4] : r8[i], send = b ? r8[i] : r8[i + 4]; r4[i] = keep + shx<16>(send); } }
        { const bool b = (lane & 8) != 0;
#pragma unroll
          for (int i = 0; i < 2; ++i) { const float keep = b ? r4[i + 2] : r4[i], send = b ? r4[i] : r4[i + 2]; r2[i] = keep + shx<8>(send); } }
        { const bool b = (lane & 4) != 0; const float keep = b ? r2[1] : r2[0], send = b ? r2[0] : r2[1]; r1 = keep + shx<4>(send); }
        r1 += shx<2>(r1); r1 += shx<1>(r1);
        float mx = r1;
        mx = fmaxf(mx, shx<4>(mx)); mx = fmaxf(mx, shx<8>(mx)); mx = fmaxf(mx, shx<16>(mx)); mx = fmaxf(mx, shx<32>(mx));
        const float ex = __expf(r1 - mx);
        float se = ex;
        se += shx<4>(se); se += shx<8>(se); se += shx<16>(se); se += shx<32>(se);
        if ((lane & 3) == 0) { const int e = ((lane >> 5) & 1) * 8 + ((lane >> 4) & 1) * 4 + ((lane >> 3) & 1) * 2 + ((lane >> 2) & 1);
            stg(p.aff() + (size_t)row * 16 + e, ex * frcp(se)); }
#pragma unroll
        for (int i = 0; i < 2; ++i) ycur[i] = ynxt[i];
#pragma unroll
        for (int i = 0; i < 4; ++i) xcur[i] = xnxt[i];
    }
}

DEV unsigned shxu(unsigned v, int m) {
    const float f = __uint_as_float(v); float r;
    switch (m) { case 1: r = shx<1>(f); break; case 2: r = shx<2>(f); break; case 4: r = shx<4>(f); break; case 8: r = shx<8>(f); break; case 16: r = shx<16>(f); break; default: r = shx<32>(f); break; }
    return __float_as_uint(r);
}
#define TK_CX(a_, b_, desc_) do { const unsigned long long x_ = key[a_], y_ = key[b_]; const bool sw_ = (desc_) ? (x_ < y_) : (x_ > y_); key[a_] = sw_ ? y_ : x_; key[b_] = sw_ ? x_ : y_; } while (0)
DEV void topk_task(const Params& p, const SetDesc& sd, int task, char* shm) {
    const int tid = TID();
    const int e = task & 15, sl = task >> 4;
    unsigned long long* buf = (unsigned long long*)shm;
    const int T = 1 << sd.lgseq, cap = sd.cap;
    const int rbase = sl << sd.lgseq;
    const bool active = tid * 4 < T;
    unsigned long long key[4];
    __syncthreads();
#pragma unroll
    for (int m = 0; m < 4; ++m) { const int i = tid * 4 + m; const float a = active ? ldg(p.aff() + (size_t)(rbase + i) * 16 + e) : 0.f;
        key[m] = ((unsigned long long)__float_as_uint(a) << 32) | (unsigned)(0xFFFFFFFFu - (unsigned)i); }
    for (int k = 2; k <= T; k <<= 1) {
        const bool desc4 = ((tid * 4) & k) == 0;
        for (int j = k >> 1; j >= 4; j >>= 1) {
            const int tj = j >> 2;
            unsigned long long pk[4];
            if (tj < 64) {
#pragma unroll
                for (int m = 0; m < 4; ++m) { const unsigned lo = shxu((unsigned)key[m], tj), hi = shxu((unsigned)(key[m] >> 32), tj); pk[m] = ((unsigned long long)hi << 32) | lo; }
            } else {
                __syncthreads();
                if (active) {
#pragma unroll
                    for (int m = 0; m < 4; ++m) buf[tid * 4 + m] = key[m]; }
                __syncthreads();
#pragma unroll
                for (int m = 0; m < 4; ++m) pk[m] = active ? buf[(tid ^ tj) * 4 + m] : 0ull;
            }
            const bool lower = (tid & tj) == 0; const bool takemax = desc4 == lower;
#pragma unroll
            for (int m = 0; m < 4; ++m) { const unsigned long long x = key[m], y = pk[m]; key[m] = takemax ? (x > y ? x : y) : (x < y ? x : y); }
        }
        if (k >= 4) { TK_CX(0, 2, desc4); TK_CX(1, 3, desc4); TK_CX(0, 1, desc4); TK_CX(2, 3, desc4); }
        else { TK_CX(0, 1, true); TK_CX(2, 3, false); }
    }
    const int sbase = e * sd.rpe + sl * cap;
    if (active) {
#pragma unroll
        for (int m = 0; m < 4; ++m) { const int i = tid * 4 + m; const unsigned long long kv = key[m]; const int tok = (int)(0xFFFFFFFFu - (unsigned)(kv & 0xFFFFFFFFu));
            const int row = rbase + tok;
            if (i < cap) { stg(p.slot_token() + sbase + i, row); stg(p.slot_gate() + sbase + i, __uint_as_float((unsigned)(kv >> 32))); stg(p.token_slots() + (size_t)row * 16 + e, sbase + i); }
            else stg(p.token_slots() + (size_t)row * 16 + e, -1); } }
    if (sl == 0) { const int used = sd.nsamp * cap;
        for (int i = used + tid; i < sd.rpe; i += NTHREADS) { stg(p.slot_token() + e * sd.rpe + i, 0); stg(p.slot_gate() + e * sd.rpe + i, 0.f); } }
}
#undef TK_CX

struct SchedMoe {
    const bf16_t* A; const int* st; const bf16_t* W; int nRT, rpe, nN, wstride;
    DEV bool next(int i, GUnit& u) const { int pmx, pn; if (!tile_order(i, 16 * nRT, nN, pmx, pn)) return false; u.pm = pmx % nRT; u.aux = pmx / nRT; u.pn = pn; return true; }
    DEV int slot0(const GUnit& u) const { return u.aux * rpe + u.pm * 256; }
    DEV const bf16_t* a_base(const GUnit&) const { return A; }
    DEV int grow(const GUnit& u, int i) const { return st ? ldg(st + slot0(u) + i) : slot0(u) + i; }
    DEV const bf16_t* b_base(const GUnit& u) const { return W + (size_t)u.aux * wstride + (size_t)u.pn * 256 * 512; }
};
DEV void phase_moe_gu(const Params& p, const SetDesc& sd, int layer, char* shm) {
    SchedMoe S; S.A = p.H(); S.st = p.slot_token(); S.W = p.WguT() + (size_t)layer * 16 * 2048 * 512; S.nRT = sd.rpe / 256; S.rpe = sd.rpe; S.nN = 8; S.wstride = 2048 * 512;
    unsigned char* hb = (unsigned char*)p.HID();
    gemm_stream<true, 512, 512, 512, true>(shm, S, [=](const GUnit& u, const f32x4 (&acc)[2][2][4][2], int r0, int c0) {
#pragma unroll
        for (int ai = 0; ai < 2; ++ai)
#pragma unroll
            for (int m = 0; m < 4; ++m) { f32x4 h0, h1; const f32x4 a0 = acc[ai][0][m][0] * F8_WINV, a1 = acc[ai][0][m][1] * F8_WINV, b0 = acc[ai][1][m][0] * F8_WINV, b1 = acc[ai][1][m][1] * F8_WINV;
#pragma unroll
                for (int j = 0; j < 4; ++j) { h0[j] = a0[j] * sigmoidf_(a0[j]) * b0[j]; h1[j] = a1[j] * sigmoidf_(a1[j]) * b1[j]; }
                const u32x2 hv = {f8pack4(h0[0], h0[1], h0[2], h0[3]), f8pack4(h1[0], h1[1], h1[2], h1[3])};
                stg((u32x2*)(hb + ((size_t)S.slot0(u) + r0 + ai * 128 + m * 16) * 1024 + u.pn * 128 + c0), hv); } });
}
DEV void phase_moe_down(const Params& p, const SetDesc& sd, int layer, char* shm) {
    SchedMoe S; S.A = p.HID(); S.st = nullptr; S.W = p.WdT() + (size_t)layer * 16 * 1024 * 512; S.nRT = sd.rpe / 256; S.rpe = sd.rpe; S.nN = 4; S.wstride = 1024 * 512;
    bf16_t* yb = p.YE(); const float* gt = p.slot_gate();
    gemm_stream<true, 512, 512, 512, true>(shm, S, [=](const GUnit& u, const f32x4 (&acc)[2][2][4][2], int r0, int c0) {
#pragma unroll
        for (int ai = 0; ai < 2; ++ai) {
            float gv[4];
#pragma unroll
            for (int m = 0; m < 4; ++m) gv[m] = ldg(gt + (size_t)S.slot0(u) + r0 + ai * 128 + m * 16) * F8_WINV;
#pragma unroll
            for (int m = 0; m < 4; ++m) { const size_t sl = (size_t)S.slot0(u) + r0 + ai * 128 + m * 16; const float g = gv[m];
                bf16_t* o = yb + sl * 1024 + u.pn * 256 + c0; store8bf(o, acc[ai][0][m][0] * g, acc[ai][0][m][1] * g); store8bf(o + 128, acc[ai][1][m][0] * g, acc[ai][1][m][1] * g); } } });
}

DEV void compact4(const int (&sl)[16], int (&c)[4], int& n) {
    n = 0; c[0] = -1; c[1] = -1; c[2] = -1; c[3] = -1;
#pragma unroll
    for (int e = 0; e < 16; ++e) if (sl[e] >= 0) { c[0] = (n == 0) ? sl[e] : c[0]; c[1] = (n == 1) ? sl[e] : c[1]; c[2] = (n == 2) ? sl[e] : c[2]; c[3] = (n == 3) ? sl[e] : c[3]; ++n; }
}
DEV void phase_combine(const Params& p, const SetDesc& sd, int layer, char* shm) {
    const int tid = TID(), lane = tid & 63, wv = tid >> 6;
    const float* g3 = p.norm_gain + ((size_t)layer * 4 + 3) * 1024;
    float* xdb = xdst_base(p, sd);
    const int stride = 8; const int rpb_ = (sd.nrows + (int)gridDim.x - 1) / (int)gridDim.x; const int row_end = min(sd.nrows, ((int)blockIdx.x + 1) * rpb_);
    int row = __builtin_amdgcn_readfirstlane((int)blockIdx.x * rpb_ + wv);
    float* par = (float*)shm;
    __syncthreads();
    { const float* mdb = mod_row(p, sd, layer, min((int)blockIdx.x * rpb_, sd.nrows - 1)); stage_params(par, g3, mdb + 5120, nullptr, nullptr, nullptr); }
    __syncthreads();
    int raw[16]; int cc[4], cn[4]; int nc = 0, nn = 0;
    u32x4 mc[4][2], mn[4][2]; f32x4 xc[4], xn[4];
#define CMB_SLOTS(r_) do { _Pragma("unroll") for (int e = 0; e < 16; ++e) raw[e] = ldg(p.token_slots() + (size_t)(r_) * 16 + e); } while (0)
#define CMB_DATA(r_, c_, n_, m_, x_) do { _Pragma("unroll") for (int k = 0; k < 4; ++k) { \
            if (k < (n_)) { const bf16_t* yr = p.YE() + (size_t)(c_)[k] * 1024 + lane * 8; (m_)[k][0] = ldg((const u32x4*)yr); (m_)[k][1] = ldg((const u32x4*)(yr + 512)); } \
            else { (m_)[k][0] = (u32x4){0u, 0u, 0u, 0u}; (m_)[k][1] = (u32x4){0u, 0u, 0u, 0u}; } } \
        _Pragma("unroll") for (int i = 0; i < 4; ++i) (x_)[i] = ldg((const f32x4*)(xdb + (size_t)(r_) * 1024 + (i >> 1) * 512 + lane * 8 + (i & 1) * 4)); } while (0)
    if (row < row_end) { CMB_SLOTS(row); compact4(raw, cc, nc); CMB_DATA(row, cc, nc, mc, xc); if (row + stride < row_end) CMB_SLOTS(row + stride); }
    for (; row < row_end; row += stride) {
        const int rn = row + stride;
        if (rn < row_end) { compact4(raw, cn, nn); CMB_DATA(rn, cn, nn, mn, xn); if (rn + stride < row_end) CMB_SLOTS(rn + stride); }
        float* xd = xdb + (size_t)row * 1024;
        float y[16];
#pragma unroll
        for (int j = 0; j < 16; ++j) y[j] = 0.f;
        if (nc <= 4) {
#pragma unroll
            for (int k = 0; k < 4; ++k)
                if (k < nc) {
#pragma unroll
                    for (int hlf = 0; hlf < 2; ++hlf) { const u32x4 m = mc[k][hlf];
                        y[hlf * 8 + 0] += lo16(m.x); y[hlf * 8 + 1] += hi16(m.x); y[hlf * 8 + 2] += lo16(m.y); y[hlf * 8 + 3] += hi16(m.y);
                        y[hlf * 8 + 4] += lo16(m.z); y[hlf * 8 + 5] += hi16(m.z); y[hlf * 8 + 6] += lo16(m.w); y[hlf * 8 + 7] += hi16(m.w); } }
        } else {
            for (int e = 0; e < 16; ++e) { const int sl_ = ldg(p.token_slots() + (size_t)row * 16 + e);
                if (sl_ >= 0) { const bf16_t* yr = p.YE() + (size_t)sl_ * 1024 + lane * 8;
#pragma unroll
                    for (int hlf = 0; hlf < 2; ++hlf) { const u32x4 m = ldg((const u32x4*)(yr + hlf * 512));
                        y[hlf * 8 + 0] += lo16(m.x); y[hlf * 8 + 1] += hi16(m.x); y[hlf * 8 + 2] += lo16(m.y); y[hlf * 8 + 3] += hi16(m.y);
                        y[hlf * 8 + 4] += lo16(m.z); y[hlf * 8 + 5] += hi16(m.z); y[hlf * 8 + 6] += lo16(m.w); y[hlf * 8 + 7] += hi16(m.w); } } }
        }
        float ss = 0.f;
#pragma unroll
        for (int j = 0; j < 16; ++j) ss += y[j] * y[j];
        ss = wave_sum(ss);
        const float rstd = rsqrtf(ss * (1.0f / 1024.0f) + RMS_EPS);
#pragma unroll
        for (int hlf = 0; hlf < 2; ++hlf)
#pragma unroll
            for (int q = 0; q < 2; ++q) { const int c0 = hlf * 512 + lane * 8 + q * 4; f32x4 xv = xc[hlf * 2 + q];
#pragma unroll
                for (int j = 0; j < 4; ++j) xv[j] += par[1024 + c0 + j] * (y[hlf * 8 + q * 4 + j] * rstd * par[c0 + j]);
                stg((f32x4*)(xd + c0), xv); }
        nc = nn;
#pragma unroll
        for (int k = 0; k < 4; ++k) { cc[k] = cn[k]; mc[k][0] = mn[k][0]; mc[k][1] = mn[k][1]; }
#pragma unroll
        for (int i = 0; i < 4; ++i) xc[i] = xn[i];
    }
#undef CMB_SLOTS
#undef CMB_DATA
}

constexpr int WQ_WORD0 = 4096;
template <class F> DEV void wq_run(const Params& p, int qidx, int ntasks, char* shm, F&& task) {
    unsigned* ctr = p.bar() + WQ_WORD0 + 64 * qidx;
    volatile int* slot = (volatile int*)(shm + 131072 + 64);
    const int tid = TID();
    int cur = blockIdx.x;
    while (cur < ntasks) {
        unsigned pend = 0u;
        if (tid == 0) pend = atomicAdd(ctr, 1u);
        task(cur);
        __syncthreads();
        if (tid == 0) *slot = (int)gridDim.x + (int)pend;
        __syncthreads();
        cur = *slot;
    }
}

template <int PH> DEV void do_phase(const Params& p, int layer, int is_ctx, int grp, char* shm) {
    const SetDesc sd = make_set(is_ctx, grp);
    if constexpr (PH == -1) phase_prologue(p, shm);
    if constexpr (PH == 0) phase_norm1(p, sd, layer, shm);
    if constexpr (PH == 1) phase_proj_a(p, sd, layer, shm);
    const int qbase = ((layer * 3 + (is_ctx ? 0 : grp + 1)) * 13 + (PH < 0 ? 0 : PH)) * 2;
    if constexpr (PH == 2) { wq_run(p, qbase, sd.nsamp * 4 * sd.ntb, shm, [&](int t) { mlstm_stepA_task(p, sd, layer, t, shm); }); if (!(is_ctx && layer == 1)) phase_pool(p, sd); }
    if constexpr (PH == 3) {
        for (int t = blockIdx.x; t < sd.nsamp * 32; t += gridDim.x) mlstm_stepB_task(p, sd, t);
        if (!(is_ctx && layer == 1)) {
            const int nq = (is_ctx ? (CTX / 64) : ROWS) / 2;
            wq_run(p, qbase, sd.nsamp * nq * 4, shm, [&](int t) { na_task(p, sd, layer, t / (nq * 4), (t >> 2) % nq, t & 3, shm); });
        }
    }
    if constexpr (PH == 4) { wq_run(p, qbase, sd.nsamp * 4 * sd.ntb, shm, [&](int t) { mlstm_stepC_task(p, sd, layer, t, shm); }); }
    if constexpr (PH == 5) phase_proj_b(p, sd, layer, shm);
    if constexpr (PH == 6) phase_merge(p, sd, layer, shm);
    if constexpr (PH == 7) phase_outproj(p, sd, layer, shm);
    if constexpr (PH == 8) phase_postmix(p, sd, layer, shm);
    if constexpr (PH == 9) { for (int t = blockIdx.x; t < sd.nsamp * 16; t += gridDim.x) topk_task(p, sd, t, shm); }
    if constexpr (PH == 10) phase_moe_gu(p, sd, layer, shm);
    if constexpr (PH == 11) phase_moe_down(p, sd, layer, shm);
    if constexpr (PH == 12) phase_combine(p, sd, layer, shm);
}

#ifndef CPU_EMU
template <int PH> __global__ void __launch_bounds__(NTHREADS, 2) k_phase(Params p, int layer, int is_ctx, int grp) {
    DYN_LDS(shm);
    do_phase<PH>(p, layer, is_ctx, grp, shm);
}
#ifndef DBL_MASK
#define DBL_MASK 0
#endif
#define RUNPH(PH) do { do_phase<PH>(p, layer, is_ctx, grp, shm); xcd_barrier(bar); if ((DBL_MASK >> (PH)) & 1) { do_phase<PH>(p, layer, is_ctx, grp, shm); xcd_barrier(bar); } } while (0)
__global__ void __launch_bounds__(NTHREADS, 2) k_mega(Params p) {
    DYN_LDS(shm);
    uint4* xbw = (uint4*)(shm + 131072);
    if (threadIdx.x == 0) *xbw = make_uint4(0u, 0u, 0u, 0u);
    __syncthreads();
    XcdBarrier bar = xcd_barrier_post(p.bar(), (volatile LAS unsigned*)xbw);
    do_phase<-1>(p, 0, 0, 0, shm);
    xcd_barrier(bar);
    for (int layer = 0; layer < 2; ++layer)
        for (int si = 0; si <= NG; ++si) {
            const int is_ctx = si == 0 ? 1 : 0, grp = si == 0 ? 0 : si - 1;
            RUNPH(0); RUNPH(1); RUNPH(2);
            if (is_ctx && layer == 1) { do_phase<3>(p, layer, is_ctx, grp, shm); continue; }
            RUNPH(3); RUNPH(4); RUNPH(5); RUNPH(6); RUNPH(7); RUNPH(8); RUNPH(9); RUNPH(10); RUNPH(11);
            do_phase<12>(p, layer, is_ctx, grp, shm);
        }
}
#endif
}

static Params make_params(void* const* d_in, void* d_out, void* d_ws) {
    Params p{};
    p.x = (const float*)d_in[0]; p.c = (const float*)d_in[1]; p.ctx = (const float*)d_in[2]; p.c_ctx = (const float*)d_in[3];
    p.norm_gain = (const float*)d_in[4]; p.ada_w = (const float*)d_in[5]; p.ada_b = (const float*)d_in[6]; p.w_in = (const float*)d_in[7];
    p.gate_bias = (const float*)d_in[8]; p.pool_w = (const float*)d_in[9]; p.pool_scale = (const float*)d_in[10]; p.rpb = (const float*)d_in[11];
    p.w_branch = (const float*)d_in[12]; p.w_out = (const float*)d_in[13]; p.router_w = (const float*)d_in[14];
    p.w_gate = (const float*)d_in[15]; p.w_up = (const float*)d_in[16]; p.w_down = (const float*)d_in[17];
    p.out = (float*)d_out; p.ws = (char*)d_ws;
    return p;
}

#ifdef CPU_EMU
int emu_cfg_B = CFG_B, emu_cfg_ROWS = CFG_ROWS, emu_cfg_CTX = CFG_CTX;
const char* g_dumpdir = "data";
static void* g_ws = nullptr;
static void dump_buf(const char* name, int layer, int is_ctx, int grp, const void* ptr, size_t bytes) {
    char nm[512]; snprintf(nm, sizeof nm, "%s/d_L%d_%s%d_%s.bin", g_dumpdir, layer, is_ctx ? "c" : "g", grp, name);
    FILE* f = fopen(nm, "wb"); fwrite(ptr, 1, bytes, f); fclose(f);
}
static void emu_hook(const Params& p, int layer, int is_ctx, int grp, int ph) {
    const size_t Rn = is_ctx ? RC : RL;
    if (ph == 0) dump_buf("H", layer, is_ctx, grp, p.H(), Rn * 1024 * 2);
    if (ph == 1) dump_buf("PROJ", layer, is_ctx, grp, is_ctx ? p.PROJc() : p.PROJa(), Rn * PWA * 2);
    if (ph == 2) dump_buf("Pb", layer, is_ctx, grp, p.Pb(), Rn * 512 * 2);
    if (ph == 3) dump_buf("Nb", layer, is_ctx, grp, p.Nb(), Rn * 512 * 2);
    if (ph == 4) dump_buf("Mb", layer, is_ctx, grp, p.Mb(), Rn * 512 * 2);
    if (ph == 5) dump_buf("BG", layer, is_ctx, grp, p.BG(), Rn * NBG * 2);
    if (ph == 6) dump_buf("MERGED", layer, is_ctx, grp, p.MERGED(), Rn * 1024 * 2);
    if (ph == 7) dump_buf("Y", layer, is_ctx, grp, p.Y(), Rn * 1024 * 2);
    if (ph == 8) { dump_buf("H2", layer, is_ctx, grp, p.H(), Rn * 1024 * 2); dump_buf("aff", layer, is_ctx, grp, p.aff(), Rn * 16 * 4); }
}
void emu_dump(const char* dir) {
    char nm[512]; snprintf(nm, sizeof nm, "%s/d_mod.bin", dir);
    FILE* f = fopen(nm, "wb"); fwrite((char*)g_ws + WSL.mod, 1, (size_t)2 * (NB + 1) * 6144 * 4, f); fclose(f);
    snprintf(nm, sizeof nm, "%s/d_ctxs.bin", dir);
    f = fopen(nm, "wb"); fwrite((char*)g_ws + WSL.ctxs, 1, (size_t)NB * CTX * 1024 * 4, f); fclose(f);
}
template <int PH> static void emu_run_phase(const Params& p, int layer, int is_ctx, int grp, int nblocks) {
    emu_launch_lambda([=]() { do_phase<PH>(p, layer, is_ctx, grp, emu_blk->smem); }, nblocks, NTHREADS, LDS_BYTES);
    if (PH >= 0) emu_hook(p, layer, is_ctx, grp, PH);
    printf("phase %d layer %d ctx %d grp %d done\n", PH, layer, is_ctx, grp); fflush(stdout);
}
#define LAUNCH_PHASE(PH) emu_run_phase<PH>(p, layer, is_ctx, grp, nblocks)
#else
#define LAUNCH_PHASE(PH) hipLaunchKernelGGL((k_phase<PH>), dim3(nblocks), dim3(NTHREADS), LDS_BYTES, stream, p, layer, is_ctx, grp)
#define SETATTR(PH) (void)hipFuncSetAttribute((const void*)k_phase<PH>, hipFuncAttributeMaxDynamicSharedMemorySize, LDS_BYTES)
#endif

extern "C" void kernel_launch(void* const* d_in, const int* in_sizes, int n_in, void* d_out, int out_size, void* d_ws, size_t ws_size, hipStream_t stream) {
    (void)in_sizes; (void)n_in; (void)out_size;
    if (ws_size < WSL.total) return;
    Params p = make_params(d_in, d_out, d_ws);
#ifdef CPU_EMU
    g_ws = d_ws;
    memset(d_ws, 0xFF, WSL.total);
    memset((char*)d_ws + WSL.bar, 0, 65536);
    const int nblocks = 16;
#else
    const int nblocks = 256;
#if MK_ONE_LAUNCH
    static int grid = 0;
    if (!grid) {
        (void)hipFuncSetAttribute((const void*)k_mega, hipFuncAttributeMaxDynamicSharedMemorySize, LDS_BYTES);
        int dev = 0, cus = 0, per_cu = 0;
        (void)hipGetDevice(&dev);
        (void)hipDeviceGetAttribute(&cus, hipDeviceAttributeMultiprocessorCount, dev);
        (void)hipOccupancyMaxActiveBlocksPerMultiprocessor(&per_cu, (const void*)k_mega, NTHREADS, LDS_BYTES);
        if (per_cu > 1) per_cu = 1;
        grid = cus * per_cu;
        if (grid > 256) grid = 256;
    }
    if (grid <= 0) return;
    (void)hipMemsetAsync(p.bar(), 0, 65536, stream);
    hipLaunchKernelGGL(k_mega, dim3(grid), dim3(NTHREADS), LDS_BYTES, stream, p);
    return;
#else
    static bool attr_done = false;
    if (!attr_done) { SETATTR(-1); SETATTR(0); SETATTR(1); SETATTR(2); SETATTR(3); SETATTR(4); SETATTR(5); SETATTR(6); SETATTR(7); SETATTR(8); SETATTR(9); SETATTR(10); SETATTR(11); SETATTR(12); attr_done = true; }
#endif
#endif
    { const int layer = 0, is_ctx = 0, grp = 0; LAUNCH_PHASE(-1); }
    for (int layer = 0; layer < 2; ++layer)
        for (int si = 0; si <= NG; ++si) {
            const int is_ctx = si == 0 ? 1 : 0, grp = si == 0 ? 0 : si - 1;
            LAUNCH_PHASE(0); LAUNCH_PHASE(1); LAUNCH_PHASE(2); LAUNCH_PHASE(3);
            if (is_ctx && layer == 1) continue;
            LAUNCH_PHASE(4); LAUNCH_PHASE(5); LAUNCH_PHASE(6); LAUNCH_PHASE(7); LAUNCH_PHASE(8); LAUNCH_PHASE(9); LAUNCH_PHASE(10); LAUNCH_PHASE(11); LAUNCH_PHASE(12);
        }
}
```

```cpp
#ifdef CPU_EMU
#include "emu.h"
#define DYN_LDS(p) char* p = emu_blk->smem
#define WAIT_V(n)
#define WAIT_L(n)
#define HIDE(v)
#define CBAR()
#else
#include <hip/hip_runtime.h>
#define DYN_LDS(p) extern __shared__ __attribute__((aligned(16))) char p[]
#define WAIT_V(n) asm volatile("s_waitcnt vmcnt(" #n ")" ::: "memory")
#define WAIT_L(n) asm volatile("s_waitcnt lgkmcnt(" #n ")" ::: "memory")
#define HIDE(v) asm volatile("" : "+v"(v))
#define CBAR() asm volatile("" ::: "memory")
#endif
#include <stdint.h>
#include <stddef.h>

#ifndef CFG_B
#define CFG_B 32
#define CFG_ROWS 32
#define CFG_CTX 256
#define CFG_G 16
#endif
#ifndef MK_ONE_LAUNCH
#define MK_ONE_LAUNCH 1
#endif

#define DEV __device__ __forceinline__
typedef short s16x4 __attribute__((ext_vector_type(4)));
#ifdef CPU_EMU
#define TR16(ptr) emu_tr16((const void*)(ptr))
#else
typedef __attribute__((address_space(3))) s16x4 lds_s16x4;
#define TR16(ptr) __builtin_amdgcn_ds_read_tr16_b64_v4i16((lds_s16x4*)(ptr))
#endif
#ifdef CPU_EMU
#define TID() (threadIdx.x)
#else
#define TID() ({ int t_ = threadIdx.x; asm volatile("" : "+v"(t_)); t_; })
#endif

typedef unsigned short bf16_t;
typedef short bf16x8 __attribute__((ext_vector_type(8)));
typedef float f32x4 __attribute__((ext_vector_type(4)));
typedef unsigned u32x2 __attribute__((ext_vector_type(2)));
typedef unsigned u32x4 __attribute__((ext_vector_type(4)));

namespace {
constexpr int D = 1024, NB = CFG_B, ROWS = CFG_ROWS, SEQ = ROWS * 64, CTX = CFG_CTX, G = CFG_G, NG = NB / G;
constexpr int RL = G * SEQ, RC = NB * CTX, RMAX = RL > RC ? RL : RC;
constexpr int PWA = 3840, NBG = 3072, PWT = PWA + NBG, PWSRC = 6672, C_SPLIT = 3600;
constexpr int C_QM = 0, C_KM = 256, C_QN = 512, C_KN = 1024, C_PU = 1536, C_GM = 2048, C_PADA = 2064, C_VM = 2304, C_OM = 2816, C_VN = 3328;
constexpr int proj_col(int n) { return n < 512 ? n : n < 1536 ? n + 1792 : n < 1552 ? n + 512 : n < 2064 ? n - 16 : n < 3088 ? n - 1552 : n + 240; }
static_assert(proj_col(512) == C_VM && proj_col(1024) == C_OM && proj_col(1536) == C_GM && proj_col(1552) == C_PU && proj_col(2064) == C_QN && proj_col(2576) == C_KN && proj_col(3088) == C_VN && proj_col(3599) == PWA - 1, "projection column map");
constexpr int NTBL = SEQ / 128, NTBC = CTX / 128;
constexpr int ilog2(int x) { return x <= 1 ? 0 : 1 + ilog2(x >> 1); }
constexpr int LGSEQ = ilog2(SEQ), LGCTX = ilog2(CTX);
static_assert((1 << LGSEQ) == SEQ && (1 << LGCTX) == CTX, "sequence lengths must be powers of two");
constexpr int cdiv(int a, int b) { return (a + b - 1) / b; }
constexpr int RPE_L = cdiv(G * (SEQ / 8), 256) * 256, RPE_C = cdiv(NB * (CTX / 8), 256) * 256, RPE_MAX = RPE_L > RPE_C ? RPE_L : RPE_C;
constexpr int NSLOT = 16 * RPE_MAX;
constexpr int NTHREADS = 512;
constexpr int GT_MAXU = 10;
constexpr int LDS_BYTES = 131072 + 256 + GT_MAXU * 1024;
constexpr int NST_L = G * 4 * 2 * NTBL, NST_C = NB * 4 * 2 * NTBC, NST = NST_L > NST_C ? NST_L : NST_C;
constexpr int NCI = NB * 4 * 2;
constexpr float RMS_EPS = 1e-6f;

struct WsLayout { size_t bar, WinT, WbT, WoT, WguT, WdT, mod, rope, ctxs, PROJc, CiC, Cin_, Cim, H, H8, PROJa, Sst, Cin, Mb, Pb, Nb, Sn, Ssc, Cn, Cm, aff, slot_token, slot_gate, token_slots, HID, YE, BG, MERGED, Y, total; };
constexpr size_t al(size_t x) { return (x + 255) / 256 * 256; }
constexpr size_t smax(size_t a, size_t b) { return a > b ? a : b; }
constexpr WsLayout make_layout() {
    WsLayout L{}; size_t o = 0;
    L.bar = o; o += al(65536);
    L.WinT = o; o += al((size_t)2 * PWT * 1024 * 2);
    L.WbT = o; o += al((size_t)2 * 3 * 1024 * 512 * 2);
    L.WoT = o; o += al((size_t)2 * 1024 * 1024 * 2);
    L.WguT = o; o += al((size_t)2 * 16 * 2048 * 1024 * 2);
    L.WdT = o; o += al((size_t)2 * 16 * 1024 * 1024 * 2);
    L.mod = o; o += al((size_t)2 * (NB + 1) * 6144 * 4);
    L.rope = o; o += al((size_t)(ROWS + 64) * 16 * 2 * 4);
    L.ctxs = o; o += al((size_t)NB * CTX * 1024 * 4);
    L.PROJc = o; o += al((size_t)RC * PWA * 2);
    L.CiC = o; o += al((size_t)NCI * 8192 * 4);
    L.Cin_ = o; o += al((size_t)NCI * 64 * 4);
    L.Cim = o; o += al((size_t)NCI * 4 * 4);
    L.H = o; o += al((size_t)RMAX * 1024 * 2);
    L.H8 = o; o += al((size_t)RMAX * 1024);
    const size_t x0 = o;
    L.PROJa = o; o += al((size_t)RMAX * PWA * 2);
    L.Sst = o; o += al((size_t)NST * 8192 * 4);
    L.Cin = o; o += al((size_t)NST * 8192 * 2);
    const size_t hid = al((size_t)NSLOT * 1024 * 2);
    o = x0 + smax(o - x0, 2 * hid);
    L.BG = x0; L.HID = x0; L.YE = x0 + hid;
    L.Mb = o; o += al((size_t)RMAX * 512 * 2);
    L.Pb = o; o += al((size_t)RMAX * 512 * 2);
    L.Nb = o; o += al((size_t)RMAX * 512 * 2);
    L.MERGED = L.H; L.Y = L.Mb;
    L.Sn = o; o += al((size_t)NST * 64 * 4);
    L.Ssc = o; o += al((size_t)NST * 4 * 4);
    L.Cn = o; o += al((size_t)NST * 64 * 4);
    L.Cm = o; o += al((size_t)NST * 4 * 4);
    L.aff = o; o += al((size_t)RMAX * 16 * 4);
    L.slot_token = o; o += al((size_t)NSLOT * 4);
    L.slot_gate = o; o += al((size_t)NSLOT * 4);
    L.token_slots = o; o += al((size_t)RMAX * 16 * 4);
    L.total = o;
    return L;
}
constexpr WsLayout WSL = make_layout();
static_assert((size_t)RMAX * NBG * 2 <= (size_t)RMAX * PWA * 2, "BG overlay must fit in PROJa");
static_assert(CFG_B != 32 || WSL.total <= ((size_t)1 << 30), "workspace budget");

struct Params {
    const float *x, *c, *ctx, *c_ctx, *norm_gain, *ada_w, *ada_b, *w_in, *gate_bias, *pool_w, *pool_scale, *rpb, *w_branch, *w_out, *router_w, *w_gate, *w_up, *w_down;
    float* out;
    char* ws;
#ifdef CPU_EMU
#define WSF(T, name) __device__ __host__ __forceinline__ T* name() const { return (T*)(ws + WSL.name); }
#else
#if defined(__HIP_DEVICE_COMPILE__)
#define WSF(T, name) __device__ __host__ __forceinline__ T* name() const { char* w_ = ws; asm volatile("" : "+s"(w_)); return (T*)(__attribute__((address_space(1))) T*)(w_ + WSL.name); }
#else
#define WSF(T, name) __device__ __host__ __forceinline__ T* name() const { return (T*)(ws + WSL.name); }
#endif
#endif
    WSF(unsigned, bar) WSF(bf16_t, WinT) WSF(bf16_t, WbT) WSF(bf16_t, WoT) WSF(bf16_t, WguT) WSF(bf16_t, WdT)
    WSF(float, mod) WSF(float, rope) WSF(float, ctxs) WSF(bf16_t, PROJc) WSF(float, CiC) WSF(float, Cin_) WSF(float, Cim)
    WSF(bf16_t, H) WSF(unsigned char, H8) WSF(bf16_t, PROJa) WSF(float, Sst) WSF(bf16_t, Cin) WSF(bf16_t, Mb) WSF(bf16_t, Pb) WSF(bf16_t, Nb)
    WSF(float, Sn) WSF(float, Ssc) WSF(float, Cn) WSF(float, Cm) WSF(float, aff) WSF(int, slot_token) WSF(float, slot_gate) WSF(int, token_slots)
    WSF(bf16_t, HID) WSF(bf16_t, YE) WSF(bf16_t, BG) WSF(bf16_t, MERGED) WSF(bf16_t, Y)
#undef WSF
};

struct SetDesc { int is_ctx, nrows, samp0, nsamp, lgseq, ntb, cap, rpe; };
DEV SetDesc make_set(int is_ctx, int grp) {
    SetDesc s;
    s.is_ctx = is_ctx;
    if (is_ctx) { s.nrows = RC; s.samp0 = 0; s.nsamp = NB; s.lgseq = LGCTX; s.ntb = NTBC; s.cap = CTX / 8; s.rpe = RPE_C; }
    else { s.nrows = RL; s.samp0 = grp * G; s.nsamp = G; s.lgseq = LGSEQ; s.ntb = NTBL; s.cap = SEQ / 8; s.rpe = RPE_L; }
    return s;
}

#ifdef CPU_EMU
#define GAS
#else
#define GAS __attribute__((address_space(1)))
#endif
template <class T> DEV T ldg(const T* p) { return *(const GAS T*)p; }
template <class T> DEV void stg(T* p, const T& v) { *(GAS T*)p = v; }
DEV float bf2f(bf16_t v) { return __uint_as_float(((unsigned)v) << 16); }
DEV bf16_t f2bf(float f) { unsigned u = __float_as_uint(f); u += 0x7FFFu + ((u >> 16) & 1u); return (bf16_t)(u >> 16); }
#if defined(__HIP_DEVICE_COMPILE__)
typedef __bf16 bf16n2 __attribute__((ext_vector_type(2)));
typedef float f32n2 __attribute__((ext_vector_type(2)));
DEV unsigned pack2(float lo, float hi) { f32n2 v = {lo, hi}; bf16n2 r = __builtin_convertvector(v, bf16n2); return __builtin_bit_cast(unsigned, r); }
#else
DEV unsigned pack2(float lo, float hi) { return (unsigned)f2bf(lo) | ((unsigned)f2bf(hi) << 16); }
#endif
DEV float lo16(unsigned u) { return __uint_as_float(u << 16); }
DEV float hi16(unsigned u) { return __uint_as_float(u & 0xFFFF0000u); }
#if defined(__HIP_DEVICE_COMPILE__)
DEV float frcp(float x) { return __builtin_amdgcn_rcpf(x); }
#else
DEV float frcp(float x) { return 1.0f / x; }
#endif
#if defined(__HIP_DEVICE_COMPILE__)
DEV float sigmoidf_(float x) { return __builtin_amdgcn_rcpf(1.0f + __expf(-x)); }
#else
DEV float sigmoidf_(float x) { return 1.0f / (1.0f + __expf(-x)); }
#endif
DEV float logsigmoidf_(float x) { return fminf(x, 0.0f) - __logf(1.0f + __expf(-fabsf(x))); }
template <int M> DEV float shx(float v) {
#if defined(__HIP_DEVICE_COMPILE__)
    const unsigned u = __builtin_bit_cast(unsigned, v);
    if constexpr (M == 1) return __builtin_bit_cast(float, __builtin_amdgcn_update_dpp(u, u, 0xB1, 0xF, 0xF, false));
    else if constexpr (M == 2) return __builtin_bit_cast(float, __builtin_amdgcn_update_dpp(u, u, 0x4E, 0xF, 0xF, false));
    else if constexpr (M == 4) { const unsigned t = __builtin_amdgcn_update_dpp(u, u, 0x141, 0xF, 0xF, false);
        return __builtin_bit_cast(float, __builtin_amdgcn_update_dpp(t, t, 0x1B, 0xF, 0xF, false)); }
    else if constexpr (M == 8) return __builtin_bit_cast(float, __builtin_amdgcn_update_dpp(u, u, 0x128, 0xF, 0xF, false));
    else if constexpr (M == 16) { const auto r = __builtin_amdgcn_permlane16_swap(u, u, false, false); return __builtin_bit_cast(float, (threadIdx.x & 16) ? r[0] : r[1]); }
    else { const auto r = __builtin_amdgcn_permlane32_swap(u, u, false, false); return __builtin_bit_cast(float, (threadIdx.x & 32) ? r[0] : r[1]); }
#else
    return __shfl_xor(v, M);
#endif
}
DEV float wave_sum(float v) { v += shx<32>(v); v += shx<16>(v); v += shx<8>(v); v += shx<4>(v); v += shx<2>(v); v += shx<1>(v); return v; }
DEV bf16x8 mk8(u32x2 lo, u32x2 hi) { u32x4 v = {lo.x, lo.y, hi.x, hi.y}; return __builtin_bit_cast(bf16x8, v); }
DEV bf16x8 mk8(u32x4 v) { return __builtin_bit_cast(bf16x8, v); }
DEV bf16x8 mk8(s16x4 lo, s16x4 hi) { return __builtin_shufflevector(lo, hi, 0, 1, 2, 3, 4, 5, 6, 7); }
DEV f32x4 mfma16(bf16x8 a, bf16x8 b, f32x4 c) { return __builtin_amdgcn_mfma_f32_16x16x32_bf16(a, b, c, 0, 0, 0); }
DEV unsigned f8enc1(float x) {
    const unsigned sgn = x < 0.f ? 0x80u : 0u; float a = x < 0.f ? -x : x; if (!(a < 448.f)) a = 448.f;
    if (a < 0.015625f) { const int q = (int)(a * 512.f + 0.5f); const float r = a * 512.f; int qq = q; if ((float)q - r == 0.5f && (q & 1)) qq = q - 1; return sgn | (unsigned)qq; }
    int e = 0; float m = a; while (m >= 2.f) { m *= 0.5f; ++e; } while (m < 1.f) { m *= 2.f; --e; }
    const float r = (m - 1.f) * 8.f; int q = (int)(r + 0.5f); if ((float)q - r == 0.5f && (q & 1)) --q;
    if (q == 8) { q = 0; ++e; }
    return sgn | (unsigned)((e + 7) << 3) | (unsigned)q;
}
#if defined(__HIP_DEVICE_COMPILE__)
DEV unsigned f8pack4(float a, float b, float c, float d) {
    a = __builtin_amdgcn_fmed3f(a, -448.f, 448.f); b = __builtin_amdgcn_fmed3f(b, -448.f, 448.f); c = __builtin_amdgcn_fmed3f(c, -448.f, 448.f); d = __builtin_amdgcn_fmed3f(d, -448.f, 448.f);
    int w = 0; w = __builtin_amdgcn_cvt_pk_fp8_f32(a, b, w, false); w = __builtin_amdgcn_cvt_pk_fp8_f32(c, d, w, true); return (unsigned)w; }
#else
DEV unsigned f8pack4(float a, float b, float c, float d) { return f8enc1(a) | (f8enc1(b) << 8) | (f8enc1(c) << 16) | (f8enc1(d) << 24); }
#endif
#ifdef CPU_EMU
DEV f32x4 mfma_f8(bf16x8 a0, bf16x8 a1, bf16x8 b0, bf16x8 b1, f32x4 c) { return emu_mfma_f8(a0, a1, b0, b1, c); }
#else
typedef int i32x4 __attribute__((ext_vector_type(4)));
typedef int i32x8 __attribute__((ext_vector_type(8)));
DEV f32x4 mfma_f8(bf16x8 a0, bf16x8 a1, bf16x8 b0, bf16x8 b1, f32x4 c) {
    const i32x8 A = __builtin_shufflevector(__builtin_bit_cast(i32x4, a0), __builtin_bit_cast(i32x4, a1), 0, 1, 2, 3, 4, 5, 6, 7);
    const i32x8 B = __builtin_shufflevector(__builtin_bit_cast(i32x4, b0), __builtin_bit_cast(i32x4, b1), 0, 1, 2, 3, 4, 5, 6, 7);
    return __builtin_amdgcn_mfma_scale_f32_16x16x128_f8f6f4(A, B, c, 0, 0, 0, 0, 0, 0);
}
#endif
constexpr float F8_WSCALE = 64.0f, F8_WINV = 1.0f / 64.0f;
DEV void store8bf(bf16_t* o, f32x4 a, f32x4 b) { u32x4 v = {pack2(a[0], a[1]), pack2(a[2], a[3]), pack2(b[0], b[1]), pack2(b[2], b[3])}; stg((u32x4*)o, v); }

#ifndef CPU_EMU
#define XB_TMO      128
#define XB_XCNT(j)  (256  + 64 * (j))
#define XB_XSUB(j)  (1280 + 64 * (j))
#define XB_XGEN(j)  (2304 + 64 * (j))
#define XB_TOP      3328
#define XB_TOPGEN   3392
#define XCD_BAR_WORDS 3456
#define XB_SPIN_CAP (1u << 18)
#define LAS __attribute__((address_space(3)))
__device__ __forceinline__ unsigned xb_ld(unsigned* p)              { return __hip_atomic_load(p, __ATOMIC_RELAXED, __HIP_MEMORY_SCOPE_AGENT); }
__device__ __forceinline__ unsigned xb_add(unsigned* p, unsigned v) { return __hip_atomic_fetch_add(p, v, __ATOMIC_RELAXED, __HIP_MEMORY_SCOPE_AGENT); }
__device__ __forceinline__ unsigned xb_xcc_id() { return (unsigned)__builtin_amdgcn_s_getreg((3 << 11) | 20) & 0xFu; }
#define XB_SPIN(cond, bar) do { unsigned _sp = 0; while (cond) { __builtin_amdgcn_s_sleep(1); \
    if ((++_sp & 255u) == 0u) { if (xb_ld(&(bar)[XB_TMO])) break; if (_sp > XB_SPIN_CAP) { atomicAdd(&(bar)[XB_TMO], 1u); break; } } } } while (0)
struct XcdBarrier { unsigned* bar; unsigned x; volatile LAS unsigned* st; };
__device__ __forceinline__ XcdBarrier xcd_barrier_post(unsigned* bar, volatile LAS unsigned* st) {
    XcdBarrier b; b.bar = bar; b.x = xb_xcc_id(); b.st = st;
    if (threadIdx.x == 0) (void)xb_add(&bar[XB_XCNT(b.x)], 1u);
    return b;
}
__device__ __forceinline__ void xcd_barrier_complete(unsigned* bar, unsigned x, unsigned& nloc, unsigned& nx) {
    const unsigned Gd = gridDim.x * gridDim.y * gridDim.z;
    unsigned sum, cnt, mine, sp = 0u;
    for (;;) {
        sum = 0u; cnt = 0u; mine = 0u;
#pragma unroll
        for (unsigned j = 0; j < 16; ++j) { const unsigned c = xb_ld(&bar[XB_XCNT(j)]); sum += c; cnt += (c > 0u) ? 1u : 0u; mine = (j == x) ? c : mine; }
        if (sum == Gd) break;
        __builtin_amdgcn_s_sleep(1);
        if ((++sp & 255u) == 0u) { if (xb_ld(&bar[XB_TMO])) break; if (sp > XB_SPIN_CAP) { atomicAdd(&bar[XB_TMO], 1u); break; } }
    }
    nloc = mine > 0u ? mine : 1u; nx = cnt > 0u ? cnt : 1u;
}
__device__ __forceinline__ void xcd_barrier(const XcdBarrier& b) {
    asm volatile("s_waitcnt vmcnt(0)" ::: "memory");
    __syncthreads();
    if (threadIdx.x == 0) {
        unsigned* bar = b.bar;
        unsigned bx = b.x; asm volatile("" : "+s"(bx));
        __builtin_amdgcn_s_waitcnt(0);
        unsigned nloc = b.st[0], nx = b.st[1];
        if (nloc == 0u) { xcd_barrier_complete(bar, bx, nloc, nx); b.st[0] = nloc; b.st[1] = nx; }
        const unsigned old = xb_add(&bar[XB_XSUB(bx)], 1u);
        const unsigned gen = old / nloc;
        if (old + 1u == (gen + 1u) * nloc) {
            __builtin_amdgcn_fence(__ATOMIC_RELEASE, "agent");
            asm volatile("s_waitcnt vmcnt(0)" ::: "memory");
            const unsigned og = xb_add(&bar[XB_TOP], 1u);
            const unsigned tg = og / nx;
            if (og + 1u == (tg + 1u) * nx) xb_add(&bar[XB_TOPGEN], 1u);
            else XB_SPIN(xb_ld(&bar[XB_TOPGEN]) == tg, bar);
            __builtin_amdgcn_fence(__ATOMIC_ACQUIRE, "agent");
            xb_add(&bar[XB_XGEN(bx)], 1u);
            asm volatile("s_waitcnt vmcnt(0)" ::: "memory");
        } else {
            XB_SPIN(xb_ld(&bar[XB_XGEN(bx)]) == gen, bar);
            __builtin_amdgcn_fence(__ATOMIC_ACQUIRE, "agent");
            asm volatile("s_waitcnt vmcnt(0)" ::: "memory");
        }
    }
    __syncthreads();
}
#endif

constexpr int BK = 64, HALF = 128, HT_BYTES = HALF * BK * 2;
DEV int lds_byte(int r, int c) { int st = (r >> 4) * 2 + (c >> 5), rr = r & 15, cc = c & 31, ob = rr * 64 + cc * 2; return st * 1024 + (ob ^ (((ob >> 9) & 1) << 5)); }
DEV void stage_rc(int b, int& Rr, int& Cc) { int st = b / 1024, sb = b % 1024, swz = sb ^ (((sb >> 9) & 1) << 5); Rr = (st >> 1) * 16 + swz / 64; Cc = (st & 1) * 32 + (swz % 64) / 2; }
DEV int perm32(int rho) { const int n = rho >> 4, i = rho & 15; return 8 * (i >> 2) + 4 * n + (i & 3); }

DEV bool tile_order(int i, int nM, int nN, int& pm, int& pn) {
    const int nwg = nM * nN; const int L = i * (int)gridDim.x + (int)blockIdx.x; if (L >= nwg) return false;
    int wgid = L; { const int q = nwg / 8, r = nwg % 8, xcd = wgid % 8, off = wgid / 8; wgid = (xcd < r ? xcd * (q + 1) : r * (q + 1) + (xcd - r) * q) + off; }
    const int nig = 8 * nN, gid = wgid / nig, fm = gid * 8, gsz = (nM - fm) < 8 ? (nM - fm) : 8;
    pm = fm + ((wgid % nig) % gsz); pn = (wgid % nig) / gsz; return true;
}
#ifdef CPU_EMU
#define GLDS16(src, dst) __builtin_amdgcn_global_load_lds((const unsigned*)(src), (unsigned*)((dst) + (TID() & 63) * 16), 16, 0, 0)
#else
#define GLDS16(src, dst) __builtin_amdgcn_global_load_lds((const unsigned*)(src), (unsigned*)(dst), 16, 0, 0)
#endif

#define BAR __builtin_amdgcn_s_barrier()
#define SCHED __builtin_amdgcn_sched_barrier(0)
struct GUnit { int pm, pn, aux; };
template <bool GATHER, int LDA_, int LDB_, int K_, bool F8 = false, class Sched, class Epi>
DEV void gemm_stream(char* shm, const Sched& S, const Epi& epi) {
#define SA(b, h) (shm + ((b) * 2 + (h)) * HT_BYTES)
#define SB(b, h) (shm + (4 + (b) * 2 + (h)) * HT_BYTES)
#define STG_B(P, bp) do { GLDS16((bp) + voffB, (P) + ldsb0); GLDS16((bp) + voffB + 64 * LDB_, (P) + ldsb0 + 8192); } while (0)
#define STG_A(P, ap, h, gv) do { if (GATHER) { GLDS16((ap) + gv[h][0], (P) + ldsb0); GLDS16((ap) + gv[h][1], (P) + ldsb0 + 8192); } \
    else { GLDS16((ap) + voffA + (h) * 128 * LDA_, (P) + ldsb0); GLDS16((ap) + voffA + ((h) * 128 + 64) * LDA_, (P) + ldsb0 + 8192); } } while (0)
#define LDA(dst, b, h) _Pragma("unroll") for (int m = 0; m < 4; ++m) _Pragma("unroll") for (int k = 0; k < 2; ++k) \
    dst[m][k] = *reinterpret_cast<const bf16x8*>(SA(b, h) + aoff + m * 2048 + k * 1024)
#define LDB(dst, b, h) _Pragma("unroll") for (int n = 0; n < 2; ++n) _Pragma("unroll") for (int k = 0; k < 2; ++k) \
    dst[n][k] = *reinterpret_cast<const bf16x8*>(SB(b, h) + boff + n * 2048 + k * 1024)
#define MMA(ai, bj, At_, Bx_) do { __builtin_amdgcn_s_setprio(1); \
    if constexpr (F8) { _Pragma("unroll") for (int m = 0; m < 4; ++m) _Pragma("unroll") for (int n = 0; n < 2; ++n) \
      acc[ai][bj][m][n] = mfma_f8(Bx_[n][0], Bx_[n][1], At_[m][0], At_[m][1], acc[ai][bj][m][n]); } \
    else { _Pragma("unroll") for (int m = 0; m < 4; ++m) _Pragma("unroll") for (int n = 0; n < 2; ++n) _Pragma("unroll") for (int k = 0; k < 2; ++k) \
      acc[ai][bj][m][n] = mfma16(Bx_[n][k], At_[m][k], acc[ai][bj][m][n]); } \
    __builtin_amdgcn_s_setprio(0); } while (0)
    constexpr int nt = K_ / BK;
    const int tid = TID();
    const int wid = __builtin_amdgcn_readfirstlane(tid >> 6), lane = tid & 63, wr = wid >> 2, wc = wid & 3, fr = lane & 15, fq = lane >> 4;
    const int ldsb0 = wid * 1024;
    int Rr0, Cc0; stage_rc(tid * 16, Rr0, Cc0);
    const int voffA = Rr0 * LDA_ + Cc0;
    const int voffB = ((Rr0 & ~31) + perm32(Rr0 & 31)) * LDB_ + Cc0;
    const int aoff = lds_byte(wr * 64 + fr, fq * 8), boff = lds_byte(wc * 32 + fr, fq * 8);
    GUnit cur, nxt; int ui = 0;
    if (!S.next(0, cur)) return;
    int gc[2][2] = {{0, 0}, {0, 0}};
    int* gtab = (int*)(shm + 131072 + 256);
    if (GATHER) {
        __syncthreads();
        { GUnit u; for (int i = 0; i < GT_MAXU && S.next(i, u); ++i) { if (tid < 256) gtab[i * 256 + tid] = S.grow(u, tid) * LDA_; } }
        __syncthreads();
#pragma unroll
        for (int h = 0; h < 2; ++h)
#pragma unroll
            for (int i = 0; i < 2; ++i) gc[h][i] = gtab[h * 128 + i * 64 + Rr0] + Cc0;
    }
    f32x4 acc[2][2][4][2];
#pragma unroll
    for (int a = 0; a < 2; ++a)
#pragma unroll
        for (int b = 0; b < 2; ++b)
#pragma unroll
            for (int m = 0; m < 4; ++m)
#pragma unroll
                for (int n = 0; n < 2; ++n) acc[a][b][m][n] = (f32x4){0.f, 0.f, 0.f, 0.f};
    bf16x8 At[4][2], B0[2][2], B1[2][2];
    const bf16_t* cA = S.a_base(cur); const bf16_t* cB = S.b_base(cur);
    STG_B(SB(0, 0), cB); STG_A(SA(0, 0), cA, 0, gc); STG_B(SB(0, 1), cB + 128 * LDB_); STG_A(SA(0, 1), cA, 1, gc);
    if (wr == 1) BAR;
    WAIT_V(4); BAR;
    STG_B(SB(1, 0), cB + BK); STG_A(SA(1, 0), cA + BK, 0, gc); STG_B(SB(1, 1), cB + 128 * LDB_ + BK);
    WAIT_V(6); BAR;
    for (;;) {
        const bool has_next = S.next(ui + 1, nxt);
        const bf16_t* nA = has_next ? S.a_base(nxt) : cA; const bf16_t* nB = has_next ? S.b_base(nxt) : cB;
#pragma unroll 1
        for (int t = 0; t < nt; t += 2) {
            const bool last = (t == nt - 2);
            const bf16_t* a1 = cA + (t + 1) * BK;
            const bf16_t* a2 = last ? nA : cA + (t + 2) * BK; const bf16_t* b2 = last ? nB : cB + (t + 2) * BK;
            const bf16_t* a3 = a2 + BK; const bf16_t* b3 = b2 + BK;
            LDB(B0, 0, 0); SCHED; LDA(At, 0, 0); STG_A(SA(1, 1), a1, 1, gc);
            if (GATHER && last && has_next) {
#pragma unroll
                for (int h = 0; h < 2; ++h)
#pragma unroll
                    for (int i = 0; i < 2; ++i) gc[h][i] = gtab[(ui + 1) * 256 + h * 128 + i * 64 + Rr0] + Cc0; }
            WAIT_L(8); BAR; WAIT_L(0); MMA(0, 0, At, B0); BAR; SCHED;
            LDB(B1, 0, 1); STG_B(SB(0, 0), b2);
            BAR; WAIT_L(0); MMA(0, 1, At, B1); BAR;
            LDA(At, 0, 1); STG_A(SA(0, 0), a2, 0, gc);
            BAR; WAIT_L(0); MMA(1, 0, At, B0); BAR; SCHED;
            STG_B(SB(0, 1), b2 + 128 * LDB_);
            WAIT_V(6); BAR; MMA(1, 1, At, B1); BAR;
            LDB(B0, 1, 0); SCHED; LDA(At, 1, 0); STG_A(SA(0, 1), a2, 1, gc);
            WAIT_L(8); BAR; WAIT_L(0); MMA(0, 0, At, B0); BAR; SCHED;
            LDB(B1, 1, 1); STG_B(SB(1, 0), b3);
            BAR; WAIT_L(0); MMA(0, 1, At, B1); BAR;
            LDA(At, 1, 1); STG_A(SA(1, 0), a3, 0, gc);
            BAR; WAIT_L(0); MMA(1, 0, At, B0); BAR; SCHED;
            STG_B(SB(1, 1), b3 + 128 * LDB_);
            WAIT_V(6); BAR; MMA(1, 1, At, B1); BAR;
        }
        {
            const int tz = TID(); const int wz = tz >> 6, lz = tz & 63, wrz = wz >> 2, wcz = wz & 3, frz = lz & 15, fqz = lz >> 4;
            epi(cur, acc, wrz * 64 + frz, wcz * 32 + 8 * fqz);
        }
        if (!has_next) break;
#pragma unroll
        for (int a = 0; a < 2; ++a)
#pragma unroll
            for (int b = 0; b < 2; ++b)
#pragma unroll
                for (int m = 0; m < 4; ++m)
#pragma unroll
                    for (int n = 0; n < 2; ++n) acc[a][b][m][n] = (f32x4){0.f, 0.f, 0.f, 0.f};
        cur = nxt; cA = nA; cB = nB; ++ui;
    }
    WAIT_V(0);
    if (wr == 0) BAR;
    BAR;
#undef SA
#undef SB
#undef STG_A
#undef STG_B
#undef LDA
#undef LDB
#undef MMA
}

constexpr int J_IN = 16 * 27, J_WB = 2 * 8 * 4, J_WO = 16 * 4, J_GU = 16 * 2 * 64, J_DN = 16 * 64, J_FOLD = 8 * 16, J_PAD = 1;
constexpr int N_MODJOBS = 2 * 96;

constexpr int J_BIG = J_IN + J_WB + J_WO + J_GU + J_DN;
struct WJob { const float* src; bf16_t* dst; int ldsrc, lddst, nvalid, k0, n0, mode, gu_which, f8; };
DEV WJob wjob_decode(const Params& p, int l, int j) {
    WJob w; w.ldsrc = 1024; w.lddst = 1024; w.nvalid = 256; w.mode = 0; w.gu_which = 0; w.f8 = 0;
    if (j < J_IN) { const int kt = j / 27, nb = j % 27; w.k0 = kt * 64; w.n0 = nb * 256; w.src = p.w_in + (size_t)l * 1024 * PWSRC; w.ldsrc = PWSRC; w.nvalid = PWSRC - w.n0; w.dst = p.WinT() + (size_t)l * PWT * 1024; w.mode = 3; }
    else if ((j -= J_IN) < J_WB) { const int bi = (j / 32) * 2, jj = j % 32, kt = jj / 4, nb = jj % 4; w.k0 = kt * 64; w.n0 = nb * 256;
        w.src = p.w_branch + ((size_t)l * 3 + bi) * 512 * 1024; w.dst = p.WbT() + ((size_t)l * 3 + bi) * 1024 * 512; w.lddst = 512; }
    else if ((j -= J_WB) < J_WO) { const int kt = j / 4, nb = j % 4; w.k0 = kt * 64; w.n0 = nb * 256; w.src = p.w_out + (size_t)l * 1024 * 1024; w.dst = p.WoT() + (size_t)l * 1024 * 1024; }
    else if ((j -= J_WO) < J_GU) { const int e = j / 128, jj = j % 128; w.gu_which = jj / 64; const int j3 = jj % 64, kt = j3 / 4, nb = j3 % 4; w.k0 = kt * 64; w.n0 = nb * 256;
        w.src = (w.gu_which ? p.w_up : p.w_gate) + ((size_t)l * 16 + e) * 1024 * 1024; w.dst = p.WguT() + ((size_t)l * 16 + e) * 2048 * 512; w.mode = 1; w.f8 = 1; }
    else { j -= J_GU; const int e = j / 64, jj = j % 64, kt = jj / 4, nb = jj % 4; w.k0 = kt * 64; w.n0 = nb * 256;
        w.src = p.w_down + ((size_t)l * 16 + e) * 1024 * 1024; w.dst = p.WdT() + ((size_t)l * 16 + e) * 1024 * 512; w.f8 = 1; }
    return w;
}
constexpr int WT_LD = 260;
DEV void wjob_load(const WJob& w, int tid, f32x4 (&vv)[8]) {
#pragma unroll
    for (int i = 0; i < 8; ++i) { const int idx = i * 512 + tid, r = idx >> 6, c = (idx & 63) * 4; int col = w.n0 + c; col = col > w.ldsrc - 4 ? w.ldsrc - 4 : col;
        vv[i] = ldg((const f32x4*)(w.src + (size_t)(w.k0 + r) * w.ldsrc + col)); }
}
DEV void wjob_finish(const WJob& w, int tid, const f32x4 (&vv)[8], float* tile) {
    __syncthreads();
#pragma unroll
    for (int i = 0; i < 8; ++i) { const int idx = i * 512 + tid, r = idx >> 6, c = (idx & 63) * 4; *(f32x4*)(tile + r * WT_LD + c) = vv[i]; }
    __syncthreads();
#pragma unroll
    for (int q = 0; q < 4; ++q) {
        const int item = q * 512 + tid, nrow = item >> 3, kc = (item & 7) * 8;
        float v[8];
#pragma unroll
        for (int jj = 0; jj < 8; ++jj) v[jj] = tile[(kc + jj) * WT_LD + nrow];
        const int n = w.n0 + nrow;
        int drow = n; bool f8 = w.f8 != 0; size_t f8base = 0;
        if (w.mode == 1) drow = (n >> 7) * 256 + w.gu_which * 128 + (n & 127);
        if (w.mode == 3) {
            if (n >= C_SPLIT) { f8 = true; f8base = (size_t)PWA * 2048; drow = n - C_SPLIT; }
            else { drow = proj_col(n); if (drow >= C_VM) { f8 = true; f8base = (size_t)C_VM * 2048; drow -= C_VM; } } }
        if (f8) { const u32x2 o = {f8pack4(v[0] * F8_WSCALE, v[1] * F8_WSCALE, v[2] * F8_WSCALE, v[3] * F8_WSCALE), f8pack4(v[4] * F8_WSCALE, v[5] * F8_WSCALE, v[6] * F8_WSCALE, v[7] * F8_WSCALE)};
            if (nrow < w.nvalid) stg((u32x2*)((unsigned char*)w.dst + f8base + (size_t)drow * 1024 + w.k0 + kc), o); }
        else if (nrow < w.nvalid) { u32x4 o = {pack2(v[0], v[1]), pack2(v[2], v[3]), pack2(v[4], v[5]), pack2(v[6], v[7])};
            stg((u32x4*)(w.dst + (size_t)drow * w.lddst + w.k0 + kc), o); }
    }
}
DEV void pro_small_job(const Params& p, int l, int j, char* shm) {
    float* tile = (float*)shm;
    const int tid = TID();
    if (j < J_FOLD) {
        const int kt = j / 16, ntl = j % 16, k0 = kt * 64, n0 = ntl * 64; const int fg = k0 / 128;
        const float* wb1 = p.w_branch + ((size_t)l * 3 + 1) * 512 * 1024;
        const float* pw = p.pool_w + ((size_t)l * 4 + fg) * 128 * 128; const float* ps = p.pool_scale + (size_t)l * 512 + fg * 128;
        const int c = tid & 63, rq = tid >> 6;
        float accv[8];
#pragma unroll
        for (int i = 0; i < 8; ++i) accv[i] = 0.f;
        for (int d = 0; d < 128; ++d) { const float wv = ldg(wb1 + (size_t)(fg * 128 + d) * 1024 + n0 + c) * ldg(ps + d);
#pragma unroll
            for (int i = 0; i < 8; ++i) accv[i] += ldg(pw + (size_t)(k0 - fg * 128 + rq * 8 + i) * 128 + d) * wv; }
        __syncthreads();
#pragma unroll
        for (int i = 0; i < 8; ++i) tile[(rq * 8 + i) * WT_LD + c] = accv[i];
        __syncthreads();
        const int nrow = tid >> 3, kc = (tid & 7) * 8; float v[8];
#pragma unroll
        for (int jj = 0; jj < 8; ++jj) v[jj] = tile[(kc + jj) * WT_LD + nrow];
        u32x4 o = {pack2(v[0], v[1]), pack2(v[2], v[3]), pack2(v[4], v[5]), pack2(v[6], v[7])};
        stg((u32x4*)(p.WbT() + ((size_t)l * 3 + 1) * 1024 * 512 + (size_t)(n0 + nrow) * 512 + k0 + kc), o);
    } else {
        bf16_t* d0 = p.WinT() + (size_t)l * PWT * 1024 + (size_t)C_PADA * 1024;
        for (int i = tid; i < (C_VM - C_PADA) * 1024 / 8; i += NTHREADS) stg((u32x4*)(d0 + (size_t)i * 8), (u32x4){0u, 0u, 0u, 0u});
    }
}

DEV void pro_mod_job(const Params& p, int job, char* shm) {
    float* sv = (float*)shm;
    const int tid = TID(), l = job / 96, col0 = (job % 96) * 64;
    const int c = tid & 63, kp = tid >> 6;
    float acc[NB + 1];
#pragma unroll
    for (int v = 0; v <= NB; ++v) acc[v] = 0.f;
    for (int half = 0; half < 2; ++half) {
        __syncthreads();
        for (int idx = tid; idx < (NB + 1) * 512; idx += 512) { const int v = idx >> 9, k = idx & 511;
            const float s = (v < NB) ? ldg(p.c + (size_t)v * 1024 + half * 512 + k) : ldg(p.c_ctx + half * 512 + k);
            sv[idx] = s * sigmoidf_(s); }
        __syncthreads();
        for (int kk = 0; kk < 64; ++kk) { const int k = kp * 64 + kk;
            const float w = ldg(p.ada_w + ((size_t)l * 1024 + half * 512 + k) * 6144 + col0 + c);
#pragma unroll
            for (int v = 0; v <= NB; ++v) acc[v] += sv[v * 512 + k] * w; }
    }
    __syncthreads();
    float* red = (float*)shm;
#pragma unroll
    for (int v = 0; v <= NB; ++v) red[(kp * (NB + 1) + v) * 64 + c] = acc[v];
    __syncthreads();
    for (int idx = tid; idx < (NB + 1) * 64; idx += 512) { const int v = idx >> 6, cc = idx & 63; float s = 0.f;
#pragma unroll
        for (int q = 0; q < 8; ++q) s += red[(q * (NB + 1) + v) * 64 + cc];
        stg(p.mod() + ((size_t)l * (NB + 1) + v) * 6144 + col0 + cc, s + ldg(p.ada_b + (size_t)l * 6144 + col0 + cc)); }
}

DEV void phase_prologue(const Params& p, char* shm) {
    const int tid = TID();
    const int nsmall = N_MODJOBS + 1 + 2 * (J_FOLD + J_PAD);
    for (int job = blockIdx.x; job < nsmall; job += gridDim.x) {
        if (job < N_MODJOBS) pro_mod_job(p, job, shm);
        else if (job == N_MODJOBS) {
            for (int idx = tid; idx < (ROWS + 64) * 16; idx += NTHREADS) { const int pos = idx >> 4, i = idx & 15;
                const float pv = (float)(pos < ROWS ? pos : pos - ROWS);
                const float inv = powf(10000.0f, -(float)(2 * i) / 32.0f);
                const float a = pv * inv; stg(p.rope() + idx * 2, cosf(a)); stg(p.rope() + idx * 2 + 1, sinf(a)); }
        } else { const int sj = job - N_MODJOBS - 1; pro_small_job(p, sj / (J_FOLD + J_PAD), sj % (J_FOLD + J_PAD), shm); }
    }
    float* tile = (float*)shm;
    const int nbig = 2 * J_BIG;
    int job = blockIdx.x;
    if (job >= nbig) return;
    WJob wc = wjob_decode(p, job / J_BIG, job % J_BIG), wn = wc;
    f32x4 vc[8], vn[8];
    wjob_load(wc, tid, vc);
    for (; job < nbig; job += gridDim.x) {
        const int jn = job + gridDim.x;
        if (jn < nbig) { wn = wjob_decode(p, jn / J_BIG, jn % J_BIG); wjob_load(wn, tid, vn); }
        wjob_finish(wc, tid, vc, tile);
        wc = wn;
#pragma unroll
        for (int i = 0; i < 8; ++i) vc[i] = vn[i];
    }
}

DEV const float* xsrc_base(const Params& p, const SetDesc& sd, int layer) {
    return (sd.is_ctx ? (layer == 0 ? p.ctx : (const float*)p.ctxs()) : (layer == 0 ? p.x : (const float*)p.out)) + (((size_t)sd.samp0) << sd.lgseq) * 1024;
}
DEV float* xdst_base(const Params& p, const SetDesc& sd) { return (sd.is_ctx ? p.ctxs() : p.out) + (((size_t)sd.samp0) << sd.lgseq) * 1024; }
DEV const float* mod_row(const Params& p, const SetDesc& sd, int layer, int row) {
    return p.mod() + ((size_t)layer * (NB + 1) + (sd.is_ctx ? NB : sd.samp0 + (row >> sd.lgseq))) * 6144;
}
DEV bf16_t* proj_buf(const Params& p, const SetDesc& sd) { return sd.is_ctx ? p.PROJc() : p.PROJa(); }

DEV void stage_params(float* par, const float* v0, const float* v1, const float* v2, const float* v3, const float* v4) {
    const int tid = TID();
    const float* src[5] = {v0, v1, v2, v3, v4};
#pragma unroll
    for (int k = 0; k < 5; ++k) if (src[k]) { for (int i = tid; i < 1024; i += NTHREADS) par[k * 1024 + i] = ldg(src[k] + i); }
}
DEV void phase_norm1(const Params& p, const SetDesc& sd, int layer, char* shm) {
    const int tid = TID(), lane = tid & 63, wv = tid >> 6;
    const float* g0 = p.norm_gain + ((size_t)layer * 4 + 0) * 1024;
    const float* xb = xsrc_base(p, sd, layer);
    const int stride = 8; const int rpb_ = (sd.nrows + (int)gridDim.x - 1) / (int)gridDim.x; const int row_end = min(sd.nrows, ((int)blockIdx.x + 1) * rpb_);
    int row = (int)blockIdx.x * rpb_ + wv;
    float* par = (float*)shm;
    __syncthreads();
    { const float* mdb = mod_row(p, sd, layer, min((int)blockIdx.x * rpb_, sd.nrows - 1)); stage_params(par, g0, mdb, mdb + 1024, nullptr, nullptr); }
    __syncthreads();
    f32x4 cur[4], nxt[4];
    if (row < row_end) {
#pragma unroll
        for (int i = 0; i < 4; ++i) cur[i] = ldg((const f32x4*)(xb + (size_t)row * 1024 + (i >> 1) * 512 + lane * 8 + (i & 1) * 4)); }
    for (; row < row_end; row += stride) {
        const int rn = row + stride;
        if (rn < row_end) {
#pragma unroll
            for (int i = 0; i < 4; ++i) nxt[i] = ldg((const f32x4*)(xb + (size_t)rn * 1024 + (i >> 1) * 512 + lane * 8 + (i & 1) * 4)); }
        const float* md = mod_row(p, sd, layer, row);
        float ss = 0.f;
#pragma unroll
        for (int i = 0; i < 4; ++i)
#pragma unroll
            for (int j = 0; j < 4; ++j) ss += cur[i][j] * cur[i][j];
        ss = wave_sum(ss);
        const float rstd = rsqrtf(ss * (1.0f / 1024.0f) + RMS_EPS);
#pragma unroll
        for (int hlf = 0; hlf < 2; ++hlf) { const int c0 = hlf * 512 + lane * 8; float o[8];
#pragma unroll
            for (int j = 0; j < 8; ++j) o[j] = cur[hlf * 2 + (j >> 2)][j & 3] * rstd * par[c0 + j] * (1.0f + par[2048 + c0 + j]) + par[1024 + c0 + j];
            u32x4 ov = {pack2(o[0], o[1]), pack2(o[2], o[3]), pack2(o[4], o[5]), pack2(o[6], o[7])};
            stg((u32x4*)(p.H() + (size_t)row * 1024 + c0), ov);
            const u32x2 o8 = {f8pack4(o[0], o[1], o[2], o[3]), f8pack4(o[4], o[5], o[6], o[7])};
            stg((u32x2*)(p.H8() + (size_t)row * 1024 + c0), o8); }
#pragma unroll
        for (int i = 0; i < 4; ++i) cur[i] = nxt[i];
    }
}

struct SchedPlain {
    const bf16_t* A; const bf16_t* Bt; int nM, nN, lda256, ldb256;
    DEV bool next(int i, GUnit& u) const { u.aux = 0; return tile_order(i, nM, nN, u.pm, u.pn); }
    DEV const bf16_t* a_base(const GUnit& u) const { return A + (size_t)u.pm * lda256; }
    DEV const bf16_t* b_base(const GUnit& u) const { return Bt + (size_t)u.pn * ldb256; }
    DEV int grow(const GUnit&, int) const { return 0; }
};
struct SchedPlainT : SchedPlain {
    DEV const bf16_t* a_base(const GUnit&) const { return A; }
    DEV int grow(const GUnit& u, int i) const { return u.pm * 256 + i; }
};
DEV void phase_proj_a(const Params& p, const SetDesc& sd, int layer, char* shm) {
    bf16_t* pb = proj_buf(p, sd);
    {
        SchedPlain S; S.A = p.H(); S.Bt = p.WinT() + (size_t)layer * PWT * 1024; S.nM = sd.nrows / 256; S.nN = C_VM / 256; S.lda256 = 256 * 1024; S.ldb256 = 256 * 1024;
        gemm_stream<false, 1024, 1024, 1024>(shm, S, [=](const GUnit& u, const f32x4 (&acc)[2][2][4][2], int r0, int c0) {
#pragma unroll
            for (int ai = 0; ai < 2; ++ai)
#pragma unroll
                for (int m = 0; m < 4; ++m) { bf16_t* o = pb + ((size_t)u.pm * 256 + r0 + ai * 128 + m * 16) * PWA + u.pn * 256 + c0;
                    store8bf(o, acc[ai][0][m][0], acc[ai][0][m][1]); store8bf(o + 128, acc[ai][1][m][0], acc[ai][1][m][1]); } });
    }
    {
        SchedPlainT S; S.A = (const bf16_t*)p.H8(); S.Bt = p.WinT() + (size_t)layer * PWT * 1024 + (size_t)C_VM * 1024; S.nM = sd.nrows / 256; S.nN = (PWA - C_VM) / 256; S.lda256 = 256 * 512; S.ldb256 = 256 * 512;
        gemm_stream<true, 512, 512, 512, true>(shm, S, [=](const GUnit& u, const f32x4 (&acc)[2][2][4][2], int r0, int c0) {
#pragma unroll
            for (int ai = 0; ai < 2; ++ai)
#pragma unroll
                for (int m = 0; m < 4; ++m) { bf16_t* o = pb + ((size_t)u.pm * 256 + r0 + ai * 128 + m * 16) * PWA + C_VM + u.pn * 256 + c0;
                    store8bf(o, acc[ai][0][m][0] * F8_WINV, acc[ai][0][m][1] * F8_WINV); store8bf(o + 128, acc[ai][1][m][0] * F8_WINV, acc[ai][1][m][1] * F8_WINV); } });
    }
}
DEV f32x4 sig4(f32x4 v) { f32x4 r; r[0] = sigmoidf_(v[0]); r[1] = sigmoidf_(v[1]); r[2] = sigmoidf_(v[2]); r[3] = sigmoidf_(v[3]); return r; }
DEV void phase_proj_b(const Params& p, const SetDesc& sd, int layer, char* shm) {
    SchedPlainT S; S.A = (const bf16_t*)p.H8(); S.Bt = p.WinT() + (size_t)layer * PWT * 1024 + (size_t)PWA * 1024; S.nM = sd.nrows / 256; S.nN = NBG / 256; S.lda256 = 256 * 512; S.ldb256 = 256 * 512;
    bf16_t* bg = p.BG();
    gemm_stream<true, 512, 512, 512, true>(shm, S, [=](const GUnit& u, const f32x4 (&acc)[2][2][4][2], int r0, int c0) {
#pragma unroll
        for (int ai = 0; ai < 2; ++ai)
#pragma unroll
            for (int m = 0; m < 4; ++m) { bf16_t* o = bg + ((size_t)u.pm * 256 + r0 + ai * 128 + m * 16) * NBG + u.pn * 256 + c0;
                store8bf(o, sig4(acc[ai][0][m][0] * F8_WINV), sig4(acc[ai][0][m][1] * F8_WINV)); store8bf(o + 128, sig4(acc[ai][1][m][0] * F8_WINV), sig4(acc[ai][1][m][1] * F8_WINV)); } });
}

DEV void gate_scan(const bf16_t* prow, int h, const float* gbias, float* ga, float* gb, float* gpm, float* gtot, float* tmp) {
    const int tid = TID(), lane = tid & 63, w = tid >> 6;
    float b = 0.f, a = 0.f, pm = 0.f; int d = 0, tok = 0;
    if (tid < 256) {
        d = tid >> 7; const int i = tid & 127; tok = d ? 127 - i : i;
        const float gi = bf2f(ldg(prow + (size_t)tok * PWA + C_GM + (2 * d) * 4 + h)) + ldg(gbias + (2 * d) * 4 + h);
        const float gf = bf2f(ldg(prow + (size_t)tok * PWA + C_GM + (2 * d + 1) * 4 + h)) + ldg(gbias + (2 * d + 1) * 4 + h);
        b = logsigmoidf_(gf);
#pragma unroll
        for (int o = 1; o < 64; o <<= 1) { const float t = __shfl_up(b, o); if (lane >= o) b += t; }
        if (lane == 63) tmp[w] = b;
        a = gi;
    }
    __syncthreads();
    if (tid < 256) {
        if (w & 1) b += tmp[w - 1];
        a -= b; pm = a;
#pragma unroll
        for (int o = 1; o < 64; o <<= 1) { const float t = __shfl_up(pm, o); if (lane >= o) pm = fmaxf(pm, t); }
        if (lane == 63) tmp[8 + w] = pm;
    }
    __syncthreads();
    if (tid < 256) {
        if (w & 1) pm = fmaxf(pm, tmp[8 + w - 1]);
        ga[d * 128 + tok] = a; gb[d * 128 + tok] = b; gpm[d * 128 + tok] = pm;
        if ((tid & 127) == 127) { gtot[d * 2] = b; gtot[d * 2 + 1] = pm; }
    }
    __syncthreads();
}

DEV void load_rope_chunk(const bf16_t* hp, int cidx, bool latent, int tl, const float* rope, float scale, float* o) {
    const u32x4 m = ldg((const u32x4*)(hp + cidx * 8));
    float x[8] = {lo16(m.x), hi16(m.x), lo16(m.y), hi16(m.y), lo16(m.z), hi16(m.z), lo16(m.w), hi16(m.w)};
    if (latent) {
        const u32x4 q = ldg((const u32x4*)(hp + (cidx ^ 2) * 8));
        const float y[8] = {lo16(q.x), hi16(q.x), lo16(q.y), hi16(q.y), lo16(q.z), hi16(q.z), lo16(q.w), hi16(q.w)};
        const int pos = (cidx < 4) ? (tl >> 6) : (ROWS + (tl & 63));
        const float* tb = rope + ((size_t)pos * 16 + (cidx & 1) * 8) * 2;
        const bool first = (cidx & 2) == 0;
#pragma unroll
        for (int j = 0; j < 8; ++j) { const float cs = ldg(tb + j * 2), sn = ldg(tb + j * 2 + 1);
            x[j] = first ? (x[j] * cs - y[j] * sn) : (x[j] * cs + y[j] * sn); }
    }
#pragma unroll
    for (int j = 0; j < 8; ++j) o[j] = x[j] * scale;
}

DEV int st_index(const SetDesc& sd, int sl, int h, int dir, int tb) { return ((sl * 4 + h) * 2 + dir) * sd.ntb + tb; }

constexpr int V_LD = 144, K_LD = 72, KS_LD = 80;
DEV void mlstm_stepA_task(const Params& p, const SetDesc& sd, int layer, int task, char* shm) {
    const int tid = TID(), lane = tid & 63, w = tid >> 6, fr = lane & 15, fq = lane >> 4, tq4 = (lane & 15) >> 2, tp4 = lane & 3;
    const int tb = task % sd.ntb, h = (task / sd.ntb) & 3, sl = task / (sd.ntb * 4);
    const int row0 = (sl << sd.lgseq) + tb * 128; const bool latent = !sd.is_ctx; const int tl0 = tb * 128;
    bf16_t* Vs = (bf16_t*)shm;
    bf16_t* Ksc = (bf16_t*)(shm + 128 * V_LD * 2);
    float* ga = (float*)(shm + 128 * V_LD * 2 + 2 * 128 * KS_LD * 2); float* gb = ga + 256; float* gpm = gb + 256; float* gtot = gpm + 256; float* tmp = gtot + 8;
    const bf16_t* prow = proj_buf(p, sd) + (size_t)row0 * PWA;
    __syncthreads();
    gate_scan(prow, h, p.gate_bias + (size_t)layer * 16, ga, gb, gpm, gtot, tmp);
    {
        const int s = tid & 127, cpi = tid >> 7, cp = (cpi & 1) + (cpi >> 1) * 4;
        const bf16_t* hp = prow + (size_t)s * PWA + C_KM + h * 64;
        float k1[8], k2[8];
        load_rope_chunk(hp, cp, latent, tl0 + s, p.rope(), 1.0f, k1);
        load_rope_chunk(hp, cp + 2, latent, tl0 + s, p.rope(), 1.0f, k2);
#pragma unroll
        for (int dir = 0; dir < 2; ++dir) { const float ws = __expf(ga[dir * 128 + s] - gtot[dir * 2 + 1]);
            u32x4 o1 = {pack2(k1[0] * ws, k1[1] * ws), pack2(k1[2] * ws, k1[3] * ws), pack2(k1[4] * ws, k1[5] * ws), pack2(k1[6] * ws, k1[7] * ws)};
            u32x4 o2 = {pack2(k2[0] * ws, k2[1] * ws), pack2(k2[2] * ws, k2[3] * ws), pack2(k2[4] * ws, k2[5] * ws), pack2(k2[6] * ws, k2[7] * ws)};
            *(u32x4*)(Ksc + (dir * 128 + s) * KS_LD + cp * 8) = o1; *(u32x4*)(Ksc + (dir * 128 + s) * KS_LD + (cp + 2) * 8) = o2; }
    }
#pragma unroll
    for (int it = 0; it < 4; ++it) { const int item = tid + it * 512, s = item >> 4, ch = item & 15;
        *(u32x4*)(Vs + s * V_LD + ch * 8) = ldg((const u32x4*)(prow + (size_t)s * PWA + C_VM + h * 128 + ch * 8)); }
    __syncthreads();
    f32x4 acc[2][4];
#pragma unroll
    for (int dir = 0; dir < 2; ++dir)
#pragma unroll
        for (int n = 0; n < 4; ++n) acc[dir][n] = (f32x4){0.f, 0.f, 0.f, 0.f};
#pragma unroll
    for (int ks = 0; ks < 4; ++ks) {
        const bf16_t* vp = Vs + (32 * ks + 4 * fq + tq4) * V_LD + w * 16 + 4 * tp4;
        const bf16x8 af = mk8(TR16(vp), TR16(vp + 16 * V_LD));
#pragma unroll
        for (int dir = 0; dir < 2; ++dir)
#pragma unroll
            for (int n = 0; n < 4; ++n) { const bf16_t* kp = Ksc + (dir * 128 + 32 * ks + 4 * fq + tq4) * KS_LD + n * 16 + 4 * tp4;
                const bf16x8 bfv = mk8(TR16(kp), TR16(kp + 16 * KS_LD));
                acc[dir][n] = mfma16(af, bfv, acc[dir][n]); }
    }
#pragma unroll
    for (int dir = 0; dir < 2; ++dir) { float* So = p.Sst() + (size_t)st_index(sd, sl, h, dir, tb) * 8192;
#pragma unroll
        for (int n = 0; n < 4; ++n)
#pragma unroll
            for (int r = 0; r < 4; ++r) stg(So + (w * 16 + fq * 4 + r) * 64 + n * 16 + fr, (float)acc[dir][n][r]); }
    if (tid < 128) { const int dir = tid >> 6, dd = tid & 63; float sm = 0.f;
        for (int i = 0; i < 128; ++i) sm += bf2f(Ksc[(dir * 128 + i) * KS_LD + dd]);
        stg(p.Sn() + (size_t)st_index(sd, sl, h, dir, tb) * 64 + dd, sm); }
    if (tid < 2) { float* sc = p.Ssc() + (size_t)st_index(sd, sl, h, tid, tb) * 4; stg(sc, gtot[tid * 2]); stg(sc + 1, gtot[tid * 2] + gtot[tid * 2 + 1]); }
}

template <int GI> DEV void pool_group(const Params& p, const SetDesc& sd, const bf16_t* pb) {
    constexpr int W = 2 << GI;
    const int nitems = sd.nrows * 16; const int T = 1 << sd.lgseq;
    for (int item = blockIdx.x * NTHREADS + TID(); item < nitems; item += gridDim.x * NTHREADS) {
        const int row = item >> 4, ch = GI * 128 + (item & 15) * 8;
        const int tt = row & (T - 1);
        u32x4 mv[W]; int cnt = 0; bool okv[W];
#pragma unroll
        for (int q = 0; q < W; ++q) { const int t2 = tt - W / 2 + q; const bool ok = (t2 >= 0) && (t2 < T); cnt += ok ? 1 : 0; okv[q] = ok;
            mv[q] = ldg((const u32x4*)(pb + (size_t)(ok ? (row - W / 2 + q) : row) * PWA + C_PU + ch)); }
        float s[8];
#pragma unroll
        for (int j = 0; j < 8; ++j) s[j] = 0.f;
#pragma unroll
        for (int q = 0; q < W; ++q) { u32x4 m = mv[q]; if (!okv[q]) m = (u32x4){0u, 0u, 0u, 0u};
            s[0] += lo16(m.x); s[1] += hi16(m.x); s[2] += lo16(m.y); s[3] += hi16(m.y); s[4] += lo16(m.z); s[5] += hi16(m.z); s[6] += lo16(m.w); s[7] += hi16(m.w); }
        const float inv = frcp((float)cnt);
        const u32x4 m = mv[W / 2];
        const float u[8] = {lo16(m.x), hi16(m.x), lo16(m.y), hi16(m.y), lo16(m.z), hi16(m.z), lo16(m.w), hi16(m.w)};
        u32x4 o = {pack2(s[0] * inv - u[0], s[1] * inv - u[1]), pack2(s[2] * inv - u[2], s[3] * inv - u[3]), pack2(s[4] * inv - u[4], s[5] * inv - u[5]), pack2(s[6] * inv - u[6], s[7] * inv - u[7])};
        stg((u32x4*)(p.Pb() + (size_t)row * 512 + ch), o);
    }
}
DEV void phase_pool(const Params& p, const SetDesc& sd) {
    const bf16_t* pb = proj_buf(p, sd);
    pool_group<0>(p, sd, pb); pool_group<1>(p, sd, pb); pool_group<2>(p, sd, pb); pool_group<3>(p, sd, pb);
}

template <int NC> DEV void mlstm_stepB_run(const Params& p, const SetDesc& sd, int task) {
    const int tid = TID();
    const int q = task & 3, dir = (task >> 2) & 1, h = (task >> 3) & 3, sl = task >> 5;
    const int ci = ((sd.samp0 + sl) * 4 + h) * 2 + dir;
    const int eoff = q * 2048 + tid * 4;
    float zr = 0.f; HIDE(zr);
    f32x4 C = {zr, zr, zr, zr}; float nv = 0.f; float m = -1e30f;
    f32x4 Sv[NC]; float blv[NC], mlv[NC], snv[NC];
#pragma unroll
    for (int c = 0; c < NC; ++c) { const int tb = dir ? NC - 1 - c : c; const size_t si = st_index(sd, sl, h, dir, tb);
        Sv[c] = ldg((const f32x4*)(p.Sst() + si * 8192 + eoff)); blv[c] = ldg(p.Ssc() + si * 4); mlv[c] = ldg(p.Ssc() + si * 4 + 1);
        snv[c] = (q == 0 && tid < 64) ? ldg(p.Sn() + si * 64 + tid) : 0.f; }
    if (!sd.is_ctx) { C = ldg((const f32x4*)(p.CiC() + (size_t)ci * 8192 + eoff)); if (q == 0 && tid < 64) nv = ldg(p.Cin_() + (size_t)ci * 64 + tid); m = ldg(p.Cim() + (size_t)ci * 4); }
#pragma unroll
    for (int c = 0; c < NC; ++c) {
        const int tb = dir ? NC - 1 - c : c; const size_t si = st_index(sd, sl, h, dir, tb);
        u32x2 o = {pack2(C[0], C[1]), pack2(C[2], C[3])};
        stg((u32x2*)(p.Cin() + si * 8192 + eoff), o);
        if (q == 0 && tid < 64) stg(p.Cn() + si * 64 + tid, nv);
        if (q == 0 && tid == 0) stg(p.Cm() + si * 4, m);
        const float mn = fmaxf(blv[c] + m, mlv[c]);
        const float dc = __expf(blv[c] + m - mn), wsn = __expf(mlv[c] - mn);
        C = C * dc + Sv[c] * wsn;
        nv = nv * dc + snv[c] * wsn;
        m = mn;
    }
    if (sd.is_ctx) { stg((f32x4*)(p.CiC() + (size_t)ci * 8192 + eoff), C); if (q == 0 && tid < 64) stg(p.Cin_() + (size_t)ci * 64 + tid, nv); if (q == 0 && tid == 0) stg(p.Cim() + (size_t)ci * 4, m); }
}
DEV void mlstm_stepB_task(const Params& p, const SetDesc& sd, int task) {
    if (sd.is_ctx) mlstm_stepB_run<NTBC>(p, sd, task); else mlstm_stepB_run<NTBL>(p, sd, task);
}

constexpr int NA_KLD = 136, NA_VLD = 144;
DEV void na_task(const Params& p, const SetDesc& sd, int layer, int sl, int rq2  , int hp, char* shm) {
    const int tid = TID(), lane = tid & 63, w = tid >> 6, tq = lane & 15, fq = lane >> 4, tq4 = (lane & 15) >> 2, tp4 = lane & 3;
    const int hh = w >> 2, g = w & 3, head = hp * 2 + hh;
    const bool ctxq = sd.is_ctx;
    bf16_t* Ks = (bf16_t*)shm;
    bf16_t* Vs = (bf16_t*)(shm + 128 * NA_KLD * 2);
    float* rpbs = (float*)(shm + 128 * NA_KLD * 2 + 128 * NA_VLD * 2);
    const int sample = sd.samp0 + sl;
    const bf16_t* pq = proj_buf(p, sd) + ((size_t)sl << sd.lgseq) * PWA;
    const bf16_t* pc = p.PROJc() + (size_t)sample * CTX * PWA;
    const int qcol = g * 16 + tq;
    int rqv[2], rsv[2], qtok[2];
#pragma unroll
    for (int u = 0; u < 2; ++u) { rqv[u] = 2 * rq2 + u; qtok[u] = rqv[u] * 64 + qcol; int r_ = rqv[u] - 4; rsv[u] = r_ < 0 ? 0 : (r_ > ROWS - 8 ? ROWS - 8 : r_); }
    const int nloc = ctxq ? 0 : (rsv[1] + 8 - rsv[0]);
    const int nstage = nloc + CTX / 64;
    __syncthreads();
    if (!ctxq) for (int i = tid; i < 2 * 465; i += NTHREADS) rpbs[i] = ldg(p.rpb + ((size_t)layer * 8 + hp * 2 + i / 465) * 465 + i % 465);
    bf16x8 qf[2][2];
#pragma unroll
    for (int u = 0; u < 2; ++u)
#pragma unroll
        for (int ks = 0; ks < 2; ++ks) qf[u][ks] = mk8(ldg((const u32x4*)(pq + (size_t)qtok[u] * PWA + C_QN + head * 64 + ks * 32 + fq * 8)));
    float m_run[2] = {-1e30f, -1e30f}, l_run[2] = {0.f, 0.f};
    f32x4 acc[2][4];
#pragma unroll
    for (int u = 0; u < 2; ++u)
#pragma unroll
        for (int mt = 0; mt < 4; ++mt) acc[u][mt] = (f32x4){0.f, 0.f, 0.f, 0.f};
    int cs = qcol - 8; cs = cs < 0 ? 0 : (cs > 48 ? 48 : cs);
    const int kc0 = (g == 0) ? 0 : (g == 1) ? 8 : (g == 2) ? 24 : 32;
    const int npair = (nstage + 1) >> 1;
    u32x4 kreg[4], vreg[4];
#define NA_SRC_ROWS(stg) (((stg) < nloc) ? (pq + (size_t)((rsv[0] + (stg)) * 64) * PWA) : (pc + (size_t)((((stg) < nstage ? (stg) : nstage - 1) - nloc) * 64) * PWA))
#define NA_FETCH(sp_) do { _Pragma("unroll") for (int it = 0; it < 4; ++it) { const int item = tid + it * 512, key2 = item >> 4, ch = item & 15; \
        const bf16_t* kb_ = NA_SRC_ROWS(2 * (sp_) + (key2 >> 6)); const bf16_t* src = kb_ + (size_t)(key2 & 63) * PWA + hp * 128 + ch * 8; \
        kreg[it] = ldg((const u32x4*)(src + C_KN)); vreg[it] = ldg((const u32x4*)(src + C_VN)); } } while (0)
    NA_FETCH(0);
    for (int sp = 0; sp < npair; ++sp) {
        __syncthreads();
#pragma unroll
        for (int it = 0; it < 4; ++it) { const int item = tid + it * 512, key2 = item >> 4, ch = item & 15;
            *(u32x4*)(Ks + key2 * NA_KLD + ch * 8) = kreg[it]; *(u32x4*)(Vs + key2 * NA_VLD + ch * 8) = vreg[it]; }
        if (sp + 1 < npair) NA_FETCH(sp + 1);
        __syncthreads();
#pragma unroll
        for (int sub = 0; sub < 2; ++sub) {
        const int st = 2 * sp + sub;
        if (st >= nstage) continue;
        const bool local = st < nloc;
        const bf16_t* Ksb = Ks + sub * 64 * NA_KLD; const bf16_t* Vsb = Vs + sub * 64 * NA_VLD;
        if (local) {
            const int kr = rsv[0] + st;
            f32x4 sa[2][2];
#pragma unroll
            for (int kt = 0; kt < 2; ++kt) { sa[0][kt] = (f32x4){0.f, 0.f, 0.f, 0.f}; sa[1][kt] = (f32x4){0.f, 0.f, 0.f, 0.f};
#pragma unroll
                for (int ks = 0; ks < 2; ++ks) { const bf16x8 kf = *(const bf16x8*)(Ksb + (kc0 + kt * 16 + tq) * NA_KLD + hh * 64 + ks * 32 + fq * 8);
                    sa[0][kt] = mfma16(kf, qf[0][ks], sa[0][kt]); sa[1][kt] = mfma16(kf, qf[1][ks], sa[1][kt]); } }
            float alpha[2]; bf16x8 pf[2];
#pragma unroll
            for (int u = 0; u < 2; ++u) {
                const bool act = (kr >= rsv[u]) && (kr < rsv[u] + 8);
                if (!act) { alpha[u] = 1.0f; pf[u] = mk8((u32x4){0u, 0u, 0u, 0u}); continue; }
                const int dr = kr - rqv[u] + 7;
                float sc[8]; float mx = -1e30f; float bs[8];
#pragma unroll
                for (int kt = 0; kt < 2; ++kt)
#pragma unroll
                    for (int r = 0; r < 4; ++r) { const int kcol = kc0 + kt * 16 + fq * 4 + r; int dc = kcol - qcol + 15; dc = dc < 0 ? 0 : (dc > 30 ? 30 : dc);
                        bs[kt * 4 + r] = rpbs[hh * 465 + dr * 31 + dc]; }
#ifndef CPU_EMU
                asm volatile("" : "+v"(bs[0]), "+v"(bs[1]), "+v"(bs[2]), "+v"(bs[3]), "+v"(bs[4]), "+v"(bs[5]), "+v"(bs[6]), "+v"(bs[7]));
#endif
#pragma unroll
                for (int kt = 0; kt < 2; ++kt)
#pragma unroll
                    for (int r = 0; r < 4; ++r) { const int kcol = kc0 + kt * 16 + fq * 4 + r; const bool valid = (kcol >= cs) && (kcol < cs + 16);
                        const float v = valid ? (sa[u][kt][r] * 0.125f + bs[kt * 4 + r]) : -1e30f; sc[kt * 4 + r] = v; mx = fmaxf(mx, v); }
                mx = fmaxf(mx, shx<16>(mx)); mx = fmaxf(mx, shx<32>(mx));
                const float mn = fmaxf(m_run[u], mx); alpha[u] = __expf(m_run[u] - mn); m_run[u] = mn;
                float ps = 0.f; float pv[8];
#pragma unroll
                for (int j = 0; j < 8; ++j) { pv[j] = __expf(sc[j] - mn); ps += pv[j]; }
                ps += shx<16>(ps); ps += shx<32>(ps);
                l_run[u] = l_run[u] * alpha[u] + ps;
                u32x4 pk = {pack2(pv[0], pv[1]), pack2(pv[2], pv[3]), pack2(pv[4], pv[5]), pack2(pv[6], pv[7])};
                pf[u] = mk8(pk);
            }
#pragma unroll
            for (int mt = 0; mt < 4; ++mt) {
                const bf16_t* vp = Vsb + (kc0 + 4 * fq + tq4) * NA_VLD + hh * 64 + mt * 16 + 4 * tp4;
                const bf16x8 vf = mk8(TR16(vp), TR16(vp + 16 * NA_VLD));
                acc[0][mt] = mfma16(vf, pf[0], acc[0][mt] * alpha[0]); acc[1][mt] = mfma16(vf, pf[1], acc[1][mt] * alpha[1]); }
        } else {
            f32x4 sa[2][4];
#pragma unroll
            for (int kt = 0; kt < 4; ++kt) { sa[0][kt] = (f32x4){0.f, 0.f, 0.f, 0.f}; sa[1][kt] = (f32x4){0.f, 0.f, 0.f, 0.f};
#pragma unroll
                for (int ks = 0; ks < 2; ++ks) { const bf16x8 kf = *(const bf16x8*)(Ksb + (kt * 16 + tq) * NA_KLD + hh * 64 + ks * 32 + fq * 8);
                    sa[0][kt] = mfma16(kf, qf[0][ks], sa[0][kt]); sa[1][kt] = mfma16(kf, qf[1][ks], sa[1][kt]); } }
            float alpha[2]; bf16x8 pf[2][2];
#pragma unroll
            for (int u = 0; u < 2; ++u) {
                float mx = -1e30f;
#pragma unroll
                for (int kt = 0; kt < 4; ++kt)
#pragma unroll
                    for (int r = 0; r < 4; ++r) { sa[u][kt][r] *= 0.125f; mx = fmaxf(mx, sa[u][kt][r]); }
                mx = fmaxf(mx, shx<16>(mx)); mx = fmaxf(mx, shx<32>(mx));
                const float mn = fmaxf(m_run[u], mx); alpha[u] = __expf(m_run[u] - mn); m_run[u] = mn;
                float ps = 0.f;
#pragma unroll
                for (int kt = 0; kt < 4; ++kt)
#pragma unroll
                    for (int r = 0; r < 4; ++r) { sa[u][kt][r] = __expf(sa[u][kt][r] - mn); ps += sa[u][kt][r]; }
                ps += shx<16>(ps); ps += shx<32>(ps);
                l_run[u] = l_run[u] * alpha[u] + ps;
#pragma unroll
                for (int h2 = 0; h2 < 2; ++h2) {
                    u32x4 pk = {pack2(sa[u][2 * h2][0], sa[u][2 * h2][1]), pack2(sa[u][2 * h2][2], sa[u][2 * h2][3]), pack2(sa[u][2 * h2 + 1][0], sa[u][2 * h2 + 1][1]), pack2(sa[u][2 * h2 + 1][2], sa[u][2 * h2 + 1][3])};
                    pf[u][h2] = mk8(pk); }
            }
#pragma unroll
            for (int mt = 0; mt < 4; ++mt) { acc[0][mt] = acc[0][mt] * alpha[0]; acc[1][mt] = acc[1][mt] * alpha[1]; }
#pragma unroll
            for (int h2 = 0; h2 < 2; ++h2)
#pragma unroll
                for (int mt = 0; mt < 4; ++mt) { const bf16_t* vp = Vsb + (32 * h2 + 4 * fq + tq4) * NA_VLD + hh * 64 + mt * 16 + 4 * tp4;
                    const bf16x8 vf = mk8(TR16(vp), TR16(vp + 16 * NA_VLD));
                    acc[0][mt] = mfma16(vf, pf[0][h2], acc[0][mt]); acc[1][mt] = mfma16(vf, pf[1][h2], acc[1][mt]); }
        }
        }
    }
#undef NA_FETCH
#undef NA_SRC_ROWS
#pragma unroll
    for (int u = 0; u < 2; ++u) {
        const float il = frcp(l_run[u]);
        const size_t orow = ((size_t)sl << sd.lgseq) + qtok[u];
#pragma unroll
        for (int mt = 0; mt < 4; ++mt) { u32x2 o = {pack2(acc[u][mt][0] * il, acc[u][mt][1] * il), pack2(acc[u][mt][2] * il, acc[u][mt][3] * il)};
            stg((u32x2*)(p.Nb() + orow * 512 + head * 64 + mt * 16 + fq * 4), o); }
    }
}

DEV void mlstm_stepC_task(const Params& p, const SetDesc& sd, int layer, int task, char* shm) {
    const int tid = TID(), lane = tid & 63, w = tid >> 6, tq = lane & 15, fq = lane >> 4, tq4 = (lane & 15) >> 2, tp4 = lane & 3;
    const int tb = task % sd.ntb, h = (task / sd.ntb) & 3, sl = task / (sd.ntb * 4);
    const int row0 = (sl << sd.lgseq) + tb * 128; const bool latent = !sd.is_ctx; const int tl0 = tb * 128;
    bf16_t* Ks = (bf16_t*)shm;
    bf16_t* Vs = (bf16_t*)(shm + 128 * K_LD * 2);
    bf16_t* Cs = (bf16_t*)(shm + 128 * K_LD * 2 + 128 * V_LD * 2);
    float* ga = (float*)(shm + 128 * K_LD * 2 * 3 + 128 * V_LD * 2); float* gb = ga + 256; float* gpm = gb + 256; float* gtot = gpm + 256; float* tmp = gtot + 8;
    float* nvs = tmp + 16;
    float* cms = nvs + 128;
    const bf16_t* prow = proj_buf(p, sd) + (size_t)row0 * PWA;
    __syncthreads();
    gate_scan(prow, h, p.gate_bias + (size_t)layer * 16, ga, gb, gpm, gtot, tmp);
    {
        const int s = tid & 127, cpi = tid >> 7, cp = (cpi & 1) + (cpi >> 1) * 4;
        const bf16_t* hp = prow + (size_t)s * PWA + C_KM + h * 64;
        float k1[8], k2[8];
        load_rope_chunk(hp, cp, latent, tl0 + s, p.rope(), 1.0f, k1);
        load_rope_chunk(hp, cp + 2, latent, tl0 + s, p.rope(), 1.0f, k2);
        u32x4 o1 = {pack2(k1[0], k1[1]), pack2(k1[2], k1[3]), pack2(k1[4], k1[5]), pack2(k1[6], k1[7])};
        u32x4 o2 = {pack2(k2[0], k2[1]), pack2(k2[2], k2[3]), pack2(k2[4], k2[5]), pack2(k2[6], k2[7])};
        *(u32x4*)(Ks + s * K_LD + cp * 8) = o1; *(u32x4*)(Ks + s * K_LD + (cp + 2) * 8) = o2;
    }
#pragma unroll
    for (int it = 0; it < 4; ++it) { const int item = tid + it * 512, s = item >> 4, ch = item & 15;
        *(u32x4*)(Vs + s * V_LD + ch * 8) = ldg((const u32x4*)(prow + (size_t)s * PWA + C_VM + h * 128 + ch * 8)); }
#pragma unroll
    for (int it = 0; it < 4; ++it) { const int item = tid + it * 512, dir = item >> 10, rem = item & 1023, v = rem >> 3, ch = rem & 7;
        *(u32x4*)(Cs + (dir * 128 + v) * K_LD + ch * 8) = ldg((const u32x4*)(p.Cin() + (size_t)st_index(sd, sl, h, dir, tb) * 8192 + v * 64 + ch * 8)); }
    if (tid < 128) nvs[tid] = ldg(p.Cn() + (size_t)st_index(sd, sl, h, tid >> 6, tb) * 64 + (tid & 63));
    if (tid < 2) cms[tid] = ldg(p.Cm() + (size_t)st_index(sd, sl, h, tid, tb) * 4);
    bf16x8 qf[2]; float qv[2][8];
    {
        const int t = w * 16 + tq; const bf16_t* hp = prow + (size_t)t * PWA + C_QM + h * 64;
#pragma unroll
        for (int ks = 0; ks < 2; ++ks) { load_rope_chunk(hp, ks * 4 + fq, latent, tl0 + t, p.rope(), 0.125f, qv[ks]);
            u32x4 o = {pack2(qv[ks][0], qv[ks][1]), pack2(qv[ks][2], qv[ks][3]), pack2(qv[ks][4], qv[ks][5]), pack2(qv[ks][6], qv[ks][7])}; qf[ks] = mk8(o); }
    }
    __syncthreads();
    const int t = w * 16 + tq;
    f32x4 hsum[8];
#pragma unroll
    for (int mt = 0; mt < 8; ++mt) hsum[mt] = (f32x4){0.f, 0.f, 0.f, 0.f};
#pragma unroll
    for (int dir = 0; dir < 2; ++dir) {
        const float m_in = cms[dir];
        const float Mt = fmaxf(m_in, gpm[dir * 128 + t]);
        const float inter = __expf(m_in - Mt);
        const float mtot = gb[dir * 128 + t] + Mt;
        f32x4 acc[8];
#pragma unroll
        for (int mt = 0; mt < 8; ++mt) { acc[mt] = (f32x4){0.f, 0.f, 0.f, 0.f};
#pragma unroll
            for (int ks = 0; ks < 2; ++ks) { const bf16x8 cf = *(const bf16x8*)(Cs + (dir * 128 + mt * 16 + tq) * K_LD + ks * 32 + fq * 8);
                acc[mt] = mfma16(cf, qf[ks], acc[mt]); }
            acc[mt] = acc[mt] * inter; }
        float qn = 0.f;
#pragma unroll
        for (int ks = 0; ks < 2; ++ks)
#pragma unroll
            for (int j = 0; j < 8; ++j) qn += bf2f(f2bf(qv[ks][j])) * nvs[dir * 64 + ks * 32 + fq * 8 + j];
        qn += shx<16>(qn); qn += shx<32>(qn);
        float den = inter * qn;
        const int u_lo = dir == 0 ? 0 : (w >> 1), u_hi = dir == 0 ? (w >> 1) : 3;
        float rsum = 0.f;
        for (int u = u_lo; u <= u_hi; ++u) {
            unsigned pk[4];
#pragma unroll
            for (int kt = 0; kt < 2; ++kt) { f32x4 sa = {0.f, 0.f, 0.f, 0.f}; const int sb = 32 * u + 16 * kt;
#pragma unroll
                for (int ks = 0; ks < 2; ++ks) { const bf16x8 kf = *(const bf16x8*)(Ks + (sb + tq) * K_LD + ks * 32 + fq * 8); sa = mfma16(kf, qf[ks], sa); }
                float pv[4]; float gv4[4];
#pragma unroll
                for (int r = 0; r < 4; ++r) gv4[r] = ga[dir * 128 + sb + fq * 4 + r];
#ifndef CPU_EMU
                asm volatile("" : "+v"(gv4[0]), "+v"(gv4[1]), "+v"(gv4[2]), "+v"(gv4[3]));
#endif
#pragma unroll
                for (int r = 0; r < 4; ++r) { const int s = sb + fq * 4 + r; const bool valid = dir == 0 ? (s <= t) : (s >= t);
                    pv[r] = valid ? sa[r] * __expf(gv4[r] - Mt) : 0.f; pv[r] = bf2f(f2bf(pv[r])); rsum += pv[r]; }
                pk[kt * 2] = pack2(pv[0], pv[1]); pk[kt * 2 + 1] = pack2(pv[2], pv[3]); }
            u32x4 pkv = {pk[0], pk[1], pk[2], pk[3]}; const bf16x8 pf = mk8(pkv);
#pragma unroll
            for (int mt = 0; mt < 8; ++mt) { const bf16_t* vp = Vs + (32 * u + 4 * fq + tq4) * V_LD + mt * 16 + 4 * tp4;
                const bf16x8 vf = mk8(TR16(vp), TR16(vp + 16 * V_LD));
                acc[mt] = mfma16(vf, pf, acc[mt]); }
        }
        rsum += shx<16>(rsum); rsum += shx<32>(rsum);
        den += rsum;
        const float dn = frcp(fmaxf(fabsf(den), __expf(-mtot)));
#pragma unroll
        for (int mt = 0; mt < 8; ++mt) hsum[mt] = hsum[mt] + acc[mt] * dn;
    }
    float ss = 0.f;
#pragma unroll
    for (int mt = 0; mt < 8; ++mt)
#pragma unroll
        for (int r = 0; r < 4; ++r) ss += hsum[mt][r] * hsum[mt][r];
    ss += shx<16>(ss); ss += shx<32>(ss);
    const float rstd = rsqrtf(ss * (1.0f / 128.0f) + RMS_EPS);
#pragma unroll
    for (int mt = 0; mt < 8; ++mt) { const int v = mt * 16 + fq * 4;
        const u32x2 om = ldg((const u32x2*)(prow + (size_t)t * PWA + C_OM + h * 128 + v));
        u32x2 o = {pack2(hsum[mt][0] * rstd * sigmoidf_(lo16(om.x)), hsum[mt][1] * rstd * sigmoidf_(hi16(om.x))),
                   pack2(hsum[mt][2] * rstd * sigmoidf_(lo16(om.y)), hsum[mt][3] * rstd * sigmoidf_(hi16(om.y)))};
        stg((u32x2*)(p.Mb() + (size_t)(row0 + t) * 512 + h * 128 + v), o); }
}

struct SchedMerge {
    const bf16_t* Mb; const bf16_t* Pb; const bf16_t* Nb; const bf16_t* Wb; int nM;
    DEV bool next(int i, GUnit& u) const { u.aux = i % 3; return tile_order(i / 3, nM, 4, u.pm, u.pn); }
    DEV const bf16_t* a_base(const GUnit& u) const { return (u.aux == 0 ? Mb : (u.aux == 1 ? Pb : Nb)) + (size_t)u.pm * 256 * 512; }
    DEV const bf16_t* b_base(const GUnit& u) const { return Wb + ((size_t)u.aux * 1024 + u.pn * 256) * 512; }
    DEV int grow(const GUnit&, int) const { return 0; }
};
DEV void phase_merge(const Params& p, const SetDesc& sd, int layer, char* shm) {
    SchedMerge S; S.Mb = p.Mb(); S.Pb = p.Pb(); S.Nb = p.Nb(); S.Wb = p.WbT() + (size_t)layer * 3 * 1024 * 512; S.nM = sd.nrows / 256;
    const bf16_t* bgb = p.BG(); bf16_t* mgb = p.MERGED();
    gemm_stream<false, 512, 512, 512>(shm, S, [=](const GUnit& u, const f32x4 (&acc)[2][2][4][2], int r0, int c0) {
#pragma unroll
        for (int ai = 0; ai < 2; ++ai) {
            u32x4 gm[4][2], pr[4][2];
#pragma unroll
            for (int m = 0; m < 4; ++m)
#pragma unroll
                for (int hf = 0; hf < 2; ++hf) { const size_t r = (size_t)u.pm * 256 + r0 + ai * 128 + m * 16;
                    gm[m][hf] = ldg((const u32x4*)(bgb + r * NBG + u.aux * 1024 + u.pn * 256 + c0 + hf * 128));
                    if (u.aux > 0) pr[m][hf] = ldg((const u32x4*)(mgb + r * 1024 + u.pn * 256 + c0 + hf * 128)); else pr[m][hf] = (u32x4){0u, 0u, 0u, 0u}; }
#pragma unroll
            for (int m = 0; m < 4; ++m)
#pragma unroll
                for (int hf = 0; hf < 2; ++hf) { const size_t r = (size_t)u.pm * 256 + r0 + ai * 128 + m * 16;
                    const f32x4 x0 = acc[ai][hf][m][0], x1 = acc[ai][hf][m][1]; const u32x4 g = gm[m][hf], q = pr[m][hf];
                    u32x4 ov = {pack2(x0[0] * lo16(g.x) + lo16(q.x), x0[1] * hi16(g.x) + hi16(q.x)), pack2(x0[2] * lo16(g.y) + lo16(q.y), x0[3] * hi16(g.y) + hi16(q.y)),
                                pack2(x1[0] * lo16(g.z) + lo16(q.z), x1[1] * hi16(g.z) + hi16(q.z)), pack2(x1[2] * lo16(g.w) + lo16(q.w), x1[3] * hi16(g.w) + hi16(q.w))};
                    stg((u32x4*)(mgb + r * 1024 + u.pn * 256 + c0 + hf * 128), ov); }
        } });
}
DEV void phase_outproj(const Params& p, const SetDesc& sd, int layer, char* shm) {
    SchedPlain S; S.A = p.MERGED(); S.Bt = p.WoT() + (size_t)layer * 1024 * 1024; S.nM = sd.nrows / 256; S.nN = 4; S.lda256 = 256 * 1024; S.ldb256 = 256 * 1024;
    bf16_t* yb = p.Y();
    gemm_stream<false, 1024, 1024, 1024>(shm, S, [=](const GUnit& u, const f32x4 (&acc)[2][2][4][2], int r0, int c0) {
#pragma unroll
        for (int ai = 0; ai < 2; ++ai)
#pragma unroll
            for (int m = 0; m < 4; ++m) { bf16_t* o = yb + ((size_t)u.pm * 256 + r0 + ai * 128 + m * 16) * 1024 + u.pn * 256 + c0;
                store8bf(o, acc[ai][0][m][0], acc[ai][0][m][1]); store8bf(o + 128, acc[ai][1][m][0], acc[ai][1][m][1]); } });
}

DEV void phase_postmix(const Params& p, const SetDesc& sd, int layer, char* shm) {
    const int tid = TID(), lane = tid & 63, wv = tid >> 6;
    float* wr_s = (float*)shm;
    __syncthreads();
    for (int i = tid; i < 1024 * 16; i += NTHREADS) { const int c = i >> 4, e = i & 15, ln = (c & 511) >> 3, j = c & 7, hf = c >> 9;
        wr_s[((((hf * 8 + j) * 4 + (e >> 2)) * 64 + ln) << 2) + (e & 3)] = ldg(p.router_w + (size_t)layer * 1024 * 16 + i); }
    __syncthreads();
    const float* g1 = p.norm_gain + ((size_t)layer * 4 + 1) * 1024; const float* g2 = p.norm_gain + ((size_t)layer * 4 + 2) * 1024;
    float* par = (float*)(shm + 65536);
    { const int rpb0_ = (sd.nrows + (int)gridDim.x - 1) / (int)gridDim.x; const float* mdb = mod_row(p, sd, layer, min((int)blockIdx.x * rpb0_, sd.nrows - 1));
      stage_params(par, g1, g2, mdb + 2048, mdb + 3072, mdb + 4096); }
    __syncthreads();
    const float* xb = xsrc_base(p, sd, layer); float* xdb = xdst_base(p, sd);
    const int stride = 8; const int rpb_ = (sd.nrows + (int)gridDim.x - 1) / (int)gridDim.x; const int row_end = min(sd.nrows, ((int)blockIdx.x + 1) * rpb_);
    int row = (int)blockIdx.x * rpb_ + wv;
    u32x4 ycur[2], ynxt[2]; f32x4 xcur[4], xnxt[4];
    if (row < row_end) {
#pragma unroll
        for (int i = 0; i < 2; ++i) ycur[i] = ldg((const u32x4*)(p.Y() + (size_t)row * 1024 + i * 512 + lane * 8));
#pragma unroll
        for (int i = 0; i < 4; ++i) xcur[i] = ldg((const f32x4*)(xb + (size_t)row * 1024 + (i >> 1) * 512 + lane * 8 + (i & 1) * 4)); }
    for (; row < row_end; row += stride) {
        int ln = lane; HIDE(ln);
        const int rn = row + stride;
        if (rn < row_end) {
#pragma unroll
            for (int i = 0; i < 2; ++i) ynxt[i] = ldg((const u32x4*)(p.Y() + (size_t)rn * 1024 + i * 512 + ln * 8));
#pragma unroll
            for (int i = 0; i < 4; ++i) xnxt[i] = ldg((const f32x4*)(xb + (size_t)rn * 1024 + (i >> 1) * 512 + ln * 8 + (i & 1) * 4)); }
        float* xd = xdb + (size_t)row * 1024;
        const float* md = mod_row(p, sd, layer, row);
        float y[16]; float ss = 0.f;
#pragma unroll
        for (int hlf = 0; hlf < 2; ++hlf) { const u32x4 m = ycur[hlf];
            const float t8[8] = {lo16(m.x), hi16(m.x), lo16(m.y), hi16(m.y), lo16(m.z), hi16(m.z), lo16(m.w), hi16(m.w)};
#pragma unroll
            for (int j = 0; j < 8; ++j) { y[hlf * 8 + j] = t8[j]; ss += t8[j] * t8[j]; } }
        ss = wave_sum(ss);
        const float rstd = rsqrtf(ss * (1.0f / 1024.0f) + RMS_EPS);
        float xn[16]; float ss2 = 0.f;
#pragma unroll
        for (int hlf = 0; hlf < 2; ++hlf)
#pragma unroll
            for (int q = 0; q < 2; ++q) { const int c0 = hlf * 512 + ln * 8 + q * 4; const f32x4 xo = xcur[hlf * 2 + q]; f32x4 xw;
#pragma unroll
                for (int j = 0; j < 4; ++j) { const float v = xo[j] + par[2048 + c0 + j] * (y[hlf * 8 + q * 4 + j] * rstd * par[c0 + j]); xw[j] = v; xn[hlf * 8 + q * 4 + j] = v; ss2 += v * v; }
                stg((f32x4*)(xd + c0), xw); }
        ss2 = wave_sum(ss2);
        const float rstd2 = rsqrtf(ss2 * (1.0f / 1024.0f) + RMS_EPS);
        float lg[16];
#pragma unroll
        for (int e = 0; e < 16; ++e) lg[e] = 0.f;
#pragma unroll
        for (int hlf = 0; hlf < 2; ++hlf) { const int c0 = hlf * 512 + ln * 8; float o[8];
#pragma unroll
            for (int j = 0; j < 8; ++j) { o[j] = xn[hlf * 8 + j] * rstd2 * par[1024 + c0 + j] * (1.0f + par[4096 + c0 + j]) + par[3072 + c0 + j];
#pragma unroll
                for (int eq = 0; eq < 4; ++eq) { const f32x4 w4 = *(const f32x4*)(wr_s + ((((hlf * 8 + j) * 4 + eq) * 64 + ln) << 2));
#pragma unroll
                    for (int e = 0; e < 4; ++e) lg[eq * 4 + e] += o[j] * w4[e]; } }
            const u32x2 ov = {f8pack4(o[0], o[1], o[2], o[3]), f8pack4(o[4], o[5], o[6], o[7])};
            stg((u32x2*)((unsigned char*)p.H() + (size_t)row * 1024 + c0), ov); }
        float r8[8], r4[4], r2[2], r1;
        { const bool b = (lane & 32) != 0;
#pragma unroll
          for (int i = 0; i < 8; ++i) { const float keep = b ? lg[i + 8] : lg[i], send = b ? lg[i] : lg[i + 8]; r8[i] = keep + shx<32>(send); } }
        { const bool b = (lane & 16) != 0;
#pragma unroll
          for (int i = 0; i < 4; ++i) { const float keep = b ? r8[i + 4] : r8[i], send = b ? r8[i] : r8[i + 4]; r4[i] = keep + shx<16>(send); } }
        { const bool b = (lane & 8) != 0;
#pragma unroll
          for (int i = 0; i < 2; ++i) { const float keep = b ? r4[i + 2] : r4[i], send = b ? r4[i] : r4[i + 2]; r2[i] = keep + shx<8>(send); } }
        { const bool b = (lane & 4) != 0; const float keep = b ? r2[1] : r2[0], send = b ? r2[0] : r2[1]; r1 = keep + shx<4>(send); }
        r1 += shx<2>(r1); r1 += shx<1>(r1);
        float mx = r1;
        mx = fmaxf(mx, shx<4>(mx)); mx = fmaxf(mx, shx<8>(mx)); mx = fmaxf(mx, shx<16>(mx)); mx = fmaxf(mx, shx<32>(mx));
        const float ex = __expf(r1 - mx);
        float se = ex;
        se += shx<4>(se); se += shx<8>(se); se += shx<16>(se); se += shx<32>(se);
        if ((lane & 3) == 0) { const int e = ((lane >> 5) & 1) * 8 + ((lane >> 4) & 1) * 4 + ((lane >> 3) & 1) * 2 + ((lane >> 2) & 1);
            stg(p.aff() + (size_t)row * 16 + e, ex * frcp(se)); }
#pragma unroll
        for (int i = 0; i < 2; ++i) ycur[i] = ynxt[i];
#pragma unroll
        for (int i = 0; i < 4; ++i) xcur[i] = xnxt[i];
    }
}

DEV unsigned shxu(unsigned v, int m) {
    const float f = __uint_as_float(v); float r;
    switch (m) { case 1: r = shx<1>(f); break; case 2: r = shx<2>(f); break; case 4: r = shx<4>(f); break; case 8: r = shx<8>(f); break; case 16: r = shx<16>(f); break; default: r = shx<32>(f); break; }
    return __float_as_uint(r);
}
#define TK_CX(a_, b_, desc_) do { const unsigned long long x_ = key[a_], y_ = key[b_]; const bool sw_ = (desc_) ? (x_ < y_) : (x_ > y_); key[a_] = sw_ ? y_ : x_; key[b_] = sw_ ? x_ : y_; } while (0)
DEV void topk_task(const Params& p, const SetDesc& sd, int task, char* shm) {
    const int tid = TID();
    const int e = task & 15, sl = task >> 4;
    unsigned long long* buf = (unsigned long long*)shm;
    const int T = 1 << sd.lgseq, cap = sd.cap;
    const int rbase = sl << sd.lgseq;
    const bool active = tid * 4 < T;
    unsigned long long key[4];
    __syncthreads();
#pragma unroll
    for (int m = 0; m < 4; ++m) { const int i = tid * 4 + m; const float a = active ? ldg(p.aff() + (size_t)(rbase + i) * 16 + e) : 0.f;
        key[m] = ((unsigned long long)__float_as_uint(a) << 32) | (unsigned)(0xFFFFFFFFu - (unsigned)i); }
    for (int k = 2; k <= T; k <<= 1) {
        const bool desc4 = ((tid * 4) & k) == 0;
        for (int j = k >> 1; j >= 4; j >>= 1) {
            const int tj = j >> 2;
            unsigned long long pk[4];
            if (tj < 64) {
#pragma unroll
                for (int m = 0; m < 4; ++m) { const unsigned lo = shxu((unsigned)key[m], tj), hi = shxu((unsigned)(key[m] >> 32), tj); pk[m] = ((unsigned long long)hi << 32) | lo; }
            } else {
                __syncthreads();
                if (active) {
#pragma unroll
                    for (int m = 0; m < 4; ++m) buf[tid * 4 + m] = key[m]; }
                __syncthreads();
#pragma unroll
                for (int m = 0; m < 4; ++m) pk[m] = active ? buf[(tid ^ tj) * 4 + m] : 0ull;
            }
            const bool lower = (tid & tj) == 0; const bool takemax = desc4 == lower;
#pragma unroll
            for (int m = 0; m < 4; ++m) { const unsigned long long x = key[m], y = pk[m]; key[m] = takemax ? (x > y ? x : y) : (x < y ? x : y); }
        }
        if (k >= 4) { TK_CX(0, 2, desc4); TK_CX(1, 3, desc4); TK_CX(0, 1, desc4); TK_CX(2, 3, desc4); }
        else { TK_CX(0, 1, true); TK_CX(2, 3, false); }
    }
    const int sbase = e * sd.rpe + sl * cap;
    if (active) {
#pragma unroll
        for (int m = 0; m < 4; ++m) { const int i = tid * 4 + m; const unsigned long long kv = key[m]; const int tok = (int)(0xFFFFFFFFu - (unsigned)(kv & 0xFFFFFFFFu));
            const int row = rbase + tok;
            if (i < cap) { stg(p.slot_token() + sbase + i, row); stg(p.slot_gate() + sbase + i, __uint_as_float((unsigned)(kv >> 32))); stg(p.token_slots() + (size_t)row * 16 + e, sbase + i); }
            else stg(p.token_slots() + (size_t)row * 16 + e, -1); } }
    if (sl == 0) { const int used = sd.nsamp * cap;
        for (int i = used + tid; i < sd.rpe; i += NTHREADS) { stg(p.slot_token() + e * sd.rpe + i, 0); stg(p.slot_gate() + e * sd.rpe + i, 0.f); } }
}
#undef TK_CX

struct SchedMoe {
    const bf16_t* A; const int* st; const bf16_t* W; int nRT, rpe, nN, wstride;
    DEV bool next(int i, GUnit& u) const { int pmx, pn; if (!tile_order(i, 16 * nRT, nN, pmx, pn)) return false; u.pm = pmx % nRT; u.aux = pmx / nRT; u.pn = pn; return true; }
    DEV int slot0(const GUnit& u) const { return u.aux * rpe + u.pm * 256; }
    DEV const bf16_t* a_base(const GUnit&) const { return A; }
    DEV int grow(const GUnit& u, int i) const { return st ? ldg(st + slot0(u) + i) : slot0(u) + i; }
    DEV const bf16_t* b_base(const GUnit& u) const { return W + (size_t)u.aux * wstride + (size_t)u.pn * 256 * 512; }
};
DEV void phase_moe_gu(const Params& p, const SetDesc& sd, int layer, char* shm) {
    SchedMoe S; S.A = p.H(); S.st = p.slot_token(); S.W = p.WguT() + (size_t)layer * 16 * 2048 * 512; S.nRT = sd.rpe / 256; S.rpe = sd.rpe; S.nN = 8; S.wstride = 2048 * 512;
    unsigned char* hb = (unsigned char*)p.HID();
    gemm_stream<true, 512, 512, 512, true>(shm, S, [=](const GUnit& u, const f32x4 (&acc)[2][2][4][2], int r0, int c0) {
#pragma unroll
        for (int ai = 0; ai < 2; ++ai)
#pragma unroll
            for (int m = 0; m < 4; ++m) { f32x4 h0, h1; const f32x4 a0 = acc[ai][0][m][0] * F8_WINV, a1 = acc[ai][0][m][1] * F8_WINV, b0 = acc[ai][1][m][0] * F8_WINV, b1 = acc[ai][1][m][1] * F8_WINV;
#pragma unroll
                for (int j = 0; j < 4; ++j) { h0[j] = a0[j] * sigmoidf_(a0[j]) * b0[j]; h1[j] = a1[j] * sigmoidf_(a1[j]) * b1[j]; }
                const u32x2 hv = {f8pack4(h0[0], h0[1], h0[2], h0[3]), f8pack4(h1[0], h1[1], h1[2], h1[3])};
                stg((u32x2*)(hb + ((size_t)S.slot0(u) + r0 + ai * 128 + m * 16) * 1024 + u.pn * 128 + c0), hv); } });
}
DEV void phase_moe_down(const Params& p, const SetDesc& sd, int layer, char* shm) {
    SchedMoe S; S.A = p.HID(); S.st = nullptr; S.W = p.WdT() + (size_t)layer * 16 * 1024 * 512; S.nRT = sd.rpe / 256; S.rpe = sd.rpe; S.nN = 4; S.wstride = 1024 * 512;
    bf16_t* yb = p.YE(); const float* gt = p.slot_gate();
    gemm_stream<true, 512, 512, 512, true>(shm, S, [=](const GUnit& u, const f32x4 (&acc)[2][2][4][2], int r0, int c0) {
#pragma unroll
        for (int ai = 0; ai < 2; ++ai) {
            float gv[4];
#pragma unroll
            for (int m = 0; m < 4; ++m) gv[m] = ldg(gt + (size_t)S.slot0(u) + r0 + ai * 128 + m * 16) * F8_WINV;
#pragma unroll
            for (int m = 0; m < 4; ++m) { const size_t sl = (size_t)S.slot0(u) + r0 + ai * 128 + m * 16; const float g = gv[m];
                bf16_t* o = yb + sl * 1024 + u.pn * 256 + c0; store8bf(o, acc[ai][0][m][0] * g, acc[ai][0][m][1] * g); store8bf(o + 128, acc[ai][1][m][0] * g, acc[ai][1][m][1] * g); } } });
}

DEV void compact4(const int (&sl)[16], int (&c)[4], int& n) {
    n = 0; c[0] = -1; c[1] = -1; c[2] = -1; c[3] = -1;
#pragma unroll
    for (int e = 0; e < 16; ++e) if (sl[e] >= 0) { c[0] = (n == 0) ? sl[e] : c[0]; c[1] = (n == 1) ? sl[e] : c[1]; c[2] = (n == 2) ? sl[e] : c[2]; c[3] = (n == 3) ? sl[e] : c[3]; ++n; }
}
DEV void phase_combine(const Params& p, const SetDesc& sd, int layer, char* shm) {
    const int tid = TID(), lane = tid & 63, wv = tid >> 6;
    const float* g3 = p.norm_gain + ((size_t)layer * 4 + 3) * 1024;
    float* xdb = xdst_base(p, sd);
    const int stride = 8; const int rpb_ = (sd.nrows + (int)gridDim.x - 1) / (int)gridDim.x; const int row_end = min(sd.nrows, ((int)blockIdx.x + 1) * rpb_);
    int row = __builtin_amdgcn_readfirstlane((int)blockIdx.x * rpb_ + wv);
    float* par = (float*)shm;
    __syncthreads();
    { const float* mdb = mod_row(p, sd, layer, min((int)blockIdx.x * rpb_, sd.nrows - 1)); stage_params(par, g3, mdb + 5120, nullptr, nullptr, nullptr); }
    __syncthreads();
    int raw[16]; int cc[4], cn[4]; int nc = 0, nn = 0;
    u32x4 mc[4][2], mn[4][2]; f32x4 xc[4], xn[4];
#define CMB_SLOTS(r_) do { _Pragma("unroll") for (int e = 0; e < 16; ++e) raw[e] = ldg(p.token_slots() + (size_t)(r_) * 16 + e); } while (0)
#define CMB_DATA(r_, c_, n_, m_, x_) do { _Pragma("unroll") for (int k = 0; k < 4; ++k) { \
            if (k < (n_)) { const bf16_t* yr = p.YE() + (size_t)(c_)[k] * 1024 + lane * 8; (m_)[k][0] = ldg((const u32x4*)yr); (m_)[k][1] = ldg((const u32x4*)(yr + 512)); } \
            else { (m_)[k][0] = (u32x4){0u, 0u, 0u, 0u}; (m_)[k][1] = (u32x4){0u, 0u, 0u, 0u}; } } \
        _Pragma("unroll") for (int i = 0; i < 4; ++i) (x_)[i] = ldg((const f32x4*)(xdb + (size_t)(r_) * 1024 + (i >> 1) * 512 + lane * 8 + (i & 1) * 4)); } while (0)
    if (row < row_end) { CMB_SLOTS(row); compact4(raw, cc, nc); CMB_DATA(row, cc, nc, mc, xc); if (row + stride < row_end) CMB_SLOTS(row + stride); }
    for (; row < row_end; row += stride) {
        const int rn = row + stride;
        if (rn < row_end) { compact4(raw, cn, nn); CMB_DATA(rn, cn, nn, mn, xn); if (rn + stride < row_end) CMB_SLOTS(rn + stride); }
        float* xd = xdb + (size_t)row * 1024;
        float y[16];
#pragma unroll
        for (int j = 0; j < 16; ++j) y[j] = 0.f;
        if (nc <= 4) {
#pragma unroll
            for (int k = 0; k < 4; ++k)
                if (k < nc) {
#pragma unroll
                    for (int hlf = 0; hlf < 2; ++hlf) { const u32x4 m = mc[k][hlf];
                        y[hlf * 8 + 0] += lo16(m.x); y[hlf * 8 + 1] += hi16(m.x); y[hlf * 8 + 2] += lo16(m.y); y[hlf * 8 + 3] += hi16(m.y);
                        y[hlf * 8 + 4] += lo16(m.z); y[hlf * 8 + 5] += hi16(m.z); y[hlf * 8 + 6] += lo16(m.w); y[hlf * 8 + 7] += hi16(m.w); } }
        } else {
            for (int e = 0; e < 16; ++e) { const int sl_ = ldg(p.token_slots() + (size_t)row * 16 + e);
                if (sl_ >= 0) { const bf16_t* yr = p.YE() + (size_t)sl_ * 1024 + lane * 8;
#pragma unroll
                    for (int hlf = 0; hlf < 2; ++hlf) { const u32x4 m = ldg((const u32x4*)(yr + hlf * 512));
                        y[hlf * 8 + 0] += lo16(m.x); y[hlf * 8 + 1] += hi16(m.x); y[hlf * 8 + 2] += lo16(m.y); y[hlf * 8 + 3] += hi16(m.y);
                        y[hlf * 8 + 4] += lo16(m.z); y[hlf * 8 + 5] += hi16(m.z); y[hlf * 8 + 6] += lo16(m.w); y[hlf * 8 + 7] += hi16(m.w); } } }
        }
        float ss = 0.f;
#pragma unroll
        for (int j = 0; j < 16; ++j) ss += y[j] * y[j];
        ss = wave_sum(ss);
        const float rstd = rsqrtf(ss * (1.0f / 1024.0f) + RMS_EPS);
#pragma unroll
        for (int hlf = 0; hlf < 2; ++hlf)
#pragma unroll
            for (int q = 0; q < 2; ++q) { const int c0 = hlf * 512 + lane * 8 + q * 4; f32x4 xv = xc[hlf * 2 + q];
#pragma unroll
                for (int j = 0; j < 4; ++j) xv[j] += par[1024 + c0 + j] * (y[hlf * 8 + q * 4 + j] * rstd * par[c0 + j]);
                stg((f32x4*)(xd + c0), xv); }
        nc = nn;
#pragma unroll
        for (int k = 0; k < 4; ++k) { cc[k] = cn[k]; mc[k][0] = mn[k][0]; mc[k][1] = mn[k][1]; }
#pragma unroll
        for (int i = 0; i < 4; ++i) xc[i] = xn[i];
    }
#undef CMB_SLOTS
#undef CMB_DATA
}

constexpr int WQ_WORD0 = 4096;
template <class F> DEV void wq_run(const Params& p, int qidx, int ntasks, char* shm, F&& task) {
    unsigned* ctr = p.bar() + WQ_WORD0 + 64 * qidx;
    volatile int* slot = (volatile int*)(shm + 131072 + 64);
    const int tid = TID();
    int cur = blockIdx.x;
    while (cur < ntasks) {
        unsigned pend = 0u;
        if (tid == 0) pend = atomicAdd(ctr, 1u);
        task(cur);
        __syncthreads();
        if (tid == 0) *slot = (int)gridDim.x + (int)pend;
        __syncthreads();
        cur = *slot;
    }
}

template <int PH> DEV void do_phase(const Params& p, int layer, int is_ctx, int grp, char* shm) {
    const SetDesc sd = make_set(is_ctx, grp);
    if constexpr (PH == -1) phase_prologue(p, shm);
    if constexpr (PH == 0) phase_norm1(p, sd, layer, shm);
    if constexpr (PH == 1) phase_proj_a(p, sd, layer, shm);
    const int qbase = ((layer * 3 + (is_ctx ? 0 : grp + 1)) * 13 + (PH < 0 ? 0 : PH)) * 2;
    if constexpr (PH == 2) { wq_run(p, qbase, sd.nsamp * 4 * sd.ntb, shm, [&](int t) { mlstm_stepA_task(p, sd, layer, t, shm); }); if (!(is_ctx && layer == 1)) phase_pool(p, sd); }
    if constexpr (PH == 3) {
        for (int t = blockIdx.x; t < sd.nsamp * 32; t += gridDim.x) mlstm_stepB_task(p, sd, t);
        if (!(is_ctx && layer == 1)) {
            const int nq = (is_ctx ? (CTX / 64) : ROWS) / 2;
            wq_run(p, qbase, sd.nsamp * nq * 4, shm, [&](int t) { na_task(p, sd, layer, t / (nq * 4), (t >> 2) % nq, t & 3, shm); });
        }
    }
    if constexpr (PH == 4) { wq_run(p, qbase, sd.nsamp * 4 * sd.ntb, shm, [&](int t) { mlstm_stepC_task(p, sd, layer, t, shm); }); }
    if constexpr (PH == 5) phase_proj_b(p, sd, layer, shm);
    if constexpr (PH == 6) phase_merge(p, sd, layer, shm);
    if constexpr (PH == 7) phase_outproj(p, sd, layer, shm);
    if constexpr (PH == 8) phase_postmix(p, sd, layer, shm);
    if constexpr (PH == 9) { for (int t = blockIdx.x; t < sd.nsamp * 16; t += gridDim.x) topk_task(p, sd, t, shm); }
    if constexpr (PH == 10) phase_moe_gu(p, sd, layer, shm);
    if constexpr (PH == 11) phase_moe_down(p, sd, layer, shm);
    if constexpr (PH == 12) phase_combine(p, sd, layer, shm);
}

#ifndef CPU_EMU
template <int PH> __global__ void __launch_bounds__(NTHREADS, 2) k_phase(Params p, int layer, int is_ctx, int grp) {
    DYN_LDS(shm);
    do_phase<PH>(p, layer, is_ctx, grp, shm);
}
#ifndef DBL_MASK
#define DBL_MASK 0
#endif
#define RUNPH(PH) do { do_phase<PH>(p, layer, is_ctx, grp, shm); xcd_barrier(bar); if ((DBL_MASK >> (PH)) & 1) { do_phase<PH>(p, layer, is_ctx, grp, shm); xcd_barrier(bar); } } while (0)
__global__ void __launch_bounds__(NTHREADS, 2) k_mega(Params p) {
    DYN_LDS(shm);
    uint4* xbw = (uint4*)(shm + 131072);
    if (threadIdx.x == 0) *xbw = make_uint4(0u, 0u, 0u, 0u);
    __syncthreads();
    XcdBarrier bar = xcd_barrier_post(p.bar(), (volatile LAS unsigned*)xbw);
    do_phase<-1>(p, 0, 0, 0, shm);
    xcd_barrier(bar);
    for (int layer = 0; layer < 2; ++layer)
        for (int si = 0; si <= NG; ++si) {
            const int is_ctx = si == 0 ? 1 : 0, grp = si == 0 ? 0 : si - 1;
            RUNPH(0); RUNPH(1); RUNPH(2);
            if (is_ctx && layer == 1) { do_phase<3>(p, layer, is_ctx, grp, shm); continue; }
            RUNPH(3); RUNPH(4); RUNPH(5); RUNPH(6); RUNPH(7); RUNPH(8); RUNPH(9); RUNPH(10); RUNPH(11);
            do_phase<12>(p, layer, is_ctx, grp, shm);
        }
}
#endif
}

static Params make_params(void* const* d_in, void* d_out, void* d_ws) {
    Params p{};
    p.x = (const float*)d_in[0]; p.c = (const float*)d_in[1]; p.ctx = (const float*)d_in[2]; p.c_ctx = (const float*)d_in[3];
    p.norm_gain = (const float*)d_in[4]; p.ada_w = (const float*)d_in[5]; p.ada_b = (const float*)d_in[6]; p.w_in = (const float*)d_in[7];
    p.gate_bias = (const float*)d_in[8]; p.pool_w = (const float*)d_in[9]; p.pool_scale = (const float*)d_in[10]; p.rpb = (const float*)d_in[11];
    p.w_branch = (const float*)d_in[12]; p.w_out = (const float*)d_in[13]; p.router_w = (const float*)d_in[14];
    p.w_gate = (const float*)d_in[15]; p.w_up = (const float*)d_in[16]; p.w_down = (const float*)d_in[17];
    p.out = (float*)d_out; p.ws = (char*)d_ws;
    return p;
}

#ifdef CPU_EMU
int emu_cfg_B = CFG_B, emu_cfg_ROWS = CFG_ROWS, emu_cfg_CTX = CFG_CTX;
const char* g_dumpdir = "data";
static void* g_ws = nullptr;
static void dump_buf(const char* name, int layer, int is_ctx, int grp, const void* ptr, size_t bytes) {
    char nm[512]; snprintf(nm, sizeof nm, "%s/d_L%d_%s%d_%s.bin", g_dumpdir, layer, is_ctx ? "c" : "g", grp, name);
    FILE* f = fopen(nm, "wb"); fwrite(ptr, 1, bytes, f); fclose(f);
}
static void emu_hook(const Params& p, int layer, int is_ctx, int grp, int ph) {
    const size_t Rn = is_ctx ? RC : RL;
    if (ph == 0) dump_buf("H", layer, is_ctx, grp, p.H(), Rn * 1024 * 2);
    if (ph == 1) dump_buf("PROJ", layer, is_ctx, grp, is_ctx ? p.PROJc() : p.PROJa(), Rn * PWA * 2);
    if (ph == 2) dump_buf("Pb", layer, is_ctx, grp, p.Pb(), Rn * 512 * 2);
    if (ph == 3) dump_buf("Nb", layer, is_ctx, grp, p.Nb(), Rn * 512 * 2);
    if (ph == 4) dump_buf("Mb", layer, is_ctx, grp, p.Mb(), Rn * 512 * 2);
    if (ph == 5) dump_buf("BG", layer, is_ctx, grp, p.BG(), Rn * NBG * 2);
    if (ph == 6) dump_buf("MERGED", layer, is_ctx, grp, p.MERGED(), Rn * 1024 * 2);
    if (ph == 7) dump_buf("Y", layer, is_ctx, grp, p.Y(), Rn * 1024 * 2);
    if (ph == 8) { dump_buf("H2", layer, is_ctx, grp, p.H(), Rn * 1024 * 2); dump_buf("aff", layer, is_ctx, grp, p.aff(), Rn * 16 * 4); }
}
void emu_dump(const char* dir) {
    char nm[512]; snprintf(nm, sizeof nm, "%s/d_mod.bin", dir);
    FILE* f = fopen(nm, "wb"); fwrite((char*)g_ws + WSL.mod, 1, (size_t)2 * (NB + 1) * 6144 * 4, f); fclose(f);
    snprintf(nm, sizeof nm, "%s/d_ctxs.bin", dir);
    f = fopen(nm, "wb"); fwrite((char*)g_ws + WSL.ctxs, 1, (size_t)NB * CTX * 1024 * 4, f); fclose(f);
}
template <int PH> static void emu_run_phase(const Params& p, int layer, int is_ctx, int grp, int nblocks) {
    emu_launch_lambda([=]() { do_phase<PH>(p, layer, is_ctx, grp, emu_blk->smem); }, nblocks, NTHREADS, LDS_BYTES);
    if (PH >= 0) emu_hook(p, layer, is_ctx, grp, PH);
    printf("phase %d layer %d ctx %d grp %d done\n", PH, layer, is_ctx, grp); fflush(stdout);
}
#define LAUNCH_PHASE(PH) emu_run_phase<PH>(p, layer, is_ctx, grp, nblocks)
#else
#define LAUNCH_PHASE(PH) hipLaunchKernelGGL((k_phase<PH>), dim3(nblocks), dim3(NTHREADS), LDS_BYTES, stream, p, layer, is_ctx, grp)
#define SETATTR(PH) (void)hipFuncSetAttribute((const void*)k_phase<PH>, hipFuncAttributeMaxDynamicSharedMemorySize, LDS_BYTES)
#endif

extern "C" void kernel_launch(void* const* d_in, const int* in_sizes, int n_in, void* d_out, int out_size, void* d_ws, size_t ws_size, hipStream_t stream) {
    (void)in_sizes; (void)n_in; (void)out_size;
    if (ws_size < WSL.total) return;
    Params p = make_params(d_in, d_out, d_ws);
#ifdef CPU_EMU
    g_ws = d_ws;
    memset(d_ws, 0xFF, WSL.total);
    memset((char*)d_ws + WSL.bar, 0, 65536);
    const int nblocks = 16;
#else
    const int nblocks = 256;
#if MK_ONE_LAUNCH
    static int grid = 0;
    if (!grid) {
        (void)hipFuncSetAttribute((const void*)k_mega, hipFuncAttributeMaxDynamicSharedMemorySize, LDS_BYTES);
        int dev = 0, cus = 0, per_cu = 0;
        (void)hipGetDevice(&dev);
        (void)hipDeviceGetAttribute(&cus, hipDeviceAttributeMultiprocessorCount, dev);
        (void)hipOccupancyMaxActiveBlocksPerMultiprocessor(&per_cu, (const void*)k_mega, NTHREADS, LDS_BYTES);
        if (per_cu > 1) per_cu = 1;
        grid = cus * per_cu;
        if (grid > 256) grid = 256;
    }
    if (grid <= 0) return;
    (void)hipMemsetAsync(p.bar(), 0, 65536, stream);
    hipLaunchKernelGGL(k_mega, dim3(grid), dim3(NTHREADS), LDS_BYTES, stream, p);
    return;
#else
    static bool attr_done = false;
    if (!attr_done) { SETATTR(-1); SETATTR(0); SETATTR(1); SETATTR(2); SETATTR(3); SETATTR(4); SETATTR(5); SETATTR(6); SETATTR(7); SETATTR(8); SETATTR(9); SETATTR(10); SETATTR(11); SETATTR(12); attr_done = true; }
#endif
#endif
    { const int layer = 0, is_ctx = 0, grp = 0; LAUNCH_PHASE(-1); }
    for (int layer = 0; layer < 2; ++layer)
        for (int si = 0; si <= NG; ++si) {
            const int is_ctx = si == 0 ? 1 : 0, grp = si == 0 ? 0 : si - 1;
            LAUNCH_PHASE(0); LAUNCH_PHASE(1); LAUNCH_PHASE(2); LAUNCH_PHASE(3);
            if (is_ctx && layer == 1) continue;
            LAUNCH_PHASE(4); LAUNCH_PHASE(5); LAUNCH_PHASE(6); LAUNCH_PHASE(7); LAUNCH_PHASE(8); LAUNCH_PHASE(9); LAUNCH_PHASE(10); LAUNCH_PHASE(11); LAUNCH_PHASE(12);
        }
}
```

```cpp
#ifdef CPU_EMU
#include "emu.h"
#define DYN_LDS(p) char* p = emu_blk->smem
#define WAIT_V(n)
#define WAIT_L(n)
#define HIDE(v)
#define CBAR()
#else
#include <hip/hip_runtime.h>
#define DYN_LDS(p) extern __shared__ __attribute__((aligned(16))) char p[]
#define WAIT_V(n) asm volatile("s_waitcnt vmcnt(" #n ")" ::: "memory")
#define WAIT_L(n) asm volatile("s_waitcnt lgkmcnt(" #n ")" ::: "memory")
#define HIDE(v) asm volatile("" : "+v"(v))
#define CBAR() asm volatile("" ::: "memory")
#endif
#include <stdint.h>
#include <stddef.h>

#ifndef CFG_B
#define CFG_B 32
#define CFG_ROWS 32
#define CFG_CTX 256
#define CFG_G 16
#endif
#ifndef MK_ONE_LAUNCH
#define MK_ONE_LAUNCH 1
#endif

#define DEV __device__ __forceinline__
typedef short s16x4 __attribute__((ext_vector_type(4)));
#ifdef CPU_EMU
#define TR16(ptr) emu_tr16((const void*)(ptr))
#else
typedef __attribute__((address_space(3))) s16x4 lds_s16x4;
#define TR16(ptr) __builtin_amdgcn_ds_read_tr16_b64_v4i16((lds_s16x4*)(ptr))
#endif
#ifdef CPU_EMU
#define TID() (threadIdx.x)
#else
#define TID() ({ int t_ = threadIdx.x; asm volatile("" : "+v"(t_)); t_; })
#endif

typedef unsigned short bf16_t;
typedef short bf16x8 __attribute__((ext_vector_type(8)));
typedef float f32x4 __attribute__((ext_vector_type(4)));
typedef unsigned u32x2 __attribute__((ext_vector_type(2)));
typedef unsigned u32x4 __attribute__((ext_vector_type(4)));

namespace {
constexpr int D = 1024, NB = CFG_B, ROWS = CFG_ROWS, SEQ = ROWS * 64, CTX = CFG_CTX, G = CFG_G, NG = NB / G;
constexpr int RL = G * SEQ, RC = NB * CTX, RMAX = RL > RC ? RL : RC;
constexpr int PWA = 3840, NBG = 3072, PWT = PWA + NBG, PWSRC = 6672, C_SPLIT = 3600;
constexpr int C_QM = 0, C_KM = 256, C_PU = 512, C_GM = 1024, C_PADA = 1040, C_F8 = 1280, C_QN = 1280, C_KN = 1792, C_VM = 2304, C_OM = 2816, C_VN = 3328;
constexpr int proj_col(int n) { return n < 512 ? n : n < 1536 ? n + 1792 : n < 1552 ? n - 512 : n < 2064 ? n - 1040 : n < 3088 ? n - 784 : n + 240; }
static_assert(proj_col(512) == C_VM && proj_col(1024) == C_OM && proj_col(1536) == C_GM && proj_col(1552) == C_PU && proj_col(2064) == C_QN && proj_col(2576) == C_KN && proj_col(3088) == C_VN && proj_col(3599) == PWA - 1, "projection column map");
constexpr int NTBL = SEQ / 128, NTBC = CTX / 128;
constexpr int ilog2(int x) { return x <= 1 ? 0 : 1 + ilog2(x >> 1); }
constexpr int LGSEQ = ilog2(SEQ), LGCTX = ilog2(CTX);
static_assert((1 << LGSEQ) == SEQ && (1 << LGCTX) == CTX, "sequence lengths must be powers of two");
constexpr int cdiv(int a, int b) { return (a + b - 1) / b; }
constexpr int RPE_L = cdiv(G * (SEQ / 8), 256) * 256, RPE_C = cdiv(NB * (CTX / 8), 256) * 256, RPE_MAX = RPE_L > RPE_C ? RPE_L : RPE_C;
constexpr int NSLOT = 16 * RPE_MAX;
constexpr int NTHREADS = 512;
constexpr int GT_MAXU = 10;
constexpr int LDS_BYTES = 131072 + 256 + GT_MAXU * 1024;
constexpr int NST_L = G * 4 * 2 * NTBL, NST_C = NB * 4 * 2 * NTBC, NST = NST_L > NST_C ? NST_L : NST_C;
constexpr int NCI = NB * 4 * 2;
constexpr float RMS_EPS = 1e-6f;

struct WsLayout { size_t bar, WinT, WbT, WoT, WguT, WdT, mod, rope, ctxs, PROJc, CiC, Cin_, Cim, H, H8, PROJa, Sst, Cin, Mb, Pb, Nb, Sn, Ssc, Cn, Cm, aff, slot_token, slot_gate, token_slots, HID, YE, BG, MERGED, Y, total; };
constexpr size_t al(size_t x) { return (x + 255) / 256 * 256; }
constexpr size_t smax(size_t a, size_t b) { return a > b ? a : b; }
constexpr WsLayout make_layout() {
    WsLayout L{}; size_t o = 0;
    L.bar = o; o += al(65536);
    L.WinT = o; o += al((size_t)2 * PWT * 1024 * 2);
    L.WbT = o; o += al((size_t)2 * 3 * 1024 * 512 * 2);
    L.WoT = o; o += al((size_t)2 * 1024 * 1024 * 2);
    L.WguT = o; o += al((size_t)2 * 16 * 2048 * 1024 * 2);
    L.WdT = o; o += al((size_t)2 * 16 * 1024 * 1024 * 2);
    L.mod = o; o += al((size_t)2 * (NB + 1) * 6144 * 4);
    L.rope = o; o += al((size_t)(ROWS + 64) * 16 * 2 * 4);
    L.ctxs = o; o += al((size_t)NB * CTX * 1024 * 4);
    L.PROJc = o; o += al((size_t)RC * PWA * 2);
    L.CiC = o; o += al((size_t)NCI * 8192 * 4);
    L.Cin_ = o; o += al((size_t)NCI * 64 * 4);
    L.Cim = o; o += al((size_t)NCI * 4 * 4);
    L.H = o; o += al((size_t)RMAX * 1024 * 2);
    L.H8 = o; o += al((size_t)RMAX * 1024);
    const size_t x0 = o;
    L.PROJa = o; o += al((size_t)RMAX * PWA * 2);
    L.Sst = o; o += al((size_t)NST * 8192 * 4);
    L.Cin = o; o += al((size_t)NST * 8192 * 2);
    const size_t hid = al((size_t)NSLOT * 1024 * 2);
    o = x0 + smax(o - x0, 2 * hid);
    L.BG = x0; L.HID = x0; L.YE = x0 + hid;
    L.Mb = o; o += al((size_t)RMAX * 512 * 2);
    L.Pb = o; o += al((size_t)RMAX * 512 * 2);
    L.Nb = o; o += al((size_t)RMAX * 512 * 2);
    L.MERGED = L.H; L.Y = L.Mb;
    L.Sn = o; o += al((size_t)NST * 64 * 4);
    L.Ssc = o; o += al((size_t)NST * 4 * 4);
    L.Cn = o; o += al((size_t)NST * 64 * 4);
    L.Cm = o; o += al((size_t)NST * 4 * 4);
    L.aff = o; o += al((size_t)RMAX * 16 * 4);
    L.slot_token = o; o += al((size_t)NSLOT * 4);
    L.slot_gate = o; o += al((size_t)NSLOT * 4);
    L.token_slots = o; o += al((size_t)RMAX * 16 * 4);
    L.total = o;
    return L;
}
constexpr WsLayout WSL = make_layout();
static_assert((size_t)RMAX * NBG * 2 <= (size_t)RMAX * PWA * 2, "BG overlay must fit in PROJa");
static_assert(CFG_B != 32 || WSL.total <= ((size_t)1 << 30), "workspace budget");

struct Params {
    const float *x, *c, *ctx, *c_ctx, *norm_gain, *ada_w, *ada_b, *w_in, *gate_bias, *pool_w, *pool_scale, *rpb, *w_branch, *w_out, *router_w, *w_gate, *w_up, *w_down;
    float* out;
    char* ws;
#ifdef CPU_EMU
#define WSF(T, name) __device__ __host__ __forceinline__ T* name() const { return (T*)(ws + WSL.name); }
#else
#if defined(__HIP_DEVICE_COMPILE__)
#define WSF(T, name) __device__ __host__ __forceinline__ T* name() const { char* w_ = ws; asm volatile("" : "+s"(w_)); return (T*)(__attribute__((address_space(1))) T*)(w_ + WSL.name); }
#else
#define WSF(T, name) __device__ __host__ __forceinline__ T* name() const { return (T*)(ws + WSL.name); }
#endif
#endif
    WSF(unsigned, bar) WSF(bf16_t, WinT) WSF(bf16_t, WbT) WSF(bf16_t, WoT) WSF(bf16_t, WguT) WSF(bf16_t, WdT)
    WSF(float, mod) WSF(float, rope) WSF(float, ctxs) WSF(bf16_t, PROJc) WSF(float, CiC) WSF(float, Cin_) WSF(float, Cim)
    WSF(bf16_t, H) WSF(unsigned char, H8) WSF(bf16_t, PROJa) WSF(float, Sst) WSF(bf16_t, Cin) WSF(bf16_t, Mb) WSF(bf16_t, Pb) WSF(bf16_t, Nb)
    WSF(float, Sn) WSF(float, Ssc) WSF(float, Cn) WSF(float, Cm) WSF(float, aff) WSF(int, slot_token) WSF(float, slot_gate) WSF(int, token_slots)
    WSF(bf16_t, HID) WSF(bf16_t, YE) WSF(bf16_t, BG) WSF(bf16_t, MERGED) WSF(bf16_t, Y)
#undef WSF
};

struct SetDesc { int is_ctx, nrows, samp0, nsamp, lgseq, ntb, cap, rpe; };
DEV SetDesc make_set(int is_ctx, int grp) {
    SetDesc s;
    s.is_ctx = is_ctx;
    if (is_ctx) { s.nrows = RC; s.samp0 = 0; s.nsamp = NB; s.lgseq = LGCTX; s.ntb = NTBC; s.cap = CTX / 8; s.rpe = RPE_C; }
    else { s.nrows = RL; s.samp0 = grp * G; s.nsamp = G; s.lgseq = LGSEQ; s.ntb = NTBL; s.cap = SEQ / 8; s.rpe = RPE_L; }
    return s;
}

#ifdef CPU_EMU
#define GAS
#else
#define GAS __attribute__((address_space(1)))
#endif
template <class T> DEV T ldg(const T* p) { return *(const GAS T*)p; }
template <class T> DEV void stg(T* p, const T& v) { *(GAS T*)p = v; }
DEV float bf2f(bf16_t v) { return __uint_as_float(((unsigned)v) << 16); }
DEV bf16_t f2bf(float f) { unsigned u = __float_as_uint(f); u += 0x7FFFu + ((u >> 16) & 1u); return (bf16_t)(u >> 16); }
#if defined(__HIP_DEVICE_COMPILE__)
typedef __bf16 bf16n2 __attribute__((ext_vector_type(2)));
typedef float f32n2 __attribute__((ext_vector_type(2)));
DEV unsigned pack2(float lo, float hi) { f32n2 v = {lo, hi}; bf16n2 r = __builtin_convertvector(v, bf16n2); return __builtin_bit_cast(unsigned, r); }
#else
DEV unsigned pack2(float lo, float hi) { return (unsigned)f2bf(lo) | ((unsigned)f2bf(hi) << 16); }
#endif
DEV float lo16(unsigned u) { return __uint_as_float(u << 16); }
DEV float hi16(unsigned u) { return __uint_as_float(u & 0xFFFF0000u); }
#if defined(__HIP_DEVICE_COMPILE__)
DEV float frcp(float x) { return __builtin_amdgcn_rcpf(x); }
#else
DEV float frcp(float x) { return 1.0f / x; }
#endif
#if defined(__HIP_DEVICE_COMPILE__)
DEV float sigmoidf_(float x) { return __builtin_amdgcn_rcpf(1.0f + __expf(-x)); }
#else
DEV float sigmoidf_(float x) { return 1.0f / (1.0f + __expf(-x)); }
#endif
DEV float logsigmoidf_(float x) { return fminf(x, 0.0f) - __logf(1.0f + __expf(-fabsf(x))); }
template <int M> DEV float shx(float v) {
#if defined(__HIP_DEVICE_COMPILE__)
    const unsigned u = __builtin_bit_cast(unsigned, v);
    if constexpr (M == 1) return __builtin_bit_cast(float, __builtin_amdgcn_update_dpp(u, u, 0xB1, 0xF, 0xF, false));
    else if constexpr (M == 2) return __builtin_bit_cast(float, __builtin_amdgcn_update_dpp(u, u, 0x4E, 0xF, 0xF, false));
    else if constexpr (M == 4) { const unsigned t = __builtin_amdgcn_update_dpp(u, u, 0x141, 0xF, 0xF, false);
        return __builtin_bit_cast(float, __builtin_amdgcn_update_dpp(t, t, 0x1B, 0xF, 0xF, false)); }
    else if constexpr (M == 8) return __builtin_bit_cast(float, __builtin_amdgcn_update_dpp(u, u, 0x128, 0xF, 0xF, false));
    else if constexpr (M == 16) { const auto r = __builtin_amdgcn_permlane16_swap(u, u, false, false); return __builtin_bit_cast(float, (threadIdx.x & 16) ? r[0] : r[1]); }
    else { const auto r = __builtin_amdgcn_permlane32_swap(u, u, false, false); return __builtin_bit_cast(float, (threadIdx.x & 32) ? r[0] : r[1]); }
#else
    return __shfl_xor(v, M);
#endif
}
DEV float wave_sum(float v) { v += shx<32>(v); v += shx<16>(v); v += shx<8>(v); v += shx<4>(v); v += shx<2>(v); v += shx<1>(v); return v; }
DEV bf16x8 mk8(u32x2 lo, u32x2 hi) { u32x4 v = {lo.x, lo.y, hi.x, hi.y}; return __builtin_bit_cast(bf16x8, v); }
DEV bf16x8 mk8(u32x4 v) { return __builtin_bit_cast(bf16x8, v); }
DEV bf16x8 mk8(s16x4 lo, s16x4 hi) { return __builtin_shufflevector(lo, hi, 0, 1, 2, 3, 4, 5, 6, 7); }
DEV f32x4 mfma16(bf16x8 a, bf16x8 b, f32x4 c) { return __builtin_amdgcn_mfma_f32_16x16x32_bf16(a, b, c, 0, 0, 0); }
DEV unsigned f8enc1(float x) {
    const unsigned sgn = x < 0.f ? 0x80u : 0u; float a = x < 0.f ? -x : x; if (!(a < 448.f)) a = 448.f;
    if (a < 0.015625f) { const int q = (int)(a * 512.f + 0.5f); const float r = a * 512.f; int qq = q; if ((float)q - r == 0.5f && (q & 1)) qq = q - 1; return sgn | (unsigned)qq; }
    int e = 0; float m = a; while (m >= 2.f) { m *= 0.5f; ++e; } while (m < 1.f) { m *= 2.f; --e; }
    const float r = (m - 1.f) * 8.f; int q = (int)(r + 0.5f); if ((float)q - r == 0.5f && (q & 1)) --q;
    if (q == 8) { q = 0; ++e; }
    return sgn | (unsigned)((e + 7) << 3) | (unsigned)q;
}
#if defined(__HIP_DEVICE_COMPILE__)
DEV unsigned f8pack4(float a, float b, float c, float d) {
    a = __builtin_amdgcn_fmed3f(a, -448.f, 448.f); b = __builtin_amdgcn_fmed3f(b, -448.f, 448.f); c = __builtin_amdgcn_fmed3f(c, -448.f, 448.f); d = __builtin_amdgcn_fmed3f(d, -448.f, 448.f);
    int w = 0; w = __builtin_amdgcn_cvt_pk_fp8_f32(a, b, w, false); w = __builtin_amdgcn_cvt_pk_fp8_f32(c, d, w, true); return (unsigned)w; }
#else
DEV unsigned f8pack4(float a, float b, float c, float d) { return f8enc1(a) | (f8enc1(b) << 8) | (f8enc1(c) << 16) | (f8enc1(d) << 24); }
#endif
#ifdef CPU_EMU
DEV f32x4 mfma_f8(bf16x8 a0, bf16x8 a1, bf16x8 b0, bf16x8 b1, f32x4 c) { return emu_mfma_f8(a0, a1, b0, b1, c); }
#else
typedef int i32x4 __attribute__((ext_vector_type(4)));
typedef int i32x8 __attribute__((ext_vector_type(8)));
DEV f32x4 mfma_f8(bf16x8 a0, bf16x8 a1, bf16x8 b0, bf16x8 b1, f32x4 c) {
    const i32x8 A = __builtin_shufflevector(__builtin_bit_cast(i32x4, a0), __builtin_bit_cast(i32x4, a1), 0, 1, 2, 3, 4, 5, 6, 7);
    const i32x8 B = __builtin_shufflevector(__builtin_bit_cast(i32x4, b0), __builtin_bit_cast(i32x4, b1), 0, 1, 2, 3, 4, 5, 6, 7);
    return __builtin_amdgcn_mfma_scale_f32_16x16x128_f8f6f4(A, B, c, 0, 0, 0, 0, 0, 0);
}
#endif
constexpr float F8_WSCALE = 64.0f, F8_WINV = 1.0f / 64.0f;
DEV void store8bf(bf16_t* o, f32x4 a, f32x4 b) { u32x4 v = {pack2(a[0], a[1]), pack2(a[2], a[3]), pack2(b[0], b[1]), pack2(b[2], b[3])}; stg((u32x4*)o, v); }

#ifndef CPU_EMU
#define XB_TMO      128
#define XB_XCNT(j)  (256  + 64 * (j))
#define XB_XSUB(j)  (1280 + 64 * (j))
#define XB_XGEN(j)  (2304 + 64 * (j))
#define XB_TOP      3328
#define XB_TOPGEN   3392
#define XCD_BAR_WORDS 3456
#define XB_SPIN_CAP (1u << 18)
#define LAS __attribute__((address_space(3)))
__device__ __forceinline__ unsigned xb_ld(unsigned* p)              { return __hip_atomic_load(p, __ATOMIC_RELAXED, __HIP_MEMORY_SCOPE_AGENT); }
__device__ __forceinline__ unsigned xb_add(unsigned* p, unsigned v) { return __hip_atomic_fetch_add(p, v, __ATOMIC_RELAXED, __HIP_MEMORY_SCOPE_AGENT); }
__device__ __forceinline__ unsigned xb_xcc_id() { return (unsigned)__builtin_amdgcn_s_getreg((3 << 11) | 20) & 0xFu; }
#define XB_SPIN(cond, bar) do { unsigned _sp = 0; while (cond) { __builtin_amdgcn_s_sleep(1); \
    if ((++_sp & 255u) == 0u) { if (xb_ld(&(bar)[XB_TMO])) break; if (_sp > XB_SPIN_CAP) { atomicAdd(&(bar)[XB_TMO], 1u); break; } } } } while (0)
struct XcdBarrier { unsigned* bar; unsigned x; volatile LAS unsigned* st; };
__device__ __forceinline__ XcdBarrier xcd_barrier_post(unsigned* bar, volatile LAS unsigned* st) {
    XcdBarrier b; b.bar = bar; b.x = xb_xcc_id(); b.st = st;
    if (threadIdx.x == 0) (void)xb_add(&bar[XB_XCNT(b.x)], 1u);
    return b;
}
__device__ __forceinline__ void xcd_barrier_complete(unsigned* bar, unsigned x, unsigned& nloc, unsigned& nx) {
    const unsigned Gd = gridDim.x * gridDim.y * gridDim.z;
    unsigned sum, cnt, mine, sp = 0u;
    for (;;) {
        sum = 0u; cnt = 0u; mine = 0u;
#pragma unroll
        for (unsigned j = 0; j < 16; ++j) { const unsigned c = xb_ld(&bar[XB_XCNT(j)]); sum += c; cnt += (c > 0u) ? 1u : 0u; mine = (j == x) ? c : mine; }
        if (sum == Gd) break;
        __builtin_amdgcn_s_sleep(1);
        if ((++sp & 255u) == 0u) { if (xb_ld(&bar[XB_TMO])) break; if (sp > XB_SPIN_CAP) { atomicAdd(&bar[XB_TMO], 1u); break; } }
    }
    nloc = mine > 0u ? mine : 1u; nx = cnt > 0u ? cnt : 1u;
}
__device__ __forceinline__ void xcd_barrier(const XcdBarrier& b) {
    asm volatile("s_waitcnt vmcnt(0)" ::: "memory");
    __syncthreads();
    if (threadIdx.x == 0) {
        unsigned* bar = b.bar;
        unsigned bx = b.x; asm volatile("" : "+s"(bx));
        __builtin_amdgcn_s_waitcnt(0);
        unsigned nloc = b.st[0], nx = b.st[1];
        if (nloc == 0u) { xcd_barrier_complete(bar, bx, nloc, nx); b.st[0] = nloc; b.st[1] = nx; }
        const unsigned old = xb_add(&bar[XB_XSUB(bx)], 1u);
        const unsigned gen = old / nloc;
        if (old + 1u == (gen + 1u) * nloc) {
            __builtin_amdgcn_fence(__ATOMIC_RELEASE, "agent");
            asm volatile("s_waitcnt vmcnt(0)" ::: "memory");
            const unsigned og = xb_add(&bar[XB_TOP], 1u);
            const unsigned tg = og / nx;
            if (og + 1u == (tg + 1u) * nx) xb_add(&bar[XB_TOPGEN], 1u);
            else XB_SPIN(xb_ld(&bar[XB_TOPGEN]) == tg, bar);
            __builtin_amdgcn_fence(__ATOMIC_ACQUIRE, "agent");
            xb_add(&bar[XB_XGEN(bx)], 1u);
            asm volatile("s_waitcnt vmcnt(0)" ::: "memory");
        } else {
            XB_SPIN(xb_ld(&bar[XB_XGEN(bx)]) == gen, bar);
            __builtin_amdgcn_fence(__ATOMIC_ACQUIRE, "agent");
            asm volatile("s_waitcnt vmcnt(0)" ::: "memory");
        }
    }
    __syncthreads();
}
#endif

constexpr int BK = 64, HALF = 128, HT_BYTES = HALF * BK * 2;
DEV int lds_byte(int r, int c) { int st = (r >> 4) * 2 + (c >> 5), rr = r & 15, cc = c & 31, ob = rr * 64 + cc * 2; return st * 1024 + (ob ^ (((ob >> 9) & 1) << 5)); }
DEV void stage_rc(int b, int& Rr, int& Cc) { int st = b / 1024, sb = b % 1024, swz = sb ^ (((sb >> 9) & 1) << 5); Rr = (st >> 1) * 16 + swz / 64; Cc = (st & 1) * 32 + (swz % 64) / 2; }
DEV int perm32(int rho) { const int n = rho >> 4, i = rho & 15; return 8 * (i >> 2) + 4 * n + (i & 3); }

DEV bool tile_from_L(int L, int nM, int nN, int& pm, int& pn) {
    const int nwg = nM * nN; if (L >= nwg) return false;
    int wgid = L; { const int q = nwg / 8, r = nwg % 8, xcd = wgid % 8, off = wgid / 8; wgid = (xcd < r ? xcd * (q + 1) : r * (q + 1) + (xcd - r) * q) + off; }
    const int nig = 8 * nN, gid = wgid / nig, fm = gid * 8, gsz = (nM - fm) < 8 ? (nM - fm) : 8;
    pm = fm + ((wgid % nig) % gsz); pn = (wgid % nig) / gsz; return true;
}
DEV bool tile_order(int i, int nM, int nN, int& pm, int& pn) { return tile_from_L(i * (int)gridDim.x + (int)blockIdx.x, nM, nN, pm, pn); }
#ifdef CPU_EMU
#define GLDS16(src, dst) __builtin_amdgcn_global_load_lds((const unsigned*)(src), (unsigned*)((dst) + (TID() & 63) * 16), 16, 0, 0)
#else
#define GLDS16(src, dst) __builtin_amdgcn_global_load_lds((const unsigned*)(src), (unsigned*)(dst), 16, 0, 0)
#endif

#define BAR __builtin_amdgcn_s_barrier()
#define SCHED __builtin_amdgcn_sched_barrier(0)
struct GUnit { int pm, pn, aux; };
template <bool GATHER, int LDA_, int LDB_, int K_, bool F8 = false, class Sched, class Epi>
DEV void gemm_stream(char* shm, const Sched& S, const Epi& epi) {
#define SA(b, h) (shm + ((b) * 2 + (h)) * HT_BYTES)
#define SB(b, h) (shm + (4 + (b) * 2 + (h)) * HT_BYTES)
#define STG_B(P, bp) do { GLDS16((bp) + voffB, (P) + ldsb0); GLDS16((bp) + voffB + 64 * LDB_, (P) + ldsb0 + 8192); } while (0)
#define STG_A(P, ap, h, gv) do { if (GATHER) { GLDS16((ap) + gv[h][0], (P) + ldsb0); GLDS16((ap) + gv[h][1], (P) + ldsb0 + 8192); } \
    else { GLDS16((ap) + voffA + (h) * 128 * LDA_, (P) + ldsb0); GLDS16((ap) + voffA + ((h) * 128 + 64) * LDA_, (P) + ldsb0 + 8192); } } while (0)
#define LDA(dst, b, h) _Pragma("unroll") for (int m = 0; m < 4; ++m) _Pragma("unroll") for (int k = 0; k < 2; ++k) \
    dst[m][k] = *reinterpret_cast<const bf16x8*>(SA(b, h) + aoff + m * 2048 + k * 1024)
#define LDB(dst, b, h) _Pragma("unroll") for (int n = 0; n < 2; ++n) _Pragma("unroll") for (int k = 0; k < 2; ++k) \
    dst[n][k] = *reinterpret_cast<const bf16x8*>(SB(b, h) + boff + n * 2048 + k * 1024)
#define MMA(ai, bj, At_, Bx_) do { __builtin_amdgcn_s_setprio(1); \
    if constexpr (F8) { _Pragma("unroll") for (int m = 0; m < 4; ++m) _Pragma("unroll") for (int n = 0; n < 2; ++n) \
      acc[ai][bj][m][n] = mfma_f8(Bx_[n][0], Bx_[n][1], At_[m][0], At_[m][1], acc[ai][bj][m][n]); } \
    else { _Pragma("unroll") for (int m = 0; m < 4; ++m) _Pragma("unroll") for (int n = 0; n < 2; ++n) _Pragma("unroll") for (int k = 0; k < 2; ++k) \
      acc[ai][bj][m][n] = mfma16(Bx_[n][k], At_[m][k], acc[ai][bj][m][n]); } \
    __builtin_amdgcn_s_setprio(0); } while (0)
    constexpr int nt = K_ / BK;
    const int tid = TID();
    const int wid = __builtin_amdgcn_readfirstlane(tid >> 6), lane = tid & 63, wr = wid >> 2, wc = wid & 3, fr = lane & 15, fq = lane >> 4;
    const int ldsb0 = wid * 1024;
    int Rr0, Cc0; stage_rc(tid * 16, Rr0, Cc0);
    const int voffA = Rr0 * LDA_ + Cc0;
    const int voffB = ((Rr0 & ~31) + perm32(Rr0 & 31)) * LDB_ + Cc0;
    const int aoff = lds_byte(wr * 64 + fr, fq * 8), boff = lds_byte(wc * 32 + fr, fq * 8);
    GUnit cur, nxt; int ui = 0;
    if (!S.next(0, cur)) return;
    int gc[2][2] = {{0, 0}, {0, 0}};
    int* gtab = (int*)(shm + 131072 + 256);
    if (GATHER) {
        __syncthreads();
        { GUnit u; for (int i = 0; i < GT_MAXU && S.next(i, u); ++i) { if (tid < 256) gtab[i * 256 + tid] = S.grow(u, tid) * LDA_; } }
        __syncthreads();
#pragma unroll
        for (int h = 0; h < 2; ++h)
#pragma unroll
            for (int i = 0; i < 2; ++i) gc[h][i] = gtab[h * 128 + i * 64 + Rr0] + Cc0;
    }
    f32x4 acc[2][2][4][2];
#pragma unroll
    for (int a = 0; a < 2; ++a)
#pragma unroll
        for (int b = 0; b < 2; ++b)
#pragma unroll
            for (int m = 0; m < 4; ++m)
#pragma unroll
                for (int n = 0; n < 2; ++n) acc[a][b][m][n] = (f32x4){0.f, 0.f, 0.f, 0.f};
    bf16x8 At[4][2], B0[2][2], B1[2][2];
    const bf16_t* cA = S.a_base(cur); const bf16_t* cB = S.b_base(cur);
    STG_B(SB(0, 0), cB); STG_A(SA(0, 0), cA, 0, gc); STG_B(SB(0, 1), cB + 128 * LDB_); STG_A(SA(0, 1), cA, 1, gc);
    if (wr == 1) BAR;
    WAIT_V(4); BAR;
    STG_B(SB(1, 0), cB + BK); STG_A(SA(1, 0), cA + BK, 0, gc); STG_B(SB(1, 1), cB + 128 * LDB_ + BK);
    WAIT_V(6); BAR;
    for (;;) {
        const bool has_next = S.next(ui + 1, nxt);
        const bf16_t* nA = has_next ? S.a_base(nxt) : cA; const bf16_t* nB = has_next ? S.b_base(nxt) : cB;
#pragma unroll 1
        for (int t = 0; t < nt; t += 2) {
            const bool last = (t == nt - 2);
            const bf16_t* a1 = cA + (t + 1) * BK;
            const bf16_t* a2 = last ? nA : cA + (t + 2) * BK; const bf16_t* b2 = last ? nB : cB + (t + 2) * BK;
            const bf16_t* a3 = a2 + BK; const bf16_t* b3 = b2 + BK;
            LDB(B0, 0, 0); SCHED; LDA(At, 0, 0); STG_A(SA(1, 1), a1, 1, gc);
            if (GATHER && last && has_next) {
#pragma unroll
                for (int h = 0; h < 2; ++h)
#pragma unroll
                    for (int i = 0; i < 2; ++i) gc[h][i] = gtab[(ui + 1) * 256 + h * 128 + i * 64 + Rr0] + Cc0; }
            WAIT_L(8); BAR; WAIT_L(0); MMA(0, 0, At, B0); BAR; SCHED;
            LDB(B1, 0, 1); STG_B(SB(0, 0), b2);
            BAR; WAIT_L(0); MMA(0, 1, At, B1); BAR;
            LDA(At, 0, 1); STG_A(SA(0, 0), a2, 0, gc);
            BAR; WAIT_L(0); MMA(1, 0, At, B0); BAR; SCHED;
            STG_B(SB(0, 1), b2 + 128 * LDB_);
            WAIT_V(6); BAR; MMA(1, 1, At, B1); BAR;
            LDB(B0, 1, 0); SCHED; LDA(At, 1, 0); STG_A(SA(0, 1), a2, 1, gc);
            WAIT_L(8); BAR; WAIT_L(0); MMA(0, 0, At, B0); BAR; SCHED;
            LDB(B1, 1, 1); STG_B(SB(1, 0), b3);
            BAR; WAIT_L(0); MMA(0, 1, At, B1); BAR;
            LDA(At, 1, 1); STG_A(SA(1, 0), a3, 0, gc);
            BAR; WAIT_L(0); MMA(1, 0, At, B0); BAR; SCHED;
            STG_B(SB(1, 1), b3 + 128 * LDB_);
            WAIT_V(6); BAR; MMA(1, 1, At, B1); BAR;
        }
        {
            const int tz = TID(); const int wz = tz >> 6, lz = tz & 63, wrz = wz >> 2, wcz = wz & 3, frz = lz & 15, fqz = lz >> 4;
            epi(cur, acc, wrz * 64 + frz, wcz * 32 + 8 * fqz);
        }
        if (!has_next) break;
#pragma unroll
        for (int a = 0; a < 2; ++a)
#pragma unroll
            for (int b = 0; b < 2; ++b)
#pragma unroll
                for (int m = 0; m < 4; ++m)
#pragma unroll
                    for (int n = 0; n < 2; ++n) acc[a][b][m][n] = (f32x4){0.f, 0.f, 0.f, 0.f};
        cur = nxt; cA = nA; cB = nB; ++ui;
    }
    WAIT_V(0);
    if (wr == 0) BAR;
    BAR;
#undef SA
#undef SB
#undef STG_A
#undef STG_B
#undef LDA
#undef LDB
#undef MMA
}

constexpr int J_IN = 16 * 27, J_WB = 2 * 8 * 4, J_WO = 16 * 4, J_GU = 16 * 2 * 64, J_DN = 16 * 64, J_FOLD = 8 * 16, J_PAD = 1;
constexpr int N_MODJOBS = 2 * 96;

constexpr int J_BIG = J_IN + J_WB + J_WO + J_GU + J_DN;
struct WJob { const float* src; bf16_t* dst; int ldsrc, lddst, nvalid, k0, n0, mode, gu_which, f8; };
DEV WJob wjob_decode(const Params& p, int l, int j) {
    WJob w; w.ldsrc = 1024; w.lddst = 1024; w.nvalid = 256; w.mode = 0; w.gu_which = 0; w.f8 = 0;
    if (j < J_IN) { const int kt = j / 27, nb = j % 27; w.k0 = kt * 64; w.n0 = nb * 256; w.src = p.w_in + (size_t)l * 1024 * PWSRC; w.ldsrc = PWSRC; w.nvalid = PWSRC - w.n0; w.dst = p.WinT() + (size_t)l * PWT * 1024; w.mode = 3; }
    else if ((j -= J_IN) < J_WB) { const int bi = (j / 32) * 2, jj = j % 32, kt = jj / 4, nb = jj % 4; w.k0 = kt * 64; w.n0 = nb * 256;
        w.src = p.w_branch + ((size_t)l * 3 + bi) * 512 * 1024; w.dst = p.WbT() + ((size_t)l * 3 + bi) * 1024 * 512; w.lddst = 512; }
    else if ((j -= J_WB) < J_WO) { const int kt = j / 4, nb = j % 4; w.k0 = kt * 64; w.n0 = nb * 256; w.src = p.w_out + (size_t)l * 1024 * 1024; w.dst = p.WoT() + (size_t)l * 1024 * 1024; }
    else if ((j -= J_WO) < J_GU) { const int e = j / 128, jj = j % 128; w.gu_which = jj / 64; const int j3 = jj % 64, kt = j3 / 4, nb = j3 % 4; w.k0 = kt * 64; w.n0 = nb * 256;
        w.src = (w.gu_which ? p.w_up : p.w_gate) + ((size_t)l * 16 + e) * 1024 * 1024; w.dst = p.WguT() + ((size_t)l * 16 + e) * 2048 * 512; w.mode = 1; w.f8 = 1; }
    else { j -= J_GU; const int e = j / 64, jj = j % 64, kt = jj / 4, nb = jj % 4; w.k0 = kt * 64; w.n0 = nb * 256;
        w.src = p.w_down + ((size_t)l * 16 + e) * 1024 * 1024; w.dst = p.WdT() + ((size_t)l * 16 + e) * 1024 * 512; w.f8 = 1; }
    return w;
}
constexpr int WT_LD = 260;
DEV void wjob_load(const WJob& w, int tid, f32x4 (&vv)[8]) {
#pragma unroll
    for (int i = 0; i < 8; ++i) { const int idx = i * 512 + tid, r = idx >> 6, c = (idx & 63) * 4; int col = w.n0 + c; col = col > w.ldsrc - 4 ? w.ldsrc - 4 : col;
        vv[i] = ldg((const f32x4*)(w.src + (size_t)(w.k0 + r) * w.ldsrc + col)); }
}
DEV void wjob_finish(const WJob& w, int tid, const f32x4 (&vv)[8], float* tile) {
    __syncthreads();
#pragma unroll
    for (int i = 0; i < 8; ++i) { const int idx = i * 512 + tid, r = idx >> 6, c = (idx & 63) * 4; *(f32x4*)(tile + r * WT_LD + c) = vv[i]; }
    __syncthreads();
#pragma unroll
    for (int q = 0; q < 4; ++q) {
        const int item = q * 512 + tid, nrow = item >> 3, kc = (item & 7) * 8;
        float v[8];
#pragma unroll
        for (int jj = 0; jj < 8; ++jj) v[jj] = tile[(kc + jj) * WT_LD + nrow];
        const int n = w.n0 + nrow;
        int drow = n; bool f8 = w.f8 != 0; size_t f8base = 0;
        if (w.mode == 1) drow = (n >> 7) * 256 + w.gu_which * 128 + (n & 127);
        if (w.mode == 3) {
            if (n >= C_SPLIT) { f8 = true; f8base = (size_t)PWA * 2048; drow = n - C_SPLIT; }
            else { drow = proj_col(n); if (drow >= C_F8) { f8 = true; f8base = (size_t)C_F8 * 2048; drow -= C_F8; } } }
        if (f8) { const u32x2 o = {f8pack4(v[0] * F8_WSCALE, v[1] * F8_WSCALE, v[2] * F8_WSCALE, v[3] * F8_WSCALE), f8pack4(v[4] * F8_WSCALE, v[5] * F8_WSCALE, v[6] * F8_WSCALE, v[7] * F8_WSCALE)};
            if (nrow < w.nvalid) stg((u32x2*)((unsigned char*)w.dst + f8base + (size_t)drow * 1024 + w.k0 + kc), o); }
        else if (nrow < w.nvalid) { u32x4 o = {pack2(v[0], v[1]), pack2(v[2], v[3]), pack2(v[4], v[5]), pack2(v[6], v[7])};
            stg((u32x4*)(w.dst + (size_t)drow * w.lddst + w.k0 + kc), o); }
    }
}
DEV void pro_small_job(const Params& p, int l, int j, char* shm) {
    float* tile = (float*)shm;
    const int tid = TID();
    if (j < J_FOLD) {
        const int kt = j / 16, ntl = j % 16, k0 = kt * 64, n0 = ntl * 64; const int fg = k0 / 128;
        const float* wb1 = p.w_branch + ((size_t)l * 3 + 1) * 512 * 1024;
        const float* pw = p.pool_w + ((size_t)l * 4 + fg) * 128 * 128; const float* ps = p.pool_scale + (size_t)l * 512 + fg * 128;
        const int c = tid & 63, rq = tid >> 6;
        float accv[8];
#pragma unroll
        for (int i = 0; i < 8; ++i) accv[i] = 0.f;
        for (int d = 0; d < 128; ++d) { const float wv = ldg(wb1 + (size_t)(fg * 128 + d) * 1024 + n0 + c) * ldg(ps + d);
#pragma unroll
            for (int i = 0; i < 8; ++i) accv[i] += ldg(pw + (size_t)(k0 - fg * 128 + rq * 8 + i) * 128 + d) * wv; }
        __syncthreads();
#pragma unroll
        for (int i = 0; i < 8; ++i) tile[(rq * 8 + i) * WT_LD + c] = accv[i];
        __syncthreads();
        const int nrow = tid >> 3, kc = (tid & 7) * 8; float v[8];
#pragma unroll
        for (int jj = 0; jj < 8; ++jj) v[jj] = tile[(kc + jj) * WT_LD + nrow];
        u32x4 o = {pack2(v[0], v[1]), pack2(v[2], v[3]), pack2(v[4], v[5]), pack2(v[6], v[7])};
        stg((u32x4*)(p.WbT() + ((size_t)l * 3 + 1) * 1024 * 512 + (size_t)(n0 + nrow) * 512 + k0 + kc), o);
    } else {
        bf16_t* d0 = p.WinT() + (size_t)l * PWT * 1024 + (size_t)C_PADA * 1024;
        for (int i = tid; i < (C_F8 - C_PADA) * 1024 / 8; i += NTHREADS) stg((u32x4*)(d0 + (size_t)i * 8), (u32x4){0u, 0u, 0u, 0u});
    }
}

DEV void pro_mod_job(const Params& p, int job, char* shm) {
    float* sv = (float*)shm;
    const int tid = TID(), l = job / 96, col0 = (job % 96) * 64;
    const int c = tid & 63, kp = tid >> 6;
    float acc[NB + 1];
#pragma unroll
    for (int v = 0; v <= NB; ++v) acc[v] = 0.f;
    for (int half = 0; half < 2; ++half) {
        __syncthreads();
        for (int idx = tid; idx < (NB + 1) * 512; idx += 512) { const int v = idx >> 9, k = idx & 511;
            const float s = (v < NB) ? ldg(p.c + (size_t)v * 1024 + half * 512 + k) : ldg(p.c_ctx + half * 512 + k);
            sv[idx] = s * sigmoidf_(s); }
        __syncthreads();
        for (int kk = 0; kk < 64; ++kk) { const int k = kp * 64 + kk;
            const float w = ldg(p.ada_w + ((size_t)l * 1024 + half * 512 + k) * 6144 + col0 + c);
#pragma unroll
            for (int v = 0; v <= NB; ++v) acc[v] += sv[v * 512 + k] * w; }
    }
    __syncthreads();
    float* red = (float*)shm;
#pragma unroll
    for (int v = 0; v <= NB; ++v) red[(kp * (NB + 1) + v) * 64 + c] = acc[v];
    __syncthreads();
    for (int idx = tid; idx < (NB + 1) * 64; idx += 512) { const int v = idx >> 6, cc = idx & 63; float s = 0.f;
#pragma unroll
        for (int q = 0; q < 8; ++q) s += red[(q * (NB + 1) + v) * 64 + cc];
        stg(p.mod() + ((size_t)l * (NB + 1) + v) * 6144 + col0 + cc, s + ldg(p.ada_b + (size_t)l * 6144 + col0 + cc)); }
}

DEV void phase_prologue(const Params& p, char* shm) {
    const int tid = TID();
    const int nsmall = N_MODJOBS + 1 + 2 * (J_FOLD + J_PAD);
    for (int job = blockIdx.x; job < nsmall; job += gridDim.x) {
        if (job < N_MODJOBS) pro_mod_job(p, job, shm);
        else if (job == N_MODJOBS) {
            for (int idx = tid; idx < (ROWS + 64) * 16; idx += NTHREADS) { const int pos = idx >> 4, i = idx & 15;
                const float pv = (float)(pos < ROWS ? pos : pos - ROWS);
                const float inv = powf(10000.0f, -(float)(2 * i) / 32.0f);
                const float a = pv * inv; stg(p.rope() + idx * 2, cosf(a)); stg(p.rope() + idx * 2 + 1, sinf(a)); }
        } else { const int sj = job - N_MODJOBS - 1; pro_small_job(p, sj / (J_FOLD + J_PAD), sj % (J_FOLD + J_PAD), shm); }
    }
    float* tile = (float*)shm;
    const int nbig = 2 * J_BIG;
    int job = blockIdx.x;
    if (job >= nbig) return;
    WJob wc = wjob_decode(p, job / J_BIG, job % J_BIG), wn = wc;
    f32x4 vc[8], vn[8];
    wjob_load(wc, tid, vc);
    for (; job < nbig; job += gridDim.x) {
        const int jn = job + gridDim.x;
        if (jn < nbig) { wn = wjob_decode(p, jn / J_BIG, jn % J_BIG); wjob_load(wn, tid, vn); }
        wjob_finish(wc, tid, vc, tile);
        wc = wn;
#pragma unroll
        for (int i = 0; i < 8; ++i) vc[i] = vn[i];
    }
}

DEV const float* xsrc_base(const Params& p, const SetDesc& sd, int layer) {
    return (sd.is_ctx ? (layer == 0 ? p.ctx : (const float*)p.ctxs()) : (layer == 0 ? p.x : (const float*)p.out)) + (((size_t)sd.samp0) << sd.lgseq) * 1024;
}
DEV float* xdst_base(const Params& p, const SetDesc& sd) { return (sd.is_ctx ? p.ctxs() : p.out) + (((size_t)sd.samp0) << sd.lgseq) * 1024; }
DEV const float* mod_row(const Params& p, const SetDesc& sd, int layer, int row) {
    return p.mod() + ((size_t)layer * (NB + 1) + (sd.is_ctx ? NB : sd.samp0 + (row >> sd.lgseq))) * 6144;
}
DEV bf16_t* proj_buf(const Params& p, const SetDesc& sd) { return sd.is_ctx ? p.PROJc() : p.PROJa(); }

DEV void stage_params(float* par, const float* v0, const float* v1, const float* v2, const float* v3, const float* v4) {
    const int tid = TID();
    const float* src[5] = {v0, v1, v2, v3, v4};
#pragma unroll
    for (int k = 0; k < 5; ++k) if (src[k]) { for (int i = tid; i < 1024; i += NTHREADS) par[k * 1024 + i] = ldg(src[k] + i); }
}
DEV void phase_norm1(const Params& p, const SetDesc& sd, int layer, char* shm) {
    const int tid = TID(), lane = tid & 63, wv = tid >> 6;
    const float* g0 = p.norm_gain + ((size_t)layer * 4 + 0) * 1024;
    const float* xb = xsrc_base(p, sd, layer);
    const int stride = 8; const int rpb_ = (sd.nrows + (int)gridDim.x - 1) / (int)gridDim.x; const int row_end = min(sd.nrows, ((int)blockIdx.x + 1) * rpb_);
    int row = (int)blockIdx.x * rpb_ + wv;
    float* par = (float*)shm;
    __syncthreads();
    { const float* mdb = mod_row(p, sd, layer, min((int)blockIdx.x * rpb_, sd.nrows - 1)); stage_params(par, g0, mdb, mdb + 1024, nullptr, nullptr); }
    __syncthreads();
    f32x4 cur[4], nxt[4];
    if (row < row_end) {
#pragma unroll
        for (int i = 0; i < 4; ++i) cur[i] = ldg((const f32x4*)(xb + (size_t)row * 1024 + (i >> 1) * 512 + lane * 8 + (i & 1) * 4)); }
    for (; row < row_end; row += stride) {
        const int rn = row + stride;
        if (rn < row_end) {
#pragma unroll
            for (int i = 0; i < 4; ++i) nxt[i] = ldg((const f32x4*)(xb + (size_t)rn * 1024 + (i >> 1) * 512 + lane * 8 + (i & 1) * 4)); }
        const float* md = mod_row(p, sd, layer, row);
        float ss = 0.f;
#pragma unroll
        for (int i = 0; i < 4; ++i)
#pragma unroll
            for (int j = 0; j < 4; ++j) ss += cur[i][j] * cur[i][j];
        ss = wave_sum(ss);
        const float rstd = rsqrtf(ss * (1.0f / 1024.0f) + RMS_EPS);
#pragma unroll
        for (int hlf = 0; hlf < 2; ++hlf) { const int c0 = hlf * 512 + lane * 8; float o[8];
#pragma unroll
            for (int j = 0; j < 8; ++j) o[j] = cur[hlf * 2 + (j >> 2)][j & 3] * rstd * par[c0 + j] * (1.0f + par[2048 + c0 + j]) + par[1024 + c0 + j];
            u32x4 ov = {pack2(o[0], o[1]), pack2(o[2], o[3]), pack2(o[4], o[5]), pack2(o[6], o[7])};
            stg((u32x4*)(p.H() + (size_t)row * 1024 + c0), ov);
            const u32x2 o8 = {f8pack4(o[0], o[1], o[2], o[3]), f8pack4(o[4], o[5], o[6], o[7])};
            stg((u32x2*)(p.H8() + (size_t)row * 1024 + c0), o8); }
#pragma unroll
        for (int i = 0; i < 4; ++i) cur[i] = nxt[i];
    }
}

struct SchedPlain {
    const bf16_t* A; const bf16_t* Bt; int nM, nN, lda256, ldb256;
    DEV bool next(int i, GUnit& u) const { u.aux = 0; return tile_order(i, nM, nN, u.pm, u.pn); }
    DEV const bf16_t* a_base(const GUnit& u) const { return A + (size_t)u.pm * lda256; }
    DEV const bf16_t* b_base(const GUnit& u) const { return Bt + (size_t)u.pn * ldb256; }
    DEV int grow(const GUnit&, int) const { return 0; }
};
struct SchedPlainT : SchedPlain {
    int split_base = -1;
    DEV bool next(int i, GUnit& u) const { u.aux = 0; const int G_ = (int)gridDim.x, b = (int)blockIdx.x; int L = i * G_ + b;
        if (split_base >= 0 && i >= split_base) { if (b < G_ / 2 || i >= split_base + 2) return false; L = split_base * G_ + (i - split_base) * (G_ / 2) + (b - G_ / 2); }
        return tile_from_L(L, nM, nN, u.pm, u.pn); }
    DEV const bf16_t* a_base(const GUnit&) const { return A; }
    DEV int grow(const GUnit& u, int i) const { return u.pm * 256 + i; }
};
DEV void phase_proj_a(const Params& p, const SetDesc& sd, int layer, char* shm) {
    bf16_t* pb = proj_buf(p, sd);
    {
        SchedPlain S; S.A = p.H(); S.Bt = p.WinT() + (size_t)layer * PWT * 1024; S.nM = sd.nrows / 256; S.nN = C_F8 / 256; S.lda256 = 256 * 1024; S.ldb256 = 256 * 1024;
        gemm_stream<false, 1024, 1024, 1024>(shm, S, [=](const GUnit& u, const f32x4 (&acc)[2][2][4][2], int r0, int c0) {
#pragma unroll
            for (int ai = 0; ai < 2; ++ai)
#pragma unroll
                for (int m = 0; m < 4; ++m) { bf16_t* o = pb + ((size_t)u.pm * 256 + r0 + ai * 128 + m * 16) * PWA + u.pn * 256 + c0;
                    store8bf(o, acc[ai][0][m][0], acc[ai][0][m][1]); store8bf(o + 128, acc[ai][1][m][0], acc[ai][1][m][1]); } });
    }
    {
        SchedPlainT S; S.A = (const bf16_t*)p.H8(); S.Bt = p.WinT() + (size_t)layer * PWT * 1024 + (size_t)C_F8 * 1024; S.nM = sd.nrows / 256; S.nN = (PWA - C_F8) / 256; S.lda256 = 256 * 512; S.ldb256 = 256 * 512;
        { const int G_ = (int)gridDim.x, T1 = S.nM * (C_F8 / 256), T2 = S.nM * S.nN; if ((G_ & 1) == 0 && (T1 % G_) * 2 == G_ && T2 % G_ == 0 && T2 / G_ >= 1) S.split_base = T2 / G_ - 1; }
        gemm_stream<true, 512, 512, 512, true>(shm, S, [=](const GUnit& u, const f32x4 (&acc)[2][2][4][2], int r0, int c0) {
#pragma unroll
            for (int ai = 0; ai < 2; ++ai)
#pragma unroll
                for (int m = 0; m < 4; ++m) { bf16_t* o = pb + ((size_t)u.pm * 256 + r0 + ai * 128 + m * 16) * PWA + C_F8 + u.pn * 256 + c0;
                    store8bf(o, acc[ai][0][m][0] * F8_WINV, acc[ai][0][m][1] * F8_WINV); store8bf(o + 128, acc[ai][1][m][0] * F8_WINV, acc[ai][1][m][1] * F8_WINV); } });
    }
}
DEV f32x4 sig4(f32x4 v) { f32x4 r; r[0] = sigmoidf_(v[0]); r[1] = sigmoidf_(v[1]); r[2] = sigmoidf_(v[2]); r[3] = sigmoidf_(v[3]); return r; }
DEV void phase_proj_b(const Params& p, const SetDesc& sd, int layer, char* shm) {
    SchedPlainT S; S.A = (const bf16_t*)p.H8(); S.Bt = p.WinT() + (size_t)layer * PWT * 1024 + (size_t)PWA * 1024; S.nM = sd.nrows / 256; S.nN = NBG / 256; S.lda256 = 256 * 512; S.ldb256 = 256 * 512;
    bf16_t* bg = p.BG();
    gemm_stream<true, 512, 512, 512, true>(shm, S, [=](const GUnit& u, const f32x4 (&acc)[2][2][4][2], int r0, int c0) {
#pragma unroll
        for (int ai = 0; ai < 2; ++ai)
#pragma unroll
            for (int m = 0; m < 4; ++m) { bf16_t* o = bg + ((size_t)u.pm * 256 + r0 + ai * 128 + m * 16) * NBG + u.pn * 256 + c0;
                store8bf(o, sig4(acc[ai][0][m][0] * F8_WINV), sig4(acc[ai][0][m][1] * F8_WINV)); store8bf(o + 128, sig4(acc[ai][1][m][0] * F8_WINV), sig4(acc[ai][1][m][1] * F8_WINV)); } });
}

DEV void gate_scan(const bf16_t* prow, int h, const float* gbias, float* ga, float* gb, float* gpm, float* gtot, float* tmp) {
    const int tid = TID(), lane = tid & 63, w = tid >> 6;
    float b = 0.f, a = 0.f, pm = 0.f; int d = 0, tok = 0;
    if (tid < 256) {
        d = tid >> 7; const int i = tid & 127; tok = d ? 127 - i : i;
        const float gi = bf2f(ldg(prow + (size_t)tok * PWA + C_GM + (2 * d) * 4 + h)) + ldg(gbias + (2 * d) * 4 + h);
        const float gf = bf2f(ldg(prow + (size_t)tok * PWA + C_GM + (2 * d + 1) * 4 + h)) + ldg(gbias + (2 * d + 1) * 4 + h);
        b = logsigmoidf_(gf);
#pragma unroll
        for (int o = 1; o < 64; o <<= 1) { const float t = __shfl_up(b, o); if (lane >= o) b += t; }
        if (lane == 63) tmp[w] = b;
        a = gi;
    }
    __syncthreads();
    if (tid < 256) {
        if (w & 1) b += tmp[w - 1];
        a -= b; pm = a;
#pragma unroll
        for (int o = 1; o < 64; o <<= 1) { const float t = __shfl_up(pm, o); if (lane >= o) pm = fmaxf(pm, t); }
        if (lane == 63) tmp[8 + w] = pm;
    }
    __syncthreads();
    if (tid < 256) {
        if (w & 1) pm = fmaxf(pm, tmp[8 + w - 1]);
        ga[d * 128 + tok] = a; gb[d * 128 + tok] = b; gpm[d * 128 + tok] = pm;
        if ((tid & 127) == 127) { gtot[d * 2] = b; gtot[d * 2 + 1] = pm; }
    }
    __syncthreads();
}

DEV void load_rope_chunk(const bf16_t* hp, int cidx, bool latent, int tl, const float* rope, float scale, float* o) {
    const u32x4 m = ldg((const u32x4*)(hp + cidx * 8));
    float x[8] = {lo16(m.x), hi16(m.x), lo16(m.y), hi16(m.y), lo16(m.z), hi16(m.z), lo16(m.w), hi16(m.w)};
    if (latent) {
        const u32x4 q = ldg((const u32x4*)(hp + (cidx ^ 2) * 8));
        const float y[8] = {lo16(q.x), hi16(q.x), lo16(q.y), hi16(q.y), lo16(q.z), hi16(q.z), lo16(q.w), hi16(q.w)};
        const int pos = (cidx < 4) ? (tl >> 6) : (ROWS + (tl & 63));
        const float* tb = rope + ((size_t)pos * 16 + (cidx & 1) * 8) * 2;
        const bool first = (cidx & 2) == 0;
#pragma unroll
        for (int j = 0; j < 8; ++j) { const float cs = ldg(tb + j * 2), sn = ldg(tb + j * 2 + 1);
            x[j] = first ? (x[j] * cs - y[j] * sn) : (x[j] * cs + y[j] * sn); }
    }
#pragma unroll
    for (int j = 0; j < 8; ++j) o[j] = x[j] * scale;
}

DEV int st_index(const SetDesc& sd, int sl, int h, int dir, int tb) { return ((sl * 4 + h) * 2 + dir) * sd.ntb + tb; }

constexpr int V_LD = 144, K_LD = 72, KS_LD = 80;
DEV void mlstm_stepA_task(const Params& p, const SetDesc& sd, int layer, int task, char* shm) {
    const int tid = TID(), lane = tid & 63, w = tid >> 6, fr = lane & 15, fq = lane >> 4, tq4 = (lane & 15) >> 2, tp4 = lane & 3;
    const int tb = task % sd.ntb, h = (task / sd.ntb) & 3, sl = task / (sd.ntb * 4);
    const int row0 = (sl << sd.lgseq) + tb * 128; const bool latent = !sd.is_ctx; const int tl0 = tb * 128;
    bf16_t* Vs = (bf16_t*)shm;
    bf16_t* Ksc = (bf16_t*)(shm + 128 * V_LD * 2);
    float* ga = (float*)(shm + 128 * V_LD * 2 + 2 * 128 * KS_LD * 2); float* gb = ga + 256; float* gpm = gb + 256; float* gtot = gpm + 256; float* tmp = gtot + 8;
    const bf16_t* prow = proj_buf(p, sd) + (size_t)row0 * PWA;
    __syncthreads();
    gate_scan(prow, h, p.gate_bias + (size_t)layer * 16, ga, gb, gpm, gtot, tmp);
    {
        const int s = tid & 127, cpi = tid >> 7, cp = (cpi & 1) + (cpi >> 1) * 4;
        const bf16_t* hp = prow + (size_t)s * PWA + C_KM + h * 64;
        float k1[8], k2[8];
        load_rope_chunk(hp, cp, latent, tl0 + s, p.rope(), 1.0f, k1);
        load_rope_chunk(hp, cp + 2, latent, tl0 + s, p.rope(), 1.0f, k2);
#pragma unroll
        for (int dir = 0; dir < 2; ++dir) { const float ws = __expf(ga[dir * 128 + s] - gtot[dir * 2 + 1]);
            u32x4 o1 = {pack2(k1[0] * ws, k1[1] * ws), pack2(k1[2] * ws, k1[3] * ws), pack2(k1[4] * ws, k1[5] * ws), pack2(k1[6] * ws, k1[7] * ws)};
            u32x4 o2 = {pack2(k2[0] * ws, k2[1] * ws), pack2(k2[2] * ws, k2[3] * ws), pack2(k2[4] * ws, k2[5] * ws), pack2(k2[6] * ws, k2[7] * ws)};
            *(u32x4*)(Ksc + (dir * 128 + s) * KS_LD + cp * 8) = o1; *(u32x4*)(Ksc + (dir * 128 + s) * KS_LD + (cp + 2) * 8) = o2; }
    }
#pragma unroll
    for (int it = 0; it < 4; ++it) { const int item = tid + it * 512, s = item >> 4, ch = item & 15;
        *(u32x4*)(Vs + s * V_LD + ch * 8) = ldg((const u32x4*)(prow + (size_t)s * PWA + C_VM + h * 128 + ch * 8)); }
    __syncthreads();
    f32x4 acc[2][4];
#pragma unroll
    for (int dir = 0; dir < 2; ++dir)
#pragma unroll
        for (int n = 0; n < 4; ++n) acc[dir][n] = (f32x4){0.f, 0.f, 0.f, 0.f};
#pragma unroll
    for (int ks = 0; ks < 4; ++ks) {
        const bf16_t* vp = Vs + (32 * ks + 4 * fq + tq4) * V_LD + w * 16 + 4 * tp4;
        const bf16x8 af = mk8(TR16(vp), TR16(vp + 16 * V_LD));
#pragma unroll
        for (int dir = 0; dir < 2; ++dir)
#pragma unroll
            for (int n = 0; n < 4; ++n) { const bf16_t* kp = Ksc + (dir * 128 + 32 * ks + 4 * fq + tq4) * KS_LD + n * 16 + 4 * tp4;
                const bf16x8 bfv = mk8(TR16(kp), TR16(kp + 16 * KS_LD));
                acc[dir][n] = mfma16(af, bfv, acc[dir][n]); }
    }
#pragma unroll
    for (int dir = 0; dir < 2; ++dir) { float* So = p.Sst() + (size_t)st_index(sd, sl, h, dir, tb) * 8192;
#pragma unroll
        for (int n = 0; n < 4; ++n)
#pragma unroll
            for (int r = 0; r < 4; ++r) stg(So + (w * 16 + fq * 4 + r) * 64 + n * 16 + fr, (float)acc[dir][n][r]); }
    if (tid < 128) { const int dir = tid >> 6, dd = tid & 63; float sm = 0.f;
        for (int i = 0; i < 128; ++i) sm += bf2f(Ksc[(dir * 128 + i) * KS_LD + dd]);
        stg(p.Sn() + (size_t)st_index(sd, sl, h, dir, tb) * 64 + dd, sm); }
    if (tid < 2) { float* sc = p.Ssc() + (size_t)st_index(sd, sl, h, tid, tb) * 4; stg(sc, gtot[tid * 2]); stg(sc + 1, gtot[tid * 2] + gtot[tid * 2 + 1]); }
}

template <int GI> DEV void pool_group(const Params& p, const SetDesc& sd, const bf16_t* pb) {
    constexpr int W = 2 << GI;
    const int nitems = sd.nrows * 16; const int T = 1 << sd.lgseq;
    for (int item = blockIdx.x * NTHREADS + TID(); item < nitems; item += gridDim.x * NTHREADS) {
        const int row = item >> 4, ch = GI * 128 + (item & 15) * 8;
        const int tt = row & (T - 1);
        u32x4 mv[W]; int cnt = 0; bool okv[W];
#pragma unroll
        for (int q = 0; q < W; ++q) { const int t2 = tt - W / 2 + q; const bool ok = (t2 >= 0) && (t2 < T); cnt += ok ? 1 : 0; okv[q] = ok;
            mv[q] = ldg((const u32x4*)(pb + (size_t)(ok ? (row - W / 2 + q) : row) * PWA + C_PU + ch)); }
        float s[8];
#pragma unroll
        for (int j = 0; j < 8; ++j) s[j] = 0.f;
#pragma unroll
        for (int q = 0; q < W; ++q) { u32x4 m = mv[q]; if (!okv[q]) m = (u32x4){0u, 0u, 0u, 0u};
            s[0] += lo16(m.x); s[1] += hi16(m.x); s[2] += lo16(m.y); s[3] += hi16(m.y); s[4] += lo16(m.z); s[5] += hi16(m.z); s[6] += lo16(m.w); s[7] += hi16(m.w); }
        const float inv = frcp((float)cnt);
        const u32x4 m = mv[W / 2];
        const float u[8] = {lo16(m.x), hi16(m.x), lo16(m.y), hi16(m.y), lo16(m.z), hi16(m.z), lo16(m.w), hi16(m.w)};
        u32x4 o = {pack2(s[0] * inv - u[0], s[1] * inv - u[1]), pack2(s[2] * inv - u[2], s[3] * inv - u[3]), pack2(s[4] * inv - u[4], s[5] * inv - u[5]), pack2(s[6] * inv - u[6], s[7] * inv - u[7])};
        stg((u32x4*)(p.Pb() + (size_t)row * 512 + ch), o);
    }
}
DEV void phase_pool(const Params& p, const SetDesc& sd) {
    const bf16_t* pb = proj_buf(p, sd);
    pool_group<0>(p, sd, pb); pool_group<1>(p, sd, pb); pool_group<2>(p, sd, pb); pool_group<3>(p, sd, pb);
}

template <int NC> DEV void mlstm_stepB_run(const Params& p, const SetDesc& sd, int task) {
    const int tid = TID();
    const int q = task & 3, dir = (task >> 2) & 1, h = (task >> 3) & 3, sl = task >> 5;
    const int ci = ((sd.samp0 + sl) * 4 + h) * 2 + dir;
    const int eoff = q * 2048 + tid * 4;
    float zr = 0.f; HIDE(zr);
    f32x4 C = {zr, zr, zr, zr}; float nv = 0.f; float m = -1e30f;
    f32x4 Sv[NC]; float blv[NC], mlv[NC], snv[NC];
#pragma unroll
    for (int c = 0; c < NC; ++c) { const int tb = dir ? NC - 1 - c : c; const size_t si = st_index(sd, sl, h, dir, tb);
        Sv[c] = ldg((const f32x4*)(p.Sst() + si * 8192 + eoff)); blv[c] = ldg(p.Ssc() + si * 4); mlv[c] = ldg(p.Ssc() + si * 4 + 1);
        snv[c] = (q == 0 && tid < 64) ? ldg(p.Sn() + si * 64 + tid) : 0.f; }
    if (!sd.is_ctx) { C = ldg((const f32x4*)(p.CiC() + (size_t)ci * 8192 + eoff)); if (q == 0 && tid < 64) nv = ldg(p.Cin_() + (size_t)ci * 64 + tid); m = ldg(p.Cim() + (size_t)ci * 4); }
#pragma unroll
    for (int c = 0; c < NC; ++c) {
        const int tb = dir ? NC - 1 - c : c; const size_t si = st_index(sd, sl, h, dir, tb);
        u32x2 o = {pack2(C[0], C[1]), pack2(C[2], C[3])};
        stg((u32x2*)(p.Cin() + si * 8192 + eoff), o);
        if (q == 0 && tid < 64) stg(p.Cn() + si * 64 + tid, nv);
        if (q == 0 && tid == 0) stg(p.Cm() + si * 4, m);
        const float mn = fmaxf(blv[c] + m, mlv[c]);
        const float dc = __expf(blv[c] + m - mn), wsn = __expf(mlv[c] - mn);
        C = C * dc + Sv[c] * wsn;
        nv = nv * dc + snv[c] * wsn;
        m = mn;
    }
    if (sd.is_ctx) { stg((f32x4*)(p.CiC() + (size_t)ci * 8192 + eoff), C); if (q == 0 && tid < 64) stg(p.Cin_() + (size_t)ci * 64 + tid, nv); if (q == 0 && tid == 0) stg(p.Cim() + (size_t)ci * 4, m); }
}
DEV void mlstm_stepB_task(const Params& p, const SetDesc& sd, int task) {
    if (sd.is_ctx) mlstm_stepB_run<NTBC>(p, sd, task); else mlstm_stepB_run<NTBL>(p, sd, task);
}

constexpr int NA_KLD = 136, NA_VLD = 144;
DEV void na_task(const Params& p, const SetDesc& sd, int layer, int sl, int rq2  , int hp, char* shm) {
    const int tid = TID(), lane = tid & 63, w = tid >> 6, tq = lane & 15, fq = lane >> 4, tq4 = (lane & 15) >> 2, tp4 = lane & 3;
    const int hh = w >> 2, g = w & 3, head = hp * 2 + hh;
    const bool ctxq = sd.is_ctx;
    bf16_t* Ks = (bf16_t*)shm;
    bf16_t* Vs = (bf16_t*)(shm + 128 * NA_KLD * 2);
    float* rpbs = (float*)(shm + 128 * NA_KLD * 2 + 128 * NA_VLD * 2);
    const int sample = sd.samp0 + sl;
    const bf16_t* pq = proj_buf(p, sd) + ((size_t)sl << sd.lgseq) * PWA;
    const bf16_t* pc = p.PROJc() + (size_t)sample * CTX * PWA;
    const int qcol = g * 16 + tq;
    int rqv[2], rsv[2], qtok[2];
#pragma unroll
    for (int u = 0; u < 2; ++u) { rqv[u] = 2 * rq2 + u; qtok[u] = rqv[u] * 64 + qcol; int r_ = rqv[u] - 4; rsv[u] = r_ < 0 ? 0 : (r_ > ROWS - 8 ? ROWS - 8 : r_); }
    const int nloc = ctxq ? 0 : (rsv[1] + 8 - rsv[0]);
    const int nstage = nloc + CTX / 64;
    __syncthreads();
    if (!ctxq) for (int i = tid; i < 2 * 465; i += NTHREADS) rpbs[i] = ldg(p.rpb + ((size_t)layer * 8 + hp * 2 + i / 465) * 465 + i % 465);
    bf16x8 qf[2][2];
#pragma unroll
    for (int u = 0; u < 2; ++u)
#pragma unroll
        for (int ks = 0; ks < 2; ++ks) qf[u][ks] = mk8(ldg((const u32x4*)(pq + (size_t)qtok[u] * PWA + C_QN + head * 64 + ks * 32 + fq * 8)));
    float m_run[2] = {-1e30f, -1e30f}, l_run[2] = {0.f, 0.f};
    f32x4 acc[2][4];
#pragma unroll
    for (int u = 0; u < 2; ++u)
#pragma unroll
        for (int mt = 0; mt < 4; ++mt) acc[u][mt] = (f32x4){0.f, 0.f, 0.f, 0.f};
    int cs = qcol - 8; cs = cs < 0 ? 0 : (cs > 48 ? 48 : cs);
    const int kc0 = (g == 0) ? 0 : (g == 1) ? 8 : (g == 2) ? 24 : 32;
    const int npair = (nstage + 1) >> 1;
    u32x4 kreg[4], vreg[4];
#define NA_SRC_ROWS(stg) (((stg) < nloc) ? (pq + (size_t)((rsv[0] + (stg)) * 64) * PWA) : (pc + (size_t)((((stg) < nstage ? (stg) : nstage - 1) - nloc) * 64) * PWA))
#define NA_FETCH(sp_) do { _Pragma("unroll") for (int it = 0; it < 4; ++it) { const int item = tid + it * 512, key2 = item >> 4, ch = item & 15; \
        const bf16_t* kb_ = NA_SRC_ROWS(2 * (sp_) + (key2 >> 6)); const bf16_t* src = kb_ + (size_t)(key2 & 63) * PWA + hp * 128 + ch * 8; \
        kreg[it] = ldg((const u32x4*)(src + C_KN)); vreg[it] = ldg((const u32x4*)(src + C_VN)); } } while (0)
    NA_FETCH(0);
    for (int sp = 0; sp < npair; ++sp) {
        __syncthreads();
#pragma unroll
        for (int it = 0; it < 4; ++it) { const int item = tid + it * 512, key2 = item >> 4, ch = item & 15;
            *(u32x4*)(Ks + key2 * NA_KLD + ch * 8) = kreg[it]; *(u32x4*)(Vs + key2 * NA_VLD + ch * 8) = vreg[it]; }
        if (sp + 1 < npair) NA_FETCH(sp + 1);
        __syncthreads();
#pragma unroll
        for (int sub = 0; sub < 2; ++sub) {
        const int st = 2 * sp + sub;
        if (st >= nstage) continue;
        const bool local = st < nloc;
        const bf16_t* Ksb = Ks + sub * 64 * NA_KLD; const bf16_t* Vsb = Vs + sub * 64 * NA_VLD;
        if (local) {
            const int kr = rsv[0] + st;
            f32x4 sa[2][2];
#pragma unroll
            for (int kt = 0; kt < 2; ++kt) { sa[0][kt] = (f32x4){0.f, 0.f, 0.f, 0.f}; sa[1][kt] = (f32x4){0.f, 0.f, 0.f, 0.f};
#pragma unroll
                for (int ks = 0; ks < 2; ++ks) { const bf16x8 kf = *(const bf16x8*)(Ksb + (kc0 + kt * 16 + tq) * NA_KLD + hh * 64 + ks * 32 + fq * 8);
                    sa[0][kt] = mfma16(kf, qf[0][ks], sa[0][kt]); sa[1][kt] = mfma16(kf, qf[1][ks], sa[1][kt]); } }
            float alpha[2]; bf16x8 pf[2];
#pragma unroll
            for (int u = 0; u < 2; ++u) {
                const bool act = (kr >= rsv[u]) && (kr < rsv[u] + 8);
                if (!act) { alpha[u] = 1.0f; pf[u] = mk8((u32x4){0u, 0u, 0u, 0u}); continue; }
                const int dr = kr - rqv[u] + 7;
                float sc[8]; float mx = -1e30f; float bs[8];
#pragma unroll
                for (int kt = 0; kt < 2; ++kt)
#pragma unroll
                    for (int r = 0; r < 4; ++r) { const int kcol = kc0 + kt * 16 + fq * 4 + r; int dc = kcol - qcol + 15; dc = dc < 0 ? 0 : (dc > 30 ? 30 : dc);
                        bs[kt * 4 + r] = rpbs[hh * 465 + dr * 31 + dc]; }
#ifndef CPU_EMU
                asm volatile("" : "+v"(bs[0]), "+v"(bs[1]), "+v"(bs[2]), "+v"(bs[3]), "+v"(bs[4]), "+v"(bs[5]), "+v"(bs[6]), "+v"(bs[7]));
#endif
#pragma unroll
                for (int kt = 0; kt < 2; ++kt)
#pragma unroll
                    for (int r = 0; r < 4; ++r) { const int kcol = kc0 + kt * 16 + fq * 4 + r; const bool valid = (kcol >= cs) && (kcol < cs + 16);
                        const float v = valid ? (sa[u][kt][r] * 0.125f + bs[kt * 4 + r]) : -1e30f; sc[kt * 4 + r] = v; mx = fmaxf(mx, v); }
                mx = fmaxf(mx, shx<16>(mx)); mx = fmaxf(mx, shx<32>(mx));
                const float mn = fmaxf(m_run[u], mx); alpha[u] = __expf(m_run[u] - mn); m_run[u] = mn;
                float ps = 0.f; float pv[8];
#pragma unroll
                for (int j = 0; j < 8; ++j) { pv[j] = __expf(sc[j] - mn); ps += pv[j]; }
                ps += shx<16>(ps); ps += shx<32>(ps);
                l_run[u] = l_run[u] * alpha[u] + ps;
                u32x4 pk = {pack2(pv[0], pv[1]), pack2(pv[2], pv[3]), pack2(pv[4], pv[5]), pack2(pv[6], pv[7])};
                pf[u] = mk8(pk);
            }
#pragma unroll
            for (int mt = 0; mt < 4; ++mt) {
                const bf16_t* vp = Vsb + (kc0 + 4 * fq + tq4) * NA_VLD + hh * 64 + mt * 16 + 4 * tp4;
                const bf16x8 vf = mk8(TR16(vp), TR16(vp + 16 * NA_VLD));
                acc[0][mt] = mfma16(vf, pf[0], acc[0][mt] * alpha[0]); acc[1][mt] = mfma16(vf, pf[1], acc[1][mt] * alpha[1]); }
        } else {
            f32x4 sa[2][4];
#pragma unroll
            for (int kt = 0; kt < 4; ++kt) { sa[0][kt] = (f32x4){0.f, 0.f, 0.f, 0.f}; sa[1][kt] = (f32x4){0.f, 0.f, 0.f, 0.f};
#pragma unroll
                for (int ks = 0; ks < 2; ++ks) { const bf16x8 kf = *(const bf16x8*)(Ksb + (kt * 16 + tq) * NA_KLD + hh * 64 + ks * 32 + fq * 8);
                    sa[0][kt] = mfma16(kf, qf[0][ks], sa[0][kt]); sa[1][kt] = mfma16(kf, qf[1][ks], sa[1][kt]); } }
            float alpha[2]; bf16x8 pf[2][2];
#pragma unroll
            for (int u = 0; u < 2; ++u) {
                float mx = -1e30f;
#pragma unroll
                for (int kt = 0; kt < 4; ++kt)
#pragma unroll
                    for (int r = 0; r < 4; ++r) { sa[u][kt][r] *= 0.125f; mx = fmaxf(mx, sa[u][kt][r]); }
                mx = fmaxf(mx, shx<16>(mx)); mx = fmaxf(mx, shx<32>(mx));
                const float mn = fmaxf(m_run[u], mx); alpha[u] = __expf(m_run[u] - mn); m_run[u] = mn;
                float ps = 0.f;
#pragma unroll
                for (int kt = 0; kt < 4; ++kt)
#pragma unroll
                    for (int r = 0; r < 4; ++r) { sa[u][kt][r] = __expf(sa[u][kt][r] - mn); ps += sa[u][kt][r]; }
                ps += shx<16>(ps); ps += shx<32>(ps);
                l_run[u] = l_run[u] * alpha[u] + ps;
#pragma unroll
                for (int h2 = 0; h2 < 2; ++h2) {
                    u32x4 pk = {pack2(sa[u][2 * h2][0], sa[u][2 * h2][1]), pack2(sa[u][2 * h2][2], sa[u][2 * h2][3]), pack2(sa[u][2 * h2 + 1][0], sa[u][2 * h2 + 1][1]), pack2(sa[u][2 * h2 + 1][2], sa[u][2 * h2 + 1][3])};
                    pf[u][h2] = mk8(pk); }
            }
#pragma unroll
            for (int mt = 0; mt < 4; ++mt) { acc[0][mt] = acc[0][mt] * alpha[0]; acc[1][mt] = acc[1][mt] * alpha[1]; }
#pragma unroll
            for (int h2 = 0; h2 < 2; ++h2)
#pragma unroll
                for (int mt = 0; mt < 4; ++mt) { const bf16_t* vp = Vsb + (32 * h2 + 4 * fq + tq4) * NA_VLD + hh * 64 + mt * 16 + 4 * tp4;
                    const bf16x8 vf = mk8(TR16(vp), TR16(vp + 16 * NA_VLD));
                    acc[0][mt] = mfma16(vf, pf[0][h2], acc[0][mt]); acc[1][mt] = mfma16(vf, pf[1][h2], acc[1][mt]); }
        }
        }
    }
#undef NA_FETCH
#undef NA_SRC_ROWS
#pragma unroll
    for (int u = 0; u < 2; ++u) {
        const float il = frcp(l_run[u]);
        const size_t orow = ((size_t)sl << sd.lgseq) + qtok[u];
#pragma unroll
        for (int mt = 0; mt < 4; ++mt) { u32x2 o = {pack2(acc[u][mt][0] * il, acc[u][mt][1] * il), pack2(acc[u][mt][2] * il, acc[u][mt][3] * il)};
            stg((u32x2*)(p.Nb() + orow * 512 + head * 64 + mt * 16 + fq * 4), o); }
    }
}

DEV void mlstm_stepC_task(const Params& p, const SetDesc& sd, int layer, int task, char* shm) {
    const int tid = TID(), lane = tid & 63, w = tid >> 6, tq = lane & 15, fq = lane >> 4, tq4 = (lane & 15) >> 2, tp4 = lane & 3;
    const int tb = task % sd.ntb, h = (task / sd.ntb) & 3, sl = task / (sd.ntb * 4);
    const int row0 = (sl << sd.lgseq) + tb * 128; const bool latent = !sd.is_ctx; const int tl0 = tb * 128;
    bf16_t* Ks = (bf16_t*)shm;
    bf16_t* Vs = (bf16_t*)(shm + 128 * K_LD * 2);
    bf16_t* Cs = (bf16_t*)(shm + 128 * K_LD * 2 + 128 * V_LD * 2);
    float* ga = (float*)(shm + 128 * K_LD * 2 * 3 + 128 * V_LD * 2); float* gb = ga + 256; float* gpm = gb + 256; float* gtot = gpm + 256; float* tmp = gtot + 8;
    float* nvs = tmp + 16;
    float* cms = nvs + 128;
    const bf16_t* prow = proj_buf(p, sd) + (size_t)row0 * PWA;
    __syncthreads();
    gate_scan(prow, h, p.gate_bias + (size_t)layer * 16, ga, gb, gpm, gtot, tmp);
    {
        const int s = tid & 127, cpi = tid >> 7, cp = (cpi & 1) + (cpi >> 1) * 4;
        const bf16_t* hp = prow + (size_t)s * PWA + C_KM + h * 64;
        float k1[8], k2[8];
        load_rope_chunk(hp, cp, latent, tl0 + s, p.rope(), 1.0f, k1);
        load_rope_chunk(hp, cp + 2, latent, tl0 + s, p.rope(), 1.0f, k2);
        u32x4 o1 = {pack2(k1[0], k1[1]), pack2(k1[2], k1[3]), pack2(k1[4], k1[5]), pack2(k1[6], k1[7])};
        u32x4 o2 = {pack2(k2[0], k2[1]), pack2(k2[2], k2[3]), pack2(k2[4], k2[5]), pack2(k2[6], k2[7])};
        *(u32x4*)(Ks + s * K_LD + cp * 8) = o1; *(u32x4*)(Ks + s * K_LD + (cp + 2) * 8) = o2;
    }
#pragma unroll
    for (int it = 0; it < 4; ++it) { const int item = tid + it * 512, s = item >> 4, ch = item & 15;
        *(u32x4*)(Vs + s * V_LD + ch * 8) = ldg((const u32x4*)(prow + (size_t)s * PWA + C_VM + h * 128 + ch * 8)); }
#pragma unroll
    for (int it = 0; it < 4; ++it) { const int item = tid + it * 512, dir = item >> 10, rem = item & 1023, v = rem >> 3, ch = rem & 7;
        *(u32x4*)(Cs + (dir * 128 + v) * K_LD + ch * 8) = ldg((const u32x4*)(p.Cin() + (size_t)st_index(sd, sl, h, dir, tb) * 8192 + v * 64 + ch * 8)); }
    if (tid < 128) nvs[tid] = ldg(p.Cn() + (size_t)st_index(sd, sl, h, tid >> 6, tb) * 64 + (tid & 63));
    if (tid < 2) cms[tid] = ldg(p.Cm() + (size_t)st_index(sd, sl, h, tid, tb) * 4);
    bf16x8 qf[2]; float qv[2][8];
    {
        const int t = w * 16 + tq; const bf16_t* hp = prow + (size_t)t * PWA + C_QM + h * 64;
#pragma unroll
        for (int ks = 0; ks < 2; ++ks) { load_rope_chunk(hp, ks * 4 + fq, latent, tl0 + t, p.rope(), 0.125f, qv[ks]);
            u32x4 o = {pack2(qv[ks][0], qv[ks][1]), pack2(qv[ks][2], qv[ks][3]), pack2(qv[ks][4], qv[ks][5]), pack2(qv[ks][6], qv[ks][7])}; qf[ks] = mk8(o); }
    }
    __syncthreads();
    const int t = w * 16 + tq;
    f32x4 hsum[8];
#pragma unroll
    for (int mt = 0; mt < 8; ++mt) hsum[mt] = (f32x4){0.f, 0.f, 0.f, 0.f};
#pragma unroll
    for (int dir = 0; dir < 2; ++dir) {
        const float m_in = cms[dir];
        const float Mt = fmaxf(m_in, gpm[dir * 128 + t]);
        const float inter = __expf(m_in - Mt);
        const float mtot = gb[dir * 128 + t] + Mt;
        f32x4 acc[8];
#pragma unroll
        for (int mt = 0; mt < 8; ++mt) { acc[mt] = (f32x4){0.f, 0.f, 0.f, 0.f};
#pragma unroll
            for (int ks = 0; ks < 2; ++ks) { const bf16x8 cf = *(const bf16x8*)(Cs + (dir * 128 + mt * 16 + tq) * K_LD + ks * 32 + fq * 8);
                acc[mt] = mfma16(cf, qf[ks], acc[mt]); }
            acc[mt] = acc[mt] * inter; }
        float qn = 0.f;
#pragma unroll
        for (int ks = 0; ks < 2; ++ks)
#pragma unroll
            for (int j = 0; j < 8; ++j) qn += bf2f(f2bf(qv[ks][j])) * nvs[dir * 64 + ks * 32 + fq * 8 + j];
        qn += shx<16>(qn); qn += shx<32>(qn);
        float den = inter * qn;
        const int u_lo = dir == 0 ? 0 : (w >> 1), u_hi = dir == 0 ? (w >> 1) : 3;
        float rsum = 0.f;
        for (int u = u_lo; u <= u_hi; ++u) {
            unsigned pk[4];
#pragma unroll
            for (int kt = 0; kt < 2; ++kt) { f32x4 sa = {0.f, 0.f, 0.f, 0.f}; const int sb = 32 * u + 16 * kt;
#pragma unroll
                for (int ks = 0; ks < 2; ++ks) { const bf16x8 kf = *(const bf16x8*)(Ks + (sb + tq) * K_LD + ks * 32 + fq * 8); sa = mfma16(kf, qf[ks], sa); }
                float pv[4]; float gv4[4];
#pragma unroll
                for (int r = 0; r < 4; ++r) gv4[r] = ga[dir * 128 + sb + fq * 4 + r];
#ifndef CPU_EMU
                asm volatile("" : "+v"(gv4[0]), "+v"(gv4[1]), "+v"(gv4[2]), "+v"(gv4[3]));
#endif
#pragma unroll
                for (int r = 0; r < 4; ++r) { const int s = sb + fq * 4 + r; const bool valid = dir == 0 ? (s <= t) : (s >= t);
                    pv[r] = valid ? sa[r] * __expf(gv4[r] - Mt) : 0.f; pv[r] = bf2f(f2bf(pv[r])); rsum += pv[r]; }
                pk[kt * 2] = pack2(pv[0], pv[1]); pk[kt * 2 + 1] = pack2(pv[2], pv[3]); }
            u32x4 pkv = {pk[0], pk[1], pk[2], pk[3]}; const bf16x8 pf = mk8(pkv);
#pragma unroll
            for (int mt = 0; mt < 8; ++mt) { const bf16_t* vp = Vs + (32 * u + 4 * fq + tq4) * V_LD + mt * 16 + 4 * tp4;
                const bf16x8 vf = mk8(TR16(vp), TR16(vp + 16 * V_LD));
                acc[mt] = mfma16(vf, pf, acc[mt]); }
        }
        rsum += shx<16>(rsum); rsum += shx<32>(rsum);
        den += rsum;
        const float dn = frcp(fmaxf(fabsf(den), __expf(-mtot)));
#pragma unroll
        for (int mt = 0; mt < 8; ++mt) hsum[mt] = hsum[mt] + acc[mt] * dn;
    }
    float ss = 0.f;
#pragma unroll
    for (int mt = 0; mt < 8; ++mt)
#pragma unroll
        for (int r = 0; r < 4; ++r) ss += hsum[mt][r] * hsum[mt][r];
    ss += shx<16>(ss); ss += shx<32>(ss);
    const float rstd = rsqrtf(ss * (1.0f / 128.0f) + RMS_EPS);
#pragma unroll
    for (int mt = 0; mt < 8; ++mt) { const int v = mt * 16 + fq * 4;
        const u32x2 om = ldg((const u32x2*)(prow + (size_t)t * PWA + C_OM + h * 128 + v));
        u32x2 o = {pack2(hsum[mt][0] * rstd * sigmoidf_(lo16(om.x)), hsum[mt][1] * rstd * sigmoidf_(hi16(om.x))),
                   pack2(hsum[mt][2] * rstd * sigmoidf_(lo16(om.y)), hsum[mt][3] * rstd * sigmoidf_(hi16(om.y)))};
        stg((u32x2*)(p.Mb() + (size_t)(row0 + t) * 512 + h * 128 + v), o); }
}

struct SchedMerge {
    const bf16_t* Mb; const bf16_t* Pb; const bf16_t* Nb; const bf16_t* Wb; int nM;
    DEV bool next(int i, GUnit& u) const { u.aux = i % 3; return tile_order(i / 3, nM, 4, u.pm, u.pn); }
    DEV const bf16_t* a_base(const GUnit& u) const { return (u.aux == 0 ? Mb : (u.aux == 1 ? Pb : Nb)) + (size_t)u.pm * 256 * 512; }
    DEV const bf16_t* b_base(const GUnit& u) const { return Wb + ((size_t)u.aux * 1024 + u.pn * 256) * 512; }
    DEV int grow(const GUnit&, int) const { return 0; }
};
DEV void phase_merge(const Params& p, const SetDesc& sd, int layer, char* shm) {
    SchedMerge S; S.Mb = p.Mb(); S.Pb = p.Pb(); S.Nb = p.Nb(); S.Wb = p.WbT() + (size_t)layer * 3 * 1024 * 512; S.nM = sd.nrows / 256;
    const bf16_t* bgb = p.BG(); bf16_t* mgb = p.MERGED();
    gemm_stream<false, 512, 512, 512>(shm, S, [=](const GUnit& u, const f32x4 (&acc)[2][2][4][2], int r0, int c0) {
#pragma unroll
        for (int ai = 0; ai < 2; ++ai) {
            u32x4 gm[4][2], pr[4][2];
#pragma unroll
            for (int m = 0; m < 4; ++m)
#pragma unroll
                for (int hf = 0; hf < 2; ++hf) { const size_t r = (size_t)u.pm * 256 + r0 + ai * 128 + m * 16;
                    gm[m][hf] = ldg((const u32x4*)(bgb + r * NBG + u.aux * 1024 + u.pn * 256 + c0 + hf * 128));
                    if (u.aux > 0) pr[m][hf] = ldg((const u32x4*)(mgb + r * 1024 + u.pn * 256 + c0 + hf * 128)); else pr[m][hf] = (u32x4){0u, 0u, 0u, 0u}; }
#pragma unroll
            for (int m = 0; m < 4; ++m)
#pragma unroll
                for (int hf = 0; hf < 2; ++hf) { const size_t r = (size_t)u.pm * 256 + r0 + ai * 128 + m * 16;
                    const f32x4 x0 = acc[ai][hf][m][0], x1 = acc[ai][hf][m][1]; const u32x4 g = gm[m][hf], q = pr[m][hf];
                    u32x4 ov = {pack2(x0[0] * lo16(g.x) + lo16(q.x), x0[1] * hi16(g.x) + hi16(q.x)), pack2(x0[2] * lo16(g.y) + lo16(q.y), x0[3] * hi16(g.y) + hi16(q.y)),
                                pack2(x1[0] * lo16(g.z) + lo16(q.z), x1[1] * hi16(g.z) + hi16(q.z)), pack2(x1[2] * lo16(g.w) + lo16(q.w), x1[3] * hi16(g.w) + hi16(q.w))};
                    stg((u32x4*)(mgb + r * 1024 + u.pn * 256 + c0 + hf * 128), ov); }
        } });
}
DEV void phase_outproj(const Params& p, const SetDesc& sd, int layer, char* shm) {
    SchedPlain S; S.A = p.MERGED(); S.Bt = p.WoT() + (size_t)layer * 1024 * 1024; S.nM = sd.nrows / 256; S.nN = 4; S.lda256 = 256 * 1024; S.ldb256 = 256 * 1024;
    bf16_t* yb = p.Y();
    gemm_stream<false, 1024, 1024, 1024>(shm, S, [=](const GUnit& u, const f32x4 (&acc)[2][2][4][2], int r0, int c0) {
#pragma unroll
        for (int ai = 0; ai < 2; ++ai)
#pragma unroll
            for (int m = 0; m < 4; ++m) { bf16_t* o = yb + ((size_t)u.pm * 256 + r0 + ai * 128 + m * 16) * 1024 + u.pn * 256 + c0;
                store8bf(o, acc[ai][0][m][0], acc[ai][0][m][1]); store8bf(o + 128, acc[ai][1][m][0], acc[ai][1][m][1]); } });
}

DEV void phase_postmix(const Params& p, const SetDesc& sd, int layer, char* shm) {
    const int tid = TID(), lane = tid & 63, wv = tid >> 6;
    float* wr_s = (float*)shm;
    __syncthreads();
    for (int i = tid; i < 1024 * 16; i += NTHREADS) { const int c = i >> 4, e = i & 15, ln = (c & 511) >> 3, j = c & 7, hf = c >> 9;
        wr_s[((((hf * 8 + j) * 4 + (e >> 2)) * 64 + ln) << 2) + (e & 3)] = ldg(p.router_w + (size_t)layer * 1024 * 16 + i); }
    __syncthreads();
    const float* g1 = p.norm_gain + ((size_t)layer * 4 + 1) * 1024; const float* g2 = p.norm_gain + ((size_t)layer * 4 + 2) * 1024;
    float* par = (float*)(shm + 65536);
    { const int rpb0_ = (sd.nrows + (int)gridDim.x - 1) / (int)gridDim.x; const float* mdb = mod_row(p, sd, layer, min((int)blockIdx.x * rpb0_, sd.nrows - 1));
      stage_params(par, g1, g2, mdb + 2048, mdb + 3072, mdb + 4096); }
    __syncthreads();
    const float* xb = xsrc_base(p, sd, layer); float* xdb = xdst_base(p, sd);
    const int stride = 8; const int rpb_ = (sd.nrows + (int)gridDim.x - 1) / (int)gridDim.x; const int row_end = min(sd.nrows, ((int)blockIdx.x + 1) * rpb_);
    int row = (int)blockIdx.x * rpb_ + wv;
    u32x4 ycur[2], ynxt[2]; f32x4 xcur[4], xnxt[4];
    if (row < row_end) {
#pragma unroll
        for (int i = 0; i < 2; ++i) ycur[i] = ldg((const u32x4*)(p.Y() + (size_t)row * 1024 + i * 512 + lane * 8));
#pragma unroll
        for (int i = 0; i < 4; ++i) xcur[i] = ldg((const f32x4*)(xb + (size_t)row * 1024 + (i >> 1) * 512 + lane * 8 + (i & 1) * 4)); }
    for (; row < row_end; row += stride) {
        int ln = lane; HIDE(ln);
        const int rn = row + stride;
        if (rn < row_end) {
#pragma unroll
            for (int i = 0; i < 2; ++i) ynxt[i] = ldg((const u32x4*)(p.Y() + (size_t)rn * 1024 + i * 512 + ln * 8));
#pragma unroll
            for (int i = 0; i < 4; ++i) xnxt[i] = ldg((const f32x4*)(xb + (size_t)rn * 1024 + (i >> 1) * 512 + ln * 8 + (i & 1) * 4)); }
        float* xd = xdb + (size_t)row * 1024;
        const float* md = mod_row(p, sd, layer, row);
        float y[16]; float ss = 0.f;
#pragma unroll
        for (int hlf = 0; hlf < 2; ++hlf) { const u32x4 m = ycur[hlf];
            const float t8[8] = {lo16(m.x), hi16(m.x), lo16(m.y), hi16(m.y), lo16(m.z), hi16(m.z), lo16(m.w), hi16(m.w)};
#pragma unroll
            for (int j = 0; j < 8; ++j) { y[hlf * 8 + j] = t8[j]; ss += t8[j] * t8[j]; } }
        ss = wave_sum(ss);
        const float rstd = rsqrtf(ss * (1.0f / 1024.0f) + RMS_EPS);
        float xn[16]; float ss2 = 0.f;
#pragma unroll
        for (int hlf = 0; hlf < 2; ++hlf)
#pragma unroll
            for (int q = 0; q < 2; ++q) { const int c0 = hlf * 512 + ln * 8 + q * 4; const f32x4 xo = xcur[hlf * 2 + q]; f32x4 xw;
#pragma unroll
                for (int j = 0; j < 4; ++j) { const float v = xo[j] + par[2048 + c0 + j] * (y[hlf * 8 + q * 4 + j] * rstd * par[c0 + j]); xw[j] = v; xn[hlf * 8 + q * 4 + j] = v; ss2 += v * v; }
                stg((f32x4*)(xd + c0), xw); }
        ss2 = wave_sum(ss2);
        const float rstd2 = rsqrtf(ss2 * (1.0f / 1024.0f) + RMS_EPS);
        float lg[16];
#pragma unroll
        for (int e = 0; e < 16; ++e) lg[e] = 0.f;
#pragma unroll
        for (int hlf = 0; hlf < 2; ++hlf) { const int c0 = hlf * 512 + ln * 8; float o[8];
#pragma unroll
            for (int j = 0; j < 8; ++j) { o[j] = xn[hlf * 8 + j] * rstd2 * par[1024 + c0 + j] * (1.0f + par[4096 + c0 + j]) + par[3072 + c0 + j];
#pragma unroll
                for (int eq = 0; eq < 4; ++eq) { const f32x4 w4 = *(const f32x4*)(wr_s + ((((hlf * 8 + j) * 4 + eq) * 64 + ln) << 2));
#pragma unroll
                    for (int e = 0; e < 4; ++e) lg[eq * 4 + e] += o[j] * w4[e]; } }
            const u32x2 ov = {f8pack4(o[0], o[1], o[2], o[3]), f8pack4(o[4], o[5], o[6], o[7])};
            stg((u32x2*)((unsigned char*)p.H() + (size_t)row * 1024 + c0), ov); }
        float r8[8], r4[4], r2[2], r1;
        { const bool b = (lane & 32) != 0;
#pragma unroll
          for (int i = 0; i < 8; ++i) { const float keep = b ? lg[i + 8] : lg[i], send = b ? lg[i] : lg[i + 8]; r8[i] = keep + shx<32>(send); } }
        { const bool b = (lane & 16) != 0;
#pragma unroll
          for (int i = 0; i < 4; ++i) { const float keep = b ? r8[i + 4] : r8[i], send = b ? r8[i] : r8[i + 4]; r4[i] = keep + shx<16>(send); } }
        { const bool b = (lane & 8) != 0;
#pragma unroll
          for (int i = 0; i < 2; ++i) { const float keep = b ? r4[i + 2] : r4[i], send = b ? r4[i] : r4[i + 2]; r2[i] = keep + shx<8>(send); } }
        { const bool b = (lane & 4) != 0; const float keep = b ? r2[1] : r2[0], send = b ? r2[0] : r2[1]; r1 = keep + shx<4>(send); }
        r1 += shx<2>(r1); r1 += shx<1>(r1);
        float mx = r1;
        mx = fmaxf(mx, shx<4>(mx)); mx = fmaxf(mx, shx<8>(mx)); mx = fmaxf(mx, shx<16>(mx)); mx = fmaxf(mx, shx<32>(mx));
        const float ex = __expf(r1 - mx);
        float se = ex;
        se += shx<4>(se); se += shx<8>(se); se += shx<16>(se); se += shx<32>(se);
        if ((lane & 3) == 0) { const int e = ((lane >> 5) & 1) * 8 + ((lane >> 4) & 1) * 4 + ((lane >> 3) & 1) * 2 + ((lane >> 2) & 1);
            stg(p.aff() + (size_t)row * 16 + e, ex * frcp(se)); }
#pragma unroll
        for (int i = 0; i < 2; ++i) ycur[i] = ynxt[i];
#pragma unroll
        for (int i = 0; i < 4; ++i) xcur[i] = xnxt[i];
    }
}

DEV unsigned shxu(unsigned v, int m) {
    const float f = __uint_as_float(v); float r;
    switch (m) { case 1: r = shx<1>(f); break; case 2: r = shx<2>(f); break; case 4: r = shx<4>(f); break; case 8: r = shx<8>(f); break; case 16: r = shx<16>(f); break; default: r = shx<32>(f); break; }
    return __float_as_uint(r);
}
#define TK_CX(a_, b_, desc_) do { const unsigned long long x_ = key[a_], y_ = key[b_]; const bool sw_ = (desc_) ? (x_ < y_) : (x_ > y_); key[a_] = sw_ ? y_ : x_; key[b_] = sw_ ? x_ : y_; } while (0)
DEV void topk_task(const Params& p, const SetDesc& sd, int task, char* shm) {
    const int tid = TID();
    const int e = task & 15, sl = task >> 4;
    unsigned long long* buf = (unsigned long long*)shm;
    const int T = 1 << sd.lgseq, cap = sd.cap;
    const int rbase = sl << sd.lgseq;
    const bool active = tid * 4 < T;
    unsigned long long key[4];
    __syncthreads();
#pragma unroll
    for (int m = 0; m < 4; ++m) { const int i = tid * 4 + m; const float a = active ? ldg(p.aff() + (size_t)(rbase + i) * 16 + e) : 0.f;
        key[m] = ((unsigned long long)__float_as_uint(a) << 32) | (unsigned)(0xFFFFFFFFu - (unsigned)i); }
    for (int k = 2; k <= T; k <<= 1) {
        const bool desc4 = ((tid * 4) & k) == 0;
        for (int j = k >> 1; j >= 4; j >>= 1) {
            const int tj = j >> 2;
            unsigned long long pk[4];
            if (tj < 64) {
#pragma unroll
                for (int m = 0; m < 4; ++m) { const unsigned lo = shxu((unsigned)key[m], tj), hi = shxu((unsigned)(key[m] >> 32), tj); pk[m] = ((unsigned long long)hi << 32) | lo; }
            } else {
                __syncthreads();
                if (active) {
#pragma unroll
                    for (int m = 0; m < 4; ++m) buf[tid * 4 + m] = key[m]; }
                __syncthreads();
#pragma unroll
                for (int m = 0; m < 4; ++m) pk[m] = active ? buf[(tid ^ tj) * 4 + m] : 0ull;
            }
            const bool lower = (tid & tj) == 0; const bool takemax = desc4 == lower;
#pragma unroll
            for (int m = 0; m < 4; ++m) { const unsigned long long x = key[m], y = pk[m]; key[m] = takemax ? (x > y ? x : y) : (x < y ? x : y); }
        }
        if (k >= 4) { TK_CX(0, 2, desc4); TK_CX(1, 3, desc4); TK_CX(0, 1, desc4); TK_CX(2, 3, desc4); }
        else { TK_CX(0, 1, true); TK_CX(2, 3, false); }
    }
    const int sbase = e * sd.rpe + sl * cap;
    if (active) {
#pragma unroll
        for (int m = 0; m < 4; ++m) { const int i = tid * 4 + m; const unsigned long long kv = key[m]; const int tok = (int)(0xFFFFFFFFu - (unsigned)(kv & 0xFFFFFFFFu));
            const int row = rbase + tok;
            if (i < cap) { stg(p.slot_token() + sbase + i, row); stg(p.slot_gate() + sbase + i, __uint_as_float((unsigned)(kv >> 32))); stg(p.token_slots() + (size_t)row * 16 + e, sbase + i); }
            else stg(p.token_slots() + (size_t)row * 16 + e, -1); } }
    if (sl == 0) { const int used = sd.nsamp * cap;
        for (int i = used + tid; i < sd.rpe; i += NTHREADS) { stg(p.slot_token() + e * sd.rpe + i, 0); stg(p.slot_gate() + e * sd.rpe + i, 0.f); } }
}
#undef TK_CX

struct SchedMoe {
    const bf16_t* A; const int* st; const bf16_t* W; int nRT, rpe, nN, wstride;
    DEV bool next(int i, GUnit& u) const { int pmx, pn; if (!tile_order(i, 16 * nRT, nN, pmx, pn)) return false; u.pm = pmx % nRT; u.aux = pmx / nRT; u.pn = pn; return true; }
    DEV int slot0(const GUnit& u) const { return u.aux * rpe + u.pm * 256; }
    DEV const bf16_t* a_base(const GUnit&) const { return A; }
    DEV int grow(const GUnit& u, int i) const { return st ? ldg(st + slot0(u) + i) : slot0(u) + i; }
    DEV const bf16_t* b_base(const GUnit& u) const { return W + (size_t)u.aux * wstride + (size_t)u.pn * 256 * 512; }
};
DEV void phase_moe_gu(const Params& p, const SetDesc& sd, int layer, char* shm) {
    SchedMoe S; S.A = p.H(); S.st = p.slot_token(); S.W = p.WguT() + (size_t)layer * 16 * 2048 * 512; S.nRT = sd.rpe / 256; S.rpe = sd.rpe; S.nN = 8; S.wstride = 2048 * 512;
    unsigned char* hb = (unsigned char*)p.HID();
    gemm_stream<true, 512, 512, 512, true>(shm, S, [=](const GUnit& u, const f32x4 (&acc)[2][2][4][2], int r0, int c0) {
#pragma unroll
        for (int ai = 0; ai < 2; ++ai)
#pragma unroll
            for (int m = 0; m < 4; ++m) { f32x4 h0, h1; const f32x4 a0 = acc[ai][0][m][0] * F8_WINV, a1 = acc[ai][0][m][1] * F8_WINV, b0 = acc[ai][1][m][0] * F8_WINV, b1 = acc[ai][1][m][1] * F8_WINV;
#pragma unroll
                for (int j = 0; j < 4; ++j) { h0[j] = a0[j] * sigmoidf_(a0[j]) * b0[j]; h1[j] = a1[j] * sigmoidf_(a1[j]) * b1[j]; }
                const u32x2 hv = {f8pack4(h0[0], h0[1], h0[2], h0[3]), f8pack4(h1[0], h1[1], h1[2], h1[3])};
                stg((u32x2*)(hb + ((size_t)S.slot0(u) + r0 + ai * 128 + m * 16) * 1024 + u.pn * 128 + c0), hv); } });
}
DEV void phase_moe_down(const Params& p, const SetDesc& sd, int layer, char* shm) {
    SchedMoe S; S.A = p.HID(); S.st = nullptr; S.W = p.WdT() + (size_t)layer * 16 * 1024 * 512; S.nRT = sd.rpe / 256; S.rpe = sd.rpe; S.nN = 4; S.wstride = 1024 * 512;
    bf16_t* yb = p.YE(); const float* gt = p.slot_gate();
    gemm_stream<true, 512, 512, 512, true>(shm, S, [=](const GUnit& u, const f32x4 (&acc)[2][2][4][2], int r0, int c0) {
#pragma unroll
        for (int ai = 0; ai < 2; ++ai) {
            float gv[4];
#pragma unroll
            for (int m = 0; m < 4; ++m) gv[m] = ldg(gt + (size_t)S.slot0(u) + r0 + ai * 128 + m * 16) * F8_WINV;
#pragma unroll
            for (int m = 0; m < 4; ++m) { const size_t sl = (size_t)S.slot0(u) + r0 + ai * 128 + m * 16; const float g = gv[m];
                bf16_t* o = yb + sl * 1024 + u.pn * 256 + c0; store8bf(o, acc[ai][0][m][0] * g, acc[ai][0][m][1] * g); store8bf(o + 128, acc[ai][1][m][0] * g, acc[ai][1][m][1] * g); } } });
}

DEV void compact4(const int (&sl)[16], int (&c)[4], int& n) {
    n = 0; c[0] = -1; c[1] = -1; c[2] = -1; c[3] = -1;
#pragma unroll
    for (int e = 0; e < 16; ++e) if (sl[e] >= 0) { c[0] = (n == 0) ? sl[e] : c[0]; c[1] = (n == 1) ? sl[e] : c[1]; c[2] = (n == 2) ? sl[e] : c[2]; c[3] = (n == 3) ? sl[e] : c[3]; ++n; }
}
DEV void phase_combine(const Params& p, const SetDesc& sd, int layer, char* shm) {
    const int tid = TID(), lane = tid & 63, wv = tid >> 6;
    const float* g3 = p.norm_gain + ((size_t)layer * 4 + 3) * 1024;
    float* xdb = xdst_base(p, sd);
    const int stride = 8; const int rpb_ = (sd.nrows + (int)gridDim.x - 1) / (int)gridDim.x; const int row_end = min(sd.nrows, ((int)blockIdx.x + 1) * rpb_);
    int row = __builtin_amdgcn_readfirstlane((int)blockIdx.x * rpb_ + wv);
    float* par = (float*)shm;
    __syncthreads();
    { const float* mdb = mod_row(p, sd, layer, min((int)blockIdx.x * rpb_, sd.nrows - 1)); stage_params(par, g3, mdb + 5120, nullptr, nullptr, nullptr); }
    __syncthreads();
    int raw[16]; int cc[4], cn[4]; int nc = 0, nn = 0;
    u32x4 mc[4][2], mn[4][2]; f32x4 xc[4], xn[4];
#define CMB_SLOTS(r_) do { _Pragma("unroll") for (int e = 0; e < 16; ++e) raw[e] = ldg(p.token_slots() + (size_t)(r_) * 16 + e); } while (0)
#define CMB_DATA(r_, c_, n_, m_, x_) do { _Pragma("unroll") for (int k = 0; k < 4; ++k) { \
            if (k < (n_)) { const bf16_t* yr = p.YE() + (size_t)(c_)[k] * 1024 + lane * 8; (m_)[k][0] = ldg((const u32x4*)yr); (m_)[k][1] = ldg((const u32x4*)(yr + 512)); } \
            else { (m_)[k][0] = (u32x4){0u, 0u, 0u, 0u}; (m_)[k][1] = (u32x4){0u, 0u, 0u, 0u}; } } \
        _Pragma("unroll") for (int i = 0; i < 4; ++i) (x_)[i] = ldg((const f32x4*)(xdb + (size_t)(r_) * 1024 + (i >> 1) * 512 + lane * 8 + (i & 1) * 4)); } while (0)
    if (row < row_end) { CMB_SLOTS(row); compact4(raw, cc, nc); CMB_DATA(row, cc, nc, mc, xc); if (row + stride < row_end) CMB_SLOTS(row + stride); }
    for (; row < row_end; row += stride) {
        const int rn = row + stride;
        if (rn < row_end) { compact4(raw, cn, nn); CMB_DATA(rn, cn, nn, mn, xn); if (rn + stride < row_end) CMB_SLOTS(rn + stride); }
        float* xd = xdb + (size_t)row * 1024;
        float y[16];
#pragma unroll
        for (int j = 0; j < 16; ++j) y[j] = 0.f;
        if (nc <= 4) {
#pragma unroll
            for (int k = 0; k < 4; ++k)
                if (k < nc) {
#pragma unroll
                    for (int hlf = 0; hlf < 2; ++hlf) { const u32x4 m = mc[k][hlf];
                        y[hlf * 8 + 0] += lo16(m.x); y[hlf * 8 + 1] += hi16(m.x); y[hlf * 8 + 2] += lo16(m.y); y[hlf * 8 + 3] += hi16(m.y);
                        y[hlf * 8 + 4] += lo16(m.z); y[hlf * 8 + 5] += hi16(m.z); y[hlf * 8 + 6] += lo16(m.w); y[hlf * 8 + 7] += hi16(m.w); } }
        } else {
            for (int e = 0; e < 16; ++e) { const int sl_ = ldg(p.token_slots() + (size_t)row * 16 + e);
                if (sl_ >= 0) { const bf16_t* yr = p.YE() + (size_t)sl_ * 1024 + lane * 8;
#pragma unroll
                    for (int hlf = 0; hlf < 2; ++hlf) { const u32x4 m = ldg((const u32x4*)(yr + hlf * 512));
                        y[hlf * 8 + 0] += lo16(m.x); y[hlf * 8 + 1] += hi16(m.x); y[hlf * 8 + 2] += lo16(m.y); y[hlf * 8 + 3] += hi16(m.y);
                        y[hlf * 8 + 4] += lo16(m.z); y[hlf * 8 + 5] += hi16(m.z); y[hlf * 8 + 6] += lo16(m.w); y[hlf * 8 + 7] += hi16(m.w); } } }
        }
        float ss = 0.f;
#pragma unroll
        for (int j = 0; j < 16; ++j) ss += y[j] * y[j];
        ss = wave_sum(ss);
        const float rstd = rsqrtf(ss * (1.0f / 1024.0f) + RMS_EPS);
#pragma unroll
        for (int hlf = 0; hlf < 2; ++hlf)
#pragma unroll
            for (int q = 0; q < 2; ++q) { const int c0 = hlf * 512 + lane * 8 + q * 4; f32x4 xv = xc[hlf * 2 + q];
#pragma unroll
                for (int j = 0; j < 4; ++j) xv[j] += par[1024 + c0 + j] * (y[hlf * 8 + q * 4 + j] * rstd * par[c0 + j]);
                stg((f32x4*)(xd + c0), xv); }
        nc = nn;
#pragma unroll
        for (int k = 0; k < 4; ++k) { cc[k] = cn[k]; mc[k][0] = mn[k][0]; mc[k][1] = mn[k][1]; }
#pragma unroll
        for (int i = 0; i < 4; ++i) xc[i] = xn[i];
    }
#undef CMB_SLOTS
#undef CMB_DATA
}

constexpr int WQ_WORD0 = 4096;
template <class F> DEV void wq_run(const Params& p, int qidx, int ntasks, char* shm, F&& task) {
    unsigned* ctr = p.bar() + WQ_WORD0 + 64 * qidx;
    volatile int* slot = (volatile int*)(shm + 131072 + 64);
    const int tid = TID();
    int cur = blockIdx.x;
    while (cur < ntasks) {
        unsigned pend = 0u;
        if (tid == 0) pend = atomicAdd(ctr, 1u);
        task(cur);
        __syncthreads();
        if (tid == 0) *slot = (int)gridDim.x + (int)pend;
        __syncthreads();
        cur = *slot;
    }
}

template <int PH> DEV void do_phase(const Params& p, int layer, int is_ctx, int grp, char* shm) {
    const SetDesc sd = make_set(is_ctx, grp);
    if constexpr (PH == -1) phase_prologue(p, shm);
    if constexpr (PH == 0) phase_norm1(p, sd, layer, shm);
    if constexpr (PH == 1) phase_proj_a(p, sd, layer, shm);
    const int qbase = ((layer * 3 + (is_ctx ? 0 : grp + 1)) * 13 + (PH < 0 ? 0 : PH)) * 2;
    if constexpr (PH == 2) { wq_run(p, qbase, sd.nsamp * 4 * sd.ntb, shm, [&](int t) { mlstm_stepA_task(p, sd, layer, t, shm); }); if (!(is_ctx && layer == 1)) phase_pool(p, sd); }
    if constexpr (PH == 3) {
        for (int t = blockIdx.x; t < sd.nsamp * 32; t += gridDim.x) mlstm_stepB_task(p, sd, t);
        if (!(is_ctx && layer == 1)) {
            const int nq = (is_ctx ? (CTX / 64) : ROWS) / 2;
            wq_run(p, qbase, sd.nsamp * nq * 4, shm, [&](int t) { na_task(p, sd, layer, t / (nq * 4), (t >> 2) % nq, t & 3, shm); });
        }
    }
    if constexpr (PH == 4) { wq_run(p, qbase, sd.nsamp * 4 * sd.ntb, shm, [&](int t) { mlstm_stepC_task(p, sd, layer, t, shm); }); }
    if constexpr (PH == 5) phase_proj_b(p, sd, layer, shm);
    if constexpr (PH == 6) phase_merge(p, sd, layer, shm);
    if constexpr (PH == 7) phase_outproj(p, sd, layer, shm);
    if constexpr (PH == 8) phase_postmix(p, sd, layer, shm);
    if constexpr (PH == 9) { for (int t = blockIdx.x; t < sd.nsamp * 16; t += gridDim.x) topk_task(p, sd, t, shm); }
    if constexpr (PH == 10) phase_moe_gu(p, sd, layer, shm);
    if constexpr (PH == 11) phase_moe_down(p, sd, layer, shm);
    if constexpr (PH == 12) phase_combine(p, sd, layer, shm);
}

#ifndef CPU_EMU
template <int PH> __global__ void __launch_bounds__(NTHREADS, 2) k_phase(Params p, int layer, int is_ctx, int grp) {
    DYN_LDS(shm);
    do_phase<PH>(p, layer, is_ctx, grp, shm);
}
#ifndef DBL_MASK
#define DBL_MASK 0
#endif
#define RUNPH(PH) do { do_phase<PH>(p, layer, is_ctx, grp, shm); xcd_barrier(bar); if ((DBL_MASK >> (PH)) & 1) { do_phase<PH>(p, layer, is_ctx, grp, shm); xcd_barrier(bar); } } while (0)
__global__ void __launch_bounds__(NTHREADS, 2) k_mega(Params p) {
    DYN_LDS(shm);
    uint4* xbw = (uint4*)(shm + 131072);
    if (threadIdx.x == 0) *xbw = make_uint4(0u, 0u, 0u, 0u);
    __syncthreads();
    XcdBarrier bar = xcd_barrier_post(p.bar(), (volatile LAS unsigned*)xbw);
    do_phase<-1>(p, 0, 0, 0, shm);
    xcd_barrier(bar);
    for (int layer = 0; layer < 2; ++layer)
        for (int si = 0; si <= NG; ++si) {
            const int is_ctx = si == 0 ? 1 : 0, grp = si == 0 ? 0 : si - 1;
            RUNPH(0); RUNPH(1); RUNPH(2);
            if (is_ctx && layer == 1) { do_phase<3>(p, layer, is_ctx, grp, shm); continue; }
            RUNPH(3); RUNPH(4); RUNPH(5); RUNPH(6); RUNPH(7); RUNPH(8); RUNPH(9); RUNPH(10); RUNPH(11);
            do_phase<12>(p, layer, is_ctx, grp, shm);
        }
}
#endif
}

static Params make_params(void* const* d_in, void* d_out, void* d_ws) {
    Params p{};
    p.x = (const float*)d_in[0]; p.c = (const float*)d_in[1]; p.ctx = (const float*)d_in[2]; p.c_ctx = (const float*)d_in[3];
    p.norm_gain = (const float*)d_in[4]; p.ada_w = (const float*)d_in[5]; p.ada_b = (const float*)d_in[6]; p.w_in = (const float*)d_in[7];
    p.gate_bias = (const float*)d_in[8]; p.pool_w = (const float*)d_in[9]; p.pool_scale = (const float*)d_in[10]; p.rpb = (const float*)d_in[11];
    p.w_branch = (const float*)d_in[12]; p.w_out = (const float*)d_in[13]; p.router_w = (const float*)d_in[14];
    p.w_gate = (const float*)d_in[15]; p.w_up = (const float*)d_in[16]; p.w_down = (const float*)d_in[17];
    p.out = (float*)d_out; p.ws = (char*)d_ws;
    return p;
}

#ifdef CPU_EMU
int emu_cfg_B = CFG_B, emu_cfg_ROWS = CFG_ROWS, emu_cfg_CTX = CFG_CTX;
const char* g_dumpdir = "data";
static void* g_ws = nullptr;
static void dump_buf(const char* name, int layer, int is_ctx, int grp, const void* ptr, size_t bytes) {
    char nm[512]; snprintf(nm, sizeof nm, "%s/d_L%d_%s%d_%s.bin", g_dumpdir, layer, is_ctx ? "c" : "g", grp, name);
    FILE* f = fopen(nm, "wb"); fwrite(ptr, 1, bytes, f); fclose(f);
}
static void emu_hook(const Params& p, int layer, int is_ctx, int grp, int ph) {
    const size_t Rn = is_ctx ? RC : RL;
    if (ph == 0) dump_buf("H", layer, is_ctx, grp, p.H(), Rn * 1024 * 2);
    if (ph == 1) dump_buf("PROJ", layer, is_ctx, grp, is_ctx ? p.PROJc() : p.PROJa(), Rn * PWA * 2);
    if (ph == 2) dump_buf("Pb", layer, is_ctx, grp, p.Pb(), Rn * 512 * 2);
    if (ph == 3) dump_buf("Nb", layer, is_ctx, grp, p.Nb(), Rn * 512 * 2);
    if (ph == 4) dump_buf("Mb", layer, is_ctx, grp, p.Mb(), Rn * 512 * 2);
    if (ph == 5) dump_buf("BG", layer, is_ctx, grp, p.BG(), Rn * NBG * 2);
    if (ph == 6) dump_buf("MERGED", layer, is_ctx, grp, p.MERGED(), Rn * 1024 * 2);
    if (ph == 7) dump_buf("Y", layer, is_ctx, grp, p.Y(), Rn * 1024 * 2);
    if (ph == 8) { dump_buf("H2", layer, is_ctx, grp, p.H(), Rn * 1024 * 2); dump_buf("aff", layer, is_ctx, grp, p.aff(), Rn * 16 * 4); }
}
void emu_dump(const char* dir) {
    char nm[512]; snprintf(nm, sizeof nm, "%s/d_mod.bin", dir);
    FILE* f = fopen(nm, "wb"); fwrite((char*)g_ws + WSL.mod, 1, (size_t)2 * (NB + 1) * 6144 * 4, f); fclose(f);
    snprintf(nm, sizeof nm, "%s/d_ctxs.bin", dir);
    f = fopen(nm, "wb"); fwrite((char*)g_ws + WSL.ctxs, 1, (size_t)NB * CTX * 1024 * 4, f); fclose(f);
}
template <int PH> static void emu_run_phase(const Params& p, int layer, int is_ctx, int grp, int nblocks) {
    emu_launch_lambda([=]() { do_phase<PH>(p, layer, is_ctx, grp, emu_blk->smem); }, nblocks, NTHREADS, LDS_BYTES);
    if (PH >= 0) emu_hook(p, layer, is_ctx, grp, PH);
    printf("phase %d layer %d ctx %d grp %d done\n", PH, layer, is_ctx, grp); fflush(stdout);
}
#define LAUNCH_PHASE(PH) emu_run_phase<PH>(p, layer, is_ctx, grp, nblocks)
#else
#define LAUNCH_PHASE(PH) hipLaunchKernelGGL((k_phase<PH>), dim3(nblocks), dim3(NTHREADS), LDS_BYTES, stream, p, layer, is_ctx, grp)
#define SETATTR(PH) (void)hipFuncSetAttribute((const void*)k_phase<PH>, hipFuncAttributeMaxDynamicSharedMemorySize, LDS_BYTES)
#endif

extern "C" void kernel_launch(void* const* d_in, const int* in_sizes, int n_in, void* d_out, int out_size, void* d_ws, size_t ws_size, hipStream_t stream) {
    (void)in_sizes; (void)n_in; (void)out_size;
    if (ws_size < WSL.total) return;
    Params p = make_params(d_in, d_out, d_ws);
#ifdef CPU_EMU
    g_ws = d_ws;
    memset(d_ws, 0xFF, WSL.total);
    memset((char*)d_ws + WSL.bar, 0, 65536);
    const int nblocks = 16;
#else
    const int nblocks = 256;
#if MK_ONE_LAUNCH
    static int grid = 0;
    if (!grid) {
        (void)hipFuncSetAttribute((const void*)k_mega, hipFuncAttributeMaxDynamicSharedMemorySize, LDS_BYTES);
        int dev = 0, cus = 0, per_cu = 0;
        (void)hipGetDevice(&dev);
        (void)hipDeviceGetAttribute(&cus, hipDeviceAttributeMultiprocessorCount, dev);
        (void)hipOccupancyMaxActiveBlocksPerMultiprocessor(&per_cu, (const void*)k_mega, NTHREADS, LDS_BYTES);
        if (per_cu > 1) per_cu = 1;
        grid = cus * per_cu;
        if (grid > 256) grid = 256;
    }
    if (grid <= 0) return;
    (void)hipMemsetAsync(p.bar(), 0, 65536, stream);
    hipLaunchKernelGGL(k_mega, dim3(grid), dim3(NTHREADS), LDS_BYTES, stream, p);
    return;
#else
    static bool attr_done = false;
    if (!attr_done) { SETATTR(-1); SETATTR(0); SETATTR(1); SETATTR(2); SETATTR(3); SETATTR(4); SETATTR(5); SETATTR(6); SETATTR(7); SETATTR(8); SETATTR(9); SETATTR(10); SETATTR(11); SETATTR(12); attr_done = true; }
#endif
#endif
    { const int layer = 0, is_ctx = 0, grp = 0; LAUNCH_PHASE(-1); }
    for (int layer = 0; layer < 2; ++layer)
        for (int si = 0; si <= NG; ++si) {
            const int is_ctx = si == 0 ? 1 : 0, grp = si == 0 ? 0 : si - 1;
            LAUNCH_PHASE(0); LAUNCH_PHASE(1); LAUNCH_PHASE(2); LAUNCH_PHASE(3);
            if (is_ctx && layer == 1) continue;
            LAUNCH_PHASE(4); LAUNCH_PHASE(5); LAUNCH_PHASE(6); LAUNCH_PHASE(7); LAUNCH_PHASE(8); LAUNCH_PHASE(9); LAUNCH_PHASE(10); LAUNCH_PHASE(11); LAUNCH_PHASE(12);
        }
}
```

```cpp
#ifdef CPU_EMU
#include "emu.h"
#define DYN_LDS(p) char* p = emu_blk->smem
#define WAIT_V(n)
#define WAIT_L(n)
#define HIDE(v)
#define CBAR()
#else
#include <hip/hip_runtime.h>
#define DYN_LDS(p) extern __shared__ __attribute__((aligned(16))) char p[]
#define WAIT_V(n) asm volatile("s_waitcnt vmcnt(" #n ")" ::: "memory")
#define WAIT_L(n) asm volatile("s_waitcnt lgkmcnt(" #n ")" ::: "memory")
#define HIDE(v) asm volatile("" : "+v"(v))
#define CBAR() asm volatile("" ::: "memory")
#endif
#include <stdint.h>
#include <stddef.h>

#ifndef CFG_B
#define CFG_B 32
#define CFG_ROWS 32
#define CFG_CTX 256
#define CFG_G 16
#endif
#ifndef MK_ONE_LAUNCH
#define MK_ONE_LAUNCH 1
#endif

#define DEV __device__ __forceinline__
typedef short s16x4 __attribute__((ext_vector_type(4)));
#ifdef CPU_EMU
#define TR16(ptr) emu_tr16((const void*)(ptr))
#else
typedef __attribute__((address_space(3))) s16x4 lds_s16x4;
#define TR16(ptr) __builtin_amdgcn_ds_read_tr16_b64_v4i16((lds_s16x4*)(ptr))
#endif
#ifdef CPU_EMU
#define TID() (threadIdx.x)
#else
#define TID() ({ int t_ = threadIdx.x; asm volatile("" : "+v"(t_)); t_; })
#endif

typedef unsigned short bf16_t;
typedef short bf16x8 __attribute__((ext_vector_type(8)));
typedef float f32x4 __attribute__((ext_vector_type(4)));
typedef unsigned u32x2 __attribute__((ext_vector_type(2)));
typedef unsigned u32x4 __attribute__((ext_vector_type(4)));

namespace {
constexpr int D = 1024, NB = CFG_B, ROWS = CFG_ROWS, SEQ = ROWS * 64, CTX = CFG_CTX, G = CFG_G, NG = NB / G;
constexpr int RL = G * SEQ, RC = NB * CTX, RMAX = RL > RC ? RL : RC;
constexpr int PWA = 3840, NBG = 3072, PWT = PWA + NBG, PWSRC = 6672, C_SPLIT = 3600;
constexpr int C_QM = 0, C_KM = 256, C_PU = 512, C_GM = 1024, C_PADA = 1040, C_F8 = 1280, C_QN = 1280, C_KN = 1792, C_VM = 2304, C_OM = 2816, C_VN = 3328;
constexpr int proj_col(int n) { return n < 512 ? n : n < 1536 ? n + 1792 : n < 1552 ? n - 512 : n < 2064 ? n - 1040 : n < 3088 ? n - 784 : n + 240; }
static_assert(proj_col(512) == C_VM && proj_col(1024) == C_OM && proj_col(1536) == C_GM && proj_col(1552) == C_PU && proj_col(2064) == C_QN && proj_col(2576) == C_KN && proj_col(3088) == C_VN && proj_col(3599) == PWA - 1, "projection column map");
constexpr int NTBL = SEQ / 128, NTBC = CTX / 128;
constexpr int ilog2(int x) { return x <= 1 ? 0 : 1 + ilog2(x >> 1); }
constexpr int LGSEQ = ilog2(SEQ), LGCTX = ilog2(CTX);
static_assert((1 << LGSEQ) == SEQ && (1 << LGCTX) == CTX, "sequence lengths must be powers of two");
constexpr int cdiv(int a, int b) { return (a + b - 1) / b; }
constexpr int RPE_L = cdiv(G * (SEQ / 8), 256) * 256, RPE_C = cdiv(NB * (CTX / 8), 256) * 256, RPE_MAX = RPE_L > RPE_C ? RPE_L : RPE_C;
constexpr int NSLOT = 16 * RPE_MAX;
constexpr int NTHREADS = 512;
constexpr int GT_MAXU = 10;
constexpr int LDS_BYTES = 131072 + 256 + GT_MAXU * 1024;
constexpr int NST_L = G * 4 * 2 * NTBL, NST_C = NB * 4 * 2 * NTBC, NST = NST_L > NST_C ? NST_L : NST_C;
constexpr int NCI = NB * 4 * 2;
constexpr float RMS_EPS = 1e-6f;

struct WsLayout { size_t bar, WinT, WbT, WoT, WguT, WdT, mod, rope, ctxs, PROJc, CiC, Cin_, Cim, H, H8, PROJa, Sst, Cin, Mb, Pb, Nb, Sn, Ssc, Cn, Cm, aff, slot_token, slot_gate, token_slots, HID, YE, BG, MERGED, Y, total; };
constexpr size_t al(size_t x) { return (x + 255) / 256 * 256; }
constexpr size_t smax(size_t a, size_t b) { return a > b ? a : b; }
constexpr WsLayout make_layout() {
    WsLayout L{}; size_t o = 0;
    L.bar = o; o += al(65536);
    L.WinT = o; o += al((size_t)2 * PWT * 1024 * 2);
    L.WbT = o; o += al((size_t)2 * 3 * 1024 * 512 * 2);
    L.WoT = o; o += al((size_t)2 * 1024 * 1024 * 2);
    L.WguT = o; o += al((size_t)2 * 16 * 2048 * 1024 * 2);
    L.WdT = o; o += al((size_t)2 * 16 * 1024 * 1024 * 2);
    L.mod = o; o += al((size_t)2 * (NB + 1) * 6144 * 4);
    L.rope = o; o += al((size_t)(ROWS + 64) * 16 * 2 * 4);
    L.ctxs = o; o += al((size_t)NB * CTX * 1024 * 4);
    L.PROJc = o; o += al((size_t)RC * PWA * 2);
    L.CiC = o; o += al((size_t)NCI * 8192 * 4);
    L.Cin_ = o; o += al((size_t)NCI * 64 * 4);
    L.Cim = o; o += al((size_t)NCI * 4 * 4);
    L.H = o; o += al((size_t)RMAX * 1024 * 2);
    L.H8 = o; o += al((size_t)RMAX * 1024);
    const size_t x0 = o;
    L.PROJa = o; o += al((size_t)RMAX * PWA * 2);
    L.Sst = o; o += al((size_t)NST * 8192 * 4);
    L.Cin = o; o += al((size_t)NST * 8192 * 2);
    const size_t hid = al((size_t)NSLOT * 1024 * 2);
    o = x0 + smax(o - x0, 2 * hid);
    L.BG = x0; L.HID = x0; L.YE = x0 + hid;
    L.Mb = o; o += al((size_t)RMAX * 512 * 2);
    L.Pb = o; o += al((size_t)RMAX * 512 * 2);
    L.Nb = o; o += al((size_t)RMAX * 512 * 2);
    L.MERGED = L.H; L.Y = L.Mb;
    L.Sn = o; o += al((size_t)NST * 64 * 4);
    L.Ssc = o; o += al((size_t)NST * 4 * 4);
    L.Cn = o; o += al((size_t)NST * 64 * 4);
    L.Cm = o; o += al((size_t)NST * 4 * 4);
    L.aff = o; o += al((size_t)RMAX * 16 * 4);
    L.slot_token = o; o += al((size_t)NSLOT * 4);
    L.slot_gate = o; o += al((size_t)NSLOT * 4);
    L.token_slots = o; o += al((size_t)RMAX * 16 * 4);
    L.total = o;
    return L;
}
constexpr WsLayout WSL = make_layout();
static_assert((size_t)RMAX * NBG * 2 <= (size_t)RMAX * PWA * 2, "BG overlay must fit in PROJa");
static_assert(CFG_B != 32 || WSL.total <= ((size_t)1 << 30), "workspace budget");

struct Params {
    const float *x, *c, *ctx, *c_ctx, *norm_gain, *ada_w, *ada_b, *w_in, *gate_bias, *pool_w, *pool_scale, *rpb, *w_branch, *w_out, *router_w, *w_gate, *w_up, *w_down;
    float* out;
    char* ws;
#ifdef CPU_EMU
#define WSF(T, name) __device__ __host__ __forceinline__ T* name() const { return (T*)(ws + WSL.name); }
#else
#if defined(__HIP_DEVICE_COMPILE__)
#define WSF(T, name) __device__ __host__ __forceinline__ T* name() const { char* w_ = ws; asm volatile("" : "+s"(w_)); return (T*)(__attribute__((address_space(1))) T*)(w_ + WSL.name); }
#else
#define WSF(T, name) __device__ __host__ __forceinline__ T* name() const { return (T*)(ws + WSL.name); }
#endif
#endif
    WSF(unsigned, bar) WSF(bf16_t, WinT) WSF(bf16_t, WbT) WSF(bf16_t, WoT) WSF(bf16_t, WguT) WSF(bf16_t, WdT)
    WSF(float, mod) WSF(float, rope) WSF(float, ctxs) WSF(bf16_t, PROJc) WSF(float, CiC) WSF(float, Cin_) WSF(float, Cim)
    WSF(bf16_t, H) WSF(unsigned char, H8) WSF(bf16_t, PROJa) WSF(float, Sst) WSF(bf16_t, Cin) WSF(bf16_t, Mb) WSF(bf16_t, Pb) WSF(bf16_t, Nb)
    WSF(float, Sn) WSF(float, Ssc) WSF(float, Cn) WSF(float, Cm) WSF(float, aff) WSF(int, slot_token) WSF(float, slot_gate) WSF(int, token_slots)
    WSF(bf16_t, HID) WSF(bf16_t, YE) WSF(bf16_t, BG) WSF(bf16_t, MERGED) WSF(bf16_t, Y)
#undef WSF
};

struct SetDesc { int is_ctx, nrows, samp0, nsamp, lgseq, ntb, cap, rpe; };
DEV SetDesc make_set(int is_ctx, int grp) {
    SetDesc s;
    s.is_ctx = is_ctx;
    if (is_ctx) { s.nrows = RC; s.samp0 = 0; s.nsamp = NB; s.lgseq = LGCTX; s.ntb = NTBC; s.cap = CTX / 8; s.rpe = RPE_C; }
    else { s.nrows = RL; s.samp0 = grp * G; s.nsamp = G; s.lgseq = LGSEQ; s.ntb = NTBL; s.cap = SEQ / 8; s.rpe = RPE_L; }
    return s;
}

#ifdef CPU_EMU
#define GAS
#else
#define GAS __attribute__((address_space(1)))
#endif
template <class T> DEV T ldg(const T* p) { return *(const GAS T*)p; }
template <class T> DEV void stg(T* p, const T& v) { *(GAS T*)p = v; }
DEV float bf2f(bf16_t v) { return __uint_as_float(((unsigned)v) << 16); }
DEV bf16_t f2bf(float f) { unsigned u = __float_as_uint(f); u += 0x7FFFu + ((u >> 16) & 1u); return (bf16_t)(u >> 16); }
#if defined(__HIP_DEVICE_COMPILE__)
typedef __bf16 bf16n2 __attribute__((ext_vector_type(2)));
typedef float f32n2 __attribute__((ext_vector_type(2)));
DEV unsigned pack2(float lo, float hi) { f32n2 v = {lo, hi}; bf16n2 r = __builtin_convertvector(v, bf16n2); return __builtin_bit_cast(unsigned, r); }
#else
DEV unsigned pack2(float lo, float hi) { return (unsigned)f2bf(lo) | ((unsigned)f2bf(hi) << 16); }
#endif
DEV float lo16(unsigned u) { return __uint_as_float(u << 16); }
DEV float hi16(unsigned u) { return __uint_as_float(u & 0xFFFF0000u); }
#if defined(__HIP_DEVICE_COMPILE__)
DEV float frcp(float x) { return __builtin_amdgcn_rcpf(x); }
#else
DEV float frcp(float x) { return 1.0f / x; }
#endif
#if defined(__HIP_DEVICE_COMPILE__)
DEV float sigmoidf_(float x) { return __builtin_amdgcn_rcpf(1.0f + __expf(-x)); }
#else
DEV float sigmoidf_(float x) { return 1.0f / (1.0f + __expf(-x)); }
#endif
DEV float logsigmoidf_(float x) { return fminf(x, 0.0f) - __logf(1.0f + __expf(-fabsf(x))); }
template <int M> DEV float shx(float v) {
#if defined(__HIP_DEVICE_COMPILE__)
    const unsigned u = __builtin_bit_cast(unsigned, v);
    if constexpr (M == 1) return __builtin_bit_cast(float, __builtin_amdgcn_update_dpp(u, u, 0xB1, 0xF, 0xF, false));
    else if constexpr (M == 2) return __builtin_bit_cast(float, __builtin_amdgcn_update_dpp(u, u, 0x4E, 0xF, 0xF, false));
    else if constexpr (M == 4) { const unsigned t = __builtin_amdgcn_update_dpp(u, u, 0x141, 0xF, 0xF, false);
        return __builtin_bit_cast(float, __builtin_amdgcn_update_dpp(t, t, 0x1B, 0xF, 0xF, false)); }
    else if constexpr (M == 8) return __builtin_bit_cast(float, __builtin_amdgcn_update_dpp(u, u, 0x128, 0xF, 0xF, false));
    else if constexpr (M == 16) { const auto r = __builtin_amdgcn_permlane16_swap(u, u, false, false); return __builtin_bit_cast(float, (threadIdx.x & 16) ? r[0] : r[1]); }
    else { const auto r = __builtin_amdgcn_permlane32_swap(u, u, false, false); return __builtin_bit_cast(float, (threadIdx.x & 32) ? r[0] : r[1]); }
#else
    return __shfl_xor(v, M);
#endif
}
DEV float wave_sum(float v) { v += shx<32>(v); v += shx<16>(v); v += shx<8>(v); v += shx<4>(v); v += shx<2>(v); v += shx<1>(v); return v; }
DEV bf16x8 mk8(u32x2 lo, u32x2 hi) { u32x4 v = {lo.x, lo.y, hi.x, hi.y}; return __builtin_bit_cast(bf16x8, v); }
DEV bf16x8 mk8(u32x4 v) { return __builtin_bit_cast(bf16x8, v); }
DEV bf16x8 mk8(s16x4 lo, s16x4 hi) { return __builtin_shufflevector(lo, hi, 0, 1, 2, 3, 4, 5, 6, 7); }
DEV f32x4 mfma16(bf16x8 a, bf16x8 b, f32x4 c) { return __builtin_amdgcn_mfma_f32_16x16x32_bf16(a, b, c, 0, 0, 0); }
DEV unsigned f8enc1(float x) {
    const unsigned sgn = x < 0.f ? 0x80u : 0u; float a = x < 0.f ? -x : x; if (!(a < 448.f)) a = 448.f;
    if (a < 0.015625f) { const int q = (int)(a * 512.f + 0.5f); const float r = a * 512.f; int qq = q; if ((float)q - r == 0.5f && (q & 1)) qq = q - 1; return sgn | (unsigned)qq; }
    int e = 0; float m = a; while (m >= 2.f) { m *= 0.5f; ++e; } while (m < 1.f) { m *= 2.f; --e; }
    const float r = (m - 1.f) * 8.f; int q = (int)(r + 0.5f); if ((float)q - r == 0.5f && (q & 1)) --q;
    if (q == 8) { q = 0; ++e; }
    return sgn | (unsigned)((e + 7) << 3) | (unsigned)q;
}
#if defined(__HIP_DEVICE_COMPILE__)
DEV unsigned f8pack4(float a, float b, float c, float d) {
    a = __builtin_amdgcn_fmed3f(a, -448.f, 448.f); b = __builtin_amdgcn_fmed3f(b, -448.f, 448.f); c = __builtin_amdgcn_fmed3f(c, -448.f, 448.f); d = __builtin_amdgcn_fmed3f(d, -448.f, 448.f);
    int w = 0; w = __builtin_amdgcn_cvt_pk_fp8_f32(a, b, w, false); w = __builtin_amdgcn_cvt_pk_fp8_f32(c, d, w, true); return (unsigned)w; }
#else
DEV unsigned f8pack4(float a, float b, float c, float d) { return f8enc1(a) | (f8enc1(b) << 8) | (f8enc1(c) << 16) | (f8enc1(d) << 24); }
#endif
#ifdef CPU_EMU
DEV f32x4 mfma_f8(bf16x8 a0, bf16x8 a1, bf16x8 b0, bf16x8 b1, f32x4 c) { return emu_mfma_f8(a0, a1, b0, b1, c); }
#else
typedef int i32x4 __attribute__((ext_vector_type(4)));
typedef int i32x8 __attribute__((ext_vector_type(8)));
DEV f32x4 mfma_f8(bf16x8 a0, bf16x8 a1, bf16x8 b0, bf16x8 b1, f32x4 c) {
    const i32x8 A = __builtin_shufflevector(__builtin_bit_cast(i32x4, a0), __builtin_bit_cast(i32x4, a1), 0, 1, 2, 3, 4, 5, 6, 7);
    const i32x8 B = __builtin_shufflevector(__builtin_bit_cast(i32x4, b0), __builtin_bit_cast(i32x4, b1), 0, 1, 2, 3, 4, 5, 6, 7);
    return __builtin_amdgcn_mfma_scale_f32_16x16x128_f8f6f4(A, B, c, 0, 0, 0, 0, 0, 0);
}
#endif
constexpr float F8_WSCALE = 64.0f, F8_WINV = 1.0f / 64.0f;
DEV void store8bf(bf16_t* o, f32x4 a, f32x4 b) { u32x4 v = {pack2(a[0], a[1]), pack2(a[2], a[3]), pack2(b[0], b[1]), pack2(b[2], b[3])}; stg((u32x4*)o, v); }

#ifndef CPU_EMU
#define XB_TMO      128
#define XB_XCNT(j)  (256  + 64 * (j))
#define XB_XSUB(j)  (1280 + 64 * (j))
#define XB_XGEN(j)  (2304 + 64 * (j))
#define XB_TOP      3328
#define XB_TOPGEN   3392
#define XCD_BAR_WORDS 3456
#define XB_SPIN_CAP (1u << 18)
#define LAS __attribute__((address_space(3)))
__device__ __forceinline__ unsigned xb_ld(unsigned* p)              { return __hip_atomic_load(p, __ATOMIC_RELAXED, __HIP_MEMORY_SCOPE_AGENT); }
__device__ __forceinline__ unsigned xb_add(unsigned* p, unsigned v) { return __hip_atomic_fetch_add(p, v, __ATOMIC_RELAXED, __HIP_MEMORY_SCOPE_AGENT); }
__device__ __forceinline__ unsigned xb_xcc_id() { return (unsigned)__builtin_amdgcn_s_getreg((3 << 11) | 20) & 0xFu; }
#define XB_SPIN(cond, bar) do { unsigned _sp = 0; while (cond) { __builtin_amdgcn_s_sleep(1); \
    if ((++_sp & 255u) == 0u) { if (xb_ld(&(bar)[XB_TMO])) break; if (_sp > XB_SPIN_CAP) { atomicAdd(&(bar)[XB_TMO], 1u); break; } } } } while (0)
struct XcdBarrier { unsigned* bar; unsigned x; volatile LAS unsigned* st; };
__device__ __forceinline__ XcdBarrier xcd_barrier_post(unsigned* bar, volatile LAS unsigned* st) {
    XcdBarrier b; b.bar = bar; b.x = xb_xcc_id(); b.st = st;
    if (threadIdx.x == 0) (void)xb_add(&bar[XB_XCNT(b.x)], 1u);
    return b;
}
__device__ __forceinline__ void xcd_barrier_complete(unsigned* bar, unsigned x, unsigned& nloc, unsigned& nx) {
    const unsigned Gd = gridDim.x * gridDim.y * gridDim.z;
    unsigned sum, cnt, mine, sp = 0u;
    for (;;) {
        sum = 0u; cnt = 0u; mine = 0u;
#pragma unroll
        for (unsigned j = 0; j < 16; ++j) { const unsigned c = xb_ld(&bar[XB_XCNT(j)]); sum += c; cnt += (c > 0u) ? 1u : 0u; mine = (j == x) ? c : mine; }
        if (sum == Gd) break;
        __builtin_amdgcn_s_sleep(1);
        if ((++sp & 255u) == 0u) { if (xb_ld(&bar[XB_TMO])) break; if (sp > XB_SPIN_CAP) { atomicAdd(&bar[XB_TMO], 1u); break; } }
    }
    nloc = mine > 0u ? mine : 1u; nx = cnt > 0u ? cnt : 1u;
}
__device__ __forceinline__ void xcd_barrier(const XcdBarrier& b) {
    asm volatile("s_waitcnt vmcnt(0)" ::: "memory");
    __syncthreads();
    if (threadIdx.x == 0) {
        unsigned* bar = b.bar;
        unsigned bx = b.x; asm volatile("" : "+s"(bx));
        __builtin_amdgcn_s_waitcnt(0);
        unsigned nloc = b.st[0], nx = b.st[1];
        if (nloc == 0u) { xcd_barrier_complete(bar, bx, nloc, nx); b.st[0] = nloc; b.st[1] = nx; }
        const unsigned old = xb_add(&bar[XB_XSUB(bx)], 1u);
        const unsigned gen = old / nloc;
        if (old + 1u == (gen + 1u) * nloc) {
            __builtin_amdgcn_fence(__ATOMIC_RELEASE, "agent");
            asm volatile("s_waitcnt vmcnt(0)" ::: "memory");
            const unsigned og = xb_add(&bar[XB_TOP], 1u);
            const unsigned tg = og / nx;
            if (og + 1u == (tg + 1u) * nx) xb_add(&bar[XB_TOPGEN], 1u);
            else XB_SPIN(xb_ld(&bar[XB_TOPGEN]) == tg, bar);
            __builtin_amdgcn_fence(__ATOMIC_ACQUIRE, "agent");
            xb_add(&bar[XB_XGEN(bx)], 1u);
            asm volatile("s_waitcnt vmcnt(0)" ::: "memory");
        } else {
            XB_SPIN(xb_ld(&bar[XB_XGEN(bx)]) == gen, bar);
            __builtin_amdgcn_fence(__ATOMIC_ACQUIRE, "agent");
            asm volatile("s_waitcnt vmcnt(0)" ::: "memory");
        }
    }
    __syncthreads();
}
#endif

constexpr int BK = 64, HALF = 128, HT_BYTES = HALF * BK * 2;
DEV int lds_byte(int r, int c) { int st = (r >> 4) * 2 + (c >> 5), rr = r & 15, cc = c & 31, ob = rr * 64 + cc * 2; return st * 1024 + (ob ^ (((ob >> 9) & 1) << 5)); }
DEV void stage_rc(int b, int& Rr, int& Cc) { int st = b / 1024, sb = b % 1024, swz = sb ^ (((sb >> 9) & 1) << 5); Rr = (st >> 1) * 16 + swz / 64; Cc = (st & 1) * 32 + (swz % 64) / 2; }
DEV int perm32(int rho) { const int n = rho >> 4, i = rho & 15; return 8 * (i >> 2) + 4 * n + (i & 3); }

DEV bool tile_from_L(int L, int nM, int nN, int& pm, int& pn) {
    const int nwg = nM * nN; if (L >= nwg) return false;
    int wgid = L; { const int q = nwg / 8, r = nwg % 8, xcd = wgid % 8, off = wgid / 8; wgid = (xcd < r ? xcd * (q + 1) : r * (q + 1) + (xcd - r) * q) + off; }
    const int nig = 8 * nN, gid = wgid / nig, fm = gid * 8, gsz = (nM - fm) < 8 ? (nM - fm) : 8;
    pm = fm + ((wgid % nig) % gsz); pn = (wgid % nig) / gsz; return true;
}
DEV bool tile_order(int i, int nM, int nN, int& pm, int& pn) { return tile_from_L(i * (int)gridDim.x + (int)blockIdx.x, nM, nN, pm, pn); }
#ifdef CPU_EMU
#define GLDS16(src, dst) __builtin_amdgcn_global_load_lds((const unsigned*)(src), (unsigned*)((dst) + (TID() & 63) * 16), 16, 0, 0)
#else
#define GLDS16(src, dst) __builtin_amdgcn_global_load_lds((const unsigned*)(src), (unsigned*)(dst), 16, 0, 0)
#endif

#define BAR __builtin_amdgcn_s_barrier()
#define SCHED __builtin_amdgcn_sched_barrier(0)
struct GUnit { int pm, pn, aux; };
template <bool GATHER, int LDA_, int LDB_, int K_, bool F8 = false, class Sched, class Epi>
DEV void gemm_stream(char* shm, const Sched& S, const Epi& epi) {
#define SA(b, h) (shm + ((b) * 2 + (h)) * HT_BYTES)
#define SB(b, h) (shm + (4 + (b) * 2 + (h)) * HT_BYTES)
#define STG_B(P, bp) do { GLDS16((bp) + voffB, (P) + ldsb0); GLDS16((bp) + voffB + 64 * LDB_, (P) + ldsb0 + 8192); } while (0)
#define STG_A(P, ap, h, gv) do { if (GATHER) { GLDS16((ap) + gv[h][0], (P) + ldsb0); GLDS16((ap) + gv[h][1], (P) + ldsb0 + 8192); } \
    else { GLDS16((ap) + voffA + (h) * 128 * LDA_, (P) + ldsb0); GLDS16((ap) + voffA + ((h) * 128 + 64) * LDA_, (P) + ldsb0 + 8192); } } while (0)
#define LDA(dst, b, h) _Pragma("unroll") for (int m = 0; m < 4; ++m) _Pragma("unroll") for (int k = 0; k < 2; ++k) \
    dst[m][k] = *reinterpret_cast<const bf16x8*>(SA(b, h) + aoff + m * 2048 + k * 1024)
#define LDB(dst, b, h) _Pragma("unroll") for (int n = 0; n < 2; ++n) _Pragma("unroll") for (int k = 0; k < 2; ++k) \
    dst[n][k] = *reinterpret_cast<const bf16x8*>(SB(b, h) + boff + n * 2048 + k * 1024)
#define MMA(ai, bj, At_, Bx_) do { __builtin_amdgcn_s_setprio(1); \
    if constexpr (F8) { _Pragma("unroll") for (int m = 0; m < 4; ++m) _Pragma("unroll") for (int n = 0; n < 2; ++n) \
      acc[ai][bj][m][n] = mfma_f8(Bx_[n][0], Bx_[n][1], At_[m][0], At_[m][1], acc[ai][bj][m][n]); } \
    else { _Pragma("unroll") for (int m = 0; m < 4; ++m) _Pragma("unroll") for (int n = 0; n < 2; ++n) _Pragma("unroll") for (int k = 0; k < 2; ++k) \
      acc[ai][bj][m][n] = mfma16(Bx_[n][k], At_[m][k], acc[ai][bj][m][n]); } \
    __builtin_amdgcn_s_setprio(0); } while (0)
    constexpr int nt = K_ / BK;
    const int tid = TID();
    const int wid = __builtin_amdgcn_readfirstlane(tid >> 6), lane = tid & 63, wr = wid >> 2, wc = wid & 3, fr = lane & 15, fq = lane >> 4;
    const int ldsb0 = wid * 1024;
    int Rr0, Cc0; stage_rc(tid * 16, Rr0, Cc0);
    const int voffA = Rr0 * LDA_ + Cc0;
    const int voffB = ((Rr0 & ~31) + perm32(Rr0 & 31)) * LDB_ + Cc0;
    const int aoff = lds_byte(wr * 64 + fr, fq * 8), boff = lds_byte(wc * 32 + fr, fq * 8);
    GUnit cur, nxt; int ui = 0;
    if (!S.next(0, cur)) return;
    int gc[2][2] = {{0, 0}, {0, 0}};
    int* gtab = (int*)(shm + 131072 + 256);
    if (GATHER) {
        __syncthreads();
        { GUnit u; for (int i = 0; i < GT_MAXU && S.next(i, u); ++i) { if (tid < 256) gtab[i * 256 + tid] = S.grow(u, tid) * LDA_; } }
        __syncthreads();
#pragma unroll
        for (int h = 0; h < 2; ++h)
#pragma unroll
            for (int i = 0; i < 2; ++i) gc[h][i] = gtab[h * 128 + i * 64 + Rr0] + Cc0;
    }
    f32x4 acc[2][2][4][2];
#pragma unroll
    for (int a = 0; a < 2; ++a)
#pragma unroll
        for (int b = 0; b < 2; ++b)
#pragma unroll
            for (int m = 0; m < 4; ++m)
#pragma unroll
                for (int n = 0; n < 2; ++n) acc[a][b][m][n] = (f32x4){0.f, 0.f, 0.f, 0.f};
    bf16x8 At[4][2], B0[2][2], B1[2][2];
    const bf16_t* cA = S.a_base(cur); const bf16_t* cB = S.b_base(cur);
    STG_B(SB(0, 0), cB); STG_A(SA(0, 0), cA, 0, gc); STG_B(SB(0, 1), cB + 128 * LDB_); STG_A(SA(0, 1), cA, 1, gc);
    if (wr == 1) BAR;
    WAIT_V(4); BAR;
    STG_B(SB(1, 0), cB + BK); STG_A(SA(1, 0), cA + BK, 0, gc); STG_B(SB(1, 1), cB + 128 * LDB_ + BK);
    WAIT_V(6); BAR;
    for (;;) {
        const bool has_next = S.next(ui + 1, nxt);
        const bf16_t* nA = has_next ? S.a_base(nxt) : cA; const bf16_t* nB = has_next ? S.b_base(nxt) : cB;
#pragma unroll 1
        for (int t = 0; t < nt; t += 2) {
            const bool last = (t == nt - 2);
            const bf16_t* a1 = cA + (t + 1) * BK;
            const bf16_t* a2 = last ? nA : cA + (t + 2) * BK; const bf16_t* b2 = last ? nB : cB + (t + 2) * BK;
            const bf16_t* a3 = a2 + BK; const bf16_t* b3 = b2 + BK;
            LDB(B0, 0, 0); SCHED; LDA(At, 0, 0); STG_A(SA(1, 1), a1, 1, gc);
            if (GATHER && last && has_next) {
#pragma unroll
                for (int h = 0; h < 2; ++h)
#pragma unroll
                    for (int i = 0; i < 2; ++i) gc[h][i] = gtab[(ui + 1) * 256 + h * 128 + i * 64 + Rr0] + Cc0; }
            WAIT_L(8); BAR; WAIT_L(0); MMA(0, 0, At, B0); BAR; SCHED;
            LDB(B1, 0, 1); STG_B(SB(0, 0), b2);
            BAR; WAIT_L(0); MMA(0, 1, At, B1); BAR;
            LDA(At, 0, 1); STG_A(SA(0, 0), a2, 0, gc);
            BAR; WAIT_L(0); MMA(1, 0, At, B0); BAR; SCHED;
            STG_B(SB(0, 1), b2 + 128 * LDB_);
            WAIT_V(6); BAR; MMA(1, 1, At, B1); BAR;
            LDB(B0, 1, 0); SCHED; LDA(At, 1, 0); STG_A(SA(0, 1), a2, 1, gc);
            WAIT_L(8); BAR; WAIT_L(0); MMA(0, 0, At, B0); BAR; SCHED;
            LDB(B1, 1, 1); STG_B(SB(1, 0), b3);
            BAR; WAIT_L(0); MMA(0, 1, At, B1); BAR;
            LDA(At, 1, 1); STG_A(SA(1, 0), a3, 0, gc);
            BAR; WAIT_L(0); MMA(1, 0, At, B0); BAR; SCHED;
            STG_B(SB(1, 1), b3 + 128 * LDB_);
            WAIT_V(6); BAR; MMA(1, 1, At, B1); BAR;
        }
        {
            const int tz = TID(); const int wz = tz >> 6, lz = tz & 63, wrz = wz >> 2, wcz = wz & 3, frz = lz & 15, fqz = lz >> 4;
            epi(cur, acc, wrz * 64 + frz, wcz * 32 + 8 * fqz);
        }
        if (!has_next) break;
#pragma unroll
        for (int a = 0; a < 2; ++a)
#pragma unroll
            for (int b = 0; b < 2; ++b)
#pragma unroll
                for (int m = 0; m < 4; ++m)
#pragma unroll
                    for (int n = 0; n < 2; ++n) acc[a][b][m][n] = (f32x4){0.f, 0.f, 0.f, 0.f};
        cur = nxt; cA = nA; cB = nB; ++ui;
    }
    WAIT_V(0);
    if (wr == 0) BAR;
    BAR;
#undef SA
#undef SB
#undef STG_A
#undef STG_B
#undef LDA
#undef LDB
#undef MMA
}

constexpr int J_IN = 16 * 27, J_WB = 2 * 8 * 4, J_WO = 16 * 4, J_GU = 16 * 2 * 64, J_DN = 16 * 64, J_FOLD = 8 * 16, J_PAD = 1;
constexpr int N_MODJOBS = 2 * 96;

constexpr int J_BIG = J_IN + J_WB + J_WO + J_GU + J_DN;
struct WJob { const float* src; bf16_t* dst; int ldsrc, lddst, nvalid, k0, n0, mode, gu_which, f8; };
DEV WJob wjob_decode(const Params& p, int l, int j) {
    WJob w; w.ldsrc = 1024; w.lddst = 1024; w.nvalid = 256; w.mode = 0; w.gu_which = 0; w.f8 = 0;
    if (j < J_IN) { const int kt = j / 27, nb = j % 27; w.k0 = kt * 64; w.n0 = nb * 256; w.src = p.w_in + (size_t)l * 1024 * PWSRC; w.ldsrc = PWSRC; w.nvalid = PWSRC - w.n0; w.dst = p.WinT() + (size_t)l * PWT * 1024; w.mode = 3; }
    else if ((j -= J_IN) < J_WB) { const int bi = (j / 32) * 2, jj = j % 32, kt = jj / 4, nb = jj % 4; w.k0 = kt * 64; w.n0 = nb * 256;
        w.src = p.w_branch + ((size_t)l * 3 + bi) * 512 * 1024; w.dst = p.WbT() + ((size_t)l * 3 + bi) * 1024 * 512; w.lddst = 512; }
    else if ((j -= J_WB) < J_WO) { const int kt = j / 4, nb = j % 4; w.k0 = kt * 64; w.n0 = nb * 256; w.src = p.w_out + (size_t)l * 1024 * 1024; w.dst = p.WoT() + (size_t)l * 1024 * 1024; }
    else if ((j -= J_WO) < J_GU) { const int e = j / 128, jj = j % 128; w.gu_which = jj / 64; const int j3 = jj % 64, kt = j3 / 4, nb = j3 % 4; w.k0 = kt * 64; w.n0 = nb * 256;
        w.src = (w.gu_which ? p.w_up : p.w_gate) + ((size_t)l * 16 + e) * 1024 * 1024; w.dst = p.WguT() + ((size_t)l * 16 + e) * 2048 * 512; w.mode = 1; w.f8 = 1; }
    else { j -= J_GU; const int e = j / 64, jj = j % 64, kt = jj / 4, nb = jj % 4; w.k0 = kt * 64; w.n0 = nb * 256;
        w.src = p.w_down + ((size_t)l * 16 + e) * 1024 * 1024; w.dst = p.WdT() + ((size_t)l * 16 + e) * 1024 * 512; w.f8 = 1; }
    return w;
}
constexpr int WT_LD = 260;
DEV void wjob_load(const WJob& w, int tid, f32x4 (&vv)[8]) {
#pragma unroll
    for (int i = 0; i < 8; ++i) { const int idx = i * 512 + tid, r = idx >> 6, c = (idx & 63) * 4; int col = w.n0 + c; col = col > w.ldsrc - 4 ? w.ldsrc - 4 : col;
        vv[i] = ldg((const f32x4*)(w.src + (size_t)(w.k0 + r) * w.ldsrc + col)); }
}
DEV void wjob_finish(const WJob& w, int tid, const f32x4 (&vv)[8], float* tile) {
    __syncthreads();
#pragma unroll
    for (int i = 0; i < 8; ++i) { const int idx = i * 512 + tid, r = idx >> 6, c = (idx & 63) * 4; *(f32x4*)(tile + r * WT_LD + c) = vv[i]; }
    __syncthreads();
#pragma unroll
    for (int q = 0; q < 4; ++q) {
        const int item = q * 512 + tid, nrow = item >> 3, kc = (item & 7) * 8;
        float v[8];
#pragma unroll
        for (int jj = 0; jj < 8; ++jj) v[jj] = tile[(kc + jj) * WT_LD + nrow];
        const int n = w.n0 + nrow;
        int drow = n; bool f8 = w.f8 != 0; size_t f8base = 0;
        if (w.mode == 1) drow = (n >> 7) * 256 + w.gu_which * 128 + (n & 127);
        if (w.mode == 3) {
            if (n >= C_SPLIT) { f8 = true; f8base = (size_t)PWA * 2048; drow = n - C_SPLIT; }
            else { drow = proj_col(n); if (drow >= C_F8) { f8 = true; f8base = (size_t)C_F8 * 2048; drow -= C_F8; } } }
        if (f8) { const u32x2 o = {f8pack4(v[0] * F8_WSCALE, v[1] * F8_WSCALE, v[2] * F8_WSCALE, v[3] * F8_WSCALE), f8pack4(v[4] * F8_WSCALE, v[5] * F8_WSCALE, v[6] * F8_WSCALE, v[7] * F8_WSCALE)};
            if (nrow < w.nvalid) stg((u32x2*)((unsigned char*)w.dst + f8base + (size_t)drow * 1024 + w.k0 + kc), o); }
        else if (nrow < w.nvalid) { u32x4 o = {pack2(v[0], v[1]), pack2(v[2], v[3]), pack2(v[4], v[5]), pack2(v[6], v[7])};
            stg((u32x4*)(w.dst + (size_t)drow * w.lddst + w.k0 + kc), o); }
    }
}
DEV void pro_small_job(const Params& p, int l, int j, char* shm) {
    float* tile = (float*)shm;
    const int tid = TID();
    if (j < J_FOLD) {
        const int kt = j / 16, ntl = j % 16, k0 = kt * 64, n0 = ntl * 64; const int fg = k0 / 128;
        const float* wb1 = p.w_branch + ((size_t)l * 3 + 1) * 512 * 1024;
        const float* pw = p.pool_w + ((size_t)l * 4 + fg) * 128 * 128; const float* ps = p.pool_scale + (size_t)l * 512 + fg * 128;
        const int c = tid & 63, rq = tid >> 6;
        float accv[8];
#pragma unroll
        for (int i = 0; i < 8; ++i) accv[i] = 0.f;
        for (int d = 0; d < 128; ++d) { const float wv = ldg(wb1 + (size_t)(fg * 128 + d) * 1024 + n0 + c) * ldg(ps + d);
#pragma unroll
            for (int i = 0; i < 8; ++i) accv[i] += ldg(pw + (size_t)(k0 - fg * 128 + rq * 8 + i) * 128 + d) * wv; }
        __syncthreads();
#pragma unroll
        for (int i = 0; i < 8; ++i) tile[(rq * 8 + i) * WT_LD + c] = accv[i];
        __syncthreads();
        const int nrow = tid >> 3, kc = (tid & 7) * 8; float v[8];
#pragma unroll
        for (int jj = 0; jj < 8; ++jj) v[jj] = tile[(kc + jj) * WT_LD + nrow];
        u32x4 o = {pack2(v[0], v[1]), pack2(v[2], v[3]), pack2(v[4], v[5]), pack2(v[6], v[7])};
        stg((u32x4*)(p.WbT() + ((size_t)l * 3 + 1) * 1024 * 512 + (size_t)(n0 + nrow) * 512 + k0 + kc), o);
    } else {
        bf16_t* d0 = p.WinT() + (size_t)l * PWT * 1024 + (size_t)C_PADA * 1024;
        for (int i = tid; i < (C_F8 - C_PADA) * 1024 / 8; i += NTHREADS) stg((u32x4*)(d0 + (size_t)i * 8), (u32x4){0u, 0u, 0u, 0u});
    }
}

DEV void pro_mod_job(const Params& p, int job, char* shm) {
    float* sv = (float*)shm;
    const int tid = TID(), l = job / 96, col0 = (job % 96) * 64;
    const int c = tid & 63, kp = tid >> 6;
    float acc[NB + 1];
#pragma unroll
    for (int v = 0; v <= NB; ++v) acc[v] = 0.f;
    for (int half = 0; half < 2; ++half) {
        __syncthreads();
        for (int idx = tid; idx < (NB + 1) * 512; idx += 512) { const int v = idx >> 9, k = idx & 511;
            const float s = (v < NB) ? ldg(p.c + (size_t)v * 1024 + half * 512 + k) : ldg(p.c_ctx + half * 512 + k);
            sv[idx] = s * sigmoidf_(s); }
        __syncthreads();
        for (int kk = 0; kk < 64; ++kk) { const int k = kp * 64 + kk;
            const float w = ldg(p.ada_w + ((size_t)l * 1024 + half * 512 + k) * 6144 + col0 + c);
#pragma unroll
            for (int v = 0; v <= NB; ++v) acc[v] += sv[v * 512 + k] * w; }
    }
    __syncthreads();
    float* red = (float*)shm;
#pragma unroll
    for (int v = 0; v <= NB; ++v) red[(kp * (NB + 1) + v) * 64 + c] = acc[v];
    __syncthreads();
    for (int idx = tid; idx < (NB + 1) * 64; idx += 512) { const int v = idx >> 6, cc = idx & 63; float s = 0.f;
#pragma unroll
        for (int q = 0; q < 8; ++q) s += red[(q * (NB + 1) + v) * 64 + cc];
        stg(p.mod() + ((size_t)l * (NB + 1) + v) * 6144 + col0 + cc, s + ldg(p.ada_b + (size_t)l * 6144 + col0 + cc)); }
}

DEV void phase_prologue(const Params& p, char* shm) {
    const int tid = TID();
    const int nsmall = N_MODJOBS + 1 + 2 * (J_FOLD + J_PAD);
    for (int job = blockIdx.x; job < nsmall; job += gridDim.x) {
        if (job < N_MODJOBS) pro_mod_job(p, job, shm);
        else if (job == N_MODJOBS) {
            for (int idx = tid; idx < (ROWS + 64) * 16; idx += NTHREADS) { const int pos = idx >> 4, i = idx & 15;
                const float pv = (float)(pos < ROWS ? pos : pos - ROWS);
                const float inv = powf(10000.0f, -(float)(2 * i) / 32.0f);
                const float a = pv * inv; stg(p.rope() + idx * 2, cosf(a)); stg(p.rope() + idx * 2 + 1, sinf(a)); }
        } else { const int sj = job - N_MODJOBS - 1; pro_small_job(p, sj / (J_FOLD + J_PAD), sj % (J_FOLD + J_PAD), shm); }
    }
    float* tile = (float*)shm;
    const int nbig = 2 * J_BIG;
    int job = blockIdx.x;
    if (job >= nbig) return;
    WJob wc = wjob_decode(p, job / J_BIG, job % J_BIG), wn = wc;
    f32x4 vc[8], vn[8];
    wjob_load(wc, tid, vc);
    for (; job < nbig; job += gridDim.x) {
        const int jn = job + gridDim.x;
        if (jn < nbig) { wn = wjob_decode(p, jn / J_BIG, jn % J_BIG); wjob_load(wn, tid, vn); }
        wjob_finish(wc, tid, vc, tile);
        wc = wn;
#pragma unroll
        for (int i = 0; i < 8; ++i) vc[i] = vn[i];
    }
}

DEV const float* xsrc_base(const Params& p, const SetDesc& sd, int layer) {
    return (sd.is_ctx ? (layer == 0 ? p.ctx : (const float*)p.ctxs()) : (layer == 0 ? p.x : (const float*)p.out)) + (((size_t)sd.samp0) << sd.lgseq) * 1024;
}
DEV float* xdst_base(const Params& p, const SetDesc& sd) { return (sd.is_ctx ? p.ctxs() : p.out) + (((size_t)sd.samp0) << sd.lgseq) * 1024; }
DEV const float* mod_row(const Params& p, const SetDesc& sd, int layer, int row) {
    return p.mod() + ((size_t)layer * (NB + 1) + (sd.is_ctx ? NB : sd.samp0 + (row >> sd.lgseq))) * 6144;
}
DEV bf16_t* proj_buf(const Params& p, const SetDesc& sd) { return sd.is_ctx ? p.PROJc() : p.PROJa(); }

DEV void stage_params(float* par, const float* v0, const float* v1, const float* v2, const float* v3, const float* v4) {
    const int tid = TID();
    const float* src[5] = {v0, v1, v2, v3, v4};
#pragma unroll
    for (int k = 0; k < 5; ++k) if (src[k]) { for (int i = tid; i < 1024; i += NTHREADS) par[k * 1024 + i] = ldg(src[k] + i); }
}
DEV void phase_norm1(const Params& p, const SetDesc& sd, int layer, char* shm) {
    const int tid = TID(), lane = tid & 63, wv = tid >> 6;
    const float* g0 = p.norm_gain + ((size_t)layer * 4 + 0) * 1024;
    const float* xb = xsrc_base(p, sd, layer);
    const int stride = 8; const int rpb_ = (sd.nrows + (int)gridDim.x - 1) / (int)gridDim.x; const int row_end = min(sd.nrows, ((int)blockIdx.x + 1) * rpb_);
    int row = (int)blockIdx.x * rpb_ + wv;
    float* par = (float*)shm;
    __syncthreads();
    { const float* mdb = mod_row(p, sd, layer, min((int)blockIdx.x * rpb_, sd.nrows - 1)); stage_params(par, g0, mdb, mdb + 1024, nullptr, nullptr); }
    __syncthreads();
    f32x4 cur[4], nxt[4];
    if (row < row_end) {
#pragma unroll
        for (int i = 0; i < 4; ++i) cur[i] = ldg((const f32x4*)(xb + (size_t)row * 1024 + (i >> 1) * 512 + lane * 8 + (i & 1) * 4)); }
    for (; row < row_end; row += stride) {
        const int rn = row + stride;
        if (rn < row_end) {
#pragma unroll
            for (int i = 0; i < 4; ++i) nxt[i] = ldg((const f32x4*)(xb + (size_t)rn * 1024 + (i >> 1) * 512 + lane * 8 + (i & 1) * 4)); }
        const float* md = mod_row(p, sd, layer, row);
        float ss = 0.f;
#pragma unroll
        for (int i = 0; i < 4; ++i)
#pragma unroll
            for (int j = 0; j < 4; ++j) ss += cur[i][j] * cur[i][j];
        ss = wave_sum(ss);
        const float rstd = rsqrtf(ss * (1.0f / 1024.0f) + RMS_EPS);
#pragma unroll
        for (int hlf = 0; hlf < 2; ++hlf) { const int c0 = hlf * 512 + lane * 8; float o[8];
#pragma unroll
            for (int j = 0; j < 8; ++j) o[j] = cur[hlf * 2 + (j >> 2)][j & 3] * rstd * par[c0 + j] * (1.0f + par[2048 + c0 + j]) + par[1024 + c0 + j];
            u32x4 ov = {pack2(o[0], o[1]), pack2(o[2], o[3]), pack2(o[4], o[5]), pack2(o[6], o[7])};
            stg((u32x4*)(p.H() + (size_t)row * 1024 + c0), ov);
            const u32x2 o8 = {f8pack4(o[0], o[1], o[2], o[3]), f8pack4(o[4], o[5], o[6], o[7])};
            stg((u32x2*)(p.H8() + (size_t)row * 1024 + c0), o8); }
#pragma unroll
        for (int i = 0; i < 4; ++i) cur[i] = nxt[i];
    }
}

struct SchedPlain {
    const bf16_t* A; const bf16_t* Bt; int nM, nN, lda256, ldb256;
    DEV bool next(int i, GUnit& u) const { u.aux = 0; return tile_order(i, nM, nN, u.pm, u.pn); }
    DEV const bf16_t* a_base(const GUnit& u) const { return A + (size_t)u.pm * lda256; }
    DEV const bf16_t* b_base(const GUnit& u) const { return Bt + (size_t)u.pn * ldb256; }
    DEV int grow(const GUnit&, int) const { return 0; }
};
struct SchedPlainT : SchedPlain {
    int split_base = -1;
    DEV bool next(int i, GUnit& u) const { u.aux = 0; const int G_ = (int)gridDim.x, b = (int)blockIdx.x; int L = i * G_ + b;
        if (split_base >= 0 && i >= split_base) { if (b < G_ / 2 || i >= split_base + 2) return false; L = split_base * G_ + (i - split_base) * (G_ / 2) + (b - G_ / 2); }
        return tile_from_L(L, nM, nN, u.pm, u.pn); }
    DEV const bf16_t* a_base(const GUnit&) const { return A; }
    DEV int grow(const GUnit& u, int i) const { return u.pm * 256 + i; }
};
DEV void phase_proj_a(const Params& p, const SetDesc& sd, int layer, char* shm) {
    bf16_t* pb = proj_buf(p, sd);
    {
        SchedPlain S; S.A = p.H(); S.Bt = p.WinT() + (size_t)layer * PWT * 1024; S.nM = sd.nrows / 256; S.nN = C_F8 / 256; S.lda256 = 256 * 1024; S.ldb256 = 256 * 1024;
        gemm_stream<false, 1024, 1024, 1024>(shm, S, [=](const GUnit& u, const f32x4 (&acc)[2][2][4][2], int r0, int c0) {
#pragma unroll
            for (int ai = 0; ai < 2; ++ai)
#pragma unroll
                for (int m = 0; m < 4; ++m) { bf16_t* o = pb + ((size_t)u.pm * 256 + r0 + ai * 128 + m * 16) * PWA + u.pn * 256 + c0;
                    store8bf(o, acc[ai][0][m][0], acc[ai][0][m][1]); store8bf(o + 128, acc[ai][1][m][0], acc[ai][1][m][1]); } });
    }
    {
        SchedPlainT S; S.A = (const bf16_t*)p.H8(); S.Bt = p.WinT() + (size_t)layer * PWT * 1024 + (size_t)C_F8 * 1024; S.nM = sd.nrows / 256; S.nN = (PWA - C_F8) / 256; S.lda256 = 256 * 512; S.ldb256 = 256 * 512;
        { const int G_ = (int)gridDim.x, T1 = S.nM * (C_F8 / 256), T2 = S.nM * S.nN; if ((G_ & 1) == 0 && (T1 % G_) * 2 == G_ && T2 % G_ == 0 && T2 / G_ >= 1) S.split_base = T2 / G_ - 1; }
        gemm_stream<true, 512, 512, 512, true>(shm, S, [=](const GUnit& u, const f32x4 (&acc)[2][2][4][2], int r0, int c0) {
#pragma unroll
            for (int ai = 0; ai < 2; ++ai)
#pragma unroll
                for (int m = 0; m < 4; ++m) { bf16_t* o = pb + ((size_t)u.pm * 256 + r0 + ai * 128 + m * 16) * PWA + C_F8 + u.pn * 256 + c0;
                    store8bf(o, acc[ai][0][m][0] * F8_WINV, acc[ai][0][m][1] * F8_WINV); store8bf(o + 128, acc[ai][1][m][0] * F8_WINV, acc[ai][1][m][1] * F8_WINV); } });
    }
}
DEV unsigned gate4u8(f32x4 v) {
    unsigned w = 0;
#pragma unroll
    for (int j = 0; j < 4; ++j) w |= (unsigned)(sigmoidf_(v[j] * F8_WINV) * 255.0f + 0.5f) << (8 * j);
    return w;
}
DEV float u8f(unsigned w, int j) { return (float)((w >> (8 * j)) & 0xFFu); }
DEV f32x4 sig4(f32x4 v) { f32x4 r; r[0] = sigmoidf_(v[0]); r[1] = sigmoidf_(v[1]); r[2] = sigmoidf_(v[2]); r[3] = sigmoidf_(v[3]); return r; }
DEV void phase_proj_b(const Params& p, const SetDesc& sd, int layer, char* shm) {
    SchedPlainT S; S.A = (const bf16_t*)p.H8(); S.Bt = p.WinT() + (size_t)layer * PWT * 1024 + (size_t)PWA * 1024; S.nM = sd.nrows / 256; S.nN = NBG / 256; S.lda256 = 256 * 512; S.ldb256 = 256 * 512;
    unsigned char* bg = (unsigned char*)p.BG();
    gemm_stream<true, 512, 512, 512, true>(shm, S, [=](const GUnit& u, const f32x4 (&acc)[2][2][4][2], int r0, int c0) {
#pragma unroll
        for (int ai = 0; ai < 2; ++ai)
#pragma unroll
            for (int m = 0; m < 4; ++m) { unsigned char* o = bg + ((size_t)u.pm * 256 + r0 + ai * 128 + m * 16) * NBG + u.pn * 256 + c0;
#pragma unroll
                for (int hf = 0; hf < 2; ++hf) { const u32x2 gv = {gate4u8(acc[ai][hf][m][0]), gate4u8(acc[ai][hf][m][1])}; stg((u32x2*)(o + hf * 128), gv); } } });
}

DEV void gate_scan(const bf16_t* prow, int h, const float* gbias, float* ga, float* gb, float* gpm, float* gtot, float* tmp) {
    const int tid = TID(), lane = tid & 63, w = tid >> 6;
    float b = 0.f, a = 0.f, pm = 0.f; int d = 0, tok = 0;
    if (tid < 256) {
        d = tid >> 7; const int i = tid & 127; tok = d ? 127 - i : i;
        const float gi = bf2f(ldg(prow + (size_t)tok * PWA + C_GM + (2 * d) * 4 + h)) + ldg(gbias + (2 * d) * 4 + h);
        const float gf = bf2f(ldg(prow + (size_t)tok * PWA + C_GM + (2 * d + 1) * 4 + h)) + ldg(gbias + (2 * d + 1) * 4 + h);
        b = logsigmoidf_(gf);
#pragma unroll
        for (int o = 1; o < 64; o <<= 1) { const float t = __shfl_up(b, o); if (lane >= o) b += t; }
        if (lane == 63) tmp[w] = b;
        a = gi;
    }
    __syncthreads();
    if (tid < 256) {
        if (w & 1) b += tmp[w - 1];
        a -= b; pm = a;
#pragma unroll
        for (int o = 1; o < 64; o <<= 1) { const float t = __shfl_up(pm, o); if (lane >= o) pm = fmaxf(pm, t); }
        if (lane == 63) tmp[8 + w] = pm;
    }
    __syncthreads();
    if (tid < 256) {
        if (w & 1) pm = fmaxf(pm, tmp[8 + w - 1]);
        ga[d * 128 + tok] = a; gb[d * 128 + tok] = b; gpm[d * 128 + tok] = pm;
        if ((tid & 127) == 127) { gtot[d * 2] = b; gtot[d * 2 + 1] = pm; }
    }
    __syncthreads();
}

DEV void load_rope_chunk(const bf16_t* hp, int cidx, bool latent, int tl, const float* rope, float scale, float* o) {
    const u32x4 m = ldg((const u32x4*)(hp + cidx * 8));
    float x[8] = {lo16(m.x), hi16(m.x), lo16(m.y), hi16(m.y), lo16(m.z), hi16(m.z), lo16(m.w), hi16(m.w)};
    if (latent) {
        const u32x4 q = ldg((const u32x4*)(hp + (cidx ^ 2) * 8));
        const float y[8] = {lo16(q.x), hi16(q.x), lo16(q.y), hi16(q.y), lo16(q.z), hi16(q.z), lo16(q.w), hi16(q.w)};
        const int pos = (cidx < 4) ? (tl >> 6) : (ROWS + (tl & 63));
        const float* tb = rope + ((size_t)pos * 16 + (cidx & 1) * 8) * 2;
        const bool first = (cidx & 2) == 0;
#pragma unroll
        for (int j = 0; j < 8; ++j) { const float cs = ldg(tb + j * 2), sn = ldg(tb + j * 2 + 1);
            x[j] = first ? (x[j] * cs - y[j] * sn) : (x[j] * cs + y[j] * sn); }
    }
#pragma unroll
    for (int j = 0; j < 8; ++j) o[j] = x[j] * scale;
}

DEV int st_index(const SetDesc& sd, int sl, int h, int dir, int tb) { return ((sl * 4 + h) * 2 + dir) * sd.ntb + tb; }

constexpr int V_LD = 144, K_LD = 72, KS_LD = 80;
DEV void mlstm_stepA_task(const Params& p, const SetDesc& sd, int layer, int task, char* shm) {
    const int tid = TID(), lane = tid & 63, w = tid >> 6, fr = lane & 15, fq = lane >> 4, tq4 = (lane & 15) >> 2, tp4 = lane & 3;
    const int tb = task % sd.ntb, h = (task / sd.ntb) & 3, sl = task / (sd.ntb * 4);
    const int row0 = (sl << sd.lgseq) + tb * 128; const bool latent = !sd.is_ctx; const int tl0 = tb * 128;
    bf16_t* Vs = (bf16_t*)shm;
    bf16_t* Ksc = (bf16_t*)(shm + 128 * V_LD * 2);
    float* ga = (float*)(shm + 128 * V_LD * 2 + 2 * 128 * KS_LD * 2); float* gb = ga + 256; float* gpm = gb + 256; float* gtot = gpm + 256; float* tmp = gtot + 8;
    const bf16_t* prow = proj_buf(p, sd) + (size_t)row0 * PWA;
    __syncthreads();
    gate_scan(prow, h, p.gate_bias + (size_t)layer * 16, ga, gb, gpm, gtot, tmp);
    {
        const int s = tid & 127, cpi = tid >> 7, cp = (cpi & 1) + (cpi >> 1) * 4;
        const bf16_t* hp = prow + (size_t)s * PWA + C_KM + h * 64;
        float k1[8], k2[8];
        load_rope_chunk(hp, cp, latent, tl0 + s, p.rope(), 1.0f, k1);
        load_rope_chunk(hp, cp + 2, latent, tl0 + s, p.rope(), 1.0f, k2);
#pragma unroll
        for (int dir = 0; dir < 2; ++dir) { const float ws = __expf(ga[dir * 128 + s] - gtot[dir * 2 + 1]);
            u32x4 o1 = {pack2(k1[0] * ws, k1[1] * ws), pack2(k1[2] * ws, k1[3] * ws), pack2(k1[4] * ws, k1[5] * ws), pack2(k1[6] * ws, k1[7] * ws)};
            u32x4 o2 = {pack2(k2[0] * ws, k2[1] * ws), pack2(k2[2] * ws, k2[3] * ws), pack2(k2[4] * ws, k2[5] * ws), pack2(k2[6] * ws, k2[7] * ws)};
            *(u32x4*)(Ksc + (dir * 128 + s) * KS_LD + cp * 8) = o1; *(u32x4*)(Ksc + (dir * 128 + s) * KS_LD + (cp + 2) * 8) = o2; }
    }
#pragma unroll
    for (int it = 0; it < 4; ++it) { const int item = tid + it * 512, s = item >> 4, ch = item & 15;
        *(u32x4*)(Vs + s * V_LD + ch * 8) = ldg((const u32x4*)(prow + (size_t)s * PWA + C_VM + h * 128 + ch * 8)); }
    __syncthreads();
    f32x4 acc[2][4];
#pragma unroll
    for (int dir = 0; dir < 2; ++dir)
#pragma unroll
        for (int n = 0; n < 4; ++n) acc[dir][n] = (f32x4){0.f, 0.f, 0.f, 0.f};
#pragma unroll
    for (int ks = 0; ks < 4; ++ks) {
        const bf16_t* vp = Vs + (32 * ks + 4 * fq + tq4) * V_LD + w * 16 + 4 * tp4;
        const bf16x8 af = mk8(TR16(vp), TR16(vp + 16 * V_LD));
#pragma unroll
        for (int dir = 0; dir < 2; ++dir)
#pragma unroll
            for (int n = 0; n < 4; ++n) { const bf16_t* kp = Ksc + (dir * 128 + 32 * ks + 4 * fq + tq4) * KS_LD + n * 16 + 4 * tp4;
                const bf16x8 bfv = mk8(TR16(kp), TR16(kp + 16 * KS_LD));
                acc[dir][n] = mfma16(af, bfv, acc[dir][n]); }
    }
#pragma unroll
    for (int dir = 0; dir < 2; ++dir) { float* So = p.Sst() + (size_t)st_index(sd, sl, h, dir, tb) * 8192;
#pragma unroll
        for (int n = 0; n < 4; ++n)
#pragma unroll
            for (int r = 0; r < 4; ++r) stg(So + (w * 16 + fq * 4 + r) * 64 + n * 16 + fr, (float)acc[dir][n][r]); }
    if (tid < 128) { const int dir = tid >> 6, dd = tid & 63; float sm = 0.f;
        for (int i = 0; i < 128; ++i) sm += bf2f(Ksc[(dir * 128 + i) * KS_LD + dd]);
        stg(p.Sn() + (size_t)st_index(sd, sl, h, dir, tb) * 64 + dd, sm); }
    if (tid < 2) { float* sc = p.Ssc() + (size_t)st_index(sd, sl, h, tid, tb) * 4; stg(sc, gtot[tid * 2]); stg(sc + 1, gtot[tid * 2] + gtot[tid * 2 + 1]); }
}

template <int GI> DEV void pool_group(const Params& p, const SetDesc& sd, const bf16_t* pb) {
    constexpr int W = 2 << GI;
    const int nitems = sd.nrows * 16; const int T = 1 << sd.lgseq;
    for (int item = blockIdx.x * NTHREADS + TID(); item < nitems; item += gridDim.x * NTHREADS) {
        const int row = item >> 4, ch = GI * 128 + (item & 15) * 8;
        const int tt = row & (T - 1);
        u32x4 mv[W]; int cnt = 0; bool okv[W];
#pragma unroll
        for (int q = 0; q < W; ++q) { const int t2 = tt - W / 2 + q; const bool ok = (t2 >= 0) && (t2 < T); cnt += ok ? 1 : 0; okv[q] = ok;
            mv[q] = ldg((const u32x4*)(pb + (size_t)(ok ? (row - W / 2 + q) : row) * PWA + C_PU + ch)); }
        float s[8];
#pragma unroll
        for (int j = 0; j < 8; ++j) s[j] = 0.f;
#pragma unroll
        for (int q = 0; q < W; ++q) { u32x4 m = mv[q]; if (!okv[q]) m = (u32x4){0u, 0u, 0u, 0u};
            s[0] += lo16(m.x); s[1] += hi16(m.x); s[2] += lo16(m.y); s[3] += hi16(m.y); s[4] += lo16(m.z); s[5] += hi16(m.z); s[6] += lo16(m.w); s[7] += hi16(m.w); }
        const float inv = frcp((float)cnt);
        const u32x4 m = mv[W / 2];
        const float u[8] = {lo16(m.x), hi16(m.x), lo16(m.y), hi16(m.y), lo16(m.z), hi16(m.z), lo16(m.w), hi16(m.w)};
        u32x4 o = {pack2(s[0] * inv - u[0], s[1] * inv - u[1]), pack2(s[2] * inv - u[2], s[3] * inv - u[3]), pack2(s[4] * inv - u[4], s[5] * inv - u[5]), pack2(s[6] * inv - u[6], s[7] * inv - u[7])};
        stg((u32x4*)(p.Pb() + (size_t)row * 512 + ch), o);
    }
}
DEV void phase_pool(const Params& p, const SetDesc& sd) {
    const bf16_t* pb = proj_buf(p, sd);
    pool_group<0>(p, sd, pb); pool_group<1>(p, sd, pb); pool_group<2>(p, sd, pb); pool_group<3>(p, sd, pb);
}

template <int NC> DEV void mlstm_stepB_run(const Params& p, const SetDesc& sd, int task) {
    const int tid = TID();
    const int q = task & 3, dir = (task >> 2) & 1, h = (task >> 3) & 3, sl = task >> 5;
    const int ci = ((sd.samp0 + sl) * 4 + h) * 2 + dir;
    const int eoff = q * 2048 + tid * 4;
    float zr = 0.f; HIDE(zr);
    f32x4 C = {zr, zr, zr, zr}; float nv = 0.f; float m = -1e30f;
    f32x4 Sv[NC]; float blv[NC], mlv[NC], snv[NC];
#pragma unroll
    for (int c = 0; c < NC; ++c) { const int tb = dir ? NC - 1 - c : c; const size_t si = st_index(sd, sl, h, dir, tb);
        Sv[c] = ldg((const f32x4*)(p.Sst() + si * 8192 + eoff)); blv[c] = ldg(p.Ssc() + si * 4); mlv[c] = ldg(p.Ssc() + si * 4 + 1);
        snv[c] = (q == 0 && tid < 64) ? ldg(p.Sn() + si * 64 + tid) : 0.f; }
    if (!sd.is_ctx) { C = ldg((const f32x4*)(p.CiC() + (size_t)ci * 8192 + eoff)); if (q == 0 && tid < 64) nv = ldg(p.Cin_() + (size_t)ci * 64 + tid); m = ldg(p.Cim() + (size_t)ci * 4); }
#pragma unroll
    for (int c = 0; c < NC; ++c) {
        const int tb = dir ? NC - 1 - c : c; const size_t si = st_index(sd, sl, h, dir, tb);
        u32x2 o = {pack2(C[0], C[1]), pack2(C[2], C[3])};
        stg((u32x2*)(p.Cin() + si * 8192 + eoff), o);
        if (q == 0 && tid < 64) stg(p.Cn() + si * 64 + tid, nv);
        if (q == 0 && tid == 0) stg(p.Cm() + si * 4, m);
        const float mn = fmaxf(blv[c] + m, mlv[c]);
        const float dc = __expf(blv[c] + m - mn), wsn = __expf(mlv[c] - mn);
        C = C * dc + Sv[c] * wsn;
        nv = nv * dc + snv[c] * wsn;
        m = mn;
    }
    if (sd.is_ctx) { stg((f32x4*)(p.CiC() + (size_t)ci * 8192 + eoff), C); if (q == 0 && tid < 64) stg(p.Cin_() + (size_t)ci * 64 + tid, nv); if (q == 0 && tid == 0) stg(p.Cim() + (size_t)ci * 4, m); }
}
DEV void mlstm_stepB_task(const Params& p, const SetDesc& sd, int task) {
    if (sd.is_ctx) mlstm_stepB_run<NTBC>(p, sd, task); else mlstm_stepB_run<NTBL>(p, sd, task);
}

constexpr int NA_KLD = 136, NA_VLD = 144;
DEV void na_task(const Params& p, const SetDesc& sd, int layer, int sl, int rq2  , int hp, char* shm) {
    const int tid = TID(), lane = tid & 63, w = tid >> 6, tq = lane & 15, fq = lane >> 4, tq4 = (lane & 15) >> 2, tp4 = lane & 3;
    const int hh = w >> 2, g = w & 3, head = hp * 2 + hh;
    const bool ctxq = sd.is_ctx;
    bf16_t* Ks = (bf16_t*)shm;
    bf16_t* Vs = (bf16_t*)(shm + 128 * NA_KLD * 2);
    float* rpbs = (float*)(shm + 128 * NA_KLD * 2 + 128 * NA_VLD * 2);
    const int sample = sd.samp0 + sl;
    const bf16_t* pq = proj_buf(p, sd) + ((size_t)sl << sd.lgseq) * PWA;
    const bf16_t* pc = p.PROJc() + (size_t)sample * CTX * PWA;
    const int qcol = g * 16 + tq;
    int rqv[2], rsv[2], qtok[2];
#pragma unroll
    for (int u = 0; u < 2; ++u) { rqv[u] = 2 * rq2 + u; qtok[u] = rqv[u] * 64 + qcol; int r_ = rqv[u] - 4; rsv[u] = r_ < 0 ? 0 : (r_ > ROWS - 8 ? ROWS - 8 : r_); }
    const int nloc = ctxq ? 0 : (rsv[1] + 8 - rsv[0]);
    const int nstage = nloc + CTX / 64;
    __syncthreads();
    if (!ctxq) for (int i = tid; i < 2 * 465; i += NTHREADS) rpbs[i] = ldg(p.rpb + ((size_t)layer * 8 + hp * 2 + i / 465) * 465 + i % 465);
    bf16x8 qf[2][2];
#pragma unroll
    for (int u = 0; u < 2; ++u)
#pragma unroll
        for (int ks = 0; ks < 2; ++ks) qf[u][ks] = mk8(ldg((const u32x4*)(pq + (size_t)qtok[u] * PWA + C_QN + head * 64 + ks * 32 + fq * 8)));
    float m_run[2] = {-1e30f, -1e30f}, l_run[2] = {0.f, 0.f};
    f32x4 acc[2][4];
#pragma unroll
    for (int u = 0; u < 2; ++u)
#pragma unroll
        for (int mt = 0; mt < 4; ++mt) acc[u][mt] = (f32x4){0.f, 0.f, 0.f, 0.f};
    int cs = qcol - 8; cs = cs < 0 ? 0 : (cs > 48 ? 48 : cs);
    const int kc0 = (g == 0) ? 0 : (g == 1) ? 8 : (g == 2) ? 24 : 32;
    const int npair = (nstage + 1) >> 1;
    u32x4 kreg[4], vreg[4];
#define NA_SRC_ROWS(stg) (((stg) < nloc) ? (pq + (size_t)((rsv[0] + (stg)) * 64) * PWA) : (pc + (size_t)((((stg) < nstage ? (stg) : nstage - 1) - nloc) * 64) * PWA))
#define NA_FETCH(sp_) do { _Pragma("unroll") for (int it = 0; it < 4; ++it) { const int item = tid + it * 512, key2 = item >> 4, ch = item & 15; \
        const bf16_t* kb_ = NA_SRC_ROWS(2 * (sp_) + (key2 >> 6)); const bf16_t* src = kb_ + (size_t)(key2 & 63) * PWA + hp * 128 + ch * 8; \
        kreg[it] = ldg((const u32x4*)(src + C_KN)); vreg[it] = ldg((const u32x4*)(src + C_VN)); } } while (0)
    NA_FETCH(0);
    for (int sp = 0; sp < npair; ++sp) {
        __syncthreads();
#pragma unroll
        for (int it = 0; it < 4; ++it) { const int item = tid + it * 512, key2 = item >> 4, ch = item & 15;
            *(u32x4*)(Ks + key2 * NA_KLD + ch * 8) = kreg[it]; *(u32x4*)(Vs + key2 * NA_VLD + ch * 8) = vreg[it]; }
        if (sp + 1 < npair) NA_FETCH(sp + 1);
        __syncthreads();
#pragma unroll
        for (int sub = 0; sub < 2; ++sub) {
        const int st = 2 * sp + sub;
        if (st >= nstage) continue;
        const bool local = st < nloc;
        const bf16_t* Ksb = Ks + sub * 64 * NA_KLD; const bf16_t* Vsb = Vs + sub * 64 * NA_VLD;
        if (local) {
            const int kr = rsv[0] + st;
            f32x4 sa[2][2];
#pragma unroll
            for (int kt = 0; kt < 2; ++kt) { sa[0][kt] = (f32x4){0.f, 0.f, 0.f, 0.f}; sa[1][kt] = (f32x4){0.f, 0.f, 0.f, 0.f};
#pragma unroll
                for (int ks = 0; ks < 2; ++ks) { const bf16x8 kf = *(const bf16x8*)(Ksb + (kc0 + kt * 16 + tq) * NA_KLD + hh * 64 + ks * 32 + fq * 8);
                    sa[0][kt] = mfma16(kf, qf[0][ks], sa[0][kt]); sa[1][kt] = mfma16(kf, qf[1][ks], sa[1][kt]); } }
            float alpha[2]; bf16x8 pf[2];
#pragma unroll
            for (int u = 0; u < 2; ++u) {
                const bool act = (kr >= rsv[u]) && (kr < rsv[u] + 8);
                if (!act) { alpha[u] = 1.0f; pf[u] = mk8((u32x4){0u, 0u, 0u, 0u}); continue; }
                const int dr = kr - rqv[u] + 7;
                float sc[8]; float mx = -1e30f; float bs[8];
#pragma unroll
                for (int kt = 0; kt < 2; ++kt)
#pragma unroll
                    for (int r = 0; r < 4; ++r) { const int kcol = kc0 + kt * 16 + fq * 4 + r; int dc = kcol - qcol + 15; dc = dc < 0 ? 0 : (dc > 30 ? 30 : dc);
                        bs[kt * 4 + r] = rpbs[hh * 465 + dr * 31 + dc]; }
#ifndef CPU_EMU
                asm volatile("" : "+v"(bs[0]), "+v"(bs[1]), "+v"(bs[2]), "+v"(bs[3]), "+v"(bs[4]), "+v"(bs[5]), "+v"(bs[6]), "+v"(bs[7]));
#endif
#pragma unroll
                for (int kt = 0; kt < 2; ++kt)
#pragma unroll
                    for (int r = 0; r < 4; ++r) { const int kcol = kc0 + kt * 16 + fq * 4 + r; const bool valid = (kcol >= cs) && (kcol < cs + 16);
                        const float v = valid ? (sa[u][kt][r] * 0.125f + bs[kt * 4 + r]) : -1e30f; sc[kt * 4 + r] = v; mx = fmaxf(mx, v); }
                mx = fmaxf(mx, shx<16>(mx)); mx = fmaxf(mx, shx<32>(mx));
                const float mn = fmaxf(m_run[u], mx); alpha[u] = __expf(m_run[u] - mn); m_run[u] = mn;
                float ps = 0.f; float pv[8];
#pragma unroll
                for (int j = 0; j < 8; ++j) { pv[j] = __expf(sc[j] - mn); ps += pv[j]; }
                ps += shx<16>(ps); ps += shx<32>(ps);
                l_run[u] = l_run[u] * alpha[u] + ps;
                u32x4 pk = {pack2(pv[0], pv[1]), pack2(pv[2], pv[3]), pack2(pv[4], pv[5]), pack2(pv[6], pv[7])};
                pf[u] = mk8(pk);
            }
#pragma unroll
            for (int mt = 0; mt < 4; ++mt) {
                const bf16_t* vp = Vsb + (kc0 + 4 * fq + tq4) * NA_VLD + hh * 64 + mt * 16 + 4 * tp4;
                const bf16x8 vf = mk8(TR16(vp), TR16(vp + 16 * NA_VLD));
                acc[0][mt] = mfma16(vf, pf[0], acc[0][mt] * alpha[0]); acc[1][mt] = mfma16(vf, pf[1], acc[1][mt] * alpha[1]); }
        } else {
            f32x4 sa[2][4];
#pragma unroll
            for (int kt = 0; kt < 4; ++kt) { sa[0][kt] = (f32x4){0.f, 0.f, 0.f, 0.f}; sa[1][kt] = (f32x4){0.f, 0.f, 0.f, 0.f};
#pragma unroll
                for (int ks = 0; ks < 2; ++ks) { const bf16x8 kf = *(const bf16x8*)(Ksb + (kt * 16 + tq) * NA_KLD + hh * 64 + ks * 32 + fq * 8);
                    sa[0][kt] = mfma16(kf, qf[0][ks], sa[0][kt]); sa[1][kt] = mfma16(kf, qf[1][ks], sa[1][kt]); } }
            float alpha[2]; bf16x8 pf[2][2];
#pragma unroll
            for (int u = 0; u < 2; ++u) {
                float mx = -1e30f;
#pragma unroll
                for (int kt = 0; kt < 4; ++kt)
#pragma unroll
                    for (int r = 0; r < 4; ++r) { sa[u][kt][r] *= 0.125f; mx = fmaxf(mx, sa[u][kt][r]); }
                mx = fmaxf(mx, shx<16>(mx)); mx = fmaxf(mx, shx<32>(mx));
                const float mn = fmaxf(m_run[u], mx); alpha[u] = __expf(m_run[u] - mn); m_run[u] = mn;
                float ps = 0.f;
#pragma unroll
                for (int kt = 0; kt < 4; ++kt)
#pragma unroll
                    for (int r = 0; r < 4; ++r) { sa[u][kt][r] = __expf(sa[u][kt][r] - mn); ps += sa[u][kt][r]; }
                ps += shx<16>(ps); ps += shx<32>(ps);
                l_run[u] = l_run[u] * alpha[u] + ps;
#pragma unroll
                for (int h2 = 0; h2 < 2; ++h2) {
                    u32x4 pk = {pack2(sa[u][2 * h2][0], sa[u][2 * h2][1]), pack2(sa[u][2 * h2][2], sa[u][2 * h2][3]), pack2(sa[u][2 * h2 + 1][0], sa[u][2 * h2 + 1][1]), pack2(sa[u][2 * h2 + 1][2], sa[u][2 * h2 + 1][3])};
                    pf[u][h2] = mk8(pk); }
            }
#pragma unroll
            for (int mt = 0; mt < 4; ++mt) { acc[0][mt] = acc[0][mt] * alpha[0]; acc[1][mt] = acc[1][mt] * alpha[1]; }
#pragma unroll
            for (int h2 = 0; h2 < 2; ++h2)
#pragma unroll
                for (int mt = 0; mt < 4; ++mt) { const bf16_t* vp = Vsb + (32 * h2 + 4 * fq + tq4) * NA_VLD + hh * 64 + mt * 16 + 4 * tp4;
                    const bf16x8 vf = mk8(TR16(vp), TR16(vp + 16 * NA_VLD));
                    acc[0][mt] = mfma16(vf, pf[0][h2], acc[0][mt]); acc[1][mt] = mfma16(vf, pf[1][h2], acc[1][mt]); }
        }
        }
    }
#undef NA_FETCH
#undef NA_SRC_ROWS
#pragma unroll
    for (int u = 0; u < 2; ++u) {
        const float il = frcp(l_run[u]);
        const size_t orow = ((size_t)sl << sd.lgseq) + qtok[u];
#pragma unroll
        for (int mt = 0; mt < 4; ++mt) { u32x2 o = {pack2(acc[u][mt][0] * il, acc[u][mt][1] * il), pack2(acc[u][mt][2] * il, acc[u][mt][3] * il)};
            stg((u32x2*)(p.Nb() + orow * 512 + head * 64 + mt * 16 + fq * 4), o); }
    }
}

DEV void mlstm_stepC_task(const Params& p, const SetDesc& sd, int layer, int task, char* shm) {
    const int tid = TID(), lane = tid & 63, w = tid >> 6, tq = lane & 15, fq = lane >> 4, tq4 = (lane & 15) >> 2, tp4 = lane & 3;
    const int tb = task % sd.ntb, h = (task / sd.ntb) & 3, sl = task / (sd.ntb * 4);
    const int row0 = (sl << sd.lgseq) + tb * 128; const bool latent = !sd.is_ctx; const int tl0 = tb * 128;
    bf16_t* Ks = (bf16_t*)shm;
    bf16_t* Vs = (bf16_t*)(shm + 128 * K_LD * 2);
    bf16_t* Cs = (bf16_t*)(shm + 128 * K_LD * 2 + 128 * V_LD * 2);
    float* ga = (float*)(shm + 128 * K_LD * 2 * 3 + 128 * V_LD * 2); float* gb = ga + 256; float* gpm = gb + 256; float* gtot = gpm + 256; float* tmp = gtot + 8;
    float* nvs = tmp + 16;
    float* cms = nvs + 128;
    const bf16_t* prow = proj_buf(p, sd) + (size_t)row0 * PWA;
    __syncthreads();
    gate_scan(prow, h, p.gate_bias + (size_t)layer * 16, ga, gb, gpm, gtot, tmp);
    {
        const int s = tid & 127, cpi = tid >> 7, cp = (cpi & 1) + (cpi >> 1) * 4;
        const bf16_t* hp = prow + (size_t)s * PWA + C_KM + h * 64;
        float k1[8], k2[8];
        load_rope_chunk(hp, cp, latent, tl0 + s, p.rope(), 1.0f, k1);
        load_rope_chunk(hp, cp + 2, latent, tl0 + s, p.rope(), 1.0f, k2);
        u32x4 o1 = {pack2(k1[0], k1[1]), pack2(k1[2], k1[3]), pack2(k1[4], k1[5]), pack2(k1[6], k1[7])};
        u32x4 o2 = {pack2(k2[0], k2[1]), pack2(k2[2], k2[3]), pack2(k2[4], k2[5]), pack2(k2[6], k2[7])};
        *(u32x4*)(Ks + s * K_LD + cp * 8) = o1; *(u32x4*)(Ks + s * K_LD + (cp + 2) * 8) = o2;
    }
#pragma unroll
    for (int it = 0; it < 4; ++it) { const int item = tid + it * 512, s = item >> 4, ch = item & 15;
        *(u32x4*)(Vs + s * V_LD + ch * 8) = ldg((const u32x4*)(prow + (size_t)s * PWA + C_VM + h * 128 + ch * 8)); }
#pragma unroll
    for (int it = 0; it < 4; ++it) { const int item = tid + it * 512, dir = item >> 10, rem = item & 1023, v = rem >> 3, ch = rem & 7;
        *(u32x4*)(Cs + (dir * 128 + v) * K_LD + ch * 8) = ldg((const u32x4*)(p.Cin() + (size_t)st_index(sd, sl, h, dir, tb) * 8192 + v * 64 + ch * 8)); }
    if (tid < 128) nvs[tid] = ldg(p.Cn() + (size_t)st_index(sd, sl, h, tid >> 6, tb) * 64 + (tid & 63));
    if (tid < 2) cms[tid] = ldg(p.Cm() + (size_t)st_index(sd, sl, h, tid, tb) * 4);
    bf16x8 qf[2]; float qv[2][8];
    {
        const int t = w * 16 + tq; const bf16_t* hp = prow + (size_t)t * PWA + C_QM + h * 64;
#pragma unroll
        for (int ks = 0; ks < 2; ++ks) { load_rope_chunk(hp, ks * 4 + fq, latent, tl0 + t, p.rope(), 0.125f, qv[ks]);
            u32x4 o = {pack2(qv[ks][0], qv[ks][1]), pack2(qv[ks][2], qv[ks][3]), pack2(qv[ks][4], qv[ks][5]), pack2(qv[ks][6], qv[ks][7])}; qf[ks] = mk8(o); }
    }
    __syncthreads();
    const int t = w * 16 + tq;
    f32x4 hsum[8];
#pragma unroll
    for (int mt = 0; mt < 8; ++mt) hsum[mt] = (f32x4){0.f, 0.f, 0.f, 0.f};
#pragma unroll
    for (int dir = 0; dir < 2; ++dir) {
        const float m_in = cms[dir];
        const float Mt = fmaxf(m_in, gpm[dir * 128 + t]);
        const float inter = __expf(m_in - Mt);
        const float mtot = gb[dir * 128 + t] + Mt;
        f32x4 acc[8];
#pragma unroll
        for (int mt = 0; mt < 8; ++mt) { acc[mt] = (f32x4){0.f, 0.f, 0.f, 0.f};
#pragma unroll
            for (int ks = 0; ks < 2; ++ks) { const bf16x8 cf = *(const bf16x8*)(Cs + (dir * 128 + mt * 16 + tq) * K_LD + ks * 32 + fq * 8);
                acc[mt] = mfma16(cf, qf[ks], acc[mt]); }
            acc[mt] = acc[mt] * inter; }
        float qn = 0.f;
#pragma unroll
        for (int ks = 0; ks < 2; ++ks)
#pragma unroll
            for (int j = 0; j < 8; ++j) qn += bf2f(f2bf(qv[ks][j])) * nvs[dir * 64 + ks * 32 + fq * 8 + j];
        qn += shx<16>(qn); qn += shx<32>(qn);
        float den = inter * qn;
        const int u_lo = dir == 0 ? 0 : (w >> 1), u_hi = dir == 0 ? (w >> 1) : 3;
        float rsum = 0.f;
        for (int u = u_lo; u <= u_hi; ++u) {
            unsigned pk[4];
#pragma unroll
            for (int kt = 0; kt < 2; ++kt) { f32x4 sa = {0.f, 0.f, 0.f, 0.f}; const int sb = 32 * u + 16 * kt;
#pragma unroll
                for (int ks = 0; ks < 2; ++ks) { const bf16x8 kf = *(const bf16x8*)(Ks + (sb + tq) * K_LD + ks * 32 + fq * 8); sa = mfma16(kf, qf[ks], sa); }
                float pv[4]; float gv4[4];
#pragma unroll
                for (int r = 0; r < 4; ++r) gv4[r] = ga[dir * 128 + sb + fq * 4 + r];
#ifndef CPU_EMU
                asm volatile("" : "+v"(gv4[0]), "+v"(gv4[1]), "+v"(gv4[2]), "+v"(gv4[3]));
#endif
#pragma unroll
                for (int r = 0; r < 4; ++r) { const int s = sb + fq * 4 + r; const bool valid = dir == 0 ? (s <= t) : (s >= t);
                    pv[r] = valid ? sa[r] * __expf(gv4[r] - Mt) : 0.f; pv[r] = bf2f(f2bf(pv[r])); rsum += pv[r]; }
                pk[kt * 2] = pack2(pv[0], pv[1]); pk[kt * 2 + 1] = pack2(pv[2], pv[3]); }
            u32x4 pkv = {pk[0], pk[1], pk[2], pk[3]}; const bf16x8 pf = mk8(pkv);
#pragma unroll
            for (int mt = 0; mt < 8; ++mt) { const bf16_t* vp = Vs + (32 * u + 4 * fq + tq4) * V_LD + mt * 16 + 4 * tp4;
                const bf16x8 vf = mk8(TR16(vp), TR16(vp + 16 * V_LD));
                acc[mt] = mfma16(vf, pf, acc[mt]); }
        }
        rsum += shx<16>(rsum); rsum += shx<32>(rsum);
        den += rsum;
        const float dn = frcp(fmaxf(fabsf(den), __expf(-mtot)));
#pragma unroll
        for (int mt = 0; mt < 8; ++mt) hsum[mt] = hsum[mt] + acc[mt] * dn;
    }
    float ss = 0.f;
#pragma unroll
    for (int mt = 0; mt < 8; ++mt)
#pragma unroll
        for (int r = 0; r < 4; ++r) ss += hsum[mt][r] * hsum[mt][r];
    ss += shx<16>(ss); ss += shx<32>(ss);
    const float rstd = rsqrtf(ss * (1.0f / 128.0f) + RMS_EPS);
#pragma unroll
    for (int mt = 0; mt < 8; ++mt) { const int v = mt * 16 + fq * 4;
        const u32x2 om = ldg((const u32x2*)(prow + (size_t)t * PWA + C_OM + h * 128 + v));
        u32x2 o = {pack2(hsum[mt][0] * rstd * sigmoidf_(lo16(om.x)), hsum[mt][1] * rstd * sigmoidf_(hi16(om.x))),
                   pack2(hsum[mt][2] * rstd * sigmoidf_(lo16(om.y)), hsum[mt][3] * rstd * sigmoidf_(hi16(om.y)))};
        stg((u32x2*)(p.Mb() + (size_t)(row0 + t) * 512 + h * 128 + v), o); }
}

struct SchedMerge {
    const bf16_t* Mb; const bf16_t* Pb; const bf16_t* Nb; const bf16_t* Wb; int nM;
    DEV bool next(int i, GUnit& u) const { u.aux = i % 3; return tile_order(i / 3, nM, 4, u.pm, u.pn); }
    DEV const bf16_t* a_base(const GUnit& u) const { return (u.aux == 0 ? Mb : (u.aux == 1 ? Pb : Nb)) + (size_t)u.pm * 256 * 512; }
    DEV const bf16_t* b_base(const GUnit& u) const { return Wb + ((size_t)u.aux * 1024 + u.pn * 256) * 512; }
    DEV int grow(const GUnit&, int) const { return 0; }
};
DEV void phase_merge(const Params& p, const SetDesc& sd, int layer, char* shm) {
    SchedMerge S; S.Mb = p.Mb(); S.Pb = p.Pb(); S.Nb = p.Nb(); S.Wb = p.WbT() + (size_t)layer * 3 * 1024 * 512; S.nM = sd.nrows / 256;
    const unsigned char* bgb = (const unsigned char*)p.BG(); bf16_t* mgb = p.MERGED();
    gemm_stream<false, 512, 512, 512>(shm, S, [=](const GUnit& u, const f32x4 (&acc)[2][2][4][2], int r0, int c0) {
#pragma unroll
        for (int ai = 0; ai < 2; ++ai) {
            u32x2 gm[4][2]; u32x4 pr[4][2];
#pragma unroll
            for (int m = 0; m < 4; ++m)
#pragma unroll
                for (int hf = 0; hf < 2; ++hf) { const size_t r = (size_t)u.pm * 256 + r0 + ai * 128 + m * 16;
                    gm[m][hf] = ldg((const u32x2*)(bgb + r * NBG + u.aux * 1024 + u.pn * 256 + c0 + hf * 128));
                    if (u.aux > 0) pr[m][hf] = ldg((const u32x4*)(mgb + r * 1024 + u.pn * 256 + c0 + hf * 128)); else pr[m][hf] = (u32x4){0u, 0u, 0u, 0u}; }
#pragma unroll
            for (int m = 0; m < 4; ++m)
#pragma unroll
                for (int hf = 0; hf < 2; ++hf) { const size_t r = (size_t)u.pm * 256 + r0 + ai * 128 + m * 16;
                    const f32x4 x0 = acc[ai][hf][m][0] * (1.0f / 255.0f), x1 = acc[ai][hf][m][1] * (1.0f / 255.0f); const u32x2 g = gm[m][hf]; const u32x4 q = pr[m][hf];
                    u32x4 ov = {pack2(x0[0] * u8f(g.x, 0) + lo16(q.x), x0[1] * u8f(g.x, 1) + hi16(q.x)), pack2(x0[2] * u8f(g.x, 2) + lo16(q.y), x0[3] * u8f(g.x, 3) + hi16(q.y)),
                                pack2(x1[0] * u8f(g.y, 0) + lo16(q.z), x1[1] * u8f(g.y, 1) + hi16(q.z)), pack2(x1[2] * u8f(g.y, 2) + lo16(q.w), x1[3] * u8f(g.y, 3) + hi16(q.w))};
                    stg((u32x4*)(mgb + r * 1024 + u.pn * 256 + c0 + hf * 128), ov); }
        } });
}
DEV void phase_outproj(const Params& p, const SetDesc& sd, int layer, char* shm) {
    SchedPlain S; S.A = p.MERGED(); S.Bt = p.WoT() + (size_t)layer * 1024 * 1024; S.nM = sd.nrows / 256; S.nN = 4; S.lda256 = 256 * 1024; S.ldb256 = 256 * 1024;
    bf16_t* yb = p.Y();
    gemm_stream<false, 1024, 1024, 1024>(shm, S, [=](const GUnit& u, const f32x4 (&acc)[2][2][4][2], int r0, int c0) {
#pragma unroll
        for (int ai = 0; ai < 2; ++ai)
#pragma unroll
            for (int m = 0; m < 4; ++m) { bf16_t* o = yb + ((size_t)u.pm * 256 + r0 + ai * 128 + m * 16) * 1024 + u.pn * 256 + c0;
                store8bf(o, acc[ai][0][m][0], acc[ai][0][m][1]); store8bf(o + 128, acc[ai][1][m][0], acc[ai][1][m][1]); } });
}

DEV void phase_postmix(const Params& p, const SetDesc& sd, int layer, char* shm) {
    const int tid = TID(), lane = tid & 63, wv = tid >> 6;
    float* wr_s = (float*)shm;
    __syncthreads();
    for (int i = tid; i < 1024 * 16; i += NTHREADS) { const int c = i >> 4, e = i & 15, ln = (c & 511) >> 3, j = c & 7, hf = c >> 9;
        wr_s[((((hf * 8 + j) * 4 + (e >> 2)) * 64 + ln) << 2) + (e & 3)] = ldg(p.router_w + (size_t)layer * 1024 * 16 + i); }
    __syncthreads();
    const float* g1 = p.norm_gain + ((size_t)layer * 4 + 1) * 1024; const float* g2 = p.norm_gain + ((size_t)layer * 4 + 2) * 1024;
    float* par = (float*)(shm + 65536);
    { const int rpb0_ = (sd.nrows + (int)gridDim.x - 1) / (int)gridDim.x; const float* mdb = mod_row(p, sd, layer, min((int)blockIdx.x * rpb0_, sd.nrows - 1));
      stage_params(par, g1, g2, mdb + 2048, mdb + 3072, mdb + 4096); }
    __syncthreads();
    const float* xb = xsrc_base(p, sd, layer); float* xdb = xdst_base(p, sd);
    const int stride = 8; const int rpb_ = (sd.nrows + (int)gridDim.x - 1) / (int)gridDim.x; const int row_end = min(sd.nrows, ((int)blockIdx.x + 1) * rpb_);
    int row = (int)blockIdx.x * rpb_ + wv;
    u32x4 ycur[2], ynxt[2]; f32x4 xcur[4], xnxt[4];
    if (row < row_end) {
#pragma unroll
        for (int i = 0; i < 2; ++i) ycur[i] = ldg((const u32x4*)(p.Y() + (size_t)row * 1024 + i * 512 + lane * 8));
#pragma unroll
        for (int i = 0; i < 4; ++i) xcur[i] = ldg((const f32x4*)(xb + (size_t)row * 1024 + (i >> 1) * 512 + lane * 8 + (i & 1) * 4)); }
    for (; row < row_end; row += stride) {
        int ln = lane; HIDE(ln);
        const int rn = row + stride;
        if (rn < row_end) {
#pragma unroll
            for (int i = 0; i < 2; ++i) ynxt[i] = ldg((const u32x4*)(p.Y() + (size_t)rn * 1024 + i * 512 + ln * 8));
#pragma unroll
            for (int i = 0; i < 4; ++i) xnxt[i] = ldg((const f32x4*)(xb + (size_t)rn * 1024 + (i >> 1) * 512 + ln * 8 + (i & 1) * 4)); }
        float* xd = xdb + (size_t)row * 1024;
        const float* md = mod_row(p, sd, layer, row);
        float y[16]; float ss = 0.f;
#pragma unroll
        for (int hlf = 0; hlf < 2; ++hlf) { const u32x4 m = ycur[hlf];
            const float t8[8] = {lo16(m.x), hi16(m.x), lo16(m.y), hi16(m.y), lo16(m.z), hi16(m.z), lo16(m.w), hi16(m.w)};
#pragma unroll
            for (int j = 0; j < 8; ++j) { y[hlf * 8 + j] = t8[j]; ss += t8[j] * t8[j]; } }
        ss = wave_sum(ss);
        const float rstd = rsqrtf(ss * (1.0f / 1024.0f) + RMS_EPS);
        float xn[16]; float ss2 = 0.f;
#pragma unroll
        for (int hlf = 0; hlf < 2; ++hlf)
#pragma unroll
            for (int q = 0; q < 2; ++q) { const int c0 = hlf * 512 + ln * 8 + q * 4; const f32x4 xo = xcur[hlf * 2 + q]; f32x4 xw;
#pragma unroll
                for (int j = 0; j < 4; ++j) { const float v = xo[j] + par[2048 + c0 + j] * (y[hlf * 8 + q * 4 + j] * rstd * par[c0 + j]); xw[j] = v; xn[hlf * 8 + q * 4 + j] = v; ss2 += v * v; }
                stg((f32x4*)(xd + c0), xw); }
        ss2 = wave_sum(ss2);
        const float rstd2 = rsqrtf(ss2 * (1.0f / 1024.0f) + RMS_EPS);
        float lg[16];
#pragma unroll
        for (int e = 0; e < 16; ++e) lg[e] = 0.f;
#pragma unroll
        for (int hlf = 0; hlf < 2; ++hlf) { const int c0 = hlf * 512 + ln * 8; float o[8];
#pragma unroll
            for (int j = 0; j < 8; ++j) { o[j] = xn[hlf * 8 + j] * rstd2 * par[1024 + c0 + j] * (1.0f + par[4096 + c0 + j]) + par[3072 + c0 + j];
#pragma unroll
                for (int eq = 0; eq < 4; ++eq) { const f32x4 w4 = *(const f32x4*)(wr_s + ((((hlf * 8 + j) * 4 + eq) * 64 + ln) << 2));
#pragma unroll
                    for (int e = 0; e < 4; ++e) lg[eq * 4 + e] += o[j] * w4[e]; } }
            const u32x2 ov = {f8pack4(o[0], o[1], o[2], o[3]), f8pack4(o[4], o[5], o[6], o[7])};
            stg((u32x2*)((unsigned char*)p.H() + (size_t)row * 1024 + c0), ov); }
        float r8[8], r4[4], r2[2], r1;
        { const bool b = (lane & 32) != 0;
#pragma unroll
          for (int i = 0; i < 8; ++i) { const float keep = b ? lg[i + 8] : lg[i], send = b ? lg[i] : lg[i + 8]; r8[i] = keep + shx<32>(send); } }
        { const bool b = (lane & 16) != 0;
#pragma unroll
          for (int i = 0; i < 4; ++i) { const float keep = b ? r8[i + 4] : r8[i], send = b ? r8[i] : r8[i + 4]; r4[i] = keep + shx<16>(send); } }
        { const bool b = (lane & 8) != 0;
#pragma unroll
          for (int i = 0; i < 2; ++i) { const float keep = b ? r4[i + 2] : r4[i], send = b ? r4[i] : r4[i + 2]; r2[i] = keep + shx<8>(send); } }
        { const bool b = (lane & 4) != 0; const float keep = b ? r2[1] : r2[0], send = b ? r2[0] : r2[1]; r1 = keep + shx<4>(send); }
        r1 += shx<2>(r1); r1 += shx<1>(r1);
        float mx = r1;
        mx = fmaxf(mx, shx<4>(mx)); mx = fmaxf(mx, shx<8>(mx)); mx = fmaxf(mx, shx<16>(mx)); mx = fmaxf(mx, shx<32>(mx));
        const float ex = __expf(r1 - mx);
        float se = ex;
        se += shx<4>(se); se += shx<8>(se); se += shx<16>(se); se += shx<32>(se);
        if ((lane & 3) == 0) { const int e = ((lane >> 5) & 1) * 8 + ((lane >> 4) & 1) * 4 + ((lane >> 3) & 1) * 2 + ((lane >> 2) & 1);
            stg(p.aff() + (size_t)row * 16 + e, ex * frcp(se)); }
#pragma unroll
        for (int i = 0; i < 2; ++i) ycur[i] = ynxt[i];
#pragma unroll
        for (int i = 0; i < 4; ++i) xcur[i] = xnxt[i];
    }
}

DEV unsigned shxu(unsigned v, int m) {
    const float f = __uint_as_float(v); float r;
    switch (m) { case 1: r = shx<1>(f); break; case 2: r = shx<2>(f); break; case 4: r = shx<4>(f); break; case 8: r = shx<8>(f); break; case 16: r = shx<16>(f); break; default: r = shx<32>(f); break; }
    return __float_as_uint(r);
}
#define TK_CX(a_, b_, desc_) do { const unsigned long long x_ = key[a_], y_ = key[b_]; const bool sw_ = (desc_) ? (x_ < y_) : (x_ > y_); key[a_] = sw_ ? y_ : x_; key[b_] = sw_ ? x_ : y_; } while (0)
DEV void topk_task(const Params& p, const SetDesc& sd, int task, char* shm) {
    const int tid = TID();
    const int e = task & 15, sl = task >> 4;
    unsigned long long* buf = (unsigned long long*)shm;
    const int T = 1 << sd.lgseq, cap = sd.cap;
    const int rbase = sl << sd.lgseq;
    const bool active = tid * 4 < T;
    unsigned long long key[4];
    __syncthreads();
#pragma unroll
    for (int m = 0; m < 4; ++m) { const int i = tid * 4 + m; const float a = active ? ldg(p.aff() + (size_t)(rbase + i) * 16 + e) : 0.f;
        key[m] = ((unsigned long long)__float_as_uint(a) << 32) | (unsigned)(0xFFFFFFFFu - (unsigned)i); }
    for (int k = 2; k <= T; k <<= 1) {
        const bool desc4 = ((tid * 4) & k) == 0;
        for (int j = k >> 1; j >= 4; j >>= 1) {
            const int tj = j >> 2;
            unsigned long long pk[4];
            if (tj < 64) {
#pragma unroll
                for (int m = 0; m < 4; ++m) { const unsigned lo = shxu((unsigned)key[m], tj), hi = shxu((unsigned)(key[m] >> 32), tj); pk[m] = ((unsigned long long)hi << 32) | lo; }
            } else {
                __syncthreads();
                if (active) {
#pragma unroll
                    for (int m = 0; m < 4; ++m) buf[tid * 4 + m] = key[m]; }
                __syncthreads();
#pragma unroll
                for (int m = 0; m < 4; ++m) pk[m] = active ? buf[(tid ^ tj) * 4 + m] : 0ull;
            }
            const bool lower = (tid & tj) == 0; const bool takemax = desc4 == lower;
#pragma unroll
            for (int m = 0; m < 4; ++m) { const unsigned long long x = key[m], y = pk[m]; key[m] = takemax ? (x > y ? x : y) : (x < y ? x : y); }
        }
        if (k >= 4) { TK_CX(0, 2, desc4); TK_CX(1, 3, desc4); TK_CX(0, 1, desc4); TK_CX(2, 3, desc4); }
        else { TK_CX(0, 1, true); TK_CX(2, 3, false); }
    }
    const int sbase = e * sd.rpe + sl * cap;
    if (active) {
#pragma unroll
        for (int m = 0; m < 4; ++m) { const int i = tid * 4 + m; const unsigned long long kv = key[m]; const int tok = (int)(0xFFFFFFFFu - (unsigned)(kv & 0xFFFFFFFFu));
            const int row = rbase + tok;
            if (i < cap) { stg(p.slot_token() + sbase + i, row); stg(p.slot_gate() + sbase + i, __uint_as_float((unsigned)(kv >> 32))); stg(p.token_slots() + (size_t)row * 16 + e, sbase + i); }
            else stg(p.token_slots() + (size_t)row * 16 + e, -1); } }
    if (sl == 0) { const int used = sd.nsamp * cap;
        for (int i = used + tid; i < sd.rpe; i += NTHREADS) { stg(p.slot_token() + e * sd.rpe + i, 0); stg(p.slot_gate() + e * sd.rpe + i, 0.f); } }
}
#undef TK_CX

struct SchedMoe {
    const bf16_t* A; const int* st; const bf16_t* W; int nRT, rpe, nN, wstride;
    DEV bool next(int i, GUnit& u) const { int pmx, pn; if (!tile_order(i, 16 * nRT, nN, pmx, pn)) return false; u.pm = pmx % nRT; u.aux = pmx / nRT; u.pn = pn; return true; }
    DEV int slot0(const GUnit& u) const { return u.aux * rpe + u.pm * 256; }
    DEV const bf16_t* a_base(const GUnit&) const { return A; }
    DEV int grow(const GUnit& u, int i) const { return st ? ldg(st + slot0(u) + i) : slot0(u) + i; }
    DEV const bf16_t* b_base(const GUnit& u) const { return W + (size_t)u.aux * wstride + (size_t)u.pn * 256 * 512; }
};
DEV void phase_moe_gu(const Params& p, const SetDesc& sd, int layer, char* shm) {
    SchedMoe S; S.A = p.H(); S.st = p.slot_token(); S.W = p.WguT() + (size_t)layer * 16 * 2048 * 512; S.nRT = sd.rpe / 256; S.rpe = sd.rpe; S.nN = 8; S.wstride = 2048 * 512;
    unsigned char* hb = (unsigned char*)p.HID();
    gemm_stream<true, 512, 512, 512, true>(shm, S, [=](const GUnit& u, const f32x4 (&acc)[2][2][4][2], int r0, int c0) {
#pragma unroll
        for (int ai = 0; ai < 2; ++ai)
#pragma unroll
            for (int m = 0; m < 4; ++m) { f32x4 h0, h1; const f32x4 a0 = acc[ai][0][m][0] * F8_WINV, a1 = acc[ai][0][m][1] * F8_WINV, b0 = acc[ai][1][m][0] * F8_WINV, b1 = acc[ai][1][m][1] * F8_WINV;
#pragma unroll
                for (int j = 0; j < 4; ++j) { h0[j] = a0[j] * sigmoidf_(a0[j]) * b0[j]; h1[j] = a1[j] * sigmoidf_(a1[j]) * b1[j]; }
                const u32x2 hv = {f8pack4(h0[0], h0[1], h0[2], h0[3]), f8pack4(h1[0], h1[1], h1[2], h1[3])};
                stg((u32x2*)(hb + ((size_t)S.slot0(u) + r0 + ai * 128 + m * 16) * 1024 + u.pn * 128 + c0), hv); } });
}
DEV void phase_moe_down(const Params& p, const SetDesc& sd, int layer, char* shm) {
    SchedMoe S; S.A = p.HID(); S.st = nullptr; S.W = p.WdT() + (size_t)layer * 16 * 1024 * 512; S.nRT = sd.rpe / 256; S.rpe = sd.rpe; S.nN = 4; S.wstride = 1024 * 512;
    bf16_t* yb = p.YE(); const float* gt = p.slot_gate();
    gemm_stream<true, 512, 512, 512, true>(shm, S, [=](const GUnit& u, const f32x4 (&acc)[2][2][4][2], int r0, int c0) {
#pragma unroll
        for (int ai = 0; ai < 2; ++ai) {
            float gv[4];
#pragma unroll
            for (int m = 0; m < 4; ++m) gv[m] = ldg(gt + (size_t)S.slot0(u) + r0 + ai * 128 + m * 16) * F8_WINV;
#pragma unroll
            for (int m = 0; m < 4; ++m) { const size_t sl = (size_t)S.slot0(u) + r0 + ai * 128 + m * 16; const float g = gv[m];
                bf16_t* o = yb + sl * 1024 + u.pn * 256 + c0; store8bf(o, acc[ai][0][m][0] * g, acc[ai][0][m][1] * g); store8bf(o + 128, acc[ai][1][m][0] * g, acc[ai][1][m][1] * g); } } });
}

DEV void compact4(const int (&sl)[16], int (&c)[4], int& n) {
    n = 0; c[0] = -1; c[1] = -1; c[2] = -1; c[3] = -1;
#pragma unroll
    for (int e = 0; e < 16; ++e) if (sl[e] >= 0) { c[0] = (n == 0) ? sl[e] : c[0]; c[1] = (n == 1) ? sl[e] : c[1]; c[2] = (n == 2) ? sl[e] : c[2]; c[3] = (n == 3) ? sl[e] : c[3]; ++n; }
}
DEV void phase_combine(const Params& p, const SetDesc& sd, int layer, char* shm) {
    const int tid = TID(), lane = tid & 63, wv = tid >> 6;
    const float* g3 = p.norm_gain + ((size_t)layer * 4 + 3) * 1024;
    float* xdb = xdst_base(p, sd);
    const int stride = 8; const int rpb_ = (sd.nrows + (int)gridDim.x - 1) / (int)gridDim.x; const int row_end = min(sd.nrows, ((int)blockIdx.x + 1) * rpb_);
    int row = __builtin_amdgcn_readfirstlane((int)blockIdx.x * rpb_ + wv);
    float* par = (float*)shm;
    __syncthreads();
    { const float* mdb = mod_row(p, sd, layer, min((int)blockIdx.x * rpb_, sd.nrows - 1)); stage_params(par, g3, mdb + 5120, nullptr, nullptr, nullptr); }
    __syncthreads();
    int raw[16]; int cc[4], cn[4]; int nc = 0, nn = 0;
    u32x4 mc[4][2], mn[4][2]; f32x4 xc[4], xn[4];
#define CMB_SLOTS(r_) do { _Pragma("unroll") for (int e = 0; e < 16; ++e) raw[e] = ldg(p.token_slots() + (size_t)(r_) * 16 + e); } while (0)
#define CMB_DATA(r_, c_, n_, m_, x_) do { _Pragma("unroll") for (int k = 0; k < 4; ++k) { \
            if (k < (n_)) { const bf16_t* yr = p.YE() + (size_t)(c_)[k] * 1024 + lane * 8; (m_)[k][0] = ldg((const u32x4*)yr); (m_)[k][1] = ldg((const u32x4*)(yr + 512)); } \
            else { (m_)[k][0] = (u32x4){0u, 0u, 0u, 0u}; (m_)[k][1] = (u32x4){0u, 0u, 0u, 0u}; } } \
        _Pragma("unroll") for (int i = 0; i < 4; ++i) (x_)[i] = ldg((const f32x4*)(xdb + (size_t)(r_) * 1024 + (i >> 1) * 512 + lane * 8 + (i & 1) * 4)); } while (0)
    if (row < row_end) { CMB_SLOTS(row); compact4(raw, cc, nc); CMB_DATA(row, cc, nc, mc, xc); if (row + stride < row_end) CMB_SLOTS(row + stride); }
    for (; row < row_end; row += stride) {
        const int rn = row + stride;
        if (rn < row_end) { compact4(raw, cn, nn); CMB_DATA(rn, cn, nn, mn, xn); if (rn + stride < row_end) CMB_SLOTS(rn + stride); }
        float* xd = xdb + (size_t)row * 1024;
        float y[16];
#pragma unroll
        for (int j = 0; j < 16; ++j) y[j] = 0.f;
        if (nc <= 4) {
#pragma unroll
            for (int k = 0; k < 4; ++k)
                if (k < nc) {
#pragma unroll
                    for (int hlf = 0; hlf < 2; ++hlf) { const u32x4 m = mc[k][hlf];
                        y[hlf * 8 + 0] += lo16(m.x); y[hlf * 8 + 1] += hi16(m.x); y[hlf * 8 + 2] += lo16(m.y); y[hlf * 8 + 3] += hi16(m.y);
                        y[hlf * 8 + 4] += lo16(m.z); y[hlf * 8 + 5] += hi16(m.z); y[hlf * 8 + 6] += lo16(m.w); y[hlf * 8 + 7] += hi16(m.w); } }
        } else {
            for (int e = 0; e < 16; ++e) { const int sl_ = ldg(p.token_slots() + (size_t)row * 16 + e);
                if (sl_ >= 0) { const bf16_t* yr = p.YE() + (size_t)sl_ * 1024 + lane * 8;
#pragma unroll
                    for (int hlf = 0; hlf < 2; ++hlf) { const u32x4 m = ldg((const u32x4*)(yr + hlf * 512));
                        y[hlf * 8 + 0] += lo16(m.x); y[hlf * 8 + 1] += hi16(m.x); y[hlf * 8 + 2] += lo16(m.y); y[hlf * 8 + 3] += hi16(m.y);
                        y[hlf * 8 + 4] += lo16(m.z); y[hlf * 8 + 5] += hi16(m.z); y[hlf * 8 + 6] += lo16(m.w); y[hlf * 8 + 7] += hi16(m.w); } } }
        }
        float ss = 0.f;
#pragma unroll
        for (int j = 0; j < 16; ++j) ss += y[j] * y[j];
        ss = wave_sum(ss);
        const float rstd = rsqrtf(ss * (1.0f / 1024.0f) + RMS_EPS);
#pragma unroll
        for (int hlf = 0; hlf < 2; ++hlf)
#pragma unroll
            for (int q = 0; q < 2; ++q) { const int c0 = hlf * 512 + lane * 8 + q * 4; f32x4 xv = xc[hlf * 2 + q];
#pragma unroll
                for (int j = 0; j < 4; ++j) xv[j] += par[1024 + c0 + j] * (y[hlf * 8 + q * 4 + j] * rstd * par[c0 + j]);
                stg((f32x4*)(xd + c0), xv); }
        nc = nn;
#pragma unroll
        for (int k = 0; k < 4; ++k) { cc[k] = cn[k]; mc[k][0] = mn[k][0]; mc[k][1] = mn[k][1]; }
#pragma unroll
        for (int i = 0; i < 4; ++i) xc[i] = xn[i];
    }
#undef CMB_SLOTS
#undef CMB_DATA
}

constexpr int WQ_WORD0 = 4096;
template <class F> DEV void wq_run(const Params& p, int qidx, int ntasks, char* shm, F&& task) {
    unsigned* ctr = p.bar() + WQ_WORD0 + 64 * qidx;
    volatile int* slot = (volatile int*)(shm + 131072 + 64);
    const int tid = TID();
    int cur = blockIdx.x;
    while (cur < ntasks) {
        unsigned pend = 0u;
        if (tid == 0) pend = atomicAdd(ctr, 1u);
        task(cur);
        __syncthreads();
        if (tid == 0) *slot = (int)gridDim.x + (int)pend;
        __syncthreads();
        cur = *slot;
    }
}

template <int PH> DEV void do_phase(const Params& p, int layer, int is_ctx, int grp, char* shm) {
    const SetDesc sd = make_set(is_ctx, grp);
    if constexpr (PH == -1) phase_prologue(p, shm);
    if constexpr (PH == 0) phase_norm1(p, sd, layer, shm);
    if constexpr (PH == 1) phase_proj_a(p, sd, layer, shm);
    const int qbase = ((layer * 3 + (is_ctx ? 0 : grp + 1)) * 13 + (PH < 0 ? 0 : PH)) * 2;
    if constexpr (PH == 2) { wq_run(p, qbase, sd.nsamp * 4 * sd.ntb, shm, [&](int t) { mlstm_stepA_task(p, sd, layer, t, shm); }); if (!(is_ctx && layer == 1)) phase_pool(p, sd); }
    if constexpr (PH == 3) {
        for (int t = blockIdx.x; t < sd.nsamp * 32; t += gridDim.x) mlstm_stepB_task(p, sd, t);
        if (!(is_ctx && layer == 1)) {
            const int nq = (is_ctx ? (CTX / 64) : ROWS) / 2;
            wq_run(p, qbase, sd.nsamp * nq * 4, shm, [&](int t) { na_task(p, sd, layer, t / (nq * 4), (t >> 2) % nq, t & 3, shm); });
        }
    }
    if constexpr (PH == 4) { wq_run(p, qbase, sd.nsamp * 4 * sd.ntb, shm, [&](int t) { mlstm_stepC_task(p, sd, layer, t, shm); }); }
    if constexpr (PH == 5) phase_proj_b(p, sd, layer, shm);
    if constexpr (PH == 6) phase_merge(p, sd, layer, shm);
    if constexpr (PH == 7) phase_outproj(p, sd, layer, shm);
    if constexpr (PH == 8) phase_postmix(p, sd, layer, shm);
    if constexpr (PH == 9) { for (int t = blockIdx.x; t < sd.nsamp * 16; t += gridDim.x) topk_task(p, sd, t, shm); }
    if constexpr (PH == 10) phase_moe_gu(p, sd, layer, shm);
    if constexpr (PH == 11) phase_moe_down(p, sd, layer, shm);
    if constexpr (PH == 12) phase_combine(p, sd, layer, shm);
}

#ifndef CPU_EMU
template <int PH> __global__ void __launch_bounds__(NTHREADS, 2) k_phase(Params p, int layer, int is_ctx, int grp) {
    DYN_LDS(shm);
    do_phase<PH>(p, layer, is_ctx, grp, shm);
}
#ifndef DBL_MASK
#define DBL_MASK 0
#endif
#define RUNPH(PH) do { do_phase<PH>(p, layer, is_ctx, grp, shm); xcd_barrier(bar); if ((DBL_MASK >> (PH)) & 1) { do_phase<PH>(p, layer, is_ctx, grp, shm); xcd_barrier(bar); } } while (0)
__global__ void __launch_bounds__(NTHREADS, 2) k_mega(Params p) {
    DYN_LDS(shm);
    uint4* xbw = (uint4*)(shm + 131072);
    if (threadIdx.x == 0) *xbw = make_uint4(0u, 0u, 0u, 0u);
    __syncthreads();
    XcdBarrier bar = xcd_barrier_post(p.bar(), (volatile LAS unsigned*)xbw);
    do_phase<-1>(p, 0, 0, 0, shm);
    xcd_barrier(bar);
    for (int layer = 0; layer < 2; ++layer)
        for (int si = 0; si <= NG; ++si) {
            const int is_ctx = si == 0 ? 1 : 0, grp = si == 0 ? 0 : si - 1;
            RUNPH(0); RUNPH(1); RUNPH(2);
            if (is_ctx && layer == 1) { do_phase<3>(p, layer, is_ctx, grp, shm); continue; }
            RUNPH(3); RUNPH(4); RUNPH(5); RUNPH(6); RUNPH(7); RUNPH(8); RUNPH(9); RUNPH(10); RUNPH(11);
            do_phase<12>(p, layer, is_ctx, grp, shm);
        }
}
#endif
}

static Params make_params(void* const* d_in, void* d_out, void* d_ws) {
    Params p{};
    p.x = (const float*)d_in[0]; p.c = (const float*)d_in[1]; p.ctx = (const float*)d_in[2]; p.c_ctx = (const float*)d_in[3];
    p.norm_gain = (const float*)d_in[4]; p.ada_w = (const float*)d_in[5]; p.ada_b = (const float*)d_in[6]; p.w_in = (const float*)d_in[7];
    p.gate_bias = (const float*)d_in[8]; p.pool_w = (const float*)d_in[9]; p.pool_scale = (const float*)d_in[10]; p.rpb = (const float*)d_in[11];
    p.w_branch = (const float*)d_in[12]; p.w_out = (const float*)d_in[13]; p.router_w = (const float*)d_in[14];
    p.w_gate = (const float*)d_in[15]; p.w_up = (const float*)d_in[16]; p.w_down = (const float*)d_in[17];
    p.out = (float*)d_out; p.ws = (char*)d_ws;
    return p;
}

#ifdef CPU_EMU
int emu_cfg_B = CFG_B, emu_cfg_ROWS = CFG_ROWS, emu_cfg_CTX = CFG_CTX;
const char* g_dumpdir = "data";
static void* g_ws = nullptr;
static void dump_buf(const char* name, int layer, int is_ctx, int grp, const void* ptr, size_t bytes) {
    char nm[512]; snprintf(nm, sizeof nm, "%s/d_L%d_%s%d_%s.bin", g_dumpdir, layer, is_ctx ? "c" : "g", grp, name);
    FILE* f = fopen(nm, "wb"); fwrite(ptr, 1, bytes, f); fclose(f);
}
static void emu_hook(const Params& p, int layer, int is_ctx, int grp, int ph) {
    const size_t Rn = is_ctx ? RC : RL;
    if (ph == 0) dump_buf("H", layer, is_ctx, grp, p.H(), Rn * 1024 * 2);
    if (ph == 1) dump_buf("PROJ", layer, is_ctx, grp, is_ctx ? p.PROJc() : p.PROJa(), Rn * PWA * 2);
    if (ph == 2) dump_buf("Pb", layer, is_ctx, grp, p.Pb(), Rn * 512 * 2);
    if (ph == 3) dump_buf("Nb", layer, is_ctx, grp, p.Nb(), Rn * 512 * 2);
    if (ph == 4) dump_buf("Mb", layer, is_ctx, grp, p.Mb(), Rn * 512 * 2);
    if (ph == 5) dump_buf("BG", layer, is_ctx, grp, p.BG(), Rn * NBG * 2);
    if (ph == 6) dump_buf("MERGED", layer, is_ctx, grp, p.MERGED(), Rn * 1024 * 2);
    if (ph == 7) dump_buf("Y", layer, is_ctx, grp, p.Y(), Rn * 1024 * 2);
    if (ph == 8) { dump_buf("H2", layer, is_ctx, grp, p.H(), Rn * 1024 * 2); dump_buf("aff", layer, is_ctx, grp, p.aff(), Rn * 16 * 4); }
}
void emu_dump(const char* dir) {
    char nm[512]; snprintf(nm, sizeof nm, "%s/d_mod.bin", dir);
    FILE* f = fopen(nm, "wb"); fwrite((char*)g_ws + WSL.mod, 1, (size_t)2 * (NB + 1) * 6144 * 4, f); fclose(f);
    snprintf(nm, sizeof nm, "%s/d_ctxs.bin", dir);
    f = fopen(nm, "wb"); fwrite((char*)g_ws + WSL.ctxs, 1, (size_t)NB * CTX * 1024 * 4, f); fclose(f);
}
template <int PH> static void emu_run_phase(const Params& p, int layer, int is_ctx, int grp, int nblocks) {
    emu_launch_lambda([=]() { do_phase<PH>(p, layer, is_ctx, grp, emu_blk->smem); }, nblocks, NTHREADS, LDS_BYTES);
    if (PH >= 0) emu_hook(p, layer, is_ctx, grp, PH);
    printf("phase %d layer %d ctx %d grp %d done\n", PH, layer, is_ctx, grp); fflush(stdout);
}
#define LAUNCH_PHASE(PH) emu_run_phase<PH>(p, layer, is_ctx, grp, nblocks)
#else
#define LAUNCH_PHASE(PH) hipLaunchKernelGGL((k_phase<PH>), dim3(nblocks), dim3(NTHREADS), LDS_BYTES, stream, p, layer, is_ctx, grp)
#define SETATTR(PH) (void)hipFuncSetAttribute((const void*)k_phase<PH>, hipFuncAttributeMaxDynamicSharedMemorySize, LDS_BYTES)
#endif

extern "C" void kernel_launch(void* const* d_in, const int* in_sizes, int n_in, void* d_out, int out_size, void* d_ws, size_t ws_size, hipStream_t stream) {
    (void)in_sizes; (void)n_in; (void)out_size;
    if (ws_size < WSL.total) return;
    Params p = make_params(d_in, d_out, d_ws);
#ifdef CPU_EMU
    g_ws = d_ws;
    memset(d_ws, 0xFF, WSL.total);
    memset((char*)d_ws + WSL.bar, 0, 65536);
    const int nblocks = 16;
#else
    const int nblocks = 256;
#if MK_ONE_LAUNCH
    static int grid = 0;
    if (!grid) {
        (void)hipFuncSetAttribute((const void*)k_mega, hipFuncAttributeMaxDynamicSharedMemorySize, LDS_BYTES);
        int dev = 0, cus = 0, per_cu = 0;
        (void)hipGetDevice(&dev);
        (void)hipDeviceGetAttribute(&cus, hipDeviceAttributeMultiprocessorCount, dev);
        (void)hipOccupancyMaxActiveBlocksPerMultiprocessor(&per_cu, (const void*)k_mega, NTHREADS, LDS_BYTES);
        if (per_cu > 1) per_cu = 1;
        grid = cus * per_cu;
        if (grid > 256) grid = 256;
    }
    if (grid <= 0) return;
    (void)hipMemsetAsync(p.bar(), 0, 65536, stream);
    hipLaunchKernelGGL(k_mega, dim3(grid), dim3(NTHREADS), LDS_BYTES, stream, p);
    return;
#else
    static bool attr_done = false;
    if (!attr_done) { SETATTR(-1); SETATTR(0); SETATTR(1); SETATTR(2); SETATTR(3); SETATTR(4); SETATTR(5); SETATTR(6); SETATTR(7); SETATTR(8); SETATTR(9); SETATTR(10); SETATTR(11); SETATTR(12); attr_done = true; }
#endif
#endif
    { const int layer = 0, is_ctx = 0, grp = 0; LAUNCH_PHASE(-1); }
    for (int layer = 0; layer < 2; ++layer)
        for (int si = 0; si <= NG; ++si) {
            const int is_ctx = si == 0 ? 1 : 0, grp = si == 0 ? 0 : si - 1;
            LAUNCH_PHASE(0); LAUNCH_PHASE(1); LAUNCH_PHASE(2); LAUNCH_PHASE(3);
            if (is_ctx && layer == 1) continue;
            LAUNCH_PHASE(4); LAUNCH_PHASE(5); LAUNCH_PHASE(6); LAUNCH_PHASE(7); LAUNCH_PHASE(8); LAUNCH_PHASE(9); LAUNCH_PHASE(10); LAUNCH_PHASE(11); LAUNCH_PHASE(12);
        }
}
```

```cpp
#ifdef CPU_EMU
#include "emu.h"
#define DYN_LDS(p) char* p = emu_blk->smem
#define WAIT_V(n)
#define WAIT_L(n)
#define HIDE(v)
#define CBAR()
#else
#include <hip/hip_runtime.h>
#define DYN_LDS(p) extern __shared__ __attribute__((aligned(16))) char p[]
#define WAIT_V(n) asm volatile("s_waitcnt vmcnt(" #n ")" ::: "memory")
#define WAIT_L(n) asm volatile("s_waitcnt lgkmcnt(" #n ")" ::: "memory")
#define HIDE(v) asm volatile("" : "+v"(v))
#define CBAR() asm volatile("" ::: "memory")
#endif
#include <stdint.h>
#include <stddef.h>

#ifndef CFG_B
#define CFG_B 32
#define CFG_ROWS 32
#define CFG_CTX 256
#define CFG_G 16
#endif
#ifndef MK_ONE_LAUNCH
#define MK_ONE_LAUNCH 1
#endif

#define DEV __device__ __forceinline__
typedef short s16x4 __attribute__((ext_vector_type(4)));
#ifdef CPU_EMU
#define TR16(ptr) emu_tr16((const void*)(ptr))
#else
typedef __attribute__((address_space(3))) s16x4 lds_s16x4;
#define TR16(ptr) __builtin_amdgcn_ds_read_tr16_b64_v4i16((lds_s16x4*)(ptr))
#endif
#ifdef CPU_EMU
#define TID() (threadIdx.x)
#else
#define TID() ({ int t_ = threadIdx.x; asm volatile("" : "+v"(t_)); t_; })
#endif

typedef unsigned short bf16_t;
typedef short bf16x8 __attribute__((ext_vector_type(8)));
typedef float f32x4 __attribute__((ext_vector_type(4)));
typedef unsigned u32x2 __attribute__((ext_vector_type(2)));
typedef unsigned u32x4 __attribute__((ext_vector_type(4)));

namespace {
constexpr int D = 1024, NB = CFG_B, ROWS = CFG_ROWS, SEQ = ROWS * 64, CTX = CFG_CTX, G = CFG_G, NG = NB / G;
constexpr int RL = G * SEQ, RC = NB * CTX, RMAX = RL > RC ? RL : RC;
constexpr int PWA = 3840, NBG = 3072, PWT = PWA + NBG, PWSRC = 6672, C_SPLIT = 3600;
constexpr int C_QM = 0, C_KM = 256, C_PU = 512, C_GM = 1024, C_PADA = 1040, C_F8 = 1280, C_QN = 1280, C_KN = 1792, C_VM = 2304, C_OM = 2816, C_VN = 3328;
constexpr int proj_col(int n) { return n < 512 ? n : n < 1536 ? n + 1792 : n < 1552 ? n - 512 : n < 2064 ? n - 1040 : n < 3088 ? n - 784 : n + 240; }
static_assert(proj_col(512) == C_VM && proj_col(1024) == C_OM && proj_col(1536) == C_GM && proj_col(1552) == C_PU && proj_col(2064) == C_QN && proj_col(2576) == C_KN && proj_col(3088) == C_VN && proj_col(3599) == PWA - 1, "projection column map");
constexpr int NTBL = SEQ / 128, NTBC = CTX / 128;
constexpr int ilog2(int x) { return x <= 1 ? 0 : 1 + ilog2(x >> 1); }
constexpr int LGSEQ = ilog2(SEQ), LGCTX = ilog2(CTX);
static_assert((1 << LGSEQ) == SEQ && (1 << LGCTX) == CTX, "sequence lengths must be powers of two");
constexpr int cdiv(int a, int b) { return (a + b - 1) / b; }
constexpr int RPE_L = cdiv(G * (SEQ / 8), 256) * 256, RPE_C = cdiv(NB * (CTX / 8), 256) * 256, RPE_MAX = RPE_L > RPE_C ? RPE_L : RPE_C;
constexpr int NSLOT = 16 * RPE_MAX;
constexpr int NTHREADS = 512;
constexpr int GT_MAXU = 10;
constexpr int LDS_BYTES = 131072 + 256 + GT_MAXU * 1024;
constexpr int NST_L = G * 4 * 2 * NTBL, NST_C = NB * 4 * 2 * NTBC, NST = NST_L > NST_C ? NST_L : NST_C;
constexpr int NCI = NB * 4 * 2;
constexpr float RMS_EPS = 1e-6f;

struct WsLayout { size_t bar, WinT, WbT, WoT, WguT, WdT, mod, rope, ctxs, PROJc, CiC, Cin_, Cim, H, H8, PROJa, Sst, Cin, Mb, Pb, Nb, Sn, Ssc, Cn, Cm, aff, slot_token, slot_gate, token_slots, HID, YE, BG, MERGED, Y, total; };
constexpr size_t al(size_t x) { return (x + 255) / 256 * 256; }
constexpr size_t smax(size_t a, size_t b) { return a > b ? a : b; }
constexpr WsLayout make_layout() {
    WsLayout L{}; size_t o = 0;
    L.bar = o; o += al(65536);
    L.WinT = o; o += al((size_t)2 * PWT * 1024 * 2);
    L.WbT = o; o += al((size_t)2 * 3 * 1024 * 512 * 2);
    L.WoT = o; o += al((size_t)2 * 1024 * 1024 * 2);
    L.WguT = o; o += al((size_t)2 * 16 * 2048 * 1024 * 2);
    L.WdT = o; o += al((size_t)2 * 16 * 1024 * 1024 * 2);
    L.mod = o; o += al((size_t)2 * (NB + 1) * 6144 * 4);
    L.rope = o; o += al((size_t)(ROWS + 64) * 16 * 2 * 4);
    L.ctxs = o; o += al((size_t)NB * CTX * 1024 * 4);
    L.PROJc = o; o += al((size_t)RC * PWA * 2);
    L.CiC = o; o += al((size_t)NCI * 8192 * 4);
    L.Cin_ = o; o += al((size_t)NCI * 64 * 4);
    L.Cim = o; o += al((size_t)NCI * 4 * 4);
    L.H = o; o += al((size_t)RMAX * 1024 * 2);
    L.H8 = o; o += al((size_t)RMAX * 1024);
    const size_t x0 = o;
    L.PROJa = o; o += al((size_t)RMAX * PWA * 2);
    L.Sst = o; o += al((size_t)NST * 8192 * 4);
    L.Cin = o; o += al((size_t)NST * 8192 * 2);
    const size_t hid = al((size_t)NSLOT * 1024 * 2);
    o = x0 + smax(o - x0, 2 * hid);
    L.BG = x0; L.HID = x0; L.YE = x0 + hid;
    L.Mb = o; o += al((size_t)RMAX * 512 * 2);
    L.Pb = o; o += al((size_t)RMAX * 512 * 2);
    L.Nb = o; o += al((size_t)RMAX * 512 * 2);
    L.MERGED = L.H; L.Y = L.Mb;
    L.Sn = o; o += al((size_t)NST * 64 * 4);
    L.Ssc = o; o += al((size_t)NST * 4 * 4);
    L.Cn = o; o += al((size_t)NST * 64 * 4);
    L.Cm = o; o += al((size_t)NST * 4 * 4);
    L.aff = o; o += al((size_t)RMAX * 16 * 4);
    L.slot_token = o; o += al((size_t)NSLOT * 4);
    L.slot_gate = o; o += al((size_t)NSLOT * 4);
    L.token_slots = o; o += al((size_t)RMAX * 16 * 4);
    L.total = o;
    return L;
}
constexpr WsLayout WSL = make_layout();
static_assert((size_t)RMAX * NBG * 2 <= (size_t)RMAX * PWA * 2, "BG overlay must fit in PROJa");
static_assert(CFG_B != 32 || WSL.total <= ((size_t)1 << 30), "workspace budget");

struct Params {
    const float *x, *c, *ctx, *c_ctx, *norm_gain, *ada_w, *ada_b, *w_in, *gate_bias, *pool_w, *pool_scale, *rpb, *w_branch, *w_out, *router_w, *w_gate, *w_up, *w_down;
    float* out;
    char* ws;
#ifdef CPU_EMU
#define WSF(T, name) __device__ __host__ __forceinline__ T* name() const { return (T*)(ws + WSL.name); }
#else
#if defined(__HIP_DEVICE_COMPILE__)
#define WSF(T, name) __device__ __host__ __forceinline__ T* name() const { char* w_ = ws; asm volatile("" : "+s"(w_)); return (T*)(__attribute__((address_space(1))) T*)(w_ + WSL.name); }
#else
#define WSF(T, name) __device__ __host__ __forceinline__ T* name() const { return (T*)(ws + WSL.name); }
#endif
#endif
    WSF(unsigned, bar) WSF(bf16_t, WinT) WSF(bf16_t, WbT) WSF(bf16_t, WoT) WSF(bf16_t, WguT) WSF(bf16_t, WdT)
    WSF(float, mod) WSF(float, rope) WSF(float, ctxs) WSF(bf16_t, PROJc) WSF(float, CiC) WSF(float, Cin_) WSF(float, Cim)
    WSF(bf16_t, H) WSF(unsigned char, H8) WSF(bf16_t, PROJa) WSF(float, Sst) WSF(bf16_t, Cin) WSF(bf16_t, Mb) WSF(bf16_t, Pb) WSF(bf16_t, Nb)
    WSF(float, Sn) WSF(float, Ssc) WSF(float, Cn) WSF(float, Cm) WSF(float, aff) WSF(int, slot_token) WSF(float, slot_gate) WSF(int, token_slots)
    WSF(bf16_t, HID) WSF(bf16_t, YE) WSF(bf16_t, BG) WSF(bf16_t, MERGED) WSF(bf16_t, Y)
#undef WSF
};

struct SetDesc { int is_ctx, nrows, samp0, nsamp, lgseq, ntb, cap, rpe; };
DEV SetDesc make_set(int is_ctx, int grp) {
    SetDesc s;
    s.is_ctx = is_ctx;
    if (is_ctx) { s.nrows = RC; s.samp0 = 0; s.nsamp = NB; s.lgseq = LGCTX; s.ntb = NTBC; s.cap = CTX / 8; s.rpe = RPE_C; }
    else { s.nrows = RL; s.samp0 = grp * G; s.nsamp = G; s.lgseq = LGSEQ; s.ntb = NTBL; s.cap = SEQ / 8; s.rpe = RPE_L; }
    return s;
}

#ifdef CPU_EMU
#define GAS
#else
#define GAS __attribute__((address_space(1)))
#endif
template <class T> DEV T ldg(const T* p) { return *(const GAS T*)p; }
template <class T> DEV void stg(T* p, const T& v) { *(GAS T*)p = v; }
DEV float bf2f(bf16_t v) { return __uint_as_float(((unsigned)v) << 16); }
DEV bf16_t f2bf(float f) { unsigned u = __float_as_uint(f); u += 0x7FFFu + ((u >> 16) & 1u); return (bf16_t)(u >> 16); }
#if defined(__HIP_DEVICE_COMPILE__)
typedef __bf16 bf16n2 __attribute__((ext_vector_type(2)));
typedef float f32n2 __attribute__((ext_vector_type(2)));
DEV unsigned pack2(float lo, float hi) { f32n2 v = {lo, hi}; bf16n2 r = __builtin_convertvector(v, bf16n2); return __builtin_bit_cast(unsigned, r); }
#else
DEV unsigned pack2(float lo, float hi) { return (unsigned)f2bf(lo) | ((unsigned)f2bf(hi) << 16); }
#endif
DEV float lo16(unsigned u) { return __uint_as_float(u << 16); }
DEV float hi16(unsigned u) { return __uint_as_float(u & 0xFFFF0000u); }
#if defined(__HIP_DEVICE_COMPILE__)
DEV float frcp(float x) { return __builtin_amdgcn_rcpf(x); }
#else
DEV float frcp(float x) { return 1.0f / x; }
#endif
#if defined(__HIP_DEVICE_COMPILE__)
DEV float sigmoidf_(float x) { return __builtin_amdgcn_rcpf(1.0f + __expf(-x)); }
#else
DEV float sigmoidf_(float x) { return 1.0f / (1.0f + __expf(-x)); }
#endif
DEV float logsigmoidf_(float x) { return fminf(x, 0.0f) - __logf(1.0f + __expf(-fabsf(x))); }
template <int M> DEV float shx(float v) {
#if defined(__HIP_DEVICE_COMPILE__)
    const unsigned u = __builtin_bit_cast(unsigned, v);
    if constexpr (M == 1) return __builtin_bit_cast(float, __builtin_amdgcn_update_dpp(u, u, 0xB1, 0xF, 0xF, false));
    else if constexpr (M == 2) return __builtin_bit_cast(float, __builtin_amdgcn_update_dpp(u, u, 0x4E, 0xF, 0xF, false));
    else if constexpr (M == 4) { const unsigned t = __builtin_amdgcn_update_dpp(u, u, 0x141, 0xF, 0xF, false);
        return __builtin_bit_cast(float, __builtin_amdgcn_update_dpp(t, t, 0x1B, 0xF, 0xF, false)); }
    else if constexpr (M == 8) return __builtin_bit_cast(float, __builtin_amdgcn_update_dpp(u, u, 0x128, 0xF, 0xF, false));
    else if constexpr (M == 16) { const auto r = __builtin_amdgcn_permlane16_swap(u, u, false, false); return __builtin_bit_cast(float, (threadIdx.x & 16) ? r[0] : r[1]); }
    else { const auto r = __builtin_amdgcn_permlane32_swap(u, u, false, false); return __builtin_bit_cast(float, (threadIdx.x & 32) ? r[0] : r[1]); }
#else
    return __shfl_xor(v, M);
#endif
}
DEV float wave_sum(float v) { v += shx<32>(v); v += shx<16>(v); v += shx<8>(v); v += shx<4>(v); v += shx<2>(v); v += shx<1>(v); return v; }
DEV bf16x8 mk8(u32x2 lo, u32x2 hi) { u32x4 v = {lo.x, lo.y, hi.x, hi.y}; return __builtin_bit_cast(bf16x8, v); }
DEV bf16x8 mk8(u32x4 v) { return __builtin_bit_cast(bf16x8, v); }
DEV bf16x8 mk8(s16x4 lo, s16x4 hi) { return __builtin_shufflevector(lo, hi, 0, 1, 2, 3, 4, 5, 6, 7); }
DEV f32x4 mfma16(bf16x8 a, bf16x8 b, f32x4 c) { return __builtin_amdgcn_mfma_f32_16x16x32_bf16(a, b, c, 0, 0, 0); }
DEV unsigned f8enc1(float x) {
    const unsigned sgn = x < 0.f ? 0x80u : 0u; float a = x < 0.f ? -x : x; if (!(a < 448.f)) a = 448.f;
    if (a < 0.015625f) { const int q = (int)(a * 512.f + 0.5f); const float r = a * 512.f; int qq = q; if ((float)q - r == 0.5f && (q & 1)) qq = q - 1; return sgn | (unsigned)qq; }
    int e = 0; float m = a; while (m >= 2.f) { m *= 0.5f; ++e; } while (m < 1.f) { m *= 2.f; --e; }
    const float r = (m - 1.f) * 8.f; int q = (int)(r + 0.5f); if ((float)q - r == 0.5f && (q & 1)) --q;
    if (q == 8) { q = 0; ++e; }
    return sgn | (unsigned)((e + 7) << 3) | (unsigned)q;
}
#if defined(__HIP_DEVICE_COMPILE__)
DEV unsigned f8pack4(float a, float b, float c, float d) {
    a = __builtin_amdgcn_fmed3f(a, -448.f, 448.f); b = __builtin_amdgcn_fmed3f(b, -448.f, 448.f); c = __builtin_amdgcn_fmed3f(c, -448.f, 448.f); d = __builtin_amdgcn_fmed3f(d, -448.f, 448.f);
    int w = 0; w = __builtin_amdgcn_cvt_pk_fp8_f32(a, b, w, false); w = __builtin_amdgcn_cvt_pk_fp8_f32(c, d, w, true); return (unsigned)w; }
#else
DEV unsigned f8pack4(float a, float b, float c, float d) { return f8enc1(a) | (f8enc1(b) << 8) | (f8enc1(c) << 16) | (f8enc1(d) << 24); }
#endif
#ifdef CPU_EMU
DEV f32x4 mfma_f8(bf16x8 a0, bf16x8 a1, bf16x8 b0, bf16x8 b1, f32x4 c) { return emu_mfma_f8(a0, a1, b0, b1, c); }
#else
typedef int i32x4 __attribute__((ext_vector_type(4)));
typedef int i32x8 __attribute__((ext_vector_type(8)));
DEV f32x4 mfma_f8(bf16x8 a0, bf16x8 a1, bf16x8 b0, bf16x8 b1, f32x4 c) {
    const i32x8 A = __builtin_shufflevector(__builtin_bit_cast(i32x4, a0), __builtin_bit_cast(i32x4, a1), 0, 1, 2, 3, 4, 5, 6, 7);
    const i32x8 B = __builtin_shufflevector(__builtin_bit_cast(i32x4, b0), __builtin_bit_cast(i32x4, b1), 0, 1, 2, 3, 4, 5, 6, 7);
    return __builtin_amdgcn_mfma_scale_f32_16x16x128_f8f6f4(A, B, c, 0, 0, 0, 0, 0, 0);
}
#endif
constexpr float F8_WSCALE = 64.0f, F8_WINV = 1.0f / 64.0f;
DEV void store8bf(bf16_t* o, f32x4 a, f32x4 b) { u32x4 v = {pack2(a[0], a[1]), pack2(a[2], a[3]), pack2(b[0], b[1]), pack2(b[2], b[3])}; stg((u32x4*)o, v); }

#ifndef CPU_EMU
#define XB_TMO      128
#define XB_XCNT(j)  (256  + 64 * (j))
#define XB_XSUB(j)  (1280 + 64 * (j))
#define XB_XGEN(j)  (2304 + 64 * (j))
#define XB_TOP      3328
#define XB_TOPGEN   3392
#define XCD_BAR_WORDS 3456
#define XB_SPIN_CAP (1u << 18)
#define LAS __attribute__((address_space(3)))
__device__ __forceinline__ unsigned xb_ld(unsigned* p)              { return __hip_atomic_load(p, __ATOMIC_RELAXED, __HIP_MEMORY_SCOPE_AGENT); }
__device__ __forceinline__ unsigned xb_add(unsigned* p, unsigned v) { return __hip_atomic_fetch_add(p, v, __ATOMIC_RELAXED, __HIP_MEMORY_SCOPE_AGENT); }
__device__ __forceinline__ unsigned xb_xcc_id() { return (unsigned)__builtin_amdgcn_s_getreg((3 << 11) | 20) & 0xFu; }
#define XB_SPIN(cond, bar) do { unsigned _sp = 0; while (cond) { __builtin_amdgcn_s_sleep(1); \
    if ((++_sp & 255u) == 0u) { if (xb_ld(&(bar)[XB_TMO])) break; if (_sp > XB_SPIN_CAP) { atomicAdd(&(bar)[XB_TMO], 1u); break; } } } } while (0)
struct XcdBarrier { unsigned* bar; unsigned x; volatile LAS unsigned* st; };
__device__ __forceinline__ XcdBarrier xcd_barrier_post(unsigned* bar, volatile LAS unsigned* st) {
    XcdBarrier b; b.bar = bar; b.x = xb_xcc_id(); b.st = st;
    if (threadIdx.x == 0) (void)xb_add(&bar[XB_XCNT(b.x)], 1u);
    return b;
}
__device__ __forceinline__ void xcd_barrier_complete(unsigned* bar, unsigned x, unsigned& nloc, unsigned& nx) {
    const unsigned Gd = gridDim.x * gridDim.y * gridDim.z;
    unsigned sum, cnt, mine, sp = 0u;
    for (;;) {
        sum = 0u; cnt = 0u; mine = 0u;
#pragma unroll
        for (unsigned j = 0; j < 16; ++j) { const unsigned c = xb_ld(&bar[XB_XCNT(j)]); sum += c; cnt += (c > 0u) ? 1u : 0u; mine = (j == x) ? c : mine; }
        if (sum == Gd) break;
        __builtin_amdgcn_s_sleep(1);
        if ((++sp & 255u) == 0u) { if (xb_ld(&bar[XB_TMO])) break; if (sp > XB_SPIN_CAP) { atomicAdd(&bar[XB_TMO], 1u); break; } }
    }
    nloc = mine > 0u ? mine : 1u; nx = cnt > 0u ? cnt : 1u;
}
__device__ __forceinline__ void xcd_barrier(const XcdBarrier& b) {
    asm volatile("s_waitcnt vmcnt(0)" ::: "memory");
    __syncthreads();
    if (threadIdx.x == 0) {
        unsigned* bar = b.bar;
        unsigned bx = b.x; asm volatile("" : "+s"(bx));
        __builtin_amdgcn_s_waitcnt(0);
        unsigned nloc = b.st[0], nx = b.st[1];
        if (nloc == 0u) { xcd_barrier_complete(bar, bx, nloc, nx); b.st[0] = nloc; b.st[1] = nx; }
        const unsigned old = xb_add(&bar[XB_XSUB(bx)], 1u);
        const unsigned gen = old / nloc;
        if (old + 1u == (gen + 1u) * nloc) {
            __builtin_amdgcn_fence(__ATOMIC_RELEASE, "agent");
            asm volatile("s_waitcnt vmcnt(0)" ::: "memory");
            const unsigned og = xb_add(&bar[XB_TOP], 1u);
            const unsigned tg = og / nx;
            if (og + 1u == (tg + 1u) * nx) xb_add(&bar[XB_TOPGEN], 1u);
            else XB_SPIN(xb_ld(&bar[XB_TOPGEN]) == tg, bar);
            __builtin_amdgcn_fence(__ATOMIC_ACQUIRE, "agent");
            xb_add(&bar[XB_XGEN(bx)], 1u);
            asm volatile("s_waitcnt vmcnt(0)" ::: "memory");
        } else {
            XB_SPIN(xb_ld(&bar[XB_XGEN(bx)]) == gen, bar);
            __builtin_amdgcn_fence(__ATOMIC_ACQUIRE, "agent");
            asm volatile("s_waitcnt vmcnt(0)" ::: "memory");
        }
    }
    __syncthreads();
}
#endif

constexpr int BK = 64, HALF = 128, HT_BYTES = HALF * BK * 2;
DEV int lds_byte(int r, int c) { int st = (r >> 4) * 2 + (c >> 5), rr = r & 15, cc = c & 31, ob = rr * 64 + cc * 2; return st * 1024 + (ob ^ (((ob >> 9) & 1) << 5)); }
DEV void stage_rc(int b, int& Rr, int& Cc) { int st = b / 1024, sb = b % 1024, swz = sb ^ (((sb >> 9) & 1) << 5); Rr = (st >> 1) * 16 + swz / 64; Cc = (st & 1) * 32 + (swz % 64) / 2; }
DEV int perm32(int rho) { const int n = rho >> 4, i = rho & 15; return 8 * (i >> 2) + 4 * n + (i & 3); }

DEV bool tile_from_L(int L, int nM, int nN, int& pm, int& pn) {
    const int nwg = nM * nN; if (L >= nwg) return false;
    int wgid = L; { const int q = nwg / 8, r = nwg % 8, xcd = wgid % 8, off = wgid / 8; wgid = (xcd < r ? xcd * (q + 1) : r * (q + 1) + (xcd - r) * q) + off; }
    const int nig = 8 * nN, gid = wgid / nig, fm = gid * 8, gsz = (nM - fm) < 8 ? (nM - fm) : 8;
    pm = fm + ((wgid % nig) % gsz); pn = (wgid % nig) / gsz; return true;
}
DEV bool tile_order(int i, int nM, int nN, int& pm, int& pn) { return tile_from_L(i * (int)gridDim.x + (int)blockIdx.x, nM, nN, pm, pn); }
#ifdef CPU_EMU
#define GLDS16(src, dst) __builtin_amdgcn_global_load_lds((const unsigned*)(src), (unsigned*)((dst) + (TID() & 63) * 16), 16, 0, 0)
#else
#define GLDS16(src, dst) __builtin_amdgcn_global_load_lds((const unsigned*)(src), (unsigned*)(dst), 16, 0, 0)
#endif

#define BAR __builtin_amdgcn_s_barrier()
#define SCHED __builtin_amdgcn_sched_barrier(0)
struct GUnit { int pm, pn, aux; };
template <class T> struct is_void_ { static constexpr bool v = false; };
template <> struct is_void_<void> { static constexpr bool v = true; };
template <class Epi> DEV bool call_epi(const Epi& e, const GUnit& u, f32x4 (&acc)[2][2][4][2], int r0, int c0) {
    if constexpr (is_void_<decltype(e(u, acc, r0, c0))>::v) { e(u, acc, r0, c0); return false; } else return e(u, acc, r0, c0);
}
template <bool GATHER, int LDA_, int LDB_, int K_, bool F8 = false, class Sched, class Epi>
DEV void gemm_stream(char* shm, const Sched& S, const Epi& epi) {
#define SA(b, h) (shm + ((b) * 2 + (h)) * HT_BYTES)
#define SB(b, h) (shm + (4 + (b) * 2 + (h)) * HT_BYTES)
#define STG_B(P, bp) do { GLDS16((bp) + voffB, (P) + ldsb0); GLDS16((bp) + voffB + 64 * LDB_, (P) + ldsb0 + 8192); } while (0)
#define STG_A(P, ap, h, gv) do { if (GATHER) { GLDS16((ap) + gv[h][0], (P) + ldsb0); GLDS16((ap) + gv[h][1], (P) + ldsb0 + 8192); } \
    else { GLDS16((ap) + voffA + (h) * 128 * LDA_, (P) + ldsb0); GLDS16((ap) + voffA + ((h) * 128 + 64) * LDA_, (P) + ldsb0 + 8192); } } while (0)
#define LDA(dst, b, h) _Pragma("unroll") for (int m = 0; m < 4; ++m) _Pragma("unroll") for (int k = 0; k < 2; ++k) \
    dst[m][k] = *reinterpret_cast<const bf16x8*>(SA(b, h) + aoff + m * 2048 + k * 1024)
#define LDB(dst, b, h) _Pragma("unroll") for (int n = 0; n < 2; ++n) _Pragma("unroll") for (int k = 0; k < 2; ++k) \
    dst[n][k] = *reinterpret_cast<const bf16x8*>(SB(b, h) + boff + n * 2048 + k * 1024)
#define MMA(ai, bj, At_, Bx_) do { __builtin_amdgcn_s_setprio(1); \
    if constexpr (F8) { _Pragma("unroll") for (int m = 0; m < 4; ++m) _Pragma("unroll") for (int n = 0; n < 2; ++n) \
      acc[ai][bj][m][n] = mfma_f8(Bx_[n][0], Bx_[n][1], At_[m][0], At_[m][1], acc[ai][bj][m][n]); } \
    else { _Pragma("unroll") for (int m = 0; m < 4; ++m) _Pragma("unroll") for (int n = 0; n < 2; ++n) _Pragma("unroll") for (int k = 0; k < 2; ++k) \
      acc[ai][bj][m][n] = mfma16(Bx_[n][k], At_[m][k], acc[ai][bj][m][n]); } \
    __builtin_amdgcn_s_setprio(0); } while (0)
    constexpr int nt = K_ / BK;
    const int tid = TID();
    const int wid = __builtin_amdgcn_readfirstlane(tid >> 6), lane = tid & 63, wr = wid >> 2, wc = wid & 3, fr = lane & 15, fq = lane >> 4;
    const int ldsb0 = wid * 1024;
    int Rr0, Cc0; stage_rc(tid * 16, Rr0, Cc0);
    const int voffA = Rr0 * LDA_ + Cc0;
    const int voffB = ((Rr0 & ~31) + perm32(Rr0 & 31)) * LDB_ + Cc0;
    const int aoff = lds_byte(wr * 64 + fr, fq * 8), boff = lds_byte(wc * 32 + fr, fq * 8);
    GUnit cur, nxt; int ui = 0;
    if (!S.next(0, cur)) return;
    int gc[2][2] = {{0, 0}, {0, 0}};
    int* gtab = (int*)(shm + 131072 + 256);
    if (GATHER) {
        __syncthreads();
        { GUnit u; for (int i = 0; i < GT_MAXU && S.next(i, u); ++i) { if (tid < 256) gtab[i * 256 + tid] = S.grow(u, tid) * LDA_; } }
        __syncthreads();
#pragma unroll
        for (int h = 0; h < 2; ++h)
#pragma unroll
            for (int i = 0; i < 2; ++i) gc[h][i] = gtab[h * 128 + i * 64 + Rr0] + Cc0;
    }
    f32x4 acc[2][2][4][2];
#pragma unroll
    for (int a = 0; a < 2; ++a)
#pragma unroll
        for (int b = 0; b < 2; ++b)
#pragma unroll
            for (int m = 0; m < 4; ++m)
#pragma unroll
                for (int n = 0; n < 2; ++n) acc[a][b][m][n] = (f32x4){0.f, 0.f, 0.f, 0.f};
    bf16x8 At[4][2], B0[2][2], B1[2][2];
    const bf16_t* cA = S.a_base(cur); const bf16_t* cB = S.b_base(cur);
    STG_B(SB(0, 0), cB); STG_A(SA(0, 0), cA, 0, gc); STG_B(SB(0, 1), cB + 128 * LDB_); STG_A(SA(0, 1), cA, 1, gc);
    if (wr == 1) BAR;
    WAIT_V(4); BAR;
    STG_B(SB(1, 0), cB + BK); STG_A(SA(1, 0), cA + BK, 0, gc); STG_B(SB(1, 1), cB + 128 * LDB_ + BK);
    WAIT_V(6); BAR;
    for (;;) {
        const bool has_next = S.next(ui + 1, nxt);
        const bf16_t* nA = has_next ? S.a_base(nxt) : cA; const bf16_t* nB = has_next ? S.b_base(nxt) : cB;
#pragma unroll 1
        for (int t = 0; t < nt; t += 2) {
            const bool last = (t == nt - 2);
            const bf16_t* a1 = cA + (t + 1) * BK;
            const bf16_t* a2 = last ? nA : cA + (t + 2) * BK; const bf16_t* b2 = last ? nB : cB + (t + 2) * BK;
            const bf16_t* a3 = a2 + BK; const bf16_t* b3 = b2 + BK;
            LDB(B0, 0, 0); SCHED; LDA(At, 0, 0); STG_A(SA(1, 1), a1, 1, gc);
            if (GATHER && last && has_next) {
#pragma unroll
                for (int h = 0; h < 2; ++h)
#pragma unroll
                    for (int i = 0; i < 2; ++i) gc[h][i] = gtab[(ui + 1) * 256 + h * 128 + i * 64 + Rr0] + Cc0; }
            WAIT_L(8); BAR; WAIT_L(0); MMA(0, 0, At, B0); BAR; SCHED;
            LDB(B1, 0, 1); STG_B(SB(0, 0), b2);
            BAR; WAIT_L(0); MMA(0, 1, At, B1); BAR;
            LDA(At, 0, 1); STG_A(SA(0, 0), a2, 0, gc);
            BAR; WAIT_L(0); MMA(1, 0, At, B0); BAR; SCHED;
            STG_B(SB(0, 1), b2 + 128 * LDB_);
            WAIT_V(6); BAR; MMA(1, 1, At, B1); BAR;
            LDB(B0, 1, 0); SCHED; LDA(At, 1, 0); STG_A(SA(0, 1), a2, 1, gc);
            WAIT_L(8); BAR; WAIT_L(0); MMA(0, 0, At, B0); BAR; SCHED;
            LDB(B1, 1, 1); STG_B(SB(1, 0), b3);
            BAR; WAIT_L(0); MMA(0, 1, At, B1); BAR;
            LDA(At, 1, 1); STG_A(SA(1, 0), a3, 0, gc);
            BAR; WAIT_L(0); MMA(1, 0, At, B0); BAR; SCHED;
            STG_B(SB(1, 1), b3 + 128 * LDB_);
            WAIT_V(6); BAR; MMA(1, 1, At, B1); BAR;
        }
        bool keep = false;
        {
            const int tz = TID(); const int wz = tz >> 6, lz = tz & 63, wrz = wz >> 2, wcz = wz & 3, frz = lz & 15, fqz = lz >> 4;
            keep = call_epi(epi, cur, acc, wrz * 64 + frz, wcz * 32 + 8 * fqz);
        }
        if (!has_next) break;
        if (!keep) {
#pragma unroll
            for (int a = 0; a < 2; ++a)
#pragma unroll
                for (int b = 0; b < 2; ++b)
#pragma unroll
                    for (int m = 0; m < 4; ++m)
#pragma unroll
                        for (int n = 0; n < 2; ++n) acc[a][b][m][n] = (f32x4){0.f, 0.f, 0.f, 0.f};
        }
        cur = nxt; cA = nA; cB = nB; ++ui;
    }
    WAIT_V(0);
    if (wr == 0) BAR;
    BAR;
#undef SA
#undef SB
#undef STG_A
#undef STG_B
#undef LDA
#undef LDB
#undef MMA
}

constexpr int J_IN = 16 * 27, J_WB = 2 * 8 * 4, J_WO = 16 * 4, J_GU = 16 * 2 * 64, J_DN = 16 * 64, J_FOLD = 8 * 16, J_PAD = 1;
constexpr int N_MODJOBS = 2 * 96;

constexpr int J_BIG = J_IN + J_WB + J_WO + J_GU + J_DN;
struct WJob { const float* src; bf16_t* dst; int ldsrc, lddst, nvalid, k0, n0, mode, gu_which, f8; };
DEV WJob wjob_decode(const Params& p, int l, int j) {
    WJob w; w.ldsrc = 1024; w.lddst = 1024; w.nvalid = 256; w.mode = 0; w.gu_which = 0; w.f8 = 0;
    if (j < J_IN) { const int kt = j / 27, nb = j % 27; w.k0 = kt * 64; w.n0 = nb * 256; w.src = p.w_in + (size_t)l * 1024 * PWSRC; w.ldsrc = PWSRC; w.nvalid = PWSRC - w.n0; w.dst = p.WinT() + (size_t)l * PWT * 1024; w.mode = 3; }
    else if ((j -= J_IN) < J_WB) { const int bi = (j / 32) * 2, jj = j % 32, kt = jj / 4, nb = jj % 4; w.k0 = kt * 64; w.n0 = nb * 256;
        w.src = p.w_branch + ((size_t)l * 3 + bi) * 512 * 1024; w.dst = p.WbT() + ((size_t)l * 3 + bi) * 1024 * 512; w.lddst = 512; }
    else if ((j -= J_WB) < J_WO) { const int kt = j / 4, nb = j % 4; w.k0 = kt * 64; w.n0 = nb * 256; w.src = p.w_out + (size_t)l * 1024 * 1024; w.dst = p.WoT() + (size_t)l * 1024 * 1024; }
    else if ((j -= J_WO) < J_GU) { const int e = j / 128, jj = j % 128; w.gu_which = jj / 64; const int j3 = jj % 64, kt = j3 / 4, nb = j3 % 4; w.k0 = kt * 64; w.n0 = nb * 256;
        w.src = (w.gu_which ? p.w_up : p.w_gate) + ((size_t)l * 16 + e) * 1024 * 1024; w.dst = p.WguT() + ((size_t)l * 16 + e) * 2048 * 512; w.mode = 1; w.f8 = 1; }
    else { j -= J_GU; const int e = j / 64, jj = j % 64, kt = jj / 4, nb = jj % 4; w.k0 = kt * 64; w.n0 = nb * 256;
        w.src = p.w_down + ((size_t)l * 16 + e) * 1024 * 1024; w.dst = p.WdT() + ((size_t)l * 16 + e) * 1024 * 512; w.f8 = 1; }
    return w;
}
constexpr int WT_LD = 260;
DEV void wjob_load(const WJob& w, int tid, f32x4 (&vv)[8]) {
#pragma unroll
    for (int i = 0; i < 8; ++i) { const int idx = i * 512 + tid, r = idx >> 6, c = (idx & 63) * 4; int col = w.n0 + c; col = col > w.ldsrc - 4 ? w.ldsrc - 4 : col;
        vv[i] = ldg((const f32x4*)(w.src + (size_t)(w.k0 + r) * w.ldsrc + col)); }
}
DEV void wjob_finish(const WJob& w, int tid, const f32x4 (&vv)[8], float* tile) {
    __syncthreads();
#pragma unroll
    for (int i = 0; i < 8; ++i) { const int idx = i * 512 + tid, r = idx >> 6, c = (idx & 63) * 4; *(f32x4*)(tile + r * WT_LD + c) = vv[i]; }
    __syncthreads();
#pragma unroll
    for (int q = 0; q < 4; ++q) {
        const int item = q * 512 + tid, nrow = item >> 3, kc = (item & 7) * 8;
        float v[8];
#pragma unroll
        for (int jj = 0; jj < 8; ++jj) v[jj] = tile[(kc + jj) * WT_LD + nrow];
        const int n = w.n0 + nrow;
        int drow = n; bool f8 = w.f8 != 0; size_t f8base = 0;
        if (w.mode == 1) drow = (n >> 7) * 256 + w.gu_which * 128 + (n & 127);
        if (w.mode == 3) {
            if (n >= C_SPLIT) { f8 = true; f8base = (size_t)PWA * 2048; drow = n - C_SPLIT; }
            else { drow = proj_col(n); if (drow >= C_F8) { f8 = true; f8base = (size_t)C_F8 * 2048; drow -= C_F8; } } }
        if (f8) { const u32x2 o = {f8pack4(v[0] * F8_WSCALE, v[1] * F8_WSCALE, v[2] * F8_WSCALE, v[3] * F8_WSCALE), f8pack4(v[4] * F8_WSCALE, v[5] * F8_WSCALE, v[6] * F8_WSCALE, v[7] * F8_WSCALE)};
            if (nrow < w.nvalid) stg((u32x2*)((unsigned char*)w.dst + f8base + (size_t)drow * 1024 + w.k0 + kc), o); }
        else if (nrow < w.nvalid) { u32x4 o = {pack2(v[0], v[1]), pack2(v[2], v[3]), pack2(v[4], v[5]), pack2(v[6], v[7])};
            stg((u32x4*)(w.dst + (size_t)drow * w.lddst + w.k0 + kc), o); }
    }
}
DEV void pro_small_job(const Params& p, int l, int j, char* shm) {
    float* tile = (float*)shm;
    const int tid = TID();
    if (j < J_FOLD) {
        const int kt = j / 16, ntl = j % 16, k0 = kt * 64, n0 = ntl * 64; const int fg = k0 / 128;
        const float* wb1 = p.w_branch + ((size_t)l * 3 + 1) * 512 * 1024;
        const float* pw = p.pool_w + ((size_t)l * 4 + fg) * 128 * 128; const float* ps = p.pool_scale + (size_t)l * 512 + fg * 128;
        const int c = tid & 63, rq = tid >> 6;
        float accv[8];
#pragma unroll
        for (int i = 0; i < 8; ++i) accv[i] = 0.f;
        for (int d = 0; d < 128; ++d) { const float wv = ldg(wb1 + (size_t)(fg * 128 + d) * 1024 + n0 + c) * ldg(ps + d);
#pragma unroll
            for (int i = 0; i < 8; ++i) accv[i] += ldg(pw + (size_t)(k0 - fg * 128 + rq * 8 + i) * 128 + d) * wv; }
        __syncthreads();
#pragma unroll
        for (int i = 0; i < 8; ++i) tile[(rq * 8 + i) * WT_LD + c] = accv[i];
        __syncthreads();
        const int nrow = tid >> 3, kc = (tid & 7) * 8; float v[8];
#pragma unroll
        for (int jj = 0; jj < 8; ++jj) v[jj] = tile[(kc + jj) * WT_LD + nrow];
        u32x4 o = {pack2(v[0], v[1]), pack2(v[2], v[3]), pack2(v[4], v[5]), pack2(v[6], v[7])};
        stg((u32x4*)(p.WbT() + ((size_t)l * 3 + 1) * 1024 * 512 + (size_t)(n0 + nrow) * 512 + k0 + kc), o);
    } else {
        bf16_t* d0 = p.WinT() + (size_t)l * PWT * 1024 + (size_t)C_PADA * 1024;
        for (int i = tid; i < (C_F8 - C_PADA) * 1024 / 8; i += NTHREADS) stg((u32x4*)(d0 + (size_t)i * 8), (u32x4){0u, 0u, 0u, 0u});
    }
}

DEV void pro_mod_job(const Params& p, int job, char* shm) {
    float* sv = (float*)shm;
    const int tid = TID(), l = job / 96, col0 = (job % 96) * 64;
    const int c = tid & 63, kp = tid >> 6;
    float acc[NB + 1];
#pragma unroll
    for (int v = 0; v <= NB; ++v) acc[v] = 0.f;
    for (int half = 0; half < 2; ++half) {
        __syncthreads();
        for (int idx = tid; idx < (NB + 1) * 512; idx += 512) { const int v = idx >> 9, k = idx & 511;
            const float s = (v < NB) ? ldg(p.c + (size_t)v * 1024 + half * 512 + k) : ldg(p.c_ctx + half * 512 + k);
            sv[idx] = s * sigmoidf_(s); }
        __syncthreads();
        for (int kk = 0; kk < 64; ++kk) { const int k = kp * 64 + kk;
            const float w = ldg(p.ada_w + ((size_t)l * 1024 + half * 512 + k) * 6144 + col0 + c);
#pragma unroll
            for (int v = 0; v <= NB; ++v) acc[v] += sv[v * 512 + k] * w; }
    }
    __syncthreads();
    float* red = (float*)shm;
#pragma unroll
    for (int v = 0; v <= NB; ++v) red[(kp * (NB + 1) + v) * 64 + c] = acc[v];
    __syncthreads();
    for (int idx = tid; idx < (NB + 1) * 64; idx += 512) { const int v = idx >> 6, cc = idx & 63; float s = 0.f;
#pragma unroll
        for (int q = 0; q < 8; ++q) s += red[(q * (NB + 1) + v) * 64 + cc];
        stg(p.mod() + ((size_t)l * (NB + 1) + v) * 6144 + col0 + cc, s + ldg(p.ada_b + (size_t)l * 6144 + col0 + cc)); }
}

DEV void phase_prologue(const Params& p, char* shm) {
    const int tid = TID();
    const int nsmall = N_MODJOBS + 1 + 2 * (J_FOLD + J_PAD);
    for (int job = blockIdx.x; job < nsmall; job += gridDim.x) {
        if (job < N_MODJOBS) pro_mod_job(p, job, shm);
        else if (job == N_MODJOBS) {
            for (int idx = tid; idx < (ROWS + 64) * 16; idx += NTHREADS) { const int pos = idx >> 4, i = idx & 15;
                const float pv = (float)(pos < ROWS ? pos : pos - ROWS);
                const float inv = powf(10000.0f, -(float)(2 * i) / 32.0f);
                const float a = pv * inv; stg(p.rope() + idx * 2, cosf(a)); stg(p.rope() + idx * 2 + 1, sinf(a)); }
        } else { const int sj = job - N_MODJOBS - 1; pro_small_job(p, sj / (J_FOLD + J_PAD), sj % (J_FOLD + J_PAD), shm); }
    }
    float* tile = (float*)shm;
    const int nbig = 2 * J_BIG;
    int job = blockIdx.x;
    if (job >= nbig) return;
    WJob wc = wjob_decode(p, job / J_BIG, job % J_BIG), wn = wc;
    f32x4 vc[8], vn[8];
    wjob_load(wc, tid, vc);
    for (; job < nbig; job += gridDim.x) {
        const int jn = job + gridDim.x;
        if (jn < nbig) { wn = wjob_decode(p, jn / J_BIG, jn % J_BIG); wjob_load(wn, tid, vn); }
        wjob_finish(wc, tid, vc, tile);
        wc = wn;
#pragma unroll
        for (int i = 0; i < 8; ++i) vc[i] = vn[i];
    }
}

DEV const float* xsrc_base(const Params& p, const SetDesc& sd, int layer) {
    return (sd.is_ctx ? (layer == 0 ? p.ctx : (const float*)p.ctxs()) : (layer == 0 ? p.x : (const float*)p.out)) + (((size_t)sd.samp0) << sd.lgseq) * 1024;
}
DEV float* xdst_base(const Params& p, const SetDesc& sd) { return (sd.is_ctx ? p.ctxs() : p.out) + (((size_t)sd.samp0) << sd.lgseq) * 1024; }
DEV const float* mod_row(const Params& p, const SetDesc& sd, int layer, int row) {
    return p.mod() + ((size_t)layer * (NB + 1) + (sd.is_ctx ? NB : sd.samp0 + (row >> sd.lgseq))) * 6144;
}
DEV bf16_t* proj_buf(const Params& p, const SetDesc& sd) { return sd.is_ctx ? p.PROJc() : p.PROJa(); }

DEV void stage_params(float* par, const float* v0, const float* v1, const float* v2, const float* v3, const float* v4) {
    const int tid = TID();
    const float* src[5] = {v0, v1, v2, v3, v4};
#pragma unroll
    for (int k = 0; k < 5; ++k) if (src[k]) { for (int i = tid; i < 1024; i += NTHREADS) par[k * 1024 + i] = ldg(src[k] + i); }
}
DEV void phase_norm1(const Params& p, const SetDesc& sd, int layer, char* shm) {
    const int tid = TID(), lane = tid & 63, wv = tid >> 6;
    const float* g0 = p.norm_gain + ((size_t)layer * 4 + 0) * 1024;
    const float* xb = xsrc_base(p, sd, layer);
    const int stride = 8; const int rpb_ = (sd.nrows + (int)gridDim.x - 1) / (int)gridDim.x; const int row_end = min(sd.nrows, ((int)blockIdx.x + 1) * rpb_);
    int row = (int)blockIdx.x * rpb_ + wv;
    float* par = (float*)shm;
    __syncthreads();
    { const float* mdb = mod_row(p, sd, layer, min((int)blockIdx.x * rpb_, sd.nrows - 1)); stage_params(par, g0, mdb, mdb + 1024, nullptr, nullptr); }
    __syncthreads();
    f32x4 cur[4], nxt[4];
    if (row < row_end) {
#pragma unroll
        for (int i = 0; i < 4; ++i) cur[i] = ldg((const f32x4*)(xb + (size_t)row * 1024 + (i >> 1) * 512 + lane * 8 + (i & 1) * 4)); }
    for (; row < row_end; row += stride) {
        const int rn = row + stride;
        if (rn < row_end) {
#pragma unroll
            for (int i = 0; i < 4; ++i) nxt[i] = ldg((const f32x4*)(xb + (size_t)rn * 1024 + (i >> 1) * 512 + lane * 8 + (i & 1) * 4)); }
        const float* md = mod_row(p, sd, layer, row);
        float ss = 0.f;
#pragma unroll
        for (int i = 0; i < 4; ++i)
#pragma unroll
            for (int j = 0; j < 4; ++j) ss += cur[i][j] * cur[i][j];
        ss = wave_sum(ss);
        const float rstd = rsqrtf(ss * (1.0f / 1024.0f) + RMS_EPS);
#pragma unroll
        for (int hlf = 0; hlf < 2; ++hlf) { const int c0 = hlf * 512 + lane * 8; float o[8];
#pragma unroll
            for (int j = 0; j < 8; ++j) o[j] = cur[hlf * 2 + (j >> 2)][j & 3] * rstd * par[c0 + j] * (1.0f + par[2048 + c0 + j]) + par[1024 + c0 + j];
            u32x4 ov = {pack2(o[0], o[1]), pack2(o[2], o[3]), pack2(o[4], o[5]), pack2(o[6], o[7])};
            stg((u32x4*)(p.H() + (size_t)row * 1024 + c0), ov);
            const u32x2 o8 = {f8pack4(o[0], o[1], o[2], o[3]), f8pack4(o[4], o[5], o[6], o[7])};
            stg((u32x2*)(p.H8() + (size_t)row * 1024 + c0), o8); }
#pragma unroll
        for (int i = 0; i < 4; ++i) cur[i] = nxt[i];
    }
}

struct SchedPlain {
    const bf16_t* A; const bf16_t* Bt; int nM, nN, lda256, ldb256;
    DEV bool next(int i, GUnit& u) const { u.aux = 0; return tile_order(i, nM, nN, u.pm, u.pn); }
    DEV const bf16_t* a_base(const GUnit& u) const { return A + (size_t)u.pm * lda256; }
    DEV const bf16_t* b_base(const GUnit& u) const { return Bt + (size_t)u.pn * ldb256; }
    DEV int grow(const GUnit&, int) const { return 0; }
};
struct SchedPlainT : SchedPlain {
    int split_base = -1;
    DEV bool next(int i, GUnit& u) const { u.aux = 0; const int G_ = (int)gridDim.x, b = (int)blockIdx.x; int L = i * G_ + b;
        if (split_base >= 0 && i >= split_base) { if (b < G_ / 2 || i >= split_base + 2) return false; L = split_base * G_ + (i - split_base) * (G_ / 2) + (b - G_ / 2); }
        return tile_from_L(L, nM, nN, u.pm, u.pn); }
    DEV const bf16_t* a_base(const GUnit&) const { return A; }
    DEV int grow(const GUnit& u, int i) const { return u.pm * 256 + i; }
};
DEV void phase_proj_a(const Params& p, const SetDesc& sd, int layer, char* shm) {
    bf16_t* pb = proj_buf(p, sd);
    {
        SchedPlain S; S.A = p.H(); S.Bt = p.WinT() + (size_t)layer * PWT * 1024; S.nM = sd.nrows / 256; S.nN = C_F8 / 256; S.lda256 = 256 * 1024; S.ldb256 = 256 * 1024;
        gemm_stream<false, 1024, 1024, 1024>(shm, S, [=](const GUnit& u, const f32x4 (&acc)[2][2][4][2], int r0, int c0) {
#pragma unroll
            for (int ai = 0; ai < 2; ++ai)
#pragma unroll
                for (int m = 0; m < 4; ++m) { bf16_t* o = pb + ((size_t)u.pm * 256 + r0 + ai * 128 + m * 16) * PWA + u.pn * 256 + c0;
                    store8bf(o, acc[ai][0][m][0], acc[ai][0][m][1]); store8bf(o + 128, acc[ai][1][m][0], acc[ai][1][m][1]); } });
    }
    {
        SchedPlainT S; S.A = (const bf16_t*)p.H8(); S.Bt = p.WinT() + (size_t)layer * PWT * 1024 + (size_t)C_F8 * 1024; S.nM = sd.nrows / 256; S.nN = (PWA - C_F8) / 256; S.lda256 = 256 * 512; S.ldb256 = 256 * 512;
        { const int G_ = (int)gridDim.x, T1 = S.nM * (C_F8 / 256), T2 = S.nM * S.nN; if ((G_ & 1) == 0 && (T1 % G_) * 2 == G_ && T2 % G_ == 0 && T2 / G_ >= 1) S.split_base = T2 / G_ - 1; }
        gemm_stream<true, 512, 512, 512, true>(shm, S, [=](const GUnit& u, const f32x4 (&acc)[2][2][4][2], int r0, int c0) {
#pragma unroll
            for (int ai = 0; ai < 2; ++ai)
#pragma unroll
                for (int m = 0; m < 4; ++m) { bf16_t* o = pb + ((size_t)u.pm * 256 + r0 + ai * 128 + m * 16) * PWA + C_F8 + u.pn * 256 + c0;
                    store8bf(o, acc[ai][0][m][0] * F8_WINV, acc[ai][0][m][1] * F8_WINV); store8bf(o + 128, acc[ai][1][m][0] * F8_WINV, acc[ai][1][m][1] * F8_WINV); } });
    }
}
DEV unsigned gate4u8(f32x4 v) {
    unsigned w = 0;
#pragma unroll
    for (int j = 0; j < 4; ++j) w |= (unsigned)fmaxf(sigmoidf_(v[j] * F8_WINV) * 255.0f + 0.5f, 1.0f) << (8 * j);
    return w;
}
DEV float u8f(unsigned w, int j) { return (float)((w >> (8 * j)) & 0xFFu); }
DEV f32x4 sig4(f32x4 v) { f32x4 r; r[0] = sigmoidf_(v[0]); r[1] = sigmoidf_(v[1]); r[2] = sigmoidf_(v[2]); r[3] = sigmoidf_(v[3]); return r; }
DEV void phase_proj_b(const Params& p, const SetDesc& sd, int layer, char* shm) {
    SchedPlainT S; S.A = (const bf16_t*)p.H8(); S.Bt = p.WinT() + (size_t)layer * PWT * 1024 + (size_t)PWA * 1024; S.nM = sd.nrows / 256; S.nN = NBG / 256; S.lda256 = 256 * 512; S.ldb256 = 256 * 512;
    unsigned char* bg = (unsigned char*)p.BG();
    gemm_stream<true, 512, 512, 512, true>(shm, S, [=](const GUnit& u, const f32x4 (&acc)[2][2][4][2], int r0, int c0) {
#pragma unroll
        for (int ai = 0; ai < 2; ++ai)
#pragma unroll
            for (int m = 0; m < 4; ++m) { unsigned char* o = bg + ((size_t)u.pm * 256 + r0 + ai * 128 + m * 16) * NBG + u.pn * 256 + c0;
#pragma unroll
                for (int hf = 0; hf < 2; ++hf) { const u32x2 gv = {gate4u8(acc[ai][hf][m][0]), gate4u8(acc[ai][hf][m][1])}; stg((u32x2*)(o + hf * 128), gv); } } });
}

DEV void gate_scan(const bf16_t* prow, int h, const float* gbias, float* ga, float* gb, float* gpm, float* gtot, float* tmp) {
    const int tid = TID(), lane = tid & 63, w = tid >> 6;
    float b = 0.f, a = 0.f, pm = 0.f; int d = 0, tok = 0;
    if (tid < 256) {
        d = tid >> 7; const int i = tid & 127; tok = d ? 127 - i : i;
        const float gi = bf2f(ldg(prow + (size_t)tok * PWA + C_GM + (2 * d) * 4 + h)) + ldg(gbias + (2 * d) * 4 + h);
        const float gf = bf2f(ldg(prow + (size_t)tok * PWA + C_GM + (2 * d + 1) * 4 + h)) + ldg(gbias + (2 * d + 1) * 4 + h);
        b = logsigmoidf_(gf);
#pragma unroll
        for (int o = 1; o < 64; o <<= 1) { const float t = __shfl_up(b, o); if (lane >= o) b += t; }
        if (lane == 63) tmp[w] = b;
        a = gi;
    }
    __syncthreads();
    if (tid < 256) {
        if (w & 1) b += tmp[w - 1];
        a -= b; pm = a;
#pragma unroll
        for (int o = 1; o < 64; o <<= 1) { const float t = __shfl_up(pm, o); if (lane >= o) pm = fmaxf(pm, t); }
        if (lane == 63) tmp[8 + w] = pm;
    }
    __syncthreads();
    if (tid < 256) {
        if (w & 1) pm = fmaxf(pm, tmp[8 + w - 1]);
        ga[d * 128 + tok] = a; gb[d * 128 + tok] = b; gpm[d * 128 + tok] = pm;
        if ((tid & 127) == 127) { gtot[d * 2] = b; gtot[d * 2 + 1] = pm; }
    }
    __syncthreads();
}

DEV void load_rope_chunk(const bf16_t* hp, int cidx, bool latent, int tl, const float* rope, float scale, float* o) {
    const u32x4 m = ldg((const u32x4*)(hp + cidx * 8));
    float x[8] = {lo16(m.x), hi16(m.x), lo16(m.y), hi16(m.y), lo16(m.z), hi16(m.z), lo16(m.w), hi16(m.w)};
    if (latent) {
        const u32x4 q = ldg((const u32x4*)(hp + (cidx ^ 2) * 8));
        const float y[8] = {lo16(q.x), hi16(q.x), lo16(q.y), hi16(q.y), lo16(q.z), hi16(q.z), lo16(q.w), hi16(q.w)};
        const int pos = (cidx < 4) ? (tl >> 6) : (ROWS + (tl & 63));
        const float* tb = rope + ((size_t)pos * 16 + (cidx & 1) * 8) * 2;
        const bool first = (cidx & 2) == 0;
#pragma unroll
        for (int j = 0; j < 8; ++j) { const float cs = ldg(tb + j * 2), sn = ldg(tb + j * 2 + 1);
            x[j] = first ? (x[j] * cs - y[j] * sn) : (x[j] * cs + y[j] * sn); }
    }
#pragma unroll
    for (int j = 0; j < 8; ++j) o[j] = x[j] * scale;
}

DEV int st_index(const SetDesc& sd, int sl, int h, int dir, int tb) { return ((sl * 4 + h) * 2 + dir) * sd.ntb + tb; }

constexpr int V_LD = 144, K_LD = 72, KS_LD = 80;
DEV void mlstm_stepA_task(const Params& p, const SetDesc& sd, int layer, int task, char* shm) {
    const int tid = TID(), lane = tid & 63, w = tid >> 6, fr = lane & 15, fq = lane >> 4, tq4 = (lane & 15) >> 2, tp4 = lane & 3;
    const int tb = task % sd.ntb, h = (task / sd.ntb) & 3, sl = task / (sd.ntb * 4);
    const int row0 = (sl << sd.lgseq) + tb * 128; const bool latent = !sd.is_ctx; const int tl0 = tb * 128;
    bf16_t* Vs = (bf16_t*)shm;
    bf16_t* Ksc = (bf16_t*)(shm + 128 * V_LD * 2);
    float* ga = (float*)(shm + 128 * V_LD * 2 + 2 * 128 * KS_LD * 2); float* gb = ga + 256; float* gpm = gb + 256; float* gtot = gpm + 256; float* tmp = gtot + 8;
    const bf16_t* prow = proj_buf(p, sd) + (size_t)row0 * PWA;
    __syncthreads();
    gate_scan(prow, h, p.gate_bias + (size_t)layer * 16, ga, gb, gpm, gtot, tmp);
    {
        const int s = tid & 127, cpi = tid >> 7, cp = (cpi & 1) + (cpi >> 1) * 4;
        const bf16_t* hp = prow + (size_t)s * PWA + C_KM + h * 64;
        float k1[8], k2[8];
        load_rope_chunk(hp, cp, latent, tl0 + s, p.rope(), 1.0f, k1);
        load_rope_chunk(hp, cp + 2, latent, tl0 + s, p.rope(), 1.0f, k2);
#pragma unroll
        for (int dir = 0; dir < 2; ++dir) { const float ws = __expf(ga[dir * 128 + s] - gtot[dir * 2 + 1]);
            u32x4 o1 = {pack2(k1[0] * ws, k1[1] * ws), pack2(k1[2] * ws, k1[3] * ws), pack2(k1[4] * ws, k1[5] * ws), pack2(k1[6] * ws, k1[7] * ws)};
            u32x4 o2 = {pack2(k2[0] * ws, k2[1] * ws), pack2(k2[2] * ws, k2[3] * ws), pack2(k2[4] * ws, k2[5] * ws), pack2(k2[6] * ws, k2[7] * ws)};
            *(u32x4*)(Ksc + (dir * 128 + s) * KS_LD + cp * 8) = o1; *(u32x4*)(Ksc + (dir * 128 + s) * KS_LD + (cp + 2) * 8) = o2; }
    }
#pragma unroll
    for (int it = 0; it < 4; ++it) { const int item = tid + it * 512, s = item >> 4, ch = item & 15;
        *(u32x4*)(Vs + s * V_LD + ch * 8) = ldg((const u32x4*)(prow + (size_t)s * PWA + C_VM + h * 128 + ch * 8)); }
    __syncthreads();
    f32x4 acc[2][4];
#pragma unroll
    for (int dir = 0; dir < 2; ++dir)
#pragma unroll
        for (int n = 0; n < 4; ++n) acc[dir][n] = (f32x4){0.f, 0.f, 0.f, 0.f};
#pragma unroll
    for (int ks = 0; ks < 4; ++ks) {
        const bf16_t* vp = Vs + (32 * ks + 4 * fq + tq4) * V_LD + w * 16 + 4 * tp4;
        const bf16x8 af = mk8(TR16(vp), TR16(vp + 16 * V_LD));
#pragma unroll
        for (int dir = 0; dir < 2; ++dir)
#pragma unroll
            for (int n = 0; n < 4; ++n) { const bf16_t* kp = Ksc + (dir * 128 + 32 * ks + 4 * fq + tq4) * KS_LD + n * 16 + 4 * tp4;
                const bf16x8 bfv = mk8(TR16(kp), TR16(kp + 16 * KS_LD));
                acc[dir][n] = mfma16(af, bfv, acc[dir][n]); }
    }
#pragma unroll
    for (int dir = 0; dir < 2; ++dir) { float* So = p.Sst() + (size_t)st_index(sd, sl, h, dir, tb) * 8192;
#pragma unroll
        for (int n = 0; n < 4; ++n)
#pragma unroll
            for (int r = 0; r < 4; ++r) stg(So + (w * 16 + fq * 4 + r) * 64 + n * 16 + fr, (float)acc[dir][n][r]); }
    if (tid < 128) { const int dir = tid >> 6, dd = tid & 63; float sm = 0.f;
        for (int i = 0; i < 128; ++i) sm += bf2f(Ksc[(dir * 128 + i) * KS_LD + dd]);
        stg(p.Sn() + (size_t)st_index(sd, sl, h, dir, tb) * 64 + dd, sm); }
    if (tid < 2) { float* sc = p.Ssc() + (size_t)st_index(sd, sl, h, tid, tb) * 4; stg(sc, gtot[tid * 2]); stg(sc + 1, gtot[tid * 2] + gtot[tid * 2 + 1]); }
}

template <int GI> DEV void pool_group(const Params& p, const SetDesc& sd, const bf16_t* pb) {
    constexpr int W = 2 << GI;
    const int nitems = sd.nrows * 16; const int T = 1 << sd.lgseq;
    for (int item = blockIdx.x * NTHREADS + TID(); item < nitems; item += gridDim.x * NTHREADS) {
        const int row = item >> 4, ch = GI * 128 + (item & 15) * 8;
        const int tt = row & (T - 1);
        u32x4 mv[W]; int cnt = 0; bool okv[W];
#pragma unroll
        for (int q = 0; q < W; ++q) { const int t2 = tt - W / 2 + q; const bool ok = (t2 >= 0) && (t2 < T); cnt += ok ? 1 : 0; okv[q] = ok;
            mv[q] = ldg((const u32x4*)(pb + (size_t)(ok ? (row - W / 2 + q) : row) * PWA + C_PU + ch)); }
        float s[8];
#pragma unroll
        for (int j = 0; j < 8; ++j) s[j] = 0.f;
#pragma unroll
        for (int q = 0; q < W; ++q) { u32x4 m = mv[q]; if (!okv[q]) m = (u32x4){0u, 0u, 0u, 0u};
            s[0] += lo16(m.x); s[1] += hi16(m.x); s[2] += lo16(m.y); s[3] += hi16(m.y); s[4] += lo16(m.z); s[5] += hi16(m.z); s[6] += lo16(m.w); s[7] += hi16(m.w); }
        const float inv = frcp((float)cnt);
        const u32x4 m = mv[W / 2];
        const float u[8] = {lo16(m.x), hi16(m.x), lo16(m.y), hi16(m.y), lo16(m.z), hi16(m.z), lo16(m.w), hi16(m.w)};
        u32x4 o = {pack2(s[0] * inv - u[0], s[1] * inv - u[1]), pack2(s[2] * inv - u[2], s[3] * inv - u[3]), pack2(s[4] * inv - u[4], s[5] * inv - u[5]), pack2(s[6] * inv - u[6], s[7] * inv - u[7])};
        stg((u32x4*)(p.Pb() + (size_t)row * 512 + ch), o);
    }
}
DEV void phase_pool(const Params& p, const SetDesc& sd) {
    const bf16_t* pb = proj_buf(p, sd);
    pool_group<0>(p, sd, pb); pool_group<1>(p, sd, pb); pool_group<2>(p, sd, pb); pool_group<3>(p, sd, pb);
}

template <int NC> DEV void mlstm_stepB_run(const Params& p, const SetDesc& sd, int task) {
    const int tid = TID();
    const int q = task & 3, dir = (task >> 2) & 1, h = (task >> 3) & 3, sl = task >> 5;
    const int ci = ((sd.samp0 + sl) * 4 + h) * 2 + dir;
    const int eoff = q * 2048 + tid * 4;
    float zr = 0.f; HIDE(zr);
    f32x4 C = {zr, zr, zr, zr}; float nv = 0.f; float m = -1e30f;
    f32x4 Sv[NC]; float blv[NC], mlv[NC], snv[NC];
#pragma unroll
    for (int c = 0; c < NC; ++c) { const int tb = dir ? NC - 1 - c : c; const size_t si = st_index(sd, sl, h, dir, tb);
        Sv[c] = ldg((const f32x4*)(p.Sst() + si * 8192 + eoff)); blv[c] = ldg(p.Ssc() + si * 4); mlv[c] = ldg(p.Ssc() + si * 4 + 1);
        snv[c] = (q == 0 && tid < 64) ? ldg(p.Sn() + si * 64 + tid) : 0.f; }
    if (!sd.is_ctx) { C = ldg((const f32x4*)(p.CiC() + (size_t)ci * 8192 + eoff)); if (q == 0 && tid < 64) nv = ldg(p.Cin_() + (size_t)ci * 64 + tid); m = ldg(p.Cim() + (size_t)ci * 4); }
#pragma unroll
    for (int c = 0; c < NC; ++c) {
        const int tb = dir ? NC - 1 - c : c; const size_t si = st_index(sd, sl, h, dir, tb);
        u32x2 o = {pack2(C[0], C[1]), pack2(C[2], C[3])};
        stg((u32x2*)(p.Cin() + si * 8192 + eoff), o);
        if (q == 0 && tid < 64) stg(p.Cn() + si * 64 + tid, nv);
        if (q == 0 && tid == 0) stg(p.Cm() + si * 4, m);
        const float mn = fmaxf(blv[c] + m, mlv[c]);
        const float dc = __expf(blv[c] + m - mn), wsn = __expf(mlv[c] - mn);
        C = C * dc + Sv[c] * wsn;
        nv = nv * dc + snv[c] * wsn;
        m = mn;
    }
    if (sd.is_ctx) { stg((f32x4*)(p.CiC() + (size_t)ci * 8192 + eoff), C); if (q == 0 && tid < 64) stg(p.Cin_() + (size_t)ci * 64 + tid, nv); if (q == 0 && tid == 0) stg(p.Cim() + (size_t)ci * 4, m); }
}
DEV void mlstm_stepB_task(const Params& p, const SetDesc& sd, int task) {
    if (sd.is_ctx) mlstm_stepB_run<NTBC>(p, sd, task); else mlstm_stepB_run<NTBL>(p, sd, task);
}

constexpr int NA_KLD = 136, NA_VLD = 144;
DEV void na_task(const Params& p, const SetDesc& sd, int layer, int sl, int rq2  , int hp, char* shm) {
    const int tid = TID(), lane = tid & 63, w = tid >> 6, tq = lane & 15, fq = lane >> 4, tq4 = (lane & 15) >> 2, tp4 = lane & 3;
    const int hh = w >> 2, g = w & 3, head = hp * 2 + hh;
    const bool ctxq = sd.is_ctx;
    bf16_t* Ks = (bf16_t*)shm;
    bf16_t* Vs = (bf16_t*)(shm + 128 * NA_KLD * 2);
    float* rpbs = (float*)(shm + 128 * NA_KLD * 2 + 128 * NA_VLD * 2);
    const int sample = sd.samp0 + sl;
    const bf16_t* pq = proj_buf(p, sd) + ((size_t)sl << sd.lgseq) * PWA;
    const bf16_t* pc = p.PROJc() + (size_t)sample * CTX * PWA;
    const int qcol = g * 16 + tq;
    int rqv[2], rsv[2], qtok[2];
#pragma unroll
    for (int u = 0; u < 2; ++u) { rqv[u] = 2 * rq2 + u; qtok[u] = rqv[u] * 64 + qcol; int r_ = rqv[u] - 4; rsv[u] = r_ < 0 ? 0 : (r_ > ROWS - 8 ? ROWS - 8 : r_); }
    const int nloc = ctxq ? 0 : (rsv[1] + 8 - rsv[0]);
    const int nstage = nloc + CTX / 64;
    __syncthreads();
    if (!ctxq) for (int i = tid; i < 2 * 465; i += NTHREADS) rpbs[i] = ldg(p.rpb + ((size_t)layer * 8 + hp * 2 + i / 465) * 465 + i % 465);
    bf16x8 qf[2][2];
#pragma unroll
    for (int u = 0; u < 2; ++u)
#pragma unroll
        for (int ks = 0; ks < 2; ++ks) qf[u][ks] = mk8(ldg((const u32x4*)(pq + (size_t)qtok[u] * PWA + C_QN + head * 64 + ks * 32 + fq * 8)));
    float m_run[2] = {-1e30f, -1e30f}, l_run[2] = {0.f, 0.f};
    f32x4 acc[2][4];
#pragma unroll
    for (int u = 0; u < 2; ++u)
#pragma unroll
        for (int mt = 0; mt < 4; ++mt) acc[u][mt] = (f32x4){0.f, 0.f, 0.f, 0.f};
    int cs = qcol - 8; cs = cs < 0 ? 0 : (cs > 48 ? 48 : cs);
    const int kc0 = (g == 0) ? 0 : (g == 1) ? 8 : (g == 2) ? 24 : 32;
    const int npair = (nstage + 1) >> 1;
    u32x4 kreg[4], vreg[4];
#define NA_SRC_ROWS(stg) (((stg) < nloc) ? (pq + (size_t)((rsv[0] + (stg)) * 64) * PWA) : (pc + (size_t)((((stg) < nstage ? (stg) : nstage - 1) - nloc) * 64) * PWA))
#define NA_FETCH(sp_) do { _Pragma("unroll") for (int it = 0; it < 4; ++it) { const int item = tid + it * 512, key2 = item >> 4, ch = item & 15; \
        const bf16_t* kb_ = NA_SRC_ROWS(2 * (sp_) + (key2 >> 6)); const bf16_t* src = kb_ + (size_t)(key2 & 63) * PWA + hp * 128 + ch * 8; \
        kreg[it] = ldg((const u32x4*)(src + C_KN)); vreg[it] = ldg((const u32x4*)(src + C_VN)); } } while (0)
    NA_FETCH(0);
    for (int sp = 0; sp < npair; ++sp) {
        __syncthreads();
#pragma unroll
        for (int it = 0; it < 4; ++it) { const int item = tid + it * 512, key2 = item >> 4, ch = item & 15;
            *(u32x4*)(Ks + key2 * NA_KLD + ch * 8) = kreg[it]; *(u32x4*)(Vs + key2 * NA_VLD + ch * 8) = vreg[it]; }
        if (sp + 1 < npair) NA_FETCH(sp + 1);
        __syncthreads();
#pragma unroll
        for (int sub = 0; sub < 2; ++sub) {
        const int st = 2 * sp + sub;
        if (st >= nstage) continue;
        const bool local = st < nloc;
        const bf16_t* Ksb = Ks + sub * 64 * NA_KLD; const bf16_t* Vsb = Vs + sub * 64 * NA_VLD;
        if (local) {
            const int kr = rsv[0] + st;
            f32x4 sa[2][2];
#pragma unroll
            for (int kt = 0; kt < 2; ++kt) { sa[0][kt] = (f32x4){0.f, 0.f, 0.f, 0.f}; sa[1][kt] = (f32x4){0.f, 0.f, 0.f, 0.f};
#pragma unroll
                for (int ks = 0; ks < 2; ++ks) { const bf16x8 kf = *(const bf16x8*)(Ksb + (kc0 + kt * 16 + tq) * NA_KLD + hh * 64 + ks * 32 + fq * 8);
                    sa[0][kt] = mfma16(kf, qf[0][ks], sa[0][kt]); sa[1][kt] = mfma16(kf, qf[1][ks], sa[1][kt]); } }
            float alpha[2]; bf16x8 pf[2];
#pragma unroll
            for (int u = 0; u < 2; ++u) {
                const bool act = (kr >= rsv[u]) && (kr < rsv[u] + 8);
                if (!act) { alpha[u] = 1.0f; pf[u] = mk8((u32x4){0u, 0u, 0u, 0u}); continue; }
                const int dr = kr - rqv[u] + 7;
                float sc[8]; float mx = -1e30f; float bs[8];
#pragma unroll
                for (int kt = 0; kt < 2; ++kt)
#pragma unroll
                    for (int r = 0; r < 4; ++r) { const int kcol = kc0 + kt * 16 + fq * 4 + r; int dc = kcol - qcol + 15; dc = dc < 0 ? 0 : (dc > 30 ? 30 : dc);
                        bs[kt * 4 + r] = rpbs[hh * 465 + dr * 31 + dc]; }
#ifndef CPU_EMU
                asm volatile("" : "+v"(bs[0]), "+v"(bs[1]), "+v"(bs[2]), "+v"(bs[3]), "+v"(bs[4]), "+v"(bs[5]), "+v"(bs[6]), "+v"(bs[7]));
#endif
#pragma unroll
                for (int kt = 0; kt < 2; ++kt)
#pragma unroll
                    for (int r = 0; r < 4; ++r) { const int kcol = kc0 + kt * 16 + fq * 4 + r; const bool valid = (kcol >= cs) && (kcol < cs + 16);
                        const float v = valid ? (sa[u][kt][r] * 0.125f + bs[kt * 4 + r]) : -1e30f; sc[kt * 4 + r] = v; mx = fmaxf(mx, v); }
                mx = fmaxf(mx, shx<16>(mx)); mx = fmaxf(mx, shx<32>(mx));
                const float mn = fmaxf(m_run[u], mx); alpha[u] = __expf(m_run[u] - mn); m_run[u] = mn;
                float ps = 0.f; float pv[8];
#pragma unroll
                for (int j = 0; j < 8; ++j) { pv[j] = __expf(sc[j] - mn); ps += pv[j]; }
                ps += shx<16>(ps); ps += shx<32>(ps);
                l_run[u] = l_run[u] * alpha[u] + ps;
                u32x4 pk = {pack2(pv[0], pv[1]), pack2(pv[2], pv[3]), pack2(pv[4], pv[5]), pack2(pv[6], pv[7])};
                pf[u] = mk8(pk);
            }
#pragma unroll
            for (int mt = 0; mt < 4; ++mt) {
                const bf16_t* vp = Vsb + (kc0 + 4 * fq + tq4) * NA_VLD + hh * 64 + mt * 16 + 4 * tp4;
                const bf16x8 vf = mk8(TR16(vp), TR16(vp + 16 * NA_VLD));
                acc[0][mt] = mfma16(vf, pf[0], acc[0][mt] * alpha[0]); acc[1][mt] = mfma16(vf, pf[1], acc[1][mt] * alpha[1]); }
        } else {
            f32x4 sa[2][4];
#pragma unroll
            for (int kt = 0; kt < 4; ++kt) { sa[0][kt] = (f32x4){0.f, 0.f, 0.f, 0.f}; sa[1][kt] = (f32x4){0.f, 0.f, 0.f, 0.f};
#pragma unroll
                for (int ks = 0; ks < 2; ++ks) { const bf16x8 kf = *(const bf16x8*)(Ksb + (kt * 16 + tq) * NA_KLD + hh * 64 + ks * 32 + fq * 8);
                    sa[0][kt] = mfma16(kf, qf[0][ks], sa[0][kt]); sa[1][kt] = mfma16(kf, qf[1][ks], sa[1][kt]); } }
            float alpha[2]; bf16x8 pf[2][2];
#pragma unroll
            for (int u = 0; u < 2; ++u) {
                float mx = -1e30f;
#pragma unroll
                for (int kt = 0; kt < 4; ++kt)
#pragma unroll
                    for (int r = 0; r < 4; ++r) { sa[u][kt][r] *= 0.125f; mx = fmaxf(mx, sa[u][kt][r]); }
                mx = fmaxf(mx, shx<16>(mx)); mx = fmaxf(mx, shx<32>(mx));
                const float mn = fmaxf(m_run[u], mx); alpha[u] = __expf(m_run[u] - mn); m_run[u] = mn;
                float ps = 0.f;
#pragma unroll
                for (int kt = 0; kt < 4; ++kt)
#pragma unroll
                    for (int r = 0; r < 4; ++r) { sa[u][kt][r] = __expf(sa[u][kt][r] - mn); ps += sa[u][kt][r]; }
                ps += shx<16>(ps); ps += shx<32>(ps);
                l_run[u] = l_run[u] * alpha[u] + ps;
#pragma unroll
                for (int h2 = 0; h2 < 2; ++h2) {
                    u32x4 pk = {pack2(sa[u][2 * h2][0], sa[u][2 * h2][1]), pack2(sa[u][2 * h2][2], sa[u][2 * h2][3]), pack2(sa[u][2 * h2 + 1][0], sa[u][2 * h2 + 1][1]), pack2(sa[u][2 * h2 + 1][2], sa[u][2 * h2 + 1][3])};
                    pf[u][h2] = mk8(pk); }
            }
#pragma unroll
            for (int mt = 0; mt < 4; ++mt) { acc[0][mt] = acc[0][mt] * alpha[0]; acc[1][mt] = acc[1][mt] * alpha[1]; }
#pragma unroll
            for (int h2 = 0; h2 < 2; ++h2)
#pragma unroll
                for (int mt = 0; mt < 4; ++mt) { const bf16_t* vp = Vsb + (32 * h2 + 4 * fq + tq4) * NA_VLD + hh * 64 + mt * 16 + 4 * tp4;
                    const bf16x8 vf = mk8(TR16(vp), TR16(vp + 16 * NA_VLD));
                    acc[0][mt] = mfma16(vf, pf[0][h2], acc[0][mt]); acc[1][mt] = mfma16(vf, pf[1][h2], acc[1][mt]); }
        }
        }
    }
#undef NA_FETCH
#undef NA_SRC_ROWS
#pragma unroll
    for (int u = 0; u < 2; ++u) {
        const float il = frcp(l_run[u]);
        const size_t orow = ((size_t)sl << sd.lgseq) + qtok[u];
#pragma unroll
        for (int mt = 0; mt < 4; ++mt) { u32x2 o = {pack2(acc[u][mt][0] * il, acc[u][mt][1] * il), pack2(acc[u][mt][2] * il, acc[u][mt][3] * il)};
            stg((u32x2*)(p.Nb() + orow * 512 + head * 64 + mt * 16 + fq * 4), o); }
    }
}

DEV void mlstm_stepC_task(const Params& p, const SetDesc& sd, int layer, int task, char* shm) {
    const int tid = TID(), lane = tid & 63, w = tid >> 6, tq = lane & 15, fq = lane >> 4, tq4 = (lane & 15) >> 2, tp4 = lane & 3;
    const int tb = task % sd.ntb, h = (task / sd.ntb) & 3, sl = task / (sd.ntb * 4);
    const int row0 = (sl << sd.lgseq) + tb * 128; const bool latent = !sd.is_ctx; const int tl0 = tb * 128;
    bf16_t* Ks = (bf16_t*)shm;
    bf16_t* Vs = (bf16_t*)(shm + 128 * K_LD * 2);
    bf16_t* Cs = (bf16_t*)(shm + 128 * K_LD * 2 + 128 * V_LD * 2);
    float* ga = (float*)(shm + 128 * K_LD * 2 * 3 + 128 * V_LD * 2); float* gb = ga + 256; float* gpm = gb + 256; float* gtot = gpm + 256; float* tmp = gtot + 8;
    float* nvs = tmp + 16;
    float* cms = nvs + 128;
    const bf16_t* prow = proj_buf(p, sd) + (size_t)row0 * PWA;
    __syncthreads();
    gate_scan(prow, h, p.gate_bias + (size_t)layer * 16, ga, gb, gpm, gtot, tmp);
    {
        const int s = tid & 127, cpi = tid >> 7, cp = (cpi & 1) + (cpi >> 1) * 4;
        const bf16_t* hp = prow + (size_t)s * PWA + C_KM + h * 64;
        float k1[8], k2[8];
        load_rope_chunk(hp, cp, latent, tl0 + s, p.rope(), 1.0f, k1);
        load_rope_chunk(hp, cp + 2, latent, tl0 + s, p.rope(), 1.0f, k2);
        u32x4 o1 = {pack2(k1[0], k1[1]), pack2(k1[2], k1[3]), pack2(k1[4], k1[5]), pack2(k1[6], k1[7])};
        u32x4 o2 = {pack2(k2[0], k2[1]), pack2(k2[2], k2[3]), pack2(k2[4], k2[5]), pack2(k2[6], k2[7])};
        *(u32x4*)(Ks + s * K_LD + cp * 8) = o1; *(u32x4*)(Ks + s * K_LD + (cp + 2) * 8) = o2;
    }
#pragma unroll
    for (int it = 0; it < 4; ++it) { const int item = tid + it * 512, s = item >> 4, ch = item & 15;
        *(u32x4*)(Vs + s * V_LD + ch * 8) = ldg((const u32x4*)(prow + (size_t)s * PWA + C_VM + h * 128 + ch * 8)); }
#pragma unroll
    for (int it = 0; it < 4; ++it) { const int item = tid + it * 512, dir = item >> 10, rem = item & 1023, v = rem >> 3, ch = rem & 7;
        *(u32x4*)(Cs + (dir * 128 + v) * K_LD + ch * 8) = ldg((const u32x4*)(p.Cin() + (size_t)st_index(sd, sl, h, dir, tb) * 8192 + v * 64 + ch * 8)); }
    if (tid < 128) nvs[tid] = ldg(p.Cn() + (size_t)st_index(sd, sl, h, tid >> 6, tb) * 64 + (tid & 63));
    if (tid < 2) cms[tid] = ldg(p.Cm() + (size_t)st_index(sd, sl, h, tid, tb) * 4);
    bf16x8 qf[2]; float qv[2][8];
    {
        const int t = w * 16 + tq; const bf16_t* hp = prow + (size_t)t * PWA + C_QM + h * 64;
#pragma unroll
        for (int ks = 0; ks < 2; ++ks) { load_rope_chunk(hp, ks * 4 + fq, latent, tl0 + t, p.rope(), 0.125f, qv[ks]);
            u32x4 o = {pack2(qv[ks][0], qv[ks][1]), pack2(qv[ks][2], qv[ks][3]), pack2(qv[ks][4], qv[ks][5]), pack2(qv[ks][6], qv[ks][7])}; qf[ks] = mk8(o); }
    }
    __syncthreads();
    const int t = w * 16 + tq;
    f32x4 hsum[8];
#pragma unroll
    for (int mt = 0; mt < 8; ++mt) hsum[mt] = (f32x4){0.f, 0.f, 0.f, 0.f};
#pragma unroll
    for (int dir = 0; dir < 2; ++dir) {
        const float m_in = cms[dir];
        const float Mt = fmaxf(m_in, gpm[dir * 128 + t]);
        const float inter = __expf(m_in - Mt);
        const float mtot = gb[dir * 128 + t] + Mt;
        f32x4 acc[8];
#pragma unroll
        for (int mt = 0; mt < 8; ++mt) { acc[mt] = (f32x4){0.f, 0.f, 0.f, 0.f};
#pragma unroll
            for (int ks = 0; ks < 2; ++ks) { const bf16x8 cf = *(const bf16x8*)(Cs + (dir * 128 + mt * 16 + tq) * K_LD + ks * 32 + fq * 8);
                acc[mt] = mfma16(cf, qf[ks], acc[mt]); }
            acc[mt] = acc[mt] * inter; }
        float qn = 0.f;
#pragma unroll
        for (int ks = 0; ks < 2; ++ks)
#pragma unroll
            for (int j = 0; j < 8; ++j) qn += bf2f(f2bf(qv[ks][j])) * nvs[dir * 64 + ks * 32 + fq * 8 + j];
        qn += shx<16>(qn); qn += shx<32>(qn);
        float den = inter * qn;
        const int u_lo = dir == 0 ? 0 : (w >> 1), u_hi = dir == 0 ? (w >> 1) : 3;
        float rsum = 0.f;
        for (int u = u_lo; u <= u_hi; ++u) {
            unsigned pk[4];
#pragma unroll
            for (int kt = 0; kt < 2; ++kt) { f32x4 sa = {0.f, 0.f, 0.f, 0.f}; const int sb = 32 * u + 16 * kt;
#pragma unroll
                for (int ks = 0; ks < 2; ++ks) { const bf16x8 kf = *(const bf16x8*)(Ks + (sb + tq) * K_LD + ks * 32 + fq * 8); sa = mfma16(kf, qf[ks], sa); }
                float pv[4]; float gv4[4];
#pragma unroll
                for (int r = 0; r < 4; ++r) gv4[r] = ga[dir * 128 + sb + fq * 4 + r];
#ifndef CPU_EMU
                asm volatile("" : "+v"(gv4[0]), "+v"(gv4[1]), "+v"(gv4[2]), "+v"(gv4[3]));
#endif
#pragma unroll
                for (int r = 0; r < 4; ++r) { const int s = sb + fq * 4 + r; const bool valid = dir == 0 ? (s <= t) : (s >= t);
                    pv[r] = valid ? sa[r] * __expf(gv4[r] - Mt) : 0.f; pv[r] = bf2f(f2bf(pv[r])); rsum += pv[r]; }
                pk[kt * 2] = pack2(pv[0], pv[1]); pk[kt * 2 + 1] = pack2(pv[2], pv[3]); }
            u32x4 pkv = {pk[0], pk[1], pk[2], pk[3]}; const bf16x8 pf = mk8(pkv);
#pragma unroll
            for (int mt = 0; mt < 8; ++mt) { const bf16_t* vp = Vs + (32 * u + 4 * fq + tq4) * V_LD + mt * 16 + 4 * tp4;
                const bf16x8 vf = mk8(TR16(vp), TR16(vp + 16 * V_LD));
                acc[mt] = mfma16(vf, pf, acc[mt]); }
        }
        rsum += shx<16>(rsum); rsum += shx<32>(rsum);
        den += rsum;
        const float dn = frcp(fmaxf(fabsf(den), __expf(-mtot)));
#pragma unroll
        for (int mt = 0; mt < 8; ++mt) hsum[mt] = hsum[mt] + acc[mt] * dn;
    }
    float ss = 0.f;
#pragma unroll
    for (int mt = 0; mt < 8; ++mt)
#pragma unroll
        for (int r = 0; r < 4; ++r) ss += hsum[mt][r] * hsum[mt][r];
    ss += shx<16>(ss); ss += shx<32>(ss);
    const float rstd = rsqrtf(ss * (1.0f / 128.0f) + RMS_EPS);
#pragma unroll
    for (int mt = 0; mt < 8; ++mt) { const int v = mt * 16 + fq * 4;
        const u32x2 om = ldg((const u32x2*)(prow + (size_t)t * PWA + C_OM + h * 128 + v));
        u32x2 o = {pack2(hsum[mt][0] * rstd * sigmoidf_(lo16(om.x)), hsum[mt][1] * rstd * sigmoidf_(hi16(om.x))),
                   pack2(hsum[mt][2] * rstd * sigmoidf_(lo16(om.y)), hsum[mt][3] * rstd * sigmoidf_(hi16(om.y)))};
        stg((u32x2*)(p.Mb() + (size_t)(row0 + t) * 512 + h * 128 + v), o); }
}

struct SchedMerge {
    const bf16_t* Mb; const bf16_t* Pb; const bf16_t* Nb; const bf16_t* Wb; int nM;
    DEV bool next(int i, GUnit& u) const { u.aux = i % 3; return tile_order(i / 3, nM, 4, u.pm, u.pn); }
    DEV const bf16_t* a_base(const GUnit& u) const { return (u.aux == 0 ? Mb : (u.aux == 1 ? Pb : Nb)) + (size_t)u.pm * 256 * 512; }
    DEV const bf16_t* b_base(const GUnit& u) const { return Wb + ((size_t)u.aux * 1024 + u.pn * 256) * 512; }
    DEV int grow(const GUnit&, int) const { return 0; }
};
DEV void phase_merge(const Params& p, const SetDesc& sd, int layer, char* shm) {
    SchedMerge S; S.Mb = p.Mb(); S.Pb = p.Pb(); S.Nb = p.Nb(); S.Wb = p.WbT() + (size_t)layer * 3 * 1024 * 512; S.nM = sd.nrows / 256;
    const unsigned char* bgb = (const unsigned char*)p.BG(); bf16_t* mgb = p.MERGED();
    gemm_stream<false, 512, 512, 512>(shm, S, [=](const GUnit& u, f32x4 (&acc)[2][2][4][2], int r0, int c0) -> bool {
        if (u.aux < 2) {
#pragma unroll
            for (int ai = 0; ai < 2; ++ai) {
                u32x2 ga[4][2], gb[4][2];
#pragma unroll
                for (int m = 0; m < 4; ++m)
#pragma unroll
                    for (int hf = 0; hf < 2; ++hf) { const unsigned char* gp = bgb + ((size_t)u.pm * 256 + r0 + ai * 128 + m * 16) * NBG + u.aux * 1024 + u.pn * 256 + c0 + hf * 128;
                        ga[m][hf] = ldg((const u32x2*)gp); gb[m][hf] = ldg((const u32x2*)(gp + 1024)); }
#pragma unroll
                for (int m = 0; m < 4; ++m)
#pragma unroll
                    for (int hf = 0; hf < 2; ++hf) {
#pragma unroll
                        for (int j = 0; j < 4; ++j) { acc[ai][hf][m][0][j] *= u8f(ga[m][hf].x, j) * frcp(u8f(gb[m][hf].x, j)); acc[ai][hf][m][1][j] *= u8f(ga[m][hf].y, j) * frcp(u8f(gb[m][hf].y, j)); } }
            }
            return true;
        }
#pragma unroll
        for (int ai = 0; ai < 2; ++ai) {
            u32x2 gm[4][2];
#pragma unroll
            for (int m = 0; m < 4; ++m)
#pragma unroll
                for (int hf = 0; hf < 2; ++hf) gm[m][hf] = ldg((const u32x2*)(bgb + ((size_t)u.pm * 256 + r0 + ai * 128 + m * 16) * NBG + 2048 + u.pn * 256 + c0 + hf * 128));
#pragma unroll
            for (int m = 0; m < 4; ++m)
#pragma unroll
                for (int hf = 0; hf < 2; ++hf) { const size_t r = (size_t)u.pm * 256 + r0 + ai * 128 + m * 16;
                    const f32x4 x0 = acc[ai][hf][m][0] * (1.0f / 255.0f), x1 = acc[ai][hf][m][1] * (1.0f / 255.0f); const u32x2 g = gm[m][hf];
                    u32x4 ov = {pack2(x0[0] * u8f(g.x, 0), x0[1] * u8f(g.x, 1)), pack2(x0[2] * u8f(g.x, 2), x0[3] * u8f(g.x, 3)),
                                pack2(x1[0] * u8f(g.y, 0), x1[1] * u8f(g.y, 1)), pack2(x1[2] * u8f(g.y, 2), x1[3] * u8f(g.y, 3))};
                    stg((u32x4*)(mgb + r * 1024 + u.pn * 256 + c0 + hf * 128), ov); }
        }
        return false; });
}
DEV void phase_outproj(const Params& p, const SetDesc& sd, int layer, char* shm) {
    SchedPlain S; S.A = p.MERGED(); S.Bt = p.WoT() + (size_t)layer * 1024 * 1024; S.nM = sd.nrows / 256; S.nN = 4; S.lda256 = 256 * 1024; S.ldb256 = 256 * 1024;
    bf16_t* yb = p.Y();
    gemm_stream<false, 1024, 1024, 1024>(shm, S, [=](const GUnit& u, const f32x4 (&acc)[2][2][4][2], int r0, int c0) {
#pragma unroll
        for (int ai = 0; ai < 2; ++ai)
#pragma unroll
            for (int m = 0; m < 4; ++m) { bf16_t* o = yb + ((size_t)u.pm * 256 + r0 + ai * 128 + m * 16) * 1024 + u.pn * 256 + c0;
                store8bf(o, acc[ai][0][m][0], acc[ai][0][m][1]); store8bf(o + 128, acc[ai][1][m][0], acc[ai][1][m][1]); } });
}

DEV void phase_postmix(const Params& p, const SetDesc& sd, int layer, char* shm) {
    const int tid = TID(), lane = tid & 63, wv = tid >> 6;
    float* wr_s = (float*)shm;
    __syncthreads();
    for (int i = tid; i < 1024 * 16; i += NTHREADS) { const int c = i >> 4, e = i & 15, ln = (c & 511) >> 3, j = c & 7, hf = c >> 9;
        wr_s[((((hf * 8 + j) * 4 + (e >> 2)) * 64 + ln) << 2) + (e & 3)] = ldg(p.router_w + (size_t)layer * 1024 * 16 + i); }
    __syncthreads();
    const float* g1 = p.norm_gain + ((size_t)layer * 4 + 1) * 1024; const float* g2 = p.norm_gain + ((size_t)layer * 4 + 2) * 1024;
    float* par = (float*)(shm + 65536);
    { const int rpb0_ = (sd.nrows + (int)gridDim.x - 1) / (int)gridDim.x; const float* mdb = mod_row(p, sd, layer, min((int)blockIdx.x * rpb0_, sd.nrows - 1));
      stage_params(par, g1, g2, mdb + 2048, mdb + 3072, mdb + 4096); }
    __syncthreads();
    const float* xb = xsrc_base(p, sd, layer); float* xdb = xdst_base(p, sd);
    const int stride = 8; const int rpb_ = (sd.nrows + (int)gridDim.x - 1) / (int)gridDim.x; const int row_end = min(sd.nrows, ((int)blockIdx.x + 1) * rpb_);
    int row = (int)blockIdx.x * rpb_ + wv;
    u32x4 ycur[2], ynxt[2]; f32x4 xcur[4], xnxt[4];
    if (row < row_end) {
#pragma unroll
        for (int i = 0; i < 2; ++i) ycur[i] = ldg((const u32x4*)(p.Y() + (size_t)row * 1024 + i * 512 + lane * 8));
#pragma unroll
        for (int i = 0; i < 4; ++i) xcur[i] = ldg((const f32x4*)(xb + (size_t)row * 1024 + (i >> 1) * 512 + lane * 8 + (i & 1) * 4)); }
    for (; row < row_end; row += stride) {
        int ln = lane; HIDE(ln);
        const int rn = row + stride;
        if (rn < row_end) {
#pragma unroll
            for (int i = 0; i < 2; ++i) ynxt[i] = ldg((const u32x4*)(p.Y() + (size_t)rn * 1024 + i * 512 + ln * 8));
#pragma unroll
            for (int i = 0; i < 4; ++i) xnxt[i] = ldg((const f32x4*)(xb + (size_t)rn * 1024 + (i >> 1) * 512 + ln * 8 + (i & 1) * 4)); }
        float* xd = xdb + (size_t)row * 1024;
        const float* md = mod_row(p, sd, layer, row);
        float y[16]; float ss = 0.f;
#pragma unroll
        for (int hlf = 0; hlf < 2; ++hlf) { const u32x4 m = ycur[hlf];
            const float t8[8] = {lo16(m.x), hi16(m.x), lo16(m.y), hi16(m.y), lo16(m.z), hi16(m.z), lo16(m.w), hi16(m.w)};
#pragma unroll
            for (int j = 0; j < 8; ++j) { y[hlf * 8 + j] = t8[j]; ss += t8[j] * t8[j]; } }
        ss = wave_sum(ss);
        const float rstd = rsqrtf(ss * (1.0f / 1024.0f) + RMS_EPS);
        float xn[16]; float ss2 = 0.f;
#pragma unroll
        for (int hlf = 0; hlf < 2; ++hlf)
#pragma unroll
            for (int q = 0; q < 2; ++q) { const int c0 = hlf * 512 + ln * 8 + q * 4; const f32x4 xo = xcur[hlf * 2 + q]; f32x4 xw;
#pragma unroll
                for (int j = 0; j < 4; ++j) { const float v = xo[j] + par[2048 + c0 + j] * (y[hlf * 8 + q * 4 + j] * rstd * par[c0 + j]); xw[j] = v; xn[hlf * 8 + q * 4 + j] = v; ss2 += v * v; }
                stg((f32x4*)(xd + c0), xw); }
        ss2 = wave_sum(ss2);
        const float rstd2 = rsqrtf(ss2 * (1.0f / 1024.0f) + RMS_EPS);
        float lg[16];
#pragma unroll
        for (int e = 0; e < 16; ++e) lg[e] = 0.f;
#pragma unroll
        for (int hlf = 0; hlf < 2; ++hlf) { const int c0 = hlf * 512 + ln * 8; float o[8];
#pragma unroll
            for (int j = 0; j < 8; ++j) { o[j] = xn[hlf * 8 + j] * rstd2 * par[1024 + c0 + j] * (1.0f + par[4096 + c0 + j]) + par[3072 + c0 + j];
#pragma unroll
                for (int eq = 0; eq < 4; ++eq) { const f32x4 w4 = *(const f32x4*)(wr_s + ((((hlf * 8 + j) * 4 + eq) * 64 + ln) << 2));
#pragma unroll
                    for (int e = 0; e < 4; ++e) lg[eq * 4 + e] += o[j] * w4[e]; } }
            const u32x2 ov = {f8pack4(o[0], o[1], o[2], o[3]), f8pack4(o[4], o[5], o[6], o[7])};
            stg((u32x2*)((unsigned char*)p.H() + (size_t)row * 1024 + c0), ov); }
        float r8[8], r4[4], r2[2], r1;
        { const bool b = (lane & 32) != 0;
#pragma unroll
          for (int i = 0; i < 8; ++i) { const float keep = b ? lg[i + 8] : lg[i], send = b ? lg[i] : lg[i + 8]; r8[i] = keep + shx<32>(send); } }
        { const bool b = (lane & 16) != 0;
#pragma unroll
          for (int i = 0; i < 4; ++i) { const float keep = b ? r8[i + 4] : r8[i], send = b ? r8[i] : r8[i + 4]; r4[i] = keep + shx<16>(send); } }
        { const bool b = (lane & 8) != 0;
#pragma unroll
          for (int i = 0; i < 2; ++i) { const float keep = b ? r4[i + 2] : r4[i], send = b ? r4[i] : r4[i + 2]; r2[i] = keep + shx<8>(send); } }
        { const bool b = (lane & 4) != 0; const float keep = b ? r2[1] : r2[0], send = b ? r2[0] : r2[1]; r1 = keep + shx<4>(send); }
        r1 += shx<2>(r1); r1 += shx<1>(r1);
        float mx = r1;
        mx = fmaxf(mx, shx<4>(mx)); mx = fmaxf(mx, shx<8>(mx)); mx = fmaxf(mx, shx<16>(mx)); mx = fmaxf(mx, shx<32>(mx));
        const float ex = __expf(r1 - mx);
        float se = ex;
        se += shx<4>(se); se += shx<8>(se); se += shx<16>(se); se += shx<32>(se);
        if ((lane & 3) == 0) { const int e = ((lane >> 5) & 1) * 8 + ((lane >> 4) & 1) * 4 + ((lane >> 3) & 1) * 2 + ((lane >> 2) & 1);
            stg(p.aff() + (size_t)row * 16 + e, ex * frcp(se)); }
#pragma unroll
        for (int i = 0; i < 2; ++i) ycur[i] = ynxt[i];
#pragma unroll
        for (int i = 0; i < 4; ++i) xcur[i] = xnxt[i];
    }
}

DEV unsigned shxu(unsigned v, int m) {
    const float f = __uint_as_float(v); float r;
    switch (m) { case 1: r = shx<1>(f); break; case 2: r = shx<2>(f); break; case 4: r = shx<4>(f); break; case 8: r = shx<8>(f); break; case 16: r = shx<16>(f); break; default: r = shx<32>(f); break; }
    return __float_as_uint(r);
}
#define TK_CX(a_, b_, desc_) do { const unsigned long long x_ = key[a_], y_ = key[b_]; const bool sw_ = (desc_) ? (x_ < y_) : (x_ > y_); key[a_] = sw_ ? y_ : x_; key[b_] = sw_ ? x_ : y_; } while (0)
DEV void topk_task(const Params& p, const SetDesc& sd, int task, char* shm) {
    const int tid = TID();
    const int e = task & 15, sl = task >> 4;
    unsigned long long* buf = (unsigned long long*)shm;
    const int T = 1 << sd.lgseq, cap = sd.cap;
    const int rbase = sl << sd.lgseq;
    const bool active = tid * 4 < T;
    unsigned long long key[4];
    __syncthreads();
#pragma unroll
    for (int m = 0; m < 4; ++m) { const int i = tid * 4 + m; const float a = active ? ldg(p.aff() + (size_t)(rbase + i) * 16 + e) : 0.f;
        key[m] = ((unsigned long long)__float_as_uint(a) << 32) | (unsigned)(0xFFFFFFFFu - (unsigned)i); }
    for (int k = 2; k <= T; k <<= 1) {
        const bool desc4 = ((tid * 4) & k) == 0;
        for (int j = k >> 1; j >= 4; j >>= 1) {
            const int tj = j >> 2;
            unsigned long long pk[4];
            if (tj < 64) {
#pragma unroll
                for (int m = 0; m < 4; ++m) { const unsigned lo = shxu((unsigned)key[m], tj), hi = shxu((unsigned)(key[m] >> 32), tj); pk[m] = ((unsigned long long)hi << 32) | lo; }
            } else {
                __syncthreads();
                if (active) {
#pragma unroll
                    for (int m = 0; m < 4; ++m) buf[tid * 4 + m] = key[m]; }
                __syncthreads();
#pragma unroll
                for (int m = 0; m < 4; ++m) pk[m] = active ? buf[(tid ^ tj) * 4 + m] : 0ull;
            }
            const bool lower = (tid & tj) == 0; const bool takemax = desc4 == lower;
#pragma unroll
            for (int m = 0; m < 4; ++m) { const unsigned long long x = key[m], y = pk[m]; key[m] = takemax ? (x > y ? x : y) : (x < y ? x : y); }
        }
        if (k >= 4) { TK_CX(0, 2, desc4); TK_CX(1, 3, desc4); TK_CX(0, 1, desc4); TK_CX(2, 3, desc4); }
        else { TK_CX(0, 1, true); TK_CX(2, 3, false); }
    }
    const int sbase = e * sd.rpe + sl * cap;
    if (active) {
#pragma unroll
        for (int m = 0; m < 4; ++m) { const int i = tid * 4 + m; const unsigned long long kv = key[m]; const int tok = (int)(0xFFFFFFFFu - (unsigned)(kv & 0xFFFFFFFFu));
            const int row = rbase + tok;
            if (i < cap) { stg(p.slot_token() + sbase + i, row); stg(p.slot_gate() + sbase + i, __uint_as_float((unsigned)(kv >> 32))); stg(p.token_slots() + (size_t)row * 16 + e, sbase + i); }
            else stg(p.token_slots() + (size_t)row * 16 + e, -1); } }
    if (sl == 0) { const int used = sd.nsamp * cap;
        for (int i = used + tid; i < sd.rpe; i += NTHREADS) { stg(p.slot_token() + e * sd.rpe + i, 0); stg(p.slot_gate() + e * sd.rpe + i, 0.f); } }
}
#undef TK_CX

struct SchedMoe {
    const bf16_t* A; const int* st; const bf16_t* W; int nRT, rpe, nN, wstride;
    DEV bool next(int i, GUnit& u) const { int pmx, pn; if (!tile_order(i, 16 * nRT, nN, pmx, pn)) return false; u.pm = pmx % nRT; u.aux = pmx / nRT; u.pn = pn; return true; }
    DEV int slot0(const GUnit& u) const { return u.aux * rpe + u.pm * 256; }
    DEV const bf16_t* a_base(const GUnit&) const { return A; }
    DEV int grow(const GUnit& u, int i) const { return st ? ldg(st + slot0(u) + i) : slot0(u) + i; }
    DEV const bf16_t* b_base(const GUnit& u) const { return W + (size_t)u.aux * wstride + (size_t)u.pn * 256 * 512; }
};
DEV void phase_moe_gu(const Params& p, const SetDesc& sd, int layer, char* shm) {
    SchedMoe S; S.A = p.H(); S.st = p.slot_token(); S.W = p.WguT() + (size_t)layer * 16 * 2048 * 512; S.nRT = sd.rpe / 256; S.rpe = sd.rpe; S.nN = 8; S.wstride = 2048 * 512;
    unsigned char* hb = (unsigned char*)p.HID();
    gemm_stream<true, 512, 512, 512, true>(shm, S, [=](const GUnit& u, const f32x4 (&acc)[2][2][4][2], int r0, int c0) {
#pragma unroll
        for (int ai = 0; ai < 2; ++ai)
#pragma unroll
            for (int m = 0; m < 4; ++m) { f32x4 h0, h1; const f32x4 a0 = acc[ai][0][m][0] * F8_WINV, a1 = acc[ai][0][m][1] * F8_WINV, b0 = acc[ai][1][m][0] * F8_WINV, b1 = acc[ai][1][m][1] * F8_WINV;
#pragma unroll
                for (int j = 0; j < 4; ++j) { h0[j] = a0[j] * sigmoidf_(a0[j]) * b0[j]; h1[j] = a1[j] * sigmoidf_(a1[j]) * b1[j]; }
                const u32x2 hv = {f8pack4(h0[0], h0[1], h0[2], h0[3]), f8pack4(h1[0], h1[1], h1[2], h1[3])};
                stg((u32x2*)(hb + ((size_t)S.slot0(u) + r0 + ai * 128 + m * 16) * 1024 + u.pn * 128 + c0), hv); } });
}
DEV void phase_moe_down(const Params& p, const SetDesc& sd, int layer, char* shm) {
    SchedMoe S; S.A = p.HID(); S.st = nullptr; S.W = p.WdT() + (size_t)layer * 16 * 1024 * 512; S.nRT = sd.rpe / 256; S.rpe = sd.rpe; S.nN = 4; S.wstride = 1024 * 512;
    bf16_t* yb = p.YE(); const float* gt = p.slot_gate();
    gemm_stream<true, 512, 512, 512, true>(shm, S, [=](const GUnit& u, const f32x4 (&acc)[2][2][4][2], int r0, int c0) {
#pragma unroll
        for (int ai = 0; ai < 2; ++ai) {
            float gv[4];
#pragma unroll
            for (int m = 0; m < 4; ++m) gv[m] = ldg(gt + (size_t)S.slot0(u) + r0 + ai * 128 + m * 16) * F8_WINV;
#pragma unroll
            for (int m = 0; m < 4; ++m) { const size_t sl = (size_t)S.slot0(u) + r0 + ai * 128 + m * 16; const float g = gv[m];
                bf16_t* o = yb + sl * 1024 + u.pn * 256 + c0; store8bf(o, acc[ai][0][m][0] * g, acc[ai][0][m][1] * g); store8bf(o + 128, acc[ai][1][m][0] * g, acc[ai][1][m][1] * g); } } });
}

DEV void compact4(const int (&sl)[16], int (&c)[4], int& n) {
    n = 0; c[0] = -1; c[1] = -1; c[2] = -1; c[3] = -1;
#pragma unroll
    for (int e = 0; e < 16; ++e) if (sl[e] >= 0) { c[0] = (n == 0) ? sl[e] : c[0]; c[1] = (n == 1) ? sl[e] : c[1]; c[2] = (n == 2) ? sl[e] : c[2]; c[3] = (n == 3) ? sl[e] : c[3]; ++n; }
}
DEV void phase_combine(const Params& p, const SetDesc& sd, int layer, char* shm) {
    const int tid = TID(), lane = tid & 63, wv = tid >> 6;
    const float* g3 = p.norm_gain + ((size_t)layer * 4 + 3) * 1024;
    float* xdb = xdst_base(p, sd);
    const int stride = 8; const int rpb_ = (sd.nrows + (int)gridDim.x - 1) / (int)gridDim.x; const int row_end = min(sd.nrows, ((int)blockIdx.x + 1) * rpb_);
    int row = __builtin_amdgcn_readfirstlane((int)blockIdx.x * rpb_ + wv);
    float* par = (float*)shm;
    __syncthreads();
    { const float* mdb = mod_row(p, sd, layer, min((int)blockIdx.x * rpb_, sd.nrows - 1)); stage_params(par, g3, mdb + 5120, nullptr, nullptr, nullptr); }
    __syncthreads();
    int raw[16]; int cc[4], cn[4]; int nc = 0, nn = 0;
    u32x4 mc[4][2], mn[4][2]; f32x4 xc[4], xn[4];
#define CMB_SLOTS(r_) do { _Pragma("unroll") for (int e = 0; e < 16; ++e) raw[e] = ldg(p.token_slots() + (size_t)(r_) * 16 + e); } while (0)
#define CMB_DATA(r_, c_, n_, m_, x_) do { _Pragma("unroll") for (int k = 0; k < 4; ++k) { \
            if (k < (n_)) { const bf16_t* yr = p.YE() + (size_t)(c_)[k] * 1024 + lane * 8; (m_)[k][0] = ldg((const u32x4*)yr); (m_)[k][1] = ldg((const u32x4*)(yr + 512)); } \
            else { (m_)[k][0] = (u32x4){0u, 0u, 0u, 0u}; (m_)[k][1] = (u32x4){0u, 0u, 0u, 0u}; } } \
        _Pragma("unroll") for (int i = 0; i < 4; ++i) (x_)[i] = ldg((const f32x4*)(xdb + (size_t)(r_) * 1024 + (i >> 1) * 512 + lane * 8 + (i & 1) * 4)); } while (0)
    if (row < row_end) { CMB_SLOTS(row); compact4(raw, cc, nc); CMB_DATA(row, cc, nc, mc, xc); if (row + stride < row_end) CMB_SLOTS(row + stride); }
    for (; row < row_end; row += stride) {
        const int rn = row + stride;
        if (rn < row_end) { compact4(raw, cn, nn); CMB_DATA(rn, cn, nn, mn, xn); if (rn + stride < row_end) CMB_SLOTS(rn + stride); }
        float* xd = xdb + (size_t)row * 1024;
        float y[16];
#pragma unroll
        for (int j = 0; j < 16; ++j) y[j] = 0.f;
        if (nc <= 4) {
#pragma unroll
            for (int k = 0; k < 4; ++k)
                if (k < nc) {
#pragma unroll
                    for (int hlf = 0; hlf < 2; ++hlf) { const u32x4 m = mc[k][hlf];
                        y[hlf * 8 + 0] += lo16(m.x); y[hlf * 8 + 1] += hi16(m.x); y[hlf * 8 + 2] += lo16(m.y); y[hlf * 8 + 3] += hi16(m.y);
                        y[hlf * 8 + 4] += lo16(m.z); y[hlf * 8 + 5] += hi16(m.z); y[hlf * 8 + 6] += lo16(m.w); y[hlf * 8 + 7] += hi16(m.w); } }
        } else {
            for (int e = 0; e < 16; ++e) { const int sl_ = ldg(p.token_slots() + (size_t)row * 16 + e);
                if (sl_ >= 0) { const bf16_t* yr = p.YE() + (size_t)sl_ * 1024 + lane * 8;
#pragma unroll
                    for (int hlf = 0; hlf < 2; ++hlf) { const u32x4 m = ldg((const u32x4*)(yr + hlf * 512));
                        y[hlf * 8 + 0] += lo16(m.x); y[hlf * 8 + 1] += hi16(m.x); y[hlf * 8 + 2] += lo16(m.y); y[hlf * 8 + 3] += hi16(m.y);
                        y[hlf * 8 + 4] += lo16(m.z); y[hlf * 8 + 5] += hi16(m.z); y[hlf * 8 + 6] += lo16(m.w); y[hlf * 8 + 7] += hi16(m.w); } } }
        }
        float ss = 0.f;
#pragma unroll
        for (int j = 0; j < 16; ++j) ss += y[j] * y[j];
        ss = wave_sum(ss);
        const float rstd = rsqrtf(ss * (1.0f / 1024.0f) + RMS_EPS);
#pragma unroll
        for (int hlf = 0; hlf < 2; ++hlf)
#pragma unroll
            for (int q = 0; q < 2; ++q) { const int c0 = hlf * 512 + lane * 8 + q * 4; f32x4 xv = xc[hlf * 2 + q];
#pragma unroll
                for (int j = 0; j < 4; ++j) xv[j] += par[1024 + c0 + j] * (y[hlf * 8 + q * 4 + j] * rstd * par[c0 + j]);
                stg((f32x4*)(xd + c0), xv); }
        nc = nn;
#pragma unroll
        for (int k = 0; k < 4; ++k) { cc[k] = cn[k]; mc[k][0] = mn[k][0]; mc[k][1] = mn[k][1]; }
#pragma unroll
        for (int i = 0; i < 4; ++i) xc[i] = xn[i];
    }
#undef CMB_SLOTS
#undef CMB_DATA
}

constexpr int WQ_WORD0 = 4096;
template <class F> DEV void wq_run(const Params& p, int qidx, int ntasks, char* shm, F&& task) {
    unsigned* ctr = p.bar() + WQ_WORD0 + 64 * qidx;
    volatile int* slot = (volatile int*)(shm + 131072 + 64);
    const int tid = TID();
    int cur = blockIdx.x;
    while (cur < ntasks) {
        unsigned pend = 0u;
        if (tid == 0) pend = atomicAdd(ctr, 1u);
        task(cur);
        __syncthreads();
        if (tid == 0) *slot = (int)gridDim.x + (int)pend;
        __syncthreads();
        cur = *slot;
    }
}

template <int PH> DEV void do_phase(const Params& p, int layer, int is_ctx, int grp, char* shm) {
    const SetDesc sd = make_set(is_ctx, grp);
    if constexpr (PH == -1) phase_prologue(p, shm);
    if constexpr (PH == 0) phase_norm1(p, sd, layer, shm);
    if constexpr (PH == 1) phase_proj_a(p, sd, layer, shm);
    const int qbase = ((layer * 3 + (is_ctx ? 0 : grp + 1)) * 13 + (PH < 0 ? 0 : PH)) * 2;
    if constexpr (PH == 2) { wq_run(p, qbase, sd.nsamp * 4 * sd.ntb, shm, [&](int t) { mlstm_stepA_task(p, sd, layer, t, shm); }); if (!(is_ctx && layer == 1)) phase_pool(p, sd); }
    if constexpr (PH == 3) {
        for (int t = blockIdx.x; t < sd.nsamp * 32; t += gridDim.x) mlstm_stepB_task(p, sd, t);
        if (!(is_ctx && layer == 1)) {
            const int nq = (is_ctx ? (CTX / 64) : ROWS) / 2;
            wq_run(p, qbase, sd.nsamp * nq * 4, shm, [&](int t) { na_task(p, sd, layer, t / (nq * 4), (t >> 2) % nq, t & 3, shm); });
        }
    }
    if constexpr (PH == 4) { wq_run(p, qbase, sd.nsamp * 4 * sd.ntb, shm, [&](int t) { mlstm_stepC_task(p, sd, layer, t, shm); }); }
    if constexpr (PH == 5) phase_proj_b(p, sd, layer, shm);
    if constexpr (PH == 6) phase_merge(p, sd, layer, shm);
    if constexpr (PH == 7) phase_outproj(p, sd, layer, shm);
    if constexpr (PH == 8) phase_postmix(p, sd, layer, shm);
    if constexpr (PH == 9) { for (int t = blockIdx.x; t < sd.nsamp * 16; t += gridDim.x) topk_task(p, sd, t, shm); }
    if constexpr (PH == 10) phase_moe_gu(p, sd, layer, shm);
    if constexpr (PH == 11) phase_moe_down(p, sd, layer, shm);
    if constexpr (PH == 12) phase_combine(p, sd, layer, shm);
}

#ifndef CPU_EMU
template <int PH> __global__ void __launch_bounds__(NTHREADS, 2) k_phase(Params p, int layer, int is_ctx, int grp) {
    DYN_LDS(shm);
    do_phase<PH>(p, layer, is_ctx, grp, shm);
}
#ifndef DBL_MASK
#define DBL_MASK 0
#endif
#define RUNPH(PH) do { do_phase<PH>(p, layer, is_ctx, grp, shm); xcd_barrier(bar); if ((DBL_MASK >> (PH)) & 1) { do_phase<PH>(p, layer, is_ctx, grp, shm); xcd_barrier(bar); } } while (0)
__global__ void __launch_bounds__(NTHREADS, 2) k_mega(Params p) {
    DYN_LDS(shm);
    uint4* xbw = (uint4*)(shm + 131072);
    if (threadIdx.x == 0) *xbw = make_uint4(0u, 0u, 0u, 0u);
    __syncthreads();
    XcdBarrier bar = xcd_barrier_post(p.bar(), (volatile LAS unsigned*)xbw);
    do_phase<-1>(p, 0, 0, 0, shm);
    xcd_barrier(bar);
    for (int layer = 0; layer < 2; ++layer)
        for (int si = 0; si <= NG; ++si) {
            const int is_ctx = si == 0 ? 1 : 0, grp = si == 0 ? 0 : si - 1;
            RUNPH(0); RUNPH(1); RUNPH(2);
            if (is_ctx && layer == 1) { do_phase<3>(p, layer, is_ctx, grp, shm); continue; }
            RUNPH(3); RUNPH(4); RUNPH(5); RUNPH(6); RUNPH(7); RUNPH(8); RUNPH(9); RUNPH(10); RUNPH(11);
            do_phase<12>(p, layer, is_ctx, grp, shm);
        }
}
#endif
}

static Params make_params(void* const* d_in, void* d_out, void* d_ws) {
    Params p{};
    p.x = (const float*)d_in[0]; p.c = (const float*)d_in[1]; p.ctx = (const float*)d_in[2]; p.c_ctx = (const float*)d_in[3];
    p.norm_gain = (const float*)d_in[4]; p.ada_w = (const float*)d_in[5]; p.ada_b = (const float*)d_in[6]; p.w_in = (const float*)d_in[7];
    p.gate_bias = (const float*)d_in[8]; p.pool_w = (const float*)d_in[9]; p.pool_scale = (const float*)d_in[10]; p.rpb = (const float*)d_in[11];
    p.w_branch = (const float*)d_in[12]; p.w_out = (const float*)d_in[13]; p.router_w = (const float*)d_in[14];
    p.w_gate = (const float*)d_in[15]; p.w_up = (const float*)d_in[16]; p.w_down = (const float*)d_in[17];
    p.out = (float*)d_out; p.ws = (char*)d_ws;
    return p;
}

#ifdef CPU_EMU
int emu_cfg_B = CFG_B, emu_cfg_ROWS = CFG_ROWS, emu_cfg_CTX = CFG_CTX;
const char* g_dumpdir = "data";
static void* g_ws = nullptr;
static void dump_buf(const char* name, int layer, int is_ctx, int grp, const void* ptr, size_t bytes) {
    char nm[512]; snprintf(nm, sizeof nm, "%s/d_L%d_%s%d_%s.bin", g_dumpdir, layer, is_ctx ? "c" : "g", grp, name);
    FILE* f = fopen(nm, "wb"); fwrite(ptr, 1, bytes, f); fclose(f);
}
static void emu_hook(const Params& p, int layer, int is_ctx, int grp, int ph) {
    const size_t Rn = is_ctx ? RC : RL;
    if (ph == 0) dump_buf("H", layer, is_ctx, grp, p.H(), Rn * 1024 * 2);
    if (ph == 1) dump_buf("PROJ", layer, is_ctx, grp, is_ctx ? p.PROJc() : p.PROJa(), Rn * PWA * 2);
    if (ph == 2) dump_buf("Pb", layer, is_ctx, grp, p.Pb(), Rn * 512 * 2);
    if (ph == 3) dump_buf("Nb", layer, is_ctx, grp, p.Nb(), Rn * 512 * 2);
    if (ph == 4) dump_buf("Mb", layer, is_ctx, grp, p.Mb(), Rn * 512 * 2);
    if (ph == 5) dump_buf("BG", layer, is_ctx, grp, p.BG(), Rn * NBG * 2);
    if (ph == 6) dump_buf("MERGED", layer, is_ctx, grp, p.MERGED(), Rn * 1024 * 2);
    if (ph == 7) dump_buf("Y", layer, is_ctx, grp, p.Y(), Rn * 1024 * 2);
    if (ph == 8) { dump_buf("H2", layer, is_ctx, grp, p.H(), Rn * 1024 * 2); dump_buf("aff", layer, is_ctx, grp, p.aff(), Rn * 16 * 4); }
}
void emu_dump(const char* dir) {
    char nm[512]; snprintf(nm, sizeof nm, "%s/d_mod.bin", dir);
    FILE* f = fopen(nm, "wb"); fwrite((char*)g_ws + WSL.mod, 1, (size_t)2 * (NB + 1) * 6144 * 4, f); fclose(f);
    snprintf(nm, sizeof nm, "%s/d_ctxs.bin", dir);
    f = fopen(nm, "wb"); fwrite((char*)g_ws + WSL.ctxs, 1, (size_t)NB * CTX * 1024 * 4, f); fclose(f);
}
template <int PH> static void emu_run_phase(const Params& p, int layer, int is_ctx, int grp, int nblocks) {
    emu_launch_lambda([=]() { do_phase<PH>(p, layer, is_ctx, grp, emu_blk->smem); }, nblocks, NTHREADS, LDS_BYTES);
    if (PH >= 0) emu_hook(p, layer, is_ctx, grp, PH);
    printf("phase %d layer %d ctx %d grp %d done\n", PH, layer, is_ctx, grp); fflush(stdout);
}
#define LAUNCH_PHASE(PH) emu_run_phase<PH>(p, layer, is_ctx, grp, nblocks)
#else
#define LAUNCH_PHASE(PH) hipLaunchKernelGGL((k_phase<PH>), dim3(nblocks), dim3(NTHREADS), LDS_BYTES, stream, p, layer, is_ctx, grp)
#define SETATTR(PH) (void)hipFuncSetAttribute((const void*)k_phase<PH>, hipFuncAttributeMaxDynamicSharedMemorySize, LDS_BYTES)
#endif

extern "C" void kernel_launch(void* const* d_in, const int* in_sizes, int n_in, void* d_out, int out_size, void* d_ws, size_t ws_size, hipStream_t stream) {
    (void)in_sizes; (void)n_in; (void)out_size;
    if (ws_size < WSL.total) return;
    Params p = make_params(d_in, d_out, d_ws);
#ifdef CPU_EMU
    g_ws = d_ws;
    memset(d_ws, 0xFF, WSL.total);
    memset((char*)d_ws + WSL.bar, 0, 65536);
    const int nblocks = 16;
#else
    const int nblocks = 256;
#if MK_ONE_LAUNCH
    static int grid = 0;
    if (!grid) {
        (void)hipFuncSetAttribute((const void*)k_mega, hipFuncAttributeMaxDynamicSharedMemorySize, LDS_BYTES);
        int dev = 0, cus = 0, per_cu = 0;
        (void)hipGetDevice(&dev);
        (void)hipDeviceGetAttribute(&cus, hipDeviceAttributeMultiprocessorCount, dev);
        (void)hipOccupancyMaxActiveBlocksPerMultiprocessor(&per_cu, (const void*)k_mega, NTHREADS, LDS_BYTES);
        if (per_cu > 1) per_cu = 1;
        grid = cus * per_cu;
        if (grid > 256) grid = 256;
    }
    if (grid <= 0) return;
    (void)hipMemsetAsync(p.bar(), 0, 65536, stream);
    hipLaunchKernelGGL(k_mega, dim3(grid), dim3(NTHREADS), LDS_BYTES, stream, p);
    return;
#else
    static bool attr_done = false;
    if (!attr_done) { SETATTR(-1); SETATTR(0); SETATTR(1); SETATTR(2); SETATTR(3); SETATTR(4); SETATTR(5); SETATTR(6); SETATTR(7); SETATTR(8); SETATTR(9); SETATTR(10); SETATTR(11); SETATTR(12); attr_done = true; }
#endif
#endif
    { const int layer = 0, is_ctx = 0, grp = 0; LAUNCH_PHASE(-1); }
    for (int layer = 0; layer < 2; ++layer)
        for (int si = 0; si <= NG; ++si) {
            const int is_ctx = si == 0 ? 1 : 0, grp = si == 0 ? 0 : si - 1;
            LAUNCH_PHASE(0); LAUNCH_PHASE(1); LAUNCH_PHASE(2); LAUNCH_PHASE(3);
            if (is_ctx && layer == 1) continue;
            LAUNCH_PHASE(4); LAUNCH_PHASE(5); LAUNCH_PHASE(6); LAUNCH_PHASE(7); LAUNCH_PHASE(8); LAUNCH_PHASE(9); LAUNCH_PHASE(10); LAUNCH_PHASE(11); LAUNCH_PHASE(12);
        }
}
```

```cpp
#ifdef CPU_EMU
#include "emu.h"
#define DYN_LDS(p) char* p = emu_blk->smem
#define WAIT_V(n)
#define WAIT_L(n)
#define HIDE(v)
#define CBAR()
#else
#include <hip/hip_runtime.h>
#define DYN_LDS(p) extern __shared__ __attribute__((aligned(16))) char p[]
#define WAIT_V(n) asm volatile("s_waitcnt vmcnt(" #n ")" ::: "memory")
#define WAIT_L(n) asm volatile("s_waitcnt lgkmcnt(" #n ")" ::: "memory")
#define HIDE(v) asm volatile("" : "+v"(v))
#define CBAR() asm volatile("" ::: "memory")
#endif
#include <stdint.h>
#include <stddef.h>

#ifndef CFG_B
#define CFG_B 32
#define CFG_ROWS 32
#define CFG_CTX 256
#define CFG_G 16
#endif
#ifndef MK_ONE_LAUNCH
#define MK_ONE_LAUNCH 1
#endif

#define DEV __device__ __forceinline__
typedef short s16x4 __attribute__((ext_vector_type(4)));
#ifdef CPU_EMU
#define TR16(ptr) emu_tr16((const void*)(ptr))
#else
typedef __attribute__((address_space(3))) s16x4 lds_s16x4;
#define TR16(ptr) __builtin_amdgcn_ds_read_tr16_b64_v4i16((lds_s16x4*)(ptr))
#endif
#ifdef CPU_EMU
#define TID() (threadIdx.x)
#else
#define TID() ({ int t_ = threadIdx.x; asm volatile("" : "+v"(t_)); t_; })
#endif

typedef unsigned short bf16_t;
typedef short bf16x8 __attribute__((ext_vector_type(8)));
typedef float f32x4 __attribute__((ext_vector_type(4)));
typedef unsigned u32x2 __attribute__((ext_vector_type(2)));
typedef unsigned u32x4 __attribute__((ext_vector_type(4)));

namespace {
constexpr int D = 1024, NB = CFG_B, ROWS = CFG_ROWS, SEQ = ROWS * 64, CTX = CFG_CTX, G = CFG_G, NG = NB / G;
constexpr int RL = G * SEQ, RC = NB * CTX, RMAX = RL > RC ? RL : RC;
constexpr int PWA = 3840, NBG = 3072, PWT = PWA + NBG, PWSRC = 6672, C_SPLIT = 3600;
constexpr int C_QM = 0, C_KM = 256, C_PU = 512, C_GM = 1024, C_PADA = 1040, C_F8 = 1280, C_QN = 1280, C_KN = 1792, C_VM = 2304, C_OM = 2816, C_VN = 3328;
constexpr int proj_col(int n) { return n < 512 ? n : n < 1536 ? n + 1792 : n < 1552 ? n - 512 : n < 2064 ? n - 1040 : n < 3088 ? n - 784 : n + 240; }
static_assert(proj_col(512) == C_VM && proj_col(1024) == C_OM && proj_col(1536) == C_GM && proj_col(1552) == C_PU && proj_col(2064) == C_QN && proj_col(2576) == C_KN && proj_col(3088) == C_VN && proj_col(3599) == PWA - 1, "projection column map");
constexpr int NTBL = SEQ / 128, NTBC = CTX / 128;
constexpr int ilog2(int x) { return x <= 1 ? 0 : 1 + ilog2(x >> 1); }
constexpr int LGSEQ = ilog2(SEQ), LGCTX = ilog2(CTX);
static_assert((1 << LGSEQ) == SEQ && (1 << LGCTX) == CTX, "sequence lengths must be powers of two");
constexpr int cdiv(int a, int b) { return (a + b - 1) / b; }
constexpr int RPE_L = cdiv(G * (SEQ / 8), 256) * 256, RPE_C = cdiv(NB * (CTX / 8), 256) * 256, RPE_MAX = RPE_L > RPE_C ? RPE_L : RPE_C;
constexpr int NSLOT = 16 * RPE_MAX;
constexpr int NTHREADS = 512;
constexpr int GT_MAXU = 10;
constexpr int LDS_BYTES = 131072 + 256 + GT_MAXU * 1024;
constexpr int NST_L = G * 4 * 2 * NTBL, NST_C = NB * 4 * 2 * NTBC, NST = NST_L > NST_C ? NST_L : NST_C;
constexpr int NCI = NB * 4 * 2;
constexpr float RMS_EPS = 1e-6f;

struct WsLayout { size_t bar, WinT, WbT, WoT, WguT, WdT, mod, rope, ctxs, PROJc, CiC, Cin_, Cim, H, H8, PROJa, Sst, Cin, Mb, Pb, Nb, Sn, Ssc, Cn, Cm, aff, slot_token, slot_gate, token_slots, HID, YE, BG, MERGED, Y, total; };
constexpr size_t al(size_t x) { return (x + 255) / 256 * 256; }
constexpr size_t smax(size_t a, size_t b) { return a > b ? a : b; }
constexpr WsLayout make_layout() {
    WsLayout L{}; size_t o = 0;
    L.bar = o; o += al(65536);
    L.WinT = o; o += al((size_t)2 * PWT * 1024 * 2);
    L.WbT = o; o += al((size_t)2 * 3 * 1024 * 512 * 2);
    L.WoT = o; o += al((size_t)2 * 1024 * 1024 * 2);
    L.WguT = o; o += al((size_t)2 * 16 * 2048 * 1024 * 2);
    L.WdT = o; o += al((size_t)2 * 16 * 1024 * 1024 * 2);
    L.mod = o; o += al((size_t)2 * (NB + 1) * 6144 * 4);
    L.rope = o; o += al((size_t)(ROWS + 64) * 16 * 2 * 4);
    L.ctxs = o; o += al((size_t)NB * CTX * 1024 * 4);
    L.PROJc = o; o += al((size_t)RC * PWA * 2);
    L.CiC = o; o += al((size_t)NCI * 8192 * 4);
    L.Cin_ = o; o += al((size_t)NCI * 64 * 4);
    L.Cim = o; o += al((size_t)NCI * 4 * 4);
    L.H = o; o += al((size_t)RMAX * 1024 * 2);
    L.H8 = o; o += al((size_t)RMAX * 1024);
    const size_t x0 = o;
    L.PROJa = o; o += al((size_t)RMAX * PWA * 2);
    L.Sst = o; o += al((size_t)NST * 8192 * 4);
    L.Cin = o; o += al((size_t)NST * 8192 * 2);
    const size_t hid = al((size_t)NSLOT * 1024 * 2);
    o = x0 + smax(o - x0, 2 * hid);
    L.BG = x0; L.HID = x0; L.YE = x0 + hid;
    L.Mb = o; o += al((size_t)RMAX * 512 * 2);
    L.Pb = o; o += al((size_t)RMAX * 512 * 2);
    L.Nb = o; o += al((size_t)RMAX * 512 * 2);
    L.MERGED = L.H; L.Y = L.Mb;
    L.Sn = o; o += al((size_t)NST * 64 * 4);
    L.Ssc = o; o += al((size_t)NST * 4 * 4);
    L.Cn = o; o += al((size_t)NST * 64 * 4);
    L.Cm = o; o += al((size_t)NST * 4 * 4);
    L.aff = o; o += al((size_t)RMAX * 16 * 4);
    L.slot_token = o; o += al((size_t)NSLOT * 4);
    L.slot_gate = o; o += al((size_t)NSLOT * 4);
    L.token_slots = o; o += al((size_t)RMAX * 16 * 4);
    L.total = o;
    return L;
}
constexpr WsLayout WSL = make_layout();
static_assert((size_t)RMAX * NBG * 2 <= (size_t)RMAX * PWA * 2, "BG overlay must fit in PROJa");
static_assert(CFG_B != 32 || WSL.total <= ((size_t)1 << 30), "workspace budget");

struct Params {
    const float *x, *c, *ctx, *c_ctx, *norm_gain, *ada_w, *ada_b, *w_in, *gate_bias, *pool_w, *pool_scale, *rpb, *w_branch, *w_out, *router_w, *w_gate, *w_up, *w_down;
    float* out;
    char* ws;
#ifdef CPU_EMU
#define WSF(T, name) __device__ __host__ __forceinline__ T* name() const { return (T*)(ws + WSL.name); }
#else
#if defined(__HIP_DEVICE_COMPILE__)
#define WSF(T, name) __device__ __host__ __forceinline__ T* name() const { char* w_ = ws; asm volatile("" : "+s"(w_)); return (T*)(__attribute__((address_space(1))) T*)(w_ + WSL.name); }
#else
#define WSF(T, name) __device__ __host__ __forceinline__ T* name() const { return (T*)(ws + WSL.name); }
#endif
#endif
    WSF(unsigned, bar) WSF(bf16_t, WinT) WSF(bf16_t, WbT) WSF(bf16_t, WoT) WSF(bf16_t, WguT) WSF(bf16_t, WdT)
    WSF(float, mod) WSF(float, rope) WSF(float, ctxs) WSF(bf16_t, PROJc) WSF(float, CiC) WSF(float, Cin_) WSF(float, Cim)
    WSF(bf16_t, H) WSF(unsigned char, H8) WSF(bf16_t, PROJa) WSF(float, Sst) WSF(bf16_t, Cin) WSF(bf16_t, Mb) WSF(bf16_t, Pb) WSF(bf16_t, Nb)
    WSF(float, Sn) WSF(float, Ssc) WSF(float, Cn) WSF(float, Cm) WSF(float, aff) WSF(int, slot_token) WSF(float, slot_gate) WSF(int, token_slots)
    WSF(bf16_t, HID) WSF(bf16_t, YE) WSF(bf16_t, BG) WSF(bf16_t, MERGED) WSF(bf16_t, Y)
#undef WSF
};

struct SetDesc { int is_ctx, nrows, samp0, nsamp, lgseq, ntb, cap, rpe; };
DEV SetDesc make_set(int is_ctx, int grp) {
    SetDesc s;
    s.is_ctx = is_ctx;
    if (is_ctx) { s.nrows = RC; s.samp0 = 0; s.nsamp = NB; s.lgseq = LGCTX; s.ntb = NTBC; s.cap = CTX / 8; s.rpe = RPE_C; }
    else { s.nrows = RL; s.samp0 = grp * G; s.nsamp = G; s.lgseq = LGSEQ; s.ntb = NTBL; s.cap = SEQ / 8; s.rpe = RPE_L; }
    return s;
}

#ifdef CPU_EMU
#define GAS
#else
#define GAS __attribute__((address_space(1)))
#endif
template <class T> DEV T ldg(const T* p) { return *(const GAS T*)p; }
template <class T> DEV void stg(T* p, const T& v) { *(GAS T*)p = v; }
DEV float bf2f(bf16_t v) { return __uint_as_float(((unsigned)v) << 16); }
DEV bf16_t f2bf(float f) { unsigned u = __float_as_uint(f); u += 0x7FFFu + ((u >> 16) & 1u); return (bf16_t)(u >> 16); }
#if defined(__HIP_DEVICE_COMPILE__)
typedef __bf16 bf16n2 __attribute__((ext_vector_type(2)));
typedef float f32n2 __attribute__((ext_vector_type(2)));
DEV unsigned pack2(float lo, float hi) { f32n2 v = {lo, hi}; bf16n2 r = __builtin_convertvector(v, bf16n2); return __builtin_bit_cast(unsigned, r); }
#else
DEV unsigned pack2(float lo, float hi) { return (unsigned)f2bf(lo) | ((unsigned)f2bf(hi) << 16); }
#endif
DEV float lo16(unsigned u) { return __uint_as_float(u << 16); }
DEV float hi16(unsigned u) { return __uint_as_float(u & 0xFFFF0000u); }
#if defined(__HIP_DEVICE_COMPILE__)
DEV float frcp(float x) { return __builtin_amdgcn_rcpf(x); }
#else
DEV float frcp(float x) { return 1.0f / x; }
#endif
#if defined(__HIP_DEVICE_COMPILE__)
DEV float sigmoidf_(float x) { return __builtin_amdgcn_rcpf(1.0f + __expf(-x)); }
#else
DEV float sigmoidf_(float x) { return 1.0f / (1.0f + __expf(-x)); }
#endif
DEV float logsigmoidf_(float x) { return fminf(x, 0.0f) - __logf(1.0f + __expf(-fabsf(x))); }
template <int M> DEV float shx(float v) {
#if defined(__HIP_DEVICE_COMPILE__)
    const unsigned u = __builtin_bit_cast(unsigned, v);
    if constexpr (M == 1) return __builtin_bit_cast(float, __builtin_amdgcn_update_dpp(u, u, 0xB1, 0xF, 0xF, false));
    else if constexpr (M == 2) return __builtin_bit_cast(float, __builtin_amdgcn_update_dpp(u, u, 0x4E, 0xF, 0xF, false));
    else if constexpr (M == 4) { const unsigned t = __builtin_amdgcn_update_dpp(u, u, 0x141, 0xF, 0xF, false);
        return __builtin_bit_cast(float, __builtin_amdgcn_update_dpp(t, t, 0x1B, 0xF, 0xF, false)); }
    else if constexpr (M == 8) return __builtin_bit_cast(float, __builtin_amdgcn_update_dpp(u, u, 0x128, 0xF, 0xF, false));
    else if constexpr (M == 16) { const auto r = __builtin_amdgcn_permlane16_swap(u, u, false, false); return __builtin_bit_cast(float, (threadIdx.x & 16) ? r[0] : r[1]); }
    else { const auto r = __builtin_amdgcn_permlane32_swap(u, u, false, false); return __builtin_bit_cast(float, (threadIdx.x & 32) ? r[0] : r[1]); }
#else
    return __shfl_xor(v, M);
#endif
}
DEV float wave_sum(float v) { v += shx<32>(v); v += shx<16>(v); v += shx<8>(v); v += shx<4>(v); v += shx<2>(v); v += shx<1>(v); return v; }
DEV bf16x8 mk8(u32x2 lo, u32x2 hi) { u32x4 v = {lo.x, lo.y, hi.x, hi.y}; return __builtin_bit_cast(bf16x8, v); }
DEV bf16x8 mk8(u32x4 v) { return __builtin_bit_cast(bf16x8, v); }
DEV bf16x8 mk8(s16x4 lo, s16x4 hi) { return __builtin_shufflevector(lo, hi, 0, 1, 2, 3, 4, 5, 6, 7); }
DEV f32x4 mfma16(bf16x8 a, bf16x8 b, f32x4 c) { return __builtin_amdgcn_mfma_f32_16x16x32_bf16(a, b, c, 0, 0, 0); }
DEV unsigned f8enc1(float x) {
    const unsigned sgn = x < 0.f ? 0x80u : 0u; float a = x < 0.f ? -x : x; if (!(a < 448.f)) a = 448.f;
    if (a < 0.015625f) { const int q = (int)(a * 512.f + 0.5f); const float r = a * 512.f; int qq = q; if ((float)q - r == 0.5f && (q & 1)) qq = q - 1; return sgn | (unsigned)qq; }
    int e = 0; float m = a; while (m >= 2.f) { m *= 0.5f; ++e; } while (m < 1.f) { m *= 2.f; --e; }
    const float r = (m - 1.f) * 8.f; int q = (int)(r + 0.5f); if ((float)q - r == 0.5f && (q & 1)) --q;
    if (q == 8) { q = 0; ++e; }
    return sgn | (unsigned)((e + 7) << 3) | (unsigned)q;
}
#if defined(__HIP_DEVICE_COMPILE__)
DEV unsigned f8pack4(float a, float b, float c, float d) {
    a = __builtin_amdgcn_fmed3f(a, -448.f, 448.f); b = __builtin_amdgcn_fmed3f(b, -448.f, 448.f); c = __builtin_amdgcn_fmed3f(c, -448.f, 448.f); d = __builtin_amdgcn_fmed3f(d, -448.f, 448.f);
    int w = 0; w = __builtin_amdgcn_cvt_pk_fp8_f32(a, b, w, false); w = __builtin_amdgcn_cvt_pk_fp8_f32(c, d, w, true); return (unsigned)w; }
#else
DEV unsigned f8pack4(float a, float b, float c, float d) { return f8enc1(a) | (f8enc1(b) << 8) | (f8enc1(c) << 16) | (f8enc1(d) << 24); }
#endif
#ifdef CPU_EMU
DEV f32x4 mfma_f8(bf16x8 a0, bf16x8 a1, bf16x8 b0, bf16x8 b1, f32x4 c) { return emu_mfma_f8(a0, a1, b0, b1, c); }
#else
typedef int i32x4 __attribute__((ext_vector_type(4)));
typedef int i32x8 __attribute__((ext_vector_type(8)));
DEV f32x4 mfma_f8(bf16x8 a0, bf16x8 a1, bf16x8 b0, bf16x8 b1, f32x4 c) {
    const i32x8 A = __builtin_shufflevector(__builtin_bit_cast(i32x4, a0), __builtin_bit_cast(i32x4, a1), 0, 1, 2, 3, 4, 5, 6, 7);
    const i32x8 B = __builtin_shufflevector(__builtin_bit_cast(i32x4, b0), __builtin_bit_cast(i32x4, b1), 0, 1, 2, 3, 4, 5, 6, 7);
    return __builtin_amdgcn_mfma_scale_f32_16x16x128_f8f6f4(A, B, c, 0, 0, 0, 0, 0, 0);
}
#endif
constexpr float F8_WSCALE = 64.0f, F8_WINV = 1.0f / 64.0f;
DEV void store8bf(bf16_t* o, f32x4 a, f32x4 b) { u32x4 v = {pack2(a[0], a[1]), pack2(a[2], a[3]), pack2(b[0], b[1]), pack2(b[2], b[3])}; stg((u32x4*)o, v); }

#ifndef CPU_EMU
#define XB_TMO      128
#define XB_XCNT(j)  (256  + 64 * (j))
#define XB_XSUB(j)  (1280 + 64 * (j))
#define XB_XGEN(j)  (2304 + 64 * (j))
#define XB_TOP      3328
#define XB_TOPGEN   3392
#define XCD_BAR_WORDS 3456
#define XB_SPIN_CAP (1u << 18)
#define LAS __attribute__((address_space(3)))
__device__ __forceinline__ unsigned xb_ld(unsigned* p)              { return __hip_atomic_load(p, __ATOMIC_RELAXED, __HIP_MEMORY_SCOPE_AGENT); }
__device__ __forceinline__ unsigned xb_add(unsigned* p, unsigned v) { return __hip_atomic_fetch_add(p, v, __ATOMIC_RELAXED, __HIP_MEMORY_SCOPE_AGENT); }
__device__ __forceinline__ unsigned xb_xcc_id() { return (unsigned)__builtin_amdgcn_s_getreg((3 << 11) | 20) & 0xFu; }
#define XB_SPIN(cond, bar) do { unsigned _sp = 0; while (cond) { __builtin_amdgcn_s_sleep(1); \
    if ((++_sp & 255u) == 0u) { if (xb_ld(&(bar)[XB_TMO])) break; if (_sp > XB_SPIN_CAP) { atomicAdd(&(bar)[XB_TMO], 1u); break; } } } } while (0)
struct XcdBarrier { unsigned* bar; unsigned x; volatile LAS unsigned* st; };
__device__ __forceinline__ XcdBarrier xcd_barrier_post(unsigned* bar, volatile LAS unsigned* st) {
    XcdBarrier b; b.bar = bar; b.x = xb_xcc_id(); b.st = st;
    if (threadIdx.x == 0) (void)xb_add(&bar[XB_XCNT(b.x)], 1u);
    return b;
}
__device__ __forceinline__ void xcd_barrier_complete(unsigned* bar, unsigned x, unsigned& nloc, unsigned& nx) {
    const unsigned Gd = gridDim.x * gridDim.y * gridDim.z;
    unsigned sum, cnt, mine, sp = 0u;
    for (;;) {
        sum = 0u; cnt = 0u; mine = 0u;
#pragma unroll
        for (unsigned j = 0; j < 16; ++j) { const unsigned c = xb_ld(&bar[XB_XCNT(j)]); sum += c; cnt += (c > 0u) ? 1u : 0u; mine = (j == x) ? c : mine; }
        if (sum == Gd) break;
        __builtin_amdgcn_s_sleep(1);
        if ((++sp & 255u) == 0u) { if (xb_ld(&bar[XB_TMO])) break; if (sp > XB_SPIN_CAP) { atomicAdd(&bar[XB_TMO], 1u); break; } }
    }
    nloc = mine > 0u ? mine : 1u; nx = cnt > 0u ? cnt : 1u;
}
__device__ __forceinline__ void xcd_barrier(const XcdBarrier& b) {
    asm volatile("s_waitcnt vmcnt(0)" ::: "memory");
    __syncthreads();
    if (threadIdx.x == 0) {
        unsigned* bar = b.bar;
        unsigned bx = b.x; asm volatile("" : "+s"(bx));
        __builtin_amdgcn_s_waitcnt(0);
        unsigned nloc = b.st[0], nx = b.st[1];
        if (nloc == 0u) { xcd_barrier_complete(bar, bx, nloc, nx); b.st[0] = nloc; b.st[1] = nx; }
        const unsigned old = xb_add(&bar[XB_XSUB(bx)], 1u);
        const unsigned gen = old / nloc;
        if (old + 1u == (gen + 1u) * nloc) {
            __builtin_amdgcn_fence(__ATOMIC_RELEASE, "agent");
            asm volatile("s_waitcnt vmcnt(0)" ::: "memory");
            const unsigned og = xb_add(&bar[XB_TOP], 1u);
            const unsigned tg = og / nx;
            if (og + 1u == (tg + 1u) * nx) xb_add(&bar[XB_TOPGEN], 1u);
            else XB_SPIN(xb_ld(&bar[XB_TOPGEN]) == tg, bar);
            __builtin_amdgcn_fence(__ATOMIC_ACQUIRE, "agent");
            xb_add(&bar[XB_XGEN(bx)], 1u);
            asm volatile("s_waitcnt vmcnt(0)" ::: "memory");
        } else {
            XB_SPIN(xb_ld(&bar[XB_XGEN(bx)]) == gen, bar);
            __builtin_amdgcn_fence(__ATOMIC_ACQUIRE, "agent");
            asm volatile("s_waitcnt vmcnt(0)" ::: "memory");
        }
    }
    __syncthreads();
}
#endif

constexpr int BK = 64, HALF = 128, HT_BYTES = HALF * BK * 2;
DEV int lds_byte(int r, int c) { int st = (r >> 4) * 2 + (c >> 5), rr = r & 15, cc = c & 31, ob = rr * 64 + cc * 2; return st * 1024 + (ob ^ (((ob >> 9) & 1) << 5)); }
DEV void stage_rc(int b, int& Rr, int& Cc) { int st = b / 1024, sb = b % 1024, swz = sb ^ (((sb >> 9) & 1) << 5); Rr = (st >> 1) * 16 + swz / 64; Cc = (st & 1) * 32 + (swz % 64) / 2; }
DEV int perm32(int rho) { const int n = rho >> 4, i = rho & 15; return 8 * (i >> 2) + 4 * n + (i & 3); }

DEV bool tile_from_L(int L, int nM, int nN, int& pm, int& pn) {
    const int nwg = nM * nN; if (L >= nwg) return false;
    int wgid = L; { const int q = nwg / 8, r = nwg % 8, xcd = wgid % 8, off = wgid / 8; wgid = (xcd < r ? xcd * (q + 1) : r * (q + 1) + (xcd - r) * q) + off; }
    const int nig = 8 * nN, gid = wgid / nig, fm = gid * 8, gsz = (nM - fm) < 8 ? (nM - fm) : 8;
    pm = fm + ((wgid % nig) % gsz); pn = (wgid % nig) / gsz; return true;
}
DEV bool tile_order(int i, int nM, int nN, int& pm, int& pn) { return tile_from_L(i * (int)gridDim.x + (int)blockIdx.x, nM, nN, pm, pn); }
#ifdef CPU_EMU
#define GLDS16(src, dst) __builtin_amdgcn_global_load_lds((const unsigned*)(src), (unsigned*)((dst) + (TID() & 63) * 16), 16, 0, 0)
#else
#define GLDS16(src, dst) __builtin_amdgcn_global_load_lds((const unsigned*)(src), (unsigned*)(dst), 16, 0, 0)
#endif

#define BAR __builtin_amdgcn_s_barrier()
#define SCHED __builtin_amdgcn_sched_barrier(0)
struct GUnit { int pm, pn, aux; };
template <class T> struct is_void_ { static constexpr bool v = false; };
template <> struct is_void_<void> { static constexpr bool v = true; };
template <class Epi> DEV bool call_epi(const Epi& e, const GUnit& u, f32x4 (&acc)[2][2][4][2], int r0, int c0) {
    if constexpr (is_void_<decltype(e(u, acc, r0, c0))>::v) { e(u, acc, r0, c0); return false; } else return e(u, acc, r0, c0);
}
template <bool GATHER, int LDA_, int LDB_, int K_, bool F8 = false, class Sched, class Epi>
DEV void gemm_stream(char* shm, const Sched& S, const Epi& epi) {
#define SA(b, h) (shm + ((b) * 2 + (h)) * HT_BYTES)
#define SB(b, h) (shm + (4 + (b) * 2 + (h)) * HT_BYTES)
#define STG_B(P, bp) do { GLDS16((bp) + voffB, (P) + ldsb0); GLDS16((bp) + voffB + 64 * LDB_, (P) + ldsb0 + 8192); } while (0)
#define STG_A(P, ap, h, gv) do { if (GATHER) { GLDS16((ap) + gv[h][0], (P) + ldsb0); GLDS16((ap) + gv[h][1], (P) + ldsb0 + 8192); } \
    else { GLDS16((ap) + voffA + (h) * 128 * LDA_, (P) + ldsb0); GLDS16((ap) + voffA + ((h) * 128 + 64) * LDA_, (P) + ldsb0 + 8192); } } while (0)
#define LDA(dst, b, h) _Pragma("unroll") for (int m = 0; m < 4; ++m) _Pragma("unroll") for (int k = 0; k < 2; ++k) \
    dst[m][k] = *reinterpret_cast<const bf16x8*>(SA(b, h) + aoff + m * 2048 + k * 1024)
#define LDB(dst, b, h) _Pragma("unroll") for (int n = 0; n < 2; ++n) _Pragma("unroll") for (int k = 0; k < 2; ++k) \
    dst[n][k] = *reinterpret_cast<const bf16x8*>(SB(b, h) + boff + n * 2048 + k * 1024)
#define MMA(ai, bj, At_, Bx_) do { __builtin_amdgcn_s_setprio(1); \
    if constexpr (F8) { _Pragma("unroll") for (int m = 0; m < 4; ++m) _Pragma("unroll") for (int n = 0; n < 2; ++n) \
      acc[ai][bj][m][n] = mfma_f8(Bx_[n][0], Bx_[n][1], At_[m][0], At_[m][1], acc[ai][bj][m][n]); } \
    else { _Pragma("unroll") for (int m = 0; m < 4; ++m) _Pragma("unroll") for (int n = 0; n < 2; ++n) _Pragma("unroll") for (int k = 0; k < 2; ++k) \
      acc[ai][bj][m][n] = mfma16(Bx_[n][k], At_[m][k], acc[ai][bj][m][n]); } \
    __builtin_amdgcn_s_setprio(0); } while (0)
    constexpr int nt = K_ / BK;
    const int tid = TID();
    const int wid = __builtin_amdgcn_readfirstlane(tid >> 6), lane = tid & 63, wr = wid >> 2, wc = wid & 3, fr = lane & 15, fq = lane >> 4;
    const int ldsb0 = wid * 1024;
    int Rr0, Cc0; stage_rc(tid * 16, Rr0, Cc0);
    const int voffA = Rr0 * LDA_ + Cc0;
    const int voffB = ((Rr0 & ~31) + perm32(Rr0 & 31)) * LDB_ + Cc0;
    const int aoff = lds_byte(wr * 64 + fr, fq * 8), boff = lds_byte(wc * 32 + fr, fq * 8);
    GUnit cur, nxt; int ui = 0;
    if (!S.next(0, cur)) return;
    int gc[2][2] = {{0, 0}, {0, 0}};
    int* gtab = (int*)(shm + 131072 + 256);
    if (GATHER) {
        __syncthreads();
        { GUnit u; for (int i = 0; i < GT_MAXU && S.next(i, u); ++i) { if (tid < 256) gtab[i * 256 + tid] = S.grow(u, tid) * LDA_; } }
        __syncthreads();
#pragma unroll
        for (int h = 0; h < 2; ++h)
#pragma unroll
            for (int i = 0; i < 2; ++i) gc[h][i] = gtab[h * 128 + i * 64 + Rr0] + Cc0;
    }
    f32x4 acc[2][2][4][2];
#pragma unroll
    for (int a = 0; a < 2; ++a)
#pragma unroll
        for (int b = 0; b < 2; ++b)
#pragma unroll
            for (int m = 0; m < 4; ++m)
#pragma unroll
                for (int n = 0; n < 2; ++n) acc[a][b][m][n] = (f32x4){0.f, 0.f, 0.f, 0.f};
    bf16x8 At[4][2], B0[2][2], B1[2][2];
    const bf16_t* cA = S.a_base(cur); const bf16_t* cB = S.b_base(cur);
    STG_B(SB(0, 0), cB); STG_A(SA(0, 0), cA, 0, gc); STG_B(SB(0, 1), cB + 128 * LDB_); STG_A(SA(0, 1), cA, 1, gc);
    if (wr == 1) BAR;
    WAIT_V(4); BAR;
    STG_B(SB(1, 0), cB + BK); STG_A(SA(1, 0), cA + BK, 0, gc); STG_B(SB(1, 1), cB + 128 * LDB_ + BK);
    WAIT_V(6); BAR;
    for (;;) {
        const bool has_next = S.next(ui + 1, nxt);
        const bf16_t* nA = has_next ? S.a_base(nxt) : cA; const bf16_t* nB = has_next ? S.b_base(nxt) : cB;
#pragma unroll 1
        for (int t = 0; t < nt; t += 2) {
            const bool last = (t == nt - 2);
            const bf16_t* a1 = cA + (t + 1) * BK;
            const bf16_t* a2 = last ? nA : cA + (t + 2) * BK; const bf16_t* b2 = last ? nB : cB + (t + 2) * BK;
            const bf16_t* a3 = a2 + BK; const bf16_t* b3 = b2 + BK;
            LDB(B0, 0, 0); SCHED; LDA(At, 0, 0); STG_A(SA(1, 1), a1, 1, gc);
            if (GATHER && last && has_next) {
#pragma unroll
                for (int h = 0; h < 2; ++h)
#pragma unroll
                    for (int i = 0; i < 2; ++i) gc[h][i] = gtab[(ui + 1) * 256 + h * 128 + i * 64 + Rr0] + Cc0; }
            WAIT_L(8); BAR; WAIT_L(0); MMA(0, 0, At, B0); BAR; SCHED;
            LDB(B1, 0, 1); STG_B(SB(0, 0), b2);
            BAR; WAIT_L(0); MMA(0, 1, At, B1); BAR;
            LDA(At, 0, 1); STG_A(SA(0, 0), a2, 0, gc);
            BAR; WAIT_L(0); MMA(1, 0, At, B0); BAR; SCHED;
            STG_B(SB(0, 1), b2 + 128 * LDB_);
            WAIT_V(6); BAR; MMA(1, 1, At, B1); BAR;
            LDB(B0, 1, 0); SCHED; LDA(At, 1, 0); STG_A(SA(0, 1), a2, 1, gc);
            WAIT_L(8); BAR; WAIT_L(0); MMA(0, 0, At, B0); BAR; SCHED;
            LDB(B1, 1, 1); STG_B(SB(1, 0), b3);
            BAR; WAIT_L(0); MMA(0, 1, At, B1); BAR;
            LDA(At, 1, 1); STG_A(SA(1, 0), a3, 0, gc);
            BAR; WAIT_L(0); MMA(1, 0, At, B0); BAR; SCHED;
            STG_B(SB(1, 1), b3 + 128 * LDB_);
            WAIT_V(6); BAR; MMA(1, 1, At, B1); BAR;
        }
        bool keep = false;
        {
            const int tz = TID(); const int wz = tz >> 6, lz = tz & 63, wrz = wz >> 2, wcz = wz & 3, frz = lz & 15, fqz = lz >> 4;
            keep = call_epi(epi, cur, acc, wrz * 64 + frz, wcz * 32 + 8 * fqz);
        }
        if (!has_next) break;
        if (!keep) {
#pragma unroll
            for (int a = 0; a < 2; ++a)
#pragma unroll
                for (int b = 0; b < 2; ++b)
#pragma unroll
                    for (int m = 0; m < 4; ++m)
#pragma unroll
                        for (int n = 0; n < 2; ++n) acc[a][b][m][n] = (f32x4){0.f, 0.f, 0.f, 0.f};
        }
        cur = nxt; cA = nA; cB = nB; ++ui;
    }
    WAIT_V(0);
    if (wr == 0) BAR;
    BAR;
#undef SA
#undef SB
#undef STG_A
#undef STG_B
#undef LDA
#undef LDB
#undef MMA
}

constexpr int J_IN = 16 * 27, J_WB = 2 * 8 * 4, J_WO = 16 * 4, J_GU = 16 * 2 * 64, J_DN = 16 * 64, J_FOLD = 8 * 16, J_PAD = 1;
constexpr int N_MODJOBS = 2 * 96;

constexpr int J_BIG = J_IN + J_WB + J_WO + J_GU + J_DN;
struct WJob { const float* src; bf16_t* dst; int ldsrc, lddst, nvalid, k0, n0, mode, gu_which, f8; };
DEV WJob wjob_decode(const Params& p, int l, int j) {
    WJob w; w.ldsrc = 1024; w.lddst = 1024; w.nvalid = 256; w.mode = 0; w.gu_which = 0; w.f8 = 0;
    if (j < J_IN) { const int kt = j / 27, nb = j % 27; w.k0 = kt * 64; w.n0 = nb * 256; w.src = p.w_in + (size_t)l * 1024 * PWSRC; w.ldsrc = PWSRC; w.nvalid = PWSRC - w.n0; w.dst = p.WinT() + (size_t)l * PWT * 1024; w.mode = 3; }
    else if ((j -= J_IN) < J_WB) { const int bi = (j / 32) * 2, jj = j % 32, kt = jj / 4, nb = jj % 4; w.k0 = kt * 64; w.n0 = nb * 256;
        w.src = p.w_branch + ((size_t)l * 3 + bi) * 512 * 1024; w.dst = p.WbT() + ((size_t)l * 3 + bi) * 1024 * 512; w.lddst = 512; }
    else if ((j -= J_WB) < J_WO) { const int kt = j / 4, nb = j % 4; w.k0 = kt * 64; w.n0 = nb * 256; w.src = p.w_out + (size_t)l * 1024 * 1024; w.dst = p.WoT() + (size_t)l * 1024 * 1024; }
    else if ((j -= J_WO) < J_GU) { const int e = j / 128, jj = j % 128; w.gu_which = jj / 64; const int j3 = jj % 64, kt = j3 / 4, nb = j3 % 4; w.k0 = kt * 64; w.n0 = nb * 256;
        w.src = (w.gu_which ? p.w_up : p.w_gate) + ((size_t)l * 16 + e) * 1024 * 1024; w.dst = p.WguT() + ((size_t)l * 16 + e) * 2048 * 512; w.mode = 1; w.f8 = 1; }
    else { j -= J_GU; const int e = j / 64, jj = j % 64, kt = jj / 4, nb = jj % 4; w.k0 = kt * 64; w.n0 = nb * 256;
        w.src = p.w_down + ((size_t)l * 16 + e) * 1024 * 1024; w.dst = p.WdT() + ((size_t)l * 16 + e) * 1024 * 512; w.f8 = 1; }
    return w;
}
constexpr int WT_LD = 260;
DEV void wjob_load(const WJob& w, int tid, f32x4 (&vv)[8]) {
#pragma unroll
    for (int i = 0; i < 8; ++i) { const int idx = i * 512 + tid, r = idx >> 6, c = (idx & 63) * 4; int col = w.n0 + c; col = col > w.ldsrc - 4 ? w.ldsrc - 4 : col;
        vv[i] = ldg((const f32x4*)(w.src + (size_t)(w.k0 + r) * w.ldsrc + col)); }
}
DEV void wjob_finish(const WJob& w, int tid, const f32x4 (&vv)[8], float* tile) {
    __syncthreads();
#pragma unroll
    for (int i = 0; i < 8; ++i) { const int idx = i * 512 + tid, r = idx >> 6, c = (idx & 63) * 4; *(f32x4*)(tile + r * WT_LD + c) = vv[i]; }
    __syncthreads();
#pragma unroll
    for (int q = 0; q < 4; ++q) {
        const int item = q * 512 + tid, nrow = item >> 3, kc = (item & 7) * 8;
        float v[8];
#pragma unroll
        for (int jj = 0; jj < 8; ++jj) v[jj] = tile[(kc + jj) * WT_LD + nrow];
        const int n = w.n0 + nrow;
        int drow = n; bool f8 = w.f8 != 0; size_t f8base = 0;
        if (w.mode == 1) drow = (n >> 7) * 256 + w.gu_which * 128 + (n & 127);
        if (w.mode == 3) {
            if (n >= C_SPLIT) { f8 = true; f8base = (size_t)PWA * 2048; drow = n - C_SPLIT; }
            else { drow = proj_col(n); if (drow >= C_F8) { f8 = true; f8base = (size_t)C_F8 * 2048; drow -= C_F8; } } }
        if (f8) { const u32x2 o = {f8pack4(v[0] * F8_WSCALE, v[1] * F8_WSCALE, v[2] * F8_WSCALE, v[3] * F8_WSCALE), f8pack4(v[4] * F8_WSCALE, v[5] * F8_WSCALE, v[6] * F8_WSCALE, v[7] * F8_WSCALE)};
            if (nrow < w.nvalid) stg((u32x2*)((unsigned char*)w.dst + f8base + (size_t)drow * 1024 + w.k0 + kc), o); }
        else if (nrow < w.nvalid) { u32x4 o = {pack2(v[0], v[1]), pack2(v[2], v[3]), pack2(v[4], v[5]), pack2(v[6], v[7])};
            stg((u32x4*)(w.dst + (size_t)drow * w.lddst + w.k0 + kc), o); }
    }
}
DEV void pro_small_job(const Params& p, int l, int j, char* shm) {
    float* tile = (float*)shm;
    const int tid = TID();
    if (j < J_FOLD) {
        const int kt = j / 16, ntl = j % 16, k0 = kt * 64, n0 = ntl * 64; const int fg = k0 / 128;
        const float* wb1 = p.w_branch + ((size_t)l * 3 + 1) * 512 * 1024;
        const float* pw = p.pool_w + ((size_t)l * 4 + fg) * 128 * 128; const float* ps = p.pool_scale + (size_t)l * 512 + fg * 128;
        const int c = tid & 63, rq = tid >> 6;
        float accv[8];
#pragma unroll
        for (int i = 0; i < 8; ++i) accv[i] = 0.f;
        for (int d = 0; d < 128; ++d) { const float wv = ldg(wb1 + (size_t)(fg * 128 + d) * 1024 + n0 + c) * ldg(ps + d);
#pragma unroll
            for (int i = 0; i < 8; ++i) accv[i] += ldg(pw + (size_t)(k0 - fg * 128 + rq * 8 + i) * 128 + d) * wv; }
        __syncthreads();
#pragma unroll
        for (int i = 0; i < 8; ++i) tile[(rq * 8 + i) * WT_LD + c] = accv[i];
        __syncthreads();
        const int nrow = tid >> 3, kc = (tid & 7) * 8; float v[8];
#pragma unroll
        for (int jj = 0; jj < 8; ++jj) v[jj] = tile[(kc + jj) * WT_LD + nrow];
        u32x4 o = {pack2(v[0], v[1]), pack2(v[2], v[3]), pack2(v[4], v[5]), pack2(v[6], v[7])};
        stg((u32x4*)(p.WbT() + ((size_t)l * 3 + 1) * 1024 * 512 + (size_t)(n0 + nrow) * 512 + k0 + kc), o);
    } else {
        bf16_t* d0 = p.WinT() + (size_t)l * PWT * 1024 + (size_t)C_PADA * 1024;
        for (int i = tid; i < (C_F8 - C_PADA) * 1024 / 8; i += NTHREADS) stg((u32x4*)(d0 + (size_t)i * 8), (u32x4){0u, 0u, 0u, 0u});
    }
}

DEV void pro_mod_job(const Params& p, int job, char* shm) {
    float* sv = (float*)shm;
    const int tid = TID(), l = job / 96, col0 = (job % 96) * 64;
    const int c = tid & 63, kp = tid >> 6;
    float acc[NB + 1];
#pragma unroll
    for (int v = 0; v <= NB; ++v) acc[v] = 0.f;
    for (int half = 0; half < 2; ++half) {
        __syncthreads();
        for (int idx = tid; idx < (NB + 1) * 512; idx += 512) { const int v = idx >> 9, k = idx & 511;
            const float s = (v < NB) ? ldg(p.c + (size_t)v * 1024 + half * 512 + k) : ldg(p.c_ctx + half * 512 + k);
            sv[idx] = s * sigmoidf_(s); }
        __syncthreads();
        for (int kk = 0; kk < 64; ++kk) { const int k = kp * 64 + kk;
            const float w = ldg(p.ada_w + ((size_t)l * 1024 + half * 512 + k) * 6144 + col0 + c);
#pragma unroll
            for (int v = 0; v <= NB; ++v) acc[v] += sv[v * 512 + k] * w; }
    }
    __syncthreads();
    float* red = (float*)shm;
#pragma unroll
    for (int v = 0; v <= NB; ++v) red[(kp * (NB + 1) + v) * 64 + c] = acc[v];
    __syncthreads();
    for (int idx = tid; idx < (NB + 1) * 64; idx += 512) { const int v = idx >> 6, cc = idx & 63; float s = 0.f;
#pragma unroll
        for (int q = 0; q < 8; ++q) s += red[(q * (NB + 1) + v) * 64 + cc];
        stg(p.mod() + ((size_t)l * (NB + 1) + v) * 6144 + col0 + cc, s + ldg(p.ada_b + (size_t)l * 6144 + col0 + cc)); }
}

DEV void phase_prologue(const Params& p, char* shm) {
    const int tid = TID();
    const int nsmall = N_MODJOBS + 1 + 2 * (J_FOLD + J_PAD);
    for (int job = blockIdx.x; job < nsmall; job += gridDim.x) {
        if (job < N_MODJOBS) pro_mod_job(p, job, shm);
        else if (job == N_MODJOBS) {
            for (int idx = tid; idx < (ROWS + 64) * 16; idx += NTHREADS) { const int pos = idx >> 4, i = idx & 15;
                const float pv = (float)(pos < ROWS ? pos : pos - ROWS);
                const float inv = powf(10000.0f, -(float)(2 * i) / 32.0f);
                const float a = pv * inv; stg(p.rope() + idx * 2, cosf(a)); stg(p.rope() + idx * 2 + 1, sinf(a)); }
        } else { const int sj = job - N_MODJOBS - 1; pro_small_job(p, sj / (J_FOLD + J_PAD), sj % (J_FOLD + J_PAD), shm); }
    }
    float* tile = (float*)shm;
    const int nbig = 2 * J_BIG;
    int job = blockIdx.x;
    if (job >= nbig) return;
    WJob wc = wjob_decode(p, job / J_BIG, job % J_BIG), wn = wc;
    f32x4 vc[8], vn[8];
    wjob_load(wc, tid, vc);
    for (; job < nbig; job += gridDim.x) {
        const int jn = job + gridDim.x;
        if (jn < nbig) { wn = wjob_decode(p, jn / J_BIG, jn % J_BIG); wjob_load(wn, tid, vn); }
        wjob_finish(wc, tid, vc, tile);
        wc = wn;
#pragma unroll
        for (int i = 0; i < 8; ++i) vc[i] = vn[i];
    }
}

DEV const float* xsrc_base(const Params& p, const SetDesc& sd, int layer) {
    return (sd.is_ctx ? (layer == 0 ? p.ctx : (const float*)p.ctxs()) : (layer == 0 ? p.x : (const float*)p.out)) + (((size_t)sd.samp0) << sd.lgseq) * 1024;
}
DEV float* xdst_base(const Params& p, const SetDesc& sd) { return (sd.is_ctx ? p.ctxs() : p.out) + (((size_t)sd.samp0) << sd.lgseq) * 1024; }
DEV const float* mod_row(const Params& p, const SetDesc& sd, int layer, int row) {
    return p.mod() + ((size_t)layer * (NB + 1) + (sd.is_ctx ? NB : sd.samp0 + (row >> sd.lgseq))) * 6144;
}
DEV bf16_t* proj_buf(const Params& p, const SetDesc& sd) { return sd.is_ctx ? p.PROJc() : p.PROJa(); }

DEV void stage_params(float* par, const float* v0, const float* v1, const float* v2, const float* v3, const float* v4) {
    const int tid = TID();
    const float* src[5] = {v0, v1, v2, v3, v4};
#pragma unroll
    for (int k = 0; k < 5; ++k) if (src[k]) { for (int i = tid; i < 1024; i += NTHREADS) par[k * 1024 + i] = ldg(src[k] + i); }
}
DEV void phase_norm1(const Params& p, const SetDesc& sd, int layer, char* shm) {
    const int tid = TID(), lane = tid & 63, wv = tid >> 6;
    const float* g0 = p.norm_gain + ((size_t)layer * 4 + 0) * 1024;
    const float* xb = xsrc_base(p, sd, layer);
    const int stride = 8; const int rpb_ = (sd.nrows + (int)gridDim.x - 1) / (int)gridDim.x; const int row_end = min(sd.nrows, ((int)blockIdx.x + 1) * rpb_);
    int row = (int)blockIdx.x * rpb_ + wv;
    float* par = (float*)shm;
    __syncthreads();
    { const float* mdb = mod_row(p, sd, layer, min((int)blockIdx.x * rpb_, sd.nrows - 1)); stage_params(par, g0, mdb, mdb + 1024, nullptr, nullptr); }
    __syncthreads();
    f32x4 cur[4], nxt[4];
    if (row < row_end) {
#pragma unroll
        for (int i = 0; i < 4; ++i) cur[i] = ldg((const f32x4*)(xb + (size_t)row * 1024 + (i >> 1) * 512 + lane * 8 + (i & 1) * 4)); }
    for (; row < row_end; row += stride) {
        const int rn = row + stride;
        if (rn < row_end) {
#pragma unroll
            for (int i = 0; i < 4; ++i) nxt[i] = ldg((const f32x4*)(xb + (size_t)rn * 1024 + (i >> 1) * 512 + lane * 8 + (i & 1) * 4)); }
        const float* md = mod_row(p, sd, layer, row);
        float ss = 0.f;
#pragma unroll
        for (int i = 0; i < 4; ++i)
#pragma unroll
            for (int j = 0; j < 4; ++j) ss += cur[i][j] * cur[i][j];
        ss = wave_sum(ss);
        const float rstd = rsqrtf(ss * (1.0f / 1024.0f) + RMS_EPS);
#pragma unroll
        for (int hlf = 0; hlf < 2; ++hlf) { const int c0 = hlf * 512 + lane * 8; float o[8];
#pragma unroll
            for (int j = 0; j < 8; ++j) o[j] = cur[hlf * 2 + (j >> 2)][j & 3] * rstd * par[c0 + j] * (1.0f + par[2048 + c0 + j]) + par[1024 + c0 + j];
            u32x4 ov = {pack2(o[0], o[1]), pack2(o[2], o[3]), pack2(o[4], o[5]), pack2(o[6], o[7])};
            stg((u32x4*)(p.H() + (size_t)row * 1024 + c0), ov);
            const u32x2 o8 = {f8pack4(o[0], o[1], o[2], o[3]), f8pack4(o[4], o[5], o[6], o[7])};
            stg((u32x2*)(p.H8() + (size_t)row * 1024 + c0), o8); }
#pragma unroll
        for (int i = 0; i < 4; ++i) cur[i] = nxt[i];
    }
}

struct SchedPlain {
    const bf16_t* A; const bf16_t* Bt; int nM, nN, lda256, ldb256;
    DEV bool next(int i, GUnit& u) const { u.aux = 0; return tile_order(i, nM, nN, u.pm, u.pn); }
    DEV const bf16_t* a_base(const GUnit& u) const { return A + (size_t)u.pm * lda256; }
    DEV const bf16_t* b_base(const GUnit& u) const { return Bt + (size_t)u.pn * ldb256; }
    DEV int grow(const GUnit&, int) const { return 0; }
};
struct SchedPlainT : SchedPlain {
    int split_base = -1;
    DEV bool next(int i, GUnit& u) const { u.aux = 0; const int G_ = (int)gridDim.x, b = (int)blockIdx.x; int L = i * G_ + b;
        if (split_base >= 0 && i >= split_base) { if (b < G_ / 2 || i >= split_base + 2) return false; L = split_base * G_ + (i - split_base) * (G_ / 2) + (b - G_ / 2); }
        return tile_from_L(L, nM, nN, u.pm, u.pn); }
    DEV const bf16_t* a_base(const GUnit&) const { return A; }
    DEV int grow(const GUnit& u, int i) const { return u.pm * 256 + i; }
};
DEV void phase_proj_a(const Params& p, const SetDesc& sd, int layer, char* shm) {
    bf16_t* pb = proj_buf(p, sd);
    {
        SchedPlain S; S.A = p.H(); S.Bt = p.WinT() + (size_t)layer * PWT * 1024; S.nM = sd.nrows / 256; S.nN = C_F8 / 256; S.lda256 = 256 * 1024; S.ldb256 = 256 * 1024;
        gemm_stream<false, 1024, 1024, 1024>(shm, S, [=](const GUnit& u, const f32x4 (&acc)[2][2][4][2], int r0, int c0) {
#pragma unroll
            for (int ai = 0; ai < 2; ++ai)
#pragma unroll
                for (int m = 0; m < 4; ++m) { bf16_t* o = pb + ((size_t)u.pm * 256 + r0 + ai * 128 + m * 16) * PWA + u.pn * 256 + c0;
                    store8bf(o, acc[ai][0][m][0], acc[ai][0][m][1]); store8bf(o + 128, acc[ai][1][m][0], acc[ai][1][m][1]); } });
    }
    {
        SchedPlainT S; S.A = (const bf16_t*)p.H8(); S.Bt = p.WinT() + (size_t)layer * PWT * 1024 + (size_t)C_F8 * 1024; S.nM = sd.nrows / 256; S.nN = (PWA - C_F8) / 256; S.lda256 = 256 * 512; S.ldb256 = 256 * 512;
        { const int G_ = (int)gridDim.x, T1 = S.nM * (C_F8 / 256), T2 = S.nM * S.nN; if ((G_ & 1) == 0 && (T1 % G_) * 2 == G_ && T2 % G_ == 0 && T2 / G_ >= 1) S.split_base = T2 / G_ - 1; }
        gemm_stream<true, 512, 512, 512, true>(shm, S, [=](const GUnit& u, const f32x4 (&acc)[2][2][4][2], int r0, int c0) {
#pragma unroll
            for (int ai = 0; ai < 2; ++ai)
#pragma unroll
                for (int m = 0; m < 4; ++m) { bf16_t* o = pb + ((size_t)u.pm * 256 + r0 + ai * 128 + m * 16) * PWA + C_F8 + u.pn * 256 + c0;
                    store8bf(o, acc[ai][0][m][0] * F8_WINV, acc[ai][0][m][1] * F8_WINV); store8bf(o + 128, acc[ai][1][m][0] * F8_WINV, acc[ai][1][m][1] * F8_WINV); } });
    }
}
DEV unsigned gate4u8(f32x4 v) {
    unsigned w = 0;
#pragma unroll
    for (int j = 0; j < 4; ++j) w |= (unsigned)fmaxf(sigmoidf_(v[j] * F8_WINV) * 255.0f + 0.5f, 1.0f) << (8 * j);
    return w;
}
DEV float u8f(unsigned w, int j) { return (float)((w >> (8 * j)) & 0xFFu); }
DEV f32x4 sig4(f32x4 v) { f32x4 r; r[0] = sigmoidf_(v[0]); r[1] = sigmoidf_(v[1]); r[2] = sigmoidf_(v[2]); r[3] = sigmoidf_(v[3]); return r; }
DEV void phase_proj_b(const Params& p, const SetDesc& sd, int layer, char* shm) {
    SchedPlainT S; S.A = (const bf16_t*)p.H8(); S.Bt = p.WinT() + (size_t)layer * PWT * 1024 + (size_t)PWA * 1024; S.nM = sd.nrows / 256; S.nN = NBG / 256; S.lda256 = 256 * 512; S.ldb256 = 256 * 512;
    unsigned char* bg = (unsigned char*)p.BG();
    gemm_stream<true, 512, 512, 512, true>(shm, S, [=](const GUnit& u, const f32x4 (&acc)[2][2][4][2], int r0, int c0) {
#pragma unroll
        for (int ai = 0; ai < 2; ++ai)
#pragma unroll
            for (int m = 0; m < 4; ++m) { unsigned char* o = bg + ((size_t)u.pm * 256 + r0 + ai * 128 + m * 16) * NBG + u.pn * 256 + c0;
#pragma unroll
                for (int hf = 0; hf < 2; ++hf) { const u32x2 gv = {gate4u8(acc[ai][hf][m][0]), gate4u8(acc[ai][hf][m][1])}; stg((u32x2*)(o + hf * 128), gv); } } });
}

DEV void gate_scan(const bf16_t* prow, int h, const float* gbias, float* ga, float* gb, float* gpm, float* gtot, float* tmp) {
    const int tid = TID(), lane = tid & 63, w = tid >> 6;
    float b = 0.f, a = 0.f, pm = 0.f; int d = 0, tok = 0;
    if (tid < 256) {
        d = tid >> 7; const int i = tid & 127; tok = d ? 127 - i : i;
        const float gi = bf2f(ldg(prow + (size_t)tok * PWA + C_GM + (2 * d) * 4 + h)) + ldg(gbias + (2 * d) * 4 + h);
        const float gf = bf2f(ldg(prow + (size_t)tok * PWA + C_GM + (2 * d + 1) * 4 + h)) + ldg(gbias + (2 * d + 1) * 4 + h);
        b = logsigmoidf_(gf);
#pragma unroll
        for (int o = 1; o < 64; o <<= 1) { const float t = __shfl_up(b, o); if (lane >= o) b += t; }
        if (lane == 63) tmp[w] = b;
        a = gi;
    }
    __syncthreads();
    if (tid < 256) {
        if (w & 1) b += tmp[w - 1];
        a -= b; pm = a;
#pragma unroll
        for (int o = 1; o < 64; o <<= 1) { const float t = __shfl_up(pm, o); if (lane >= o) pm = fmaxf(pm, t); }
        if (lane == 63) tmp[8 + w] = pm;
    }
    __syncthreads();
    if (tid < 256) {
        if (w & 1) pm = fmaxf(pm, tmp[8 + w - 1]);
        ga[d * 128 + tok] = a; gb[d * 128 + tok] = b; gpm[d * 128 + tok] = pm;
        if ((tid & 127) == 127) { gtot[d * 2] = b; gtot[d * 2 + 1] = pm; }
    }
    __syncthreads();
}

DEV void load_rope_chunk(const bf16_t* hp, int cidx, bool latent, int tl, const float* rope, float scale, float* o) {
    const u32x4 m = ldg((const u32x4*)(hp + cidx * 8));
    float x[8] = {lo16(m.x), hi16(m.x), lo16(m.y), hi16(m.y), lo16(m.z), hi16(m.z), lo16(m.w), hi16(m.w)};
    if (latent) {
        const u32x4 q = ldg((const u32x4*)(hp + (cidx ^ 2) * 8));
        const float y[8] = {lo16(q.x), hi16(q.x), lo16(q.y), hi16(q.y), lo16(q.z), hi16(q.z), lo16(q.w), hi16(q.w)};
        const int pos = (cidx < 4) ? (tl >> 6) : (ROWS + (tl & 63));
        const float* tb = rope + ((size_t)pos * 16 + (cidx & 1) * 8) * 2;
        const bool first = (cidx & 2) == 0;
#pragma unroll
        for (int j = 0; j < 8; ++j) { const float cs = ldg(tb + j * 2), sn = ldg(tb + j * 2 + 1);
            x[j] = first ? (x[j] * cs - y[j] * sn) : (x[j] * cs + y[j] * sn); }
    }
#pragma unroll
    for (int j = 0; j < 8; ++j) o[j] = x[j] * scale;
}

DEV int st_index(const SetDesc& sd, int sl, int h, int dir, int tb) { return ((sl * 4 + h) * 2 + dir) * sd.ntb + tb; }

constexpr int V_LD = 144, K_LD = 72, KS_LD = 80;
DEV void mlstm_stepA_task(const Params& p, const SetDesc& sd, int layer, int task, char* shm) {
    const int tid = TID(), lane = tid & 63, w = tid >> 6, fr = lane & 15, fq = lane >> 4, tq4 = (lane & 15) >> 2, tp4 = lane & 3;
    const int tb = task % sd.ntb, h = (task / sd.ntb) & 3, sl = task / (sd.ntb * 4);
    const int row0 = (sl << sd.lgseq) + tb * 128; const bool latent = !sd.is_ctx; const int tl0 = tb * 128;
    bf16_t* Vs = (bf16_t*)shm;
    bf16_t* Ksc = (bf16_t*)(shm + 128 * V_LD * 2);
    float* ga = (float*)(shm + 128 * V_LD * 2 + 2 * 128 * KS_LD * 2); float* gb = ga + 256; float* gpm = gb + 256; float* gtot = gpm + 256; float* tmp = gtot + 8;
    const bf16_t* prow = proj_buf(p, sd) + (size_t)row0 * PWA;
    __syncthreads();
    gate_scan(prow, h, p.gate_bias + (size_t)layer * 16, ga, gb, gpm, gtot, tmp);
    {
        const int s = tid & 127, cpi = tid >> 7, cp = (cpi & 1) + (cpi >> 1) * 4;
        const bf16_t* hp = prow + (size_t)s * PWA + C_KM + h * 64;
        float k1[8], k2[8];
        load_rope_chunk(hp, cp, latent, tl0 + s, p.rope(), 1.0f, k1);
        load_rope_chunk(hp, cp + 2, latent, tl0 + s, p.rope(), 1.0f, k2);
#pragma unroll
        for (int dir = 0; dir < 2; ++dir) { const float ws = __expf(ga[dir * 128 + s] - gtot[dir * 2 + 1]);
            u32x4 o1 = {pack2(k1[0] * ws, k1[1] * ws), pack2(k1[2] * ws, k1[3] * ws), pack2(k1[4] * ws, k1[5] * ws), pack2(k1[6] * ws, k1[7] * ws)};
            u32x4 o2 = {pack2(k2[0] * ws, k2[1] * ws), pack2(k2[2] * ws, k2[3] * ws), pack2(k2[4] * ws, k2[5] * ws), pack2(k2[6] * ws, k2[7] * ws)};
            *(u32x4*)(Ksc + (dir * 128 + s) * KS_LD + cp * 8) = o1; *(u32x4*)(Ksc + (dir * 128 + s) * KS_LD + (cp + 2) * 8) = o2; }
    }
#pragma unroll
    for (int it = 0; it < 4; ++it) { const int item = tid + it * 512, s = item >> 4, ch = item & 15;
        *(u32x4*)(Vs + s * V_LD + ch * 8) = ldg((const u32x4*)(prow + (size_t)s * PWA + C_VM + h * 128 + ch * 8)); }
    __syncthreads();
    f32x4 acc[2][4];
#pragma unroll
    for (int dir = 0; dir < 2; ++dir)
#pragma unroll
        for (int n = 0; n < 4; ++n) acc[dir][n] = (f32x4){0.f, 0.f, 0.f, 0.f};
#pragma unroll
    for (int ks = 0; ks < 4; ++ks) {
        const bf16_t* vp = Vs + (32 * ks + 4 * fq + tq4) * V_LD + w * 16 + 4 * tp4;
        const bf16x8 af = mk8(TR16(vp), TR16(vp + 16 * V_LD));
#pragma unroll
        for (int dir = 0; dir < 2; ++dir)
#pragma unroll
            for (int n = 0; n < 4; ++n) { const bf16_t* kp = Ksc + (dir * 128 + 32 * ks + 4 * fq + tq4) * KS_LD + n * 16 + 4 * tp4;
                const bf16x8 bfv = mk8(TR16(kp), TR16(kp + 16 * KS_LD));
                acc[dir][n] = mfma16(af, bfv, acc[dir][n]); }
    }
#pragma unroll
    for (int dir = 0; dir < 2; ++dir) { float* So = p.Sst() + (size_t)st_index(sd, sl, h, dir, tb) * 8192;
#pragma unroll
        for (int n = 0; n < 4; ++n)
#pragma unroll
            for (int r = 0; r < 4; ++r) stg(So + (w * 16 + fq * 4 + r) * 64 + n * 16 + fr, (float)acc[dir][n][r]); }
    if (tid < 128) { const int dir = tid >> 6, dd = tid & 63; float sm = 0.f;
        for (int i = 0; i < 128; ++i) sm += bf2f(Ksc[(dir * 128 + i) * KS_LD + dd]);
        stg(p.Sn() + (size_t)st_index(sd, sl, h, dir, tb) * 64 + dd, sm); }
    if (tid < 2) { float* sc = p.Ssc() + (size_t)st_index(sd, sl, h, tid, tb) * 4; stg(sc, gtot[tid * 2]); stg(sc + 1, gtot[tid * 2] + gtot[tid * 2 + 1]); }
}

template <int GI> DEV void pool_group(const Params& p, const SetDesc& sd, const bf16_t* pb) {
    constexpr int W = 2 << GI;
    const int nitems = sd.nrows * 16; const int T = 1 << sd.lgseq;
    for (int item = blockIdx.x * NTHREADS + TID(); item < nitems; item += gridDim.x * NTHREADS) {
        const int row = item >> 4, ch = GI * 128 + (item & 15) * 8;
        const int tt = row & (T - 1);
        u32x4 mv[W]; int cnt = 0; bool okv[W];
#pragma unroll
        for (int q = 0; q < W; ++q) { const int t2 = tt - W / 2 + q; const bool ok = (t2 >= 0) && (t2 < T); cnt += ok ? 1 : 0; okv[q] = ok;
            mv[q] = ldg((const u32x4*)(pb + (size_t)(ok ? (row - W / 2 + q) : row) * PWA + C_PU + ch)); }
        float s[8];
#pragma unroll
        for (int j = 0; j < 8; ++j) s[j] = 0.f;
#pragma unroll
        for (int q = 0; q < W; ++q) { u32x4 m = mv[q]; if (!okv[q]) m = (u32x4){0u, 0u, 0u, 0u};
            s[0] += lo16(m.x); s[1] += hi16(m.x); s[2] += lo16(m.y); s[3] += hi16(m.y); s[4] += lo16(m.z); s[5] += hi16(m.z); s[6] += lo16(m.w); s[7] += hi16(m.w); }
        const float inv = frcp((float)cnt);
        const u32x4 m = mv[W / 2];
        const float u[8] = {lo16(m.x), hi16(m.x), lo16(m.y), hi16(m.y), lo16(m.z), hi16(m.z), lo16(m.w), hi16(m.w)};
        u32x4 o = {pack2(s[0] * inv - u[0], s[1] * inv - u[1]), pack2(s[2] * inv - u[2], s[3] * inv - u[3]), pack2(s[4] * inv - u[4], s[5] * inv - u[5]), pack2(s[6] * inv - u[6], s[7] * inv - u[7])};
        stg((u32x4*)(p.Pb() + (size_t)row * 512 + ch), o);
    }
}
DEV void phase_pool(const Params& p, const SetDesc& sd) {
    const bf16_t* pb = proj_buf(p, sd);
    pool_group<0>(p, sd, pb); pool_group<1>(p, sd, pb); pool_group<2>(p, sd, pb); pool_group<3>(p, sd, pb);
}

template <int NC> DEV void mlstm_stepB_run(const Params& p, const SetDesc& sd, int task) {
    const int tid = TID();
    const int q = task & 3, dir = (task >> 2) & 1, h = (task >> 3) & 3, sl = task >> 5;
    const int ci = ((sd.samp0 + sl) * 4 + h) * 2 + dir;
    const int eoff = q * 2048 + tid * 4;
    float zr = 0.f; HIDE(zr);
    f32x4 C = {zr, zr, zr, zr}; float nv = 0.f; float m = -1e30f;
    f32x4 Sv[NC]; float blv[NC], mlv[NC], snv[NC];
#pragma unroll
    for (int c = 0; c < NC; ++c) { const int tb = dir ? NC - 1 - c : c; const size_t si = st_index(sd, sl, h, dir, tb);
        Sv[c] = ldg((const f32x4*)(p.Sst() + si * 8192 + eoff)); blv[c] = ldg(p.Ssc() + si * 4); mlv[c] = ldg(p.Ssc() + si * 4 + 1);
        snv[c] = (q == 0 && tid < 64) ? ldg(p.Sn() + si * 64 + tid) : 0.f; }
    if (!sd.is_ctx) { C = ldg((const f32x4*)(p.CiC() + (size_t)ci * 8192 + eoff)); if (q == 0 && tid < 64) nv = ldg(p.Cin_() + (size_t)ci * 64 + tid); m = ldg(p.Cim() + (size_t)ci * 4); }
#pragma unroll
    for (int c = 0; c < NC; ++c) {
        const int tb = dir ? NC - 1 - c : c; const size_t si = st_index(sd, sl, h, dir, tb);
        u32x2 o = {pack2(C[0], C[1]), pack2(C[2], C[3])};
        stg((u32x2*)(p.Cin() + si * 8192 + eoff), o);
        if (q == 0 && tid < 64) stg(p.Cn() + si * 64 + tid, nv);
        if (q == 0 && tid == 0) stg(p.Cm() + si * 4, m);
        const float mn = fmaxf(blv[c] + m, mlv[c]);
        const float dc = __expf(blv[c] + m - mn), wsn = __expf(mlv[c] - mn);
        C = C * dc + Sv[c] * wsn;
        nv = nv * dc + snv[c] * wsn;
        m = mn;
    }
    if (sd.is_ctx) { stg((f32x4*)(p.CiC() + (size_t)ci * 8192 + eoff), C); if (q == 0 && tid < 64) stg(p.Cin_() + (size_t)ci * 64 + tid, nv); if (q == 0 && tid == 0) stg(p.Cim() + (size_t)ci * 4, m); }
}
DEV void mlstm_stepB_task(const Params& p, const SetDesc& sd, int task) {
    if (sd.is_ctx) mlstm_stepB_run<NTBC>(p, sd, task); else mlstm_stepB_run<NTBL>(p, sd, task);
}

constexpr int NA_KLD = 136, NA_VLD = 144;
DEV void na_task(const Params& p, const SetDesc& sd, int layer, int sl, int rq2  , int hp, char* shm) {
    const int tid = TID(), lane = tid & 63, w = tid >> 6, tq = lane & 15, fq = lane >> 4, tq4 = (lane & 15) >> 2, tp4 = lane & 3;
    const int hh = w >> 2, g = w & 3, head = hp * 2 + hh;
    const bool ctxq = sd.is_ctx;
    bf16_t* Ks = (bf16_t*)shm;
    bf16_t* Vs = (bf16_t*)(shm + 128 * NA_KLD * 2);
    float* rpbs = (float*)(shm + 128 * NA_KLD * 2 + 128 * NA_VLD * 2);
    const int sample = sd.samp0 + sl;
    const bf16_t* pq = proj_buf(p, sd) + ((size_t)sl << sd.lgseq) * PWA;
    const bf16_t* pc = p.PROJc() + (size_t)sample * CTX * PWA;
    const int qcol = g * 16 + tq;
    int rqv[2], rsv[2], qtok[2];
#pragma unroll
    for (int u = 0; u < 2; ++u) { rqv[u] = 2 * rq2 + u; qtok[u] = rqv[u] * 64 + qcol; int r_ = rqv[u] - 4; rsv[u] = r_ < 0 ? 0 : (r_ > ROWS - 8 ? ROWS - 8 : r_); }
    const int nloc = ctxq ? 0 : (rsv[1] + 8 - rsv[0]);
    const int nstage = nloc + CTX / 64;
    __syncthreads();
    if (!ctxq) for (int i = tid; i < 2 * 465; i += NTHREADS) rpbs[i] = ldg(p.rpb + ((size_t)layer * 8 + hp * 2 + i / 465) * 465 + i % 465);
    bf16x8 qf[2][2];
#pragma unroll
    for (int u = 0; u < 2; ++u)
#pragma unroll
        for (int ks = 0; ks < 2; ++ks) qf[u][ks] = mk8(ldg((const u32x4*)(pq + (size_t)qtok[u] * PWA + C_QN + head * 64 + ks * 32 + fq * 8)));
    float m_run[2] = {-1e30f, -1e30f}, l_run[2] = {0.f, 0.f};
    f32x4 acc[2][4];
#pragma unroll
    for (int u = 0; u < 2; ++u)
#pragma unroll
        for (int mt = 0; mt < 4; ++mt) acc[u][mt] = (f32x4){0.f, 0.f, 0.f, 0.f};
    int cs = qcol - 8; cs = cs < 0 ? 0 : (cs > 48 ? 48 : cs);
    const int kc0 = (g == 0) ? 0 : (g == 1) ? 8 : (g == 2) ? 24 : 32;
    const int npair = (nstage + 1) >> 1;
    u32x4 kreg[4], vreg[4];
#define NA_SRC_ROWS(stg) (((stg) < nloc) ? (pq + (size_t)((rsv[0] + (stg)) * 64) * PWA) : (pc + (size_t)((((stg) < nstage ? (stg) : nstage - 1) - nloc) * 64) * PWA))
#define NA_FETCH(sp_) do { _Pragma("unroll") for (int it = 0; it < 4; ++it) { const int item = tid + it * 512, key2 = item >> 4, ch = item & 15; \
        const bf16_t* kb_ = NA_SRC_ROWS(2 * (sp_) + (key2 >> 6)); const bf16_t* src = kb_ + (size_t)(key2 & 63) * PWA + hp * 128 + ch * 8; \
        kreg[it] = ldg((const u32x4*)(src + C_KN)); vreg[it] = ldg((const u32x4*)(src + C_VN)); } } while (0)
    NA_FETCH(0);
    for (int sp = 0; sp < npair; ++sp) {
        __syncthreads();
#pragma unroll
        for (int it = 0; it < 4; ++it) { const int item = tid + it * 512, key2 = item >> 4, ch = item & 15;
            *(u32x4*)(Ks + key2 * NA_KLD + ch * 8) = kreg[it]; *(u32x4*)(Vs + key2 * NA_VLD + ch * 8) = vreg[it]; }
        if (sp + 1 < npair) NA_FETCH(sp + 1);
        __syncthreads();
#pragma unroll
        for (int sub = 0; sub < 2; ++sub) {
        const int st = 2 * sp + sub;
        if (st >= nstage) continue;
        const bool local = st < nloc;
        const bf16_t* Ksb = Ks + sub * 64 * NA_KLD; const bf16_t* Vsb = Vs + sub * 64 * NA_VLD;
        if (local) {
            const int kr = rsv[0] + st;
            f32x4 sa[2][2];
#pragma unroll
            for (int kt = 0; kt < 2; ++kt) { sa[0][kt] = (f32x4){0.f, 0.f, 0.f, 0.f}; sa[1][kt] = (f32x4){0.f, 0.f, 0.f, 0.f};
#pragma unroll
                for (int ks = 0; ks < 2; ++ks) { const bf16x8 kf = *(const bf16x8*)(Ksb + (kc0 + kt * 16 + tq) * NA_KLD + hh * 64 + ks * 32 + fq * 8);
                    sa[0][kt] = mfma16(kf, qf[0][ks], sa[0][kt]); sa[1][kt] = mfma16(kf, qf[1][ks], sa[1][kt]); } }
            float alpha[2]; bf16x8 pf[2];
#pragma unroll
            for (int u = 0; u < 2; ++u) {
                const bool act = (kr >= rsv[u]) && (kr < rsv[u] + 8);
                if (!act) { alpha[u] = 1.0f; pf[u] = mk8((u32x4){0u, 0u, 0u, 0u}); continue; }
                const int dr = kr - rqv[u] + 7;
                float sc[8]; float mx = -1e30f; float bs[8];
#pragma unroll
                for (int kt = 0; kt < 2; ++kt)
#pragma unroll
                    for (int r = 0; r < 4; ++r) { const int kcol = kc0 + kt * 16 + fq * 4 + r; int dc = kcol - qcol + 15; dc = dc < 0 ? 0 : (dc > 30 ? 30 : dc);
                        bs[kt * 4 + r] = rpbs[hh * 465 + dr * 31 + dc]; }
#ifndef CPU_EMU
                asm volatile("" : "+v"(bs[0]), "+v"(bs[1]), "+v"(bs[2]), "+v"(bs[3]), "+v"(bs[4]), "+v"(bs[5]), "+v"(bs[6]), "+v"(bs[7]));
#endif
#pragma unroll
                for (int kt = 0; kt < 2; ++kt)
#pragma unroll
                    for (int r = 0; r < 4; ++r) { const int kcol = kc0 + kt * 16 + fq * 4 + r; const bool valid = (kcol >= cs) && (kcol < cs + 16);
                        const float v = valid ? (sa[u][kt][r] * 0.125f + bs[kt * 4 + r]) : -1e30f; sc[kt * 4 + r] = v; mx = fmaxf(mx, v); }
                mx = fmaxf(mx, shx<16>(mx)); mx = fmaxf(mx, shx<32>(mx));
                const float mn = fmaxf(m_run[u], mx); alpha[u] = __expf(m_run[u] - mn); m_run[u] = mn;
                float ps = 0.f; float pv[8];
#pragma unroll
                for (int j = 0; j < 8; ++j) { pv[j] = __expf(sc[j] - mn); ps += pv[j]; }
                ps += shx<16>(ps); ps += shx<32>(ps);
                l_run[u] = l_run[u] * alpha[u] + ps;
                u32x4 pk = {pack2(pv[0], pv[1]), pack2(pv[2], pv[3]), pack2(pv[4], pv[5]), pack2(pv[6], pv[7])};
                pf[u] = mk8(pk);
            }
#pragma unroll
            for (int mt = 0; mt < 4; ++mt) {
                const bf16_t* vp = Vsb + (kc0 + 4 * fq + tq4) * NA_VLD + hh * 64 + mt * 16 + 4 * tp4;
                const bf16x8 vf = mk8(TR16(vp), TR16(vp + 16 * NA_VLD));
                acc[0][mt] = mfma16(vf, pf[0], acc[0][mt] * alpha[0]); acc[1][mt] = mfma16(vf, pf[1], acc[1][mt] * alpha[1]); }
        } else {
            f32x4 sa[2][4];
#pragma unroll
            for (int kt = 0; kt < 4; ++kt) { sa[0][kt] = (f32x4){0.f, 0.f, 0.f, 0.f}; sa[1][kt] = (f32x4){0.f, 0.f, 0.f, 0.f};
#pragma unroll
                for (int ks = 0; ks < 2; ++ks) { const bf16x8 kf = *(const bf16x8*)(Ksb + (kt * 16 + tq) * NA_KLD + hh * 64 + ks * 32 + fq * 8);
                    sa[0][kt] = mfma16(kf, qf[0][ks], sa[0][kt]); sa[1][kt] = mfma16(kf, qf[1][ks], sa[1][kt]); } }
            float alpha[2]; bf16x8 pf[2][2];
#pragma unroll
            for (int u = 0; u < 2; ++u) {
                float mx = -1e30f;
#pragma unroll
                for (int kt = 0; kt < 4; ++kt)
#pragma unroll
                    for (int r = 0; r < 4; ++r) { sa[u][kt][r] *= 0.125f; mx = fmaxf(mx, sa[u][kt][r]); }
                mx = fmaxf(mx, shx<16>(mx)); mx = fmaxf(mx, shx<32>(mx));
                const float mn = fmaxf(m_run[u], mx); alpha[u] = __expf(m_run[u] - mn); m_run[u] = mn;
                float ps = 0.f;
#pragma unroll
                for (int kt = 0; kt < 4; ++kt)
#pragma unroll
                    for (int r = 0; r < 4; ++r) { sa[u][kt][r] = __expf(sa[u][kt][r] - mn); ps += sa[u][kt][r]; }
                ps += shx<16>(ps); ps += shx<32>(ps);
                l_run[u] = l_run[u] * alpha[u] + ps;
#pragma unroll
                for (int h2 = 0; h2 < 2; ++h2) {
                    u32x4 pk = {pack2(sa[u][2 * h2][0], sa[u][2 * h2][1]), pack2(sa[u][2 * h2][2], sa[u][2 * h2][3]), pack2(sa[u][2 * h2 + 1][0], sa[u][2 * h2 + 1][1]), pack2(sa[u][2 * h2 + 1][2], sa[u][2 * h2 + 1][3])};
                    pf[u][h2] = mk8(pk); }
            }
#pragma unroll
            for (int mt = 0; mt < 4; ++mt) { acc[0][mt] = acc[0][mt] * alpha[0]; acc[1][mt] = acc[1][mt] * alpha[1]; }
#pragma unroll
            for (int h2 = 0; h2 < 2; ++h2)
#pragma unroll
                for (int mt = 0; mt < 4; ++mt) { const bf16_t* vp = Vsb + (32 * h2 + 4 * fq + tq4) * NA_VLD + hh * 64 + mt * 16 + 4 * tp4;
                    const bf16x8 vf = mk8(TR16(vp), TR16(vp + 16 * NA_VLD));
                    acc[0][mt] = mfma16(vf, pf[0][h2], acc[0][mt]); acc[1][mt] = mfma16(vf, pf[1][h2], acc[1][mt]); }
        }
        }
    }
#undef NA_FETCH
#undef NA_SRC_ROWS
#pragma unroll
    for (int u = 0; u < 2; ++u) {
        const float il = frcp(l_run[u]);
        const size_t orow = ((size_t)sl << sd.lgseq) + qtok[u];
#pragma unroll
        for (int mt = 0; mt < 4; ++mt) { u32x2 o = {pack2(acc[u][mt][0] * il, acc[u][mt][1] * il), pack2(acc[u][mt][2] * il, acc[u][mt][3] * il)};
            stg((u32x2*)(p.Nb() + orow * 512 + head * 64 + mt * 16 + fq * 4), o); }
    }
}

DEV void mlstm_stepC_task(const Params& p, const SetDesc& sd, int layer, int task, char* shm) {
    const int tid = TID(), lane = tid & 63, w = tid >> 6, tq = lane & 15, fq = lane >> 4, tq4 = (lane & 15) >> 2, tp4 = lane & 3;
    const int tb = task % sd.ntb, h = (task / sd.ntb) & 3, sl = task / (sd.ntb * 4);
    const int row0 = (sl << sd.lgseq) + tb * 128; const bool latent = !sd.is_ctx; const int tl0 = tb * 128;
    bf16_t* Ks = (bf16_t*)shm;
    bf16_t* Vs = (bf16_t*)(shm + 128 * K_LD * 2);
    bf16_t* Cs = (bf16_t*)(shm + 128 * K_LD * 2 + 128 * V_LD * 2);
    float* ga = (float*)(shm + 128 * K_LD * 2 * 3 + 128 * V_LD * 2); float* gb = ga + 256; float* gpm = gb + 256; float* gtot = gpm + 256; float* tmp = gtot + 8;
    float* nvs = tmp + 16;
    float* cms = nvs + 128;
    const bf16_t* prow = proj_buf(p, sd) + (size_t)row0 * PWA;
    __syncthreads();
    gate_scan(prow, h, p.gate_bias + (size_t)layer * 16, ga, gb, gpm, gtot, tmp);
    {
        const int s = tid & 127, cpi = tid >> 7, cp = (cpi & 1) + (cpi >> 1) * 4;
        const bf16_t* hp = prow + (size_t)s * PWA + C_KM + h * 64;
        float k1[8], k2[8];
        load_rope_chunk(hp, cp, latent, tl0 + s, p.rope(), 1.0f, k1);
        load_rope_chunk(hp, cp + 2, latent, tl0 + s, p.rope(), 1.0f, k2);
        u32x4 o1 = {pack2(k1[0], k1[1]), pack2(k1[2], k1[3]), pack2(k1[4], k1[5]), pack2(k1[6], k1[7])};
        u32x4 o2 = {pack2(k2[0], k2[1]), pack2(k2[2], k2[3]), pack2(k2[4], k2[5]), pack2(k2[6], k2[7])};
        *(u32x4*)(Ks + s * K_LD + cp * 8) = o1; *(u32x4*)(Ks + s * K_LD + (cp + 2) * 8) = o2;
    }
#pragma unroll
    for (int it = 0; it < 4; ++it) { const int item = tid + it * 512, s = item >> 4, ch = item & 15;
        *(u32x4*)(Vs + s * V_LD + ch * 8) = ldg((const u32x4*)(prow + (size_t)s * PWA + C_VM + h * 128 + ch * 8)); }
#pragma unroll
    for (int it = 0; it < 4; ++it) { const int item = tid + it * 512, dir = item >> 10, rem = item & 1023, v = rem >> 3, ch = rem & 7;
        *(u32x4*)(Cs + (dir * 128 + v) * K_LD + ch * 8) = ldg((const u32x4*)(p.Cin() + (size_t)st_index(sd, sl, h, dir, tb) * 8192 + v * 64 + ch * 8)); }
    if (tid < 128) nvs[tid] = ldg(p.Cn() + (size_t)st_index(sd, sl, h, tid >> 6, tb) * 64 + (tid & 63));
    if (tid < 2) cms[tid] = ldg(p.Cm() + (size_t)st_index(sd, sl, h, tid, tb) * 4);
    bf16x8 qf[2]; float qv[2][8];
    {
        const int t = w * 16 + tq; const bf16_t* hp = prow + (size_t)t * PWA + C_QM + h * 64;
#pragma unroll
        for (int ks = 0; ks < 2; ++ks) { load_rope_chunk(hp, ks * 4 + fq, latent, tl0 + t, p.rope(), 0.125f, qv[ks]);
            u32x4 o = {pack2(qv[ks][0], qv[ks][1]), pack2(qv[ks][2], qv[ks][3]), pack2(qv[ks][4], qv[ks][5]), pack2(qv[ks][6], qv[ks][7])}; qf[ks] = mk8(o); }
    }
    __syncthreads();
    const int t = w * 16 + tq;
    f32x4 hsum[8];
#pragma unroll
    for (int mt = 0; mt < 8; ++mt) hsum[mt] = (f32x4){0.f, 0.f, 0.f, 0.f};
#pragma unroll
    for (int dir = 0; dir < 2; ++dir) {
        const float m_in = cms[dir];
        const float Mt = fmaxf(m_in, gpm[dir * 128 + t]);
        const float inter = __expf(m_in - Mt);
        const float mtot = gb[dir * 128 + t] + Mt;
        f32x4 acc[8];
#pragma unroll
        for (int mt = 0; mt < 8; ++mt) { acc[mt] = (f32x4){0.f, 0.f, 0.f, 0.f};
#pragma unroll
            for (int ks = 0; ks < 2; ++ks) { const bf16x8 cf = *(const bf16x8*)(Cs + (dir * 128 + mt * 16 + tq) * K_LD + ks * 32 + fq * 8);
                acc[mt] = mfma16(cf, qf[ks], acc[mt]); }
            acc[mt] = acc[mt] * inter; }
        float qn = 0.f;
#pragma unroll
        for (int ks = 0; ks < 2; ++ks)
#pragma unroll
            for (int j = 0; j < 8; ++j) qn += bf2f(f2bf(qv[ks][j])) * nvs[dir * 64 + ks * 32 + fq * 8 + j];
        qn += shx<16>(qn); qn += shx<32>(qn);
        float den = inter * qn;
        const int u_lo = dir == 0 ? 0 : (w >> 1), u_hi = dir == 0 ? (w >> 1) : 3;
        float rsum = 0.f;
        for (int u = u_lo; u <= u_hi; ++u) {
            unsigned pk[4];
#pragma unroll
            for (int kt = 0; kt < 2; ++kt) { f32x4 sa = {0.f, 0.f, 0.f, 0.f}; const int sb = 32 * u + 16 * kt;
#pragma unroll
                for (int ks = 0; ks < 2; ++ks) { const bf16x8 kf = *(const bf16x8*)(Ks + (sb + tq) * K_LD + ks * 32 + fq * 8); sa = mfma16(kf, qf[ks], sa); }
                float pv[4]; float gv4[4];
#pragma unroll
                for (int r = 0; r < 4; ++r) gv4[r] = ga[dir * 128 + sb + fq * 4 + r];
#ifndef CPU_EMU
                asm volatile("" : "+v"(gv4[0]), "+v"(gv4[1]), "+v"(gv4[2]), "+v"(gv4[3]));
#endif
#pragma unroll
                for (int r = 0; r < 4; ++r) { const int s = sb + fq * 4 + r; const bool valid = dir == 0 ? (s <= t) : (s >= t);
                    pv[r] = valid ? sa[r] * __expf(gv4[r] - Mt) : 0.f; pv[r] = bf2f(f2bf(pv[r])); rsum += pv[r]; }
                pk[kt * 2] = pack2(pv[0], pv[1]); pk[kt * 2 + 1] = pack2(pv[2], pv[3]); }
            u32x4 pkv = {pk[0], pk[1], pk[2], pk[3]}; const bf16x8 pf = mk8(pkv);
#pragma unroll
            for (int mt = 0; mt < 8; ++mt) { const bf16_t* vp = Vs + (32 * u + 4 * fq + tq4) * V_LD + mt * 16 + 4 * tp4;
                const bf16x8 vf = mk8(TR16(vp), TR16(vp + 16 * V_LD));
                acc[mt] = mfma16(vf, pf, acc[mt]); }
        }
        rsum += shx<16>(rsum); rsum += shx<32>(rsum);
        den += rsum;
        const float dn = frcp(fmaxf(fabsf(den), __expf(-mtot)));
#pragma unroll
        for (int mt = 0; mt < 8; ++mt) hsum[mt] = hsum[mt] + acc[mt] * dn;
    }
    float ss = 0.f;
#pragma unroll
    for (int mt = 0; mt < 8; ++mt)
#pragma unroll
        for (int r = 0; r < 4; ++r) ss += hsum[mt][r] * hsum[mt][r];
    ss += shx<16>(ss); ss += shx<32>(ss);
    const float rstd = rsqrtf(ss * (1.0f / 128.0f) + RMS_EPS);
#pragma unroll
    for (int mt = 0; mt < 8; ++mt) { const int v = mt * 16 + fq * 4;
        const u32x2 om = ldg((const u32x2*)(prow + (size_t)t * PWA + C_OM + h * 128 + v));
        u32x2 o = {pack2(hsum[mt][0] * rstd * sigmoidf_(lo16(om.x)), hsum[mt][1] * rstd * sigmoidf_(hi16(om.x))),
                   pack2(hsum[mt][2] * rstd * sigmoidf_(lo16(om.y)), hsum[mt][3] * rstd * sigmoidf_(hi16(om.y)))};
        stg((u32x2*)(p.Mb() + (size_t)(row0 + t) * 512 + h * 128 + v), o); }
}

struct SchedMerge {
    const bf16_t* Mb; const bf16_t* Pb; const bf16_t* Nb; const bf16_t* Wb; int nM;
    DEV bool next(int i, GUnit& u) const { u.aux = i % 3; return tile_order(i / 3, nM, 4, u.pm, u.pn); }
    DEV const bf16_t* a_base(const GUnit& u) const { return (u.aux == 0 ? Mb : (u.aux == 1 ? Pb : Nb)) + (size_t)u.pm * 256 * 512; }
    DEV const bf16_t* b_base(const GUnit& u) const { return Wb + ((size_t)u.aux * 1024 + u.pn * 256) * 512; }
    DEV int grow(const GUnit&, int) const { return 0; }
};
DEV void phase_merge(const Params& p, const SetDesc& sd, int layer, char* shm) {
    SchedMerge S; S.Mb = p.Mb(); S.Pb = p.Pb(); S.Nb = p.Nb(); S.Wb = p.WbT() + (size_t)layer * 3 * 1024 * 512; S.nM = sd.nrows / 256;
    const unsigned char* bgb = (const unsigned char*)p.BG(); bf16_t* mgb = p.MERGED();
    gemm_stream<false, 512, 512, 512>(shm, S, [=](const GUnit& u, f32x4 (&acc)[2][2][4][2], int r0, int c0) -> bool {
        if (u.aux < 2) {
            u32x2 ga[2][4][2], gb[2][4][2];
#pragma unroll
            for (int ai = 0; ai < 2; ++ai)
#pragma unroll
                for (int m = 0; m < 4; ++m)
#pragma unroll
                    for (int hf = 0; hf < 2; ++hf) { const unsigned char* gp = bgb + ((size_t)u.pm * 256 + r0 + ai * 128 + m * 16) * NBG + u.aux * 1024 + u.pn * 256 + c0 + hf * 128;
                        ga[ai][m][hf] = ldg((const u32x2*)gp); gb[ai][m][hf] = ldg((const u32x2*)(gp + 1024)); }
#pragma unroll
            for (int ai = 0; ai < 2; ++ai)
#pragma unroll
                for (int m = 0; m < 4; ++m)
#pragma unroll
                    for (int hf = 0; hf < 2; ++hf) {
#pragma unroll
                        for (int j = 0; j < 4; ++j) { acc[ai][hf][m][0][j] *= u8f(ga[ai][m][hf].x, j) * frcp(u8f(gb[ai][m][hf].x, j)); acc[ai][hf][m][1][j] *= u8f(ga[ai][m][hf].y, j) * frcp(u8f(gb[ai][m][hf].y, j)); } }
            return true;
        }
        u32x2 gm2[2][4][2];
#pragma unroll
        for (int ai = 0; ai < 2; ++ai)
#pragma unroll
            for (int m = 0; m < 4; ++m)
#pragma unroll
                for (int hf = 0; hf < 2; ++hf) gm2[ai][m][hf] = ldg((const u32x2*)(bgb + ((size_t)u.pm * 256 + r0 + ai * 128 + m * 16) * NBG + 2048 + u.pn * 256 + c0 + hf * 128));
#pragma unroll
        for (int ai = 0; ai < 2; ++ai) {
#pragma unroll
            for (int m = 0; m < 4; ++m)
#pragma unroll
                for (int hf = 0; hf < 2; ++hf) { const size_t r = (size_t)u.pm * 256 + r0 + ai * 128 + m * 16;
                    const f32x4 x0 = acc[ai][hf][m][0] * (1.0f / 255.0f), x1 = acc[ai][hf][m][1] * (1.0f / 255.0f); const u32x2 g = gm2[ai][m][hf];
                    u32x4 ov = {pack2(x0[0] * u8f(g.x, 0), x0[1] * u8f(g.x, 1)), pack2(x0[2] * u8f(g.x, 2), x0[3] * u8f(g.x, 3)),
                                pack2(x1[0] * u8f(g.y, 0), x1[1] * u8f(g.y, 1)), pack2(x1[2] * u8f(g.y, 2), x1[3] * u8f(g.y, 3))};
                    stg((u32x4*)(mgb + r * 1024 + u.pn * 256 + c0 + hf * 128), ov); }
        }
        return false; });
}
DEV void phase_outproj(const Params& p, const SetDesc& sd, int layer, char* shm) {
    SchedPlain S; S.A = p.MERGED(); S.Bt = p.WoT() + (size_t)layer * 1024 * 1024; S.nM = sd.nrows / 256; S.nN = 4; S.lda256 = 256 * 1024; S.ldb256 = 256 * 1024;
    bf16_t* yb = p.Y();
    gemm_stream<false, 1024, 1024, 1024>(shm, S, [=](const GUnit& u, const f32x4 (&acc)[2][2][4][2], int r0, int c0) {
#pragma unroll
        for (int ai = 0; ai < 2; ++ai)
#pragma unroll
            for (int m = 0; m < 4; ++m) { bf16_t* o = yb + ((size_t)u.pm * 256 + r0 + ai * 128 + m * 16) * 1024 + u.pn * 256 + c0;
                store8bf(o, acc[ai][0][m][0], acc[ai][0][m][1]); store8bf(o + 128, acc[ai][1][m][0], acc[ai][1][m][1]); } });
}

DEV void phase_postmix(const Params& p, const SetDesc& sd, int layer, char* shm) {
    const int tid = TID(), lane = tid & 63, wv = tid >> 6;
    float* wr_s = (float*)shm;
    __syncthreads();
    for (int i = tid; i < 1024 * 16; i += NTHREADS) { const int c = i >> 4, e = i & 15, ln = (c & 511) >> 3, j = c & 7, hf = c >> 9;
        wr_s[((((hf * 8 + j) * 4 + (e >> 2)) * 64 + ln) << 2) + (e & 3)] = ldg(p.router_w + (size_t)layer * 1024 * 16 + i); }
    __syncthreads();
    const float* g1 = p.norm_gain + ((size_t)layer * 4 + 1) * 1024; const float* g2 = p.norm_gain + ((size_t)layer * 4 + 2) * 1024;
    float* par = (float*)(shm + 65536);
    { const int rpb0_ = (sd.nrows + (int)gridDim.x - 1) / (int)gridDim.x; const float* mdb = mod_row(p, sd, layer, min((int)blockIdx.x * rpb0_, sd.nrows - 1));
      stage_params(par, g1, g2, mdb + 2048, mdb + 3072, mdb + 4096); }
    __syncthreads();
    const float* xb = xsrc_base(p, sd, layer); float* xdb = xdst_base(p, sd);
    const int stride = 8; const int rpb_ = (sd.nrows + (int)gridDim.x - 1) / (int)gridDim.x; const int row_end = min(sd.nrows, ((int)blockIdx.x + 1) * rpb_);
    int row = (int)blockIdx.x * rpb_ + wv;
    u32x4 ycur[2], ynxt[2]; f32x4 xcur[4], xnxt[4];
    if (row < row_end) {
#pragma unroll
        for (int i = 0; i < 2; ++i) ycur[i] = ldg((const u32x4*)(p.Y() + (size_t)row * 1024 + i * 512 + lane * 8));
#pragma unroll
        for (int i = 0; i < 4; ++i) xcur[i] = ldg((const f32x4*)(xb + (size_t)row * 1024 + (i >> 1) * 512 + lane * 8 + (i & 1) * 4)); }
    for (; row < row_end; row += stride) {
        int ln = lane; HIDE(ln);
        const int rn = row + stride;
        if (rn < row_end) {
#pragma unroll
            for (int i = 0; i < 2; ++i) ynxt[i] = ldg((const u32x4*)(p.Y() + (size_t)rn * 1024 + i * 512 + ln * 8));
#pragma unroll
            for (int i = 0; i < 4; ++i) xnxt[i] = ldg((const f32x4*)(xb + (size_t)rn * 1024 + (i >> 1) * 512 + ln * 8 + (i & 1) * 4)); }
        float* xd = xdb + (size_t)row * 1024;
        const float* md = mod_row(p, sd, layer, row);
        float y[16]; float ss = 0.f;
#pragma unroll
        for (int hlf = 0; hlf < 2; ++hlf) { const u32x4 m = ycur[hlf];
            const float t8[8] = {lo16(m.x), hi16(m.x), lo16(m.y), hi16(m.y), lo16(m.z), hi16(m.z), lo16(m.w), hi16(m.w)};
#pragma unroll
            for (int j = 0; j < 8; ++j) { y[hlf * 8 + j] = t8[j]; ss += t8[j] * t8[j]; } }
        ss = wave_sum(ss);
        const float rstd = rsqrtf(ss * (1.0f / 1024.0f) + RMS_EPS);
        float xn[16]; float ss2 = 0.f;
#pragma unroll
        for (int hlf = 0; hlf < 2; ++hlf)
#pragma unroll
            for (int q = 0; q < 2; ++q) { const int c0 = hlf * 512 + ln * 8 + q * 4; const f32x4 xo = xcur[hlf * 2 + q]; f32x4 xw;
#pragma unroll
                for (int j = 0; j < 4; ++j) { const float v = xo[j] + par[2048 + c0 + j] * (y[hlf * 8 + q * 4 + j] * rstd * par[c0 + j]); xw[j] = v; xn[hlf * 8 + q * 4 + j] = v; ss2 += v * v; }
                stg((f32x4*)(xd + c0), xw); }
        ss2 = wave_sum(ss2);
        const float rstd2 = rsqrtf(ss2 * (1.0f / 1024.0f) + RMS_EPS);
        float lg[16];
#pragma unroll
        for (int e = 0; e < 16; ++e) lg[e] = 0.f;
#pragma unroll
        for (int hlf = 0; hlf < 2; ++hlf) { const int c0 = hlf * 512 + ln * 8; float o[8];
#pragma unroll
            for (int j = 0; j < 8; ++j) { o[j] = xn[hlf * 8 + j] * rstd2 * par[1024 + c0 + j] * (1.0f + par[4096 + c0 + j]) + par[3072 + c0 + j];
#pragma unroll
                for (int eq = 0; eq < 4; ++eq) { const f32x4 w4 = *(const f32x4*)(wr_s + ((((hlf * 8 + j) * 4 + eq) * 64 + ln) << 2));
#pragma unroll
                    for (int e = 0; e < 4; ++e) lg[eq * 4 + e] += o[j] * w4[e]; } }
            const u32x2 ov = {f8pack4(o[0], o[1], o[2], o[3]), f8pack4(o[4], o[5], o[6], o[7])};
            stg((u32x2*)((unsigned char*)p.H() + (size_t)row * 1024 + c0), ov); }
        float r8[8], r4[4], r2[2], r1;
        { const bool b = (lane & 32) != 0;
#pragma unroll
          for (int i = 0; i < 8; ++i) { const float keep = b ? lg[i + 8] : lg[i], send = b ? lg[i] : lg[i + 8]; r8[i] = keep + shx<32>(send); } }
        { const bool b = (lane & 16) != 0;
#pragma unroll
          for (int i = 0; i < 4; ++i) { const float keep = b ? r8[i + 4] : r8[i], send = b ? r8[i] : r8[i + 4]; r4[i] = keep + shx<16>(send); } }
        { const bool b = (lane & 8) != 0;
#pragma unroll
          for (int i = 0; i < 2; ++i) { const float keep = b ? r4[i + 2] : r4[i], send = b ? r4[i] : r4[i + 2]; r2[i] = keep + shx<8>(send); } }
        { const bool b = (lane & 4) != 0; const float keep = b ? r2[1] : r2[0], send = b ? r2[0] : r2[1]; r1 = keep + shx<4>(send); }
        r1 += shx<2>(r1); r1 += shx<1>(r1);
        float mx = r1;
        mx = fmaxf(mx, shx<4>(mx)); mx = fmaxf(mx, shx<8>(mx)); mx = fmaxf(mx, shx<16>(mx)); mx = fmaxf(mx, shx<32>(mx));
        const float ex = __expf(r1 - mx);
        float se = ex;
        se += shx<4>(se); se += shx<8>(se); se += shx<16>(se); se += shx<32>(se);
        if ((lane & 3) == 0) { const int e = ((lane >> 5) & 1) * 8 + ((lane >> 4) & 1) * 4 + ((lane >> 3) & 1) * 2 + ((lane >> 2) & 1);
            stg(p.aff() + (size_t)row * 16 + e, ex * frcp(se)); }
#pragma unroll
        for (int i = 0; i < 2; ++i) ycur[i] = ynxt[i];
#pragma unroll
        for (int i = 0; i < 4; ++i) xcur[i] = xnxt[i];
    }
}

DEV unsigned shxu(unsigned v, int m) {
    const float f = __uint_as_float(v); float r;
    switch (m) { case 1: r = shx<1>(f); break; case 2: r = shx<2>(f); break; case 4: r = shx<4>(f); break; case 8: r = shx<8>(f); break; case 16: r = shx<16>(f); break; default: r = shx<32>(f); break; }
    return __float_as_uint(r);
}
#define TK_CX(a_, b_, desc_) do { const unsigned long long x_ = key[a_], y_ = key[b_]; const bool sw_ = (desc_) ? (x_ < y_) : (x_ > y_); key[a_] = sw_ ? y_ : x_; key[b_] = sw_ ? x_ : y_; } while (0)
DEV void topk_task(const Params& p, const SetDesc& sd, int task, char* shm) {
    const int tid = TID();
    const int e = task & 15, sl = task >> 4;
    unsigned long long* buf = (unsigned long long*)shm;
    const int T = 1 << sd.lgseq, cap = sd.cap;
    const int rbase = sl << sd.lgseq;
    const bool active = tid * 4 < T;
    unsigned long long key[4];
    __syncthreads();
#pragma unroll
    for (int m = 0; m < 4; ++m) { const int i = tid * 4 + m; const float a = active ? ldg(p.aff() + (size_t)(rbase + i) * 16 + e) : 0.f;
        key[m] = ((unsigned long long)__float_as_uint(a) << 32) | (unsigned)(0xFFFFFFFFu - (unsigned)i); }
    for (int k = 2; k <= T; k <<= 1) {
        const bool desc4 = ((tid * 4) & k) == 0;
        for (int j = k >> 1; j >= 4; j >>= 1) {
            const int tj = j >> 2;
            unsigned long long pk[4];
            if (tj < 64) {
#pragma unroll
                for (int m = 0; m < 4; ++m) { const unsigned lo = shxu((unsigned)key[m], tj), hi = shxu((unsigned)(key[m] >> 32), tj); pk[m] = ((unsigned long long)hi << 32) | lo; }
            } else {
                __syncthreads();
                if (active) {
#pragma unroll
                    for (int m = 0; m < 4; ++m) buf[tid * 4 + m] = key[m]; }
                __syncthreads();
#pragma unroll
                for (int m = 0; m < 4; ++m) pk[m] = active ? buf[(tid ^ tj) * 4 + m] : 0ull;
            }
            const bool lower = (tid & tj) == 0; const bool takemax = desc4 == lower;
#pragma unroll
            for (int m = 0; m < 4; ++m) { const unsigned long long x = key[m], y = pk[m]; key[m] = takemax ? (x > y ? x : y) : (x < y ? x : y); }
        }
        if (k >= 4) { TK_CX(0, 2, desc4); TK_CX(1, 3, desc4); TK_CX(0, 1, desc4); TK_CX(2, 3, desc4); }
        else { TK_CX(0, 1, true); TK_CX(2, 3, false); }
    }
    const int sbase = e * sd.rpe + sl * cap;
    if (active) {
#pragma unroll
        for (int m = 0; m < 4; ++m) { const int i = tid * 4 + m; const unsigned long long kv = key[m]; const int tok = (int)(0xFFFFFFFFu - (unsigned)(kv & 0xFFFFFFFFu));
            const int row = rbase + tok;
            if (i < cap) { stg(p.slot_token() + sbase + i, row); stg(p.slot_gate() + sbase + i, __uint_as_float((unsigned)(kv >> 32))); stg(p.token_slots() + (size_t)row * 16 + e, sbase + i); }
            else stg(p.token_slots() + (size_t)row * 16 + e, -1); } }
    if (sl == 0) { const int used = sd.nsamp * cap;
        for (int i = used + tid; i < sd.rpe; i += NTHREADS) { stg(p.slot_token() + e * sd.rpe + i, 0); stg(p.slot_gate() + e * sd.rpe + i, 0.f); } }
}
#undef TK_CX

struct SchedMoe {
    const bf16_t* A; const int* st; const bf16_t* W; int nRT, rpe, nN, wstride;
    DEV bool next(int i, GUnit& u) const { int pmx, pn; if (!tile_order(i, 16 * nRT, nN, pmx, pn)) return false; u.pm = pmx % nRT; u.aux = pmx / nRT; u.pn = pn; return true; }
    DEV int slot0(const GUnit& u) const { return u.aux * rpe + u.pm * 256; }
    DEV const bf16_t* a_base(const GUnit&) const { return A; }
    DEV int grow(const GUnit& u, int i) const { return st ? ldg(st + slot0(u) + i) : slot0(u) + i; }
    DEV const bf16_t* b_base(const GUnit& u) const { return W + (size_t)u.aux * wstride + (size_t)u.pn * 256 * 512; }
};
DEV void phase_moe_gu(const Params& p, const SetDesc& sd, int layer, char* shm) {
    SchedMoe S; S.A = p.H(); S.st = p.slot_token(); S.W = p.WguT() + (size_t)layer * 16 * 2048 * 512; S.nRT = sd.rpe / 256; S.rpe = sd.rpe; S.nN = 8; S.wstride = 2048 * 512;
    unsigned char* hb = (unsigned char*)p.HID();
    gemm_stream<true, 512, 512, 512, true>(shm, S, [=](const GUnit& u, const f32x4 (&acc)[2][2][4][2], int r0, int c0) {
#pragma unroll
        for (int ai = 0; ai < 2; ++ai)
#pragma unroll
            for (int m = 0; m < 4; ++m) { f32x4 h0, h1; const f32x4 a0 = acc[ai][0][m][0] * F8_WINV, a1 = acc[ai][0][m][1] * F8_WINV, b0 = acc[ai][1][m][0] * F8_WINV, b1 = acc[ai][1][m][1] * F8_WINV;
#pragma unroll
                for (int j = 0; j < 4; ++j) { h0[j] = a0[j] * sigmoidf_(a0[j]) * b0[j]; h1[j] = a1[j] * sigmoidf_(a1[j]) * b1[j]; }
                const u32x2 hv = {f8pack4(h0[0], h0[1], h0[2], h0[3]), f8pack4(h1[0], h1[1], h1[2], h1[3])};
                stg((u32x2*)(hb + ((size_t)S.slot0(u) + r0 + ai * 128 + m * 16) * 1024 + u.pn * 128 + c0), hv); } });
}
DEV void phase_moe_down(const Params& p, const SetDesc& sd, int layer, char* shm) {
    SchedMoe S; S.A = p.HID(); S.st = nullptr; S.W = p.WdT() + (size_t)layer * 16 * 1024 * 512; S.nRT = sd.rpe / 256; S.rpe = sd.rpe; S.nN = 4; S.wstride = 1024 * 512;
    bf16_t* yb = p.YE(); const float* gt = p.slot_gate();
    gemm_stream<true, 512, 512, 512, true>(shm, S, [=](const GUnit& u, const f32x4 (&acc)[2][2][4][2], int r0, int c0) {
#pragma unroll
        for (int ai = 0; ai < 2; ++ai) {
            float gv[4];
#pragma unroll
            for (int m = 0; m < 4; ++m) gv[m] = ldg(gt + (size_t)S.slot0(u) + r0 + ai * 128 + m * 16) * F8_WINV;
#pragma unroll
            for (int m = 0; m < 4; ++m) { const size_t sl = (size_t)S.slot0(u) + r0 + ai * 128 + m * 16; const float g = gv[m];
                bf16_t* o = yb + sl * 1024 + u.pn * 256 + c0; store8bf(o, acc[ai][0][m][0] * g, acc[ai][0][m][1] * g); store8bf(o + 128, acc[ai][1][m][0] * g, acc[ai][1][m][1] * g); } } });
}

DEV void compact4(const int (&sl)[16], int (&c)[4], int& n) {
    n = 0; c[0] = -1; c[1] = -1; c[2] = -1; c[3] = -1;
#pragma unroll
    for (int e = 0; e < 16; ++e) if (sl[e] >= 0) { c[0] = (n == 0) ? sl[e] : c[0]; c[1] = (n == 1) ? sl[e] : c[1]; c[2] = (n == 2) ? sl[e] : c[2]; c[3] = (n == 3) ? sl[e] : c[3]; ++n; }
}
DEV void phase_combine(const Params& p, const SetDesc& sd, int layer, char* shm) {
    const int tid = TID(), lane = tid & 63, wv = tid >> 6;
    const float* g3 = p.norm_gain + ((size_t)layer * 4 + 3) * 1024;
    float* xdb = xdst_base(p, sd);
    const int stride = 8; const int rpb_ = (sd.nrows + (int)gridDim.x - 1) / (int)gridDim.x; const int row_end = min(sd.nrows, ((int)blockIdx.x + 1) * rpb_);
    int row = __builtin_amdgcn_readfirstlane((int)blockIdx.x * rpb_ + wv);
    float* par = (float*)shm;
    __syncthreads();
    { const float* mdb = mod_row(p, sd, layer, min((int)blockIdx.x * rpb_, sd.nrows - 1)); stage_params(par, g3, mdb + 5120, nullptr, nullptr, nullptr); }
    __syncthreads();
    int raw[16]; int cc[4], cn[4]; int nc = 0, nn = 0;
    u32x4 mc[4][2], mn[4][2]; f32x4 xc[4], xn[4];
#define CMB_SLOTS(r_) do { _Pragma("unroll") for (int e = 0; e < 16; ++e) raw[e] = ldg(p.token_slots() + (size_t)(r_) * 16 + e); } while (0)
#define CMB_DATA(r_, c_, n_, m_, x_) do { _Pragma("unroll") for (int k = 0; k < 4; ++k) { \
            if (k < (n_)) { const bf16_t* yr = p.YE() + (size_t)(c_)[k] * 1024 + lane * 8; (m_)[k][0] = ldg((const u32x4*)yr); (m_)[k][1] = ldg((const u32x4*)(yr + 512)); } \
            else { (m_)[k][0] = (u32x4){0u, 0u, 0u, 0u}; (m_)[k][1] = (u32x4){0u, 0u, 0u, 0u}; } } \
        _Pragma("unroll") for (int i = 0; i < 4; ++i) (x_)[i] = ldg((const f32x4*)(xdb + (size_t)(r_) * 1024 + (i >> 1) * 512 + lane * 8 + (i & 1) * 4)); } while (0)
    if (row < row_end) { CMB_SLOTS(row); compact4(raw, cc, nc); CMB_DATA(row, cc, nc, mc, xc); if (row + stride < row_end) CMB_SLOTS(row + stride); }
    for (; row < row_end; row += stride) {
        const int rn = row + stride;
        if (rn < row_end) { compact4(raw, cn, nn); CMB_DATA(rn, cn, nn, mn, xn); if (rn + stride < row_end) CMB_SLOTS(rn + stride); }
        float* xd = xdb + (size_t)row * 1024;
        float y[16];
#pragma unroll
        for (int j = 0; j < 16; ++j) y[j] = 0.f;
        if (nc <= 4) {
#pragma unroll
            for (int k = 0; k < 4; ++k)
                if (k < nc) {
#pragma unroll
                    for (int hlf = 0; hlf < 2; ++hlf) { const u32x4 m = mc[k][hlf];
                        y[hlf * 8 + 0] += lo16(m.x); y[hlf * 8 + 1] += hi16(m.x); y[hlf * 8 + 2] += lo16(m.y); y[hlf * 8 + 3] += hi16(m.y);
                        y[hlf * 8 + 4] += lo16(m.z); y[hlf * 8 + 5] += hi16(m.z); y[hlf * 8 + 6] += lo16(m.w); y[hlf * 8 + 7] += hi16(m.w); } }
        } else {
            for (int e = 0; e < 16; ++e) { const int sl_ = ldg(p.token_slots() + (size_t)row * 16 + e);
                if (sl_ >= 0) { const bf16_t* yr = p.YE() + (size_t)sl_ * 1024 + lane * 8;
#pragma unroll
                    for (int hlf = 0; hlf < 2; ++hlf) { const u32x4 m = ldg((const u32x4*)(yr + hlf * 512));
                        y[hlf * 8 + 0] += lo16(m.x); y[hlf * 8 + 1] += hi16(m.x); y[hlf * 8 + 2] += lo16(m.y); y[hlf * 8 + 3] += hi16(m.y);
                        y[hlf * 8 + 4] += lo16(m.z); y[hlf * 8 + 5] += hi16(m.z); y[hlf * 8 + 6] += lo16(m.w); y[hlf * 8 + 7] += hi16(m.w); } } }
        }
        float ss = 0.f;
#pragma unroll
        for (int j = 0; j < 16; ++j) ss += y[j] * y[j];
        ss = wave_sum(ss);
        const float rstd = rsqrtf(ss * (1.0f / 1024.0f) + RMS_EPS);
#pragma unroll
        for (int hlf = 0; hlf < 2; ++hlf)
#pragma unroll
            for (int q = 0; q < 2; ++q) { const int c0 = hlf * 512 + lane * 8 + q * 4; f32x4 xv = xc[hlf * 2 + q];
#pragma unroll
                for (int j = 0; j < 4; ++j) xv[j] += par[1024 + c0 + j] * (y[hlf * 8 + q * 4 + j] * rstd * par[c0 + j]);
                stg((f32x4*)(xd + c0), xv); }
        nc = nn;
#pragma unroll
        for (int k = 0; k < 4; ++k) { cc[k] = cn[k]; mc[k][0] = mn[k][0]; mc[k][1] = mn[k][1]; }
#pragma unroll
        for (int i = 0; i < 4; ++i) xc[i] = xn[i];
    }
#undef CMB_SLOTS
#undef CMB_DATA
}

constexpr int WQ_WORD0 = 4096;
template <class F> DEV void wq_run(const Params& p, int qidx, int ntasks, char* shm, F&& task) {
    unsigned* ctr = p.bar() + WQ_WORD0 + 64 * qidx;
    volatile int* slot = (volatile int*)(shm + 131072 + 64);
    const int tid = TID();
    int cur = blockIdx.x;
    while (cur < ntasks) {
        unsigned pend = 0u;
        if (tid == 0) pend = atomicAdd(ctr, 1u);
        task(cur);
        __syncthreads();
        if (tid == 0) *slot = (int)gridDim.x + (int)pend;
        __syncthreads();
        cur = *slot;
    }
}

template <int PH> DEV void do_phase(const Params& p, int layer, int is_ctx, int grp, char* shm) {
    const SetDesc sd = make_set(is_ctx, grp);
    if constexpr (PH == -1) phase_prologue(p, shm);
    if constexpr (PH == 0) phase_norm1(p, sd, layer, shm);
    if constexpr (PH == 1) phase_proj_a(p, sd, layer, shm);
    const int qbase = ((layer * 3 + (is_ctx ? 0 : grp + 1)) * 13 + (PH < 0 ? 0 : PH)) * 2;
    if constexpr (PH == 2) { wq_run(p, qbase, sd.nsamp * 4 * sd.ntb, shm, [&](int t) { mlstm_stepA_task(p, sd, layer, t, shm); }); if (!(is_ctx && layer == 1)) phase_pool(p, sd); }
    if constexpr (PH == 3) {
        for (int t = blockIdx.x; t < sd.nsamp * 32; t += gridDim.x) mlstm_stepB_task(p, sd, t);
        if (!(is_ctx && layer == 1)) {
            const int nq = (is_ctx ? (CTX / 64) : ROWS) / 2;
            wq_run(p, qbase, sd.nsamp * nq * 4, shm, [&](int t) { na_task(p, sd, layer, t / (nq * 4), (t >> 2) % nq, t & 3, shm); });
        }
    }
    if constexpr (PH == 4) { wq_run(p, qbase, sd.nsamp * 4 * sd.ntb, shm, [&](int t) { mlstm_stepC_task(p, sd, layer, t, shm); }); }
    if constexpr (PH == 5) phase_proj_b(p, sd, layer, shm);
    if constexpr (PH == 6) phase_merge(p, sd, layer, shm);
    if constexpr (PH == 7) phase_outproj(p, sd, layer, shm);
    if constexpr (PH == 8) phase_postmix(p, sd, layer, shm);
    if constexpr (PH == 9) { for (int t = blockIdx.x; t < sd.nsamp * 16; t += gridDim.x) topk_task(p, sd, t, shm); }
    if constexpr (PH == 10) phase_moe_gu(p, sd, layer, shm);
    if constexpr (PH == 11) phase_moe_down(p, sd, layer, shm);
    if constexpr (PH == 12) phase_combine(p, sd, layer, shm);
}

#ifndef CPU_EMU
template <int PH> __global__ void __launch_bounds__(NTHREADS, 2) k_phase(Params p, int layer, int is_ctx, int grp) {
    DYN_LDS(shm);
    do_phase<PH>(p, layer, is_ctx, grp, shm);
}
#ifndef DBL_MASK
#define DBL_MASK 0
#endif
#define RUNPH(PH) do { do_phase<PH>(p, layer, is_ctx, grp, shm); xcd_barrier(bar); if ((DBL_MASK >> (PH)) & 1) { do_phase<PH>(p, layer, is_ctx, grp, shm); xcd_barrier(bar); } } while (0)
__global__ void __launch_bounds__(NTHREADS, 2) k_mega(Params p) {
    DYN_LDS(shm);
    uint4* xbw = (uint4*)(shm + 131072);
    if (threadIdx.x == 0) *xbw = make_uint4(0u, 0u, 0u, 0u);
    __syncthreads();
    XcdBarrier bar = xcd_barrier_post(p.bar(), (volatile LAS unsigned*)xbw);
    do_phase<-1>(p, 0, 0, 0, shm);
    xcd_barrier(bar);
    for (int layer = 0; layer < 2; ++layer)
        for (int si = 0; si <= NG; ++si) {
            const int is_ctx = si == 0 ? 1 : 0, grp = si == 0 ? 0 : si - 1;
            RUNPH(0); RUNPH(1); RUNPH(2);
            if (is_ctx && layer == 1) { do_phase<3>(p, layer, is_ctx, grp, shm); continue; }
            RUNPH(3); RUNPH(4); RUNPH(5); RUNPH(6); RUNPH(7); RUNPH(8); RUNPH(9); RUNPH(10); RUNPH(11);
            do_phase<12>(p, layer, is_ctx, grp, shm);
        }
}
#endif
}

static Params make_params(void* const* d_in, void* d_out, void* d_ws) {
    Params p{};
    p.x = (const float*)d_in[0]; p.c = (const float*)d_in[1]; p.ctx = (const float*)d_in[2]; p.c_ctx = (const float*)d_in[3];
    p.norm_gain = (const float*)d_in[4]; p.ada_w = (const float*)d_in[5]; p.ada_b = (const float*)d_in[6]; p.w_in = (const float*)d_in[7];
    p.gate_bias = (const float*)d_in[8]; p.pool_w = (const float*)d_in[9]; p.pool_scale = (const float*)d_in[10]; p.rpb = (const float*)d_in[11];
    p.w_branch = (const float*)d_in[12]; p.w_out = (const float*)d_in[13]; p.router_w = (const float*)d_in[14];
    p.w_gate = (const float*)d_in[15]; p.w_up = (const float*)d_in[16]; p.w_down = (const float*)d_in[17];
    p.out = (float*)d_out; p.ws = (char*)d_ws;
    return p;
}

#ifdef CPU_EMU
int emu_cfg_B = CFG_B, emu_cfg_ROWS = CFG_ROWS, emu_cfg_CTX = CFG_CTX;
const char* g_dumpdir = "data";
static void* g_ws = nullptr;
static void dump_buf(const char* name, int layer, int is_ctx, int grp, const void* ptr, size_t bytes) {
    char nm[512]; snprintf(nm, sizeof nm, "%s/d_L%d_%s%d_%s.bin", g_dumpdir, layer, is_ctx ? "c" : "g", grp, name);
    FILE* f = fopen(nm, "wb"); fwrite(ptr, 1, bytes, f); fclose(f);
}
static void emu_hook(const Params& p, int layer, int is_ctx, int grp, int ph) {
    const size_t Rn = is_ctx ? RC : RL;
    if (ph == 0) dump_buf("H", layer, is_ctx, grp, p.H(), Rn * 1024 * 2);
    if (ph == 1) dump_buf("PROJ", layer, is_ctx, grp, is_ctx ? p.PROJc() : p.PROJa(), Rn * PWA * 2);
    if (ph == 2) dump_buf("Pb", layer, is_ctx, grp, p.Pb(), Rn * 512 * 2);
    if (ph == 3) dump_buf("Nb", layer, is_ctx, grp, p.Nb(), Rn * 512 * 2);
    if (ph == 4) dump_buf("Mb", layer, is_ctx, grp, p.Mb(), Rn * 512 * 2);
    if (ph == 5) dump_buf("BG", layer, is_ctx, grp, p.BG(), Rn * NBG * 2);
    if (ph == 6) dump_buf("MERGED", layer, is_ctx, grp, p.MERGED(), Rn * 1024 * 2);
    if (ph == 7) dump_buf("Y", layer, is_ctx, grp, p.Y(), Rn * 1024 * 2);
    if (ph == 8) { dump_buf("H2", layer, is_ctx, grp, p.H(), Rn * 1024 * 2); dump_buf("aff", layer, is_ctx, grp, p.aff(), Rn * 16 * 4); }
}
void emu_dump(const char* dir) {
    char nm[512]; snprintf(nm, sizeof nm, "%s/d_mod.bin", dir);
    FILE* f = fopen(nm, "wb"); fwrite((char*)g_ws + WSL.mod, 1, (size_t)2 * (NB + 1) * 6144 * 4, f); fclose(f);
    snprintf(nm, sizeof nm, "%s/d_ctxs.bin", dir);
    f = fopen(nm, "wb"); fwrite((char*)g_ws + WSL.ctxs, 1, (size_t)NB * CTX * 1024 * 4, f); fclose(f);
}
template <int PH> static void emu_run_phase(const Params& p, int layer, int is_ctx, int grp, int nblocks) {
    emu_launch_lambda([=]() { do_phase<PH>(p, layer, is_ctx, grp, emu_blk->smem); }, nblocks, NTHREADS, LDS_BYTES);
    if (PH >= 0) emu_hook(p, layer, is_ctx, grp, PH);
    printf("phase %d layer %d ctx %d grp %d done\n", PH, layer, is_ctx, grp); fflush(stdout);
}
#define LAUNCH_PHASE(PH) emu_run_phase<PH>(p, layer, is_ctx, grp, nblocks)
#else
#define LAUNCH_PHASE(PH) hipLaunchKernelGGL((k_phase<PH>), dim3(nblocks), dim3(NTHREADS), LDS_BYTES, stream, p, layer, is_ctx, grp)
#define SETATTR(PH) (void)hipFuncSetAttribute((const void*)k_phase<PH>, hipFuncAttributeMaxDynamicSharedMemorySize, LDS_BYTES)
#endif

extern "C" void kernel_launch(void* const* d_in, const int* in_sizes, int n_in, void* d_out, int out_size, void* d_ws, size_t ws_size, hipStream_t stream) {
    (void)in_sizes; (void)n_in; (void)out_size;
    if (ws_size < WSL.total) return;
    Params p = make_params(d_in, d_out, d_ws);
#ifdef CPU_EMU
    g_ws = d_ws;
    memset(d_ws, 0xFF, WSL.total);
    memset((char*)d_ws + WSL.bar, 0, 65536);
    const int nblocks = 16;
#else
    const int nblocks = 256;
#if MK_ONE_LAUNCH
    static int grid = 0;
    if (!grid) {
        (void)hipFuncSetAttribute((const void*)k_mega, hipFuncAttributeMaxDynamicSharedMemorySize, LDS_BYTES);
        int dev = 0, cus = 0, per_cu = 0;
        (void)hipGetDevice(&dev);
        (void)hipDeviceGetAttribute(&cus, hipDeviceAttributeMultiprocessorCount, dev);
        (void)hipOccupancyMaxActiveBlocksPerMultiprocessor(&per_cu, (const void*)k_mega, NTHREADS, LDS_BYTES);
        if (per_cu > 1) per_cu = 1;
        grid = cus * per_cu;
        if (grid > 256) grid = 256;
    }
    if (grid <= 0) return;
    (void)hipMemsetAsync(p.bar(), 0, 65536, stream);
    hipLaunchKernelGGL(k_mega, dim3(grid), dim3(NTHREADS), LDS_BYTES, stream, p);
    return;
#else
    static bool attr_done = false;
    if (!attr_done) { SETATTR(-1); SETATTR(0); SETATTR(1); SETATTR(2); SETATTR(3); SETATTR(4); SETATTR(5); SETATTR(6); SETATTR(7); SETATTR(8); SETATTR(9); SETATTR(10); SETATTR(11); SETATTR(12); attr_done = true; }
#endif
#endif
    { const int layer = 0, is_ctx = 0, grp = 0; LAUNCH_PHASE(-1); }
    for (int layer = 0; layer < 2; ++layer)
        for (int si = 0; si <= NG; ++si) {
            const int is_ctx = si == 0 ? 1 : 0, grp = si == 0 ? 0 : si - 1;
            LAUNCH_PHASE(0); LAUNCH_PHASE(1); LAUNCH_PHASE(2); LAUNCH_PHASE(3);
            if (is_ctx && layer == 1) continue;
            LAUNCH_PHASE(4); LAUNCH_PHASE(5); LAUNCH_PHASE(6); LAUNCH_PHASE(7); LAUNCH_PHASE(8); LAUNCH_PHASE(9); LAUNCH_PHASE(10); LAUNCH_PHASE(11); LAUNCH_PHASE(12);
        }
}
```

```cpp
#ifdef CPU_EMU
#include "emu.h"
#define DYN_LDS(p) char* p = emu_blk->smem
#define WAIT_V(n)
#define WAIT_L(n)
#define HIDE(v)
#define CBAR()
#else
#include <hip/hip_runtime.h>
#define DYN_LDS(p) extern __shared__ __attribute__((aligned(16))) char p[]
#define WAIT_V(n) asm volatile("s_waitcnt vmcnt(" #n ")" ::: "memory")
#define WAIT_L(n) asm volatile("s_waitcnt lgkmcnt(" #n ")" ::: "memory")
#define HIDE(v) asm volatile("" : "+v"(v))
#define CBAR() asm volatile("" ::: "memory")
#endif
#include <stdint.h>
#include <stddef.h>

#ifndef CFG_B
#define CFG_B 32
#define CFG_ROWS 32
#define CFG_CTX 256
#define CFG_G 16
#endif
#ifndef MK_ONE_LAUNCH
#define MK_ONE_LAUNCH 1
#endif

#define DEV __device__ __forceinline__
typedef short s16x4 __attribute__((ext_vector_type(4)));
#ifdef CPU_EMU
#define TR16(ptr) emu_tr16((const void*)(ptr))
#else
typedef __attribute__((address_space(3))) s16x4 lds_s16x4;
#define TR16(ptr) __builtin_amdgcn_ds_read_tr16_b64_v4i16((lds_s16x4*)(ptr))
#endif
#ifdef CPU_EMU
#define TID() (threadIdx.x)
#else
#define TID() ({ int t_ = threadIdx.x; asm volatile("" : "+v"(t_)); t_; })
#endif

typedef unsigned short bf16_t;
typedef short bf16x8 __attribute__((ext_vector_type(8)));
typedef float f32x4 __attribute__((ext_vector_type(4)));
typedef unsigned u32x2 __attribute__((ext_vector_type(2)));
typedef unsigned u32x4 __attribute__((ext_vector_type(4)));

namespace {
constexpr int D = 1024, NB = CFG_B, ROWS = CFG_ROWS, SEQ = ROWS * 64, CTX = CFG_CTX, G = CFG_G, NG = NB / G;
constexpr int RL = G * SEQ, RC = NB * CTX, RMAX = RL > RC ? RL : RC;
constexpr int PWA = 3840, NBG = 3072, PWT = PWA + NBG, PWSRC = 6672, C_SPLIT = 3600;
constexpr int C_QM = 0, C_KM = 256, C_PU = 512, C_GM = 1024, C_PADA = 1040, C_F8 = 1280, C_QN = 1280, C_KN = 1792, C_VM = 2304, C_OM = 2816, C_VN = 3328;
constexpr int proj_col(int n) { return n < 512 ? n : n < 1536 ? n + 1792 : n < 1552 ? n - 512 : n < 2064 ? n - 1040 : n < 3088 ? n - 784 : n + 240; }
static_assert(proj_col(512) == C_VM && proj_col(1024) == C_OM && proj_col(1536) == C_GM && proj_col(1552) == C_PU && proj_col(2064) == C_QN && proj_col(2576) == C_KN && proj_col(3088) == C_VN && proj_col(3599) == PWA - 1, "projection column map");
constexpr int NTBL = SEQ / 128, NTBC = CTX / 128;
constexpr int ilog2(int x) { return x <= 1 ? 0 : 1 + ilog2(x >> 1); }
constexpr int LGSEQ = ilog2(SEQ), LGCTX = ilog2(CTX);
static_assert((1 << LGSEQ) == SEQ && (1 << LGCTX) == CTX, "sequence lengths must be powers of two");
constexpr int cdiv(int a, int b) { return (a + b - 1) / b; }
constexpr int RPE_L = cdiv(G * (SEQ / 8), 256) * 256, RPE_C = cdiv(NB * (CTX / 8), 256) * 256, RPE_MAX = RPE_L > RPE_C ? RPE_L : RPE_C;
constexpr int NSLOT = 16 * RPE_MAX;
constexpr int NTHREADS = 512;
constexpr int GT_MAXU = 10;
constexpr int LDS_BYTES = 131072 + 256 + GT_MAXU * 1024;
constexpr int NST_L = G * 4 * 2 * NTBL, NST_C = NB * 4 * 2 * NTBC, NST = NST_L > NST_C ? NST_L : NST_C;
constexpr int NCI = NB * 4 * 2;
constexpr float RMS_EPS = 1e-6f;

struct WsLayout { size_t bar, WinT, WbT, WoT, WguT, WdT, mod, rope, ctxs, xb, PROJc, CiC, Cin_, Cim, H, H8, PROJa, Sst, Cin, Mb, Pb, Nb, Sn, Ssc, Cn, Cm, aff, slot_token, slot_gate, token_slots, HID, YE, BG, MERGED, Y, total; };
constexpr size_t al(size_t x) { return (x + 255) / 256 * 256; }
constexpr size_t smax(size_t a, size_t b) { return a > b ? a : b; }
constexpr WsLayout make_layout() {
    WsLayout L{}; size_t o = 0;
    L.bar = o; o += al(65536);
    L.WinT = o; o += al((size_t)2 * PWT * 1024 * 2);
    L.WbT = o; o += al((size_t)2 * 3 * 1024 * 512 * 2);
    L.WoT = o; o += al((size_t)2 * 1024 * 1024 * 2);
    L.WguT = o; o += al((size_t)2 * 16 * 2048 * 1024);
    L.WdT = o; o += al((size_t)2 * 16 * 1024 * 1024);
    L.mod = o; o += al((size_t)2 * (NB + 1) * 6144 * 4);
    L.rope = o; o += al((size_t)(ROWS + 64) * 16 * 2 * 4);
    L.ctxs = o; o += al((size_t)NB * CTX * 1024 * 2);
    L.xb = o; o += al((size_t)NB * SEQ * 1024 * 2);
    L.PROJc = o; o += al((size_t)RC * PWA * 2);
    L.CiC = o; o += al((size_t)NCI * 8192 * 4);
    L.Cin_ = o; o += al((size_t)NCI * 64 * 4);
    L.Cim = o; o += al((size_t)NCI * 4 * 4);
    L.H = o; o += al((size_t)RMAX * 1024 * 2);
    L.H8 = o; o += al((size_t)RMAX * 1024);
    const size_t x0 = o;
    L.PROJa = o; o += al((size_t)RMAX * PWA * 2);
    L.Sst = o; o += al((size_t)NST * 8192 * 4);
    L.Cin = o; o += al((size_t)NST * 8192 * 2);
    const size_t hid = al((size_t)NSLOT * 1024 * 2);
    o = x0 + smax(o - x0, 2 * hid);
    L.BG = x0; L.HID = x0; L.YE = x0 + hid;
    L.Mb = o; o += al((size_t)RMAX * 512 * 2);
    L.Pb = o; o += al((size_t)RMAX * 512 * 2);
    L.Nb = o; o += al((size_t)RMAX * 512 * 2);
    L.MERGED = L.H; L.Y = L.Mb;
    L.Sn = o; o += al((size_t)NST * 64 * 4);
    L.Ssc = o; o += al((size_t)NST * 4 * 4);
    L.Cn = o; o += al((size_t)NST * 64 * 4);
    L.Cm = o; o += al((size_t)NST * 4 * 4);
    L.aff = o; o += al((size_t)RMAX * 16 * 4);
    L.slot_token = o; o += al((size_t)NSLOT * 4);
    L.slot_gate = o; o += al((size_t)NSLOT * 4);
    L.token_slots = o; o += al((size_t)RMAX * 16 * 4);
    L.total = o;
    return L;
}
constexpr WsLayout WSL = make_layout();
static_assert((size_t)RMAX * NBG * 2 <= (size_t)RMAX * PWA * 2, "BG overlay must fit in PROJa");
static_assert(CFG_B != 32 || WSL.total <= ((size_t)1 << 30), "workspace budget");

struct Params {
    const float *x, *c, *ctx, *c_ctx, *norm_gain, *ada_w, *ada_b, *w_in, *gate_bias, *pool_w, *pool_scale, *rpb, *w_branch, *w_out, *router_w, *w_gate, *w_up, *w_down;
    float* out;
    char* ws;
#ifdef CPU_EMU
#define WSF(T, name) __device__ __host__ __forceinline__ T* name() const { return (T*)(ws + WSL.name); }
#else
#if defined(__HIP_DEVICE_COMPILE__)
#define WSF(T, name) __device__ __host__ __forceinline__ T* name() const { char* w_ = ws; asm volatile("" : "+s"(w_)); return (T*)(__attribute__((address_space(1))) T*)(w_ + WSL.name); }
#else
#define WSF(T, name) __device__ __host__ __forceinline__ T* name() const { return (T*)(ws + WSL.name); }
#endif
#endif
    WSF(unsigned, bar) WSF(bf16_t, WinT) WSF(bf16_t, WbT) WSF(bf16_t, WoT) WSF(bf16_t, WguT) WSF(bf16_t, WdT)
    WSF(float, mod) WSF(float, rope) WSF(bf16_t, ctxs) WSF(bf16_t, xb) WSF(bf16_t, PROJc) WSF(float, CiC) WSF(float, Cin_) WSF(float, Cim)
    WSF(bf16_t, H) WSF(unsigned char, H8) WSF(bf16_t, PROJa) WSF(float, Sst) WSF(bf16_t, Cin) WSF(bf16_t, Mb) WSF(bf16_t, Pb) WSF(bf16_t, Nb)
    WSF(float, Sn) WSF(float, Ssc) WSF(float, Cn) WSF(float, Cm) WSF(float, aff) WSF(int, slot_token) WSF(float, slot_gate) WSF(int, token_slots)
    WSF(bf16_t, HID) WSF(bf16_t, YE) WSF(bf16_t, BG) WSF(bf16_t, MERGED) WSF(bf16_t, Y)
#undef WSF
};

struct SetDesc { int is_ctx, nrows, samp0, nsamp, lgseq, ntb, cap, rpe; };
DEV SetDesc make_set(int is_ctx, int grp) {
    SetDesc s;
    s.is_ctx = is_ctx;
    if (is_ctx) { s.nrows = RC; s.samp0 = 0; s.nsamp = NB; s.lgseq = LGCTX; s.ntb = NTBC; s.cap = CTX / 8; s.rpe = RPE_C; }
    else { s.nrows = RL; s.samp0 = grp * G; s.nsamp = G; s.lgseq = LGSEQ; s.ntb = NTBL; s.cap = SEQ / 8; s.rpe = RPE_L; }
    return s;
}

#ifdef CPU_EMU
#define GAS
#else
#define GAS __attribute__((address_space(1)))
#endif
template <class T> DEV T ldg(const T* p) { return *(const GAS T*)p; }
template <class T> DEV void stg(T* p, const T& v) { *(GAS T*)p = v; }
DEV float bf2f(bf16_t v) { return __uint_as_float(((unsigned)v) << 16); }
DEV bf16_t f2bf(float f) { unsigned u = __float_as_uint(f); u += 0x7FFFu + ((u >> 16) & 1u); return (bf16_t)(u >> 16); }
#if defined(__HIP_DEVICE_COMPILE__)
typedef __bf16 bf16n2 __attribute__((ext_vector_type(2)));
typedef float f32n2 __attribute__((ext_vector_type(2)));
DEV unsigned pack2(float lo, float hi) { f32n2 v = {lo, hi}; bf16n2 r = __builtin_convertvector(v, bf16n2); return __builtin_bit_cast(unsigned, r); }
#else
DEV unsigned pack2(float lo, float hi) { return (unsigned)f2bf(lo) | ((unsigned)f2bf(hi) << 16); }
#endif
DEV float lo16(unsigned u) { return __uint_as_float(u << 16); }
DEV float hi16(unsigned u) { return __uint_as_float(u & 0xFFFF0000u); }
#if defined(__HIP_DEVICE_COMPILE__)
DEV float frcp(float x) { return __builtin_amdgcn_rcpf(x); }
#else
DEV float frcp(float x) { return 1.0f / x; }
#endif
#if defined(__HIP_DEVICE_COMPILE__)
DEV float sigmoidf_(float x) { return __builtin_amdgcn_rcpf(1.0f + __expf(-x)); }
#else
DEV float sigmoidf_(float x) { return 1.0f / (1.0f + __expf(-x)); }
#endif
DEV float logsigmoidf_(float x) { return fminf(x, 0.0f) - __logf(1.0f + __expf(-fabsf(x))); }
template <int M> DEV float shx(float v) {
#if defined(__HIP_DEVICE_COMPILE__)
    const unsigned u = __builtin_bit_cast(unsigned, v);
    if constexpr (M == 1) return __builtin_bit_cast(float, __builtin_amdgcn_update_dpp(u, u, 0xB1, 0xF, 0xF, false));
    else if constexpr (M == 2) return __builtin_bit_cast(float, __builtin_amdgcn_update_dpp(u, u, 0x4E, 0xF, 0xF, false));
    else if constexpr (M == 4) { const unsigned t = __builtin_amdgcn_update_dpp(u, u, 0x141, 0xF, 0xF, false);
        return __builtin_bit_cast(float, __builtin_amdgcn_update_dpp(t, t, 0x1B, 0xF, 0xF, false)); }
    else if constexpr (M == 8) return __builtin_bit_cast(float, __builtin_amdgcn_update_dpp(u, u, 0x128, 0xF, 0xF, false));
    else if constexpr (M == 16) { const auto r = __builtin_amdgcn_permlane16_swap(u, u, false, false); return __builtin_bit_cast(float, (threadIdx.x & 16) ? r[0] : r[1]); }
    else { const auto r = __builtin_amdgcn_permlane32_swap(u, u, false, false); return __builtin_bit_cast(float, (threadIdx.x & 32) ? r[0] : r[1]); }
#else
    return __shfl_xor(v, M);
#endif
}
DEV float wave_sum(float v) { v += shx<32>(v); v += shx<16>(v); v += shx<8>(v); v += shx<4>(v); v += shx<2>(v); v += shx<1>(v); return v; }
DEV bf16x8 mk8(u32x2 lo, u32x2 hi) { u32x4 v = {lo.x, lo.y, hi.x, hi.y}; return __builtin_bit_cast(bf16x8, v); }
DEV bf16x8 mk8(u32x4 v) { return __builtin_bit_cast(bf16x8, v); }
DEV bf16x8 mk8(s16x4 lo, s16x4 hi) { return __builtin_shufflevector(lo, hi, 0, 1, 2, 3, 4, 5, 6, 7); }
DEV f32x4 mfma16(bf16x8 a, bf16x8 b, f32x4 c) { return __builtin_amdgcn_mfma_f32_16x16x32_bf16(a, b, c, 0, 0, 0); }
DEV unsigned f8enc1(float x) {
    const unsigned sgn = x < 0.f ? 0x80u : 0u; float a = x < 0.f ? -x : x; if (!(a < 448.f)) a = 448.f;
    if (a < 0.015625f) { const int q = (int)(a * 512.f + 0.5f); const float r = a * 512.f; int qq = q; if ((float)q - r == 0.5f && (q & 1)) qq = q - 1; return sgn | (unsigned)qq; }
    int e = 0; float m = a; while (m >= 2.f) { m *= 0.5f; ++e; } while (m < 1.f) { m *= 2.f; --e; }
    const float r = (m - 1.f) * 8.f; int q = (int)(r + 0.5f); if ((float)q - r == 0.5f && (q & 1)) --q;
    if (q == 8) { q = 0; ++e; }
    return sgn | (unsigned)((e + 7) << 3) | (unsigned)q;
}
#if defined(__HIP_DEVICE_COMPILE__)
DEV unsigned f8pack4(float a, float b, float c, float d) {
    a = __builtin_amdgcn_fmed3f(a, -448.f, 448.f); b = __builtin_amdgcn_fmed3f(b, -448.f, 448.f); c = __builtin_amdgcn_fmed3f(c, -448.f, 448.f); d = __builtin_amdgcn_fmed3f(d, -448.f, 448.f);
    int w = 0; w = __builtin_amdgcn_cvt_pk_fp8_f32(a, b, w, false); w = __builtin_amdgcn_cvt_pk_fp8_f32(c, d, w, true); return (unsigned)w; }
#else
DEV unsigned f8pack4(float a, float b, float c, float d) { return f8enc1(a) | (f8enc1(b) << 8) | (f8enc1(c) << 16) | (f8enc1(d) << 24); }
#endif
#ifdef CPU_EMU
DEV f32x4 mfma_f8(bf16x8 a0, bf16x8 a1, bf16x8 b0, bf16x8 b1, f32x4 c) { return emu_mfma_f8(a0, a1, b0, b1, c); }
#else
typedef int i32x4 __attribute__((ext_vector_type(4)));
typedef int i32x8 __attribute__((ext_vector_type(8)));
DEV f32x4 mfma_f8(bf16x8 a0, bf16x8 a1, bf16x8 b0, bf16x8 b1, f32x4 c) {
    const i32x8 A = __builtin_shufflevector(__builtin_bit_cast(i32x4, a0), __builtin_bit_cast(i32x4, a1), 0, 1, 2, 3, 4, 5, 6, 7);
    const i32x8 B = __builtin_shufflevector(__builtin_bit_cast(i32x4, b0), __builtin_bit_cast(i32x4, b1), 0, 1, 2, 3, 4, 5, 6, 7);
    return __builtin_amdgcn_mfma_scale_f32_16x16x128_f8f6f4(A, B, c, 0, 0, 0, 0, 0, 0);
}
#endif
constexpr float F8_WSCALE = 64.0f, F8_WINV = 1.0f / 64.0f;
DEV void store8bf(bf16_t* o, f32x4 a, f32x4 b) { u32x4 v = {pack2(a[0], a[1]), pack2(a[2], a[3]), pack2(b[0], b[1]), pack2(b[2], b[3])}; stg((u32x4*)o, v); }

#ifndef CPU_EMU
#define XB_TMO      128
#define XB_XCNT(j)  (256  + 64 * (j))
#define XB_XSUB(j)  (1280 + 64 * (j))
#define XB_XGEN(j)  (2304 + 64 * (j))
#define XB_TOP      3328
#define XB_TOPGEN   3392
#define XCD_BAR_WORDS 3456
#define XB_SPIN_CAP (1u << 18)
#define LAS __attribute__((address_space(3)))
__device__ __forceinline__ unsigned xb_ld(unsigned* p)              { return __hip_atomic_load(p, __ATOMIC_RELAXED, __HIP_MEMORY_SCOPE_AGENT); }
__device__ __forceinline__ unsigned xb_add(unsigned* p, unsigned v) { return __hip_atomic_fetch_add(p, v, __ATOMIC_RELAXED, __HIP_MEMORY_SCOPE_AGENT); }
__device__ __forceinline__ unsigned xb_xcc_id() { return (unsigned)__builtin_amdgcn_s_getreg((3 << 11) | 20) & 0xFu; }
#define XB_SPIN(cond, bar) do { unsigned _sp = 0; while (cond) { __builtin_amdgcn_s_sleep(1); \
    if ((++_sp & 255u) == 0u) { if (xb_ld(&(bar)[XB_TMO])) break; if (_sp > XB_SPIN_CAP) { atomicAdd(&(bar)[XB_TMO], 1u); break; } } } } while (0)
struct XcdBarrier { unsigned* bar; unsigned x; volatile LAS unsigned* st; };
__device__ __forceinline__ XcdBarrier xcd_barrier_post(unsigned* bar, volatile LAS unsigned* st) {
    XcdBarrier b; b.bar = bar; b.x = xb_xcc_id(); b.st = st;
    if (threadIdx.x == 0) (void)xb_add(&bar[XB_XCNT(b.x)], 1u);
    return b;
}
__device__ __forceinline__ void xcd_barrier_complete(unsigned* bar, unsigned x, unsigned& nloc, unsigned& nx) {
    const unsigned Gd = gridDim.x * gridDim.y * gridDim.z;
    unsigned sum, cnt, mine, sp = 0u;
    for (;;) {
        sum = 0u; cnt = 0u; mine = 0u;
#pragma unroll
        for (unsigned j = 0; j < 16; ++j) { const unsigned c = xb_ld(&bar[XB_XCNT(j)]); sum += c; cnt += (c > 0u) ? 1u : 0u; mine = (j == x) ? c : mine; }
        if (sum == Gd) break;
        __builtin_amdgcn_s_sleep(1);
        if ((++sp & 255u) == 0u) { if (xb_ld(&bar[XB_TMO])) break; if (sp > XB_SPIN_CAP) { atomicAdd(&bar[XB_TMO], 1u); break; } }
    }
    nloc = mine > 0u ? mine : 1u; nx = cnt > 0u ? cnt : 1u;
}
__device__ __forceinline__ void xcd_barrier(const XcdBarrier& b) {
    asm volatile("s_waitcnt vmcnt(0)" ::: "memory");
    __syncthreads();
    if (threadIdx.x == 0) {
        unsigned* bar = b.bar;
        unsigned bx = b.x; asm volatile("" : "+s"(bx));
        __builtin_amdgcn_s_waitcnt(0);
        unsigned nloc = b.st[0], nx = b.st[1];
        if (nloc == 0u) { xcd_barrier_complete(bar, bx, nloc, nx); b.st[0] = nloc; b.st[1] = nx; }
        const unsigned old = xb_add(&bar[XB_XSUB(bx)], 1u);
        const unsigned gen = old / nloc;
        if (old + 1u == (gen + 1u) * nloc) {
            __builtin_amdgcn_fence(__ATOMIC_RELEASE, "agent");
            asm volatile("s_waitcnt vmcnt(0)" ::: "memory");
            const unsigned og = xb_add(&bar[XB_TOP], 1u);
            const unsigned tg = og / nx;
            if (og + 1u == (tg + 1u) * nx) xb_add(&bar[XB_TOPGEN], 1u);
            else XB_SPIN(xb_ld(&bar[XB_TOPGEN]) == tg, bar);
            __builtin_amdgcn_fence(__ATOMIC_ACQUIRE, "agent");
            xb_add(&bar[XB_XGEN(bx)], 1u);
            asm volatile("s_waitcnt vmcnt(0)" ::: "memory");
        } else {
            XB_SPIN(xb_ld(&bar[XB_XGEN(bx)]) == gen, bar);
            __builtin_amdgcn_fence(__ATOMIC_ACQUIRE, "agent");
            asm volatile("s_waitcnt vmcnt(0)" ::: "memory");
        }
    }
    __syncthreads();
}
#endif

constexpr int BK = 64, HALF = 128, HT_BYTES = HALF * BK * 2;
DEV int lds_byte(int r, int c) { int st = (r >> 4) * 2 + (c >> 5), rr = r & 15, cc = c & 31, ob = rr * 64 + cc * 2; return st * 1024 + (ob ^ (((ob >> 9) & 1) << 5)); }
DEV void stage_rc(int b, int& Rr, int& Cc) { int st = b / 1024, sb = b % 1024, swz = sb ^ (((sb >> 9) & 1) << 5); Rr = (st >> 1) * 16 + swz / 64; Cc = (st & 1) * 32 + (swz % 64) / 2; }
DEV int perm32(int rho) { const int n = rho >> 4, i = rho & 15; return 8 * (i >> 2) + 4 * n + (i & 3); }

DEV bool tile_from_L(int L, int nM, int nN, int& pm, int& pn) {
    const int nwg = nM * nN; if (L >= nwg) return false;
    int wgid = L; { const int q = nwg / 8, r = nwg % 8, xcd = wgid % 8, off = wgid / 8; wgid = (xcd < r ? xcd * (q + 1) : r * (q + 1) + (xcd - r) * q) + off; }
    const int nig = 8 * nN, gid = wgid / nig, fm = gid * 8, gsz = (nM - fm) < 8 ? (nM - fm) : 8;
    pm = fm + ((wgid % nig) % gsz); pn = (wgid % nig) / gsz; return true;
}
DEV bool tile_order(int i, int nM, int nN, int& pm, int& pn) { return tile_from_L(i * (int)gridDim.x + (int)blockIdx.x, nM, nN, pm, pn); }
#ifdef CPU_EMU
#define GLDS16(src, dst) __builtin_amdgcn_global_load_lds((const unsigned*)(src), (unsigned*)((dst) + (TID() & 63) * 16), 16, 0, 0)
#else
#define GLDS16(src, dst) __builtin_amdgcn_global_load_lds((const unsigned*)(src), (unsigned*)(dst), 16, 0, 0)
#endif

#define BAR __builtin_amdgcn_s_barrier()
#define SCHED __builtin_amdgcn_sched_barrier(0)
struct GUnit { int pm, pn, aux; };
template <class T> struct is_void_ { static constexpr bool v = false; };
template <> struct is_void_<void> { static constexpr bool v = true; };
template <class Epi> DEV bool call_epi(const Epi& e, const GUnit& u, f32x4 (&acc)[2][2][4][2], int r0, int c0) {
    if constexpr (is_void_<decltype(e(u, acc, r0, c0))>::v) { e(u, acc, r0, c0); return false; } else return e(u, acc, r0, c0);
}
template <bool GATHER, int LDA_, int LDB_, int K_, bool F8 = false, class Sched, class Epi>
DEV void gemm_stream(char* shm, const Sched& S, const Epi& epi) {
#define SA(b, h) (shm + ((b) * 2 + (h)) * HT_BYTES)
#define SB(b, h) (shm + (4 + (b) * 2 + (h)) * HT_BYTES)
#define STG_B(P, bp) do { GLDS16((bp) + voffB, (P) + ldsb0); GLDS16((bp) + voffB + 64 * LDB_, (P) + ldsb0 + 8192); } while (0)
#define STG_A(P, ap, h, gv) do { if (GATHER) { GLDS16((ap) + gv[h][0], (P) + ldsb0); GLDS16((ap) + gv[h][1], (P) + ldsb0 + 8192); } \
    else { GLDS16((ap) + voffA + (h) * 128 * LDA_, (P) + ldsb0); GLDS16((ap) + voffA + ((h) * 128 + 64) * LDA_, (P) + ldsb0 + 8192); } } while (0)
#define LDA(dst, b, h) _Pragma("unroll") for (int m = 0; m < 4; ++m) _Pragma("unroll") for (int k = 0; k < 2; ++k) \
    dst[m][k] = *reinterpret_cast<const bf16x8*>(SA(b, h) + aoff + m * 2048 + k * 1024)
#define LDB(dst, b, h) _Pragma("unroll") for (int n = 0; n < 2; ++n) _Pragma("unroll") for (int k = 0; k < 2; ++k) \
    dst[n][k] = *reinterpret_cast<const bf16x8*>(SB(b, h) + boff + n * 2048 + k * 1024)
#define MMA(ai, bj, At_, Bx_) do { __builtin_amdgcn_s_setprio(1); \
    if constexpr (F8) { _Pragma("unroll") for (int m = 0; m < 4; ++m) _Pragma("unroll") for (int n = 0; n < 2; ++n) \
      acc[ai][bj][m][n] = mfma_f8(Bx_[n][0], Bx_[n][1], At_[m][0], At_[m][1], acc[ai][bj][m][n]); } \
    else { _Pragma("unroll") for (int m = 0; m < 4; ++m) _Pragma("unroll") for (int n = 0; n < 2; ++n) _Pragma("unroll") for (int k = 0; k < 2; ++k) \
      acc[ai][bj][m][n] = mfma16(Bx_[n][k], At_[m][k], acc[ai][bj][m][n]); } \
    __builtin_amdgcn_s_setprio(0); } while (0)
    constexpr int nt = K_ / BK;
    const int tid = TID();
    const int wid = __builtin_amdgcn_readfirstlane(tid >> 6), lane = tid & 63, wr = wid >> 2, wc = wid & 3, fr = lane & 15, fq = lane >> 4;
    const int ldsb0 = wid * 1024;
    int Rr0, Cc0; stage_rc(tid * 16, Rr0, Cc0);
    const int voffA = Rr0 * LDA_ + Cc0;
    const int voffB = ((Rr0 & ~31) + perm32(Rr0 & 31)) * LDB_ + Cc0;
    const int aoff = lds_byte(wr * 64 + fr, fq * 8), boff = lds_byte(wc * 32 + fr, fq * 8);
    GUnit cur, nxt; int ui = 0;
    if (!S.next(0, cur)) return;
    int gc[2][2] = {{0, 0}, {0, 0}};
    int* gtab = (int*)(shm + 131072 + 256);
    if (GATHER) {
        __syncthreads();
        { GUnit u; for (int i = 0; i < GT_MAXU && S.next(i, u); ++i) { if (tid < 256) gtab[i * 256 + tid] = S.grow(u, tid) * LDA_; } }
        __syncthreads();
#pragma unroll
        for (int h = 0; h < 2; ++h)
#pragma unroll
            for (int i = 0; i < 2; ++i) gc[h][i] = gtab[h * 128 + i * 64 + Rr0] + Cc0;
    }
    f32x4 acc[2][2][4][2];
#pragma unroll
    for (int a = 0; a < 2; ++a)
#pragma unroll
        for (int b = 0; b < 2; ++b)
#pragma unroll
            for (int m = 0; m < 4; ++m)
#pragma unroll
                for (int n = 0; n < 2; ++n) acc[a][b][m][n] = (f32x4){0.f, 0.f, 0.f, 0.f};
    bf16x8 At[4][2], B0[2][2], B1[2][2];
    const bf16_t* cA = S.a_base(cur); const bf16_t* cB = S.b_base(cur);
    STG_B(SB(0, 0), cB); STG_A(SA(0, 0), cA, 0, gc); STG_B(SB(0, 1), cB + 128 * LDB_); STG_A(SA(0, 1), cA, 1, gc);
    if (wr == 1) BAR;
    WAIT_V(4); BAR;
    STG_B(SB(1, 0), cB + BK); STG_A(SA(1, 0), cA + BK, 0, gc); STG_B(SB(1, 1), cB + 128 * LDB_ + BK);
    WAIT_V(6); BAR;
    for (;;) {
        const bool has_next = S.next(ui + 1, nxt);
        const bf16_t* nA = has_next ? S.a_base(nxt) : cA; const bf16_t* nB = has_next ? S.b_base(nxt) : cB;
#pragma unroll 1
        for (int t = 0; t < nt; t += 2) {
            const bool last = (t == nt - 2);
            const bf16_t* a1 = cA + (t + 1) * BK;
            const bf16_t* a2 = last ? nA : cA + (t + 2) * BK; const bf16_t* b2 = last ? nB : cB + (t + 2) * BK;
            const bf16_t* a3 = a2 + BK; const bf16_t* b3 = b2 + BK;
            LDB(B0, 0, 0); SCHED; LDA(At, 0, 0); STG_A(SA(1, 1), a1, 1, gc);
            if (GATHER && last && has_next) {
#pragma unroll
                for (int h = 0; h < 2; ++h)
#pragma unroll
                    for (int i = 0; i < 2; ++i) gc[h][i] = gtab[(ui + 1) * 256 + h * 128 + i * 64 + Rr0] + Cc0; }
            WAIT_L(8); BAR; WAIT_L(0); MMA(0, 0, At, B0); BAR; SCHED;
            LDB(B1, 0, 1); STG_B(SB(0, 0), b2);
            BAR; WAIT_L(0); MMA(0, 1, At, B1); BAR;
            LDA(At, 0, 1); STG_A(SA(0, 0), a2, 0, gc);
            BAR; WAIT_L(0); MMA(1, 0, At, B0); BAR; SCHED;
            STG_B(SB(0, 1), b2 + 128 * LDB_);
            WAIT_V(6); BAR; MMA(1, 1, At, B1); BAR;
            LDB(B0, 1, 0); SCHED; LDA(At, 1, 0); STG_A(SA(0, 1), a2, 1, gc);
            WAIT_L(8); BAR; WAIT_L(0); MMA(0, 0, At, B0); BAR; SCHED;
            LDB(B1, 1, 1); STG_B(SB(1, 0), b3);
            BAR; WAIT_L(0); MMA(0, 1, At, B1); BAR;
            LDA(At, 1, 1); STG_A(SA(1, 0), a3, 0, gc);
            BAR; WAIT_L(0); MMA(1, 0, At, B0); BAR; SCHED;
            STG_B(SB(1, 1), b3 + 128 * LDB_);
            WAIT_V(6); BAR; MMA(1, 1, At, B1); BAR;
        }
        bool keep = false;
        {
            const int tz = TID(); const int wz = tz >> 6, lz = tz & 63, wrz = wz >> 2, wcz = wz & 3, frz = lz & 15, fqz = lz >> 4;
            keep = call_epi(epi, cur, acc, wrz * 64 + frz, wcz * 32 + 8 * fqz);
        }
        if (!has_next) break;
        if (!keep) {
#pragma unroll
            for (int a = 0; a < 2; ++a)
#pragma unroll
                for (int b = 0; b < 2; ++b)
#pragma unroll
                    for (int m = 0; m < 4; ++m)
#pragma unroll
                        for (int n = 0; n < 2; ++n) acc[a][b][m][n] = (f32x4){0.f, 0.f, 0.f, 0.f};
        }
        cur = nxt; cA = nA; cB = nB; ++ui;
    }
    WAIT_V(0);
    if (wr == 0) BAR;
    BAR;
#undef SA
#undef SB
#undef STG_A
#undef STG_B
#undef LDA
#undef LDB
#undef MMA
}

constexpr int J_IN = 16 * 27, J_WB = 2 * 8 * 4, J_WO = 16 * 4, J_GU = 16 * 2 * 64, J_DN = 16 * 64, J_FOLD = 8 * 16, J_PAD = 1;
constexpr int N_MODJOBS = 2 * 96;

constexpr int J_BIG = J_IN + J_WB + J_WO + J_GU + J_DN;
struct WJob { const float* src; bf16_t* dst; int ldsrc, lddst, nvalid, k0, n0, mode, gu_which, f8; };
DEV WJob wjob_decode(const Params& p, int l, int j) {
    WJob w; w.ldsrc = 1024; w.lddst = 1024; w.nvalid = 256; w.mode = 0; w.gu_which = 0; w.f8 = 0;
    if (j < J_IN) { const int kt = j / 27, nb = j % 27; w.k0 = kt * 64; w.n0 = nb * 256; w.src = p.w_in + (size_t)l * 1024 * PWSRC; w.ldsrc = PWSRC; w.nvalid = PWSRC - w.n0; w.dst = p.WinT() + (size_t)l * PWT * 1024; w.mode = 3; }
    else if ((j -= J_IN) < J_WB) { const int bi = (j / 32) * 2, jj = j % 32, kt = jj / 4, nb = jj % 4; w.k0 = kt * 64; w.n0 = nb * 256;
        w.src = p.w_branch + ((size_t)l * 3 + bi) * 512 * 1024; w.dst = p.WbT() + ((size_t)l * 3 + bi) * 1024 * 512; w.lddst = 512; }
    else if ((j -= J_WB) < J_WO) { const int kt = j / 4, nb = j % 4; w.k0 = kt * 64; w.n0 = nb * 256; w.src = p.w_out + (size_t)l * 1024 * 1024; w.dst = p.WoT() + (size_t)l * 1024 * 1024; }
    else if ((j -= J_WO) < J_GU) { const int e = j / 128, jj = j % 128; w.gu_which = jj / 64; const int j3 = jj % 64, kt = j3 / 4, nb = j3 % 4; w.k0 = kt * 64; w.n0 = nb * 256;
        w.src = (w.gu_which ? p.w_up : p.w_gate) + ((size_t)l * 16 + e) * 1024 * 1024; w.dst = p.WguT() + ((size_t)l * 16 + e) * 2048 * 512; w.mode = 1; w.f8 = 1; }
    else { j -= J_GU; const int e = j / 64, jj = j % 64, kt = jj / 4, nb = jj % 4; w.k0 = kt * 64; w.n0 = nb * 256;
        w.src = p.w_down + ((size_t)l * 16 + e) * 1024 * 1024; w.dst = p.WdT() + ((size_t)l * 16 + e) * 1024 * 512; w.f8 = 1; }
    return w;
}
constexpr int WT_LD = 260;
DEV void wjob_load(const WJob& w, int tid, f32x4 (&vv)[8]) {
#pragma unroll
    for (int i = 0; i < 8; ++i) { const int idx = i * 512 + tid, r = idx >> 6, c = (idx & 63) * 4; int col = w.n0 + c; col = col > w.ldsrc - 4 ? w.ldsrc - 4 : col;
        vv[i] = ldg((const f32x4*)(w.src + (size_t)(w.k0 + r) * w.ldsrc + col)); }
}
DEV void wjob_finish(const WJob& w, int tid, const f32x4 (&vv)[8], float* tile) {
    __syncthreads();
#pragma unroll
    for (int i = 0; i < 8; ++i) { const int idx = i * 512 + tid, r = idx >> 6, c = (idx & 63) * 4; *(f32x4*)(tile + r * WT_LD + c) = vv[i]; }
    __syncthreads();
#pragma unroll
    for (int q = 0; q < 4; ++q) {
        const int item = q * 512 + tid, nrow = item >> 3, kc = (item & 7) * 8;
        float v[8];
#pragma unroll
        for (int jj = 0; jj < 8; ++jj) v[jj] = tile[(kc + jj) * WT_LD + nrow];
        const int n = w.n0 + nrow;
        int drow = n; bool f8 = w.f8 != 0; size_t f8base = 0;
        if (w.mode == 1) drow = (n >> 7) * 256 + w.gu_which * 128 + (n & 127);
        if (w.mode == 3) {
            if (n >= C_SPLIT) { f8 = true; f8base = (size_t)PWA * 2048; drow = n - C_SPLIT; }
            else { drow = proj_col(n); if (drow >= C_F8) { f8 = true; f8base = (size_t)C_F8 * 2048; drow -= C_F8; } } }
        if (f8) { const u32x2 o = {f8pack4(v[0] * F8_WSCALE, v[1] * F8_WSCALE, v[2] * F8_WSCALE, v[3] * F8_WSCALE), f8pack4(v[4] * F8_WSCALE, v[5] * F8_WSCALE, v[6] * F8_WSCALE, v[7] * F8_WSCALE)};
            if (nrow < w.nvalid) stg((u32x2*)((unsigned char*)w.dst + f8base + (size_t)drow * 1024 + w.k0 + kc), o); }
        else if (nrow < w.nvalid) { u32x4 o = {pack2(v[0], v[1]), pack2(v[2], v[3]), pack2(v[4], v[5]), pack2(v[6], v[7])};
            stg((u32x4*)(w.dst + (size_t)drow * w.lddst + w.k0 + kc), o); }
    }
}
DEV void pro_small_job(const Params& p, int l, int j, char* shm) {
    float* tile = (float*)shm;
    const int tid = TID();
    if (j < J_FOLD) {
        const int kt = j / 16, ntl = j % 16, k0 = kt * 64, n0 = ntl * 64; const int fg = k0 / 128;
        const float* wb1 = p.w_branch + ((size_t)l * 3 + 1) * 512 * 1024;
        const float* pw = p.pool_w + ((size_t)l * 4 + fg) * 128 * 128; const float* ps = p.pool_scale + (size_t)l * 512 + fg * 128;
        const int c = tid & 63, rq = tid >> 6;
        float accv[8];
#pragma unroll
        for (int i = 0; i < 8; ++i) accv[i] = 0.f;
        for (int d = 0; d < 128; ++d) { const float wv = ldg(wb1 + (size_t)(fg * 128 + d) * 1024 + n0 + c) * ldg(ps + d);
#pragma unroll
            for (int i = 0; i < 8; ++i) accv[i] += ldg(pw + (size_t)(k0 - fg * 128 + rq * 8 + i) * 128 + d) * wv; }
        __syncthreads();
#pragma unroll
        for (int i = 0; i < 8; ++i) tile[(rq * 8 + i) * WT_LD + c] = accv[i];
        __syncthreads();
        const int nrow = tid >> 3, kc = (tid & 7) * 8; float v[8];
#pragma unroll
        for (int jj = 0; jj < 8; ++jj) v[jj] = tile[(kc + jj) * WT_LD + nrow];
        u32x4 o = {pack2(v[0], v[1]), pack2(v[2], v[3]), pack2(v[4], v[5]), pack2(v[6], v[7])};
        stg((u32x4*)(p.WbT() + ((size_t)l * 3 + 1) * 1024 * 512 + (size_t)(n0 + nrow) * 512 + k0 + kc), o);
    } else {
        bf16_t* d0 = p.WinT() + (size_t)l * PWT * 1024 + (size_t)C_PADA * 1024;
        for (int i = tid; i < (C_F8 - C_PADA) * 1024 / 8; i += NTHREADS) stg((u32x4*)(d0 + (size_t)i * 8), (u32x4){0u, 0u, 0u, 0u});
    }
}

DEV void pro_mod_job(const Params& p, int job, char* shm) {
    float* sv = (float*)shm;
    const int tid = TID(), l = job / 96, col0 = (job % 96) * 64;
    const int c = tid & 63, kp = tid >> 6;
    float acc[NB + 1];
#pragma unroll
    for (int v = 0; v <= NB; ++v) acc[v] = 0.f;
    for (int half = 0; half < 2; ++half) {
        __syncthreads();
        for (int idx = tid; idx < (NB + 1) * 512; idx += 512) { const int v = idx >> 9, k = idx & 511;
            const float s = (v < NB) ? ldg(p.c + (size_t)v * 1024 + half * 512 + k) : ldg(p.c_ctx + half * 512 + k);
            sv[idx] = s * sigmoidf_(s); }
        __syncthreads();
        for (int kk = 0; kk < 64; ++kk) { const int k = kp * 64 + kk;
            const float w = ldg(p.ada_w + ((size_t)l * 1024 + half * 512 + k) * 6144 + col0 + c);
#pragma unroll
            for (int v = 0; v <= NB; ++v) acc[v] += sv[v * 512 + k] * w; }
    }
    __syncthreads();
    float* red = (float*)shm;
#pragma unroll
    for (int v = 0; v <= NB; ++v) red[(kp * (NB + 1) + v) * 64 + c] = acc[v];
    __syncthreads();
    for (int idx = tid; idx < (NB + 1) * 64; idx += 512) { const int v = idx >> 6, cc = idx & 63; float s = 0.f;
#pragma unroll
        for (int q = 0; q < 8; ++q) s += red[(q * (NB + 1) + v) * 64 + cc];
        stg(p.mod() + ((size_t)l * (NB + 1) + v) * 6144 + col0 + cc, s + ldg(p.ada_b + (size_t)l * 6144 + col0 + cc)); }
}

DEV void phase_prologue(const Params& p, char* shm) {
    const int tid = TID();
    const int nsmall = N_MODJOBS + 1 + 2 * (J_FOLD + J_PAD);
    for (int job = blockIdx.x; job < nsmall; job += gridDim.x) {
        if (job < N_MODJOBS) pro_mod_job(p, job, shm);
        else if (job == N_MODJOBS) {
            for (int idx = tid; idx < (ROWS + 64) * 16; idx += NTHREADS) { const int pos = idx >> 4, i = idx & 15;
                const float pv = (float)(pos < ROWS ? pos : pos - ROWS);
                const float inv = powf(10000.0f, -(float)(2 * i) / 32.0f);
                const float a = pv * inv; stg(p.rope() + idx * 2, cosf(a)); stg(p.rope() + idx * 2 + 1, sinf(a)); }
        } else { const int sj = job - N_MODJOBS - 1; pro_small_job(p, sj / (J_FOLD + J_PAD), sj % (J_FOLD + J_PAD), shm); }
    }
    float* tile = (float*)shm;
    const int nbig = 2 * J_BIG;
    int job = blockIdx.x;
    if (job >= nbig) return;
    WJob wc = wjob_decode(p, job / J_BIG, job % J_BIG), wn = wc;
    f32x4 vc[8], vn[8];
    wjob_load(wc, tid, vc);
    for (; job < nbig; job += gridDim.x) {
        const int jn = job + gridDim.x;
        if (jn < nbig) { wn = wjob_decode(p, jn / J_BIG, jn % J_BIG); wjob_load(wn, tid, vn); }
        wjob_finish(wc, tid, vc, tile);
        wc = wn;
#pragma unroll
        for (int i = 0; i < 8; ++i) vc[i] = vn[i];
    }
}

DEV const float* xin_f32(const Params& p, const SetDesc& sd) { return (sd.is_ctx ? p.ctx : p.x) + (((size_t)sd.samp0) << sd.lgseq) * 1024; }
DEV bf16_t* xbf_base(const Params& p, const SetDesc& sd) { return (sd.is_ctx ? p.ctxs() : p.xb()) + (((size_t)sd.samp0) << sd.lgseq) * 1024; }
DEV float* xout_f32(const Params& p, const SetDesc& sd) { return p.out + (((size_t)sd.samp0) << sd.lgseq) * 1024; }
template <bool BF> struct XRow;
template <> struct XRow<false> { f32x4 v[4];
    DEV void load(const void* b, size_t row, int lane) { const float* q = (const float*)b + row * 1024 + lane * 8;
#pragma unroll
        for (int i = 0; i < 4; ++i) v[i] = ldg((const f32x4*)(q + (i >> 1) * 512 + (i & 1) * 4)); }
    DEV f32x4 get(int i) const { return v[i]; } };
template <> struct XRow<true> { u32x4 v[2];
    DEV void load(const void* b, size_t row, int lane) { const bf16_t* q = (const bf16_t*)b + row * 1024 + lane * 8;
#pragma unroll
        for (int h = 0; h < 2; ++h) v[h] = ldg((const u32x4*)(q + h * 512)); }
    DEV f32x4 get(int i) const { const u32x4 m = v[i >> 1]; return (i & 1) ? (f32x4){lo16(m.z), hi16(m.z), lo16(m.w), hi16(m.w)} : (f32x4){lo16(m.x), hi16(m.x), lo16(m.y), hi16(m.y)}; } };
template <bool BF> DEV void xrow_store8(void* b, size_t row, int c0, f32x4 a, f32x4 c) {
    if constexpr (BF) store8bf((bf16_t*)b + row * 1024 + c0, a, c);
    else { float* q = (float*)b + row * 1024 + c0; stg((f32x4*)q, a); stg((f32x4*)(q + 4), c); }
}
DEV const float* mod_row(const Params& p, const SetDesc& sd, int layer, int row) {
    return p.mod() + ((size_t)layer * (NB + 1) + (sd.is_ctx ? NB : sd.samp0 + (row >> sd.lgseq))) * 6144;
}
DEV bf16_t* proj_buf(const Params& p, const SetDesc& sd) { return sd.is_ctx ? p.PROJc() : p.PROJa(); }

DEV void stage_params(float* par, const float* v0, const float* v1, const float* v2, const float* v3, const float* v4) {
    const int tid = TID();
    const float* src[5] = {v0, v1, v2, v3, v4};
#pragma unroll
    for (int k = 0; k < 5; ++k) if (src[k]) { for (int i = tid; i < 1024; i += NTHREADS) par[k * 1024 + i] = ldg(src[k] + i); }
}
template <bool SRC_BF> DEV void phase_norm1(const Params& p, const SetDesc& sd, int layer, char* shm) {
    const int tid = TID(), lane = tid & 63, wv = tid >> 6;
    const float* g0 = p.norm_gain + ((size_t)layer * 4 + 0) * 1024;
    const void* xb = SRC_BF ? (const void*)xbf_base(p, sd) : (const void*)xin_f32(p, sd);
    const int stride = 8; const int rpb_ = (sd.nrows + (int)gridDim.x - 1) / (int)gridDim.x; const int row_end = min(sd.nrows, ((int)blockIdx.x + 1) * rpb_);
    int row = (int)blockIdx.x * rpb_ + wv;
    float* par = (float*)shm;
    __syncthreads();
    { const float* mdb = mod_row(p, sd, layer, min((int)blockIdx.x * rpb_, sd.nrows - 1)); stage_params(par, g0, mdb, mdb + 1024, nullptr, nullptr); }
    __syncthreads();
    XRow<SRC_BF> curr, nxtr;
    if (row < row_end) curr.load(xb, row, lane);
    for (; row < row_end; row += stride) {
        const int rn = row + stride;
        if (rn < row_end) nxtr.load(xb, rn, lane);
        f32x4 cur[4];
#pragma unroll
        for (int i = 0; i < 4; ++i) cur[i] = curr.get(i);
        float ss = 0.f;
#pragma unroll
        for (int i = 0; i < 4; ++i)
#pragma unroll
            for (int j = 0; j < 4; ++j) ss += cur[i][j] * cur[i][j];
        ss = wave_sum(ss);
        const float rstd = rsqrtf(ss * (1.0f / 1024.0f) + RMS_EPS);
#pragma unroll
        for (int hlf = 0; hlf < 2; ++hlf) { const int c0 = hlf * 512 + lane * 8; float o[8];
#pragma unroll
            for (int j = 0; j < 8; ++j) o[j] = cur[hlf * 2 + (j >> 2)][j & 3] * rstd * par[c0 + j] * (1.0f + par[2048 + c0 + j]) + par[1024 + c0 + j];
            u32x4 ov = {pack2(o[0], o[1]), pack2(o[2], o[3]), pack2(o[4], o[5]), pack2(o[6], o[7])};
            stg((u32x4*)(p.H() + (size_t)row * 1024 + c0), ov);
            const u32x2 o8 = {f8pack4(o[0], o[1], o[2], o[3]), f8pack4(o[4], o[5], o[6], o[7])};
            stg((u32x2*)(p.H8() + (size_t)row * 1024 + c0), o8); }
        curr = nxtr;
    }
}

struct SchedPlain {
    const bf16_t* A; const bf16_t* Bt; int nM, nN, lda256, ldb256;
    DEV bool next(int i, GUnit& u) const { u.aux = 0; return tile_order(i, nM, nN, u.pm, u.pn); }
    DEV const bf16_t* a_base(const GUnit& u) const { return A + (size_t)u.pm * lda256; }
    DEV const bf16_t* b_base(const GUnit& u) const { return Bt + (size_t)u.pn * ldb256; }
    DEV int grow(const GUnit&, int) const { return 0; }
};
struct SchedPlainT : SchedPlain {
    int split_base = -1;
    DEV bool next(int i, GUnit& u) const { u.aux = 0; const int G_ = (int)gridDim.x, b = (int)blockIdx.x; int L = i * G_ + b;
        if (split_base >= 0 && i >= split_base) { if (b < G_ / 2 || i >= split_base + 2) return false; L = split_base * G_ + (i - split_base) * (G_ / 2) + (b - G_ / 2); }
        return tile_from_L(L, nM, nN, u.pm, u.pn); }
    DEV const bf16_t* a_base(const GUnit&) const { return A; }
    DEV int grow(const GUnit& u, int i) const { return u.pm * 256 + i; }
};
DEV void phase_proj_a(const Params& p, const SetDesc& sd, int layer, char* shm) {
    bf16_t* pb = proj_buf(p, sd);
    {
        SchedPlain S; S.A = p.H(); S.Bt = p.WinT() + (size_t)layer * PWT * 1024; S.nM = sd.nrows / 256; S.nN = C_F8 / 256; S.lda256 = 256 * 1024; S.ldb256 = 256 * 1024;
        gemm_stream<false, 1024, 1024, 1024>(shm, S, [=](const GUnit& u, const f32x4 (&acc)[2][2][4][2], int r0, int c0) {
#pragma unroll
            for (int ai = 0; ai < 2; ++ai)
#pragma unroll
                for (int m = 0; m < 4; ++m) { bf16_t* o = pb + ((size_t)u.pm * 256 + r0 + ai * 128 + m * 16) * PWA + u.pn * 256 + c0;
                    store8bf(o, acc[ai][0][m][0], acc[ai][0][m][1]); store8bf(o + 128, acc[ai][1][m][0], acc[ai][1][m][1]); } });
    }
    {
        SchedPlainT S; S.A = (const bf16_t*)p.H8(); S.Bt = p.WinT() + (size_t)layer * PWT * 1024 + (size_t)C_F8 * 1024; S.nM = sd.nrows / 256; S.nN = (PWA - C_F8) / 256; S.lda256 = 256 * 512; S.ldb256 = 256 * 512;
        { const int G_ = (int)gridDim.x, T1 = S.nM * (C_F8 / 256), T2 = S.nM * S.nN; if ((G_ & 1) == 0 && (T1 % G_) * 2 == G_ && T2 % G_ == 0 && T2 / G_ >= 1) S.split_base = T2 / G_ - 1; }
        gemm_stream<true, 512, 512, 512, true>(shm, S, [=](const GUnit& u, const f32x4 (&acc)[2][2][4][2], int r0, int c0) {
#pragma unroll
            for (int ai = 0; ai < 2; ++ai)
#pragma unroll
                for (int m = 0; m < 4; ++m) { bf16_t* o = pb + ((size_t)u.pm * 256 + r0 + ai * 128 + m * 16) * PWA + C_F8 + u.pn * 256 + c0;
                    store8bf(o, acc[ai][0][m][0] * F8_WINV, acc[ai][0][m][1] * F8_WINV); store8bf(o + 128, acc[ai][1][m][0] * F8_WINV, acc[ai][1][m][1] * F8_WINV); } });
    }
}
DEV unsigned gate4u8(f32x4 v) {
    unsigned w = 0;
#pragma unroll
    for (int j = 0; j < 4; ++j) w |= (unsigned)fmaxf(sigmoidf_(v[j] * F8_WINV) * 255.0f + 0.5f, 1.0f) << (8 * j);
    return w;
}
DEV float u8f(unsigned w, int j) { return (float)((w >> (8 * j)) & 0xFFu); }
DEV f32x4 sig4(f32x4 v) { f32x4 r; r[0] = sigmoidf_(v[0]); r[1] = sigmoidf_(v[1]); r[2] = sigmoidf_(v[2]); r[3] = sigmoidf_(v[3]); return r; }
DEV void phase_proj_b(const Params& p, const SetDesc& sd, int layer, char* shm) {
    SchedPlainT S; S.A = (const bf16_t*)p.H8(); S.Bt = p.WinT() + (size_t)layer * PWT * 1024 + (size_t)PWA * 1024; S.nM = sd.nrows / 256; S.nN = NBG / 256; S.lda256 = 256 * 512; S.ldb256 = 256 * 512;
    unsigned char* bg = (unsigned char*)p.BG();
    gemm_stream<true, 512, 512, 512, true>(shm, S, [=](const GUnit& u, const f32x4 (&acc)[2][2][4][2], int r0, int c0) {
#pragma unroll
        for (int ai = 0; ai < 2; ++ai)
#pragma unroll
            for (int m = 0; m < 4; ++m) { unsigned char* o = bg + ((size_t)u.pm * 256 + r0 + ai * 128 + m * 16) * NBG + u.pn * 256 + c0;
#pragma unroll
                for (int hf = 0; hf < 2; ++hf) { const u32x2 gv = {gate4u8(acc[ai][hf][m][0]), gate4u8(acc[ai][hf][m][1])}; stg((u32x2*)(o + hf * 128), gv); } } });
}

DEV void gate_scan(const bf16_t* prow, int h, const float* gbias, float* ga, float* gb, float* gpm, float* gtot, float* tmp) {
    const int tid = TID(), lane = tid & 63, w = tid >> 6;
    float b = 0.f, a = 0.f, pm = 0.f; int d = 0, tok = 0;
    if (tid < 256) {
        d = tid >> 7; const int i = tid & 127; tok = d ? 127 - i : i;
        const float gi = bf2f(ldg(prow + (size_t)tok * PWA + C_GM + (2 * d) * 4 + h)) + ldg(gbias + (2 * d) * 4 + h);
        const float gf = bf2f(ldg(prow + (size_t)tok * PWA + C_GM + (2 * d + 1) * 4 + h)) + ldg(gbias + (2 * d + 1) * 4 + h);
        b = logsigmoidf_(gf);
#pragma unroll
        for (int o = 1; o < 64; o <<= 1) { const float t = __shfl_up(b, o); if (lane >= o) b += t; }
        if (lane == 63) tmp[w] = b;
        a = gi;
    }
    __syncthreads();
    if (tid < 256) {
        if (w & 1) b += tmp[w - 1];
        a -= b; pm = a;
#pragma unroll
        for (int o = 1; o < 64; o <<= 1) { const float t = __shfl_up(pm, o); if (lane >= o) pm = fmaxf(pm, t); }
        if (lane == 63) tmp[8 + w] = pm;
    }
    __syncthreads();
    if (tid < 256) {
        if (w & 1) pm = fmaxf(pm, tmp[8 + w - 1]);
        ga[d * 128 + tok] = a; gb[d * 128 + tok] = b; gpm[d * 128 + tok] = pm;
        if ((tid & 127) == 127) { gtot[d * 2] = b; gtot[d * 2 + 1] = pm; }
    }
    __syncthreads();
}

DEV void load_rope_chunk(const bf16_t* hp, int cidx, bool latent, int tl, const float* rope, float scale, float* o) {
    const u32x4 m = ldg((const u32x4*)(hp + cidx * 8));
    float x[8] = {lo16(m.x), hi16(m.x), lo16(m.y), hi16(m.y), lo16(m.z), hi16(m.z), lo16(m.w), hi16(m.w)};
    if (latent) {
        const u32x4 q = ldg((const u32x4*)(hp + (cidx ^ 2) * 8));
        const float y[8] = {lo16(q.x), hi16(q.x), lo16(q.y), hi16(q.y), lo16(q.z), hi16(q.z), lo16(q.w), hi16(q.w)};
        const int pos = (cidx < 4) ? (tl >> 6) : (ROWS + (tl & 63));
        const float* tb = rope + ((size_t)pos * 16 + (cidx & 1) * 8) * 2;
        const bool first = (cidx & 2) == 0;
#pragma unroll
        for (int j = 0; j < 8; ++j) { const float cs = ldg(tb + j * 2), sn = ldg(tb + j * 2 + 1);
            x[j] = first ? (x[j] * cs - y[j] * sn) : (x[j] * cs + y[j] * sn); }
    }
#pragma unroll
    for (int j = 0; j < 8; ++j) o[j] = x[j] * scale;
}

DEV int st_index(const SetDesc& sd, int sl, int h, int dir, int tb) { return ((sl * 4 + h) * 2 + dir) * sd.ntb + tb; }

constexpr int V_LD = 144, K_LD = 72, KS_LD = 80;
DEV void mlstm_stepA_task(const Params& p, const SetDesc& sd, int layer, int task, char* shm) {
    const int tid = TID(), lane = tid & 63, w = tid >> 6, fr = lane & 15, fq = lane >> 4, tq4 = (lane & 15) >> 2, tp4 = lane & 3;
    const int tb = task % sd.ntb, h = (task / sd.ntb) & 3, sl = task / (sd.ntb * 4);
    const int row0 = (sl << sd.lgseq) + tb * 128; const bool latent = !sd.is_ctx; const int tl0 = tb * 128;
    bf16_t* Vs = (bf16_t*)shm;
    bf16_t* Ksc = (bf16_t*)(shm + 128 * V_LD * 2);
    float* ga = (float*)(shm + 128 * V_LD * 2 + 2 * 128 * KS_LD * 2); float* gb = ga + 256; float* gpm = gb + 256; float* gtot = gpm + 256; float* tmp = gtot + 8;
    const bf16_t* prow = proj_buf(p, sd) + (size_t)row0 * PWA;
    __syncthreads();
    gate_scan(prow, h, p.gate_bias + (size_t)layer * 16, ga, gb, gpm, gtot, tmp);
    {
        const int s = tid & 127, cpi = tid >> 7, cp = (cpi & 1) + (cpi >> 1) * 4;
        const bf16_t* hp = prow + (size_t)s * PWA + C_KM + h * 64;
        float k1[8], k2[8];
        load_rope_chunk(hp, cp, latent, tl0 + s, p.rope(), 1.0f, k1);
        load_rope_chunk(hp, cp + 2, latent, tl0 + s, p.rope(), 1.0f, k2);
#pragma unroll
        for (int dir = 0; dir < 2; ++dir) { const float ws = __expf(ga[dir * 128 + s] - gtot[dir * 2 + 1]);
            u32x4 o1 = {pack2(k1[0] * ws, k1[1] * ws), pack2(k1[2] * ws, k1[3] * ws), pack2(k1[4] * ws, k1[5] * ws), pack2(k1[6] * ws, k1[7] * ws)};
            u32x4 o2 = {pack2(k2[0] * ws, k2[1] * ws), pack2(k2[2] * ws, k2[3] * ws), pack2(k2[4] * ws, k2[5] * ws), pack2(k2[6] * ws, k2[7] * ws)};
            *(u32x4*)(Ksc + (dir * 128 + s) * KS_LD + cp * 8) = o1; *(u32x4*)(Ksc + (dir * 128 + s) * KS_LD + (cp + 2) * 8) = o2; }
    }
#pragma unroll
    for (int it = 0; it < 4; ++it) { const int item = tid + it * 512, s = item >> 4, ch = item & 15;
        *(u32x4*)(Vs + s * V_LD + ch * 8) = ldg((const u32x4*)(prow + (size_t)s * PWA + C_VM + h * 128 + ch * 8)); }
    __syncthreads();
    f32x4 acc[2][4];
#pragma unroll
    for (int dir = 0; dir < 2; ++dir)
#pragma unroll
        for (int n = 0; n < 4; ++n) acc[dir][n] = (f32x4){0.f, 0.f, 0.f, 0.f};
#pragma unroll
    for (int ks = 0; ks < 4; ++ks) {
        const bf16_t* vp = Vs + (32 * ks + 4 * fq + tq4) * V_LD + w * 16 + 4 * tp4;
        const bf16x8 af = mk8(TR16(vp), TR16(vp + 16 * V_LD));
#pragma unroll
        for (int dir = 0; dir < 2; ++dir)
#pragma unroll
            for (int n = 0; n < 4; ++n) { const bf16_t* kp = Ksc + (dir * 128 + 32 * ks + 4 * fq + tq4) * KS_LD + n * 16 + 4 * tp4;
                const bf16x8 bfv = mk8(TR16(kp), TR16(kp + 16 * KS_LD));
                acc[dir][n] = mfma16(af, bfv, acc[dir][n]); }
    }
#pragma unroll
    for (int dir = 0; dir < 2; ++dir) { float* So = p.Sst() + (size_t)st_index(sd, sl, h, dir, tb) * 8192;
#pragma unroll
        for (int n = 0; n < 4; ++n)
#pragma unroll
            for (int r = 0; r < 4; ++r) stg(So + (w * 16 + fq * 4 + r) * 64 + n * 16 + fr, (float)acc[dir][n][r]); }
    if (tid < 128) { const int dir = tid >> 6, dd = tid & 63; float sm = 0.f;
        for (int i = 0; i < 128; ++i) sm += bf2f(Ksc[(dir * 128 + i) * KS_LD + dd]);
        stg(p.Sn() + (size_t)st_index(sd, sl, h, dir, tb) * 64 + dd, sm); }
    if (tid < 2) { float* sc = p.Ssc() + (size_t)st_index(sd, sl, h, tid, tb) * 4; stg(sc, gtot[tid * 2]); stg(sc + 1, gtot[tid * 2] + gtot[tid * 2 + 1]); }
}

template <int GI> DEV void pool_group(const Params& p, const SetDesc& sd, const bf16_t* pb) {
    constexpr int W = 2 << GI;
    const int nitems = sd.nrows * 16; const int T = 1 << sd.lgseq;
    for (int item = blockIdx.x * NTHREADS + TID(); item < nitems; item += gridDim.x * NTHREADS) {
        const int row = item >> 4, ch = GI * 128 + (item & 15) * 8;
        const int tt = row & (T - 1);
        u32x4 mv[W]; int cnt = 0; bool okv[W];
#pragma unroll
        for (int q = 0; q < W; ++q) { const int t2 = tt - W / 2 + q; const bool ok = (t2 >= 0) && (t2 < T); cnt += ok ? 1 : 0; okv[q] = ok;
            mv[q] = ldg((const u32x4*)(pb + (size_t)(ok ? (row - W / 2 + q) : row) * PWA + C_PU + ch)); }
        float s[8];
#pragma unroll
        for (int j = 0; j < 8; ++j) s[j] = 0.f;
#pragma unroll
        for (int q = 0; q < W; ++q) { u32x4 m = mv[q]; if (!okv[q]) m = (u32x4){0u, 0u, 0u, 0u};
            s[0] += lo16(m.x); s[1] += hi16(m.x); s[2] += lo16(m.y); s[3] += hi16(m.y); s[4] += lo16(m.z); s[5] += hi16(m.z); s[6] += lo16(m.w); s[7] += hi16(m.w); }
        const float inv = frcp((float)cnt);
        const u32x4 m = mv[W / 2];
        const float u[8] = {lo16(m.x), hi16(m.x), lo16(m.y), hi16(m.y), lo16(m.z), hi16(m.z), lo16(m.w), hi16(m.w)};
        u32x4 o = {pack2(s[0] * inv - u[0], s[1] * inv - u[1]), pack2(s[2] * inv - u[2], s[3] * inv - u[3]), pack2(s[4] * inv - u[4], s[5] * inv - u[5]), pack2(s[6] * inv - u[6], s[7] * inv - u[7])};
        stg((u32x4*)(p.Pb() + (size_t)row * 512 + ch), o);
    }
}
DEV void phase_pool(const Params& p, const SetDesc& sd) {
    const bf16_t* pb = proj_buf(p, sd);
    pool_group<0>(p, sd, pb); pool_group<1>(p, sd, pb); pool_group<2>(p, sd, pb); pool_group<3>(p, sd, pb);
}

template <int NC> DEV void mlstm_stepB_run(const Params& p, const SetDesc& sd, int task) {
    const int tid = TID();
    const int q = task & 3, dir = (task >> 2) & 1, h = (task >> 3) & 3, sl = task >> 5;
    const int ci = ((sd.samp0 + sl) * 4 + h) * 2 + dir;
    const int eoff = q * 2048 + tid * 4;
    float zr = 0.f; HIDE(zr);
    f32x4 C = {zr, zr, zr, zr}; float nv = 0.f; float m = -1e30f;
    f32x4 Sv[NC]; float blv[NC], mlv[NC], snv[NC];
#pragma unroll
    for (int c = 0; c < NC; ++c) { const int tb = dir ? NC - 1 - c : c; const size_t si = st_index(sd, sl, h, dir, tb);
        Sv[c] = ldg((const f32x4*)(p.Sst() + si * 8192 + eoff)); blv[c] = ldg(p.Ssc() + si * 4); mlv[c] = ldg(p.Ssc() + si * 4 + 1);
        snv[c] = (q == 0 && tid < 64) ? ldg(p.Sn() + si * 64 + tid) : 0.f; }
    if (!sd.is_ctx) { C = ldg((const f32x4*)(p.CiC() + (size_t)ci * 8192 + eoff)); if (q == 0 && tid < 64) nv = ldg(p.Cin_() + (size_t)ci * 64 + tid); m = ldg(p.Cim() + (size_t)ci * 4); }
#pragma unroll
    for (int c = 0; c < NC; ++c) {
        const int tb = dir ? NC - 1 - c : c; const size_t si = st_index(sd, sl, h, dir, tb);
        u32x2 o = {pack2(C[0], C[1]), pack2(C[2], C[3])};
        stg((u32x2*)(p.Cin() + si * 8192 + eoff), o);
        if (q == 0 && tid < 64) stg(p.Cn() + si * 64 + tid, nv);
        if (q == 0 && tid == 0) stg(p.Cm() + si * 4, m);
        const float mn = fmaxf(blv[c] + m, mlv[c]);
        const float dc = __expf(blv[c] + m - mn), wsn = __expf(mlv[c] - mn);
        C = C * dc + Sv[c] * wsn;
        nv = nv * dc + snv[c] * wsn;
        m = mn;
    }
    if (sd.is_ctx) { stg((f32x4*)(p.CiC() + (size_t)ci * 8192 + eoff), C); if (q == 0 && tid < 64) stg(p.Cin_() + (size_t)ci * 64 + tid, nv); if (q == 0 && tid == 0) stg(p.Cim() + (size_t)ci * 4, m); }
}
DEV void mlstm_stepB_task(const Params& p, const SetDesc& sd, int task) {
    if (sd.is_ctx) mlstm_stepB_run<NTBC>(p, sd, task); else mlstm_stepB_run<NTBL>(p, sd, task);
}

constexpr int NA_KLD = 136, NA_VLD = 144;
DEV void na_task(const Params& p, const SetDesc& sd, int layer, int sl, int rq2  , int hp, char* shm) {
    const int tid = TID(), lane = tid & 63, w = tid >> 6, tq = lane & 15, fq = lane >> 4, tq4 = (lane & 15) >> 2, tp4 = lane & 3;
    const int hh = w >> 2, g = w & 3, head = hp * 2 + hh;
    const bool ctxq = sd.is_ctx;
    bf16_t* Ks = (bf16_t*)shm;
    bf16_t* Vs = (bf16_t*)(shm + 128 * NA_KLD * 2);
    float* rpbs = (float*)(shm + 128 * NA_KLD * 2 + 128 * NA_VLD * 2);
    const int sample = sd.samp0 + sl;
    const bf16_t* pq = proj_buf(p, sd) + ((size_t)sl << sd.lgseq) * PWA;
    const bf16_t* pc = p.PROJc() + (size_t)sample * CTX * PWA;
    const int qcol = g * 16 + tq;
    int rqv[2], rsv[2], qtok[2];
#pragma unroll
    for (int u = 0; u < 2; ++u) { rqv[u] = 2 * rq2 + u; qtok[u] = rqv[u] * 64 + qcol; int r_ = rqv[u] - 4; rsv[u] = r_ < 0 ? 0 : (r_ > ROWS - 8 ? ROWS - 8 : r_); }
    const int nloc = ctxq ? 0 : (rsv[1] + 8 - rsv[0]);
    const int nstage = nloc + CTX / 64;
    __syncthreads();
    if (!ctxq) for (int i = tid; i < 2 * 465; i += NTHREADS) rpbs[i] = ldg(p.rpb + ((size_t)layer * 8 + hp * 2 + i / 465) * 465 + i % 465);
    bf16x8 qf[2][2];
#pragma unroll
    for (int u = 0; u < 2; ++u)
#pragma unroll
        for (int ks = 0; ks < 2; ++ks) qf[u][ks] = mk8(ldg((const u32x4*)(pq + (size_t)qtok[u] * PWA + C_QN + head * 64 + ks * 32 + fq * 8)));
    float m_run[2] = {-1e30f, -1e30f}, l_run[2] = {0.f, 0.f};
    f32x4 acc[2][4];
#pragma unroll
    for (int u = 0; u < 2; ++u)
#pragma unroll
        for (int mt = 0; mt < 4; ++mt) acc[u][mt] = (f32x4){0.f, 0.f, 0.f, 0.f};
    int cs = qcol - 8; cs = cs < 0 ? 0 : (cs > 48 ? 48 : cs);
    const int kc0 = (g == 0) ? 0 : (g == 1) ? 8 : (g == 2) ? 24 : 32;
    const int npair = (nstage + 1) >> 1;
    u32x4 kreg[4], vreg[4];
#define NA_SRC_ROWS(stg) (((stg) < nloc) ? (pq + (size_t)((rsv[0] + (stg)) * 64) * PWA) : (pc + (size_t)((((stg) < nstage ? (stg) : nstage - 1) - nloc) * 64) * PWA))
#define NA_FETCH(sp_) do { _Pragma("unroll") for (int it = 0; it < 4; ++it) { const int item = tid + it * 512, key2 = item >> 4, ch = item & 15; \
        const bf16_t* kb_ = NA_SRC_ROWS(2 * (sp_) + (key2 >> 6)); const bf16_t* src = kb_ + (size_t)(key2 & 63) * PWA + hp * 128 + ch * 8; \
        kreg[it] = ldg((const u32x4*)(src + C_KN)); vreg[it] = ldg((const u32x4*)(src + C_VN)); } } while (0)
    NA_FETCH(0);
    for (int sp = 0; sp < npair; ++sp) {
        __syncthreads();
#pragma unroll
        for (int it = 0; it < 4; ++it) { const int item = tid + it * 512, key2 = item >> 4, ch = item & 15;
            *(u32x4*)(Ks + key2 * NA_KLD + ch * 8) = kreg[it]; *(u32x4*)(Vs + key2 * NA_VLD + ch * 8) = vreg[it]; }
        if (sp + 1 < npair) NA_FETCH(sp + 1);
        __syncthreads();
#pragma unroll
        for (int sub = 0; sub < 2; ++sub) {
        const int st = 2 * sp + sub;
        if (st >= nstage) continue;
        const bool local = st < nloc;
        const bf16_t* Ksb = Ks + sub * 64 * NA_KLD; const bf16_t* Vsb = Vs + sub * 64 * NA_VLD;
        if (local) {
            const int kr = rsv[0] + st;
            f32x4 sa[2][2];
#pragma unroll
            for (int kt = 0; kt < 2; ++kt) { sa[0][kt] = (f32x4){0.f, 0.f, 0.f, 0.f}; sa[1][kt] = (f32x4){0.f, 0.f, 0.f, 0.f};
#pragma unroll
                for (int ks = 0; ks < 2; ++ks) { const bf16x8 kf = *(const bf16x8*)(Ksb + (kc0 + kt * 16 + tq) * NA_KLD + hh * 64 + ks * 32 + fq * 8);
                    sa[0][kt] = mfma16(kf, qf[0][ks], sa[0][kt]); sa[1][kt] = mfma16(kf, qf[1][ks], sa[1][kt]); } }
            float alpha[2]; bf16x8 pf[2];
#pragma unroll
            for (int u = 0; u < 2; ++u) {
                const bool act = (kr >= rsv[u]) && (kr < rsv[u] + 8);
                if (!act) { alpha[u] = 1.0f; pf[u] = mk8((u32x4){0u, 0u, 0u, 0u}); continue; }
                const int dr = kr - rqv[u] + 7;
                float sc[8]; float mx = -1e30f; float bs[8];
#pragma unroll
                for (int kt = 0; kt < 2; ++kt)
#pragma unroll
                    for (int r = 0; r < 4; ++r) { const int kcol = kc0 + kt * 16 + fq * 4 + r; int dc = kcol - qcol + 15; dc = dc < 0 ? 0 : (dc > 30 ? 30 : dc);
                        bs[kt * 4 + r] = rpbs[hh * 465 + dr * 31 + dc]; }
#ifndef CPU_EMU
                asm volatile("" : "+v"(bs[0]), "+v"(bs[1]), "+v"(bs[2]), "+v"(bs[3]), "+v"(bs[4]), "+v"(bs[5]), "+v"(bs[6]), "+v"(bs[7]));
#endif
#pragma unroll
                for (int kt = 0; kt < 2; ++kt)
#pragma unroll
                    for (int r = 0; r < 4; ++r) { const int kcol = kc0 + kt * 16 + fq * 4 + r; const bool valid = (kcol >= cs) && (kcol < cs + 16);
                        const float v = valid ? (sa[u][kt][r] * 0.125f + bs[kt * 4 + r]) : -1e30f; sc[kt * 4 + r] = v; mx = fmaxf(mx, v); }
                mx = fmaxf(mx, shx<16>(mx)); mx = fmaxf(mx, shx<32>(mx));
                const float mn = fmaxf(m_run[u], mx); alpha[u] = __expf(m_run[u] - mn); m_run[u] = mn;
                float ps = 0.f; float pv[8];
#pragma unroll
                for (int j = 0; j < 8; ++j) { pv[j] = __expf(sc[j] - mn); ps += pv[j]; }
                ps += shx<16>(ps); ps += shx<32>(ps);
                l_run[u] = l_run[u] * alpha[u] + ps;
                u32x4 pk = {pack2(pv[0], pv[1]), pack2(pv[2], pv[3]), pack2(pv[4], pv[5]), pack2(pv[6], pv[7])};
                pf[u] = mk8(pk);
            }
#pragma unroll
            for (int mt = 0; mt < 4; ++mt) {
                const bf16_t* vp = Vsb + (kc0 + 4 * fq + tq4) * NA_VLD + hh * 64 + mt * 16 + 4 * tp4;
                const bf16x8 vf = mk8(TR16(vp), TR16(vp + 16 * NA_VLD));
                acc[0][mt] = mfma16(vf, pf[0], acc[0][mt] * alpha[0]); acc[1][mt] = mfma16(vf, pf[1], acc[1][mt] * alpha[1]); }
        } else {
            f32x4 sa[2][4];
#pragma unroll
            for (int kt = 0; kt < 4; ++kt) { sa[0][kt] = (f32x4){0.f, 0.f, 0.f, 0.f}; sa[1][kt] = (f32x4){0.f, 0.f, 0.f, 0.f};
#pragma unroll
                for (int ks = 0; ks < 2; ++ks) { const bf16x8 kf = *(const bf16x8*)(Ksb + (kt * 16 + tq) * NA_KLD + hh * 64 + ks * 32 + fq * 8);
                    sa[0][kt] = mfma16(kf, qf[0][ks], sa[0][kt]); sa[1][kt] = mfma16(kf, qf[1][ks], sa[1][kt]); } }
            float alpha[2]; bf16x8 pf[2][2];
#pragma unroll
            for (int u = 0; u < 2; ++u) {
                float mx = -1e30f;
#pragma unroll
                for (int kt = 0; kt < 4; ++kt)
#pragma unroll
                    for (int r = 0; r < 4; ++r) { sa[u][kt][r] *= 0.125f; mx = fmaxf(mx, sa[u][kt][r]); }
                mx = fmaxf(mx, shx<16>(mx)); mx = fmaxf(mx, shx<32>(mx));
                const float mn = fmaxf(m_run[u], mx); alpha[u] = __expf(m_run[u] - mn); m_run[u] = mn;
                float ps = 0.f;
#pragma unroll
                for (int kt = 0; kt < 4; ++kt)
#pragma unroll
                    for (int r = 0; r < 4; ++r) { sa[u][kt][r] = __expf(sa[u][kt][r] - mn); ps += sa[u][kt][r]; }
                ps += shx<16>(ps); ps += shx<32>(ps);
                l_run[u] = l_run[u] * alpha[u] + ps;
#pragma unroll
                for (int h2 = 0; h2 < 2; ++h2) {
                    u32x4 pk = {pack2(sa[u][2 * h2][0], sa[u][2 * h2][1]), pack2(sa[u][2 * h2][2], sa[u][2 * h2][3]), pack2(sa[u][2 * h2 + 1][0], sa[u][2 * h2 + 1][1]), pack2(sa[u][2 * h2 + 1][2], sa[u][2 * h2 + 1][3])};
                    pf[u][h2] = mk8(pk); }
            }
#pragma unroll
            for (int mt = 0; mt < 4; ++mt) { acc[0][mt] = acc[0][mt] * alpha[0]; acc[1][mt] = acc[1][mt] * alpha[1]; }
#pragma unroll
            for (int h2 = 0; h2 < 2; ++h2)
#pragma unroll
                for (int mt = 0; mt < 4; ++mt) { const bf16_t* vp = Vsb + (32 * h2 + 4 * fq + tq4) * NA_VLD + hh * 64 + mt * 16 + 4 * tp4;
                    const bf16x8 vf = mk8(TR16(vp), TR16(vp + 16 * NA_VLD));
                    acc[0][mt] = mfma16(vf, pf[0][h2], acc[0][mt]); acc[1][mt] = mfma16(vf, pf[1][h2], acc[1][mt]); }
        }
        }
    }
#undef NA_FETCH
#undef NA_SRC_ROWS
#pragma unroll
    for (int u = 0; u < 2; ++u) {
        const float il = frcp(l_run[u]);
        const size_t orow = ((size_t)sl << sd.lgseq) + qtok[u];
#pragma unroll
        for (int mt = 0; mt < 4; ++mt) { u32x2 o = {pack2(acc[u][mt][0] * il, acc[u][mt][1] * il), pack2(acc[u][mt][2] * il, acc[u][mt][3] * il)};
            stg((u32x2*)(p.Nb() + orow * 512 + head * 64 + mt * 16 + fq * 4), o); }
    }
}

DEV void mlstm_stepC_task(const Params& p, const SetDesc& sd, int layer, int task, char* shm) {
    const int tid = TID(), lane = tid & 63, w = tid >> 6, tq = lane & 15, fq = lane >> 4, tq4 = (lane & 15) >> 2, tp4 = lane & 3;
    const int tb = task % sd.ntb, h = (task / sd.ntb) & 3, sl = task / (sd.ntb * 4);
    const int row0 = (sl << sd.lgseq) + tb * 128; const bool latent = !sd.is_ctx; const int tl0 = tb * 128;
    bf16_t* Ks = (bf16_t*)shm;
    bf16_t* Vs = (bf16_t*)(shm + 128 * K_LD * 2);
    bf16_t* Cs = (bf16_t*)(shm + 128 * K_LD * 2 + 128 * V_LD * 2);
    float* ga = (float*)(shm + 128 * K_LD * 2 * 3 + 128 * V_LD * 2); float* gb = ga + 256; float* gpm = gb + 256; float* gtot = gpm + 256; float* tmp = gtot + 8;
    float* nvs = tmp + 16;
    float* cms = nvs + 128;
    const bf16_t* prow = proj_buf(p, sd) + (size_t)row0 * PWA;
    __syncthreads();
    gate_scan(prow, h, p.gate_bias + (size_t)layer * 16, ga, gb, gpm, gtot, tmp);
    {
        const int s = tid & 127, cpi = tid >> 7, cp = (cpi & 1) + (cpi >> 1) * 4;
        const bf16_t* hp = prow + (size_t)s * PWA + C_KM + h * 64;
        float k1[8], k2[8];
        load_rope_chunk(hp, cp, latent, tl0 + s, p.rope(), 1.0f, k1);
        load_rope_chunk(hp, cp + 2, latent, tl0 + s, p.rope(), 1.0f, k2);
        u32x4 o1 = {pack2(k1[0], k1[1]), pack2(k1[2], k1[3]), pack2(k1[4], k1[5]), pack2(k1[6], k1[7])};
        u32x4 o2 = {pack2(k2[0], k2[1]), pack2(k2[2], k2[3]), pack2(k2[4], k2[5]), pack2(k2[6], k2[7])};
        *(u32x4*)(Ks + s * K_LD + cp * 8) = o1; *(u32x4*)(Ks + s * K_LD + (cp + 2) * 8) = o2;
    }
#pragma unroll
    for (int it = 0; it < 4; ++it) { const int item = tid + it * 512, s = item >> 4, ch = item & 15;
        *(u32x4*)(Vs + s * V_LD + ch * 8) = ldg((const u32x4*)(prow + (size_t)s * PWA + C_VM + h * 128 + ch * 8)); }
#pragma unroll
    for (int it = 0; it < 4; ++it) { const int item = tid + it * 512, dir = item >> 10, rem = item & 1023, v = rem >> 3, ch = rem & 7;
        *(u32x4*)(Cs + (dir * 128 + v) * K_LD + ch * 8) = ldg((const u32x4*)(p.Cin() + (size_t)st_index(sd, sl, h, dir, tb) * 8192 + v * 64 + ch * 8)); }
    if (tid < 128) nvs[tid] = ldg(p.Cn() + (size_t)st_index(sd, sl, h, tid >> 6, tb) * 64 + (tid & 63));
    if (tid < 2) cms[tid] = ldg(p.Cm() + (size_t)st_index(sd, sl, h, tid, tb) * 4);
    bf16x8 qf[2]; float qv[2][8];
    {
        const int t = w * 16 + tq; const bf16_t* hp = prow + (size_t)t * PWA + C_QM + h * 64;
#pragma unroll
        for (int ks = 0; ks < 2; ++ks) { load_rope_chunk(hp, ks * 4 + fq, latent, tl0 + t, p.rope(), 0.125f, qv[ks]);
            u32x4 o = {pack2(qv[ks][0], qv[ks][1]), pack2(qv[ks][2], qv[ks][3]), pack2(qv[ks][4], qv[ks][5]), pack2(qv[ks][6], qv[ks][7])}; qf[ks] = mk8(o); }
    }
    __syncthreads();
    const int t = w * 16 + tq;
    f32x4 hsum[8];
#pragma unroll
    for (int mt = 0; mt < 8; ++mt) hsum[mt] = (f32x4){0.f, 0.f, 0.f, 0.f};
#pragma unroll
    for (int dir = 0; dir < 2; ++dir) {
        const float m_in = cms[dir];
        const float Mt = fmaxf(m_in, gpm[dir * 128 + t]);
        const float inter = __expf(m_in - Mt);
        const float mtot = gb[dir * 128 + t] + Mt;
        f32x4 acc[8];
#pragma unroll
        for (int mt = 0; mt < 8; ++mt) { acc[mt] = (f32x4){0.f, 0.f, 0.f, 0.f};
#pragma unroll
            for (int ks = 0; ks < 2; ++ks) { const bf16x8 cf = *(const bf16x8*)(Cs + (dir * 128 + mt * 16 + tq) * K_LD + ks * 32 + fq * 8);
                acc[mt] = mfma16(cf, qf[ks], acc[mt]); }
            acc[mt] = acc[mt] * inter; }
        float qn = 0.f;
#pragma unroll
        for (int ks = 0; ks < 2; ++ks)
#pragma unroll
            for (int j = 0; j < 8; ++j) qn += bf2f(f2bf(qv[ks][j])) * nvs[dir * 64 + ks * 32 + fq * 8 + j];
        qn += shx<16>(qn); qn += shx<32>(qn);
        float den = inter * qn;
        const int u_lo = dir == 0 ? 0 : (w >> 1), u_hi = dir == 0 ? (w >> 1) : 3;
        float rsum = 0.f;
        for (int u = u_lo; u <= u_hi; ++u) {
            unsigned pk[4];
#pragma unroll
            for (int kt = 0; kt < 2; ++kt) { f32x4 sa = {0.f, 0.f, 0.f, 0.f}; const int sb = 32 * u + 16 * kt;
#pragma unroll
                for (int ks = 0; ks < 2; ++ks) { const bf16x8 kf = *(const bf16x8*)(Ks + (sb + tq) * K_LD + ks * 32 + fq * 8); sa = mfma16(kf, qf[ks], sa); }
                float pv[4]; float gv4[4];
#pragma unroll
                for (int r = 0; r < 4; ++r) gv4[r] = ga[dir * 128 + sb + fq * 4 + r];
#ifndef CPU_EMU
                asm volatile("" : "+v"(gv4[0]), "+v"(gv4[1]), "+v"(gv4[2]), "+v"(gv4[3]));
#endif
#pragma unroll
                for (int r = 0; r < 4; ++r) { const int s = sb + fq * 4 + r; const bool valid = dir == 0 ? (s <= t) : (s >= t);
                    pv[r] = valid ? sa[r] * __expf(gv4[r] - Mt) : 0.f; pv[r] = bf2f(f2bf(pv[r])); rsum += pv[r]; }
                pk[kt * 2] = pack2(pv[0], pv[1]); pk[kt * 2 + 1] = pack2(pv[2], pv[3]); }
            u32x4 pkv = {pk[0], pk[1], pk[2], pk[3]}; const bf16x8 pf = mk8(pkv);
#pragma unroll
            for (int mt = 0; mt < 8; ++mt) { const bf16_t* vp = Vs + (32 * u + 4 * fq + tq4) * V_LD + mt * 16 + 4 * tp4;
                const bf16x8 vf = mk8(TR16(vp), TR16(vp + 16 * V_LD));
                acc[mt] = mfma16(vf, pf, acc[mt]); }
        }
        rsum += shx<16>(rsum); rsum += shx<32>(rsum);
        den += rsum;
        const float dn = frcp(fmaxf(fabsf(den), __expf(-mtot)));
#pragma unroll
        for (int mt = 0; mt < 8; ++mt) hsum[mt] = hsum[mt] + acc[mt] * dn;
    }
    float ss = 0.f;
#pragma unroll
    for (int mt = 0; mt < 8; ++mt)
#pragma unroll
        for (int r = 0; r < 4; ++r) ss += hsum[mt][r] * hsum[mt][r];
    ss += shx<16>(ss); ss += shx<32>(ss);
    const float rstd = rsqrtf(ss * (1.0f / 128.0f) + RMS_EPS);
#pragma unroll
    for (int mt = 0; mt < 8; ++mt) { const int v = mt * 16 + fq * 4;
        const u32x2 om = ldg((const u32x2*)(prow + (size_t)t * PWA + C_OM + h * 128 + v));
        u32x2 o = {pack2(hsum[mt][0] * rstd * sigmoidf_(lo16(om.x)), hsum[mt][1] * rstd * sigmoidf_(hi16(om.x))),
                   pack2(hsum[mt][2] * rstd * sigmoidf_(lo16(om.y)), hsum[mt][3] * rstd * sigmoidf_(hi16(om.y)))};
        stg((u32x2*)(p.Mb() + (size_t)(row0 + t) * 512 + h * 128 + v), o); }
}

struct SchedMerge {
    const bf16_t* Mb; const bf16_t* Pb; const bf16_t* Nb; const bf16_t* Wb; int nM;
    DEV bool next(int i, GUnit& u) const { u.aux = i % 3; return tile_order(i / 3, nM, 4, u.pm, u.pn); }
    DEV const bf16_t* a_base(const GUnit& u) const { return (u.aux == 0 ? Mb : (u.aux == 1 ? Pb : Nb)) + (size_t)u.pm * 256 * 512; }
    DEV const bf16_t* b_base(const GUnit& u) const { return Wb + ((size_t)u.aux * 1024 + u.pn * 256) * 512; }
    DEV int grow(const GUnit&, int) const { return 0; }
};
DEV void phase_merge(const Params& p, const SetDesc& sd, int layer, char* shm) {
    SchedMerge S; S.Mb = p.Mb(); S.Pb = p.Pb(); S.Nb = p.Nb(); S.Wb = p.WbT() + (size_t)layer * 3 * 1024 * 512; S.nM = sd.nrows / 256;
    const unsigned char* bgb = (const unsigned char*)p.BG(); bf16_t* mgb = p.MERGED();
    gemm_stream<false, 512, 512, 512>(shm, S, [=](const GUnit& u, f32x4 (&acc)[2][2][4][2], int r0, int c0) -> bool {
        if (u.aux < 2) {
            u32x2 ga[2][4][2], gb[2][4][2];
#pragma unroll
            for (int ai = 0; ai < 2; ++ai)
#pragma unroll
                for (int m = 0; m < 4; ++m)
#pragma unroll
                    for (int hf = 0; hf < 2; ++hf) { const unsigned char* gp = bgb + ((size_t)u.pm * 256 + r0 + ai * 128 + m * 16) * NBG + u.aux * 1024 + u.pn * 256 + c0 + hf * 128;
                        ga[ai][m][hf] = ldg((const u32x2*)gp); gb[ai][m][hf] = ldg((const u32x2*)(gp + 1024)); }
#pragma unroll
            for (int ai = 0; ai < 2; ++ai)
#pragma unroll
                for (int m = 0; m < 4; ++m)
#pragma unroll
                    for (int hf = 0; hf < 2; ++hf) {
#pragma unroll
                        for (int j = 0; j < 4; ++j) { acc[ai][hf][m][0][j] *= u8f(ga[ai][m][hf].x, j) * frcp(u8f(gb[ai][m][hf].x, j)); acc[ai][hf][m][1][j] *= u8f(ga[ai][m][hf].y, j) * frcp(u8f(gb[ai][m][hf].y, j)); } }
            return true;
        }
        u32x2 gm2[2][4][2];
#pragma unroll
        for (int ai = 0; ai < 2; ++ai)
#pragma unroll
            for (int m = 0; m < 4; ++m)
#pragma unroll
                for (int hf = 0; hf < 2; ++hf) gm2[ai][m][hf] = ldg((const u32x2*)(bgb + ((size_t)u.pm * 256 + r0 + ai * 128 + m * 16) * NBG + 2048 + u.pn * 256 + c0 + hf * 128));
#pragma unroll
        for (int ai = 0; ai < 2; ++ai) {
#pragma unroll
            for (int m = 0; m < 4; ++m)
#pragma unroll
                for (int hf = 0; hf < 2; ++hf) { const size_t r = (size_t)u.pm * 256 + r0 + ai * 128 + m * 16;
                    const f32x4 x0 = acc[ai][hf][m][0] * (1.0f / 255.0f), x1 = acc[ai][hf][m][1] * (1.0f / 255.0f); const u32x2 g = gm2[ai][m][hf];
                    u32x4 ov = {pack2(x0[0] * u8f(g.x, 0), x0[1] * u8f(g.x, 1)), pack2(x0[2] * u8f(g.x, 2), x0[3] * u8f(g.x, 3)),
                                pack2(x1[0] * u8f(g.y, 0), x1[1] * u8f(g.y, 1)), pack2(x1[2] * u8f(g.y, 2), x1[3] * u8f(g.y, 3))};
                    stg((u32x4*)(mgb + r * 1024 + u.pn * 256 + c0 + hf * 128), ov); }
        }
        return false; });
}
DEV void phase_outproj(const Params& p, const SetDesc& sd, int layer, char* shm) {
    SchedPlain S; S.A = p.MERGED(); S.Bt = p.WoT() + (size_t)layer * 1024 * 1024; S.nM = sd.nrows / 256; S.nN = 4; S.lda256 = 256 * 1024; S.ldb256 = 256 * 1024;
    bf16_t* yb = p.Y();
    gemm_stream<false, 1024, 1024, 1024>(shm, S, [=](const GUnit& u, const f32x4 (&acc)[2][2][4][2], int r0, int c0) {
#pragma unroll
        for (int ai = 0; ai < 2; ++ai)
#pragma unroll
            for (int m = 0; m < 4; ++m) { bf16_t* o = yb + ((size_t)u.pm * 256 + r0 + ai * 128 + m * 16) * 1024 + u.pn * 256 + c0;
                store8bf(o, acc[ai][0][m][0], acc[ai][0][m][1]); store8bf(o + 128, acc[ai][1][m][0], acc[ai][1][m][1]); } });
}

template <bool SRC_BF> DEV void phase_postmix(const Params& p, const SetDesc& sd, int layer, char* shm) {
    const int tid = TID(), lane = tid & 63, wv = tid >> 6;
    float* wr_s = (float*)shm;
    __syncthreads();
    for (int i = tid; i < 1024 * 16; i += NTHREADS) { const int c = i >> 4, e = i & 15, ln = (c & 511) >> 3, j = c & 7, hf = c >> 9;
        wr_s[((((hf * 8 + j) * 4 + (e >> 2)) * 64 + ln) << 2) + (e & 3)] = ldg(p.router_w + (size_t)layer * 1024 * 16 + i); }
    __syncthreads();
    const float* g1 = p.norm_gain + ((size_t)layer * 4 + 1) * 1024; const float* g2 = p.norm_gain + ((size_t)layer * 4 + 2) * 1024;
    float* par = (float*)(shm + 65536);
    { const int rpb0_ = (sd.nrows + (int)gridDim.x - 1) / (int)gridDim.x; const float* mdb = mod_row(p, sd, layer, min((int)blockIdx.x * rpb0_, sd.nrows - 1));
      stage_params(par, g1, g2, mdb + 2048, mdb + 3072, mdb + 4096); }
    __syncthreads();
    const void* xb = SRC_BF ? (const void*)xbf_base(p, sd) : (const void*)xin_f32(p, sd); bf16_t* xdb = xbf_base(p, sd);
    const int stride = 8; const int rpb_ = (sd.nrows + (int)gridDim.x - 1) / (int)gridDim.x; const int row_end = min(sd.nrows, ((int)blockIdx.x + 1) * rpb_);
    int row = (int)blockIdx.x * rpb_ + wv;
    u32x4 ycur[2], ynxt[2]; XRow<SRC_BF> xcur, xnxt;
    if (row < row_end) {
#pragma unroll
        for (int i = 0; i < 2; ++i) ycur[i] = ldg((const u32x4*)(p.Y() + (size_t)row * 1024 + i * 512 + lane * 8));
        xcur.load(xb, row, lane); }
    for (; row < row_end; row += stride) {
        int ln = lane; HIDE(ln);
        const int rn = row + stride;
        if (rn < row_end) {
#pragma unroll
            for (int i = 0; i < 2; ++i) ynxt[i] = ldg((const u32x4*)(p.Y() + (size_t)rn * 1024 + i * 512 + ln * 8));
            xnxt.load(xb, rn, ln); }
        float y[16]; float ss = 0.f;
#pragma unroll
        for (int hlf = 0; hlf < 2; ++hlf) { const u32x4 m = ycur[hlf];
            const float t8[8] = {lo16(m.x), hi16(m.x), lo16(m.y), hi16(m.y), lo16(m.z), hi16(m.z), lo16(m.w), hi16(m.w)};
#pragma unroll
            for (int j = 0; j < 8; ++j) { y[hlf * 8 + j] = t8[j]; ss += t8[j] * t8[j]; } }
        ss = wave_sum(ss);
        const float rstd = rsqrtf(ss * (1.0f / 1024.0f) + RMS_EPS);
        float xn[16]; float ss2 = 0.f;
#pragma unroll
        for (int hlf = 0; hlf < 2; ++hlf) { f32x4 xw[2];
#pragma unroll
            for (int q = 0; q < 2; ++q) { const int c0 = hlf * 512 + ln * 8 + q * 4; const f32x4 xo = xcur.get(hlf * 2 + q);
#pragma unroll
                for (int j = 0; j < 4; ++j) { const float v = xo[j] + par[2048 + c0 + j] * (y[hlf * 8 + q * 4 + j] * rstd * par[c0 + j]); xw[q][j] = v; xn[hlf * 8 + q * 4 + j] = v; ss2 += v * v; } }
            xrow_store8<true>(xdb, row, hlf * 512 + ln * 8, xw[0], xw[1]); }
        ss2 = wave_sum(ss2);
        const float rstd2 = rsqrtf(ss2 * (1.0f / 1024.0f) + RMS_EPS);
        float lg[16];
#pragma unroll
        for (int e = 0; e < 16; ++e) lg[e] = 0.f;
#pragma unroll
        for (int hlf = 0; hlf < 2; ++hlf) { const int c0 = hlf * 512 + ln * 8; float o[8];
#pragma unroll
            for (int j = 0; j < 8; ++j) { o[j] = xn[hlf * 8 + j] * rstd2 * par[1024 + c0 + j] * (1.0f + par[4096 + c0 + j]) + par[3072 + c0 + j];
#pragma unroll
                for (int eq = 0; eq < 4; ++eq) { const f32x4 w4 = *(const f32x4*)(wr_s + ((((hlf * 8 + j) * 4 + eq) * 64 + ln) << 2));
#pragma unroll
                    for (int e = 0; e < 4; ++e) lg[eq * 4 + e] += o[j] * w4[e]; } }
            const u32x2 ov = {f8pack4(o[0], o[1], o[2], o[3]), f8pack4(o[4], o[5], o[6], o[7])};
            stg((u32x2*)((unsigned char*)p.H() + (size_t)row * 1024 + c0), ov); }
        float r8[8], r4[4], r2[2], r1;
        { const bool b = (lane & 32) != 0;
#pragma unroll
          for (int i = 0; i < 8; ++i) { const float keep = b ? lg[i + 8] : lg[i], send = b ? lg[i] : lg[i + 8]; r8[i] = keep + shx<32>(send); } }
        { const bool b = (lane & 16) != 0;
#pragma unroll
          for (int i = 0; i < 4; ++i) { const float keep = b ? r8[i + 4] : r8[i], send = b ? r8[i] : r8[i + 4]; r4[i] = keep + shx<16>(send); } }
        { const bool b = (lane & 8) != 0;
#pragma unroll
          for (int i = 0; i < 2; ++i) { const float keep = b ? r4[i + 2] : r4[i], send = b ? r4[i] : r4[i + 2]; r2[i] = keep + shx<8>(send); } }
        { const bool b = (lane & 4) != 0; const float keep = b ? r2[1] : r2[0], send = b ? r2[0] : r2[1]; r1 = keep + shx<4>(send); }
        r1 += shx<2>(r1); r1 += shx<1>(r1);
        float mx = r1;
        mx = fmaxf(mx, shx<4>(mx)); mx = fmaxf(mx, shx<8>(mx)); mx = fmaxf(mx, shx<16>(mx)); mx = fmaxf(mx, shx<32>(mx));
        const float ex = __expf(r1 - mx);
        float se = ex;
        se += shx<4>(se); se += shx<8>(se); se += shx<16>(se); se += shx<32>(se);
        if ((lane & 3) == 0) { const int e = ((lane >> 5) & 1) * 8 + ((lane >> 4) & 1) * 4 + ((lane >> 3) & 1) * 2 + ((lane >> 2) & 1);
            stg(p.aff() + (size_t)row * 16 + e, ex * frcp(se)); }
#pragma unroll
        for (int i = 0; i < 2; ++i) ycur[i] = ynxt[i];
        xcur = xnxt;
    }
}

DEV unsigned shxu(unsigned v, int m) {
    const float f = __uint_as_float(v); float r;
    switch (m) { case 1: r = shx<1>(f); break; case 2: r = shx<2>(f); break; case 4: r = shx<4>(f); break; case 8: r = shx<8>(f); break; case 16: r = shx<16>(f); break; default: r = shx<32>(f); break; }
    return __float_as_uint(r);
}
#define TK_CX(a_, b_, desc_) do { const unsigned long long x_ = key[a_], y_ = key[b_]; const bool sw_ = (desc_) ? (x_ < y_) : (x_ > y_); key[a_] = sw_ ? y_ : x_; key[b_] = sw_ ? x_ : y_; } while (0)
DEV void topk_task(const Params& p, const SetDesc& sd, int task, char* shm) {
    const int tid = TID();
    const int e = task & 15, sl = task >> 4;
    unsigned long long* buf = (unsigned long long*)shm;
    const int T = 1 << sd.lgseq, cap = sd.cap;
    const int rbase = sl << sd.lgseq;
    const bool active = tid * 4 < T;
    unsigned long long key[4];
    __syncthreads();
#pragma unroll
    for (int m = 0; m < 4; ++m) { const int i = tid * 4 + m; const float a = active ? ldg(p.aff() + (size_t)(rbase + i) * 16 + e) : 0.f;
        key[m] = ((unsigned long long)__float_as_uint(a) << 32) | (unsigned)(0xFFFFFFFFu - (unsigned)i); }
    for (int k = 2; k <= T; k <<= 1) {
        const bool desc4 = ((tid * 4) & k) == 0;
        for (int j = k >> 1; j >= 4; j >>= 1) {
            const int tj = j >> 2;
            unsigned long long pk[4];
            if (tj < 64) {
#pragma unroll
                for (int m = 0; m < 4; ++m) { const unsigned lo = shxu((unsigned)key[m], tj), hi = shxu((unsigned)(key[m] >> 32), tj); pk[m] = ((unsigned long long)hi << 32) | lo; }
            } else {
                __syncthreads();
                if (active) {
#pragma unroll
                    for (int m = 0; m < 4; ++m) buf[tid * 4 + m] = key[m]; }
                __syncthreads();
#pragma unroll
                for (int m = 0; m < 4; ++m) pk[m] = active ? buf[(tid ^ tj) * 4 + m] : 0ull;
            }
            const bool lower = (tid & tj) == 0; const bool takemax = desc4 == lower;
#pragma unroll
            for (int m = 0; m < 4; ++m) { const unsigned long long x = key[m], y = pk[m]; key[m] = takemax ? (x > y ? x : y) : (x < y ? x : y); }
        }
        if (k >= 4) { TK_CX(0, 2, desc4); TK_CX(1, 3, desc4); TK_CX(0, 1, desc4); TK_CX(2, 3, desc4); }
        else { TK_CX(0, 1, true); TK_CX(2, 3, false); }
    }
    const int sbase = e * sd.rpe + sl * cap;
    if (active) {
#pragma unroll
        for (int m = 0; m < 4; ++m) { const int i = tid * 4 + m; const unsigned long long kv = key[m]; const int tok = (int)(0xFFFFFFFFu - (unsigned)(kv & 0xFFFFFFFFu));
            const int row = rbase + tok;
            if (i < cap) { stg(p.slot_token() + sbase + i, row); stg(p.slot_gate() + sbase + i, __uint_as_float((unsigned)(kv >> 32))); stg(p.token_slots() + (size_t)row * 16 + e, sbase + i); }
            else stg(p.token_slots() + (size_t)row * 16 + e, -1); } }
    if (sl == 0) { const int used = sd.nsamp * cap;
        for (int i = used + tid; i < sd.rpe; i += NTHREADS) { stg(p.slot_token() + e * sd.rpe + i, 0); stg(p.slot_gate() + e * sd.rpe + i, 0.f); } }
}
#undef TK_CX

struct SchedMoe {
    const bf16_t* A; const int* st; const bf16_t* W; int nRT, rpe, nN, wstride;
    DEV bool next(int i, GUnit& u) const { int pmx, pn; if (!tile_order(i, 16 * nRT, nN, pmx, pn)) return false; u.pm = pmx % nRT; u.aux = pmx / nRT; u.pn = pn; return true; }
    DEV int slot0(const GUnit& u) const { return u.aux * rpe + u.pm * 256; }
    DEV const bf16_t* a_base(const GUnit&) const { return A; }
    DEV int grow(const GUnit& u, int i) const { return st ? ldg(st + slot0(u) + i) : slot0(u) + i; }
    DEV const bf16_t* b_base(const GUnit& u) const { return W + (size_t)u.aux * wstride + (size_t)u.pn * 256 * 512; }
};
DEV void phase_moe_gu(const Params& p, const SetDesc& sd, int layer, char* shm) {
    SchedMoe S; S.A = p.H(); S.st = p.slot_token(); S.W = p.WguT() + (size_t)layer * 16 * 2048 * 512; S.nRT = sd.rpe / 256; S.rpe = sd.rpe; S.nN = 8; S.wstride = 2048 * 512;
    unsigned char* hb = (unsigned char*)p.HID();
    gemm_stream<true, 512, 512, 512, true>(shm, S, [=](const GUnit& u, const f32x4 (&acc)[2][2][4][2], int r0, int c0) {
#pragma unroll
        for (int ai = 0; ai < 2; ++ai)
#pragma unroll
            for (int m = 0; m < 4; ++m) { f32x4 h0, h1; const f32x4 a0 = acc[ai][0][m][0] * F8_WINV, a1 = acc[ai][0][m][1] * F8_WINV, b0 = acc[ai][1][m][0] * F8_WINV, b1 = acc[ai][1][m][1] * F8_WINV;
#pragma unroll
                for (int j = 0; j < 4; ++j) { h0[j] = a0[j] * sigmoidf_(a0[j]) * b0[j]; h1[j] = a1[j] * sigmoidf_(a1[j]) * b1[j]; }
                const u32x2 hv = {f8pack4(h0[0], h0[1], h0[2], h0[3]), f8pack4(h1[0], h1[1], h1[2], h1[3])};
                stg((u32x2*)(hb + ((size_t)S.slot0(u) + r0 + ai * 128 + m * 16) * 1024 + u.pn * 128 + c0), hv); } });
}
DEV void phase_moe_down(const Params& p, const SetDesc& sd, int layer, char* shm) {
    SchedMoe S; S.A = p.HID(); S.st = nullptr; S.W = p.WdT() + (size_t)layer * 16 * 1024 * 512; S.nRT = sd.rpe / 256; S.rpe = sd.rpe; S.nN = 4; S.wstride = 1024 * 512;
    bf16_t* yb = p.YE(); const float* gt = p.slot_gate();
    gemm_stream<true, 512, 512, 512, true>(shm, S, [=](const GUnit& u, const f32x4 (&acc)[2][2][4][2], int r0, int c0) {
#pragma unroll
        for (int ai = 0; ai < 2; ++ai) {
            float gv[4];
#pragma unroll
            for (int m = 0; m < 4; ++m) gv[m] = ldg(gt + (size_t)S.slot0(u) + r0 + ai * 128 + m * 16) * F8_WINV;
#pragma unroll
            for (int m = 0; m < 4; ++m) { const size_t sl = (size_t)S.slot0(u) + r0 + ai * 128 + m * 16; const float g = gv[m];
                bf16_t* o = yb + sl * 1024 + u.pn * 256 + c0; store8bf(o, acc[ai][0][m][0] * g, acc[ai][0][m][1] * g); store8bf(o + 128, acc[ai][1][m][0] * g, acc[ai][1][m][1] * g); } } });
}

DEV void compact4(const int (&sl)[16], int (&c)[4], int& n) {
    n = 0; c[0] = -1; c[1] = -1; c[2] = -1; c[3] = -1;
#pragma unroll
    for (int e = 0; e < 16; ++e) if (sl[e] >= 0) { c[0] = (n == 0) ? sl[e] : c[0]; c[1] = (n == 1) ? sl[e] : c[1]; c[2] = (n == 2) ? sl[e] : c[2]; c[3] = (n == 3) ? sl[e] : c[3]; ++n; }
}
template <bool DST_F32> DEV void phase_combine(const Params& p, const SetDesc& sd, int layer, char* shm) {
    const int tid = TID(), lane = tid & 63, wv = tid >> 6;
    const float* g3 = p.norm_gain + ((size_t)layer * 4 + 3) * 1024;
    const bf16_t* xsb = xbf_base(p, sd); void* xdb = DST_F32 ? (void*)xout_f32(p, sd) : (void*)xbf_base(p, sd);
    const int stride = 8; const int rpb_ = (sd.nrows + (int)gridDim.x - 1) / (int)gridDim.x; const int row_end = min(sd.nrows, ((int)blockIdx.x + 1) * rpb_);
    int row = __builtin_amdgcn_readfirstlane((int)blockIdx.x * rpb_ + wv);
    float* par = (float*)shm;
    __syncthreads();
    { const float* mdb = mod_row(p, sd, layer, min((int)blockIdx.x * rpb_, sd.nrows - 1)); stage_params(par, g3, mdb + 5120, nullptr, nullptr, nullptr); }
    __syncthreads();
    int raw[16]; int cc[4], cn[4]; int nc = 0, nn = 0;
    u32x4 mc[4][2], mn[4][2]; XRow<true> xc, xn;
#define CMB_SLOTS(r_) do { _Pragma("unroll") for (int e = 0; e < 16; ++e) raw[e] = ldg(p.token_slots() + (size_t)(r_) * 16 + e); } while (0)
#define CMB_DATA(r_, c_, n_, m_, x_) do { _Pragma("unroll") for (int k = 0; k < 4; ++k) { \
            if (k < (n_)) { const bf16_t* yr = p.YE() + (size_t)(c_)[k] * 1024 + lane * 8; (m_)[k][0] = ldg((const u32x4*)yr); (m_)[k][1] = ldg((const u32x4*)(yr + 512)); } \
            else { (m_)[k][0] = (u32x4){0u, 0u, 0u, 0u}; (m_)[k][1] = (u32x4){0u, 0u, 0u, 0u}; } } \
        (x_).load(xsb, (r_), lane); } while (0)
    if (row < row_end) { CMB_SLOTS(row); compact4(raw, cc, nc); CMB_DATA(row, cc, nc, mc, xc); if (row + stride < row_end) CMB_SLOTS(row + stride); }
    for (; row < row_end; row += stride) {
        const int rn = row + stride;
        if (rn < row_end) { compact4(raw, cn, nn); CMB_DATA(rn, cn, nn, mn, xn); if (rn + stride < row_end) CMB_SLOTS(rn + stride); }
        float y[16];
#pragma unroll
        for (int j = 0; j < 16; ++j) y[j] = 0.f;
        if (nc <= 4) {
#pragma unroll
            for (int k = 0; k < 4; ++k)
                if (k < nc) {
#pragma unroll
                    for (int hlf = 0; hlf < 2; ++hlf) { const u32x4 m = mc[k][hlf];
                        y[hlf * 8 + 0] += lo16(m.x); y[hlf * 8 + 1] += hi16(m.x); y[hlf * 8 + 2] += lo16(m.y); y[hlf * 8 + 3] += hi16(m.y);
                        y[hlf * 8 + 4] += lo16(m.z); y[hlf * 8 + 5] += hi16(m.z); y[hlf * 8 + 6] += lo16(m.w); y[hlf * 8 + 7] += hi16(m.w); } }
        } else {
            for (int e = 0; e < 16; ++e) { const int sl_ = ldg(p.token_slots() + (size_t)row * 16 + e);
                if (sl_ >= 0) { const bf16_t* yr = p.YE() + (size_t)sl_ * 1024 + lane * 8;
#pragma unroll
                    for (int hlf = 0; hlf < 2; ++hlf) { const u32x4 m = ldg((const u32x4*)(yr + hlf * 512));
                        y[hlf * 8 + 0] += lo16(m.x); y[hlf * 8 + 1] += hi16(m.x); y[hlf * 8 + 2] += lo16(m.y); y[hlf * 8 + 3] += hi16(m.y);
                        y[hlf * 8 + 4] += lo16(m.z); y[hlf * 8 + 5] += hi16(m.z); y[hlf * 8 + 6] += lo16(m.w); y[hlf * 8 + 7] += hi16(m.w); } } }
        }
        float ss = 0.f;
#pragma unroll
        for (int j = 0; j < 16; ++j) ss += y[j] * y[j];
        ss = wave_sum(ss);
        const float rstd = rsqrtf(ss * (1.0f / 1024.0f) + RMS_EPS);
#pragma unroll
        for (int hlf = 0; hlf < 2; ++hlf) { f32x4 xv[2];
#pragma unroll
            for (int q = 0; q < 2; ++q) { const int c0 = hlf * 512 + lane * 8 + q * 4; xv[q] = xc.get(hlf * 2 + q);
#pragma unroll
                for (int j = 0; j < 4; ++j) xv[q][j] += par[1024 + c0 + j] * (y[hlf * 8 + q * 4 + j] * rstd * par[c0 + j]); }
            xrow_store8<!DST_F32>(xdb, row, hlf * 512 + lane * 8, xv[0], xv[1]); }
        nc = nn;
#pragma unroll
        for (int k = 0; k < 4; ++k) { cc[k] = cn[k]; mc[k][0] = mn[k][0]; mc[k][1] = mn[k][1]; }
        xc = xn;
    }
#undef CMB_SLOTS
#undef CMB_DATA
}

constexpr int WQ_WORD0 = 4096;
template <class F> DEV void wq_run(const Params& p, int qidx, int ntasks, char* shm, F&& task) {
    unsigned* ctr = p.bar() + WQ_WORD0 + 64 * qidx;
    volatile int* slot = (volatile int*)(shm + 131072 + 64);
    const int tid = TID();
    int cur = blockIdx.x;
    while (cur < ntasks) {
        unsigned pend = 0u;
        if (tid == 0) pend = atomicAdd(ctr, 1u);
        task(cur);
        __syncthreads();
        if (tid == 0) *slot = (int)gridDim.x + (int)pend;
        __syncthreads();
        cur = *slot;
    }
}

template <int PH> DEV void do_phase(const Params& p, int layer, int is_ctx, int grp, char* shm) {
    const SetDesc sd = make_set(is_ctx, grp);
    if constexpr (PH == -1) phase_prologue(p, shm);
    if constexpr (PH == 0) { if (layer == 0) phase_norm1<false>(p, sd, layer, shm); else phase_norm1<true>(p, sd, layer, shm); }
    if constexpr (PH == 1) phase_proj_a(p, sd, layer, shm);
    const int qbase = ((layer * 3 + (is_ctx ? 0 : grp + 1)) * 13 + (PH < 0 ? 0 : PH)) * 2;
    if constexpr (PH == 2) { wq_run(p, qbase, sd.nsamp * 4 * sd.ntb, shm, [&](int t) { mlstm_stepA_task(p, sd, layer, t, shm); }); if (!(is_ctx && layer == 1)) phase_pool(p, sd); }
    if constexpr (PH == 3) {
        for (int t = blockIdx.x; t < sd.nsamp * 32; t += gridDim.x) mlstm_stepB_task(p, sd, t);
        if (!(is_ctx && layer == 1)) {
            const int nq = (is_ctx ? (CTX / 64) : ROWS) / 2;
            wq_run(p, qbase, sd.nsamp * nq * 4, shm, [&](int t) { na_task(p, sd, layer, t / (nq * 4), (t >> 2) % nq, t & 3, shm); });
        }
    }
    if constexpr (PH == 4) { wq_run(p, qbase, sd.nsamp * 4 * sd.ntb, shm, [&](int t) { mlstm_stepC_task(p, sd, layer, t, shm); }); }
    if constexpr (PH == 5) phase_proj_b(p, sd, layer, shm);
    if constexpr (PH == 6) phase_merge(p, sd, layer, shm);
    if constexpr (PH == 7) phase_outproj(p, sd, layer, shm);
    if constexpr (PH == 8) { if (layer == 0) phase_postmix<false>(p, sd, layer, shm); else phase_postmix<true>(p, sd, layer, shm); }
    if constexpr (PH == 9) { for (int t = blockIdx.x; t < sd.nsamp * 16; t += gridDim.x) topk_task(p, sd, t, shm); }
    if constexpr (PH == 10) phase_moe_gu(p, sd, layer, shm);
    if constexpr (PH == 11) phase_moe_down(p, sd, layer, shm);
    if constexpr (PH == 12) { if (layer == 0) phase_combine<false>(p, sd, layer, shm); else phase_combine<true>(p, sd, layer, shm); }
}

#ifndef CPU_EMU
template <int PH> __global__ void __launch_bounds__(NTHREADS, 2) k_phase(Params p, int layer, int is_ctx, int grp) {
    DYN_LDS(shm);
    do_phase<PH>(p, layer, is_ctx, grp, shm);
}
#ifndef DBL_MASK
#define DBL_MASK 0
#endif
#define RUNPH(PH) do { do_phase<PH>(p, layer, is_ctx, grp, shm); xcd_barrier(bar); if ((DBL_MASK >> (PH)) & 1) { do_phase<PH>(p, layer, is_ctx, grp, shm); xcd_barrier(bar); } } while (0)
__global__ void __launch_bounds__(NTHREADS, 2) k_mega(Params p) {
    DYN_LDS(shm);
    uint4* xbw = (uint4*)(shm + 131072);
    if (threadIdx.x == 0) *xbw = make_uint4(0u, 0u, 0u, 0u);
    __syncthreads();
    XcdBarrier bar = xcd_barrier_post(p.bar(), (volatile LAS unsigned*)xbw);
    do_phase<-1>(p, 0, 0, 0, shm);
    xcd_barrier(bar);
    for (int layer = 0; layer < 2; ++layer)
        for (int si = 0; si <= NG; ++si) {
            const int is_ctx = si == 0 ? 1 : 0, grp = si == 0 ? 0 : si - 1;
            RUNPH(0); RUNPH(1); RUNPH(2);
            if (is_ctx && layer == 1) { do_phase<3>(p, layer, is_ctx, grp, shm); continue; }
            RUNPH(3); RUNPH(4); RUNPH(5); RUNPH(6); RUNPH(7); RUNPH(8); RUNPH(9); RUNPH(10); RUNPH(11);
            do_phase<12>(p, layer, is_ctx, grp, shm);
        }
}
#endif
}

static Params make_params(void* const* d_in, void* d_out, void* d_ws) {
    Params p{};
    p.x = (const float*)d_in[0]; p.c = (const float*)d_in[1]; p.ctx = (const float*)d_in[2]; p.c_ctx = (const float*)d_in[3];
    p.norm_gain = (const float*)d_in[4]; p.ada_w = (const float*)d_in[5]; p.ada_b = (const float*)d_in[6]; p.w_in = (const float*)d_in[7];
    p.gate_bias = (const float*)d_in[8]; p.pool_w = (const float*)d_in[9]; p.pool_scale = (const float*)d_in[10]; p.rpb = (const float*)d_in[11];
    p.w_branch = (const float*)d_in[12]; p.w_out = (const float*)d_in[13]; p.router_w = (const float*)d_in[14];
    p.w_gate = (const float*)d_in[15]; p.w_up = (const float*)d_in[16]; p.w_down = (const float*)d_in[17];
    p.out = (float*)d_out; p.ws = (char*)d_ws;
    return p;
}

#ifdef CPU_EMU
int emu_cfg_B = CFG_B, emu_cfg_ROWS = CFG_ROWS, emu_cfg_CTX = CFG_CTX;
const char* g_dumpdir = "data";
static void* g_ws = nullptr;
static void dump_buf(const char* name, int layer, int is_ctx, int grp, const void* ptr, size_t bytes) {
    char nm[512]; snprintf(nm, sizeof nm, "%s/d_L%d_%s%d_%s.bin", g_dumpdir, layer, is_ctx ? "c" : "g", grp, name);
    FILE* f = fopen(nm, "wb"); fwrite(ptr, 1, bytes, f); fclose(f);
}
static void emu_hook(const Params& p, int layer, int is_ctx, int grp, int ph) {
    const size_t Rn = is_ctx ? RC : RL;
    if (ph == 0) dump_buf("H", layer, is_ctx, grp, p.H(), Rn * 1024 * 2);
    if (ph == 1) dump_buf("PROJ", layer, is_ctx, grp, is_ctx ? p.PROJc() : p.PROJa(), Rn * PWA * 2);
    if (ph == 2) dump_buf("Pb", layer, is_ctx, grp, p.Pb(), Rn * 512 * 2);
    if (ph == 3) dump_buf("Nb", layer, is_ctx, grp, p.Nb(), Rn * 512 * 2);
    if (ph == 4) dump_buf("Mb", layer, is_ctx, grp, p.Mb(), Rn * 512 * 2);
    if (ph == 5) dump_buf("BG", layer, is_ctx, grp, p.BG(), Rn * NBG * 2);
    if (ph == 6) dump_buf("MERGED", layer, is_ctx, grp, p.MERGED(), Rn * 1024 * 2);
    if (ph == 7) dump_buf("Y", layer, is_ctx, grp, p.Y(), Rn * 1024 * 2);
    if (ph == 8) { dump_buf("H2", layer, is_ctx, grp, p.H(), Rn * 1024 * 2); dump_buf("aff", layer, is_ctx, grp, p.aff(), Rn * 16 * 4); }
}
void emu_dump(const char* dir) {
    char nm[512]; snprintf(nm, sizeof nm, "%s/d_mod.bin", dir);
    FILE* f = fopen(nm, "wb"); fwrite((char*)g_ws + WSL.mod, 1, (size_t)2 * (NB + 1) * 6144 * 4, f); fclose(f);
    snprintf(nm, sizeof nm, "%s/d_ctxs.bin", dir);
    f = fopen(nm, "wb"); fwrite((char*)g_ws + WSL.ctxs, 1, (size_t)NB * CTX * 1024 * 2, f); fclose(f);
}
template <int PH> static void emu_run_phase(const Params& p, int layer, int is_ctx, int grp, int nblocks) {
    emu_launch_lambda([=]() { do_phase<PH>(p, layer, is_ctx, grp, emu_blk->smem); }, nblocks, NTHREADS, LDS_BYTES);
    if (PH >= 0) emu_hook(p, layer, is_ctx, grp, PH);
    printf("phase %d layer %d ctx %d grp %d done\n", PH, layer, is_ctx, grp); fflush(stdout);
}
#define LAUNCH_PHASE(PH) emu_run_phase<PH>(p, layer, is_ctx, grp, nblocks)
#else
#define LAUNCH_PHASE(PH) hipLaunchKernelGGL((k_phase<PH>), dim3(nblocks), dim3(NTHREADS), LDS_BYTES, stream, p, layer, is_ctx, grp)
#define SETATTR(PH) (void)hipFuncSetAttribute((const void*)k_phase<PH>, hipFuncAttributeMaxDynamicSharedMemorySize, LDS_BYTES)
#endif

extern "C" void kernel_launch(void* const* d_in, const int* in_sizes, int n_in, void* d_out, int out_size, void* d_ws, size_t ws_size, hipStream_t stream) {
    (void)in_sizes; (void)n_in; (void)out_size;
    if (ws_size < WSL.total) return;
    Params p = make_params(d_in, d_out, d_ws);
#ifdef CPU_EMU
    g_ws = d_ws;
    memset(d_ws, 0xFF, WSL.total);
    memset((char*)d_ws + WSL.bar, 0, 65536);
    const int nblocks = 16;
#else
    const int nblocks = 256;
#if MK_ONE_LAUNCH
    static int grid = 0;
    if (!grid) {
        (void)hipFuncSetAttribute((const void*)k_mega, hipFuncAttributeMaxDynamicSharedMemorySize, LDS_BYTES);
        int dev = 0, cus = 0, per_cu = 0;
        (void)hipGetDevice(&dev);
        (void)hipDeviceGetAttribute(&cus, hipDeviceAttributeMultiprocessorCount, dev);
        (void)hipOccupancyMaxActiveBlocksPerMultiprocessor(&per_cu, (const void*)k_mega, NTHREADS, LDS_BYTES);
        if (per_cu > 1) per_cu = 1;
        grid = cus * per_cu;
        if (grid > 256) grid = 256;
    }
    if (grid <= 0) return;
    (void)hipMemsetAsync(p.bar(), 0, 65536, stream);
    hipLaunchKernelGGL(k_mega, dim3(grid), dim3(NTHREADS), LDS_BYTES, stream, p);
    return;
#else
    static bool attr_done = false;
    if (!attr_done) { SETATTR(-1); SETATTR(0); SETATTR(1); SETATTR(2); SETATTR(3); SETATTR(4); SETATTR(5); SETATTR(6); SETATTR(7); SETATTR(8); SETATTR(9); SETATTR(10); SETATTR(11); SETATTR(12); attr_done = true; }
#endif
#endif
    { const int layer = 0, is_ctx = 0, grp = 0; LAUNCH_PHASE(-1); }
    for (int layer = 0; layer < 2; ++layer)
        for (int si = 0; si <= NG; ++si) {
            const int is_ctx = si == 0 ? 1 : 0, grp = si == 0 ? 0 : si - 1;
            LAUNCH_PHASE(0); LAUNCH_PHASE(1); LAUNCH_PHASE(2); LAUNCH_PHASE(3);
            if (is_ctx && layer == 1) continue;
            LAUNCH_PHASE(4); LAUNCH_PHASE(5); LAUNCH_PHASE(6); LAUNCH_PHASE(7); LAUNCH_PHASE(8); LAUNCH_PHASE(9); LAUNCH_PHASE(10); LAUNCH_PHASE(11); LAUNCH_PHASE(12);
        }
}
```

```cpp
#ifdef CPU_EMU
#include "emu.h"
#define DYN_LDS(p) char* p = emu_blk->smem
#define WAIT_V(n)
#define WAIT_L(n)
#define HIDE(v)
#define CBAR()
#else
#include <hip/hip_runtime.h>
#define DYN_LDS(p) extern __shared__ __attribute__((aligned(16))) char p[]
#define WAIT_V(n) asm volatile("s_waitcnt vmcnt(" #n ")" ::: "memory")
#define WAIT_L(n) asm volatile("s_waitcnt lgkmcnt(" #n ")" ::: "memory")
#define HIDE(v) asm volatile("" : "+v"(v))
#define CBAR() asm volatile("" ::: "memory")
#endif
#include <stdint.h>
#include <stddef.h>

#ifndef CFG_B
#define CFG_B 32
#define CFG_ROWS 32
#define CFG_CTX 256
#define CFG_G 16
#endif
#ifndef MK_ONE_LAUNCH
#define MK_ONE_LAUNCH 1
#endif

#define DEV __device__ __forceinline__
typedef short s16x4 __attribute__((ext_vector_type(4)));
#ifdef CPU_EMU
#define TR16(ptr) emu_tr16((const void*)(ptr))
#else
typedef __attribute__((address_space(3))) s16x4 lds_s16x4;
#define TR16(ptr) __builtin_amdgcn_ds_read_tr16_b64_v4i16((lds_s16x4*)(ptr))
#endif
#ifdef CPU_EMU
#define TID() (threadIdx.x)
#else
#define TID() ({ int t_ = threadIdx.x; asm volatile("" : "+v"(t_)); t_; })
#endif

typedef unsigned short bf16_t;
typedef short bf16x8 __attribute__((ext_vector_type(8)));
typedef float f32x4 __attribute__((ext_vector_type(4)));
typedef unsigned u32x2 __attribute__((ext_vector_type(2)));
typedef unsigned u32x4 __attribute__((ext_vector_type(4)));

namespace {
constexpr int D = 1024, NB = CFG_B, ROWS = CFG_ROWS, SEQ = ROWS * 64, CTX = CFG_CTX, G = CFG_G, NG = NB / G;
constexpr int RL = G * SEQ, RC = NB * CTX, RMAX = RL > RC ? RL : RC;
constexpr int PWA = 3840, NBG = 3072, PWT = PWA + NBG, PWSRC = 6672, C_SPLIT = 3600;
constexpr int C_QM = 0, C_KM = 256, C_PU = 512, C_GM = 1024, C_PADA = 1040, C_F8 = 1280, C_QN = 1280, C_KN = 1792, C_VM = 2304, C_OM = 2816, C_VN = 3328;
constexpr int proj_col(int n) { return n < 512 ? n : n < 1536 ? n + 1792 : n < 1552 ? n - 512 : n < 2064 ? n - 1040 : n < 3088 ? n - 784 : n + 240; }
static_assert(proj_col(512) == C_VM && proj_col(1024) == C_OM && proj_col(1536) == C_GM && proj_col(1552) == C_PU && proj_col(2064) == C_QN && proj_col(2576) == C_KN && proj_col(3088) == C_VN && proj_col(3599) == PWA - 1, "projection column map");
constexpr int NTBL = SEQ / 128, NTBC = CTX / 128;
constexpr int ilog2(int x) { return x <= 1 ? 0 : 1 + ilog2(x >> 1); }
constexpr int LGSEQ = ilog2(SEQ), LGCTX = ilog2(CTX);
static_assert((1 << LGSEQ) == SEQ && (1 << LGCTX) == CTX, "sequence lengths must be powers of two");
constexpr int cdiv(int a, int b) { return (a + b - 1) / b; }
constexpr int RPE_L = cdiv(G * (SEQ / 8), 256) * 256, RPE_C = cdiv(NB * (CTX / 8), 256) * 256, RPE_MAX = RPE_L > RPE_C ? RPE_L : RPE_C;
constexpr int NSLOT = 16 * RPE_MAX;
constexpr int NTHREADS = 512;
constexpr int GT_MAXU = 10;
constexpr int LDS_BYTES = 131072 + 256 + GT_MAXU * 1024;
constexpr int NST_L = G * 4 * 2 * NTBL, NST_C = NB * 4 * 2 * NTBC, NST = NST_L > NST_C ? NST_L : NST_C;
constexpr int NCI = NB * 4 * 2;
constexpr float RMS_EPS = 1e-6f;

struct WsLayout { size_t bar, WinT, WbT, WoT, WguT, WdT, mod, rope, ctxs, xb, PROJc, CiC, Cin_, Cim, H, H8, PROJa, Sst, Cin, Mb, Pb, Nb, Sn, Ssc, Cn, Cm, aff, slot_token, slot_gate, token_slots, HID, YE, BG, MERGED, Y, total; };
constexpr size_t al(size_t x) { return (x + 255) / 256 * 256; }
constexpr size_t smax(size_t a, size_t b) { return a > b ? a : b; }
constexpr WsLayout make_layout() {
    WsLayout L{}; size_t o = 0;
    L.bar = o; o += al(65536);
    L.WinT = o; o += al((size_t)2 * PWT * 1024 * 2);
    L.WbT = o; o += al((size_t)2 * 3 * 1024 * 512 * 2);
    L.WoT = o; o += al((size_t)2 * 1024 * 1024 * 2);
    L.WguT = o; o += al((size_t)2 * 16 * 2048 * 1024);
    L.WdT = o; o += al((size_t)2 * 16 * 1024 * 1024);
    L.mod = o; o += al((size_t)2 * (NB + 1) * 6144 * 4);
    L.rope = o; o += al((size_t)(ROWS + 64) * 16 * 2 * 4);
    L.ctxs = o; o += al((size_t)NB * CTX * 1024 * 2);
    L.xb = o; o += al((size_t)NB * SEQ * 1024 * 2);
    L.PROJc = o; o += al((size_t)RC * PWA * 2);
    L.CiC = o; o += al((size_t)NCI * 8192 * 4);
    L.Cin_ = o; o += al((size_t)NCI * 64 * 4);
    L.Cim = o; o += al((size_t)NCI * 4 * 4);
    L.H = o; o += al((size_t)RMAX * 1024 * 2);
    L.H8 = o; o += al((size_t)RMAX * 1024);
    const size_t x0 = o;
    L.PROJa = o; o += al((size_t)RMAX * PWA * 2);
    L.Sst = o; o += al((size_t)NST * 8192 * 4);
    L.Cin = o; o += al((size_t)NST * 8192 * 2);
    const size_t hid = al((size_t)NSLOT * 1024 * 2);
    o = x0 + smax(o - x0, 2 * hid);
    L.BG = x0; L.HID = x0; L.YE = x0 + hid;
    L.Mb = o; o += al((size_t)RMAX * 512 * 2);
    L.Pb = o; o += al((size_t)RMAX * 512 * 2);
    L.Nb = o; o += al((size_t)RMAX * 512 * 2);
    L.MERGED = L.H; L.Y = L.Mb;
    L.Sn = o; o += al((size_t)NST * 64 * 4);
    L.Ssc = o; o += al((size_t)NST * 4 * 4);
    L.Cn = o; o += al((size_t)NST * 64 * 4);
    L.Cm = o; o += al((size_t)NST * 4 * 4);
    L.aff = o; o += al((size_t)RMAX * 16 * 4);
    L.slot_token = o; o += al((size_t)NSLOT * 4);
    L.slot_gate = o; o += al((size_t)NSLOT * 4);
    L.token_slots = o; o += al((size_t)RMAX * 16 * 4);
    L.total = o;
    return L;
}
constexpr WsLayout WSL = make_layout();
static_assert((size_t)RMAX * NBG * 2 <= (size_t)RMAX * PWA * 2, "BG overlay must fit in PROJa");
static_assert(CFG_B != 32 || WSL.total <= ((size_t)1 << 30), "workspace budget");

struct Params {
    const float *x, *c, *ctx, *c_ctx, *norm_gain, *ada_w, *ada_b, *w_in, *gate_bias, *pool_w, *pool_scale, *rpb, *w_branch, *w_out, *router_w, *w_gate, *w_up, *w_down;
    float* out;
    char* ws;
#ifdef CPU_EMU
#define WSF(T, name) __device__ __host__ __forceinline__ T* name() const { return (T*)(ws + WSL.name); }
#else
#if defined(__HIP_DEVICE_COMPILE__)
#define WSF(T, name) __device__ __host__ __forceinline__ T* name() const { char* w_ = ws; asm volatile("" : "+s"(w_)); return (T*)(__attribute__((address_space(1))) T*)(w_ + WSL.name); }
#else
#define WSF(T, name) __device__ __host__ __forceinline__ T* name() const { return (T*)(ws + WSL.name); }
#endif
#endif
    WSF(unsigned, bar) WSF(bf16_t, WinT) WSF(bf16_t, WbT) WSF(bf16_t, WoT) WSF(bf16_t, WguT) WSF(bf16_t, WdT)
    WSF(float, mod) WSF(float, rope) WSF(bf16_t, ctxs) WSF(bf16_t, xb) WSF(bf16_t, PROJc) WSF(float, CiC) WSF(float, Cin_) WSF(float, Cim)
    WSF(bf16_t, H) WSF(unsigned char, H8) WSF(bf16_t, PROJa) WSF(float, Sst) WSF(bf16_t, Cin) WSF(bf16_t, Mb) WSF(bf16_t, Pb) WSF(bf16_t, Nb)
    WSF(float, Sn) WSF(float, Ssc) WSF(float, Cn) WSF(float, Cm) WSF(float, aff) WSF(int, slot_token) WSF(float, slot_gate) WSF(int, token_slots)
    WSF(bf16_t, HID) WSF(bf16_t, YE) WSF(bf16_t, BG) WSF(bf16_t, MERGED) WSF(bf16_t, Y)
#undef WSF
};

struct SetDesc { int is_ctx, nrows, samp0, nsamp, lgseq, ntb, cap, rpe; };
DEV SetDesc make_set(int is_ctx, int grp) {
    SetDesc s;
    s.is_ctx = is_ctx;
    if (is_ctx) { s.nrows = RC; s.samp0 = 0; s.nsamp = NB; s.lgseq = LGCTX; s.ntb = NTBC; s.cap = CTX / 8; s.rpe = RPE_C; }
    else { s.nrows = RL; s.samp0 = grp * G; s.nsamp = G; s.lgseq = LGSEQ; s.ntb = NTBL; s.cap = SEQ / 8; s.rpe = RPE_L; }
    return s;
}

#ifdef CPU_EMU
#define GAS
#else
#define GAS __attribute__((address_space(1)))
#endif
template <class T> DEV T ldg(const T* p) { return *(const GAS T*)p; }
template <class T> DEV void stg(T* p, const T& v) { *(GAS T*)p = v; }
DEV float bf2f(bf16_t v) { return __uint_as_float(((unsigned)v) << 16); }
DEV bf16_t f2bf(float f) { unsigned u = __float_as_uint(f); u += 0x7FFFu + ((u >> 16) & 1u); return (bf16_t)(u >> 16); }
#if defined(__HIP_DEVICE_COMPILE__)
typedef __bf16 bf16n2 __attribute__((ext_vector_type(2)));
typedef float f32n2 __attribute__((ext_vector_type(2)));
DEV unsigned pack2(float lo, float hi) { f32n2 v = {lo, hi}; bf16n2 r = __builtin_convertvector(v, bf16n2); return __builtin_bit_cast(unsigned, r); }
#else
DEV unsigned pack2(float lo, float hi) { return (unsigned)f2bf(lo) | ((unsigned)f2bf(hi) << 16); }
#endif
DEV float lo16(unsigned u) { return __uint_as_float(u << 16); }
DEV float hi16(unsigned u) { return __uint_as_float(u & 0xFFFF0000u); }
#if defined(__HIP_DEVICE_COMPILE__)
DEV float frcp(float x) { return __builtin_amdgcn_rcpf(x); }
#else
DEV float frcp(float x) { return 1.0f / x; }
#endif
#if defined(__HIP_DEVICE_COMPILE__)
DEV float sigmoidf_(float x) { return __builtin_amdgcn_rcpf(1.0f + __expf(-x)); }
#else
DEV float sigmoidf_(float x) { return 1.0f / (1.0f + __expf(-x)); }
#endif
DEV float logsigmoidf_(float x) { return fminf(x, 0.0f) - __logf(1.0f + __expf(-fabsf(x))); }
template <int M> DEV float shx(float v) {
#if defined(__HIP_DEVICE_COMPILE__)
    const unsigned u = __builtin_bit_cast(unsigned, v);
    if constexpr (M == 1) return __builtin_bit_cast(float, __builtin_amdgcn_update_dpp(u, u, 0xB1, 0xF, 0xF, false));
    else if constexpr (M == 2) return __builtin_bit_cast(float, __builtin_amdgcn_update_dpp(u, u, 0x4E, 0xF, 0xF, false));
    else if constexpr (M == 4) { const unsigned t = __builtin_amdgcn_update_dpp(u, u, 0x141, 0xF, 0xF, false);
        return __builtin_bit_cast(float, __builtin_amdgcn_update_dpp(t, t, 0x1B, 0xF, 0xF, false)); }
    else if constexpr (M == 8) return __builtin_bit_cast(float, __builtin_amdgcn_update_dpp(u, u, 0x128, 0xF, 0xF, false));
    else if constexpr (M == 16) { const auto r = __builtin_amdgcn_permlane16_swap(u, u, false, false); return __builtin_bit_cast(float, (threadIdx.x & 16) ? r[0] : r[1]); }
    else { const auto r = __builtin_amdgcn_permlane32_swap(u, u, false, false); return __builtin_bit_cast(float, (threadIdx.x & 32) ? r[0] : r[1]); }
#else
    return __shfl_xor(v, M);
#endif
}
DEV float wave_sum(float v) { v += shx<32>(v); v += shx<16>(v); v += shx<8>(v); v += shx<4>(v); v += shx<2>(v); v += shx<1>(v); return v; }
DEV bf16x8 mk8(u32x2 lo, u32x2 hi) { u32x4 v = {lo.x, lo.y, hi.x, hi.y}; return __builtin_bit_cast(bf16x8, v); }
DEV bf16x8 mk8(u32x4 v) { return __builtin_bit_cast(bf16x8, v); }
DEV bf16x8 mk8(s16x4 lo, s16x4 hi) { return __builtin_shufflevector(lo, hi, 0, 1, 2, 3, 4, 5, 6, 7); }
DEV f32x4 mfma16(bf16x8 a, bf16x8 b, f32x4 c) { return __builtin_amdgcn_mfma_f32_16x16x32_bf16(a, b, c, 0, 0, 0); }
DEV unsigned f8enc1(float x) {
    const unsigned sgn = x < 0.f ? 0x80u : 0u; float a = x < 0.f ? -x : x; if (!(a < 448.f)) a = 448.f;
    if (a < 0.015625f) { const int q = (int)(a * 512.f + 0.5f); const float r = a * 512.f; int qq = q; if ((float)q - r == 0.5f && (q & 1)) qq = q - 1; return sgn | (unsigned)qq; }
    int e = 0; float m = a; while (m >= 2.f) { m *= 0.5f; ++e; } while (m < 1.f) { m *= 2.f; --e; }
    const float r = (m - 1.f) * 8.f; int q = (int)(r + 0.5f); if ((float)q - r == 0.5f && (q & 1)) --q;
    if (q == 8) { q = 0; ++e; }
    return sgn | (unsigned)((e + 7) << 3) | (unsigned)q;
}
#if defined(__HIP_DEVICE_COMPILE__)
DEV unsigned f8pack4(float a, float b, float c, float d) {
    a = __builtin_amdgcn_fmed3f(a, -448.f, 448.f); b = __builtin_amdgcn_fmed3f(b, -448.f, 448.f); c = __builtin_amdgcn_fmed3f(c, -448.f, 448.f); d = __builtin_amdgcn_fmed3f(d, -448.f, 448.f);
    int w = 0; w = __builtin_amdgcn_cvt_pk_fp8_f32(a, b, w, false); w = __builtin_amdgcn_cvt_pk_fp8_f32(c, d, w, true); return (unsigned)w; }
#else
DEV unsigned f8pack4(float a, float b, float c, float d) { return f8enc1(a) | (f8enc1(b) << 8) | (f8enc1(c) << 16) | (f8enc1(d) << 24); }
#endif
DEV float f8dec1(unsigned v) {
    const unsigned e = (v >> 3) & 15u, m = v & 7u; float r = e == 0 ? (float)m * (1.0f / 512.0f) : __uint_as_float(((e + 120u) << 23) | (m << 20));
    return (v & 0x80u) ? -r : r;
}
#if defined(__HIP_DEVICE_COMPILE__)
DEV f32x4 f8x4_f32(unsigned w) { const auto lo = __builtin_amdgcn_cvt_pk_f32_fp8((int)w, false), hi = __builtin_amdgcn_cvt_pk_f32_fp8((int)w, true); return (f32x4){lo[0], lo[1], hi[0], hi[1]}; }
#else
DEV f32x4 f8x4_f32(unsigned w) { return (f32x4){f8dec1(w & 255u), f8dec1((w >> 8) & 255u), f8dec1((w >> 16) & 255u), f8dec1(w >> 24)}; }
#endif
constexpr float YE_SCALE = 32.0f, YE_INV = 1.0f / 32.0f;
#ifdef CPU_EMU
DEV f32x4 mfma_f8(bf16x8 a0, bf16x8 a1, bf16x8 b0, bf16x8 b1, f32x4 c) { return emu_mfma_f8(a0, a1, b0, b1, c); }
#else
typedef int i32x4 __attribute__((ext_vector_type(4)));
typedef int i32x8 __attribute__((ext_vector_type(8)));
DEV f32x4 mfma_f8(bf16x8 a0, bf16x8 a1, bf16x8 b0, bf16x8 b1, f32x4 c) {
    const i32x8 A = __builtin_shufflevector(__builtin_bit_cast(i32x4, a0), __builtin_bit_cast(i32x4, a1), 0, 1, 2, 3, 4, 5, 6, 7);
    const i32x8 B = __builtin_shufflevector(__builtin_bit_cast(i32x4, b0), __builtin_bit_cast(i32x4, b1), 0, 1, 2, 3, 4, 5, 6, 7);
    return __builtin_amdgcn_mfma_scale_f32_16x16x128_f8f6f4(A, B, c, 0, 0, 0, 0, 0, 0);
}
#endif
constexpr float F8_WSCALE = 64.0f, F8_WINV = 1.0f / 64.0f;
DEV void store8bf(bf16_t* o, f32x4 a, f32x4 b) { u32x4 v = {pack2(a[0], a[1]), pack2(a[2], a[3]), pack2(b[0], b[1]), pack2(b[2], b[3])}; stg((u32x4*)o, v); }

#ifndef CPU_EMU
#define XB_TMO      128
#define XB_XCNT(j)  (256  + 64 * (j))
#define XB_XSUB(j)  (1280 + 64 * (j))
#define XB_XGEN(j)  (2304 + 64 * (j))
#define XB_TOP      3328
#define XB_TOPGEN   3392
#define XCD_BAR_WORDS 3456
#define XB_SPIN_CAP (1u << 18)
#define LAS __attribute__((address_space(3)))
__device__ __forceinline__ unsigned xb_ld(unsigned* p)              { return __hip_atomic_load(p, __ATOMIC_RELAXED, __HIP_MEMORY_SCOPE_AGENT); }
__device__ __forceinline__ unsigned xb_add(unsigned* p, unsigned v) { return __hip_atomic_fetch_add(p, v, __ATOMIC_RELAXED, __HIP_MEMORY_SCOPE_AGENT); }
__device__ __forceinline__ unsigned xb_xcc_id() { return (unsigned)__builtin_amdgcn_s_getreg((3 << 11) | 20) & 0xFu; }
#define XB_SPIN(cond, bar) do { unsigned _sp = 0; while (cond) { __builtin_amdgcn_s_sleep(1); \
    if ((++_sp & 255u) == 0u) { if (xb_ld(&(bar)[XB_TMO])) break; if (_sp > XB_SPIN_CAP) { atomicAdd(&(bar)[XB_TMO], 1u); break; } } } } while (0)
struct XcdBarrier { unsigned* bar; unsigned x; volatile LAS unsigned* st; };
__device__ __forceinline__ XcdBarrier xcd_barrier_post(unsigned* bar, volatile LAS unsigned* st) {
    XcdBarrier b; b.bar = bar; b.x = xb_xcc_id(); b.st = st;
    if (threadIdx.x == 0) (void)xb_add(&bar[XB_XCNT(b.x)], 1u);
    return b;
}
__device__ __forceinline__ void xcd_barrier_complete(unsigned* bar, unsigned x, unsigned& nloc, unsigned& nx) {
    const unsigned Gd = gridDim.x * gridDim.y * gridDim.z;
    unsigned sum, cnt, mine, sp = 0u;
    for (;;) {
        sum = 0u; cnt = 0u; mine = 0u;
#pragma unroll
        for (unsigned j = 0; j < 16; ++j) { const unsigned c = xb_ld(&bar[XB_XCNT(j)]); sum += c; cnt += (c > 0u) ? 1u : 0u; mine = (j == x) ? c : mine; }
        if (sum == Gd) break;
        __builtin_amdgcn_s_sleep(1);
        if ((++sp & 255u) == 0u) { if (xb_ld(&bar[XB_TMO])) break; if (sp > XB_SPIN_CAP) { atomicAdd(&bar[XB_TMO], 1u); break; } }
    }
    nloc = mine > 0u ? mine : 1u; nx = cnt > 0u ? cnt : 1u;
}
__device__ __forceinline__ void xcd_barrier(const XcdBarrier& b) {
    asm volatile("s_waitcnt vmcnt(0)" ::: "memory");
    __syncthreads();
    if (threadIdx.x == 0) {
        unsigned* bar = b.bar;
        unsigned bx = b.x; asm volatile("" : "+s"(bx));
        __builtin_amdgcn_s_waitcnt(0);
        unsigned nloc = b.st[0], nx = b.st[1];
        if (nloc == 0u) { xcd_barrier_complete(bar, bx, nloc, nx); b.st[0] = nloc; b.st[1] = nx; }
        const unsigned old = xb_add(&bar[XB_XSUB(bx)], 1u);
        const unsigned gen = old / nloc;
        if (old + 1u == (gen + 1u) * nloc) {
            __builtin_amdgcn_fence(__ATOMIC_RELEASE, "agent");
            asm volatile("s_waitcnt vmcnt(0)" ::: "memory");
            const unsigned og = xb_add(&bar[XB_TOP], 1u);
            const unsigned tg = og / nx;
            if (og + 1u == (tg + 1u) * nx) xb_add(&bar[XB_TOPGEN], 1u);
            else XB_SPIN(xb_ld(&bar[XB_TOPGEN]) == tg, bar);
            __builtin_amdgcn_fence(__ATOMIC_ACQUIRE, "agent");
            xb_add(&bar[XB_XGEN(bx)], 1u);
            asm volatile("s_waitcnt vmcnt(0)" ::: "memory");
        } else {
            XB_SPIN(xb_ld(&bar[XB_XGEN(bx)]) == gen, bar);
            __builtin_amdgcn_fence(__ATOMIC_ACQUIRE, "agent");
            asm volatile("s_waitcnt vmcnt(0)" ::: "memory");
        }
    }
    __syncthreads();
}
#endif

constexpr int BK = 64, HALF = 128, HT_BYTES = HALF * BK * 2;
DEV int lds_byte(int r, int c) { int st = (r >> 4) * 2 + (c >> 5), rr = r & 15, cc = c & 31, ob = rr * 64 + cc * 2; return st * 1024 + (ob ^ (((ob >> 9) & 1) << 5)); }
DEV void stage_rc(int b, int& Rr, int& Cc) { int st = b / 1024, sb = b % 1024, swz = sb ^ (((sb >> 9) & 1) << 5); Rr = (st >> 1) * 16 + swz / 64; Cc = (st & 1) * 32 + (swz % 64) / 2; }
DEV int perm32(int rho) { const int n = rho >> 4, i = rho & 15; return 8 * (i >> 2) + 4 * n + (i & 3); }

DEV bool tile_from_L(int L, int nM, int nN, int& pm, int& pn) {
    const int nwg = nM * nN; if (L >= nwg) return false;
    int wgid = L; { const int q = nwg / 8, r = nwg % 8, xcd = wgid % 8, off = wgid / 8; wgid = (xcd < r ? xcd * (q + 1) : r * (q + 1) + (xcd - r) * q) + off; }
    const int nig = 8 * nN, gid = wgid / nig, fm = gid * 8, gsz = (nM - fm) < 8 ? (nM - fm) : 8;
    pm = fm + ((wgid % nig) % gsz); pn = (wgid % nig) / gsz; return true;
}
DEV bool tile_order(int i, int nM, int nN, int& pm, int& pn) { return tile_from_L(i * (int)gridDim.x + (int)blockIdx.x, nM, nN, pm, pn); }
#ifdef CPU_EMU
#define GLDS16(src, dst) __builtin_amdgcn_global_load_lds((const unsigned*)(src), (unsigned*)((dst) + (TID() & 63) * 16), 16, 0, 0)
#else
#define GLDS16(src, dst) __builtin_amdgcn_global_load_lds((const unsigned*)(src), (unsigned*)(dst), 16, 0, 0)
#endif

#define BAR __builtin_amdgcn_s_barrier()
#define SCHED __builtin_amdgcn_sched_barrier(0)
struct GUnit { int pm, pn, aux; };
template <class T> struct is_void_ { static constexpr bool v = false; };
template <> struct is_void_<void> { static constexpr bool v = true; };
template <class Epi> DEV bool call_epi(const Epi& e, const GUnit& u, f32x4 (&acc)[2][2][4][2], int r0, int c0) {
    if constexpr (is_void_<decltype(e(u, acc, r0, c0))>::v) { e(u, acc, r0, c0); return false; } else return e(u, acc, r0, c0);
}
template <bool GATHER, int LDA_, int LDB_, int K_, bool F8 = false, class Sched, class Epi>
DEV void gemm_stream(char* shm, const Sched& S, const Epi& epi) {
#define SA(b, h) (shm + ((b) * 2 + (h)) * HT_BYTES)
#define SB(b, h) (shm + (4 + (b) * 2 + (h)) * HT_BYTES)
#define STG_B(P, bp) do { GLDS16((bp) + voffB, (P) + ldsb0); GLDS16((bp) + voffB + 64 * LDB_, (P) + ldsb0 + 8192); } while (0)
#define STG_A(P, ap, h, gv) do { if (GATHER) { GLDS16((ap) + gv[h][0], (P) + ldsb0); GLDS16((ap) + gv[h][1], (P) + ldsb0 + 8192); } \
    else { GLDS16((ap) + voffA + (h) * 128 * LDA_, (P) + ldsb0); GLDS16((ap) + voffA + ((h) * 128 + 64) * LDA_, (P) + ldsb0 + 8192); } } while (0)
#define LDA(dst, b, h) _Pragma("unroll") for (int m = 0; m < 4; ++m) _Pragma("unroll") for (int k = 0; k < 2; ++k) \
    dst[m][k] = *reinterpret_cast<const bf16x8*>(SA(b, h) + aoff + m * 2048 + k * 1024)
#define LDB(dst, b, h) _Pragma("unroll") for (int n = 0; n < 2; ++n) _Pragma("unroll") for (int k = 0; k < 2; ++k) \
    dst[n][k] = *reinterpret_cast<const bf16x8*>(SB(b, h) + boff + n * 2048 + k * 1024)
#define MMA(ai, bj, At_, Bx_) do { __builtin_amdgcn_s_setprio(1); \
    if constexpr (F8) { _Pragma("unroll") for (int m = 0; m < 4; ++m) _Pragma("unroll") for (int n = 0; n < 2; ++n) \
      acc[ai][bj][m][n] = mfma_f8(Bx_[n][0], Bx_[n][1], At_[m][0], At_[m][1], acc[ai][bj][m][n]); } \
    else { _Pragma("unroll") for (int m = 0; m < 4; ++m) _Pragma("unroll") for (int n = 0; n < 2; ++n) _Pragma("unroll") for (int k = 0; k < 2; ++k) \
      acc[ai][bj][m][n] = mfma16(Bx_[n][k], At_[m][k], acc[ai][bj][m][n]); } \
    __builtin_amdgcn_s_setprio(0); } while (0)
    constexpr int nt = K_ / BK;
    const int tid = TID();
    const int wid = __builtin_amdgcn_readfirstlane(tid >> 6), lane = tid & 63, wr = wid >> 2, wc = wid & 3, fr = lane & 15, fq = lane >> 4;
    const int ldsb0 = wid * 1024;
    int Rr0, Cc0; stage_rc(tid * 16, Rr0, Cc0);
    const int voffA = Rr0 * LDA_ + Cc0;
    const int voffB = ((Rr0 & ~31) + perm32(Rr0 & 31)) * LDB_ + Cc0;
    const int aoff = lds_byte(wr * 64 + fr, fq * 8), boff = lds_byte(wc * 32 + fr, fq * 8);
    GUnit cur, nxt; int ui = 0;
    if (!S.next(0, cur)) return;
    int gc[2][2] = {{0, 0}, {0, 0}};
    int* gtab = (int*)(shm + 131072 + 256);
    if (GATHER) {
        __syncthreads();
        { GUnit u; for (int i = 0; i < GT_MAXU && S.next(i, u); ++i) { if (tid < 256) gtab[i * 256 + tid] = S.grow(u, tid) * LDA_; } }
        __syncthreads();
#pragma unroll
        for (int h = 0; h < 2; ++h)
#pragma unroll
            for (int i = 0; i < 2; ++i) gc[h][i] = gtab[h * 128 + i * 64 + Rr0] + Cc0;
    }
    f32x4 acc[2][2][4][2];
#pragma unroll
    for (int a = 0; a < 2; ++a)
#pragma unroll
        for (int b = 0; b < 2; ++b)
#pragma unroll
            for (int m = 0; m < 4; ++m)
#pragma unroll
                for (int n = 0; n < 2; ++n) acc[a][b][m][n] = (f32x4){0.f, 0.f, 0.f, 0.f};
    bf16x8 At[4][2], B0[2][2], B1[2][2];
    const bf16_t* cA = S.a_base(cur); const bf16_t* cB = S.b_base(cur);
    STG_B(SB(0, 0), cB); STG_A(SA(0, 0), cA, 0, gc); STG_B(SB(0, 1), cB + 128 * LDB_); STG_A(SA(0, 1), cA, 1, gc);
    if (wr == 1) BAR;
    WAIT_V(4); BAR;
    STG_B(SB(1, 0), cB + BK); STG_A(SA(1, 0), cA + BK, 0, gc); STG_B(SB(1, 1), cB + 128 * LDB_ + BK);
    WAIT_V(6); BAR;
    for (;;) {
        const bool has_next = S.next(ui + 1, nxt);
        const bf16_t* nA = has_next ? S.a_base(nxt) : cA; const bf16_t* nB = has_next ? S.b_base(nxt) : cB;
#pragma unroll 1
        for (int t = 0; t < nt; t += 2) {
            const bool last = (t == nt - 2);
            const bf16_t* a1 = cA + (t + 1) * BK;
            const bf16_t* a2 = last ? nA : cA + (t + 2) * BK; const bf16_t* b2 = last ? nB : cB + (t + 2) * BK;
            const bf16_t* a3 = a2 + BK; const bf16_t* b3 = b2 + BK;
            LDB(B0, 0, 0); SCHED; LDA(At, 0, 0); STG_A(SA(1, 1), a1, 1, gc);
            if (GATHER && last && has_next) {
#pragma unroll
                for (int h = 0; h < 2; ++h)
#pragma unroll
                    for (int i = 0; i < 2; ++i) gc[h][i] = gtab[(ui + 1) * 256 + h * 128 + i * 64 + Rr0] + Cc0; }
            WAIT_L(8); BAR; WAIT_L(0); MMA(0, 0, At, B0); BAR; SCHED;
            LDB(B1, 0, 1); STG_B(SB(0, 0), b2);
            BAR; WAIT_L(0); MMA(0, 1, At, B1); BAR;
            LDA(At, 0, 1); STG_A(SA(0, 0), a2, 0, gc);
            BAR; WAIT_L(0); MMA(1, 0, At, B0); BAR; SCHED;
            STG_B(SB(0, 1), b2 + 128 * LDB_);
            WAIT_V(6); BAR; MMA(1, 1, At, B1); BAR;
            LDB(B0, 1, 0); SCHED; LDA(At, 1, 0); STG_A(SA(0, 1), a2, 1, gc);
            WAIT_L(8); BAR; WAIT_L(0); MMA(0, 0, At, B0); BAR; SCHED;
            LDB(B1, 1, 1); STG_B(SB(1, 0), b3);
            BAR; WAIT_L(0); MMA(0, 1, At, B1); BAR;
            LDA(At, 1, 1); STG_A(SA(1, 0), a3, 0, gc);
            BAR; WAIT_L(0); MMA(1, 0, At, B0); BAR; SCHED;
            STG_B(SB(1, 1), b3 + 128 * LDB_);
            WAIT_V(6); BAR; MMA(1, 1, At, B1); BAR;
        }
        bool keep = false;
        {
            const int tz = TID(); const int wz = tz >> 6, lz = tz & 63, wrz = wz >> 2, wcz = wz & 3, frz = lz & 15, fqz = lz >> 4;
            keep = call_epi(epi, cur, acc, wrz * 64 + frz, wcz * 32 + 8 * fqz);
        }
        if (!has_next) break;
        if (!keep) {
#pragma unroll
            for (int a = 0; a < 2; ++a)
#pragma unroll
                for (int b = 0; b < 2; ++b)
#pragma unroll
                    for (int m = 0; m < 4; ++m)
#pragma unroll
                        for (int n = 0; n < 2; ++n) acc[a][b][m][n] = (f32x4){0.f, 0.f, 0.f, 0.f};
        }
        cur = nxt; cA = nA; cB = nB; ++ui;
    }
    WAIT_V(0);
    if (wr == 0) BAR;
    BAR;
#undef SA
#undef SB
#undef STG_A
#undef STG_B
#undef LDA
#undef LDB
#undef MMA
}

constexpr int J_IN = 16 * 27, J_WB = 2 * 8 * 4, J_WO = 16 * 4, J_GU = 16 * 2 * 64, J_DN = 16 * 64, J_FOLD = 8 * 16, J_PAD = 1;
constexpr int N_MODJOBS = 2 * 96;

constexpr int J_BIG = J_IN + J_WB + J_WO + J_GU + J_DN;
struct WJob { const float* src; bf16_t* dst; int ldsrc, lddst, nvalid, k0, n0, mode, gu_which, f8; };
DEV WJob wjob_decode(const Params& p, int l, int j) {
    WJob w; w.ldsrc = 1024; w.lddst = 1024; w.nvalid = 256; w.mode = 0; w.gu_which = 0; w.f8 = 0;
    if (j < J_IN) { const int kt = j / 27, nb = j % 27; w.k0 = kt * 64; w.n0 = nb * 256; w.src = p.w_in + (size_t)l * 1024 * PWSRC; w.ldsrc = PWSRC; w.nvalid = PWSRC - w.n0; w.dst = p.WinT() + (size_t)l * PWT * 1024; w.mode = 3; }
    else if ((j -= J_IN) < J_WB) { const int bi = (j / 32) * 2, jj = j % 32, kt = jj / 4, nb = jj % 4; w.k0 = kt * 64; w.n0 = nb * 256;
        w.src = p.w_branch + ((size_t)l * 3 + bi) * 512 * 1024; w.dst = p.WbT() + ((size_t)l * 3 + bi) * 1024 * 512; w.lddst = 512; }
    else if ((j -= J_WB) < J_WO) { const int kt = j / 4, nb = j % 4; w.k0 = kt * 64; w.n0 = nb * 256; w.src = p.w_out + (size_t)l * 1024 * 1024; w.dst = p.WoT() + (size_t)l * 1024 * 1024; }
    else if ((j -= J_WO) < J_GU) { const int e = j / 128, jj = j % 128; w.gu_which = jj / 64; const int j3 = jj % 64, kt = j3 / 4, nb = j3 % 4; w.k0 = kt * 64; w.n0 = nb * 256;
        w.src = (w.gu_which ? p.w_up : p.w_gate) + ((size_t)l * 16 + e) * 1024 * 1024; w.dst = p.WguT() + ((size_t)l * 16 + e) * 2048 * 512; w.mode = 1; w.f8 = 1; }
    else { j -= J_GU; const int e = j / 64, jj = j % 64, kt = jj / 4, nb = jj % 4; w.k0 = kt * 64; w.n0 = nb * 256;
        w.src = p.w_down + ((size_t)l * 16 + e) * 1024 * 1024; w.dst = p.WdT() + ((size_t)l * 16 + e) * 1024 * 512; w.f8 = 1; }
    return w;
}
constexpr int WT_LD = 260;
DEV void wjob_load(const WJob& w, int tid, f32x4 (&vv)[8]) {
#pragma unroll
    for (int i = 0; i < 8; ++i) { const int idx = i * 512 + tid, r = idx >> 6, c = (idx & 63) * 4; int col = w.n0 + c; col = col > w.ldsrc - 4 ? w.ldsrc - 4 : col;
        vv[i] = ldg((const f32x4*)(w.src + (size_t)(w.k0 + r) * w.ldsrc + col)); }
}
DEV void wjob_finish(const WJob& w, int tid, const f32x4 (&vv)[8], float* tile) {
    __syncthreads();
#pragma unroll
    for (int i = 0; i < 8; ++i) { const int idx = i * 512 + tid, r = idx >> 6, c = (idx & 63) * 4; *(f32x4*)(tile + r * WT_LD + c) = vv[i]; }
    __syncthreads();
#pragma unroll
    for (int q = 0; q < 4; ++q) {
        const int item = q * 512 + tid, nrow = item >> 3, kc = (item & 7) * 8;
        float v[8];
#pragma unroll
        for (int jj = 0; jj < 8; ++jj) v[jj] = tile[(kc + jj) * WT_LD + nrow];
        const int n = w.n0 + nrow;
        int drow = n; bool f8 = w.f8 != 0; size_t f8base = 0;
        if (w.mode == 1) drow = (n >> 7) * 256 + w.gu_which * 128 + (n & 127);
        if (w.mode == 3) {
            if (n >= C_SPLIT) { f8 = true; f8base = (size_t)PWA * 2048; drow = n - C_SPLIT; }
            else { drow = proj_col(n); if (drow >= C_F8) { f8 = true; f8base = (size_t)C_F8 * 2048; drow -= C_F8; } } }
        if (f8) { const u32x2 o = {f8pack4(v[0] * F8_WSCALE, v[1] * F8_WSCALE, v[2] * F8_WSCALE, v[3] * F8_WSCALE), f8pack4(v[4] * F8_WSCALE, v[5] * F8_WSCALE, v[6] * F8_WSCALE, v[7] * F8_WSCALE)};
            if (nrow < w.nvalid) stg((u32x2*)((unsigned char*)w.dst + f8base + (size_t)drow * 1024 + w.k0 + kc), o); }
        else if (nrow < w.nvalid) { u32x4 o = {pack2(v[0], v[1]), pack2(v[2], v[3]), pack2(v[4], v[5]), pack2(v[6], v[7])};
            stg((u32x4*)(w.dst + (size_t)drow * w.lddst + w.k0 + kc), o); }
    }
}
DEV void pro_small_job(const Params& p, int l, int j, char* shm) {
    float* tile = (float*)shm;
    const int tid = TID();
    if (j < J_FOLD) {
        const int kt = j / 16, ntl = j % 16, k0 = kt * 64, n0 = ntl * 64; const int fg = k0 / 128;
        const float* wb1 = p.w_branch + ((size_t)l * 3 + 1) * 512 * 1024;
        const float* pw = p.pool_w + ((size_t)l * 4 + fg) * 128 * 128; const float* ps = p.pool_scale + (size_t)l * 512 + fg * 128;
        const int c = tid & 63, rq = tid >> 6;
        float accv[8];
#pragma unroll
        for (int i = 0; i < 8; ++i) accv[i] = 0.f;
        for (int d = 0; d < 128; ++d) { const float wv = ldg(wb1 + (size_t)(fg * 128 + d) * 1024 + n0 + c) * ldg(ps + d);
#pragma unroll
            for (int i = 0; i < 8; ++i) accv[i] += ldg(pw + (size_t)(k0 - fg * 128 + rq * 8 + i) * 128 + d) * wv; }
        __syncthreads();
#pragma unroll
        for (int i = 0; i < 8; ++i) tile[(rq * 8 + i) * WT_LD + c] = accv[i];
        __syncthreads();
        const int nrow = tid >> 3, kc = (tid & 7) * 8; float v[8];
#pragma unroll
        for (int jj = 0; jj < 8; ++jj) v[jj] = tile[(kc + jj) * WT_LD + nrow];
        u32x4 o = {pack2(v[0], v[1]), pack2(v[2], v[3]), pack2(v[4], v[5]), pack2(v[6], v[7])};
        stg((u32x4*)(p.WbT() + ((size_t)l * 3 + 1) * 1024 * 512 + (size_t)(n0 + nrow) * 512 + k0 + kc), o);
    } else {
        bf16_t* d0 = p.WinT() + (size_t)l * PWT * 1024 + (size_t)C_PADA * 1024;
        for (int i = tid; i < (C_F8 - C_PADA) * 1024 / 8; i += NTHREADS) stg((u32x4*)(d0 + (size_t)i * 8), (u32x4){0u, 0u, 0u, 0u});
    }
}

DEV void pro_mod_job(const Params& p, int job, char* shm) {
    float* sv = (float*)shm;
    const int tid = TID(), l = job / 96, col0 = (job % 96) * 64;
    const int c = tid & 63, kp = tid >> 6;
    float acc[NB + 1];
#pragma unroll
    for (int v = 0; v <= NB; ++v) acc[v] = 0.f;
    for (int half = 0; half < 2; ++half) {
        __syncthreads();
        for (int idx = tid; idx < (NB + 1) * 512; idx += 512) { const int v = idx >> 9, k = idx & 511;
            const float s = (v < NB) ? ldg(p.c + (size_t)v * 1024 + half * 512 + k) : ldg(p.c_ctx + half * 512 + k);
            sv[idx] = s * sigmoidf_(s); }
        __syncthreads();
        for (int kk = 0; kk < 64; ++kk) { const int k = kp * 64 + kk;
            const float w = ldg(p.ada_w + ((size_t)l * 1024 + half * 512 + k) * 6144 + col0 + c);
#pragma unroll
            for (int v = 0; v <= NB; ++v) acc[v] += sv[v * 512 + k] * w; }
    }
    __syncthreads();
    float* red = (float*)shm;
#pragma unroll
    for (int v = 0; v <= NB; ++v) red[(kp * (NB + 1) + v) * 64 + c] = acc[v];
    __syncthreads();
    for (int idx = tid; idx < (NB + 1) * 64; idx += 512) { const int v = idx >> 6, cc = idx & 63; float s = 0.f;
#pragma unroll
        for (int q = 0; q < 8; ++q) s += red[(q * (NB + 1) + v) * 64 + cc];
        stg(p.mod() + ((size_t)l * (NB + 1) + v) * 6144 + col0 + cc, s + ldg(p.ada_b + (size_t)l * 6144 + col0 + cc)); }
}

DEV void phase_prologue(const Params& p, char* shm) {
    const int tid = TID();
    const int nsmall = N_MODJOBS + 1 + 2 * (J_FOLD + J_PAD);
    for (int job = blockIdx.x; job < nsmall; job += gridDim.x) {
        if (job < N_MODJOBS) pro_mod_job(p, job, shm);
        else if (job == N_MODJOBS) {
            for (int idx = tid; idx < (ROWS + 64) * 16; idx += NTHREADS) { const int pos = idx >> 4, i = idx & 15;
                const float pv = (float)(pos < ROWS ? pos : pos - ROWS);
                const float inv = powf(10000.0f, -(float)(2 * i) / 32.0f);
                const float a = pv * inv; stg(p.rope() + idx * 2, cosf(a)); stg(p.rope() + idx * 2 + 1, sinf(a)); }
        } else { const int sj = job - N_MODJOBS - 1; pro_small_job(p, sj / (J_FOLD + J_PAD), sj % (J_FOLD + J_PAD), shm); }
    }
    float* tile = (float*)shm;
    const int nbig = 2 * J_BIG;
    int job = blockIdx.x;
    if (job >= nbig) return;
    WJob wc = wjob_decode(p, job / J_BIG, job % J_BIG), wn = wc;
    f32x4 vc[8], vn[8];
    wjob_load(wc, tid, vc);
    for (; job < nbig; job += gridDim.x) {
        const int jn = job + gridDim.x;
        if (jn < nbig) { wn = wjob_decode(p, jn / J_BIG, jn % J_BIG); wjob_load(wn, tid, vn); }
        wjob_finish(wc, tid, vc, tile);
        wc = wn;
#pragma unroll
        for (int i = 0; i < 8; ++i) vc[i] = vn[i];
    }
}

DEV const float* xin_f32(const Params& p, const SetDesc& sd) { return (sd.is_ctx ? p.ctx : p.x) + (((size_t)sd.samp0) << sd.lgseq) * 1024; }
DEV bf16_t* xbf_base(const Params& p, const SetDesc& sd) { return (sd.is_ctx ? p.ctxs() : p.xb()) + (((size_t)sd.samp0) << sd.lgseq) * 1024; }
DEV float* xout_f32(const Params& p, const SetDesc& sd) { return p.out + (((size_t)sd.samp0) << sd.lgseq) * 1024; }
template <bool BF> struct XRow;
template <> struct XRow<false> { f32x4 v[4];
    DEV void load(const void* b, size_t row, int lane) { const float* q = (const float*)b + row * 1024 + lane * 8;
#pragma unroll
        for (int i = 0; i < 4; ++i) v[i] = ldg((const f32x4*)(q + (i >> 1) * 512 + (i & 1) * 4)); }
    DEV f32x4 get(int i) const { return v[i]; } };
template <> struct XRow<true> { u32x4 v[2];
    DEV void load(const void* b, size_t row, int lane) { const bf16_t* q = (const bf16_t*)b + row * 1024 + lane * 8;
#pragma unroll
        for (int h = 0; h < 2; ++h) v[h] = ldg((const u32x4*)(q + h * 512)); }
    DEV f32x4 get(int i) const { const u32x4 m = v[i >> 1]; return (i & 1) ? (f32x4){lo16(m.z), hi16(m.z), lo16(m.w), hi16(m.w)} : (f32x4){lo16(m.x), hi16(m.x), lo16(m.y), hi16(m.y)}; } };
template <bool BF> DEV void xrow_store8(void* b, size_t row, int c0, f32x4 a, f32x4 c) {
    if constexpr (BF) store8bf((bf16_t*)b + row * 1024 + c0, a, c);
    else { float* q = (float*)b + row * 1024 + c0; stg((f32x4*)q, a); stg((f32x4*)(q + 4), c); }
}
DEV const float* mod_row(const Params& p, const SetDesc& sd, int layer, int row) {
    return p.mod() + ((size_t)layer * (NB + 1) + (sd.is_ctx ? NB : sd.samp0 + (row >> sd.lgseq))) * 6144;
}
DEV bf16_t* proj_buf(const Params& p, const SetDesc& sd) { return sd.is_ctx ? p.PROJc() : p.PROJa(); }

DEV void stage_params(float* par, const float* v0, const float* v1, const float* v2, const float* v3, const float* v4) {
    const int tid = TID();
    const float* src[5] = {v0, v1, v2, v3, v4};
#pragma unroll
    for (int k = 0; k < 5; ++k) if (src[k]) { for (int i = tid; i < 1024; i += NTHREADS) par[k * 1024 + i] = ldg(src[k] + i); }
}
template <bool SRC_BF> DEV void phase_norm1(const Params& p, const SetDesc& sd, int layer, char* shm) {
    const int tid = TID(), lane = tid & 63, wv = tid >> 6;
    const float* g0 = p.norm_gain + ((size_t)layer * 4 + 0) * 1024;
    const void* xb = SRC_BF ? (const void*)xbf_base(p, sd) : (const void*)xin_f32(p, sd);
    const int stride = 8; const int rpb_ = (sd.nrows + (int)gridDim.x - 1) / (int)gridDim.x; const int row_end = min(sd.nrows, ((int)blockIdx.x + 1) * rpb_);
    int row = (int)blockIdx.x * rpb_ + wv;
    float* par = (float*)shm;
    __syncthreads();
    { const float* mdb = mod_row(p, sd, layer, min((int)blockIdx.x * rpb_, sd.nrows - 1)); stage_params(par, g0, mdb, mdb + 1024, nullptr, nullptr); }
    __syncthreads();
    XRow<SRC_BF> curr, nxtr;
    if (row < row_end) curr.load(xb, row, lane);
    for (; row < row_end; row += stride) {
        const int rn = row + stride;
        if (rn < row_end) nxtr.load(xb, rn, lane);
        f32x4 cur[4];
#pragma unroll
        for (int i = 0; i < 4; ++i) cur[i] = curr.get(i);
        float ss = 0.f;
#pragma unroll
        for (int i = 0; i < 4; ++i)
#pragma unroll
            for (int j = 0; j < 4; ++j) ss += cur[i][j] * cur[i][j];
        ss = wave_sum(ss);
        const float rstd = rsqrtf(ss * (1.0f / 1024.0f) + RMS_EPS);
#pragma unroll
        for (int hlf = 0; hlf < 2; ++hlf) { const int c0 = hlf * 512 + lane * 8; float o[8];
#pragma unroll
            for (int j = 0; j < 8; ++j) o[j] = cur[hlf * 2 + (j >> 2)][j & 3] * rstd * par[c0 + j] * (1.0f + par[2048 + c0 + j]) + par[1024 + c0 + j];
            u32x4 ov = {pack2(o[0], o[1]), pack2(o[2], o[3]), pack2(o[4], o[5]), pack2(o[6], o[7])};
            stg((u32x4*)(p.H() + (size_t)row * 1024 + c0), ov);
            const u32x2 o8 = {f8pack4(o[0], o[1], o[2], o[3]), f8pack4(o[4], o[5], o[6], o[7])};
            stg((u32x2*)(p.H8() + (size_t)row * 1024 + c0), o8); }
        curr = nxtr;
    }
}

struct SchedPlain {
    const bf16_t* A; const bf16_t* Bt; int nM, nN, lda256, ldb256;
    DEV bool next(int i, GUnit& u) const { u.aux = 0; return tile_order(i, nM, nN, u.pm, u.pn); }
    DEV const bf16_t* a_base(const GUnit& u) const { return A + (size_t)u.pm * lda256; }
    DEV const bf16_t* b_base(const GUnit& u) const { return Bt + (size_t)u.pn * ldb256; }
    DEV int grow(const GUnit&, int) const { return 0; }
};
struct SchedPlainT : SchedPlain {
    int split_base = -1;
    DEV bool next(int i, GUnit& u) const { u.aux = 0; const int G_ = (int)gridDim.x, b = (int)blockIdx.x; int L = i * G_ + b;
        if (split_base >= 0 && i >= split_base) { if (b < G_ / 2 || i >= split_base + 2) return false; L = split_base * G_ + (i - split_base) * (G_ / 2) + (b - G_ / 2); }
        return tile_from_L(L, nM, nN, u.pm, u.pn); }
    DEV const bf16_t* a_base(const GUnit&) const { return A; }
    DEV int grow(const GUnit& u, int i) const { return u.pm * 256 + i; }
};
DEV void phase_proj_a(const Params& p, const SetDesc& sd, int layer, char* shm) {
    bf16_t* pb = proj_buf(p, sd);
    {
        SchedPlain S; S.A = p.H(); S.Bt = p.WinT() + (size_t)layer * PWT * 1024; S.nM = sd.nrows / 256; S.nN = C_F8 / 256; S.lda256 = 256 * 1024; S.ldb256 = 256 * 1024;
        gemm_stream<false, 1024, 1024, 1024>(shm, S, [=](const GUnit& u, const f32x4 (&acc)[2][2][4][2], int r0, int c0) {
#pragma unroll
            for (int ai = 0; ai < 2; ++ai)
#pragma unroll
                for (int m = 0; m < 4; ++m) { bf16_t* o = pb + ((size_t)u.pm * 256 + r0 + ai * 128 + m * 16) * PWA + u.pn * 256 + c0;
                    store8bf(o, acc[ai][0][m][0], acc[ai][0][m][1]); store8bf(o + 128, acc[ai][1][m][0], acc[ai][1][m][1]); } });
    }
    {
        SchedPlainT S; S.A = (const bf16_t*)p.H8(); S.Bt = p.WinT() + (size_t)layer * PWT * 1024 + (size_t)C_F8 * 1024; S.nM = sd.nrows / 256; S.nN = (PWA - C_F8) / 256; S.lda256 = 256 * 512; S.ldb256 = 256 * 512;
        { const int G_ = (int)gridDim.x, T1 = S.nM * (C_F8 / 256), T2 = S.nM * S.nN; if ((G_ & 1) == 0 && (T1 % G_) * 2 == G_ && T2 % G_ == 0 && T2 / G_ >= 1) S.split_base = T2 / G_ - 1; }
        gemm_stream<true, 512, 512, 512, true>(shm, S, [=](const GUnit& u, const f32x4 (&acc)[2][2][4][2], int r0, int c0) {
#pragma unroll
            for (int ai = 0; ai < 2; ++ai)
#pragma unroll
                for (int m = 0; m < 4; ++m) { bf16_t* o = pb + ((size_t)u.pm * 256 + r0 + ai * 128 + m * 16) * PWA + C_F8 + u.pn * 256 + c0;
                    store8bf(o, acc[ai][0][m][0] * F8_WINV, acc[ai][0][m][1] * F8_WINV); store8bf(o + 128, acc[ai][1][m][0] * F8_WINV, acc[ai][1][m][1] * F8_WINV); } });
    }
}
DEV unsigned gate4u8(f32x4 v) {
    unsigned w = 0;
#pragma unroll
    for (int j = 0; j < 4; ++j) w |= (unsigned)fmaxf(sigmoidf_(v[j] * F8_WINV) * 255.0f + 0.5f, 1.0f) << (8 * j);
    return w;
}
DEV float u8f(unsigned w, int j) { return (float)((w >> (8 * j)) & 0xFFu); }
DEV f32x4 sig4(f32x4 v) { f32x4 r; r[0] = sigmoidf_(v[0]); r[1] = sigmoidf_(v[1]); r[2] = sigmoidf_(v[2]); r[3] = sigmoidf_(v[3]); return r; }
DEV void phase_proj_b(const Params& p, const SetDesc& sd, int layer, char* shm) {
    SchedPlainT S; S.A = (const bf16_t*)p.H8(); S.Bt = p.WinT() + (size_t)layer * PWT * 1024 + (size_t)PWA * 1024; S.nM = sd.nrows / 256; S.nN = NBG / 256; S.lda256 = 256 * 512; S.ldb256 = 256 * 512;
    unsigned char* bg = (unsigned char*)p.BG();
    gemm_stream<true, 512, 512, 512, true>(shm, S, [=](const GUnit& u, const f32x4 (&acc)[2][2][4][2], int r0, int c0) {
#pragma unroll
        for (int ai = 0; ai < 2; ++ai)
#pragma unroll
            for (int m = 0; m < 4; ++m) { unsigned char* o = bg + ((size_t)u.pm * 256 + r0 + ai * 128 + m * 16) * NBG + u.pn * 256 + c0;
#pragma unroll
                for (int hf = 0; hf < 2; ++hf) { const u32x2 gv = {gate4u8(acc[ai][hf][m][0]), gate4u8(acc[ai][hf][m][1])}; stg((u32x2*)(o + hf * 128), gv); } } });
}

DEV void gate_scan(const bf16_t* prow, int h, const float* gbias, float* ga, float* gb, float* gpm, float* gtot, float* tmp) {
    const int tid = TID(), lane = tid & 63, w = tid >> 6;
    float b = 0.f, a = 0.f, pm = 0.f; int d = 0, tok = 0;
    if (tid < 256) {
        d = tid >> 7; const int i = tid & 127; tok = d ? 127 - i : i;
        const float gi = bf2f(ldg(prow + (size_t)tok * PWA + C_GM + (2 * d) * 4 + h)) + ldg(gbias + (2 * d) * 4 + h);
        const float gf = bf2f(ldg(prow + (size_t)tok * PWA + C_GM + (2 * d + 1) * 4 + h)) + ldg(gbias + (2 * d + 1) * 4 + h);
        b = logsigmoidf_(gf);
#pragma unroll
        for (int o = 1; o < 64; o <<= 1) { const float t = __shfl_up(b, o); if (lane >= o) b += t; }
        if (lane == 63) tmp[w] = b;
        a = gi;
    }
    __syncthreads();
    if (tid < 256) {
        if (w & 1) b += tmp[w - 1];
        a -= b; pm = a;
#pragma unroll
        for (int o = 1; o < 64; o <<= 1) { const float t = __shfl_up(pm, o); if (lane >= o) pm = fmaxf(pm, t); }
        if (lane == 63) tmp[8 + w] = pm;
    }
    __syncthreads();
    if (tid < 256) {
        if (w & 1) pm = fmaxf(pm, tmp[8 + w - 1]);
        ga[d * 128 + tok] = a; gb[d * 128 + tok] = b; gpm[d * 128 + tok] = pm;
        if ((tid & 127) == 127) { gtot[d * 2] = b; gtot[d * 2 + 1] = pm; }
    }
    __syncthreads();
}

DEV void load_rope_chunk(const bf16_t* hp, int cidx, bool latent, int tl, const float* rope, float scale, float* o) {
    const u32x4 m = ldg((const u32x4*)(hp + cidx * 8));
    float x[8] = {lo16(m.x), hi16(m.x), lo16(m.y), hi16(m.y), lo16(m.z), hi16(m.z), lo16(m.w), hi16(m.w)};
    if (latent) {
        const u32x4 q = ldg((const u32x4*)(hp + (cidx ^ 2) * 8));
        const float y[8] = {lo16(q.x), hi16(q.x), lo16(q.y), hi16(q.y), lo16(q.z), hi16(q.z), lo16(q.w), hi16(q.w)};
        const int pos = (cidx < 4) ? (tl >> 6) : (ROWS + (tl & 63));
        const float* tb = rope + ((size_t)pos * 16 + (cidx & 1) * 8) * 2;
        const bool first = (cidx & 2) == 0;
#pragma unroll
        for (int j = 0; j < 8; ++j) { const float cs = ldg(tb + j * 2), sn = ldg(tb + j * 2 + 1);
            x[j] = first ? (x[j] * cs - y[j] * sn) : (x[j] * cs + y[j] * sn); }
    }
#pragma unroll
    for (int j = 0; j < 8; ++j) o[j] = x[j] * scale;
}

DEV int st_index(const SetDesc& sd, int sl, int h, int dir, int tb) { return ((sl * 4 + h) * 2 + dir) * sd.ntb + tb; }

constexpr int V_LD = 144, K_LD = 72, KS_LD = 80;
DEV void mlstm_stepA_task(const Params& p, const SetDesc& sd, int layer, int task, char* shm) {
    const int tid = TID(), lane = tid & 63, w = tid >> 6, fr = lane & 15, fq = lane >> 4, tq4 = (lane & 15) >> 2, tp4 = lane & 3;
    const int tb = task % sd.ntb, h = (task / sd.ntb) & 3, sl = task / (sd.ntb * 4);
    const int row0 = (sl << sd.lgseq) + tb * 128; const bool latent = !sd.is_ctx; const int tl0 = tb * 128;
    bf16_t* Vs = (bf16_t*)shm;
    bf16_t* Ksc = (bf16_t*)(shm + 128 * V_LD * 2);
    float* ga = (float*)(shm + 128 * V_LD * 2 + 2 * 128 * KS_LD * 2); float* gb = ga + 256; float* gpm = gb + 256; float* gtot = gpm + 256; float* tmp = gtot + 8;
    const bf16_t* prow = proj_buf(p, sd) + (size_t)row0 * PWA;
    __syncthreads();
    gate_scan(prow, h, p.gate_bias + (size_t)layer * 16, ga, gb, gpm, gtot, tmp);
    {
        const int s = tid & 127, cpi = tid >> 7, cp = (cpi & 1) + (cpi >> 1) * 4;
        const bf16_t* hp = prow + (size_t)s * PWA + C_KM + h * 64;
        float k1[8], k2[8];
        load_rope_chunk(hp, cp, latent, tl0 + s, p.rope(), 1.0f, k1);
        load_rope_chunk(hp, cp + 2, latent, tl0 + s, p.rope(), 1.0f, k2);
#pragma unroll
        for (int dir = 0; dir < 2; ++dir) { const float ws = __expf(ga[dir * 128 + s] - gtot[dir * 2 + 1]);
            u32x4 o1 = {pack2(k1[0] * ws, k1[1] * ws), pack2(k1[2] * ws, k1[3] * ws), pack2(k1[4] * ws, k1[5] * ws), pack2(k1[6] * ws, k1[7] * ws)};
            u32x4 o2 = {pack2(k2[0] * ws, k2[1] * ws), pack2(k2[2] * ws, k2[3] * ws), pack2(k2[4] * ws, k2[5] * ws), pack2(k2[6] * ws, k2[7] * ws)};
            *(u32x4*)(Ksc + (dir * 128 + s) * KS_LD + cp * 8) = o1; *(u32x4*)(Ksc + (dir * 128 + s) * KS_LD + (cp + 2) * 8) = o2; }
    }
#pragma unroll
    for (int it = 0; it < 4; ++it) { const int item = tid + it * 512, s = item >> 4, ch = item & 15;
        *(u32x4*)(Vs + s * V_LD + ch * 8) = ldg((const u32x4*)(prow + (size_t)s * PWA + C_VM + h * 128 + ch * 8)); }
    __syncthreads();
    f32x4 acc[2][4];
#pragma unroll
    for (int dir = 0; dir < 2; ++dir)
#pragma unroll
        for (int n = 0; n < 4; ++n) acc[dir][n] = (f32x4){0.f, 0.f, 0.f, 0.f};
#pragma unroll
    for (int ks = 0; ks < 4; ++ks) {
        const bf16_t* vp = Vs + (32 * ks + 4 * fq + tq4) * V_LD + w * 16 + 4 * tp4;
        const bf16x8 af = mk8(TR16(vp), TR16(vp + 16 * V_LD));
#pragma unroll
        for (int dir = 0; dir < 2; ++dir)
#pragma unroll
            for (int n = 0; n < 4; ++n) { const bf16_t* kp = Ksc + (dir * 128 + 32 * ks + 4 * fq + tq4) * KS_LD + n * 16 + 4 * tp4;
                const bf16x8 bfv = mk8(TR16(kp), TR16(kp + 16 * KS_LD));
                acc[dir][n] = mfma16(af, bfv, acc[dir][n]); }
    }
#pragma unroll
    for (int dir = 0; dir < 2; ++dir) { float* So = p.Sst() + (size_t)st_index(sd, sl, h, dir, tb) * 8192;
#pragma unroll
        for (int n = 0; n < 4; ++n)
#pragma unroll
            for (int r = 0; r < 4; ++r) stg(So + (w * 16 + fq * 4 + r) * 64 + n * 16 + fr, (float)acc[dir][n][r]); }
    if (tid < 128) { const int dir = tid >> 6, dd = tid & 63; float sm = 0.f;
        for (int i = 0; i < 128; ++i) sm += bf2f(Ksc[(dir * 128 + i) * KS_LD + dd]);
        stg(p.Sn() + (size_t)st_index(sd, sl, h, dir, tb) * 64 + dd, sm); }
    if (tid < 2) { float* sc = p.Ssc() + (size_t)st_index(sd, sl, h, tid, tb) * 4; stg(sc, gtot[tid * 2]); stg(sc + 1, gtot[tid * 2] + gtot[tid * 2 + 1]); }
}

template <int GI> DEV void pool_group(const Params& p, const SetDesc& sd, const bf16_t* pb) {
    constexpr int W = 2 << GI;
    const int nitems = sd.nrows * 16; const int T = 1 << sd.lgseq;
    for (int item = blockIdx.x * NTHREADS + TID(); item < nitems; item += gridDim.x * NTHREADS) {
        const int row = item >> 4, ch = GI * 128 + (item & 15) * 8;
        const int tt = row & (T - 1);
        u32x4 mv[W]; int cnt = 0; bool okv[W];
#pragma unroll
        for (int q = 0; q < W; ++q) { const int t2 = tt - W / 2 + q; const bool ok = (t2 >= 0) && (t2 < T); cnt += ok ? 1 : 0; okv[q] = ok;
            mv[q] = ldg((const u32x4*)(pb + (size_t)(ok ? (row - W / 2 + q) : row) * PWA + C_PU + ch)); }
        float s[8];
#pragma unroll
        for (int j = 0; j < 8; ++j) s[j] = 0.f;
#pragma unroll
        for (int q = 0; q < W; ++q) { u32x4 m = mv[q]; if (!okv[q]) m = (u32x4){0u, 0u, 0u, 0u};
            s[0] += lo16(m.x); s[1] += hi16(m.x); s[2] += lo16(m.y); s[3] += hi16(m.y); s[4] += lo16(m.z); s[5] += hi16(m.z); s[6] += lo16(m.w); s[7] += hi16(m.w); }
        const float inv = frcp((float)cnt);
        const u32x4 m = mv[W / 2];
        const float u[8] = {lo16(m.x), hi16(m.x), lo16(m.y), hi16(m.y), lo16(m.z), hi16(m.z), lo16(m.w), hi16(m.w)};
        u32x4 o = {pack2(s[0] * inv - u[0], s[1] * inv - u[1]), pack2(s[2] * inv - u[2], s[3] * inv - u[3]), pack2(s[4] * inv - u[4], s[5] * inv - u[5]), pack2(s[6] * inv - u[6], s[7] * inv - u[7])};
        stg((u32x4*)(p.Pb() + (size_t)row * 512 + ch), o);
    }
}
DEV void phase_pool(const Params& p, const SetDesc& sd) {
    const bf16_t* pb = proj_buf(p, sd);
    pool_group<0>(p, sd, pb); pool_group<1>(p, sd, pb); pool_group<2>(p, sd, pb); pool_group<3>(p, sd, pb);
}

template <int NC> DEV void mlstm_stepB_run(const Params& p, const SetDesc& sd, int task) {
    const int tid = TID();
    const int q = task & 3, dir = (task >> 2) & 1, h = (task >> 3) & 3, sl = task >> 5;
    const int ci = ((sd.samp0 + sl) * 4 + h) * 2 + dir;
    const int eoff = q * 2048 + tid * 4;
    float zr = 0.f; HIDE(zr);
    f32x4 C = {zr, zr, zr, zr}; float nv = 0.f; float m = -1e30f;
    f32x4 Sv[NC]; float blv[NC], mlv[NC], snv[NC];
#pragma unroll
    for (int c = 0; c < NC; ++c) { const int tb = dir ? NC - 1 - c : c; const size_t si = st_index(sd, sl, h, dir, tb);
        Sv[c] = ldg((const f32x4*)(p.Sst() + si * 8192 + eoff)); blv[c] = ldg(p.Ssc() + si * 4); mlv[c] = ldg(p.Ssc() + si * 4 + 1);
        snv[c] = (q == 0 && tid < 64) ? ldg(p.Sn() + si * 64 + tid) : 0.f; }
    if (!sd.is_ctx) { C = ldg((const f32x4*)(p.CiC() + (size_t)ci * 8192 + eoff)); if (q == 0 && tid < 64) nv = ldg(p.Cin_() + (size_t)ci * 64 + tid); m = ldg(p.Cim() + (size_t)ci * 4); }
#pragma unroll
    for (int c = 0; c < NC; ++c) {
        const int tb = dir ? NC - 1 - c : c; const size_t si = st_index(sd, sl, h, dir, tb);
        u32x2 o = {pack2(C[0], C[1]), pack2(C[2], C[3])};
        stg((u32x2*)(p.Cin() + si * 8192 + eoff), o);
        if (q == 0 && tid < 64) stg(p.Cn() + si * 64 + tid, nv);
        if (q == 0 && tid == 0) stg(p.Cm() + si * 4, m);
        const float mn = fmaxf(blv[c] + m, mlv[c]);
        const float dc = __expf(blv[c] + m - mn), wsn = __expf(mlv[c] - mn);
        C = C * dc + Sv[c] * wsn;
        nv = nv * dc + snv[c] * wsn;
        m = mn;
    }
    if (sd.is_ctx) { stg((f32x4*)(p.CiC() + (size_t)ci * 8192 + eoff), C); if (q == 0 && tid < 64) stg(p.Cin_() + (size_t)ci * 64 + tid, nv); if (q == 0 && tid == 0) stg(p.Cim() + (size_t)ci * 4, m); }
}
DEV void mlstm_stepB_task(const Params& p, const SetDesc& sd, int task) {
    if (sd.is_ctx) mlstm_stepB_run<NTBC>(p, sd, task); else mlstm_stepB_run<NTBL>(p, sd, task);
}

constexpr int NA_KLD = 136, NA_VLD = 144;
DEV void na_task(const Params& p, const SetDesc& sd, int layer, int sl, int rq2  , int hp, char* shm) {
    const int tid = TID(), lane = tid & 63, w = tid >> 6, tq = lane & 15, fq = lane >> 4, tq4 = (lane & 15) >> 2, tp4 = lane & 3;
    const int hh = w >> 2, g = w & 3, head = hp * 2 + hh;
    const bool ctxq = sd.is_ctx;
    bf16_t* Ks = (bf16_t*)shm;
    bf16_t* Vs = (bf16_t*)(shm + 128 * NA_KLD * 2);
    float* rpbs = (float*)(shm + 128 * NA_KLD * 2 + 128 * NA_VLD * 2);
    const int sample = sd.samp0 + sl;
    const bf16_t* pq = proj_buf(p, sd) + ((size_t)sl << sd.lgseq) * PWA;
    const bf16_t* pc = p.PROJc() + (size_t)sample * CTX * PWA;
    const int qcol = g * 16 + tq;
    int rqv[2], rsv[2], qtok[2];
#pragma unroll
    for (int u = 0; u < 2; ++u) { rqv[u] = 2 * rq2 + u; qtok[u] = rqv[u] * 64 + qcol; int r_ = rqv[u] - 4; rsv[u] = r_ < 0 ? 0 : (r_ > ROWS - 8 ? ROWS - 8 : r_); }
    const int nloc = ctxq ? 0 : (rsv[1] + 8 - rsv[0]);
    const int nstage = nloc + CTX / 64;
    __syncthreads();
    if (!ctxq) for (int i = tid; i < 2 * 465; i += NTHREADS) rpbs[i] = ldg(p.rpb + ((size_t)layer * 8 + hp * 2 + i / 465) * 465 + i % 465);
    bf16x8 qf[2][2];
#pragma unroll
    for (int u = 0; u < 2; ++u)
#pragma unroll
        for (int ks = 0; ks < 2; ++ks) qf[u][ks] = mk8(ldg((const u32x4*)(pq + (size_t)qtok[u] * PWA + C_QN + head * 64 + ks * 32 + fq * 8)));
    float m_run[2] = {-1e30f, -1e30f}, l_run[2] = {0.f, 0.f};
    f32x4 acc[2][4];
#pragma unroll
    for (int u = 0; u < 2; ++u)
#pragma unroll
        for (int mt = 0; mt < 4; ++mt) acc[u][mt] = (f32x4){0.f, 0.f, 0.f, 0.f};
    int cs = qcol - 8; cs = cs < 0 ? 0 : (cs > 48 ? 48 : cs);
    const int kc0 = (g == 0) ? 0 : (g == 1) ? 8 : (g == 2) ? 24 : 32;
    const int npair = (nstage + 1) >> 1;
    u32x4 kreg[4], vreg[4];
#define NA_SRC_ROWS(stg) (((stg) < nloc) ? (pq + (size_t)((rsv[0] + (stg)) * 64) * PWA) : (pc + (size_t)((((stg) < nstage ? (stg) : nstage - 1) - nloc) * 64) * PWA))
#define NA_FETCH(sp_) do { _Pragma("unroll") for (int it = 0; it < 4; ++it) { const int item = tid + it * 512, key2 = item >> 4, ch = item & 15; \
        const bf16_t* kb_ = NA_SRC_ROWS(2 * (sp_) + (key2 >> 6)); const bf16_t* src = kb_ + (size_t)(key2 & 63) * PWA + hp * 128 + ch * 8; \
        kreg[it] = ldg((const u32x4*)(src + C_KN)); vreg[it] = ldg((const u32x4*)(src + C_VN)); } } while (0)
    NA_FETCH(0);
    for (int sp = 0; sp < npair; ++sp) {
        __syncthreads();
#pragma unroll
        for (int it = 0; it < 4; ++it) { const int item = tid + it * 512, key2 = item >> 4, ch = item & 15;
            *(u32x4*)(Ks + key2 * NA_KLD + ch * 8) = kreg[it]; *(u32x4*)(Vs + key2 * NA_VLD + ch * 8) = vreg[it]; }
        if (sp + 1 < npair) NA_FETCH(sp + 1);
        __syncthreads();
#pragma unroll
        for (int sub = 0; sub < 2; ++sub) {
        const int st = 2 * sp + sub;
        if (st >= nstage) continue;
        const bool local = st < nloc;
        const bf16_t* Ksb = Ks + sub * 64 * NA_KLD; const bf16_t* Vsb = Vs + sub * 64 * NA_VLD;
        if (local) {
            const int kr = rsv[0] + st;
            f32x4 sa[2][2];
#pragma unroll
            for (int kt = 0; kt < 2; ++kt) { sa[0][kt] = (f32x4){0.f, 0.f, 0.f, 0.f}; sa[1][kt] = (f32x4){0.f, 0.f, 0.f, 0.f};
#pragma unroll
                for (int ks = 0; ks < 2; ++ks) { const bf16x8 kf = *(const bf16x8*)(Ksb + (kc0 + kt * 16 + tq) * NA_KLD + hh * 64 + ks * 32 + fq * 8);
                    sa[0][kt] = mfma16(kf, qf[0][ks], sa[0][kt]); sa[1][kt] = mfma16(kf, qf[1][ks], sa[1][kt]); } }
            float alpha[2]; bf16x8 pf[2];
#pragma unroll
            for (int u = 0; u < 2; ++u) {
                const bool act = (kr >= rsv[u]) && (kr < rsv[u] + 8);
                if (!act) { alpha[u] = 1.0f; pf[u] = mk8((u32x4){0u, 0u, 0u, 0u}); continue; }
                const int dr = kr - rqv[u] + 7;
                float sc[8]; float mx = -1e30f; float bs[8];
#pragma unroll
                for (int kt = 0; kt < 2; ++kt)
#pragma unroll
                    for (int r = 0; r < 4; ++r) { const int kcol = kc0 + kt * 16 + fq * 4 + r; int dc = kcol - qcol + 15; dc = dc < 0 ? 0 : (dc > 30 ? 30 : dc);
                        bs[kt * 4 + r] = rpbs[hh * 465 + dr * 31 + dc]; }
#ifndef CPU_EMU
                asm volatile("" : "+v"(bs[0]), "+v"(bs[1]), "+v"(bs[2]), "+v"(bs[3]), "+v"(bs[4]), "+v"(bs[5]), "+v"(bs[6]), "+v"(bs[7]));
#endif
#pragma unroll
                for (int kt = 0; kt < 2; ++kt)
#pragma unroll
                    for (int r = 0; r < 4; ++r) { const int kcol = kc0 + kt * 16 + fq * 4 + r; const bool valid = (kcol >= cs) && (kcol < cs + 16);
                        const float v = valid ? (sa[u][kt][r] * 0.125f + bs[kt * 4 + r]) : -1e30f; sc[kt * 4 + r] = v; mx = fmaxf(mx, v); }
                mx = fmaxf(mx, shx<16>(mx)); mx = fmaxf(mx, shx<32>(mx));
                const float mn = fmaxf(m_run[u], mx); alpha[u] = __expf(m_run[u] - mn); m_run[u] = mn;
                float ps = 0.f; float pv[8];
#pragma unroll
                for (int j = 0; j < 8; ++j) { pv[j] = __expf(sc[j] - mn); ps += pv[j]; }
                ps += shx<16>(ps); ps += shx<32>(ps);
                l_run[u] = l_run[u] * alpha[u] + ps;
                u32x4 pk = {pack2(pv[0], pv[1]), pack2(pv[2], pv[3]), pack2(pv[4], pv[5]), pack2(pv[6], pv[7])};
                pf[u] = mk8(pk);
            }
#pragma unroll
            for (int mt = 0; mt < 4; ++mt) {
                const bf16_t* vp = Vsb + (kc0 + 4 * fq + tq4) * NA_VLD + hh * 64 + mt * 16 + 4 * tp4;
                const bf16x8 vf = mk8(TR16(vp), TR16(vp + 16 * NA_VLD));
                acc[0][mt] = mfma16(vf, pf[0], acc[0][mt] * alpha[0]); acc[1][mt] = mfma16(vf, pf[1], acc[1][mt] * alpha[1]); }
        } else {
            f32x4 sa[2][4];
#pragma unroll
            for (int kt = 0; kt < 4; ++kt) { sa[0][kt] = (f32x4){0.f, 0.f, 0.f, 0.f}; sa[1][kt] = (f32x4){0.f, 0.f, 0.f, 0.f};
#pragma unroll
                for (int ks = 0; ks < 2; ++ks) { const bf16x8 kf = *(const bf16x8*)(Ksb + (kt * 16 + tq) * NA_KLD + hh * 64 + ks * 32 + fq * 8);
                    sa[0][kt] = mfma16(kf, qf[0][ks], sa[0][kt]); sa[1][kt] = mfma16(kf, qf[1][ks], sa[1][kt]); } }
            float alpha[2]; bf16x8 pf[2][2];
#pragma unroll
            for (int u = 0; u < 2; ++u) {
                float mx = -1e30f;
#pragma unroll
                for (int kt = 0; kt < 4; ++kt)
#pragma unroll
                    for (int r = 0; r < 4; ++r) { sa[u][kt][r] *= 0.125f; mx = fmaxf(mx, sa[u][kt][r]); }
                mx = fmaxf(mx, shx<16>(mx)); mx = fmaxf(mx, shx<32>(mx));
                const float mn = fmaxf(m_run[u], mx); alpha[u] = __expf(m_run[u] - mn); m_run[u] = mn;
                float ps = 0.f;
#pragma unroll
                for (int kt = 0; kt < 4; ++kt)
#pragma unroll
                    for (int r = 0; r < 4; ++r) { sa[u][kt][r] = __expf(sa[u][kt][r] - mn); ps += sa[u][kt][r]; }
                ps += shx<16>(ps); ps += shx<32>(ps);
                l_run[u] = l_run[u] * alpha[u] + ps;
#pragma unroll
                for (int h2 = 0; h2 < 2; ++h2) {
                    u32x4 pk = {pack2(sa[u][2 * h2][0], sa[u][2 * h2][1]), pack2(sa[u][2 * h2][2], sa[u][2 * h2][3]), pack2(sa[u][2 * h2 + 1][0], sa[u][2 * h2 + 1][1]), pack2(sa[u][2 * h2 + 1][2], sa[u][2 * h2 + 1][3])};
                    pf[u][h2] = mk8(pk); }
            }
#pragma unroll
            for (int mt = 0; mt < 4; ++mt) { acc[0][mt] = acc[0][mt] * alpha[0]; acc[1][mt] = acc[1][mt] * alpha[1]; }
#pragma unroll
            for (int h2 = 0; h2 < 2; ++h2)
#pragma unroll
                for (int mt = 0; mt < 4; ++mt) { const bf16_t* vp = Vsb + (32 * h2 + 4 * fq + tq4) * NA_VLD + hh * 64 + mt * 16 + 4 * tp4;
                    const bf16x8 vf = mk8(TR16(vp), TR16(vp + 16 * NA_VLD));
                    acc[0][mt] = mfma16(vf, pf[0][h2], acc[0][mt]); acc[1][mt] = mfma16(vf, pf[1][h2], acc[1][mt]); }
        }
        }
    }
#undef NA_FETCH
#undef NA_SRC_ROWS
#pragma unroll
    for (int u = 0; u < 2; ++u) {
        const float il = frcp(l_run[u]);
        const size_t orow = ((size_t)sl << sd.lgseq) + qtok[u];
#pragma unroll
        for (int mt = 0; mt < 4; ++mt) { u32x2 o = {pack2(acc[u][mt][0] * il, acc[u][mt][1] * il), pack2(acc[u][mt][2] * il, acc[u][mt][3] * il)};
            stg((u32x2*)(p.Nb() + orow * 512 + head * 64 + mt * 16 + fq * 4), o); }
    }
}

DEV void mlstm_stepC_task(const Params& p, const SetDesc& sd, int layer, int task, char* shm) {
    const int tid = TID(), lane = tid & 63, w = tid >> 6, tq = lane & 15, fq = lane >> 4, tq4 = (lane & 15) >> 2, tp4 = lane & 3;
    const int tb = task % sd.ntb, h = (task / sd.ntb) & 3, sl = task / (sd.ntb * 4);
    const int row0 = (sl << sd.lgseq) + tb * 128; const bool latent = !sd.is_ctx; const int tl0 = tb * 128;
    bf16_t* Ks = (bf16_t*)shm;
    bf16_t* Vs = (bf16_t*)(shm + 128 * K_LD * 2);
    bf16_t* Cs = (bf16_t*)(shm + 128 * K_LD * 2 + 128 * V_LD * 2);
    float* ga = (float*)(shm + 128 * K_LD * 2 * 3 + 128 * V_LD * 2); float* gb = ga + 256; float* gpm = gb + 256; float* gtot = gpm + 256; float* tmp = gtot + 8;
    float* nvs = tmp + 16;
    float* cms = nvs + 128;
    const bf16_t* prow = proj_buf(p, sd) + (size_t)row0 * PWA;
    __syncthreads();
    gate_scan(prow, h, p.gate_bias + (size_t)layer * 16, ga, gb, gpm, gtot, tmp);
    {
        const int s = tid & 127, cpi = tid >> 7, cp = (cpi & 1) + (cpi >> 1) * 4;
        const bf16_t* hp = prow + (size_t)s * PWA + C_KM + h * 64;
        float k1[8], k2[8];
        load_rope_chunk(hp, cp, latent, tl0 + s, p.rope(), 1.0f, k1);
        load_rope_chunk(hp, cp + 2, latent, tl0 + s, p.rope(), 1.0f, k2);
        u32x4 o1 = {pack2(k1[0], k1[1]), pack2(k1[2], k1[3]), pack2(k1[4], k1[5]), pack2(k1[6], k1[7])};
        u32x4 o2 = {pack2(k2[0], k2[1]), pack2(k2[2], k2[3]), pack2(k2[4], k2[5]), pack2(k2[6], k2[7])};
        *(u32x4*)(Ks + s * K_LD + cp * 8) = o1; *(u32x4*)(Ks + s * K_LD + (cp + 2) * 8) = o2;
    }
#pragma unroll
    for (int it = 0; it < 4; ++it) { const int item = tid + it * 512, s = item >> 4, ch = item & 15;
        *(u32x4*)(Vs + s * V_LD + ch * 8) = ldg((const u32x4*)(prow + (size_t)s * PWA + C_VM + h * 128 + ch * 8)); }
#pragma unroll
    for (int it = 0; it < 4; ++it) { const int item = tid + it * 512, dir = item >> 10, rem = item & 1023, v = rem >> 3, ch = rem & 7;
        *(u32x4*)(Cs + (dir * 128 + v) * K_LD + ch * 8) = ldg((const u32x4*)(p.Cin() + (size_t)st_index(sd, sl, h, dir, tb) * 8192 + v * 64 + ch * 8)); }
    if (tid < 128) nvs[tid] = ldg(p.Cn() + (size_t)st_index(sd, sl, h, tid >> 6, tb) * 64 + (tid & 63));
    if (tid < 2) cms[tid] = ldg(p.Cm() + (size_t)st_index(sd, sl, h, tid, tb) * 4);
    bf16x8 qf[2]; float qv[2][8];
    {
        const int t = w * 16 + tq; const bf16_t* hp = prow + (size_t)t * PWA + C_QM + h * 64;
#pragma unroll
        for (int ks = 0; ks < 2; ++ks) { load_rope_chunk(hp, ks * 4 + fq, latent, tl0 + t, p.rope(), 0.125f, qv[ks]);
            u32x4 o = {pack2(qv[ks][0], qv[ks][1]), pack2(qv[ks][2], qv[ks][3]), pack2(qv[ks][4], qv[ks][5]), pack2(qv[ks][6], qv[ks][7])}; qf[ks] = mk8(o); }
    }
    __syncthreads();
    const int t = w * 16 + tq;
    f32x4 hsum[8];
#pragma unroll
    for (int mt = 0; mt < 8; ++mt) hsum[mt] = (f32x4){0.f, 0.f, 0.f, 0.f};
#pragma unroll
    for (int dir = 0; dir < 2; ++dir) {
        const float m_in = cms[dir];
        const float Mt = fmaxf(m_in, gpm[dir * 128 + t]);
        const float inter = __expf(m_in - Mt);
        const float mtot = gb[dir * 128 + t] + Mt;
        f32x4 acc[8];
#pragma unroll
        for (int mt = 0; mt < 8; ++mt) { acc[mt] = (f32x4){0.f, 0.f, 0.f, 0.f};
#pragma unroll
            for (int ks = 0; ks < 2; ++ks) { const bf16x8 cf = *(const bf16x8*)(Cs + (dir * 128 + mt * 16 + tq) * K_LD + ks * 32 + fq * 8);
                acc[mt] = mfma16(cf, qf[ks], acc[mt]); }
            acc[mt] = acc[mt] * inter; }
        float qn = 0.f;
#pragma unroll
        for (int ks = 0; ks < 2; ++ks)
#pragma unroll
            for (int j = 0; j < 8; ++j) qn += bf2f(f2bf(qv[ks][j])) * nvs[dir * 64 + ks * 32 + fq * 8 + j];
        qn += shx<16>(qn); qn += shx<32>(qn);
        float den = inter * qn;
        const int u_lo = dir == 0 ? 0 : (w >> 1), u_hi = dir == 0 ? (w >> 1) : 3;
        float rsum = 0.f;
        for (int u = u_lo; u <= u_hi; ++u) {
            unsigned pk[4];
#pragma unroll
            for (int kt = 0; kt < 2; ++kt) { f32x4 sa = {0.f, 0.f, 0.f, 0.f}; const int sb = 32 * u + 16 * kt;
#pragma unroll
                for (int ks = 0; ks < 2; ++ks) { const bf16x8 kf = *(const bf16x8*)(Ks + (sb + tq) * K_LD + ks * 32 + fq * 8); sa = mfma16(kf, qf[ks], sa); }
                float pv[4]; float gv4[4];
#pragma unroll
                for (int r = 0; r < 4; ++r) gv4[r] = ga[dir * 128 + sb + fq * 4 + r];
#ifndef CPU_EMU
                asm volatile("" : "+v"(gv4[0]), "+v"(gv4[1]), "+v"(gv4[2]), "+v"(gv4[3]));
#endif
#pragma unroll
                for (int r = 0; r < 4; ++r) { const int s = sb + fq * 4 + r; const bool valid = dir == 0 ? (s <= t) : (s >= t);
                    pv[r] = valid ? sa[r] * __expf(gv4[r] - Mt) : 0.f; pv[r] = bf2f(f2bf(pv[r])); rsum += pv[r]; }
                pk[kt * 2] = pack2(pv[0], pv[1]); pk[kt * 2 + 1] = pack2(pv[2], pv[3]); }
            u32x4 pkv = {pk[0], pk[1], pk[2], pk[3]}; const bf16x8 pf = mk8(pkv);
#pragma unroll
            for (int mt = 0; mt < 8; ++mt) { const bf16_t* vp = Vs + (32 * u + 4 * fq + tq4) * V_LD + mt * 16 + 4 * tp4;
                const bf16x8 vf = mk8(TR16(vp), TR16(vp + 16 * V_LD));
                acc[mt] = mfma16(vf, pf, acc[mt]); }
        }
        rsum += shx<16>(rsum); rsum += shx<32>(rsum);
        den += rsum;
        const float dn = frcp(fmaxf(fabsf(den), __expf(-mtot)));
#pragma unroll
        for (int mt = 0; mt < 8; ++mt) hsum[mt] = hsum[mt] + acc[mt] * dn;
    }
    float ss = 0.f;
#pragma unroll
    for (int mt = 0; mt < 8; ++mt)
#pragma unroll
        for (int r = 0; r < 4; ++r) ss += hsum[mt][r] * hsum[mt][r];
    ss += shx<16>(ss); ss += shx<32>(ss);
    const float rstd = rsqrtf(ss * (1.0f / 128.0f) + RMS_EPS);
#pragma unroll
    for (int mt = 0; mt < 8; ++mt) { const int v = mt * 16 + fq * 4;
        const u32x2 om = ldg((const u32x2*)(prow + (size_t)t * PWA + C_OM + h * 128 + v));
        u32x2 o = {pack2(hsum[mt][0] * rstd * sigmoidf_(lo16(om.x)), hsum[mt][1] * rstd * sigmoidf_(hi16(om.x))),
                   pack2(hsum[mt][2] * rstd * sigmoidf_(lo16(om.y)), hsum[mt][3] * rstd * sigmoidf_(hi16(om.y)))};
        stg((u32x2*)(p.Mb() + (size_t)(row0 + t) * 512 + h * 128 + v), o); }
}

struct SchedMerge {
    const bf16_t* Mb; const bf16_t* Pb; const bf16_t* Nb; const bf16_t* Wb; int nM;
    DEV bool next(int i, GUnit& u) const { u.aux = i % 3; return tile_order(i / 3, nM, 4, u.pm, u.pn); }
    DEV const bf16_t* a_base(const GUnit& u) const { return (u.aux == 0 ? Mb : (u.aux == 1 ? Pb : Nb)) + (size_t)u.pm * 256 * 512; }
    DEV const bf16_t* b_base(const GUnit& u) const { return Wb + ((size_t)u.aux * 1024 + u.pn * 256) * 512; }
    DEV int grow(const GUnit&, int) const { return 0; }
};
DEV void phase_merge(const Params& p, const SetDesc& sd, int layer, char* shm) {
    SchedMerge S; S.Mb = p.Mb(); S.Pb = p.Pb(); S.Nb = p.Nb(); S.Wb = p.WbT() + (size_t)layer * 3 * 1024 * 512; S.nM = sd.nrows / 256;
    const unsigned char* bgb = (const unsigned char*)p.BG(); bf16_t* mgb = p.MERGED();
    gemm_stream<false, 512, 512, 512>(shm, S, [=](const GUnit& u, f32x4 (&acc)[2][2][4][2], int r0, int c0) -> bool {
        if (u.aux < 2) {
            u32x2 ga[2][4][2], gb[2][4][2];
#pragma unroll
            for (int ai = 0; ai < 2; ++ai)
#pragma unroll
                for (int m = 0; m < 4; ++m)
#pragma unroll
                    for (int hf = 0; hf < 2; ++hf) { const unsigned char* gp = bgb + ((size_t)u.pm * 256 + r0 + ai * 128 + m * 16) * NBG + u.aux * 1024 + u.pn * 256 + c0 + hf * 128;
                        ga[ai][m][hf] = ldg((const u32x2*)gp); gb[ai][m][hf] = ldg((const u32x2*)(gp + 1024)); }
#pragma unroll
            for (int ai = 0; ai < 2; ++ai)
#pragma unroll
                for (int m = 0; m < 4; ++m)
#pragma unroll
                    for (int hf = 0; hf < 2; ++hf) {
#pragma unroll
                        for (int j = 0; j < 4; ++j) { acc[ai][hf][m][0][j] *= u8f(ga[ai][m][hf].x, j) * frcp(u8f(gb[ai][m][hf].x, j)); acc[ai][hf][m][1][j] *= u8f(ga[ai][m][hf].y, j) * frcp(u8f(gb[ai][m][hf].y, j)); } }
            return true;
        }
        u32x2 gm2[2][4][2];
#pragma unroll
        for (int ai = 0; ai < 2; ++ai)
#pragma unroll
            for (int m = 0; m < 4; ++m)
#pragma unroll
                for (int hf = 0; hf < 2; ++hf) gm2[ai][m][hf] = ldg((const u32x2*)(bgb + ((size_t)u.pm * 256 + r0 + ai * 128 + m * 16) * NBG + 2048 + u.pn * 256 + c0 + hf * 128));
#pragma unroll
        for (int ai = 0; ai < 2; ++ai) {
#pragma unroll
            for (int m = 0; m < 4; ++m)
#pragma unroll
                for (int hf = 0; hf < 2; ++hf) { const size_t r = (size_t)u.pm * 256 + r0 + ai * 128 + m * 16;
                    const f32x4 x0 = acc[ai][hf][m][0] * (1.0f / 255.0f), x1 = acc[ai][hf][m][1] * (1.0f / 255.0f); const u32x2 g = gm2[ai][m][hf];
                    u32x4 ov = {pack2(x0[0] * u8f(g.x, 0), x0[1] * u8f(g.x, 1)), pack2(x0[2] * u8f(g.x, 2), x0[3] * u8f(g.x, 3)),
                                pack2(x1[0] * u8f(g.y, 0), x1[1] * u8f(g.y, 1)), pack2(x1[2] * u8f(g.y, 2), x1[3] * u8f(g.y, 3))};
                    stg((u32x4*)(mgb + r * 1024 + u.pn * 256 + c0 + hf * 128), ov); }
        }
        return false; });
}
DEV void phase_outproj(const Params& p, const SetDesc& sd, int layer, char* shm) {
    SchedPlain S; S.A = p.MERGED(); S.Bt = p.WoT() + (size_t)layer * 1024 * 1024; S.nM = sd.nrows / 256; S.nN = 4; S.lda256 = 256 * 1024; S.ldb256 = 256 * 1024;
    bf16_t* yb = p.Y();
    gemm_stream<false, 1024, 1024, 1024>(shm, S, [=](const GUnit& u, const f32x4 (&acc)[2][2][4][2], int r0, int c0) {
#pragma unroll
        for (int ai = 0; ai < 2; ++ai)
#pragma unroll
            for (int m = 0; m < 4; ++m) { bf16_t* o = yb + ((size_t)u.pm * 256 + r0 + ai * 128 + m * 16) * 1024 + u.pn * 256 + c0;
                store8bf(o, acc[ai][0][m][0], acc[ai][0][m][1]); store8bf(o + 128, acc[ai][1][m][0], acc[ai][1][m][1]); } });
}

template <bool SRC_BF> DEV void phase_postmix(const Params& p, const SetDesc& sd, int layer, char* shm) {
    const int tid = TID(), lane = tid & 63, wv = tid >> 6;
    float* wr_s = (float*)shm;
    __syncthreads();
    for (int i = tid; i < 1024 * 16; i += NTHREADS) { const int c = i >> 4, e = i & 15, ln = (c & 511) >> 3, j = c & 7, hf = c >> 9;
        wr_s[((((hf * 8 + j) * 4 + (e >> 2)) * 64 + ln) << 2) + (e & 3)] = ldg(p.router_w + (size_t)layer * 1024 * 16 + i); }
    __syncthreads();
    const float* g1 = p.norm_gain + ((size_t)layer * 4 + 1) * 1024; const float* g2 = p.norm_gain + ((size_t)layer * 4 + 2) * 1024;
    float* par = (float*)(shm + 65536);
    { const int rpb0_ = (sd.nrows + (int)gridDim.x - 1) / (int)gridDim.x; const float* mdb = mod_row(p, sd, layer, min((int)blockIdx.x * rpb0_, sd.nrows - 1));
      stage_params(par, g1, g2, mdb + 2048, mdb + 3072, mdb + 4096); }
    __syncthreads();
    const void* xb = SRC_BF ? (const void*)xbf_base(p, sd) : (const void*)xin_f32(p, sd); bf16_t* xdb = xbf_base(p, sd);
    const int stride = 8; const int rpb_ = (sd.nrows + (int)gridDim.x - 1) / (int)gridDim.x; const int row_end = min(sd.nrows, ((int)blockIdx.x + 1) * rpb_);
    int row = (int)blockIdx.x * rpb_ + wv;
    u32x4 ycur[2], ynxt[2]; XRow<SRC_BF> xcur, xnxt;
    if (row < row_end) {
#pragma unroll
        for (int i = 0; i < 2; ++i) ycur[i] = ldg((const u32x4*)(p.Y() + (size_t)row * 1024 + i * 512 + lane * 8));
        xcur.load(xb, row, lane); }
    for (; row < row_end; row += stride) {
        int ln = lane; HIDE(ln);
        const int rn = row + stride;
        if (rn < row_end) {
#pragma unroll
            for (int i = 0; i < 2; ++i) ynxt[i] = ldg((const u32x4*)(p.Y() + (size_t)rn * 1024 + i * 512 + ln * 8));
            xnxt.load(xb, rn, ln); }
        float y[16]; float ss = 0.f;
#pragma unroll
        for (int hlf = 0; hlf < 2; ++hlf) { const u32x4 m = ycur[hlf];
            const float t8[8] = {lo16(m.x), hi16(m.x), lo16(m.y), hi16(m.y), lo16(m.z), hi16(m.z), lo16(m.w), hi16(m.w)};
#pragma unroll
            for (int j = 0; j < 8; ++j) { y[hlf * 8 + j] = t8[j]; ss += t8[j] * t8[j]; } }
        ss = wave_sum(ss);
        const float rstd = rsqrtf(ss * (1.0f / 1024.0f) + RMS_EPS);
        float xn[16]; float ss2 = 0.f;
#pragma unroll
        for (int hlf = 0; hlf < 2; ++hlf) { f32x4 xw[2];
#pragma unroll
            for (int q = 0; q < 2; ++q) { const int c0 = hlf * 512 + ln * 8 + q * 4; const f32x4 xo = xcur.get(hlf * 2 + q);
#pragma unroll
                for (int j = 0; j < 4; ++j) { const float v = xo[j] + par[2048 + c0 + j] * (y[hlf * 8 + q * 4 + j] * rstd * par[c0 + j]); xw[q][j] = v; xn[hlf * 8 + q * 4 + j] = v; ss2 += v * v; } }
            xrow_store8<true>(xdb, row, hlf * 512 + ln * 8, xw[0], xw[1]); }
        ss2 = wave_sum(ss2);
        const float rstd2 = rsqrtf(ss2 * (1.0f / 1024.0f) + RMS_EPS);
        float lg[16];
#pragma unroll
        for (int e = 0; e < 16; ++e) lg[e] = 0.f;
#pragma unroll
        for (int hlf = 0; hlf < 2; ++hlf) { const int c0 = hlf * 512 + ln * 8; float o[8];
#pragma unroll
            for (int j = 0; j < 8; ++j) { o[j] = xn[hlf * 8 + j] * rstd2 * par[1024 + c0 + j] * (1.0f + par[4096 + c0 + j]) + par[3072 + c0 + j];
#pragma unroll
                for (int eq = 0; eq < 4; ++eq) { const f32x4 w4 = *(const f32x4*)(wr_s + ((((hlf * 8 + j) * 4 + eq) * 64 + ln) << 2));
#pragma unroll
                    for (int e = 0; e < 4; ++e) lg[eq * 4 + e] += o[j] * w4[e]; } }
            const u32x2 ov = {f8pack4(o[0], o[1], o[2], o[3]), f8pack4(o[4], o[5], o[6], o[7])};
            stg((u32x2*)((unsigned char*)p.H() + (size_t)row * 1024 + c0), ov); }
        float r8[8], r4[4], r2[2], r1;
        { const bool b = (lane & 32) != 0;
#pragma unroll
          for (int i = 0; i < 8; ++i) { const float keep = b ? lg[i + 8] : lg[i], send = b ? lg[i] : lg[i + 8]; r8[i] = keep + shx<32>(send); } }
        { const bool b = (lane & 16) != 0;
#pragma unroll
          for (int i = 0; i < 4; ++i) { const float keep = b ? r8[i + 4] : r8[i], send = b ? r8[i] : r8[i + 4]; r4[i] = keep + shx<16>(send); } }
        { const bool b = (lane & 8) != 0;
#pragma unroll
          for (int i = 0; i < 2; ++i) { const float keep = b ? r4[i + 2] : r4[i], send = b ? r4[i] : r4[i + 2]; r2[i] = keep + shx<8>(send); } }
        { const bool b = (lane & 4) != 0; const float keep = b ? r2[1] : r2[0], send = b ? r2[0] : r2[1]; r1 = keep + shx<4>(send); }
        r1 += shx<2>(r1); r1 += shx<1>(r1);
        float mx = r1;
        mx = fmaxf(mx, shx<4>(mx)); mx = fmaxf(mx, shx<8>(mx)); mx = fmaxf(mx, shx<16>(mx)); mx = fmaxf(mx, shx<32>(mx));
        const float ex = __expf(r1 - mx);
        float se = ex;
        se += shx<4>(se); se += shx<8>(se); se += shx<16>(se); se += shx<32>(se);
        if ((lane & 3) == 0) { const int e = ((lane >> 5) & 1) * 8 + ((lane >> 4) & 1) * 4 + ((lane >> 3) & 1) * 2 + ((lane >> 2) & 1);
            stg(p.aff() + (size_t)row * 16 + e, ex * frcp(se)); }
#pragma unroll
        for (int i = 0; i < 2; ++i) ycur[i] = ynxt[i];
        xcur = xnxt;
    }
}

DEV unsigned shxu(unsigned v, int m) {
    const float f = __uint_as_float(v); float r;
    switch (m) { case 1: r = shx<1>(f); break; case 2: r = shx<2>(f); break; case 4: r = shx<4>(f); break; case 8: r = shx<8>(f); break; case 16: r = shx<16>(f); break; default: r = shx<32>(f); break; }
    return __float_as_uint(r);
}
#define TK_CX(a_, b_, desc_) do { const unsigned long long x_ = key[a_], y_ = key[b_]; const bool sw_ = (desc_) ? (x_ < y_) : (x_ > y_); key[a_] = sw_ ? y_ : x_; key[b_] = sw_ ? x_ : y_; } while (0)
DEV void topk_task(const Params& p, const SetDesc& sd, int task, char* shm) {
    const int tid = TID();
    const int e = task & 15, sl = task >> 4;
    unsigned long long* buf = (unsigned long long*)shm;
    const int T = 1 << sd.lgseq, cap = sd.cap;
    const int rbase = sl << sd.lgseq;
    const bool active = tid * 4 < T;
    unsigned long long key[4];
    __syncthreads();
#pragma unroll
    for (int m = 0; m < 4; ++m) { const int i = tid * 4 + m; const float a = active ? ldg(p.aff() + (size_t)(rbase + i) * 16 + e) : 0.f;
        key[m] = ((unsigned long long)__float_as_uint(a) << 32) | (unsigned)(0xFFFFFFFFu - (unsigned)i); }
    for (int k = 2; k <= T; k <<= 1) {
        const bool desc4 = ((tid * 4) & k) == 0;
        for (int j = k >> 1; j >= 4; j >>= 1) {
            const int tj = j >> 2;
            unsigned long long pk[4];
            if (tj < 64) {
#pragma unroll
                for (int m = 0; m < 4; ++m) { const unsigned lo = shxu((unsigned)key[m], tj), hi = shxu((unsigned)(key[m] >> 32), tj); pk[m] = ((unsigned long long)hi << 32) | lo; }
            } else {
                __syncthreads();
                if (active) {
#pragma unroll
                    for (int m = 0; m < 4; ++m) buf[tid * 4 + m] = key[m]; }
                __syncthreads();
#pragma unroll
                for (int m = 0; m < 4; ++m) pk[m] = active ? buf[(tid ^ tj) * 4 + m] : 0ull;
            }
            const bool lower = (tid & tj) == 0; const bool takemax = desc4 == lower;
#pragma unroll
            for (int m = 0; m < 4; ++m) { const unsigned long long x = key[m], y = pk[m]; key[m] = takemax ? (x > y ? x : y) : (x < y ? x : y); }
        }
        if (k >= 4) { TK_CX(0, 2, desc4); TK_CX(1, 3, desc4); TK_CX(0, 1, desc4); TK_CX(2, 3, desc4); }
        else { TK_CX(0, 1, true); TK_CX(2, 3, false); }
    }
    const int sbase = e * sd.rpe + sl * cap;
    if (active) {
#pragma unroll
        for (int m = 0; m < 4; ++m) { const int i = tid * 4 + m; const unsigned long long kv = key[m]; const int tok = (int)(0xFFFFFFFFu - (unsigned)(kv & 0xFFFFFFFFu));
            const int row = rbase + tok;
            if (i < cap) { stg(p.slot_token() + sbase + i, row); stg(p.slot_gate() + sbase + i, __uint_as_float((unsigned)(kv >> 32))); stg(p.token_slots() + (size_t)row * 16 + e, sbase + i); }
            else stg(p.token_slots() + (size_t)row * 16 + e, -1); } }
    if (sl == 0) { const int used = sd.nsamp * cap;
        for (int i = used + tid; i < sd.rpe; i += NTHREADS) { stg(p.slot_token() + e * sd.rpe + i, 0); stg(p.slot_gate() + e * sd.rpe + i, 0.f); } }
}
#undef TK_CX

struct SchedMoe {
    const bf16_t* A; const int* st; const bf16_t* W; int nRT, rpe, nN, wstride;
    DEV bool next(int i, GUnit& u) const { int pmx, pn; if (!tile_order(i, 16 * nRT, nN, pmx, pn)) return false; u.pm = pmx % nRT; u.aux = pmx / nRT; u.pn = pn; return true; }
    DEV int slot0(const GUnit& u) const { return u.aux * rpe + u.pm * 256; }
    DEV const bf16_t* a_base(const GUnit&) const { return A; }
    DEV int grow(const GUnit& u, int i) const { return st ? ldg(st + slot0(u) + i) : slot0(u) + i; }
    DEV const bf16_t* b_base(const GUnit& u) const { return W + (size_t)u.aux * wstride + (size_t)u.pn * 256 * 512; }
};
DEV void phase_moe_gu(const Params& p, const SetDesc& sd, int layer, char* shm) {
    SchedMoe S; S.A = p.H(); S.st = p.slot_token(); S.W = p.WguT() + (size_t)layer * 16 * 2048 * 512; S.nRT = sd.rpe / 256; S.rpe = sd.rpe; S.nN = 8; S.wstride = 2048 * 512;
    unsigned char* hb = (unsigned char*)p.HID();
    gemm_stream<true, 512, 512, 512, true>(shm, S, [=](const GUnit& u, const f32x4 (&acc)[2][2][4][2], int r0, int c0) {
#pragma unroll
        for (int ai = 0; ai < 2; ++ai)
#pragma unroll
            for (int m = 0; m < 4; ++m) { f32x4 h0, h1; const f32x4 a0 = acc[ai][0][m][0] * F8_WINV, a1 = acc[ai][0][m][1] * F8_WINV, b0 = acc[ai][1][m][0] * F8_WINV, b1 = acc[ai][1][m][1] * F8_WINV;
#pragma unroll
                for (int j = 0; j < 4; ++j) { h0[j] = a0[j] * sigmoidf_(a0[j]) * b0[j]; h1[j] = a1[j] * sigmoidf_(a1[j]) * b1[j]; }
                const u32x2 hv = {f8pack4(h0[0], h0[1], h0[2], h0[3]), f8pack4(h1[0], h1[1], h1[2], h1[3])};
                stg((u32x2*)(hb + ((size_t)S.slot0(u) + r0 + ai * 128 + m * 16) * 1024 + u.pn * 128 + c0), hv); } });
}
DEV void phase_moe_down(const Params& p, const SetDesc& sd, int layer, char* shm) {
    SchedMoe S; S.A = p.HID(); S.st = nullptr; S.W = p.WdT() + (size_t)layer * 16 * 1024 * 512; S.nRT = sd.rpe / 256; S.rpe = sd.rpe; S.nN = 4; S.wstride = 1024 * 512;
    unsigned char* yb = (unsigned char*)p.YE(); const float* gt = p.slot_gate();
    gemm_stream<true, 512, 512, 512, true>(shm, S, [=](const GUnit& u, const f32x4 (&acc)[2][2][4][2], int r0, int c0) {
#pragma unroll
        for (int ai = 0; ai < 2; ++ai) {
            float gv[4];
#pragma unroll
            for (int m = 0; m < 4; ++m) gv[m] = ldg(gt + (size_t)S.slot0(u) + r0 + ai * 128 + m * 16) * (F8_WINV * YE_SCALE);
#pragma unroll
            for (int m = 0; m < 4; ++m) { const size_t sl = (size_t)S.slot0(u) + r0 + ai * 128 + m * 16; const float g = gv[m];
                unsigned char* o = yb + sl * 1024 + u.pn * 256 + c0;
#pragma unroll
                for (int hf = 0; hf < 2; ++hf) { const f32x4 a = acc[ai][hf][m][0] * g, b = acc[ai][hf][m][1] * g;
                    const u32x2 ov = {f8pack4(a[0], a[1], a[2], a[3]), f8pack4(b[0], b[1], b[2], b[3])}; stg((u32x2*)(o + hf * 128), ov); } } } });
}

DEV void compact4(const int (&sl)[16], int (&c)[4], int& n) {
    n = 0; c[0] = -1; c[1] = -1; c[2] = -1; c[3] = -1;
#pragma unroll
    for (int e = 0; e < 16; ++e) if (sl[e] >= 0) { c[0] = (n == 0) ? sl[e] : c[0]; c[1] = (n == 1) ? sl[e] : c[1]; c[2] = (n == 2) ? sl[e] : c[2]; c[3] = (n == 3) ? sl[e] : c[3]; ++n; }
}
template <bool DST_F32> DEV void phase_combine(const Params& p, const SetDesc& sd, int layer, char* shm) {
    const int tid = TID(), lane = tid & 63, wv = tid >> 6;
    const float* g3 = p.norm_gain + ((size_t)layer * 4 + 3) * 1024;
    const bf16_t* xsb = xbf_base(p, sd); void* xdb = DST_F32 ? (void*)xout_f32(p, sd) : (void*)xbf_base(p, sd);
    const int stride = 8; const int rpb_ = (sd.nrows + (int)gridDim.x - 1) / (int)gridDim.x; const int row_end = min(sd.nrows, ((int)blockIdx.x + 1) * rpb_);
    int row = __builtin_amdgcn_readfirstlane((int)blockIdx.x * rpb_ + wv);
    float* par = (float*)shm;
    __syncthreads();
    { const float* mdb = mod_row(p, sd, layer, min((int)blockIdx.x * rpb_, sd.nrows - 1)); stage_params(par, g3, mdb + 5120, nullptr, nullptr, nullptr); }
    __syncthreads();
    int raw[16]; int cc[4], cn[4]; int nc = 0, nn = 0;
    u32x2 mc[4][2], mn[4][2]; XRow<true> xc, xn;
#define CMB_SLOTS(r_) do { _Pragma("unroll") for (int e = 0; e < 16; ++e) raw[e] = ldg(p.token_slots() + (size_t)(r_) * 16 + e); } while (0)
#define CMB_DATA(r_, c_, n_, m_, x_) do { _Pragma("unroll") for (int k = 0; k < 4; ++k) { \
            if (k < (n_)) { const unsigned char* yr = (const unsigned char*)p.YE() + (size_t)(c_)[k] * 1024 + lane * 8; (m_)[k][0] = ldg((const u32x2*)yr); (m_)[k][1] = ldg((const u32x2*)(yr + 512)); } \
            else { (m_)[k][0] = (u32x2){0u, 0u}; (m_)[k][1] = (u32x2){0u, 0u}; } } \
        (x_).load(xsb, (r_), lane); } while (0)
    if (row < row_end) { CMB_SLOTS(row); compact4(raw, cc, nc); CMB_DATA(row, cc, nc, mc, xc); if (row + stride < row_end) CMB_SLOTS(row + stride); }
    for (; row < row_end; row += stride) {
        const int rn = row + stride;
        if (rn < row_end) { compact4(raw, cn, nn); CMB_DATA(rn, cn, nn, mn, xn); if (rn + stride < row_end) CMB_SLOTS(rn + stride); }
        float y[16];
#pragma unroll
        for (int j = 0; j < 16; ++j) y[j] = 0.f;
        if (nc <= 4) {
#pragma unroll
            for (int k = 0; k < 4; ++k)
                if (k < nc) {
#pragma unroll
                    for (int hlf = 0; hlf < 2; ++hlf) { const f32x4 a = f8x4_f32(mc[k][hlf].x), b = f8x4_f32(mc[k][hlf].y);
#pragma unroll
                        for (int j = 0; j < 4; ++j) { y[hlf * 8 + j] += a[j]; y[hlf * 8 + 4 + j] += b[j]; } } }
        } else {
            for (int e = 0; e < 16; ++e) { const int sl_ = ldg(p.token_slots() + (size_t)row * 16 + e);
                if (sl_ >= 0) { const unsigned char* yr = (const unsigned char*)p.YE() + (size_t)sl_ * 1024 + lane * 8;
#pragma unroll
                    for (int hlf = 0; hlf < 2; ++hlf) { const u32x2 m = ldg((const u32x2*)(yr + hlf * 512)); const f32x4 a = f8x4_f32(m.x), b = f8x4_f32(m.y);
#pragma unroll
                        for (int j = 0; j < 4; ++j) { y[hlf * 8 + j] += a[j]; y[hlf * 8 + 4 + j] += b[j]; } } } }
        }
        float ss = 0.f;
#pragma unroll
        for (int j = 0; j < 16; ++j) ss += y[j] * y[j];
        ss = wave_sum(ss);
        const float rstd = rsqrtf(ss * (YE_INV * YE_INV / 1024.0f) + RMS_EPS) * YE_INV;
#pragma unroll
        for (int hlf = 0; hlf < 2; ++hlf) { f32x4 xv[2];
#pragma unroll
            for (int q = 0; q < 2; ++q) { const int c0 = hlf * 512 + lane * 8 + q * 4; xv[q] = xc.get(hlf * 2 + q);
#pragma unroll
                for (int j = 0; j < 4; ++j) xv[q][j] += par[1024 + c0 + j] * (y[hlf * 8 + q * 4 + j] * rstd * par[c0 + j]); }
            xrow_store8<!DST_F32>(xdb, row, hlf * 512 + lane * 8, xv[0], xv[1]); }
        nc = nn;
#pragma unroll
        for (int k = 0; k < 4; ++k) { cc[k] = cn[k]; mc[k][0] = mn[k][0]; mc[k][1] = mn[k][1]; }
        xc = xn;
    }
#undef CMB_SLOTS
#undef CMB_DATA
}

constexpr int WQ_WORD0 = 4096;
template <class F> DEV void wq_run(const Params& p, int qidx, int ntasks, char* shm, F&& task) {
    unsigned* ctr = p.bar() + WQ_WORD0 + 64 * qidx;
    volatile int* slot = (volatile int*)(shm + 131072 + 64);
    const int tid = TID();
    int cur = blockIdx.x;
    while (cur < ntasks) {
        unsigned pend = 0u;
        if (tid == 0) pend = atomicAdd(ctr, 1u);
        task(cur);
        __syncthreads();
        if (tid == 0) *slot = (int)gridDim.x + (int)pend;
        __syncthreads();
        cur = *slot;
    }
}

template <int PH> DEV void do_phase(const Params& p, int layer, int is_ctx, int grp, char* shm) {
    const SetDesc sd = make_set(is_ctx, grp);
    if constexpr (PH == -1) phase_prologue(p, shm);
    if constexpr (PH == 0) { if (layer == 0) phase_norm1<false>(p, sd, layer, shm); else phase_norm1<true>(p, sd, layer, shm); }
    if constexpr (PH == 1) phase_proj_a(p, sd, layer, shm);
    const int qbase = ((layer * 3 + (is_ctx ? 0 : grp + 1)) * 13 + (PH < 0 ? 0 : PH)) * 2;
    if constexpr (PH == 2) { wq_run(p, qbase, sd.nsamp * 4 * sd.ntb, shm, [&](int t) { mlstm_stepA_task(p, sd, layer, t, shm); }); if (!(is_ctx && layer == 1)) phase_pool(p, sd); }
    if constexpr (PH == 3) {
        for (int t = blockIdx.x; t < sd.nsamp * 32; t += gridDim.x) mlstm_stepB_task(p, sd, t);
        if (!(is_ctx && layer == 1)) {
            const int nq = (is_ctx ? (CTX / 64) : ROWS) / 2;
            wq_run(p, qbase, sd.nsamp * nq * 4, shm, [&](int t) { na_task(p, sd, layer, t / (nq * 4), (t >> 2) % nq, t & 3, shm); });
        }
    }
    if constexpr (PH == 4) { wq_run(p, qbase, sd.nsamp * 4 * sd.ntb, shm, [&](int t) { mlstm_stepC_task(p, sd, layer, t, shm); }); }
    if constexpr (PH == 5) phase_proj_b(p, sd, layer, shm);
    if constexpr (PH == 6) phase_merge(p, sd, layer, shm);
    if constexpr (PH == 7) phase_outproj(p, sd, layer, shm);
    if constexpr (PH == 8) { if (layer == 0) phase_postmix<false>(p, sd, layer, shm); else phase_postmix<true>(p, sd, layer, shm); }
    if constexpr (PH == 9) { for (int t = blockIdx.x; t < sd.nsamp * 16; t += gridDim.x) topk_task(p, sd, t, shm); }
    if constexpr (PH == 10) phase_moe_gu(p, sd, layer, shm);
    if constexpr (PH == 11) phase_moe_down(p, sd, layer, shm);
    if constexpr (PH == 12) { if (layer == 0) phase_combine<false>(p, sd, layer, shm); else phase_combine<true>(p, sd, layer, shm); }
}

#ifndef CPU_EMU
template <int PH> __global__ void __launch_bounds__(NTHREADS, 2) k_phase(Params p, int layer, int is_ctx, int grp) {
    DYN_LDS(shm);
    do_phase<PH>(p, layer, is_ctx, grp, shm);
}
#ifndef DBL_MASK
#define DBL_MASK 0
#endif
#define RUNPH(PH) do { do_phase<PH>(p, layer, is_ctx, grp, shm); xcd_barrier(bar); if ((DBL_MASK >> (PH)) & 1) { do_phase<PH>(p, layer, is_ctx, grp, shm); xcd_barrier(bar); } } while (0)
__global__ void __launch_bounds__(NTHREADS, 2) k_mega(Params p) {
    DYN_LDS(shm);
    uint4* xbw = (uint4*)(shm + 131072);
    if (threadIdx.x == 0) *xbw = make_uint4(0u, 0u, 0u, 0u);
    __syncthreads();
    XcdBarrier bar = xcd_barrier_post(p.bar(), (volatile LAS unsigned*)xbw);
    do_phase<-1>(p, 0, 0, 0, shm);
    xcd_barrier(bar);
    for (int layer = 0; layer < 2; ++layer)
        for (int si = 0; si <= NG; ++si) {
            const int is_ctx = si == 0 ? 1 : 0, grp = si == 0 ? 0 : si - 1;
            RUNPH(0); RUNPH(1); RUNPH(2);
            if (is_ctx && layer == 1) { do_phase<3>(p, layer, is_ctx, grp, shm); continue; }
            RUNPH(3); RUNPH(4); RUNPH(5); RUNPH(6); RUNPH(7); RUNPH(8); RUNPH(9); RUNPH(10); RUNPH(11);
            do_phase<12>(p, layer, is_ctx, grp, shm);
        }
}
#endif
}

static Params make_params(void* const* d_in, void* d_out, void* d_ws) {
    Params p{};
    p.x = (const float*)d_in[0]; p.c = (const float*)d_in[1]; p.ctx = (const float*)d_in[2]; p.c_ctx = (const float*)d_in[3];
    p.norm_gain = (const float*)d_in[4]; p.ada_w = (const float*)d_in[5]; p.ada_b = (const float*)d_in[6]; p.w_in = (const float*)d_in[7];
    p.gate_bias = (const float*)d_in[8]; p.pool_w = (const float*)d_in[9]; p.pool_scale = (const float*)d_in[10]; p.rpb = (const float*)d_in[11];
    p.w_branch = (const float*)d_in[12]; p.w_out = (const float*)d_in[13]; p.router_w = (const float*)d_in[14];
    p.w_gate = (const float*)d_in[15]; p.w_up = (const float*)d_in[16]; p.w_down = (const float*)d_in[17];
    p.out = (float*)d_out; p.ws = (char*)d_ws;
    return p;
}

#ifdef CPU_EMU
int emu_cfg_B = CFG_B, emu_cfg_ROWS = CFG_ROWS, emu_cfg_CTX = CFG_CTX;
const char* g_dumpdir = "data";
static void* g_ws = nullptr;
static void dump_buf(const char* name, int layer, int is_ctx, int grp, const void* ptr, size_t bytes) {
    char nm[512]; snprintf(nm, sizeof nm, "%s/d_L%d_%s%d_%s.bin", g_dumpdir, layer, is_ctx ? "c" : "g", grp, name);
    FILE* f = fopen(nm, "wb"); fwrite(ptr, 1, bytes, f); fclose(f);
}
static void emu_hook(const Params& p, int layer, int is_ctx, int grp, int ph) {
    const size_t Rn = is_ctx ? RC : RL;
    if (ph == 0) dump_buf("H", layer, is_ctx, grp, p.H(), Rn * 1024 * 2);
    if (ph == 1) dump_buf("PROJ", layer, is_ctx, grp, is_ctx ? p.PROJc() : p.PROJa(), Rn * PWA * 2);
    if (ph == 2) dump_buf("Pb", layer, is_ctx, grp, p.Pb(), Rn * 512 * 2);
    if (ph == 3) dump_buf("Nb", layer, is_ctx, grp, p.Nb(), Rn * 512 * 2);
    if (ph == 4) dump_buf("Mb", layer, is_ctx, grp, p.Mb(), Rn * 512 * 2);
    if (ph == 5) dump_buf("BG", layer, is_ctx, grp, p.BG(), Rn * NBG * 2);
    if (ph == 6) dump_buf("MERGED", layer, is_ctx, grp, p.MERGED(), Rn * 1024 * 2);
    if (ph == 7) dump_buf("Y", layer, is_ctx, grp, p.Y(), Rn * 1024 * 2);
    if (ph == 8) { dump_buf("H2", layer, is_ctx, grp, p.H(), Rn * 1024 * 2); dump_buf("aff", layer, is_ctx, grp, p.aff(), Rn * 16 * 4); }
}
void emu_dump(const char* dir) {
    char nm[512]; snprintf(nm, sizeof nm, "%s/d_mod.bin", dir);
    FILE* f = fopen(nm, "wb"); fwrite((char*)g_ws + WSL.mod, 1, (size_t)2 * (NB + 1) * 6144 * 4, f); fclose(f);
    snprintf(nm, sizeof nm, "%s/d_ctxs.bin", dir);
    f = fopen(nm, "wb"); fwrite((char*)g_ws + WSL.ctxs, 1, (size_t)NB * CTX * 1024 * 2, f); fclose(f);
}
template <int PH> static void emu_run_phase(const Params& p, int layer, int is_ctx, int grp, int nblocks) {
    emu_launch_lambda([=]() { do_phase<PH>(p, layer, is_ctx, grp, emu_blk->smem); }, nblocks, NTHREADS, LDS_BYTES);
    if (PH >= 0) emu_hook(p, layer, is_ctx, grp, PH);
    printf("phase %d layer %d ctx %d grp %d done\n", PH, layer, is_ctx, grp); fflush(stdout);
}
#define LAUNCH_PHASE(PH) emu_run_phase<PH>(p, layer, is_ctx, grp, nblocks)
#else
#define LAUNCH_PHASE(PH) hipLaunchKernelGGL((k_phase<PH>), dim3(nblocks), dim3(NTHREADS), LDS_BYTES, stream, p, layer, is_ctx, grp)
#define SETATTR(PH) (void)hipFuncSetAttribute((const void*)k_phase<PH>, hipFuncAttributeMaxDynamicSharedMemorySize, LDS_BYTES)
#endif

extern "C" void kernel_launch(void* const* d_in, const int* in_sizes, int n_in, void* d_out, int out_size, void* d_ws, size_t ws_size, hipStream_t stream) {
    (void)in_sizes; (void)n_in; (void)out_size;
    if (ws_size < WSL.total) return;
    Params p = make_params(d_in, d_out, d_ws);
#ifdef CPU_EMU
    g_ws = d_ws;
    memset(d_ws, 0xFF, WSL.total);
    memset((char*)d_ws + WSL.bar, 0, 65536);
    const int nblocks = 16;
#else
    const int nblocks = 256;
#if MK_ONE_LAUNCH
    static int grid = 0;
    if (!grid) {
        (void)hipFuncSetAttribute((const void*)k_mega, hipFuncAttributeMaxDynamicSharedMemorySize, LDS_BYTES);
        int dev = 0, cus = 0, per_cu = 0;
        (void)hipGetDevice(&dev);
        (void)hipDeviceGetAttribute(&cus, hipDeviceAttributeMultiprocessorCount, dev);
        (void)hipOccupancyMaxActiveBlocksPerMultiprocessor(&per_cu, (const void*)k_mega, NTHREADS, LDS_BYTES);
        if (per_cu > 1) per_cu = 1;
        grid = cus * per_cu;
        if (grid > 256) grid = 256;
    }
    if (grid <= 0) return;
    (void)hipMemsetAsync(p.bar(), 0, 65536, stream);
    hipLaunchKernelGGL(k_mega, dim3(grid), dim3(NTHREADS), LDS_BYTES, stream, p);
    return;
#else
    static bool attr_done = false;
    if (!attr_done) { SETATTR(-1); SETATTR(0); SETATTR(1); SETATTR(2); SETATTR(3); SETATTR(4); SETATTR(5); SETATTR(6); SETATTR(7); SETATTR(8); SETATTR(9); SETATTR(10); SETATTR(11); SETATTR(12); attr_done = true; }
#endif
#endif
    { const int layer = 0, is_ctx = 0, grp = 0; LAUNCH_PHASE(-1); }
    for (int layer = 0; layer < 2; ++layer)
        for (int si = 0; si <= NG; ++si) {
            const int is_ctx = si == 0 ? 1 : 0, grp = si == 0 ? 0 : si - 1;
            LAUNCH_PHASE(0); LAUNCH_PHASE(1); LAUNCH_PHASE(2); LAUNCH_PHASE(3);
            if (is_ctx && layer == 1) continue;
            LAUNCH_PHASE(4); LAUNCH_PHASE(5); LAUNCH_PHASE(6); LAUNCH_PHASE(7); LAUNCH_PHASE(8); LAUNCH_PHASE(9); LAUNCH_PHASE(10); LAUNCH_PHASE(11); LAUNCH_PHASE(12);
        }
}
```

```cpp
#ifdef CPU_EMU
#include "emu.h"
#define DYN_LDS(p) char* p = emu_blk->smem
#define WAIT_V(n)
#define WAIT_L(n)
#define HIDE(v)
#define CBAR()
#else
#include <hip/hip_runtime.h>
#define DYN_LDS(p) extern __shared__ __attribute__((aligned(16))) char p[]
#define WAIT_V(n) asm volatile("s_waitcnt vmcnt(" #n ")" ::: "memory")
#define WAIT_L(n) asm volatile("s_waitcnt lgkmcnt(" #n ")" ::: "memory")
#define HIDE(v) asm volatile("" : "+v"(v))
#define CBAR() asm volatile("" ::: "memory")
#endif
#include <stdint.h>
#include <stddef.h>

#ifndef CFG_B
#define CFG_B 32
#define CFG_ROWS 32
#define CFG_CTX 256
#define CFG_G 16
#endif
#ifndef MK_ONE_LAUNCH
#define MK_ONE_LAUNCH 1
#endif

#define DEV __device__ __forceinline__
typedef short s16x4 __attribute__((ext_vector_type(4)));
#ifdef CPU_EMU
#define TR16(ptr) emu_tr16((const void*)(ptr))
#else
typedef __attribute__((address_space(3))) s16x4 lds_s16x4;
#define TR16(ptr) __builtin_amdgcn_ds_read_tr16_b64_v4i16((lds_s16x4*)(ptr))
#endif
#ifdef CPU_EMU
#define TID() (threadIdx.x)
#else
#define TID() ({ int t_ = threadIdx.x; asm volatile("" : "+v"(t_)); t_; })
#endif

typedef unsigned short bf16_t;
typedef short bf16x8 __attribute__((ext_vector_type(8)));
typedef float f32x4 __attribute__((ext_vector_type(4)));
typedef unsigned u32x2 __attribute__((ext_vector_type(2)));
typedef unsigned u32x4 __attribute__((ext_vector_type(4)));

namespace {
constexpr int D = 1024, NB = CFG_B, ROWS = CFG_ROWS, SEQ = ROWS * 64, CTX = CFG_CTX, G = CFG_G, NG = NB / G;
constexpr int RL = G * SEQ, RC = NB * CTX, RMAX = RL > RC ? RL : RC;
constexpr int PWA = 3840, NBG = 3072, PWT = PWA + NBG, PWSRC = 6672, C_SPLIT = 3600;
constexpr int C_QM = 0, C_KM = 256, C_PU = 512, C_GM = 1024, C_PADA = 1040, C_F8 = 1280, C_QN = 1280, C_KN = 1792, C_VM = 2304, C_OM = 2816, C_VN = 3328;
constexpr int proj_col(int n) { return n < 512 ? n : n < 1536 ? n + 1792 : n < 1552 ? n - 512 : n < 2064 ? n - 1040 : n < 3088 ? n - 784 : n + 240; }
static_assert(proj_col(512) == C_VM && proj_col(1024) == C_OM && proj_col(1536) == C_GM && proj_col(1552) == C_PU && proj_col(2064) == C_QN && proj_col(2576) == C_KN && proj_col(3088) == C_VN && proj_col(3599) == PWA - 1, "projection column map");
constexpr int NTBL = SEQ / 128, NTBC = CTX / 128;
constexpr int ilog2(int x) { return x <= 1 ? 0 : 1 + ilog2(x >> 1); }
constexpr int LGSEQ = ilog2(SEQ), LGCTX = ilog2(CTX);
static_assert((1 << LGSEQ) == SEQ && (1 << LGCTX) == CTX, "sequence lengths must be powers of two");
constexpr int cdiv(int a, int b) { return (a + b - 1) / b; }
constexpr int RPE_L = cdiv(G * (SEQ / 8), 256) * 256, RPE_C = cdiv(NB * (CTX / 8), 256) * 256, RPE_MAX = RPE_L > RPE_C ? RPE_L : RPE_C;
constexpr int NSLOT = 16 * RPE_MAX;
constexpr int NTHREADS = 512;
constexpr int GT_MAXU = 10;
constexpr int LDS_BYTES = 131072 + 256 + GT_MAXU * 1024;
constexpr int NST_L = G * 4 * 2 * NTBL, NST_C = NB * 4 * 2 * NTBC, NST = NST_L > NST_C ? NST_L : NST_C;
constexpr int NCI = NB * 4 * 2;
constexpr float RMS_EPS = 1e-6f;

struct WsLayout { size_t bar, WinT, WbT, WoT, WguT, WdT, mod, rope, ctxs, xb, PROJc, CiC, Cin_, Cim, H, H8, PROJa, Sst, Cin, Mb, Pb, Nb, Sn, Ssc, Cn, Cm, aff, slot_token, slot_gate, token_slots, HID, YE, BG, MERGED, Y, total; };
constexpr size_t al(size_t x) { return (x + 255) / 256 * 256; }
constexpr size_t smax(size_t a, size_t b) { return a > b ? a : b; }
constexpr WsLayout make_layout() {
    WsLayout L{}; size_t o = 0;
    L.bar = o; o += al(65536);
    L.WinT = o; o += al((size_t)2 * PWT * 1024 * 2);
    L.WbT = o; o += al((size_t)2 * 3 * 1024 * 512 * 2);
    L.WoT = o; o += al((size_t)2 * 1024 * 1024 * 2);
    L.WguT = o; o += al((size_t)2 * 16 * 2048 * 1024);
    L.WdT = o; o += al((size_t)2 * 16 * 1024 * 1024);
    L.mod = o; o += al((size_t)2 * (NB + 1) * 6144 * 4);
    L.rope = o; o += al((size_t)(ROWS + 64) * 16 * 2 * 4);
    L.ctxs = o; o += al((size_t)NB * CTX * 1024 * 2);
    L.xb = o; o += al((size_t)NB * SEQ * 1024 * 2);
    L.PROJc = o; o += al((size_t)RC * PWA * 2);
    L.CiC = o; o += al((size_t)NCI * 8192 * 4);
    L.Cin_ = o; o += al((size_t)NCI * 64 * 4);
    L.Cim = o; o += al((size_t)NCI * 4 * 4);
    L.H = o; o += al((size_t)RMAX * 1024 * 2);
    L.H8 = o; o += al((size_t)RMAX * 1024);
    const size_t x0 = o;
    L.PROJa = o; o += al((size_t)RMAX * PWA * 2);
    L.Sst = o; o += al((size_t)NST * 8192 * 4);
    L.Cin = o; o += al((size_t)NST * 8192 * 2);
    const size_t hid = al((size_t)NSLOT * 1024 * 2);
    o = x0 + smax(o - x0, 2 * hid);
    L.BG = x0; L.HID = x0; L.YE = x0 + hid;
    L.Mb = o; o += al((size_t)RMAX * 512 * 2);
    L.Pb = o; o += al((size_t)RMAX * 512 * 2);
    L.Nb = o; o += al((size_t)RMAX * 512 * 2);
    L.MERGED = L.H; L.Y = L.Mb;
    L.Sn = o; o += al((size_t)NST * 64 * 4);
    L.Ssc = o; o += al((size_t)NST * 4 * 4);
    L.Cn = o; o += al((size_t)NST * 64 * 4);
    L.Cm = o; o += al((size_t)NST * 4 * 4);
    L.aff = o; o += al((size_t)RMAX * 16 * 4);
    L.slot_token = o; o += al((size_t)NSLOT * 4);
    L.slot_gate = o; o += al((size_t)NSLOT * 4);
    L.token_slots = o; o += al((size_t)RMAX * 16 * 4);
    L.total = o;
    return L;
}
constexpr WsLayout WSL = make_layout();
static_assert((size_t)RMAX * NBG * 2 <= (size_t)RMAX * PWA * 2, "BG overlay must fit in PROJa");
static_assert(CFG_B != 32 || WSL.total <= ((size_t)1 << 30), "workspace budget");

struct Params {
    const float *x, *c, *ctx, *c_ctx, *norm_gain, *ada_w, *ada_b, *w_in, *gate_bias, *pool_w, *pool_scale, *rpb, *w_branch, *w_out, *router_w, *w_gate, *w_up, *w_down;
    float* out;
    char* ws;
#ifdef CPU_EMU
#define WSF(T, name) __device__ __host__ __forceinline__ T* name() const { return (T*)(ws + WSL.name); }
#else
#if defined(__HIP_DEVICE_COMPILE__)
#define WSF(T, name) __device__ __host__ __forceinline__ T* name() const { char* w_ = ws; asm volatile("" : "+s"(w_)); return (T*)(__attribute__((address_space(1))) T*)(w_ + WSL.name); }
#else
#define WSF(T, name) __device__ __host__ __forceinline__ T* name() const { return (T*)(ws + WSL.name); }
#endif
#endif
    WSF(unsigned, bar) WSF(bf16_t, WinT) WSF(bf16_t, WbT) WSF(bf16_t, WoT) WSF(bf16_t, WguT) WSF(bf16_t, WdT)
    WSF(float, mod) WSF(float, rope) WSF(bf16_t, ctxs) WSF(bf16_t, xb) WSF(bf16_t, PROJc) WSF(float, CiC) WSF(float, Cin_) WSF(float, Cim)
    WSF(bf16_t, H) WSF(unsigned char, H8) WSF(bf16_t, PROJa) WSF(float, Sst) WSF(bf16_t, Cin) WSF(bf16_t, Mb) WSF(bf16_t, Pb) WSF(bf16_t, Nb)
    WSF(float, Sn) WSF(float, Ssc) WSF(float, Cn) WSF(float, Cm) WSF(float, aff) WSF(int, slot_token) WSF(float, slot_gate) WSF(int, token_slots)
    WSF(bf16_t, HID) WSF(bf16_t, YE) WSF(bf16_t, BG) WSF(bf16_t, MERGED) WSF(bf16_t, Y)
#undef WSF
};

struct SetDesc { int is_ctx, nrows, samp0, nsamp, lgseq, ntb, cap, rpe; };
DEV SetDesc make_set(int is_ctx, int grp) {
    SetDesc s;
    s.is_ctx = is_ctx;
    if (is_ctx) { s.nrows = RC; s.samp0 = 0; s.nsamp = NB; s.lgseq = LGCTX; s.ntb = NTBC; s.cap = CTX / 8; s.rpe = RPE_C; }
    else { s.nrows = RL; s.samp0 = grp * G; s.nsamp = G; s.lgseq = LGSEQ; s.ntb = NTBL; s.cap = SEQ / 8; s.rpe = RPE_L; }
    return s;
}

#ifdef CPU_EMU
#define GAS
#else
#define GAS __attribute__((address_space(1)))
#endif
template <class T> DEV T ldg(const T* p) { return *(const GAS T*)p; }
template <class T> DEV void stg(T* p, const T& v) { *(GAS T*)p = v; }
DEV float bf2f(bf16_t v) { return __uint_as_float(((unsigned)v) << 16); }
DEV bf16_t f2bf(float f) { unsigned u = __float_as_uint(f); u += 0x7FFFu + ((u >> 16) & 1u); return (bf16_t)(u >> 16); }
#if defined(__HIP_DEVICE_COMPILE__)
typedef __bf16 bf16n2 __attribute__((ext_vector_type(2)));
typedef float f32n2 __attribute__((ext_vector_type(2)));
DEV unsigned pack2(float lo, float hi) { f32n2 v = {lo, hi}; bf16n2 r = __builtin_convertvector(v, bf16n2); return __builtin_bit_cast(unsigned, r); }
#else
DEV unsigned pack2(float lo, float hi) { return (unsigned)f2bf(lo) | ((unsigned)f2bf(hi) << 16); }
#endif
DEV float lo16(unsigned u) { return __uint_as_float(u << 16); }
DEV float hi16(unsigned u) { return __uint_as_float(u & 0xFFFF0000u); }
#if defined(__HIP_DEVICE_COMPILE__)
DEV float frcp(float x) { return __builtin_amdgcn_rcpf(x); }
#else
DEV float frcp(float x) { return 1.0f / x; }
#endif
#if defined(__HIP_DEVICE_COMPILE__)
DEV float sigmoidf_(float x) { return __builtin_amdgcn_rcpf(1.0f + __expf(-x)); }
#else
DEV float sigmoidf_(float x) { return 1.0f / (1.0f + __expf(-x)); }
#endif
DEV float logsigmoidf_(float x) { return fminf(x, 0.0f) - __logf(1.0f + __expf(-fabsf(x))); }
template <int M> DEV float shx(float v) {
#if defined(__HIP_DEVICE_COMPILE__)
    const unsigned u = __builtin_bit_cast(unsigned, v);
    if constexpr (M == 1) return __builtin_bit_cast(float, __builtin_amdgcn_update_dpp(u, u, 0xB1, 0xF, 0xF, false));
    else if constexpr (M == 2) return __builtin_bit_cast(float, __builtin_amdgcn_update_dpp(u, u, 0x4E, 0xF, 0xF, false));
    else if constexpr (M == 4) { const unsigned t = __builtin_amdgcn_update_dpp(u, u, 0x141, 0xF, 0xF, false);
        return __builtin_bit_cast(float, __builtin_amdgcn_update_dpp(t, t, 0x1B, 0xF, 0xF, false)); }
    else if constexpr (M == 8) return __builtin_bit_cast(float, __builtin_amdgcn_update_dpp(u, u, 0x128, 0xF, 0xF, false));
    else if constexpr (M == 16) { const auto r = __builtin_amdgcn_permlane16_swap(u, u, false, false); return __builtin_bit_cast(float, (threadIdx.x & 16) ? r[0] : r[1]); }
    else { const auto r = __builtin_amdgcn_permlane32_swap(u, u, false, false); return __builtin_bit_cast(float, (threadIdx.x & 32) ? r[0] : r[1]); }
#else
    return __shfl_xor(v, M);
#endif
}
DEV float wave_sum(float v) { v += shx<32>(v); v += shx<16>(v); v += shx<8>(v); v += shx<4>(v); v += shx<2>(v); v += shx<1>(v); return v; }
DEV bf16x8 mk8(u32x2 lo, u32x2 hi) { u32x4 v = {lo.x, lo.y, hi.x, hi.y}; return __builtin_bit_cast(bf16x8, v); }
DEV bf16x8 mk8(u32x4 v) { return __builtin_bit_cast(bf16x8, v); }
DEV bf16x8 mk8(s16x4 lo, s16x4 hi) { return __builtin_shufflevector(lo, hi, 0, 1, 2, 3, 4, 5, 6, 7); }
DEV f32x4 mfma16(bf16x8 a, bf16x8 b, f32x4 c) { return __builtin_amdgcn_mfma_f32_16x16x32_bf16(a, b, c, 0, 0, 0); }
DEV unsigned f8enc1(float x) {
    const unsigned sgn = x < 0.f ? 0x80u : 0u; float a = x < 0.f ? -x : x; if (!(a < 448.f)) a = 448.f;
    if (a < 0.015625f) { const int q = (int)(a * 512.f + 0.5f); const float r = a * 512.f; int qq = q; if ((float)q - r == 0.5f && (q & 1)) qq = q - 1; return sgn | (unsigned)qq; }
    int e = 0; float m = a; while (m >= 2.f) { m *= 0.5f; ++e; } while (m < 1.f) { m *= 2.f; --e; }
    const float r = (m - 1.f) * 8.f; int q = (int)(r + 0.5f); if ((float)q - r == 0.5f && (q & 1)) --q;
    if (q == 8) { q = 0; ++e; }
    return sgn | (unsigned)((e + 7) << 3) | (unsigned)q;
}
#if defined(__HIP_DEVICE_COMPILE__)
DEV unsigned f8pack4(float a, float b, float c, float d) {
    a = __builtin_amdgcn_fmed3f(a, -448.f, 448.f); b = __builtin_amdgcn_fmed3f(b, -448.f, 448.f); c = __builtin_amdgcn_fmed3f(c, -448.f, 448.f); d = __builtin_amdgcn_fmed3f(d, -448.f, 448.f);
    int w = 0; w = __builtin_amdgcn_cvt_pk_fp8_f32(a, b, w, false); w = __builtin_amdgcn_cvt_pk_fp8_f32(c, d, w, true); return (unsigned)w; }
#else
DEV unsigned f8pack4(float a, float b, float c, float d) { return f8enc1(a) | (f8enc1(b) << 8) | (f8enc1(c) << 16) | (f8enc1(d) << 24); }
#endif
DEV float f8dec1(unsigned v) {
    const unsigned e = (v >> 3) & 15u, m = v & 7u; float r = e == 0 ? (float)m * (1.0f / 512.0f) : __uint_as_float(((e + 120u) << 23) | (m << 20));
    return (v & 0x80u) ? -r : r;
}
#if defined(__HIP_DEVICE_COMPILE__)
DEV f32x4 f8x4_f32(unsigned w) { const auto lo = __builtin_amdgcn_cvt_pk_f32_fp8((int)w, false), hi = __builtin_amdgcn_cvt_pk_f32_fp8((int)w, true); return (f32x4){lo[0], lo[1], hi[0], hi[1]}; }
#else
DEV f32x4 f8x4_f32(unsigned w) { return (f32x4){f8dec1(w & 255u), f8dec1((w >> 8) & 255u), f8dec1((w >> 16) & 255u), f8dec1(w >> 24)}; }
#endif
constexpr float YE_SCALE = 32.0f, YE_INV = 1.0f / 32.0f;
#ifdef CPU_EMU
DEV f32x4 mfma_f8(bf16x8 a0, bf16x8 a1, bf16x8 b0, bf16x8 b1, f32x4 c) { return emu_mfma_f8(a0, a1, b0, b1, c); }
#else
typedef int i32x4 __attribute__((ext_vector_type(4)));
typedef int i32x8 __attribute__((ext_vector_type(8)));
DEV f32x4 mfma_f8(bf16x8 a0, bf16x8 a1, bf16x8 b0, bf16x8 b1, f32x4 c) {
    const i32x8 A = __builtin_shufflevector(__builtin_bit_cast(i32x4, a0), __builtin_bit_cast(i32x4, a1), 0, 1, 2, 3, 4, 5, 6, 7);
    const i32x8 B = __builtin_shufflevector(__builtin_bit_cast(i32x4, b0), __builtin_bit_cast(i32x4, b1), 0, 1, 2, 3, 4, 5, 6, 7);
    return __builtin_amdgcn_mfma_scale_f32_16x16x128_f8f6f4(A, B, c, 0, 0, 0, 0, 0, 0);
}
#endif
constexpr float F8_WSCALE = 64.0f, F8_WINV = 1.0f / 64.0f;
DEV void store8bf(bf16_t* o, f32x4 a, f32x4 b) { u32x4 v = {pack2(a[0], a[1]), pack2(a[2], a[3]), pack2(b[0], b[1]), pack2(b[2], b[3])}; stg((u32x4*)o, v); }

#ifndef CPU_EMU
#define XB_TMO      128
#define XB_XCNT(j)  (256  + 64 * (j))
#define XB_XSUB(j)  (1280 + 64 * (j))
#define XB_XGEN(j)  (2304 + 64 * (j))
#define XB_TOP      3328
#define XB_TOPGEN   3392
#define XCD_BAR_WORDS 3456
#define XB_SPIN_CAP (1u << 18)
#define LAS __attribute__((address_space(3)))
__device__ __forceinline__ unsigned xb_ld(unsigned* p)              { return __hip_atomic_load(p, __ATOMIC_RELAXED, __HIP_MEMORY_SCOPE_AGENT); }
__device__ __forceinline__ unsigned xb_add(unsigned* p, unsigned v) { return __hip_atomic_fetch_add(p, v, __ATOMIC_RELAXED, __HIP_MEMORY_SCOPE_AGENT); }
__device__ __forceinline__ unsigned xb_xcc_id() { return (unsigned)__builtin_amdgcn_s_getreg((3 << 11) | 20) & 0xFu; }
#define XB_SPIN(cond, bar) do { unsigned _sp = 0; while (cond) { __builtin_amdgcn_s_sleep(1); \
    if ((++_sp & 255u) == 0u) { if (xb_ld(&(bar)[XB_TMO])) break; if (_sp > XB_SPIN_CAP) { atomicAdd(&(bar)[XB_TMO], 1u); break; } } } } while (0)
struct XcdBarrier { unsigned* bar; unsigned x; volatile LAS unsigned* st; };
__device__ __forceinline__ XcdBarrier xcd_barrier_post(unsigned* bar, volatile LAS unsigned* st) {
    XcdBarrier b; b.bar = bar; b.x = xb_xcc_id(); b.st = st;
    if (threadIdx.x == 0) (void)xb_add(&bar[XB_XCNT(b.x)], 1u);
    return b;
}
__device__ __forceinline__ void xcd_barrier_complete(unsigned* bar, unsigned x, unsigned& nloc, unsigned& nx) {
    const unsigned Gd = gridDim.x * gridDim.y * gridDim.z;
    unsigned sum, cnt, mine, sp = 0u;
    for (;;) {
        sum = 0u; cnt = 0u; mine = 0u;
#pragma unroll
        for (unsigned j = 0; j < 16; ++j) { const unsigned c = xb_ld(&bar[XB_XCNT(j)]); sum += c; cnt += (c > 0u) ? 1u : 0u; mine = (j == x) ? c : mine; }
        if (sum == Gd) break;
        __builtin_amdgcn_s_sleep(1);
        if ((++sp & 255u) == 0u) { if (xb_ld(&bar[XB_TMO])) break; if (sp > XB_SPIN_CAP) { atomicAdd(&bar[XB_TMO], 1u); break; } }
    }
    nloc = mine > 0u ? mine : 1u; nx = cnt > 0u ? cnt : 1u;
}
__device__ __forceinline__ void xcd_barrier(const XcdBarrier& b) {
    asm volatile("s_waitcnt vmcnt(0)" ::: "memory");
    __syncthreads();
    if (threadIdx.x == 0) {
        unsigned* bar = b.bar;
        unsigned bx = b.x; asm volatile("" : "+s"(bx));
        __builtin_amdgcn_s_waitcnt(0);
        unsigned nloc = b.st[0], nx = b.st[1];
        if (nloc == 0u) { xcd_barrier_complete(bar, bx, nloc, nx); b.st[0] = nloc; b.st[1] = nx; }
        const unsigned old = xb_add(&bar[XB_XSUB(bx)], 1u);
        const unsigned gen = old / nloc;
        if (old + 1u == (gen + 1u) * nloc) {
            __builtin_amdgcn_fence(__ATOMIC_RELEASE, "agent");
            asm volatile("s_waitcnt vmcnt(0)" ::: "memory");
            const unsigned og = xb_add(&bar[XB_TOP], 1u);
            const unsigned tg = og / nx;
            if (og + 1u == (tg + 1u) * nx) xb_add(&bar[XB_TOPGEN], 1u);
            else XB_SPIN(xb_ld(&bar[XB_TOPGEN]) == tg, bar);
            __builtin_amdgcn_fence(__ATOMIC_ACQUIRE, "agent");
            xb_add(&bar[XB_XGEN(bx)], 1u);
            asm volatile("s_waitcnt vmcnt(0)" ::: "memory");
        } else {
            XB_SPIN(xb_ld(&bar[XB_XGEN(bx)]) == gen, bar);
            __builtin_amdgcn_fence(__ATOMIC_ACQUIRE, "agent");
            asm volatile("s_waitcnt vmcnt(0)" ::: "memory");
        }
    }
    __syncthreads();
}
#endif

constexpr int BK = 64, HALF = 128, HT_BYTES = HALF * BK * 2;
DEV int lds_byte(int r, int c) { int st = (r >> 4) * 2 + (c >> 5), rr = r & 15, cc = c & 31, ob = rr * 64 + cc * 2; return st * 1024 + (ob ^ (((ob >> 9) & 1) << 5)); }
DEV void stage_rc(int b, int& Rr, int& Cc) { int st = b / 1024, sb = b % 1024, swz = sb ^ (((sb >> 9) & 1) << 5); Rr = (st >> 1) * 16 + swz / 64; Cc = (st & 1) * 32 + (swz % 64) / 2; }
DEV int perm32(int rho) { const int n = rho >> 4, i = rho & 15; return 8 * (i >> 2) + 4 * n + (i & 3); }

DEV bool tile_from_L(int L, int nM, int nN, int& pm, int& pn) {
    const int nwg = nM * nN; if (L >= nwg) return false;
    int wgid = L; { const int q = nwg / 8, r = nwg % 8, xcd = wgid % 8, off = wgid / 8; wgid = (xcd < r ? xcd * (q + 1) : r * (q + 1) + (xcd - r) * q) + off; }
    const int nig = 8 * nN, gid = wgid / nig, fm = gid * 8, gsz = (nM - fm) < 8 ? (nM - fm) : 8;
    pm = fm + ((wgid % nig) % gsz); pn = (wgid % nig) / gsz; return true;
}
DEV bool tile_order(int i, int nM, int nN, int& pm, int& pn) { return tile_from_L(i * (int)gridDim.x + (int)blockIdx.x, nM, nN, pm, pn); }
#ifdef CPU_EMU
#define GLDS16(src, dst) __builtin_amdgcn_global_load_lds((const unsigned*)(src), (unsigned*)((dst) + (TID() & 63) * 16), 16, 0, 0)
#else
#define GLDS16(src, dst) __builtin_amdgcn_global_load_lds((const unsigned*)(src), (unsigned*)(dst), 16, 0, 0)
#endif

#define BAR __builtin_amdgcn_s_barrier()
#define SCHED __builtin_amdgcn_sched_barrier(0)
struct GUnit { int pm, pn, aux; };
template <class T> struct is_void_ { static constexpr bool v = false; };
template <> struct is_void_<void> { static constexpr bool v = true; };
template <class Epi> DEV bool call_epi(const Epi& e, const GUnit& u, f32x4 (&acc)[2][2][4][2], int r0, int c0) {
    if constexpr (is_void_<decltype(e(u, acc, r0, c0))>::v) { e(u, acc, r0, c0); return false; } else return e(u, acc, r0, c0);
}
template <bool GATHER, int LDA_, int LDB_, int K_, bool F8 = false, class Sched, class Epi>
DEV void gemm_stream(char* shm, const Sched& S, const Epi& epi) {
#define SA(b, h) (shm + ((b) * 2 + (h)) * HT_BYTES)
#define SB(b, h) (shm + (4 + (b) * 2 + (h)) * HT_BYTES)
#define STG_B(P, bp) do { GLDS16((bp) + voffB, (P) + ldsb0); GLDS16((bp) + voffB + 64 * LDB_, (P) + ldsb0 + 8192); } while (0)
#define STG_A(P, ap, h, gv) do { if (GATHER) { GLDS16((ap) + gv[h][0], (P) + ldsb0); GLDS16((ap) + gv[h][1], (P) + ldsb0 + 8192); } \
    else { GLDS16((ap) + voffA + (h) * 128 * LDA_, (P) + ldsb0); GLDS16((ap) + voffA + ((h) * 128 + 64) * LDA_, (P) + ldsb0 + 8192); } } while (0)
#define LDA(dst, b, h) _Pragma("unroll") for (int m = 0; m < 4; ++m) _Pragma("unroll") for (int k = 0; k < 2; ++k) \
    dst[m][k] = *reinterpret_cast<const bf16x8*>(SA(b, h) + aoff + m * 2048 + k * 1024)
#define LDB(dst, b, h) _Pragma("unroll") for (int n = 0; n < 2; ++n) _Pragma("unroll") for (int k = 0; k < 2; ++k) \
    dst[n][k] = *reinterpret_cast<const bf16x8*>(SB(b, h) + boff + n * 2048 + k * 1024)
#define MMA(ai, bj, At_, Bx_) do { __builtin_amdgcn_s_setprio(1); \
    if constexpr (F8) { _Pragma("unroll") for (int m = 0; m < 4; ++m) _Pragma("unroll") for (int n = 0; n < 2; ++n) \
      acc[ai][bj][m][n] = mfma_f8(Bx_[n][0], Bx_[n][1], At_[m][0], At_[m][1], acc[ai][bj][m][n]); } \
    else { _Pragma("unroll") for (int m = 0; m < 4; ++m) _Pragma("unroll") for (int n = 0; n < 2; ++n) _Pragma("unroll") for (int k = 0; k < 2; ++k) \
      acc[ai][bj][m][n] = mfma16(Bx_[n][k], At_[m][k], acc[ai][bj][m][n]); } \
    __builtin_amdgcn_s_setprio(0); } while (0)
    constexpr int nt = K_ / BK;
    const int tid = TID();
    const int wid = __builtin_amdgcn_readfirstlane(tid >> 6), lane = tid & 63, wr = wid >> 2, wc = wid & 3, fr = lane & 15, fq = lane >> 4;
    const int ldsb0 = wid * 1024;
    int Rr0, Cc0; stage_rc(tid * 16, Rr0, Cc0);
    const int voffA = Rr0 * LDA_ + Cc0;
    const int voffB = ((Rr0 & ~31) + perm32(Rr0 & 31)) * LDB_ + Cc0;
    const int aoff = lds_byte(wr * 64 + fr, fq * 8), boff = lds_byte(wc * 32 + fr, fq * 8);
    GUnit cur, nxt; int ui = 0;
    if (!S.next(0, cur)) return;
    int gc[2][2] = {{0, 0}, {0, 0}};
    int* gtab = (int*)(shm + 131072 + 256);
    if (GATHER) {
        __syncthreads();
        { GUnit u; for (int i = 0; i < GT_MAXU && S.next(i, u); ++i) { if (tid < 256) gtab[i * 256 + tid] = S.grow(u, tid) * LDA_; } }
        __syncthreads();
#pragma unroll
        for (int h = 0; h < 2; ++h)
#pragma unroll
            for (int i = 0; i < 2; ++i) gc[h][i] = gtab[h * 128 + i * 64 + Rr0] + Cc0;
    }
    f32x4 acc[2][2][4][2];
#pragma unroll
    for (int a = 0; a < 2; ++a)
#pragma unroll
        for (int b = 0; b < 2; ++b)
#pragma unroll
            for (int m = 0; m < 4; ++m)
#pragma unroll
                for (int n = 0; n < 2; ++n) acc[a][b][m][n] = (f32x4){0.f, 0.f, 0.f, 0.f};
    bf16x8 At[4][2], B0[2][2], B1[2][2];
    const bf16_t* cA = S.a_base(cur); const bf16_t* cB = S.b_base(cur);
    STG_B(SB(0, 0), cB); STG_A(SA(0, 0), cA, 0, gc); STG_B(SB(0, 1), cB + 128 * LDB_); STG_A(SA(0, 1), cA, 1, gc);
    if (wr == 1) BAR;
    WAIT_V(4); BAR;
    STG_B(SB(1, 0), cB + BK); STG_A(SA(1, 0), cA + BK, 0, gc); STG_B(SB(1, 1), cB + 128 * LDB_ + BK);
    WAIT_V(6); BAR;
    for (;;) {
        const bool has_next = S.next(ui + 1, nxt);
        const bf16_t* nA = has_next ? S.a_base(nxt) : cA; const bf16_t* nB = has_next ? S.b_base(nxt) : cB;
#pragma unroll 1
        for (int t = 0; t < nt; t += 2) {
            const bool last = (t == nt - 2);
            const bf16_t* a1 = cA + (t + 1) * BK;
            const bf16_t* a2 = last ? nA : cA + (t + 2) * BK; const bf16_t* b2 = last ? nB : cB + (t + 2) * BK;
            const bf16_t* a3 = a2 + BK; const bf16_t* b3 = b2 + BK;
            LDB(B0, 0, 0); SCHED; LDA(At, 0, 0); STG_A(SA(1, 1), a1, 1, gc);
            if (GATHER && last && has_next) {
#pragma unroll
                for (int h = 0; h < 2; ++h)
#pragma unroll
                    for (int i = 0; i < 2; ++i) gc[h][i] = gtab[(ui + 1) * 256 + h * 128 + i * 64 + Rr0] + Cc0; }
            WAIT_L(8); BAR; WAIT_L(0); MMA(0, 0, At, B0); BAR; SCHED;
            LDB(B1, 0, 1); STG_B(SB(0, 0), b2);
            BAR; WAIT_L(0); MMA(0, 1, At, B1); BAR;
            LDA(At, 0, 1); STG_A(SA(0, 0), a2, 0, gc);
            BAR; WAIT_L(0); MMA(1, 0, At, B0); BAR; SCHED;
            STG_B(SB(0, 1), b2 + 128 * LDB_);
            WAIT_V(6); BAR; MMA(1, 1, At, B1); BAR;
            LDB(B0, 1, 0); SCHED; LDA(At, 1, 0); STG_A(SA(0, 1), a2, 1, gc);
            WAIT_L(8); BAR; WAIT_L(0); MMA(0, 0, At, B0); BAR; SCHED;
            LDB(B1, 1, 1); STG_B(SB(1, 0), b3);
            BAR; WAIT_L(0); MMA(0, 1, At, B1); BAR;
            LDA(At, 1, 1); STG_A(SA(1, 0), a3, 0, gc);
            BAR; WAIT_L(0); MMA(1, 0, At, B0); BAR; SCHED;
            STG_B(SB(1, 1), b3 + 128 * LDB_);
            WAIT_V(6); BAR; MMA(1, 1, At, B1); BAR;
        }
        bool keep = false;
        {
            const int tz = TID(); const int wz = tz >> 6, lz = tz & 63, wrz = wz >> 2, wcz = wz & 3, frz = lz & 15, fqz = lz >> 4;
            keep = call_epi(epi, cur, acc, wrz * 64 + frz, wcz * 32 + 8 * fqz);
        }
        if (!has_next) break;
        if (!keep) {
#pragma unroll
            for (int a = 0; a < 2; ++a)
#pragma unroll
                for (int b = 0; b < 2; ++b)
#pragma unroll
                    for (int m = 0; m < 4; ++m)
#pragma unroll
                        for (int n = 0; n < 2; ++n) acc[a][b][m][n] = (f32x4){0.f, 0.f, 0.f, 0.f};
        }
        cur = nxt; cA = nA; cB = nB; ++ui;
    }
    WAIT_V(0);
    if (wr == 0) BAR;
    BAR;
#undef SA
#undef SB
#undef STG_A
#undef STG_B
#undef LDA
#undef LDB
#undef MMA
}

constexpr int J_IN = 16 * 27, J_WB = 2 * 8 * 4, J_WO = 16 * 4, J_GU = 16 * 2 * 64, J_DN = 16 * 64, J_FOLD = 8 * 16, J_PAD = 1;
constexpr int N_MODJOBS = 2 * 96;

constexpr int J_BIG = J_IN + J_WB + J_WO + J_GU + J_DN;
struct WJob { const float* src; bf16_t* dst; int ldsrc, lddst, nvalid, k0, n0, mode, gu_which, f8; };
DEV WJob wjob_decode(const Params& p, int l, int j) {
    WJob w; w.ldsrc = 1024; w.lddst = 1024; w.nvalid = 256; w.mode = 0; w.gu_which = 0; w.f8 = 0;
    if (j < J_IN) { const int kt = j / 27, nb = j % 27; w.k0 = kt * 64; w.n0 = nb * 256; w.src = p.w_in + (size_t)l * 1024 * PWSRC; w.ldsrc = PWSRC; w.nvalid = PWSRC - w.n0; w.dst = p.WinT() + (size_t)l * PWT * 1024; w.mode = 3; }
    else if ((j -= J_IN) < J_WB) { const int bi = (j / 32) * 2, jj = j % 32, kt = jj / 4, nb = jj % 4; w.k0 = kt * 64; w.n0 = nb * 256;
        w.src = p.w_branch + ((size_t)l * 3 + bi) * 512 * 1024; w.dst = p.WbT() + ((size_t)l * 3 + bi) * 1024 * 512; w.lddst = 512; }
    else if ((j -= J_WB) < J_WO) { const int kt = j / 4, nb = j % 4; w.k0 = kt * 64; w.n0 = nb * 256; w.src = p.w_out + (size_t)l * 1024 * 1024; w.dst = p.WoT() + (size_t)l * 1024 * 1024; }
    else if ((j -= J_WO) < J_GU) { const int e = j / 128, jj = j % 128; w.gu_which = jj / 64; const int j3 = jj % 64, kt = j3 / 4, nb = j3 % 4; w.k0 = kt * 64; w.n0 = nb * 256;
        w.src = (w.gu_which ? p.w_up : p.w_gate) + ((size_t)l * 16 + e) * 1024 * 1024; w.dst = p.WguT() + ((size_t)l * 16 + e) * 2048 * 512; w.mode = 1; w.f8 = 1; }
    else { j -= J_GU; const int e = j / 64, jj = j % 64, kt = jj / 4, nb = jj % 4; w.k0 = kt * 64; w.n0 = nb * 256;
        w.src = p.w_down + ((size_t)l * 16 + e) * 1024 * 1024; w.dst = p.WdT() + ((size_t)l * 16 + e) * 1024 * 512; w.f8 = 1; }
    return w;
}
constexpr int WT_LD = 260;
DEV void wjob_load(const WJob& w, int tid, f32x4 (&vv)[8]) {
#pragma unroll
    for (int i = 0; i < 8; ++i) { const int idx = i * 512 + tid, r = idx >> 6, c = (idx & 63) * 4; int col = w.n0 + c; col = col > w.ldsrc - 4 ? w.ldsrc - 4 : col;
        vv[i] = ldg((const f32x4*)(w.src + (size_t)(w.k0 + r) * w.ldsrc + col)); }
}
DEV void wjob_finish(const WJob& w, int tid, const f32x4 (&vv)[8], float* tile) {
    __syncthreads();
#pragma unroll
    for (int i = 0; i < 8; ++i) { const int idx = i * 512 + tid, r = idx >> 6, c = (idx & 63) * 4; *(f32x4*)(tile + r * WT_LD + c) = vv[i]; }
    __syncthreads();
#pragma unroll
    for (int q = 0; q < 4; ++q) {
        const int item = q * 512 + tid, nrow = item >> 3, kc = (item & 7) * 8;
        float v[8];
#pragma unroll
        for (int jj = 0; jj < 8; ++jj) v[jj] = tile[(kc + jj) * WT_LD + nrow];
        const int n = w.n0 + nrow;
        int drow = n; bool f8 = w.f8 != 0; size_t f8base = 0;
        if (w.mode == 1) drow = (n >> 7) * 256 + w.gu_which * 128 + (n & 127);
        if (w.mode == 3) {
            if (n >= C_SPLIT) { f8 = true; f8base = (size_t)PWA * 2048; drow = n - C_SPLIT; }
            else { drow = proj_col(n); if (drow >= C_F8) { f8 = true; f8base = (size_t)C_F8 * 2048; drow -= C_F8; } } }
        if (f8) { const u32x2 o = {f8pack4(v[0] * F8_WSCALE, v[1] * F8_WSCALE, v[2] * F8_WSCALE, v[3] * F8_WSCALE), f8pack4(v[4] * F8_WSCALE, v[5] * F8_WSCALE, v[6] * F8_WSCALE, v[7] * F8_WSCALE)};
            if (nrow < w.nvalid) stg((u32x2*)((unsigned char*)w.dst + f8base + (size_t)drow * 1024 + w.k0 + kc), o); }
        else if (nrow < w.nvalid) { u32x4 o = {pack2(v[0], v[1]), pack2(v[2], v[3]), pack2(v[4], v[5]), pack2(v[6], v[7])};
            stg((u32x4*)(w.dst + (size_t)drow * w.lddst + w.k0 + kc), o); }
    }
}
DEV void pro_small_job(const Params& p, int l, int j, char* shm) {
    float* tile = (float*)shm;
    const int tid = TID();
    if (j < J_FOLD) {
        const int kt = j / 16, ntl = j % 16, k0 = kt * 64, n0 = ntl * 64; const int fg = k0 / 128;
        const float* wb1 = p.w_branch + ((size_t)l * 3 + 1) * 512 * 1024;
        const float* pw = p.pool_w + ((size_t)l * 4 + fg) * 128 * 128; const float* ps = p.pool_scale + (size_t)l * 512 + fg * 128;
        const int c = tid & 63, rq = tid >> 6;
        float accv[8];
#pragma unroll
        for (int i = 0; i < 8; ++i) accv[i] = 0.f;
        for (int d = 0; d < 128; ++d) { const float wv = ldg(wb1 + (size_t)(fg * 128 + d) * 1024 + n0 + c) * ldg(ps + d);
#pragma unroll
            for (int i = 0; i < 8; ++i) accv[i] += ldg(pw + (size_t)(k0 - fg * 128 + rq * 8 + i) * 128 + d) * wv; }
        __syncthreads();
#pragma unroll
        for (int i = 0; i < 8; ++i) tile[(rq * 8 + i) * WT_LD + c] = accv[i];
        __syncthreads();
        const int nrow = tid >> 3, kc = (tid & 7) * 8; float v[8];
#pragma unroll
        for (int jj = 0; jj < 8; ++jj) v[jj] = tile[(kc + jj) * WT_LD + nrow];
        u32x4 o = {pack2(v[0], v[1]), pack2(v[2], v[3]), pack2(v[4], v[5]), pack2(v[6], v[7])};
        stg((u32x4*)(p.WbT() + ((size_t)l * 3 + 1) * 1024 * 512 + (size_t)(n0 + nrow) * 512 + k0 + kc), o);
    } else {
        bf16_t* d0 = p.WinT() + (size_t)l * PWT * 1024 + (size_t)C_PADA * 1024;
        for (int i = tid; i < (C_F8 - C_PADA) * 1024 / 8; i += NTHREADS) stg((u32x4*)(d0 + (size_t)i * 8), (u32x4){0u, 0u, 0u, 0u});
    }
}

DEV void pro_mod_job(const Params& p, int job, char* shm) {
    float* sv = (float*)shm;
    const int tid = TID(), l = job / 96, col0 = (job % 96) * 64;
    const int c = tid & 63, kp = tid >> 6;
    float acc[NB + 1];
#pragma unroll
    for (int v = 0; v <= NB; ++v) acc[v] = 0.f;
    for (int half = 0; half < 2; ++half) {
        __syncthreads();
        for (int idx = tid; idx < (NB + 1) * 512; idx += 512) { const int v = idx >> 9, k = idx & 511;
            const float s = (v < NB) ? ldg(p.c + (size_t)v * 1024 + half * 512 + k) : ldg(p.c_ctx + half * 512 + k);
            sv[idx] = s * sigmoidf_(s); }
        __syncthreads();
        for (int kk = 0; kk < 64; ++kk) { const int k = kp * 64 + kk;
            const float w = ldg(p.ada_w + ((size_t)l * 1024 + half * 512 + k) * 6144 + col0 + c);
#pragma unroll
            for (int v = 0; v <= NB; ++v) acc[v] += sv[v * 512 + k] * w; }
    }
    __syncthreads();
    float* red = (float*)shm;
#pragma unroll
    for (int v = 0; v <= NB; ++v) red[(kp * (NB + 1) + v) * 64 + c] = acc[v];
    __syncthreads();
    for (int idx = tid; idx < (NB + 1) * 64; idx += 512) { const int v = idx >> 6, cc = idx & 63; float s = 0.f;
#pragma unroll
        for (int q = 0; q < 8; ++q) s += red[(q * (NB + 1) + v) * 64 + cc];
        stg(p.mod() + ((size_t)l * (NB + 1) + v) * 6144 + col0 + cc, s + ldg(p.ada_b + (size_t)l * 6144 + col0 + cc)); }
}

DEV void phase_prologue(const Params& p, char* shm) {
    const int tid = TID();
    const int nsmall = N_MODJOBS + 1 + 2 * (J_FOLD + J_PAD);
    for (int job = blockIdx.x; job < nsmall; job += gridDim.x) {
        if (job < N_MODJOBS) pro_mod_job(p, job, shm);
        else if (job == N_MODJOBS) {
            for (int idx = tid; idx < (ROWS + 64) * 16; idx += NTHREADS) { const int pos = idx >> 4, i = idx & 15;
                const float pv = (float)(pos < ROWS ? pos : pos - ROWS);
                const float inv = powf(10000.0f, -(float)(2 * i) / 32.0f);
                const float a = pv * inv; stg(p.rope() + idx * 2, cosf(a)); stg(p.rope() + idx * 2 + 1, sinf(a)); }
        } else { const int sj = job - N_MODJOBS - 1; pro_small_job(p, sj / (J_FOLD + J_PAD), sj % (J_FOLD + J_PAD), shm); }
    }
    float* tile = (float*)shm;
    const int nbig = 2 * J_BIG;
    int job = blockIdx.x;
    if (job >= nbig) return;
    WJob wc = wjob_decode(p, job / J_BIG, job % J_BIG), wn = wc;
    f32x4 vc[8], vn[8];
    wjob_load(wc, tid, vc);
    for (; job < nbig; job += gridDim.x) {
        const int jn = job + gridDim.x;
        if (jn < nbig) { wn = wjob_decode(p, jn / J_BIG, jn % J_BIG); wjob_load(wn, tid, vn); }
        wjob_finish(wc, tid, vc, tile);
        wc = wn;
#pragma unroll
        for (int i = 0; i < 8; ++i) vc[i] = vn[i];
    }
}

DEV const float* xin_f32(const Params& p, const SetDesc& sd) { return (sd.is_ctx ? p.ctx : p.x) + (((size_t)sd.samp0) << sd.lgseq) * 1024; }
DEV bf16_t* xbf_base(const Params& p, const SetDesc& sd) { return (sd.is_ctx ? p.ctxs() : p.xb()) + (((size_t)sd.samp0) << sd.lgseq) * 1024; }
DEV float* xout_f32(const Params& p, const SetDesc& sd) { return p.out + (((size_t)sd.samp0) << sd.lgseq) * 1024; }
template <bool BF> struct XRow;
template <> struct XRow<false> { f32x4 v[4];
    DEV void load(const void* b, size_t row, int lane) { const float* q = (const float*)b + row * 1024 + lane * 8;
#pragma unroll
        for (int i = 0; i < 4; ++i) v[i] = ldg((const f32x4*)(q + (i >> 1) * 512 + (i & 1) * 4)); }
    DEV f32x4 get(int i) const { return v[i]; } };
template <> struct XRow<true> { u32x4 v[2];
    DEV void load(const void* b, size_t row, int lane) { const bf16_t* q = (const bf16_t*)b + row * 1024 + lane * 8;
#pragma unroll
        for (int h = 0; h < 2; ++h) v[h] = ldg((const u32x4*)(q + h * 512)); }
    DEV f32x4 get(int i) const { const u32x4 m = v[i >> 1]; return (i & 1) ? (f32x4){lo16(m.z), hi16(m.z), lo16(m.w), hi16(m.w)} : (f32x4){lo16(m.x), hi16(m.x), lo16(m.y), hi16(m.y)}; } };
template <bool BF> DEV void xrow_store8(void* b, size_t row, int c0, f32x4 a, f32x4 c) {
    if constexpr (BF) store8bf((bf16_t*)b + row * 1024 + c0, a, c);
    else { float* q = (float*)b + row * 1024 + c0; stg((f32x4*)q, a); stg((f32x4*)(q + 4), c); }
}
DEV const float* mod_row(const Params& p, const SetDesc& sd, int layer, int row) {
    return p.mod() + ((size_t)layer * (NB + 1) + (sd.is_ctx ? NB : sd.samp0 + (row >> sd.lgseq))) * 6144;
}
DEV bf16_t* proj_buf(const Params& p, const SetDesc& sd) { return sd.is_ctx ? p.PROJc() : p.PROJa(); }

DEV void stage_params(float* par, const float* v0, const float* v1, const float* v2, const float* v3, const float* v4) {
    const int tid = TID();
    const float* src[5] = {v0, v1, v2, v3, v4};
#pragma unroll
    for (int k = 0; k < 5; ++k) if (src[k]) { for (int i = tid; i < 1024; i += NTHREADS) par[k * 1024 + i] = ldg(src[k] + i); }
}
template <bool SRC_BF> DEV void phase_norm1(const Params& p, const SetDesc& sd, int layer, char* shm) {
    const int tid = TID(), lane = tid & 63, wv = tid >> 6;
    const float* g0 = p.norm_gain + ((size_t)layer * 4 + 0) * 1024;
    const void* xb = SRC_BF ? (const void*)xbf_base(p, sd) : (const void*)xin_f32(p, sd);
    const int stride = 8; const int rpb_ = (sd.nrows + (int)gridDim.x - 1) / (int)gridDim.x; const int row_end = min(sd.nrows, ((int)blockIdx.x + 1) * rpb_);
    int row = (int)blockIdx.x * rpb_ + wv;
    float* par = (float*)shm;
    __syncthreads();
    { const float* mdb = mod_row(p, sd, layer, min((int)blockIdx.x * rpb_, sd.nrows - 1)); stage_params(par, g0, mdb, mdb + 1024, nullptr, nullptr); }
    __syncthreads();
    XRow<SRC_BF> curr, nxtr;
    if (row < row_end) curr.load(xb, row, lane);
    for (; row < row_end; row += stride) {
        const int rn = row + stride;
        if (rn < row_end) nxtr.load(xb, rn, lane);
        f32x4 cur[4];
#pragma unroll
        for (int i = 0; i < 4; ++i) cur[i] = curr.get(i);
        float ss = 0.f;
#pragma unroll
        for (int i = 0; i < 4; ++i)
#pragma unroll
            for (int j = 0; j < 4; ++j) ss += cur[i][j] * cur[i][j];
        ss = wave_sum(ss);
        const float rstd = rsqrtf(ss * (1.0f / 1024.0f) + RMS_EPS);
#pragma unroll
        for (int hlf = 0; hlf < 2; ++hlf) { const int c0 = hlf * 512 + lane * 8; float o[8];
#pragma unroll
            for (int j = 0; j < 8; ++j) o[j] = cur[hlf * 2 + (j >> 2)][j & 3] * rstd * par[c0 + j] * (1.0f + par[2048 + c0 + j]) + par[1024 + c0 + j];
            u32x4 ov = {pack2(o[0], o[1]), pack2(o[2], o[3]), pack2(o[4], o[5]), pack2(o[6], o[7])};
            stg((u32x4*)(p.H() + (size_t)row * 1024 + c0), ov);
            const u32x2 o8 = {f8pack4(o[0], o[1], o[2], o[3]), f8pack4(o[4], o[5], o[6], o[7])};
            stg((u32x2*)(p.H8() + (size_t)row * 1024 + c0), o8); }
        curr = nxtr;
    }
}

struct SchedPlain {
    const bf16_t* A; const bf16_t* Bt; int nM, nN, lda256, ldb256;
    DEV bool next(int i, GUnit& u) const { u.aux = 0; return tile_order(i, nM, nN, u.pm, u.pn); }
    DEV const bf16_t* a_base(const GUnit& u) const { return A + (size_t)u.pm * lda256; }
    DEV const bf16_t* b_base(const GUnit& u) const { return Bt + (size_t)u.pn * ldb256; }
    DEV int grow(const GUnit&, int) const { return 0; }
};
struct SchedPlainT : SchedPlain {
    int split_base = -1;
    DEV bool next(int i, GUnit& u) const { u.aux = 0; const int G_ = (int)gridDim.x, b = (int)blockIdx.x; int L = i * G_ + b;
        if (split_base >= 0 && i >= split_base) { if (b < G_ / 2 || i >= split_base + 2) return false; L = split_base * G_ + (i - split_base) * (G_ / 2) + (b - G_ / 2); }
        return tile_from_L(L, nM, nN, u.pm, u.pn); }
    DEV const bf16_t* a_base(const GUnit&) const { return A; }
    DEV int grow(const GUnit& u, int i) const { return u.pm * 256 + i; }
};
DEV void phase_proj_a(const Params& p, const SetDesc& sd, int layer, char* shm) {
    bf16_t* pb = proj_buf(p, sd);
    {
        SchedPlain S; S.A = p.H(); S.Bt = p.WinT() + (size_t)layer * PWT * 1024; S.nM = sd.nrows / 256; S.nN = C_F8 / 256; S.lda256 = 256 * 1024; S.ldb256 = 256 * 1024;
        gemm_stream<false, 1024, 1024, 1024>(shm, S, [=](const GUnit& u, const f32x4 (&acc)[2][2][4][2], int r0, int c0) {
#pragma unroll
            for (int ai = 0; ai < 2; ++ai)
#pragma unroll
                for (int m = 0; m < 4; ++m) { bf16_t* o = pb + ((size_t)u.pm * 256 + r0 + ai * 128 + m * 16) * PWA + u.pn * 256 + c0;
                    if (u.pn * 256 + c0 < C_PADA) store8bf(o, acc[ai][0][m][0], acc[ai][0][m][1]);
                    if (u.pn * 256 + 128 < C_PADA) store8bf(o + 128, acc[ai][1][m][0], acc[ai][1][m][1]); } });
    }
    {
        SchedPlainT S; S.A = (const bf16_t*)p.H8(); S.Bt = p.WinT() + (size_t)layer * PWT * 1024 + (size_t)C_F8 * 1024; S.nM = sd.nrows / 256; S.nN = (PWA - C_F8) / 256; S.lda256 = 256 * 512; S.ldb256 = 256 * 512;
        { const int G_ = (int)gridDim.x, T1 = S.nM * (C_F8 / 256), T2 = S.nM * S.nN; if ((G_ & 1) == 0 && (T1 % G_) * 2 == G_ && T2 % G_ == 0 && T2 / G_ >= 1) S.split_base = T2 / G_ - 1; }
        gemm_stream<true, 512, 512, 512, true>(shm, S, [=](const GUnit& u, const f32x4 (&acc)[2][2][4][2], int r0, int c0) {
#pragma unroll
            for (int ai = 0; ai < 2; ++ai)
#pragma unroll
                for (int m = 0; m < 4; ++m) { bf16_t* o = pb + ((size_t)u.pm * 256 + r0 + ai * 128 + m * 16) * PWA + C_F8 + u.pn * 256 + c0;
                    store8bf(o, acc[ai][0][m][0] * F8_WINV, acc[ai][0][m][1] * F8_WINV); store8bf(o + 128, acc[ai][1][m][0] * F8_WINV, acc[ai][1][m][1] * F8_WINV); } });
    }
}
DEV unsigned gate4u8(f32x4 v) {
    unsigned w = 0;
#pragma unroll
    for (int j = 0; j < 4; ++j) w |= (unsigned)fmaxf(sigmoidf_(v[j] * F8_WINV) * 255.0f + 0.5f, 1.0f) << (8 * j);
    return w;
}
DEV float u8f(unsigned w, int j) { return (float)((w >> (8 * j)) & 0xFFu); }
DEV f32x4 sig4(f32x4 v) { f32x4 r; r[0] = sigmoidf_(v[0]); r[1] = sigmoidf_(v[1]); r[2] = sigmoidf_(v[2]); r[3] = sigmoidf_(v[3]); return r; }
DEV void phase_proj_b(const Params& p, const SetDesc& sd, int layer, char* shm) {
    SchedPlainT S; S.A = (const bf16_t*)p.H8(); S.Bt = p.WinT() + (size_t)layer * PWT * 1024 + (size_t)PWA * 1024; S.nM = sd.nrows / 256; S.nN = NBG / 256; S.lda256 = 256 * 512; S.ldb256 = 256 * 512;
    unsigned char* bg = (unsigned char*)p.BG();
    gemm_stream<true, 512, 512, 512, true>(shm, S, [=](const GUnit& u, const f32x4 (&acc)[2][2][4][2], int r0, int c0) {
#pragma unroll
        for (int ai = 0; ai < 2; ++ai)
#pragma unroll
            for (int m = 0; m < 4; ++m) { unsigned char* o = bg + ((size_t)u.pm * 256 + r0 + ai * 128 + m * 16) * NBG + u.pn * 256 + c0;
#pragma unroll
                for (int hf = 0; hf < 2; ++hf) { const u32x2 gv = {gate4u8(acc[ai][hf][m][0]), gate4u8(acc[ai][hf][m][1])}; stg((u32x2*)(o + hf * 128), gv); } } });
}

DEV void gate_scan(const bf16_t* prow, int h, const float* gbias, float* ga, float* gb, float* gpm, float* gtot, float* tmp) {
    const int tid = TID(), lane = tid & 63, w = tid >> 6;
    float b = 0.f, a = 0.f, pm = 0.f; int d = 0, tok = 0;
    if (tid < 256) {
        d = tid >> 7; const int i = tid & 127; tok = d ? 127 - i : i;
        const float gi = bf2f(ldg(prow + (size_t)tok * PWA + C_GM + (2 * d) * 4 + h)) + ldg(gbias + (2 * d) * 4 + h);
        const float gf = bf2f(ldg(prow + (size_t)tok * PWA + C_GM + (2 * d + 1) * 4 + h)) + ldg(gbias + (2 * d + 1) * 4 + h);
        b = logsigmoidf_(gf);
#pragma unroll
        for (int o = 1; o < 64; o <<= 1) { const float t = __shfl_up(b, o); if (lane >= o) b += t; }
        if (lane == 63) tmp[w] = b;
        a = gi;
    }
    __syncthreads();
    if (tid < 256) {
        if (w & 1) b += tmp[w - 1];
        a -= b; pm = a;
#pragma unroll
        for (int o = 1; o < 64; o <<= 1) { const float t = __shfl_up(pm, o); if (lane >= o) pm = fmaxf(pm, t); }
        if (lane == 63) tmp[8 + w] = pm;
    }
    __syncthreads();
    if (tid < 256) {
        if (w & 1) pm = fmaxf(pm, tmp[8 + w - 1]);
        ga[d * 128 + tok] = a; gb[d * 128 + tok] = b; gpm[d * 128 + tok] = pm;
        if ((tid & 127) == 127) { gtot[d * 2] = b; gtot[d * 2 + 1] = pm; }
    }
    __syncthreads();
}

DEV void load_rope_chunk(const bf16_t* hp, int cidx, bool latent, int tl, const float* rope, float scale, float* o) {
    const u32x4 m = ldg((const u32x4*)(hp + cidx * 8));
    float x[8] = {lo16(m.x), hi16(m.x), lo16(m.y), hi16(m.y), lo16(m.z), hi16(m.z), lo16(m.w), hi16(m.w)};
    if (latent) {
        const u32x4 q = ldg((const u32x4*)(hp + (cidx ^ 2) * 8));
        const float y[8] = {lo16(q.x), hi16(q.x), lo16(q.y), hi16(q.y), lo16(q.z), hi16(q.z), lo16(q.w), hi16(q.w)};
        const int pos = (cidx < 4) ? (tl >> 6) : (ROWS + (tl & 63));
        const float* tb = rope + ((size_t)pos * 16 + (cidx & 1) * 8) * 2;
        const bool first = (cidx & 2) == 0;
#pragma unroll
        for (int j = 0; j < 8; ++j) { const float cs = ldg(tb + j * 2), sn = ldg(tb + j * 2 + 1);
            x[j] = first ? (x[j] * cs - y[j] * sn) : (x[j] * cs + y[j] * sn); }
    }
#pragma unroll
    for (int j = 0; j < 8; ++j) o[j] = x[j] * scale;
}

DEV int st_index(const SetDesc& sd, int sl, int h, int dir, int tb) { return ((sl * 4 + h) * 2 + dir) * sd.ntb + tb; }

constexpr int V_LD = 144, K_LD = 72, KS_LD = 80;
DEV void mlstm_stepA_task(const Params& p, const SetDesc& sd, int layer, int task, char* shm) {
    const int tid = TID(), lane = tid & 63, w = tid >> 6, fr = lane & 15, fq = lane >> 4, tq4 = (lane & 15) >> 2, tp4 = lane & 3;
    const int tb = task % sd.ntb, h = (task / sd.ntb) & 3, sl = task / (sd.ntb * 4);
    const int row0 = (sl << sd.lgseq) + tb * 128; const bool latent = !sd.is_ctx; const int tl0 = tb * 128;
    bf16_t* Vs = (bf16_t*)shm;
    bf16_t* Ksc = (bf16_t*)(shm + 128 * V_LD * 2);
    float* ga = (float*)(shm + 128 * V_LD * 2 + 2 * 128 * KS_LD * 2); float* gb = ga + 256; float* gpm = gb + 256; float* gtot = gpm + 256; float* tmp = gtot + 8;
    const bf16_t* prow = proj_buf(p, sd) + (size_t)row0 * PWA;
    __syncthreads();
    gate_scan(prow, h, p.gate_bias + (size_t)layer * 16, ga, gb, gpm, gtot, tmp);
    {
        const int s = tid & 127, cpi = tid >> 7, cp = (cpi & 1) + (cpi >> 1) * 4;
        const bf16_t* hp = prow + (size_t)s * PWA + C_KM + h * 64;
        float k1[8], k2[8];
        load_rope_chunk(hp, cp, latent, tl0 + s, p.rope(), 1.0f, k1);
        load_rope_chunk(hp, cp + 2, latent, tl0 + s, p.rope(), 1.0f, k2);
#pragma unroll
        for (int dir = 0; dir < 2; ++dir) { const float ws = __expf(ga[dir * 128 + s] - gtot[dir * 2 + 1]);
            u32x4 o1 = {pack2(k1[0] * ws, k1[1] * ws), pack2(k1[2] * ws, k1[3] * ws), pack2(k1[4] * ws, k1[5] * ws), pack2(k1[6] * ws, k1[7] * ws)};
            u32x4 o2 = {pack2(k2[0] * ws, k2[1] * ws), pack2(k2[2] * ws, k2[3] * ws), pack2(k2[4] * ws, k2[5] * ws), pack2(k2[6] * ws, k2[7] * ws)};
            *(u32x4*)(Ksc + (dir * 128 + s) * KS_LD + cp * 8) = o1; *(u32x4*)(Ksc + (dir * 128 + s) * KS_LD + (cp + 2) * 8) = o2; }
    }
#pragma unroll
    for (int it = 0; it < 4; ++it) { const int item = tid + it * 512, s = item >> 4, ch = item & 15;
        *(u32x4*)(Vs + s * V_LD + ch * 8) = ldg((const u32x4*)(prow + (size_t)s * PWA + C_VM + h * 128 + ch * 8)); }
    __syncthreads();
    f32x4 acc[2][4];
#pragma unroll
    for (int dir = 0; dir < 2; ++dir)
#pragma unroll
        for (int n = 0; n < 4; ++n) acc[dir][n] = (f32x4){0.f, 0.f, 0.f, 0.f};
#pragma unroll
    for (int ks = 0; ks < 4; ++ks) {
        const bf16_t* vp = Vs + (32 * ks + 4 * fq + tq4) * V_LD + w * 16 + 4 * tp4;
        const bf16x8 af = mk8(TR16(vp), TR16(vp + 16 * V_LD));
#pragma unroll
        for (int dir = 0; dir < 2; ++dir)
#pragma unroll
            for (int n = 0; n < 4; ++n) { const bf16_t* kp = Ksc + (dir * 128 + 32 * ks + 4 * fq + tq4) * KS_LD + n * 16 + 4 * tp4;
                const bf16x8 bfv = mk8(TR16(kp), TR16(kp + 16 * KS_LD));
                acc[dir][n] = mfma16(bfv, af, acc[dir][n]); }
    }
#pragma unroll
    for (int dir = 0; dir < 2; ++dir) { float* So = p.Sst() + (size_t)st_index(sd, sl, h, dir, tb) * 8192;
#pragma unroll
        for (int n = 0; n < 4; ++n) stg((f32x4*)(So + (w * 16 + fr) * 64 + n * 16 + fq * 4), acc[dir][n]); }
    if (tid < 128) { const int dir = tid >> 6, dd = tid & 63; float sm = 0.f;
        for (int i = 0; i < 128; ++i) sm += bf2f(Ksc[(dir * 128 + i) * KS_LD + dd]);
        stg(p.Sn() + (size_t)st_index(sd, sl, h, dir, tb) * 64 + dd, sm); }
    if (tid < 2) { float* sc = p.Ssc() + (size_t)st_index(sd, sl, h, tid, tb) * 4; stg(sc, gtot[tid * 2]); stg(sc + 1, gtot[tid * 2] + gtot[tid * 2 + 1]); }
}

template <int GI> DEV void pool_group(const Params& p, const SetDesc& sd, const bf16_t* pb) {
    constexpr int W = 2 << GI;
    const int nitems = sd.nrows * 16; const int T = 1 << sd.lgseq;
    for (int item = blockIdx.x * NTHREADS + TID(); item < nitems; item += gridDim.x * NTHREADS) {
        const int row = item >> 4, ch = GI * 128 + (item & 15) * 8;
        const int tt = row & (T - 1);
        u32x4 mv[W]; int cnt = 0; bool okv[W];
#pragma unroll
        for (int q = 0; q < W; ++q) { const int t2 = tt - W / 2 + q; const bool ok = (t2 >= 0) && (t2 < T); cnt += ok ? 1 : 0; okv[q] = ok;
            mv[q] = ldg((const u32x4*)(pb + (size_t)(ok ? (row - W / 2 + q) : row) * PWA + C_PU + ch)); }
        float s[8];
#pragma unroll
        for (int j = 0; j < 8; ++j) s[j] = 0.f;
#pragma unroll
        for (int q = 0; q < W; ++q) { u32x4 m = mv[q]; if (!okv[q]) m = (u32x4){0u, 0u, 0u, 0u};
            s[0] += lo16(m.x); s[1] += hi16(m.x); s[2] += lo16(m.y); s[3] += hi16(m.y); s[4] += lo16(m.z); s[5] += hi16(m.z); s[6] += lo16(m.w); s[7] += hi16(m.w); }
        const float inv = frcp((float)cnt);
        const u32x4 m = mv[W / 2];
        const float u[8] = {lo16(m.x), hi16(m.x), lo16(m.y), hi16(m.y), lo16(m.z), hi16(m.z), lo16(m.w), hi16(m.w)};
        u32x4 o = {pack2(s[0] * inv - u[0], s[1] * inv - u[1]), pack2(s[2] * inv - u[2], s[3] * inv - u[3]), pack2(s[4] * inv - u[4], s[5] * inv - u[5]), pack2(s[6] * inv - u[6], s[7] * inv - u[7])};
        stg((u32x4*)(p.Pb() + (size_t)row * 512 + ch), o);
    }
}
DEV void phase_pool(const Params& p, const SetDesc& sd) {
    const bf16_t* pb = proj_buf(p, sd);
    pool_group<0>(p, sd, pb); pool_group<1>(p, sd, pb); pool_group<2>(p, sd, pb); pool_group<3>(p, sd, pb);
}

template <int NC> DEV void mlstm_stepB_run(const Params& p, const SetDesc& sd, int task) {
    const int tid = TID();
    const int q = task & 3, dir = (task >> 2) & 1, h = (task >> 3) & 3, sl = task >> 5;
    const int ci = ((sd.samp0 + sl) * 4 + h) * 2 + dir;
    const int eoff = q * 2048 + tid * 4;
    float zr = 0.f; HIDE(zr);
    f32x4 C = {zr, zr, zr, zr}; float nv = 0.f; float m = -1e30f;
    f32x4 Sv[NC]; float blv[NC], mlv[NC], snv[NC];
#pragma unroll
    for (int c = 0; c < NC; ++c) { const int tb = dir ? NC - 1 - c : c; const size_t si = st_index(sd, sl, h, dir, tb);
        Sv[c] = ldg((const f32x4*)(p.Sst() + si * 8192 + eoff)); blv[c] = ldg(p.Ssc() + si * 4); mlv[c] = ldg(p.Ssc() + si * 4 + 1);
        snv[c] = (q == 0 && tid < 64) ? ldg(p.Sn() + si * 64 + tid) : 0.f; }
    if (!sd.is_ctx) { C = ldg((const f32x4*)(p.CiC() + (size_t)ci * 8192 + eoff)); if (q == 0 && tid < 64) nv = ldg(p.Cin_() + (size_t)ci * 64 + tid); m = ldg(p.Cim() + (size_t)ci * 4); }
#pragma unroll
    for (int c = 0; c < NC; ++c) {
        const int tb = dir ? NC - 1 - c : c; const size_t si = st_index(sd, sl, h, dir, tb);
        u32x2 o = {pack2(C[0], C[1]), pack2(C[2], C[3])};
        stg((u32x2*)(p.Cin() + si * 8192 + eoff), o);
        if (q == 0 && tid < 64) stg(p.Cn() + si * 64 + tid, nv);
        if (q == 0 && tid == 0) stg(p.Cm() + si * 4, m);
        const float mn = fmaxf(blv[c] + m, mlv[c]);
        const float dc = __expf(blv[c] + m - mn), wsn = __expf(mlv[c] - mn);
        C = C * dc + Sv[c] * wsn;
        nv = nv * dc + snv[c] * wsn;
        m = mn;
    }
    if (sd.is_ctx) { stg((f32x4*)(p.CiC() + (size_t)ci * 8192 + eoff), C); if (q == 0 && tid < 64) stg(p.Cin_() + (size_t)ci * 64 + tid, nv); if (q == 0 && tid == 0) stg(p.Cim() + (size_t)ci * 4, m); }
}
DEV void mlstm_stepB_task(const Params& p, const SetDesc& sd, int task) {
    if (sd.is_ctx) mlstm_stepB_run<NTBC>(p, sd, task); else mlstm_stepB_run<NTBL>(p, sd, task);
}

constexpr int NA_KLD = 136, NA_VLD = 144;
DEV void na_task(const Params& p, const SetDesc& sd, int layer, int sl, int rq2  , int hp, char* shm) {
    const int tid = TID(), lane = tid & 63, w = tid >> 6, tq = lane & 15, fq = lane >> 4, tq4 = (lane & 15) >> 2, tp4 = lane & 3;
    const int hh = w >> 2, g = w & 3, head = hp * 2 + hh;
    const bool ctxq = sd.is_ctx;
    bf16_t* Ks = (bf16_t*)shm;
    bf16_t* Vs = (bf16_t*)(shm + 128 * NA_KLD * 2);
    float* rpbs = (float*)(shm + 128 * NA_KLD * 2 + 128 * NA_VLD * 2);
    const int sample = sd.samp0 + sl;
    const bf16_t* pq = proj_buf(p, sd) + ((size_t)sl << sd.lgseq) * PWA;
    const bf16_t* pc = p.PROJc() + (size_t)sample * CTX * PWA;
    const int qcol = g * 16 + tq;
    int rqv[2], rsv[2], qtok[2];
#pragma unroll
    for (int u = 0; u < 2; ++u) { rqv[u] = 2 * rq2 + u; qtok[u] = rqv[u] * 64 + qcol; int r_ = rqv[u] - 4; rsv[u] = r_ < 0 ? 0 : (r_ > ROWS - 8 ? ROWS - 8 : r_); }
    const int nloc = ctxq ? 0 : (rsv[1] + 8 - rsv[0]);
    const int nstage = nloc + CTX / 64;
    __syncthreads();
    if (!ctxq) for (int i = tid; i < 2 * 465; i += NTHREADS) rpbs[i] = ldg(p.rpb + ((size_t)layer * 8 + hp * 2 + i / 465) * 465 + i % 465);
    bf16x8 qf[2][2];
#pragma unroll
    for (int u = 0; u < 2; ++u)
#pragma unroll
        for (int ks = 0; ks < 2; ++ks) qf[u][ks] = mk8(ldg((const u32x4*)(pq + (size_t)qtok[u] * PWA + C_QN + head * 64 + ks * 32 + fq * 8)));
    float m_run[2] = {-1e30f, -1e30f}, l_run[2] = {0.f, 0.f};
    f32x4 acc[2][4];
#pragma unroll
    for (int u = 0; u < 2; ++u)
#pragma unroll
        for (int mt = 0; mt < 4; ++mt) acc[u][mt] = (f32x4){0.f, 0.f, 0.f, 0.f};
    int cs = qcol - 8; cs = cs < 0 ? 0 : (cs > 48 ? 48 : cs);
    const int kc0 = (g == 0) ? 0 : (g == 1) ? 8 : (g == 2) ? 24 : 32;
    const int npair = (nstage + 1) >> 1;
    u32x4 kreg[4], vreg[4];
#define NA_SRC_ROWS(stg) (((stg) < nloc) ? (pq + (size_t)((rsv[0] + (stg)) * 64) * PWA) : (pc + (size_t)((((stg) < nstage ? (stg) : nstage - 1) - nloc) * 64) * PWA))
#define NA_FETCH(sp_) do { _Pragma("unroll") for (int it = 0; it < 4; ++it) { const int item = tid + it * 512, key2 = item >> 4, ch = item & 15; \
        const bf16_t* kb_ = NA_SRC_ROWS(2 * (sp_) + (key2 >> 6)); const bf16_t* src = kb_ + (size_t)(key2 & 63) * PWA + hp * 128 + ch * 8; \
        kreg[it] = ldg((const u32x4*)(src + C_KN)); vreg[it] = ldg((const u32x4*)(src + C_VN)); } } while (0)
    NA_FETCH(0);
    for (int sp = 0; sp < npair; ++sp) {
        __syncthreads();
#pragma unroll
        for (int it = 0; it < 4; ++it) { const int item = tid + it * 512, key2 = item >> 4, ch = item & 15;
            *(u32x4*)(Ks + key2 * NA_KLD + ch * 8) = kreg[it]; *(u32x4*)(Vs + key2 * NA_VLD + ch * 8) = vreg[it]; }
        if (sp + 1 < npair) NA_FETCH(sp + 1);
        __syncthreads();
#pragma unroll
        for (int sub = 0; sub < 2; ++sub) {
        const int st = 2 * sp + sub;
        if (st >= nstage) continue;
        const bool local = st < nloc;
        const bf16_t* Ksb = Ks + sub * 64 * NA_KLD; const bf16_t* Vsb = Vs + sub * 64 * NA_VLD;
        if (local) {
            const int kr = rsv[0] + st;
            f32x4 sa[2][2];
#pragma unroll
            for (int kt = 0; kt < 2; ++kt) { sa[0][kt] = (f32x4){0.f, 0.f, 0.f, 0.f}; sa[1][kt] = (f32x4){0.f, 0.f, 0.f, 0.f};
#pragma unroll
                for (int ks = 0; ks < 2; ++ks) { const bf16x8 kf = *(const bf16x8*)(Ksb + (kc0 + kt * 16 + tq) * NA_KLD + hh * 64 + ks * 32 + fq * 8);
                    sa[0][kt] = mfma16(kf, qf[0][ks], sa[0][kt]); sa[1][kt] = mfma16(kf, qf[1][ks], sa[1][kt]); } }
            float alpha[2]; bf16x8 pf[2];
#pragma unroll
            for (int u = 0; u < 2; ++u) {
                const bool act = (kr >= rsv[u]) && (kr < rsv[u] + 8);
                if (!act) { alpha[u] = 1.0f; pf[u] = mk8((u32x4){0u, 0u, 0u, 0u}); continue; }
                const int dr = kr - rqv[u] + 7;
                float sc[8]; float mx = -1e30f; float bs[8];
#pragma unroll
                for (int kt = 0; kt < 2; ++kt)
#pragma unroll
                    for (int r = 0; r < 4; ++r) { const int kcol = kc0 + kt * 16 + fq * 4 + r; int dc = kcol - qcol + 15; dc = dc < 0 ? 0 : (dc > 30 ? 30 : dc);
                        bs[kt * 4 + r] = rpbs[hh * 465 + dr * 31 + dc]; }
#ifndef CPU_EMU
                asm volatile("" : "+v"(bs[0]), "+v"(bs[1]), "+v"(bs[2]), "+v"(bs[3]), "+v"(bs[4]), "+v"(bs[5]), "+v"(bs[6]), "+v"(bs[7]));
#endif
#pragma unroll
                for (int kt = 0; kt < 2; ++kt)
#pragma unroll
                    for (int r = 0; r < 4; ++r) { const int kcol = kc0 + kt * 16 + fq * 4 + r; const bool valid = (kcol >= cs) && (kcol < cs + 16);
                        const float v = valid ? (sa[u][kt][r] * 0.125f + bs[kt * 4 + r]) : -1e30f; sc[kt * 4 + r] = v; mx = fmaxf(mx, v); }
                mx = fmaxf(mx, shx<16>(mx)); mx = fmaxf(mx, shx<32>(mx));
                const float mn = fmaxf(m_run[u], mx); alpha[u] = __expf(m_run[u] - mn); m_run[u] = mn;
                float ps = 0.f; float pv[8];
#pragma unroll
                for (int j = 0; j < 8; ++j) { pv[j] = __expf(sc[j] - mn); ps += pv[j]; }
                ps += shx<16>(ps); ps += shx<32>(ps);
                l_run[u] = l_run[u] * alpha[u] + ps;
                u32x4 pk = {pack2(pv[0], pv[1]), pack2(pv[2], pv[3]), pack2(pv[4], pv[5]), pack2(pv[6], pv[7])};
                pf[u] = mk8(pk);
            }
#pragma unroll
            for (int mt = 0; mt < 4; ++mt) {
                const bf16_t* vp = Vsb + (kc0 + 4 * fq + tq4) * NA_VLD + hh * 64 + mt * 16 + 4 * tp4;
                const bf16x8 vf = mk8(TR16(vp), TR16(vp + 16 * NA_VLD));
                acc[0][mt] = mfma16(vf, pf[0], acc[0][mt] * alpha[0]); acc[1][mt] = mfma16(vf, pf[1], acc[1][mt] * alpha[1]); }
        } else {
            f32x4 sa[2][4];
#pragma unroll
            for (int kt = 0; kt < 4; ++kt) { sa[0][kt] = (f32x4){0.f, 0.f, 0.f, 0.f}; sa[1][kt] = (f32x4){0.f, 0.f, 0.f, 0.f};
#pragma unroll
                for (int ks = 0; ks < 2; ++ks) { const bf16x8 kf = *(const bf16x8*)(Ksb + (kt * 16 + tq) * NA_KLD + hh * 64 + ks * 32 + fq * 8);
                    sa[0][kt] = mfma16(kf, qf[0][ks], sa[0][kt]); sa[1][kt] = mfma16(kf, qf[1][ks], sa[1][kt]); } }
            float alpha[2]; bf16x8 pf[2][2];
#pragma unroll
            for (int u = 0; u < 2; ++u) {
                float mx = -1e30f;
#pragma unroll
                for (int kt = 0; kt < 4; ++kt)
#pragma unroll
                    for (int r = 0; r < 4; ++r) { sa[u][kt][r] *= 0.125f; mx = fmaxf(mx, sa[u][kt][r]); }
                mx = fmaxf(mx, shx<16>(mx)); mx = fmaxf(mx, shx<32>(mx));
                const float mn = fmaxf(m_run[u], mx); alpha[u] = __expf(m_run[u] - mn); m_run[u] = mn;
                float ps = 0.f;
#pragma unroll
                for (int kt = 0; kt < 4; ++kt)
#pragma unroll
                    for (int r = 0; r < 4; ++r) { sa[u][kt][r] = __expf(sa[u][kt][r] - mn); ps += sa[u][kt][r]; }
                ps += shx<16>(ps); ps += shx<32>(ps);
                l_run[u] = l_run[u] * alpha[u] + ps;
#pragma unroll
                for (int h2 = 0; h2 < 2; ++h2) {
                    u32x4 pk = {pack2(sa[u][2 * h2][0], sa[u][2 * h2][1]), pack2(sa[u][2 * h2][2], sa[u][2 * h2][3]), pack2(sa[u][2 * h2 + 1][0], sa[u][2 * h2 + 1][1]), pack2(sa[u][2 * h2 + 1][2], sa[u][2 * h2 + 1][3])};
                    pf[u][h2] = mk8(pk); }
            }
#pragma unroll
            for (int mt = 0; mt < 4; ++mt) { acc[0][mt] = acc[0][mt] * alpha[0]; acc[1][mt] = acc[1][mt] * alpha[1]; }
#pragma unroll
            for (int h2 = 0; h2 < 2; ++h2)
#pragma unroll
                for (int mt = 0; mt < 4; ++mt) { const bf16_t* vp = Vsb + (32 * h2 + 4 * fq + tq4) * NA_VLD + hh * 64 + mt * 16 + 4 * tp4;
                    const bf16x8 vf = mk8(TR16(vp), TR16(vp + 16 * NA_VLD));
                    acc[0][mt] = mfma16(vf, pf[0][h2], acc[0][mt]); acc[1][mt] = mfma16(vf, pf[1][h2], acc[1][mt]); }
        }
        }
    }
#undef NA_FETCH
#undef NA_SRC_ROWS
#pragma unroll
    for (int u = 0; u < 2; ++u) {
        const float il = frcp(l_run[u]);
        const size_t orow = ((size_t)sl << sd.lgseq) + qtok[u];
#pragma unroll
        for (int mt = 0; mt < 4; ++mt) { u32x2 o = {pack2(acc[u][mt][0] * il, acc[u][mt][1] * il), pack2(acc[u][mt][2] * il, acc[u][mt][3] * il)};
            stg((u32x2*)(p.Nb() + orow * 512 + head * 64 + mt * 16 + fq * 4), o); }
    }
}

DEV void mlstm_stepC_task(const Params& p, const SetDesc& sd, int layer, int task, char* shm) {
    const int tid = TID(), lane = tid & 63, w = tid >> 6, tq = lane & 15, fq = lane >> 4, tq4 = (lane & 15) >> 2, tp4 = lane & 3;
    const int tb = task % sd.ntb, h = (task / sd.ntb) & 3, sl = task / (sd.ntb * 4);
    const int row0 = (sl << sd.lgseq) + tb * 128; const bool latent = !sd.is_ctx; const int tl0 = tb * 128;
    bf16_t* Ks = (bf16_t*)shm;
    bf16_t* Vs = (bf16_t*)(shm + 128 * K_LD * 2);
    bf16_t* Cs = (bf16_t*)(shm + 128 * K_LD * 2 + 128 * V_LD * 2);
    float* ga = (float*)(shm + 128 * K_LD * 2 * 3 + 128 * V_LD * 2); float* gb = ga + 256; float* gpm = gb + 256; float* gtot = gpm + 256; float* tmp = gtot + 8;
    float* nvs = tmp + 16;
    float* cms = nvs + 128;
    const bf16_t* prow = proj_buf(p, sd) + (size_t)row0 * PWA;
    __syncthreads();
    gate_scan(prow, h, p.gate_bias + (size_t)layer * 16, ga, gb, gpm, gtot, tmp);
    {
        const int s = tid & 127, cpi = tid >> 7, cp = (cpi & 1) + (cpi >> 1) * 4;
        const bf16_t* hp = prow + (size_t)s * PWA + C_KM + h * 64;
        float k1[8], k2[8];
        load_rope_chunk(hp, cp, latent, tl0 + s, p.rope(), 1.0f, k1);
        load_rope_chunk(hp, cp + 2, latent, tl0 + s, p.rope(), 1.0f, k2);
        u32x4 o1 = {pack2(k1[0], k1[1]), pack2(k1[2], k1[3]), pack2(k1[4], k1[5]), pack2(k1[6], k1[7])};
        u32x4 o2 = {pack2(k2[0], k2[1]), pack2(k2[2], k2[3]), pack2(k2[4], k2[5]), pack2(k2[6], k2[7])};
        *(u32x4*)(Ks + s * K_LD + cp * 8) = o1; *(u32x4*)(Ks + s * K_LD + (cp + 2) * 8) = o2;
    }
#pragma unroll
    for (int it = 0; it < 4; ++it) { const int item = tid + it * 512, s = item >> 4, ch = item & 15;
        *(u32x4*)(Vs + s * V_LD + ch * 8) = ldg((const u32x4*)(prow + (size_t)s * PWA + C_VM + h * 128 + ch * 8)); }
#pragma unroll
    for (int it = 0; it < 4; ++it) { const int item = tid + it * 512, dir = item >> 10, rem = item & 1023, v = rem >> 3, ch = rem & 7;
        *(u32x4*)(Cs + (dir * 128 + v) * K_LD + ch * 8) = ldg((const u32x4*)(p.Cin() + (size_t)st_index(sd, sl, h, dir, tb) * 8192 + v * 64 + ch * 8)); }
    if (tid < 128) nvs[tid] = ldg(p.Cn() + (size_t)st_index(sd, sl, h, tid >> 6, tb) * 64 + (tid & 63));
    if (tid < 2) cms[tid] = ldg(p.Cm() + (size_t)st_index(sd, sl, h, tid, tb) * 4);
    bf16x8 qf[2]; float qv[2][8];
    {
        const int t = w * 16 + tq; const bf16_t* hp = prow + (size_t)t * PWA + C_QM + h * 64;
#pragma unroll
        for (int ks = 0; ks < 2; ++ks) { load_rope_chunk(hp, ks * 4 + fq, latent, tl0 + t, p.rope(), 0.125f, qv[ks]);
            u32x4 o = {pack2(qv[ks][0], qv[ks][1]), pack2(qv[ks][2], qv[ks][3]), pack2(qv[ks][4], qv[ks][5]), pack2(qv[ks][6], qv[ks][7])}; qf[ks] = mk8(o); }
    }
    __syncthreads();
    const int t = w * 16 + tq;
    f32x4 hsum[8];
#pragma unroll
    for (int mt = 0; mt < 8; ++mt) hsum[mt] = (f32x4){0.f, 0.f, 0.f, 0.f};
#pragma unroll
    for (int dir = 0; dir < 2; ++dir) {
        const float m_in = cms[dir];
        const float Mt = fmaxf(m_in, gpm[dir * 128 + t]);
        const float inter = __expf(m_in - Mt);
        const float mtot = gb[dir * 128 + t] + Mt;
        f32x4 acc[8];
#pragma unroll
        for (int mt = 0; mt < 8; ++mt) { acc[mt] = (f32x4){0.f, 0.f, 0.f, 0.f};
#pragma unroll
            for (int ks = 0; ks < 2; ++ks) { const bf16x8 cf = *(const bf16x8*)(Cs + (dir * 128 + mt * 16 + tq) * K_LD + ks * 32 + fq * 8);
                acc[mt] = mfma16(cf, qf[ks], acc[mt]); }
            acc[mt] = acc[mt] * inter; }
        float qn = 0.f;
#pragma unroll
        for (int ks = 0; ks < 2; ++ks)
#pragma unroll
            for (int j = 0; j < 8; ++j) qn += bf2f(f2bf(qv[ks][j])) * nvs[dir * 64 + ks * 32 + fq * 8 + j];
        qn += shx<16>(qn); qn += shx<32>(qn);
        float den = inter * qn;
        const int u_lo = dir == 0 ? 0 : (w >> 1), u_hi = dir == 0 ? (w >> 1) : 3;
        float rsum = 0.f;
        for (int u = u_lo; u <= u_hi; ++u) {
            unsigned pk[4];
#pragma unroll
            for (int kt = 0; kt < 2; ++kt) { f32x4 sa = {0.f, 0.f, 0.f, 0.f}; const int sb = 32 * u + 16 * kt;
#pragma unroll
                for (int ks = 0; ks < 2; ++ks) { const bf16x8 kf = *(const bf16x8*)(Ks + (sb + tq) * K_LD + ks * 32 + fq * 8); sa = mfma16(kf, qf[ks], sa); }
                float pv[4]; float gv4[4];
#pragma unroll
                for (int r = 0; r < 4; ++r) gv4[r] = ga[dir * 128 + sb + fq * 4 + r];
#ifndef CPU_EMU
                asm volatile("" : "+v"(gv4[0]), "+v"(gv4[1]), "+v"(gv4[2]), "+v"(gv4[3]));
#endif
#pragma unroll
                for (int r = 0; r < 4; ++r) { const int s = sb + fq * 4 + r; const bool valid = dir == 0 ? (s <= t) : (s >= t);
                    pv[r] = valid ? sa[r] * __expf(gv4[r] - Mt) : 0.f; pv[r] = bf2f(f2bf(pv[r])); rsum += pv[r]; }
                pk[kt * 2] = pack2(pv[0], pv[1]); pk[kt * 2 + 1] = pack2(pv[2], pv[3]); }
            u32x4 pkv = {pk[0], pk[1], pk[2], pk[3]}; const bf16x8 pf = mk8(pkv);
#pragma unroll
            for (int mt = 0; mt < 8; ++mt) { const bf16_t* vp = Vs + (32 * u + 4 * fq + tq4) * V_LD + mt * 16 + 4 * tp4;
                const bf16x8 vf = mk8(TR16(vp), TR16(vp + 16 * V_LD));
                acc[mt] = mfma16(vf, pf, acc[mt]); }
        }
        rsum += shx<16>(rsum); rsum += shx<32>(rsum);
        den += rsum;
        const float dn = frcp(fmaxf(fabsf(den), __expf(-mtot)));
#pragma unroll
        for (int mt = 0; mt < 8; ++mt) hsum[mt] = hsum[mt] + acc[mt] * dn;
    }
    float ss = 0.f;
#pragma unroll
    for (int mt = 0; mt < 8; ++mt)
#pragma unroll
        for (int r = 0; r < 4; ++r) ss += hsum[mt][r] * hsum[mt][r];
    ss += shx<16>(ss); ss += shx<32>(ss);
    const float rstd = rsqrtf(ss * (1.0f / 128.0f) + RMS_EPS);
#pragma unroll
    for (int mt = 0; mt < 8; ++mt) { const int v = mt * 16 + fq * 4;
        const u32x2 om = ldg((const u32x2*)(prow + (size_t)t * PWA + C_OM + h * 128 + v));
        u32x2 o = {pack2(hsum[mt][0] * rstd * sigmoidf_(lo16(om.x)), hsum[mt][1] * rstd * sigmoidf_(hi16(om.x))),
                   pack2(hsum[mt][2] * rstd * sigmoidf_(lo16(om.y)), hsum[mt][3] * rstd * sigmoidf_(hi16(om.y)))};
        stg((u32x2*)(p.Mb() + (size_t)(row0 + t) * 512 + h * 128 + v), o); }
}

struct SchedMerge {
    const bf16_t* Mb; const bf16_t* Pb; const bf16_t* Nb; const bf16_t* Wb; int nM;
    DEV bool next(int i, GUnit& u) const { u.aux = i % 3; return tile_order(i / 3, nM, 4, u.pm, u.pn); }
    DEV const bf16_t* a_base(const GUnit& u) const { return (u.aux == 0 ? Mb : (u.aux == 1 ? Pb : Nb)) + (size_t)u.pm * 256 * 512; }
    DEV const bf16_t* b_base(const GUnit& u) const { return Wb + ((size_t)u.aux * 1024 + u.pn * 256) * 512; }
    DEV int grow(const GUnit&, int) const { return 0; }
};
DEV void phase_merge(const Params& p, const SetDesc& sd, int layer, char* shm) {
    SchedMerge S; S.Mb = p.Mb(); S.Pb = p.Pb(); S.Nb = p.Nb(); S.Wb = p.WbT() + (size_t)layer * 3 * 1024 * 512; S.nM = sd.nrows / 256;
    const unsigned char* bgb = (const unsigned char*)p.BG(); bf16_t* mgb = p.MERGED();
    gemm_stream<false, 512, 512, 512>(shm, S, [=](const GUnit& u, f32x4 (&acc)[2][2][4][2], int r0, int c0) -> bool {
        if (u.aux < 2) {
            u32x2 ga[2][4][2], gb[2][4][2];
#pragma unroll
            for (int ai = 0; ai < 2; ++ai)
#pragma unroll
                for (int m = 0; m < 4; ++m)
#pragma unroll
                    for (int hf = 0; hf < 2; ++hf) { const unsigned char* gp = bgb + ((size_t)u.pm * 256 + r0 + ai * 128 + m * 16) * NBG + u.aux * 1024 + u.pn * 256 + c0 + hf * 128;
                        ga[ai][m][hf] = ldg((const u32x2*)gp); gb[ai][m][hf] = ldg((const u32x2*)(gp + 1024)); }
#pragma unroll
            for (int ai = 0; ai < 2; ++ai)
#pragma unroll
                for (int m = 0; m < 4; ++m)
#pragma unroll
                    for (int hf = 0; hf < 2; ++hf) {
#pragma unroll
                        for (int j = 0; j < 4; ++j) { acc[ai][hf][m][0][j] *= u8f(ga[ai][m][hf].x, j) * frcp(u8f(gb[ai][m][hf].x, j)); acc[ai][hf][m][1][j] *= u8f(ga[ai][m][hf].y, j) * frcp(u8f(gb[ai][m][hf].y, j)); } }
            return true;
        }
        u32x2 gm2[2][4][2];
#pragma unroll
        for (int ai = 0; ai < 2; ++ai)
#pragma unroll
            for (int m = 0; m < 4; ++m)
#pragma unroll
                for (int hf = 0; hf < 2; ++hf) gm2[ai][m][hf] = ldg((const u32x2*)(bgb + ((size_t)u.pm * 256 + r0 + ai * 128 + m * 16) * NBG + 2048 + u.pn * 256 + c0 + hf * 128));
#pragma unroll
        for (int ai = 0; ai < 2; ++ai) {
#pragma unroll
            for (int m = 0; m < 4; ++m)
#pragma unroll
                for (int hf = 0; hf < 2; ++hf) { const size_t r = (size_t)u.pm * 256 + r0 + ai * 128 + m * 16;
                    const f32x4 x0 = acc[ai][hf][m][0] * (1.0f / 255.0f), x1 = acc[ai][hf][m][1] * (1.0f / 255.0f); const u32x2 g = gm2[ai][m][hf];
                    u32x4 ov = {pack2(x0[0] * u8f(g.x, 0), x0[1] * u8f(g.x, 1)), pack2(x0[2] * u8f(g.x, 2), x0[3] * u8f(g.x, 3)),
                                pack2(x1[0] * u8f(g.y, 0), x1[1] * u8f(g.y, 1)), pack2(x1[2] * u8f(g.y, 2), x1[3] * u8f(g.y, 3))};
                    stg((u32x4*)(mgb + r * 1024 + u.pn * 256 + c0 + hf * 128), ov); }
        }
        return false; });
}
DEV void phase_outproj(const Params& p, const SetDesc& sd, int layer, char* shm) {
    SchedPlain S; S.A = p.MERGED(); S.Bt = p.WoT() + (size_t)layer * 1024 * 1024; S.nM = sd.nrows / 256; S.nN = 4; S.lda256 = 256 * 1024; S.ldb256 = 256 * 1024;
    bf16_t* yb = p.Y();
    gemm_stream<false, 1024, 1024, 1024>(shm, S, [=](const GUnit& u, const f32x4 (&acc)[2][2][4][2], int r0, int c0) {
#pragma unroll
        for (int ai = 0; ai < 2; ++ai)
#pragma unroll
            for (int m = 0; m < 4; ++m) { bf16_t* o = yb + ((size_t)u.pm * 256 + r0 + ai * 128 + m * 16) * 1024 + u.pn * 256 + c0;
                store8bf(o, acc[ai][0][m][0], acc[ai][0][m][1]); store8bf(o + 128, acc[ai][1][m][0], acc[ai][1][m][1]); } });
}

template <bool SRC_BF> DEV void phase_postmix(const Params& p, const SetDesc& sd, int layer, char* shm) {
    const int tid = TID(), lane = tid & 63, wv = tid >> 6;
    float* wr_s = (float*)shm;
    __syncthreads();
    for (int i = tid; i < 1024 * 16; i += NTHREADS) { const int c = i >> 4, e = i & 15, ln = (c & 511) >> 3, j = c & 7, hf = c >> 9;
        wr_s[((((hf * 8 + j) * 4 + (e >> 2)) * 64 + ln) << 2) + (e & 3)] = ldg(p.router_w + (size_t)layer * 1024 * 16 + i); }
    __syncthreads();
    const float* g1 = p.norm_gain + ((size_t)layer * 4 + 1) * 1024; const float* g2 = p.norm_gain + ((size_t)layer * 4 + 2) * 1024;
    float* par = (float*)(shm + 65536);
    { const int rpb0_ = (sd.nrows + (int)gridDim.x - 1) / (int)gridDim.x; const float* mdb = mod_row(p, sd, layer, min((int)blockIdx.x * rpb0_, sd.nrows - 1));
      stage_params(par, g1, g2, mdb + 2048, mdb + 3072, mdb + 4096); }
    __syncthreads();
    const void* xb = SRC_BF ? (const void*)xbf_base(p, sd) : (const void*)xin_f32(p, sd); bf16_t* xdb = xbf_base(p, sd);
    const int stride = 8; const int rpb_ = (sd.nrows + (int)gridDim.x - 1) / (int)gridDim.x; const int row_end = min(sd.nrows, ((int)blockIdx.x + 1) * rpb_);
    int row = (int)blockIdx.x * rpb_ + wv;
    u32x4 ycur[2], ynxt[2]; XRow<SRC_BF> xcur, xnxt;
    if (row < row_end) {
#pragma unroll
        for (int i = 0; i < 2; ++i) ycur[i] = ldg((const u32x4*)(p.Y() + (size_t)row * 1024 + i * 512 + lane * 8));
        xcur.load(xb, row, lane); }
    for (; row < row_end; row += stride) {
        int ln = lane; HIDE(ln);
        const int rn = row + stride;
        if (rn < row_end) {
#pragma unroll
            for (int i = 0; i < 2; ++i) ynxt[i] = ldg((const u32x4*)(p.Y() + (size_t)rn * 1024 + i * 512 + ln * 8));
            xnxt.load(xb, rn, ln); }
        float y[16]; float ss = 0.f;
#pragma unroll
        for (int hlf = 0; hlf < 2; ++hlf) { const u32x4 m = ycur[hlf];
            const float t8[8] = {lo16(m.x), hi16(m.x), lo16(m.y), hi16(m.y), lo16(m.z), hi16(m.z), lo16(m.w), hi16(m.w)};
#pragma unroll
            for (int j = 0; j < 8; ++j) { y[hlf * 8 + j] = t8[j]; ss += t8[j] * t8[j]; } }
        ss = wave_sum(ss);
        const float rstd = rsqrtf(ss * (1.0f / 1024.0f) + RMS_EPS);
        float xn[16]; float ss2 = 0.f;
#pragma unroll
        for (int hlf = 0; hlf < 2; ++hlf) { f32x4 xw[2];
#pragma unroll
            for (int q = 0; q < 2; ++q) { const int c0 = hlf * 512 + ln * 8 + q * 4; const f32x4 xo = xcur.get(hlf * 2 + q);
#pragma unroll
                for (int j = 0; j < 4; ++j) { const float v = xo[j] + par[2048 + c0 + j] * (y[hlf * 8 + q * 4 + j] * rstd * par[c0 + j]); xw[q][j] = v; xn[hlf * 8 + q * 4 + j] = v; ss2 += v * v; } }
            xrow_store8<true>(xdb, row, hlf * 512 + ln * 8, xw[0], xw[1]); }
        ss2 = wave_sum(ss2);
        const float rstd2 = rsqrtf(ss2 * (1.0f / 1024.0f) + RMS_EPS);
        float lg[16];
#pragma unroll
        for (int e = 0; e < 16; ++e) lg[e] = 0.f;
#pragma unroll
        for (int hlf = 0; hlf < 2; ++hlf) { const int c0 = hlf * 512 + ln * 8; float o[8];
#pragma unroll
            for (int j = 0; j < 8; ++j) { o[j] = xn[hlf * 8 + j] * rstd2 * par[1024 + c0 + j] * (1.0f + par[4096 + c0 + j]) + par[3072 + c0 + j];
#pragma unroll
                for (int eq = 0; eq < 4; ++eq) { const f32x4 w4 = *(const f32x4*)(wr_s + ((((hlf * 8 + j) * 4 + eq) * 64 + ln) << 2));
#pragma unroll
                    for (int e = 0; e < 4; ++e) lg[eq * 4 + e] += o[j] * w4[e]; } }
            const u32x2 ov = {f8pack4(o[0], o[1], o[2], o[3]), f8pack4(o[4], o[5], o[6], o[7])};
            stg((u32x2*)((unsigned char*)p.H() + (size_t)row * 1024 + c0), ov); }
        float r8[8], r4[4], r2[2], r1;
        { const bool b = (lane & 32) != 0;
#pragma unroll
          for (int i = 0; i < 8; ++i) { const float keep = b ? lg[i + 8] : lg[i], send = b ? lg[i] : lg[i + 8]; r8[i] = keep + shx<32>(send); } }
        { const bool b = (lane & 16) != 0;
#pragma unroll
          for (int i = 0; i < 4; ++i) { const float keep = b ? r8[i + 4] : r8[i], send = b ? r8[i] : r8[i + 4]; r4[i] = keep + shx<16>(send); } }
        { const bool b = (lane & 8) != 0;
#pragma unroll
          for (int i = 0; i < 2; ++i) { const float keep = b ? r4[i + 2] : r4[i], send = b ? r4[i] : r4[i + 2]; r2[i] = keep + shx<8>(send); } }
        { const bool b = (lane & 4) != 0; const float keep = b ? r2[1] : r2[0], send = b ? r2[0] : r2[1]; r1 = keep + shx<4>(send); }
        r1 += shx<2>(r1); r1 += shx<1>(r1);
        float mx = r1;
        mx = fmaxf(mx, shx<4>(mx)); mx = fmaxf(mx, shx<8>(mx)); mx = fmaxf(mx, shx<16>(mx)); mx = fmaxf(mx, shx<32>(mx));
        const float ex = __expf(r1 - mx);
        float se = ex;
        se += shx<4>(se); se += shx<8>(se); se += shx<16>(se); se += shx<32>(se);
        if ((lane & 3) == 0) { const int e = ((lane >> 5) & 1) * 8 + ((lane >> 4) & 1) * 4 + ((lane >> 3) & 1) * 2 + ((lane >> 2) & 1);
            stg(p.aff() + (size_t)row * 16 + e, ex * frcp(se)); }
#pragma unroll
        for (int i = 0; i < 2; ++i) ycur[i] = ynxt[i];
        xcur = xnxt;
    }
}

DEV unsigned shxu(unsigned v, int m) {
    const float f = __uint_as_float(v); float r;
    switch (m) { case 1: r = shx<1>(f); break; case 2: r = shx<2>(f); break; case 4: r = shx<4>(f); break; case 8: r = shx<8>(f); break; case 16: r = shx<16>(f); break; default: r = shx<32>(f); break; }
    return __float_as_uint(r);
}
#define TK_CX(a_, b_, desc_) do { const unsigned long long x_ = key[a_], y_ = key[b_]; const bool sw_ = (desc_) ? (x_ < y_) : (x_ > y_); key[a_] = sw_ ? y_ : x_; key[b_] = sw_ ? x_ : y_; } while (0)
template <int TJ> DEV void tk_step_sh(unsigned long long (&key)[4], int tid, bool desc4) {
    unsigned long long pk[4];
#pragma unroll
    for (int m = 0; m < 4; ++m) { const unsigned lo = __float_as_uint(shx<TJ>(__uint_as_float((unsigned)key[m]))), hi = __float_as_uint(shx<TJ>(__uint_as_float((unsigned)(key[m] >> 32))));
        pk[m] = ((unsigned long long)hi << 32) | lo; }
    const bool takemax = desc4 == ((tid & TJ) == 0);
#pragma unroll
    for (int m = 0; m < 4; ++m) { const unsigned long long x = key[m], y = pk[m]; key[m] = takemax ? (x > y ? x : y) : (x < y ? x : y); }
}
DEV void tk_step_lds(unsigned long long (&key)[4], unsigned long long* buf, int tid, int tj, bool active, bool desc4) {
    unsigned long long pk[4];
    __syncthreads();
    if (active) {
#pragma unroll
        for (int m = 0; m < 4; ++m) buf[tid * 4 + m] = key[m]; }
    __syncthreads();
#pragma unroll
    for (int m = 0; m < 4; ++m) pk[m] = active ? buf[(tid ^ tj) * 4 + m] : 0ull;
    const bool takemax = desc4 == ((tid & tj) == 0);
#pragma unroll
    for (int m = 0; m < 4; ++m) { const unsigned long long x = key[m], y = pk[m]; key[m] = takemax ? (x > y ? x : y) : (x < y ? x : y); }
}
DEV void topk_task(const Params& p, const SetDesc& sd, int task, char* shm) {
    const int tid = TID();
    const int e = task & 15, sl = task >> 4;
    unsigned long long* buf = (unsigned long long*)shm;
    const int T = 1 << sd.lgseq, cap = sd.cap;
    const int rbase = sl << sd.lgseq;
    const bool active = tid * 4 < T;
    unsigned long long key[4];
    __syncthreads();
#pragma unroll
    for (int m = 0; m < 4; ++m) { const int i = tid * 4 + m; const float a = active ? ldg(p.aff() + (size_t)(rbase + i) * 16 + e) : 0.f;
        key[m] = ((unsigned long long)__float_as_uint(a) << 32) | (unsigned)(0xFFFFFFFFu - (unsigned)i); }
    for (int k = 2; k <= T; k <<= 1) {
        const bool desc4 = ((tid * 4) & k) == 0;
        for (int j = k >> 1; j >= 256; j >>= 1) tk_step_lds(key, buf, tid, j >> 2, active, desc4);
        if (k >= 256) tk_step_sh<32>(key, tid, desc4);
        if (k >= 128) tk_step_sh<16>(key, tid, desc4);
        if (k >= 64) tk_step_sh<8>(key, tid, desc4);
        if (k >= 32) tk_step_sh<4>(key, tid, desc4);
        if (k >= 16) tk_step_sh<2>(key, tid, desc4);
        if (k >= 8) tk_step_sh<1>(key, tid, desc4);
        if (k >= 4) { TK_CX(0, 2, desc4); TK_CX(1, 3, desc4); TK_CX(0, 1, desc4); TK_CX(2, 3, desc4); }
        else { TK_CX(0, 1, true); TK_CX(2, 3, false); }
    }
    const int sbase = e * sd.rpe + sl * cap;
    if (active) {
#pragma unroll
        for (int m = 0; m < 4; ++m) { const int i = tid * 4 + m; const unsigned long long kv = key[m]; const int tok = (int)(0xFFFFFFFFu - (unsigned)(kv & 0xFFFFFFFFu));
            const int row = rbase + tok;
            if (i < cap) { stg(p.slot_token() + sbase + i, row); stg(p.slot_gate() + sbase + i, __uint_as_float((unsigned)(kv >> 32))); stg(p.token_slots() + (size_t)row * 16 + e, sbase + i); }
            else stg(p.token_slots() + (size_t)row * 16 + e, -1); } }
    if (sl == 0) { const int used = sd.nsamp * cap;
        for (int i = used + tid; i < sd.rpe; i += NTHREADS) { stg(p.slot_token() + e * sd.rpe + i, 0); stg(p.slot_gate() + e * sd.rpe + i, 0.f); } }
}
#undef TK_CX

struct SchedMoe {
    const bf16_t* A; const int* st; const bf16_t* W; int nRT, rpe, nN, wstride;
    DEV bool next(int i, GUnit& u) const { int pmx, pn; if (!tile_order(i, 16 * nRT, nN, pmx, pn)) return false; u.pm = pmx % nRT; u.aux = pmx / nRT; u.pn = pn; return true; }
    DEV int slot0(const GUnit& u) const { return u.aux * rpe + u.pm * 256; }
    DEV const bf16_t* a_base(const GUnit&) const { return A; }
    DEV int grow(const GUnit& u, int i) const { return st ? ldg(st + slot0(u) + i) : slot0(u) + i; }
    DEV const bf16_t* b_base(const GUnit& u) const { return W + (size_t)u.aux * wstride + (size_t)u.pn * 256 * 512; }
};
DEV void phase_moe_gu(const Params& p, const SetDesc& sd, int layer, char* shm) {
    SchedMoe S; S.A = p.H(); S.st = p.slot_token(); S.W = p.WguT() + (size_t)layer * 16 * 2048 * 512; S.nRT = sd.rpe / 256; S.rpe = sd.rpe; S.nN = 8; S.wstride = 2048 * 512;
    unsigned char* hb = (unsigned char*)p.HID();
    gemm_stream<true, 512, 512, 512, true>(shm, S, [=](const GUnit& u, const f32x4 (&acc)[2][2][4][2], int r0, int c0) {
#pragma unroll
        for (int ai = 0; ai < 2; ++ai)
#pragma unroll
            for (int m = 0; m < 4; ++m) { f32x4 h0, h1; const f32x4 a0 = acc[ai][0][m][0] * F8_WINV, a1 = acc[ai][0][m][1] * F8_WINV, b0 = acc[ai][1][m][0] * F8_WINV, b1 = acc[ai][1][m][1] * F8_WINV;
#pragma unroll
                for (int j = 0; j < 4; ++j) { h0[j] = a0[j] * sigmoidf_(a0[j]) * b0[j]; h1[j] = a1[j] * sigmoidf_(a1[j]) * b1[j]; }
                const u32x2 hv = {f8pack4(h0[0], h0[1], h0[2], h0[3]), f8pack4(h1[0], h1[1], h1[2], h1[3])};
                stg((u32x2*)(hb + ((size_t)S.slot0(u) + r0 + ai * 128 + m * 16) * 1024 + u.pn * 128 + c0), hv); } });
}
DEV void phase_moe_down(const Params& p, const SetDesc& sd, int layer, char* shm) {
    SchedMoe S; S.A = p.HID(); S.st = nullptr; S.W = p.WdT() + (size_t)layer * 16 * 1024 * 512; S.nRT = sd.rpe / 256; S.rpe = sd.rpe; S.nN = 4; S.wstride = 1024 * 512;
    unsigned char* yb = (unsigned char*)p.YE(); const float* gt = p.slot_gate();
    gemm_stream<true, 512, 512, 512, true>(shm, S, [=](const GUnit& u, const f32x4 (&acc)[2][2][4][2], int r0, int c0) {
#pragma unroll
        for (int ai = 0; ai < 2; ++ai) {
            float gv[4];
#pragma unroll
            for (int m = 0; m < 4; ++m) gv[m] = ldg(gt + (size_t)S.slot0(u) + r0 + ai * 128 + m * 16) * (F8_WINV * YE_SCALE);
#pragma unroll
            for (int m = 0; m < 4; ++m) { const size_t sl = (size_t)S.slot0(u) + r0 + ai * 128 + m * 16; const float g = gv[m];
                unsigned char* o = yb + sl * 1024 + u.pn * 256 + c0;
#pragma unroll
                for (int hf = 0; hf < 2; ++hf) { const f32x4 a = acc[ai][hf][m][0] * g, b = acc[ai][hf][m][1] * g;
                    const u32x2 ov = {f8pack4(a[0], a[1], a[2], a[3]), f8pack4(b[0], b[1], b[2], b[3])}; stg((u32x2*)(o + hf * 128), ov); } } } });
}

DEV void compact4(const int (&sl)[16], int (&c)[4], int& n) {
    n = 0; c[0] = -1; c[1] = -1; c[2] = -1; c[3] = -1;
#pragma unroll
    for (int e = 0; e < 16; ++e) if (sl[e] >= 0) { c[0] = (n == 0) ? sl[e] : c[0]; c[1] = (n == 1) ? sl[e] : c[1]; c[2] = (n == 2) ? sl[e] : c[2]; c[3] = (n == 3) ? sl[e] : c[3]; ++n; }
}
template <bool DST_F32> DEV void phase_combine(const Params& p, const SetDesc& sd, int layer, char* shm) {
    const int tid = TID(), lane = tid & 63, wv = tid >> 6;
    const float* g3 = p.norm_gain + ((size_t)layer * 4 + 3) * 1024;
    const bf16_t* xsb = xbf_base(p, sd); void* xdb = DST_F32 ? (void*)xout_f32(p, sd) : (void*)xbf_base(p, sd);
    const int stride = 8; const int rpb_ = (sd.nrows + (int)gridDim.x - 1) / (int)gridDim.x; const int row_end = min(sd.nrows, ((int)blockIdx.x + 1) * rpb_);
    int row = __builtin_amdgcn_readfirstlane((int)blockIdx.x * rpb_ + wv);
    float* par = (float*)shm;
    __syncthreads();
    { const float* mdb = mod_row(p, sd, layer, min((int)blockIdx.x * rpb_, sd.nrows - 1)); stage_params(par, g3, mdb + 5120, nullptr, nullptr, nullptr); }
    __syncthreads();
    int raw[16]; int cc[4], cn[4]; int nc = 0, nn = 0;
    u32x2 mc[4][2], mn[4][2]; XRow<true> xc, xn;
#define CMB_SLOTS(r_) do { _Pragma("unroll") for (int e = 0; e < 16; ++e) raw[e] = ldg(p.token_slots() + (size_t)(r_) * 16 + e); } while (0)
#define CMB_DATA(r_, c_, n_, m_, x_) do { _Pragma("unroll") for (int k = 0; k < 4; ++k) { \
            if (k < (n_)) { const unsigned char* yr = (const unsigned char*)p.YE() + (size_t)(c_)[k] * 1024 + lane * 8; (m_)[k][0] = ldg((const u32x2*)yr); (m_)[k][1] = ldg((const u32x2*)(yr + 512)); } \
            else { (m_)[k][0] = (u32x2){0u, 0u}; (m_)[k][1] = (u32x2){0u, 0u}; } } \
        (x_).load(xsb, (r_), lane); } while (0)
    if (row < row_end) { CMB_SLOTS(row); compact4(raw, cc, nc); CMB_DATA(row, cc, nc, mc, xc); if (row + stride < row_end) CMB_SLOTS(row + stride); }
    for (; row < row_end; row += stride) {
        const int rn = row + stride;
        if (rn < row_end) { compact4(raw, cn, nn); CMB_DATA(rn, cn, nn, mn, xn); if (rn + stride < row_end) CMB_SLOTS(rn + stride); }
        float y[16];
#pragma unroll
        for (int j = 0; j < 16; ++j) y[j] = 0.f;
        if (nc <= 4) {
#pragma unroll
            for (int k = 0; k < 4; ++k)
                if (k < nc) {
#pragma unroll
                    for (int hlf = 0; hlf < 2; ++hlf) { const f32x4 a = f8x4_f32(mc[k][hlf].x), b = f8x4_f32(mc[k][hlf].y);
#pragma unroll
                        for (int j = 0; j < 4; ++j) { y[hlf * 8 + j] += a[j]; y[hlf * 8 + 4 + j] += b[j]; } } }
        } else {
            for (int e = 0; e < 16; ++e) { const int sl_ = ldg(p.token_slots() + (size_t)row * 16 + e);
                if (sl_ >= 0) { const unsigned char* yr = (const unsigned char*)p.YE() + (size_t)sl_ * 1024 + lane * 8;
#pragma unroll
                    for (int hlf = 0; hlf < 2; ++hlf) { const u32x2 m = ldg((const u32x2*)(yr + hlf * 512)); const f32x4 a = f8x4_f32(m.x), b = f8x4_f32(m.y);
#pragma unroll
                        for (int j = 0; j < 4; ++j) { y[hlf * 8 + j] += a[j]; y[hlf * 8 + 4 + j] += b[j]; } } } }
        }
        float ss = 0.f;
#pragma unroll
        for (int j = 0; j < 16; ++j) ss += y[j] * y[j];
        ss = wave_sum(ss);
        const float rstd = rsqrtf(ss * (YE_INV * YE_INV / 1024.0f) + RMS_EPS) * YE_INV;
#pragma unroll
        for (int hlf = 0; hlf < 2; ++hlf) { f32x4 xv[2];
#pragma unroll
            for (int q = 0; q < 2; ++q) { const int c0 = hlf * 512 + lane * 8 + q * 4; xv[q] = xc.get(hlf * 2 + q);
#pragma unroll
                for (int j = 0; j < 4; ++j) xv[q][j] += par[1024 + c0 + j] * (y[hlf * 8 + q * 4 + j] * rstd * par[c0 + j]); }
            xrow_store8<!DST_F32>(xdb, row, hlf * 512 + lane * 8, xv[0], xv[1]); }
        nc = nn;
#pragma unroll
        for (int k = 0; k < 4; ++k) { cc[k] = cn[k]; mc[k][0] = mn[k][0]; mc[k][1] = mn[k][1]; }
        xc = xn;
    }
#undef CMB_SLOTS
#undef CMB_DATA
}

constexpr int WQ_WORD0 = 4096;
template <class F> DEV void wq_run(const Params& p, int qidx, int ntasks, char* shm, F&& task) {
    unsigned* ctr = p.bar() + WQ_WORD0 + 64 * qidx;
    volatile int* slot = (volatile int*)(shm + 131072 + 64);
    const int tid = TID();
    int cur = blockIdx.x;
    while (cur < ntasks) {
        unsigned pend = 0u;
        if (tid == 0) pend = atomicAdd(ctr, 1u);
        task(cur);
        __syncthreads();
        if (tid == 0) *slot = (int)gridDim.x + (int)pend;
        __syncthreads();
        cur = *slot;
    }
}

template <int PH> DEV void do_phase(const Params& p, int layer, int is_ctx, int grp, char* shm) {
    const SetDesc sd = make_set(is_ctx, grp);
    if constexpr (PH == -1) phase_prologue(p, shm);
    if constexpr (PH == 0) { if (layer == 0) phase_norm1<false>(p, sd, layer, shm); else phase_norm1<true>(p, sd, layer, shm); }
    if constexpr (PH == 1) phase_proj_a(p, sd, layer, shm);
    const int qbase = ((layer * 3 + (is_ctx ? 0 : grp + 1)) * 13 + (PH < 0 ? 0 : PH)) * 2;
    if constexpr (PH == 2) { wq_run(p, qbase, sd.nsamp * 4 * sd.ntb, shm, [&](int t) { mlstm_stepA_task(p, sd, layer, t, shm); }); if (!(is_ctx && layer == 1)) phase_pool(p, sd); }
    if constexpr (PH == 3) {
        for (int t = blockIdx.x; t < sd.nsamp * 32; t += gridDim.x) mlstm_stepB_task(p, sd, t);
        if (!(is_ctx && layer == 1)) {
            const int nq = (is_ctx ? (CTX / 64) : ROWS) / 2;
            wq_run(p, qbase, sd.nsamp * nq * 4, shm, [&](int t) { na_task(p, sd, layer, t / (nq * 4), (t >> 2) % nq, t & 3, shm); });
        }
    }
    if constexpr (PH == 4) { wq_run(p, qbase, sd.nsamp * 4 * sd.ntb, shm, [&](int t) { mlstm_stepC_task(p, sd, layer, t, shm); }); }
    if constexpr (PH == 5) phase_proj_b(p, sd, layer, shm);
    if constexpr (PH == 6) phase_merge(p, sd, layer, shm);
    if constexpr (PH == 7) phase_outproj(p, sd, layer, shm);
    if constexpr (PH == 8) { if (layer == 0) phase_postmix<false>(p, sd, layer, shm); else phase_postmix<true>(p, sd, layer, shm); }
    if constexpr (PH == 9) { for (int t = blockIdx.x; t < sd.nsamp * 16; t += gridDim.x) topk_task(p, sd, t, shm); }
    if constexpr (PH == 10) phase_moe_gu(p, sd, layer, shm);
    if constexpr (PH == 11) phase_moe_down(p, sd, layer, shm);
    if constexpr (PH == 12) { if (layer == 0) phase_combine<false>(p, sd, layer, shm); else phase_combine<true>(p, sd, layer, shm); }
}

#ifndef CPU_EMU
template <int PH> __global__ void __launch_bounds__(NTHREADS, 2) k_phase(Params p, int layer, int is_ctx, int grp) {
    DYN_LDS(shm);
    do_phase<PH>(p, layer, is_ctx, grp, shm);
}
#ifndef DBL_MASK
#define DBL_MASK 0
#endif
#define RUNPH(PH) do { do_phase<PH>(p, layer, is_ctx, grp, shm); xcd_barrier(bar); if ((DBL_MASK >> (PH)) & 1) { do_phase<PH>(p, layer, is_ctx, grp, shm); xcd_barrier(bar); } } while (0)
__global__ void __launch_bounds__(NTHREADS, 2) k_mega(Params p) {
    DYN_LDS(shm);
    uint4* xbw = (uint4*)(shm + 131072);
    if (threadIdx.x == 0) *xbw = make_uint4(0u, 0u, 0u, 0u);
    __syncthreads();
    XcdBarrier bar = xcd_barrier_post(p.bar(), (volatile LAS unsigned*)xbw);
    do_phase<-1>(p, 0, 0, 0, shm);
    xcd_barrier(bar);
    for (int layer = 0; layer < 2; ++layer)
        for (int si = 0; si <= NG; ++si) {
            const int is_ctx = si == 0 ? 1 : 0, grp = si == 0 ? 0 : si - 1;
            RUNPH(0); RUNPH(1); RUNPH(2);
            if (is_ctx && layer == 1) { do_phase<3>(p, layer, is_ctx, grp, shm); continue; }
            RUNPH(3); RUNPH(4); RUNPH(5); RUNPH(6); RUNPH(7); RUNPH(8); RUNPH(9); RUNPH(10); RUNPH(11);
            do_phase<12>(p, layer, is_ctx, grp, shm);
        }
}
#endif
}

static Params make_params(void* const* d_in, void* d_out, void* d_ws) {
    Params p{};
    p.x = (const float*)d_in[0]; p.c = (const float*)d_in[1]; p.ctx = (const float*)d_in[2]; p.c_ctx = (const float*)d_in[3];
    p.norm_gain = (const float*)d_in[4]; p.ada_w = (const float*)d_in[5]; p.ada_b = (const float*)d_in[6]; p.w_in = (const float*)d_in[7];
    p.gate_bias = (const float*)d_in[8]; p.pool_w = (const float*)d_in[9]; p.pool_scale = (const float*)d_in[10]; p.rpb = (const float*)d_in[11];
    p.w_branch = (const float*)d_in[12]; p.w_out = (const float*)d_in[13]; p.router_w = (const float*)d_in[14];
    p.w_gate = (const float*)d_in[15]; p.w_up = (const float*)d_in[16]; p.w_down = (const float*)d_in[17];
    p.out = (float*)d_out; p.ws = (char*)d_ws;
    return p;
}

#ifdef CPU_EMU
int emu_cfg_B = CFG_B, emu_cfg_ROWS = CFG_ROWS, emu_cfg_CTX = CFG_CTX;
const char* g_dumpdir = "data";
static void* g_ws = nullptr;
static void dump_buf(const char* name, int layer, int is_ctx, int grp, const void* ptr, size_t bytes) {
    char nm[512]; snprintf(nm, sizeof nm, "%s/d_L%d_%s%d_%s.bin", g_dumpdir, layer, is_ctx ? "c" : "g", grp, name);
    FILE* f = fopen(nm, "wb"); fwrite(ptr, 1, bytes, f); fclose(f);
}
static void emu_hook(const Params& p, int layer, int is_ctx, int grp, int ph) {
    const size_t Rn = is_ctx ? RC : RL;
    if (ph == 0) dump_buf("H", layer, is_ctx, grp, p.H(), Rn * 1024 * 2);
    if (ph == 1) dump_buf("PROJ", layer, is_ctx, grp, is_ctx ? p.PROJc() : p.PROJa(), Rn * PWA * 2);
    if (ph == 2) dump_buf("Pb", layer, is_ctx, grp, p.Pb(), Rn * 512 * 2);
    if (ph == 3) dump_buf("Nb", layer, is_ctx, grp, p.Nb(), Rn * 512 * 2);
    if (ph == 4) dump_buf("Mb", layer, is_ctx, grp, p.Mb(), Rn * 512 * 2);
    if (ph == 5) dump_buf("BG", layer, is_ctx, grp, p.BG(), Rn * NBG * 2);
    if (ph == 6) dump_buf("MERGED", layer, is_ctx, grp, p.MERGED(), Rn * 1024 * 2);
    if (ph == 7) dump_buf("Y", layer, is_ctx, grp, p.Y(), Rn * 1024 * 2);
    if (ph == 8) { dump_buf("H2", layer, is_ctx, grp, p.H(), Rn * 1024 * 2); dump_buf("aff", layer, is_ctx, grp, p.aff(), Rn * 16 * 4); }
}
void emu_dump(const char* dir) {
    char nm[512]; snprintf(nm, sizeof nm, "%s/d_mod.bin", dir);
    FILE* f = fopen(nm, "wb"); fwrite((char*)g_ws + WSL.mod, 1, (size_t)2 * (NB + 1) * 6144 * 4, f); fclose(f);
    snprintf(nm, sizeof nm, "%s/d_ctxs.bin", dir);
    f = fopen(nm, "wb"); fwrite((char*)g_ws + WSL.ctxs, 1, (size_t)NB * CTX * 1024 * 2, f); fclose(f);
}
template <int PH> static void emu_run_phase(const Params& p, int layer, int is_ctx, int grp, int nblocks) {
    emu_launch_lambda([=]() { do_phase<PH>(p, layer, is_ctx, grp, emu_blk->smem); }, nblocks, NTHREADS, LDS_BYTES);
    if (PH >= 0) emu_hook(p, layer, is_ctx, grp, PH);
    printf("phase %d layer %d ctx %d grp %d done\n", PH, layer, is_ctx, grp); fflush(stdout);
}
#define LAUNCH_PHASE(PH) emu_run_phase<PH>(p, layer, is_ctx, grp, nblocks)
#else
#define LAUNCH_PHASE(PH) hipLaunchKernelGGL((k_phase<PH>), dim3(nblocks), dim3(NTHREADS), LDS_BYTES, stream, p, layer, is_ctx, grp)
#define SETATTR(PH) (void)hipFuncSetAttribute((const void*)k_phase<PH>, hipFuncAttributeMaxDynamicSharedMemorySize, LDS_BYTES)
#endif

extern "C" void kernel_launch(void* const* d_in, const int* in_sizes, int n_in, void* d_out, int out_size, void* d_ws, size_t ws_size, hipStream_t stream) {
    (void)in_sizes; (void)n_in; (void)out_size;
    if (ws_size < WSL.total) return;
    Params p = make_params(d_in, d_out, d_ws);
#ifdef CPU_EMU
    g_ws = d_ws;
    memset(d_ws, 0xFF, WSL.total);
    memset((char*)d_ws + WSL.bar, 0, 65536);
    const int nblocks = 16;
#else
    const int nblocks = 256;
#if MK_ONE_LAUNCH
    static int grid = 0;
    if (!grid) {
        (void)hipFuncSetAttribute((const void*)k_mega, hipFuncAttributeMaxDynamicSharedMemorySize, LDS_BYTES);
        int dev = 0, cus = 0, per_cu = 0;
        (void)hipGetDevice(&dev);
        (void)hipDeviceGetAttribute(&cus, hipDeviceAttributeMultiprocessorCount, dev);
        (void)hipOccupancyMaxActiveBlocksPerMultiprocessor(&per_cu, (const void*)k_mega, NTHREADS, LDS_BYTES);
        if (per_cu > 1) per_cu = 1;
        grid = cus * per_cu;
        if (grid > 256) grid = 256;
    }
    if (grid <= 0) return;
    (void)hipMemsetAsync(p.bar(), 0, 65536, stream);
    hipLaunchKernelGGL(k_mega, dim3(grid), dim3(NTHREADS), LDS_BYTES, stream, p);
    return;
#else
    static bool attr_done = false;
    if (!attr_done) { SETATTR(-1); SETATTR(0); SETATTR(1); SETATTR(2); SETATTR(3); SETATTR(4); SETATTR(5); SETATTR(6); SETATTR(7); SETATTR(8); SETATTR(9); SETATTR(10); SETATTR(11); SETATTR(12); attr_done = true; }
#endif
#endif
    { const int layer = 0, is_ctx = 0, grp = 0; LAUNCH_PHASE(-1); }
    for (int layer = 0; layer < 2; ++layer)
        for (int si = 0; si <= NG; ++si) {
            const int is_ctx = si == 0 ? 1 : 0, grp = si == 0 ? 0 : si - 1;
            LAUNCH_PHASE(0); LAUNCH_PHASE(1); LAUNCH_PHASE(2); LAUNCH_PHASE(3);
            if (is_ctx && layer == 1) continue;
            LAUNCH_PHASE(4); LAUNCH_PHASE(5); LAUNCH_PHASE(6); LAUNCH_PHASE(7); LAUNCH_PHASE(8); LAUNCH_PHASE(9); LAUNCH_PHASE(10); LAUNCH_PHASE(11); LAUNCH_PHASE(12);
        }
}
```

```cpp
#ifdef CPU_EMU
#include "emu.h"
#define DYN_LDS(p) char* p = emu_blk->smem
#define WAIT_V(n)
#define WAIT_L(n)
#define HIDE(v)
#define CBAR()
#else
#include <hip/hip_runtime.h>
#define DYN_LDS(p) extern __shared__ __attribute__((aligned(16))) char p[]
#define WAIT_V(n) asm volatile("s_waitcnt vmcnt(" #n ")" ::: "memory")
#define WAIT_L(n) asm volatile("s_waitcnt lgkmcnt(" #n ")" ::: "memory")
#define HIDE(v) asm volatile("" : "+v"(v))
#define CBAR() asm volatile("" ::: "memory")
#endif
#include <stdint.h>
#include <stddef.h>

#ifndef CFG_B
#define CFG_B 32
#define CFG_ROWS 32
#define CFG_CTX 256
#define CFG_G 16
#endif
#ifndef MK_ONE_LAUNCH
#define MK_ONE_LAUNCH 1
#endif

#define DEV __device__ __forceinline__
typedef short s16x4 __attribute__((ext_vector_type(4)));
#ifdef CPU_EMU
#define TR16(ptr) emu_tr16((const void*)(ptr))
#else
typedef __attribute__((address_space(3))) s16x4 lds_s16x4;
#define TR16(ptr) __builtin_amdgcn_ds_read_tr16_b64_v4i16((lds_s16x4*)(ptr))
#endif
#ifdef CPU_EMU
#define TID() (threadIdx.x)
#else
#define TID() ({ int t_ = threadIdx.x; asm volatile("" : "+v"(t_)); t_; })
#endif

typedef unsigned short bf16_t;
typedef short bf16x8 __attribute__((ext_vector_type(8)));
typedef float f32x4 __attribute__((ext_vector_type(4)));
typedef unsigned u32x2 __attribute__((ext_vector_type(2)));
typedef unsigned u32x4 __attribute__((ext_vector_type(4)));

namespace {
constexpr int D = 1024, NB = CFG_B, ROWS = CFG_ROWS, SEQ = ROWS * 64, CTX = CFG_CTX, G = CFG_G, NG = NB / G;
constexpr int RL = G * SEQ, RC = NB * CTX, RMAX = RL > RC ? RL : RC;
constexpr int PWA = 3840, NBG = 3072, PWT = PWA + NBG, PWSRC = 6672, C_SPLIT = 3600;
constexpr int C_QM = 0, C_KM = 256, C_PU = 512, C_GM = 1024, C_PADA = 1040, C_F8 = 1280, C_QN = 1280, C_KN = 1792, C_VM = 2304, C_OM = 2816, C_VN = 3328;
constexpr int proj_col(int n) { return n < 512 ? n : n < 1536 ? n + 1792 : n < 1552 ? n - 512 : n < 2064 ? n - 1040 : n < 3088 ? n - 784 : n + 240; }
static_assert(proj_col(512) == C_VM && proj_col(1024) == C_OM && proj_col(1536) == C_GM && proj_col(1552) == C_PU && proj_col(2064) == C_QN && proj_col(2576) == C_KN && proj_col(3088) == C_VN && proj_col(3599) == PWA - 1, "projection column map");
constexpr int NTBL = SEQ / 128, NTBC = CTX / 128;
constexpr int ilog2(int x) { return x <= 1 ? 0 : 1 + ilog2(x >> 1); }
constexpr int LGSEQ = ilog2(SEQ), LGCTX = ilog2(CTX);
static_assert((1 << LGSEQ) == SEQ && (1 << LGCTX) == CTX, "sequence lengths must be powers of two");
constexpr int cdiv(int a, int b) { return (a + b - 1) / b; }
constexpr int RPE_L = cdiv(G * (SEQ / 8), 256) * 256, RPE_C = cdiv(NB * (CTX / 8), 256) * 256, RPE_MAX = RPE_L > RPE_C ? RPE_L : RPE_C;
constexpr int NSLOT = 16 * RPE_MAX;
constexpr int NTHREADS = 512;
constexpr int GT_MAXU = 12;
constexpr int LDS_BYTES = 131072 + 256 + GT_MAXU * 1024;
constexpr int NST_L = G * 4 * 2 * NTBL, NST_C = NB * 4 * 2 * NTBC, NST = NST_L > NST_C ? NST_L : NST_C;
constexpr int NCI = NB * 4 * 2;
constexpr float RMS_EPS = 1e-6f;

struct WsLayout { size_t bar, WinT, WbT, WoT, WguT, WdT, mod, rope, ctxs, xb, PROJc, CiC, Cin_, Cim, H, H8, PROJa, Sst, Cin, Mb, Pb, Nb, Sn, Ssc, Cn, Cm, aff, slot_token, slot_gate, token_slots, HID, YE, BG, MERGED, Y, total; };
constexpr size_t al(size_t x) { return (x + 255) / 256 * 256; }
constexpr size_t smax(size_t a, size_t b) { return a > b ? a : b; }
constexpr WsLayout make_layout() {
    WsLayout L{}; size_t o = 0;
    L.bar = o; o += al(65536);
    L.WinT = o; o += al((size_t)2 * PWT * 1024 * 2);
    L.WbT = o; o += al((size_t)2 * 3 * 1024 * 512 * 2);
    L.WoT = o; o += al((size_t)2 * 1024 * 1024 * 2);
    L.WguT = o; o += al((size_t)2 * 16 * 2048 * 1024);
    L.WdT = o; o += al((size_t)2 * 16 * 1024 * 1024);
    L.mod = o; o += al((size_t)2 * (NB + 1) * 6144 * 4);
    L.rope = o; o += al((size_t)(ROWS + 64) * 16 * 2 * 4);
    L.ctxs = o; o += al((size_t)NB * CTX * 1024 * 2);
    L.xb = o; o += al((size_t)NB * SEQ * 1024 * 2);
    L.PROJc = o; o += al((size_t)RC * PWA * 2);
    L.CiC = o; o += al((size_t)NCI * 8192 * 4);
    L.Cin_ = o; o += al((size_t)NCI * 64 * 4);
    L.Cim = o; o += al((size_t)NCI * 4 * 4);
    L.H = o; o += al((size_t)RMAX * 1024 * 2);
    L.H8 = o; o += al((size_t)RMAX * 1024);
    const size_t x0 = o;
    L.PROJa = o; o += al((size_t)RMAX * PWA * 2);
    L.Sst = o; o += al((size_t)NST * 8192 * 4);
    L.Cin = o; o += al((size_t)NST * 8192 * 2);
    const size_t hid = al((size_t)NSLOT * 1024 * 2);
    o = x0 + smax(o - x0, 2 * hid);
    L.HID = x0; L.YE = x0 + hid;
    L.Mb = o; o += al((size_t)RMAX * 512 * 2);
    L.Pb = o; o += al((size_t)RMAX * 512 * 2);
    L.Nb = o; o += al((size_t)RMAX * 512 * 2);
    L.MERGED = L.H; L.Y = L.Mb;
    L.BG = o; o += al((size_t)RMAX * NBG);
    L.Sn = o; o += al((size_t)NST * 64 * 4);
    L.Ssc = o; o += al((size_t)NST * 4 * 4);
    L.Cn = o; o += al((size_t)NST * 64 * 4);
    L.Cm = o; o += al((size_t)NST * 4 * 4);
    L.aff = o; o += al((size_t)RMAX * 16 * 4);
    L.slot_token = o; o += al((size_t)NSLOT * 4);
    L.slot_gate = o; o += al((size_t)NSLOT * 4);
    L.token_slots = o; o += al((size_t)RMAX * 16 * 4);
    L.total = o;
    return L;
}
constexpr WsLayout WSL = make_layout();
static_assert(CFG_B != 32 || WSL.total <= ((size_t)1 << 30), "workspace budget");

struct Params {
    const float *x, *c, *ctx, *c_ctx, *norm_gain, *ada_w, *ada_b, *w_in, *gate_bias, *pool_w, *pool_scale, *rpb, *w_branch, *w_out, *router_w, *w_gate, *w_up, *w_down;
    float* out;
    char* ws;
#ifdef CPU_EMU
#define WSF(T, name) __device__ __host__ __forceinline__ T* name() const { return (T*)(ws + WSL.name); }
#else
#if defined(__HIP_DEVICE_COMPILE__)
#define WSF(T, name) __device__ __host__ __forceinline__ T* name() const { char* w_ = ws; asm volatile("" : "+s"(w_)); return (T*)(__attribute__((address_space(1))) T*)(w_ + WSL.name); }
#else
#define WSF(T, name) __device__ __host__ __forceinline__ T* name() const { return (T*)(ws + WSL.name); }
#endif
#endif
    WSF(unsigned, bar) WSF(bf16_t, WinT) WSF(bf16_t, WbT) WSF(bf16_t, WoT) WSF(bf16_t, WguT) WSF(bf16_t, WdT)
    WSF(float, mod) WSF(float, rope) WSF(bf16_t, ctxs) WSF(bf16_t, xb) WSF(bf16_t, PROJc) WSF(float, CiC) WSF(float, Cin_) WSF(float, Cim)
    WSF(bf16_t, H) WSF(unsigned char, H8) WSF(bf16_t, PROJa) WSF(float, Sst) WSF(bf16_t, Cin) WSF(bf16_t, Mb) WSF(bf16_t, Pb) WSF(bf16_t, Nb)
    WSF(float, Sn) WSF(float, Ssc) WSF(float, Cn) WSF(float, Cm) WSF(float, aff) WSF(int, slot_token) WSF(float, slot_gate) WSF(int, token_slots)
    WSF(bf16_t, HID) WSF(bf16_t, YE) WSF(unsigned char, BG) WSF(bf16_t, MERGED) WSF(bf16_t, Y)
#undef WSF
};

struct SetDesc { int is_ctx, nrows, samp0, nsamp, lgseq, ntb, cap, rpe; };
DEV SetDesc make_set(int is_ctx, int grp) {
    SetDesc s;
    s.is_ctx = is_ctx;
    if (is_ctx) { s.nrows = RC; s.samp0 = 0; s.nsamp = NB; s.lgseq = LGCTX; s.ntb = NTBC; s.cap = CTX / 8; s.rpe = RPE_C; }
    else { s.nrows = RL; s.samp0 = grp * G; s.nsamp = G; s.lgseq = LGSEQ; s.ntb = NTBL; s.cap = SEQ / 8; s.rpe = RPE_L; }
    return s;
}

#ifdef CPU_EMU
#define GAS
#else
#define GAS __attribute__((address_space(1)))
#endif
template <class T> DEV T ldg(const T* p) { return *(const GAS T*)p; }
template <class T> DEV void stg(T* p, const T& v) { *(GAS T*)p = v; }
DEV float bf2f(bf16_t v) { return __uint_as_float(((unsigned)v) << 16); }
DEV bf16_t f2bf(float f) { unsigned u = __float_as_uint(f); u += 0x7FFFu + ((u >> 16) & 1u); return (bf16_t)(u >> 16); }
#if defined(__HIP_DEVICE_COMPILE__)
typedef __bf16 bf16n2 __attribute__((ext_vector_type(2)));
typedef float f32n2 __attribute__((ext_vector_type(2)));
DEV unsigned pack2(float lo, float hi) { f32n2 v = {lo, hi}; bf16n2 r = __builtin_convertvector(v, bf16n2); return __builtin_bit_cast(unsigned, r); }
#else
DEV unsigned pack2(float lo, float hi) { return (unsigned)f2bf(lo) | ((unsigned)f2bf(hi) << 16); }
#endif
DEV float lo16(unsigned u) { return __uint_as_float(u << 16); }
DEV float hi16(unsigned u) { return __uint_as_float(u & 0xFFFF0000u); }
#if defined(__HIP_DEVICE_COMPILE__)
DEV float frcp(float x) { return __builtin_amdgcn_rcpf(x); }
#else
DEV float frcp(float x) { return 1.0f / x; }
#endif
#if defined(__HIP_DEVICE_COMPILE__)
DEV float sigmoidf_(float x) { return __builtin_amdgcn_rcpf(1.0f + __expf(-x)); }
#else
DEV float sigmoidf_(float x) { return 1.0f / (1.0f + __expf(-x)); }
#endif
DEV float logsigmoidf_(float x) { return fminf(x, 0.0f) - __logf(1.0f + __expf(-fabsf(x))); }
template <int M> DEV float shx(float v) {
#if defined(__HIP_DEVICE_COMPILE__)
    const unsigned u = __builtin_bit_cast(unsigned, v);
    if constexpr (M == 1) return __builtin_bit_cast(float, __builtin_amdgcn_update_dpp(u, u, 0xB1, 0xF, 0xF, false));
    else if constexpr (M == 2) return __builtin_bit_cast(float, __builtin_amdgcn_update_dpp(u, u, 0x4E, 0xF, 0xF, false));
    else if constexpr (M == 4) { const unsigned t = __builtin_amdgcn_update_dpp(u, u, 0x141, 0xF, 0xF, false);
        return __builtin_bit_cast(float, __builtin_amdgcn_update_dpp(t, t, 0x1B, 0xF, 0xF, false)); }
    else if constexpr (M == 8) return __builtin_bit_cast(float, __builtin_amdgcn_update_dpp(u, u, 0x128, 0xF, 0xF, false));
    else if constexpr (M == 16) { const auto r = __builtin_amdgcn_permlane16_swap(u, u, false, false); return __builtin_bit_cast(float, (threadIdx.x & 16) ? r[0] : r[1]); }
    else { const auto r = __builtin_amdgcn_permlane32_swap(u, u, false, false); return __builtin_bit_cast(float, (threadIdx.x & 32) ? r[0] : r[1]); }
#else
    return __shfl_xor(v, M);
#endif
}
DEV float wave_sum(float v) { v += shx<32>(v); v += shx<16>(v); v += shx<8>(v); v += shx<4>(v); v += shx<2>(v); v += shx<1>(v); return v; }
DEV bf16x8 mk8(u32x2 lo, u32x2 hi) { u32x4 v = {lo.x, lo.y, hi.x, hi.y}; return __builtin_bit_cast(bf16x8, v); }
DEV bf16x8 mk8(u32x4 v) { return __builtin_bit_cast(bf16x8, v); }
DEV bf16x8 mk8(s16x4 lo, s16x4 hi) { return __builtin_shufflevector(lo, hi, 0, 1, 2, 3, 4, 5, 6, 7); }
DEV f32x4 mfma16(bf16x8 a, bf16x8 b, f32x4 c) { return __builtin_amdgcn_mfma_f32_16x16x32_bf16(a, b, c, 0, 0, 0); }
DEV unsigned f8enc1(float x) {
    const unsigned sgn = x < 0.f ? 0x80u : 0u; float a = x < 0.f ? -x : x; if (!(a < 448.f)) a = 448.f;
    if (a < 0.015625f) { const int q = (int)(a * 512.f + 0.5f); const float r = a * 512.f; int qq = q; if ((float)q - r == 0.5f && (q & 1)) qq = q - 1; return sgn | (unsigned)qq; }
    int e = 0; float m = a; while (m >= 2.f) { m *= 0.5f; ++e; } while (m < 1.f) { m *= 2.f; --e; }
    const float r = (m - 1.f) * 8.f; int q = (int)(r + 0.5f); if ((float)q - r == 0.5f && (q & 1)) --q;
    if (q == 8) { q = 0; ++e; }
    return sgn | (unsigned)((e + 7) << 3) | (unsigned)q;
}
#if defined(__HIP_DEVICE_COMPILE__)
DEV unsigned f8pack4(float a, float b, float c, float d) {
    a = __builtin_amdgcn_fmed3f(a, -448.f, 448.f); b = __builtin_amdgcn_fmed3f(b, -448.f, 448.f); c = __builtin_amdgcn_fmed3f(c, -448.f, 448.f); d = __builtin_amdgcn_fmed3f(d, -448.f, 448.f);
    int w = 0; w = __builtin_amdgcn_cvt_pk_fp8_f32(a, b, w, false); w = __builtin_amdgcn_cvt_pk_fp8_f32(c, d, w, true); return (unsigned)w; }
#else
DEV unsigned f8pack4(float a, float b, float c, float d) { return f8enc1(a) | (f8enc1(b) << 8) | (f8enc1(c) << 16) | (f8enc1(d) << 24); }
#endif
DEV float f8dec1(unsigned v) {
    const unsigned e = (v >> 3) & 15u, m = v & 7u; float r = e == 0 ? (float)m * (1.0f / 512.0f) : __uint_as_float(((e + 120u) << 23) | (m << 20));
    return (v & 0x80u) ? -r : r;
}
#if defined(__HIP_DEVICE_COMPILE__)
DEV f32x4 f8x4_f32(unsigned w) { const auto lo = __builtin_amdgcn_cvt_pk_f32_fp8((int)w, false), hi = __builtin_amdgcn_cvt_pk_f32_fp8((int)w, true); return (f32x4){lo[0], lo[1], hi[0], hi[1]}; }
#else
DEV f32x4 f8x4_f32(unsigned w) { return (f32x4){f8dec1(w & 255u), f8dec1((w >> 8) & 255u), f8dec1((w >> 16) & 255u), f8dec1(w >> 24)}; }
#endif
constexpr float YE_SCALE = 32.0f, YE_INV = 1.0f / 32.0f;
#ifdef CPU_EMU
DEV f32x4 mfma_f8(bf16x8 a0, bf16x8 a1, bf16x8 b0, bf16x8 b1, f32x4 c) { return emu_mfma_f8(a0, a1, b0, b1, c); }
#else
typedef int i32x4 __attribute__((ext_vector_type(4)));
typedef int i32x8 __attribute__((ext_vector_type(8)));
DEV f32x4 mfma_f8(bf16x8 a0, bf16x8 a1, bf16x8 b0, bf16x8 b1, f32x4 c) {
    const i32x8 A = __builtin_shufflevector(__builtin_bit_cast(i32x4, a0), __builtin_bit_cast(i32x4, a1), 0, 1, 2, 3, 4, 5, 6, 7);
    const i32x8 B = __builtin_shufflevector(__builtin_bit_cast(i32x4, b0), __builtin_bit_cast(i32x4, b1), 0, 1, 2, 3, 4, 5, 6, 7);
    return __builtin_amdgcn_mfma_scale_f32_16x16x128_f8f6f4(A, B, c, 0, 0, 0, 0, 0, 0);
}
#endif
constexpr float F8_WSCALE = 64.0f, F8_WINV = 1.0f / 64.0f;
DEV void store8bf(bf16_t* o, f32x4 a, f32x4 b) { u32x4 v = {pack2(a[0], a[1]), pack2(a[2], a[3]), pack2(b[0], b[1]), pack2(b[2], b[3])}; stg((u32x4*)o, v); }

#ifndef CPU_EMU
#define XB_TMO      128
#define XB_XCNT(j)  (256  + 64 * (j))
#define XB_XSUB(j)  (1280 + 64 * (j))
#define XB_XGEN(j)  (2304 + 64 * (j))
#define XB_TOP      3328
#define XB_TOPGEN   3392
#define XCD_BAR_WORDS 3456
#define XB_SPIN_CAP (1u << 18)
#define LAS __attribute__((address_space(3)))
__device__ __forceinline__ unsigned xb_ld(unsigned* p)              { return __hip_atomic_load(p, __ATOMIC_RELAXED, __HIP_MEMORY_SCOPE_AGENT); }
__device__ __forceinline__ unsigned xb_add(unsigned* p, unsigned v) { return __hip_atomic_fetch_add(p, v, __ATOMIC_RELAXED, __HIP_MEMORY_SCOPE_AGENT); }
__device__ __forceinline__ unsigned xb_xcc_id() { return (unsigned)__builtin_amdgcn_s_getreg((3 << 11) | 20) & 0xFu; }
#define XB_SPIN(cond, bar) do { unsigned _sp = 0; while (cond) { __builtin_amdgcn_s_sleep(1); \
    if ((++_sp & 255u) == 0u) { if (xb_ld(&(bar)[XB_TMO])) break; if (_sp > XB_SPIN_CAP) { atomicAdd(&(bar)[XB_TMO], 1u); break; } } } } while (0)
struct XcdBarrier { unsigned* bar; unsigned x; volatile LAS unsigned* st; };
__device__ __forceinline__ XcdBarrier xcd_barrier_post(unsigned* bar, volatile LAS unsigned* st) {
    XcdBarrier b; b.bar = bar; b.x = xb_xcc_id(); b.st = st;
    if (threadIdx.x == 0) (void)xb_add(&bar[XB_XCNT(b.x)], 1u);
    return b;
}
__device__ __forceinline__ void xcd_barrier_complete(unsigned* bar, unsigned x, unsigned& nloc, unsigned& nx) {
    const unsigned Gd = gridDim.x * gridDim.y * gridDim.z;
    unsigned sum, cnt, mine, sp = 0u;
    for (;;) {
        sum = 0u; cnt = 0u; mine = 0u;
#pragma unroll
        for (unsigned j = 0; j < 16; ++j) { const unsigned c = xb_ld(&bar[XB_XCNT(j)]); sum += c; cnt += (c > 0u) ? 1u : 0u; mine = (j == x) ? c : mine; }
        if (sum == Gd) break;
        __builtin_amdgcn_s_sleep(1);
        if ((++sp & 255u) == 0u) { if (xb_ld(&bar[XB_TMO])) break; if (sp > XB_SPIN_CAP) { atomicAdd(&bar[XB_TMO], 1u); break; } }
    }
    nloc = mine > 0u ? mine : 1u; nx = cnt > 0u ? cnt : 1u;
}
__device__ __forceinline__ void xcd_barrier(const XcdBarrier& b) {
    asm volatile("s_waitcnt vmcnt(0)" ::: "memory");
    __syncthreads();
    if (threadIdx.x == 0) {
        unsigned* bar = b.bar;
        unsigned bx = b.x; asm volatile("" : "+s"(bx));
        __builtin_amdgcn_s_waitcnt(0);
        unsigned nloc = b.st[0], nx = b.st[1];
        if (nloc == 0u) { xcd_barrier_complete(bar, bx, nloc, nx); b.st[0] = nloc; b.st[1] = nx; }
        const unsigned old = xb_add(&bar[XB_XSUB(bx)], 1u);
        const unsigned gen = old / nloc;
        if (old + 1u == (gen + 1u) * nloc) {
            __builtin_amdgcn_fence(__ATOMIC_RELEASE, "agent");
            asm volatile("s_waitcnt vmcnt(0)" ::: "memory");
            const unsigned og = xb_add(&bar[XB_TOP], 1u);
            const unsigned tg = og / nx;
            if (og + 1u == (tg + 1u) * nx) xb_add(&bar[XB_TOPGEN], 1u);
            else XB_SPIN(xb_ld(&bar[XB_TOPGEN]) == tg, bar);
            __builtin_amdgcn_fence(__ATOMIC_ACQUIRE, "agent");
            xb_add(&bar[XB_XGEN(bx)], 1u);
            asm volatile("s_waitcnt vmcnt(0)" ::: "memory");
        } else {
            XB_SPIN(xb_ld(&bar[XB_XGEN(bx)]) == gen, bar);
            __builtin_amdgcn_fence(__ATOMIC_ACQUIRE, "agent");
            asm volatile("s_waitcnt vmcnt(0)" ::: "memory");
        }
    }
    __syncthreads();
}
#endif

constexpr int BK = 64, HALF = 128, HT_BYTES = HALF * BK * 2;
DEV int lds_byte(int r, int c) { int st = (r >> 4) * 2 + (c >> 5), rr = r & 15, cc = c & 31, ob = rr * 64 + cc * 2; return st * 1024 + (ob ^ (((ob >> 9) & 1) << 5)); }
DEV void stage_rc(int b, int& Rr, int& Cc) { int st = b / 1024, sb = b % 1024, swz = sb ^ (((sb >> 9) & 1) << 5); Rr = (st >> 1) * 16 + swz / 64; Cc = (st & 1) * 32 + (swz % 64) / 2; }
DEV int perm32(int rho) { const int n = rho >> 4, i = rho & 15; return 8 * (i >> 2) + 4 * n + (i & 3); }

DEV bool tile_from_L(int L, int nM, int nN, int& pm, int& pn) {
    const int nwg = nM * nN; if (L >= nwg) return false;
    int wgid = L; { const int q = nwg / 8, r = nwg % 8, xcd = wgid % 8, off = wgid / 8; wgid = (xcd < r ? xcd * (q + 1) : r * (q + 1) + (xcd - r) * q) + off; }
    const int nig = 8 * nN, gid = wgid / nig, fm = gid * 8, gsz = (nM - fm) < 8 ? (nM - fm) : 8;
    pm = fm + ((wgid % nig) % gsz); pn = (wgid % nig) / gsz; return true;
}
DEV bool tile_order(int i, int nM, int nN, int& pm, int& pn) { return tile_from_L(i * (int)gridDim.x + (int)blockIdx.x, nM, nN, pm, pn); }
#ifdef CPU_EMU
#define GLDS16(src, dst) __builtin_amdgcn_global_load_lds((const unsigned*)(src), (unsigned*)((dst) + (TID() & 63) * 16), 16, 0, 0)
#else
#define GLDS16(src, dst) __builtin_amdgcn_global_load_lds((const unsigned*)(src), (unsigned*)(dst), 16, 0, 0)
#endif

#define BAR __builtin_amdgcn_s_barrier()
#define SCHED __builtin_amdgcn_sched_barrier(0)
struct GUnit { int pm, pn, aux; };
template <class T> struct is_void_ { static constexpr bool v = false; };
template <> struct is_void_<void> { static constexpr bool v = true; };
template <class Epi> DEV bool call_epi(const Epi& e, const GUnit& u, f32x4 (&acc)[2][2][4][2], int r0, int c0) {
    if constexpr (is_void_<decltype(e(u, acc, r0, c0))>::v) { e(u, acc, r0, c0); return false; } else return e(u, acc, r0, c0);
}
template <bool GATHER, int LDA_, int LDB_, int K_, bool F8 = false, class Sched, class Epi>
DEV void gemm_stream(char* shm, const Sched& S, const Epi& epi) {
#define SA(b, h) (shm + ((b) * 2 + (h)) * HT_BYTES)
#define SB(b, h) (shm + (4 + (b) * 2 + (h)) * HT_BYTES)
#define STG_B(P, bp) do { GLDS16((bp) + voffB, (P) + ldsb0); GLDS16((bp) + voffB + 64 * LDB_, (P) + ldsb0 + 8192); } while (0)
#define STG_A(P, ap, h, gv) do { if (GATHER) { GLDS16((ap) + gv[h][0], (P) + ldsb0); GLDS16((ap) + gv[h][1], (P) + ldsb0 + 8192); } \
    else { GLDS16((ap) + voffA + (h) * 128 * LDA_, (P) + ldsb0); GLDS16((ap) + voffA + ((h) * 128 + 64) * LDA_, (P) + ldsb0 + 8192); } } while (0)
#define LDA(dst, b, h) _Pragma("unroll") for (int m = 0; m < 4; ++m) _Pragma("unroll") for (int k = 0; k < 2; ++k) \
    dst[m][k] = *reinterpret_cast<const bf16x8*>(SA(b, h) + aoff + m * 2048 + k * 1024)
#define LDB(dst, b, h) _Pragma("unroll") for (int n = 0; n < 2; ++n) _Pragma("unroll") for (int k = 0; k < 2; ++k) \
    dst[n][k] = *reinterpret_cast<const bf16x8*>(SB(b, h) + boff + n * 2048 + k * 1024)
#define MMA(ai, bj, At_, Bx_) do { __builtin_amdgcn_s_setprio(1); \
    if constexpr (F8) { _Pragma("unroll") for (int m = 0; m < 4; ++m) _Pragma("unroll") for (int n = 0; n < 2; ++n) \
      acc[ai][bj][m][n] = mfma_f8(Bx_[n][0], Bx_[n][1], At_[m][0], At_[m][1], acc[ai][bj][m][n]); } \
    else { _Pragma("unroll") for (int m = 0; m < 4; ++m) _Pragma("unroll") for (int n = 0; n < 2; ++n) _Pragma("unroll") for (int k = 0; k < 2; ++k) \
      acc[ai][bj][m][n] = mfma16(Bx_[n][k], At_[m][k], acc[ai][bj][m][n]); } \
    __builtin_amdgcn_s_setprio(0); } while (0)
    constexpr int nt = K_ / BK;
    const int tid = TID();
    const int wid = __builtin_amdgcn_readfirstlane(tid >> 6), lane = tid & 63, wr = wid >> 2, wc = wid & 3, fr = lane & 15, fq = lane >> 4;
    const int ldsb0 = wid * 1024;
    int Rr0, Cc0; stage_rc(tid * 16, Rr0, Cc0);
    const int voffA = Rr0 * LDA_ + Cc0;
    const int voffB = ((Rr0 & ~31) + perm32(Rr0 & 31)) * LDB_ + Cc0;
    const int aoff = lds_byte(wr * 64 + fr, fq * 8), boff = lds_byte(wc * 32 + fr, fq * 8);
    GUnit cur, nxt; int ui = 0;
    if (!S.next(0, cur)) return;
    int gc[2][2] = {{0, 0}, {0, 0}};
    int* gtab = (int*)(shm + 131072 + 256);
    if (GATHER) {
        __syncthreads();
        { GUnit u; for (int i = 0; i < GT_MAXU && S.next(i, u); ++i) { if (tid < 256) gtab[i * 256 + tid] = S.grow(u, tid) * LDA_; } }
        __syncthreads();
#pragma unroll
        for (int h = 0; h < 2; ++h)
#pragma unroll
            for (int i = 0; i < 2; ++i) gc[h][i] = gtab[h * 128 + i * 64 + Rr0] + Cc0;
    }
    f32x4 acc[2][2][4][2];
#pragma unroll
    for (int a = 0; a < 2; ++a)
#pragma unroll
        for (int b = 0; b < 2; ++b)
#pragma unroll
            for (int m = 0; m < 4; ++m)
#pragma unroll
                for (int n = 0; n < 2; ++n) acc[a][b][m][n] = (f32x4){0.f, 0.f, 0.f, 0.f};
    bf16x8 At[4][2], B0[2][2], B1[2][2];
    const bf16_t* cA = S.a_base(cur); const bf16_t* cB = S.b_base(cur);
    STG_B(SB(0, 0), cB); STG_A(SA(0, 0), cA, 0, gc); STG_B(SB(0, 1), cB + 128 * LDB_); STG_A(SA(0, 1), cA, 1, gc);
    if (wr == 1) BAR;
    WAIT_V(4); BAR;
    STG_B(SB(1, 0), cB + BK); STG_A(SA(1, 0), cA + BK, 0, gc); STG_B(SB(1, 1), cB + 128 * LDB_ + BK);
    WAIT_V(6); BAR;
    for (;;) {
        const bool has_next = S.next(ui + 1, nxt);
        const bf16_t* nA = has_next ? S.a_base(nxt) : cA; const bf16_t* nB = has_next ? S.b_base(nxt) : cB;
#pragma unroll 1
        for (int t = 0; t < nt; t += 2) {
            const bool last = (t == nt - 2);
            const bf16_t* a1 = cA + (t + 1) * BK;
            const bf16_t* a2 = last ? nA : cA + (t + 2) * BK; const bf16_t* b2 = last ? nB : cB + (t + 2) * BK;
            const bf16_t* a3 = a2 + BK; const bf16_t* b3 = b2 + BK;
            LDB(B0, 0, 0); SCHED; LDA(At, 0, 0); STG_A(SA(1, 1), a1, 1, gc);
            if (GATHER && last && has_next) {
#pragma unroll
                for (int h = 0; h < 2; ++h)
#pragma unroll
                    for (int i = 0; i < 2; ++i) gc[h][i] = gtab[(ui + 1) * 256 + h * 128 + i * 64 + Rr0] + Cc0; }
            WAIT_L(8); BAR; WAIT_L(0); MMA(0, 0, At, B0); BAR; SCHED;
            LDB(B1, 0, 1); STG_B(SB(0, 0), b2);
            BAR; WAIT_L(0); MMA(0, 1, At, B1); BAR;
            LDA(At, 0, 1); STG_A(SA(0, 0), a2, 0, gc);
            BAR; WAIT_L(0); MMA(1, 0, At, B0); BAR; SCHED;
            STG_B(SB(0, 1), b2 + 128 * LDB_);
            WAIT_V(6); BAR; MMA(1, 1, At, B1); BAR;
            LDB(B0, 1, 0); SCHED; LDA(At, 1, 0); STG_A(SA(0, 1), a2, 1, gc);
            WAIT_L(8); BAR; WAIT_L(0); MMA(0, 0, At, B0); BAR; SCHED;
            LDB(B1, 1, 1); STG_B(SB(1, 0), b3);
            BAR; WAIT_L(0); MMA(0, 1, At, B1); BAR;
            LDA(At, 1, 1); STG_A(SA(1, 0), a3, 0, gc);
            BAR; WAIT_L(0); MMA(1, 0, At, B0); BAR; SCHED;
            STG_B(SB(1, 1), b3 + 128 * LDB_);
            WAIT_V(6); BAR; MMA(1, 1, At, B1); BAR;
        }
        bool keep = false;
        {
            const int tz = TID(); const int wz = tz >> 6, lz = tz & 63, wrz = wz >> 2, wcz = wz & 3, frz = lz & 15, fqz = lz >> 4;
            keep = call_epi(epi, cur, acc, wrz * 64 + frz, wcz * 32 + 8 * fqz);
        }
        if (!has_next) break;
        if (!keep) {
#pragma unroll
            for (int a = 0; a < 2; ++a)
#pragma unroll
                for (int b = 0; b < 2; ++b)
#pragma unroll
                    for (int m = 0; m < 4; ++m)
#pragma unroll
                        for (int n = 0; n < 2; ++n) acc[a][b][m][n] = (f32x4){0.f, 0.f, 0.f, 0.f};
        }
        cur = nxt; cA = nA; cB = nB; ++ui;
    }
    WAIT_V(0);
    if (wr == 0) BAR;
    BAR;
#undef SA
#undef SB
#undef STG_A
#undef STG_B
#undef LDA
#undef LDB
#undef MMA
}

constexpr int J_IN = 16 * 27, J_WB = 2 * 8 * 4, J_WO = 16 * 4, J_GU = 16 * 2 * 64, J_DN = 16 * 64, J_FOLD = 8 * 16, J_PAD = 1;
constexpr int N_MODJOBS = 2 * 96;

constexpr int J_BIG = J_IN + J_WB + J_WO + J_GU + J_DN;
struct WJob { const float* src; bf16_t* dst; int ldsrc, lddst, nvalid, k0, n0, mode, gu_which, f8; };
DEV WJob wjob_decode(const Params& p, int l, int j) {
    WJob w; w.ldsrc = 1024; w.lddst = 1024; w.nvalid = 256; w.mode = 0; w.gu_which = 0; w.f8 = 0;
    if (j < J_IN) { const int kt = j / 27, nb = j % 27; w.k0 = kt * 64; w.n0 = nb * 256; w.src = p.w_in + (size_t)l * 1024 * PWSRC; w.ldsrc = PWSRC; w.nvalid = PWSRC - w.n0; w.dst = p.WinT() + (size_t)l * PWT * 1024; w.mode = 3; }
    else if ((j -= J_IN) < J_WB) { const int bi = (j / 32) * 2, jj = j % 32, kt = jj / 4, nb = jj % 4; w.k0 = kt * 64; w.n0 = nb * 256;
        w.src = p.w_branch + ((size_t)l * 3 + bi) * 512 * 1024; w.dst = p.WbT() + ((size_t)l * 3 + bi) * 1024 * 512; w.lddst = 512; }
    else if ((j -= J_WB) < J_WO) { const int kt = j / 4, nb = j % 4; w.k0 = kt * 64; w.n0 = nb * 256; w.src = p.w_out + (size_t)l * 1024 * 1024; w.dst = p.WoT() + (size_t)l * 1024 * 1024; }
    else if ((j -= J_WO) < J_GU) { const int e = j / 128, jj = j % 128; w.gu_which = jj / 64; const int j3 = jj % 64, kt = j3 / 4, nb = j3 % 4; w.k0 = kt * 64; w.n0 = nb * 256;
        w.src = (w.gu_which ? p.w_up : p.w_gate) + ((size_t)l * 16 + e) * 1024 * 1024; w.dst = p.WguT() + ((size_t)l * 16 + e) * 2048 * 512; w.mode = 1; w.f8 = 1; }
    else { j -= J_GU; const int e = j / 64, jj = j % 64, kt = jj / 4, nb = jj % 4; w.k0 = kt * 64; w.n0 = nb * 256;
        w.src = p.w_down + ((size_t)l * 16 + e) * 1024 * 1024; w.dst = p.WdT() + ((size_t)l * 16 + e) * 1024 * 512; w.f8 = 1; }
    return w;
}
constexpr int WT_LD = 260;
DEV void wjob_load(const WJob& w, int tid, f32x4 (&vv)[8]) {
#pragma unroll
    for (int i = 0; i < 8; ++i) { const int idx = i * 512 + tid, r = idx >> 6, c = (idx & 63) * 4; int col = w.n0 + c; col = col > w.ldsrc - 4 ? w.ldsrc - 4 : col;
        vv[i] = ldg((const f32x4*)(w.src + (size_t)(w.k0 + r) * w.ldsrc + col)); }
}
DEV void wjob_finish(const WJob& w, int tid, const f32x4 (&vv)[8], float* tile) {
    __syncthreads();
#pragma unroll
    for (int i = 0; i < 8; ++i) { const int idx = i * 512 + tid, r = idx >> 6, c = (idx & 63) * 4; *(f32x4*)(tile + r * WT_LD + c) = vv[i]; }
    __syncthreads();
#pragma unroll
    for (int q = 0; q < 4; ++q) {
        const int item = q * 512 + tid, nrow = item >> 3, kc = (item & 7) * 8;
        float v[8];
#pragma unroll
        for (int jj = 0; jj < 8; ++jj) v[jj] = tile[(kc + jj) * WT_LD + nrow];
        const int n = w.n0 + nrow;
        int drow = n; bool f8 = w.f8 != 0; size_t f8base = 0;
        if (w.mode == 1) drow = (n >> 7) * 256 + w.gu_which * 128 + (n & 127);
        if (w.mode == 3) {
            if (n >= C_SPLIT) { f8 = true; f8base = (size_t)PWA * 2048; drow = n - C_SPLIT; }
            else { drow = proj_col(n); if (drow >= C_F8) { f8 = true; f8base = (size_t)C_F8 * 2048; drow -= C_F8; } } }
        if (f8) { const u32x2 o = {f8pack4(v[0] * F8_WSCALE, v[1] * F8_WSCALE, v[2] * F8_WSCALE, v[3] * F8_WSCALE), f8pack4(v[4] * F8_WSCALE, v[5] * F8_WSCALE, v[6] * F8_WSCALE, v[7] * F8_WSCALE)};
            if (nrow < w.nvalid) stg((u32x2*)((unsigned char*)w.dst + f8base + (size_t)drow * 1024 + w.k0 + kc), o); }
        else if (nrow < w.nvalid) { u32x4 o = {pack2(v[0], v[1]), pack2(v[2], v[3]), pack2(v[4], v[5]), pack2(v[6], v[7])};
            stg((u32x4*)(w.dst + (size_t)drow * w.lddst + w.k0 + kc), o); }
    }
}
DEV void pro_small_job(const Params& p, int l, int j, char* shm) {
    float* tile = (float*)shm;
    const int tid = TID();
    if (j < J_FOLD) {
        const int kt = j / 16, ntl = j % 16, k0 = kt * 64, n0 = ntl * 64; const int fg = k0 / 128;
        const float* wb1 = p.w_branch + ((size_t)l * 3 + 1) * 512 * 1024;
        const float* pw = p.pool_w + ((size_t)l * 4 + fg) * 128 * 128; const float* ps = p.pool_scale + (size_t)l * 512 + fg * 128;
        const int c = tid & 63, rq = tid >> 6;
        float accv[8];
#pragma unroll
        for (int i = 0; i < 8; ++i) accv[i] = 0.f;
        for (int d = 0; d < 128; ++d) { const float wv = ldg(wb1 + (size_t)(fg * 128 + d) * 1024 + n0 + c) * ldg(ps + d);
#pragma unroll
            for (int i = 0; i < 8; ++i) accv[i] += ldg(pw + (size_t)(k0 - fg * 128 + rq * 8 + i) * 128 + d) * wv; }
        __syncthreads();
#pragma unroll
        for (int i = 0; i < 8; ++i) tile[(rq * 8 + i) * WT_LD + c] = accv[i];
        __syncthreads();
        const int nrow = tid >> 3, kc = (tid & 7) * 8; float v[8];
#pragma unroll
        for (int jj = 0; jj < 8; ++jj) v[jj] = tile[(kc + jj) * WT_LD + nrow];
        u32x4 o = {pack2(v[0], v[1]), pack2(v[2], v[3]), pack2(v[4], v[5]), pack2(v[6], v[7])};
        stg((u32x4*)(p.WbT() + ((size_t)l * 3 + 1) * 1024 * 512 + (size_t)(n0 + nrow) * 512 + k0 + kc), o);
    } else {
        bf16_t* d0 = p.WinT() + (size_t)l * PWT * 1024 + (size_t)C_PADA * 1024;
        for (int i = tid; i < (C_F8 - C_PADA) * 1024 / 8; i += NTHREADS) stg((u32x4*)(d0 + (size_t)i * 8), (u32x4){0u, 0u, 0u, 0u});
    }
}

DEV void pro_mod_job(const Params& p, int job, char* shm) {
    float* sv = (float*)shm;
    const int tid = TID(), l = job / 96, col0 = (job % 96) * 64;
    const int c = tid & 63, kp = tid >> 6;
    float acc[NB + 1];
#pragma unroll
    for (int v = 0; v <= NB; ++v) acc[v] = 0.f;
    for (int half = 0; half < 2; ++half) {
        __syncthreads();
        for (int idx = tid; idx < (NB + 1) * 512; idx += 512) { const int v = idx >> 9, k = idx & 511;
            const float s = (v < NB) ? ldg(p.c + (size_t)v * 1024 + half * 512 + k) : ldg(p.c_ctx + half * 512 + k);
            sv[idx] = s * sigmoidf_(s); }
        __syncthreads();
        for (int kk = 0; kk < 64; ++kk) { const int k = kp * 64 + kk;
            const float w = ldg(p.ada_w + ((size_t)l * 1024 + half * 512 + k) * 6144 + col0 + c);
#pragma unroll
            for (int v = 0; v <= NB; ++v) acc[v] += sv[v * 512 + k] * w; }
    }
    __syncthreads();
    float* red = (float*)shm;
#pragma unroll
    for (int v = 0; v <= NB; ++v) red[(kp * (NB + 1) + v) * 64 + c] = acc[v];
    __syncthreads();
    for (int idx = tid; idx < (NB + 1) * 64; idx += 512) { const int v = idx >> 6, cc = idx & 63; float s = 0.f;
#pragma unroll
        for (int q = 0; q < 8; ++q) s += red[(q * (NB + 1) + v) * 64 + cc];
        stg(p.mod() + ((size_t)l * (NB + 1) + v) * 6144 + col0 + cc, s + ldg(p.ada_b + (size_t)l * 6144 + col0 + cc)); }
}

DEV void phase_prologue(const Params& p, char* shm) {
    const int tid = TID();
    const int nsmall = N_MODJOBS + 1 + 2 * (J_FOLD + J_PAD);
    for (int job = blockIdx.x; job < nsmall; job += gridDim.x) {
        if (job < N_MODJOBS) pro_mod_job(p, job, shm);
        else if (job == N_MODJOBS) {
            for (int idx = tid; idx < (ROWS + 64) * 16; idx += NTHREADS) { const int pos = idx >> 4, i = idx & 15;
                const float pv = (float)(pos < ROWS ? pos : pos - ROWS);
                const float inv = powf(10000.0f, -(float)(2 * i) / 32.0f);
                const float a = pv * inv; stg(p.rope() + idx * 2, cosf(a)); stg(p.rope() + idx * 2 + 1, sinf(a)); }
        } else { const int sj = job - N_MODJOBS - 1; pro_small_job(p, sj / (J_FOLD + J_PAD), sj % (J_FOLD + J_PAD), shm); }
    }
    float* tile = (float*)shm;
    const int nbig = 2 * J_BIG;
    int job = blockIdx.x;
    if (job >= nbig) return;
    WJob wc = wjob_decode(p, job / J_BIG, job % J_BIG), wn = wc;
    f32x4 vc[8], vn[8];
    wjob_load(wc, tid, vc);
    for (; job < nbig; job += gridDim.x) {
        const int jn = job + gridDim.x;
        if (jn < nbig) { wn = wjob_decode(p, jn / J_BIG, jn % J_BIG); wjob_load(wn, tid, vn); }
        wjob_finish(wc, tid, vc, tile);
        wc = wn;
#pragma unroll
        for (int i = 0; i < 8; ++i) vc[i] = vn[i];
    }
}

DEV const float* xin_f32(const Params& p, const SetDesc& sd) { return (sd.is_ctx ? p.ctx : p.x) + (((size_t)sd.samp0) << sd.lgseq) * 1024; }
DEV bf16_t* xbf_base(const Params& p, const SetDesc& sd) { return (sd.is_ctx ? p.ctxs() : p.xb()) + (((size_t)sd.samp0) << sd.lgseq) * 1024; }
DEV float* xout_f32(const Params& p, const SetDesc& sd) { return p.out + (((size_t)sd.samp0) << sd.lgseq) * 1024; }
template <bool BF> struct XRow;
template <> struct XRow<false> { f32x4 v[4];
    DEV void load(const void* b, size_t row, int lane) { const float* q = (const float*)b + row * 1024 + lane * 8;
#pragma unroll
        for (int i = 0; i < 4; ++i) v[i] = ldg((const f32x4*)(q + (i >> 1) * 512 + (i & 1) * 4)); }
    DEV f32x4 get(int i) const { return v[i]; } };
template <> struct XRow<true> { u32x4 v[2];
    DEV void load(const void* b, size_t row, int lane) { const bf16_t* q = (const bf16_t*)b + row * 1024 + lane * 8;
#pragma unroll
        for (int h = 0; h < 2; ++h) v[h] = ldg((const u32x4*)(q + h * 512)); }
    DEV f32x4 get(int i) const { const u32x4 m = v[i >> 1]; return (i & 1) ? (f32x4){lo16(m.z), hi16(m.z), lo16(m.w), hi16(m.w)} : (f32x4){lo16(m.x), hi16(m.x), lo16(m.y), hi16(m.y)}; } };
template <bool BF> DEV void xrow_store8(void* b, size_t row, int c0, f32x4 a, f32x4 c) {
    if constexpr (BF) store8bf((bf16_t*)b + row * 1024 + c0, a, c);
    else { float* q = (float*)b + row * 1024 + c0; stg((f32x4*)q, a); stg((f32x4*)(q + 4), c); }
}
DEV const float* mod_row(const Params& p, const SetDesc& sd, int layer, int row) {
    return p.mod() + ((size_t)layer * (NB + 1) + (sd.is_ctx ? NB : sd.samp0 + (row >> sd.lgseq))) * 6144;
}
DEV bf16_t* proj_buf(const Params& p, const SetDesc& sd) { return sd.is_ctx ? p.PROJc() : p.PROJa(); }

DEV void stage_params(float* par, const float* v0, const float* v1, const float* v2, const float* v3, const float* v4) {
    const int tid = TID();
    const float* src[5] = {v0, v1, v2, v3, v4};
#pragma unroll
    for (int k = 0; k < 5; ++k) if (src[k]) { for (int i = tid; i < 1024; i += NTHREADS) par[k * 1024 + i] = ldg(src[k] + i); }
}
template <bool SRC_BF> DEV void phase_norm1(const Params& p, const SetDesc& sd, int layer, char* shm) {
    const int tid = TID(), lane = tid & 63, wv = tid >> 6;
    const float* g0 = p.norm_gain + ((size_t)layer * 4 + 0) * 1024;
    const void* xb = SRC_BF ? (const void*)xbf_base(p, sd) : (const void*)xin_f32(p, sd);
    const int stride = 8; const int rpb_ = (sd.nrows + (int)gridDim.x - 1) / (int)gridDim.x; const int row_end = min(sd.nrows, ((int)blockIdx.x + 1) * rpb_);
    int row = (int)blockIdx.x * rpb_ + wv;
    float* par = (float*)shm;
    __syncthreads();
    { const float* mdb = mod_row(p, sd, layer, min((int)blockIdx.x * rpb_, sd.nrows - 1)); stage_params(par, g0, mdb, mdb + 1024, nullptr, nullptr); }
    __syncthreads();
    XRow<SRC_BF> curr, nxtr;
    if (row < row_end) curr.load(xb, row, lane);
    for (; row < row_end; row += stride) {
        const int rn = row + stride;
        if (rn < row_end) nxtr.load(xb, rn, lane);
        f32x4 cur[4];
#pragma unroll
        for (int i = 0; i < 4; ++i) cur[i] = curr.get(i);
        float ss = 0.f;
#pragma unroll
        for (int i = 0; i < 4; ++i)
#pragma unroll
            for (int j = 0; j < 4; ++j) ss += cur[i][j] * cur[i][j];
        ss = wave_sum(ss);
        const float rstd = rsqrtf(ss * (1.0f / 1024.0f) + RMS_EPS);
#pragma unroll
        for (int hlf = 0; hlf < 2; ++hlf) { const int c0 = hlf * 512 + lane * 8; float o[8];
#pragma unroll
            for (int j = 0; j < 8; ++j) o[j] = cur[hlf * 2 + (j >> 2)][j & 3] * rstd * par[c0 + j] * (1.0f + par[2048 + c0 + j]) + par[1024 + c0 + j];
            u32x4 ov = {pack2(o[0], o[1]), pack2(o[2], o[3]), pack2(o[4], o[5]), pack2(o[6], o[7])};
            stg((u32x4*)(p.H() + (size_t)row * 1024 + c0), ov);
            const u32x2 o8 = {f8pack4(o[0], o[1], o[2], o[3]), f8pack4(o[4], o[5], o[6], o[7])};
            stg((u32x2*)(p.H8() + (size_t)row * 1024 + c0), o8); }
        curr = nxtr;
    }
}

struct SchedPlain {
    const bf16_t* A; const bf16_t* Bt; int nM, nN, lda256, ldb256;
    DEV bool next(int i, GUnit& u) const { u.aux = 0; return tile_order(i, nM, nN, u.pm, u.pn); }
    DEV const bf16_t* a_base(const GUnit& u) const { return A + (size_t)u.pm * lda256; }
    DEV const bf16_t* b_base(const GUnit& u) const { return Bt + (size_t)u.pn * ldb256; }
    DEV int grow(const GUnit&, int) const { return 0; }
};
struct SchedPlainT : SchedPlain {
    int split_base = -1;
    DEV bool next(int i, GUnit& u) const { u.aux = 0; const int G_ = (int)gridDim.x, b = (int)blockIdx.x; int L = i * G_ + b;
        if (split_base >= 0 && i >= split_base) { if (b < G_ / 2 || i >= split_base + 2) return false; L = split_base * G_ + (i - split_base) * (G_ / 2) + (b - G_ / 2); }
        return tile_from_L(L, nM, nN, u.pm, u.pn); }
    DEV const bf16_t* a_base(const GUnit&) const { return A; }
    DEV int grow(const GUnit& u, int i) const { return u.pm * 256 + i; }
};
struct SchedProjF8 : SchedPlainT {
    const bf16_t* Bt2; int na8;
    DEV const bf16_t* b_base(const GUnit& u) const { return u.pn < na8 ? Bt + (size_t)u.pn * ldb256 : Bt2 + (size_t)(u.pn - na8) * ldb256; }
};
DEV unsigned gate4u8(f32x4 v) {
    unsigned w = 0;
#pragma unroll
    for (int j = 0; j < 4; ++j) w |= (unsigned)fmaxf(sigmoidf_(v[j] * F8_WINV) * 255.0f + 0.5f, 1.0f) << (8 * j);
    return w;
}
DEV float u8f(unsigned w, int j) { return (float)((w >> (8 * j)) & 0xFFu); }
DEV void phase_proj_a(const Params& p, const SetDesc& sd, int layer, char* shm) {
    bf16_t* pb = proj_buf(p, sd);
    {
        SchedPlain S; S.A = p.H(); S.Bt = p.WinT() + (size_t)layer * PWT * 1024; S.nM = sd.nrows / 256; S.nN = C_F8 / 256; S.lda256 = 256 * 1024; S.ldb256 = 256 * 1024;
        gemm_stream<false, 1024, 1024, 1024>(shm, S, [=](const GUnit& u, const f32x4 (&acc)[2][2][4][2], int r0, int c0) {
#pragma unroll
            for (int ai = 0; ai < 2; ++ai)
#pragma unroll
                for (int m = 0; m < 4; ++m) { bf16_t* o = pb + ((size_t)u.pm * 256 + r0 + ai * 128 + m * 16) * PWA + u.pn * 256 + c0;
                    if (u.pn * 256 + c0 < C_PADA) store8bf(o, acc[ai][0][m][0], acc[ai][0][m][1]);
                    if (u.pn * 256 + 128 < C_PADA) store8bf(o + 128, acc[ai][1][m][0], acc[ai][1][m][1]); } });
    }
    {
        constexpr int NA8 = (PWA - C_F8) / 256;
        SchedProjF8 S; S.A = (const bf16_t*)p.H8(); S.Bt = p.WinT() + (size_t)layer * PWT * 1024 + (size_t)C_F8 * 1024; S.Bt2 = p.WinT() + (size_t)layer * PWT * 1024 + (size_t)PWA * 1024; S.na8 = NA8;
        S.nM = sd.nrows / 256; S.nN = NA8 + NBG / 256; S.lda256 = 256 * 512; S.ldb256 = 256 * 512;
        { const int G_ = (int)gridDim.x, T1 = S.nM * (C_F8 / 256), T2 = S.nM * S.nN; if ((G_ & 1) == 0 && (T1 % G_) * 2 == G_ && T2 % G_ == 0 && T2 / G_ >= 1) S.split_base = T2 / G_ - 1; }
        unsigned char* bg = p.BG();
        gemm_stream<true, 512, 512, 512, true>(shm, S, [=](const GUnit& u, const f32x4 (&acc)[2][2][4][2], int r0, int c0) {
            if (u.pn < NA8) {
#pragma unroll
                for (int ai = 0; ai < 2; ++ai)
#pragma unroll
                    for (int m = 0; m < 4; ++m) { bf16_t* o = pb + ((size_t)u.pm * 256 + r0 + ai * 128 + m * 16) * PWA + C_F8 + u.pn * 256 + c0;
                        store8bf(o, acc[ai][0][m][0] * F8_WINV, acc[ai][0][m][1] * F8_WINV); store8bf(o + 128, acc[ai][1][m][0] * F8_WINV, acc[ai][1][m][1] * F8_WINV); }
            } else {
#pragma unroll
                for (int ai = 0; ai < 2; ++ai)
#pragma unroll
                    for (int m = 0; m < 4; ++m) { unsigned char* o = bg + ((size_t)u.pm * 256 + r0 + ai * 128 + m * 16) * NBG + (u.pn - NA8) * 256 + c0;
#pragma unroll
                        for (int hf = 0; hf < 2; ++hf) { const u32x2 gv = {gate4u8(acc[ai][hf][m][0]), gate4u8(acc[ai][hf][m][1])}; stg((u32x2*)(o + hf * 128), gv); } }
            } });
    }
}
DEV f32x4 sig4(f32x4 v) { f32x4 r; r[0] = sigmoidf_(v[0]); r[1] = sigmoidf_(v[1]); r[2] = sigmoidf_(v[2]); r[3] = sigmoidf_(v[3]); return r; }
DEV void gate_scan(const bf16_t* prow, int h, const float* gbias, float* ga, float* gb, float* gpm, float* gtot, float* tmp) {
    const int tid = TID(), lane = tid & 63, w = tid >> 6;
    float b = 0.f, a = 0.f, pm = 0.f; int d = 0, tok = 0;
    if (tid < 256) {
        d = tid >> 7; const int i = tid & 127; tok = d ? 127 - i : i;
        const float gi = bf2f(ldg(prow + (size_t)tok * PWA + C_GM + (2 * d) * 4 + h)) + ldg(gbias + (2 * d) * 4 + h);
        const float gf = bf2f(ldg(prow + (size_t)tok * PWA + C_GM + (2 * d + 1) * 4 + h)) + ldg(gbias + (2 * d + 1) * 4 + h);
        b = logsigmoidf_(gf);
#pragma unroll
        for (int o = 1; o < 64; o <<= 1) { const float t = __shfl_up(b, o); if (lane >= o) b += t; }
        if (lane == 63) tmp[w] = b;
        a = gi;
    }
    __syncthreads();
    if (tid < 256) {
        if (w & 1) b += tmp[w - 1];
        a -= b; pm = a;
#pragma unroll
        for (int o = 1; o < 64; o <<= 1) { const float t = __shfl_up(pm, o); if (lane >= o) pm = fmaxf(pm, t); }
        if (lane == 63) tmp[8 + w] = pm;
    }
    __syncthreads();
    if (tid < 256) {
        if (w & 1) pm = fmaxf(pm, tmp[8 + w - 1]);
        ga[d * 128 + tok] = a; gb[d * 128 + tok] = b; gpm[d * 128 + tok] = pm;
        if ((tid & 127) == 127) { gtot[d * 2] = b; gtot[d * 2 + 1] = pm; }
    }
    __syncthreads();
}

DEV void load_rope_chunk(const bf16_t* hp, int cidx, bool latent, int tl, const float* rope, float scale, float* o) {
    const u32x4 m = ldg((const u32x4*)(hp + cidx * 8));
    float x[8] = {lo16(m.x), hi16(m.x), lo16(m.y), hi16(m.y), lo16(m.z), hi16(m.z), lo16(m.w), hi16(m.w)};
    if (latent) {
        const u32x4 q = ldg((const u32x4*)(hp + (cidx ^ 2) * 8));
        const float y[8] = {lo16(q.x), hi16(q.x), lo16(q.y), hi16(q.y), lo16(q.z), hi16(q.z), lo16(q.w), hi16(q.w)};
        const int pos = (cidx < 4) ? (tl >> 6) : (ROWS + (tl & 63));
        const float* tb = rope + ((size_t)pos * 16 + (cidx & 1) * 8) * 2;
        const bool first = (cidx & 2) == 0;
#pragma unroll
        for (int j = 0; j < 8; ++j) { const float cs = ldg(tb + j * 2), sn = ldg(tb + j * 2 + 1);
            x[j] = first ? (x[j] * cs - y[j] * sn) : (x[j] * cs + y[j] * sn); }
    }
#pragma unroll
    for (int j = 0; j < 8; ++j) o[j] = x[j] * scale;
}

DEV int st_index(const SetDesc& sd, int sl, int h, int dir, int tb) { return ((sl * 4 + h) * 2 + dir) * sd.ntb + tb; }

constexpr int V_LD = 144, K_LD = 72, KS_LD = 80;
DEV void mlstm_stepA_task(const Params& p, const SetDesc& sd, int layer, int task, char* shm) {
    const int tid = TID(), lane = tid & 63, w = tid >> 6, fr = lane & 15, fq = lane >> 4, tq4 = (lane & 15) >> 2, tp4 = lane & 3;
    const int tb = task % sd.ntb, h = (task / sd.ntb) & 3, sl = task / (sd.ntb * 4);
    const int row0 = (sl << sd.lgseq) + tb * 128; const bool latent = !sd.is_ctx; const int tl0 = tb * 128;
    bf16_t* Vs = (bf16_t*)shm;
    bf16_t* Ksc = (bf16_t*)(shm + 128 * V_LD * 2);
    float* ga = (float*)(shm + 128 * V_LD * 2 + 2 * 128 * KS_LD * 2); float* gb = ga + 256; float* gpm = gb + 256; float* gtot = gpm + 256; float* tmp = gtot + 8;
    const bf16_t* prow = proj_buf(p, sd) + (size_t)row0 * PWA;
    __syncthreads();
    gate_scan(prow, h, p.gate_bias + (size_t)layer * 16, ga, gb, gpm, gtot, tmp);
    {
        const int s = tid & 127, cpi = tid >> 7, cp = (cpi & 1) + (cpi >> 1) * 4;
        const bf16_t* hp = prow + (size_t)s * PWA + C_KM + h * 64;
        float k1[8], k2[8];
        load_rope_chunk(hp, cp, latent, tl0 + s, p.rope(), 1.0f, k1);
        load_rope_chunk(hp, cp + 2, latent, tl0 + s, p.rope(), 1.0f, k2);
#pragma unroll
        for (int dir = 0; dir < 2; ++dir) { const float ws = __expf(ga[dir * 128 + s] - gtot[dir * 2 + 1]);
            u32x4 o1 = {pack2(k1[0] * ws, k1[1] * ws), pack2(k1[2] * ws, k1[3] * ws), pack2(k1[4] * ws, k1[5] * ws), pack2(k1[6] * ws, k1[7] * ws)};
            u32x4 o2 = {pack2(k2[0] * ws, k2[1] * ws), pack2(k2[2] * ws, k2[3] * ws), pack2(k2[4] * ws, k2[5] * ws), pack2(k2[6] * ws, k2[7] * ws)};
            *(u32x4*)(Ksc + (dir * 128 + s) * KS_LD + cp * 8) = o1; *(u32x4*)(Ksc + (dir * 128 + s) * KS_LD + (cp + 2) * 8) = o2; }
    }
#pragma unroll
    for (int it = 0; it < 4; ++it) { const int item = tid + it * 512, s = item >> 4, ch = item & 15;
        *(u32x4*)(Vs + s * V_LD + ch * 8) = ldg((const u32x4*)(prow + (size_t)s * PWA + C_VM + h * 128 + ch * 8)); }
    __syncthreads();
    f32x4 acc[2][4];
#pragma unroll
    for (int dir = 0; dir < 2; ++dir)
#pragma unroll
        for (int n = 0; n < 4; ++n) acc[dir][n] = (f32x4){0.f, 0.f, 0.f, 0.f};
#pragma unroll
    for (int ks = 0; ks < 4; ++ks) {
        const bf16_t* vp = Vs + (32 * ks + 4 * fq + tq4) * V_LD + w * 16 + 4 * tp4;
        const bf16x8 af = mk8(TR16(vp), TR16(vp + 16 * V_LD));
#pragma unroll
        for (int dir = 0; dir < 2; ++dir)
#pragma unroll
            for (int n = 0; n < 4; ++n) { const bf16_t* kp = Ksc + (dir * 128 + 32 * ks + 4 * fq + tq4) * KS_LD + n * 16 + 4 * tp4;
                const bf16x8 bfv = mk8(TR16(kp), TR16(kp + 16 * KS_LD));
                acc[dir][n] = mfma16(bfv, af, acc[dir][n]); }
    }
#pragma unroll
    for (int dir = 0; dir < 2; ++dir) { float* So = p.Sst() + (size_t)st_index(sd, sl, h, dir, tb) * 8192;
#pragma unroll
        for (int n = 0; n < 4; ++n) stg((f32x4*)(So + (w * 16 + fr) * 64 + n * 16 + fq * 4), acc[dir][n]); }
    if (tid < 128) { const int dir = tid >> 6, dd = tid & 63; float sm = 0.f;
        for (int i = 0; i < 128; ++i) sm += bf2f(Ksc[(dir * 128 + i) * KS_LD + dd]);
        stg(p.Sn() + (size_t)st_index(sd, sl, h, dir, tb) * 64 + dd, sm); }
    if (tid < 2) { float* sc = p.Ssc() + (size_t)st_index(sd, sl, h, tid, tb) * 4; stg(sc, gtot[tid * 2]); stg(sc + 1, gtot[tid * 2] + gtot[tid * 2 + 1]); }
}

template <int GI> DEV void pool_group(const Params& p, const SetDesc& sd, const bf16_t* pb) {
    constexpr int W = 2 << GI;
    const int nitems = sd.nrows * 16; const int T = 1 << sd.lgseq;
    for (int item = blockIdx.x * NTHREADS + TID(); item < nitems; item += gridDim.x * NTHREADS) {
        const int row = item >> 4, ch = GI * 128 + (item & 15) * 8;
        const int tt = row & (T - 1);
        u32x4 mv[W]; int cnt = 0; bool okv[W];
#pragma unroll
        for (int q = 0; q < W; ++q) { const int t2 = tt - W / 2 + q; const bool ok = (t2 >= 0) && (t2 < T); cnt += ok ? 1 : 0; okv[q] = ok;
            mv[q] = ldg((const u32x4*)(pb + (size_t)(ok ? (row - W / 2 + q) : row) * PWA + C_PU + ch)); }
        float s[8];
#pragma unroll
        for (int j = 0; j < 8; ++j) s[j] = 0.f;
#pragma unroll
        for (int q = 0; q < W; ++q) { u32x4 m = mv[q]; if (!okv[q]) m = (u32x4){0u, 0u, 0u, 0u};
            s[0] += lo16(m.x); s[1] += hi16(m.x); s[2] += lo16(m.y); s[3] += hi16(m.y); s[4] += lo16(m.z); s[5] += hi16(m.z); s[6] += lo16(m.w); s[7] += hi16(m.w); }
        const float inv = frcp((float)cnt);
        const u32x4 m = mv[W / 2];
        const float u[8] = {lo16(m.x), hi16(m.x), lo16(m.y), hi16(m.y), lo16(m.z), hi16(m.z), lo16(m.w), hi16(m.w)};
        u32x4 o = {pack2(s[0] * inv - u[0], s[1] * inv - u[1]), pack2(s[2] * inv - u[2], s[3] * inv - u[3]), pack2(s[4] * inv - u[4], s[5] * inv - u[5]), pack2(s[6] * inv - u[6], s[7] * inv - u[7])};
        stg((u32x4*)(p.Pb() + (size_t)row * 512 + ch), o);
    }
}
DEV void phase_pool(const Params& p, const SetDesc& sd) {
    const bf16_t* pb = proj_buf(p, sd);
    pool_group<0>(p, sd, pb); pool_group<1>(p, sd, pb); pool_group<2>(p, sd, pb); pool_group<3>(p, sd, pb);
}

template <int NC> DEV void mlstm_stepB_run(const Params& p, const SetDesc& sd, int task) {
    const int tid = TID();
    const int q = task & 3, dir = (task >> 2) & 1, h = (task >> 3) & 3, sl = task >> 5;
    const int ci = ((sd.samp0 + sl) * 4 + h) * 2 + dir;
    const int eoff = q * 2048 + tid * 4;
    float zr = 0.f; HIDE(zr);
    f32x4 C = {zr, zr, zr, zr}; float nv = 0.f; float m = -1e30f;
    f32x4 Sv[NC]; float blv[NC], mlv[NC], snv[NC];
#pragma unroll
    for (int c = 0; c < NC; ++c) { const int tb = dir ? NC - 1 - c : c; const size_t si = st_index(sd, sl, h, dir, tb);
        Sv[c] = ldg((const f32x4*)(p.Sst() + si * 8192 + eoff)); blv[c] = ldg(p.Ssc() + si * 4); mlv[c] = ldg(p.Ssc() + si * 4 + 1);
        snv[c] = (q == 0 && tid < 64) ? ldg(p.Sn() + si * 64 + tid) : 0.f; }
    if (!sd.is_ctx) { C = ldg((const f32x4*)(p.CiC() + (size_t)ci * 8192 + eoff)); if (q == 0 && tid < 64) nv = ldg(p.Cin_() + (size_t)ci * 64 + tid); m = ldg(p.Cim() + (size_t)ci * 4); }
#pragma unroll
    for (int c = 0; c < NC; ++c) {
        const int tb = dir ? NC - 1 - c : c; const size_t si = st_index(sd, sl, h, dir, tb);
        u32x2 o = {pack2(C[0], C[1]), pack2(C[2], C[3])};
        stg((u32x2*)(p.Cin() + si * 8192 + eoff), o);
        if (q == 0 && tid < 64) stg(p.Cn() + si * 64 + tid, nv);
        if (q == 0 && tid == 0) stg(p.Cm() + si * 4, m);
        const float mn = fmaxf(blv[c] + m, mlv[c]);
        const float dc = __expf(blv[c] + m - mn), wsn = __expf(mlv[c] - mn);
        C = C * dc + Sv[c] * wsn;
        nv = nv * dc + snv[c] * wsn;
        m = mn;
    }
    if (sd.is_ctx) { stg((f32x4*)(p.CiC() + (size_t)ci * 8192 + eoff), C); if (q == 0 && tid < 64) stg(p.Cin_() + (size_t)ci * 64 + tid, nv); if (q == 0 && tid == 0) stg(p.Cim() + (size_t)ci * 4, m); }
}
DEV void mlstm_stepB_task(const Params& p, const SetDesc& sd, int task) {
    if (sd.is_ctx) mlstm_stepB_run<NTBC>(p, sd, task); else mlstm_stepB_run<NTBL>(p, sd, task);
}

constexpr int NA_KLD = 136, NA_VLD = 144;
DEV void na_task(const Params& p, const SetDesc& sd, int layer, int sl, int rq2  , int hp, char* shm) {
    const int tid = TID(), lane = tid & 63, w = tid >> 6, tq = lane & 15, fq = lane >> 4, tq4 = (lane & 15) >> 2, tp4 = lane & 3;
    const int hh = w >> 2, g = w & 3, head = hp * 2 + hh;
    const bool ctxq = sd.is_ctx;
    bf16_t* Ks = (bf16_t*)shm;
    bf16_t* Vs = (bf16_t*)(shm + 128 * NA_KLD * 2);
    float* rpbs = (float*)(shm + 128 * NA_KLD * 2 + 128 * NA_VLD * 2);
    const int sample = sd.samp0 + sl;
    const bf16_t* pq = proj_buf(p, sd) + ((size_t)sl << sd.lgseq) * PWA;
    const bf16_t* pc = p.PROJc() + (size_t)sample * CTX * PWA;
    const int qcol = g * 16 + tq;
    int rqv[2], rsv[2], qtok[2];
#pragma unroll
    for (int u = 0; u < 2; ++u) { rqv[u] = 2 * rq2 + u; qtok[u] = rqv[u] * 64 + qcol; int r_ = rqv[u] - 4; rsv[u] = r_ < 0 ? 0 : (r_ > ROWS - 8 ? ROWS - 8 : r_); }
    const int nloc = ctxq ? 0 : (rsv[1] + 8 - rsv[0]);
    const int nstage = nloc + CTX / 64;
    __syncthreads();
    if (!ctxq) for (int i = tid; i < 2 * 465; i += NTHREADS) rpbs[i] = ldg(p.rpb + ((size_t)layer * 8 + hp * 2 + i / 465) * 465 + i % 465);
    bf16x8 qf[2][2];
#pragma unroll
    for (int u = 0; u < 2; ++u)
#pragma unroll
        for (int ks = 0; ks < 2; ++ks) qf[u][ks] = mk8(ldg((const u32x4*)(pq + (size_t)qtok[u] * PWA + C_QN + head * 64 + ks * 32 + fq * 8)));
    float m_run[2] = {-1e30f, -1e30f}, l_run[2] = {0.f, 0.f};
    f32x4 acc[2][4];
#pragma unroll
    for (int u = 0; u < 2; ++u)
#pragma unroll
        for (int mt = 0; mt < 4; ++mt) acc[u][mt] = (f32x4){0.f, 0.f, 0.f, 0.f};
    int cs = qcol - 8; cs = cs < 0 ? 0 : (cs > 48 ? 48 : cs);
    const int kc0 = (g == 0) ? 0 : (g == 1) ? 8 : (g == 2) ? 24 : 32;
    const int npair = (nstage + 1) >> 1;
    u32x4 kreg[4], vreg[4];
#define NA_SRC_ROWS(stg) (((stg) < nloc) ? (pq + (size_t)((rsv[0] + (stg)) * 64) * PWA) : (pc + (size_t)((((stg) < nstage ? (stg) : nstage - 1) - nloc) * 64) * PWA))
#define NA_FETCH(sp_) do { _Pragma("unroll") for (int it = 0; it < 4; ++it) { const int item = tid + it * 512, key2 = item >> 4, ch = item & 15; \
        const bf16_t* kb_ = NA_SRC_ROWS(2 * (sp_) + (key2 >> 6)); const bf16_t* src = kb_ + (size_t)(key2 & 63) * PWA + hp * 128 + ch * 8; \
        kreg[it] = ldg((const u32x4*)(src + C_KN)); vreg[it] = ldg((const u32x4*)(src + C_VN)); } } while (0)
    NA_FETCH(0);
    for (int sp = 0; sp < npair; ++sp) {
        __syncthreads();
#pragma unroll
        for (int it = 0; it < 4; ++it) { const int item = tid + it * 512, key2 = item >> 4, ch = item & 15;
            *(u32x4*)(Ks + key2 * NA_KLD + ch * 8) = kreg[it]; *(u32x4*)(Vs + key2 * NA_VLD + ch * 8) = vreg[it]; }
        if (sp + 1 < npair) NA_FETCH(sp + 1);
        __syncthreads();
#pragma unroll
        for (int sub = 0; sub < 2; ++sub) {
        const int st = 2 * sp + sub;
        if (st >= nstage) continue;
        const bool local = st < nloc;
        const bf16_t* Ksb = Ks + sub * 64 * NA_KLD; const bf16_t* Vsb = Vs + sub * 64 * NA_VLD;
        if (local) {
            const int kr = rsv[0] + st;
            f32x4 sa[2][2];
#pragma unroll
            for (int kt = 0; kt < 2; ++kt) { sa[0][kt] = (f32x4){0.f, 0.f, 0.f, 0.f}; sa[1][kt] = (f32x4){0.f, 0.f, 0.f, 0.f};
#pragma unroll
                for (int ks = 0; ks < 2; ++ks) { const bf16x8 kf = *(const bf16x8*)(Ksb + (kc0 + kt * 16 + tq) * NA_KLD + hh * 64 + ks * 32 + fq * 8);
                    sa[0][kt] = mfma16(kf, qf[0][ks], sa[0][kt]); sa[1][kt] = mfma16(kf, qf[1][ks], sa[1][kt]); } }
            float alpha[2]; bf16x8 pf[2];
#pragma unroll
            for (int u = 0; u < 2; ++u) {
                const bool act = (kr >= rsv[u]) && (kr < rsv[u] + 8);
                if (!act) { alpha[u] = 1.0f; pf[u] = mk8((u32x4){0u, 0u, 0u, 0u}); continue; }
                const int dr = kr - rqv[u] + 7;
                float sc[8]; float mx = -1e30f; float bs[8];
#pragma unroll
                for (int kt = 0; kt < 2; ++kt)
#pragma unroll
                    for (int r = 0; r < 4; ++r) { const int kcol = kc0 + kt * 16 + fq * 4 + r; int dc = kcol - qcol + 15; dc = dc < 0 ? 0 : (dc > 30 ? 30 : dc);
                        bs[kt * 4 + r] = rpbs[hh * 465 + dr * 31 + dc]; }
#ifndef CPU_EMU
                asm volatile("" : "+v"(bs[0]), "+v"(bs[1]), "+v"(bs[2]), "+v"(bs[3]), "+v"(bs[4]), "+v"(bs[5]), "+v"(bs[6]), "+v"(bs[7]));
#endif
#pragma unroll
                for (int kt = 0; kt < 2; ++kt)
#pragma unroll
                    for (int r = 0; r < 4; ++r) { const int kcol = kc0 + kt * 16 + fq * 4 + r; const bool valid = (kcol >= cs) && (kcol < cs + 16);
                        const float v = valid ? (sa[u][kt][r] * 0.125f + bs[kt * 4 + r]) : -1e30f; sc[kt * 4 + r] = v; mx = fmaxf(mx, v); }
                mx = fmaxf(mx, shx<16>(mx)); mx = fmaxf(mx, shx<32>(mx));
                const float mn = fmaxf(m_run[u], mx); alpha[u] = __expf(m_run[u] - mn); m_run[u] = mn;
                float ps = 0.f; float pv[8];
#pragma unroll
                for (int j = 0; j < 8; ++j) { pv[j] = __expf(sc[j] - mn); ps += pv[j]; }
                ps += shx<16>(ps); ps += shx<32>(ps);
                l_run[u] = l_run[u] * alpha[u] + ps;
                u32x4 pk = {pack2(pv[0], pv[1]), pack2(pv[2], pv[3]), pack2(pv[4], pv[5]), pack2(pv[6], pv[7])};
                pf[u] = mk8(pk);
            }
#pragma unroll
            for (int mt = 0; mt < 4; ++mt) {
                const bf16_t* vp = Vsb + (kc0 + 4 * fq + tq4) * NA_VLD + hh * 64 + mt * 16 + 4 * tp4;
                const bf16x8 vf = mk8(TR16(vp), TR16(vp + 16 * NA_VLD));
                acc[0][mt] = mfma16(vf, pf[0], acc[0][mt] * alpha[0]); acc[1][mt] = mfma16(vf, pf[1], acc[1][mt] * alpha[1]); }
        } else {
            f32x4 sa[2][4];
#pragma unroll
            for (int kt = 0; kt < 4; ++kt) { sa[0][kt] = (f32x4){0.f, 0.f, 0.f, 0.f}; sa[1][kt] = (f32x4){0.f, 0.f, 0.f, 0.f};
#pragma unroll
                for (int ks = 0; ks < 2; ++ks) { const bf16x8 kf = *(const bf16x8*)(Ksb + (kt * 16 + tq) * NA_KLD + hh * 64 + ks * 32 + fq * 8);
                    sa[0][kt] = mfma16(kf, qf[0][ks], sa[0][kt]); sa[1][kt] = mfma16(kf, qf[1][ks], sa[1][kt]); } }
            float alpha[2]; bf16x8 pf[2][2];
#pragma unroll
            for (int u = 0; u < 2; ++u) {
                float mx = -1e30f;
#pragma unroll
                for (int kt = 0; kt < 4; ++kt)
#pragma unroll
                    for (int r = 0; r < 4; ++r) { sa[u][kt][r] *= 0.125f; mx = fmaxf(mx, sa[u][kt][r]); }
                mx = fmaxf(mx, shx<16>(mx)); mx = fmaxf(mx, shx<32>(mx));
                const float mn = fmaxf(m_run[u], mx); alpha[u] = __expf(m_run[u] - mn); m_run[u] = mn;
                float ps = 0.f;
#pragma unroll
                for (int kt = 0; kt < 4; ++kt)
#pragma unroll
                    for (int r = 0; r < 4; ++r) { sa[u][kt][r] = __expf(sa[u][kt][r] - mn); ps += sa[u][kt][r]; }
                ps += shx<16>(ps); ps += shx<32>(ps);
                l_run[u] = l_run[u] * alpha[u] + ps;
#pragma unroll
                for (int h2 = 0; h2 < 2; ++h2) {
                    u32x4 pk = {pack2(sa[u][2 * h2][0], sa[u][2 * h2][1]), pack2(sa[u][2 * h2][2], sa[u][2 * h2][3]), pack2(sa[u][2 * h2 + 1][0], sa[u][2 * h2 + 1][1]), pack2(sa[u][2 * h2 + 1][2], sa[u][2 * h2 + 1][3])};
                    pf[u][h2] = mk8(pk); }
            }
#pragma unroll
            for (int mt = 0; mt < 4; ++mt) { acc[0][mt] = acc[0][mt] * alpha[0]; acc[1][mt] = acc[1][mt] * alpha[1]; }
#pragma unroll
            for (int h2 = 0; h2 < 2; ++h2)
#pragma unroll
                for (int mt = 0; mt < 4; ++mt) { const bf16_t* vp = Vsb + (32 * h2 + 4 * fq + tq4) * NA_VLD + hh * 64 + mt * 16 + 4 * tp4;
                    const bf16x8 vf = mk8(TR16(vp), TR16(vp + 16 * NA_VLD));
                    acc[0][mt] = mfma16(vf, pf[0][h2], acc[0][mt]); acc[1][mt] = mfma16(vf, pf[1][h2], acc[1][mt]); }
        }
        }
    }
#undef NA_FETCH
#undef NA_SRC_ROWS
#pragma unroll
    for (int u = 0; u < 2; ++u) {
        const float il = frcp(l_run[u]);
        const size_t orow = ((size_t)sl << sd.lgseq) + qtok[u];
#pragma unroll
        for (int mt = 0; mt < 4; ++mt) { u32x2 o = {pack2(acc[u][mt][0] * il, acc[u][mt][1] * il), pack2(acc[u][mt][2] * il, acc[u][mt][3] * il)};
            stg((u32x2*)(p.Nb() + orow * 512 + head * 64 + mt * 16 + fq * 4), o); }
    }
}

DEV void mlstm_stepC_task(const Params& p, const SetDesc& sd, int layer, int task, char* shm) {
    const int tid = TID(), lane = tid & 63, w = tid >> 6, tq = lane & 15, fq = lane >> 4, tq4 = (lane & 15) >> 2, tp4 = lane & 3;
    const int tb = task % sd.ntb, h = (task / sd.ntb) & 3, sl = task / (sd.ntb * 4);
    const int row0 = (sl << sd.lgseq) + tb * 128; const bool latent = !sd.is_ctx; const int tl0 = tb * 128;
    bf16_t* Ks = (bf16_t*)shm;
    bf16_t* Vs = (bf16_t*)(shm + 128 * K_LD * 2);
    bf16_t* Cs = (bf16_t*)(shm + 128 * K_LD * 2 + 128 * V_LD * 2);
    float* ga = (float*)(shm + 128 * K_LD * 2 * 3 + 128 * V_LD * 2); float* gb = ga + 256; float* gpm = gb + 256; float* gtot = gpm + 256; float* tmp = gtot + 8;
    float* nvs = tmp + 16;
    float* cms = nvs + 128;
    const bf16_t* prow = proj_buf(p, sd) + (size_t)row0 * PWA;
    __syncthreads();
    gate_scan(prow, h, p.gate_bias + (size_t)layer * 16, ga, gb, gpm, gtot, tmp);
    {
        const int s = tid & 127, cpi = tid >> 7, cp = (cpi & 1) + (cpi >> 1) * 4;
        const bf16_t* hp = prow + (size_t)s * PWA + C_KM + h * 64;
        float k1[8], k2[8];
        load_rope_chunk(hp, cp, latent, tl0 + s, p.rope(), 1.0f, k1);
        load_rope_chunk(hp, cp + 2, latent, tl0 + s, p.rope(), 1.0f, k2);
        u32x4 o1 = {pack2(k1[0], k1[1]), pack2(k1[2], k1[3]), pack2(k1[4], k1[5]), pack2(k1[6], k1[7])};
        u32x4 o2 = {pack2(k2[0], k2[1]), pack2(k2[2], k2[3]), pack2(k2[4], k2[5]), pack2(k2[6], k2[7])};
        *(u32x4*)(Ks + s * K_LD + cp * 8) = o1; *(u32x4*)(Ks + s * K_LD + (cp + 2) * 8) = o2;
    }
#pragma unroll
    for (int it = 0; it < 4; ++it) { const int item = tid + it * 512, s = item >> 4, ch = item & 15;
        *(u32x4*)(Vs + s * V_LD + ch * 8) = ldg((const u32x4*)(prow + (size_t)s * PWA + C_VM + h * 128 + ch * 8)); }
#pragma unroll
    for (int it = 0; it < 4; ++it) { const int item = tid + it * 512, dir = item >> 10, rem = item & 1023, v = rem >> 3, ch = rem & 7;
        *(u32x4*)(Cs + (dir * 128 + v) * K_LD + ch * 8) = ldg((const u32x4*)(p.Cin() + (size_t)st_index(sd, sl, h, dir, tb) * 8192 + v * 64 + ch * 8)); }
    if (tid < 128) nvs[tid] = ldg(p.Cn() + (size_t)st_index(sd, sl, h, tid >> 6, tb) * 64 + (tid & 63));
    if (tid < 2) cms[tid] = ldg(p.Cm() + (size_t)st_index(sd, sl, h, tid, tb) * 4);
    bf16x8 qf[2]; float qv[2][8];
    {
        const int t = w * 16 + tq; const bf16_t* hp = prow + (size_t)t * PWA + C_QM + h * 64;
#pragma unroll
        for (int ks = 0; ks < 2; ++ks) { load_rope_chunk(hp, ks * 4 + fq, latent, tl0 + t, p.rope(), 0.125f, qv[ks]);
            u32x4 o = {pack2(qv[ks][0], qv[ks][1]), pack2(qv[ks][2], qv[ks][3]), pack2(qv[ks][4], qv[ks][5]), pack2(qv[ks][6], qv[ks][7])}; qf[ks] = mk8(o); }
    }
    __syncthreads();
    const int t = w * 16 + tq;
    f32x4 hsum[8];
#pragma unroll
    for (int mt = 0; mt < 8; ++mt) hsum[mt] = (f32x4){0.f, 0.f, 0.f, 0.f};
#pragma unroll
    for (int dir = 0; dir < 2; ++dir) {
        const float m_in = cms[dir];
        const float Mt = fmaxf(m_in, gpm[dir * 128 + t]);
        const float inter = __expf(m_in - Mt);
        const float mtot = gb[dir * 128 + t] + Mt;
        f32x4 acc[8];
#pragma unroll
        for (int mt = 0; mt < 8; ++mt) { acc[mt] = (f32x4){0.f, 0.f, 0.f, 0.f};
#pragma unroll
            for (int ks = 0; ks < 2; ++ks) { const bf16x8 cf = *(const bf16x8*)(Cs + (dir * 128 + mt * 16 + tq) * K_LD + ks * 32 + fq * 8);
                acc[mt] = mfma16(cf, qf[ks], acc[mt]); }
            acc[mt] = acc[mt] * inter; }
        float qn = 0.f;
#pragma unroll
        for (int ks = 0; ks < 2; ++ks)
#pragma unroll
            for (int j = 0; j < 8; ++j) qn += bf2f(f2bf(qv[ks][j])) * nvs[dir * 64 + ks * 32 + fq * 8 + j];
        qn += shx<16>(qn); qn += shx<32>(qn);
        float den = inter * qn;
        const int u_lo = dir == 0 ? 0 : (w >> 1), u_hi = dir == 0 ? (w >> 1) : 3;
        float rsum = 0.f;
        for (int u = u_lo; u <= u_hi; ++u) {
            unsigned pk[4];
#pragma unroll
            for (int kt = 0; kt < 2; ++kt) { f32x4 sa = {0.f, 0.f, 0.f, 0.f}; const int sb = 32 * u + 16 * kt;
#pragma unroll
                for (int ks = 0; ks < 2; ++ks) { const bf16x8 kf = *(const bf16x8*)(Ks + (sb + tq) * K_LD + ks * 32 + fq * 8); sa = mfma16(kf, qf[ks], sa); }
                float pv[4]; float gv4[4];
#pragma unroll
                for (int r = 0; r < 4; ++r) gv4[r] = ga[dir * 128 + sb + fq * 4 + r];
#ifndef CPU_EMU
                asm volatile("" : "+v"(gv4[0]), "+v"(gv4[1]), "+v"(gv4[2]), "+v"(gv4[3]));
#endif
#pragma unroll
                for (int r = 0; r < 4; ++r) { const int s = sb + fq * 4 + r; const bool valid = dir == 0 ? (s <= t) : (s >= t);
                    pv[r] = valid ? sa[r] * __expf(gv4[r] - Mt) : 0.f; pv[r] = bf2f(f2bf(pv[r])); rsum += pv[r]; }
                pk[kt * 2] = pack2(pv[0], pv[1]); pk[kt * 2 + 1] = pack2(pv[2], pv[3]); }
            u32x4 pkv = {pk[0], pk[1], pk[2], pk[3]}; const bf16x8 pf = mk8(pkv);
#pragma unroll
            for (int mt = 0; mt < 8; ++mt) { const bf16_t* vp = Vs + (32 * u + 4 * fq + tq4) * V_LD + mt * 16 + 4 * tp4;
                const bf16x8 vf = mk8(TR16(vp), TR16(vp + 16 * V_LD));
                acc[mt] = mfma16(vf, pf, acc[mt]); }
        }
        rsum += shx<16>(rsum); rsum += shx<32>(rsum);
        den += rsum;
        const float dn = frcp(fmaxf(fabsf(den), __expf(-mtot)));
#pragma unroll
        for (int mt = 0; mt < 8; ++mt) hsum[mt] = hsum[mt] + acc[mt] * dn;
    }
    float ss = 0.f;
#pragma unroll
    for (int mt = 0; mt < 8; ++mt)
#pragma unroll
        for (int r = 0; r < 4; ++r) ss += hsum[mt][r] * hsum[mt][r];
    ss += shx<16>(ss); ss += shx<32>(ss);
    const float rstd = rsqrtf(ss * (1.0f / 128.0f) + RMS_EPS);
#pragma unroll
    for (int mt = 0; mt < 8; ++mt) { const int v = mt * 16 + fq * 4;
        const u32x2 om = ldg((const u32x2*)(prow + (size_t)t * PWA + C_OM + h * 128 + v));
        u32x2 o = {pack2(hsum[mt][0] * rstd * sigmoidf_(lo16(om.x)), hsum[mt][1] * rstd * sigmoidf_(hi16(om.x))),
                   pack2(hsum[mt][2] * rstd * sigmoidf_(lo16(om.y)), hsum[mt][3] * rstd * sigmoidf_(hi16(om.y)))};
        stg((u32x2*)(p.Mb() + (size_t)(row0 + t) * 512 + h * 128 + v), o); }
}

struct SchedMerge {
    const bf16_t* Mb; const bf16_t* Pb; const bf16_t* Nb; const bf16_t* Wb; int nM;
    DEV bool next(int i, GUnit& u) const { u.aux = i % 3; return tile_order(i / 3, nM, 4, u.pm, u.pn); }
    DEV const bf16_t* a_base(const GUnit& u) const { return (u.aux == 0 ? Mb : (u.aux == 1 ? Pb : Nb)) + (size_t)u.pm * 256 * 512; }
    DEV const bf16_t* b_base(const GUnit& u) const { return Wb + ((size_t)u.aux * 1024 + u.pn * 256) * 512; }
    DEV int grow(const GUnit&, int) const { return 0; }
};
DEV void phase_merge(const Params& p, const SetDesc& sd, int layer, char* shm) {
    SchedMerge S; S.Mb = p.Mb(); S.Pb = p.Pb(); S.Nb = p.Nb(); S.Wb = p.WbT() + (size_t)layer * 3 * 1024 * 512; S.nM = sd.nrows / 256;
    const unsigned char* bgb = p.BG(); bf16_t* mgb = p.MERGED();
    gemm_stream<false, 512, 512, 512>(shm, S, [=](const GUnit& u, f32x4 (&acc)[2][2][4][2], int r0, int c0) -> bool {
        if (u.aux < 2) {
            u32x2 ga[2][4][2], gb[2][4][2];
#pragma unroll
            for (int ai = 0; ai < 2; ++ai)
#pragma unroll
                for (int m = 0; m < 4; ++m)
#pragma unroll
                    for (int hf = 0; hf < 2; ++hf) { const unsigned char* gp = bgb + ((size_t)u.pm * 256 + r0 + ai * 128 + m * 16) * NBG + u.aux * 1024 + u.pn * 256 + c0 + hf * 128;
                        ga[ai][m][hf] = ldg((const u32x2*)gp); gb[ai][m][hf] = ldg((const u32x2*)(gp + 1024)); }
#pragma unroll
            for (int ai = 0; ai < 2; ++ai)
#pragma unroll
                for (int m = 0; m < 4; ++m)
#pragma unroll
                    for (int hf = 0; hf < 2; ++hf) {
#pragma unroll
                        for (int j = 0; j < 4; ++j) { acc[ai][hf][m][0][j] *= u8f(ga[ai][m][hf].x, j) * frcp(u8f(gb[ai][m][hf].x, j)); acc[ai][hf][m][1][j] *= u8f(ga[ai][m][hf].y, j) * frcp(u8f(gb[ai][m][hf].y, j)); } }
            return true;
        }
        u32x2 gm2[2][4][2];
#pragma unroll
        for (int ai = 0; ai < 2; ++ai)
#pragma unroll
            for (int m = 0; m < 4; ++m)
#pragma unroll
                for (int hf = 0; hf < 2; ++hf) gm2[ai][m][hf] = ldg((const u32x2*)(bgb + ((size_t)u.pm * 256 + r0 + ai * 128 + m * 16) * NBG + 2048 + u.pn * 256 + c0 + hf * 128));
#pragma unroll
        for (int ai = 0; ai < 2; ++ai) {
#pragma unroll
            for (int m = 0; m < 4; ++m)
#pragma unroll
                for (int hf = 0; hf < 2; ++hf) { const size_t r = (size_t)u.pm * 256 + r0 + ai * 128 + m * 16;
                    const f32x4 x0 = acc[ai][hf][m][0] * (1.0f / 255.0f), x1 = acc[ai][hf][m][1] * (1.0f / 255.0f); const u32x2 g = gm2[ai][m][hf];
                    u32x4 ov = {pack2(x0[0] * u8f(g.x, 0), x0[1] * u8f(g.x, 1)), pack2(x0[2] * u8f(g.x, 2), x0[3] * u8f(g.x, 3)),
                                pack2(x1[0] * u8f(g.y, 0), x1[1] * u8f(g.y, 1)), pack2(x1[2] * u8f(g.y, 2), x1[3] * u8f(g.y, 3))};
                    stg((u32x4*)(mgb + r * 1024 + u.pn * 256 + c0 + hf * 128), ov); }
        }
        return false; });
}
DEV void phase_outproj(const Params& p, const SetDesc& sd, int layer, char* shm) {
    SchedPlain S; S.A = p.MERGED(); S.Bt = p.WoT() + (size_t)layer * 1024 * 1024; S.nM = sd.nrows / 256; S.nN = 4; S.lda256 = 256 * 1024; S.ldb256 = 256 * 1024;
    bf16_t* yb = p.Y();
    gemm_stream<false, 1024, 1024, 1024>(shm, S, [=](const GUnit& u, const f32x4 (&acc)[2][2][4][2], int r0, int c0) {
#pragma unroll
        for (int ai = 0; ai < 2; ++ai)
#pragma unroll
            for (int m = 0; m < 4; ++m) { bf16_t* o = yb + ((size_t)u.pm * 256 + r0 + ai * 128 + m * 16) * 1024 + u.pn * 256 + c0;
                store8bf(o, acc[ai][0][m][0], acc[ai][0][m][1]); store8bf(o + 128, acc[ai][1][m][0], acc[ai][1][m][1]); } });
}

template <bool SRC_BF> DEV void phase_postmix(const Params& p, const SetDesc& sd, int layer, char* shm) {
    const int tid = TID(), lane = tid & 63, wv = tid >> 6;
    float* wr_s = (float*)shm;
    __syncthreads();
    for (int i = tid; i < 1024 * 16; i += NTHREADS) { const int c = i >> 4, e = i & 15, ln = (c & 511) >> 3, j = c & 7, hf = c >> 9;
        wr_s[((((hf * 8 + j) * 4 + (e >> 2)) * 64 + ln) << 2) + (e & 3)] = ldg(p.router_w + (size_t)layer * 1024 * 16 + i); }
    __syncthreads();
    const float* g1 = p.norm_gain + ((size_t)layer * 4 + 1) * 1024; const float* g2 = p.norm_gain + ((size_t)layer * 4 + 2) * 1024;
    float* par = (float*)(shm + 65536);
    { const int rpb0_ = (sd.nrows + (int)gridDim.x - 1) / (int)gridDim.x; const float* mdb = mod_row(p, sd, layer, min((int)blockIdx.x * rpb0_, sd.nrows - 1));
      stage_params(par, g1, g2, mdb + 2048, mdb + 3072, mdb + 4096); }
    __syncthreads();
    const void* xb = SRC_BF ? (const void*)xbf_base(p, sd) : (const void*)xin_f32(p, sd); bf16_t* xdb = xbf_base(p, sd);
    const int stride = 8; const int rpb_ = (sd.nrows + (int)gridDim.x - 1) / (int)gridDim.x; const int row_end = min(sd.nrows, ((int)blockIdx.x + 1) * rpb_);
    int row = (int)blockIdx.x * rpb_ + wv;
    u32x4 ycur[2], ynxt[2]; XRow<SRC_BF> xcur, xnxt;
    if (row < row_end) {
#pragma unroll
        for (int i = 0; i < 2; ++i) ycur[i] = ldg((const u32x4*)(p.Y() + (size_t)row * 1024 + i * 512 + lane * 8));
        xcur.load(xb, row, lane); }
    for (; row < row_end; row += stride) {
        int ln = lane; HIDE(ln);
        const int rn = row + stride;
        if (rn < row_end) {
#pragma unroll
            for (int i = 0; i < 2; ++i) ynxt[i] = ldg((const u32x4*)(p.Y() + (size_t)rn * 1024 + i * 512 + ln * 8));
            xnxt.load(xb, rn, ln); }
        float y[16]; float ss = 0.f;
#pragma unroll
        for (int hlf = 0; hlf < 2; ++hlf) { const u32x4 m = ycur[hlf];
            const float t8[8] = {lo16(m.x), hi16(m.x), lo16(m.y), hi16(m.y), lo16(m.z), hi16(m.z), lo16(m.w), hi16(m.w)};
#pragma unroll
            for (int j = 0; j < 8; ++j) { y[hlf * 8 + j] = t8[j]; ss += t8[j] * t8[j]; } }
        ss = wave_sum(ss);
        const float rstd = rsqrtf(ss * (1.0f / 1024.0f) + RMS_EPS);
        float xn[16]; float ss2 = 0.f;
#pragma unroll
        for (int hlf = 0; hlf < 2; ++hlf) { f32x4 xw[2];
#pragma unroll
            for (int q = 0; q < 2; ++q) { const int c0 = hlf * 512 + ln * 8 + q * 4; const f32x4 xo = xcur.get(hlf * 2 + q);
#pragma unroll
                for (int j = 0; j < 4; ++j) { const float v = xo[j] + par[2048 + c0 + j] * (y[hlf * 8 + q * 4 + j] * rstd * par[c0 + j]); xw[q][j] = v; xn[hlf * 8 + q * 4 + j] = v; ss2 += v * v; } }
            xrow_store8<true>(xdb, row, hlf * 512 + ln * 8, xw[0], xw[1]); }
        ss2 = wave_sum(ss2);
        const float rstd2 = rsqrtf(ss2 * (1.0f / 1024.0f) + RMS_EPS);
        float lg[16];
#pragma unroll
        for (int e = 0; e < 16; ++e) lg[e] = 0.f;
#pragma unroll
        for (int hlf = 0; hlf < 2; ++hlf) { const int c0 = hlf * 512 + ln * 8; float o[8];
#pragma unroll
            for (int j = 0; j < 8; ++j) { o[j] = xn[hlf * 8 + j] * rstd2 * par[1024 + c0 + j] * (1.0f + par[4096 + c0 + j]) + par[3072 + c0 + j];
#pragma unroll
                for (int eq = 0; eq < 4; ++eq) { const f32x4 w4 = *(const f32x4*)(wr_s + ((((hlf * 8 + j) * 4 + eq) * 64 + ln) << 2));
#pragma unroll
                    for (int e = 0; e < 4; ++e) lg[eq * 4 + e] += o[j] * w4[e]; } }
            const u32x2 ov = {f8pack4(o[0], o[1], o[2], o[3]), f8pack4(o[4], o[5], o[6], o[7])};
            stg((u32x2*)((unsigned char*)p.H() + (size_t)row * 1024 + c0), ov); }
        float r8[8], r4[4], r2[2], r1;
        { const bool b = (lane & 32) != 0;
#pragma unroll
          for (int i = 0; i < 8; ++i) { const float keep = b ? lg[i + 8] : lg[i], send = b ? lg[i] : lg[i + 8]; r8[i] = keep + shx<32>(send); } }
        { const bool b = (lane & 16) != 0;
#pragma unroll
          for (int i = 0; i < 4; ++i) { const float keep = b ? r8[i + 4] : r8[i], send = b ? r8[i] : r8[i + 4]; r4[i] = keep + shx<16>(send); } }
        { const bool b = (lane & 8) != 0;
#pragma unroll
          for (int i = 0; i < 2; ++i) { const float keep = b ? r4[i + 2] : r4[i], send = b ? r4[i] : r4[i + 2]; r2[i] = keep + shx<8>(send); } }
        { const bool b = (lane & 4) != 0; const float keep = b ? r2[1] : r2[0], send = b ? r2[0] : r2[1]; r1 = keep + shx<4>(send); }
        r1 += shx<2>(r1); r1 += shx<1>(r1);
        float mx = r1;
        mx = fmaxf(mx, shx<4>(mx)); mx = fmaxf(mx, shx<8>(mx)); mx = fmaxf(mx, shx<16>(mx)); mx = fmaxf(mx, shx<32>(mx));
        const float ex = __expf(r1 - mx);
        float se = ex;
        se += shx<4>(se); se += shx<8>(se); se += shx<16>(se); se += shx<32>(se);
        if ((lane & 3) == 0) { const int e = ((lane >> 5) & 1) * 8 + ((lane >> 4) & 1) * 4 + ((lane >> 3) & 1) * 2 + ((lane >> 2) & 1);
            stg(p.aff() + (size_t)row * 16 + e, ex * frcp(se)); }
#pragma unroll
        for (int i = 0; i < 2; ++i) ycur[i] = ynxt[i];
        xcur = xnxt;
    }
}

DEV unsigned shxu(unsigned v, int m) {
    const float f = __uint_as_float(v); float r;
    switch (m) { case 1: r = shx<1>(f); break; case 2: r = shx<2>(f); break; case 4: r = shx<4>(f); break; case 8: r = shx<8>(f); break; case 16: r = shx<16>(f); break; default: r = shx<32>(f); break; }
    return __float_as_uint(r);
}
#define TK_CX(a_, b_, desc_) do { const unsigned long long x_ = key[a_], y_ = key[b_]; const bool sw_ = (desc_) ? (x_ < y_) : (x_ > y_); key[a_] = sw_ ? y_ : x_; key[b_] = sw_ ? x_ : y_; } while (0)
template <int TJ> DEV void tk_step_sh(unsigned long long (&key)[4], int tid, bool desc4) {
    unsigned long long pk[4];
#pragma unroll
    for (int m = 0; m < 4; ++m) { const unsigned lo = __float_as_uint(shx<TJ>(__uint_as_float((unsigned)key[m]))), hi = __float_as_uint(shx<TJ>(__uint_as_float((unsigned)(key[m] >> 32))));
        pk[m] = ((unsigned long long)hi << 32) | lo; }
    const bool takemax = desc4 == ((tid & TJ) == 0);
#pragma unroll
    for (int m = 0; m < 4; ++m) { const unsigned long long x = key[m], y = pk[m]; key[m] = takemax ? (x > y ? x : y) : (x < y ? x : y); }
}
DEV void tk_step_lds(unsigned long long (&key)[4], unsigned long long* buf, int tid, int tj, bool active, bool desc4) {
    unsigned long long pk[4];
    __syncthreads();
    if (active) {
#pragma unroll
        for (int m = 0; m < 4; ++m) buf[tid * 4 + m] = key[m]; }
    __syncthreads();
#pragma unroll
    for (int m = 0; m < 4; ++m) pk[m] = active ? buf[(tid ^ tj) * 4 + m] : 0ull;
    const bool takemax = desc4 == ((tid & tj) == 0);
#pragma unroll
    for (int m = 0; m < 4; ++m) { const unsigned long long x = key[m], y = pk[m]; key[m] = takemax ? (x > y ? x : y) : (x < y ? x : y); }
}
DEV void topk_task(const Params& p, const SetDesc& sd, int task, char* shm) {
    const int tid = TID();
    const int e = task & 15, sl = task >> 4;
    unsigned long long* buf = (unsigned long long*)shm;
    const int T = 1 << sd.lgseq, cap = sd.cap;
    const int rbase = sl << sd.lgseq;
    const bool active = tid * 4 < T;
    unsigned long long key[4];
    __syncthreads();
#pragma unroll
    for (int m = 0; m < 4; ++m) { const int i = tid * 4 + m; const float a = active ? ldg(p.aff() + (size_t)(rbase + i) * 16 + e) : 0.f;
        key[m] = ((unsigned long long)__float_as_uint(a) << 32) | (unsigned)(0xFFFFFFFFu - (unsigned)i); }
    for (int k = 2; k <= T; k <<= 1) {
        const bool desc4 = ((tid * 4) & k) == 0;
        for (int j = k >> 1; j >= 256; j >>= 1) tk_step_lds(key, buf, tid, j >> 2, active, desc4);
        if (k >= 256) tk_step_sh<32>(key, tid, desc4);
        if (k >= 128) tk_step_sh<16>(key, tid, desc4);
        if (k >= 64) tk_step_sh<8>(key, tid, desc4);
        if (k >= 32) tk_step_sh<4>(key, tid, desc4);
        if (k >= 16) tk_step_sh<2>(key, tid, desc4);
        if (k >= 8) tk_step_sh<1>(key, tid, desc4);
        if (k >= 4) { TK_CX(0, 2, desc4); TK_CX(1, 3, desc4); TK_CX(0, 1, desc4); TK_CX(2, 3, desc4); }
        else { TK_CX(0, 1, true); TK_CX(2, 3, false); }
    }
    const int sbase = e * sd.rpe + sl * cap;
    if (active) {
#pragma unroll
        for (int m = 0; m < 4; ++m) { const int i = tid * 4 + m; const unsigned long long kv = key[m]; const int tok = (int)(0xFFFFFFFFu - (unsigned)(kv & 0xFFFFFFFFu));
            const int row = rbase + tok;
            if (i < cap) { stg(p.slot_token() + sbase + i, row); stg(p.slot_gate() + sbase + i, __uint_as_float((unsigned)(kv >> 32))); stg(p.token_slots() + (size_t)row * 16 + e, sbase + i); }
            else stg(p.token_slots() + (size_t)row * 16 + e, -1); } }
    if (sl == 0) { const int used = sd.nsamp * cap;
        for (int i = used + tid; i < sd.rpe; i += NTHREADS) { stg(p.slot_token() + e * sd.rpe + i, 0); stg(p.slot_gate() + e * sd.rpe + i, 0.f); } }
}
#undef TK_CX

struct SchedMoe {
    const bf16_t* A; const int* st; const bf16_t* W; int nRT, rpe, nN, wstride;
    DEV bool next(int i, GUnit& u) const { int pmx, pn; if (!tile_order(i, 16 * nRT, nN, pmx, pn)) return false; u.pm = pmx % nRT; u.aux = pmx / nRT; u.pn = pn; return true; }
    DEV int slot0(const GUnit& u) const { return u.aux * rpe + u.pm * 256; }
    DEV const bf16_t* a_base(const GUnit&) const { return A; }
    DEV int grow(const GUnit& u, int i) const { return st ? ldg(st + slot0(u) + i) : slot0(u) + i; }
    DEV const bf16_t* b_base(const GUnit& u) const { return W + (size_t)u.aux * wstride + (size_t)u.pn * 256 * 512; }
};
DEV void phase_moe_gu(const Params& p, const SetDesc& sd, int layer, char* shm) {
    SchedMoe S; S.A = p.H(); S.st = p.slot_token(); S.W = p.WguT() + (size_t)layer * 16 * 2048 * 512; S.nRT = sd.rpe / 256; S.rpe = sd.rpe; S.nN = 8; S.wstride = 2048 * 512;
    unsigned char* hb = (unsigned char*)p.HID();
    gemm_stream<true, 512, 512, 512, true>(shm, S, [=](const GUnit& u, const f32x4 (&acc)[2][2][4][2], int r0, int c0) {
#pragma unroll
        for (int ai = 0; ai < 2; ++ai)
#pragma unroll
            for (int m = 0; m < 4; ++m) { f32x4 h0, h1; const f32x4 a0 = acc[ai][0][m][0] * F8_WINV, a1 = acc[ai][0][m][1] * F8_WINV, b0 = acc[ai][1][m][0] * F8_WINV, b1 = acc[ai][1][m][1] * F8_WINV;
#pragma unroll
                for (int j = 0; j < 4; ++j) { h0[j] = a0[j] * sigmoidf_(a0[j]) * b0[j]; h1[j] = a1[j] * sigmoidf_(a1[j]) * b1[j]; }
                const u32x2 hv = {f8pack4(h0[0], h0[1], h0[2], h0[3]), f8pack4(h1[0], h1[1], h1[2], h1[3])};
                stg((u32x2*)(hb + ((size_t)S.slot0(u) + r0 + ai * 128 + m * 16) * 1024 + u.pn * 128 + c0), hv); } });
}
DEV void phase_moe_down(const Params& p, const SetDesc& sd, int layer, char* shm) {
    SchedMoe S; S.A = p.HID(); S.st = nullptr; S.W = p.WdT() + (size_t)layer * 16 * 1024 * 512; S.nRT = sd.rpe / 256; S.rpe = sd.rpe; S.nN = 4; S.wstride = 1024 * 512;
    unsigned char* yb = (unsigned char*)p.YE(); const float* gt = p.slot_gate();
    gemm_stream<true, 512, 512, 512, true>(shm, S, [=](const GUnit& u, const f32x4 (&acc)[2][2][4][2], int r0, int c0) {
#pragma unroll
        for (int ai = 0; ai < 2; ++ai) {
            float gv[4];
#pragma unroll
            for (int m = 0; m < 4; ++m) gv[m] = ldg(gt + (size_t)S.slot0(u) + r0 + ai * 128 + m * 16) * (F8_WINV * YE_SCALE);
#pragma unroll
            for (int m = 0; m < 4; ++m) { const size_t sl = (size_t)S.slot0(u) + r0 + ai * 128 + m * 16; const float g = gv[m];
                unsigned char* o = yb + sl * 1024 + u.pn * 256 + c0;
#pragma unroll
                for (int hf = 0; hf < 2; ++hf) { const f32x4 a = acc[ai][hf][m][0] * g, b = acc[ai][hf][m][1] * g;
                    const u32x2 ov = {f8pack4(a[0], a[1], a[2], a[3]), f8pack4(b[0], b[1], b[2], b[3])}; stg((u32x2*)(o + hf * 128), ov); } } } });
}

DEV void compact4(const int (&sl)[16], int (&c)[4], int& n) {
    n = 0; c[0] = -1; c[1] = -1; c[2] = -1; c[3] = -1;
#pragma unroll
    for (int e = 0; e < 16; ++e) if (sl[e] >= 0) { c[0] = (n == 0) ? sl[e] : c[0]; c[1] = (n == 1) ? sl[e] : c[1]; c[2] = (n == 2) ? sl[e] : c[2]; c[3] = (n == 3) ? sl[e] : c[3]; ++n; }
}
template <bool DST_F32> DEV void phase_combine(const Params& p, const SetDesc& sd, int layer, char* shm) {
    const int tid = TID(), lane = tid & 63, wv = tid >> 6;
    const float* g3 = p.norm_gain + ((size_t)layer * 4 + 3) * 1024;
    const bf16_t* xsb = xbf_base(p, sd); void* xdb = DST_F32 ? (void*)xout_f32(p, sd) : (void*)xbf_base(p, sd);
    const int stride = 8; const int rpb_ = (sd.nrows + (int)gridDim.x - 1) / (int)gridDim.x; const int row_end = min(sd.nrows, ((int)blockIdx.x + 1) * rpb_);
    int row = __builtin_amdgcn_readfirstlane((int)blockIdx.x * rpb_ + wv);
    float* par = (float*)shm;
    __syncthreads();
    { const float* mdb = mod_row(p, sd, layer, min((int)blockIdx.x * rpb_, sd.nrows - 1)); stage_params(par, g3, mdb + 5120, nullptr, nullptr, nullptr); }
    __syncthreads();
    int raw[16]; int cc[4], cn[4]; int nc = 0, nn = 0;
    u32x2 mc[4][2], mn[4][2]; XRow<true> xc, xn;
#define CMB_SLOTS(r_) do { _Pragma("unroll") for (int e = 0; e < 16; ++e) raw[e] = ldg(p.token_slots() + (size_t)(r_) * 16 + e); } while (0)
#define CMB_DATA(r_, c_, n_, m_, x_) do { _Pragma("unroll") for (int k = 0; k < 4; ++k) { \
            if (k < (n_)) { const unsigned char* yr = (const unsigned char*)p.YE() + (size_t)(c_)[k] * 1024 + lane * 8; (m_)[k][0] = ldg((const u32x2*)yr); (m_)[k][1] = ldg((const u32x2*)(yr + 512)); } \
            else { (m_)[k][0] = (u32x2){0u, 0u}; (m_)[k][1] = (u32x2){0u, 0u}; } } \
        (x_).load(xsb, (r_), lane); } while (0)
    if (row < row_end) { CMB_SLOTS(row); compact4(raw, cc, nc); CMB_DATA(row, cc, nc, mc, xc); if (row + stride < row_end) CMB_SLOTS(row + stride); }
    for (; row < row_end; row += stride) {
        const int rn = row + stride;
        if (rn < row_end) { compact4(raw, cn, nn); CMB_DATA(rn, cn, nn, mn, xn); if (rn + stride < row_end) CMB_SLOTS(rn + stride); }
        float y[16];
#pragma unroll
        for (int j = 0; j < 16; ++j) y[j] = 0.f;
        if (nc <= 4) {
#pragma unroll
            for (int k = 0; k < 4; ++k)
                if (k < nc) {
#pragma unroll
                    for (int hlf = 0; hlf < 2; ++hlf) { const f32x4 a = f8x4_f32(mc[k][hlf].x), b = f8x4_f32(mc[k][hlf].y);
#pragma unroll
                        for (int j = 0; j < 4; ++j) { y[hlf * 8 + j] += a[j]; y[hlf * 8 + 4 + j] += b[j]; } } }
        } else {
            for (int e = 0; e < 16; ++e) { const int sl_ = ldg(p.token_slots() + (size_t)row * 16 + e);
                if (sl_ >= 0) { const unsigned char* yr = (const unsigned char*)p.YE() + (size_t)sl_ * 1024 + lane * 8;
#pragma unroll
                    for (int hlf = 0; hlf < 2; ++hlf) { const u32x2 m = ldg((const u32x2*)(yr + hlf * 512)); const f32x4 a = f8x4_f32(m.x), b = f8x4_f32(m.y);
#pragma unroll
                        for (int j = 0; j < 4; ++j) { y[hlf * 8 + j] += a[j]; y[hlf * 8 + 4 + j] += b[j]; } } } }
        }
        float ss = 0.f;
#pragma unroll
        for (int j = 0; j < 16; ++j) ss += y[j] * y[j];
        ss = wave_sum(ss);
        const float rstd = rsqrtf(ss * (YE_INV * YE_INV / 1024.0f) + RMS_EPS) * YE_INV;
#pragma unroll
        for (int hlf = 0; hlf < 2; ++hlf) { f32x4 xv[2];
#pragma unroll
            for (int q = 0; q < 2; ++q) { const int c0 = hlf * 512 + lane * 8 + q * 4; xv[q] = xc.get(hlf * 2 + q);
#pragma unroll
                for (int j = 0; j < 4; ++j) xv[q][j] += par[1024 + c0 + j] * (y[hlf * 8 + q * 4 + j] * rstd * par[c0 + j]); }
            xrow_store8<!DST_F32>(xdb, row, hlf * 512 + lane * 8, xv[0], xv[1]); }
        nc = nn;
#pragma unroll
        for (int k = 0; k < 4; ++k) { cc[k] = cn[k]; mc[k][0] = mn[k][0]; mc[k][1] = mn[k][1]; }
        xc = xn;
    }
#undef CMB_SLOTS
#undef CMB_DATA
}

constexpr int WQ_WORD0 = 4096;
template <class F> DEV void wq_run(const Params& p, int qidx, int ntasks, char* shm, F&& task) {
    unsigned* ctr = p.bar() + WQ_WORD0 + 64 * qidx;
    volatile int* slot = (volatile int*)(shm + 131072 + 64);
    const int tid = TID();
    int cur = blockIdx.x;
    while (cur < ntasks) {
        unsigned pend = 0u;
        if (tid == 0) pend = atomicAdd(ctr, 1u);
        task(cur);
        __syncthreads();
        if (tid == 0) *slot = (int)gridDim.x + (int)pend;
        __syncthreads();
        cur = *slot;
    }
}

template <int PH> DEV void do_phase(const Params& p, int layer, int is_ctx, int grp, char* shm) {
    const SetDesc sd = make_set(is_ctx, grp);
    if constexpr (PH == -1) phase_prologue(p, shm);
    if constexpr (PH == 0) { if (layer == 0) phase_norm1<false>(p, sd, layer, shm); else phase_norm1<true>(p, sd, layer, shm); }
    if constexpr (PH == 1) phase_proj_a(p, sd, layer, shm);
    const int qbase = ((layer * 3 + (is_ctx ? 0 : grp + 1)) * 13 + (PH < 0 ? 0 : PH)) * 2;
    if constexpr (PH == 2) { wq_run(p, qbase, sd.nsamp * 4 * sd.ntb, shm, [&](int t) { mlstm_stepA_task(p, sd, layer, t, shm); }); if (!(is_ctx && layer == 1)) phase_pool(p, sd); }
    if constexpr (PH == 3) {
        for (int t = blockIdx.x; t < sd.nsamp * 32; t += gridDim.x) mlstm_stepB_task(p, sd, t);
        if (!(is_ctx && layer == 1)) {
            const int nq = (is_ctx ? (CTX / 64) : ROWS) / 2;
            wq_run(p, qbase, sd.nsamp * nq * 4, shm, [&](int t) { na_task(p, sd, layer, t / (nq * 4), (t >> 2) % nq, t & 3, shm); });
        }
    }
    if constexpr (PH == 4) { wq_run(p, qbase, sd.nsamp * 4 * sd.ntb, shm, [&](int t) { mlstm_stepC_task(p, sd, layer, t, shm); }); }
    if constexpr (PH == 6) phase_merge(p, sd, layer, shm);
    if constexpr (PH == 7) phase_outproj(p, sd, layer, shm);
    if constexpr (PH == 8) { if (layer == 0) phase_postmix<false>(p, sd, layer, shm); else phase_postmix<true>(p, sd, layer, shm); }
    if constexpr (PH == 9) { for (int t = blockIdx.x; t < sd.nsamp * 16; t += gridDim.x) topk_task(p, sd, t, shm); }
    if constexpr (PH == 10) phase_moe_gu(p, sd, layer, shm);
    if constexpr (PH == 11) phase_moe_down(p, sd, layer, shm);
    if constexpr (PH == 12) { if (layer == 0) phase_combine<false>(p, sd, layer, shm); else phase_combine<true>(p, sd, layer, shm); }
}

#ifndef CPU_EMU
template <int PH> __global__ void __launch_bounds__(NTHREADS, 2) k_phase(Params p, int layer, int is_ctx, int grp) {
    DYN_LDS(shm);
    do_phase<PH>(p, layer, is_ctx, grp, shm);
}
#ifndef DBL_MASK
#define DBL_MASK 0
#endif
#define RUNPH(PH) do { do_phase<PH>(p, layer, is_ctx, grp, shm); xcd_barrier(bar); if ((DBL_MASK >> (PH)) & 1) { do_phase<PH>(p, layer, is_ctx, grp, shm); xcd_barrier(bar); } } while (0)
__global__ void __launch_bounds__(NTHREADS, 2) k_mega(Params p) {
    DYN_LDS(shm);
    uint4* xbw = (uint4*)(shm + 131072);
    if (threadIdx.x == 0) *xbw = make_uint4(0u, 0u, 0u, 0u);
    __syncthreads();
    XcdBarrier bar = xcd_barrier_post(p.bar(), (volatile LAS unsigned*)xbw);
    do_phase<-1>(p, 0, 0, 0, shm);
    xcd_barrier(bar);
    for (int layer = 0; layer < 2; ++layer)
        for (int si = 0; si <= NG; ++si) {
            const int is_ctx = si == 0 ? 1 : 0, grp = si == 0 ? 0 : si - 1;
            RUNPH(0); RUNPH(1); RUNPH(2);
            if (is_ctx && layer == 1) { do_phase<3>(p, layer, is_ctx, grp, shm); continue; }
            RUNPH(3); RUNPH(4); RUNPH(6); RUNPH(7); RUNPH(8); RUNPH(9); RUNPH(10); RUNPH(11);
            do_phase<12>(p, layer, is_ctx, grp, shm);
        }
}
#endif
}

static Params make_params(void* const* d_in, void* d_out, void* d_ws) {
    Params p{};
    p.x = (const float*)d_in[0]; p.c = (const float*)d_in[1]; p.ctx = (const float*)d_in[2]; p.c_ctx = (const float*)d_in[3];
    p.norm_gain = (const float*)d_in[4]; p.ada_w = (const float*)d_in[5]; p.ada_b = (const float*)d_in[6]; p.w_in = (const float*)d_in[7];
    p.gate_bias = (const float*)d_in[8]; p.pool_w = (const float*)d_in[9]; p.pool_scale = (const float*)d_in[10]; p.rpb = (const float*)d_in[11];
    p.w_branch = (const float*)d_in[12]; p.w_out = (const float*)d_in[13]; p.router_w = (const float*)d_in[14];
    p.w_gate = (const float*)d_in[15]; p.w_up = (const float*)d_in[16]; p.w_down = (const float*)d_in[17];
    p.out = (float*)d_out; p.ws = (char*)d_ws;
    return p;
}

#ifdef CPU_EMU
int emu_cfg_B = CFG_B, emu_cfg_ROWS = CFG_ROWS, emu_cfg_CTX = CFG_CTX;
const char* g_dumpdir = "data";
static void* g_ws = nullptr;
static void dump_buf(const char* name, int layer, int is_ctx, int grp, const void* ptr, size_t bytes) {
    char nm[512]; snprintf(nm, sizeof nm, "%s/d_L%d_%s%d_%s.bin", g_dumpdir, layer, is_ctx ? "c" : "g", grp, name);
    FILE* f = fopen(nm, "wb"); fwrite(ptr, 1, bytes, f); fclose(f);
}
static void emu_hook(const Params& p, int layer, int is_ctx, int grp, int ph) {
    const size_t Rn = is_ctx ? RC : RL;
    if (ph == 0) dump_buf("H", layer, is_ctx, grp, p.H(), Rn * 1024 * 2);
    if (ph == 1) dump_buf("PROJ", layer, is_ctx, grp, is_ctx ? p.PROJc() : p.PROJa(), Rn * PWA * 2);
    if (ph == 2) dump_buf("Pb", layer, is_ctx, grp, p.Pb(), Rn * 512 * 2);
    if (ph == 3) dump_buf("Nb", layer, is_ctx, grp, p.Nb(), Rn * 512 * 2);
    if (ph == 4) dump_buf("Mb", layer, is_ctx, grp, p.Mb(), Rn * 512 * 2);
    if (ph == 1) dump_buf("BG", layer, is_ctx, grp, p.BG(), Rn * NBG);
    if (ph == 6) dump_buf("MERGED", layer, is_ctx, grp, p.MERGED(), Rn * 1024 * 2);
    if (ph == 7) dump_buf("Y", layer, is_ctx, grp, p.Y(), Rn * 1024 * 2);
    if (ph == 8) { dump_buf("H2", layer, is_ctx, grp, p.H(), Rn * 1024 * 2); dump_buf("aff", layer, is_ctx, grp, p.aff(), Rn * 16 * 4); }
}
void emu_dump(const char* dir) {
    char nm[512]; snprintf(nm, sizeof nm, "%s/d_mod.bin", dir);
    FILE* f = fopen(nm, "wb"); fwrite((char*)g_ws + WSL.mod, 1, (size_t)2 * (NB + 1) * 6144 * 4, f); fclose(f);
    snprintf(nm, sizeof nm, "%s/d_ctxs.bin", dir);
    f = fopen(nm, "wb"); fwrite((char*)g_ws + WSL.ctxs, 1, (size_t)NB * CTX * 1024 * 2, f); fclose(f);
}
template <int PH> static void emu_run_phase(const Params& p, int layer, int is_ctx, int grp, int nblocks) {
    emu_launch_lambda([=]() { do_phase<PH>(p, layer, is_ctx, grp, emu_blk->smem); }, nblocks, NTHREADS, LDS_BYTES);
    if (PH >= 0) emu_hook(p, layer, is_ctx, grp, PH);
    printf("phase %d layer %d ctx %d grp %d done\n", PH, layer, is_ctx, grp); fflush(stdout);
}
#define LAUNCH_PHASE(PH) emu_run_phase<PH>(p, layer, is_ctx, grp, nblocks)
#else
#define LAUNCH_PHASE(PH) hipLaunchKernelGGL((k_phase<PH>), dim3(nblocks), dim3(NTHREADS), LDS_BYTES, stream, p, layer, is_ctx, grp)
#define SETATTR(PH) (void)hipFuncSetAttribute((const void*)k_phase<PH>, hipFuncAttributeMaxDynamicSharedMemorySize, LDS_BYTES)
#endif

extern "C" void kernel_launch(void* const* d_in, const int* in_sizes, int n_in, void* d_out, int out_size, void* d_ws, size_t ws_size, hipStream_t stream) {
    (void)in_sizes; (void)n_in; (void)out_size;
    if (ws_size < WSL.total) return;
    Params p = make_params(d_in, d_out, d_ws);
#ifdef CPU_EMU
    g_ws = d_ws;
    memset(d_ws, 0xFF, WSL.total);
    memset((char*)d_ws + WSL.bar, 0, 65536);
    const int nblocks = 16;
#else
    const int nblocks = 256;
#if MK_ONE_LAUNCH
    static int grid = 0;
    if (!grid) {
        (void)hipFuncSetAttribute((const void*)k_mega, hipFuncAttributeMaxDynamicSharedMemorySize, LDS_BYTES);
        int dev = 0, cus = 0, per_cu = 0;
        (void)hipGetDevice(&dev);
        (void)hipDeviceGetAttribute(&cus, hipDeviceAttributeMultiprocessorCount, dev);
        (void)hipOccupancyMaxActiveBlocksPerMultiprocessor(&per_cu, (const void*)k_mega, NTHREADS, LDS_BYTES);
        if (per_cu > 1) per_cu = 1;
        grid = cus * per_cu;
        if (grid > 256) grid = 256;
    }
    if (grid <= 0) return;
    (void)hipMemsetAsync(p.bar(), 0, 65536, stream);
    hipLaunchKernelGGL(k_mega, dim3(grid), dim3(NTHREADS), LDS_BYTES, stream, p);
    return;
#else
    static bool attr_done = false;
    if (!attr_done) { SETATTR(-1); SETATTR(0); SETATTR(1); SETATTR(2); SETATTR(3); SETATTR(4); SETATTR(5); SETATTR(6); SETATTR(7); SETATTR(8); SETATTR(9); SETATTR(10); SETATTR(11); SETATTR(12); attr_done = true; }
#endif
#endif
    { const int layer = 0, is_ctx = 0, grp = 0; LAUNCH_PHASE(-1); }
    for (int layer = 0; layer < 2; ++layer)
        for (int si = 0; si <= NG; ++si) {
            const int is_ctx = si == 0 ? 1 : 0, grp = si == 0 ? 0 : si - 1;
            LAUNCH_PHASE(0); LAUNCH_PHASE(1); LAUNCH_PHASE(2); LAUNCH_PHASE(3);
            if (is_ctx && layer == 1) continue;
            LAUNCH_PHASE(4); LAUNCH_PHASE(6); LAUNCH_PHASE(7); LAUNCH_PHASE(8); LAUNCH_PHASE(9); LAUNCH_PHASE(10); LAUNCH_PHASE(11); LAUNCH_PHASE(12);
        }
}
```

```cpp
#ifdef CPU_EMU
#include "emu.h"
#define DYN_LDS(p) char* p = emu_blk->smem
#define WAIT_V(n)
#define WAIT_L(n)
#define HIDE(v)
#define CBAR()
#else
#include <hip/hip_runtime.h>
#define DYN_LDS(p) extern __shared__ __attribute__((aligned(16))) char p[]
#define WAIT_V(n) asm volatile("s_waitcnt vmcnt(" #n ")" ::: "memory")
#define WAIT_L(n) asm volatile("s_waitcnt lgkmcnt(" #n ")" ::: "memory")
#define HIDE(v) asm volatile("" : "+v"(v))
#define CBAR() asm volatile("" ::: "memory")
#endif
#include <stdint.h>
#include <stddef.h>

#ifndef CFG_B
#define CFG_B 32
#define CFG_ROWS 32
#define CFG_CTX 256
#define CFG_G 16
#endif
#ifndef MK_ONE_LAUNCH
#define MK_ONE_LAUNCH 1
#endif

#define DEV __device__ __forceinline__
typedef short s16x4 __attribute__((ext_vector_type(4)));
#ifdef CPU_EMU
#define TR16(ptr) emu_tr16((const void*)(ptr))
#else
typedef __attribute__((address_space(3))) s16x4 lds_s16x4;
#define TR16(ptr) __builtin_amdgcn_ds_read_tr16_b64_v4i16((lds_s16x4*)(ptr))
#endif
#ifdef CPU_EMU
#define TID() (threadIdx.x)
#else
#define TID() ({ int t_ = threadIdx.x; asm volatile("" : "+v"(t_)); t_; })
#endif

typedef unsigned short bf16_t;
typedef short bf16x8 __attribute__((ext_vector_type(8)));
typedef float f32x4 __attribute__((ext_vector_type(4)));
typedef unsigned u32x2 __attribute__((ext_vector_type(2)));
typedef unsigned u32x4 __attribute__((ext_vector_type(4)));

namespace {
constexpr int D = 1024, NB = CFG_B, ROWS = CFG_ROWS, SEQ = ROWS * 64, CTX = CFG_CTX, G = CFG_G, NG = NB / G;
constexpr int RL = G * SEQ, RC = NB * CTX, RMAX = RL > RC ? RL : RC;
constexpr int PWA = 3840, NBG = 3072, PWT = PWA + NBG, PWSRC = 6672, C_SPLIT = 3600;
constexpr int C_QM = 0, C_KM = 256, C_PU = 512, C_GM = 1024, C_PADA = 1040, C_F8 = 1280, C_QN = 1280, C_KN = 1792, C_VM = 2304, C_OM = 2816, C_VN = 3328;
constexpr int proj_col(int n) { return n < 512 ? n : n < 1536 ? n + 1792 : n < 1552 ? n - 512 : n < 2064 ? n - 1040 : n < 3088 ? n - 784 : n + 240; }
static_assert(proj_col(512) == C_VM && proj_col(1024) == C_OM && proj_col(1536) == C_GM && proj_col(1552) == C_PU && proj_col(2064) == C_QN && proj_col(2576) == C_KN && proj_col(3088) == C_VN && proj_col(3599) == PWA - 1, "projection column map");
constexpr int NTBL = SEQ / 128, NTBC = CTX / 128;
constexpr int ilog2(int x) { return x <= 1 ? 0 : 1 + ilog2(x >> 1); }
constexpr int LGSEQ = ilog2(SEQ), LGCTX = ilog2(CTX);
static_assert((1 << LGSEQ) == SEQ && (1 << LGCTX) == CTX, "sequence lengths must be powers of two");
constexpr int cdiv(int a, int b) { return (a + b - 1) / b; }
constexpr int RPE_L = cdiv(G * (SEQ / 8), 256) * 256, RPE_C = cdiv(NB * (CTX / 8), 256) * 256, RPE_MAX = RPE_L > RPE_C ? RPE_L : RPE_C;
constexpr int NSLOT = 16 * RPE_MAX;
constexpr int NTHREADS = 512;
constexpr int GT_MAXU = 12;
constexpr int LDS_BYTES = 131072 + 256 + GT_MAXU * 1024;
constexpr int NST_L = G * 4 * 2 * NTBL, NST_C = NB * 4 * 2 * NTBC, NST = NST_L > NST_C ? NST_L : NST_C;
constexpr int NCI = NB * 4 * 2;
constexpr float RMS_EPS = 1e-6f;

struct WsLayout { size_t bar, WinT, WbT, WoT, WguT, WdT, mod, rope, ctxs, xb, PROJc, CiC, Cin_, Cim, H, H8, PROJa, Sst, Cin, Mb, Pb, Nb, Sn, Ssc, Cn, Cm, aff, slot_token, slot_gate, token_slots, HID, YE, BG, MERGED, Y, total; };
constexpr size_t al(size_t x) { return (x + 255) / 256 * 256; }
constexpr size_t smax(size_t a, size_t b) { return a > b ? a : b; }
constexpr WsLayout make_layout() {
    WsLayout L{}; size_t o = 0;
    L.bar = o; o += al(65536);
    L.WinT = o; o += al((size_t)2 * PWT * 1024 * 2);
    L.WbT = o; o += al((size_t)2 * 3 * 1024 * 512 * 2);
    L.WoT = o; o += al((size_t)2 * 1024 * 1024 * 2);
    L.WguT = o; o += al((size_t)2 * 16 * 2048 * 1024);
    L.WdT = o; o += al((size_t)2 * 16 * 1024 * 1024);
    L.mod = o; o += al((size_t)2 * (NB + 1) * 6144 * 4);
    L.rope = o; o += al((size_t)(ROWS + 64) * 16 * 2 * 4);
    L.ctxs = o; o += al((size_t)NB * CTX * 1024 * 2);
    L.xb = o; o += al((size_t)NB * SEQ * 1024 * 2);
    L.PROJc = o; o += al((size_t)RC * PWA * 2);
    L.CiC = o; o += al((size_t)NCI * 8192 * 4);
    L.Cin_ = o; o += al((size_t)NCI * 64 * 4);
    L.Cim = o; o += al((size_t)NCI * 4 * 4);
    L.H = o; o += al((size_t)RMAX * 1024 * 2);
    L.H8 = o; o += al((size_t)RMAX * 1024);
    const size_t x0 = o;
    L.PROJa = o; o += al((size_t)RMAX * PWA * 2);
    L.Sst = o; o += al((size_t)NST * 8192 * 4);
    L.Cin = o; o += al((size_t)NST * 8192 * 2);
    const size_t hid = al((size_t)NSLOT * 1024 * 2);
    o = x0 + smax(o - x0, 2 * hid);
    L.HID = x0; L.YE = x0 + hid;
    L.Mb = o; o += al((size_t)RMAX * 512 * 2);
    L.Pb = o; o += al((size_t)RMAX * 512 * 2);
    L.Nb = o; o += al((size_t)RMAX * 512 * 2);
    L.MERGED = L.H; L.Y = L.Mb;
    L.BG = o; o += al((size_t)RMAX * NBG);
    L.Sn = o; o += al((size_t)NST * 64 * 4);
    L.Ssc = o; o += al((size_t)NST * 4 * 4);
    L.Cn = o; o += al((size_t)NST * 64 * 4);
    L.Cm = o; o += al((size_t)NST * 4 * 4);
    L.aff = o; o += al((size_t)RMAX * 16 * 4);
    L.slot_token = o; o += al((size_t)NSLOT * 4);
    L.slot_gate = o; o += al((size_t)NSLOT * 4);
    L.token_slots = o; o += al((size_t)RMAX * 16 * 4);
    L.total = o;
    return L;
}
constexpr WsLayout WSL = make_layout();
static_assert(CFG_B != 32 || WSL.total <= ((size_t)1 << 30), "workspace budget");

struct Params {
    const float *x, *c, *ctx, *c_ctx, *norm_gain, *ada_w, *ada_b, *w_in, *gate_bias, *pool_w, *pool_scale, *rpb, *w_branch, *w_out, *router_w, *w_gate, *w_up, *w_down;
    float* out;
    char* ws;
#ifdef CPU_EMU
#define WSF(T, name) __device__ __host__ __forceinline__ T* name() const { return (T*)(ws + WSL.name); }
#else
#if defined(__HIP_DEVICE_COMPILE__)
#define WSF(T, name) __device__ __host__ __forceinline__ T* name() const { char* w_ = ws; asm volatile("" : "+s"(w_)); return (T*)(__attribute__((address_space(1))) T*)(w_ + WSL.name); }
#else
#define WSF(T, name) __device__ __host__ __forceinline__ T* name() const { return (T*)(ws + WSL.name); }
#endif
#endif
    WSF(unsigned, bar) WSF(bf16_t, WinT) WSF(bf16_t, WbT) WSF(bf16_t, WoT) WSF(bf16_t, WguT) WSF(bf16_t, WdT)
    WSF(float, mod) WSF(float, rope) WSF(bf16_t, ctxs) WSF(bf16_t, xb) WSF(bf16_t, PROJc) WSF(float, CiC) WSF(float, Cin_) WSF(float, Cim)
    WSF(bf16_t, H) WSF(unsigned char, H8) WSF(bf16_t, PROJa) WSF(float, Sst) WSF(bf16_t, Cin) WSF(bf16_t, Mb) WSF(bf16_t, Pb) WSF(bf16_t, Nb)
    WSF(float, Sn) WSF(float, Ssc) WSF(float, Cn) WSF(float, Cm) WSF(float, aff) WSF(int, slot_token) WSF(float, slot_gate) WSF(int, token_slots)
    WSF(bf16_t, HID) WSF(bf16_t, YE) WSF(unsigned char, BG) WSF(bf16_t, MERGED) WSF(bf16_t, Y)
#undef WSF
};

struct SetDesc { int is_ctx, nrows, samp0, nsamp, lgseq, ntb, cap, rpe; };
DEV SetDesc make_set(int is_ctx, int grp) {
    SetDesc s;
    s.is_ctx = is_ctx;
    if (is_ctx) { s.nrows = RC; s.samp0 = 0; s.nsamp = NB; s.lgseq = LGCTX; s.ntb = NTBC; s.cap = CTX / 8; s.rpe = RPE_C; }
    else { s.nrows = RL; s.samp0 = grp * G; s.nsamp = G; s.lgseq = LGSEQ; s.ntb = NTBL; s.cap = SEQ / 8; s.rpe = RPE_L; }
    return s;
}

#ifdef CPU_EMU
#define GAS
#else
#define GAS __attribute__((address_space(1)))
#endif
template <class T> DEV T ldg(const T* p) { return *(const GAS T*)p; }
template <class T> DEV void stg(T* p, const T& v) { *(GAS T*)p = v; }
DEV float bf2f(bf16_t v) { return __uint_as_float(((unsigned)v) << 16); }
DEV bf16_t f2bf(float f) { unsigned u = __float_as_uint(f); u += 0x7FFFu + ((u >> 16) & 1u); return (bf16_t)(u >> 16); }
#if defined(__HIP_DEVICE_COMPILE__)
typedef __bf16 bf16n2 __attribute__((ext_vector_type(2)));
typedef float f32n2 __attribute__((ext_vector_type(2)));
DEV unsigned pack2(float lo, float hi) { f32n2 v = {lo, hi}; bf16n2 r = __builtin_convertvector(v, bf16n2); return __builtin_bit_cast(unsigned, r); }
#else
DEV unsigned pack2(float lo, float hi) { return (unsigned)f2bf(lo) | ((unsigned)f2bf(hi) << 16); }
#endif
DEV float lo16(unsigned u) { return __uint_as_float(u << 16); }
DEV float hi16(unsigned u) { return __uint_as_float(u & 0xFFFF0000u); }
#if defined(__HIP_DEVICE_COMPILE__)
DEV float frcp(float x) { return __builtin_amdgcn_rcpf(x); }
#else
DEV float frcp(float x) { return 1.0f / x; }
#endif
#if defined(__HIP_DEVICE_COMPILE__)
DEV float sigmoidf_(float x) { return __builtin_amdgcn_rcpf(1.0f + __expf(-x)); }
#else
DEV float sigmoidf_(float x) { return 1.0f / (1.0f + __expf(-x)); }
#endif
DEV float logsigmoidf_(float x) { return fminf(x, 0.0f) - __logf(1.0f + __expf(-fabsf(x))); }
template <int M> DEV float shx(float v) {
#if defined(__HIP_DEVICE_COMPILE__)
    const unsigned u = __builtin_bit_cast(unsigned, v);
    if constexpr (M == 1) return __builtin_bit_cast(float, __builtin_amdgcn_update_dpp(u, u, 0xB1, 0xF, 0xF, false));
    else if constexpr (M == 2) return __builtin_bit_cast(float, __builtin_amdgcn_update_dpp(u, u, 0x4E, 0xF, 0xF, false));
    else if constexpr (M == 4) { const unsigned t = __builtin_amdgcn_update_dpp(u, u, 0x141, 0xF, 0xF, false);
        return __builtin_bit_cast(float, __builtin_amdgcn_update_dpp(t, t, 0x1B, 0xF, 0xF, false)); }
    else if constexpr (M == 8) return __builtin_bit_cast(float, __builtin_amdgcn_update_dpp(u, u, 0x128, 0xF, 0xF, false));
    else if constexpr (M == 16) { const auto r = __builtin_amdgcn_permlane16_swap(u, u, false, false); return __builtin_bit_cast(float, (threadIdx.x & 16) ? r[0] : r[1]); }
    else { const auto r = __builtin_amdgcn_permlane32_swap(u, u, false, false); return __builtin_bit_cast(float, (threadIdx.x & 32) ? r[0] : r[1]); }
#else
    return __shfl_xor(v, M);
#endif
}
DEV float wave_sum(float v) { v += shx<32>(v); v += shx<16>(v); v += shx<8>(v); v += shx<4>(v); v += shx<2>(v); v += shx<1>(v); return v; }
DEV bf16x8 mk8(u32x2 lo, u32x2 hi) { u32x4 v = {lo.x, lo.y, hi.x, hi.y}; return __builtin_bit_cast(bf16x8, v); }
DEV bf16x8 mk8(u32x4 v) { return __builtin_bit_cast(bf16x8, v); }
DEV bf16x8 mk8(s16x4 lo, s16x4 hi) { return __builtin_shufflevector(lo, hi, 0, 1, 2, 3, 4, 5, 6, 7); }
DEV f32x4 mfma16(bf16x8 a, bf16x8 b, f32x4 c) { return __builtin_amdgcn_mfma_f32_16x16x32_bf16(a, b, c, 0, 0, 0); }
DEV unsigned f8enc1(float x) {
    const unsigned sgn = x < 0.f ? 0x80u : 0u; float a = x < 0.f ? -x : x; if (!(a < 448.f)) a = 448.f;
    if (a < 0.015625f) { const int q = (int)(a * 512.f + 0.5f); const float r = a * 512.f; int qq = q; if ((float)q - r == 0.5f && (q & 1)) qq = q - 1; return sgn | (unsigned)qq; }
    int e = 0; float m = a; while (m >= 2.f) { m *= 0.5f; ++e; } while (m < 1.f) { m *= 2.f; --e; }
    const float r = (m - 1.f) * 8.f; int q = (int)(r + 0.5f); if ((float)q - r == 0.5f && (q & 1)) --q;
    if (q == 8) { q = 0; ++e; }
    return sgn | (unsigned)((e + 7) << 3) | (unsigned)q;
}
#if defined(__HIP_DEVICE_COMPILE__)
DEV unsigned f8pack4(float a, float b, float c, float d) {
    a = __builtin_amdgcn_fmed3f(a, -448.f, 448.f); b = __builtin_amdgcn_fmed3f(b, -448.f, 448.f); c = __builtin_amdgcn_fmed3f(c, -448.f, 448.f); d = __builtin_amdgcn_fmed3f(d, -448.f, 448.f);
    int w = 0; w = __builtin_amdgcn_cvt_pk_fp8_f32(a, b, w, false); w = __builtin_amdgcn_cvt_pk_fp8_f32(c, d, w, true); return (unsigned)w; }
#else
DEV unsigned f8pack4(float a, float b, float c, float d) { return f8enc1(a) | (f8enc1(b) << 8) | (f8enc1(c) << 16) | (f8enc1(d) << 24); }
#endif
DEV float f8dec1(unsigned v) {
    const unsigned e = (v >> 3) & 15u, m = v & 7u; float r = e == 0 ? (float)m * (1.0f / 512.0f) : __uint_as_float(((e + 120u) << 23) | (m << 20));
    return (v & 0x80u) ? -r : r;
}
#if defined(__HIP_DEVICE_COMPILE__)
DEV f32x4 f8x4_f32(unsigned w) { const auto lo = __builtin_amdgcn_cvt_pk_f32_fp8((int)w, false), hi = __builtin_amdgcn_cvt_pk_f32_fp8((int)w, true); return (f32x4){lo[0], lo[1], hi[0], hi[1]}; }
#else
DEV f32x4 f8x4_f32(unsigned w) { return (f32x4){f8dec1(w & 255u), f8dec1((w >> 8) & 255u), f8dec1((w >> 16) & 255u), f8dec1(w >> 24)}; }
#endif
constexpr float YE_SCALE = 32.0f, YE_INV = 1.0f / 32.0f;
#ifdef CPU_EMU
DEV f32x4 mfma_f8(bf16x8 a0, bf16x8 a1, bf16x8 b0, bf16x8 b1, f32x4 c) { return emu_mfma_f8(a0, a1, b0, b1, c); }
#else
typedef int i32x4 __attribute__((ext_vector_type(4)));
typedef int i32x8 __attribute__((ext_vector_type(8)));
DEV f32x4 mfma_f8(bf16x8 a0, bf16x8 a1, bf16x8 b0, bf16x8 b1, f32x4 c) {
    const i32x8 A = __builtin_shufflevector(__builtin_bit_cast(i32x4, a0), __builtin_bit_cast(i32x4, a1), 0, 1, 2, 3, 4, 5, 6, 7);
    const i32x8 B = __builtin_shufflevector(__builtin_bit_cast(i32x4, b0), __builtin_bit_cast(i32x4, b1), 0, 1, 2, 3, 4, 5, 6, 7);
    return __builtin_amdgcn_mfma_scale_f32_16x16x128_f8f6f4(A, B, c, 0, 0, 0, 0, 0, 0);
}
#endif
constexpr float F8_WSCALE = 64.0f, F8_WINV = 1.0f / 64.0f;
DEV void store8bf(bf16_t* o, f32x4 a, f32x4 b) { u32x4 v = {pack2(a[0], a[1]), pack2(a[2], a[3]), pack2(b[0], b[1]), pack2(b[2], b[3])}; stg((u32x4*)o, v); }

#ifndef CPU_EMU
#define XB_TMO      128
#define XB_XCNT(j)  (256  + 64 * (j))
#define XB_XSUB(j)  (1280 + 64 * (j))
#define XB_XGEN(j)  (2304 + 64 * (j))
#define XB_TOP      3328
#define XB_TOPGEN   3392
#define XCD_BAR_WORDS 3456
#define XB_SPIN_CAP (1u << 18)
#define LAS __attribute__((address_space(3)))
__device__ __forceinline__ unsigned xb_ld(unsigned* p)              { return __hip_atomic_load(p, __ATOMIC_RELAXED, __HIP_MEMORY_SCOPE_AGENT); }
__device__ __forceinline__ unsigned xb_add(unsigned* p, unsigned v) { return __hip_atomic_fetch_add(p, v, __ATOMIC_RELAXED, __HIP_MEMORY_SCOPE_AGENT); }
__device__ __forceinline__ unsigned xb_xcc_id() { return (unsigned)__builtin_amdgcn_s_getreg((3 << 11) | 20) & 0xFu; }
#define XB_SPIN(cond, bar) do { unsigned _sp = 0; while (cond) { __builtin_amdgcn_s_sleep(1); \
    if ((++_sp & 255u) == 0u) { if (xb_ld(&(bar)[XB_TMO])) break; if (_sp > XB_SPIN_CAP) { atomicAdd(&(bar)[XB_TMO], 1u); break; } } } } while (0)
struct XcdBarrier { unsigned* bar; unsigned x; volatile LAS unsigned* st; };
__device__ __forceinline__ XcdBarrier xcd_barrier_post(unsigned* bar, volatile LAS unsigned* st) {
    XcdBarrier b; b.bar = bar; b.x = xb_xcc_id(); b.st = st;
    if (threadIdx.x == 0) (void)xb_add(&bar[XB_XCNT(b.x)], 1u);
    return b;
}
__device__ __forceinline__ void xcd_barrier_complete(unsigned* bar, unsigned x, unsigned& nloc, unsigned& nx) {
    const unsigned Gd = gridDim.x * gridDim.y * gridDim.z;
    unsigned sum, cnt, mine, sp = 0u;
    for (;;) {
        sum = 0u; cnt = 0u; mine = 0u;
#pragma unroll
        for (unsigned j = 0; j < 16; ++j) { const unsigned c = xb_ld(&bar[XB_XCNT(j)]); sum += c; cnt += (c > 0u) ? 1u : 0u; mine = (j == x) ? c : mine; }
        if (sum == Gd) break;
        __builtin_amdgcn_s_sleep(1);
        if ((++sp & 255u) == 0u) { if (xb_ld(&bar[XB_TMO])) break; if (sp > XB_SPIN_CAP) { atomicAdd(&bar[XB_TMO], 1u); break; } }
    }
    nloc = mine > 0u ? mine : 1u; nx = cnt > 0u ? cnt : 1u;
}
__device__ __forceinline__ void xcd_barrier(const XcdBarrier& b) {
    asm volatile("s_waitcnt vmcnt(0)" ::: "memory");
    __syncthreads();
    if (threadIdx.x == 0) {
        unsigned* bar = b.bar;
        unsigned bx = b.x; asm volatile("" : "+s"(bx));
        __builtin_amdgcn_s_waitcnt(0);
        unsigned nloc = b.st[0], nx = b.st[1];
        if (nloc == 0u) { xcd_barrier_complete(bar, bx, nloc, nx); b.st[0] = nloc; b.st[1] = nx; }
        const unsigned old = xb_add(&bar[XB_XSUB(bx)], 1u);
        const unsigned gen = old / nloc;
        if (old + 1u == (gen + 1u) * nloc) {
            __builtin_amdgcn_fence(__ATOMIC_RELEASE, "agent");
            asm volatile("s_waitcnt vmcnt(0)" ::: "memory");
            const unsigned og = xb_add(&bar[XB_TOP], 1u);
            const unsigned tg = og / nx;
            if (og + 1u == (tg + 1u) * nx) xb_add(&bar[XB_TOPGEN], 1u);
            else XB_SPIN(xb_ld(&bar[XB_TOPGEN]) == tg, bar);
            __builtin_amdgcn_fence(__ATOMIC_ACQUIRE, "agent");
            xb_add(&bar[XB_XGEN(bx)], 1u);
            asm volatile("s_waitcnt vmcnt(0)" ::: "memory");
        } else {
            XB_SPIN(xb_ld(&bar[XB_XGEN(bx)]) == gen, bar);
            __builtin_amdgcn_fence(__ATOMIC_ACQUIRE, "agent");
            asm volatile("s_waitcnt vmcnt(0)" ::: "memory");
        }
    }
    __syncthreads();
}
#endif

constexpr int BK = 64, HALF = 128, HT_BYTES = HALF * BK * 2;
DEV int lds_byte(int r, int c) { int st = (r >> 4) * 2 + (c >> 5), rr = r & 15, cc = c & 31, ob = rr * 64 + cc * 2; return st * 1024 + (ob ^ (((ob >> 9) & 1) << 5)); }
DEV void stage_rc(int b, int& Rr, int& Cc) { int st = b / 1024, sb = b % 1024, swz = sb ^ (((sb >> 9) & 1) << 5); Rr = (st >> 1) * 16 + swz / 64; Cc = (st & 1) * 32 + (swz % 64) / 2; }
DEV int perm32(int rho) { const int n = rho >> 4, i = rho & 15; return 8 * (i >> 2) + 4 * n + (i & 3); }

DEV bool tile_from_L(int L, int nM, int nN, int& pm, int& pn) {
    const int nwg = nM * nN; if (L >= nwg) return false;
    int wgid = L; { const int q = nwg / 8, r = nwg % 8, xcd = wgid % 8, off = wgid / 8; wgid = (xcd < r ? xcd * (q + 1) : r * (q + 1) + (xcd - r) * q) + off; }
    const int nig = 8 * nN, gid = wgid / nig, fm = gid * 8, gsz = (nM - fm) < 8 ? (nM - fm) : 8;
    pm = fm + ((wgid % nig) % gsz); pn = (wgid % nig) / gsz; return true;
}
DEV bool tile_order(int i, int nM, int nN, int& pm, int& pn) { return tile_from_L(i * (int)gridDim.x + (int)blockIdx.x, nM, nN, pm, pn); }
#ifdef CPU_EMU
#define GLDS16(src, dst) __builtin_amdgcn_global_load_lds((const unsigned*)(src), (unsigned*)((dst) + (TID() & 63) * 16), 16, 0, 0)
#else
#define GLDS16(src, dst) __builtin_amdgcn_global_load_lds((const unsigned*)(src), (unsigned*)(dst), 16, 0, 0)
#endif

#define BAR __builtin_amdgcn_s_barrier()
#define SCHED __builtin_amdgcn_sched_barrier(0)
struct GUnit { int pm, pn, aux; };
template <class T> struct is_void_ { static constexpr bool v = false; };
template <> struct is_void_<void> { static constexpr bool v = true; };
template <class Epi> DEV bool call_epi(const Epi& e, const GUnit& u, f32x4 (&acc)[2][2][4][2], int r0, int c0) {
    if constexpr (is_void_<decltype(e(u, acc, r0, c0))>::v) { e(u, acc, r0, c0); return false; } else return e(u, acc, r0, c0);
}
template <bool GATHER, int LDA_, int LDB_, int K_, bool F8 = false, class Sched, class Epi>
DEV void gemm_stream(char* shm, const Sched& S, const Epi& epi) {
#define SA(b, h) (shm + ((b) * 2 + (h)) * HT_BYTES)
#define SB(b, h) (shm + (4 + (b) * 2 + (h)) * HT_BYTES)
#define STG_B(P, bp) do { GLDS16((bp) + voffB, (P) + ldsb0); GLDS16((bp) + voffB + 64 * LDB_, (P) + ldsb0 + 8192); } while (0)
#define STG_A(P, ap, h, gv) do { if (GATHER) { GLDS16((ap) + gv[h][0], (P) + ldsb0); GLDS16((ap) + gv[h][1], (P) + ldsb0 + 8192); } \
    else { GLDS16((ap) + voffA + (h) * 128 * LDA_, (P) + ldsb0); GLDS16((ap) + voffA + ((h) * 128 + 64) * LDA_, (P) + ldsb0 + 8192); } } while (0)
#define LDA(dst, b, h) _Pragma("unroll") for (int m = 0; m < 4; ++m) _Pragma("unroll") for (int k = 0; k < 2; ++k) \
    dst[m][k] = *reinterpret_cast<const bf16x8*>(SA(b, h) + aoff + m * 2048 + k * 1024)
#define LDB(dst, b, h) _Pragma("unroll") for (int n = 0; n < 2; ++n) _Pragma("unroll") for (int k = 0; k < 2; ++k) \
    dst[n][k] = *reinterpret_cast<const bf16x8*>(SB(b, h) + boff + n * 2048 + k * 1024)
#define MMA(ai, bj, At_, Bx_) do { __builtin_amdgcn_s_setprio(1); \
    if constexpr (F8) { _Pragma("unroll") for (int m = 0; m < 4; ++m) _Pragma("unroll") for (int n = 0; n < 2; ++n) \
      acc[ai][bj][m][n] = mfma_f8(Bx_[n][0], Bx_[n][1], At_[m][0], At_[m][1], acc[ai][bj][m][n]); } \
    else { _Pragma("unroll") for (int m = 0; m < 4; ++m) _Pragma("unroll") for (int n = 0; n < 2; ++n) _Pragma("unroll") for (int k = 0; k < 2; ++k) \
      acc[ai][bj][m][n] = mfma16(Bx_[n][k], At_[m][k], acc[ai][bj][m][n]); } \
    __builtin_amdgcn_s_setprio(0); } while (0)
    constexpr int nt = K_ / BK;
    const int tid = TID();
    const int wid = __builtin_amdgcn_readfirstlane(tid >> 6), lane = tid & 63, wr = wid >> 2, wc = wid & 3, fr = lane & 15, fq = lane >> 4;
    const int ldsb0 = wid * 1024;
    int Rr0, Cc0; stage_rc(tid * 16, Rr0, Cc0);
    const int voffA = Rr0 * LDA_ + Cc0;
    const int voffB = ((Rr0 & ~31) + perm32(Rr0 & 31)) * LDB_ + Cc0;
    const int aoff = lds_byte(wr * 64 + fr, fq * 8), boff = lds_byte(wc * 32 + fr, fq * 8);
    GUnit cur, nxt; int ui = 0;
    if (!S.next(0, cur)) return;
    int gc[2][2] = {{0, 0}, {0, 0}};
    int* gtab = (int*)(shm + 131072 + 256);
    if (GATHER) {
        __syncthreads();
        { GUnit u; for (int i = 0; i < GT_MAXU && S.next(i, u); ++i) { if (tid < 256) gtab[i * 256 + tid] = S.grow(u, tid) * LDA_; } }
        __syncthreads();
#pragma unroll
        for (int h = 0; h < 2; ++h)
#pragma unroll
            for (int i = 0; i < 2; ++i) gc[h][i] = gtab[h * 128 + i * 64 + Rr0] + Cc0;
    }
    f32x4 acc[2][2][4][2];
#pragma unroll
    for (int a = 0; a < 2; ++a)
#pragma unroll
        for (int b = 0; b < 2; ++b)
#pragma unroll
            for (int m = 0; m < 4; ++m)
#pragma unroll
                for (int n = 0; n < 2; ++n) acc[a][b][m][n] = (f32x4){0.f, 0.f, 0.f, 0.f};
    bf16x8 At[4][2], B0[2][2], B1[2][2];
    const bf16_t* cA = S.a_base(cur); const bf16_t* cB = S.b_base(cur);
    STG_B(SB(0, 0), cB); STG_A(SA(0, 0), cA, 0, gc); STG_B(SB(0, 1), cB + 128 * LDB_); STG_A(SA(0, 1), cA, 1, gc);
    if (wr == 1) BAR;
    WAIT_V(4); BAR;
    STG_B(SB(1, 0), cB + BK); STG_A(SA(1, 0), cA + BK, 0, gc); STG_B(SB(1, 1), cB + 128 * LDB_ + BK);
    WAIT_V(6); BAR;
    for (;;) {
        const bool has_next = S.next(ui + 1, nxt);
        const bf16_t* nA = has_next ? S.a_base(nxt) : cA; const bf16_t* nB = has_next ? S.b_base(nxt) : cB;
#pragma unroll 1
        for (int t = 0; t < nt; t += 2) {
            const bool last = (t == nt - 2);
            const bf16_t* a1 = cA + (t + 1) * BK;
            const bf16_t* a2 = last ? nA : cA + (t + 2) * BK; const bf16_t* b2 = last ? nB : cB + (t + 2) * BK;
            const bf16_t* a3 = a2 + BK; const bf16_t* b3 = b2 + BK;
            LDB(B0, 0, 0); SCHED; LDA(At, 0, 0); STG_A(SA(1, 1), a1, 1, gc);
            if (GATHER && last && has_next) {
#pragma unroll
                for (int h = 0; h < 2; ++h)
#pragma unroll
                    for (int i = 0; i < 2; ++i) gc[h][i] = gtab[(ui + 1) * 256 + h * 128 + i * 64 + Rr0] + Cc0; }
            WAIT_L(8); BAR; WAIT_L(0); MMA(0, 0, At, B0); BAR; SCHED;
            LDB(B1, 0, 1); STG_B(SB(0, 0), b2);
            BAR; WAIT_L(0); MMA(0, 1, At, B1); BAR;
            LDA(At, 0, 1); STG_A(SA(0, 0), a2, 0, gc);
            BAR; WAIT_L(0); MMA(1, 0, At, B0); BAR; SCHED;
            STG_B(SB(0, 1), b2 + 128 * LDB_);
            WAIT_V(6); BAR; MMA(1, 1, At, B1); BAR;
            LDB(B0, 1, 0); SCHED; LDA(At, 1, 0); STG_A(SA(0, 1), a2, 1, gc);
            WAIT_L(8); BAR; WAIT_L(0); MMA(0, 0, At, B0); BAR; SCHED;
            LDB(B1, 1, 1); STG_B(SB(1, 0), b3);
            BAR; WAIT_L(0); MMA(0, 1, At, B1); BAR;
            LDA(At, 1, 1); STG_A(SA(1, 0), a3, 0, gc);
            BAR; WAIT_L(0); MMA(1, 0, At, B0); BAR; SCHED;
            STG_B(SB(1, 1), b3 + 128 * LDB_);
            WAIT_V(6); BAR; MMA(1, 1, At, B1); BAR;
        }
        bool keep = false;
        {
            const int tz = TID(); const int wz = tz >> 6, lz = tz & 63, wrz = wz >> 2, wcz = wz & 3, frz = lz & 15, fqz = lz >> 4;
            keep = call_epi(epi, cur, acc, wrz * 64 + frz, wcz * 32 + 8 * fqz);
        }
        if (!has_next) break;
        if (!keep) {
#pragma unroll
            for (int a = 0; a < 2; ++a)
#pragma unroll
                for (int b = 0; b < 2; ++b)
#pragma unroll
                    for (int m = 0; m < 4; ++m)
#pragma unroll
                        for (int n = 0; n < 2; ++n) acc[a][b][m][n] = (f32x4){0.f, 0.f, 0.f, 0.f};
        }
        cur = nxt; cA = nA; cB = nB; ++ui;
    }
    WAIT_V(0);
    if (wr == 0) BAR;
    BAR;
#undef SA
#undef SB
#undef STG_A
#undef STG_B
#undef LDA
#undef LDB
#undef MMA
}

constexpr int J_IN = 16 * 27, J_WB = 2 * 8 * 4, J_WO = 16 * 4, J_GU = 16 * 2 * 64, J_DN = 16 * 64, J_FOLD = 8 * 16, J_PAD = 1;
constexpr int N_MODJOBS = 2 * 96;

constexpr int J_BIG = J_IN + J_WB + J_WO + J_GU + J_DN;
struct WJob { const float* src; bf16_t* dst; int ldsrc, lddst, nvalid, k0, n0, mode, gu_which, f8; };
DEV WJob wjob_decode(const Params& p, int l, int j) {
    WJob w; w.ldsrc = 1024; w.lddst = 1024; w.nvalid = 256; w.mode = 0; w.gu_which = 0; w.f8 = 0;
    if (j < J_IN) { const int kt = j / 27, nb = j % 27; w.k0 = kt * 64; w.n0 = nb * 256; w.src = p.w_in + (size_t)l * 1024 * PWSRC; w.ldsrc = PWSRC; w.nvalid = PWSRC - w.n0; w.dst = p.WinT() + (size_t)l * PWT * 1024; w.mode = 3; }
    else if ((j -= J_IN) < J_WB) { const int bi = (j / 32) * 2, jj = j % 32, kt = jj / 4, nb = jj % 4; w.k0 = kt * 64; w.n0 = nb * 256;
        w.src = p.w_branch + ((size_t)l * 3 + bi) * 512 * 1024; w.dst = p.WbT() + ((size_t)l * 3 + bi) * 1024 * 512; w.lddst = 512; }
    else if ((j -= J_WB) < J_WO) { const int kt = j / 4, nb = j % 4; w.k0 = kt * 64; w.n0 = nb * 256; w.src = p.w_out + (size_t)l * 1024 * 1024; w.dst = p.WoT() + (size_t)l * 1024 * 1024; }
    else if ((j -= J_WO) < J_GU) { const int e = j / 128, jj = j % 128; w.gu_which = jj / 64; const int j3 = jj % 64, kt = j3 / 4, nb = j3 % 4; w.k0 = kt * 64; w.n0 = nb * 256;
        w.src = (w.gu_which ? p.w_up : p.w_gate) + ((size_t)l * 16 + e) * 1024 * 1024; w.dst = p.WguT() + ((size_t)l * 16 + e) * 2048 * 512; w.mode = 1; w.f8 = 1; }
    else { j -= J_GU; const int e = j / 64, jj = j % 64, kt = jj / 4, nb = jj % 4; w.k0 = kt * 64; w.n0 = nb * 256;
        w.src = p.w_down + ((size_t)l * 16 + e) * 1024 * 1024; w.dst = p.WdT() + ((size_t)l * 16 + e) * 1024 * 512; w.f8 = 1; }
    return w;
}
constexpr int WT_LD = 260;
DEV void wjob_load(const WJob& w, int tid, f32x4 (&vv)[8]) {
#pragma unroll
    for (int i = 0; i < 8; ++i) { const int idx = i * 512 + tid, r = idx >> 6, c = (idx & 63) * 4; int col = w.n0 + c; col = col > w.ldsrc - 4 ? w.ldsrc - 4 : col;
        vv[i] = ldg((const f32x4*)(w.src + (size_t)(w.k0 + r) * w.ldsrc + col)); }
}
DEV void wjob_finish(const WJob& w, int tid, const f32x4 (&vv)[8], float* tile) {
    __syncthreads();
#pragma unroll
    for (int i = 0; i < 8; ++i) { const int idx = i * 512 + tid, r = idx >> 6, c = (idx & 63) * 4; *(f32x4*)(tile + r * WT_LD + c) = vv[i]; }
    __syncthreads();
#pragma unroll
    for (int q = 0; q < 4; ++q) {
        const int item = q * 512 + tid, nrow = item >> 3, kc = (item & 7) * 8;
        float v[8];
#pragma unroll
        for (int jj = 0; jj < 8; ++jj) v[jj] = tile[(kc + jj) * WT_LD + nrow];
        const int n = w.n0 + nrow;
        int drow = n; bool f8 = w.f8 != 0; size_t f8base = 0;
        if (w.mode == 1) drow = (n >> 7) * 256 + w.gu_which * 128 + (n & 127);
        if (w.mode == 3) {
            if (n >= C_SPLIT) { f8 = true; f8base = (size_t)PWA * 2048; drow = n - C_SPLIT; }
            else { drow = proj_col(n); if (drow >= C_F8) { f8 = true; f8base = (size_t)C_F8 * 2048; drow -= C_F8; } } }
        if (f8) { const u32x2 o = {f8pack4(v[0] * F8_WSCALE, v[1] * F8_WSCALE, v[2] * F8_WSCALE, v[3] * F8_WSCALE), f8pack4(v[4] * F8_WSCALE, v[5] * F8_WSCALE, v[6] * F8_WSCALE, v[7] * F8_WSCALE)};
            if (nrow < w.nvalid) stg((u32x2*)((unsigned char*)w.dst + f8base + (size_t)drow * 1024 + w.k0 + kc), o); }
        else if (nrow < w.nvalid) { u32x4 o = {pack2(v[0], v[1]), pack2(v[2], v[3]), pack2(v[4], v[5]), pack2(v[6], v[7])};
            stg((u32x4*)(w.dst + (size_t)drow * w.lddst + w.k0 + kc), o); }
    }
}
DEV void pro_small_job(const Params& p, int l, int j, char* shm) {
    float* tile = (float*)shm;
    const int tid = TID();
    if (j < J_FOLD) {
        const int kt = j / 16, ntl = j % 16, k0 = kt * 64, n0 = ntl * 64; const int fg = k0 / 128;
        const float* wb1 = p.w_branch + ((size_t)l * 3 + 1) * 512 * 1024;
        const float* pw = p.pool_w + ((size_t)l * 4 + fg) * 128 * 128; const float* ps = p.pool_scale + (size_t)l * 512 + fg * 128;
        const int c = tid & 63, rq = tid >> 6;
        float accv[8];
#pragma unroll
        for (int i = 0; i < 8; ++i) accv[i] = 0.f;
        for (int d = 0; d < 128; ++d) { const float wv = ldg(wb1 + (size_t)(fg * 128 + d) * 1024 + n0 + c) * ldg(ps + d);
#pragma unroll
            for (int i = 0; i < 8; ++i) accv[i] += ldg(pw + (size_t)(k0 - fg * 128 + rq * 8 + i) * 128 + d) * wv; }
        __syncthreads();
#pragma unroll
        for (int i = 0; i < 8; ++i) tile[(rq * 8 + i) * WT_LD + c] = accv[i];
        __syncthreads();
        const int nrow = tid >> 3, kc = (tid & 7) * 8; float v[8];
#pragma unroll
        for (int jj = 0; jj < 8; ++jj) v[jj] = tile[(kc + jj) * WT_LD + nrow];
        u32x4 o = {pack2(v[0], v[1]), pack2(v[2], v[3]), pack2(v[4], v[5]), pack2(v[6], v[7])};
        stg((u32x4*)(p.WbT() + ((size_t)l * 3 + 1) * 1024 * 512 + (size_t)(n0 + nrow) * 512 + k0 + kc), o);
    } else {
        bf16_t* d0 = p.WinT() + (size_t)l * PWT * 1024 + (size_t)C_PADA * 1024;
        for (int i = tid; i < (C_F8 - C_PADA) * 1024 / 8; i += NTHREADS) stg((u32x4*)(d0 + (size_t)i * 8), (u32x4){0u, 0u, 0u, 0u});
    }
}

DEV void pro_mod_job(const Params& p, int job, char* shm) {
    float* sv = (float*)shm;
    const int tid = TID(), l = job / 96, col0 = (job % 96) * 64;
    const int c = tid & 63, kp = tid >> 6;
    float acc[NB + 1];
#pragma unroll
    for (int v = 0; v <= NB; ++v) acc[v] = 0.f;
    for (int half = 0; half < 2; ++half) {
        __syncthreads();
        for (int idx = tid; idx < (NB + 1) * 512; idx += 512) { const int v = idx >> 9, k = idx & 511;
            const float s = (v < NB) ? ldg(p.c + (size_t)v * 1024 + half * 512 + k) : ldg(p.c_ctx + half * 512 + k);
            sv[idx] = s * sigmoidf_(s); }
        __syncthreads();
        for (int kk = 0; kk < 64; ++kk) { const int k = kp * 64 + kk;
            const float w = ldg(p.ada_w + ((size_t)l * 1024 + half * 512 + k) * 6144 + col0 + c);
#pragma unroll
            for (int v = 0; v <= NB; ++v) acc[v] += sv[v * 512 + k] * w; }
    }
    __syncthreads();
    float* red = (float*)shm;
#pragma unroll
    for (int v = 0; v <= NB; ++v) red[(kp * (NB + 1) + v) * 64 + c] = acc[v];
    __syncthreads();
    for (int idx = tid; idx < (NB + 1) * 64; idx += 512) { const int v = idx >> 6, cc = idx & 63; float s = 0.f;
#pragma unroll
        for (int q = 0; q < 8; ++q) s += red[(q * (NB + 1) + v) * 64 + cc];
        stg(p.mod() + ((size_t)l * (NB + 1) + v) * 6144 + col0 + cc, s + ldg(p.ada_b + (size_t)l * 6144 + col0 + cc)); }
}

DEV void phase_prologue(const Params& p, char* shm) {
    const int tid = TID();
    const int nsmall = N_MODJOBS + 1 + 2 * (J_FOLD + J_PAD);
    for (int job = blockIdx.x; job < nsmall; job += gridDim.x) {
        if (job < N_MODJOBS) pro_mod_job(p, job, shm);
        else if (job == N_MODJOBS) {
            for (int idx = tid; idx < (ROWS + 64) * 16; idx += NTHREADS) { const int pos = idx >> 4, i = idx & 15;
                const float pv = (float)(pos < ROWS ? pos : pos - ROWS);
                const float inv = powf(10000.0f, -(float)(2 * i) / 32.0f);
                const float a = pv * inv; stg(p.rope() + idx * 2, cosf(a)); stg(p.rope() + idx * 2 + 1, sinf(a)); }
        } else { const int sj = job - N_MODJOBS - 1; pro_small_job(p, sj / (J_FOLD + J_PAD), sj % (J_FOLD + J_PAD), shm); }
    }
    float* tile = (float*)shm;
    const int nbig = 2 * J_BIG;
    int job = blockIdx.x;
    if (job >= nbig) return;
    WJob wc = wjob_decode(p, job / J_BIG, job % J_BIG), wn = wc;
    f32x4 vc[8], vn[8];
    wjob_load(wc, tid, vc);
    for (; job < nbig; job += gridDim.x) {
        const int jn = job + gridDim.x;
        if (jn < nbig) { wn = wjob_decode(p, jn / J_BIG, jn % J_BIG); wjob_load(wn, tid, vn); }
        wjob_finish(wc, tid, vc, tile);
        wc = wn;
#pragma unroll
        for (int i = 0; i < 8; ++i) vc[i] = vn[i];
    }
}

DEV const float* xin_f32(const Params& p, const SetDesc& sd) { return (sd.is_ctx ? p.ctx : p.x) + (((size_t)sd.samp0) << sd.lgseq) * 1024; }
DEV bf16_t* xbf_base(const Params& p, const SetDesc& sd) { return (sd.is_ctx ? p.ctxs() : p.xb()) + (((size_t)sd.samp0) << sd.lgseq) * 1024; }
DEV float* xout_f32(const Params& p, const SetDesc& sd) { return p.out + (((size_t)sd.samp0) << sd.lgseq) * 1024; }
template <bool BF> struct XRow;
template <> struct XRow<false> { f32x4 v[4];
    DEV void load(const void* b, size_t row, int lane) { const float* q = (const float*)b + row * 1024 + lane * 8;
#pragma unroll
        for (int i = 0; i < 4; ++i) v[i] = ldg((const f32x4*)(q + (i >> 1) * 512 + (i & 1) * 4)); }
    DEV f32x4 get(int i) const { return v[i]; } };
template <> struct XRow<true> { u32x4 v[2];
    DEV void load(const void* b, size_t row, int lane) { const bf16_t* q = (const bf16_t*)b + row * 1024 + lane * 8;
#pragma unroll
        for (int h = 0; h < 2; ++h) v[h] = ldg((const u32x4*)(q + h * 512)); }
    DEV f32x4 get(int i) const { const u32x4 m = v[i >> 1]; return (i & 1) ? (f32x4){lo16(m.z), hi16(m.z), lo16(m.w), hi16(m.w)} : (f32x4){lo16(m.x), hi16(m.x), lo16(m.y), hi16(m.y)}; } };
template <bool BF> DEV void xrow_store8(void* b, size_t row, int c0, f32x4 a, f32x4 c) {
    if constexpr (BF) store8bf((bf16_t*)b + row * 1024 + c0, a, c);
    else { float* q = (float*)b + row * 1024 + c0; stg((f32x4*)q, a); stg((f32x4*)(q + 4), c); }
}
DEV const float* mod_row(const Params& p, const SetDesc& sd, int layer, int row) {
    return p.mod() + ((size_t)layer * (NB + 1) + (sd.is_ctx ? NB : sd.samp0 + (row >> sd.lgseq))) * 6144;
}
DEV bf16_t* proj_buf(const Params& p, const SetDesc& sd) { return sd.is_ctx ? p.PROJc() : p.PROJa(); }

DEV void stage_params(float* par, const float* v0, const float* v1, const float* v2, const float* v3, const float* v4) {
    const int tid = TID();
    const float* src[5] = {v0, v1, v2, v3, v4};
#pragma unroll
    for (int k = 0; k < 5; ++k) if (src[k]) { for (int i = tid; i < 1024; i += NTHREADS) par[k * 1024 + i] = ldg(src[k] + i); }
}
template <bool SRC_BF> DEV void phase_norm1(const Params& p, const SetDesc& sd, int layer, char* shm) {
    const int tid = TID(), lane = tid & 63, wv = tid >> 6;
    const float* g0 = p.norm_gain + ((size_t)layer * 4 + 0) * 1024;
    const void* xb = SRC_BF ? (const void*)xbf_base(p, sd) : (const void*)xin_f32(p, sd);
    const int stride = 8; const int rpb_ = (sd.nrows + (int)gridDim.x - 1) / (int)gridDim.x; const int row_end = min(sd.nrows, ((int)blockIdx.x + 1) * rpb_);
    int row = (int)blockIdx.x * rpb_ + wv;
    float* par = (float*)shm;
    __syncthreads();
    { const float* mdb = mod_row(p, sd, layer, min((int)blockIdx.x * rpb_, sd.nrows - 1)); stage_params(par, g0, mdb, mdb + 1024, nullptr, nullptr); }
    __syncthreads();
    XRow<SRC_BF> curr, nxtr;
    if (row < row_end) curr.load(xb, row, lane);
    for (; row < row_end; row += stride) {
        const int rn = row + stride;
        if (rn < row_end) nxtr.load(xb, rn, lane);
        f32x4 cur[4];
#pragma unroll
        for (int i = 0; i < 4; ++i) cur[i] = curr.get(i);
        float ss = 0.f;
#pragma unroll
        for (int i = 0; i < 4; ++i)
#pragma unroll
            for (int j = 0; j < 4; ++j) ss += cur[i][j] * cur[i][j];
        ss = wave_sum(ss);
        const float rstd = rsqrtf(ss * (1.0f / 1024.0f) + RMS_EPS);
#pragma unroll
        for (int hlf = 0; hlf < 2; ++hlf) { const int c0 = hlf * 512 + lane * 8; float o[8];
#pragma unroll
            for (int j = 0; j < 8; ++j) o[j] = cur[hlf * 2 + (j >> 2)][j & 3] * rstd * par[c0 + j] * (1.0f + par[2048 + c0 + j]) + par[1024 + c0 + j];
            u32x4 ov = {pack2(o[0], o[1]), pack2(o[2], o[3]), pack2(o[4], o[5]), pack2(o[6], o[7])};
            stg((u32x4*)(p.H() + (size_t)row * 1024 + c0), ov);
            const u32x2 o8 = {f8pack4(o[0], o[1], o[2], o[3]), f8pack4(o[4], o[5], o[6], o[7])};
            stg((u32x2*)(p.H8() + (size_t)row * 1024 + c0), o8); }
        curr = nxtr;
    }
}

struct SchedPlain {
    const bf16_t* A; const bf16_t* Bt; int nM, nN, lda256, ldb256;
    DEV bool next(int i, GUnit& u) const { u.aux = 0; return tile_order(i, nM, nN, u.pm, u.pn); }
    DEV const bf16_t* a_base(const GUnit& u) const { return A + (size_t)u.pm * lda256; }
    DEV const bf16_t* b_base(const GUnit& u) const { return Bt + (size_t)u.pn * ldb256; }
    DEV int grow(const GUnit&, int) const { return 0; }
};
struct SchedPlainT : SchedPlain {
    int split_base = -1;
    DEV bool next(int i, GUnit& u) const { u.aux = 0; const int G_ = (int)gridDim.x, b = (int)blockIdx.x; int L = i * G_ + b;
        if (split_base >= 0 && i >= split_base) { if (b < G_ / 2 || i >= split_base + 2) return false; L = split_base * G_ + (i - split_base) * (G_ / 2) + (b - G_ / 2); }
        return tile_from_L(L, nM, nN, u.pm, u.pn); }
    DEV const bf16_t* a_base(const GUnit&) const { return A; }
    DEV int grow(const GUnit& u, int i) const { return u.pm * 256 + i; }
};
struct SchedProjF8 : SchedPlainT {
    const bf16_t* Bt2; int na8;
    DEV const bf16_t* b_base(const GUnit& u) const { return u.pn < na8 ? Bt + (size_t)u.pn * ldb256 : Bt2 + (size_t)(u.pn - na8) * ldb256; }
};
DEV unsigned gate4u8(f32x4 v) {
    unsigned w = 0;
#pragma unroll
    for (int j = 0; j < 4; ++j) w |= (unsigned)fmaxf(sigmoidf_(v[j] * F8_WINV) * 255.0f + 0.5f, 1.0f) << (8 * j);
    return w;
}
DEV float u8f(unsigned w, int j) { return (float)((w >> (8 * j)) & 0xFFu); }
DEV void phase_proj_a(const Params& p, const SetDesc& sd, int layer, char* shm) {
    bf16_t* pb = proj_buf(p, sd);
    {
        SchedPlain S; S.A = p.H(); S.Bt = p.WinT() + (size_t)layer * PWT * 1024; S.nM = sd.nrows / 256; S.nN = C_F8 / 256; S.lda256 = 256 * 1024; S.ldb256 = 256 * 1024;
        gemm_stream<false, 1024, 1024, 1024>(shm, S, [=](const GUnit& u, const f32x4 (&acc)[2][2][4][2], int r0, int c0) {
#pragma unroll
            for (int ai = 0; ai < 2; ++ai)
#pragma unroll
                for (int m = 0; m < 4; ++m) { bf16_t* o = pb + ((size_t)u.pm * 256 + r0 + ai * 128 + m * 16) * PWA + u.pn * 256 + c0;
                    if (u.pn * 256 + c0 < C_PADA) store8bf(o, acc[ai][0][m][0], acc[ai][0][m][1]);
                    if (u.pn * 256 + 128 < C_PADA) store8bf(o + 128, acc[ai][1][m][0], acc[ai][1][m][1]); } });
    }
    {
        constexpr int NA8 = (PWA - C_F8) / 256;
        SchedProjF8 S; S.A = (const bf16_t*)p.H8(); S.Bt = p.WinT() + (size_t)layer * PWT * 1024 + (size_t)C_F8 * 1024; S.Bt2 = p.WinT() + (size_t)layer * PWT * 1024 + (size_t)PWA * 1024; S.na8 = NA8;
        S.nM = sd.nrows / 256; S.nN = NA8 + NBG / 256; S.lda256 = 256 * 512; S.ldb256 = 256 * 512;
        { const int G_ = (int)gridDim.x, T1 = S.nM * (C_F8 / 256), T2 = S.nM * S.nN; if ((G_ & 1) == 0 && (T1 % G_) * 2 == G_ && T2 % G_ == 0 && T2 / G_ >= 1) S.split_base = T2 / G_ - 1; }
        unsigned char* bg = p.BG();
        gemm_stream<true, 512, 512, 512, true>(shm, S, [=](const GUnit& u, const f32x4 (&acc)[2][2][4][2], int r0, int c0) {
            if (u.pn < NA8) {
#pragma unroll
                for (int ai = 0; ai < 2; ++ai)
#pragma unroll
                    for (int m = 0; m < 4; ++m) { bf16_t* o = pb + ((size_t)u.pm * 256 + r0 + ai * 128 + m * 16) * PWA + C_F8 + u.pn * 256 + c0;
                        store8bf(o, acc[ai][0][m][0] * F8_WINV, acc[ai][0][m][1] * F8_WINV); store8bf(o + 128, acc[ai][1][m][0] * F8_WINV, acc[ai][1][m][1] * F8_WINV); }
            } else {
#pragma unroll
                for (int ai = 0; ai < 2; ++ai)
#pragma unroll
                    for (int m = 0; m < 4; ++m) { unsigned char* o = bg + ((size_t)u.pm * 256 + r0 + ai * 128 + m * 16) * NBG + (u.pn - NA8) * 256 + c0;
#pragma unroll
                        for (int hf = 0; hf < 2; ++hf) { const u32x2 gv = {gate4u8(acc[ai][hf][m][0]), gate4u8(acc[ai][hf][m][1])}; stg((u32x2*)(o + hf * 128), gv); } }
            } });
    }
}
DEV f32x4 sig4(f32x4 v) { f32x4 r; r[0] = sigmoidf_(v[0]); r[1] = sigmoidf_(v[1]); r[2] = sigmoidf_(v[2]); r[3] = sigmoidf_(v[3]); return r; }
DEV void gate_scan(const bf16_t* prow, int h, const float* gbias, float* ga, float* gb, float* gpm, float* gtot, float* tmp) {
    const int tid = TID(), lane = tid & 63, w = tid >> 6;
    float b = 0.f, a = 0.f, pm = 0.f; int d = 0, tok = 0;
    if (tid < 256) {
        d = tid >> 7; const int i = tid & 127; tok = d ? 127 - i : i;
        const float gi = bf2f(ldg(prow + (size_t)tok * PWA + C_GM + (2 * d) * 4 + h)) + ldg(gbias + (2 * d) * 4 + h);
        const float gf = bf2f(ldg(prow + (size_t)tok * PWA + C_GM + (2 * d + 1) * 4 + h)) + ldg(gbias + (2 * d + 1) * 4 + h);
        b = logsigmoidf_(gf);
#pragma unroll
        for (int o = 1; o < 64; o <<= 1) { const float t = __shfl_up(b, o); if (lane >= o) b += t; }
        if (lane == 63) tmp[w] = b;
        a = gi;
    }
    __syncthreads();
    if (tid < 256) {
        if (w & 1) b += tmp[w - 1];
        a -= b; pm = a;
#pragma unroll
        for (int o = 1; o < 64; o <<= 1) { const float t = __shfl_up(pm, o); if (lane >= o) pm = fmaxf(pm, t); }
        if (lane == 63) tmp[8 + w] = pm;
    }
    __syncthreads();
    if (tid < 256) {
        if (w & 1) pm = fmaxf(pm, tmp[8 + w - 1]);
        ga[d * 128 + tok] = a; gb[d * 128 + tok] = b; gpm[d * 128 + tok] = pm;
        if ((tid & 127) == 127) { gtot[d * 2] = b; gtot[d * 2 + 1] = pm; }
    }
    __syncthreads();
}

struct RopeRaw { u32x4 m, q; f32x4 rt[4]; };
DEV void rope_issue(RopeRaw& r, const bf16_t* hp, int cidx, bool latent, int tl, const float* rope) {
    r.m = ldg((const u32x4*)(hp + cidx * 8));
    if (latent) {
        r.q = ldg((const u32x4*)(hp + (cidx ^ 2) * 8));
        const int pos = (cidx < 4) ? (tl >> 6) : (ROWS + (tl & 63));
        const float* tb = rope + ((size_t)pos * 16 + (cidx & 1) * 8) * 2;
#pragma unroll
        for (int i = 0; i < 4; ++i) r.rt[i] = ldg((const f32x4*)(tb + i * 4));
    }
}
DEV void rope_apply(const RopeRaw& r, int cidx, bool latent, float scale, float* o) {
    const u32x4 m = r.m;
    float x[8] = {lo16(m.x), hi16(m.x), lo16(m.y), hi16(m.y), lo16(m.z), hi16(m.z), lo16(m.w), hi16(m.w)};
    if (latent) {
        const u32x4 q = r.q;
        const float y[8] = {lo16(q.x), hi16(q.x), lo16(q.y), hi16(q.y), lo16(q.z), hi16(q.z), lo16(q.w), hi16(q.w)};
        const bool first = (cidx & 2) == 0;
#pragma unroll
        for (int j = 0; j < 8; ++j) { const float cs = r.rt[j >> 1][(j & 1) * 2], sn = r.rt[j >> 1][(j & 1) * 2 + 1];
            x[j] = first ? (x[j] * cs - y[j] * sn) : (x[j] * cs + y[j] * sn); }
    }
#pragma unroll
    for (int j = 0; j < 8; ++j) o[j] = x[j] * scale;
}

DEV int st_index(const SetDesc& sd, int sl, int h, int dir, int tb) { return ((sl * 4 + h) * 2 + dir) * sd.ntb + tb; }

constexpr int V_LD = 144, K_LD = 72, KS_LD = 80;
DEV void mlstm_stepA_task(const Params& p, const SetDesc& sd, int layer, int task, char* shm) {
    const int tid = TID(), lane = tid & 63, w = tid >> 6, fr = lane & 15, fq = lane >> 4, tq4 = (lane & 15) >> 2, tp4 = lane & 3;
    const int tb = task % sd.ntb, h = (task / sd.ntb) & 3, sl = task / (sd.ntb * 4);
    const int row0 = (sl << sd.lgseq) + tb * 128; const bool latent = !sd.is_ctx; const int tl0 = tb * 128;
    bf16_t* Vs = (bf16_t*)shm;
    bf16_t* Ksc = (bf16_t*)(shm + 128 * V_LD * 2);
    float* ga = (float*)(shm + 128 * V_LD * 2 + 2 * 128 * KS_LD * 2); float* gb = ga + 256; float* gpm = gb + 256; float* gtot = gpm + 256; float* tmp = gtot + 8;
    const bf16_t* prow = proj_buf(p, sd) + (size_t)row0 * PWA;
    RopeRaw rk1, rk2; u32x4 vreg[4];
    { const int s = tid & 127, cpi = tid >> 7, cp = (cpi & 1) + (cpi >> 1) * 4; const bf16_t* hp = prow + (size_t)s * PWA + C_KM + h * 64;
      rope_issue(rk1, hp, cp, latent, tl0 + s, p.rope()); rope_issue(rk2, hp, cp + 2, latent, tl0 + s, p.rope()); }
#pragma unroll
    for (int it = 0; it < 4; ++it) { const int item = tid + it * 512, s = item >> 4, ch = item & 15; vreg[it] = ldg((const u32x4*)(prow + (size_t)s * PWA + C_VM + h * 128 + ch * 8)); }
    __syncthreads();
    gate_scan(prow, h, p.gate_bias + (size_t)layer * 16, ga, gb, gpm, gtot, tmp);
    {
        const int s = tid & 127, cpi = tid >> 7, cp = (cpi & 1) + (cpi >> 1) * 4;
        float k1[8], k2[8];
        rope_apply(rk1, cp, latent, 1.0f, k1);
        rope_apply(rk2, cp + 2, latent, 1.0f, k2);
#pragma unroll
        for (int dir = 0; dir < 2; ++dir) { const float ws = __expf(ga[dir * 128 + s] - gtot[dir * 2 + 1]);
            u32x4 o1 = {pack2(k1[0] * ws, k1[1] * ws), pack2(k1[2] * ws, k1[3] * ws), pack2(k1[4] * ws, k1[5] * ws), pack2(k1[6] * ws, k1[7] * ws)};
            u32x4 o2 = {pack2(k2[0] * ws, k2[1] * ws), pack2(k2[2] * ws, k2[3] * ws), pack2(k2[4] * ws, k2[5] * ws), pack2(k2[6] * ws, k2[7] * ws)};
            *(u32x4*)(Ksc + (dir * 128 + s) * KS_LD + cp * 8) = o1; *(u32x4*)(Ksc + (dir * 128 + s) * KS_LD + (cp + 2) * 8) = o2; }
    }
#pragma unroll
    for (int it = 0; it < 4; ++it) { const int item = tid + it * 512, s = item >> 4, ch = item & 15; *(u32x4*)(Vs + s * V_LD + ch * 8) = vreg[it]; }
    __syncthreads();
    f32x4 acc[2][4];
#pragma unroll
    for (int dir = 0; dir < 2; ++dir)
#pragma unroll
        for (int n = 0; n < 4; ++n) acc[dir][n] = (f32x4){0.f, 0.f, 0.f, 0.f};
#pragma unroll
    for (int ks = 0; ks < 4; ++ks) {
        const bf16_t* vp = Vs + (32 * ks + 4 * fq + tq4) * V_LD + w * 16 + 4 * tp4;
        const bf16x8 af = mk8(TR16(vp), TR16(vp + 16 * V_LD));
#pragma unroll
        for (int dir = 0; dir < 2; ++dir)
#pragma unroll
            for (int n = 0; n < 4; ++n) { const bf16_t* kp = Ksc + (dir * 128 + 32 * ks + 4 * fq + tq4) * KS_LD + n * 16 + 4 * tp4;
                const bf16x8 bfv = mk8(TR16(kp), TR16(kp + 16 * KS_LD));
                acc[dir][n] = mfma16(bfv, af, acc[dir][n]); }
    }
#pragma unroll
    for (int dir = 0; dir < 2; ++dir) { float* So = p.Sst() + (size_t)st_index(sd, sl, h, dir, tb) * 8192;
#pragma unroll
        for (int n = 0; n < 4; ++n) stg((f32x4*)(So + (w * 16 + fr) * 64 + n * 16 + fq * 4), acc[dir][n]); }
    if (tid < 128) { const int dir = tid >> 6, dd = tid & 63; float sm = 0.f;
        for (int i = 0; i < 128; ++i) sm += bf2f(Ksc[(dir * 128 + i) * KS_LD + dd]);
        stg(p.Sn() + (size_t)st_index(sd, sl, h, dir, tb) * 64 + dd, sm); }
    if (tid < 2) { float* sc = p.Ssc() + (size_t)st_index(sd, sl, h, tid, tb) * 4; stg(sc, gtot[tid * 2]); stg(sc + 1, gtot[tid * 2] + gtot[tid * 2 + 1]); }
}

template <int GI> DEV void pool_group(const Params& p, const SetDesc& sd, const bf16_t* pb) {
    constexpr int W = 2 << GI;
    const int nitems = sd.nrows * 16; const int T = 1 << sd.lgseq;
    for (int item = blockIdx.x * NTHREADS + TID(); item < nitems; item += gridDim.x * NTHREADS) {
        const int row = item >> 4, ch = GI * 128 + (item & 15) * 8;
        const int tt = row & (T - 1);
        u32x4 mv[W]; int cnt = 0; bool okv[W];
#pragma unroll
        for (int q = 0; q < W; ++q) { const int t2 = tt - W / 2 + q; const bool ok = (t2 >= 0) && (t2 < T); cnt += ok ? 1 : 0; okv[q] = ok;
            mv[q] = ldg((const u32x4*)(pb + (size_t)(ok ? (row - W / 2 + q) : row) * PWA + C_PU + ch)); }
        float s[8];
#pragma unroll
        for (int j = 0; j < 8; ++j) s[j] = 0.f;
#pragma unroll
        for (int q = 0; q < W; ++q) { u32x4 m = mv[q]; if (!okv[q]) m = (u32x4){0u, 0u, 0u, 0u};
            s[0] += lo16(m.x); s[1] += hi16(m.x); s[2] += lo16(m.y); s[3] += hi16(m.y); s[4] += lo16(m.z); s[5] += hi16(m.z); s[6] += lo16(m.w); s[7] += hi16(m.w); }
        const float inv = frcp((float)cnt);
        const u32x4 m = mv[W / 2];
        const float u[8] = {lo16(m.x), hi16(m.x), lo16(m.y), hi16(m.y), lo16(m.z), hi16(m.z), lo16(m.w), hi16(m.w)};
        u32x4 o = {pack2(s[0] * inv - u[0], s[1] * inv - u[1]), pack2(s[2] * inv - u[2], s[3] * inv - u[3]), pack2(s[4] * inv - u[4], s[5] * inv - u[5]), pack2(s[6] * inv - u[6], s[7] * inv - u[7])};
        stg((u32x4*)(p.Pb() + (size_t)row * 512 + ch), o);
    }
}
DEV void phase_pool(const Params& p, const SetDesc& sd) {
    const bf16_t* pb = proj_buf(p, sd);
    pool_group<0>(p, sd, pb); pool_group<1>(p, sd, pb); pool_group<2>(p, sd, pb); pool_group<3>(p, sd, pb);
}

template <int NC> DEV void mlstm_stepB_run(const Params& p, const SetDesc& sd, int task) {
    const int tid = TID();
    const int q = task & 3, dir = (task >> 2) & 1, h = (task >> 3) & 3, sl = task >> 5;
    const int ci = ((sd.samp0 + sl) * 4 + h) * 2 + dir;
    const int eoff = q * 2048 + tid * 4;
    float zr = 0.f; HIDE(zr);
    f32x4 C = {zr, zr, zr, zr}; float nv = 0.f; float m = -1e30f;
    f32x4 Sv[NC]; float blv[NC], mlv[NC], snv[NC];
#pragma unroll
    for (int c = 0; c < NC; ++c) { const int tb = dir ? NC - 1 - c : c; const size_t si = st_index(sd, sl, h, dir, tb);
        Sv[c] = ldg((const f32x4*)(p.Sst() + si * 8192 + eoff)); blv[c] = ldg(p.Ssc() + si * 4); mlv[c] = ldg(p.Ssc() + si * 4 + 1);
        snv[c] = (q == 0 && tid < 64) ? ldg(p.Sn() + si * 64 + tid) : 0.f; }
    if (!sd.is_ctx) { C = ldg((const f32x4*)(p.CiC() + (size_t)ci * 8192 + eoff)); if (q == 0 && tid < 64) nv = ldg(p.Cin_() + (size_t)ci * 64 + tid); m = ldg(p.Cim() + (size_t)ci * 4); }
#pragma unroll
    for (int c = 0; c < NC; ++c) {
        const int tb = dir ? NC - 1 - c : c; const size_t si = st_index(sd, sl, h, dir, tb);
        u32x2 o = {pack2(C[0], C[1]), pack2(C[2], C[3])};
        stg((u32x2*)(p.Cin() + si * 8192 + eoff), o);
        if (q == 0 && tid < 64) stg(p.Cn() + si * 64 + tid, nv);
        if (q == 0 && tid == 0) stg(p.Cm() + si * 4, m);
        const float mn = fmaxf(blv[c] + m, mlv[c]);
        const float dc = __expf(blv[c] + m - mn), wsn = __expf(mlv[c] - mn);
        C = C * dc + Sv[c] * wsn;
        nv = nv * dc + snv[c] * wsn;
        m = mn;
    }
    if (sd.is_ctx) { stg((f32x4*)(p.CiC() + (size_t)ci * 8192 + eoff), C); if (q == 0 && tid < 64) stg(p.Cin_() + (size_t)ci * 64 + tid, nv); if (q == 0 && tid == 0) stg(p.Cim() + (size_t)ci * 4, m); }
}
DEV void mlstm_stepB_task(const Params& p, const SetDesc& sd, int task) {
    if (sd.is_ctx) mlstm_stepB_run<NTBC>(p, sd, task); else mlstm_stepB_run<NTBL>(p, sd, task);
}

constexpr int NA_KLD = 136, NA_VLD = 144;
DEV void na_task(const Params& p, const SetDesc& sd, int layer, int sl, int rq2  , int hp, char* shm) {
    const int tid = TID(), lane = tid & 63, w = tid >> 6, tq = lane & 15, fq = lane >> 4, tq4 = (lane & 15) >> 2, tp4 = lane & 3;
    const int hh = w >> 2, g = w & 3, head = hp * 2 + hh;
    const bool ctxq = sd.is_ctx;
    bf16_t* Ks = (bf16_t*)shm;
    bf16_t* Vs = (bf16_t*)(shm + 128 * NA_KLD * 2);
    float* rpbs = (float*)(shm + 128 * NA_KLD * 2 + 128 * NA_VLD * 2);
    const int sample = sd.samp0 + sl;
    const bf16_t* pq = proj_buf(p, sd) + ((size_t)sl << sd.lgseq) * PWA;
    const bf16_t* pc = p.PROJc() + (size_t)sample * CTX * PWA;
    const int qcol = g * 16 + tq;
    int rqv[2], rsv[2], qtok[2];
#pragma unroll
    for (int u = 0; u < 2; ++u) { rqv[u] = 2 * rq2 + u; qtok[u] = rqv[u] * 64 + qcol; int r_ = rqv[u] - 4; rsv[u] = r_ < 0 ? 0 : (r_ > ROWS - 8 ? ROWS - 8 : r_); }
    const int nloc = ctxq ? 0 : (rsv[1] + 8 - rsv[0]);
    const int nstage = nloc + CTX / 64;
    __syncthreads();
    if (!ctxq) for (int i = tid; i < 2 * 465; i += NTHREADS) rpbs[i] = ldg(p.rpb + ((size_t)layer * 8 + hp * 2 + i / 465) * 465 + i % 465);
    bf16x8 qf[2][2];
#pragma unroll
    for (int u = 0; u < 2; ++u)
#pragma unroll
        for (int ks = 0; ks < 2; ++ks) qf[u][ks] = mk8(ldg((const u32x4*)(pq + (size_t)qtok[u] * PWA + C_QN + head * 64 + ks * 32 + fq * 8)));
    float m_run[2] = {-1e30f, -1e30f}, l_run[2] = {0.f, 0.f};
    f32x4 acc[2][4];
#pragma unroll
    for (int u = 0; u < 2; ++u)
#pragma unroll
        for (int mt = 0; mt < 4; ++mt) acc[u][mt] = (f32x4){0.f, 0.f, 0.f, 0.f};
    int cs = qcol - 8; cs = cs < 0 ? 0 : (cs > 48 ? 48 : cs);
    const int kc0 = (g == 0) ? 0 : (g == 1) ? 8 : (g == 2) ? 24 : 32;
    const int npair = (nstage + 1) >> 1;
    u32x4 kreg[4], vreg[4];
#define NA_SRC_ROWS(stg) (((stg) < nloc) ? (pq + (size_t)((rsv[0] + (stg)) * 64) * PWA) : (pc + (size_t)((((stg) < nstage ? (stg) : nstage - 1) - nloc) * 64) * PWA))
#define NA_FETCH(sp_) do { _Pragma("unroll") for (int it = 0; it < 4; ++it) { const int item = tid + it * 512, key2 = item >> 4, ch = item & 15; \
        const bf16_t* kb_ = NA_SRC_ROWS(2 * (sp_) + (key2 >> 6)); const bf16_t* src = kb_ + (size_t)(key2 & 63) * PWA + hp * 128 + ch * 8; \
        kreg[it] = ldg((const u32x4*)(src + C_KN)); vreg[it] = ldg((const u32x4*)(src + C_VN)); } } while (0)
    NA_FETCH(0);
    for (int sp = 0; sp < npair; ++sp) {
        __syncthreads();
#pragma unroll
        for (int it = 0; it < 4; ++it) { const int item = tid + it * 512, key2 = item >> 4, ch = item & 15;
            *(u32x4*)(Ks + key2 * NA_KLD + ch * 8) = kreg[it]; *(u32x4*)(Vs + key2 * NA_VLD + ch * 8) = vreg[it]; }
        if (sp + 1 < npair) NA_FETCH(sp + 1);
        __syncthreads();
#pragma unroll
        for (int sub = 0; sub < 2; ++sub) {
        const int st = 2 * sp + sub;
        if (st >= nstage) continue;
        const bool local = st < nloc;
        const bf16_t* Ksb = Ks + sub * 64 * NA_KLD; const bf16_t* Vsb = Vs + sub * 64 * NA_VLD;
        if (local) {
            const int kr = rsv[0] + st;
            f32x4 sa[2][2];
#pragma unroll
            for (int kt = 0; kt < 2; ++kt) { sa[0][kt] = (f32x4){0.f, 0.f, 0.f, 0.f}; sa[1][kt] = (f32x4){0.f, 0.f, 0.f, 0.f};
#pragma unroll
                for (int ks = 0; ks < 2; ++ks) { const bf16x8 kf = *(const bf16x8*)(Ksb + (kc0 + kt * 16 + tq) * NA_KLD + hh * 64 + ks * 32 + fq * 8);
                    sa[0][kt] = mfma16(kf, qf[0][ks], sa[0][kt]); sa[1][kt] = mfma16(kf, qf[1][ks], sa[1][kt]); } }
            float alpha[2]; bf16x8 pf[2];
#pragma unroll
            for (int u = 0; u < 2; ++u) {
                const bool act = (kr >= rsv[u]) && (kr < rsv[u] + 8);
                if (!act) { alpha[u] = 1.0f; pf[u] = mk8((u32x4){0u, 0u, 0u, 0u}); continue; }
                const int dr = kr - rqv[u] + 7;
                float sc[8]; float mx = -1e30f; float bs[8];
#pragma unroll
                for (int kt = 0; kt < 2; ++kt)
#pragma unroll
                    for (int r = 0; r < 4; ++r) { const int kcol = kc0 + kt * 16 + fq * 4 + r; int dc = kcol - qcol + 15; dc = dc < 0 ? 0 : (dc > 30 ? 30 : dc);
                        bs[kt * 4 + r] = rpbs[hh * 465 + dr * 31 + dc]; }
#ifndef CPU_EMU
                asm volatile("" : "+v"(bs[0]), "+v"(bs[1]), "+v"(bs[2]), "+v"(bs[3]), "+v"(bs[4]), "+v"(bs[5]), "+v"(bs[6]), "+v"(bs[7]));
#endif
#pragma unroll
                for (int kt = 0; kt < 2; ++kt)
#pragma unroll
                    for (int r = 0; r < 4; ++r) { const int kcol = kc0 + kt * 16 + fq * 4 + r; const bool valid = (kcol >= cs) && (kcol < cs + 16);
                        const float v = valid ? (sa[u][kt][r] * 0.125f + bs[kt * 4 + r]) : -1e30f; sc[kt * 4 + r] = v; mx = fmaxf(mx, v); }
                mx = fmaxf(mx, shx<16>(mx)); mx = fmaxf(mx, shx<32>(mx));
                const float mn = fmaxf(m_run[u], mx); alpha[u] = __expf(m_run[u] - mn); m_run[u] = mn;
                float ps = 0.f; float pv[8];
#pragma unroll
                for (int j = 0; j < 8; ++j) { pv[j] = __expf(sc[j] - mn); ps += pv[j]; }
                ps += shx<16>(ps); ps += shx<32>(ps);
                l_run[u] = l_run[u] * alpha[u] + ps;
                u32x4 pk = {pack2(pv[0], pv[1]), pack2(pv[2], pv[3]), pack2(pv[4], pv[5]), pack2(pv[6], pv[7])};
                pf[u] = mk8(pk);
            }
#pragma unroll
            for (int mt = 0; mt < 4; ++mt) {
                const bf16_t* vp = Vsb + (kc0 + 4 * fq + tq4) * NA_VLD + hh * 64 + mt * 16 + 4 * tp4;
                const bf16x8 vf = mk8(TR16(vp), TR16(vp + 16 * NA_VLD));
                acc[0][mt] = mfma16(vf, pf[0], acc[0][mt] * alpha[0]); acc[1][mt] = mfma16(vf, pf[1], acc[1][mt] * alpha[1]); }
        } else {
            f32x4 sa[2][4];
#pragma unroll
            for (int kt = 0; kt < 4; ++kt) { sa[0][kt] = (f32x4){0.f, 0.f, 0.f, 0.f}; sa[1][kt] = (f32x4){0.f, 0.f, 0.f, 0.f};
#pragma unroll
                for (int ks = 0; ks < 2; ++ks) { const bf16x8 kf = *(const bf16x8*)(Ksb + (kt * 16 + tq) * NA_KLD + hh * 64 + ks * 32 + fq * 8);
                    sa[0][kt] = mfma16(kf, qf[0][ks], sa[0][kt]); sa[1][kt] = mfma16(kf, qf[1][ks], sa[1][kt]); } }
            float alpha[2]; bf16x8 pf[2][2];
#pragma unroll
            for (int u = 0; u < 2; ++u) {
                float mx = -1e30f;
#pragma unroll
                for (int kt = 0; kt < 4; ++kt)
#pragma unroll
                    for (int r = 0; r < 4; ++r) { sa[u][kt][r] *= 0.125f; mx = fmaxf(mx, sa[u][kt][r]); }
                mx = fmaxf(mx, shx<16>(mx)); mx = fmaxf(mx, shx<32>(mx));
                const float mn = fmaxf(m_run[u], mx); alpha[u] = __expf(m_run[u] - mn); m_run[u] = mn;
                float ps = 0.f;
#pragma unroll
                for (int kt = 0; kt < 4; ++kt)
#pragma unroll
                    for (int r = 0; r < 4; ++r) { sa[u][kt][r] = __expf(sa[u][kt][r] - mn); ps += sa[u][kt][r]; }
                ps += shx<16>(ps); ps += shx<32>(ps);
                l_run[u] = l_run[u] * alpha[u] + ps;
#pragma unroll
                for (int h2 = 0; h2 < 2; ++h2) {
                    u32x4 pk = {pack2(sa[u][2 * h2][0], sa[u][2 * h2][1]), pack2(sa[u][2 * h2][2], sa[u][2 * h2][3]), pack2(sa[u][2 * h2 + 1][0], sa[u][2 * h2 + 1][1]), pack2(sa[u][2 * h2 + 1][2], sa[u][2 * h2 + 1][3])};
                    pf[u][h2] = mk8(pk); }
            }
#pragma unroll
            for (int mt = 0; mt < 4; ++mt) { acc[0][mt] = acc[0][mt] * alpha[0]; acc[1][mt] = acc[1][mt] * alpha[1]; }
#pragma unroll
            for (int h2 = 0; h2 < 2; ++h2)
#pragma unroll
                for (int mt = 0; mt < 4; ++mt) { const bf16_t* vp = Vsb + (32 * h2 + 4 * fq + tq4) * NA_VLD + hh * 64 + mt * 16 + 4 * tp4;
                    const bf16x8 vf = mk8(TR16(vp), TR16(vp + 16 * NA_VLD));
                    acc[0][mt] = mfma16(vf, pf[0][h2], acc[0][mt]); acc[1][mt] = mfma16(vf, pf[1][h2], acc[1][mt]); }
        }
        }
    }
#undef NA_FETCH
#undef NA_SRC_ROWS
#pragma unroll
    for (int u = 0; u < 2; ++u) {
        const float il = frcp(l_run[u]);
        const size_t orow = ((size_t)sl << sd.lgseq) + qtok[u];
#pragma unroll
        for (int mt = 0; mt < 4; ++mt) { u32x2 o = {pack2(acc[u][mt][0] * il, acc[u][mt][1] * il), pack2(acc[u][mt][2] * il, acc[u][mt][3] * il)};
            stg((u32x2*)(p.Nb() + orow * 512 + head * 64 + mt * 16 + fq * 4), o); }
    }
}

DEV void mlstm_stepC_task(const Params& p, const SetDesc& sd, int layer, int task, char* shm) {
    const int tid = TID(), lane = tid & 63, w = tid >> 6, tq = lane & 15, fq = lane >> 4, tq4 = (lane & 15) >> 2, tp4 = lane & 3;
    const int tb = task % sd.ntb, h = (task / sd.ntb) & 3, sl = task / (sd.ntb * 4);
    const int row0 = (sl << sd.lgseq) + tb * 128; const bool latent = !sd.is_ctx; const int tl0 = tb * 128;
    bf16_t* Ks = (bf16_t*)shm;
    bf16_t* Vs = (bf16_t*)(shm + 128 * K_LD * 2);
    bf16_t* Cs = (bf16_t*)(shm + 128 * K_LD * 2 + 128 * V_LD * 2);
    float* ga = (float*)(shm + 128 * K_LD * 2 * 3 + 128 * V_LD * 2); float* gb = ga + 256; float* gpm = gb + 256; float* gtot = gpm + 256; float* tmp = gtot + 8;
    float* nvs = tmp + 16;
    float* cms = nvs + 128;
    const bf16_t* prow = proj_buf(p, sd) + (size_t)row0 * PWA;
    RopeRaw rk1, rk2, rq[2]; u32x4 vreg[4], creg[4];
    { const int s = tid & 127, cpi = tid >> 7, cp = (cpi & 1) + (cpi >> 1) * 4; const bf16_t* hp = prow + (size_t)s * PWA + C_KM + h * 64;
      rope_issue(rk1, hp, cp, latent, tl0 + s, p.rope()); rope_issue(rk2, hp, cp + 2, latent, tl0 + s, p.rope()); }
    { const int t_ = w * 16 + tq; const bf16_t* hp = prow + (size_t)t_ * PWA + C_QM + h * 64;
#pragma unroll
      for (int ks = 0; ks < 2; ++ks) rope_issue(rq[ks], hp, ks * 4 + fq, latent, tl0 + t_, p.rope()); }
#pragma unroll
    for (int it = 0; it < 4; ++it) { const int item = tid + it * 512, s = item >> 4, ch = item & 15; vreg[it] = ldg((const u32x4*)(prow + (size_t)s * PWA + C_VM + h * 128 + ch * 8)); }
#pragma unroll
    for (int it = 0; it < 4; ++it) { const int item = tid + it * 512, dir = item >> 10, rem = item & 1023, v = rem >> 3, ch = rem & 7;
        creg[it] = ldg((const u32x4*)(p.Cin() + (size_t)st_index(sd, sl, h, dir, tb) * 8192 + v * 64 + ch * 8)); }
    __syncthreads();
    gate_scan(prow, h, p.gate_bias + (size_t)layer * 16, ga, gb, gpm, gtot, tmp);
    {
        const int s = tid & 127, cpi = tid >> 7, cp = (cpi & 1) + (cpi >> 1) * 4;
        float k1[8], k2[8];
        rope_apply(rk1, cp, latent, 1.0f, k1);
        rope_apply(rk2, cp + 2, latent, 1.0f, k2);
        u32x4 o1 = {pack2(k1[0], k1[1]), pack2(k1[2], k1[3]), pack2(k1[4], k1[5]), pack2(k1[6], k1[7])};
        u32x4 o2 = {pack2(k2[0], k2[1]), pack2(k2[2], k2[3]), pack2(k2[4], k2[5]), pack2(k2[6], k2[7])};
        *(u32x4*)(Ks + s * K_LD + cp * 8) = o1; *(u32x4*)(Ks + s * K_LD + (cp + 2) * 8) = o2;
    }
#pragma unroll
    for (int it = 0; it < 4; ++it) { const int item = tid + it * 512, s = item >> 4, ch = item & 15; *(u32x4*)(Vs + s * V_LD + ch * 8) = vreg[it]; }
#pragma unroll
    for (int it = 0; it < 4; ++it) { const int item = tid + it * 512, dir = item >> 10, rem = item & 1023, v = rem >> 3, ch = rem & 7; *(u32x4*)(Cs + (dir * 128 + v) * K_LD + ch * 8) = creg[it]; }
    if (tid < 128) nvs[tid] = ldg(p.Cn() + (size_t)st_index(sd, sl, h, tid >> 6, tb) * 64 + (tid & 63));
    if (tid < 2) cms[tid] = ldg(p.Cm() + (size_t)st_index(sd, sl, h, tid, tb) * 4);
    bf16x8 qf[2]; float qv[2][8];
    {
#pragma unroll
        for (int ks = 0; ks < 2; ++ks) { rope_apply(rq[ks], ks * 4 + fq, latent, 0.125f, qv[ks]);
            u32x4 o = {pack2(qv[ks][0], qv[ks][1]), pack2(qv[ks][2], qv[ks][3]), pack2(qv[ks][4], qv[ks][5]), pack2(qv[ks][6], qv[ks][7])}; qf[ks] = mk8(o); }
    }
    __syncthreads();
    const int t = w * 16 + tq;
    f32x4 hsum[8];
#pragma unroll
    for (int mt = 0; mt < 8; ++mt) hsum[mt] = (f32x4){0.f, 0.f, 0.f, 0.f};
#pragma unroll
    for (int dir = 0; dir < 2; ++dir) {
        const float m_in = cms[dir];
        const float Mt = fmaxf(m_in, gpm[dir * 128 + t]);
        const float inter = __expf(m_in - Mt);
        const float mtot = gb[dir * 128 + t] + Mt;
        f32x4 acc[8];
#pragma unroll
        for (int mt = 0; mt < 8; ++mt) { acc[mt] = (f32x4){0.f, 0.f, 0.f, 0.f};
#pragma unroll
            for (int ks = 0; ks < 2; ++ks) { const bf16x8 cf = *(const bf16x8*)(Cs + (dir * 128 + mt * 16 + tq) * K_LD + ks * 32 + fq * 8);
                acc[mt] = mfma16(cf, qf[ks], acc[mt]); }
            acc[mt] = acc[mt] * inter; }
        float qn = 0.f;
#pragma unroll
        for (int ks = 0; ks < 2; ++ks)
#pragma unroll
            for (int j = 0; j < 8; ++j) qn += bf2f(f2bf(qv[ks][j])) * nvs[dir * 64 + ks * 32 + fq * 8 + j];
        qn += shx<16>(qn); qn += shx<32>(qn);
        float den = inter * qn;
        const int u_lo = dir == 0 ? 0 : (w >> 1), u_hi = dir == 0 ? (w >> 1) : 3;
        float rsum = 0.f;
        for (int u = u_lo; u <= u_hi; ++u) {
            unsigned pk[4];
#pragma unroll
            for (int kt = 0; kt < 2; ++kt) { f32x4 sa = {0.f, 0.f, 0.f, 0.f}; const int sb = 32 * u + 16 * kt;
#pragma unroll
                for (int ks = 0; ks < 2; ++ks) { const bf16x8 kf = *(const bf16x8*)(Ks + (sb + tq) * K_LD + ks * 32 + fq * 8); sa = mfma16(kf, qf[ks], sa); }
                float pv[4]; float gv4[4];
#pragma unroll
                for (int r = 0; r < 4; ++r) gv4[r] = ga[dir * 128 + sb + fq * 4 + r];
#ifndef CPU_EMU
                asm volatile("" : "+v"(gv4[0]), "+v"(gv4[1]), "+v"(gv4[2]), "+v"(gv4[3]));
#endif
#pragma unroll
                for (int r = 0; r < 4; ++r) { const int s = sb + fq * 4 + r; const bool valid = dir == 0 ? (s <= t) : (s >= t);
                    pv[r] = valid ? sa[r] * __expf(gv4[r] - Mt) : 0.f; pv[r] = bf2f(f2bf(pv[r])); rsum += pv[r]; }
                pk[kt * 2] = pack2(pv[0], pv[1]); pk[kt * 2 + 1] = pack2(pv[2], pv[3]); }
            u32x4 pkv = {pk[0], pk[1], pk[2], pk[3]}; const bf16x8 pf = mk8(pkv);
#pragma unroll
            for (int mt = 0; mt < 8; ++mt) { const bf16_t* vp = Vs + (32 * u + 4 * fq + tq4) * V_LD + mt * 16 + 4 * tp4;
                const bf16x8 vf = mk8(TR16(vp), TR16(vp + 16 * V_LD));
                acc[mt] = mfma16(vf, pf, acc[mt]); }
        }
        rsum += shx<16>(rsum); rsum += shx<32>(rsum);
        den += rsum;
        const float dn = frcp(fmaxf(fabsf(den), __expf(-mtot)));
#pragma unroll
        for (int mt = 0; mt < 8; ++mt) hsum[mt] = hsum[mt] + acc[mt] * dn;
    }
    float ss = 0.f;
#pragma unroll
    for (int mt = 0; mt < 8; ++mt)
#pragma unroll
        for (int r = 0; r < 4; ++r) ss += hsum[mt][r] * hsum[mt][r];
    ss += shx<16>(ss); ss += shx<32>(ss);
    const float rstd = rsqrtf(ss * (1.0f / 128.0f) + RMS_EPS);
#pragma unroll
    for (int mt = 0; mt < 8; ++mt) { const int v = mt * 16 + fq * 4;
        const u32x2 om = ldg((const u32x2*)(prow + (size_t)t * PWA + C_OM + h * 128 + v));
        u32x2 o = {pack2(hsum[mt][0] * rstd * sigmoidf_(lo16(om.x)), hsum[mt][1] * rstd * sigmoidf_(hi16(om.x))),
                   pack2(hsum[mt][2] * rstd * sigmoidf_(lo16(om.y)), hsum[mt][3] * rstd * sigmoidf_(hi16(om.y)))};
        stg((u32x2*)(p.Mb() + (size_t)(row0 + t) * 512 + h * 128 + v), o); }
}

struct SchedMerge {
    const bf16_t* Mb; const bf16_t* Pb; const bf16_t* Nb; const bf16_t* Wb; int nM;
    DEV bool next(int i, GUnit& u) const { u.aux = i % 3; return tile_order(i / 3, nM, 4, u.pm, u.pn); }
    DEV const bf16_t* a_base(const GUnit& u) const { return (u.aux == 0 ? Mb : (u.aux == 1 ? Pb : Nb)) + (size_t)u.pm * 256 * 512; }
    DEV const bf16_t* b_base(const GUnit& u) const { return Wb + ((size_t)u.aux * 1024 + u.pn * 256) * 512; }
    DEV int grow(const GUnit&, int) const { return 0; }
};
DEV void phase_merge(const Params& p, const SetDesc& sd, int layer, char* shm) {
    SchedMerge S; S.Mb = p.Mb(); S.Pb = p.Pb(); S.Nb = p.Nb(); S.Wb = p.WbT() + (size_t)layer * 3 * 1024 * 512; S.nM = sd.nrows / 256;
    const unsigned char* bgb = p.BG(); bf16_t* mgb = p.MERGED();
    gemm_stream<false, 512, 512, 512>(shm, S, [=](const GUnit& u, f32x4 (&acc)[2][2][4][2], int r0, int c0) -> bool {
        if (u.aux < 2) {
            u32x2 ga[2][4][2], gb[2][4][2];
#pragma unroll
            for (int ai = 0; ai < 2; ++ai)
#pragma unroll
                for (int m = 0; m < 4; ++m)
#pragma unroll
                    for (int hf = 0; hf < 2; ++hf) { const unsigned char* gp = bgb + ((size_t)u.pm * 256 + r0 + ai * 128 + m * 16) * NBG + u.aux * 1024 + u.pn * 256 + c0 + hf * 128;
                        ga[ai][m][hf] = ldg((const u32x2*)gp); gb[ai][m][hf] = ldg((const u32x2*)(gp + 1024)); }
#pragma unroll
            for (int ai = 0; ai < 2; ++ai)
#pragma unroll
                for (int m = 0; m < 4; ++m)
#pragma unroll
                    for (int hf = 0; hf < 2; ++hf) {
#pragma unroll
                        for (int j = 0; j < 4; ++j) { acc[ai][hf][m][0][j] *= u8f(ga[ai][m][hf].x, j) * frcp(u8f(gb[ai][m][hf].x, j)); acc[ai][hf][m][1][j] *= u8f(ga[ai][m][hf].y, j) * frcp(u8f(gb[ai][m][hf].y, j)); } }
            return true;
        }
        u32x2 gm2[2][4][2];
#pragma unroll
        for (int ai = 0; ai < 2; ++ai)
#pragma unroll
            for (int m = 0; m < 4; ++m)
#pragma unroll
                for (int hf = 0; hf < 2; ++hf) gm2[ai][m][hf] = ldg((const u32x2*)(bgb + ((size_t)u.pm * 256 + r0 + ai * 128 + m * 16) * NBG + 2048 + u.pn * 256 + c0 + hf * 128));
#pragma unroll
        for (int ai = 0; ai < 2; ++ai) {
#pragma unroll
            for (int m = 0; m < 4; ++m)
#pragma unroll
                for (int hf = 0; hf < 2; ++hf) { const size_t r = (size_t)u.pm * 256 + r0 + ai * 128 + m * 16;
                    const f32x4 x0 = acc[ai][hf][m][0] * (1.0f / 255.0f), x1 = acc[ai][hf][m][1] * (1.0f / 255.0f); const u32x2 g = gm2[ai][m][hf];
                    u32x4 ov = {pack2(x0[0] * u8f(g.x, 0), x0[1] * u8f(g.x, 1)), pack2(x0[2] * u8f(g.x, 2), x0[3] * u8f(g.x, 3)),
                                pack2(x1[0] * u8f(g.y, 0), x1[1] * u8f(g.y, 1)), pack2(x1[2] * u8f(g.y, 2), x1[3] * u8f(g.y, 3))};
                    stg((u32x4*)(mgb + r * 1024 + u.pn * 256 + c0 + hf * 128), ov); }
        }
        return false; });
}
DEV void phase_outproj(const Params& p, const SetDesc& sd, int layer, char* shm) {
    SchedPlain S; S.A = p.MERGED(); S.Bt = p.WoT() + (size_t)layer * 1024 * 1024; S.nM = sd.nrows / 256; S.nN = 4; S.lda256 = 256 * 1024; S.ldb256 = 256 * 1024;
    bf16_t* yb = p.Y();
    gemm_stream<false, 1024, 1024, 1024>(shm, S, [=](const GUnit& u, const f32x4 (&acc)[2][2][4][2], int r0, int c0) {
#pragma unroll
        for (int ai = 0; ai < 2; ++ai)
#pragma unroll
            for (int m = 0; m < 4; ++m) { bf16_t* o = yb + ((size_t)u.pm * 256 + r0 + ai * 128 + m * 16) * 1024 + u.pn * 256 + c0;
                store8bf(o, acc[ai][0][m][0], acc[ai][0][m][1]); store8bf(o + 128, acc[ai][1][m][0], acc[ai][1][m][1]); } });
}

template <bool SRC_BF> DEV void phase_postmix(const Params& p, const SetDesc& sd, int layer, char* shm) {
    const int tid = TID(), lane = tid & 63, wv = tid >> 6;
    float* wr_s = (float*)shm;
    __syncthreads();
    for (int i = tid; i < 1024 * 16; i += NTHREADS) { const int c = i >> 4, e = i & 15, ln = (c & 511) >> 3, j = c & 7, hf = c >> 9;
        wr_s[((((hf * 8 + j) * 4 + (e >> 2)) * 64 + ln) << 2) + (e & 3)] = ldg(p.router_w + (size_t)layer * 1024 * 16 + i); }
    __syncthreads();
    const float* g1 = p.norm_gain + ((size_t)layer * 4 + 1) * 1024; const float* g2 = p.norm_gain + ((size_t)layer * 4 + 2) * 1024;
    float* par = (float*)(shm + 65536);
    { const int rpb0_ = (sd.nrows + (int)gridDim.x - 1) / (int)gridDim.x; const float* mdb = mod_row(p, sd, layer, min((int)blockIdx.x * rpb0_, sd.nrows - 1));
      stage_params(par, g1, g2, mdb + 2048, mdb + 3072, mdb + 4096); }
    __syncthreads();
    const void* xb = SRC_BF ? (const void*)xbf_base(p, sd) : (const void*)xin_f32(p, sd); bf16_t* xdb = xbf_base(p, sd);
    const int stride = 8; const int rpb_ = (sd.nrows + (int)gridDim.x - 1) / (int)gridDim.x; const int row_end = min(sd.nrows, ((int)blockIdx.x + 1) * rpb_);
    int row = (int)blockIdx.x * rpb_ + wv;
    u32x4 ycur[2], ynxt[2]; XRow<SRC_BF> xcur, xnxt;
    if (row < row_end) {
#pragma unroll
        for (int i = 0; i < 2; ++i) ycur[i] = ldg((const u32x4*)(p.Y() + (size_t)row * 1024 + i * 512 + lane * 8));
        xcur.load(xb, row, lane); }
    for (; row < row_end; row += stride) {
        int ln = lane; HIDE(ln);
        const int rn = row + stride;
        if (rn < row_end) {
#pragma unroll
            for (int i = 0; i < 2; ++i) ynxt[i] = ldg((const u32x4*)(p.Y() + (size_t)rn * 1024 + i * 512 + ln * 8));
            xnxt.load(xb, rn, ln); }
        float y[16]; float ss = 0.f;
#pragma unroll
        for (int hlf = 0; hlf < 2; ++hlf) { const u32x4 m = ycur[hlf];
            const float t8[8] = {lo16(m.x), hi16(m.x), lo16(m.y), hi16(m.y), lo16(m.z), hi16(m.z), lo16(m.w), hi16(m.w)};
#pragma unroll
            for (int j = 0; j < 8; ++j) { y[hlf * 8 + j] = t8[j]; ss += t8[j] * t8[j]; } }
        ss = wave_sum(ss);
        const float rstd = rsqrtf(ss * (1.0f / 1024.0f) + RMS_EPS);
        float xn[16]; float ss2 = 0.f;
#pragma unroll
        for (int hlf = 0; hlf < 2; ++hlf) { f32x4 xw[2];
#pragma unroll
            for (int q = 0; q < 2; ++q) { const int c0 = hlf * 512 + ln * 8 + q * 4; const f32x4 xo = xcur.get(hlf * 2 + q);
#pragma unroll
                for (int j = 0; j < 4; ++j) { const float v = xo[j] + par[2048 + c0 + j] * (y[hlf * 8 + q * 4 + j] * rstd * par[c0 + j]); xw[q][j] = v; xn[hlf * 8 + q * 4 + j] = v; ss2 += v * v; } }
            xrow_store8<true>(xdb, row, hlf * 512 + ln * 8, xw[0], xw[1]); }
        ss2 = wave_sum(ss2);
        const float rstd2 = rsqrtf(ss2 * (1.0f / 1024.0f) + RMS_EPS);
        float lg[16];
#pragma unroll
        for (int e = 0; e < 16; ++e) lg[e] = 0.f;
#pragma unroll
        for (int hlf = 0; hlf < 2; ++hlf) { const int c0 = hlf * 512 + ln * 8; float o[8];
#pragma unroll
            for (int j = 0; j < 8; ++j) { o[j] = xn[hlf * 8 + j] * rstd2 * par[1024 + c0 + j] * (1.0f + par[4096 + c0 + j]) + par[3072 + c0 + j];
#pragma unroll
                for (int eq = 0; eq < 4; ++eq) { const f32x4 w4 = *(const f32x4*)(wr_s + ((((hlf * 8 + j) * 4 + eq) * 64 + ln) << 2));
#pragma unroll
                    for (int e = 0; e < 4; ++e) lg[eq * 4 + e] += o[j] * w4[e]; } }
            const u32x2 ov = {f8pack4(o[0], o[1], o[2], o[3]), f8pack4(o[4], o[5], o[6], o[7])};
            stg((u32x2*)((unsigned char*)p.H() + (size_t)row * 1024 + c0), ov); }
        float r8[8], r4[4], r2[2], r1;
        { const bool b = (lane & 32) != 0;
#pragma unroll
          for (int i = 0; i < 8; ++i) { const float keep = b ? lg[i + 8] : lg[i], send = b ? lg[i] : lg[i + 8]; r8[i] = keep + shx<32>(send); } }
        { const bool b = (lane & 16) != 0;
#pragma unroll
          for (int i = 0; i < 4; ++i) { const float keep = b ? r8[i + 4] : r8[i], send = b ? r8[i] : r8[i + 4]; r4[i] = keep + shx<16>(send); } }
        { const bool b = (lane & 8) != 0;
#pragma unroll
          for (int i = 0; i < 2; ++i) { const float keep = b ? r4[i + 2] : r4[i], send = b ? r4[i] : r4[i + 2]; r2[i] = keep + shx<8>(send); } }
        { const bool b = (lane & 4) != 0; const float keep = b ? r2[1] : r2[0], send = b ? r2[0] : r2[1]; r1 = keep + shx<4>(send); }
        r1 += shx<2>(r1); r1 += shx<1>(r1);
        float mx = r1;
        mx = fmaxf(mx, shx<4>(mx)); mx = fmaxf(mx, shx<8>(mx)); mx = fmaxf(mx, shx<16>(mx)); mx = fmaxf(mx, shx<32>(mx));
        const float ex = __expf(r1 - mx);
        float se = ex;
        se += shx<4>(se); se += shx<8>(se); se += shx<16>(se); se += shx<32>(se);
        if ((lane & 3) == 0) { const int e = ((lane >> 5) & 1) * 8 + ((lane >> 4) & 1) * 4 + ((lane >> 3) & 1) * 2 + ((lane >> 2) & 1);
            stg(p.aff() + (size_t)row * 16 + e, ex * frcp(se)); }
#pragma unroll
        for (int i = 0; i < 2; ++i) ycur[i] = ynxt[i];
        xcur = xnxt;
    }
}

DEV unsigned shxu(unsigned v, int m) {
    const float f = __uint_as_float(v); float r;
    switch (m) { case 1: r = shx<1>(f); break; case 2: r = shx<2>(f); break; case 4: r = shx<4>(f); break; case 8: r = shx<8>(f); break; case 16: r = shx<16>(f); break; default: r = shx<32>(f); break; }
    return __float_as_uint(r);
}
#define TK_CX(a_, b_, desc_) do { const unsigned long long x_ = key[a_], y_ = key[b_]; const bool sw_ = (desc_) ? (x_ < y_) : (x_ > y_); key[a_] = sw_ ? y_ : x_; key[b_] = sw_ ? x_ : y_; } while (0)
template <int TJ> DEV void tk_step_sh(unsigned long long (&key)[4], int tid, bool desc4) {
    unsigned long long pk[4];
#pragma unroll
    for (int m = 0; m < 4; ++m) { const unsigned lo = __float_as_uint(shx<TJ>(__uint_as_float((unsigned)key[m]))), hi = __float_as_uint(shx<TJ>(__uint_as_float((unsigned)(key[m] >> 32))));
        pk[m] = ((unsigned long long)hi << 32) | lo; }
    const bool takemax = desc4 == ((tid & TJ) == 0);
#pragma unroll
    for (int m = 0; m < 4; ++m) { const unsigned long long x = key[m], y = pk[m]; key[m] = takemax ? (x > y ? x : y) : (x < y ? x : y); }
}
DEV void tk_step_lds(unsigned long long (&key)[4], unsigned long long* buf, int tid, int tj, bool active, bool desc4) {
    unsigned long long pk[4];
    __syncthreads();
    if (active) {
#pragma unroll
        for (int m = 0; m < 4; ++m) buf[tid * 4 + m] = key[m]; }
    __syncthreads();
#pragma unroll
    for (int m = 0; m < 4; ++m) pk[m] = active ? buf[(tid ^ tj) * 4 + m] : 0ull;
    const bool takemax = desc4 == ((tid & tj) == 0);
#pragma unroll
    for (int m = 0; m < 4; ++m) { const unsigned long long x = key[m], y = pk[m]; key[m] = takemax ? (x > y ? x : y) : (x < y ? x : y); }
}
DEV void topk_task(const Params& p, const SetDesc& sd, int task, char* shm) {
    const int tid = TID();
    const int e = task & 15, sl = task >> 4;
    unsigned long long* buf = (unsigned long long*)shm;
    const int T = 1 << sd.lgseq, cap = sd.cap;
    const int rbase = sl << sd.lgseq;
    const bool active = tid * 4 < T;
    unsigned long long key[4];
    __syncthreads();
#pragma unroll
    for (int m = 0; m < 4; ++m) { const int i = tid * 4 + m; const float a = active ? ldg(p.aff() + (size_t)(rbase + i) * 16 + e) : 0.f;
        key[m] = ((unsigned long long)__float_as_uint(a) << 32) | (unsigned)(0xFFFFFFFFu - (unsigned)i); }
    for (int k = 2; k <= T; k <<= 1) {
        const bool desc4 = ((tid * 4) & k) == 0;
        for (int j = k >> 1; j >= 256; j >>= 1) tk_step_lds(key, buf, tid, j >> 2, active, desc4);
        if (k >= 256) tk_step_sh<32>(key, tid, desc4);
        if (k >= 128) tk_step_sh<16>(key, tid, desc4);
        if (k >= 64) tk_step_sh<8>(key, tid, desc4);
        if (k >= 32) tk_step_sh<4>(key, tid, desc4);
        if (k >= 16) tk_step_sh<2>(key, tid, desc4);
        if (k >= 8) tk_step_sh<1>(key, tid, desc4);
        if (k >= 4) { TK_CX(0, 2, desc4); TK_CX(1, 3, desc4); TK_CX(0, 1, desc4); TK_CX(2, 3, desc4); }
        else { TK_CX(0, 1, true); TK_CX(2, 3, false); }
    }
    const int sbase = e * sd.rpe + sl * cap;
    if (active) {
#pragma unroll
        for (int m = 0; m < 4; ++m) { const int i = tid * 4 + m; const unsigned long long kv = key[m]; const int tok = (int)(0xFFFFFFFFu - (unsigned)(kv & 0xFFFFFFFFu));
            const int row = rbase + tok;
            if (i < cap) { stg(p.slot_token() + sbase + i, row); stg(p.slot_gate() + sbase + i, __uint_as_float((unsigned)(kv >> 32))); stg(p.token_slots() + (size_t)row * 16 + e, sbase + i); }
            else stg(p.token_slots() + (size_t)row * 16 + e, -1); } }
    if (sl == 0) { const int used = sd.nsamp * cap;
        for (int i = used + tid; i < sd.rpe; i += NTHREADS) { stg(p.slot_token() + e * sd.rpe + i, 0); stg(p.slot_gate() + e * sd.rpe + i, 0.f); } }
}
#undef TK_CX

struct SchedMoe {
    const bf16_t* A; const int* st; const bf16_t* W; int nRT, rpe, nN, wstride;
    DEV bool next(int i, GUnit& u) const { int pmx, pn; if (!tile_order(i, 16 * nRT, nN, pmx, pn)) return false; u.pm = pmx % nRT; u.aux = pmx / nRT; u.pn = pn; return true; }
    DEV int slot0(const GUnit& u) const { return u.aux * rpe + u.pm * 256; }
    DEV const bf16_t* a_base(const GUnit&) const { return A; }
    DEV int grow(const GUnit& u, int i) const { return st ? ldg(st + slot0(u) + i) : slot0(u) + i; }
    DEV const bf16_t* b_base(const GUnit& u) const { return W + (size_t)u.aux * wstride + (size_t)u.pn * 256 * 512; }
};
DEV void phase_moe_gu(const Params& p, const SetDesc& sd, int layer, char* shm) {
    SchedMoe S; S.A = p.H(); S.st = p.slot_token(); S.W = p.WguT() + (size_t)layer * 16 * 2048 * 512; S.nRT = sd.rpe / 256; S.rpe = sd.rpe; S.nN = 8; S.wstride = 2048 * 512;
    unsigned char* hb = (unsigned char*)p.HID();
    gemm_stream<true, 512, 512, 512, true>(shm, S, [=](const GUnit& u, const f32x4 (&acc)[2][2][4][2], int r0, int c0) {
#pragma unroll
        for (int ai = 0; ai < 2; ++ai)
#pragma unroll
            for (int m = 0; m < 4; ++m) { f32x4 h0, h1; const f32x4 a0 = acc[ai][0][m][0] * F8_WINV, a1 = acc[ai][0][m][1] * F8_WINV, b0 = acc[ai][1][m][0] * F8_WINV, b1 = acc[ai][1][m][1] * F8_WINV;
#pragma unroll
                for (int j = 0; j < 4; ++j) { h0[j] = a0[j] * sigmoidf_(a0[j]) * b0[j]; h1[j] = a1[j] * sigmoidf_(a1[j]) * b1[j]; }
                const u32x2 hv = {f8pack4(h0[0], h0[1], h0[2], h0[3]), f8pack4(h1[0], h1[1], h1[2], h1[3])};
                stg((u32x2*)(hb + ((size_t)S.slot0(u) + r0 + ai * 128 + m * 16) * 1024 + u.pn * 128 + c0), hv); } });
}
DEV void phase_moe_down(const Params& p, const SetDesc& sd, int layer, char* shm) {
    SchedMoe S; S.A = p.HID(); S.st = nullptr; S.W = p.WdT() + (size_t)layer * 16 * 1024 * 512; S.nRT = sd.rpe / 256; S.rpe = sd.rpe; S.nN = 4; S.wstride = 1024 * 512;
    unsigned char* yb = (unsigned char*)p.YE(); const float* gt = p.slot_gate();
    gemm_stream<true, 512, 512, 512, true>(shm, S, [=](const GUnit& u, const f32x4 (&acc)[2][2][4][2], int r0, int c0) {
#pragma unroll
        for (int ai = 0; ai < 2; ++ai) {
            float gv[4];
#pragma unroll
            for (int m = 0; m < 4; ++m) gv[m] = ldg(gt + (size_t)S.slot0(u) + r0 + ai * 128 + m * 16) * (F8_WINV * YE_SCALE);
#pragma unroll
            for (int m = 0; m < 4; ++m) { const size_t sl = (size_t)S.slot0(u) + r0 + ai * 128 + m * 16; const float g = gv[m];
                unsigned char* o = yb + sl * 1024 + u.pn * 256 + c0;
#pragma unroll
                for (int hf = 0; hf < 2; ++hf) { const f32x4 a = acc[ai][hf][m][0] * g, b = acc[ai][hf][m][1] * g;
                    const u32x2 ov = {f8pack4(a[0], a[1], a[2], a[3]), f8pack4(b[0], b[1], b[2], b[3])}; stg((u32x2*)(o + hf * 128), ov); } } } });
}

DEV void compact4(const int (&sl)[16], int (&c)[4], int& n) {
    n = 0; c[0] = -1; c[1] = -1; c[2] = -1; c[3] = -1;
#pragma unroll
    for (int e = 0; e < 16; ++e) if (sl[e] >= 0) { c[0] = (n == 0) ? sl[e] : c[0]; c[1] = (n == 1) ? sl[e] : c[1]; c[2] = (n == 2) ? sl[e] : c[2]; c[3] = (n == 3) ? sl[e] : c[3]; ++n; }
}
template <bool DST_F32> DEV void phase_combine(const Params& p, const SetDesc& sd, int layer, char* shm) {
    const int tid = TID(), lane = tid & 63, wv = tid >> 6;
    const float* g3 = p.norm_gain + ((size_t)layer * 4 + 3) * 1024;
    const bf16_t* xsb = xbf_base(p, sd); void* xdb = DST_F32 ? (void*)xout_f32(p, sd) : (void*)xbf_base(p, sd);
    const int stride = 8; const int rpb_ = (sd.nrows + (int)gridDim.x - 1) / (int)gridDim.x; const int row_end = min(sd.nrows, ((int)blockIdx.x + 1) * rpb_);
    int row = __builtin_amdgcn_readfirstlane((int)blockIdx.x * rpb_ + wv);
    float* par = (float*)shm;
    __syncthreads();
    { const float* mdb = mod_row(p, sd, layer, min((int)blockIdx.x * rpb_, sd.nrows - 1)); stage_params(par, g3, mdb + 5120, nullptr, nullptr, nullptr); }
    __syncthreads();
    int raw[16]; int cc[4], cn[4]; int nc = 0, nn = 0;
    u32x2 mc[4][2], mn[4][2]; XRow<true> xc, xn;
#define CMB_SLOTS(r_) do { _Pragma("unroll") for (int e = 0; e < 16; ++e) raw[e] = ldg(p.token_slots() + (size_t)(r_) * 16 + e); } while (0)
#define CMB_DATA(r_, c_, n_, m_, x_) do { _Pragma("unroll") for (int k = 0; k < 4; ++k) { \
            if (k < (n_)) { const unsigned char* yr = (const unsigned char*)p.YE() + (size_t)(c_)[k] * 1024 + lane * 8; (m_)[k][0] = ldg((const u32x2*)yr); (m_)[k][1] = ldg((const u32x2*)(yr + 512)); } \
            else { (m_)[k][0] = (u32x2){0u, 0u}; (m_)[k][1] = (u32x2){0u, 0u}; } } \
        (x_).load(xsb, (r_), lane); } while (0)
    if (row < row_end) { CMB_SLOTS(row); compact4(raw, cc, nc); CMB_DATA(row, cc, nc, mc, xc); if (row + stride < row_end) CMB_SLOTS(row + stride); }
    for (; row < row_end; row += stride) {
        const int rn = row + stride;
        if (rn < row_end) { compact4(raw, cn, nn); CMB_DATA(rn, cn, nn, mn, xn); if (rn + stride < row_end) CMB_SLOTS(rn + stride); }
        float y[16];
#pragma unroll
        for (int j = 0; j < 16; ++j) y[j] = 0.f;
        if (nc <= 4) {
#pragma unroll
            for (int k = 0; k < 4; ++k)
                if (k < nc) {
#pragma unroll
                    for (int hlf = 0; hlf < 2; ++hlf) { const f32x4 a = f8x4_f32(mc[k][hlf].x), b = f8x4_f32(mc[k][hlf].y);
#pragma unroll
                        for (int j = 0; j < 4; ++j) { y[hlf * 8 + j] += a[j]; y[hlf * 8 + 4 + j] += b[j]; } } }
        } else {
            for (int e = 0; e < 16; ++e) { const int sl_ = ldg(p.token_slots() + (size_t)row * 16 + e);
                if (sl_ >= 0) { const unsigned char* yr = (const unsigned char*)p.YE() + (size_t)sl_ * 1024 + lane * 8;
#pragma unroll
                    for (int hlf = 0; hlf < 2; ++hlf) { const u32x2 m = ldg((const u32x2*)(yr + hlf * 512)); const f32x4 a = f8x4_f32(m.x), b = f8x4_f32(m.y);
#pragma unroll
                        for (int j = 0; j < 4; ++j) { y[hlf * 8 + j] += a[j]; y[hlf * 8 + 4 + j] += b[j]; } } } }
        }
        float ss = 0.f;
#pragma unroll
        for (int j = 0; j < 16; ++j) ss += y[j] * y[j];
        ss = wave_sum(ss);
        const float rstd = rsqrtf(ss * (YE_INV * YE_INV / 1024.0f) + RMS_EPS) * YE_INV;
#pragma unroll
        for (int hlf = 0; hlf < 2; ++hlf) { f32x4 xv[2];
#pragma unroll
            for (int q = 0; q < 2; ++q) { const int c0 = hlf * 512 + lane * 8 + q * 4; xv[q] = xc.get(hlf * 2 + q);
#pragma unroll
                for (int j = 0; j < 4; ++j) xv[q][j] += par[1024 + c0 + j] * (y[hlf * 8 + q * 4 + j] * rstd * par[c0 + j]); }
            xrow_store8<!DST_F32>(xdb, row, hlf * 512 + lane * 8, xv[0], xv[1]); }
        nc = nn;
#pragma unroll
        for (int k = 0; k < 4; ++k) { cc[k] = cn[k]; mc[k][0] = mn[k][0]; mc[k][1] = mn[k][1]; }
        xc = xn;
    }
#undef CMB_SLOTS
#undef CMB_DATA
}

constexpr int WQ_WORD0 = 4096;
template <class F> DEV void wq_run(const Params& p, int qidx, int ntasks, char* shm, F&& task) {
    unsigned* ctr = p.bar() + WQ_WORD0 + 64 * qidx;
    volatile int* slot = (volatile int*)(shm + 131072 + 64);
    const int tid = TID();
    int cur = blockIdx.x;
    while (cur < ntasks) {
        unsigned pend = 0u;
        if (tid == 0) pend = atomicAdd(ctr, 1u);
        task(cur);
        __syncthreads();
        if (tid == 0) *slot = (int)gridDim.x + (int)pend;
        __syncthreads();
        cur = *slot;
    }
}

template <int PH> DEV void do_phase(const Params& p, int layer, int is_ctx, int grp, char* shm) {
    const SetDesc sd = make_set(is_ctx, grp);
    if constexpr (PH == -1) phase_prologue(p, shm);
    if constexpr (PH == 0) { if (layer == 0) phase_norm1<false>(p, sd, layer, shm); else phase_norm1<true>(p, sd, layer, shm); }
    if constexpr (PH == 1) phase_proj_a(p, sd, layer, shm);
    const int qbase = ((layer * 3 + (is_ctx ? 0 : grp + 1)) * 13 + (PH < 0 ? 0 : PH)) * 2;
    if constexpr (PH == 2) { wq_run(p, qbase, sd.nsamp * 4 * sd.ntb, shm, [&](int t) { mlstm_stepA_task(p, sd, layer, t, shm); }); if (!(is_ctx && layer == 1)) phase_pool(p, sd); }
    if constexpr (PH == 3) {
        for (int t = blockIdx.x; t < sd.nsamp * 32; t += gridDim.x) mlstm_stepB_task(p, sd, t);
        if (!(is_ctx && layer == 1)) {
            const int nq = (is_ctx ? (CTX / 64) : ROWS) / 2;
            wq_run(p, qbase, sd.nsamp * nq * 4, shm, [&](int t) { na_task(p, sd, layer, t / (nq * 4), (t >> 2) % nq, t & 3, shm); });
        }
    }
    if constexpr (PH == 4) { wq_run(p, qbase, sd.nsamp * 4 * sd.ntb, shm, [&](int t) { mlstm_stepC_task(p, sd, layer, t, shm); }); }
    if constexpr (PH == 6) phase_merge(p, sd, layer, shm);
    if constexpr (PH == 7) phase_outproj(p, sd, layer, shm);
    if constexpr (PH == 8) { if (layer == 0) phase_postmix<false>(p, sd, layer, shm); else phase_postmix<true>(p, sd, layer, shm); }
    if constexpr (PH == 9) { for (int t = blockIdx.x; t < sd.nsamp * 16; t += gridDim.x) topk_task(p, sd, t, shm); }
    if constexpr (PH == 10) phase_moe_gu(p, sd, layer, shm);
    if constexpr (PH == 11) phase_moe_down(p, sd, layer, shm);
    if constexpr (PH == 12) { if (layer == 0) phase_combine<false>(p, sd, layer, shm); else phase_combine<true>(p, sd, layer, shm); }
}

#ifndef CPU_EMU
template <int PH> __global__ void __launch_bounds__(NTHREADS, 2) k_phase(Params p, int layer, int is_ctx, int grp) {
    DYN_LDS(shm);
    do_phase<PH>(p, layer, is_ctx, grp, shm);
}
#ifndef DBL_MASK
#define DBL_MASK 0
#endif
#define RUNPH(PH) do { do_phase<PH>(p, layer, is_ctx, grp, shm); xcd_barrier(bar); if ((DBL_MASK >> (PH)) & 1) { do_phase<PH>(p, layer, is_ctx, grp, shm); xcd_barrier(bar); } } while (0)
__global__ void __launch_bounds__(NTHREADS, 2) k_mega(Params p) {
    DYN_LDS(shm);
    uint4* xbw = (uint4*)(shm + 131072);
    if (threadIdx.x == 0) *xbw = make_uint4(0u, 0u, 0u, 0u);
    __syncthreads();
    XcdBarrier bar = xcd_barrier_post(p.bar(), (volatile LAS unsigned*)xbw);
    do_phase<-1>(p, 0, 0, 0, shm);
    xcd_barrier(bar);
    for (int layer = 0; layer < 2; ++layer)
        for (int si = 0; si <= NG; ++si) {
            const int is_ctx = si == 0 ? 1 : 0, grp = si == 0 ? 0 : si - 1;
            RUNPH(0); RUNPH(1); RUNPH(2);
            if (is_ctx && layer == 1) { do_phase<3>(p, layer, is_ctx, grp, shm); continue; }
            RUNPH(3); RUNPH(4); RUNPH(6); RUNPH(7); RUNPH(8); RUNPH(9); RUNPH(10); RUNPH(11);
            do_phase<12>(p, layer, is_ctx, grp, shm);
        }
}
#endif
}

static Params make_params(void* const* d_in, void* d_out, void* d_ws) {
    Params p{};
    p.x = (const float*)d_in[0]; p.c = (const float*)d_in[1]; p.ctx = (const float*)d_in[2]; p.c_ctx = (const float*)d_in[3];
    p.norm_gain = (const float*)d_in[4]; p.ada_w = (const float*)d_in[5]; p.ada_b = (const float*)d_in[6]; p.w_in = (const float*)d_in[7];
    p.gate_bias = (const float*)d_in[8]; p.pool_w = (const float*)d_in[9]; p.pool_scale = (const float*)d_in[10]; p.rpb = (const float*)d_in[11];
    p.w_branch = (const float*)d_in[12]; p.w_out = (const float*)d_in[13]; p.router_w = (const float*)d_in[14];
    p.w_gate = (const float*)d_in[15]; p.w_up = (const float*)d_in[16]; p.w_down = (const float*)d_in[17];
    p.out = (float*)d_out; p.ws = (char*)d_ws;
    return p;
}

#ifdef CPU_EMU
int emu_cfg_B = CFG_B, emu_cfg_ROWS = CFG_ROWS, emu_cfg_CTX = CFG_CTX;
const char* g_dumpdir = "data";
static void* g_ws = nullptr;
static void dump_buf(const char* name, int layer, int is_ctx, int grp, const void* ptr, size_t bytes) {
    char nm[512]; snprintf(nm, sizeof nm, "%s/d_L%d_%s%d_%s.bin", g_dumpdir, layer, is_ctx ? "c" : "g", grp, name);
    FILE* f = fopen(nm, "wb"); fwrite(ptr, 1, bytes, f); fclose(f);
}
static void emu_hook(const Params& p, int layer, int is_ctx, int grp, int ph) {
    const size_t Rn = is_ctx ? RC : RL;
    if (ph == 0) dump_buf("H", layer, is_ctx, grp, p.H(), Rn * 1024 * 2);
    if (ph == 1) dump_buf("PROJ", layer, is_ctx, grp, is_ctx ? p.PROJc() : p.PROJa(), Rn * PWA * 2);
    if (ph == 2) dump_buf("Pb", layer, is_ctx, grp, p.Pb(), Rn * 512 * 2);
    if (ph == 3) dump_buf("Nb", layer, is_ctx, grp, p.Nb(), Rn * 512 * 2);
    if (ph == 4) dump_buf("Mb", layer, is_ctx, grp, p.Mb(), Rn * 512 * 2);
    if (ph == 1) dump_buf("BG", layer, is_ctx, grp, p.BG(), Rn * NBG);
    if (ph == 6) dump_buf("MERGED", layer, is_ctx, grp, p.MERGED(), Rn * 1024 * 2);
    if (ph == 7) dump_buf("Y", layer, is_ctx, grp, p.Y(), Rn * 1024 * 2);
    if (ph == 8) { dump_buf("H2", layer, is_ctx, grp, p.H(), Rn * 1024 * 2); dump_buf("aff", layer, is_ctx, grp, p.aff(), Rn * 16 * 4); }
}
void emu_dump(const char* dir) {
    char nm[512]; snprintf(nm, sizeof nm, "%s/d_mod.bin", dir);
    FILE* f = fopen(nm, "wb"); fwrite((char*)g_ws + WSL.mod, 1, (size_t)2 * (NB + 1) * 6144 * 4, f); fclose(f);
    snprintf(nm, sizeof nm, "%s/d_ctxs.bin", dir);
    f = fopen(nm, "wb"); fwrite((char*)g_ws + WSL.ctxs, 1, (size_t)NB * CTX * 1024 * 2, f); fclose(f);
}
template <int PH> static void emu_run_phase(const Params& p, int layer, int is_ctx, int grp, int nblocks) {
    emu_launch_lambda([=]() { do_phase<PH>(p, layer, is_ctx, grp, emu_blk->smem); }, nblocks, NTHREADS, LDS_BYTES);
    if (PH >= 0) emu_hook(p, layer, is_ctx, grp, PH);
    printf("phase %d layer %d ctx %d grp %d done\n", PH, layer, is_ctx, grp); fflush(stdout);
}
#define LAUNCH_PHASE(PH) emu_run_phase<PH>(p, layer, is_ctx, grp, nblocks)
#else
#define LAUNCH_PHASE(PH) hipLaunchKernelGGL((k_phase<PH>), dim3(nblocks), dim3(NTHREADS), LDS_BYTES, stream, p, layer, is_ctx, grp)
#define SETATTR(PH) (void)hipFuncSetAttribute((const void*)k_phase<PH>, hipFuncAttributeMaxDynamicSharedMemorySize, LDS_BYTES)
#endif

extern "C" void kernel_launch(void* const* d_in, const int* in_sizes, int n_in, void* d_out, int out_size, void* d_ws, size_t ws_size, hipStream_t stream) {
    (void)in_sizes; (void)n_in; (void)out_size;
    if (ws_size < WSL.total) return;
    Params p = make_params(d_in, d_out, d_ws);
#ifdef CPU_EMU
    g_ws = d_ws;
    memset(d_ws, 0xFF, WSL.total);
    memset((char*)d_ws + WSL.bar, 0, 65536);
    const int nblocks = 16;
#else
    const int nblocks = 256;
#if MK_ONE_LAUNCH
    static int grid = 0;
    if (!grid) {
        (void)hipFuncSetAttribute((const void*)k_mega, hipFuncAttributeMaxDynamicSharedMemorySize, LDS_BYTES);
        int dev = 0, cus = 0, per_cu = 0;
        (void)hipGetDevice(&dev);
        (void)hipDeviceGetAttribute(&cus, hipDeviceAttributeMultiprocessorCount, dev);
        (void)hipOccupancyMaxActiveBlocksPerMultiprocessor(&per_cu, (const void*)k_mega, NTHREADS, LDS_BYTES);
        if (per_cu > 1) per_cu = 1;
        grid = cus * per_cu;
        if (grid > 256) grid = 256;
    }
    if (grid <= 0) return;
    (void)hipMemsetAsync(p.bar(), 0, 65536, stream);
    hipLaunchKernelGGL(k_mega, dim3(grid), dim3(NTHREADS), LDS_BYTES, stream, p);
    return;
#else
    static bool attr_done = false;
    if (!attr_done) { SETATTR(-1); SETATTR(0); SETATTR(1); SETATTR(2); SETATTR(3); SETATTR(4); SETATTR(5); SETATTR(6); SETATTR(7); SETATTR(8); SETATTR(9); SETATTR(10); SETATTR(11); SETATTR(12); attr_done = true; }
#endif
#endif
    { const int layer = 0, is_ctx = 0, grp = 0; LAUNCH_PHASE(-1); }
    for (int layer = 0; layer < 2; ++layer)
        for (int si = 0; si <= NG; ++si) {
            const int is_ctx = si == 0 ? 1 : 0, grp = si == 0 ? 0 : si - 1;
            LAUNCH_PHASE(0); LAUNCH_PHASE(1); LAUNCH_PHASE(2); LAUNCH_PHASE(3);
            if (is_ctx && layer == 1) continue;
            LAUNCH_PHASE(4); LAUNCH_PHASE(6); LAUNCH_PHASE(7); LAUNCH_PHASE(8); LAUNCH_PHASE(9); LAUNCH_PHASE(10); LAUNCH_PHASE(11); LAUNCH_PHASE(12);
        }
}
```

```cpp
#ifdef CPU_EMU
#include "emu.h"
#define DYN_LDS(p) char* p = emu_blk->smem
#define WAIT_V(n)
#define WAIT_L(n)
#define HIDE(v)
#define CBAR()
#else
#include <hip/hip_runtime.h>
#define DYN_LDS(p) extern __shared__ __attribute__((aligned(16))) char p[]
#define WAIT_V(n) asm volatile("s_waitcnt vmcnt(" #n ")" ::: "memory")
#define WAIT_L(n) asm volatile("s_waitcnt lgkmcnt(" #n ")" ::: "memory")
#define HIDE(v) asm volatile("" : "+v"(v))
#define CBAR() asm volatile("" ::: "memory")
#endif
#include <stdint.h>
#include <stddef.h>

#ifndef CFG_B
#define CFG_B 32
#define CFG_ROWS 32
#define CFG_CTX 256
#define CFG_G 16
#endif
#ifndef MK_ONE_LAUNCH
#define MK_ONE_LAUNCH 1
#endif

#define DEV __device__ __forceinline__
typedef short s16x4 __attribute__((ext_vector_type(4)));
#ifdef CPU_EMU
#define TR16(ptr) emu_tr16((const void*)(ptr))
#else
typedef __attribute__((address_space(3))) s16x4 lds_s16x4;
#define TR16(ptr) __builtin_amdgcn_ds_read_tr16_b64_v4i16((lds_s16x4*)(ptr))
#endif
#ifdef CPU_EMU
#define TID() (threadIdx.x)
#else
#define TID() ({ int t_ = threadIdx.x; asm volatile("" : "+v"(t_)); t_; })
#endif

typedef unsigned short bf16_t;
typedef short bf16x8 __attribute__((ext_vector_type(8)));
typedef float f32x4 __attribute__((ext_vector_type(4)));
typedef unsigned u32x2 __attribute__((ext_vector_type(2)));
typedef unsigned u32x4 __attribute__((ext_vector_type(4)));

namespace {
constexpr int D = 1024, NB = CFG_B, ROWS = CFG_ROWS, SEQ = ROWS * 64, CTX = CFG_CTX, G = CFG_G, NG = NB / G;
constexpr int RL = G * SEQ, RC = NB * CTX, RMAX = RL > RC ? RL : RC;
constexpr int PWA = 3840, NBG = 3072, PWT = PWA + NBG, PWSRC = 6672, C_SPLIT = 3600;
constexpr int C_QM = 0, C_KM = 256, C_PU = 512, C_GM = 1024, C_PADA = 1040, C_F8 = 1280, C_QN = 1280, C_KN = 1792, C_VM = 2304, C_OM = 2816, C_VN = 3328;
constexpr int proj_col(int n) { return n < 512 ? n : n < 1536 ? n + 1792 : n < 1552 ? n - 512 : n < 2064 ? n - 1040 : n < 3088 ? n - 784 : n + 240; }
static_assert(proj_col(512) == C_VM && proj_col(1024) == C_OM && proj_col(1536) == C_GM && proj_col(1552) == C_PU && proj_col(2064) == C_QN && proj_col(2576) == C_KN && proj_col(3088) == C_VN && proj_col(3599) == PWA - 1, "projection column map");
constexpr int NTBL = SEQ / 128, NTBC = CTX / 128;
constexpr int ilog2(int x) { return x <= 1 ? 0 : 1 + ilog2(x >> 1); }
constexpr int LGSEQ = ilog2(SEQ), LGCTX = ilog2(CTX);
static_assert((1 << LGSEQ) == SEQ && (1 << LGCTX) == CTX, "sequence lengths must be powers of two");
constexpr int cdiv(int a, int b) { return (a + b - 1) / b; }
constexpr int RPE_L = cdiv(G * (SEQ / 8), 256) * 256, RPE_C = cdiv(NB * (CTX / 8), 256) * 256, RPE_MAX = RPE_L > RPE_C ? RPE_L : RPE_C;
constexpr int NSLOT = 16 * RPE_MAX;
constexpr int NTHREADS = 512;
constexpr int GT_MAXU = 12;
constexpr int LDS_BYTES = 131072 + 256 + GT_MAXU * 1024;
constexpr int NST_L = G * 4 * 2 * NTBL, NST_C = NB * 4 * 2 * NTBC, NST = NST_L > NST_C ? NST_L : NST_C;
constexpr int NCI = NB * 4 * 2;
constexpr float RMS_EPS = 1e-6f;

struct WsLayout { size_t bar, WinT, WbT, WoT, WguT, WdT, mod, rope, ctxs, xb, PROJc, CiC, Cin_, Cim, H, H8, PROJa, Sst, Cin, Mb, Pb, Nb, Sn, Ssc, Cn, Cm, aff, slot_token, slot_gate, token_slots, HID, YE, BG, MERGED, Y, total; };
constexpr size_t al(size_t x) { return (x + 255) / 256 * 256; }
constexpr size_t smax(size_t a, size_t b) { return a > b ? a : b; }
constexpr WsLayout make_layout() {
    WsLayout L{}; size_t o = 0;
    L.bar = o; o += al(65536);
    L.WinT = o; o += al((size_t)2 * PWT * 1024 * 2);
    L.WbT = o; o += al((size_t)2 * 3 * 1024 * 512 * 2);
    L.WoT = o; o += al((size_t)2 * 1024 * 1024 * 2);
    L.WguT = o; o += al((size_t)2 * 16 * 2048 * 1024);
    L.WdT = o; o += al((size_t)2 * 16 * 1024 * 1024);
    L.mod = o; o += al((size_t)2 * (NB + 1) * 6144 * 4);
    L.rope = o; o += al((size_t)(ROWS + 64) * 16 * 2 * 4);
    L.ctxs = o; o += al((size_t)NB * CTX * 1024 * 2);
    L.xb = o; o += al((size_t)NB * SEQ * 1024 * 2);
    L.PROJc = o; o += al((size_t)RC * PWA * 2);
    L.CiC = o; o += al((size_t)NCI * 8192 * 4);
    L.Cin_ = o; o += al((size_t)NCI * 64 * 4);
    L.Cim = o; o += al((size_t)NCI * 4 * 4);
    L.H = o; o += al((size_t)RMAX * 1024 * 2);
    L.H8 = o; o += al((size_t)RMAX * 1024);
    const size_t x0 = o;
    L.PROJa = o; o += al((size_t)RMAX * PWA * 2);
    L.Sst = o; o += al((size_t)NST * 8192 * 4);
    L.Cin = o; o += al((size_t)NST * 8192 * 2);
    const size_t hid = al((size_t)NSLOT * 1024 * 2);
    o = x0 + smax(o - x0, 2 * hid);
    L.HID = x0; L.YE = x0 + hid;
    L.Mb = o; o += al((size_t)RMAX * 512 * 2);
    L.Pb = o; o += al((size_t)RMAX * 512 * 2);
    L.Nb = o; o += al((size_t)RMAX * 512 * 2);
    L.MERGED = L.H; L.Y = L.Mb;
    L.BG = o; o += al((size_t)RMAX * NBG);
    L.Sn = o; o += al((size_t)NST * 64 * 4);
    L.Ssc = o; o += al((size_t)NST * 4 * 4);
    L.Cn = o; o += al((size_t)NST * 64 * 4);
    L.Cm = o; o += al((size_t)NST * 4 * 4);
    L.aff = o; o += al((size_t)RMAX * 16 * 4);
    L.slot_token = o; o += al((size_t)NSLOT * 4);
    L.slot_gate = o; o += al((size_t)NSLOT * 4);
    L.token_slots = o; o += al((size_t)RMAX * 16 * 4);
    L.total = o;
    return L;
}
constexpr WsLayout WSL = make_layout();
static_assert(CFG_B != 32 || WSL.total <= ((size_t)1 << 30), "workspace budget");

struct Params {
    const float *x, *c, *ctx, *c_ctx, *norm_gain, *ada_w, *ada_b, *w_in, *gate_bias, *pool_w, *pool_scale, *rpb, *w_branch, *w_out, *router_w, *w_gate, *w_up, *w_down;
    float* out;
    char* ws;
#ifdef CPU_EMU
#define WSF(T, name) __device__ __host__ __forceinline__ T* name() const { return (T*)(ws + WSL.name); }
#else
#if defined(__HIP_DEVICE_COMPILE__)
#define WSF(T, name) __device__ __host__ __forceinline__ T* name() const { char* w_ = ws; asm volatile("" : "+s"(w_)); return (T*)(__attribute__((address_space(1))) T*)(w_ + WSL.name); }
#else
#define WSF(T, name) __device__ __host__ __forceinline__ T* name() const { return (T*)(ws + WSL.name); }
#endif
#endif
    WSF(unsigned, bar) WSF(bf16_t, WinT) WSF(bf16_t, WbT) WSF(bf16_t, WoT) WSF(bf16_t, WguT) WSF(bf16_t, WdT)
    WSF(float, mod) WSF(float, rope) WSF(bf16_t, ctxs) WSF(bf16_t, xb) WSF(bf16_t, PROJc) WSF(float, CiC) WSF(float, Cin_) WSF(float, Cim)
    WSF(bf16_t, H) WSF(unsigned char, H8) WSF(bf16_t, PROJa) WSF(float, Sst) WSF(bf16_t, Cin) WSF(bf16_t, Mb) WSF(bf16_t, Pb) WSF(bf16_t, Nb)
    WSF(float, Sn) WSF(float, Ssc) WSF(float, Cn) WSF(float, Cm) WSF(float, aff) WSF(int, slot_token) WSF(float, slot_gate) WSF(int, token_slots)
    WSF(bf16_t, HID) WSF(bf16_t, YE) WSF(unsigned char, BG) WSF(bf16_t, MERGED) WSF(bf16_t, Y)
#undef WSF
};

struct SetDesc { int is_ctx, nrows, samp0, nsamp, lgseq, ntb, cap, rpe; };
DEV SetDesc make_set(int is_ctx, int grp) {
    SetDesc s;
    s.is_ctx = is_ctx;
    if (is_ctx) { s.nrows = RC; s.samp0 = 0; s.nsamp = NB; s.lgseq = LGCTX; s.ntb = NTBC; s.cap = CTX / 8; s.rpe = RPE_C; }
    else { s.nrows = RL; s.samp0 = grp * G; s.nsamp = G; s.lgseq = LGSEQ; s.ntb = NTBL; s.cap = SEQ / 8; s.rpe = RPE_L; }
    return s;
}

#ifdef CPU_EMU
#define GAS
#else
#define GAS __attribute__((address_space(1)))
#endif
template <class T> DEV T ldg(const T* p) { return *(const GAS T*)p; }
template <class T> DEV void stg(T* p, const T& v) { *(GAS T*)p = v; }
DEV float bf2f(bf16_t v) { return __uint_as_float(((unsigned)v) << 16); }
DEV bf16_t f2bf(float f) { unsigned u = __float_as_uint(f); u += 0x7FFFu + ((u >> 16) & 1u); return (bf16_t)(u >> 16); }
#if defined(__HIP_DEVICE_COMPILE__)
typedef __bf16 bf16n2 __attribute__((ext_vector_type(2)));
typedef float f32n2 __attribute__((ext_vector_type(2)));
DEV unsigned pack2(float lo, float hi) { f32n2 v = {lo, hi}; bf16n2 r = __builtin_convertvector(v, bf16n2); return __builtin_bit_cast(unsigned, r); }
#else
DEV unsigned pack2(float lo, float hi) { return (unsigned)f2bf(lo) | ((unsigned)f2bf(hi) << 16); }
#endif
DEV float lo16(unsigned u) { return __uint_as_float(u << 16); }
DEV float hi16(unsigned u) { return __uint_as_float(u & 0xFFFF0000u); }
#if defined(__HIP_DEVICE_COMPILE__)
DEV float frcp(float x) { return __builtin_amdgcn_rcpf(x); }
#else
DEV float frcp(float x) { return 1.0f / x; }
#endif
#if defined(__HIP_DEVICE_COMPILE__)
DEV float sigmoidf_(float x) { return __builtin_amdgcn_rcpf(1.0f + __expf(-x)); }
#else
DEV float sigmoidf_(float x) { return 1.0f / (1.0f + __expf(-x)); }
#endif
DEV float logsigmoidf_(float x) { return fminf(x, 0.0f) - __logf(1.0f + __expf(-fabsf(x))); }
template <int M> DEV float shx(float v) {
#if defined(__HIP_DEVICE_COMPILE__)
    const unsigned u = __builtin_bit_cast(unsigned, v);
    if constexpr (M == 1) return __builtin_bit_cast(float, __builtin_amdgcn_update_dpp(u, u, 0xB1, 0xF, 0xF, false));
    else if constexpr (M == 2) return __builtin_bit_cast(float, __builtin_amdgcn_update_dpp(u, u, 0x4E, 0xF, 0xF, false));
    else if constexpr (M == 4) { const unsigned t = __builtin_amdgcn_update_dpp(u, u, 0x141, 0xF, 0xF, false);
        return __builtin_bit_cast(float, __builtin_amdgcn_update_dpp(t, t, 0x1B, 0xF, 0xF, false)); }
    else if constexpr (M == 8) return __builtin_bit_cast(float, __builtin_amdgcn_update_dpp(u, u, 0x128, 0xF, 0xF, false));
    else if constexpr (M == 16) { const auto r = __builtin_amdgcn_permlane16_swap(u, u, false, false); return __builtin_bit_cast(float, (threadIdx.x & 16) ? r[0] : r[1]); }
    else { const auto r = __builtin_amdgcn_permlane32_swap(u, u, false, false); return __builtin_bit_cast(float, (threadIdx.x & 32) ? r[0] : r[1]); }
#else
    return __shfl_xor(v, M);
#endif
}
DEV float wave_sum(float v) { v += shx<32>(v); v += shx<16>(v); v += shx<8>(v); v += shx<4>(v); v += shx<2>(v); v += shx<1>(v); return v; }
DEV bf16x8 mk8(u32x2 lo, u32x2 hi) { u32x4 v = {lo.x, lo.y, hi.x, hi.y}; return __builtin_bit_cast(bf16x8, v); }
DEV bf16x8 mk8(u32x4 v) { return __builtin_bit_cast(bf16x8, v); }
DEV bf16x8 mk8(s16x4 lo, s16x4 hi) { return __builtin_shufflevector(lo, hi, 0, 1, 2, 3, 4, 5, 6, 7); }
DEV f32x4 mfma16(bf16x8 a, bf16x8 b, f32x4 c) { return __builtin_amdgcn_mfma_f32_16x16x32_bf16(a, b, c, 0, 0, 0); }
DEV unsigned f8enc1(float x) {
    const unsigned sgn = x < 0.f ? 0x80u : 0u; float a = x < 0.f ? -x : x; if (!(a < 448.f)) a = 448.f;
    if (a < 0.015625f) { const int q = (int)(a * 512.f + 0.5f); const float r = a * 512.f; int qq = q; if ((float)q - r == 0.5f && (q & 1)) qq = q - 1; return sgn | (unsigned)qq; }
    int e = 0; float m = a; while (m >= 2.f) { m *= 0.5f; ++e; } while (m < 1.f) { m *= 2.f; --e; }
    const float r = (m - 1.f) * 8.f; int q = (int)(r + 0.5f); if ((float)q - r == 0.5f && (q & 1)) --q;
    if (q == 8) { q = 0; ++e; }
    return sgn | (unsigned)((e + 7) << 3) | (unsigned)q;
}
#if defined(__HIP_DEVICE_COMPILE__)
DEV unsigned f8pack4(float a, float b, float c, float d) {
    a = __builtin_amdgcn_fmed3f(a, -448.f, 448.f); b = __builtin_amdgcn_fmed3f(b, -448.f, 448.f); c = __builtin_amdgcn_fmed3f(c, -448.f, 448.f); d = __builtin_amdgcn_fmed3f(d, -448.f, 448.f);
    int w = 0; w = __builtin_amdgcn_cvt_pk_fp8_f32(a, b, w, false); w = __builtin_amdgcn_cvt_pk_fp8_f32(c, d, w, true); return (unsigned)w; }
#else
DEV unsigned f8pack4(float a, float b, float c, float d) { return f8enc1(a) | (f8enc1(b) << 8) | (f8enc1(c) << 16) | (f8enc1(d) << 24); }
#endif
DEV float f8dec1(unsigned v) {
    const unsigned e = (v >> 3) & 15u, m = v & 7u; float r = e == 0 ? (float)m * (1.0f / 512.0f) : __uint_as_float(((e + 120u) << 23) | (m << 20));
    return (v & 0x80u) ? -r : r;
}
#if defined(__HIP_DEVICE_COMPILE__)
DEV f32x4 f8x4_f32(unsigned w) { const auto lo = __builtin_amdgcn_cvt_pk_f32_fp8((int)w, false), hi = __builtin_amdgcn_cvt_pk_f32_fp8((int)w, true); return (f32x4){lo[0], lo[1], hi[0], hi[1]}; }
#else
DEV f32x4 f8x4_f32(unsigned w) { return (f32x4){f8dec1(w & 255u), f8dec1((w >> 8) & 255u), f8dec1((w >> 16) & 255u), f8dec1(w >> 24)}; }
#endif
constexpr float YE_SCALE = 32.0f, YE_INV = 1.0f / 32.0f;
#ifdef CPU_EMU
DEV f32x4 mfma_f8(bf16x8 a0, bf16x8 a1, bf16x8 b0, bf16x8 b1, f32x4 c) { return emu_mfma_f8(a0, a1, b0, b1, c); }
#else
typedef int i32x4 __attribute__((ext_vector_type(4)));
typedef int i32x8 __attribute__((ext_vector_type(8)));
DEV f32x4 mfma_f8(bf16x8 a0, bf16x8 a1, bf16x8 b0, bf16x8 b1, f32x4 c) {
    const i32x8 A = __builtin_shufflevector(__builtin_bit_cast(i32x4, a0), __builtin_bit_cast(i32x4, a1), 0, 1, 2, 3, 4, 5, 6, 7);
    const i32x8 B = __builtin_shufflevector(__builtin_bit_cast(i32x4, b0), __builtin_bit_cast(i32x4, b1), 0, 1, 2, 3, 4, 5, 6, 7);
    return __builtin_amdgcn_mfma_scale_f32_16x16x128_f8f6f4(A, B, c, 0, 0, 0, 0, 0, 0);
}
#endif
constexpr float F8_WSCALE = 64.0f, F8_WINV = 1.0f / 64.0f;
DEV void store8bf(bf16_t* o, f32x4 a, f32x4 b) { u32x4 v = {pack2(a[0], a[1]), pack2(a[2], a[3]), pack2(b[0], b[1]), pack2(b[2], b[3])}; stg((u32x4*)o, v); }

#ifndef CPU_EMU
#define XB_TMO      128
#define XB_XCNT(j)  (256  + 64 * (j))
#define XB_XSUB(j)  (1280 + 64 * (j))
#define XB_XGEN(j)  (2304 + 64 * (j))
#define XB_TOP      3328
#define XB_TOPGEN   3392
#define XCD_BAR_WORDS 3456
#define XB_SPIN_CAP (1u << 18)
#define LAS __attribute__((address_space(3)))
__device__ __forceinline__ unsigned xb_ld(unsigned* p)              { return __hip_atomic_load(p, __ATOMIC_RELAXED, __HIP_MEMORY_SCOPE_AGENT); }
__device__ __forceinline__ unsigned xb_add(unsigned* p, unsigned v) { return __hip_atomic_fetch_add(p, v, __ATOMIC_RELAXED, __HIP_MEMORY_SCOPE_AGENT); }
__device__ __forceinline__ unsigned xb_xcc_id() { return (unsigned)__builtin_amdgcn_s_getreg((3 << 11) | 20) & 0xFu; }
#define XB_SPIN(cond, bar) do { unsigned _sp = 0; while (cond) { __builtin_amdgcn_s_sleep(1); \
    if ((++_sp & 255u) == 0u) { if (xb_ld(&(bar)[XB_TMO])) break; if (_sp > XB_SPIN_CAP) { atomicAdd(&(bar)[XB_TMO], 1u); break; } } } } while (0)
struct XcdBarrier { unsigned* bar; unsigned x; volatile LAS unsigned* st; };
__device__ __forceinline__ XcdBarrier xcd_barrier_post(unsigned* bar, volatile LAS unsigned* st) {
    XcdBarrier b; b.bar = bar; b.x = xb_xcc_id(); b.st = st;
    if (threadIdx.x == 0) (void)xb_add(&bar[XB_XCNT(b.x)], 1u);
    return b;
}
__device__ __forceinline__ void xcd_barrier_complete(unsigned* bar, unsigned x, unsigned& nloc, unsigned& nx) {
    const unsigned Gd = gridDim.x * gridDim.y * gridDim.z;
    unsigned sum, cnt, mine, sp = 0u;
    for (;;) {
        sum = 0u; cnt = 0u; mine = 0u;
#pragma unroll
        for (unsigned j = 0; j < 16; ++j) { const unsigned c = xb_ld(&bar[XB_XCNT(j)]); sum += c; cnt += (c > 0u) ? 1u : 0u; mine = (j == x) ? c : mine; }
        if (sum == Gd) break;
        __builtin_amdgcn_s_sleep(1);
        if ((++sp & 255u) == 0u) { if (xb_ld(&bar[XB_TMO])) break; if (sp > XB_SPIN_CAP) { atomicAdd(&bar[XB_TMO], 1u); break; } }
    }
    nloc = mine > 0u ? mine : 1u; nx = cnt > 0u ? cnt : 1u;
}
__device__ __forceinline__ void xcd_barrier(const XcdBarrier& b) {
    asm volatile("s_waitcnt vmcnt(0)" ::: "memory");
    __syncthreads();
    if (threadIdx.x == 0) {
        unsigned* bar = b.bar;
        unsigned bx = b.x; asm volatile("" : "+s"(bx));
        __builtin_amdgcn_s_waitcnt(0);
        unsigned nloc = b.st[0], nx = b.st[1];
        if (nloc == 0u) { xcd_barrier_complete(bar, bx, nloc, nx); b.st[0] = nloc; b.st[1] = nx; }
        const unsigned old = xb_add(&bar[XB_XSUB(bx)], 1u);
        const unsigned gen = old / nloc;
        if (old + 1u == (gen + 1u) * nloc) {
            __builtin_amdgcn_fence(__ATOMIC_RELEASE, "agent");
            asm volatile("s_waitcnt vmcnt(0)" ::: "memory");
            const unsigned og = xb_add(&bar[XB_TOP], 1u);
            const unsigned tg = og / nx;
            if (og + 1u == (tg + 1u) * nx) xb_add(&bar[XB_TOPGEN], 1u);
            else XB_SPIN(xb_ld(&bar[XB_TOPGEN]) == tg, bar);
            __builtin_amdgcn_fence(__ATOMIC_ACQUIRE, "agent");
            xb_add(&bar[XB_XGEN(bx)], 1u);
            asm volatile("s_waitcnt vmcnt(0)" ::: "memory");
        } else {
            XB_SPIN(xb_ld(&bar[XB_XGEN(bx)]) == gen, bar);
            __builtin_amdgcn_fence(__ATOMIC_ACQUIRE, "agent");
            asm volatile("s_waitcnt vmcnt(0)" ::: "memory");
        }
    }
    __syncthreads();
}
#endif

constexpr int BK = 64, HALF = 128, HT_BYTES = HALF * BK * 2;
DEV int lds_byte(int r, int c) { int st = (r >> 4) * 2 + (c >> 5), rr = r & 15, cc = c & 31, ob = rr * 64 + cc * 2; return st * 1024 + (ob ^ (((ob >> 9) & 1) << 5)); }
DEV void stage_rc(int b, int& Rr, int& Cc) { int st = b / 1024, sb = b % 1024, swz = sb ^ (((sb >> 9) & 1) << 5); Rr = (st >> 1) * 16 + swz / 64; Cc = (st & 1) * 32 + (swz % 64) / 2; }
DEV int perm32(int rho) { const int n = rho >> 4, i = rho & 15; return 8 * (i >> 2) + 4 * n + (i & 3); }

DEV bool tile_from_L(int L, int nM, int nN, int& pm, int& pn) {
    const int nwg = nM * nN; if (L >= nwg) return false;
    int wgid = L; { const int q = nwg / 8, r = nwg % 8, xcd = wgid % 8, off = wgid / 8; wgid = (xcd < r ? xcd * (q + 1) : r * (q + 1) + (xcd - r) * q) + off; }
    const int nig = 8 * nN, gid = wgid / nig, fm = gid * 8, gsz = (nM - fm) < 8 ? (nM - fm) : 8;
    pm = fm + ((wgid % nig) % gsz); pn = (wgid % nig) / gsz; return true;
}
DEV bool tile_order(int i, int nM, int nN, int& pm, int& pn) { return tile_from_L(i * (int)gridDim.x + (int)blockIdx.x, nM, nN, pm, pn); }
#ifdef CPU_EMU
#define GLDS16(src, dst) __builtin_amdgcn_global_load_lds((const unsigned*)(src), (unsigned*)((dst) + (TID() & 63) * 16), 16, 0, 0)
#else
#define GLDS16(src, dst) __builtin_amdgcn_global_load_lds((const unsigned*)(src), (unsigned*)(dst), 16, 0, 0)
#endif

#define BAR __builtin_amdgcn_s_barrier()
#define SCHED __builtin_amdgcn_sched_barrier(0)
struct GUnit { int pm, pn, aux; };
template <class T> struct is_void_ { static constexpr bool v = false; };
template <> struct is_void_<void> { static constexpr bool v = true; };
template <class Epi> DEV bool call_epi(const Epi& e, const GUnit& u, f32x4 (&acc)[2][2][4][2], int r0, int c0) {
    if constexpr (is_void_<decltype(e(u, acc, r0, c0))>::v) { e(u, acc, r0, c0); return false; } else return e(u, acc, r0, c0);
}
template <bool GATHER, int LDA_, int LDB_, int K_, bool F8 = false, class Sched, class Epi>
DEV void gemm_stream(char* shm, const Sched& S, const Epi& epi) {
#define SA(b, h) (shm + ((b) * 2 + (h)) * HT_BYTES)
#define SB(b, h) (shm + (4 + (b) * 2 + (h)) * HT_BYTES)
#define STG_B(P, bp) do { GLDS16((bp) + voffB, (P) + ldsb0); GLDS16((bp) + voffB + 64 * LDB_, (P) + ldsb0 + 8192); } while (0)
#define STG_A(P, ap, h, gv) do { if (GATHER) { GLDS16((ap) + gv[h][0], (P) + ldsb0); GLDS16((ap) + gv[h][1], (P) + ldsb0 + 8192); } \
    else { GLDS16((ap) + voffA + (h) * 128 * LDA_, (P) + ldsb0); GLDS16((ap) + voffA + ((h) * 128 + 64) * LDA_, (P) + ldsb0 + 8192); } } while (0)
#define LDA(dst, b, h) _Pragma("unroll") for (int m = 0; m < 4; ++m) _Pragma("unroll") for (int k = 0; k < 2; ++k) \
    dst[m][k] = *reinterpret_cast<const bf16x8*>(SA(b, h) + aoff + m * 2048 + k * 1024)
#define LDB(dst, b, h) _Pragma("unroll") for (int n = 0; n < 2; ++n) _Pragma("unroll") for (int k = 0; k < 2; ++k) \
    dst[n][k] = *reinterpret_cast<const bf16x8*>(SB(b, h) + boff + n * 2048 + k * 1024)
#define MMA(ai, bj, At_, Bx_) do { __builtin_amdgcn_s_setprio(1); \
    if constexpr (F8) { _Pragma("unroll") for (int m = 0; m < 4; ++m) _Pragma("unroll") for (int n = 0; n < 2; ++n) \
      acc[ai][bj][m][n] = mfma_f8(Bx_[n][0], Bx_[n][1], At_[m][0], At_[m][1], acc[ai][bj][m][n]); } \
    else { _Pragma("unroll") for (int m = 0; m < 4; ++m) _Pragma("unroll") for (int n = 0; n < 2; ++n) _Pragma("unroll") for (int k = 0; k < 2; ++k) \
      acc[ai][bj][m][n] = mfma16(Bx_[n][k], At_[m][k], acc[ai][bj][m][n]); } \
    __builtin_amdgcn_s_setprio(0); } while (0)
    constexpr int nt = K_ / BK;
    const int tid = TID();
    const int wid = __builtin_amdgcn_readfirstlane(tid >> 6), lane = tid & 63, wr = wid >> 2, wc = wid & 3, fr = lane & 15, fq = lane >> 4;
    const int ldsb0 = wid * 1024;
    int Rr0, Cc0; stage_rc(tid * 16, Rr0, Cc0);
    const int voffA = Rr0 * LDA_ + Cc0;
    const int voffB = ((Rr0 & ~31) + perm32(Rr0 & 31)) * LDB_ + Cc0;
    const int aoff = lds_byte(wr * 64 + fr, fq * 8), boff = lds_byte(wc * 32 + fr, fq * 8);
    GUnit cur, nxt; int ui = 0;
    if (!S.next(0, cur)) return;
    int gc[2][2] = {{0, 0}, {0, 0}};
    int* gtab = (int*)(shm + 131072 + 256);
    if (GATHER) {
        __syncthreads();
        { GUnit u; for (int i = 0; i < GT_MAXU && S.next(i, u); ++i) { if (tid < 256) gtab[i * 256 + tid] = S.grow(u, tid) * LDA_; } }
        __syncthreads();
#pragma unroll
        for (int h = 0; h < 2; ++h)
#pragma unroll
            for (int i = 0; i < 2; ++i) gc[h][i] = gtab[h * 128 + i * 64 + Rr0] + Cc0;
    }
    f32x4 acc[2][2][4][2];
#pragma unroll
    for (int a = 0; a < 2; ++a)
#pragma unroll
        for (int b = 0; b < 2; ++b)
#pragma unroll
            for (int m = 0; m < 4; ++m)
#pragma unroll
                for (int n = 0; n < 2; ++n) acc[a][b][m][n] = (f32x4){0.f, 0.f, 0.f, 0.f};
    bf16x8 At[4][2], B0[2][2], B1[2][2];
    const bf16_t* cA = S.a_base(cur); const bf16_t* cB = S.b_base(cur);
    STG_B(SB(0, 0), cB); STG_A(SA(0, 0), cA, 0, gc); STG_B(SB(0, 1), cB + 128 * LDB_); STG_A(SA(0, 1), cA, 1, gc);
    if (wr == 1) BAR;
    WAIT_V(4); BAR;
    STG_B(SB(1, 0), cB + BK); STG_A(SA(1, 0), cA + BK, 0, gc); STG_B(SB(1, 1), cB + 128 * LDB_ + BK);
    WAIT_V(6); BAR;
    for (;;) {
        const bool has_next = S.next(ui + 1, nxt);
        const bf16_t* nA = has_next ? S.a_base(nxt) : cA; const bf16_t* nB = has_next ? S.b_base(nxt) : cB;
#pragma unroll 1
        for (int t = 0; t < nt; t += 2) {
            const bool last = (t == nt - 2);
            const bf16_t* a1 = cA + (t + 1) * BK;
            const bf16_t* a2 = last ? nA : cA + (t + 2) * BK; const bf16_t* b2 = last ? nB : cB + (t + 2) * BK;
            const bf16_t* a3 = a2 + BK; const bf16_t* b3 = b2 + BK;
            LDB(B0, 0, 0); SCHED; LDA(At, 0, 0); STG_A(SA(1, 1), a1, 1, gc);
            if (GATHER && last && has_next) {
#pragma unroll
                for (int h = 0; h < 2; ++h)
#pragma unroll
                    for (int i = 0; i < 2; ++i) gc[h][i] = gtab[(ui + 1) * 256 + h * 128 + i * 64 + Rr0] + Cc0; }
            WAIT_L(8); BAR; WAIT_L(0); MMA(0, 0, At, B0); BAR; SCHED;
            LDB(B1, 0, 1); STG_B(SB(0, 0), b2);
            BAR; WAIT_L(0); MMA(0, 1, At, B1); BAR;
            LDA(At, 0, 1); STG_A(SA(0, 0), a2, 0, gc);
            BAR; WAIT_L(0); MMA(1, 0, At, B0); BAR; SCHED;
            STG_B(SB(0, 1), b2 + 128 * LDB_);
            WAIT_V(6); BAR; MMA(1, 1, At, B1); BAR;
            LDB(B0, 1, 0); SCHED; LDA(At, 1, 0); STG_A(SA(0, 1), a2, 1, gc);
            WAIT_L(8); BAR; WAIT_L(0); MMA(0, 0, At, B0); BAR; SCHED;
            LDB(B1, 1, 1); STG_B(SB(1, 0), b3);
            BAR; WAIT_L(0); MMA(0, 1, At, B1); BAR;
            LDA(At, 1, 1); STG_A(SA(1, 0), a3, 0, gc);
            BAR; WAIT_L(0); MMA(1, 0, At, B0); BAR; SCHED;
            STG_B(SB(1, 1), b3 + 128 * LDB_);
            WAIT_V(6); BAR; MMA(1, 1, At, B1); BAR;
        }
        bool keep = false;
        {
            const int tz = TID(); const int wz = tz >> 6, lz = tz & 63, wrz = wz >> 2, wcz = wz & 3, frz = lz & 15, fqz = lz >> 4;
            keep = call_epi(epi, cur, acc, wrz * 64 + frz, wcz * 32 + 8 * fqz);
        }
        if (!has_next) break;
        if (!keep) {
#pragma unroll
            for (int a = 0; a < 2; ++a)
#pragma unroll
                for (int b = 0; b < 2; ++b)
#pragma unroll
                    for (int m = 0; m < 4; ++m)
#pragma unroll
                        for (int n = 0; n < 2; ++n) acc[a][b][m][n] = (f32x4){0.f, 0.f, 0.f, 0.f};
        }
        cur = nxt; cA = nA; cB = nB; ++ui;
    }
    WAIT_V(0);
    if (wr == 0) BAR;
    BAR;
#undef SA
#undef SB
#undef STG_A
#undef STG_B
#undef LDA
#undef LDB
#undef MMA
}

constexpr int J_IN = 16 * 27, J_WB = 2 * 8 * 4, J_WO = 16 * 4, J_GU = 16 * 2 * 64, J_DN = 16 * 64, J_FOLD = 8 * 16, J_PAD = 1;
constexpr int N_MODJOBS = 2 * 96;

constexpr int J_BIG = J_IN + J_WB + J_WO + J_GU + J_DN;
struct WJob { const float* src; bf16_t* dst; int ldsrc, lddst, nvalid, k0, n0, mode, gu_which, f8; };
DEV WJob wjob_decode(const Params& p, int l, int j) {
    WJob w; w.ldsrc = 1024; w.lddst = 1024; w.nvalid = 256; w.mode = 0; w.gu_which = 0; w.f8 = 0;
    if (j < J_IN) { const int kt = j / 27, nb = j % 27; w.k0 = kt * 64; w.n0 = nb * 256; w.src = p.w_in + (size_t)l * 1024 * PWSRC; w.ldsrc = PWSRC; w.nvalid = PWSRC - w.n0; w.dst = p.WinT() + (size_t)l * PWT * 1024; w.mode = 3; }
    else if ((j -= J_IN) < J_WB) { const int bi = (j / 32) * 2, jj = j % 32, kt = jj / 4, nb = jj % 4; w.k0 = kt * 64; w.n0 = nb * 256;
        w.src = p.w_branch + ((size_t)l * 3 + bi) * 512 * 1024; w.dst = p.WbT() + ((size_t)l * 3 + bi) * 1024 * 512; w.lddst = 512; }
    else if ((j -= J_WB) < J_WO) { const int kt = j / 4, nb = j % 4; w.k0 = kt * 64; w.n0 = nb * 256; w.src = p.w_out + (size_t)l * 1024 * 1024; w.dst = p.WoT() + (size_t)l * 1024 * 1024; }
    else if ((j -= J_WO) < J_GU) { const int e = j / 128, jj = j % 128; w.gu_which = jj / 64; const int j3 = jj % 64, kt = j3 / 4, nb = j3 % 4; w.k0 = kt * 64; w.n0 = nb * 256;
        w.src = (w.gu_which ? p.w_up : p.w_gate) + ((size_t)l * 16 + e) * 1024 * 1024; w.dst = p.WguT() + ((size_t)l * 16 + e) * 2048 * 512; w.mode = 1; w.f8 = 1; }
    else { j -= J_GU; const int e = j / 64, jj = j % 64, kt = jj / 4, nb = jj % 4; w.k0 = kt * 64; w.n0 = nb * 256;
        w.src = p.w_down + ((size_t)l * 16 + e) * 1024 * 1024; w.dst = p.WdT() + ((size_t)l * 16 + e) * 1024 * 512; w.f8 = 1; }
    return w;
}
constexpr int WT_LD = 260;
DEV void wjob_load(const WJob& w, int tid, f32x4 (&vv)[8]) {
#pragma unroll
    for (int i = 0; i < 8; ++i) { const int idx = i * 512 + tid, r = idx >> 6, c = (idx & 63) * 4; int col = w.n0 + c; col = col > w.ldsrc - 4 ? w.ldsrc - 4 : col;
        vv[i] = ldg((const f32x4*)(w.src + (size_t)(w.k0 + r) * w.ldsrc + col)); }
}
DEV void wjob_finish(const WJob& w, int tid, const f32x4 (&vv)[8], float* tile) {
    __syncthreads();
#pragma unroll
    for (int i = 0; i < 8; ++i) { const int idx = i * 512 + tid, r = idx >> 6, c = (idx & 63) * 4; *(f32x4*)(tile + r * WT_LD + c) = vv[i]; }
    __syncthreads();
#pragma unroll
    for (int q = 0; q < 4; ++q) {
        const int item = q * 512 + tid, nrow = item >> 3, kc = (item & 7) * 8;
        float v[8];
#pragma unroll
        for (int jj = 0; jj < 8; ++jj) v[jj] = tile[(kc + jj) * WT_LD + nrow];
        const int n = w.n0 + nrow;
        int drow = n; bool f8 = w.f8 != 0; size_t f8base = 0;
        if (w.mode == 1) drow = (n >> 7) * 256 + w.gu_which * 128 + (n & 127);
        if (w.mode == 3) {
            if (n >= C_SPLIT) { f8 = true; f8base = (size_t)PWA * 2048; drow = n - C_SPLIT; }
            else { drow = proj_col(n); if (drow >= C_F8) { f8 = true; f8base = (size_t)C_F8 * 2048; drow -= C_F8; } } }
        if (f8) { const u32x2 o = {f8pack4(v[0] * F8_WSCALE, v[1] * F8_WSCALE, v[2] * F8_WSCALE, v[3] * F8_WSCALE), f8pack4(v[4] * F8_WSCALE, v[5] * F8_WSCALE, v[6] * F8_WSCALE, v[7] * F8_WSCALE)};
            if (nrow < w.nvalid) stg((u32x2*)((unsigned char*)w.dst + f8base + (size_t)drow * 1024 + w.k0 + kc), o); }
        else if (nrow < w.nvalid) { u32x4 o = {pack2(v[0], v[1]), pack2(v[2], v[3]), pack2(v[4], v[5]), pack2(v[6], v[7])};
            stg((u32x4*)(w.dst + (size_t)drow * w.lddst + w.k0 + kc), o); }
    }
}
DEV void pro_small_job(const Params& p, int l, int j, char* shm) {
    float* tile = (float*)shm;
    const int tid = TID();
    if (j < J_FOLD) {
        const int kt = j / 16, ntl = j % 16, k0 = kt * 64, n0 = ntl * 64; const int fg = k0 / 128;
        const float* wb1 = p.w_branch + ((size_t)l * 3 + 1) * 512 * 1024;
        const float* pw = p.pool_w + ((size_t)l * 4 + fg) * 128 * 128; const float* ps = p.pool_scale + (size_t)l * 512 + fg * 128;
        const int c = tid & 63, rq = tid >> 6;
        float accv[8];
#pragma unroll
        for (int i = 0; i < 8; ++i) accv[i] = 0.f;
        for (int d = 0; d < 128; ++d) { const float wv = ldg(wb1 + (size_t)(fg * 128 + d) * 1024 + n0 + c) * ldg(ps + d);
#pragma unroll
            for (int i = 0; i < 8; ++i) accv[i] += ldg(pw + (size_t)(k0 - fg * 128 + rq * 8 + i) * 128 + d) * wv; }
        __syncthreads();
#pragma unroll
        for (int i = 0; i < 8; ++i) tile[(rq * 8 + i) * WT_LD + c] = accv[i];
        __syncthreads();
        const int nrow = tid >> 3, kc = (tid & 7) * 8; float v[8];
#pragma unroll
        for (int jj = 0; jj < 8; ++jj) v[jj] = tile[(kc + jj) * WT_LD + nrow];
        u32x4 o = {pack2(v[0], v[1]), pack2(v[2], v[3]), pack2(v[4], v[5]), pack2(v[6], v[7])};
        stg((u32x4*)(p.WbT() + ((size_t)l * 3 + 1) * 1024 * 512 + (size_t)(n0 + nrow) * 512 + k0 + kc), o);
    } else {
        bf16_t* d0 = p.WinT() + (size_t)l * PWT * 1024 + (size_t)C_PADA * 1024;
        for (int i = tid; i < (C_F8 - C_PADA) * 1024 / 8; i += NTHREADS) stg((u32x4*)(d0 + (size_t)i * 8), (u32x4){0u, 0u, 0u, 0u});
    }
}

DEV void pro_mod_job(const Params& p, int job, char* shm) {
    float* sv = (float*)shm;
    const int tid = TID(), l = job / 96, col0 = (job % 96) * 64;
    const int c = tid & 63, kp = tid >> 6;
    float acc[NB + 1];
#pragma unroll
    for (int v = 0; v <= NB; ++v) acc[v] = 0.f;
    for (int half = 0; half < 2; ++half) {
        __syncthreads();
        for (int idx = tid; idx < (NB + 1) * 512; idx += 512) { const int v = idx >> 9, k = idx & 511;
            const float s = (v < NB) ? ldg(p.c + (size_t)v * 1024 + half * 512 + k) : ldg(p.c_ctx + half * 512 + k);
            sv[idx] = s * sigmoidf_(s); }
        __syncthreads();
        for (int kk = 0; kk < 64; ++kk) { const int k = kp * 64 + kk;
            const float w = ldg(p.ada_w + ((size_t)l * 1024 + half * 512 + k) * 6144 + col0 + c);
#pragma unroll
            for (int v = 0; v <= NB; ++v) acc[v] += sv[v * 512 + k] * w; }
    }
    __syncthreads();
    float* red = (float*)shm;
#pragma unroll
    for (int v = 0; v <= NB; ++v) red[(kp * (NB + 1) + v) * 64 + c] = acc[v];
    __syncthreads();
    for (int idx = tid; idx < (NB + 1) * 64; idx += 512) { const int v = idx >> 6, cc = idx & 63; float s = 0.f;
#pragma unroll
        for (int q = 0; q < 8; ++q) s += red[(q * (NB + 1) + v) * 64 + cc];
        stg(p.mod() + ((size_t)l * (NB + 1) + v) * 6144 + col0 + cc, s + ldg(p.ada_b + (size_t)l * 6144 + col0 + cc)); }
}

DEV void phase_prologue(const Params& p, char* shm) {
    const int tid = TID();
    const int nsmall = N_MODJOBS + 1 + 2 * (J_FOLD + J_PAD);
    for (int job = blockIdx.x; job < nsmall; job += gridDim.x) {
        if (job < N_MODJOBS) pro_mod_job(p, job, shm);
        else if (job == N_MODJOBS) {
            for (int idx = tid; idx < (ROWS + 64) * 16; idx += NTHREADS) { const int pos = idx >> 4, i = idx & 15;
                const float pv = (float)(pos < ROWS ? pos : pos - ROWS);
                const float inv = powf(10000.0f, -(float)(2 * i) / 32.0f);
                const float a = pv * inv; stg(p.rope() + idx * 2, cosf(a)); stg(p.rope() + idx * 2 + 1, sinf(a)); }
        } else { const int sj = job - N_MODJOBS - 1; pro_small_job(p, sj / (J_FOLD + J_PAD), sj % (J_FOLD + J_PAD), shm); }
    }
    float* tile = (float*)shm;
    const int nbig = 2 * J_BIG;
    int job = blockIdx.x;
    if (job >= nbig) return;
    WJob wc = wjob_decode(p, job / J_BIG, job % J_BIG), wn = wc;
    f32x4 vc[8], vn[8];
    wjob_load(wc, tid, vc);
    for (; job < nbig; job += gridDim.x) {
        const int jn = job + gridDim.x;
        if (jn < nbig) { wn = wjob_decode(p, jn / J_BIG, jn % J_BIG); wjob_load(wn, tid, vn); }
        wjob_finish(wc, tid, vc, tile);
        wc = wn;
#pragma unroll
        for (int i = 0; i < 8; ++i) vc[i] = vn[i];
    }
}

DEV const float* xin_f32(const Params& p, const SetDesc& sd) { return (sd.is_ctx ? p.ctx : p.x) + (((size_t)sd.samp0) << sd.lgseq) * 1024; }
DEV bf16_t* xbf_base(const Params& p, const SetDesc& sd) { return (sd.is_ctx ? p.ctxs() : p.xb()) + (((size_t)sd.samp0) << sd.lgseq) * 1024; }
DEV float* xout_f32(const Params& p, const SetDesc& sd) { return p.out + (((size_t)sd.samp0) << sd.lgseq) * 1024; }
template <bool BF> struct XRow;
template <> struct XRow<false> { f32x4 v[4];
    DEV void load(const void* b, size_t row, int lane) { const float* q = (const float*)b + row * 1024 + lane * 8;
#pragma unroll
        for (int i = 0; i < 4; ++i) v[i] = ldg((const f32x4*)(q + (i >> 1) * 512 + (i & 1) * 4)); }
    DEV f32x4 get(int i) const { return v[i]; } };
template <> struct XRow<true> { u32x4 v[2];
    DEV void load(const void* b, size_t row, int lane) { const bf16_t* q = (const bf16_t*)b + row * 1024 + lane * 8;
#pragma unroll
        for (int h = 0; h < 2; ++h) v[h] = ldg((const u32x4*)(q + h * 512)); }
    DEV f32x4 get(int i) const { const u32x4 m = v[i >> 1]; return (i & 1) ? (f32x4){lo16(m.z), hi16(m.z), lo16(m.w), hi16(m.w)} : (f32x4){lo16(m.x), hi16(m.x), lo16(m.y), hi16(m.y)}; } };
template <bool BF> DEV void xrow_store8(void* b, size_t row, int c0, f32x4 a, f32x4 c) {
    if constexpr (BF) store8bf((bf16_t*)b + row * 1024 + c0, a, c);
    else { float* q = (float*)b + row * 1024 + c0; stg((f32x4*)q, a); stg((f32x4*)(q + 4), c); }
}
DEV const float* mod_row(const Params& p, const SetDesc& sd, int layer, int row) {
    return p.mod() + ((size_t)layer * (NB + 1) + (sd.is_ctx ? NB : sd.samp0 + (row >> sd.lgseq))) * 6144;
}
DEV bf16_t* proj_buf(const Params& p, const SetDesc& sd) { return sd.is_ctx ? p.PROJc() : p.PROJa(); }

DEV void stage_params(float* par, const float* v0, const float* v1, const float* v2, const float* v3, const float* v4) {
    const int tid = TID();
    const float* src[5] = {v0, v1, v2, v3, v4};
#pragma unroll
    for (int k = 0; k < 5; ++k) if (src[k]) { for (int i = tid; i < 1024; i += NTHREADS) par[k * 1024 + i] = ldg(src[k] + i); }
}
template <bool SRC_BF> DEV void phase_norm1(const Params& p, const SetDesc& sd, int layer, char* shm) {
    const int tid = TID(), lane = tid & 63, wv = tid >> 6;
    const float* g0 = p.norm_gain + ((size_t)layer * 4 + 0) * 1024;
    const void* xb = SRC_BF ? (const void*)xbf_base(p, sd) : (const void*)xin_f32(p, sd);
    const int stride = 8; const int rpb_ = (sd.nrows + (int)gridDim.x - 1) / (int)gridDim.x; const int row_end = min(sd.nrows, ((int)blockIdx.x + 1) * rpb_);
    int row = (int)blockIdx.x * rpb_ + wv;
    float* par = (float*)shm;
    __syncthreads();
    { const float* mdb = mod_row(p, sd, layer, min((int)blockIdx.x * rpb_, sd.nrows - 1)); stage_params(par, g0, mdb, mdb + 1024, nullptr, nullptr); }
    __syncthreads();
    XRow<SRC_BF> curr, nxtr;
    if (row < row_end) curr.load(xb, row, lane);
    for (; row < row_end; row += stride) {
        const int rn = row + stride;
        if (rn < row_end) nxtr.load(xb, rn, lane);
        f32x4 cur[4];
#pragma unroll
        for (int i = 0; i < 4; ++i) cur[i] = curr.get(i);
        float ss = 0.f;
#pragma unroll
        for (int i = 0; i < 4; ++i)
#pragma unroll
            for (int j = 0; j < 4; ++j) ss += cur[i][j] * cur[i][j];
        ss = wave_sum(ss);
        const float rstd = rsqrtf(ss * (1.0f / 1024.0f) + RMS_EPS);
#pragma unroll
        for (int hlf = 0; hlf < 2; ++hlf) { const int c0 = hlf * 512 + lane * 8; float o[8];
#pragma unroll
            for (int j = 0; j < 8; ++j) o[j] = cur[hlf * 2 + (j >> 2)][j & 3] * rstd * par[c0 + j] * (1.0f + par[2048 + c0 + j]) + par[1024 + c0 + j];
            u32x4 ov = {pack2(o[0], o[1]), pack2(o[2], o[3]), pack2(o[4], o[5]), pack2(o[6], o[7])};
            stg((u32x4*)(p.H() + (size_t)row * 1024 + c0), ov);
            const u32x2 o8 = {f8pack4(o[0], o[1], o[2], o[3]), f8pack4(o[4], o[5], o[6], o[7])};
            stg((u32x2*)(p.H8() + (size_t)row * 1024 + c0), o8); }
        curr = nxtr;
    }
}

struct SchedPlain {
    const bf16_t* A; const bf16_t* Bt; int nM, nN, lda256, ldb256;
    DEV bool next(int i, GUnit& u) const { u.aux = 0; return tile_order(i, nM, nN, u.pm, u.pn); }
    DEV const bf16_t* a_base(const GUnit& u) const { return A + (size_t)u.pm * lda256; }
    DEV const bf16_t* b_base(const GUnit& u) const { return Bt + (size_t)u.pn * ldb256; }
    DEV int grow(const GUnit&, int) const { return 0; }
};
struct SchedPlainT : SchedPlain {
    int split_base = -1;
    DEV bool next(int i, GUnit& u) const { u.aux = 0; const int G_ = (int)gridDim.x, b = (int)blockIdx.x; int L = i * G_ + b;
        if (split_base >= 0 && i >= split_base) { if (b < G_ / 2 || i >= split_base + 2) return false; L = split_base * G_ + (i - split_base) * (G_ / 2) + (b - G_ / 2); }
        return tile_from_L(L, nM, nN, u.pm, u.pn); }
    DEV const bf16_t* a_base(const GUnit&) const { return A; }
    DEV int grow(const GUnit& u, int i) const { return u.pm * 256 + i; }
};
struct SchedProjF8 : SchedPlainT {
    const bf16_t* Bt2; int na8;
    DEV const bf16_t* b_base(const GUnit& u) const { return u.pn < na8 ? Bt + (size_t)u.pn * ldb256 : Bt2 + (size_t)(u.pn - na8) * ldb256; }
};
DEV unsigned gate4u8(f32x4 v) {
    unsigned w = 0;
#pragma unroll
    for (int j = 0; j < 4; ++j) w |= (unsigned)fmaxf(sigmoidf_(v[j] * F8_WINV) * 255.0f + 0.5f, 1.0f) << (8 * j);
    return w;
}
DEV float u8f(unsigned w, int j) { return (float)((w >> (8 * j)) & 0xFFu); }
DEV void phase_proj_a(const Params& p, const SetDesc& sd, int layer, char* shm) {
    bf16_t* pb = proj_buf(p, sd);
    {
        SchedPlain S; S.A = p.H(); S.Bt = p.WinT() + (size_t)layer * PWT * 1024; S.nM = sd.nrows / 256; S.nN = C_F8 / 256; S.lda256 = 256 * 1024; S.ldb256 = 256 * 1024;
        gemm_stream<false, 1024, 1024, 1024>(shm, S, [=](const GUnit& u, const f32x4 (&acc)[2][2][4][2], int r0, int c0) {
#pragma unroll
            for (int ai = 0; ai < 2; ++ai)
#pragma unroll
                for (int m = 0; m < 4; ++m) { bf16_t* o = pb + ((size_t)u.pm * 256 + r0 + ai * 128 + m * 16) * PWA + u.pn * 256 + c0;
                    if (u.pn * 256 + c0 < C_PADA) store8bf(o, acc[ai][0][m][0], acc[ai][0][m][1]);
                    if (u.pn * 256 + 128 < C_PADA) store8bf(o + 128, acc[ai][1][m][0], acc[ai][1][m][1]); } });
    }
    {
        constexpr int NA8 = (PWA - C_F8) / 256;
        SchedProjF8 S; S.A = (const bf16_t*)p.H8(); S.Bt = p.WinT() + (size_t)layer * PWT * 1024 + (size_t)C_F8 * 1024; S.Bt2 = p.WinT() + (size_t)layer * PWT * 1024 + (size_t)PWA * 1024; S.na8 = NA8;
        S.nM = sd.nrows / 256; S.nN = NA8 + NBG / 256; S.lda256 = 256 * 512; S.ldb256 = 256 * 512;
        { const int G_ = (int)gridDim.x, T1 = S.nM * (C_F8 / 256), T2 = S.nM * S.nN; if ((G_ & 1) == 0 && (T1 % G_) * 2 == G_ && T2 % G_ == 0 && T2 / G_ >= 1) S.split_base = T2 / G_ - 1; }
        unsigned char* bg = p.BG();
        gemm_stream<true, 512, 512, 512, true>(shm, S, [=](const GUnit& u, const f32x4 (&acc)[2][2][4][2], int r0, int c0) {
            if (u.pn < NA8) {
#pragma unroll
                for (int ai = 0; ai < 2; ++ai)
#pragma unroll
                    for (int m = 0; m < 4; ++m) { bf16_t* o = pb + ((size_t)u.pm * 256 + r0 + ai * 128 + m * 16) * PWA + C_F8 + u.pn * 256 + c0;
                        store8bf(o, acc[ai][0][m][0] * F8_WINV, acc[ai][0][m][1] * F8_WINV); store8bf(o + 128, acc[ai][1][m][0] * F8_WINV, acc[ai][1][m][1] * F8_WINV); }
            } else {
#pragma unroll
                for (int ai = 0; ai < 2; ++ai)
#pragma unroll
                    for (int m = 0; m < 4; ++m) { unsigned char* o = bg + ((size_t)u.pm * 256 + r0 + ai * 128 + m * 16) * NBG + (u.pn - NA8) * 256 + c0;
#pragma unroll
                        for (int hf = 0; hf < 2; ++hf) { const u32x2 gv = {gate4u8(acc[ai][hf][m][0]), gate4u8(acc[ai][hf][m][1])}; stg((u32x2*)(o + hf * 128), gv); } }
            } });
    }
}
DEV f32x4 sig4(f32x4 v) { f32x4 r; r[0] = sigmoidf_(v[0]); r[1] = sigmoidf_(v[1]); r[2] = sigmoidf_(v[2]); r[3] = sigmoidf_(v[3]); return r; }
DEV void gate_scan(const bf16_t* prow, int h, const float* gbias, float* ga, float* gb, float* gpm, float* gtot, float* tmp) {
    const int tid = TID(), lane = tid & 63, w = tid >> 6;
    float b = 0.f, a = 0.f, pm = 0.f; int d = 0, tok = 0;
    if (tid < 256) {
        d = tid >> 7; const int i = tid & 127; tok = d ? 127 - i : i;
        const float gi = bf2f(ldg(prow + (size_t)tok * PWA + C_GM + (2 * d) * 4 + h)) + ldg(gbias + (2 * d) * 4 + h);
        const float gf = bf2f(ldg(prow + (size_t)tok * PWA + C_GM + (2 * d + 1) * 4 + h)) + ldg(gbias + (2 * d + 1) * 4 + h);
        b = logsigmoidf_(gf);
#pragma unroll
        for (int o = 1; o < 64; o <<= 1) { const float t = __shfl_up(b, o); if (lane >= o) b += t; }
        if (lane == 63) tmp[w] = b;
        a = gi;
    }
    __syncthreads();
    if (tid < 256) {
        if (w & 1) b += tmp[w - 1];
        a -= b; pm = a;
#pragma unroll
        for (int o = 1; o < 64; o <<= 1) { const float t = __shfl_up(pm, o); if (lane >= o) pm = fmaxf(pm, t); }
        if (lane == 63) tmp[8 + w] = pm;
    }
    __syncthreads();
    if (tid < 256) {
        if (w & 1) pm = fmaxf(pm, tmp[8 + w - 1]);
        ga[d * 128 + tok] = a; gb[d * 128 + tok] = b; gpm[d * 128 + tok] = pm;
        if ((tid & 127) == 127) { gtot[d * 2] = b; gtot[d * 2 + 1] = pm; }
    }
    __syncthreads();
}

struct RopeRaw { u32x4 m, q; f32x4 rt[4]; };
DEV void rope_issue(RopeRaw& r, const bf16_t* hp, int cidx, bool latent, int tl, const float* rope) {
    r.m = ldg((const u32x4*)(hp + cidx * 8));
    if (latent) {
        r.q = ldg((const u32x4*)(hp + (cidx ^ 2) * 8));
        const int pos = (cidx < 4) ? (tl >> 6) : (ROWS + (tl & 63));
        const float* tb = rope + ((size_t)pos * 16 + (cidx & 1) * 8) * 2;
#pragma unroll
        for (int i = 0; i < 4; ++i) r.rt[i] = ldg((const f32x4*)(tb + i * 4));
    }
}
DEV void rope_apply(const RopeRaw& r, int cidx, bool latent, float scale, float* o) {
    const u32x4 m = r.m;
    float x[8] = {lo16(m.x), hi16(m.x), lo16(m.y), hi16(m.y), lo16(m.z), hi16(m.z), lo16(m.w), hi16(m.w)};
    if (latent) {
        const u32x4 q = r.q;
        const float y[8] = {lo16(q.x), hi16(q.x), lo16(q.y), hi16(q.y), lo16(q.z), hi16(q.z), lo16(q.w), hi16(q.w)};
        const bool first = (cidx & 2) == 0;
#pragma unroll
        for (int j = 0; j < 8; ++j) { const float cs = r.rt[j >> 1][(j & 1) * 2], sn = r.rt[j >> 1][(j & 1) * 2 + 1];
            x[j] = first ? (x[j] * cs - y[j] * sn) : (x[j] * cs + y[j] * sn); }
    }
#pragma unroll
    for (int j = 0; j < 8; ++j) o[j] = x[j] * scale;
}

DEV int st_index(const SetDesc& sd, int sl, int h, int dir, int tb) { return ((sl * 4 + h) * 2 + dir) * sd.ntb + tb; }

constexpr int V_LD = 144, K_LD = 72, KS_LD = 80;
struct PrefA { RopeRaw rk1, rk2; u32x4 vreg[4]; };
DEV void stepA_issue(PrefA& f, const Params& p, const SetDesc& sd, int task) {
    const int tid = TID();
    const int tb = task % sd.ntb, h = (task / sd.ntb) & 3, sl = task / (sd.ntb * 4);
    const int row0 = (sl << sd.lgseq) + tb * 128; const bool latent = !sd.is_ctx; const int tl0 = tb * 128;
    const bf16_t* prow = proj_buf(p, sd) + (size_t)row0 * PWA;
    { const int s = tid & 127, cpi = tid >> 7, cp = (cpi & 1) + (cpi >> 1) * 4; const bf16_t* hp = prow + (size_t)s * PWA + C_KM + h * 64;
      rope_issue(f.rk1, hp, cp, latent, tl0 + s, p.rope()); rope_issue(f.rk2, hp, cp + 2, latent, tl0 + s, p.rope()); }
#pragma unroll
    for (int it = 0; it < 4; ++it) { const int item = tid + it * 512, s = item >> 4, ch = item & 15; f.vreg[it] = ldg((const u32x4*)(prow + (size_t)s * PWA + C_VM + h * 128 + ch * 8)); }
}
DEV void mlstm_stepA_task(const Params& p, const SetDesc& sd, int layer, int task, int next_task, PrefA& f, char* shm) {
    const int tid = TID(), lane = tid & 63, w = tid >> 6, fr = lane & 15, fq = lane >> 4, tq4 = (lane & 15) >> 2, tp4 = lane & 3;
    const int tb = task % sd.ntb, h = (task / sd.ntb) & 3, sl = task / (sd.ntb * 4);
    const int row0 = (sl << sd.lgseq) + tb * 128; const bool latent = !sd.is_ctx;
    bf16_t* Vs = (bf16_t*)shm;
    bf16_t* Ksc = (bf16_t*)(shm + 128 * V_LD * 2);
    float* ga = (float*)(shm + 128 * V_LD * 2 + 2 * 128 * KS_LD * 2); float* gb = ga + 256; float* gpm = gb + 256; float* gtot = gpm + 256; float* tmp = gtot + 8;
    const bf16_t* prow = proj_buf(p, sd) + (size_t)row0 * PWA;
    __syncthreads();
    gate_scan(prow, h, p.gate_bias + (size_t)layer * 16, ga, gb, gpm, gtot, tmp);
    {
        const int s = tid & 127, cpi = tid >> 7, cp = (cpi & 1) + (cpi >> 1) * 4;
        float k1[8], k2[8];
        rope_apply(f.rk1, cp, latent, 1.0f, k1);
        rope_apply(f.rk2, cp + 2, latent, 1.0f, k2);
#pragma unroll
        for (int dir = 0; dir < 2; ++dir) { const float ws = __expf(ga[dir * 128 + s] - gtot[dir * 2 + 1]);
            u32x4 o1 = {pack2(k1[0] * ws, k1[1] * ws), pack2(k1[2] * ws, k1[3] * ws), pack2(k1[4] * ws, k1[5] * ws), pack2(k1[6] * ws, k1[7] * ws)};
            u32x4 o2 = {pack2(k2[0] * ws, k2[1] * ws), pack2(k2[2] * ws, k2[3] * ws), pack2(k2[4] * ws, k2[5] * ws), pack2(k2[6] * ws, k2[7] * ws)};
            *(u32x4*)(Ksc + (dir * 128 + s) * KS_LD + cp * 8) = o1; *(u32x4*)(Ksc + (dir * 128 + s) * KS_LD + (cp + 2) * 8) = o2; }
    }
#pragma unroll
    for (int it = 0; it < 4; ++it) { const int item = tid + it * 512, s = item >> 4, ch = item & 15; *(u32x4*)(Vs + s * V_LD + ch * 8) = f.vreg[it]; }
    if (next_task >= 0) stepA_issue(f, p, sd, next_task);
    __syncthreads();
    f32x4 acc[2][4];
#pragma unroll
    for (int dir = 0; dir < 2; ++dir)
#pragma unroll
        for (int n = 0; n < 4; ++n) acc[dir][n] = (f32x4){0.f, 0.f, 0.f, 0.f};
#pragma unroll
    for (int ks = 0; ks < 4; ++ks) {
        const bf16_t* vp = Vs + (32 * ks + 4 * fq + tq4) * V_LD + w * 16 + 4 * tp4;
        const bf16x8 af = mk8(TR16(vp), TR16(vp + 16 * V_LD));
#pragma unroll
        for (int dir = 0; dir < 2; ++dir)
#pragma unroll
            for (int n = 0; n < 4; ++n) { const bf16_t* kp = Ksc + (dir * 128 + 32 * ks + 4 * fq + tq4) * KS_LD + n * 16 + 4 * tp4;
                const bf16x8 bfv = mk8(TR16(kp), TR16(kp + 16 * KS_LD));
                acc[dir][n] = mfma16(bfv, af, acc[dir][n]); }
    }
#pragma unroll
    for (int dir = 0; dir < 2; ++dir) { float* So = p.Sst() + (size_t)st_index(sd, sl, h, dir, tb) * 8192;
#pragma unroll
        for (int n = 0; n < 4; ++n) stg((f32x4*)(So + (w * 16 + fr) * 64 + n * 16 + fq * 4), acc[dir][n]); }
    if (tid < 128) { const int dir = tid >> 6, dd = tid & 63; float sm = 0.f;
        for (int i = 0; i < 128; ++i) sm += bf2f(Ksc[(dir * 128 + i) * KS_LD + dd]);
        stg(p.Sn() + (size_t)st_index(sd, sl, h, dir, tb) * 64 + dd, sm); }
    if (tid < 2) { float* sc = p.Ssc() + (size_t)st_index(sd, sl, h, tid, tb) * 4; stg(sc, gtot[tid * 2]); stg(sc + 1, gtot[tid * 2] + gtot[tid * 2 + 1]); }
}

template <int GI> DEV void pool_group(const Params& p, const SetDesc& sd, const bf16_t* pb) {
    constexpr int W = 2 << GI;
    const int nitems = sd.nrows * 16; const int T = 1 << sd.lgseq;
    for (int item = blockIdx.x * NTHREADS + TID(); item < nitems; item += gridDim.x * NTHREADS) {
        const int row = item >> 4, ch = GI * 128 + (item & 15) * 8;
        const int tt = row & (T - 1);
        u32x4 mv[W]; int cnt = 0; bool okv[W];
#pragma unroll
        for (int q = 0; q < W; ++q) { const int t2 = tt - W / 2 + q; const bool ok = (t2 >= 0) && (t2 < T); cnt += ok ? 1 : 0; okv[q] = ok;
            mv[q] = ldg((const u32x4*)(pb + (size_t)(ok ? (row - W / 2 + q) : row) * PWA + C_PU + ch)); }
        float s[8];
#pragma unroll
        for (int j = 0; j < 8; ++j) s[j] = 0.f;
#pragma unroll
        for (int q = 0; q < W; ++q) { u32x4 m = mv[q]; if (!okv[q]) m = (u32x4){0u, 0u, 0u, 0u};
            s[0] += lo16(m.x); s[1] += hi16(m.x); s[2] += lo16(m.y); s[3] += hi16(m.y); s[4] += lo16(m.z); s[5] += hi16(m.z); s[6] += lo16(m.w); s[7] += hi16(m.w); }
        const float inv = frcp((float)cnt);
        const u32x4 m = mv[W / 2];
        const float u[8] = {lo16(m.x), hi16(m.x), lo16(m.y), hi16(m.y), lo16(m.z), hi16(m.z), lo16(m.w), hi16(m.w)};
        u32x4 o = {pack2(s[0] * inv - u[0], s[1] * inv - u[1]), pack2(s[2] * inv - u[2], s[3] * inv - u[3]), pack2(s[4] * inv - u[4], s[5] * inv - u[5]), pack2(s[6] * inv - u[6], s[7] * inv - u[7])};
        stg((u32x4*)(p.Pb() + (size_t)row * 512 + ch), o);
    }
}
DEV void phase_pool(const Params& p, const SetDesc& sd) {
    const bf16_t* pb = proj_buf(p, sd);
    pool_group<0>(p, sd, pb); pool_group<1>(p, sd, pb); pool_group<2>(p, sd, pb); pool_group<3>(p, sd, pb);
}

template <int NC> DEV void mlstm_stepB_run(const Params& p, const SetDesc& sd, int task) {
    const int tid = TID();
    const int q = task & 3, dir = (task >> 2) & 1, h = (task >> 3) & 3, sl = task >> 5;
    const int ci = ((sd.samp0 + sl) * 4 + h) * 2 + dir;
    const int eoff = q * 2048 + tid * 4;
    float zr = 0.f; HIDE(zr);
    f32x4 C = {zr, zr, zr, zr}; float nv = 0.f; float m = -1e30f;
    f32x4 Sv[NC]; float blv[NC], mlv[NC], snv[NC];
#pragma unroll
    for (int c = 0; c < NC; ++c) { const int tb = dir ? NC - 1 - c : c; const size_t si = st_index(sd, sl, h, dir, tb);
        Sv[c] = ldg((const f32x4*)(p.Sst() + si * 8192 + eoff)); blv[c] = ldg(p.Ssc() + si * 4); mlv[c] = ldg(p.Ssc() + si * 4 + 1);
        snv[c] = (q == 0 && tid < 64) ? ldg(p.Sn() + si * 64 + tid) : 0.f; }
    if (!sd.is_ctx) { C = ldg((const f32x4*)(p.CiC() + (size_t)ci * 8192 + eoff)); if (q == 0 && tid < 64) nv = ldg(p.Cin_() + (size_t)ci * 64 + tid); m = ldg(p.Cim() + (size_t)ci * 4); }
#pragma unroll
    for (int c = 0; c < NC; ++c) {
        const int tb = dir ? NC - 1 - c : c; const size_t si = st_index(sd, sl, h, dir, tb);
        u32x2 o = {pack2(C[0], C[1]), pack2(C[2], C[3])};
        stg((u32x2*)(p.Cin() + si * 8192 + eoff), o);
        if (q == 0 && tid < 64) stg(p.Cn() + si * 64 + tid, nv);
        if (q == 0 && tid == 0) stg(p.Cm() + si * 4, m);
        const float mn = fmaxf(blv[c] + m, mlv[c]);
        const float dc = __expf(blv[c] + m - mn), wsn = __expf(mlv[c] - mn);
        C = C * dc + Sv[c] * wsn;
        nv = nv * dc + snv[c] * wsn;
        m = mn;
    }
    if (sd.is_ctx) { stg((f32x4*)(p.CiC() + (size_t)ci * 8192 + eoff), C); if (q == 0 && tid < 64) stg(p.Cin_() + (size_t)ci * 64 + tid, nv); if (q == 0 && tid == 0) stg(p.Cim() + (size_t)ci * 4, m); }
}
DEV void mlstm_stepB_task(const Params& p, const SetDesc& sd, int task) {
    if (sd.is_ctx) mlstm_stepB_run<NTBC>(p, sd, task); else mlstm_stepB_run<NTBL>(p, sd, task);
}

constexpr int NA_KLD = 136, NA_VLD = 144;
DEV void na_task(const Params& p, const SetDesc& sd, int layer, int sl, int rq2  , int hp, char* shm) {
    const int tid = TID(), lane = tid & 63, w = tid >> 6, tq = lane & 15, fq = lane >> 4, tq4 = (lane & 15) >> 2, tp4 = lane & 3;
    const int hh = w >> 2, g = w & 3, head = hp * 2 + hh;
    const bool ctxq = sd.is_ctx;
    bf16_t* Ks = (bf16_t*)shm;
    bf16_t* Vs = (bf16_t*)(shm + 128 * NA_KLD * 2);
    float* rpbs = (float*)(shm + 128 * NA_KLD * 2 + 128 * NA_VLD * 2);
    const int sample = sd.samp0 + sl;
    const bf16_t* pq = proj_buf(p, sd) + ((size_t)sl << sd.lgseq) * PWA;
    const bf16_t* pc = p.PROJc() + (size_t)sample * CTX * PWA;
    const int qcol = g * 16 + tq;
    int rqv[2], rsv[2], qtok[2];
#pragma unroll
    for (int u = 0; u < 2; ++u) { rqv[u] = 2 * rq2 + u; qtok[u] = rqv[u] * 64 + qcol; int r_ = rqv[u] - 4; rsv[u] = r_ < 0 ? 0 : (r_ > ROWS - 8 ? ROWS - 8 : r_); }
    const int nloc = ctxq ? 0 : (rsv[1] + 8 - rsv[0]);
    const int nstage = nloc + CTX / 64;
    __syncthreads();
    if (!ctxq) for (int i = tid; i < 2 * 465; i += NTHREADS) rpbs[i] = ldg(p.rpb + ((size_t)layer * 8 + hp * 2 + i / 465) * 465 + i % 465);
    bf16x8 qf[2][2];
#pragma unroll
    for (int u = 0; u < 2; ++u)
#pragma unroll
        for (int ks = 0; ks < 2; ++ks) qf[u][ks] = mk8(ldg((const u32x4*)(pq + (size_t)qtok[u] * PWA + C_QN + head * 64 + ks * 32 + fq * 8)));
    float m_run[2] = {-1e30f, -1e30f}, l_run[2] = {0.f, 0.f};
    f32x4 acc[2][4];
#pragma unroll
    for (int u = 0; u < 2; ++u)
#pragma unroll
        for (int mt = 0; mt < 4; ++mt) acc[u][mt] = (f32x4){0.f, 0.f, 0.f, 0.f};
    int cs = qcol - 8; cs = cs < 0 ? 0 : (cs > 48 ? 48 : cs);
    const int kc0 = (g == 0) ? 0 : (g == 1) ? 8 : (g == 2) ? 24 : 32;
    const int npair = (nstage + 1) >> 1;
    u32x4 kreg[4], vreg[4];
#define NA_SRC_ROWS(stg) (((stg) < nloc) ? (pq + (size_t)((rsv[0] + (stg)) * 64) * PWA) : (pc + (size_t)((((stg) < nstage ? (stg) : nstage - 1) - nloc) * 64) * PWA))
#define NA_FETCH(sp_) do { _Pragma("unroll") for (int it = 0; it < 4; ++it) { const int item = tid + it * 512, key2 = item >> 4, ch = item & 15; \
        const bf16_t* kb_ = NA_SRC_ROWS(2 * (sp_) + (key2 >> 6)); const bf16_t* src = kb_ + (size_t)(key2 & 63) * PWA + hp * 128 + ch * 8; \
        kreg[it] = ldg((const u32x4*)(src + C_KN)); vreg[it] = ldg((const u32x4*)(src + C_VN)); } } while (0)
    NA_FETCH(0);
    for (int sp = 0; sp < npair; ++sp) {
        __syncthreads();
#pragma unroll
        for (int it = 0; it < 4; ++it) { const int item = tid + it * 512, key2 = item >> 4, ch = item & 15;
            *(u32x4*)(Ks + key2 * NA_KLD + ch * 8) = kreg[it]; *(u32x4*)(Vs + key2 * NA_VLD + ch * 8) = vreg[it]; }
        if (sp + 1 < npair) NA_FETCH(sp + 1);
        __syncthreads();
#pragma unroll
        for (int sub = 0; sub < 2; ++sub) {
        const int st = 2 * sp + sub;
        if (st >= nstage) continue;
        const bool local = st < nloc;
        const bf16_t* Ksb = Ks + sub * 64 * NA_KLD; const bf16_t* Vsb = Vs + sub * 64 * NA_VLD;
        if (local) {
            const int kr = rsv[0] + st;
            f32x4 sa[2][2];
#pragma unroll
            for (int kt = 0; kt < 2; ++kt) { sa[0][kt] = (f32x4){0.f, 0.f, 0.f, 0.f}; sa[1][kt] = (f32x4){0.f, 0.f, 0.f, 0.f};
#pragma unroll
                for (int ks = 0; ks < 2; ++ks) { const bf16x8 kf = *(const bf16x8*)(Ksb + (kc0 + kt * 16 + tq) * NA_KLD + hh * 64 + ks * 32 + fq * 8);
                    sa[0][kt] = mfma16(kf, qf[0][ks], sa[0][kt]); sa[1][kt] = mfma16(kf, qf[1][ks], sa[1][kt]); } }
            float alpha[2]; bf16x8 pf[2];
#pragma unroll
            for (int u = 0; u < 2; ++u) {
                const bool act = (kr >= rsv[u]) && (kr < rsv[u] + 8);
                if (!act) { alpha[u] = 1.0f; pf[u] = mk8((u32x4){0u, 0u, 0u, 0u}); continue; }
                const int dr = kr - rqv[u] + 7;
                float sc[8]; float mx = -1e30f; float bs[8];
#pragma unroll
                for (int kt = 0; kt < 2; ++kt)
#pragma unroll
                    for (int r = 0; r < 4; ++r) { const int kcol = kc0 + kt * 16 + fq * 4 + r; int dc = kcol - qcol + 15; dc = dc < 0 ? 0 : (dc > 30 ? 30 : dc);
                        bs[kt * 4 + r] = rpbs[hh * 465 + dr * 31 + dc]; }
#ifndef CPU_EMU
                asm volatile("" : "+v"(bs[0]), "+v"(bs[1]), "+v"(bs[2]), "+v"(bs[3]), "+v"(bs[4]), "+v"(bs[5]), "+v"(bs[6]), "+v"(bs[7]));
#endif
#pragma unroll
                for (int kt = 0; kt < 2; ++kt)
#pragma unroll
                    for (int r = 0; r < 4; ++r) { const int kcol = kc0 + kt * 16 + fq * 4 + r; const bool valid = (kcol >= cs) && (kcol < cs + 16);
                        const float v = valid ? (sa[u][kt][r] * 0.125f + bs[kt * 4 + r]) : -1e30f; sc[kt * 4 + r] = v; mx = fmaxf(mx, v); }
                mx = fmaxf(mx, shx<16>(mx)); mx = fmaxf(mx, shx<32>(mx));
                const float mn = fmaxf(m_run[u], mx); alpha[u] = __expf(m_run[u] - mn); m_run[u] = mn;
                float ps = 0.f; float pv[8];
#pragma unroll
                for (int j = 0; j < 8; ++j) { pv[j] = __expf(sc[j] - mn); ps += pv[j]; }
                ps += shx<16>(ps); ps += shx<32>(ps);
                l_run[u] = l_run[u] * alpha[u] + ps;
                u32x4 pk = {pack2(pv[0], pv[1]), pack2(pv[2], pv[3]), pack2(pv[4], pv[5]), pack2(pv[6], pv[7])};
                pf[u] = mk8(pk);
            }
#pragma unroll
            for (int mt = 0; mt < 4; ++mt) {
                const bf16_t* vp = Vsb + (kc0 + 4 * fq + tq4) * NA_VLD + hh * 64 + mt * 16 + 4 * tp4;
                const bf16x8 vf = mk8(TR16(vp), TR16(vp + 16 * NA_VLD));
                acc[0][mt] = mfma16(vf, pf[0], acc[0][mt] * alpha[0]); acc[1][mt] = mfma16(vf, pf[1], acc[1][mt] * alpha[1]); }
        } else {
            f32x4 sa[2][4];
#pragma unroll
            for (int kt = 0; kt < 4; ++kt) { sa[0][kt] = (f32x4){0.f, 0.f, 0.f, 0.f}; sa[1][kt] = (f32x4){0.f, 0.f, 0.f, 0.f};
#pragma unroll
                for (int ks = 0; ks < 2; ++ks) { const bf16x8 kf = *(const bf16x8*)(Ksb + (kt * 16 + tq) * NA_KLD + hh * 64 + ks * 32 + fq * 8);
                    sa[0][kt] = mfma16(kf, qf[0][ks], sa[0][kt]); sa[1][kt] = mfma16(kf, qf[1][ks], sa[1][kt]); } }
            float alpha[2]; bf16x8 pf[2][2];
#pragma unroll
            for (int u = 0; u < 2; ++u) {
                float mx = -1e30f;
#pragma unroll
                for (int kt = 0; kt < 4; ++kt)
#pragma unroll
                    for (int r = 0; r < 4; ++r) { sa[u][kt][r] *= 0.125f; mx = fmaxf(mx, sa[u][kt][r]); }
                mx = fmaxf(mx, shx<16>(mx)); mx = fmaxf(mx, shx<32>(mx));
                const float mn = fmaxf(m_run[u], mx); alpha[u] = __expf(m_run[u] - mn); m_run[u] = mn;
                float ps = 0.f;
#pragma unroll
                for (int kt = 0; kt < 4; ++kt)
#pragma unroll
                    for (int r = 0; r < 4; ++r) { sa[u][kt][r] = __expf(sa[u][kt][r] - mn); ps += sa[u][kt][r]; }
                ps += shx<16>(ps); ps += shx<32>(ps);
                l_run[u] = l_run[u] * alpha[u] + ps;
#pragma unroll
                for (int h2 = 0; h2 < 2; ++h2) {
                    u32x4 pk = {pack2(sa[u][2 * h2][0], sa[u][2 * h2][1]), pack2(sa[u][2 * h2][2], sa[u][2 * h2][3]), pack2(sa[u][2 * h2 + 1][0], sa[u][2 * h2 + 1][1]), pack2(sa[u][2 * h2 + 1][2], sa[u][2 * h2 + 1][3])};
                    pf[u][h2] = mk8(pk); }
            }
#pragma unroll
            for (int mt = 0; mt < 4; ++mt) { acc[0][mt] = acc[0][mt] * alpha[0]; acc[1][mt] = acc[1][mt] * alpha[1]; }
#pragma unroll
            for (int h2 = 0; h2 < 2; ++h2)
#pragma unroll
                for (int mt = 0; mt < 4; ++mt) { const bf16_t* vp = Vsb + (32 * h2 + 4 * fq + tq4) * NA_VLD + hh * 64 + mt * 16 + 4 * tp4;
                    const bf16x8 vf = mk8(TR16(vp), TR16(vp + 16 * NA_VLD));
                    acc[0][mt] = mfma16(vf, pf[0][h2], acc[0][mt]); acc[1][mt] = mfma16(vf, pf[1][h2], acc[1][mt]); }
        }
        }
    }
#undef NA_FETCH
#undef NA_SRC_ROWS
#pragma unroll
    for (int u = 0; u < 2; ++u) {
        const float il = frcp(l_run[u]);
        const size_t orow = ((size_t)sl << sd.lgseq) + qtok[u];
#pragma unroll
        for (int mt = 0; mt < 4; ++mt) { u32x2 o = {pack2(acc[u][mt][0] * il, acc[u][mt][1] * il), pack2(acc[u][mt][2] * il, acc[u][mt][3] * il)};
            stg((u32x2*)(p.Nb() + orow * 512 + head * 64 + mt * 16 + fq * 4), o); }
    }
}

struct PrefC { RopeRaw rk1, rk2; u32x4 vreg[4], creg[4]; };
DEV void stepC_issue(PrefC& f, const Params& p, const SetDesc& sd, int task) {
    const int tid = TID();
    const int tb = task % sd.ntb, h = (task / sd.ntb) & 3, sl = task / (sd.ntb * 4);
    const int row0 = (sl << sd.lgseq) + tb * 128; const bool latent = !sd.is_ctx; const int tl0 = tb * 128;
    const bf16_t* prow = proj_buf(p, sd) + (size_t)row0 * PWA;
    { const int s = tid & 127, cpi = tid >> 7, cp = (cpi & 1) + (cpi >> 1) * 4; const bf16_t* hp = prow + (size_t)s * PWA + C_KM + h * 64;
      rope_issue(f.rk1, hp, cp, latent, tl0 + s, p.rope()); rope_issue(f.rk2, hp, cp + 2, latent, tl0 + s, p.rope()); }
#pragma unroll
    for (int it = 0; it < 4; ++it) { const int item = tid + it * 512, s = item >> 4, ch = item & 15; f.vreg[it] = ldg((const u32x4*)(prow + (size_t)s * PWA + C_VM + h * 128 + ch * 8)); }
#pragma unroll
    for (int it = 0; it < 4; ++it) { const int item = tid + it * 512, dir = item >> 10, rem = item & 1023, v = rem >> 3, ch = rem & 7;
        f.creg[it] = ldg((const u32x4*)(p.Cin() + (size_t)st_index(sd, sl, h, dir, tb) * 8192 + v * 64 + ch * 8)); }
}
DEV void mlstm_stepC_task(const Params& p, const SetDesc& sd, int layer, int task, int next_task, PrefC& f, char* shm) {
    const int tid = TID(), lane = tid & 63, w = tid >> 6, tq = lane & 15, fq = lane >> 4, tq4 = (lane & 15) >> 2, tp4 = lane & 3;
    const int tb = task % sd.ntb, h = (task / sd.ntb) & 3, sl = task / (sd.ntb * 4);
    const int row0 = (sl << sd.lgseq) + tb * 128; const bool latent = !sd.is_ctx; const int tl0 = tb * 128;
    bf16_t* Ks = (bf16_t*)shm;
    bf16_t* Vs = (bf16_t*)(shm + 128 * K_LD * 2);
    bf16_t* Cs = (bf16_t*)(shm + 128 * K_LD * 2 + 128 * V_LD * 2);
    float* ga = (float*)(shm + 128 * K_LD * 2 * 3 + 128 * V_LD * 2); float* gb = ga + 256; float* gpm = gb + 256; float* gtot = gpm + 256; float* tmp = gtot + 8;
    float* nvs = tmp + 16;
    float* cms = nvs + 128;
    const bf16_t* prow = proj_buf(p, sd) + (size_t)row0 * PWA;
    RopeRaw rq[2];
    { const int t_ = w * 16 + tq; const bf16_t* hp = prow + (size_t)t_ * PWA + C_QM + h * 64;
#pragma unroll
      for (int ks = 0; ks < 2; ++ks) rope_issue(rq[ks], hp, ks * 4 + fq, latent, tl0 + t_, p.rope()); }
    __syncthreads();
    gate_scan(prow, h, p.gate_bias + (size_t)layer * 16, ga, gb, gpm, gtot, tmp);
    {
        const int s = tid & 127, cpi = tid >> 7, cp = (cpi & 1) + (cpi >> 1) * 4;
        float k1[8], k2[8];
        rope_apply(f.rk1, cp, latent, 1.0f, k1);
        rope_apply(f.rk2, cp + 2, latent, 1.0f, k2);
        u32x4 o1 = {pack2(k1[0], k1[1]), pack2(k1[2], k1[3]), pack2(k1[4], k1[5]), pack2(k1[6], k1[7])};
        u32x4 o2 = {pack2(k2[0], k2[1]), pack2(k2[2], k2[3]), pack2(k2[4], k2[5]), pack2(k2[6], k2[7])};
        *(u32x4*)(Ks + s * K_LD + cp * 8) = o1; *(u32x4*)(Ks + s * K_LD + (cp + 2) * 8) = o2;
    }
#pragma unroll
    for (int it = 0; it < 4; ++it) { const int item = tid + it * 512, s = item >> 4, ch = item & 15; *(u32x4*)(Vs + s * V_LD + ch * 8) = f.vreg[it]; }
#pragma unroll
    for (int it = 0; it < 4; ++it) { const int item = tid + it * 512, dir = item >> 10, rem = item & 1023, v = rem >> 3, ch = rem & 7; *(u32x4*)(Cs + (dir * 128 + v) * K_LD + ch * 8) = f.creg[it]; }
    if (tid < 128) nvs[tid] = ldg(p.Cn() + (size_t)st_index(sd, sl, h, tid >> 6, tb) * 64 + (tid & 63));
    if (tid < 2) cms[tid] = ldg(p.Cm() + (size_t)st_index(sd, sl, h, tid, tb) * 4);
    bf16x8 qf[2]; float qv[2][8];
    {
#pragma unroll
        for (int ks = 0; ks < 2; ++ks) { rope_apply(rq[ks], ks * 4 + fq, latent, 0.125f, qv[ks]);
            u32x4 o = {pack2(qv[ks][0], qv[ks][1]), pack2(qv[ks][2], qv[ks][3]), pack2(qv[ks][4], qv[ks][5]), pack2(qv[ks][6], qv[ks][7])}; qf[ks] = mk8(o); }
    }
    if (next_task >= 0) stepC_issue(f, p, sd, next_task);
    __syncthreads();
    const int t = w * 16 + tq;
    f32x4 hsum[8];
#pragma unroll
    for (int mt = 0; mt < 8; ++mt) hsum[mt] = (f32x4){0.f, 0.f, 0.f, 0.f};
#pragma unroll
    for (int dir = 0; dir < 2; ++dir) {
        const float m_in = cms[dir];
        const float Mt = fmaxf(m_in, gpm[dir * 128 + t]);
        const float inter = __expf(m_in - Mt);
        const float mtot = gb[dir * 128 + t] + Mt;
        f32x4 acc[8];
#pragma unroll
        for (int mt = 0; mt < 8; ++mt) { acc[mt] = (f32x4){0.f, 0.f, 0.f, 0.f};
#pragma unroll
            for (int ks = 0; ks < 2; ++ks) { const bf16x8 cf = *(const bf16x8*)(Cs + (dir * 128 + mt * 16 + tq) * K_LD + ks * 32 + fq * 8);
                acc[mt] = mfma16(cf, qf[ks], acc[mt]); }
            acc[mt] = acc[mt] * inter; }
        float qn = 0.f;
#pragma unroll
        for (int ks = 0; ks < 2; ++ks)
#pragma unroll
            for (int j = 0; j < 8; ++j) qn += bf2f(f2bf(qv[ks][j])) * nvs[dir * 64 + ks * 32 + fq * 8 + j];
        qn += shx<16>(qn); qn += shx<32>(qn);
        float den = inter * qn;
        const int u_lo = dir == 0 ? 0 : (w >> 1), u_hi = dir == 0 ? (w >> 1) : 3;
        float rsum = 0.f;
        for (int u = u_lo; u <= u_hi; ++u) {
            unsigned pk[4];
#pragma unroll
            for (int kt = 0; kt < 2; ++kt) { f32x4 sa = {0.f, 0.f, 0.f, 0.f}; const int sb = 32 * u + 16 * kt;
#pragma unroll
                for (int ks = 0; ks < 2; ++ks) { const bf16x8 kf = *(const bf16x8*)(Ks + (sb + tq) * K_LD + ks * 32 + fq * 8); sa = mfma16(kf, qf[ks], sa); }
                float pv[4]; float gv4[4];
#pragma unroll
                for (int r = 0; r < 4; ++r) gv4[r] = ga[dir * 128 + sb + fq * 4 + r];
#ifndef CPU_EMU
                asm volatile("" : "+v"(gv4[0]), "+v"(gv4[1]), "+v"(gv4[2]), "+v"(gv4[3]));
#endif
#pragma unroll
                for (int r = 0; r < 4; ++r) { const int s = sb + fq * 4 + r; const bool valid = dir == 0 ? (s <= t) : (s >= t);
                    pv[r] = valid ? sa[r] * __expf(gv4[r] - Mt) : 0.f; pv[r] = bf2f(f2bf(pv[r])); rsum += pv[r]; }
                pk[kt * 2] = pack2(pv[0], pv[1]); pk[kt * 2 + 1] = pack2(pv[2], pv[3]); }
            u32x4 pkv = {pk[0], pk[1], pk[2], pk[3]}; const bf16x8 pf = mk8(pkv);
#pragma unroll
            for (int mt = 0; mt < 8; ++mt) { const bf16_t* vp = Vs + (32 * u + 4 * fq + tq4) * V_LD + mt * 16 + 4 * tp4;
                const bf16x8 vf = mk8(TR16(vp), TR16(vp + 16 * V_LD));
                acc[mt] = mfma16(vf, pf, acc[mt]); }
        }
        rsum += shx<16>(rsum); rsum += shx<32>(rsum);
        den += rsum;
        const float dn = frcp(fmaxf(fabsf(den), __expf(-mtot)));
#pragma unroll
        for (int mt = 0; mt < 8; ++mt) hsum[mt] = hsum[mt] + acc[mt] * dn;
    }
    float ss = 0.f;
#pragma unroll
    for (int mt = 0; mt < 8; ++mt)
#pragma unroll
        for (int r = 0; r < 4; ++r) ss += hsum[mt][r] * hsum[mt][r];
    ss += shx<16>(ss); ss += shx<32>(ss);
    const float rstd = rsqrtf(ss * (1.0f / 128.0f) + RMS_EPS);
#pragma unroll
    for (int mt = 0; mt < 8; ++mt) { const int v = mt * 16 + fq * 4;
        const u32x2 om = ldg((const u32x2*)(prow + (size_t)t * PWA + C_OM + h * 128 + v));
        u32x2 o = {pack2(hsum[mt][0] * rstd * sigmoidf_(lo16(om.x)), hsum[mt][1] * rstd * sigmoidf_(hi16(om.x))),
                   pack2(hsum[mt][2] * rstd * sigmoidf_(lo16(om.y)), hsum[mt][3] * rstd * sigmoidf_(hi16(om.y)))};
        stg((u32x2*)(p.Mb() + (size_t)(row0 + t) * 512 + h * 128 + v), o); }
}

struct SchedMerge {
    const bf16_t* Mb; const bf16_t* Pb; const bf16_t* Nb; const bf16_t* Wb; int nM;
    DEV bool next(int i, GUnit& u) const { u.aux = i % 3; return tile_order(i / 3, nM, 4, u.pm, u.pn); }
    DEV const bf16_t* a_base(const GUnit& u) const { return (u.aux == 0 ? Mb : (u.aux == 1 ? Pb : Nb)) + (size_t)u.pm * 256 * 512; }
    DEV const bf16_t* b_base(const GUnit& u) const { return Wb + ((size_t)u.aux * 1024 + u.pn * 256) * 512; }
    DEV int grow(const GUnit&, int) const { return 0; }
};
DEV void phase_merge(const Params& p, const SetDesc& sd, int layer, char* shm) {
    SchedMerge S; S.Mb = p.Mb(); S.Pb = p.Pb(); S.Nb = p.Nb(); S.Wb = p.WbT() + (size_t)layer * 3 * 1024 * 512; S.nM = sd.nrows / 256;
    const unsigned char* bgb = p.BG(); bf16_t* mgb = p.MERGED();
    gemm_stream<false, 512, 512, 512>(shm, S, [=](const GUnit& u, f32x4 (&acc)[2][2][4][2], int r0, int c0) -> bool {
        if (u.aux < 2) {
            u32x2 ga[2][4][2], gb[2][4][2];
#pragma unroll
            for (int ai = 0; ai < 2; ++ai)
#pragma unroll
                for (int m = 0; m < 4; ++m)
#pragma unroll
                    for (int hf = 0; hf < 2; ++hf) { const unsigned char* gp = bgb + ((size_t)u.pm * 256 + r0 + ai * 128 + m * 16) * NBG + u.aux * 1024 + u.pn * 256 + c0 + hf * 128;
                        ga[ai][m][hf] = ldg((const u32x2*)gp); gb[ai][m][hf] = ldg((const u32x2*)(gp + 1024)); }
#pragma unroll
            for (int ai = 0; ai < 2; ++ai)
#pragma unroll
                for (int m = 0; m < 4; ++m)
#pragma unroll
                    for (int hf = 0; hf < 2; ++hf) {
#pragma unroll
                        for (int j = 0; j < 4; ++j) { acc[ai][hf][m][0][j] *= u8f(ga[ai][m][hf].x, j) * frcp(u8f(gb[ai][m][hf].x, j)); acc[ai][hf][m][1][j] *= u8f(ga[ai][m][hf].y, j) * frcp(u8f(gb[ai][m][hf].y, j)); } }
            return true;
        }
        u32x2 gm2[2][4][2];
#pragma unroll
        for (int ai = 0; ai < 2; ++ai)
#pragma unroll
            for (int m = 0; m < 4; ++m)
#pragma unroll
                for (int hf = 0; hf < 2; ++hf) gm2[ai][m][hf] = ldg((const u32x2*)(bgb + ((size_t)u.pm * 256 + r0 + ai * 128 + m * 16) * NBG + 2048 + u.pn * 256 + c0 + hf * 128));
#pragma unroll
        for (int ai = 0; ai < 2; ++ai) {
#pragma unroll
            for (int m = 0; m < 4; ++m)
#pragma unroll
                for (int hf = 0; hf < 2; ++hf) { const size_t r = (size_t)u.pm * 256 + r0 + ai * 128 + m * 16;
                    const f32x4 x0 = acc[ai][hf][m][0] * (1.0f / 255.0f), x1 = acc[ai][hf][m][1] * (1.0f / 255.0f); const u32x2 g = gm2[ai][m][hf];
                    u32x4 ov = {pack2(x0[0] * u8f(g.x, 0), x0[1] * u8f(g.x, 1)), pack2(x0[2] * u8f(g.x, 2), x0[3] * u8f(g.x, 3)),
                                pack2(x1[0] * u8f(g.y, 0), x1[1] * u8f(g.y, 1)), pack2(x1[2] * u8f(g.y, 2), x1[3] * u8f(g.y, 3))};
                    stg((u32x4*)(mgb + r * 1024 + u.pn * 256 + c0 + hf * 128), ov); }
        }
        return false; });
}
DEV void phase_outproj(const Params& p, const SetDesc& sd, int layer, char* shm) {
    SchedPlain S; S.A = p.MERGED(); S.Bt = p.WoT() + (size_t)layer * 1024 * 1024; S.nM = sd.nrows / 256; S.nN = 4; S.lda256 = 256 * 1024; S.ldb256 = 256 * 1024;
    bf16_t* yb = p.Y();
    gemm_stream<false, 1024, 1024, 1024>(shm, S, [=](const GUnit& u, const f32x4 (&acc)[2][2][4][2], int r0, int c0) {
#pragma unroll
        for (int ai = 0; ai < 2; ++ai)
#pragma unroll
            for (int m = 0; m < 4; ++m) { bf16_t* o = yb + ((size_t)u.pm * 256 + r0 + ai * 128 + m * 16) * 1024 + u.pn * 256 + c0;
                store8bf(o, acc[ai][0][m][0], acc[ai][0][m][1]); store8bf(o + 128, acc[ai][1][m][0], acc[ai][1][m][1]); } });
}

template <bool SRC_BF> DEV void phase_postmix(const Params& p, const SetDesc& sd, int layer, char* shm) {
    const int tid = TID(), lane = tid & 63, wv = tid >> 6;
    float* wr_s = (float*)shm;
    __syncthreads();
    for (int i = tid; i < 1024 * 16; i += NTHREADS) { const int c = i >> 4, e = i & 15, ln = (c & 511) >> 3, j = c & 7, hf = c >> 9;
        wr_s[((((hf * 8 + j) * 4 + (e >> 2)) * 64 + ln) << 2) + (e & 3)] = ldg(p.router_w + (size_t)layer * 1024 * 16 + i); }
    __syncthreads();
    const float* g1 = p.norm_gain + ((size_t)layer * 4 + 1) * 1024; const float* g2 = p.norm_gain + ((size_t)layer * 4 + 2) * 1024;
    float* par = (float*)(shm + 65536);
    { const int rpb0_ = (sd.nrows + (int)gridDim.x - 1) / (int)gridDim.x; const float* mdb = mod_row(p, sd, layer, min((int)blockIdx.x * rpb0_, sd.nrows - 1));
      stage_params(par, g1, g2, mdb + 2048, mdb + 3072, mdb + 4096); }
    __syncthreads();
    const void* xb = SRC_BF ? (const void*)xbf_base(p, sd) : (const void*)xin_f32(p, sd); bf16_t* xdb = xbf_base(p, sd);
    const int stride = 8; const int rpb_ = (sd.nrows + (int)gridDim.x - 1) / (int)gridDim.x; const int row_end = min(sd.nrows, ((int)blockIdx.x + 1) * rpb_);
    int row = (int)blockIdx.x * rpb_ + wv;
    u32x4 ycur[2], ynxt[2]; XRow<SRC_BF> xcur, xnxt;
    if (row < row_end) {
#pragma unroll
        for (int i = 0; i < 2; ++i) ycur[i] = ldg((const u32x4*)(p.Y() + (size_t)row * 1024 + i * 512 + lane * 8));
        xcur.load(xb, row, lane); }
    for (; row < row_end; row += stride) {
        int ln = lane; HIDE(ln);
        const int rn = row + stride;
        if (rn < row_end) {
#pragma unroll
            for (int i = 0; i < 2; ++i) ynxt[i] = ldg((const u32x4*)(p.Y() + (size_t)rn * 1024 + i * 512 + ln * 8));
            xnxt.load(xb, rn, ln); }
        float y[16]; float ss = 0.f;
#pragma unroll
        for (int hlf = 0; hlf < 2; ++hlf) { const u32x4 m = ycur[hlf];
            const float t8[8] = {lo16(m.x), hi16(m.x), lo16(m.y), hi16(m.y), lo16(m.z), hi16(m.z), lo16(m.w), hi16(m.w)};
#pragma unroll
            for (int j = 0; j < 8; ++j) { y[hlf * 8 + j] = t8[j]; ss += t8[j] * t8[j]; } }
        ss = wave_sum(ss);
        const float rstd = rsqrtf(ss * (1.0f / 1024.0f) + RMS_EPS);
        float xn[16]; float ss2 = 0.f;
#pragma unroll
        for (int hlf = 0; hlf < 2; ++hlf) { f32x4 xw[2];
#pragma unroll
            for (int q = 0; q < 2; ++q) { const int c0 = hlf * 512 + ln * 8 + q * 4; const f32x4 xo = xcur.get(hlf * 2 + q);
#pragma unroll
                for (int j = 0; j < 4; ++j) { const float v = xo[j] + par[2048 + c0 + j] * (y[hlf * 8 + q * 4 + j] * rstd * par[c0 + j]); xw[q][j] = v; xn[hlf * 8 + q * 4 + j] = v; ss2 += v * v; } }
            xrow_store8<true>(xdb, row, hlf * 512 + ln * 8, xw[0], xw[1]); }
        ss2 = wave_sum(ss2);
        const float rstd2 = rsqrtf(ss2 * (1.0f / 1024.0f) + RMS_EPS);
        float lg[16];
#pragma unroll
        for (int e = 0; e < 16; ++e) lg[e] = 0.f;
#pragma unroll
        for (int hlf = 0; hlf < 2; ++hlf) { const int c0 = hlf * 512 + ln * 8; float o[8];
#pragma unroll
            for (int j = 0; j < 8; ++j) { o[j] = xn[hlf * 8 + j] * rstd2 * par[1024 + c0 + j] * (1.0f + par[4096 + c0 + j]) + par[3072 + c0 + j];
#pragma unroll
                for (int eq = 0; eq < 4; ++eq) { const f32x4 w4 = *(const f32x4*)(wr_s + ((((hlf * 8 + j) * 4 + eq) * 64 + ln) << 2));
#pragma unroll
                    for (int e = 0; e < 4; ++e) lg[eq * 4 + e] += o[j] * w4[e]; } }
            const u32x2 ov = {f8pack4(o[0], o[1], o[2], o[3]), f8pack4(o[4], o[5], o[6], o[7])};
            stg((u32x2*)((unsigned char*)p.H() + (size_t)row * 1024 + c0), ov); }
        float r8[8], r4[4], r2[2], r1;
        { const bool b = (lane & 32) != 0;
#pragma unroll
          for (int i = 0; i < 8; ++i) { const float keep = b ? lg[i + 8] : lg[i], send = b ? lg[i] : lg[i + 8]; r8[i] = keep + shx<32>(send); } }
        { const bool b = (lane & 16) != 0;
#pragma unroll
          for (int i = 0; i < 4; ++i) { const float keep = b ? r8[i + 4] : r8[i], send = b ? r8[i] : r8[i + 4]; r4[i] = keep + shx<16>(send); } }
        { const bool b = (lane & 8) != 0;
#pragma unroll
          for (int i = 0; i < 2; ++i) { const float keep = b ? r4[i + 2] : r4[i], send = b ? r4[i] : r4[i + 2]; r2[i] = keep + shx<8>(send); } }
        { const bool b = (lane & 4) != 0; const float keep = b ? r2[1] : r2[0], send = b ? r2[0] : r2[1]; r1 = keep + shx<4>(send); }
        r1 += shx<2>(r1); r1 += shx<1>(r1);
        float mx = r1;
        mx = fmaxf(mx, shx<4>(mx)); mx = fmaxf(mx, shx<8>(mx)); mx = fmaxf(mx, shx<16>(mx)); mx = fmaxf(mx, shx<32>(mx));
        const float ex = __expf(r1 - mx);
        float se = ex;
        se += shx<4>(se); se += shx<8>(se); se += shx<16>(se); se += shx<32>(se);
        if ((lane & 3) == 0) { const int e = ((lane >> 5) & 1) * 8 + ((lane >> 4) & 1) * 4 + ((lane >> 3) & 1) * 2 + ((lane >> 2) & 1);
            stg(p.aff() + (size_t)row * 16 + e, ex * frcp(se)); }
#pragma unroll
        for (int i = 0; i < 2; ++i) ycur[i] = ynxt[i];
        xcur = xnxt;
    }
}

DEV unsigned shxu(unsigned v, int m) {
    const float f = __uint_as_float(v); float r;
    switch (m) { case 1: r = shx<1>(f); break; case 2: r = shx<2>(f); break; case 4: r = shx<4>(f); break; case 8: r = shx<8>(f); break; case 16: r = shx<16>(f); break; default: r = shx<32>(f); break; }
    return __float_as_uint(r);
}
#define TK_CX(a_, b_, desc_) do { const unsigned long long x_ = key[a_], y_ = key[b_]; const bool sw_ = (desc_) ? (x_ < y_) : (x_ > y_); key[a_] = sw_ ? y_ : x_; key[b_] = sw_ ? x_ : y_; } while (0)
template <int TJ> DEV void tk_step_sh(unsigned long long (&key)[4], int tid, bool desc4) {
    unsigned long long pk[4];
#pragma unroll
    for (int m = 0; m < 4; ++m) { const unsigned lo = __float_as_uint(shx<TJ>(__uint_as_float((unsigned)key[m]))), hi = __float_as_uint(shx<TJ>(__uint_as_float((unsigned)(key[m] >> 32))));
        pk[m] = ((unsigned long long)hi << 32) | lo; }
    const bool takemax = desc4 == ((tid & TJ) == 0);
#pragma unroll
    for (int m = 0; m < 4; ++m) { const unsigned long long x = key[m], y = pk[m]; key[m] = takemax ? (x > y ? x : y) : (x < y ? x : y); }
}
DEV void tk_step_lds(unsigned long long (&key)[4], unsigned long long* buf, int tid, int tj, bool active, bool desc4) {
    unsigned long long pk[4];
    __syncthreads();
    if (active) {
#pragma unroll
        for (int m = 0; m < 4; ++m) buf[tid * 4 + m] = key[m]; }
    __syncthreads();
#pragma unroll
    for (int m = 0; m < 4; ++m) pk[m] = active ? buf[(tid ^ tj) * 4 + m] : 0ull;
    const bool takemax = desc4 == ((tid & tj) == 0);
#pragma unroll
    for (int m = 0; m < 4; ++m) { const unsigned long long x = key[m], y = pk[m]; key[m] = takemax ? (x > y ? x : y) : (x < y ? x : y); }
}
DEV void topk_task(const Params& p, const SetDesc& sd, int task, char* shm) {
    const int tid = TID();
    const int e = task & 15, sl = task >> 4;
    unsigned long long* buf = (unsigned long long*)shm;
    const int T = 1 << sd.lgseq, cap = sd.cap;
    const int rbase = sl << sd.lgseq;
    const bool active = tid * 4 < T;
    unsigned long long key[4];
    __syncthreads();
#pragma unroll
    for (int m = 0; m < 4; ++m) { const int i = tid * 4 + m; const float a = active ? ldg(p.aff() + (size_t)(rbase + i) * 16 + e) : 0.f;
        key[m] = ((unsigned long long)__float_as_uint(a) << 32) | (unsigned)(0xFFFFFFFFu - (unsigned)i); }
    for (int k = 2; k <= T; k <<= 1) {
        const bool desc4 = ((tid * 4) & k) == 0;
        for (int j = k >> 1; j >= 256; j >>= 1) tk_step_lds(key, buf, tid, j >> 2, active, desc4);
        if (k >= 256) tk_step_sh<32>(key, tid, desc4);
        if (k >= 128) tk_step_sh<16>(key, tid, desc4);
        if (k >= 64) tk_step_sh<8>(key, tid, desc4);
        if (k >= 32) tk_step_sh<4>(key, tid, desc4);
        if (k >= 16) tk_step_sh<2>(key, tid, desc4);
        if (k >= 8) tk_step_sh<1>(key, tid, desc4);
        if (k >= 4) { TK_CX(0, 2, desc4); TK_CX(1, 3, desc4); TK_CX(0, 1, desc4); TK_CX(2, 3, desc4); }
        else { TK_CX(0, 1, true); TK_CX(2, 3, false); }
    }
    const int sbase = e * sd.rpe + sl * cap;
    if (active) {
#pragma unroll
        for (int m = 0; m < 4; ++m) { const int i = tid * 4 + m; const unsigned long long kv = key[m]; const int tok = (int)(0xFFFFFFFFu - (unsigned)(kv & 0xFFFFFFFFu));
            const int row = rbase + tok;
            if (i < cap) { stg(p.slot_token() + sbase + i, row); stg(p.slot_gate() + sbase + i, __uint_as_float((unsigned)(kv >> 32))); stg(p.token_slots() + (size_t)row * 16 + e, sbase + i); }
            else stg(p.token_slots() + (size_t)row * 16 + e, -1); } }
    if (sl == 0) { const int used = sd.nsamp * cap;
        for (int i = used + tid; i < sd.rpe; i += NTHREADS) { stg(p.slot_token() + e * sd.rpe + i, 0); stg(p.slot_gate() + e * sd.rpe + i, 0.f); } }
}
#undef TK_CX

struct SchedMoe {
    const bf16_t* A; const int* st; const bf16_t* W; int nRT, rpe, nN, wstride;
    DEV bool next(int i, GUnit& u) const { int pmx, pn; if (!tile_order(i, 16 * nRT, nN, pmx, pn)) return false; u.pm = pmx % nRT; u.aux = pmx / nRT; u.pn = pn; return true; }
    DEV int slot0(const GUnit& u) const { return u.aux * rpe + u.pm * 256; }
    DEV const bf16_t* a_base(const GUnit&) const { return A; }
    DEV int grow(const GUnit& u, int i) const { return st ? ldg(st + slot0(u) + i) : slot0(u) + i; }
    DEV const bf16_t* b_base(const GUnit& u) const { return W + (size_t)u.aux * wstride + (size_t)u.pn * 256 * 512; }
};
DEV void phase_moe_gu(const Params& p, const SetDesc& sd, int layer, char* shm) {
    SchedMoe S; S.A = p.H(); S.st = p.slot_token(); S.W = p.WguT() + (size_t)layer * 16 * 2048 * 512; S.nRT = sd.rpe / 256; S.rpe = sd.rpe; S.nN = 8; S.wstride = 2048 * 512;
    unsigned char* hb = (unsigned char*)p.HID();
    gemm_stream<true, 512, 512, 512, true>(shm, S, [=](const GUnit& u, const f32x4 (&acc)[2][2][4][2], int r0, int c0) {
#pragma unroll
        for (int ai = 0; ai < 2; ++ai)
#pragma unroll
            for (int m = 0; m < 4; ++m) { f32x4 h0, h1; const f32x4 a0 = acc[ai][0][m][0] * F8_WINV, a1 = acc[ai][0][m][1] * F8_WINV, b0 = acc[ai][1][m][0] * F8_WINV, b1 = acc[ai][1][m][1] * F8_WINV;
#pragma unroll
                for (int j = 0; j < 4; ++j) { h0[j] = a0[j] * sigmoidf_(a0[j]) * b0[j]; h1[j] = a1[j] * sigmoidf_(a1[j]) * b1[j]; }
                const u32x2 hv = {f8pack4(h0[0], h0[1], h0[2], h0[3]), f8pack4(h1[0], h1[1], h1[2], h1[3])};
                stg((u32x2*)(hb + ((size_t)S.slot0(u) + r0 + ai * 128 + m * 16) * 1024 + u.pn * 128 + c0), hv); } });
}
DEV void phase_moe_down(const Params& p, const SetDesc& sd, int layer, char* shm) {
    SchedMoe S; S.A = p.HID(); S.st = nullptr; S.W = p.WdT() + (size_t)layer * 16 * 1024 * 512; S.nRT = sd.rpe / 256; S.rpe = sd.rpe; S.nN = 4; S.wstride = 1024 * 512;
    unsigned char* yb = (unsigned char*)p.YE(); const float* gt = p.slot_gate();
    gemm_stream<true, 512, 512, 512, true>(shm, S, [=](const GUnit& u, const f32x4 (&acc)[2][2][4][2], int r0, int c0) {
#pragma unroll
        for (int ai = 0; ai < 2; ++ai) {
            float gv[4];
#pragma unroll
            for (int m = 0; m < 4; ++m) gv[m] = ldg(gt + (size_t)S.slot0(u) + r0 + ai * 128 + m * 16) * (F8_WINV * YE_SCALE);
#pragma unroll
            for (int m = 0; m < 4; ++m) { const size_t sl = (size_t)S.slot0(u) + r0 + ai * 128 + m * 16; const float g = gv[m];
                unsigned char* o = yb + sl * 1024 + u.pn * 256 + c0;
#pragma unroll
                for (int hf = 0; hf < 2; ++hf) { const f32x4 a = acc[ai][hf][m][0] * g, b = acc[ai][hf][m][1] * g;
                    const u32x2 ov = {f8pack4(a[0], a[1], a[2], a[3]), f8pack4(b[0], b[1], b[2], b[3])}; stg((u32x2*)(o + hf * 128), ov); } } } });
}

DEV void compact4(const int (&sl)[16], int (&c)[4], int& n) {
    n = 0; c[0] = -1; c[1] = -1; c[2] = -1; c[3] = -1;
#pragma unroll
    for (int e = 0; e < 16; ++e) if (sl[e] >= 0) { c[0] = (n == 0) ? sl[e] : c[0]; c[1] = (n == 1) ? sl[e] : c[1]; c[2] = (n == 2) ? sl[e] : c[2]; c[3] = (n == 3) ? sl[e] : c[3]; ++n; }
}
template <bool DST_F32> DEV void phase_combine(const Params& p, const SetDesc& sd, int layer, char* shm) {
    const int tid = TID(), lane = tid & 63, wv = tid >> 6;
    const float* g3 = p.norm_gain + ((size_t)layer * 4 + 3) * 1024;
    const bf16_t* xsb = xbf_base(p, sd); void* xdb = DST_F32 ? (void*)xout_f32(p, sd) : (void*)xbf_base(p, sd);
    const int stride = 8; const int rpb_ = (sd.nrows + (int)gridDim.x - 1) / (int)gridDim.x; const int row_end = min(sd.nrows, ((int)blockIdx.x + 1) * rpb_);
    int row = __builtin_amdgcn_readfirstlane((int)blockIdx.x * rpb_ + wv);
    float* par = (float*)shm;
    __syncthreads();
    { const float* mdb = mod_row(p, sd, layer, min((int)blockIdx.x * rpb_, sd.nrows - 1)); stage_params(par, g3, mdb + 5120, nullptr, nullptr, nullptr); }
    __syncthreads();
    int raw[16]; int cc[4], cn[4]; int nc = 0, nn = 0;
    u32x2 mc[4][2], mn[4][2]; XRow<true> xc, xn;
#define CMB_SLOTS(r_) do { _Pragma("unroll") for (int e = 0; e < 16; ++e) raw[e] = ldg(p.token_slots() + (size_t)(r_) * 16 + e); } while (0)
#define CMB_DATA(r_, c_, n_, m_, x_) do { _Pragma("unroll") for (int k = 0; k < 4; ++k) { \
            if (k < (n_)) { const unsigned char* yr = (const unsigned char*)p.YE() + (size_t)(c_)[k] * 1024 + lane * 8; (m_)[k][0] = ldg((const u32x2*)yr); (m_)[k][1] = ldg((const u32x2*)(yr + 512)); } \
            else { (m_)[k][0] = (u32x2){0u, 0u}; (m_)[k][1] = (u32x2){0u, 0u}; } } \
        (x_).load(xsb, (r_), lane); } while (0)
    if (row < row_end) { CMB_SLOTS(row); compact4(raw, cc, nc); CMB_DATA(row, cc, nc, mc, xc); if (row + stride < row_end) CMB_SLOTS(row + stride); }
    for (; row < row_end; row += stride) {
        const int rn = row + stride;
        if (rn < row_end) { compact4(raw, cn, nn); CMB_DATA(rn, cn, nn, mn, xn); if (rn + stride < row_end) CMB_SLOTS(rn + stride); }
        float y[16];
#pragma unroll
        for (int j = 0; j < 16; ++j) y[j] = 0.f;
        if (nc <= 4) {
#pragma unroll
            for (int k = 0; k < 4; ++k)
                if (k < nc) {
#pragma unroll
                    for (int hlf = 0; hlf < 2; ++hlf) { const f32x4 a = f8x4_f32(mc[k][hlf].x), b = f8x4_f32(mc[k][hlf].y);
#pragma unroll
                        for (int j = 0; j < 4; ++j) { y[hlf * 8 + j] += a[j]; y[hlf * 8 + 4 + j] += b[j]; } } }
        } else {
            for (int e = 0; e < 16; ++e) { const int sl_ = ldg(p.token_slots() + (size_t)row * 16 + e);
                if (sl_ >= 0) { const unsigned char* yr = (const unsigned char*)p.YE() + (size_t)sl_ * 1024 + lane * 8;
#pragma unroll
                    for (int hlf = 0; hlf < 2; ++hlf) { const u32x2 m = ldg((const u32x2*)(yr + hlf * 512)); const f32x4 a = f8x4_f32(m.x), b = f8x4_f32(m.y);
#pragma unroll
                        for (int j = 0; j < 4; ++j) { y[hlf * 8 + j] += a[j]; y[hlf * 8 + 4 + j] += b[j]; } } } }
        }
        float ss = 0.f;
#pragma unroll
        for (int j = 0; j < 16; ++j) ss += y[j] * y[j];
        ss = wave_sum(ss);
        const float rstd = rsqrtf(ss * (YE_INV * YE_INV / 1024.0f) + RMS_EPS) * YE_INV;
#pragma unroll
        for (int hlf = 0; hlf < 2; ++hlf) { f32x4 xv[2];
#pragma unroll
            for (int q = 0; q < 2; ++q) { const int c0 = hlf * 512 + lane * 8 + q * 4; xv[q] = xc.get(hlf * 2 + q);
#pragma unroll
                for (int j = 0; j < 4; ++j) xv[q][j] += par[1024 + c0 + j] * (y[hlf * 8 + q * 4 + j] * rstd * par[c0 + j]); }
            xrow_store8<!DST_F32>(xdb, row, hlf * 512 + lane * 8, xv[0], xv[1]); }
        nc = nn;
#pragma unroll
        for (int k = 0; k < 4; ++k) { cc[k] = cn[k]; mc[k][0] = mn[k][0]; mc[k][1] = mn[k][1]; }
        xc = xn;
    }
#undef CMB_SLOTS
#undef CMB_DATA
}

constexpr int WQ_WORD0 = 4096;
template <class F> DEV void wq_run(const Params& p, int qidx, int ntasks, char* shm, F&& task) {
    unsigned* ctr = p.bar() + WQ_WORD0 + 64 * qidx;
    volatile int* slot = (volatile int*)(shm + 131072 + 64);
    const int tid = TID();
    int cur = blockIdx.x;
    while (cur < ntasks) {
        unsigned pend = 0u;
        if (tid == 0) pend = atomicAdd(ctr, 1u);
        task(cur);
        __syncthreads();
        if (tid == 0) *slot = (int)gridDim.x + (int)pend;
        __syncthreads();
        cur = *slot;
    }
}

template <int PH> DEV void do_phase(const Params& p, int layer, int is_ctx, int grp, char* shm) {
    const SetDesc sd = make_set(is_ctx, grp);
    if constexpr (PH == -1) phase_prologue(p, shm);
    if constexpr (PH == 0) { if (layer == 0) phase_norm1<false>(p, sd, layer, shm); else phase_norm1<true>(p, sd, layer, shm); }
    if constexpr (PH == 1) phase_proj_a(p, sd, layer, shm);
    const int qbase = ((layer * 3 + (is_ctx ? 0 : grp + 1)) * 13 + (PH < 0 ? 0 : PH)) * 2;
    if constexpr (PH == 2) {
        { const int nt = sd.nsamp * 4 * sd.ntb, G_ = (int)gridDim.x; int t = blockIdx.x;
          if (t < nt) { PrefA f; stepA_issue(f, p, sd, t); for (; t < nt; t += G_) mlstm_stepA_task(p, sd, layer, t, t + G_ < nt ? t + G_ : -1, f, shm); } }
        if (!(is_ctx && layer == 1)) phase_pool(p, sd); }
    if constexpr (PH == 3) {
        for (int t = blockIdx.x; t < sd.nsamp * 32; t += gridDim.x) mlstm_stepB_task(p, sd, t);
        if (!(is_ctx && layer == 1)) {
            const int nq = (is_ctx ? (CTX / 64) : ROWS) / 2;
            wq_run(p, qbase, sd.nsamp * nq * 4, shm, [&](int t) { na_task(p, sd, layer, t / (nq * 4), (t >> 2) % nq, t & 3, shm); });
        }
    }
    if constexpr (PH == 4) { const int nt = sd.nsamp * 4 * sd.ntb, G_ = (int)gridDim.x; int t = blockIdx.x;
        if (t < nt) { PrefC f; stepC_issue(f, p, sd, t); for (; t < nt; t += G_) mlstm_stepC_task(p, sd, layer, t, t + G_ < nt ? t + G_ : -1, f, shm); } }
    if constexpr (PH == 6) phase_merge(p, sd, layer, shm);
    if constexpr (PH == 7) phase_outproj(p, sd, layer, shm);
    if constexpr (PH == 8) { if (layer == 0) phase_postmix<false>(p, sd, layer, shm); else phase_postmix<true>(p, sd, layer, shm); }
    if constexpr (PH == 9) { for (int t = blockIdx.x; t < sd.nsamp * 16; t += gridDim.x) topk_task(p, sd, t, shm); }
    if constexpr (PH == 10) phase_moe_gu(p, sd, layer, shm);
    if constexpr (PH == 11) phase_moe_down(p, sd, layer, shm);
    if constexpr (PH == 12) { if (layer == 0) phase_combine<false>(p, sd, layer, shm); else phase_combine<true>(p, sd, layer, shm); }
}

#ifndef CPU_EMU
template <int PH> __global__ void __launch_bounds__(NTHREADS, 2) k_phase(Params p, int layer, int is_ctx, int grp) {
    DYN_LDS(shm);
    do_phase<PH>(p, layer, is_ctx, grp, shm);
}
#ifndef DBL_MASK
#define DBL_MASK 0
#endif
#define RUNPH(PH) do { do_phase<PH>(p, layer, is_ctx, grp, shm); xcd_barrier(bar); if ((DBL_MASK >> (PH)) & 1) { do_phase<PH>(p, layer, is_ctx, grp, shm); xcd_barrier(bar); } } while (0)
__global__ void __launch_bounds__(NTHREADS, 2) k_mega(Params p) {
    DYN_LDS(shm);
    uint4* xbw = (uint4*)(shm + 131072);
    if (threadIdx.x == 0) *xbw = make_uint4(0u, 0u, 0u, 0u);
    __syncthreads();
    XcdBarrier bar = xcd_barrier_post(p.bar(), (volatile LAS unsigned*)xbw);
    do_phase<-1>(p, 0, 0, 0, shm);
    xcd_barrier(bar);
    for (int layer = 0; layer < 2; ++layer)
        for (int si = 0; si <= NG; ++si) {
            const int is_ctx = si == 0 ? 1 : 0, grp = si == 0 ? 0 : si - 1;
            RUNPH(0); RUNPH(1); RUNPH(2);
            if (is_ctx && layer == 1) { do_phase<3>(p, layer, is_ctx, grp, shm); continue; }
            RUNPH(3); RUNPH(4); RUNPH(6); RUNPH(7); RUNPH(8); RUNPH(9); RUNPH(10); RUNPH(11);
            do_phase<12>(p, layer, is_ctx, grp, shm);
        }
}
#endif
}

static Params make_params(void* const* d_in, void* d_out, void* d_ws) {
    Params p{};
    p.x = (const float*)d_in[0]; p.c = (const float*)d_in[1]; p.ctx = (const float*)d_in[2]; p.c_ctx = (const float*)d_in[3];
    p.norm_gain = (const float*)d_in[4]; p.ada_w = (const float*)d_in[5]; p.ada_b = (const float*)d_in[6]; p.w_in = (const float*)d_in[7];
    p.gate_bias = (const float*)d_in[8]; p.pool_w = (const float*)d_in[9]; p.pool_scale = (const float*)d_in[10]; p.rpb = (const float*)d_in[11];
    p.w_branch = (const float*)d_in[12]; p.w_out = (const float*)d_in[13]; p.router_w = (const float*)d_in[14];
    p.w_gate = (const float*)d_in[15]; p.w_up = (const float*)d_in[16]; p.w_down = (const float*)d_in[17];
    p.out = (float*)d_out; p.ws = (char*)d_ws;
    return p;
}

#ifdef CPU_EMU
int emu_cfg_B = CFG_B, emu_cfg_ROWS = CFG_ROWS, emu_cfg_CTX = CFG_CTX;
const char* g_dumpdir = "data";
static void* g_ws = nullptr;
static void dump_buf(const char* name, int layer, int is_ctx, int grp, const void* ptr, size_t bytes) {
    char nm[512]; snprintf(nm, sizeof nm, "%s/d_L%d_%s%d_%s.bin", g_dumpdir, layer, is_ctx ? "c" : "g", grp, name);
    FILE* f = fopen(nm, "wb"); fwrite(ptr, 1, bytes, f); fclose(f);
}
static void emu_hook(const Params& p, int layer, int is_ctx, int grp, int ph) {
    const size_t Rn = is_ctx ? RC : RL;
    if (ph == 0) dump_buf("H", layer, is_ctx, grp, p.H(), Rn * 1024 * 2);
    if (ph == 1) dump_buf("PROJ", layer, is_ctx, grp, is_ctx ? p.PROJc() : p.PROJa(), Rn * PWA * 2);
    if (ph == 2) dump_buf("Pb", layer, is_ctx, grp, p.Pb(), Rn * 512 * 2);
    if (ph == 3) dump_buf("Nb", layer, is_ctx, grp, p.Nb(), Rn * 512 * 2);
    if (ph == 4) dump_buf("Mb", layer, is_ctx, grp, p.Mb(), Rn * 512 * 2);
    if (ph == 1) dump_buf("BG", layer, is_ctx, grp, p.BG(), Rn * NBG);
    if (ph == 6) dump_buf("MERGED", layer, is_ctx, grp, p.MERGED(), Rn * 1024 * 2);
    if (ph == 7) dump_buf("Y", layer, is_ctx, grp, p.Y(), Rn * 1024 * 2);
    if (ph == 8) { dump_buf("H2", layer, is_ctx, grp, p.H(), Rn * 1024 * 2); dump_buf("aff", layer, is_ctx, grp, p.aff(), Rn * 16 * 4); }
}
void emu_dump(const char* dir) {
    char nm[512]; snprintf(nm, sizeof nm, "%s/d_mod.bin", dir);
    FILE* f = fopen(nm, "wb"); fwrite((char*)g_ws + WSL.mod, 1, (size_t)2 * (NB + 1) * 6144 * 4, f); fclose(f);
    snprintf(nm, sizeof nm, "%s/d_ctxs.bin", dir);
    f = fopen(nm, "wb"); fwrite((char*)g_ws + WSL.ctxs, 1, (size_t)NB * CTX * 1024 * 2, f); fclose(f);
}
template <int PH> static void emu_run_phase(const Params& p, int layer, int is_ctx, int grp, int nblocks) {
    emu_launch_lambda([=]() { do_phase<PH>(p, layer, is_ctx, grp, emu_blk->smem); }, nblocks, NTHREADS, LDS_BYTES);
    if (PH >= 0) emu_hook(p, layer, is_ctx, grp, PH);
    printf("phase %d layer %d ctx %d grp %d done\n", PH, layer, is_ctx, grp); fflush(stdout);
}
#define LAUNCH_PHASE(PH) emu_run_phase<PH>(p, layer, is_ctx, grp, nblocks)
#else
#define LAUNCH_PHASE(PH) hipLaunchKernelGGL((k_phase<PH>), dim3(nblocks), dim3(NTHREADS), LDS_BYTES, stream, p, layer, is_ctx, grp)
#define SETATTR(PH) (void)hipFuncSetAttribute((const void*)k_phase<PH>, hipFuncAttributeMaxDynamicSharedMemorySize, LDS_BYTES)
#endif

extern "C" void kernel_launch(void* const* d_in, const int* in_sizes, int n_in, void* d_out, int out_size, void* d_ws, size_t ws_size, hipStream_t stream) {
    (void)in_sizes; (void)n_in; (void)out_size;
    if (ws_size < WSL.total) return;
    Params p = make_params(d_in, d_out, d_ws);
#ifdef CPU_EMU
    g_ws = d_ws;
    memset(d_ws, 0xFF, WSL.total);
    memset((char*)d_ws + WSL.bar, 0, 65536);
    const int nblocks = 16;
#else
    const int nblocks = 256;
#if MK_ONE_LAUNCH
    static int grid = 0;
    if (!grid) {
        (void)hipFuncSetAttribute((const void*)k_mega, hipFuncAttributeMaxDynamicSharedMemorySize, LDS_BYTES);
        int dev = 0, cus = 0, per_cu = 0;
        (void)hipGetDevice(&dev);
        (void)hipDeviceGetAttribute(&cus, hipDeviceAttributeMultiprocessorCount, dev);
        (void)hipOccupancyMaxActiveBlocksPerMultiprocessor(&per_cu, (const void*)k_mega, NTHREADS, LDS_BYTES);
        if (per_cu > 1) per_cu = 1;
        grid = cus * per_cu;
        if (grid > 256) grid = 256;
    }
    if (grid <= 0) return;
    (void)hipMemsetAsync(p.bar(), 0, 65536, stream);
    hipLaunchKernelGGL(k_mega, dim3(grid), dim3(NTHREADS), LDS_BYTES, stream, p);
    return;
#else
    static bool attr_done = false;
    if (!attr_done) { SETATTR(-1); SETATTR(0); SETATTR(1); SETATTR(2); SETATTR(3); SETATTR(4); SETATTR(5); SETATTR(6); SETATTR(7); SETATTR(8); SETATTR(9); SETATTR(10); SETATTR(11); SETATTR(12); attr_done = true; }
#endif
#endif
    { const int layer = 0, is_ctx = 0, grp = 0; LAUNCH_PHASE(-1); }
    for (int layer = 0; layer < 2; ++layer)
        for (int si = 0; si <= NG; ++si) {
            const int is_ctx = si == 0 ? 1 : 0, grp = si == 0 ? 0 : si - 1;
            LAUNCH_PHASE(0); LAUNCH_PHASE(1); LAUNCH_PHASE(2); LAUNCH_PHASE(3);
            if (is_ctx && layer == 1) continue;
            LAUNCH_PHASE(4); LAUNCH_PHASE(6); LAUNCH_PHASE(7); LAUNCH_PHASE(8); LAUNCH_PHASE(9); LAUNCH_PHASE(10); LAUNCH_PHASE(11); LAUNCH_PHASE(12);
        }
}
```

```cpp
#ifdef CPU_EMU
#include "emu.h"
#define DYN_LDS(p) char* p = emu_blk->smem
#define WAIT_V(n)
#define WAIT_L(n)
#define HIDE(v)
#define CBAR()
#else
#include <hip/hip_runtime.h>
#define DYN_LDS(p) extern __shared__ __attribute__((aligned(16))) char p[]
#define WAIT_V(n) asm volatile("s_waitcnt vmcnt(" #n ")" ::: "memory")
#define WAIT_L(n) asm volatile("s_waitcnt lgkmcnt(" #n ")" ::: "memory")
#define HIDE(v) asm volatile("" : "+v"(v))
#define CBAR() asm volatile("" ::: "memory")
#endif
#include <stdint.h>
#include <stddef.h>

#ifndef CFG_B
#define CFG_B 32
#define CFG_ROWS 32
#define CFG_CTX 256
#define CFG_G 16
#endif
#ifndef MK_ONE_LAUNCH
#define MK_ONE_LAUNCH 1
#endif

#define DEV __device__ __forceinline__
typedef short s16x4 __attribute__((ext_vector_type(4)));
#ifdef CPU_EMU
#define TR16(ptr) emu_tr16((const void*)(ptr))
#else
typedef __attribute__((address_space(3))) s16x4 lds_s16x4;
#define TR16(ptr) __builtin_amdgcn_ds_read_tr16_b64_v4i16((lds_s16x4*)(ptr))
#endif
#ifdef CPU_EMU
#define TID() (threadIdx.x)
#else
#define TID() ({ int t_ = threadIdx.x; asm volatile("" : "+v"(t_)); t_; })
#endif

typedef unsigned short bf16_t;
typedef short bf16x8 __attribute__((ext_vector_type(8)));
typedef float f32x4 __attribute__((ext_vector_type(4)));
typedef unsigned u32x2 __attribute__((ext_vector_type(2)));
typedef unsigned u32x4 __attribute__((ext_vector_type(4)));

namespace {
constexpr int D = 1024, NB = CFG_B, ROWS = CFG_ROWS, SEQ = ROWS * 64, CTX = CFG_CTX, G = CFG_G, NG = NB / G;
constexpr int RL = G * SEQ, RC = NB * CTX, RMAX = RL > RC ? RL : RC;
constexpr int PWA = 3840, NBG = 3072, PWT = PWA + NBG, PWSRC = 6672, C_SPLIT = 3600;
constexpr int C_QM = 0, C_KM = 256, C_PU = 512, C_GM = 1024, C_PADA = 1040, C_F8 = 1280, C_QN = 1280, C_KN = 1792, C_VM = 2304, C_OM = 2816, C_VN = 3328;
constexpr int proj_col(int n) { return n < 512 ? n : n < 1536 ? n + 1792 : n < 1552 ? n - 512 : n < 2064 ? n - 1040 : n < 3088 ? n - 784 : n + 240; }
static_assert(proj_col(512) == C_VM && proj_col(1024) == C_OM && proj_col(1536) == C_GM && proj_col(1552) == C_PU && proj_col(2064) == C_QN && proj_col(2576) == C_KN && proj_col(3088) == C_VN && proj_col(3599) == PWA - 1, "projection column map");
constexpr int NTBL = SEQ / 128, NTBC = CTX / 128;
constexpr int ilog2(int x) { return x <= 1 ? 0 : 1 + ilog2(x >> 1); }
constexpr int LGSEQ = ilog2(SEQ), LGCTX = ilog2(CTX);
static_assert((1 << LGSEQ) == SEQ && (1 << LGCTX) == CTX, "sequence lengths must be powers of two");
constexpr int cdiv(int a, int b) { return (a + b - 1) / b; }
constexpr int RPE_L = cdiv(G * (SEQ / 8), 256) * 256, RPE_C = cdiv(NB * (CTX / 8), 256) * 256, RPE_MAX = RPE_L > RPE_C ? RPE_L : RPE_C;
constexpr int NSLOT = 16 * RPE_MAX;
constexpr int NTHREADS = 512;
constexpr int GT_MAXU = 12;
constexpr int LDS_BYTES = 131072 + 256 + GT_MAXU * 1024;
constexpr int NST_L = G * 4 * 2 * NTBL, NST_C = NB * 4 * 2 * NTBC, NST = NST_L > NST_C ? NST_L : NST_C;
constexpr int NCI = NB * 4 * 2;
constexpr float RMS_EPS = 1e-6f;

struct WsLayout { size_t bar, WinT, WbT, WoT, WguT, WdT, mod, rope, ctxs, xb, PROJc, CiC, Cin_, Cim, H, H8, PROJa, Sst, Cin, Mb, Pb, Nb, Sn, Ssc, Cn, Cm, aff, slot_token, slot_gate, token_slots, HID, YE, BG, MERGED, Y, total; };
constexpr size_t al(size_t x) { return (x + 255) / 256 * 256; }
constexpr size_t smax(size_t a, size_t b) { return a > b ? a : b; }
constexpr WsLayout make_layout() {
    WsLayout L{}; size_t o = 0;
    L.bar = o; o += al(65536);
    L.WinT = o; o += al((size_t)2 * PWT * 1024 * 2);
    L.WbT = o; o += al((size_t)2 * 3 * 1024 * 512 * 2);
    L.WoT = o; o += al((size_t)2 * 1024 * 1024 * 2);
    L.WguT = o; o += al((size_t)2 * 16 * 2048 * 1024);
    L.WdT = o; o += al((size_t)2 * 16 * 1024 * 1024);
    L.mod = o; o += al((size_t)2 * (NB + 1) * 6144 * 4);
    L.rope = o; o += al((size_t)(ROWS + 64) * 16 * 2 * 4);
    L.ctxs = o; o += al((size_t)NB * CTX * 1024 * 2);
    L.xb = o; o += al((size_t)NB * SEQ * 1024 * 2);
    L.PROJc = o; o += al((size_t)RC * PWA * 2);
    L.CiC = o; o += al((size_t)NCI * 8192 * 4);
    L.Cin_ = o; o += al((size_t)NCI * 64 * 4);
    L.Cim = o; o += al((size_t)NCI * 4 * 4);
    L.H = o; o += al((size_t)RMAX * 1024 * 2);
    L.H8 = o; o += al((size_t)RMAX * 1024);
    const size_t x0 = o;
    L.PROJa = o; o += al((size_t)RMAX * PWA * 2);
    L.Sst = o; o += al((size_t)NST * 8192 * 4);
    L.Cin = o; o += al((size_t)NST * 8192 * 2);
    const size_t hid = al((size_t)NSLOT * 1024 * 2);
    o = x0 + smax(o - x0, 2 * hid);
    L.HID = x0; L.YE = x0 + hid;
    L.Mb = o; o += al((size_t)RMAX * 512 * 2);
    L.Pb = o; o += al((size_t)RMAX * 512 * 2);
    L.Nb = o; o += al((size_t)RMAX * 512 * 2);
    L.MERGED = L.H; L.Y = L.Mb;
    L.BG = o; o += al((size_t)RMAX * NBG);
    L.Sn = o; o += al((size_t)NST * 64 * 4);
    L.Ssc = o; o += al((size_t)NST * 4 * 4);
    L.Cn = o; o += al((size_t)NST * 64 * 4);
    L.Cm = o; o += al((size_t)NST * 4 * 4);
    L.aff = o; o += al((size_t)RMAX * 16 * 4);
    L.slot_token = o; o += al((size_t)NSLOT * 4);
    L.slot_gate = o; o += al((size_t)NSLOT * 4);
    L.token_slots = o; o += al((size_t)RMAX * 16 * 4);
    L.total = o;
    return L;
}
constexpr WsLayout WSL = make_layout();
static_assert(CFG_B != 32 || WSL.total <= ((size_t)1 << 30), "workspace budget");

struct Params {
    const float *x, *c, *ctx, *c_ctx, *norm_gain, *ada_w, *ada_b, *w_in, *gate_bias, *pool_w, *pool_scale, *rpb, *w_branch, *w_out, *router_w, *w_gate, *w_up, *w_down;
    float* out;
    char* ws;
#ifdef CPU_EMU
#define WSF(T, name) __device__ __host__ __forceinline__ T* name() const { return (T*)(ws + WSL.name); }
#else
#if defined(__HIP_DEVICE_COMPILE__)
#define WSF(T, name) __device__ __host__ __forceinline__ T* name() const { char* w_ = ws; asm volatile("" : "+s"(w_)); return (T*)(__attribute__((address_space(1))) T*)(w_ + WSL.name); }
#else
#define WSF(T, name) __device__ __host__ __forceinline__ T* name() const { return (T*)(ws + WSL.name); }
#endif
#endif
    WSF(unsigned, bar) WSF(bf16_t, WinT) WSF(bf16_t, WbT) WSF(bf16_t, WoT) WSF(bf16_t, WguT) WSF(bf16_t, WdT)
    WSF(float, mod) WSF(float, rope) WSF(bf16_t, ctxs) WSF(bf16_t, xb) WSF(bf16_t, PROJc) WSF(float, CiC) WSF(float, Cin_) WSF(float, Cim)
    WSF(bf16_t, H) WSF(unsigned char, H8) WSF(bf16_t, PROJa) WSF(bf16_t, Sst) WSF(bf16_t, Cin) WSF(bf16_t, Mb) WSF(bf16_t, Pb) WSF(bf16_t, Nb)
    WSF(float, Sn) WSF(float, Ssc) WSF(float, Cn) WSF(float, Cm) WSF(float, aff) WSF(int, slot_token) WSF(float, slot_gate) WSF(int, token_slots)
    WSF(bf16_t, HID) WSF(bf16_t, YE) WSF(unsigned char, BG) WSF(bf16_t, MERGED) WSF(bf16_t, Y)
#undef WSF
};

struct SetDesc { int is_ctx, nrows, samp0, nsamp, lgseq, ntb, cap, rpe; };
DEV SetDesc make_set(int is_ctx, int grp) {
    SetDesc s;
    s.is_ctx = is_ctx;
    if (is_ctx) { s.nrows = RC; s.samp0 = 0; s.nsamp = NB; s.lgseq = LGCTX; s.ntb = NTBC; s.cap = CTX / 8; s.rpe = RPE_C; }
    else { s.nrows = RL; s.samp0 = grp * G; s.nsamp = G; s.lgseq = LGSEQ; s.ntb = NTBL; s.cap = SEQ / 8; s.rpe = RPE_L; }
    return s;
}

#ifdef CPU_EMU
#define GAS
#else
#define GAS __attribute__((address_space(1)))
#endif
template <class T> DEV T ldg(const T* p) { return *(const GAS T*)p; }
template <class T> DEV void stg(T* p, const T& v) { *(GAS T*)p = v; }
DEV float bf2f(bf16_t v) { return __uint_as_float(((unsigned)v) << 16); }
DEV bf16_t f2bf(float f) { unsigned u = __float_as_uint(f); u += 0x7FFFu + ((u >> 16) & 1u); return (bf16_t)(u >> 16); }
#if defined(__HIP_DEVICE_COMPILE__)
typedef __bf16 bf16n2 __attribute__((ext_vector_type(2)));
typedef float f32n2 __attribute__((ext_vector_type(2)));
DEV unsigned pack2(float lo, float hi) { f32n2 v = {lo, hi}; bf16n2 r = __builtin_convertvector(v, bf16n2); return __builtin_bit_cast(unsigned, r); }
#else
DEV unsigned pack2(float lo, float hi) { return (unsigned)f2bf(lo) | ((unsigned)f2bf(hi) << 16); }
#endif
DEV float lo16(unsigned u) { return __uint_as_float(u << 16); }
DEV float hi16(unsigned u) { return __uint_as_float(u & 0xFFFF0000u); }
#if defined(__HIP_DEVICE_COMPILE__)
DEV float frcp(float x) { return __builtin_amdgcn_rcpf(x); }
#else
DEV float frcp(float x) { return 1.0f / x; }
#endif
#if defined(__HIP_DEVICE_COMPILE__)
DEV float sigmoidf_(float x) { return __builtin_amdgcn_rcpf(1.0f + __expf(-x)); }
#else
DEV float sigmoidf_(float x) { return 1.0f / (1.0f + __expf(-x)); }
#endif
DEV float logsigmoidf_(float x) { return fminf(x, 0.0f) - __logf(1.0f + __expf(-fabsf(x))); }
template <int M> DEV float shx(float v) {
#if defined(__HIP_DEVICE_COMPILE__)
    const unsigned u = __builtin_bit_cast(unsigned, v);
    if constexpr (M == 1) return __builtin_bit_cast(float, __builtin_amdgcn_update_dpp(u, u, 0xB1, 0xF, 0xF, false));
    else if constexpr (M == 2) return __builtin_bit_cast(float, __builtin_amdgcn_update_dpp(u, u, 0x4E, 0xF, 0xF, false));
    else if constexpr (M == 4) { const unsigned t = __builtin_amdgcn_update_dpp(u, u, 0x141, 0xF, 0xF, false);
        return __builtin_bit_cast(float, __builtin_amdgcn_update_dpp(t, t, 0x1B, 0xF, 0xF, false)); }
    else if constexpr (M == 8) return __builtin_bit_cast(float, __builtin_amdgcn_update_dpp(u, u, 0x128, 0xF, 0xF, false));
    else if constexpr (M == 16) { const auto r = __builtin_amdgcn_permlane16_swap(u, u, false, false); return __builtin_bit_cast(float, (threadIdx.x & 16) ? r[0] : r[1]); }
    else { const auto r = __builtin_amdgcn_permlane32_swap(u, u, false, false); return __builtin_bit_cast(float, (threadIdx.x & 32) ? r[0] : r[1]); }
#else
    return __shfl_xor(v, M);
#endif
}
DEV float wave_sum(float v) { v += shx<32>(v); v += shx<16>(v); v += shx<8>(v); v += shx<4>(v); v += shx<2>(v); v += shx<1>(v); return v; }
DEV bf16x8 mk8(u32x2 lo, u32x2 hi) { u32x4 v = {lo.x, lo.y, hi.x, hi.y}; return __builtin_bit_cast(bf16x8, v); }
DEV bf16x8 mk8(u32x4 v) { return __builtin_bit_cast(bf16x8, v); }
DEV bf16x8 mk8(s16x4 lo, s16x4 hi) { return __builtin_shufflevector(lo, hi, 0, 1, 2, 3, 4, 5, 6, 7); }
DEV f32x4 mfma16(bf16x8 a, bf16x8 b, f32x4 c) { return __builtin_amdgcn_mfma_f32_16x16x32_bf16(a, b, c, 0, 0, 0); }
DEV unsigned f8enc1(float x) {
    const unsigned sgn = x < 0.f ? 0x80u : 0u; float a = x < 0.f ? -x : x; if (!(a < 448.f)) a = 448.f;
    if (a < 0.015625f) { const int q = (int)(a * 512.f + 0.5f); const float r = a * 512.f; int qq = q; if ((float)q - r == 0.5f && (q & 1)) qq = q - 1; return sgn | (unsigned)qq; }
    int e = 0; float m = a; while (m >= 2.f) { m *= 0.5f; ++e; } while (m < 1.f) { m *= 2.f; --e; }
    const float r = (m - 1.f) * 8.f; int q = (int)(r + 0.5f); if ((float)q - r == 0.5f && (q & 1)) --q;
    if (q == 8) { q = 0; ++e; }
    return sgn | (unsigned)((e + 7) << 3) | (unsigned)q;
}
#if defined(__HIP_DEVICE_COMPILE__)
DEV unsigned f8pack4(float a, float b, float c, float d) {
    a = __builtin_amdgcn_fmed3f(a, -448.f, 448.f); b = __builtin_amdgcn_fmed3f(b, -448.f, 448.f); c = __builtin_amdgcn_fmed3f(c, -448.f, 448.f); d = __builtin_amdgcn_fmed3f(d, -448.f, 448.f);
    int w = 0; w = __builtin_amdgcn_cvt_pk_fp8_f32(a, b, w, false); w = __builtin_amdgcn_cvt_pk_fp8_f32(c, d, w, true); return (unsigned)w; }
#else
DEV unsigned f8pack4(float a, float b, float c, float d) { return f8enc1(a) | (f8enc1(b) << 8) | (f8enc1(c) << 16) | (f8enc1(d) << 24); }
#endif
DEV float f8dec1(unsigned v) {
    const unsigned e = (v >> 3) & 15u, m = v & 7u; float r = e == 0 ? (float)m * (1.0f / 512.0f) : __uint_as_float(((e + 120u) << 23) | (m << 20));
    return (v & 0x80u) ? -r : r;
}
#if defined(__HIP_DEVICE_COMPILE__)
DEV f32x4 f8x4_f32(unsigned w) { const auto lo = __builtin_amdgcn_cvt_pk_f32_fp8((int)w, false), hi = __builtin_amdgcn_cvt_pk_f32_fp8((int)w, true); return (f32x4){lo[0], lo[1], hi[0], hi[1]}; }
#else
DEV f32x4 f8x4_f32(unsigned w) { return (f32x4){f8dec1(w & 255u), f8dec1((w >> 8) & 255u), f8dec1((w >> 16) & 255u), f8dec1(w >> 24)}; }
#endif
constexpr float YE_SCALE = 32.0f, YE_INV = 1.0f / 32.0f;
#ifdef CPU_EMU
DEV f32x4 mfma_f8(bf16x8 a0, bf16x8 a1, bf16x8 b0, bf16x8 b1, f32x4 c) { return emu_mfma_f8(a0, a1, b0, b1, c); }
#else
typedef int i32x4 __attribute__((ext_vector_type(4)));
typedef int i32x8 __attribute__((ext_vector_type(8)));
DEV f32x4 mfma_f8(bf16x8 a0, bf16x8 a1, bf16x8 b0, bf16x8 b1, f32x4 c) {
    const i32x8 A = __builtin_shufflevector(__builtin_bit_cast(i32x4, a0), __builtin_bit_cast(i32x4, a1), 0, 1, 2, 3, 4, 5, 6, 7);
    const i32x8 B = __builtin_shufflevector(__builtin_bit_cast(i32x4, b0), __builtin_bit_cast(i32x4, b1), 0, 1, 2, 3, 4, 5, 6, 7);
    return __builtin_amdgcn_mfma_scale_f32_16x16x128_f8f6f4(A, B, c, 0, 0, 0, 0, 0, 0);
}
#endif
constexpr float F8_WSCALE = 64.0f, F8_WINV = 1.0f / 64.0f;
DEV void store8bf(bf16_t* o, f32x4 a, f32x4 b) { u32x4 v = {pack2(a[0], a[1]), pack2(a[2], a[3]), pack2(b[0], b[1]), pack2(b[2], b[3])}; stg((u32x4*)o, v); }

#ifndef CPU_EMU
#define XB_TMO      128
#define XB_XCNT(j)  (256  + 64 * (j))
#define XB_XSUB(j)  (1280 + 64 * (j))
#define XB_XGEN(j)  (2304 + 64 * (j))
#define XB_TOP      3328
#define XB_TOPGEN   3392
#define XCD_BAR_WORDS 3456
#define XB_SPIN_CAP (1u << 18)
#define LAS __attribute__((address_space(3)))
__device__ __forceinline__ unsigned xb_ld(unsigned* p)              { return __hip_atomic_load(p, __ATOMIC_RELAXED, __HIP_MEMORY_SCOPE_AGENT); }
__device__ __forceinline__ unsigned xb_add(unsigned* p, unsigned v) { return __hip_atomic_fetch_add(p, v, __ATOMIC_RELAXED, __HIP_MEMORY_SCOPE_AGENT); }
__device__ __forceinline__ unsigned xb_xcc_id() { return (unsigned)__builtin_amdgcn_s_getreg((3 << 11) | 20) & 0xFu; }
#define XB_SPIN(cond, bar) do { unsigned _sp = 0; while (cond) { __builtin_amdgcn_s_sleep(1); \
    if ((++_sp & 255u) == 0u) { if (xb_ld(&(bar)[XB_TMO])) break; if (_sp > XB_SPIN_CAP) { atomicAdd(&(bar)[XB_TMO], 1u); break; } } } } while (0)
struct XcdBarrier { unsigned* bar; unsigned x; volatile LAS unsigned* st; };
__device__ __forceinline__ XcdBarrier xcd_barrier_post(unsigned* bar, volatile LAS unsigned* st) {
    XcdBarrier b; b.bar = bar; b.x = xb_xcc_id(); b.st = st;
    if (threadIdx.x == 0) (void)xb_add(&bar[XB_XCNT(b.x)], 1u);
    return b;
}
__device__ __forceinline__ void xcd_barrier_complete(unsigned* bar, unsigned x, unsigned& nloc, unsigned& nx) {
    const unsigned Gd = gridDim.x * gridDim.y * gridDim.z;
    unsigned sum, cnt, mine, sp = 0u;
    for (;;) {
        sum = 0u; cnt = 0u; mine = 0u;
#pragma unroll
        for (unsigned j = 0; j < 16; ++j) { const unsigned c = xb_ld(&bar[XB_XCNT(j)]); sum += c; cnt += (c > 0u) ? 1u : 0u; mine = (j == x) ? c : mine; }
        if (sum == Gd) break;
        __builtin_amdgcn_s_sleep(1);
        if ((++sp & 255u) == 0u) { if (xb_ld(&bar[XB_TMO])) break; if (sp > XB_SPIN_CAP) { atomicAdd(&bar[XB_TMO], 1u); break; } }
    }
    nloc = mine > 0u ? mine : 1u; nx = cnt > 0u ? cnt : 1u;
}
__device__ __forceinline__ void xcd_barrier(const XcdBarrier& b) {
    asm volatile("s_waitcnt vmcnt(0)" ::: "memory");
    __syncthreads();
    if (threadIdx.x == 0) {
        unsigned* bar = b.bar;
        unsigned bx = b.x; asm volatile("" : "+s"(bx));
        __builtin_amdgcn_s_waitcnt(0);
        unsigned nloc = b.st[0], nx = b.st[1];
        if (nloc == 0u) { xcd_barrier_complete(bar, bx, nloc, nx); b.st[0] = nloc; b.st[1] = nx; }
        const unsigned old = xb_add(&bar[XB_XSUB(bx)], 1u);
        const unsigned gen = old / nloc;
        if (old + 1u == (gen + 1u) * nloc) {
            __builtin_amdgcn_fence(__ATOMIC_RELEASE, "agent");
            asm volatile("s_waitcnt vmcnt(0)" ::: "memory");
            const unsigned og = xb_add(&bar[XB_TOP], 1u);
            const unsigned tg = og / nx;
            if (og + 1u == (tg + 1u) * nx) xb_add(&bar[XB_TOPGEN], 1u);
            else XB_SPIN(xb_ld(&bar[XB_TOPGEN]) == tg, bar);
            __builtin_amdgcn_fence(__ATOMIC_ACQUIRE, "agent");
            xb_add(&bar[XB_XGEN(bx)], 1u);
            asm volatile("s_waitcnt vmcnt(0)" ::: "memory");
        } else {
            XB_SPIN(xb_ld(&bar[XB_XGEN(bx)]) == gen, bar);
            __builtin_amdgcn_fence(__ATOMIC_ACQUIRE, "agent");
            asm volatile("s_waitcnt vmcnt(0)" ::: "memory");
        }
    }
    __syncthreads();
}
#endif

constexpr int BK = 64, HALF = 128, HT_BYTES = HALF * BK * 2;
DEV int lds_byte(int r, int c) { int st = (r >> 4) * 2 + (c >> 5), rr = r & 15, cc = c & 31, ob = rr * 64 + cc * 2; return st * 1024 + (ob ^ (((ob >> 9) & 1) << 5)); }
DEV void stage_rc(int b, int& Rr, int& Cc) { int st = b / 1024, sb = b % 1024, swz = sb ^ (((sb >> 9) & 1) << 5); Rr = (st >> 1) * 16 + swz / 64; Cc = (st & 1) * 32 + (swz % 64) / 2; }
DEV int perm32(int rho) { const int n = rho >> 4, i = rho & 15; return 8 * (i >> 2) + 4 * n + (i & 3); }

DEV bool tile_from_L(int L, int nM, int nN, int& pm, int& pn) {
    const int nwg = nM * nN; if (L >= nwg) return false;
    int wgid = L; { const int q = nwg / 8, r = nwg % 8, xcd = wgid % 8, off = wgid / 8; wgid = (xcd < r ? xcd * (q + 1) : r * (q + 1) + (xcd - r) * q) + off; }
    const int nig = 8 * nN, gid = wgid / nig, fm = gid * 8, gsz = (nM - fm) < 8 ? (nM - fm) : 8;
    pm = fm + ((wgid % nig) % gsz); pn = (wgid % nig) / gsz; return true;
}
DEV bool tile_order(int i, int nM, int nN, int& pm, int& pn) { return tile_from_L(i * (int)gridDim.x + (int)blockIdx.x, nM, nN, pm, pn); }
#ifdef CPU_EMU
#define GLDS16(src, dst) __builtin_amdgcn_global_load_lds((const unsigned*)(src), (unsigned*)((dst) + (TID() & 63) * 16), 16, 0, 0)
#else
#define GLDS16(src, dst) __builtin_amdgcn_global_load_lds((const unsigned*)(src), (unsigned*)(dst), 16, 0, 0)
#endif

#define BAR __builtin_amdgcn_s_barrier()
#define SCHED __builtin_amdgcn_sched_barrier(0)
struct GUnit { int pm, pn, aux; };
template <class T> struct is_void_ { static constexpr bool v = false; };
template <> struct is_void_<void> { static constexpr bool v = true; };
template <class Epi> DEV bool call_epi(const Epi& e, const GUnit& u, f32x4 (&acc)[2][2][4][2], int r0, int c0) {
    if constexpr (is_void_<decltype(e(u, acc, r0, c0))>::v) { e(u, acc, r0, c0); return false; } else return e(u, acc, r0, c0);
}
template <bool GATHER, int LDA_, int LDB_, int K_, bool F8 = false, class Sched, class Epi>
DEV void gemm_stream(char* shm, const Sched& S, const Epi& epi) {
#define SA(b, h) (shm + ((b) * 2 + (h)) * HT_BYTES)
#define SB(b, h) (shm + (4 + (b) * 2 + (h)) * HT_BYTES)
#define STG_B(P, bp) do { GLDS16((bp) + voffB, (P) + ldsb0); GLDS16((bp) + voffB + 64 * LDB_, (P) + ldsb0 + 8192); } while (0)
#define STG_A(P, ap, h, gv) do { if (GATHER) { GLDS16((ap) + gv[h][0], (P) + ldsb0); GLDS16((ap) + gv[h][1], (P) + ldsb0 + 8192); } \
    else { GLDS16((ap) + voffA + (h) * 128 * LDA_, (P) + ldsb0); GLDS16((ap) + voffA + ((h) * 128 + 64) * LDA_, (P) + ldsb0 + 8192); } } while (0)
#define LDA(dst, b, h) _Pragma("unroll") for (int m = 0; m < 4; ++m) _Pragma("unroll") for (int k = 0; k < 2; ++k) \
    dst[m][k] = *reinterpret_cast<const bf16x8*>(SA(b, h) + aoff + m * 2048 + k * 1024)
#define LDB(dst, b, h) _Pragma("unroll") for (int n = 0; n < 2; ++n) _Pragma("unroll") for (int k = 0; k < 2; ++k) \
    dst[n][k] = *reinterpret_cast<const bf16x8*>(SB(b, h) + boff + n * 2048 + k * 1024)
#define MMA(ai, bj, At_, Bx_) do { __builtin_amdgcn_s_setprio(1); \
    if constexpr (F8) { _Pragma("unroll") for (int m = 0; m < 4; ++m) _Pragma("unroll") for (int n = 0; n < 2; ++n) \
      acc[ai][bj][m][n] = mfma_f8(Bx_[n][0], Bx_[n][1], At_[m][0], At_[m][1], acc[ai][bj][m][n]); } \
    else { _Pragma("unroll") for (int m = 0; m < 4; ++m) _Pragma("unroll") for (int n = 0; n < 2; ++n) _Pragma("unroll") for (int k = 0; k < 2; ++k) \
      acc[ai][bj][m][n] = mfma16(Bx_[n][k], At_[m][k], acc[ai][bj][m][n]); } \
    __builtin_amdgcn_s_setprio(0); } while (0)
    constexpr int nt = K_ / BK;
    const int tid = TID();
    const int wid = __builtin_amdgcn_readfirstlane(tid >> 6), lane = tid & 63, wr = wid >> 2, wc = wid & 3, fr = lane & 15, fq = lane >> 4;
    const int ldsb0 = wid * 1024;
    int Rr0, Cc0; stage_rc(tid * 16, Rr0, Cc0);
    const int voffA = Rr0 * LDA_ + Cc0;
    const int voffB = ((Rr0 & ~31) + perm32(Rr0 & 31)) * LDB_ + Cc0;
    const int aoff = lds_byte(wr * 64 + fr, fq * 8), boff = lds_byte(wc * 32 + fr, fq * 8);
    GUnit cur, nxt; int ui = 0;
    if (!S.next(0, cur)) return;
    int gc[2][2] = {{0, 0}, {0, 0}};
    int* gtab = (int*)(shm + 131072 + 256);
    if (GATHER) {
        __syncthreads();
        { GUnit u; for (int i = 0; i < GT_MAXU && S.next(i, u); ++i) { if (tid < 256) gtab[i * 256 + tid] = S.grow(u, tid) * LDA_; } }
        __syncthreads();
#pragma unroll
        for (int h = 0; h < 2; ++h)
#pragma unroll
            for (int i = 0; i < 2; ++i) gc[h][i] = gtab[h * 128 + i * 64 + Rr0] + Cc0;
    }
    f32x4 acc[2][2][4][2];
#pragma unroll
    for (int a = 0; a < 2; ++a)
#pragma unroll
        for (int b = 0; b < 2; ++b)
#pragma unroll
            for (int m = 0; m < 4; ++m)
#pragma unroll
                for (int n = 0; n < 2; ++n) acc[a][b][m][n] = (f32x4){0.f, 0.f, 0.f, 0.f};
    bf16x8 At[4][2], B0[2][2], B1[2][2];
    const bf16_t* cA = S.a_base(cur); const bf16_t* cB = S.b_base(cur);
    STG_B(SB(0, 0), cB); STG_A(SA(0, 0), cA, 0, gc); STG_B(SB(0, 1), cB + 128 * LDB_); STG_A(SA(0, 1), cA, 1, gc);
    if (wr == 1) BAR;
    WAIT_V(4); BAR;
    STG_B(SB(1, 0), cB + BK); STG_A(SA(1, 0), cA + BK, 0, gc); STG_B(SB(1, 1), cB + 128 * LDB_ + BK);
    WAIT_V(6); BAR;
    for (;;) {
        const bool has_next = S.next(ui + 1, nxt);
        const bf16_t* nA = has_next ? S.a_base(nxt) : cA; const bf16_t* nB = has_next ? S.b_base(nxt) : cB;
#pragma unroll 1
        for (int t = 0; t < nt; t += 2) {
            const bool last = (t == nt - 2);
            const bf16_t* a1 = cA + (t + 1) * BK;
            const bf16_t* a2 = last ? nA : cA + (t + 2) * BK; const bf16_t* b2 = last ? nB : cB + (t + 2) * BK;
            const bf16_t* a3 = a2 + BK; const bf16_t* b3 = b2 + BK;
            LDB(B0, 0, 0); SCHED; LDA(At, 0, 0); STG_A(SA(1, 1), a1, 1, gc);
            if (GATHER && last && has_next) {
#pragma unroll
                for (int h = 0; h < 2; ++h)
#pragma unroll
                    for (int i = 0; i < 2; ++i) gc[h][i] = gtab[(ui + 1) * 256 + h * 128 + i * 64 + Rr0] + Cc0; }
            WAIT_L(8); BAR; WAIT_L(0); MMA(0, 0, At, B0); BAR; SCHED;
            LDB(B1, 0, 1); STG_B(SB(0, 0), b2);
            BAR; WAIT_L(0); MMA(0, 1, At, B1); BAR;
            LDA(At, 0, 1); STG_A(SA(0, 0), a2, 0, gc);
            BAR; WAIT_L(0); MMA(1, 0, At, B0); BAR; SCHED;
            STG_B(SB(0, 1), b2 + 128 * LDB_);
            WAIT_V(6); BAR; MMA(1, 1, At, B1); BAR;
            LDB(B0, 1, 0); SCHED; LDA(At, 1, 0); STG_A(SA(0, 1), a2, 1, gc);
            WAIT_L(8); BAR; WAIT_L(0); MMA(0, 0, At, B0); BAR; SCHED;
            LDB(B1, 1, 1); STG_B(SB(1, 0), b3);
            BAR; WAIT_L(0); MMA(0, 1, At, B1); BAR;
            LDA(At, 1, 1); STG_A(SA(1, 0), a3, 0, gc);
            BAR; WAIT_L(0); MMA(1, 0, At, B0); BAR; SCHED;
            STG_B(SB(1, 1), b3 + 128 * LDB_);
            WAIT_V(6); BAR; MMA(1, 1, At, B1); BAR;
        }
        bool keep = false;
        {
            const int tz = TID(); const int wz = tz >> 6, lz = tz & 63, wrz = wz >> 2, wcz = wz & 3, frz = lz & 15, fqz = lz >> 4;
            keep = call_epi(epi, cur, acc, wrz * 64 + frz, wcz * 32 + 8 * fqz);
        }
        if (!has_next) break;
        if (!keep) {
#pragma unroll
            for (int a = 0; a < 2; ++a)
#pragma unroll
                for (int b = 0; b < 2; ++b)
#pragma unroll
                    for (int m = 0; m < 4; ++m)
#pragma unroll
                        for (int n = 0; n < 2; ++n) acc[a][b][m][n] = (f32x4){0.f, 0.f, 0.f, 0.f};
        }
        cur = nxt; cA = nA; cB = nB; ++ui;
    }
    WAIT_V(0);
    if (wr == 0) BAR;
    BAR;
#undef SA
#undef SB
#undef STG_A
#undef STG_B
#undef LDA
#undef LDB
#undef MMA
}

constexpr int J_IN = 16 * 27, J_WB = 2 * 8 * 4, J_WO = 16 * 4, J_GU = 16 * 2 * 64, J_DN = 16 * 64, J_FOLD = 8 * 16, J_PAD = 1;
constexpr int N_MODJOBS = 2 * 96;

constexpr int J_BIG = J_IN + J_WB + J_WO + J_GU + J_DN;
struct WJob { const float* src; bf16_t* dst; int ldsrc, lddst, nvalid, k0, n0, mode, gu_which, f8; };
DEV WJob wjob_decode(const Params& p, int l, int j) {
    WJob w; w.ldsrc = 1024; w.lddst = 1024; w.nvalid = 256; w.mode = 0; w.gu_which = 0; w.f8 = 0;
    if (j < J_IN) { const int kt = j / 27, nb = j % 27; w.k0 = kt * 64; w.n0 = nb * 256; w.src = p.w_in + (size_t)l * 1024 * PWSRC; w.ldsrc = PWSRC; w.nvalid = PWSRC - w.n0; w.dst = p.WinT() + (size_t)l * PWT * 1024; w.mode = 3; }
    else if ((j -= J_IN) < J_WB) { const int bi = (j / 32) * 2, jj = j % 32, kt = jj / 4, nb = jj % 4; w.k0 = kt * 64; w.n0 = nb * 256;
        w.src = p.w_branch + ((size_t)l * 3 + bi) * 512 * 1024; w.dst = p.WbT() + ((size_t)l * 3 + bi) * 1024 * 512; w.lddst = 512; }
    else if ((j -= J_WB) < J_WO) { const int kt = j / 4, nb = j % 4; w.k0 = kt * 64; w.n0 = nb * 256; w.src = p.w_out + (size_t)l * 1024 * 1024; w.dst = p.WoT() + (size_t)l * 1024 * 1024; }
    else if ((j -= J_WO) < J_GU) { const int e = j / 128, jj = j % 128; w.gu_which = jj / 64; const int j3 = jj % 64, kt = j3 / 4, nb = j3 % 4; w.k0 = kt * 64; w.n0 = nb * 256;
        w.src = (w.gu_which ? p.w_up : p.w_gate) + ((size_t)l * 16 + e) * 1024 * 1024; w.dst = p.WguT() + ((size_t)l * 16 + e) * 2048 * 512; w.mode = 1; w.f8 = 1; }
    else { j -= J_GU; const int e = j / 64, jj = j % 64, kt = jj / 4, nb = jj % 4; w.k0 = kt * 64; w.n0 = nb * 256;
        w.src = p.w_down + ((size_t)l * 16 + e) * 1024 * 1024; w.dst = p.WdT() + ((size_t)l * 16 + e) * 1024 * 512; w.f8 = 1; }
    return w;
}
constexpr int WT_LD = 260;
DEV void wjob_load(const WJob& w, int tid, f32x4 (&vv)[8]) {
#pragma unroll
    for (int i = 0; i < 8; ++i) { const int idx = i * 512 + tid, r = idx >> 6, c = (idx & 63) * 4; int col = w.n0 + c; col = col > w.ldsrc - 4 ? w.ldsrc - 4 : col;
        vv[i] = ldg((const f32x4*)(w.src + (size_t)(w.k0 + r) * w.ldsrc + col)); }
}
DEV void wjob_finish(const WJob& w, int tid, const f32x4 (&vv)[8], float* tile) {
    __syncthreads();
#pragma unroll
    for (int i = 0; i < 8; ++i) { const int idx = i * 512 + tid, r = idx >> 6, c = (idx & 63) * 4; *(f32x4*)(tile + r * WT_LD + c) = vv[i]; }
    __syncthreads();
#pragma unroll
    for (int q = 0; q < 4; ++q) {
        const int item = q * 512 + tid, nrow = item >> 3, kc = (item & 7) * 8;
        float v[8];
#pragma unroll
        for (int jj = 0; jj < 8; ++jj) v[jj] = tile[(kc + jj) * WT_LD + nrow];
        const int n = w.n0 + nrow;
        int drow = n; bool f8 = w.f8 != 0; size_t f8base = 0;
        if (w.mode == 1) drow = (n >> 7) * 256 + w.gu_which * 128 + (n & 127);
        if (w.mode == 3) {
            if (n >= C_SPLIT) { f8 = true; f8base = (size_t)PWA * 2048; drow = n - C_SPLIT; }
            else { drow = proj_col(n); if (drow >= C_F8) { f8 = true; f8base = (size_t)C_F8 * 2048; drow -= C_F8; } } }
        if (f8) { const u32x2 o = {f8pack4(v[0] * F8_WSCALE, v[1] * F8_WSCALE, v[2] * F8_WSCALE, v[3] * F8_WSCALE), f8pack4(v[4] * F8_WSCALE, v[5] * F8_WSCALE, v[6] * F8_WSCALE, v[7] * F8_WSCALE)};
            if (nrow < w.nvalid) stg((u32x2*)((unsigned char*)w.dst + f8base + (size_t)drow * 1024 + w.k0 + kc), o); }
        else if (nrow < w.nvalid) { u32x4 o = {pack2(v[0], v[1]), pack2(v[2], v[3]), pack2(v[4], v[5]), pack2(v[6], v[7])};
            stg((u32x4*)(w.dst + (size_t)drow * w.lddst + w.k0 + kc), o); }
    }
}
DEV void pro_small_job(const Params& p, int l, int j, char* shm) {
    float* tile = (float*)shm;
    const int tid = TID();
    if (j < J_FOLD) {
        const int kt = j / 16, ntl = j % 16, k0 = kt * 64, n0 = ntl * 64; const int fg = k0 / 128;
        const float* wb1 = p.w_branch + ((size_t)l * 3 + 1) * 512 * 1024;
        const float* pw = p.pool_w + ((size_t)l * 4 + fg) * 128 * 128; const float* ps = p.pool_scale + (size_t)l * 512 + fg * 128;
        const int c = tid & 63, rq = tid >> 6;
        float accv[8];
#pragma unroll
        for (int i = 0; i < 8; ++i) accv[i] = 0.f;
        for (int d = 0; d < 128; ++d) { const float wv = ldg(wb1 + (size_t)(fg * 128 + d) * 1024 + n0 + c) * ldg(ps + d);
#pragma unroll
            for (int i = 0; i < 8; ++i) accv[i] += ldg(pw + (size_t)(k0 - fg * 128 + rq * 8 + i) * 128 + d) * wv; }
        __syncthreads();
#pragma unroll
        for (int i = 0; i < 8; ++i) tile[(rq * 8 + i) * WT_LD + c] = accv[i];
        __syncthreads();
        const int nrow = tid >> 3, kc = (tid & 7) * 8; float v[8];
#pragma unroll
        for (int jj = 0; jj < 8; ++jj) v[jj] = tile[(kc + jj) * WT_LD + nrow];
        u32x4 o = {pack2(v[0], v[1]), pack2(v[2], v[3]), pack2(v[4], v[5]), pack2(v[6], v[7])};
        stg((u32x4*)(p.WbT() + ((size_t)l * 3 + 1) * 1024 * 512 + (size_t)(n0 + nrow) * 512 + k0 + kc), o);
    } else {
        bf16_t* d0 = p.WinT() + (size_t)l * PWT * 1024 + (size_t)C_PADA * 1024;
        for (int i = tid; i < (C_F8 - C_PADA) * 1024 / 8; i += NTHREADS) stg((u32x4*)(d0 + (size_t)i * 8), (u32x4){0u, 0u, 0u, 0u});
    }
}

DEV void pro_mod_job(const Params& p, int job, char* shm) {
    float* sv = (float*)shm;
    const int tid = TID(), l = job / 96, col0 = (job % 96) * 64;
    const int c = tid & 63, kp = tid >> 6;
    float acc[NB + 1];
#pragma unroll
    for (int v = 0; v <= NB; ++v) acc[v] = 0.f;
    for (int half = 0; half < 2; ++half) {
        __syncthreads();
        for (int idx = tid; idx < (NB + 1) * 512; idx += 512) { const int v = idx >> 9, k = idx & 511;
            const float s = (v < NB) ? ldg(p.c + (size_t)v * 1024 + half * 512 + k) : ldg(p.c_ctx + half * 512 + k);
            sv[idx] = s * sigmoidf_(s); }
        __syncthreads();
        for (int kk = 0; kk < 64; ++kk) { const int k = kp * 64 + kk;
            const float w = ldg(p.ada_w + ((size_t)l * 1024 + half * 512 + k) * 6144 + col0 + c);
#pragma unroll
            for (int v = 0; v <= NB; ++v) acc[v] += sv[v * 512 + k] * w; }
    }
    __syncthreads();
    float* red = (float*)shm;
#pragma unroll
    for (int v = 0; v <= NB; ++v) red[(kp * (NB + 1) + v) * 64 + c] = acc[v];
    __syncthreads();
    for (int idx = tid; idx < (NB + 1) * 64; idx += 512) { const int v = idx >> 6, cc = idx & 63; float s = 0.f;
#pragma unroll
        for (int q = 0; q < 8; ++q) s += red[(q * (NB + 1) + v) * 64 + cc];
        stg(p.mod() + ((size_t)l * (NB + 1) + v) * 6144 + col0 + cc, s + ldg(p.ada_b + (size_t)l * 6144 + col0 + cc)); }
}

DEV void phase_prologue(const Params& p, char* shm) {
    const int tid = TID();
    const int nsmall = N_MODJOBS + 1 + 2 * (J_FOLD + J_PAD);
    for (int job = blockIdx.x; job < nsmall; job += gridDim.x) {
        if (job < N_MODJOBS) pro_mod_job(p, job, shm);
        else if (job == N_MODJOBS) {
            for (int idx = tid; idx < (ROWS + 64) * 16; idx += NTHREADS) { const int pos = idx >> 4, i = idx & 15;
                const float pv = (float)(pos < ROWS ? pos : pos - ROWS);
                const float inv = powf(10000.0f, -(float)(2 * i) / 32.0f);
                const float a = pv * inv; stg(p.rope() + idx * 2, cosf(a)); stg(p.rope() + idx * 2 + 1, sinf(a)); }
        } else { const int sj = job - N_MODJOBS - 1; pro_small_job(p, sj / (J_FOLD + J_PAD), sj % (J_FOLD + J_PAD), shm); }
    }
    float* tile = (float*)shm;
    const int nbig = 2 * J_BIG;
    int job = blockIdx.x;
    if (job >= nbig) return;
    WJob wc = wjob_decode(p, job / J_BIG, job % J_BIG), wn = wc;
    f32x4 vc[8], vn[8];
    wjob_load(wc, tid, vc);
    for (; job < nbig; job += gridDim.x) {
        const int jn = job + gridDim.x;
        if (jn < nbig) { wn = wjob_decode(p, jn / J_BIG, jn % J_BIG); wjob_load(wn, tid, vn); }
        wjob_finish(wc, tid, vc, tile);
        wc = wn;
#pragma unroll
        for (int i = 0; i < 8; ++i) vc[i] = vn[i];
    }
}

DEV const float* xin_f32(const Params& p, const SetDesc& sd) { return (sd.is_ctx ? p.ctx : p.x) + (((size_t)sd.samp0) << sd.lgseq) * 1024; }
DEV bf16_t* xbf_base(const Params& p, const SetDesc& sd) { return (sd.is_ctx ? p.ctxs() : p.xb()) + (((size_t)sd.samp0) << sd.lgseq) * 1024; }
DEV float* xout_f32(const Params& p, const SetDesc& sd) { return p.out + (((size_t)sd.samp0) << sd.lgseq) * 1024; }
template <bool BF> struct XRow;
template <> struct XRow<false> { f32x4 v[4];
    DEV void load(const void* b, size_t row, int lane) { const float* q = (const float*)b + row * 1024 + lane * 8;
#pragma unroll
        for (int i = 0; i < 4; ++i) v[i] = ldg((const f32x4*)(q + (i >> 1) * 512 + (i & 1) * 4)); }
    DEV f32x4 get(int i) const { return v[i]; } };
template <> struct XRow<true> { u32x4 v[2];
    DEV void load(const void* b, size_t row, int lane) { const bf16_t* q = (const bf16_t*)b + row * 1024 + lane * 8;
#pragma unroll
        for (int h = 0; h < 2; ++h) v[h] = ldg((const u32x4*)(q + h * 512)); }
    DEV f32x4 get(int i) const { const u32x4 m = v[i >> 1]; return (i & 1) ? (f32x4){lo16(m.z), hi16(m.z), lo16(m.w), hi16(m.w)} : (f32x4){lo16(m.x), hi16(m.x), lo16(m.y), hi16(m.y)}; } };
template <bool BF> DEV void xrow_store8(void* b, size_t row, int c0, f32x4 a, f32x4 c) {
    if constexpr (BF) store8bf((bf16_t*)b + row * 1024 + c0, a, c);
    else { float* q = (float*)b + row * 1024 + c0; stg((f32x4*)q, a); stg((f32x4*)(q + 4), c); }
}
DEV const float* mod_row(const Params& p, const SetDesc& sd, int layer, int row) {
    return p.mod() + ((size_t)layer * (NB + 1) + (sd.is_ctx ? NB : sd.samp0 + (row >> sd.lgseq))) * 6144;
}
DEV bf16_t* proj_buf(const Params& p, const SetDesc& sd) { return sd.is_ctx ? p.PROJc() : p.PROJa(); }

DEV void stage_params(float* par, const float* v0, const float* v1, const float* v2, const float* v3, const float* v4) {
    const int tid = TID();
    const float* src[5] = {v0, v1, v2, v3, v4};
#pragma unroll
    for (int k = 0; k < 5; ++k) if (src[k]) { for (int i = tid; i < 1024; i += NTHREADS) par[k * 1024 + i] = ldg(src[k] + i); }
}
template <bool SRC_BF> DEV void phase_norm1(const Params& p, const SetDesc& sd, int layer, char* shm) {
    const int tid = TID(), lane = tid & 63, wv = tid >> 6;
    const float* g0 = p.norm_gain + ((size_t)layer * 4 + 0) * 1024;
    const void* xb = SRC_BF ? (const void*)xbf_base(p, sd) : (const void*)xin_f32(p, sd);
    const int stride = 8; const int rpb_ = (sd.nrows + (int)gridDim.x - 1) / (int)gridDim.x; const int row_end = min(sd.nrows, ((int)blockIdx.x + 1) * rpb_);
    int row = (int)blockIdx.x * rpb_ + wv;
    float* par = (float*)shm;
    __syncthreads();
    { const float* mdb = mod_row(p, sd, layer, min((int)blockIdx.x * rpb_, sd.nrows - 1)); stage_params(par, g0, mdb, mdb + 1024, nullptr, nullptr); }
    __syncthreads();
    XRow<SRC_BF> curr, nxtr;
    if (row < row_end) curr.load(xb, row, lane);
    for (; row < row_end; row += stride) {
        const int rn = row + stride;
        if (rn < row_end) nxtr.load(xb, rn, lane);
        f32x4 cur[4];
#pragma unroll
        for (int i = 0; i < 4; ++i) cur[i] = curr.get(i);
        float ss = 0.f;
#pragma unroll
        for (int i = 0; i < 4; ++i)
#pragma unroll
            for (int j = 0; j < 4; ++j) ss += cur[i][j] * cur[i][j];
        ss = wave_sum(ss);
        const float rstd = rsqrtf(ss * (1.0f / 1024.0f) + RMS_EPS);
#pragma unroll
        for (int hlf = 0; hlf < 2; ++hlf) { const int c0 = hlf * 512 + lane * 8; float o[8];
#pragma unroll
            for (int j = 0; j < 8; ++j) o[j] = cur[hlf * 2 + (j >> 2)][j & 3] * rstd * par[c0 + j] * (1.0f + par[2048 + c0 + j]) + par[1024 + c0 + j];
            u32x4 ov = {pack2(o[0], o[1]), pack2(o[2], o[3]), pack2(o[4], o[5]), pack2(o[6], o[7])};
            stg((u32x4*)(p.H() + (size_t)row * 1024 + c0), ov);
            const u32x2 o8 = {f8pack4(o[0], o[1], o[2], o[3]), f8pack4(o[4], o[5], o[6], o[7])};
            stg((u32x2*)(p.H8() + (size_t)row * 1024 + c0), o8); }
        curr = nxtr;
    }
}

struct SchedPlain {
    const bf16_t* A; const bf16_t* Bt; int nM, nN, lda256, ldb256;
    DEV bool next(int i, GUnit& u) const { u.aux = 0; return tile_order(i, nM, nN, u.pm, u.pn); }
    DEV const bf16_t* a_base(const GUnit& u) const { return A + (size_t)u.pm * lda256; }
    DEV const bf16_t* b_base(const GUnit& u) const { return Bt + (size_t)u.pn * ldb256; }
    DEV int grow(const GUnit&, int) const { return 0; }
};
struct SchedPlainT : SchedPlain {
    int split_base = -1;
    DEV bool next(int i, GUnit& u) const { u.aux = 0; const int G_ = (int)gridDim.x, b = (int)blockIdx.x; int L = i * G_ + b;
        if (split_base >= 0 && i >= split_base) { if (b < G_ / 2 || i >= split_base + 2) return false; L = split_base * G_ + (i - split_base) * (G_ / 2) + (b - G_ / 2); }
        return tile_from_L(L, nM, nN, u.pm, u.pn); }
    DEV const bf16_t* a_base(const GUnit&) const { return A; }
    DEV int grow(const GUnit& u, int i) const { return u.pm * 256 + i; }
};
struct SchedProjF8 : SchedPlainT {
    const bf16_t* Bt2; int na8;
    DEV const bf16_t* b_base(const GUnit& u) const { return u.pn < na8 ? Bt + (size_t)u.pn * ldb256 : Bt2 + (size_t)(u.pn - na8) * ldb256; }
};
DEV unsigned gate4u8(f32x4 v) {
    unsigned w = 0;
#pragma unroll
    for (int j = 0; j < 4; ++j) w |= (unsigned)fmaxf(sigmoidf_(v[j] * F8_WINV) * 255.0f + 0.5f, 1.0f) << (8 * j);
    return w;
}
DEV float u8f(unsigned w, int j) { return (float)((w >> (8 * j)) & 0xFFu); }
DEV void phase_proj_a(const Params& p, const SetDesc& sd, int layer, char* shm) {
    bf16_t* pb = proj_buf(p, sd);
    {
        SchedPlain S; S.A = p.H(); S.Bt = p.WinT() + (size_t)layer * PWT * 1024; S.nM = sd.nrows / 256; S.nN = C_F8 / 256; S.lda256 = 256 * 1024; S.ldb256 = 256 * 1024;
        gemm_stream<false, 1024, 1024, 1024>(shm, S, [=](const GUnit& u, const f32x4 (&acc)[2][2][4][2], int r0, int c0) {
#pragma unroll
            for (int ai = 0; ai < 2; ++ai)
#pragma unroll
                for (int m = 0; m < 4; ++m) { bf16_t* o = pb + ((size_t)u.pm * 256 + r0 + ai * 128 + m * 16) * PWA + u.pn * 256 + c0;
                    if (u.pn * 256 + c0 < C_PADA) store8bf(o, acc[ai][0][m][0], acc[ai][0][m][1]);
                    if (u.pn * 256 + 128 < C_PADA) store8bf(o + 128, acc[ai][1][m][0], acc[ai][1][m][1]); } });
    }
    {
        constexpr int NA8 = (PWA - C_F8) / 256;
        SchedProjF8 S; S.A = (const bf16_t*)p.H8(); S.Bt = p.WinT() + (size_t)layer * PWT * 1024 + (size_t)C_F8 * 1024; S.Bt2 = p.WinT() + (size_t)layer * PWT * 1024 + (size_t)PWA * 1024; S.na8 = NA8;
        S.nM = sd.nrows / 256; S.nN = NA8 + NBG / 256; S.lda256 = 256 * 512; S.ldb256 = 256 * 512;
        { const int G_ = (int)gridDim.x, T1 = S.nM * (C_F8 / 256), T2 = S.nM * S.nN; if ((G_ & 1) == 0 && (T1 % G_) * 2 == G_ && T2 % G_ == 0 && T2 / G_ >= 1) S.split_base = T2 / G_ - 1; }
        unsigned char* bg = p.BG();
        gemm_stream<true, 512, 512, 512, true>(shm, S, [=](const GUnit& u, const f32x4 (&acc)[2][2][4][2], int r0, int c0) {
            if (u.pn < NA8) {
#pragma unroll
                for (int ai = 0; ai < 2; ++ai)
#pragma unroll
                    for (int m = 0; m < 4; ++m) { bf16_t* o = pb + ((size_t)u.pm * 256 + r0 + ai * 128 + m * 16) * PWA + C_F8 + u.pn * 256 + c0;
                        store8bf(o, acc[ai][0][m][0] * F8_WINV, acc[ai][0][m][1] * F8_WINV); store8bf(o + 128, acc[ai][1][m][0] * F8_WINV, acc[ai][1][m][1] * F8_WINV); }
            } else {
#pragma unroll
                for (int ai = 0; ai < 2; ++ai)
#pragma unroll
                    for (int m = 0; m < 4; ++m) { unsigned char* o = bg + ((size_t)u.pm * 256 + r0 + ai * 128 + m * 16) * NBG + (u.pn - NA8) * 256 + c0;
#pragma unroll
                        for (int hf = 0; hf < 2; ++hf) { const u32x2 gv = {gate4u8(acc[ai][hf][m][0]), gate4u8(acc[ai][hf][m][1])}; stg((u32x2*)(o + hf * 128), gv); } }
            } });
    }
}
DEV f32x4 sig4(f32x4 v) { f32x4 r; r[0] = sigmoidf_(v[0]); r[1] = sigmoidf_(v[1]); r[2] = sigmoidf_(v[2]); r[3] = sigmoidf_(v[3]); return r; }
DEV void gate_scan(const bf16_t* prow, int h, const float* gbias, float* ga, float* gb, float* gpm, float* gtot, float* tmp) {
    const int tid = TID(), lane = tid & 63, w = tid >> 6;
    float b = 0.f, a = 0.f, pm = 0.f; int d = 0, tok = 0;
    if (tid < 256) {
        d = tid >> 7; const int i = tid & 127; tok = d ? 127 - i : i;
        const float gi = bf2f(ldg(prow + (size_t)tok * PWA + C_GM + (2 * d) * 4 + h)) + ldg(gbias + (2 * d) * 4 + h);
        const float gf = bf2f(ldg(prow + (size_t)tok * PWA + C_GM + (2 * d + 1) * 4 + h)) + ldg(gbias + (2 * d + 1) * 4 + h);
        b = logsigmoidf_(gf);
#pragma unroll
        for (int o = 1; o < 64; o <<= 1) { const float t = __shfl_up(b, o); if (lane >= o) b += t; }
        if (lane == 63) tmp[w] = b;
        a = gi;
    }
    __syncthreads();
    if (tid < 256) {
        if (w & 1) b += tmp[w - 1];
        a -= b; pm = a;
#pragma unroll
        for (int o = 1; o < 64; o <<= 1) { const float t = __shfl_up(pm, o); if (lane >= o) pm = fmaxf(pm, t); }
        if (lane == 63) tmp[8 + w] = pm;
    }
    __syncthreads();
    if (tid < 256) {
        if (w & 1) pm = fmaxf(pm, tmp[8 + w - 1]);
        ga[d * 128 + tok] = a; gb[d * 128 + tok] = b; gpm[d * 128 + tok] = pm;
        if ((tid & 127) == 127) { gtot[d * 2] = b; gtot[d * 2 + 1] = pm; }
    }
    __syncthreads();
}

struct RopeRaw { u32x4 m, q; f32x4 rt[4]; };
DEV void rope_issue(RopeRaw& r, const bf16_t* hp, int cidx, bool latent, int tl, const float* rope) {
    r.m = ldg((const u32x4*)(hp + cidx * 8));
    if (latent) {
        r.q = ldg((const u32x4*)(hp + (cidx ^ 2) * 8));
        const int pos = (cidx < 4) ? (tl >> 6) : (ROWS + (tl & 63));
        const float* tb = rope + ((size_t)pos * 16 + (cidx & 1) * 8) * 2;
#pragma unroll
        for (int i = 0; i < 4; ++i) r.rt[i] = ldg((const f32x4*)(tb + i * 4));
    }
}
DEV void rope_apply(const RopeRaw& r, int cidx, bool latent, float scale, float* o) {
    const u32x4 m = r.m;
    float x[8] = {lo16(m.x), hi16(m.x), lo16(m.y), hi16(m.y), lo16(m.z), hi16(m.z), lo16(m.w), hi16(m.w)};
    if (latent) {
        const u32x4 q = r.q;
        const float y[8] = {lo16(q.x), hi16(q.x), lo16(q.y), hi16(q.y), lo16(q.z), hi16(q.z), lo16(q.w), hi16(q.w)};
        const bool first = (cidx & 2) == 0;
#pragma unroll
        for (int j = 0; j < 8; ++j) { const float cs = r.rt[j >> 1][(j & 1) * 2], sn = r.rt[j >> 1][(j & 1) * 2 + 1];
            x[j] = first ? (x[j] * cs - y[j] * sn) : (x[j] * cs + y[j] * sn); }
    }
#pragma unroll
    for (int j = 0; j < 8; ++j) o[j] = x[j] * scale;
}

DEV int st_index(const SetDesc& sd, int sl, int h, int dir, int tb) { return ((sl * 4 + h) * 2 + dir) * sd.ntb + tb; }

constexpr int V_LD = 144, K_LD = 72, KS_LD = 80;
struct PrefA { RopeRaw rk1, rk2; u32x4 vreg[4]; };
DEV void stepA_issue(PrefA& f, const Params& p, const SetDesc& sd, int task) {
    const int tid = TID();
    const int tb = task % sd.ntb, h = (task / sd.ntb) & 3, sl = task / (sd.ntb * 4);
    const int row0 = (sl << sd.lgseq) + tb * 128; const bool latent = !sd.is_ctx; const int tl0 = tb * 128;
    const bf16_t* prow = proj_buf(p, sd) + (size_t)row0 * PWA;
    { const int s = tid & 127, cpi = tid >> 7, cp = (cpi & 1) + (cpi >> 1) * 4; const bf16_t* hp = prow + (size_t)s * PWA + C_KM + h * 64;
      rope_issue(f.rk1, hp, cp, latent, tl0 + s, p.rope()); rope_issue(f.rk2, hp, cp + 2, latent, tl0 + s, p.rope()); }
#pragma unroll
    for (int it = 0; it < 4; ++it) { const int item = tid + it * 512, s = item >> 4, ch = item & 15; f.vreg[it] = ldg((const u32x4*)(prow + (size_t)s * PWA + C_VM + h * 128 + ch * 8)); }
}
DEV void mlstm_stepA_task(const Params& p, const SetDesc& sd, int layer, int task, int next_task, PrefA& f, char* shm) {
    const int tid = TID(), lane = tid & 63, w = tid >> 6, fr = lane & 15, fq = lane >> 4, tq4 = (lane & 15) >> 2, tp4 = lane & 3;
    const int tb = task % sd.ntb, h = (task / sd.ntb) & 3, sl = task / (sd.ntb * 4);
    const int row0 = (sl << sd.lgseq) + tb * 128; const bool latent = !sd.is_ctx;
    bf16_t* Vs = (bf16_t*)shm;
    bf16_t* Ksc = (bf16_t*)(shm + 128 * V_LD * 2);
    float* ga = (float*)(shm + 128 * V_LD * 2 + 2 * 128 * KS_LD * 2); float* gb = ga + 256; float* gpm = gb + 256; float* gtot = gpm + 256; float* tmp = gtot + 8;
    const bf16_t* prow = proj_buf(p, sd) + (size_t)row0 * PWA;
    __syncthreads();
    gate_scan(prow, h, p.gate_bias + (size_t)layer * 16, ga, gb, gpm, gtot, tmp);
    {
        const int s = tid & 127, cpi = tid >> 7, cp = (cpi & 1) + (cpi >> 1) * 4;
        float k1[8], k2[8];
        rope_apply(f.rk1, cp, latent, 1.0f, k1);
        rope_apply(f.rk2, cp + 2, latent, 1.0f, k2);
#pragma unroll
        for (int dir = 0; dir < 2; ++dir) { const float ws = __expf(ga[dir * 128 + s] - gtot[dir * 2 + 1]);
            u32x4 o1 = {pack2(k1[0] * ws, k1[1] * ws), pack2(k1[2] * ws, k1[3] * ws), pack2(k1[4] * ws, k1[5] * ws), pack2(k1[6] * ws, k1[7] * ws)};
            u32x4 o2 = {pack2(k2[0] * ws, k2[1] * ws), pack2(k2[2] * ws, k2[3] * ws), pack2(k2[4] * ws, k2[5] * ws), pack2(k2[6] * ws, k2[7] * ws)};
            *(u32x4*)(Ksc + (dir * 128 + s) * KS_LD + cp * 8) = o1; *(u32x4*)(Ksc + (dir * 128 + s) * KS_LD + (cp + 2) * 8) = o2; }
    }
#pragma unroll
    for (int it = 0; it < 4; ++it) { const int item = tid + it * 512, s = item >> 4, ch = item & 15; *(u32x4*)(Vs + s * V_LD + ch * 8) = f.vreg[it]; }
    if (next_task >= 0) stepA_issue(f, p, sd, next_task);
    __syncthreads();
    f32x4 acc[2][4];
#pragma unroll
    for (int dir = 0; dir < 2; ++dir)
#pragma unroll
        for (int n = 0; n < 4; ++n) acc[dir][n] = (f32x4){0.f, 0.f, 0.f, 0.f};
#pragma unroll
    for (int ks = 0; ks < 4; ++ks) {
        const bf16_t* vp = Vs + (32 * ks + 4 * fq + tq4) * V_LD + w * 16 + 4 * tp4;
        const bf16x8 af = mk8(TR16(vp), TR16(vp + 16 * V_LD));
#pragma unroll
        for (int dir = 0; dir < 2; ++dir)
#pragma unroll
            for (int n = 0; n < 4; ++n) { const bf16_t* kp = Ksc + (dir * 128 + 32 * ks + 4 * fq + tq4) * KS_LD + n * 16 + 4 * tp4;
                const bf16x8 bfv = mk8(TR16(kp), TR16(kp + 16 * KS_LD));
                acc[dir][n] = mfma16(bfv, af, acc[dir][n]); }
    }
#pragma unroll
    for (int dir = 0; dir < 2; ++dir) { bf16_t* So = p.Sst() + (size_t)st_index(sd, sl, h, dir, tb) * 8192;
#pragma unroll
        for (int n = 0; n < 4; ++n) { const u32x2 o = {pack2(acc[dir][n][0], acc[dir][n][1]), pack2(acc[dir][n][2], acc[dir][n][3])}; stg((u32x2*)(So + (w * 16 + fr) * 64 + n * 16 + fq * 4), o); } }
    if (tid < 128) { const int dir = tid >> 6, dd = tid & 63; float sm = 0.f;
        for (int i = 0; i < 128; ++i) sm += bf2f(Ksc[(dir * 128 + i) * KS_LD + dd]);
        stg(p.Sn() + (size_t)st_index(sd, sl, h, dir, tb) * 64 + dd, sm); }
    if (tid < 2) { float* sc = p.Ssc() + (size_t)st_index(sd, sl, h, tid, tb) * 4; stg(sc, gtot[tid * 2]); stg(sc + 1, gtot[tid * 2] + gtot[tid * 2 + 1]); }
}

template <int GI> DEV void pool_group(const Params& p, const SetDesc& sd, const bf16_t* pb) {
    constexpr int W = 2 << GI;
    const int nitems = sd.nrows * 16; const int T = 1 << sd.lgseq;
    for (int item = blockIdx.x * NTHREADS + TID(); item < nitems; item += gridDim.x * NTHREADS) {
        const int row = item >> 4, ch = GI * 128 + (item & 15) * 8;
        const int tt = row & (T - 1);
        u32x4 mv[W]; int cnt = 0; bool okv[W];
#pragma unroll
        for (int q = 0; q < W; ++q) { const int t2 = tt - W / 2 + q; const bool ok = (t2 >= 0) && (t2 < T); cnt += ok ? 1 : 0; okv[q] = ok;
            mv[q] = ldg((const u32x4*)(pb + (size_t)(ok ? (row - W / 2 + q) : row) * PWA + C_PU + ch)); }
        float s[8];
#pragma unroll
        for (int j = 0; j < 8; ++j) s[j] = 0.f;
#pragma unroll
        for (int q = 0; q < W; ++q) { u32x4 m = mv[q]; if (!okv[q]) m = (u32x4){0u, 0u, 0u, 0u};
            s[0] += lo16(m.x); s[1] += hi16(m.x); s[2] += lo16(m.y); s[3] += hi16(m.y); s[4] += lo16(m.z); s[5] += hi16(m.z); s[6] += lo16(m.w); s[7] += hi16(m.w); }
        const float inv = frcp((float)cnt);
        const u32x4 m = mv[W / 2];
        const float u[8] = {lo16(m.x), hi16(m.x), lo16(m.y), hi16(m.y), lo16(m.z), hi16(m.z), lo16(m.w), hi16(m.w)};
        u32x4 o = {pack2(s[0] * inv - u[0], s[1] * inv - u[1]), pack2(s[2] * inv - u[2], s[3] * inv - u[3]), pack2(s[4] * inv - u[4], s[5] * inv - u[5]), pack2(s[6] * inv - u[6], s[7] * inv - u[7])};
        stg((u32x4*)(p.Pb() + (size_t)row * 512 + ch), o);
    }
}
DEV void phase_pool(const Params& p, const SetDesc& sd) {
    const bf16_t* pb = proj_buf(p, sd);
    pool_group<0>(p, sd, pb); pool_group<1>(p, sd, pb); pool_group<2>(p, sd, pb); pool_group<3>(p, sd, pb);
}

template <int NC> DEV void mlstm_stepB_run(const Params& p, const SetDesc& sd, int task) {
    const int tid = TID();
    const int q = task & 3, dir = (task >> 2) & 1, h = (task >> 3) & 3, sl = task >> 5;
    const int ci = ((sd.samp0 + sl) * 4 + h) * 2 + dir;
    const int eoff = q * 2048 + tid * 4;
    float zr = 0.f; HIDE(zr);
    f32x4 C = {zr, zr, zr, zr}; float nv = 0.f; float m = -1e30f;
    f32x4 Sv[NC]; float blv[NC], mlv[NC], snv[NC];
#pragma unroll
    for (int c = 0; c < NC; ++c) { const int tb = dir ? NC - 1 - c : c; const size_t si = st_index(sd, sl, h, dir, tb);
        { const u32x2 sr = ldg((const u32x2*)(p.Sst() + si * 8192 + eoff)); Sv[c] = (f32x4){lo16(sr.x), hi16(sr.x), lo16(sr.y), hi16(sr.y)}; } blv[c] = ldg(p.Ssc() + si * 4); mlv[c] = ldg(p.Ssc() + si * 4 + 1);
        snv[c] = (q == 0 && tid < 64) ? ldg(p.Sn() + si * 64 + tid) : 0.f; }
    if (!sd.is_ctx) { C = ldg((const f32x4*)(p.CiC() + (size_t)ci * 8192 + eoff)); if (q == 0 && tid < 64) nv = ldg(p.Cin_() + (size_t)ci * 64 + tid); m = ldg(p.Cim() + (size_t)ci * 4); }
#pragma unroll
    for (int c = 0; c < NC; ++c) {
        const int tb = dir ? NC - 1 - c : c; const size_t si = st_index(sd, sl, h, dir, tb);
        u32x2 o = {pack2(C[0], C[1]), pack2(C[2], C[3])};
        stg((u32x2*)(p.Cin() + si * 8192 + eoff), o);
        if (q == 0 && tid < 64) stg(p.Cn() + si * 64 + tid, nv);
        if (q == 0 && tid == 0) stg(p.Cm() + si * 4, m);
        const float mn = fmaxf(blv[c] + m, mlv[c]);
        const float dc = __expf(blv[c] + m - mn), wsn = __expf(mlv[c] - mn);
        C = C * dc + Sv[c] * wsn;
        nv = nv * dc + snv[c] * wsn;
        m = mn;
    }
    if (sd.is_ctx) { stg((f32x4*)(p.CiC() + (size_t)ci * 8192 + eoff), C); if (q == 0 && tid < 64) stg(p.Cin_() + (size_t)ci * 64 + tid, nv); if (q == 0 && tid == 0) stg(p.Cim() + (size_t)ci * 4, m); }
}
DEV void mlstm_stepB_task(const Params& p, const SetDesc& sd, int task) {
    if (sd.is_ctx) mlstm_stepB_run<NTBC>(p, sd, task); else mlstm_stepB_run<NTBL>(p, sd, task);
}

constexpr int NA_KLD = 136, NA_VLD = 144;
DEV void na_task(const Params& p, const SetDesc& sd, int layer, int sl, int rq2  , int hp, char* shm) {
    const int tid = TID(), lane = tid & 63, w = tid >> 6, tq = lane & 15, fq = lane >> 4, tq4 = (lane & 15) >> 2, tp4 = lane & 3;
    const int hh = w >> 2, g = w & 3, head = hp * 2 + hh;
    const bool ctxq = sd.is_ctx;
    bf16_t* Ks = (bf16_t*)shm;
    bf16_t* Vs = (bf16_t*)(shm + 128 * NA_KLD * 2);
    float* rpbs = (float*)(shm + 128 * NA_KLD * 2 + 128 * NA_VLD * 2);
    const int sample = sd.samp0 + sl;
    const bf16_t* pq = proj_buf(p, sd) + ((size_t)sl << sd.lgseq) * PWA;
    const bf16_t* pc = p.PROJc() + (size_t)sample * CTX * PWA;
    const int qcol = g * 16 + tq;
    int rqv[2], rsv[2], qtok[2];
#pragma unroll
    for (int u = 0; u < 2; ++u) { rqv[u] = 2 * rq2 + u; qtok[u] = rqv[u] * 64 + qcol; int r_ = rqv[u] - 4; rsv[u] = r_ < 0 ? 0 : (r_ > ROWS - 8 ? ROWS - 8 : r_); }
    const int nloc = ctxq ? 0 : (rsv[1] + 8 - rsv[0]);
    const int nstage = nloc + CTX / 64;
    __syncthreads();
    if (!ctxq) for (int i = tid; i < 2 * 465; i += NTHREADS) rpbs[i] = ldg(p.rpb + ((size_t)layer * 8 + hp * 2 + i / 465) * 465 + i % 465);
    bf16x8 qf[2][2];
#pragma unroll
    for (int u = 0; u < 2; ++u)
#pragma unroll
        for (int ks = 0; ks < 2; ++ks) qf[u][ks] = mk8(ldg((const u32x4*)(pq + (size_t)qtok[u] * PWA + C_QN + head * 64 + ks * 32 + fq * 8)));
    float m_run[2] = {-1e30f, -1e30f}, l_run[2] = {0.f, 0.f};
    f32x4 acc[2][4];
#pragma unroll
    for (int u = 0; u < 2; ++u)
#pragma unroll
        for (int mt = 0; mt < 4; ++mt) acc[u][mt] = (f32x4){0.f, 0.f, 0.f, 0.f};
    int cs = qcol - 8; cs = cs < 0 ? 0 : (cs > 48 ? 48 : cs);
    const int kc0 = (g == 0) ? 0 : (g == 1) ? 8 : (g == 2) ? 24 : 32;
    const int npair = (nstage + 1) >> 1;
    u32x4 kreg[4], vreg[4];
#define NA_SRC_ROWS(stg) (((stg) < nloc) ? (pq + (size_t)((rsv[0] + (stg)) * 64) * PWA) : (pc + (size_t)((((stg) < nstage ? (stg) : nstage - 1) - nloc) * 64) * PWA))
#define NA_FETCH(sp_) do { _Pragma("unroll") for (int it = 0; it < 4; ++it) { const int item = tid + it * 512, key2 = item >> 4, ch = item & 15; \
        const bf16_t* kb_ = NA_SRC_ROWS(2 * (sp_) + (key2 >> 6)); const bf16_t* src = kb_ + (size_t)(key2 & 63) * PWA + hp * 128 + ch * 8; \
        kreg[it] = ldg((const u32x4*)(src + C_KN)); vreg[it] = ldg((const u32x4*)(src + C_VN)); } } while (0)
    NA_FETCH(0);
    for (int sp = 0; sp < npair; ++sp) {
        __syncthreads();
#pragma unroll
        for (int it = 0; it < 4; ++it) { const int item = tid + it * 512, key2 = item >> 4, ch = item & 15;
            *(u32x4*)(Ks + key2 * NA_KLD + ch * 8) = kreg[it]; *(u32x4*)(Vs + key2 * NA_VLD + ch * 8) = vreg[it]; }
        if (sp + 1 < npair) NA_FETCH(sp + 1);
        __syncthreads();
#pragma unroll
        for (int sub = 0; sub < 2; ++sub) {
        const int st = 2 * sp + sub;
        if (st >= nstage) continue;
        const bool local = st < nloc;
        const bf16_t* Ksb = Ks + sub * 64 * NA_KLD; const bf16_t* Vsb = Vs + sub * 64 * NA_VLD;
        if (local) {
            const int kr = rsv[0] + st;
            f32x4 sa[2][2];
#pragma unroll
            for (int kt = 0; kt < 2; ++kt) { sa[0][kt] = (f32x4){0.f, 0.f, 0.f, 0.f}; sa[1][kt] = (f32x4){0.f, 0.f, 0.f, 0.f};
#pragma unroll
                for (int ks = 0; ks < 2; ++ks) { const bf16x8 kf = *(const bf16x8*)(Ksb + (kc0 + kt * 16 + tq) * NA_KLD + hh * 64 + ks * 32 + fq * 8);
                    sa[0][kt] = mfma16(kf, qf[0][ks], sa[0][kt]); sa[1][kt] = mfma16(kf, qf[1][ks], sa[1][kt]); } }
            float alpha[2]; bf16x8 pf[2];
#pragma unroll
            for (int u = 0; u < 2; ++u) {
                const bool act = (kr >= rsv[u]) && (kr < rsv[u] + 8);
                if (!act) { alpha[u] = 1.0f; pf[u] = mk8((u32x4){0u, 0u, 0u, 0u}); continue; }
                const int dr = kr - rqv[u] + 7;
                float sc[8]; float mx = -1e30f; float bs[8];
#pragma unroll
                for (int kt = 0; kt < 2; ++kt)
#pragma unroll
                    for (int r = 0; r < 4; ++r) { const int kcol = kc0 + kt * 16 + fq * 4 + r; int dc = kcol - qcol + 15; dc = dc < 0 ? 0 : (dc > 30 ? 30 : dc);
                        bs[kt * 4 + r] = rpbs[hh * 465 + dr * 31 + dc]; }
#ifndef CPU_EMU
                asm volatile("" : "+v"(bs[0]), "+v"(bs[1]), "+v"(bs[2]), "+v"(bs[3]), "+v"(bs[4]), "+v"(bs[5]), "+v"(bs[6]), "+v"(bs[7]));
#endif
#pragma unroll
                for (int kt = 0; kt < 2; ++kt)
#pragma unroll
                    for (int r = 0; r < 4; ++r) { const int kcol = kc0 + kt * 16 + fq * 4 + r; const bool valid = (kcol >= cs) && (kcol < cs + 16);
                        const float v = valid ? (sa[u][kt][r] * 0.125f + bs[kt * 4 + r]) : -1e30f; sc[kt * 4 + r] = v; mx = fmaxf(mx, v); }
                mx = fmaxf(mx, shx<16>(mx)); mx = fmaxf(mx, shx<32>(mx));
                const float mn = fmaxf(m_run[u], mx); alpha[u] = __expf(m_run[u] - mn); m_run[u] = mn;
                float ps = 0.f; float pv[8];
#pragma unroll
                for (int j = 0; j < 8; ++j) { pv[j] = __expf(sc[j] - mn); ps += pv[j]; }
                ps += shx<16>(ps); ps += shx<32>(ps);
                l_run[u] = l_run[u] * alpha[u] + ps;
                u32x4 pk = {pack2(pv[0], pv[1]), pack2(pv[2], pv[3]), pack2(pv[4], pv[5]), pack2(pv[6], pv[7])};
                pf[u] = mk8(pk);
            }
#pragma unroll
            for (int mt = 0; mt < 4; ++mt) {
                const bf16_t* vp = Vsb + (kc0 + 4 * fq + tq4) * NA_VLD + hh * 64 + mt * 16 + 4 * tp4;
                const bf16x8 vf = mk8(TR16(vp), TR16(vp + 16 * NA_VLD));
                acc[0][mt] = mfma16(vf, pf[0], acc[0][mt] * alpha[0]); acc[1][mt] = mfma16(vf, pf[1], acc[1][mt] * alpha[1]); }
        } else {
            f32x4 sa[2][4];
#pragma unroll
            for (int kt = 0; kt < 4; ++kt) { sa[0][kt] = (f32x4){0.f, 0.f, 0.f, 0.f}; sa[1][kt] = (f32x4){0.f, 0.f, 0.f, 0.f};
#pragma unroll
                for (int ks = 0; ks < 2; ++ks) { const bf16x8 kf = *(const bf16x8*)(Ksb + (kt * 16 + tq) * NA_KLD + hh * 64 + ks * 32 + fq * 8);
                    sa[0][kt] = mfma16(kf, qf[0][ks], sa[0][kt]); sa[1][kt] = mfma16(kf, qf[1][ks], sa[1][kt]); } }
            float alpha[2]; bf16x8 pf[2][2];
#pragma unroll
            for (int u = 0; u < 2; ++u) {
                float mx = -1e30f;
#pragma unroll
                for (int kt = 0; kt < 4; ++kt)
#pragma unroll
                    for (int r = 0; r < 4; ++r) { sa[u][kt][r] *= 0.125f; mx = fmaxf(mx, sa[u][kt][r]); }
                mx = fmaxf(mx, shx<16>(mx)); mx = fmaxf(mx, shx<32>(mx));
                const float mn = fmaxf(m_run[u], mx); alpha[u] = __expf(m_run[u] - mn); m_run[u] = mn;
                float ps = 0.f;
#pragma unroll
                for (int kt = 0; kt < 4; ++kt)
#pragma unroll
                    for (int r = 0; r < 4; ++r) { sa[u][kt][r] = __expf(sa[u][kt][r] - mn); ps += sa[u][kt][r]; }
                ps += shx<16>(ps); ps += shx<32>(ps);
                l_run[u] = l_run[u] * alpha[u] + ps;
#pragma unroll
                for (int h2 = 0; h2 < 2; ++h2) {
                    u32x4 pk = {pack2(sa[u][2 * h2][0], sa[u][2 * h2][1]), pack2(sa[u][2 * h2][2], sa[u][2 * h2][3]), pack2(sa[u][2 * h2 + 1][0], sa[u][2 * h2 + 1][1]), pack2(sa[u][2 * h2 + 1][2], sa[u][2 * h2 + 1][3])};
                    pf[u][h2] = mk8(pk); }
            }
#pragma unroll
            for (int mt = 0; mt < 4; ++mt) { acc[0][mt] = acc[0][mt] * alpha[0]; acc[1][mt] = acc[1][mt] * alpha[1]; }
#pragma unroll
            for (int h2 = 0; h2 < 2; ++h2)
#pragma unroll
                for (int mt = 0; mt < 4; ++mt) { const bf16_t* vp = Vsb + (32 * h2 + 4 * fq + tq4) * NA_VLD + hh * 64 + mt * 16 + 4 * tp4;
                    const bf16x8 vf = mk8(TR16(vp), TR16(vp + 16 * NA_VLD));
                    acc[0][mt] = mfma16(vf, pf[0][h2], acc[0][mt]); acc[1][mt] = mfma16(vf, pf[1][h2], acc[1][mt]); }
        }
        }
    }
#undef NA_FETCH
#undef NA_SRC_ROWS
#pragma unroll
    for (int u = 0; u < 2; ++u) {
        const float il = frcp(l_run[u]);
        const size_t orow = ((size_t)sl << sd.lgseq) + qtok[u];
#pragma unroll
        for (int mt = 0; mt < 4; ++mt) { u32x2 o = {pack2(acc[u][mt][0] * il, acc[u][mt][1] * il), pack2(acc[u][mt][2] * il, acc[u][mt][3] * il)};
            stg((u32x2*)(p.Nb() + orow * 512 + head * 64 + mt * 16 + fq * 4), o); }
    }
}

struct PrefC { RopeRaw rk1, rk2; u32x4 vreg[4], creg[4]; };
DEV void stepC_issue(PrefC& f, const Params& p, const SetDesc& sd, int task) {
    const int tid = TID();
    const int tb = task % sd.ntb, h = (task / sd.ntb) & 3, sl = task / (sd.ntb * 4);
    const int row0 = (sl << sd.lgseq) + tb * 128; const bool latent = !sd.is_ctx; const int tl0 = tb * 128;
    const bf16_t* prow = proj_buf(p, sd) + (size_t)row0 * PWA;
    { const int s = tid & 127, cpi = tid >> 7, cp = (cpi & 1) + (cpi >> 1) * 4; const bf16_t* hp = prow + (size_t)s * PWA + C_KM + h * 64;
      rope_issue(f.rk1, hp, cp, latent, tl0 + s, p.rope()); rope_issue(f.rk2, hp, cp + 2, latent, tl0 + s, p.rope()); }
#pragma unroll
    for (int it = 0; it < 4; ++it) { const int item = tid + it * 512, s = item >> 4, ch = item & 15; f.vreg[it] = ldg((const u32x4*)(prow + (size_t)s * PWA + C_VM + h * 128 + ch * 8)); }
#pragma unroll
    for (int it = 0; it < 4; ++it) { const int item = tid + it * 512, dir = item >> 10, rem = item & 1023, v = rem >> 3, ch = rem & 7;
        f.creg[it] = ldg((const u32x4*)(p.Cin() + (size_t)st_index(sd, sl, h, dir, tb) * 8192 + v * 64 + ch * 8)); }
}
DEV void mlstm_stepC_task(const Params& p, const SetDesc& sd, int layer, int task, int next_task, PrefC& f, char* shm) {
    const int tid = TID(), lane = tid & 63, w = tid >> 6, tq = lane & 15, fq = lane >> 4, tq4 = (lane & 15) >> 2, tp4 = lane & 3;
    const int tb = task % sd.ntb, h = (task / sd.ntb) & 3, sl = task / (sd.ntb * 4);
    const int row0 = (sl << sd.lgseq) + tb * 128; const bool latent = !sd.is_ctx; const int tl0 = tb * 128;
    bf16_t* Ks = (bf16_t*)shm;
    bf16_t* Vs = (bf16_t*)(shm + 128 * K_LD * 2);
    bf16_t* Cs = (bf16_t*)(shm + 128 * K_LD * 2 + 128 * V_LD * 2);
    float* ga = (float*)(shm + 128 * K_LD * 2 * 3 + 128 * V_LD * 2); float* gb = ga + 256; float* gpm = gb + 256; float* gtot = gpm + 256; float* tmp = gtot + 8;
    float* nvs = tmp + 16;
    float* cms = nvs + 128;
    const bf16_t* prow = proj_buf(p, sd) + (size_t)row0 * PWA;
    RopeRaw rq[2];
    { const int t_ = w * 16 + tq; const bf16_t* hp = prow + (size_t)t_ * PWA + C_QM + h * 64;
#pragma unroll
      for (int ks = 0; ks < 2; ++ks) rope_issue(rq[ks], hp, ks * 4 + fq, latent, tl0 + t_, p.rope()); }
    __syncthreads();
    gate_scan(prow, h, p.gate_bias + (size_t)layer * 16, ga, gb, gpm, gtot, tmp);
    {
        const int s = tid & 127, cpi = tid >> 7, cp = (cpi & 1) + (cpi >> 1) * 4;
        float k1[8], k2[8];
        rope_apply(f.rk1, cp, latent, 1.0f, k1);
        rope_apply(f.rk2, cp + 2, latent, 1.0f, k2);
        u32x4 o1 = {pack2(k1[0], k1[1]), pack2(k1[2], k1[3]), pack2(k1[4], k1[5]), pack2(k1[6], k1[7])};
        u32x4 o2 = {pack2(k2[0], k2[1]), pack2(k2[2], k2[3]), pack2(k2[4], k2[5]), pack2(k2[6], k2[7])};
        *(u32x4*)(Ks + s * K_LD + cp * 8) = o1; *(u32x4*)(Ks + s * K_LD + (cp + 2) * 8) = o2;
    }
#pragma unroll
    for (int it = 0; it < 4; ++it) { const int item = tid + it * 512, s = item >> 4, ch = item & 15; *(u32x4*)(Vs + s * V_LD + ch * 8) = f.vreg[it]; }
#pragma unroll
    for (int it = 0; it < 4; ++it) { const int item = tid + it * 512, dir = item >> 10, rem = item & 1023, v = rem >> 3, ch = rem & 7; *(u32x4*)(Cs + (dir * 128 + v) * K_LD + ch * 8) = f.creg[it]; }
    if (tid < 128) nvs[tid] = ldg(p.Cn() + (size_t)st_index(sd, sl, h, tid >> 6, tb) * 64 + (tid & 63));
    if (tid < 2) cms[tid] = ldg(p.Cm() + (size_t)st_index(sd, sl, h, tid, tb) * 4);
    bf16x8 qf[2]; float qv[2][8];
    {
#pragma unroll
        for (int ks = 0; ks < 2; ++ks) { rope_apply(rq[ks], ks * 4 + fq, latent, 0.125f, qv[ks]);
            u32x4 o = {pack2(qv[ks][0], qv[ks][1]), pack2(qv[ks][2], qv[ks][3]), pack2(qv[ks][4], qv[ks][5]), pack2(qv[ks][6], qv[ks][7])}; qf[ks] = mk8(o); }
    }
    if (next_task >= 0) stepC_issue(f, p, sd, next_task);
    __syncthreads();
    const int t = w * 16 + tq;
    f32x4 hsum[8];
#pragma unroll
    for (int mt = 0; mt < 8; ++mt) hsum[mt] = (f32x4){0.f, 0.f, 0.f, 0.f};
#pragma unroll
    for (int dir = 0; dir < 2; ++dir) {
        const float m_in = cms[dir];
        const float Mt = fmaxf(m_in, gpm[dir * 128 + t]);
        const float inter = __expf(m_in - Mt);
        const float mtot = gb[dir * 128 + t] + Mt;
        f32x4 acc[8];
#pragma unroll
        for (int mt = 0; mt < 8; ++mt) { acc[mt] = (f32x4){0.f, 0.f, 0.f, 0.f};
#pragma unroll
            for (int ks = 0; ks < 2; ++ks) { const bf16x8 cf = *(const bf16x8*)(Cs + (dir * 128 + mt * 16 + tq) * K_LD + ks * 32 + fq * 8);
                acc[mt] = mfma16(cf, qf[ks], acc[mt]); }
            acc[mt] = acc[mt] * inter; }
        float qn = 0.f;
#pragma unroll
        for (int ks = 0; ks < 2; ++ks)
#pragma unroll
            for (int j = 0; j < 8; ++j) qn += bf2f(f2bf(qv[ks][j])) * nvs[dir * 64 + ks * 32 + fq * 8 + j];
        qn += shx<16>(qn); qn += shx<32>(qn);
        float den = inter * qn;
        const int u_lo = dir == 0 ? 0 : (w >> 1), u_hi = dir == 0 ? (w >> 1) : 3;
        float rsum = 0.f;
        for (int u = u_lo; u <= u_hi; ++u) {
            unsigned pk[4];
#pragma unroll
            for (int kt = 0; kt < 2; ++kt) { f32x4 sa = {0.f, 0.f, 0.f, 0.f}; const int sb = 32 * u + 16 * kt;
#pragma unroll
                for (int ks = 0; ks < 2; ++ks) { const bf16x8 kf = *(const bf16x8*)(Ks + (sb + tq) * K_LD + ks * 32 + fq * 8); sa = mfma16(kf, qf[ks], sa); }
                float pv[4]; float gv4[4];
#pragma unroll
                for (int r = 0; r < 4; ++r) gv4[r] = ga[dir * 128 + sb + fq * 4 + r];
#ifndef CPU_EMU
                asm volatile("" : "+v"(gv4[0]), "+v"(gv4[1]), "+v"(gv4[2]), "+v"(gv4[3]));
#endif
#pragma unroll
                for (int r = 0; r < 4; ++r) { const int s = sb + fq * 4 + r; const bool valid = dir == 0 ? (s <= t) : (s >= t);
                    pv[r] = valid ? sa[r] * __expf(gv4[r] - Mt) : 0.f; pv[r] = bf2f(f2bf(pv[r])); rsum += pv[r]; }
                pk[kt * 2] = pack2(pv[0], pv[1]); pk[kt * 2 + 1] = pack2(pv[2], pv[3]); }
            u32x4 pkv = {pk[0], pk[1], pk[2], pk[3]}; const bf16x8 pf = mk8(pkv);
#pragma unroll
            for (int mt = 0; mt < 8; ++mt) { const bf16_t* vp = Vs + (32 * u + 4 * fq + tq4) * V_LD + mt * 16 + 4 * tp4;
                const bf16x8 vf = mk8(TR16(vp), TR16(vp + 16 * V_LD));
                acc[mt] = mfma16(vf, pf, acc[mt]); }
        }
        rsum += shx<16>(rsum); rsum += shx<32>(rsum);
        den += rsum;
        const float dn = frcp(fmaxf(fabsf(den), __expf(-mtot)));
#pragma unroll
        for (int mt = 0; mt < 8; ++mt) hsum[mt] = hsum[mt] + acc[mt] * dn;
    }
    float ss = 0.f;
#pragma unroll
    for (int mt = 0; mt < 8; ++mt)
#pragma unroll
        for (int r = 0; r < 4; ++r) ss += hsum[mt][r] * hsum[mt][r];
    ss += shx<16>(ss); ss += shx<32>(ss);
    const float rstd = rsqrtf(ss * (1.0f / 128.0f) + RMS_EPS);
#pragma unroll
    for (int mt = 0; mt < 8; ++mt) { const int v = mt * 16 + fq * 4;
        const u32x2 om = ldg((const u32x2*)(prow + (size_t)t * PWA + C_OM + h * 128 + v));
        u32x2 o = {pack2(hsum[mt][0] * rstd * sigmoidf_(lo16(om.x)), hsum[mt][1] * rstd * sigmoidf_(hi16(om.x))),
                   pack2(hsum[mt][2] * rstd * sigmoidf_(lo16(om.y)), hsum[mt][3] * rstd * sigmoidf_(hi16(om.y)))};
        stg((u32x2*)(p.Mb() + (size_t)(row0 + t) * 512 + h * 128 + v), o); }
}

struct SchedMerge {
    const bf16_t* Mb; const bf16_t* Pb; const bf16_t* Nb; const bf16_t* Wb; int nM;
    DEV bool next(int i, GUnit& u) const { u.aux = i % 3; return tile_order(i / 3, nM, 4, u.pm, u.pn); }
    DEV const bf16_t* a_base(const GUnit& u) const { return (u.aux == 0 ? Mb : (u.aux == 1 ? Pb : Nb)) + (size_t)u.pm * 256 * 512; }
    DEV const bf16_t* b_base(const GUnit& u) const { return Wb + ((size_t)u.aux * 1024 + u.pn * 256) * 512; }
    DEV int grow(const GUnit&, int) const { return 0; }
};
DEV void phase_merge(const Params& p, const SetDesc& sd, int layer, char* shm) {
    SchedMerge S; S.Mb = p.Mb(); S.Pb = p.Pb(); S.Nb = p.Nb(); S.Wb = p.WbT() + (size_t)layer * 3 * 1024 * 512; S.nM = sd.nrows / 256;
    const unsigned char* bgb = p.BG(); bf16_t* mgb = p.MERGED();
    gemm_stream<false, 512, 512, 512>(shm, S, [=](const GUnit& u, f32x4 (&acc)[2][2][4][2], int r0, int c0) -> bool {
        if (u.aux < 2) {
            u32x2 ga[2][4][2], gb[2][4][2];
#pragma unroll
            for (int ai = 0; ai < 2; ++ai)
#pragma unroll
                for (int m = 0; m < 4; ++m)
#pragma unroll
                    for (int hf = 0; hf < 2; ++hf) { const unsigned char* gp = bgb + ((size_t)u.pm * 256 + r0 + ai * 128 + m * 16) * NBG + u.aux * 1024 + u.pn * 256 + c0 + hf * 128;
                        ga[ai][m][hf] = ldg((const u32x2*)gp); gb[ai][m][hf] = ldg((const u32x2*)(gp + 1024)); }
#pragma unroll
            for (int ai = 0; ai < 2; ++ai)
#pragma unroll
                for (int m = 0; m < 4; ++m)
#pragma unroll
                    for (int hf = 0; hf < 2; ++hf) {
#pragma unroll
                        for (int j = 0; j < 4; ++j) { acc[ai][hf][m][0][j] *= u8f(ga[ai][m][hf].x, j) * frcp(u8f(gb[ai][m][hf].x, j)); acc[ai][hf][m][1][j] *= u8f(ga[ai][m][hf].y, j) * frcp(u8f(gb[ai][m][hf].y, j)); } }
            return true;
        }
        u32x2 gm2[2][4][2];
#pragma unroll
        for (int ai = 0; ai < 2; ++ai)
#pragma unroll
            for (int m = 0; m < 4; ++m)
#pragma unroll
                for (int hf = 0; hf < 2; ++hf) gm2[ai][m][hf] = ldg((const u32x2*)(bgb + ((size_t)u.pm * 256 + r0 + ai * 128 + m * 16) * NBG + 2048 + u.pn * 256 + c0 + hf * 128));
#pragma unroll
        for (int ai = 0; ai < 2; ++ai) {
#pragma unroll
            for (int m = 0; m < 4; ++m)
#pragma unroll
                for (int hf = 0; hf < 2; ++hf) { const size_t r = (size_t)u.pm * 256 + r0 + ai * 128 + m * 16;
                    const f32x4 x0 = acc[ai][hf][m][0] * (1.0f / 255.0f), x1 = acc[ai][hf][m][1] * (1.0f / 255.0f); const u32x2 g = gm2[ai][m][hf];
                    u32x4 ov = {pack2(x0[0] * u8f(g.x, 0), x0[1] * u8f(g.x, 1)), pack2(x0[2] * u8f(g.x, 2), x0[3] * u8f(g.x, 3)),
                                pack2(x1[0] * u8f(g.y, 0), x1[1] * u8f(g.y, 1)), pack2(x1[2] * u8f(g.y, 2), x1[3] * u8f(g.y, 3))};
                    stg((u32x4*)(mgb + r * 1024 + u.pn * 256 + c0 + hf * 128), ov); }
        }
        return false; });
}
DEV void phase_outproj(const Params& p, const SetDesc& sd, int layer, char* shm) {
    SchedPlain S; S.A = p.MERGED(); S.Bt = p.WoT() + (size_t)layer * 1024 * 1024; S.nM = sd.nrows / 256; S.nN = 4; S.lda256 = 256 * 1024; S.ldb256 = 256 * 1024;
    bf16_t* yb = p.Y();
    gemm_stream<false, 1024, 1024, 1024>(shm, S, [=](const GUnit& u, const f32x4 (&acc)[2][2][4][2], int r0, int c0) {
#pragma unroll
        for (int ai = 0; ai < 2; ++ai)
#pragma unroll
            for (int m = 0; m < 4; ++m) { bf16_t* o = yb + ((size_t)u.pm * 256 + r0 + ai * 128 + m * 16) * 1024 + u.pn * 256 + c0;
                store8bf(o, acc[ai][0][m][0], acc[ai][0][m][1]); store8bf(o + 128, acc[ai][1][m][0], acc[ai][1][m][1]); } });
}

template <bool SRC_BF> DEV void phase_postmix(const Params& p, const SetDesc& sd, int layer, char* shm) {
    const int tid = TID(), lane = tid & 63, wv = tid >> 6;
    float* wr_s = (float*)shm;
    __syncthreads();
    for (int i = tid; i < 1024 * 16; i += NTHREADS) { const int c = i >> 4, e = i & 15, ln = (c & 511) >> 3, j = c & 7, hf = c >> 9;
        wr_s[((((hf * 8 + j) * 4 + (e >> 2)) * 64 + ln) << 2) + (e & 3)] = ldg(p.router_w + (size_t)layer * 1024 * 16 + i); }
    __syncthreads();
    const float* g1 = p.norm_gain + ((size_t)layer * 4 + 1) * 1024; const float* g2 = p.norm_gain + ((size_t)layer * 4 + 2) * 1024;
    float* par = (float*)(shm + 65536);
    { const int rpb0_ = (sd.nrows + (int)gridDim.x - 1) / (int)gridDim.x; const float* mdb = mod_row(p, sd, layer, min((int)blockIdx.x * rpb0_, sd.nrows - 1));
      stage_params(par, g1, g2, mdb + 2048, mdb + 3072, mdb + 4096); }
    __syncthreads();
    const void* xb = SRC_BF ? (const void*)xbf_base(p, sd) : (const void*)xin_f32(p, sd); bf16_t* xdb = xbf_base(p, sd);
    const int stride = 8; const int rpb_ = (sd.nrows + (int)gridDim.x - 1) / (int)gridDim.x; const int row_end = min(sd.nrows, ((int)blockIdx.x + 1) * rpb_);
    int row = (int)blockIdx.x * rpb_ + wv;
    u32x4 ycur[2], ynxt[2]; XRow<SRC_BF> xcur, xnxt;
    if (row < row_end) {
#pragma unroll
        for (int i = 0; i < 2; ++i) ycur[i] = ldg((const u32x4*)(p.Y() + (size_t)row * 1024 + i * 512 + lane * 8));
        xcur.load(xb, row, lane); }
    for (; row < row_end; row += stride) {
        int ln = lane; HIDE(ln);
        const int rn = row + stride;
        if (rn < row_end) {
#pragma unroll
            for (int i = 0; i < 2; ++i) ynxt[i] = ldg((const u32x4*)(p.Y() + (size_t)rn * 1024 + i * 512 + ln * 8));
            xnxt.load(xb, rn, ln); }
        float y[16]; float ss = 0.f;
#pragma unroll
        for (int hlf = 0; hlf < 2; ++hlf) { const u32x4 m = ycur[hlf];
            const float t8[8] = {lo16(m.x), hi16(m.x), lo16(m.y), hi16(m.y), lo16(m.z), hi16(m.z), lo16(m.w), hi16(m.w)};
#pragma unroll
            for (int j = 0; j < 8; ++j) { y[hlf * 8 + j] = t8[j]; ss += t8[j] * t8[j]; } }
        ss = wave_sum(ss);
        const float rstd = rsqrtf(ss * (1.0f / 1024.0f) + RMS_EPS);
        float xn[16]; float ss2 = 0.f;
#pragma unroll
        for (int hlf = 0; hlf < 2; ++hlf) { f32x4 xw[2];
#pragma unroll
            for (int q = 0; q < 2; ++q) { const int c0 = hlf * 512 + ln * 8 + q * 4; const f32x4 xo = xcur.get(hlf * 2 + q);
#pragma unroll
                for (int j = 0; j < 4; ++j) { const float v = xo[j] + par[2048 + c0 + j] * (y[hlf * 8 + q * 4 + j] * rstd * par[c0 + j]); xw[q][j] = v; xn[hlf * 8 + q * 4 + j] = v; ss2 += v * v; } }
            xrow_store8<true>(xdb, row, hlf * 512 + ln * 8, xw[0], xw[1]); }
        ss2 = wave_sum(ss2);
        const float rstd2 = rsqrtf(ss2 * (1.0f / 1024.0f) + RMS_EPS);
        float lg[16];
#pragma unroll
        for (int e = 0; e < 16; ++e) lg[e] = 0.f;
#pragma unroll
        for (int hlf = 0; hlf < 2; ++hlf) { const int c0 = hlf * 512 + ln * 8; float o[8];
#pragma unroll
            for (int j = 0; j < 8; ++j) { o[j] = xn[hlf * 8 + j] * rstd2 * par[1024 + c0 + j] * (1.0f + par[4096 + c0 + j]) + par[3072 + c0 + j];
#pragma unroll
                for (int eq = 0; eq < 4; ++eq) { const f32x4 w4 = *(const f32x4*)(wr_s + ((((hlf * 8 + j) * 4 + eq) * 64 + ln) << 2));
#pragma unroll
                    for (int e = 0; e < 4; ++e) lg[eq * 4 + e] += o[j] * w4[e]; } }
            const u32x2 ov = {f8pack4(o[0], o[1], o[2], o[3]), f8pack4(o[4], o[5], o[6], o[7])};
            stg((u32x2*)((unsigned char*)p.H() + (size_t)row * 1024 + c0), ov); }
        float r8[8], r4[4], r2[2], r1;
        { const bool b = (lane & 32) != 0;
#pragma unroll
          for (int i = 0; i < 8; ++i) { const float keep = b ? lg[i + 8] : lg[i], send = b ? lg[i] : lg[i + 8]; r8[i] = keep + shx<32>(send); } }
        { const bool b = (lane & 16) != 0;
#pragma unroll
          for (int i = 0; i < 4; ++i) { const float keep = b ? r8[i + 4] : r8[i], send = b ? r8[i] : r8[i + 4]; r4[i] = keep + shx<16>(send); } }
        { const bool b = (lane & 8) != 0;
#pragma unroll
          for (int i = 0; i < 2; ++i) { const float keep = b ? r4[i + 2] : r4[i], send = b ? r4[i] : r4[i + 2]; r2[i] = keep + shx<8>(send); } }
        { const bool b = (lane & 4) != 0; const float keep = b ? r2[1] : r2[0], send = b ? r2[0] : r2[1]; r1 = keep + shx<4>(send); }
        r1 += shx<2>(r1); r1 += shx<1>(r1);
        float mx = r1;
        mx = fmaxf(mx, shx<4>(mx)); mx = fmaxf(mx, shx<8>(mx)); mx = fmaxf(mx, shx<16>(mx)); mx = fmaxf(mx, shx<32>(mx));
        const float ex = __expf(r1 - mx);
        float se = ex;
        se += shx<4>(se); se += shx<8>(se); se += shx<16>(se); se += shx<32>(se);
        if ((lane & 3) == 0) { const int e = ((lane >> 5) & 1) * 8 + ((lane >> 4) & 1) * 4 + ((lane >> 3) & 1) * 2 + ((lane >> 2) & 1);
            stg(p.aff() + (size_t)row * 16 + e, ex * frcp(se)); }
#pragma unroll
        for (int i = 0; i < 2; ++i) ycur[i] = ynxt[i];
        xcur = xnxt;
    }
}

DEV unsigned shxu(unsigned v, int m) {
    const float f = __uint_as_float(v); float r;
    switch (m) { case 1: r = shx<1>(f); break; case 2: r = shx<2>(f); break; case 4: r = shx<4>(f); break; case 8: r = shx<8>(f); break; case 16: r = shx<16>(f); break; default: r = shx<32>(f); break; }
    return __float_as_uint(r);
}
#define TK_CX(a_, b_, desc_) do { const unsigned long long x_ = key[a_], y_ = key[b_]; const bool sw_ = (desc_) ? (x_ < y_) : (x_ > y_); key[a_] = sw_ ? y_ : x_; key[b_] = sw_ ? x_ : y_; } while (0)
template <int TJ> DEV void tk_step_sh(unsigned long long (&key)[4], int tid, bool desc4) {
    unsigned long long pk[4];
#pragma unroll
    for (int m = 0; m < 4; ++m) { const unsigned lo = __float_as_uint(shx<TJ>(__uint_as_float((unsigned)key[m]))), hi = __float_as_uint(shx<TJ>(__uint_as_float((unsigned)(key[m] >> 32))));
        pk[m] = ((unsigned long long)hi << 32) | lo; }
    const bool takemax = desc4 == ((tid & TJ) == 0);
#pragma unroll
    for (int m = 0; m < 4; ++m) { const unsigned long long x = key[m], y = pk[m]; key[m] = takemax ? (x > y ? x : y) : (x < y ? x : y); }
}
DEV void tk_step_lds(unsigned long long (&key)[4], unsigned long long* buf, int tid, int tj, bool active, bool desc4) {
    unsigned long long pk[4];
    __syncthreads();
    if (active) {
#pragma unroll
        for (int m = 0; m < 4; ++m) buf[tid * 4 + m] = key[m]; }
    __syncthreads();
#pragma unroll
    for (int m = 0; m < 4; ++m) pk[m] = active ? buf[(tid ^ tj) * 4 + m] : 0ull;
    const bool takemax = desc4 == ((tid & tj) == 0);
#pragma unroll
    for (int m = 0; m < 4; ++m) { const unsigned long long x = key[m], y = pk[m]; key[m] = takemax ? (x > y ? x : y) : (x < y ? x : y); }
}
DEV void topk_task(const Params& p, const SetDesc& sd, int task, char* shm) {
    const int tid = TID();
    const int e = task & 15, sl = task >> 4;
    unsigned long long* buf = (unsigned long long*)shm;
    const int T = 1 << sd.lgseq, cap = sd.cap;
    const int rbase = sl << sd.lgseq;
    const bool active = tid * 4 < T;
    unsigned long long key[4];
    __syncthreads();
#pragma unroll
    for (int m = 0; m < 4; ++m) { const int i = tid * 4 + m; const float a = active ? ldg(p.aff() + (size_t)(rbase + i) * 16 + e) : 0.f;
        key[m] = ((unsigned long long)__float_as_uint(a) << 32) | (unsigned)(0xFFFFFFFFu - (unsigned)i); }
    for (int k = 2; k <= T; k <<= 1) {
        const bool desc4 = ((tid * 4) & k) == 0;
        for (int j = k >> 1; j >= 256; j >>= 1) tk_step_lds(key, buf, tid, j >> 2, active, desc4);
        if (k >= 256) tk_step_sh<32>(key, tid, desc4);
        if (k >= 128) tk_step_sh<16>(key, tid, desc4);
        if (k >= 64) tk_step_sh<8>(key, tid, desc4);
        if (k >= 32) tk_step_sh<4>(key, tid, desc4);
        if (k >= 16) tk_step_sh<2>(key, tid, desc4);
        if (k >= 8) tk_step_sh<1>(key, tid, desc4);
        if (k >= 4) { TK_CX(0, 2, desc4); TK_CX(1, 3, desc4); TK_CX(0, 1, desc4); TK_CX(2, 3, desc4); }
        else { TK_CX(0, 1, true); TK_CX(2, 3, false); }
    }
    const int sbase = e * sd.rpe + sl * cap;
    if (active) {
#pragma unroll
        for (int m = 0; m < 4; ++m) { const int i = tid * 4 + m; const unsigned long long kv = key[m]; const int tok = (int)(0xFFFFFFFFu - (unsigned)(kv & 0xFFFFFFFFu));
            const int row = rbase + tok;
            if (i < cap) { stg(p.slot_token() + sbase + i, row); stg(p.slot_gate() + sbase + i, __uint_as_float((unsigned)(kv >> 32))); stg(p.token_slots() + (size_t)row * 16 + e, sbase + i); }
            else stg(p.token_slots() + (size_t)row * 16 + e, -1); } }
    if (sl == 0) { const int used = sd.nsamp * cap;
        for (int i = used + tid; i < sd.rpe; i += NTHREADS) { stg(p.slot_token() + e * sd.rpe + i, 0); stg(p.slot_gate() + e * sd.rpe + i, 0.f); } }
}
#undef TK_CX

struct SchedMoe {
    const bf16_t* A; const int* st; const bf16_t* W; int nRT, rpe, nN, wstride;
    DEV bool next(int i, GUnit& u) const { int pmx, pn; if (!tile_order(i, 16 * nRT, nN, pmx, pn)) return false; u.pm = pmx % nRT; u.aux = pmx / nRT; u.pn = pn; return true; }
    DEV int slot0(const GUnit& u) const { return u.aux * rpe + u.pm * 256; }
    DEV const bf16_t* a_base(const GUnit&) const { return A; }
    DEV int grow(const GUnit& u, int i) const { return st ? ldg(st + slot0(u) + i) : slot0(u) + i; }
    DEV const bf16_t* b_base(const GUnit& u) const { return W + (size_t)u.aux * wstride + (size_t)u.pn * 256 * 512; }
};
DEV void phase_moe_gu(const Params& p, const SetDesc& sd, int layer, char* shm) {
    SchedMoe S; S.A = p.H(); S.st = p.slot_token(); S.W = p.WguT() + (size_t)layer * 16 * 2048 * 512; S.nRT = sd.rpe / 256; S.rpe = sd.rpe; S.nN = 8; S.wstride = 2048 * 512;
    unsigned char* hb = (unsigned char*)p.HID();
    gemm_stream<true, 512, 512, 512, true>(shm, S, [=](const GUnit& u, const f32x4 (&acc)[2][2][4][2], int r0, int c0) {
#pragma unroll
        for (int ai = 0; ai < 2; ++ai)
#pragma unroll
            for (int m = 0; m < 4; ++m) { f32x4 h0, h1; const f32x4 a0 = acc[ai][0][m][0] * F8_WINV, a1 = acc[ai][0][m][1] * F8_WINV, b0 = acc[ai][1][m][0] * F8_WINV, b1 = acc[ai][1][m][1] * F8_WINV;
#pragma unroll
                for (int j = 0; j < 4; ++j) { h0[j] = a0[j] * sigmoidf_(a0[j]) * b0[j]; h1[j] = a1[j] * sigmoidf_(a1[j]) * b1[j]; }
                const u32x2 hv = {f8pack4(h0[0], h0[1], h0[2], h0[3]), f8pack4(h1[0], h1[1], h1[2], h1[3])};
                stg((u32x2*)(hb + ((size_t)S.slot0(u) + r0 + ai * 128 + m * 16) * 1024 + u.pn * 128 + c0), hv); } });
}
DEV void phase_moe_down(const Params& p, const SetDesc& sd, int layer, char* shm) {
    SchedMoe S; S.A = p.HID(); S.st = nullptr; S.W = p.WdT() + (size_t)layer * 16 * 1024 * 512; S.nRT = sd.rpe / 256; S.rpe = sd.rpe; S.nN = 4; S.wstride = 1024 * 512;
    unsigned char* yb = (unsigned char*)p.YE(); const float* gt = p.slot_gate();
    gemm_stream<true, 512, 512, 512, true>(shm, S, [=](const GUnit& u, const f32x4 (&acc)[2][2][4][2], int r0, int c0) {
#pragma unroll
        for (int ai = 0; ai < 2; ++ai) {
            float gv[4];
#pragma unroll
            for (int m = 0; m < 4; ++m) gv[m] = ldg(gt + (size_t)S.slot0(u) + r0 + ai * 128 + m * 16) * (F8_WINV * YE_SCALE);
#pragma unroll
            for (int m = 0; m < 4; ++m) { const size_t sl = (size_t)S.slot0(u) + r0 + ai * 128 + m * 16; const float g = gv[m];
                unsigned char* o = yb + sl * 1024 + u.pn * 256 + c0;
#pragma unroll
                for (int hf = 0; hf < 2; ++hf) { const f32x4 a = acc[ai][hf][m][0] * g, b = acc[ai][hf][m][1] * g;
                    const u32x2 ov = {f8pack4(a[0], a[1], a[2], a[3]), f8pack4(b[0], b[1], b[2], b[3])}; stg((u32x2*)(o + hf * 128), ov); } } } });
}

DEV void compact4(const int (&sl)[16], int (&c)[4], int& n) {
    n = 0; c[0] = -1; c[1] = -1; c[2] = -1; c[3] = -1;
#pragma unroll
    for (int e = 0; e < 16; ++e) if (sl[e] >= 0) { c[0] = (n == 0) ? sl[e] : c[0]; c[1] = (n == 1) ? sl[e] : c[1]; c[2] = (n == 2) ? sl[e] : c[2]; c[3] = (n == 3) ? sl[e] : c[3]; ++n; }
}
template <bool DST_F32> DEV void phase_combine(const Params& p, const SetDesc& sd, int layer, char* shm) {
    const int tid = TID(), lane = tid & 63, wv = tid >> 6;
    const float* g3 = p.norm_gain + ((size_t)layer * 4 + 3) * 1024;
    const bf16_t* xsb = xbf_base(p, sd); void* xdb = DST_F32 ? (void*)xout_f32(p, sd) : (void*)xbf_base(p, sd);
    const int stride = 8; const int rpb_ = (sd.nrows + (int)gridDim.x - 1) / (int)gridDim.x; const int row_end = min(sd.nrows, ((int)blockIdx.x + 1) * rpb_);
    int row = __builtin_amdgcn_readfirstlane((int)blockIdx.x * rpb_ + wv);
    float* par = (float*)shm;
    __syncthreads();
    { const float* mdb = mod_row(p, sd, layer, min((int)blockIdx.x * rpb_, sd.nrows - 1)); stage_params(par, g3, mdb + 5120, nullptr, nullptr, nullptr); }
    __syncthreads();
    int raw[16]; int cc[4], cn[4]; int nc = 0, nn = 0;
    u32x2 mc[4][2], mn[4][2]; XRow<true> xc, xn;
#define CMB_SLOTS(r_) do { _Pragma("unroll") for (int e = 0; e < 16; ++e) raw[e] = ldg(p.token_slots() + (size_t)(r_) * 16 + e); } while (0)
#define CMB_DATA(r_, c_, n_, m_, x_) do { _Pragma("unroll") for (int k = 0; k < 4; ++k) { \
            if (k < (n_)) { const unsigned char* yr = (const unsigned char*)p.YE() + (size_t)(c_)[k] * 1024 + lane * 8; (m_)[k][0] = ldg((const u32x2*)yr); (m_)[k][1] = ldg((const u32x2*)(yr + 512)); } \
            else { (m_)[k][0] = (u32x2){0u, 0u}; (m_)[k][1] = (u32x2){0u, 0u}; } } \
        (x_).load(xsb, (r_), lane); } while (0)
    if (row < row_end) { CMB_SLOTS(row); compact4(raw, cc, nc); CMB_DATA(row, cc, nc, mc, xc); if (row + stride < row_end) CMB_SLOTS(row + stride); }
    for (; row < row_end; row += stride) {
        const int rn = row + stride;
        if (rn < row_end) { compact4(raw, cn, nn); CMB_DATA(rn, cn, nn, mn, xn); if (rn + stride < row_end) CMB_SLOTS(rn + stride); }
        float y[16];
#pragma unroll
        for (int j = 0; j < 16; ++j) y[j] = 0.f;
        if (nc <= 4) {
#pragma unroll
            for (int k = 0; k < 4; ++k)
                if (k < nc) {
#pragma unroll
                    for (int hlf = 0; hlf < 2; ++hlf) { const f32x4 a = f8x4_f32(mc[k][hlf].x), b = f8x4_f32(mc[k][hlf].y);
#pragma unroll
                        for (int j = 0; j < 4; ++j) { y[hlf * 8 + j] += a[j]; y[hlf * 8 + 4 + j] += b[j]; } } }
        } else {
            for (int e = 0; e < 16; ++e) { const int sl_ = ldg(p.token_slots() + (size_t)row * 16 + e);
                if (sl_ >= 0) { const unsigned char* yr = (const unsigned char*)p.YE() + (size_t)sl_ * 1024 + lane * 8;
#pragma unroll
                    for (int hlf = 0; hlf < 2; ++hlf) { const u32x2 m = ldg((const u32x2*)(yr + hlf * 512)); const f32x4 a = f8x4_f32(m.x), b = f8x4_f32(m.y);
#pragma unroll
                        for (int j = 0; j < 4; ++j) { y[hlf * 8 + j] += a[j]; y[hlf * 8 + 4 + j] += b[j]; } } } }
        }
        float ss = 0.f;
#pragma unroll
        for (int j = 0; j < 16; ++j) ss += y[j] * y[j];
        ss = wave_sum(ss);
        const float rstd = rsqrtf(ss * (YE_INV * YE_INV / 1024.0f) + RMS_EPS) * YE_INV;
#pragma unroll
        for (int hlf = 0; hlf < 2; ++hlf) { f32x4 xv[2];
#pragma unroll
            for (int q = 0; q < 2; ++q) { const int c0 = hlf * 512 + lane * 8 + q * 4; xv[q] = xc.get(hlf * 2 + q);
#pragma unroll
                for (int j = 0; j < 4; ++j) xv[q][j] += par[1024 + c0 + j] * (y[hlf * 8 + q * 4 + j] * rstd * par[c0 + j]); }
            xrow_store8<!DST_F32>(xdb, row, hlf * 512 + lane * 8, xv[0], xv[1]); }
        nc = nn;
#pragma unroll
        for (int k = 0; k < 4; ++k) { cc[k] = cn[k]; mc[k][0] = mn[k][0]; mc[k][1] = mn[k][1]; }
        xc = xn;
    }
#undef CMB_SLOTS
#undef CMB_DATA
}

constexpr int WQ_WORD0 = 4096;
template <class F> DEV void wq_run(const Params& p, int qidx, int ntasks, char* shm, F&& task) {
    unsigned* ctr = p.bar() + WQ_WORD0 + 64 * qidx;
    volatile int* slot = (volatile int*)(shm + 131072 + 64);
    const int tid = TID();
    int cur = blockIdx.x;
    while (cur < ntasks) {
        unsigned pend = 0u;
        if (tid == 0) pend = atomicAdd(ctr, 1u);
        task(cur);
        __syncthreads();
        if (tid == 0) *slot = (int)gridDim.x + (int)pend;
        __syncthreads();
        cur = *slot;
    }
}

template <int PH> DEV void do_phase(const Params& p, int layer, int is_ctx, int grp, char* shm) {
    const SetDesc sd = make_set(is_ctx, grp);
    if constexpr (PH == -1) phase_prologue(p, shm);
    if constexpr (PH == 0) { if (layer == 0) phase_norm1<false>(p, sd, layer, shm); else phase_norm1<true>(p, sd, layer, shm); }
    if constexpr (PH == 1) phase_proj_a(p, sd, layer, shm);
    const int qbase = ((layer * 3 + (is_ctx ? 0 : grp + 1)) * 13 + (PH < 0 ? 0 : PH)) * 2;
    if constexpr (PH == 2) {
        { const int nt = sd.nsamp * 4 * sd.ntb, G_ = (int)gridDim.x; int t = blockIdx.x;
          if (t < nt) { PrefA f; stepA_issue(f, p, sd, t); for (; t < nt; t += G_) mlstm_stepA_task(p, sd, layer, t, t + G_ < nt ? t + G_ : -1, f, shm); } }
        if (!(is_ctx && layer == 1)) phase_pool(p, sd); }
    if constexpr (PH == 3) {
        for (int t = blockIdx.x; t < sd.nsamp * 32; t += gridDim.x) mlstm_stepB_task(p, sd, t);
        if (!(is_ctx && layer == 1)) {
            const int nq = (is_ctx ? (CTX / 64) : ROWS) / 2;
            wq_run(p, qbase, sd.nsamp * nq * 4, shm, [&](int t) { na_task(p, sd, layer, t / (nq * 4), (t >> 2) % nq, t & 3, shm); });
        }
    }
    if constexpr (PH == 4) { const int nt = sd.nsamp * 4 * sd.ntb, G_ = (int)gridDim.x; int t = blockIdx.x;
        if (t < nt) { PrefC f; stepC_issue(f, p, sd, t); for (; t < nt; t += G_) mlstm_stepC_task(p, sd, layer, t, t + G_ < nt ? t + G_ : -1, f, shm); } }
    if constexpr (PH == 6) phase_merge(p, sd, layer, shm);
    if constexpr (PH == 7) phase_outproj(p, sd, layer, shm);
    if constexpr (PH == 8) { if (layer == 0) phase_postmix<false>(p, sd, layer, shm); else phase_postmix<true>(p, sd, layer, shm); }
    if constexpr (PH == 9) { for (int t = blockIdx.x; t < sd.nsamp * 16; t += gridDim.x) topk_task(p, sd, t, shm); }
    if constexpr (PH == 10) phase_moe_gu(p, sd, layer, shm);
    if constexpr (PH == 11) phase_moe_down(p, sd, layer, shm);
    if constexpr (PH == 12) { if (layer == 0) phase_combine<false>(p, sd, layer, shm); else phase_combine<true>(p, sd, layer, shm); }
}

#ifndef CPU_EMU
template <int PH> __global__ void __launch_bounds__(NTHREADS, 2) k_phase(Params p, int layer, int is_ctx, int grp) {
    DYN_LDS(shm);
    do_phase<PH>(p, layer, is_ctx, grp, shm);
}
#ifndef DBL_MASK
#define DBL_MASK 0
#endif
#define RUNPH(PH) do { do_phase<PH>(p, layer, is_ctx, grp, shm); xcd_barrier(bar); if ((DBL_MASK >> (PH)) & 1) { do_phase<PH>(p, layer, is_ctx, grp, shm); xcd_barrier(bar); } } while (0)
__global__ void __launch_bounds__(NTHREADS, 2) k_mega(Params p) {
    DYN_LDS(shm);
    uint4* xbw = (uint4*)(shm + 131072);
    if (threadIdx.x == 0) *xbw = make_uint4(0u, 0u, 0u, 0u);
    __syncthreads();
    XcdBarrier bar = xcd_barrier_post(p.bar(), (volatile LAS unsigned*)xbw);
    do_phase<-1>(p, 0, 0, 0, shm);
    xcd_barrier(bar);
    for (int layer = 0; layer < 2; ++layer)
        for (int si = 0; si <= NG; ++si) {
            const int is_ctx = si == 0 ? 1 : 0, grp = si == 0 ? 0 : si - 1;
            RUNPH(0); RUNPH(1); RUNPH(2);
            if (is_ctx && layer == 1) { do_phase<3>(p, layer, is_ctx, grp, shm); continue; }
            RUNPH(3); RUNPH(4); RUNPH(6); RUNPH(7); RUNPH(8); RUNPH(9); RUNPH(10); RUNPH(11);
            do_phase<12>(p, layer, is_ctx, grp, shm);
        }
}
#endif
}

static Params make_params(void* const* d_in, void* d_out, void* d_ws) {
    Params p{};
    p.x = (const float*)d_in[0]; p.c = (const float*)d_in[1]; p.ctx = (const float*)d_in[2]; p.c_ctx = (const float*)d_in[3];
    p.norm_gain = (const float*)d_in[4]; p.ada_w = (const float*)d_in[5]; p.ada_b = (const float*)d_in[6]; p.w_in = (const float*)d_in[7];
    p.gate_bias = (const float*)d_in[8]; p.pool_w = (const float*)d_in[9]; p.pool_scale = (const float*)d_in[10]; p.rpb = (const float*)d_in[11];
    p.w_branch = (const float*)d_in[12]; p.w_out = (const float*)d_in[13]; p.router_w = (const float*)d_in[14];
    p.w_gate = (const float*)d_in[15]; p.w_up = (const float*)d_in[16]; p.w_down = (const float*)d_in[17];
    p.out = (float*)d_out; p.ws = (char*)d_ws;
    return p;
}

#ifdef CPU_EMU
int emu_cfg_B = CFG_B, emu_cfg_ROWS = CFG_ROWS, emu_cfg_CTX = CFG_CTX;
const char* g_dumpdir = "data";
static void* g_ws = nullptr;
static void dump_buf(const char* name, int layer, int is_ctx, int grp, const void* ptr, size_t bytes) {
    char nm[512]; snprintf(nm, sizeof nm, "%s/d_L%d_%s%d_%s.bin", g_dumpdir, layer, is_ctx ? "c" : "g", grp, name);
    FILE* f = fopen(nm, "wb"); fwrite(ptr, 1, bytes, f); fclose(f);
}
static void emu_hook(const Params& p, int layer, int is_ctx, int grp, int ph) {
    const size_t Rn = is_ctx ? RC : RL;
    if (ph == 0) dump_buf("H", layer, is_ctx, grp, p.H(), Rn * 1024 * 2);
    if (ph == 1) dump_buf("PROJ", layer, is_ctx, grp, is_ctx ? p.PROJc() : p.PROJa(), Rn * PWA * 2);
    if (ph == 2) dump_buf("Pb", layer, is_ctx, grp, p.Pb(), Rn * 512 * 2);
    if (ph == 3) dump_buf("Nb", layer, is_ctx, grp, p.Nb(), Rn * 512 * 2);
    if (ph == 4) dump_buf("Mb", layer, is_ctx, grp, p.Mb(), Rn * 512 * 2);
    if (ph == 1) dump_buf("BG", layer, is_ctx, grp, p.BG(), Rn * NBG);
    if (ph == 6) dump_buf("MERGED", layer, is_ctx, grp, p.MERGED(), Rn * 1024 * 2);
    if (ph == 7) dump_buf("Y", layer, is_ctx, grp, p.Y(), Rn * 1024 * 2);
    if (ph == 8) { dump_buf("H2", layer, is_ctx, grp, p.H(), Rn * 1024 * 2); dump_buf("aff", layer, is_ctx, grp, p.aff(), Rn * 16 * 4); }
}
void emu_dump(const char* dir) {
    char nm[512]; snprintf(nm, sizeof nm, "%s/d_mod.bin", dir);
    FILE* f = fopen(nm, "wb"); fwrite((char*)g_ws + WSL.mod, 1, (size_t)2 * (NB + 1) * 6144 * 4, f); fclose(f);
    snprintf(nm, sizeof nm, "%s/d_ctxs.bin", dir);
    f = fopen(nm, "wb"); fwrite((char*)g_ws + WSL.ctxs, 1, (size_t)NB * CTX * 1024 * 2, f); fclose(f);
}
template <int PH> static void emu_run_phase(const Params& p, int layer, int is_ctx, int grp, int nblocks) {
    emu_launch_lambda([=]() { do_phase<PH>(p, layer, is_ctx, grp, emu_blk->smem); }, nblocks, NTHREADS, LDS_BYTES);
    if (PH >= 0) emu_hook(p, layer, is_ctx, grp, PH);
    printf("phase %d layer %d ctx %d grp %d done\n", PH, layer, is_ctx, grp); fflush(stdout);
}
#define LAUNCH_PHASE(PH) emu_run_phase<PH>(p, layer, is_ctx, grp, nblocks)
#else
#define LAUNCH_PHASE(PH) hipLaunchKernelGGL((k_phase<PH>), dim3(nblocks), dim3(NTHREADS), LDS_BYTES, stream, p, layer, is_ctx, grp)
#define SETATTR(PH) (void)hipFuncSetAttribute((const void*)k_phase<PH>, hipFuncAttributeMaxDynamicSharedMemorySize, LDS_BYTES)
#endif

extern "C" void kernel_launch(void* const* d_in, const int* in_sizes, int n_in, void* d_out, int out_size, void* d_ws, size_t ws_size, hipStream_t stream) {
    (void)in_sizes; (void)n_in; (void)out_size;
    if (ws_size < WSL.total) return;
    Params p = make_params(d_in, d_out, d_ws);
#ifdef CPU_EMU
    g_ws = d_ws;
    memset(d_ws, 0xFF, WSL.total);
    memset((char*)d_ws + WSL.bar, 0, 65536);
    const int nblocks = 16;
#else
    const int nblocks = 256;
#if MK_ONE_LAUNCH
    static int grid = 0;
    if (!grid) {
        (void)hipFuncSetAttribute((const void*)k_mega, hipFuncAttributeMaxDynamicSharedMemorySize, LDS_BYTES);
        int dev = 0, cus = 0, per_cu = 0;
        (void)hipGetDevice(&dev);
        (void)hipDeviceGetAttribute(&cus, hipDeviceAttributeMultiprocessorCount, dev);
        (void)hipOccupancyMaxActiveBlocksPerMultiprocessor(&per_cu, (const void*)k_mega, NTHREADS, LDS_BYTES);
        if (per_cu > 1) per_cu = 1;
        grid = cus * per_cu;
        if (grid > 256) grid = 256;
    }
    if (grid <= 0) return;
    (void)hipMemsetAsync(p.bar(), 0, 65536, stream);
    hipLaunchKernelGGL(k_mega, dim3(grid), dim3(NTHREADS), LDS_BYTES, stream, p);
    return;
#else
    static bool attr_done = false;
    if (!attr_done) { SETATTR(-1); SETATTR(0); SETATTR(1); SETATTR(2); SETATTR(3); SETATTR(4); SETATTR(5); SETATTR(6); SETATTR(7); SETATTR(8); SETATTR(9); SETATTR(10); SETATTR(11); SETATTR(12); attr_done = true; }
#endif
#endif
    { const int layer = 0, is_ctx = 0, grp = 0; LAUNCH_PHASE(-1); }
    for (int layer = 0; layer < 2; ++layer)
        for (int si = 0; si <= NG; ++si) {
            const int is_ctx = si == 0 ? 1 : 0, grp = si == 0 ? 0 : si - 1;
            LAUNCH_PHASE(0); LAUNCH_PHASE(1); LAUNCH_PHASE(2); LAUNCH_PHASE(3);
            if (is_ctx && layer == 1) continue;
            LAUNCH_PHASE(4); LAUNCH_PHASE(6); LAUNCH_PHASE(7); LAUNCH_PHASE(8); LAUNCH_PHASE(9); LAUNCH_PHASE(10); LAUNCH_PHASE(11); LAUNCH_PHASE(12);
        }
}
```

```cpp
#ifdef CPU_EMU
#include "emu.h"
#define DYN_LDS(p) char* p = emu_blk->smem
#define WAIT_V(n)
#define WAIT_L(n)
#define HIDE(v)
#define CBAR()
#else
#include <hip/hip_runtime.h>
#define DYN_LDS(p) extern __shared__ __attribute__((aligned(16))) char p[]
#define WAIT_V(n) asm volatile("s_waitcnt vmcnt(" #n ")" ::: "memory")
#define WAIT_L(n) asm volatile("s_waitcnt lgkmcnt(" #n ")" ::: "memory")
#define HIDE(v) asm volatile("" : "+v"(v))
#define CBAR() asm volatile("" ::: "memory")
#endif
#include <stdint.h>
#include <stddef.h>

#ifndef CFG_B
#define CFG_B 32
#define CFG_ROWS 32
#define CFG_CTX 256
#define CFG_G 16
#endif
#ifndef MK_ONE_LAUNCH
#define MK_ONE_LAUNCH 1
#endif

#define DEV __device__ __forceinline__
typedef short s16x4 __attribute__((ext_vector_type(4)));
#ifdef CPU_EMU
#define TR16(ptr) emu_tr16((const void*)(ptr))
#else
typedef __attribute__((address_space(3))) s16x4 lds_s16x4;
#define TR16(ptr) __builtin_amdgcn_ds_read_tr16_b64_v4i16((lds_s16x4*)(ptr))
#endif
#ifdef CPU_EMU
#define TID() (threadIdx.x)
#else
#define TID() ({ int t_ = threadIdx.x; asm volatile("" : "+v"(t_)); t_; })
#endif

typedef unsigned short bf16_t;
typedef short bf16x8 __attribute__((ext_vector_type(8)));
typedef float f32x4 __attribute__((ext_vector_type(4)));
typedef unsigned u32x2 __attribute__((ext_vector_type(2)));
typedef unsigned u32x4 __attribute__((ext_vector_type(4)));

namespace {
constexpr int D = 1024, NB = CFG_B, ROWS = CFG_ROWS, SEQ = ROWS * 64, CTX = CFG_CTX, G = CFG_G, NG = NB / G;
constexpr int RL = G * SEQ, RC = NB * CTX, RMAX = RL > RC ? RL : RC;
constexpr int PWA = 3840, NBG = 3072, PWT = PWA + NBG, PWSRC = 6672, C_SPLIT = 3600;
constexpr int C_QM = 0, C_KM = 256, C_PU = 512, C_GM = 1024, C_PADA = 1040, C_F8 = 1280, C_QN = 1280, C_KN = 1792, C_VM = 2304, C_OM = 2816, C_VN = 3328;
constexpr int proj_col(int n) { return n < 512 ? n : n < 1536 ? n + 1792 : n < 1552 ? n - 512 : n < 2064 ? n - 1040 : n < 3088 ? n - 784 : n + 240; }
static_assert(proj_col(512) == C_VM && proj_col(1024) == C_OM && proj_col(1536) == C_GM && proj_col(1552) == C_PU && proj_col(2064) == C_QN && proj_col(2576) == C_KN && proj_col(3088) == C_VN && proj_col(3599) == PWA - 1, "projection column map");
constexpr int NTBL = SEQ / 128, NTBC = CTX / 128;
constexpr int ilog2(int x) { return x <= 1 ? 0 : 1 + ilog2(x >> 1); }
constexpr int LGSEQ = ilog2(SEQ), LGCTX = ilog2(CTX);
static_assert((1 << LGSEQ) == SEQ && (1 << LGCTX) == CTX, "sequence lengths must be powers of two");
constexpr int cdiv(int a, int b) { return (a + b - 1) / b; }
constexpr int RPE_L = cdiv(G * (SEQ / 8), 256) * 256, RPE_C = cdiv(NB * (CTX / 8), 256) * 256, RPE_MAX = RPE_L > RPE_C ? RPE_L : RPE_C;
constexpr int NSLOT = 16 * RPE_MAX;
constexpr int NTHREADS = 512;
constexpr int GT_MAXU = 12;
constexpr int LDS_BYTES = 131072 + 256 + GT_MAXU * 1024;
constexpr int NST_L = G * 4 * 2 * NTBL, NST_C = NB * 4 * 2 * NTBC, NST = NST_L > NST_C ? NST_L : NST_C;
constexpr int NCI = NB * 4 * 2;
constexpr float RMS_EPS = 1e-6f;

struct WsLayout { size_t bar, WinT, WbT, WoT, WguT, WdT, mod, rope, ctxs, xb, PROJc, CiC, Cin_, Cim, H, H8, PROJa, Sst, Cin, Mb, Pb, Nb, Sn, Ssc, Cn, Cm, aff, slot_token, slot_gate, token_slots, HID, YE, BG, MERGED, Y, total; };
constexpr size_t al(size_t x) { return (x + 255) / 256 * 256; }
constexpr size_t smax(size_t a, size_t b) { return a > b ? a : b; }
constexpr WsLayout make_layout() {
    WsLayout L{}; size_t o = 0;
    L.bar = o; o += al(65536);
    L.WinT = o; o += al((size_t)2 * PWT * 1024 * 2);
    L.WbT = o; o += al((size_t)2 * 3 * 1024 * 512 * 2);
    L.WoT = o; o += al((size_t)2 * 1024 * 1024 * 2);
    L.WguT = o; o += al((size_t)2 * 16 * 2048 * 1024);
    L.WdT = o; o += al((size_t)2 * 16 * 1024 * 1024);
    L.mod = o; o += al((size_t)2 * (NB + 1) * 6144 * 4);
    L.rope = o; o += al((size_t)(ROWS + 64) * 16 * 2 * 4);
    L.ctxs = o; o += al((size_t)NB * CTX * 1024 * 2);
    L.xb = o; o += al((size_t)NB * SEQ * 1024 * 2);
    L.PROJc = o; o += al((size_t)RC * PWA * 2);
    L.CiC = o; o += al((size_t)NCI * 8192 * 4);
    L.Cin_ = o; o += al((size_t)NCI * 64 * 4);
    L.Cim = o; o += al((size_t)NCI * 4 * 4);
    L.H = o; o += al((size_t)RMAX * 1024 * 2);
    L.H8 = o; o += al((size_t)RMAX * 1024);
    const size_t x0 = o;
    L.PROJa = o; o += al((size_t)RMAX * PWA * 2);
    L.Sst = o; o += al((size_t)NST * 8192 * 4);
    L.Cin = o; o += al((size_t)NST * 8192 * 2);
    const size_t hid = al((size_t)NSLOT * 1024 * 2);
    o = x0 + smax(o - x0, 2 * hid);
    L.HID = x0; L.YE = x0 + hid;
    L.Mb = o; o += al((size_t)RMAX * 512 * 2);
    L.Pb = o; o += al((size_t)RMAX * 512 * 2);
    L.Nb = o; o += al((size_t)RMAX * 512 * 2);
    L.MERGED = L.H; L.Y = L.Mb;
    L.BG = o; o += al((size_t)RMAX * NBG);
    L.Sn = o; o += al((size_t)NST * 64 * 4);
    L.Ssc = o; o += al((size_t)NST * 4 * 4);
    L.Cn = o; o += al((size_t)NST * 64 * 4);
    L.Cm = o; o += al((size_t)NST * 4 * 4);
    L.aff = o; o += al((size_t)RMAX * 16 * 4);
    L.slot_token = o; o += al((size_t)NSLOT * 4);
    L.slot_gate = o; o += al((size_t)NSLOT * 4);
    L.token_slots = o; o += al((size_t)RMAX * 16 * 4);
    L.total = o;
    return L;
}
constexpr WsLayout WSL = make_layout();
static_assert(CFG_B != 32 || WSL.total <= ((size_t)1 << 30), "workspace budget");

struct Params {
    const float *x, *c, *ctx, *c_ctx, *norm_gain, *ada_w, *ada_b, *w_in, *gate_bias, *pool_w, *pool_scale, *rpb, *w_branch, *w_out, *router_w, *w_gate, *w_up, *w_down;
    float* out;
    char* ws;
#ifdef CPU_EMU
#define WSF(T, name) __device__ __host__ __forceinline__ T* name() const { return (T*)(ws + WSL.name); }
#else
#if defined(__HIP_DEVICE_COMPILE__)
#define WSF(T, name) __device__ __host__ __forceinline__ T* name() const { char* w_ = ws; asm volatile("" : "+s"(w_)); return (T*)(__attribute__((address_space(1))) T*)(w_ + WSL.name); }
#else
#define WSF(T, name) __device__ __host__ __forceinline__ T* name() const { return (T*)(ws + WSL.name); }
#endif
#endif
    WSF(unsigned, bar) WSF(bf16_t, WinT) WSF(bf16_t, WbT) WSF(bf16_t, WoT) WSF(bf16_t, WguT) WSF(bf16_t, WdT)
    WSF(float, mod) WSF(float, rope) WSF(bf16_t, ctxs) WSF(bf16_t, xb) WSF(bf16_t, PROJc) WSF(float, CiC) WSF(float, Cin_) WSF(float, Cim)
    WSF(bf16_t, H) WSF(unsigned char, H8) WSF(bf16_t, PROJa) WSF(float, Sst) WSF(bf16_t, Cin) WSF(bf16_t, Mb) WSF(bf16_t, Pb) WSF(bf16_t, Nb)
    WSF(float, Sn) WSF(float, Ssc) WSF(float, Cn) WSF(float, Cm) WSF(float, aff) WSF(int, slot_token) WSF(float, slot_gate) WSF(int, token_slots)
    WSF(bf16_t, HID) WSF(bf16_t, YE) WSF(unsigned char, BG) WSF(bf16_t, MERGED) WSF(bf16_t, Y)
#undef WSF
};

struct SetDesc { int is_ctx, nrows, samp0, nsamp, lgseq, ntb, cap, rpe; };
DEV SetDesc make_set(int is_ctx, int grp) {
    SetDesc s;
    s.is_ctx = is_ctx;
    if (is_ctx) { s.nrows = RC; s.samp0 = 0; s.nsamp = NB; s.lgseq = LGCTX; s.ntb = NTBC; s.cap = CTX / 8; s.rpe = RPE_C; }
    else { s.nrows = RL; s.samp0 = grp * G; s.nsamp = G; s.lgseq = LGSEQ; s.ntb = NTBL; s.cap = SEQ / 8; s.rpe = RPE_L; }
    return s;
}

#ifdef CPU_EMU
#define GAS
#else
#define GAS __attribute__((address_space(1)))
#endif
template <class T> DEV T ldg(const T* p) { return *(const GAS T*)p; }
template <class T> DEV void stg(T* p, const T& v) { *(GAS T*)p = v; }
DEV float bf2f(bf16_t v) { return __uint_as_float(((unsigned)v) << 16); }
DEV bf16_t f2bf(float f) { unsigned u = __float_as_uint(f); u += 0x7FFFu + ((u >> 16) & 1u); return (bf16_t)(u >> 16); }
#if defined(__HIP_DEVICE_COMPILE__)
typedef __bf16 bf16n2 __attribute__((ext_vector_type(2)));
typedef float f32n2 __attribute__((ext_vector_type(2)));
DEV unsigned pack2(float lo, float hi) { f32n2 v = {lo, hi}; bf16n2 r = __builtin_convertvector(v, bf16n2); return __builtin_bit_cast(unsigned, r); }
#else
DEV unsigned pack2(float lo, float hi) { return (unsigned)f2bf(lo) | ((unsigned)f2bf(hi) << 16); }
#endif
DEV float lo16(unsigned u) { return __uint_as_float(u << 16); }
DEV float hi16(unsigned u) { return __uint_as_float(u & 0xFFFF0000u); }
#if defined(__HIP_DEVICE_COMPILE__)
DEV float frcp(float x) { return __builtin_amdgcn_rcpf(x); }
#else
DEV float frcp(float x) { return 1.0f / x; }
#endif
#if defined(__HIP_DEVICE_COMPILE__)
DEV float sigmoidf_(float x) { return __builtin_amdgcn_rcpf(1.0f + __expf(-x)); }
#else
DEV float sigmoidf_(float x) { return 1.0f / (1.0f + __expf(-x)); }
#endif
DEV float logsigmoidf_(float x) { return fminf(x, 0.0f) - __logf(1.0f + __expf(-fabsf(x))); }
template <int M> DEV float shx(float v) {
#if defined(__HIP_DEVICE_COMPILE__)
    const unsigned u = __builtin_bit_cast(unsigned, v);
    if constexpr (M == 1) return __builtin_bit_cast(float, __builtin_amdgcn_update_dpp(u, u, 0xB1, 0xF, 0xF, false));
    else if constexpr (M == 2) return __builtin_bit_cast(float, __builtin_amdgcn_update_dpp(u, u, 0x4E, 0xF, 0xF, false));
    else if constexpr (M == 4) { const unsigned t = __builtin_amdgcn_update_dpp(u, u, 0x141, 0xF, 0xF, false);
        return __builtin_bit_cast(float, __builtin_amdgcn_update_dpp(t, t, 0x1B, 0xF, 0xF, false)); }
    else if constexpr (M == 8) return __builtin_bit_cast(float, __builtin_amdgcn_update_dpp(u, u, 0x128, 0xF, 0xF, false));
    else if constexpr (M == 16) { const auto r = __builtin_amdgcn_permlane16_swap(u, u, false, false); return __builtin_bit_cast(float, (threadIdx.x & 16) ? r[0] : r[1]); }
    else { const auto r = __builtin_amdgcn_permlane32_swap(u, u, false, false); return __builtin_bit_cast(float, (threadIdx.x & 32) ? r[0] : r[1]); }
#else
    return __shfl_xor(v, M);
#endif
}
DEV float wave_sum(float v) { v += shx<32>(v); v += shx<16>(v); v += shx<8>(v); v += shx<4>(v); v += shx<2>(v); v += shx<1>(v); return v; }
DEV bf16x8 mk8(u32x2 lo, u32x2 hi) { u32x4 v = {lo.x, lo.y, hi.x, hi.y}; return __builtin_bit_cast(bf16x8, v); }
DEV bf16x8 mk8(u32x4 v) { return __builtin_bit_cast(bf16x8, v); }
DEV bf16x8 mk8(s16x4 lo, s16x4 hi) { return __builtin_shufflevector(lo, hi, 0, 1, 2, 3, 4, 5, 6, 7); }
DEV f32x4 mfma16(bf16x8 a, bf16x8 b, f32x4 c) { return __builtin_amdgcn_mfma_f32_16x16x32_bf16(a, b, c, 0, 0, 0); }
DEV unsigned f8enc1(float x) {
    const unsigned sgn = x < 0.f ? 0x80u : 0u; float a = x < 0.f ? -x : x; if (!(a < 448.f)) a = 448.f;
    if (a < 0.015625f) { const int q = (int)(a * 512.f + 0.5f); const float r = a * 512.f; int qq = q; if ((float)q - r == 0.5f && (q & 1)) qq = q - 1; return sgn | (unsigned)qq; }
    int e = 0; float m = a; while (m >= 2.f) { m *= 0.5f; ++e; } while (m < 1.f) { m *= 2.f; --e; }
    const float r = (m - 1.f) * 8.f; int q = (int)(r + 0.5f); if ((float)q - r == 0.5f && (q & 1)) --q;
    if (q == 8) { q = 0; ++e; }
    return sgn | (unsigned)((e + 7) << 3) | (unsigned)q;
}
#if defined(__HIP_DEVICE_COMPILE__)
DEV unsigned f8pack4(float a, float b, float c, float d) {
    a = __builtin_amdgcn_fmed3f(a, -448.f, 448.f); b = __builtin_amdgcn_fmed3f(b, -448.f, 448.f); c = __builtin_amdgcn_fmed3f(c, -448.f, 448.f); d = __builtin_amdgcn_fmed3f(d, -448.f, 448.f);
    int w = 0; w = __builtin_amdgcn_cvt_pk_fp8_f32(a, b, w, false); w = __builtin_amdgcn_cvt_pk_fp8_f32(c, d, w, true); return (unsigned)w; }
#else
DEV unsigned f8pack4(float a, float b, float c, float d) { return f8enc1(a) | (f8enc1(b) << 8) | (f8enc1(c) << 16) | (f8enc1(d) << 24); }
#endif
DEV float f8dec1(unsigned v) {
    const unsigned e = (v >> 3) & 15u, m = v & 7u; float r = e == 0 ? (float)m * (1.0f / 512.0f) : __uint_as_float(((e + 120u) << 23) | (m << 20));
    return (v & 0x80u) ? -r : r;
}
#if defined(__HIP_DEVICE_COMPILE__)
DEV f32x4 f8x4_f32(unsigned w) { const auto lo = __builtin_amdgcn_cvt_pk_f32_fp8((int)w, false), hi = __builtin_amdgcn_cvt_pk_f32_fp8((int)w, true); return (f32x4){lo[0], lo[1], hi[0], hi[1]}; }
#else
DEV f32x4 f8x4_f32(unsigned w) { return (f32x4){f8dec1(w & 255u), f8dec1((w >> 8) & 255u), f8dec1((w >> 16) & 255u), f8dec1(w >> 24)}; }
#endif
constexpr float YE_SCALE = 32.0f, YE_INV = 1.0f / 32.0f;
#ifdef CPU_EMU
DEV f32x4 mfma_f8(bf16x8 a0, bf16x8 a1, bf16x8 b0, bf16x8 b1, f32x4 c) { return emu_mfma_f8(a0, a1, b0, b1, c); }
#else
typedef int i32x4 __attribute__((ext_vector_type(4)));
typedef int i32x8 __attribute__((ext_vector_type(8)));
DEV f32x4 mfma_f8(bf16x8 a0, bf16x8 a1, bf16x8 b0, bf16x8 b1, f32x4 c) {
    const i32x8 A = __builtin_shufflevector(__builtin_bit_cast(i32x4, a0), __builtin_bit_cast(i32x4, a1), 0, 1, 2, 3, 4, 5, 6, 7);
    const i32x8 B = __builtin_shufflevector(__builtin_bit_cast(i32x4, b0), __builtin_bit_cast(i32x4, b1), 0, 1, 2, 3, 4, 5, 6, 7);
    return __builtin_amdgcn_mfma_scale_f32_16x16x128_f8f6f4(A, B, c, 0, 0, 0, 0, 0, 0);
}
#endif
constexpr float F8_WSCALE = 64.0f, F8_WINV = 1.0f / 64.0f;
DEV void store8bf(bf16_t* o, f32x4 a, f32x4 b) { u32x4 v = {pack2(a[0], a[1]), pack2(a[2], a[3]), pack2(b[0], b[1]), pack2(b[2], b[3])}; stg((u32x4*)o, v); }

#ifndef CPU_EMU
#define XB_TMO      128
#define XB_XCNT(j)  (256  + 64 * (j))
#define XB_XSUB(j)  (1280 + 64 * (j))
#define XB_XGEN(j)  (2304 + 64 * (j))
#define XB_TOP      3328
#define XB_TOPGEN   3392
#define XCD_BAR_WORDS 3456
#define XB_SPIN_CAP (1u << 18)
#define LAS __attribute__((address_space(3)))
__device__ __forceinline__ unsigned xb_ld(unsigned* p)              { return __hip_atomic_load(p, __ATOMIC_RELAXED, __HIP_MEMORY_SCOPE_AGENT); }
__device__ __forceinline__ unsigned xb_add(unsigned* p, unsigned v) { return __hip_atomic_fetch_add(p, v, __ATOMIC_RELAXED, __HIP_MEMORY_SCOPE_AGENT); }
__device__ __forceinline__ unsigned xb_xcc_id() { return (unsigned)__builtin_amdgcn_s_getreg((3 << 11) | 20) & 0xFu; }
#define XB_SPIN(cond, bar) do { unsigned _sp = 0; while (cond) { __builtin_amdgcn_s_sleep(1); \
    if ((++_sp & 255u) == 0u) { if (xb_ld(&(bar)[XB_TMO])) break; if (_sp > XB_SPIN_CAP) { atomicAdd(&(bar)[XB_TMO], 1u); break; } } } } while (0)
struct XcdBarrier { unsigned* bar; unsigned x; volatile LAS unsigned* st; };
__device__ __forceinline__ XcdBarrier xcd_barrier_post(unsigned* bar, volatile LAS unsigned* st) {
    XcdBarrier b; b.bar = bar; b.x = xb_xcc_id(); b.st = st;
    if (threadIdx.x == 0) (void)xb_add(&bar[XB_XCNT(b.x)], 1u);
    return b;
}
__device__ __forceinline__ void xcd_barrier_complete(unsigned* bar, unsigned x, unsigned& nloc, unsigned& nx) {
    const unsigned Gd = gridDim.x * gridDim.y * gridDim.z;
    unsigned sum, cnt, mine, sp = 0u;
    for (;;) {
        sum = 0u; cnt = 0u; mine = 0u;
#pragma unroll
        for (unsigned j = 0; j < 16; ++j) { const unsigned c = xb_ld(&bar[XB_XCNT(j)]); sum += c; cnt += (c > 0u) ? 1u : 0u; mine = (j == x) ? c : mine; }
        if (sum == Gd) break;
        __builtin_amdgcn_s_sleep(1);
        if ((++sp & 255u) == 0u) { if (xb_ld(&bar[XB_TMO])) break; if (sp > XB_SPIN_CAP) { atomicAdd(&bar[XB_TMO], 1u); break; } }
    }
    nloc = mine > 0u ? mine : 1u; nx = cnt > 0u ? cnt : 1u;
}
__device__ __forceinline__ void xcd_barrier(const XcdBarrier& b) {
    asm volatile("s_waitcnt vmcnt(0)" ::: "memory");
    __syncthreads();
    if (threadIdx.x == 0) {
        unsigned* bar = b.bar;
        unsigned bx = b.x; asm volatile("" : "+s"(bx));
        __builtin_amdgcn_s_waitcnt(0);
        unsigned nloc = b.st[0], nx = b.st[1];
        if (nloc == 0u) { xcd_barrier_complete(bar, bx, nloc, nx); b.st[0] = nloc; b.st[1] = nx; }
        const unsigned old = xb_add(&bar[XB_XSUB(bx)], 1u);
        const unsigned gen = old / nloc;
        if (old + 1u == (gen + 1u) * nloc) {
            __builtin_amdgcn_fence(__ATOMIC_RELEASE, "agent");
            asm volatile("s_waitcnt vmcnt(0)" ::: "memory");
            const unsigned og = xb_add(&bar[XB_TOP], 1u);
            const unsigned tg = og / nx;
            if (og + 1u == (tg + 1u) * nx) xb_add(&bar[XB_TOPGEN], 1u);
            else XB_SPIN(xb_ld(&bar[XB_TOPGEN]) == tg, bar);
            __builtin_amdgcn_fence(__ATOMIC_ACQUIRE, "agent");
            xb_add(&bar[XB_XGEN(bx)], 1u);
            asm volatile("s_waitcnt vmcnt(0)" ::: "memory");
        } else {
            XB_SPIN(xb_ld(&bar[XB_XGEN(bx)]) == gen, bar);
            __builtin_amdgcn_fence(__ATOMIC_ACQUIRE, "agent");
            asm volatile("s_waitcnt vmcnt(0)" ::: "memory");
        }
    }
    __syncthreads();
}
#endif

constexpr int BK = 64, HALF = 128, HT_BYTES = HALF * BK * 2;
DEV int lds_byte(int r, int c) { int st = (r >> 4) * 2 + (c >> 5), rr = r & 15, cc = c & 31, ob = rr * 64 + cc * 2; return st * 1024 + (ob ^ (((ob >> 9) & 1) << 5)); }
DEV void stage_rc(int b, int& Rr, int& Cc) { int st = b / 1024, sb = b % 1024, swz = sb ^ (((sb >> 9) & 1) << 5); Rr = (st >> 1) * 16 + swz / 64; Cc = (st & 1) * 32 + (swz % 64) / 2; }
DEV int perm32(int rho) { const int n = rho >> 4, i = rho & 15; return 8 * (i >> 2) + 4 * n + (i & 3); }

DEV bool tile_from_L(int L, int nM, int nN, int& pm, int& pn) {
    const int nwg = nM * nN; if (L >= nwg) return false;
    int wgid = L; { const int q = nwg / 8, r = nwg % 8, xcd = wgid % 8, off = wgid / 8; wgid = (xcd < r ? xcd * (q + 1) : r * (q + 1) + (xcd - r) * q) + off; }
    const int nig = 8 * nN, gid = wgid / nig, fm = gid * 8, gsz = (nM - fm) < 8 ? (nM - fm) : 8;
    pm = fm + ((wgid % nig) % gsz); pn = (wgid % nig) / gsz; return true;
}
DEV bool tile_order(int i, int nM, int nN, int& pm, int& pn) { return tile_from_L(i * (int)gridDim.x + (int)blockIdx.x, nM, nN, pm, pn); }
#ifdef CPU_EMU
#define GLDS16(src, dst) __builtin_amdgcn_global_load_lds((const unsigned*)(src), (unsigned*)((dst) + (TID() & 63) * 16), 16, 0, 0)
#else
#define GLDS16(src, dst) __builtin_amdgcn_global_load_lds((const unsigned*)(src), (unsigned*)(dst), 16, 0, 0)
#endif

#define BAR __builtin_amdgcn_s_barrier()
#define SCHED __builtin_amdgcn_sched_barrier(0)
struct GUnit { int pm, pn, aux; };
template <class T> struct is_void_ { static constexpr bool v = false; };
template <> struct is_void_<void> { static constexpr bool v = true; };
template <class Epi> DEV bool call_epi(const Epi& e, const GUnit& u, f32x4 (&acc)[2][2][4][2], int r0, int c0) {
    if constexpr (is_void_<decltype(e(u, acc, r0, c0))>::v) { e(u, acc, r0, c0); return false; } else return e(u, acc, r0, c0);
}
template <bool GATHER, int LDA_, int LDB_, int K_, bool F8 = false, class Sched, class Epi>
DEV void gemm_stream(char* shm, const Sched& S, const Epi& epi) {
#define SA(b, h) (shm + ((b) * 2 + (h)) * HT_BYTES)
#define SB(b, h) (shm + (4 + (b) * 2 + (h)) * HT_BYTES)
#define STG_B(P, bp) do { GLDS16((bp) + voffB, (P) + ldsb0); GLDS16((bp) + voffB + 64 * LDB_, (P) + ldsb0 + 8192); } while (0)
#define STG_A(P, ap, h, gv) do { if (GATHER) { GLDS16((ap) + gv[h][0], (P) + ldsb0); GLDS16((ap) + gv[h][1], (P) + ldsb0 + 8192); } \
    else { GLDS16((ap) + voffA + (h) * 128 * LDA_, (P) + ldsb0); GLDS16((ap) + voffA + ((h) * 128 + 64) * LDA_, (P) + ldsb0 + 8192); } } while (0)
#define LDA(dst, b, h) _Pragma("unroll") for (int m = 0; m < 4; ++m) _Pragma("unroll") for (int k = 0; k < 2; ++k) \
    dst[m][k] = *reinterpret_cast<const bf16x8*>(SA(b, h) + aoff + m * 2048 + k * 1024)
#define LDB(dst, b, h) _Pragma("unroll") for (int n = 0; n < 2; ++n) _Pragma("unroll") for (int k = 0; k < 2; ++k) \
    dst[n][k] = *reinterpret_cast<const bf16x8*>(SB(b, h) + boff + n * 2048 + k * 1024)
#define MMA(ai, bj, At_, Bx_) do { __builtin_amdgcn_s_setprio(1); \
    if constexpr (F8) { _Pragma("unroll") for (int m = 0; m < 4; ++m) _Pragma("unroll") for (int n = 0; n < 2; ++n) \
      acc[ai][bj][m][n] = mfma_f8(Bx_[n][0], Bx_[n][1], At_[m][0], At_[m][1], acc[ai][bj][m][n]); } \
    else { _Pragma("unroll") for (int m = 0; m < 4; ++m) _Pragma("unroll") for (int n = 0; n < 2; ++n) _Pragma("unroll") for (int k = 0; k < 2; ++k) \
      acc[ai][bj][m][n] = mfma16(Bx_[n][k], At_[m][k], acc[ai][bj][m][n]); } \
    __builtin_amdgcn_s_setprio(0); } while (0)
    constexpr int nt = K_ / BK;
    const int tid = TID();
    const int wid = __builtin_amdgcn_readfirstlane(tid >> 6), lane = tid & 63, wr = wid >> 2, wc = wid & 3, fr = lane & 15, fq = lane >> 4;
    const int ldsb0 = wid * 1024;
    int Rr0, Cc0; stage_rc(tid * 16, Rr0, Cc0);
    const int voffA = Rr0 * LDA_ + Cc0;
    const int voffB = ((Rr0 & ~31) + perm32(Rr0 & 31)) * LDB_ + Cc0;
    const int aoff = lds_byte(wr * 64 + fr, fq * 8), boff = lds_byte(wc * 32 + fr, fq * 8);
    GUnit cur, nxt; int ui = 0;
    if (!S.next(0, cur)) return;
    int gc[2][2] = {{0, 0}, {0, 0}};
    int* gtab = (int*)(shm + 131072 + 256);
    if (GATHER) {
        __syncthreads();
        { GUnit u; for (int i = 0; i < GT_MAXU && S.next(i, u); ++i) { if (tid < 256) gtab[i * 256 + tid] = S.grow(u, tid) * LDA_; } }
        __syncthreads();
#pragma unroll
        for (int h = 0; h < 2; ++h)
#pragma unroll
            for (int i = 0; i < 2; ++i) gc[h][i] = gtab[h * 128 + i * 64 + Rr0] + Cc0;
    }
    f32x4 acc[2][2][4][2];
#pragma unroll
    for (int a = 0; a < 2; ++a)
#pragma unroll
        for (int b = 0; b < 2; ++b)
#pragma unroll
            for (int m = 0; m < 4; ++m)
#pragma unroll
                for (int n = 0; n < 2; ++n) acc[a][b][m][n] = (f32x4){0.f, 0.f, 0.f, 0.f};
    bf16x8 At[4][2], B0[2][2], B1[2][2];
    const bf16_t* cA = S.a_base(cur); const bf16_t* cB = S.b_base(cur);
    STG_B(SB(0, 0), cB); STG_A(SA(0, 0), cA, 0, gc); STG_B(SB(0, 1), cB + 128 * LDB_); STG_A(SA(0, 1), cA, 1, gc);
    if (wr == 1) BAR;
    WAIT_V(4); BAR;
    STG_B(SB(1, 0), cB + BK); STG_A(SA(1, 0), cA + BK, 0, gc); STG_B(SB(1, 1), cB + 128 * LDB_ + BK);
    WAIT_V(6); BAR;
    for (;;) {
        const bool has_next = S.next(ui + 1, nxt);
        const bf16_t* nA = has_next ? S.a_base(nxt) : cA; const bf16_t* nB = has_next ? S.b_base(nxt) : cB;
#pragma unroll 1
        for (int t = 0; t < nt; t += 2) {
            const bool last = (t == nt - 2);
            const bf16_t* a1 = cA + (t + 1) * BK;
            const bf16_t* a2 = last ? nA : cA + (t + 2) * BK; const bf16_t* b2 = last ? nB : cB + (t + 2) * BK;
            const bf16_t* a3 = a2 + BK; const bf16_t* b3 = b2 + BK;
            LDB(B0, 0, 0); SCHED; LDA(At, 0, 0); STG_A(SA(1, 1), a1, 1, gc);
            if (GATHER && last && has_next) {
#pragma unroll
                for (int h = 0; h < 2; ++h)
#pragma unroll
                    for (int i = 0; i < 2; ++i) gc[h][i] = gtab[(ui + 1) * 256 + h * 128 + i * 64 + Rr0] + Cc0; }
            WAIT_L(8); BAR; WAIT_L(0); MMA(0, 0, At, B0); BAR; SCHED;
            LDB(B1, 0, 1); STG_B(SB(0, 0), b2);
            BAR; WAIT_L(0); MMA(0, 1, At, B1); BAR;
            LDA(At, 0, 1); STG_A(SA(0, 0), a2, 0, gc);
            BAR; WAIT_L(0); MMA(1, 0, At, B0); BAR; SCHED;
            STG_B(SB(0, 1), b2 + 128 * LDB_);
            WAIT_V(6); BAR; MMA(1, 1, At, B1); BAR;
            LDB(B0, 1, 0); SCHED; LDA(At, 1, 0); STG_A(SA(0, 1), a2, 1, gc);
            WAIT_L(8); BAR; WAIT_L(0); MMA(0, 0, At, B0); BAR; SCHED;
            LDB(B1, 1, 1); STG_B(SB(1, 0), b3);
            BAR; WAIT_L(0); MMA(0, 1, At, B1); BAR;
            LDA(At, 1, 1); STG_A(SA(1, 0), a3, 0, gc);
            BAR; WAIT_L(0); MMA(1, 0, At, B0); BAR; SCHED;
            STG_B(SB(1, 1), b3 + 128 * LDB_);
            WAIT_V(6); BAR; MMA(1, 1, At, B1); BAR;
        }
        bool keep = false;
        {
            const int tz = TID(); const int wz = tz >> 6, lz = tz & 63, wrz = wz >> 2, wcz = wz & 3, frz = lz & 15, fqz = lz >> 4;
            keep = call_epi(epi, cur, acc, wrz * 64 + frz, wcz * 32 + 8 * fqz);
        }
        if (!has_next) break;
        if (!keep) {
#pragma unroll
            for (int a = 0; a < 2; ++a)
#pragma unroll
                for (int b = 0; b < 2; ++b)
#pragma unroll
                    for (int m = 0; m < 4; ++m)
#pragma unroll
                        for (int n = 0; n < 2; ++n) acc[a][b][m][n] = (f32x4){0.f, 0.f, 0.f, 0.f};
        }
        cur = nxt; cA = nA; cB = nB; ++ui;
    }
    WAIT_V(0);
    if (wr == 0) BAR;
    BAR;
#undef SA
#undef SB
#undef STG_A
#undef STG_B
#undef LDA
#undef LDB
#undef MMA
}

constexpr int J_IN = 16 * 27, J_WB = 2 * 8 * 4, J_WO = 16 * 4, J_GU = 16 * 2 * 64, J_DN = 16 * 64, J_FOLD = 8 * 16, J_PAD = 1;
constexpr int N_MODJOBS = 2 * 96;

constexpr int J_BIG = J_IN + J_WB + J_WO + J_GU + J_DN;
struct WJob { const float* src; bf16_t* dst; int ldsrc, lddst, nvalid, k0, n0, mode, gu_which, f8; };
DEV WJob wjob_decode(const Params& p, int l, int j) {
    WJob w; w.ldsrc = 1024; w.lddst = 1024; w.nvalid = 256; w.mode = 0; w.gu_which = 0; w.f8 = 0;
    if (j < J_IN) { const int kt = j / 27, nb = j % 27; w.k0 = kt * 64; w.n0 = nb * 256; w.src = p.w_in + (size_t)l * 1024 * PWSRC; w.ldsrc = PWSRC; w.nvalid = PWSRC - w.n0; w.dst = p.WinT() + (size_t)l * PWT * 1024; w.mode = 3; }
    else if ((j -= J_IN) < J_WB) { const int bi = (j / 32) * 2, jj = j % 32, kt = jj / 4, nb = jj % 4; w.k0 = kt * 64; w.n0 = nb * 256;
        w.src = p.w_branch + ((size_t)l * 3 + bi) * 512 * 1024; w.dst = p.WbT() + ((size_t)l * 3 + bi) * 1024 * 512; w.lddst = 512; }
    else if ((j -= J_WB) < J_WO) { const int kt = j / 4, nb = j % 4; w.k0 = kt * 64; w.n0 = nb * 256; w.src = p.w_out + (size_t)l * 1024 * 1024; w.dst = p.WoT() + (size_t)l * 1024 * 1024; }
    else if ((j -= J_WO) < J_GU) { const int e = j / 128, jj = j % 128; w.gu_which = jj / 64; const int j3 = jj % 64, kt = j3 / 4, nb = j3 % 4; w.k0 = kt * 64; w.n0 = nb * 256;
        w.src = (w.gu_which ? p.w_up : p.w_gate) + ((size_t)l * 16 + e) * 1024 * 1024; w.dst = p.WguT() + ((size_t)l * 16 + e) * 2048 * 512; w.mode = 1; w.f8 = 1; }
    else { j -= J_GU; const int e = j / 64, jj = j % 64, kt = jj / 4, nb = jj % 4; w.k0 = kt * 64; w.n0 = nb * 256;
        w.src = p.w_down + ((size_t)l * 16 + e) * 1024 * 1024; w.dst = p.WdT() + ((size_t)l * 16 + e) * 1024 * 512; w.f8 = 1; }
    return w;
}
constexpr int WT_LD = 260;
DEV void wjob_load(const WJob& w, int tid, f32x4 (&vv)[8]) {
#pragma unroll
    for (int i = 0; i < 8; ++i) { const int idx = i * 512 + tid, r = idx >> 6, c = (idx & 63) * 4; int col = w.n0 + c; col = col > w.ldsrc - 4 ? w.ldsrc - 4 : col;
        vv[i] = ldg((const f32x4*)(w.src + (size_t)(w.k0 + r) * w.ldsrc + col)); }
}
DEV void wjob_finish(const WJob& w, int tid, const f32x4 (&vv)[8], float* tile) {
    __syncthreads();
#pragma unroll
    for (int i = 0; i < 8; ++i) { const int idx = i * 512 + tid, r = idx >> 6, c = (idx & 63) * 4; *(f32x4*)(tile + r * WT_LD + c) = vv[i]; }
    __syncthreads();
#pragma unroll
    for (int q = 0; q < 4; ++q) {
        const int item = q * 512 + tid, nrow = item >> 3, kc = (item & 7) * 8;
        float v[8];
#pragma unroll
        for (int jj = 0; jj < 8; ++jj) v[jj] = tile[(kc + jj) * WT_LD + nrow];
        const int n = w.n0 + nrow;
        int drow = n; bool f8 = w.f8 != 0; size_t f8base = 0;
        if (w.mode == 1) drow = (n >> 7) * 256 + w.gu_which * 128 + (n & 127);
        if (w.mode == 3) {
            if (n >= C_SPLIT) { f8 = true; f8base = (size_t)PWA * 2048; drow = n - C_SPLIT; }
            else { drow = proj_col(n); if (drow >= C_F8) { f8 = true; f8base = (size_t)C_F8 * 2048; drow -= C_F8; } } }
        if (f8) { const u32x2 o = {f8pack4(v[0] * F8_WSCALE, v[1] * F8_WSCALE, v[2] * F8_WSCALE, v[3] * F8_WSCALE), f8pack4(v[4] * F8_WSCALE, v[5] * F8_WSCALE, v[6] * F8_WSCALE, v[7] * F8_WSCALE)};
            if (nrow < w.nvalid) stg((u32x2*)((unsigned char*)w.dst + f8base + (size_t)drow * 1024 + w.k0 + kc), o); }
        else if (nrow < w.nvalid) { u32x4 o = {pack2(v[0], v[1]), pack2(v[2], v[3]), pack2(v[4], v[5]), pack2(v[6], v[7])};
            stg((u32x4*)(w.dst + (size_t)drow * w.lddst + w.k0 + kc), o); }
    }
}
DEV void pro_small_job(const Params& p, int l, int j, char* shm) {
    float* tile = (float*)shm;
    const int tid = TID();
    if (j < J_FOLD) {
        const int kt = j / 16, ntl = j % 16, k0 = kt * 64, n0 = ntl * 64; const int fg = k0 / 128;
        const float* wb1 = p.w_branch + ((size_t)l * 3 + 1) * 512 * 1024;
        const float* pw = p.pool_w + ((size_t)l * 4 + fg) * 128 * 128; const float* ps = p.pool_scale + (size_t)l * 512 + fg * 128;
        const int c = tid & 63, rq = tid >> 6;
        float accv[8];
#pragma unroll
        for (int i = 0; i < 8; ++i) accv[i] = 0.f;
        for (int d = 0; d < 128; ++d) { const float wv = ldg(wb1 + (size_t)(fg * 128 + d) * 1024 + n0 + c) * ldg(ps + d);
#pragma unroll
            for (int i = 0; i < 8; ++i) accv[i] += ldg(pw + (size_t)(k0 - fg * 128 + rq * 8 + i) * 128 + d) * wv; }
        __syncthreads();
#pragma unroll
        for (int i = 0; i < 8; ++i) tile[(rq * 8 + i) * WT_LD + c] = accv[i];
        __syncthreads();
        const int nrow = tid >> 3, kc = (tid & 7) * 8; float v[8];
#pragma unroll
        for (int jj = 0; jj < 8; ++jj) v[jj] = tile[(kc + jj) * WT_LD + nrow];
        u32x4 o = {pack2(v[0], v[1]), pack2(v[2], v[3]), pack2(v[4], v[5]), pack2(v[6], v[7])};
        stg((u32x4*)(p.WbT() + ((size_t)l * 3 + 1) * 1024 * 512 + (size_t)(n0 + nrow) * 512 + k0 + kc), o);
    } else {
        bf16_t* d0 = p.WinT() + (size_t)l * PWT * 1024 + (size_t)C_PADA * 1024;
        for (int i = tid; i < (C_F8 - C_PADA) * 1024 / 8; i += NTHREADS) stg((u32x4*)(d0 + (size_t)i * 8), (u32x4){0u, 0u, 0u, 0u});
    }
}

DEV void pro_mod_job(const Params& p, int job, char* shm) {
    float* sv = (float*)shm;
    const int tid = TID(), l = job / 96, col0 = (job % 96) * 64;
    const int c = tid & 63, kp = tid >> 6;
    float acc[NB + 1];
#pragma unroll
    for (int v = 0; v <= NB; ++v) acc[v] = 0.f;
    for (int half = 0; half < 2; ++half) {
        __syncthreads();
        for (int idx = tid; idx < (NB + 1) * 512; idx += 512) { const int v = idx >> 9, k = idx & 511;
            const float s = (v < NB) ? ldg(p.c + (size_t)v * 1024 + half * 512 + k) : ldg(p.c_ctx + half * 512 + k);
            sv[idx] = s * sigmoidf_(s); }
        __syncthreads();
        for (int kk = 0; kk < 64; ++kk) { const int k = kp * 64 + kk;
            const float w = ldg(p.ada_w + ((size_t)l * 1024 + half * 512 + k) * 6144 + col0 + c);
#pragma unroll
            for (int v = 0; v <= NB; ++v) acc[v] += sv[v * 512 + k] * w; }
    }
    __syncthreads();
    float* red = (float*)shm;
#pragma unroll
    for (int v = 0; v <= NB; ++v) red[(kp * (NB + 1) + v) * 64 + c] = acc[v];
    __syncthreads();
    for (int idx = tid; idx < (NB + 1) * 64; idx += 512) { const int v = idx >> 6, cc = idx & 63; float s = 0.f;
#pragma unroll
        for (int q = 0; q < 8; ++q) s += red[(q * (NB + 1) + v) * 64 + cc];
        stg(p.mod() + ((size_t)l * (NB + 1) + v) * 6144 + col0 + cc, s + ldg(p.ada_b + (size_t)l * 6144 + col0 + cc)); }
}

DEV void phase_prologue(const Params& p, char* shm) {
    const int tid = TID();
    const int nsmall = N_MODJOBS + 1 + 2 * (J_FOLD + J_PAD);
    for (int job = blockIdx.x; job < nsmall; job += gridDim.x) {
        if (job < N_MODJOBS) pro_mod_job(p, job, shm);
        else if (job == N_MODJOBS) {
            for (int idx = tid; idx < (ROWS + 64) * 16; idx += NTHREADS) { const int pos = idx >> 4, i = idx & 15;
                const float pv = (float)(pos < ROWS ? pos : pos - ROWS);
                const float inv = powf(10000.0f, -(float)(2 * i) / 32.0f);
                const float a = pv * inv; stg(p.rope() + idx * 2, cosf(a)); stg(p.rope() + idx * 2 + 1, sinf(a)); }
        } else { const int sj = job - N_MODJOBS - 1; pro_small_job(p, sj / (J_FOLD + J_PAD), sj % (J_FOLD + J_PAD), shm); }
    }
    float* tile = (float*)shm;
    const int nbig = 2 * J_BIG;
    int job = blockIdx.x;
    if (job >= nbig) return;
    WJob wc = wjob_decode(p, job / J_BIG, job % J_BIG), wn = wc;
    f32x4 vc[8], vn[8];
    wjob_load(wc, tid, vc);
    for (; job < nbig; job += gridDim.x) {
        const int jn = job + gridDim.x;
        if (jn < nbig) { wn = wjob_decode(p, jn / J_BIG, jn % J_BIG); wjob_load(wn, tid, vn); }
        wjob_finish(wc, tid, vc, tile);
        wc = wn;
#pragma unroll
        for (int i = 0; i < 8; ++i) vc[i] = vn[i];
    }
}

DEV const float* xin_f32(const Params& p, const SetDesc& sd) { return (sd.is_ctx ? p.ctx : p.x) + (((size_t)sd.samp0) << sd.lgseq) * 1024; }
DEV bf16_t* xbf_base(const Params& p, const SetDesc& sd) { return (sd.is_ctx ? p.ctxs() : p.xb()) + (((size_t)sd.samp0) << sd.lgseq) * 1024; }
DEV float* xout_f32(const Params& p, const SetDesc& sd) { return p.out + (((size_t)sd.samp0) << sd.lgseq) * 1024; }
template <bool BF> struct XRow;
template <> struct XRow<false> { f32x4 v[4];
    DEV void load(const void* b, size_t row, int lane) { const float* q = (const float*)b + row * 1024 + lane * 8;
#pragma unroll
        for (int i = 0; i < 4; ++i) v[i] = ldg((const f32x4*)(q + (i >> 1) * 512 + (i & 1) * 4)); }
    DEV f32x4 get(int i) const { return v[i]; } };
template <> struct XRow<true> { u32x4 v[2];
    DEV void load(const void* b, size_t row, int lane) { const bf16_t* q = (const bf16_t*)b + row * 1024 + lane * 8;
#pragma unroll
        for (int h = 0; h < 2; ++h) v[h] = ldg((const u32x4*)(q + h * 512)); }
    DEV f32x4 get(int i) const { const u32x4 m = v[i >> 1]; return (i & 1) ? (f32x4){lo16(m.z), hi16(m.z), lo16(m.w), hi16(m.w)} : (f32x4){lo16(m.x), hi16(m.x), lo16(m.y), hi16(m.y)}; } };
template <bool BF> DEV void xrow_store8(void* b, size_t row, int c0, f32x4 a, f32x4 c) {
    if constexpr (BF) store8bf((bf16_t*)b + row * 1024 + c0, a, c);
    else { float* q = (float*)b + row * 1024 + c0; stg((f32x4*)q, a); stg((f32x4*)(q + 4), c); }
}
DEV const float* mod_row(const Params& p, const SetDesc& sd, int layer, int row) {
    return p.mod() + ((size_t)layer * (NB + 1) + (sd.is_ctx ? NB : sd.samp0 + (row >> sd.lgseq))) * 6144;
}
DEV bf16_t* proj_buf(const Params& p, const SetDesc& sd) { return sd.is_ctx ? p.PROJc() : p.PROJa(); }

DEV void stage_params(float* par, const float* v0, const float* v1, const float* v2, const float* v3, const float* v4) {
    const int tid = TID();
    const float* src[5] = {v0, v1, v2, v3, v4};
#pragma unroll
    for (int k = 0; k < 5; ++k) if (src[k]) { for (int i = tid; i < 1024; i += NTHREADS) par[k * 1024 + i] = ldg(src[k] + i); }
}
template <bool SRC_BF> DEV void phase_norm1(const Params& p, const SetDesc& sd, int layer, char* shm) {
    const int tid = TID(), lane = tid & 63, wv = tid >> 6;
    const float* g0 = p.norm_gain + ((size_t)layer * 4 + 0) * 1024;
    const void* xb = SRC_BF ? (const void*)xbf_base(p, sd) : (const void*)xin_f32(p, sd);
    const int stride = 8; const int rpb_ = (sd.nrows + (int)gridDim.x - 1) / (int)gridDim.x; const int row_end = min(sd.nrows, ((int)blockIdx.x + 1) * rpb_);
    int row = (int)blockIdx.x * rpb_ + wv;
    float* par = (float*)shm;
    __syncthreads();
    { const float* mdb = mod_row(p, sd, layer, min((int)blockIdx.x * rpb_, sd.nrows - 1)); stage_params(par, g0, mdb, mdb + 1024, nullptr, nullptr); }
    __syncthreads();
    XRow<SRC_BF> curr, nxtr;
    if (row < row_end) curr.load(xb, row, lane);
    for (; row < row_end; row += stride) {
        const int rn = row + stride;
        if (rn < row_end) nxtr.load(xb, rn, lane);
        f32x4 cur[4];
#pragma unroll
        for (int i = 0; i < 4; ++i) cur[i] = curr.get(i);
        float ss = 0.f;
#pragma unroll
        for (int i = 0; i < 4; ++i)
#pragma unroll
            for (int j = 0; j < 4; ++j) ss += cur[i][j] * cur[i][j];
        ss = wave_sum(ss);
        const float rstd = rsqrtf(ss * (1.0f / 1024.0f) + RMS_EPS);
#pragma unroll
        for (int hlf = 0; hlf < 2; ++hlf) { const int c0 = hlf * 512 + lane * 8; float o[8];
#pragma unroll
            for (int j = 0; j < 8; ++j) o[j] = cur[hlf * 2 + (j >> 2)][j & 3] * rstd * par[c0 + j] * (1.0f + par[2048 + c0 + j]) + par[1024 + c0 + j];
            u32x4 ov = {pack2(o[0], o[1]), pack2(o[2], o[3]), pack2(o[4], o[5]), pack2(o[6], o[7])};
            stg((u32x4*)(p.H() + (size_t)row * 1024 + c0), ov);
            const u32x2 o8 = {f8pack4(o[0], o[1], o[2], o[3]), f8pack4(o[4], o[5], o[6], o[7])};
            stg((u32x2*)(p.H8() + (size_t)row * 1024 + c0), o8); }
        curr = nxtr;
    }
}

struct SchedPlain {
    const bf16_t* A; const bf16_t* Bt; int nM, nN, lda256, ldb256; int kv_only = 0;
    DEV bool next(int i, GUnit& u) const { u.aux = 0; if (!tile_order(i, nM, nN, u.pm, u.pn)) return false; if (kv_only) u.pn = u.pn == 0 ? 1 : 4; return true; }
    DEV const bf16_t* a_base(const GUnit& u) const { return A + (size_t)u.pm * lda256; }
    DEV const bf16_t* b_base(const GUnit& u) const { return Bt + (size_t)u.pn * ldb256; }
    DEV int grow(const GUnit&, int) const { return 0; }
};
struct SchedPlainT : SchedPlain {
    int split_base = -1;
    DEV bool next(int i, GUnit& u) const { u.aux = 0; const int G_ = (int)gridDim.x, b = (int)blockIdx.x; int L = i * G_ + b;
        if (split_base >= 0 && i >= split_base) { if (b < G_ / 2 || i >= split_base + 2) return false; L = split_base * G_ + (i - split_base) * (G_ / 2) + (b - G_ / 2); }
        if (!tile_from_L(L, nM, nN, u.pm, u.pn)) return false; if (kv_only) u.pn = u.pn < 4 ? u.pn + 2 : u.pn + 4; return true; }
    DEV const bf16_t* a_base(const GUnit&) const { return A; }
    DEV int grow(const GUnit& u, int i) const { return u.pm * 256 + i; }
};
struct SchedProjF8 : SchedPlainT {
    const bf16_t* Bt2; int na8;
    DEV const bf16_t* b_base(const GUnit& u) const { return u.pn < na8 ? Bt + (size_t)u.pn * ldb256 : Bt2 + (size_t)(u.pn - na8) * ldb256; }
};
DEV unsigned gate4u8(f32x4 v) {
    unsigned w = 0;
#pragma unroll
    for (int j = 0; j < 4; ++j) w |= (unsigned)fmaxf(sigmoidf_(v[j] * F8_WINV) * 255.0f + 0.5f, 1.0f) << (8 * j);
    return w;
}
DEV float u8f(unsigned w, int j) { return (float)((w >> (8 * j)) & 0xFFu); }
DEV void phase_proj_a(const Params& p, const SetDesc& sd, int layer, char* shm) {
    const bool kv_only = sd.is_ctx && layer == 1;
    bf16_t* pb = proj_buf(p, sd);
    {
        SchedPlain S; S.A = p.H(); S.Bt = p.WinT() + (size_t)layer * PWT * 1024; S.nM = sd.nrows / 256; S.nN = C_F8 / 256; S.lda256 = 256 * 1024; S.ldb256 = 256 * 1024;
        if (kv_only) { S.kv_only = 1; S.nN = 2; }
        gemm_stream<false, 1024, 1024, 1024>(shm, S, [=](const GUnit& u, const f32x4 (&acc)[2][2][4][2], int r0, int c0) {
#pragma unroll
            for (int ai = 0; ai < 2; ++ai)
#pragma unroll
                for (int m = 0; m < 4; ++m) { bf16_t* o = pb + ((size_t)u.pm * 256 + r0 + ai * 128 + m * 16) * PWA + u.pn * 256 + c0;
                    if (u.pn * 256 + c0 < C_PADA) store8bf(o, acc[ai][0][m][0], acc[ai][0][m][1]);
                    if (u.pn * 256 + 128 < C_PADA) store8bf(o + 128, acc[ai][1][m][0], acc[ai][1][m][1]); } });
    }
    {
        constexpr int NA8 = (PWA - C_F8) / 256;
        SchedProjF8 S; S.A = (const bf16_t*)p.H8(); S.Bt = p.WinT() + (size_t)layer * PWT * 1024 + (size_t)C_F8 * 1024; S.Bt2 = p.WinT() + (size_t)layer * PWT * 1024 + (size_t)PWA * 1024; S.na8 = NA8;
        S.nM = sd.nrows / 256; S.nN = NA8 + NBG / 256; S.lda256 = 256 * 512; S.ldb256 = 256 * 512;
        if (kv_only) { S.kv_only = 1; S.nN = 6; }
        { const int G_ = (int)gridDim.x, T1 = S.nM * (kv_only ? 2 : C_F8 / 256), T2 = S.nM * S.nN; if ((G_ & 1) == 0 && (T1 % G_) * 2 == G_ && T2 % G_ == 0 && T2 / G_ >= 1) S.split_base = T2 / G_ - 1; }
        unsigned char* bg = p.BG();
        gemm_stream<true, 512, 512, 512, true>(shm, S, [=](const GUnit& u, const f32x4 (&acc)[2][2][4][2], int r0, int c0) {
            if (u.pn < NA8) {
#pragma unroll
                for (int ai = 0; ai < 2; ++ai)
#pragma unroll
                    for (int m = 0; m < 4; ++m) { bf16_t* o = pb + ((size_t)u.pm * 256 + r0 + ai * 128 + m * 16) * PWA + C_F8 + u.pn * 256 + c0;
                        store8bf(o, acc[ai][0][m][0] * F8_WINV, acc[ai][0][m][1] * F8_WINV); store8bf(o + 128, acc[ai][1][m][0] * F8_WINV, acc[ai][1][m][1] * F8_WINV); }
            } else {
#pragma unroll
                for (int ai = 0; ai < 2; ++ai)
#pragma unroll
                    for (int m = 0; m < 4; ++m) { unsigned char* o = bg + ((size_t)u.pm * 256 + r0 + ai * 128 + m * 16) * NBG + (u.pn - NA8) * 256 + c0;
#pragma unroll
                        for (int hf = 0; hf < 2; ++hf) { const u32x2 gv = {gate4u8(acc[ai][hf][m][0]), gate4u8(acc[ai][hf][m][1])}; stg((u32x2*)(o + hf * 128), gv); } }
            } });
    }
}
DEV f32x4 sig4(f32x4 v) { f32x4 r; r[0] = sigmoidf_(v[0]); r[1] = sigmoidf_(v[1]); r[2] = sigmoidf_(v[2]); r[3] = sigmoidf_(v[3]); return r; }
DEV void gate_scan(const bf16_t* prow, int h, const float* gbias, float* ga, float* gb, float* gpm, float* gtot, float* tmp) {
    const int tid = TID(), lane = tid & 63, w = tid >> 6;
    float b = 0.f, a = 0.f, pm = 0.f; int d = 0, tok = 0;
    if (tid < 256) {
        d = tid >> 7; const int i = tid & 127; tok = d ? 127 - i : i;
        const float gi = bf2f(ldg(prow + (size_t)tok * PWA + C_GM + (2 * d) * 4 + h)) + ldg(gbias + (2 * d) * 4 + h);
        const float gf = bf2f(ldg(prow + (size_t)tok * PWA + C_GM + (2 * d + 1) * 4 + h)) + ldg(gbias + (2 * d + 1) * 4 + h);
        b = logsigmoidf_(gf);
#pragma unroll
        for (int o = 1; o < 64; o <<= 1) { const float t = __shfl_up(b, o); if (lane >= o) b += t; }
        if (lane == 63) tmp[w] = b;
        a = gi;
    }
    __syncthreads();
    if (tid < 256) {
        if (w & 1) b += tmp[w - 1];
        a -= b; pm = a;
#pragma unroll
        for (int o = 1; o < 64; o <<= 1) { const float t = __shfl_up(pm, o); if (lane >= o) pm = fmaxf(pm, t); }
        if (lane == 63) tmp[8 + w] = pm;
    }
    __syncthreads();
    if (tid < 256) {
        if (w & 1) pm = fmaxf(pm, tmp[8 + w - 1]);
        ga[d * 128 + tok] = a; gb[d * 128 + tok] = b; gpm[d * 128 + tok] = pm;
        if ((tid & 127) == 127) { gtot[d * 2] = b; gtot[d * 2 + 1] = pm; }
    }
    __syncthreads();
}

struct RopeRaw { u32x4 m, q; f32x4 rt[4]; };
DEV void rope_issue(RopeRaw& r, const bf16_t* hp, int cidx, bool latent, int tl, const float* rope) {
    r.m = ldg((const u32x4*)(hp + cidx * 8));
    if (latent) {
        r.q = ldg((const u32x4*)(hp + (cidx ^ 2) * 8));
        const int pos = (cidx < 4) ? (tl >> 6) : (ROWS + (tl & 63));
        const float* tb = rope + ((size_t)pos * 16 + (cidx & 1) * 8) * 2;
#pragma unroll
        for (int i = 0; i < 4; ++i) r.rt[i] = ldg((const f32x4*)(tb + i * 4));
    }
}
DEV void rope_apply(const RopeRaw& r, int cidx, bool latent, float scale, float* o) {
    const u32x4 m = r.m;
    float x[8] = {lo16(m.x), hi16(m.x), lo16(m.y), hi16(m.y), lo16(m.z), hi16(m.z), lo16(m.w), hi16(m.w)};
    if (latent) {
        const u32x4 q = r.q;
        const float y[8] = {lo16(q.x), hi16(q.x), lo16(q.y), hi16(q.y), lo16(q.z), hi16(q.z), lo16(q.w), hi16(q.w)};
        const bool first = (cidx & 2) == 0;
#pragma unroll
        for (int j = 0; j < 8; ++j) { const float cs = r.rt[j >> 1][(j & 1) * 2], sn = r.rt[j >> 1][(j & 1) * 2 + 1];
            x[j] = first ? (x[j] * cs - y[j] * sn) : (x[j] * cs + y[j] * sn); }
    }
#pragma unroll
    for (int j = 0; j < 8; ++j) o[j] = x[j] * scale;
}

DEV int st_index(const SetDesc& sd, int sl, int h, int dir, int tb) { return ((sl * 4 + h) * 2 + dir) * sd.ntb + tb; }

constexpr int V_LD = 144, K_LD = 72, KS_LD = 80;
struct PrefA { RopeRaw rk1, rk2; u32x4 vreg[4]; };
DEV void stepA_issue(PrefA& f, const Params& p, const SetDesc& sd, int task) {
    const int tid = TID();
    const int tb = task % sd.ntb, h = (task / sd.ntb) & 3, sl = task / (sd.ntb * 4);
    const int row0 = (sl << sd.lgseq) + tb * 128; const bool latent = !sd.is_ctx; const int tl0 = tb * 128;
    const bf16_t* prow = proj_buf(p, sd) + (size_t)row0 * PWA;
    { const int s = tid & 127, cpi = tid >> 7, cp = (cpi & 1) + (cpi >> 1) * 4; const bf16_t* hp = prow + (size_t)s * PWA + C_KM + h * 64;
      rope_issue(f.rk1, hp, cp, latent, tl0 + s, p.rope()); rope_issue(f.rk2, hp, cp + 2, latent, tl0 + s, p.rope()); }
#pragma unroll
    for (int it = 0; it < 4; ++it) { const int item = tid + it * 512, s = item >> 4, ch = item & 15; f.vreg[it] = ldg((const u32x4*)(prow + (size_t)s * PWA + C_VM + h * 128 + ch * 8)); }
}
DEV void mlstm_stepA_task(const Params& p, const SetDesc& sd, int layer, int task, int next_task, PrefA& f, char* shm) {
    const int tid = TID(), lane = tid & 63, w = tid >> 6, fr = lane & 15, fq = lane >> 4, tq4 = (lane & 15) >> 2, tp4 = lane & 3;
    const int tb = task % sd.ntb, h = (task / sd.ntb) & 3, sl = task / (sd.ntb * 4);
    const int row0 = (sl << sd.lgseq) + tb * 128; const bool latent = !sd.is_ctx;
    bf16_t* Vs = (bf16_t*)shm;
    bf16_t* Ksc = (bf16_t*)(shm + 128 * V_LD * 2);
    float* ga = (float*)(shm + 128 * V_LD * 2 + 2 * 128 * KS_LD * 2); float* gb = ga + 256; float* gpm = gb + 256; float* gtot = gpm + 256; float* tmp = gtot + 8;
    const bf16_t* prow = proj_buf(p, sd) + (size_t)row0 * PWA;
    __syncthreads();
    gate_scan(prow, h, p.gate_bias + (size_t)layer * 16, ga, gb, gpm, gtot, tmp);
    {
        const int s = tid & 127, cpi = tid >> 7, cp = (cpi & 1) + (cpi >> 1) * 4;
        float k1[8], k2[8];
        rope_apply(f.rk1, cp, latent, 1.0f, k1);
        rope_apply(f.rk2, cp + 2, latent, 1.0f, k2);
#pragma unroll
        for (int dir = 0; dir < 2; ++dir) { const float ws = __expf(ga[dir * 128 + s] - gtot[dir * 2 + 1]);
            u32x4 o1 = {pack2(k1[0] * ws, k1[1] * ws), pack2(k1[2] * ws, k1[3] * ws), pack2(k1[4] * ws, k1[5] * ws), pack2(k1[6] * ws, k1[7] * ws)};
            u32x4 o2 = {pack2(k2[0] * ws, k2[1] * ws), pack2(k2[2] * ws, k2[3] * ws), pack2(k2[4] * ws, k2[5] * ws), pack2(k2[6] * ws, k2[7] * ws)};
            *(u32x4*)(Ksc + (dir * 128 + s) * KS_LD + cp * 8) = o1; *(u32x4*)(Ksc + (dir * 128 + s) * KS_LD + (cp + 2) * 8) = o2; }
    }
#pragma unroll
    for (int it = 0; it < 4; ++it) { const int item = tid + it * 512, s = item >> 4, ch = item & 15; *(u32x4*)(Vs + s * V_LD + ch * 8) = f.vreg[it]; }
    if (next_task >= 0) stepA_issue(f, p, sd, next_task);
    __syncthreads();
    f32x4 acc[2][4];
#pragma unroll
    for (int dir = 0; dir < 2; ++dir)
#pragma unroll
        for (int n = 0; n < 4; ++n) acc[dir][n] = (f32x4){0.f, 0.f, 0.f, 0.f};
#pragma unroll
    for (int ks = 0; ks < 4; ++ks) {
        const bf16_t* vp = Vs + (32 * ks + 4 * fq + tq4) * V_LD + w * 16 + 4 * tp4;
        const bf16x8 af = mk8(TR16(vp), TR16(vp + 16 * V_LD));
#pragma unroll
        for (int dir = 0; dir < 2; ++dir)
#pragma unroll
            for (int n = 0; n < 4; ++n) { const bf16_t* kp = Ksc + (dir * 128 + 32 * ks + 4 * fq + tq4) * KS_LD + n * 16 + 4 * tp4;
                const bf16x8 bfv = mk8(TR16(kp), TR16(kp + 16 * KS_LD));
                acc[dir][n] = mfma16(bfv, af, acc[dir][n]); }
    }
#pragma unroll
    for (int dir = 0; dir < 2; ++dir) { float* So = p.Sst() + (size_t)st_index(sd, sl, h, dir, tb) * 8192;
#pragma unroll
        for (int n = 0; n < 4; ++n) stg((f32x4*)(So + (w * 16 + fr) * 64 + n * 16 + fq * 4), acc[dir][n]); }
    if (tid < 128) { const int dir = tid >> 6, dd = tid & 63; float sm = 0.f;
        for (int i = 0; i < 128; ++i) sm += bf2f(Ksc[(dir * 128 + i) * KS_LD + dd]);
        stg(p.Sn() + (size_t)st_index(sd, sl, h, dir, tb) * 64 + dd, sm); }
    if (tid < 2) { float* sc = p.Ssc() + (size_t)st_index(sd, sl, h, tid, tb) * 4; stg(sc, gtot[tid * 2]); stg(sc + 1, gtot[tid * 2] + gtot[tid * 2 + 1]); }
}

template <int GI> DEV void pool_group(const Params& p, const SetDesc& sd, const bf16_t* pb) {
    constexpr int W = 2 << GI;
    const int nitems = sd.nrows * 16; const int T = 1 << sd.lgseq;
    for (int item = blockIdx.x * NTHREADS + TID(); item < nitems; item += gridDim.x * NTHREADS) {
        const int row = item >> 4, ch = GI * 128 + (item & 15) * 8;
        const int tt = row & (T - 1);
        u32x4 mv[W]; int cnt = 0; bool okv[W];
#pragma unroll
        for (int q = 0; q < W; ++q) { const int t2 = tt - W / 2 + q; const bool ok = (t2 >= 0) && (t2 < T); cnt += ok ? 1 : 0; okv[q] = ok;
            mv[q] = ldg((const u32x4*)(pb + (size_t)(ok ? (row - W / 2 + q) : row) * PWA + C_PU + ch)); }
        float s[8];
#pragma unroll
        for (int j = 0; j < 8; ++j) s[j] = 0.f;
#pragma unroll
        for (int q = 0; q < W; ++q) { u32x4 m = mv[q]; if (!okv[q]) m = (u32x4){0u, 0u, 0u, 0u};
            s[0] += lo16(m.x); s[1] += hi16(m.x); s[2] += lo16(m.y); s[3] += hi16(m.y); s[4] += lo16(m.z); s[5] += hi16(m.z); s[6] += lo16(m.w); s[7] += hi16(m.w); }
        const float inv = frcp((float)cnt);
        const u32x4 m = mv[W / 2];
        const float u[8] = {lo16(m.x), hi16(m.x), lo16(m.y), hi16(m.y), lo16(m.z), hi16(m.z), lo16(m.w), hi16(m.w)};
        u32x4 o = {pack2(s[0] * inv - u[0], s[1] * inv - u[1]), pack2(s[2] * inv - u[2], s[3] * inv - u[3]), pack2(s[4] * inv - u[4], s[5] * inv - u[5]), pack2(s[6] * inv - u[6], s[7] * inv - u[7])};
        stg((u32x4*)(p.Pb() + (size_t)row * 512 + ch), o);
    }
}
DEV void phase_pool(const Params& p, const SetDesc& sd) {
    const bf16_t* pb = proj_buf(p, sd);
    pool_group<0>(p, sd, pb); pool_group<1>(p, sd, pb); pool_group<2>(p, sd, pb); pool_group<3>(p, sd, pb);
}

template <int NC> DEV void mlstm_stepB_run(const Params& p, const SetDesc& sd, int task) {
    const int tid = TID();
    const int q = task & 3, dir = (task >> 2) & 1, h = (task >> 3) & 3, sl = task >> 5;
    const int ci = ((sd.samp0 + sl) * 4 + h) * 2 + dir;
    const int eoff = q * 2048 + tid * 4;
    float zr = 0.f; HIDE(zr);
    f32x4 C = {zr, zr, zr, zr}; float nv = 0.f; float m = -1e30f;
    f32x4 Sv[NC]; float blv[NC], mlv[NC], snv[NC];
#pragma unroll
    for (int c = 0; c < NC; ++c) { const int tb = dir ? NC - 1 - c : c; const size_t si = st_index(sd, sl, h, dir, tb);
        Sv[c] = ldg((const f32x4*)(p.Sst() + si * 8192 + eoff)); blv[c] = ldg(p.Ssc() + si * 4); mlv[c] = ldg(p.Ssc() + si * 4 + 1);
        snv[c] = (q == 0 && tid < 64) ? ldg(p.Sn() + si * 64 + tid) : 0.f; }
    if (!sd.is_ctx) { C = ldg((const f32x4*)(p.CiC() + (size_t)ci * 8192 + eoff)); if (q == 0 && tid < 64) nv = ldg(p.Cin_() + (size_t)ci * 64 + tid); m = ldg(p.Cim() + (size_t)ci * 4); }
#pragma unroll
    for (int c = 0; c < NC; ++c) {
        const int tb = dir ? NC - 1 - c : c; const size_t si = st_index(sd, sl, h, dir, tb);
        u32x2 o = {pack2(C[0], C[1]), pack2(C[2], C[3])};
        stg((u32x2*)(p.Cin() + si * 8192 + eoff), o);
        if (q == 0 && tid < 64) stg(p.Cn() + si * 64 + tid, nv);
        if (q == 0 && tid == 0) stg(p.Cm() + si * 4, m);
        const float mn = fmaxf(blv[c] + m, mlv[c]);
        const float dc = __expf(blv[c] + m - mn), wsn = __expf(mlv[c] - mn);
        C = C * dc + Sv[c] * wsn;
        nv = nv * dc + snv[c] * wsn;
        m = mn;
    }
    if (sd.is_ctx) { stg((f32x4*)(p.CiC() + (size_t)ci * 8192 + eoff), C); if (q == 0 && tid < 64) stg(p.Cin_() + (size_t)ci * 64 + tid, nv); if (q == 0 && tid == 0) stg(p.Cim() + (size_t)ci * 4, m); }
}
DEV void mlstm_stepB_task(const Params& p, const SetDesc& sd, int task) {
    if (sd.is_ctx) mlstm_stepB_run<NTBC>(p, sd, task); else mlstm_stepB_run<NTBL>(p, sd, task);
}

constexpr int NA_KLD = 136, NA_VLD = 144;
DEV void na_task(const Params& p, const SetDesc& sd, int layer, int sl, int rq2  , int hp, char* shm) {
    const int tid = TID(), lane = tid & 63, w = tid >> 6, tq = lane & 15, fq = lane >> 4, tq4 = (lane & 15) >> 2, tp4 = lane & 3;
    const int hh = w >> 2, g = w & 3, head = hp * 2 + hh;
    const bool ctxq = sd.is_ctx;
    bf16_t* Ks = (bf16_t*)shm;
    bf16_t* Vs = (bf16_t*)(shm + 128 * NA_KLD * 2);
    float* rpbs = (float*)(shm + 128 * NA_KLD * 2 + 128 * NA_VLD * 2);
    const int sample = sd.samp0 + sl;
    const bf16_t* pq = proj_buf(p, sd) + ((size_t)sl << sd.lgseq) * PWA;
    const bf16_t* pc = p.PROJc() + (size_t)sample * CTX * PWA;
    const int qcol = g * 16 + tq;
    int rqv[2], rsv[2], qtok[2];
#pragma unroll
    for (int u = 0; u < 2; ++u) { rqv[u] = 2 * rq2 + u; qtok[u] = rqv[u] * 64 + qcol; int r_ = rqv[u] - 4; rsv[u] = r_ < 0 ? 0 : (r_ > ROWS - 8 ? ROWS - 8 : r_); }
    const int nloc = ctxq ? 0 : (rsv[1] + 8 - rsv[0]);
    const int nstage = nloc + CTX / 64;
    __syncthreads();
    if (!ctxq) for (int i = tid; i < 2 * 465; i += NTHREADS) rpbs[i] = ldg(p.rpb + ((size_t)layer * 8 + hp * 2 + i / 465) * 465 + i % 465);
    bf16x8 qf[2][2];
#pragma unroll
    for (int u = 0; u < 2; ++u)
#pragma unroll
        for (int ks = 0; ks < 2; ++ks) qf[u][ks] = mk8(ldg((const u32x4*)(pq + (size_t)qtok[u] * PWA + C_QN + head * 64 + ks * 32 + fq * 8)));
    float m_run[2] = {-1e30f, -1e30f}, l_run[2] = {0.f, 0.f};
    f32x4 acc[2][4];
#pragma unroll
    for (int u = 0; u < 2; ++u)
#pragma unroll
        for (int mt = 0; mt < 4; ++mt) acc[u][mt] = (f32x4){0.f, 0.f, 0.f, 0.f};
    int cs = qcol - 8; cs = cs < 0 ? 0 : (cs > 48 ? 48 : cs);
    const int kc0 = (g == 0) ? 0 : (g == 1) ? 8 : (g == 2) ? 24 : 32;
    const int npair = (nstage + 1) >> 1;
    u32x4 kreg[4], vreg[4];
#define NA_SRC_ROWS(stg) (((stg) < nloc) ? (pq + (size_t)((rsv[0] + (stg)) * 64) * PWA) : (pc + (size_t)((((stg) < nstage ? (stg) : nstage - 1) - nloc) * 64) * PWA))
#define NA_FETCH(sp_) do { _Pragma("unroll") for (int it = 0; it < 4; ++it) { const int item = tid + it * 512, key2 = item >> 4, ch = item & 15; \
        const bf16_t* kb_ = NA_SRC_ROWS(2 * (sp_) + (key2 >> 6)); const bf16_t* src = kb_ + (size_t)(key2 & 63) * PWA + hp * 128 + ch * 8; \
        kreg[it] = ldg((const u32x4*)(src + C_KN)); vreg[it] = ldg((const u32x4*)(src + C_VN)); } } while (0)
    NA_FETCH(0);
    for (int sp = 0; sp < npair; ++sp) {
        __syncthreads();
#pragma unroll
        for (int it = 0; it < 4; ++it) { const int item = tid + it * 512, key2 = item >> 4, ch = item & 15;
            *(u32x4*)(Ks + key2 * NA_KLD + ch * 8) = kreg[it]; *(u32x4*)(Vs + key2 * NA_VLD + ch * 8) = vreg[it]; }
        if (sp + 1 < npair) NA_FETCH(sp + 1);
        __syncthreads();
#pragma unroll
        for (int sub = 0; sub < 2; ++sub) {
        const int st = 2 * sp + sub;
        if (st >= nstage) continue;
        const bool local = st < nloc;
        const bf16_t* Ksb = Ks + sub * 64 * NA_KLD; const bf16_t* Vsb = Vs + sub * 64 * NA_VLD;
        if (local) {
            const int kr = rsv[0] + st;
            f32x4 sa[2][2];
#pragma unroll
            for (int kt = 0; kt < 2; ++kt) { sa[0][kt] = (f32x4){0.f, 0.f, 0.f, 0.f}; sa[1][kt] = (f32x4){0.f, 0.f, 0.f, 0.f};
#pragma unroll
                for (int ks = 0; ks < 2; ++ks) { const bf16x8 kf = *(const bf16x8*)(Ksb + (kc0 + kt * 16 + tq) * NA_KLD + hh * 64 + ks * 32 + fq * 8);
                    sa[0][kt] = mfma16(kf, qf[0][ks], sa[0][kt]); sa[1][kt] = mfma16(kf, qf[1][ks], sa[1][kt]); } }
            float alpha[2]; bf16x8 pf[2];
#pragma unroll
            for (int u = 0; u < 2; ++u) {
                const bool act = (kr >= rsv[u]) && (kr < rsv[u] + 8);
                if (!act) { alpha[u] = 1.0f; pf[u] = mk8((u32x4){0u, 0u, 0u, 0u}); continue; }
                const int dr = kr - rqv[u] + 7;
                float sc[8]; float mx = -1e30f; float bs[8];
#pragma unroll
                for (int kt = 0; kt < 2; ++kt)
#pragma unroll
                    for (int r = 0; r < 4; ++r) { const int kcol = kc0 + kt * 16 + fq * 4 + r; int dc = kcol - qcol + 15; dc = dc < 0 ? 0 : (dc > 30 ? 30 : dc);
                        bs[kt * 4 + r] = rpbs[hh * 465 + dr * 31 + dc]; }
#ifndef CPU_EMU
                asm volatile("" : "+v"(bs[0]), "+v"(bs[1]), "+v"(bs[2]), "+v"(bs[3]), "+v"(bs[4]), "+v"(bs[5]), "+v"(bs[6]), "+v"(bs[7]));
#endif
#pragma unroll
                for (int kt = 0; kt < 2; ++kt)
#pragma unroll
                    for (int r = 0; r < 4; ++r) { const int kcol = kc0 + kt * 16 + fq * 4 + r; const bool valid = (kcol >= cs) && (kcol < cs + 16);
                        const float v = valid ? (sa[u][kt][r] * 0.125f + bs[kt * 4 + r]) : -1e30f; sc[kt * 4 + r] = v; mx = fmaxf(mx, v); }
                mx = fmaxf(mx, shx<16>(mx)); mx = fmaxf(mx, shx<32>(mx));
                const float mn = fmaxf(m_run[u], mx); alpha[u] = __expf(m_run[u] - mn); m_run[u] = mn;
                float ps = 0.f; float pv[8];
#pragma unroll
                for (int j = 0; j < 8; ++j) { pv[j] = __expf(sc[j] - mn); ps += pv[j]; }
                ps += shx<16>(ps); ps += shx<32>(ps);
                l_run[u] = l_run[u] * alpha[u] + ps;
                u32x4 pk = {pack2(pv[0], pv[1]), pack2(pv[2], pv[3]), pack2(pv[4], pv[5]), pack2(pv[6], pv[7])};
                pf[u] = mk8(pk);
            }
#pragma unroll
            for (int mt = 0; mt < 4; ++mt) {
                const bf16_t* vp = Vsb + (kc0 + 4 * fq + tq4) * NA_VLD + hh * 64 + mt * 16 + 4 * tp4;
                const bf16x8 vf = mk8(TR16(vp), TR16(vp + 16 * NA_VLD));
                acc[0][mt] = mfma16(vf, pf[0], acc[0][mt] * alpha[0]); acc[1][mt] = mfma16(vf, pf[1], acc[1][mt] * alpha[1]); }
        } else {
            f32x4 sa[2][4];
#pragma unroll
            for (int kt = 0; kt < 4; ++kt) { sa[0][kt] = (f32x4){0.f, 0.f, 0.f, 0.f}; sa[1][kt] = (f32x4){0.f, 0.f, 0.f, 0.f};
#pragma unroll
                for (int ks = 0; ks < 2; ++ks) { const bf16x8 kf = *(const bf16x8*)(Ksb + (kt * 16 + tq) * NA_KLD + hh * 64 + ks * 32 + fq * 8);
                    sa[0][kt] = mfma16(kf, qf[0][ks], sa[0][kt]); sa[1][kt] = mfma16(kf, qf[1][ks], sa[1][kt]); } }
            float alpha[2]; bf16x8 pf[2][2];
#pragma unroll
            for (int u = 0; u < 2; ++u) {
                float mx = -1e30f;
#pragma unroll
                for (int kt = 0; kt < 4; ++kt)
#pragma unroll
                    for (int r = 0; r < 4; ++r) { sa[u][kt][r] *= 0.125f; mx = fmaxf(mx, sa[u][kt][r]); }
                mx = fmaxf(mx, shx<16>(mx)); mx = fmaxf(mx, shx<32>(mx));
                const float mn = fmaxf(m_run[u], mx); alpha[u] = __expf(m_run[u] - mn); m_run[u] = mn;
                float ps = 0.f;
#pragma unroll
                for (int kt = 0; kt < 4; ++kt)
#pragma unroll
                    for (int r = 0; r < 4; ++r) { sa[u][kt][r] = __expf(sa[u][kt][r] - mn); ps += sa[u][kt][r]; }
                ps += shx<16>(ps); ps += shx<32>(ps);
                l_run[u] = l_run[u] * alpha[u] + ps;
#pragma unroll
                for (int h2 = 0; h2 < 2; ++h2) {
                    u32x4 pk = {pack2(sa[u][2 * h2][0], sa[u][2 * h2][1]), pack2(sa[u][2 * h2][2], sa[u][2 * h2][3]), pack2(sa[u][2 * h2 + 1][0], sa[u][2 * h2 + 1][1]), pack2(sa[u][2 * h2 + 1][2], sa[u][2 * h2 + 1][3])};
                    pf[u][h2] = mk8(pk); }
            }
#pragma unroll
            for (int mt = 0; mt < 4; ++mt) { acc[0][mt] = acc[0][mt] * alpha[0]; acc[1][mt] = acc[1][mt] * alpha[1]; }
#pragma unroll
            for (int h2 = 0; h2 < 2; ++h2)
#pragma unroll
                for (int mt = 0; mt < 4; ++mt) { const bf16_t* vp = Vsb + (32 * h2 + 4 * fq + tq4) * NA_VLD + hh * 64 + mt * 16 + 4 * tp4;
                    const bf16x8 vf = mk8(TR16(vp), TR16(vp + 16 * NA_VLD));
                    acc[0][mt] = mfma16(vf, pf[0][h2], acc[0][mt]); acc[1][mt] = mfma16(vf, pf[1][h2], acc[1][mt]); }
        }
        }
    }
#undef NA_FETCH
#undef NA_SRC_ROWS
#pragma unroll
    for (int u = 0; u < 2; ++u) {
        const float il = frcp(l_run[u]);
        const size_t orow = ((size_t)sl << sd.lgseq) + qtok[u];
#pragma unroll
        for (int mt = 0; mt < 4; ++mt) { u32x2 o = {pack2(acc[u][mt][0] * il, acc[u][mt][1] * il), pack2(acc[u][mt][2] * il, acc[u][mt][3] * il)};
            stg((u32x2*)(p.Nb() + orow * 512 + head * 64 + mt * 16 + fq * 4), o); }
    }
}

struct PrefC { RopeRaw rk1, rk2; u32x4 vreg[4], creg[4]; };
DEV void stepC_issue(PrefC& f, const Params& p, const SetDesc& sd, int task) {
    const int tid = TID();
    const int tb = task % sd.ntb, h = (task / sd.ntb) & 3, sl = task / (sd.ntb * 4);
    const int row0 = (sl << sd.lgseq) + tb * 128; const bool latent = !sd.is_ctx; const int tl0 = tb * 128;
    const bf16_t* prow = proj_buf(p, sd) + (size_t)row0 * PWA;
    { const int s = tid & 127, cpi = tid >> 7, cp = (cpi & 1) + (cpi >> 1) * 4; const bf16_t* hp = prow + (size_t)s * PWA + C_KM + h * 64;
      rope_issue(f.rk1, hp, cp, latent, tl0 + s, p.rope()); rope_issue(f.rk2, hp, cp + 2, latent, tl0 + s, p.rope()); }
#pragma unroll
    for (int it = 0; it < 4; ++it) { const int item = tid + it * 512, s = item >> 4, ch = item & 15; f.vreg[it] = ldg((const u32x4*)(prow + (size_t)s * PWA + C_VM + h * 128 + ch * 8)); }
#pragma unroll
    for (int it = 0; it < 4; ++it) { const int item = tid + it * 512, dir = item >> 10, rem = item & 1023, v = rem >> 3, ch = rem & 7;
        f.creg[it] = ldg((const u32x4*)(p.Cin() + (size_t)st_index(sd, sl, h, dir, tb) * 8192 + v * 64 + ch * 8)); }
}
DEV void mlstm_stepC_task(const Params& p, const SetDesc& sd, int layer, int task, int next_task, PrefC& f, char* shm) {
    const int tid = TID(), lane = tid & 63, w = tid >> 6, tq = lane & 15, fq = lane >> 4, tq4 = (lane & 15) >> 2, tp4 = lane & 3;
    const int tb = task % sd.ntb, h = (task / sd.ntb) & 3, sl = task / (sd.ntb * 4);
    const int row0 = (sl << sd.lgseq) + tb * 128; const bool latent = !sd.is_ctx; const int tl0 = tb * 128;
    bf16_t* Ks = (bf16_t*)shm;
    bf16_t* Vs = (bf16_t*)(shm + 128 * K_LD * 2);
    bf16_t* Cs = (bf16_t*)(shm + 128 * K_LD * 2 + 128 * V_LD * 2);
    float* ga = (float*)(shm + 128 * K_LD * 2 * 3 + 128 * V_LD * 2); float* gb = ga + 256; float* gpm = gb + 256; float* gtot = gpm + 256; float* tmp = gtot + 8;
    float* nvs = tmp + 16;
    float* cms = nvs + 128;
    const bf16_t* prow = proj_buf(p, sd) + (size_t)row0 * PWA;
    RopeRaw rq[2];
    { const int t_ = w * 16 + tq; const bf16_t* hp = prow + (size_t)t_ * PWA + C_QM + h * 64;
#pragma unroll
      for (int ks = 0; ks < 2; ++ks) rope_issue(rq[ks], hp, ks * 4 + fq, latent, tl0 + t_, p.rope()); }
    __syncthreads();
    gate_scan(prow, h, p.gate_bias + (size_t)layer * 16, ga, gb, gpm, gtot, tmp);
    {
        const int s = tid & 127, cpi = tid >> 7, cp = (cpi & 1) + (cpi >> 1) * 4;
        float k1[8], k2[8];
        rope_apply(f.rk1, cp, latent, 1.0f, k1);
        rope_apply(f.rk2, cp + 2, latent, 1.0f, k2);
        u32x4 o1 = {pack2(k1[0], k1[1]), pack2(k1[2], k1[3]), pack2(k1[4], k1[5]), pack2(k1[6], k1[7])};
        u32x4 o2 = {pack2(k2[0], k2[1]), pack2(k2[2], k2[3]), pack2(k2[4], k2[5]), pack2(k2[6], k2[7])};
        *(u32x4*)(Ks + s * K_LD + cp * 8) = o1; *(u32x4*)(Ks + s * K_LD + (cp + 2) * 8) = o2;
    }
#pragma unroll
    for (int it = 0; it < 4; ++it) { const int item = tid + it * 512, s = item >> 4, ch = item & 15; *(u32x4*)(Vs + s * V_LD + ch * 8) = f.vreg[it]; }
#pragma unroll
    for (int it = 0; it < 4; ++it) { const int item = tid + it * 512, dir = item >> 10, rem = item & 1023, v = rem >> 3, ch = rem & 7; *(u32x4*)(Cs + (dir * 128 + v) * K_LD + ch * 8) = f.creg[it]; }
    if (tid < 128) nvs[tid] = ldg(p.Cn() + (size_t)st_index(sd, sl, h, tid >> 6, tb) * 64 + (tid & 63));
    if (tid < 2) cms[tid] = ldg(p.Cm() + (size_t)st_index(sd, sl, h, tid, tb) * 4);
    bf16x8 qf[2]; float qv[2][8];
    {
#pragma unroll
        for (int ks = 0; ks < 2; ++ks) { rope_apply(rq[ks], ks * 4 + fq, latent, 0.125f, qv[ks]);
            u32x4 o = {pack2(qv[ks][0], qv[ks][1]), pack2(qv[ks][2], qv[ks][3]), pack2(qv[ks][4], qv[ks][5]), pack2(qv[ks][6], qv[ks][7])}; qf[ks] = mk8(o); }
    }
    if (next_task >= 0) stepC_issue(f, p, sd, next_task);
    __syncthreads();
    const int t = w * 16 + tq;
    f32x4 hsum[8];
#pragma unroll
    for (int mt = 0; mt < 8; ++mt) hsum[mt] = (f32x4){0.f, 0.f, 0.f, 0.f};
#pragma unroll
    for (int dir = 0; dir < 2; ++dir) {
        const float m_in = cms[dir];
        const float Mt = fmaxf(m_in, gpm[dir * 128 + t]);
        const float inter = __expf(m_in - Mt);
        const float mtot = gb[dir * 128 + t] + Mt;
        f32x4 acc[8];
#pragma unroll
        for (int mt = 0; mt < 8; ++mt) { acc[mt] = (f32x4){0.f, 0.f, 0.f, 0.f};
#pragma unroll
            for (int ks = 0; ks < 2; ++ks) { const bf16x8 cf = *(const bf16x8*)(Cs + (dir * 128 + mt * 16 + tq) * K_LD + ks * 32 + fq * 8);
                acc[mt] = mfma16(cf, qf[ks], acc[mt]); }
            acc[mt] = acc[mt] * inter; }
        float qn = 0.f;
#pragma unroll
        for (int ks = 0; ks < 2; ++ks)
#pragma unroll
            for (int j = 0; j < 8; ++j) qn += bf2f(f2bf(qv[ks][j])) * nvs[dir * 64 + ks * 32 + fq * 8 + j];
        qn += shx<16>(qn); qn += shx<32>(qn);
        float den = inter * qn;
        const int u_lo = dir == 0 ? 0 : (w >> 1), u_hi = dir == 0 ? (w >> 1) : 3;
        float rsum = 0.f;
        for (int u = u_lo; u <= u_hi; ++u) {
            unsigned pk[4];
#pragma unroll
            for (int kt = 0; kt < 2; ++kt) { f32x4 sa = {0.f, 0.f, 0.f, 0.f}; const int sb = 32 * u + 16 * kt;
#pragma unroll
                for (int ks = 0; ks < 2; ++ks) { const bf16x8 kf = *(const bf16x8*)(Ks + (sb + tq) * K_LD + ks * 32 + fq * 8); sa = mfma16(kf, qf[ks], sa); }
                float pv[4]; float gv4[4];
#pragma unroll
                for (int r = 0; r < 4; ++r) gv4[r] = ga[dir * 128 + sb + fq * 4 + r];
#ifndef CPU_EMU
                asm volatile("" : "+v"(gv4[0]), "+v"(gv4[1]), "+v"(gv4[2]), "+v"(gv4[3]));
#endif
#pragma unroll
                for (int r = 0; r < 4; ++r) { const int s = sb + fq * 4 + r; const bool valid = dir == 0 ? (s <= t) : (s >= t);
                    pv[r] = valid ? sa[r] * __expf(gv4[r] - Mt) : 0.f; pv[r] = bf2f(f2bf(pv[r])); rsum += pv[r]; }
                pk[kt * 2] = pack2(pv[0], pv[1]); pk[kt * 2 + 1] = pack2(pv[2], pv[3]); }
            u32x4 pkv = {pk[0], pk[1], pk[2], pk[3]}; const bf16x8 pf = mk8(pkv);
#pragma unroll
            for (int mt = 0; mt < 8; ++mt) { const bf16_t* vp = Vs + (32 * u + 4 * fq + tq4) * V_LD + mt * 16 + 4 * tp4;
                const bf16x8 vf = mk8(TR16(vp), TR16(vp + 16 * V_LD));
                acc[mt] = mfma16(vf, pf, acc[mt]); }
        }
        rsum += shx<16>(rsum); rsum += shx<32>(rsum);
        den += rsum;
        const float dn = frcp(fmaxf(fabsf(den), __expf(-mtot)));
#pragma unroll
        for (int mt = 0; mt < 8; ++mt) hsum[mt] = hsum[mt] + acc[mt] * dn;
    }
    float ss = 0.f;
#pragma unroll
    for (int mt = 0; mt < 8; ++mt)
#pragma unroll
        for (int r = 0; r < 4; ++r) ss += hsum[mt][r] * hsum[mt][r];
    ss += shx<16>(ss); ss += shx<32>(ss);
    const float rstd = rsqrtf(ss * (1.0f / 128.0f) + RMS_EPS);
#pragma unroll
    for (int mt = 0; mt < 8; ++mt) { const int v = mt * 16 + fq * 4;
        const u32x2 om = ldg((const u32x2*)(prow + (size_t)t * PWA + C_OM + h * 128 + v));
        u32x2 o = {pack2(hsum[mt][0] * rstd * sigmoidf_(lo16(om.x)), hsum[mt][1] * rstd * sigmoidf_(hi16(om.x))),
                   pack2(hsum[mt][2] * rstd * sigmoidf_(lo16(om.y)), hsum[mt][3] * rstd * sigmoidf_(hi16(om.y)))};
        stg((u32x2*)(p.Mb() + (size_t)(row0 + t) * 512 + h * 128 + v), o); }
}

struct SchedMerge {
    const bf16_t* Mb; const bf16_t* Pb; const bf16_t* Nb; const bf16_t* Wb; int nM;
    DEV bool next(int i, GUnit& u) const { u.aux = i % 3; return tile_order(i / 3, nM, 4, u.pm, u.pn); }
    DEV const bf16_t* a_base(const GUnit& u) const { return (u.aux == 0 ? Mb : (u.aux == 1 ? Pb : Nb)) + (size_t)u.pm * 256 * 512; }
    DEV const bf16_t* b_base(const GUnit& u) const { return Wb + ((size_t)u.aux * 1024 + u.pn * 256) * 512; }
    DEV int grow(const GUnit&, int) const { return 0; }
};
DEV void phase_merge(const Params& p, const SetDesc& sd, int layer, char* shm) {
    SchedMerge S; S.Mb = p.Mb(); S.Pb = p.Pb(); S.Nb = p.Nb(); S.Wb = p.WbT() + (size_t)layer * 3 * 1024 * 512; S.nM = sd.nrows / 256;
    const unsigned char* bgb = p.BG(); bf16_t* mgb = p.MERGED();
    gemm_stream<false, 512, 512, 512>(shm, S, [=](const GUnit& u, f32x4 (&acc)[2][2][4][2], int r0, int c0) -> bool {
        if (u.aux < 2) {
            u32x2 ga[2][4][2], gb[2][4][2];
#pragma unroll
            for (int ai = 0; ai < 2; ++ai)
#pragma unroll
                for (int m = 0; m < 4; ++m)
#pragma unroll
                    for (int hf = 0; hf < 2; ++hf) { const unsigned char* gp = bgb + ((size_t)u.pm * 256 + r0 + ai * 128 + m * 16) * NBG + u.aux * 1024 + u.pn * 256 + c0 + hf * 128;
                        ga[ai][m][hf] = ldg((const u32x2*)gp); gb[ai][m][hf] = ldg((const u32x2*)(gp + 1024)); }
#pragma unroll
            for (int ai = 0; ai < 2; ++ai)
#pragma unroll
                for (int m = 0; m < 4; ++m)
#pragma unroll
                    for (int hf = 0; hf < 2; ++hf) {
#pragma unroll
                        for (int j = 0; j < 4; ++j) { acc[ai][hf][m][0][j] *= u8f(ga[ai][m][hf].x, j) * frcp(u8f(gb[ai][m][hf].x, j)); acc[ai][hf][m][1][j] *= u8f(ga[ai][m][hf].y, j) * frcp(u8f(gb[ai][m][hf].y, j)); } }
            return true;
        }
        u32x2 gm2[2][4][2];
#pragma unroll
        for (int ai = 0; ai < 2; ++ai)
#pragma unroll
            for (int m = 0; m < 4; ++m)
#pragma unroll
                for (int hf = 0; hf < 2; ++hf) gm2[ai][m][hf] = ldg((const u32x2*)(bgb + ((size_t)u.pm * 256 + r0 + ai * 128 + m * 16) * NBG + 2048 + u.pn * 256 + c0 + hf * 128));
#pragma unroll
        for (int ai = 0; ai < 2; ++ai) {
#pragma unroll
            for (int m = 0; m < 4; ++m)
#pragma unroll
                for (int hf = 0; hf < 2; ++hf) { const size_t r = (size_t)u.pm * 256 + r0 + ai * 128 + m * 16;
                    const f32x4 x0 = acc[ai][hf][m][0] * (1.0f / 255.0f), x1 = acc[ai][hf][m][1] * (1.0f / 255.0f); const u32x2 g = gm2[ai][m][hf];
                    u32x4 ov = {pack2(x0[0] * u8f(g.x, 0), x0[1] * u8f(g.x, 1)), pack2(x0[2] * u8f(g.x, 2), x0[3] * u8f(g.x, 3)),
                                pack2(x1[0] * u8f(g.y, 0), x1[1] * u8f(g.y, 1)), pack2(x1[2] * u8f(g.y, 2), x1[3] * u8f(g.y, 3))};
                    stg((u32x4*)(mgb + r * 1024 + u.pn * 256 + c0 + hf * 128), ov); }
        }
        return false; });
}
DEV void phase_outproj(const Params& p, const SetDesc& sd, int layer, char* shm) {
    SchedPlain S; S.A = p.MERGED(); S.Bt = p.WoT() + (size_t)layer * 1024 * 1024; S.nM = sd.nrows / 256; S.nN = 4; S.lda256 = 256 * 1024; S.ldb256 = 256 * 1024;
    bf16_t* yb = p.Y();
    gemm_stream<false, 1024, 1024, 1024>(shm, S, [=](const GUnit& u, const f32x4 (&acc)[2][2][4][2], int r0, int c0) {
#pragma unroll
        for (int ai = 0; ai < 2; ++ai)
#pragma unroll
            for (int m = 0; m < 4; ++m) { bf16_t* o = yb + ((size_t)u.pm * 256 + r0 + ai * 128 + m * 16) * 1024 + u.pn * 256 + c0;
                store8bf(o, acc[ai][0][m][0], acc[ai][0][m][1]); store8bf(o + 128, acc[ai][1][m][0], acc[ai][1][m][1]); } });
}

template <bool SRC_BF> DEV void phase_postmix(const Params& p, const SetDesc& sd, int layer, char* shm) {
    const int tid = TID(), lane = tid & 63, wv = tid >> 6;
    float* wr_s = (float*)shm;
    __syncthreads();
    for (int i = tid; i < 1024 * 16; i += NTHREADS) { const int c = i >> 4, e = i & 15, ln = (c & 511) >> 3, j = c & 7, hf = c >> 9;
        wr_s[((((hf * 8 + j) * 4 + (e >> 2)) * 64 + ln) << 2) + (e & 3)] = ldg(p.router_w + (size_t)layer * 1024 * 16 + i); }
    __syncthreads();
    const float* g1 = p.norm_gain + ((size_t)layer * 4 + 1) * 1024; const float* g2 = p.norm_gain + ((size_t)layer * 4 + 2) * 1024;
    float* par = (float*)(shm + 65536);
    { const int rpb0_ = (sd.nrows + (int)gridDim.x - 1) / (int)gridDim.x; const float* mdb = mod_row(p, sd, layer, min((int)blockIdx.x * rpb0_, sd.nrows - 1));
      stage_params(par, g1, g2, mdb + 2048, mdb + 3072, mdb + 4096); }
    __syncthreads();
    const void* xb = SRC_BF ? (const void*)xbf_base(p, sd) : (const void*)xin_f32(p, sd); bf16_t* xdb = xbf_base(p, sd);
    const int stride = 8; const int rpb_ = (sd.nrows + (int)gridDim.x - 1) / (int)gridDim.x; const int row_end = min(sd.nrows, ((int)blockIdx.x + 1) * rpb_);
    int row = (int)blockIdx.x * rpb_ + wv;
    u32x4 ycur[2], ynxt[2]; XRow<SRC_BF> xcur, xnxt;
    if (row < row_end) {
#pragma unroll
        for (int i = 0; i < 2; ++i) ycur[i] = ldg((const u32x4*)(p.Y() + (size_t)row * 1024 + i * 512 + lane * 8));
        xcur.load(xb, row, lane); }
    for (; row < row_end; row += stride) {
        int ln = lane; HIDE(ln);
        const int rn = row + stride;
        if (rn < row_end) {
#pragma unroll
            for (int i = 0; i < 2; ++i) ynxt[i] = ldg((const u32x4*)(p.Y() + (size_t)rn * 1024 + i * 512 + ln * 8));
            xnxt.load(xb, rn, ln); }
        float y[16]; float ss = 0.f;
#pragma unroll
        for (int hlf = 0; hlf < 2; ++hlf) { const u32x4 m = ycur[hlf];
            const float t8[8] = {lo16(m.x), hi16(m.x), lo16(m.y), hi16(m.y), lo16(m.z), hi16(m.z), lo16(m.w), hi16(m.w)};
#pragma unroll
            for (int j = 0; j < 8; ++j) { y[hlf * 8 + j] = t8[j]; ss += t8[j] * t8[j]; } }
        ss = wave_sum(ss);
        const float rstd = rsqrtf(ss * (1.0f / 1024.0f) + RMS_EPS);
        float xn[16]; float ss2 = 0.f;
#pragma unroll
        for (int hlf = 0; hlf < 2; ++hlf) { f32x4 xw[2];
#pragma unroll
            for (int q = 0; q < 2; ++q) { const int c0 = hlf * 512 + ln * 8 + q * 4; const f32x4 xo = xcur.get(hlf * 2 + q);
#pragma unroll
                for (int j = 0; j < 4; ++j) { const float v = xo[j] + par[2048 + c0 + j] * (y[hlf * 8 + q * 4 + j] * rstd * par[c0 + j]); xw[q][j] = v; xn[hlf * 8 + q * 4 + j] = v; ss2 += v * v; } }
            xrow_store8<true>(xdb, row, hlf * 512 + ln * 8, xw[0], xw[1]); }
        ss2 = wave_sum(ss2);
        const float rstd2 = rsqrtf(ss2 * (1.0f / 1024.0f) + RMS_EPS);
        float lg[16];
#pragma unroll
        for (int e = 0; e < 16; ++e) lg[e] = 0.f;
#pragma unroll
        for (int hlf = 0; hlf < 2; ++hlf) { const int c0 = hlf * 512 + ln * 8; float o[8];
#pragma unroll
            for (int j = 0; j < 8; ++j) { o[j] = xn[hlf * 8 + j] * rstd2 * par[1024 + c0 + j] * (1.0f + par[4096 + c0 + j]) + par[3072 + c0 + j];
#pragma unroll
                for (int eq = 0; eq < 4; ++eq) { const f32x4 w4 = *(const f32x4*)(wr_s + ((((hlf * 8 + j) * 4 + eq) * 64 + ln) << 2));
#pragma unroll
                    for (int e = 0; e < 4; ++e) lg[eq * 4 + e] += o[j] * w4[e]; } }
            const u32x2 ov = {f8pack4(o[0], o[1], o[2], o[3]), f8pack4(o[4], o[5], o[6], o[7])};
            stg((u32x2*)((unsigned char*)p.H() + (size_t)row * 1024 + c0), ov); }
        float r8[8], r4[4], r2[2], r1;
        { const bool b = (lane & 32) != 0;
#pragma unroll
          for (int i = 0; i < 8; ++i) { const float keep = b ? lg[i + 8] : lg[i], send = b ? lg[i] : lg[i + 8]; r8[i] = keep + shx<32>(send); } }
        { const bool b = (lane & 16) != 0;
#pragma unroll
          for (int i = 0; i < 4; ++i) { const float keep = b ? r8[i + 4] : r8[i], send = b ? r8[i] : r8[i + 4]; r4[i] = keep + shx<16>(send); } }
        { const bool b = (lane & 8) != 0;
#pragma unroll
          for (int i = 0; i < 2; ++i) { const float keep = b ? r4[i + 2] : r4[i], send = b ? r4[i] : r4[i + 2]; r2[i] = keep + shx<8>(send); } }
        { const bool b = (lane & 4) != 0; const float keep = b ? r2[1] : r2[0], send = b ? r2[0] : r2[1]; r1 = keep + shx<4>(send); }
        r1 += shx<2>(r1); r1 += shx<1>(r1);
        float mx = r1;
        mx = fmaxf(mx, shx<4>(mx)); mx = fmaxf(mx, shx<8>(mx)); mx = fmaxf(mx, shx<16>(mx)); mx = fmaxf(mx, shx<32>(mx));
        const float ex = __expf(r1 - mx);
        float se = ex;
        se += shx<4>(se); se += shx<8>(se); se += shx<16>(se); se += shx<32>(se);
        if ((lane & 3) == 0) { const int e = ((lane >> 5) & 1) * 8 + ((lane >> 4) & 1) * 4 + ((lane >> 3) & 1) * 2 + ((lane >> 2) & 1);
            stg(p.aff() + (size_t)row * 16 + e, ex * frcp(se)); }
#pragma unroll
        for (int i = 0; i < 2; ++i) ycur[i] = ynxt[i];
        xcur = xnxt;
    }
}

DEV unsigned shxu(unsigned v, int m) {
    const float f = __uint_as_float(v); float r;
    switch (m) { case 1: r = shx<1>(f); break; case 2: r = shx<2>(f); break; case 4: r = shx<4>(f); break; case 8: r = shx<8>(f); break; case 16: r = shx<16>(f); break; default: r = shx<32>(f); break; }
    return __float_as_uint(r);
}
#define TK_CX(a_, b_, desc_) do { const unsigned long long x_ = key[a_], y_ = key[b_]; const bool sw_ = (desc_) ? (x_ < y_) : (x_ > y_); key[a_] = sw_ ? y_ : x_; key[b_] = sw_ ? x_ : y_; } while (0)
template <int TJ> DEV void tk_step_sh(unsigned long long (&key)[4], int tid, bool desc4) {
    unsigned long long pk[4];
#pragma unroll
    for (int m = 0; m < 4; ++m) { const unsigned lo = __float_as_uint(shx<TJ>(__uint_as_float((unsigned)key[m]))), hi = __float_as_uint(shx<TJ>(__uint_as_float((unsigned)(key[m] >> 32))));
        pk[m] = ((unsigned long long)hi << 32) | lo; }
    const bool takemax = desc4 == ((tid & TJ) == 0);
#pragma unroll
    for (int m = 0; m < 4; ++m) { const unsigned long long x = key[m], y = pk[m]; key[m] = takemax ? (x > y ? x : y) : (x < y ? x : y); }
}
DEV void tk_step_lds(unsigned long long (&key)[4], unsigned long long* buf, int tid, int tj, bool active, bool desc4) {
    unsigned long long pk[4];
    __syncthreads();
    if (active) {
#pragma unroll
        for (int m = 0; m < 4; ++m) buf[tid * 4 + m] = key[m]; }
    __syncthreads();
#pragma unroll
    for (int m = 0; m < 4; ++m) pk[m] = active ? buf[(tid ^ tj) * 4 + m] : 0ull;
    const bool takemax = desc4 == ((tid & tj) == 0);
#pragma unroll
    for (int m = 0; m < 4; ++m) { const unsigned long long x = key[m], y = pk[m]; key[m] = takemax ? (x > y ? x : y) : (x < y ? x : y); }
}
DEV void topk_task(const Params& p, const SetDesc& sd, int task, char* shm) {
    const int tid = TID();
    const int e = task & 15, sl = task >> 4;
    unsigned long long* buf = (unsigned long long*)shm;
    const int T = 1 << sd.lgseq, cap = sd.cap;
    const int rbase = sl << sd.lgseq;
    const bool active = tid * 4 < T;
    unsigned long long key[4];
    __syncthreads();
#pragma unroll
    for (int m = 0; m < 4; ++m) { const int i = tid * 4 + m; const float a = active ? ldg(p.aff() + (size_t)(rbase + i) * 16 + e) : 0.f;
        key[m] = ((unsigned long long)__float_as_uint(a) << 32) | (unsigned)(0xFFFFFFFFu - (unsigned)i); }
    for (int k = 2; k <= T; k <<= 1) {
        const bool desc4 = ((tid * 4) & k) == 0;
        for (int j = k >> 1; j >= 256; j >>= 1) tk_step_lds(key, buf, tid, j >> 2, active, desc4);
        if (k >= 256) tk_step_sh<32>(key, tid, desc4);
        if (k >= 128) tk_step_sh<16>(key, tid, desc4);
        if (k >= 64) tk_step_sh<8>(key, tid, desc4);
        if (k >= 32) tk_step_sh<4>(key, tid, desc4);
        if (k >= 16) tk_step_sh<2>(key, tid, desc4);
        if (k >= 8) tk_step_sh<1>(key, tid, desc4);
        if (k >= 4) { TK_CX(0, 2, desc4); TK_CX(1, 3, desc4); TK_CX(0, 1, desc4); TK_CX(2, 3, desc4); }
        else { TK_CX(0, 1, true); TK_CX(2, 3, false); }
    }
    const int sbase = e * sd.rpe + sl * cap;
    if (active) {
#pragma unroll
        for (int m = 0; m < 4; ++m) { const int i = tid * 4 + m; const unsigned long long kv = key[m]; const int tok = (int)(0xFFFFFFFFu - (unsigned)(kv & 0xFFFFFFFFu));
            const int row = rbase + tok;
            if (i < cap) { stg(p.slot_token() + sbase + i, row); stg(p.slot_gate() + sbase + i, __uint_as_float((unsigned)(kv >> 32))); stg(p.token_slots() + (size_t)row * 16 + e, sbase + i); }
            else stg(p.token_slots() + (size_t)row * 16 + e, -1); } }
    if (sl == 0) { const int used = sd.nsamp * cap;
        for (int i = used + tid; i < sd.rpe; i += NTHREADS) { stg(p.slot_token() + e * sd.rpe + i, 0); stg(p.slot_gate() + e * sd.rpe + i, 0.f); } }
}
#undef TK_CX

struct SchedMoe {
    const bf16_t* A; const int* st; const bf16_t* W; int nRT, rpe, nN, wstride;
    DEV bool next(int i, GUnit& u) const { int pmx, pn; if (!tile_order(i, 16 * nRT, nN, pmx, pn)) return false; u.pm = pmx % nRT; u.aux = pmx / nRT; u.pn = pn; return true; }
    DEV int slot0(const GUnit& u) const { return u.aux * rpe + u.pm * 256; }
    DEV const bf16_t* a_base(const GUnit&) const { return A; }
    DEV int grow(const GUnit& u, int i) const { return st ? ldg(st + slot0(u) + i) : slot0(u) + i; }
    DEV const bf16_t* b_base(const GUnit& u) const { return W + (size_t)u.aux * wstride + (size_t)u.pn * 256 * 512; }
};
DEV void phase_moe_gu(const Params& p, const SetDesc& sd, int layer, char* shm) {
    SchedMoe S; S.A = p.H(); S.st = p.slot_token(); S.W = p.WguT() + (size_t)layer * 16 * 2048 * 512; S.nRT = sd.rpe / 256; S.rpe = sd.rpe; S.nN = 8; S.wstride = 2048 * 512;
    unsigned char* hb = (unsigned char*)p.HID();
    gemm_stream<true, 512, 512, 512, true>(shm, S, [=](const GUnit& u, const f32x4 (&acc)[2][2][4][2], int r0, int c0) {
#pragma unroll
        for (int ai = 0; ai < 2; ++ai)
#pragma unroll
            for (int m = 0; m < 4; ++m) { f32x4 h0, h1; const f32x4 a0 = acc[ai][0][m][0] * F8_WINV, a1 = acc[ai][0][m][1] * F8_WINV, b0 = acc[ai][1][m][0] * F8_WINV, b1 = acc[ai][1][m][1] * F8_WINV;
#pragma unroll
                for (int j = 0; j < 4; ++j) { h0[j] = a0[j] * sigmoidf_(a0[j]) * b0[j]; h1[j] = a1[j] * sigmoidf_(a1[j]) * b1[j]; }
                const u32x2 hv = {f8pack4(h0[0], h0[1], h0[2], h0[3]), f8pack4(h1[0], h1[1], h1[2], h1[3])};
                stg((u32x2*)(hb + ((size_t)S.slot0(u) + r0 + ai * 128 + m * 16) * 1024 + u.pn * 128 + c0), hv); } });
}
DEV void phase_moe_down(const Params& p, const SetDesc& sd, int layer, char* shm) {
    SchedMoe S; S.A = p.HID(); S.st = nullptr; S.W = p.WdT() + (size_t)layer * 16 * 1024 * 512; S.nRT = sd.rpe / 256; S.rpe = sd.rpe; S.nN = 4; S.wstride = 1024 * 512;
    unsigned char* yb = (unsigned char*)p.YE(); const float* gt = p.slot_gate();
    gemm_stream<true, 512, 512, 512, true>(shm, S, [=](const GUnit& u, const f32x4 (&acc)[2][2][4][2], int r0, int c0) {
#pragma unroll
        for (int ai = 0; ai < 2; ++ai) {
            float gv[4];
#pragma unroll
            for (int m = 0; m < 4; ++m) gv[m] = ldg(gt + (size_t)S.slot0(u) + r0 + ai * 128 + m * 16) * (F8_WINV * YE_SCALE);
#pragma unroll
            for (int m = 0; m < 4; ++m) { const size_t sl = (size_t)S.slot0(u) + r0 + ai * 128 + m * 16; const float g = gv[m];
                unsigned char* o = yb + sl * 1024 + u.pn * 256 + c0;
#pragma unroll
                for (int hf = 0; hf < 2; ++hf) { const f32x4 a = acc[ai][hf][m][0] * g, b = acc[ai][hf][m][1] * g;
                    const u32x2 ov = {f8pack4(a[0], a[1], a[2], a[3]), f8pack4(b[0], b[1], b[2], b[3])}; stg((u32x2*)(o + hf * 128), ov); } } } });
}

DEV void compact4(const int (&sl)[16], int (&c)[4], int& n) {
    n = 0; c[0] = -1; c[1] = -1; c[2] = -1; c[3] = -1;
#pragma unroll
    for (int e = 0; e < 16; ++e) if (sl[e] >= 0) { c[0] = (n == 0) ? sl[e] : c[0]; c[1] = (n == 1) ? sl[e] : c[1]; c[2] = (n == 2) ? sl[e] : c[2]; c[3] = (n == 3) ? sl[e] : c[3]; ++n; }
}
template <bool DST_F32> DEV void phase_combine(const Params& p, const SetDesc& sd, int layer, char* shm) {
    const int tid = TID(), lane = tid & 63, wv = tid >> 6;
    const float* g3 = p.norm_gain + ((size_t)layer * 4 + 3) * 1024;
    const bf16_t* xsb = xbf_base(p, sd); void* xdb = DST_F32 ? (void*)xout_f32(p, sd) : (void*)xbf_base(p, sd);
    const int stride = 8; const int rpb_ = (sd.nrows + (int)gridDim.x - 1) / (int)gridDim.x; const int row_end = min(sd.nrows, ((int)blockIdx.x + 1) * rpb_);
    int row = __builtin_amdgcn_readfirstlane((int)blockIdx.x * rpb_ + wv);
    float* par = (float*)shm;
    __syncthreads();
    { const float* mdb = mod_row(p, sd, layer, min((int)blockIdx.x * rpb_, sd.nrows - 1)); stage_params(par, g3, mdb + 5120, nullptr, nullptr, nullptr); }
    __syncthreads();
    int raw[16]; int cc[4], cn[4]; int nc = 0, nn = 0;
    u32x2 mc[4][2], mn[4][2]; XRow<true> xc, xn;
#define CMB_SLOTS(r_) do { _Pragma("unroll") for (int e = 0; e < 16; ++e) raw[e] = ldg(p.token_slots() + (size_t)(r_) * 16 + e); } while (0)
#define CMB_DATA(r_, c_, n_, m_, x_) do { _Pragma("unroll") for (int k = 0; k < 4; ++k) { \
            if (k < (n_)) { const unsigned char* yr = (const unsigned char*)p.YE() + (size_t)(c_)[k] * 1024 + lane * 8; (m_)[k][0] = ldg((const u32x2*)yr); (m_)[k][1] = ldg((const u32x2*)(yr + 512)); } \
            else { (m_)[k][0] = (u32x2){0u, 0u}; (m_)[k][1] = (u32x2){0u, 0u}; } } \
        (x_).load(xsb, (r_), lane); } while (0)
    if (row < row_end) { CMB_SLOTS(row); compact4(raw, cc, nc); CMB_DATA(row, cc, nc, mc, xc); if (row + stride < row_end) CMB_SLOTS(row + stride); }
    for (; row < row_end; row += stride) {
        const int rn = row + stride;
        if (rn < row_end) { compact4(raw, cn, nn); CMB_DATA(rn, cn, nn, mn, xn); if (rn + stride < row_end) CMB_SLOTS(rn + stride); }
        float y[16];
#pragma unroll
        for (int j = 0; j < 16; ++j) y[j] = 0.f;
        if (nc <= 4) {
#pragma unroll
            for (int k = 0; k < 4; ++k)
                if (k < nc) {
#pragma unroll
                    for (int hlf = 0; hlf < 2; ++hlf) { const f32x4 a = f8x4_f32(mc[k][hlf].x), b = f8x4_f32(mc[k][hlf].y);
#pragma unroll
                        for (int j = 0; j < 4; ++j) { y[hlf * 8 + j] += a[j]; y[hlf * 8 + 4 + j] += b[j]; } } }
        } else {
            for (int e = 0; e < 16; ++e) { const int sl_ = ldg(p.token_slots() + (size_t)row * 16 + e);
                if (sl_ >= 0) { const unsigned char* yr = (const unsigned char*)p.YE() + (size_t)sl_ * 1024 + lane * 8;
#pragma unroll
                    for (int hlf = 0; hlf < 2; ++hlf) { const u32x2 m = ldg((const u32x2*)(yr + hlf * 512)); const f32x4 a = f8x4_f32(m.x), b = f8x4_f32(m.y);
#pragma unroll
                        for (int j = 0; j < 4; ++j) { y[hlf * 8 + j] += a[j]; y[hlf * 8 + 4 + j] += b[j]; } } } }
        }
        float ss = 0.f;
#pragma unroll
        for (int j = 0; j < 16; ++j) ss += y[j] * y[j];
        ss = wave_sum(ss);
        const float rstd = rsqrtf(ss * (YE_INV * YE_INV / 1024.0f) + RMS_EPS) * YE_INV;
#pragma unroll
        for (int hlf = 0; hlf < 2; ++hlf) { f32x4 xv[2];
#pragma unroll
            for (int q = 0; q < 2; ++q) { const int c0 = hlf * 512 + lane * 8 + q * 4; xv[q] = xc.get(hlf * 2 + q);
#pragma unroll
                for (int j = 0; j < 4; ++j) xv[q][j] += par[1024 + c0 + j] * (y[hlf * 8 + q * 4 + j] * rstd * par[c0 + j]); }
            xrow_store8<!DST_F32>(xdb, row, hlf * 512 + lane * 8, xv[0], xv[1]); }
        nc = nn;
#pragma unroll
        for (int k = 0; k < 4; ++k) { cc[k] = cn[k]; mc[k][0] = mn[k][0]; mc[k][1] = mn[k][1]; }
        xc = xn;
    }
#undef CMB_SLOTS
#undef CMB_DATA
}

constexpr int WQ_WORD0 = 4096;
template <class F> DEV void wq_run(const Params& p, int qidx, int ntasks, char* shm, F&& task) {
    unsigned* ctr = p.bar() + WQ_WORD0 + 64 * qidx;
    volatile int* slot = (volatile int*)(shm + 131072 + 64);
    const int tid = TID();
    int cur = blockIdx.x;
    while (cur < ntasks) {
        unsigned pend = 0u;
        if (tid == 0) pend = atomicAdd(ctr, 1u);
        task(cur);
        __syncthreads();
        if (tid == 0) *slot = (int)gridDim.x + (int)pend;
        __syncthreads();
        cur = *slot;
    }
}

template <int PH> DEV void do_phase(const Params& p, int layer, int is_ctx, int grp, char* shm) {
    const SetDesc sd = make_set(is_ctx, grp);
    if constexpr (PH == -1) phase_prologue(p, shm);
    if constexpr (PH == 0) { if (layer == 0) phase_norm1<false>(p, sd, layer, shm); else phase_norm1<true>(p, sd, layer, shm); }
    if constexpr (PH == 1) phase_proj_a(p, sd, layer, shm);
    const int qbase = ((layer * 3 + (is_ctx ? 0 : grp + 1)) * 13 + (PH < 0 ? 0 : PH)) * 2;
    if constexpr (PH == 2) {
        { const int nt = sd.nsamp * 4 * sd.ntb, G_ = (int)gridDim.x; int t = blockIdx.x;
          if (t < nt) { PrefA f; stepA_issue(f, p, sd, t); for (; t < nt; t += G_) mlstm_stepA_task(p, sd, layer, t, t + G_ < nt ? t + G_ : -1, f, shm); } }
        if (!(is_ctx && layer == 1)) phase_pool(p, sd); }
    if constexpr (PH == 3) {
        for (int t = blockIdx.x; t < sd.nsamp * 32; t += gridDim.x) mlstm_stepB_task(p, sd, t);
        if (!(is_ctx && layer == 1)) {
            const int nq = (is_ctx ? (CTX / 64) : ROWS) / 2;
            wq_run(p, qbase, sd.nsamp * nq * 4, shm, [&](int t) { na_task(p, sd, layer, t / (nq * 4), (t >> 2) % nq, t & 3, shm); });
        }
    }
    if constexpr (PH == 4) { const int nt = sd.nsamp * 4 * sd.ntb, G_ = (int)gridDim.x; int t = blockIdx.x;
        if (t < nt) { PrefC f; stepC_issue(f, p, sd, t); for (; t < nt; t += G_) mlstm_stepC_task(p, sd, layer, t, t + G_ < nt ? t + G_ : -1, f, shm); } }
    if constexpr (PH == 6) phase_merge(p, sd, layer, shm);
    if constexpr (PH == 7) phase_outproj(p, sd, layer, shm);
    if constexpr (PH == 8) { if (layer == 0) phase_postmix<false>(p, sd, layer, shm); else phase_postmix<true>(p, sd, layer, shm); }
    if constexpr (PH == 9) { for (int t = blockIdx.x; t < sd.nsamp * 16; t += gridDim.x) topk_task(p, sd, t, shm); }
    if constexpr (PH == 10) phase_moe_gu(p, sd, layer, shm);
    if constexpr (PH == 11) phase_moe_down(p, sd, layer, shm);
    if constexpr (PH == 12) { if (layer == 0) phase_combine<false>(p, sd, layer, shm); else phase_combine<true>(p, sd, layer, shm); }
}

#ifndef CPU_EMU
template <int PH> __global__ void __launch_bounds__(NTHREADS, 2) k_phase(Params p, int layer, int is_ctx, int grp) {
    DYN_LDS(shm);
    do_phase<PH>(p, layer, is_ctx, grp, shm);
}
#ifndef DBL_MASK
#define DBL_MASK 0
#endif
#define RUNPH(PH) do { do_phase<PH>(p, layer, is_ctx, grp, shm); xcd_barrier(bar); if ((DBL_MASK >> (PH)) & 1) { do_phase<PH>(p, layer, is_ctx, grp, shm); xcd_barrier(bar); } } while (0)
__global__ void __launch_bounds__(NTHREADS, 2) k_mega(Params p) {
    DYN_LDS(shm);
    uint4* xbw = (uint4*)(shm + 131072);
    if (threadIdx.x == 0) *xbw = make_uint4(0u, 0u, 0u, 0u);
    __syncthreads();
    XcdBarrier bar = xcd_barrier_post(p.bar(), (volatile LAS unsigned*)xbw);
    do_phase<-1>(p, 0, 0, 0, shm);
    xcd_barrier(bar);
    for (int layer = 0; layer < 2; ++layer)
        for (int si = 0; si <= NG; ++si) {
            const int is_ctx = si == 0 ? 1 : 0, grp = si == 0 ? 0 : si - 1;
            RUNPH(0); RUNPH(1); RUNPH(2);
            if (is_ctx && layer == 1) { do_phase<3>(p, layer, is_ctx, grp, shm); continue; }
            RUNPH(3); RUNPH(4); RUNPH(6); RUNPH(7); RUNPH(8); RUNPH(9); RUNPH(10); RUNPH(11);
            do_phase<12>(p, layer, is_ctx, grp, shm);
        }
}
#endif
}

static Params make_params(void* const* d_in, void* d_out, void* d_ws) {
    Params p{};
    p.x = (const float*)d_in[0]; p.c = (const float*)d_in[1]; p.ctx = (const float*)d_in[2]; p.c_ctx = (const float*)d_in[3];
    p.norm_gain = (const float*)d_in[4]; p.ada_w = (const float*)d_in[5]; p.ada_b = (const float*)d_in[6]; p.w_in = (const float*)d_in[7];
    p.gate_bias = (const float*)d_in[8]; p.pool_w = (const float*)d_in[9]; p.pool_scale = (const float*)d_in[10]; p.rpb = (const float*)d_in[11];
    p.w_branch = (const float*)d_in[12]; p.w_out = (const float*)d_in[13]; p.router_w = (const float*)d_in[14];
    p.w_gate = (const float*)d_in[15]; p.w_up = (const float*)d_in[16]; p.w_down = (const float*)d_in[17];
    p.out = (float*)d_out; p.ws = (char*)d_ws;
    return p;
}

#ifdef CPU_EMU
int emu_cfg_B = CFG_B, emu_cfg_ROWS = CFG_ROWS, emu_cfg_CTX = CFG_CTX;
const char* g_dumpdir = "data";
static void* g_ws = nullptr;
static void dump_buf(const char* name, int layer, int is_ctx, int grp, const void* ptr, size_t bytes) {
    char nm[512]; snprintf(nm, sizeof nm, "%s/d_L%d_%s%d_%s.bin", g_dumpdir, layer, is_ctx ? "c" : "g", grp, name);
    FILE* f = fopen(nm, "wb"); fwrite(ptr, 1, bytes, f); fclose(f);
}
static void emu_hook(const Params& p, int layer, int is_ctx, int grp, int ph) {
    const size_t Rn = is_ctx ? RC : RL;
    if (ph == 0) dump_buf("H", layer, is_ctx, grp, p.H(), Rn * 1024 * 2);
    if (ph == 1) dump_buf("PROJ", layer, is_ctx, grp, is_ctx ? p.PROJc() : p.PROJa(), Rn * PWA * 2);
    if (ph == 2) dump_buf("Pb", layer, is_ctx, grp, p.Pb(), Rn * 512 * 2);
    if (ph == 3) dump_buf("Nb", layer, is_ctx, grp, p.Nb(), Rn * 512 * 2);
    if (ph == 4) dump_buf("Mb", layer, is_ctx, grp, p.Mb(), Rn * 512 * 2);
    if (ph == 1) dump_buf("BG", layer, is_ctx, grp, p.BG(), Rn * NBG);
    if (ph == 6) dump_buf("MERGED", layer, is_ctx, grp, p.MERGED(), Rn * 1024 * 2);
    if (ph == 7) dump_buf("Y", layer, is_ctx, grp, p.Y(), Rn * 1024 * 2);
    if (ph == 8) { dump_buf("H2", layer, is_ctx, grp, p.H(), Rn * 1024 * 2); dump_buf("aff", layer, is_ctx, grp, p.aff(), Rn * 16 * 4); }
}
void emu_dump(const char* dir) {
    char nm[512]; snprintf(nm, sizeof nm, "%s/d_mod.bin", dir);
    FILE* f = fopen(nm, "wb"); fwrite((char*)g_ws + WSL.mod, 1, (size_t)2 * (NB + 1) * 6144 * 4, f); fclose(f);
    snprintf(nm, sizeof nm, "%s/d_ctxs.bin", dir);
    f = fopen(nm, "wb"); fwrite((char*)g_ws + WSL.ctxs, 1, (size_t)NB * CTX * 1024 * 2, f); fclose(f);
}
template <int PH> static void emu_run_phase(const Params& p, int layer, int is_ctx, int grp, int nblocks) {
    emu_launch_lambda([=]() { do_phase<PH>(p, layer, is_ctx, grp, emu_blk->smem); }, nblocks, NTHREADS, LDS_BYTES);
    if (PH >= 0) emu_hook(p, layer, is_ctx, grp, PH);
    printf("phase %d layer %d ctx %d grp %d done\n", PH, layer, is_ctx, grp); fflush(stdout);
}
#define LAUNCH_PHASE(PH) emu_run_phase<PH>(p, layer, is_ctx, grp, nblocks)
#else
#define LAUNCH_PHASE(PH) hipLaunchKernelGGL((k_phase<PH>), dim3(nblocks), dim3(NTHREADS), LDS_BYTES, stream, p, layer, is_ctx, grp)
#define SETATTR(PH) (void)hipFuncSetAttribute((const void*)k_phase<PH>, hipFuncAttributeMaxDynamicSharedMemorySize, LDS_BYTES)
#endif

extern "C" void kernel_launch(void* const* d_in, const int* in_sizes, int n_in, void* d_out, int out_size, void* d_ws, size_t ws_size, hipStream_t stream) {
    (void)in_sizes; (void)n_in; (void)out_size;
    if (ws_size < WSL.total) return;
    Params p = make_params(d_in, d_out, d_ws);
#ifdef CPU_EMU
    g_ws = d_ws;
    memset(d_ws, 0xFF, WSL.total);
    memset((char*)d_ws + WSL.bar, 0, 65536);
    const int nblocks = 16;
#else
    const int nblocks = 256;
#if MK_ONE_LAUNCH
    static int grid = 0;
    if (!grid) {
        (void)hipFuncSetAttribute((const void*)k_mega, hipFuncAttributeMaxDynamicSharedMemorySize, LDS_BYTES);
        int dev = 0, cus = 0, per_cu = 0;
        (void)hipGetDevice(&dev);
        (void)hipDeviceGetAttribute(&cus, hipDeviceAttributeMultiprocessorCount, dev);
        (void)hipOccupancyMaxActiveBlocksPerMultiprocessor(&per_cu, (const void*)k_mega, NTHREADS, LDS_BYTES);
        if (per_cu > 1) per_cu = 1;
        grid = cus * per_cu;
        if (grid > 256) grid = 256;
    }
    if (grid <= 0) return;
    (void)hipMemsetAsync(p.bar(), 0, 65536, stream);
    hipLaunchKernelGGL(k_mega, dim3(grid), dim3(NTHREADS), LDS_BYTES, stream, p);
    return;
#else
    static bool attr_done = false;
    if (!attr_done) { SETATTR(-1); SETATTR(0); SETATTR(1); SETATTR(2); SETATTR(3); SETATTR(4); SETATTR(5); SETATTR(6); SETATTR(7); SETATTR(8); SETATTR(9); SETATTR(10); SETATTR(11); SETATTR(12); attr_done = true; }
#endif
#endif
    { const int layer = 0, is_ctx = 0, grp = 0; LAUNCH_PHASE(-1); }
    for (int layer = 0; layer < 2; ++layer)
        for (int si = 0; si <= NG; ++si) {
            const int is_ctx = si == 0 ? 1 : 0, grp = si == 0 ? 0 : si - 1;
            LAUNCH_PHASE(0); LAUNCH_PHASE(1); LAUNCH_PHASE(2); LAUNCH_PHASE(3);
            if (is_ctx && layer == 1) continue;
            LAUNCH_PHASE(4); LAUNCH_PHASE(6); LAUNCH_PHASE(7); LAUNCH_PHASE(8); LAUNCH_PHASE(9); LAUNCH_PHASE(10); LAUNCH_PHASE(11); LAUNCH_PHASE(12);
        }
}
```

```cpp
#ifdef CPU_EMU
#include "emu.h"
#define DYN_LDS(p) char* p = emu_blk->smem
#define WAIT_V(n)
#define WAIT_L(n)
#define HIDE(v)
#define CBAR()
#else
#include <hip/hip_runtime.h>
#define DYN_LDS(p) extern __shared__ __attribute__((aligned(16))) char p[]
#define WAIT_V(n) asm volatile("s_waitcnt vmcnt(" #n ")" ::: "memory")
#define WAIT_L(n) asm volatile("s_waitcnt lgkmcnt(" #n ")" ::: "memory")
#define HIDE(v) asm volatile("" : "+v"(v))
#define CBAR() asm volatile("" ::: "memory")
#endif
#include <stdint.h>
#include <stddef.h>

#ifndef CFG_B
#define CFG_B 32
#define CFG_ROWS 32
#define CFG_CTX 256
#define CFG_G 16
#endif
#ifndef MK_ONE_LAUNCH
#define MK_ONE_LAUNCH 1
#endif

#define DEV __device__ __forceinline__
typedef short s16x4 __attribute__((ext_vector_type(4)));
#ifdef CPU_EMU
#define TR16(ptr) emu_tr16((const void*)(ptr))
#else
typedef __attribute__((address_space(3))) s16x4 lds_s16x4;
#define TR16(ptr) __builtin_amdgcn_ds_read_tr16_b64_v4i16((lds_s16x4*)(ptr))
#endif
#ifdef CPU_EMU
#define TID() (threadIdx.x)
#else
#define TID() ({ int t_ = threadIdx.x; asm volatile("" : "+v"(t_)); t_; })
#endif

typedef unsigned short bf16_t;
typedef short bf16x8 __attribute__((ext_vector_type(8)));
typedef float f32x4 __attribute__((ext_vector_type(4)));
typedef unsigned u32x2 __attribute__((ext_vector_type(2)));
typedef unsigned u32x4 __attribute__((ext_vector_type(4)));

namespace {
constexpr int D = 1024, NB = CFG_B, ROWS = CFG_ROWS, SEQ = ROWS * 64, CTX = CFG_CTX, G = CFG_G, NG = NB / G;
constexpr int RL = G * SEQ, RC = NB * CTX, RMAX = RL > RC ? RL : RC;
constexpr int PWA = 3840, NBG = 3072, PWT = PWA + NBG, PWSRC = 6672, C_SPLIT = 3600;
constexpr int C_QM = 0, C_KM = 256, C_PU = 512, C_GM = 1024, C_PADA = 1040, C_F8 = 1280, C_QN = 1280, C_KN = 1792, C_VM = 2304, C_OM = 2816, C_VN = 3328;
constexpr int proj_col(int n) { return n < 512 ? n : n < 1536 ? n + 1792 : n < 1552 ? n - 512 : n < 2064 ? n - 1040 : n < 3088 ? n - 784 : n + 240; }
static_assert(proj_col(512) == C_VM && proj_col(1024) == C_OM && proj_col(1536) == C_GM && proj_col(1552) == C_PU && proj_col(2064) == C_QN && proj_col(2576) == C_KN && proj_col(3088) == C_VN && proj_col(3599) == PWA - 1, "projection column map");
constexpr int NTBL = SEQ / 128, NTBC = CTX / 128;
constexpr int ilog2(int x) { return x <= 1 ? 0 : 1 + ilog2(x >> 1); }
constexpr int LGSEQ = ilog2(SEQ), LGCTX = ilog2(CTX);
static_assert((1 << LGSEQ) == SEQ && (1 << LGCTX) == CTX, "sequence lengths must be powers of two");
constexpr int cdiv(int a, int b) { return (a + b - 1) / b; }
constexpr int RPE_L = cdiv(G * (SEQ / 8), 256) * 256, RPE_C = cdiv(NB * (CTX / 8), 256) * 256, RPE_MAX = RPE_L > RPE_C ? RPE_L : RPE_C;
constexpr int NSLOT = 16 * RPE_MAX;
constexpr int NTHREADS = 512;
constexpr int GT_MAXU = 12;
constexpr int LDS_BYTES = 131072 + 256 + GT_MAXU * 1024;
constexpr int NST_L = G * 4 * 2 * NTBL, NST_C = NB * 4 * 2 * NTBC, NST = NST_L > NST_C ? NST_L : NST_C;
constexpr int NCI = NB * 4 * 2;
constexpr float RMS_EPS = 1e-6f;

struct WsLayout { size_t bar, WinT, WbT, WoT, WguT, WdT, mod, rope, ctxs, xb, PROJc, CiC, Cin_, Cim, H, H8, PROJa, Sst, Cin, Mb, Pb, Nb, Sn, Ssc, Cn, Cm, aff, slot_token, slot_gate, token_slots, HID, YE, BG, MERGED, Y, total; };
constexpr size_t al(size_t x) { return (x + 255) / 256 * 256; }
constexpr size_t smax(size_t a, size_t b) { return a > b ? a : b; }
constexpr WsLayout make_layout() {
    WsLayout L{}; size_t o = 0;
    L.bar = o; o += al(65536);
    L.WinT = o; o += al((size_t)2 * PWT * 1024 * 2);
    L.WbT = o; o += al((size_t)2 * 3 * 1024 * 512 * 2);
    L.WoT = o; o += al((size_t)2 * 1024 * 1024 * 2);
    L.WguT = o; o += al((size_t)2 * 16 * 2048 * 1024);
    L.WdT = o; o += al((size_t)2 * 16 * 1024 * 1024);
    L.mod = o; o += al((size_t)2 * (NB + 1) * 6144 * 4);
    L.rope = o; o += al((size_t)(ROWS + 64) * 16 * 2 * 4);
    L.ctxs = o; o += al((size_t)NB * CTX * 1024 * 2);
    L.xb = o; o += al((size_t)NB * SEQ * 1024 * 2);
    L.PROJc = o; o += al((size_t)RC * PWA * 2);
    L.CiC = o; o += al((size_t)NCI * 8192 * 4);
    L.Cin_ = o; o += al((size_t)NCI * 64 * 4);
    L.Cim = o; o += al((size_t)NCI * 4 * 4);
    L.H = o; o += al((size_t)RMAX * 1024 * 2);
    L.H8 = o; o += al((size_t)RMAX * 1024);
    const size_t x0 = o;
    L.PROJa = o; o += al((size_t)RMAX * PWA * 2);
    L.Sst = o; o += al((size_t)NST * 8192 * 4);
    L.Cin = o; o += al((size_t)NST * 8192 * 2);
    const size_t hid = al((size_t)NSLOT * 1024 * 2);
    o = x0 + smax(o - x0, 2 * hid);
    L.HID = x0; L.YE = x0 + hid;
    L.Mb = o; o += al((size_t)RMAX * 512 * 2);
    L.Pb = o; o += al((size_t)RMAX * 512 * 2);
    L.Nb = o; o += al((size_t)RMAX * 512 * 2);
    L.MERGED = L.H; L.Y = L.Mb;
    L.BG = o; o += al((size_t)RMAX * NBG);
    L.Sn = o; o += al((size_t)NST * 64 * 4);
    L.Ssc = o; o += al((size_t)NST * 4 * 4);
    L.Cn = o; o += al((size_t)NST * 64 * 4);
    L.Cm = o; o += al((size_t)NST * 4 * 4);
    L.aff = o; o += al((size_t)RMAX * 16 * 4);
    L.slot_token = o; o += al((size_t)NSLOT * 4);
    L.slot_gate = o; o += al((size_t)NSLOT * 4);
    L.token_slots = o; o += al((size_t)RMAX * 16 * 4);
    L.total = o;
    return L;
}
constexpr WsLayout WSL = make_layout();
static_assert(CFG_B != 32 || WSL.total <= ((size_t)1 << 30), "workspace budget");

struct Params {
    const float *x, *c, *ctx, *c_ctx, *norm_gain, *ada_w, *ada_b, *w_in, *gate_bias, *pool_w, *pool_scale, *rpb, *w_branch, *w_out, *router_w, *w_gate, *w_up, *w_down;
    float* out;
    char* ws;
#ifdef CPU_EMU
#define WSF(T, name) __device__ __host__ __forceinline__ T* name() const { return (T*)(ws + WSL.name); }
#else
#if defined(__HIP_DEVICE_COMPILE__)
#define WSF(T, name) __device__ __host__ __forceinline__ T* name() const { char* w_ = ws; asm volatile("" : "+s"(w_)); return (T*)(__attribute__((address_space(1))) T*)(w_ + WSL.name); }
#else
#define WSF(T, name) __device__ __host__ __forceinline__ T* name() const { return (T*)(ws + WSL.name); }
#endif
#endif
    WSF(unsigned, bar) WSF(bf16_t, WinT) WSF(bf16_t, WbT) WSF(bf16_t, WoT) WSF(bf16_t, WguT) WSF(bf16_t, WdT)
    WSF(float, mod) WSF(float, rope) WSF(bf16_t, ctxs) WSF(bf16_t, xb) WSF(bf16_t, PROJc) WSF(float, CiC) WSF(float, Cin_) WSF(float, Cim)
    WSF(bf16_t, H) WSF(unsigned char, H8) WSF(bf16_t, PROJa) WSF(float, Sst) WSF(bf16_t, Cin) WSF(bf16_t, Mb) WSF(bf16_t, Pb) WSF(bf16_t, Nb)
    WSF(float, Sn) WSF(float, Ssc) WSF(float, Cn) WSF(float, Cm) WSF(float, aff) WSF(int, slot_token) WSF(float, slot_gate) WSF(int, token_slots)
    WSF(bf16_t, HID) WSF(bf16_t, YE) WSF(unsigned char, BG) WSF(bf16_t, MERGED) WSF(bf16_t, Y)
#undef WSF
};

struct SetDesc { int is_ctx, nrows, samp0, nsamp, lgseq, ntb, cap, rpe; };
DEV SetDesc make_set(int is_ctx, int grp) {
    SetDesc s;
    s.is_ctx = is_ctx;
    if (is_ctx) { s.nrows = RC; s.samp0 = 0; s.nsamp = NB; s.lgseq = LGCTX; s.ntb = NTBC; s.cap = CTX / 8; s.rpe = RPE_C; }
    else { s.nrows = RL; s.samp0 = grp * G; s.nsamp = G; s.lgseq = LGSEQ; s.ntb = NTBL; s.cap = SEQ / 8; s.rpe = RPE_L; }
    return s;
}

#ifdef CPU_EMU
#define GAS
#else
#define GAS __attribute__((address_space(1)))
#endif
template <class T> DEV T ldg(const T* p) { return *(const GAS T*)p; }
template <class T> DEV void stg(T* p, const T& v) { *(GAS T*)p = v; }
DEV float bf2f(bf16_t v) { return __uint_as_float(((unsigned)v) << 16); }
DEV bf16_t f2bf(float f) { unsigned u = __float_as_uint(f); u += 0x7FFFu + ((u >> 16) & 1u); return (bf16_t)(u >> 16); }
#if defined(__HIP_DEVICE_COMPILE__)
typedef __bf16 bf16n2 __attribute__((ext_vector_type(2)));
typedef float f32n2 __attribute__((ext_vector_type(2)));
DEV unsigned pack2(float lo, float hi) { f32n2 v = {lo, hi}; bf16n2 r = __builtin_convertvector(v, bf16n2); return __builtin_bit_cast(unsigned, r); }
#else
DEV unsigned pack2(float lo, float hi) { return (unsigned)f2bf(lo) | ((unsigned)f2bf(hi) << 16); }
#endif
DEV float lo16(unsigned u) { return __uint_as_float(u << 16); }
DEV float hi16(unsigned u) { return __uint_as_float(u & 0xFFFF0000u); }
#if defined(__HIP_DEVICE_COMPILE__)
DEV float frcp(float x) { return __builtin_amdgcn_rcpf(x); }
#else
DEV float frcp(float x) { return 1.0f / x; }
#endif
#if defined(__HIP_DEVICE_COMPILE__)
DEV float sigmoidf_(float x) { return __builtin_amdgcn_rcpf(1.0f + __expf(-x)); }
#else
DEV float sigmoidf_(float x) { return 1.0f / (1.0f + __expf(-x)); }
#endif
DEV float logsigmoidf_(float x) { return fminf(x, 0.0f) - __logf(1.0f + __expf(-fabsf(x))); }
template <int M> DEV float shx(float v) {
#if defined(__HIP_DEVICE_COMPILE__)
    const unsigned u = __builtin_bit_cast(unsigned, v);
    if constexpr (M == 1) return __builtin_bit_cast(float, __builtin_amdgcn_update_dpp(u, u, 0xB1, 0xF, 0xF, false));
    else if constexpr (M == 2) return __builtin_bit_cast(float, __builtin_amdgcn_update_dpp(u, u, 0x4E, 0xF, 0xF, false));
    else if constexpr (M == 4) { const unsigned t = __builtin_amdgcn_update_dpp(u, u, 0x141, 0xF, 0xF, false);
        return __builtin_bit_cast(float, __builtin_amdgcn_update_dpp(t, t, 0x1B, 0xF, 0xF, false)); }
    else if constexpr (M == 8) return __builtin_bit_cast(float, __builtin_amdgcn_update_dpp(u, u, 0x128, 0xF, 0xF, false));
    else if constexpr (M == 16) { const auto r = __builtin_amdgcn_permlane16_swap(u, u, false, false); return __builtin_bit_cast(float, (threadIdx.x & 16) ? r[0] : r[1]); }
    else { const auto r = __builtin_amdgcn_permlane32_swap(u, u, false, false); return __builtin_bit_cast(float, (threadIdx.x & 32) ? r[0] : r[1]); }
#else
    return __shfl_xor(v, M);
#endif
}
DEV float wave_sum(float v) { v += shx<32>(v); v += shx<16>(v); v += shx<8>(v); v += shx<4>(v); v += shx<2>(v); v += shx<1>(v); return v; }
DEV bf16x8 mk8(u32x2 lo, u32x2 hi) { u32x4 v = {lo.x, lo.y, hi.x, hi.y}; return __builtin_bit_cast(bf16x8, v); }
DEV bf16x8 mk8(u32x4 v) { return __builtin_bit_cast(bf16x8, v); }
DEV bf16x8 mk8(s16x4 lo, s16x4 hi) { return __builtin_shufflevector(lo, hi, 0, 1, 2, 3, 4, 5, 6, 7); }
DEV f32x4 mfma16(bf16x8 a, bf16x8 b, f32x4 c) { return __builtin_amdgcn_mfma_f32_16x16x32_bf16(a, b, c, 0, 0, 0); }
DEV unsigned f8enc1(float x) {
    const unsigned sgn = x < 0.f ? 0x80u : 0u; float a = x < 0.f ? -x : x; if (!(a < 448.f)) a = 448.f;
    if (a < 0.015625f) { const int q = (int)(a * 512.f + 0.5f); const float r = a * 512.f; int qq = q; if ((float)q - r == 0.5f && (q & 1)) qq = q - 1; return sgn | (unsigned)qq; }
    int e = 0; float m = a; while (m >= 2.f) { m *= 0.5f; ++e; } while (m < 1.f) { m *= 2.f; --e; }
    const float r = (m - 1.f) * 8.f; int q = (int)(r + 0.5f); if ((float)q - r == 0.5f && (q & 1)) --q;
    if (q == 8) { q = 0; ++e; }
    return sgn | (unsigned)((e + 7) << 3) | (unsigned)q;
}
#if defined(__HIP_DEVICE_COMPILE__)
DEV unsigned f8pack4(float a, float b, float c, float d) {
    a = __builtin_amdgcn_fmed3f(a, -448.f, 448.f); b = __builtin_amdgcn_fmed3f(b, -448.f, 448.f); c = __builtin_amdgcn_fmed3f(c, -448.f, 448.f); d = __builtin_amdgcn_fmed3f(d, -448.f, 448.f);
    int w = 0; w = __builtin_amdgcn_cvt_pk_fp8_f32(a, b, w, false); w = __builtin_amdgcn_cvt_pk_fp8_f32(c, d, w, true); return (unsigned)w; }
#else
DEV unsigned f8pack4(float a, float b, float c, float d) { return f8enc1(a) | (f8enc1(b) << 8) | (f8enc1(c) << 16) | (f8enc1(d) << 24); }
#endif
DEV float f8dec1(unsigned v) {
    const unsigned e = (v >> 3) & 15u, m = v & 7u; float r = e == 0 ? (float)m * (1.0f / 512.0f) : __uint_as_float(((e + 120u) << 23) | (m << 20));
    return (v & 0x80u) ? -r : r;
}
#if defined(__HIP_DEVICE_COMPILE__)
DEV f32x4 f8x4_f32(unsigned w) { const auto lo = __builtin_amdgcn_cvt_pk_f32_fp8((int)w, false), hi = __builtin_amdgcn_cvt_pk_f32_fp8((int)w, true); return (f32x4){lo[0], lo[1], hi[0], hi[1]}; }
#else
DEV f32x4 f8x4_f32(unsigned w) { return (f32x4){f8dec1(w & 255u), f8dec1((w >> 8) & 255u), f8dec1((w >> 16) & 255u), f8dec1(w >> 24)}; }
#endif
constexpr float YE_SCALE = 32.0f, YE_INV = 1.0f / 32.0f;
#ifdef CPU_EMU
DEV f32x4 mfma_f8(bf16x8 a0, bf16x8 a1, bf16x8 b0, bf16x8 b1, f32x4 c) { return emu_mfma_f8(a0, a1, b0, b1, c); }
#else
typedef int i32x4 __attribute__((ext_vector_type(4)));
typedef int i32x8 __attribute__((ext_vector_type(8)));
DEV f32x4 mfma_f8(bf16x8 a0, bf16x8 a1, bf16x8 b0, bf16x8 b1, f32x4 c) {
    const i32x8 A = __builtin_shufflevector(__builtin_bit_cast(i32x4, a0), __builtin_bit_cast(i32x4, a1), 0, 1, 2, 3, 4, 5, 6, 7);
    const i32x8 B = __builtin_shufflevector(__builtin_bit_cast(i32x4, b0), __builtin_bit_cast(i32x4, b1), 0, 1, 2, 3, 4, 5, 6, 7);
    return __builtin_amdgcn_mfma_scale_f32_16x16x128_f8f6f4(A, B, c, 0, 0, 0, 0, 0, 0);
}
#endif
constexpr float F8_WSCALE = 64.0f, F8_WINV = 1.0f / 64.0f;
DEV void store8bf(bf16_t* o, f32x4 a, f32x4 b) { u32x4 v = {pack2(a[0], a[1]), pack2(a[2], a[3]), pack2(b[0], b[1]), pack2(b[2], b[3])}; stg((u32x4*)o, v); }

#ifndef CPU_EMU
#define XB_TMO      128
#define XB_XCNT(j)  (256  + 64 * (j))
#define XB_XSUB(j)  (1280 + 64 * (j))
#define XB_XGEN(j)  (2304 + 64 * (j))
#define XB_TOP      3328
#define XB_TOPGEN   3392
#define XCD_BAR_WORDS 3456
#define XB_SPIN_CAP (1u << 18)
#define LAS __attribute__((address_space(3)))
__device__ __forceinline__ unsigned xb_ld(unsigned* p)              { return __hip_atomic_load(p, __ATOMIC_RELAXED, __HIP_MEMORY_SCOPE_AGENT); }
__device__ __forceinline__ unsigned xb_add(unsigned* p, unsigned v) { return __hip_atomic_fetch_add(p, v, __ATOMIC_RELAXED, __HIP_MEMORY_SCOPE_AGENT); }
__device__ __forceinline__ unsigned xb_xcc_id() { return (unsigned)__builtin_amdgcn_s_getreg((3 << 11) | 20) & 0xFu; }
#define XB_SPIN(cond, bar) do { unsigned _sp = 0; while (cond) { __builtin_amdgcn_s_sleep(1); \
    if ((++_sp & 255u) == 0u) { if (xb_ld(&(bar)[XB_TMO])) break; if (_sp > XB_SPIN_CAP) { atomicAdd(&(bar)[XB_TMO], 1u); break; } } } } while (0)
struct XcdBarrier { unsigned* bar; unsigned x; volatile LAS unsigned* st; };
__device__ __forceinline__ XcdBarrier xcd_barrier_post(unsigned* bar, volatile LAS unsigned* st) {
    XcdBarrier b; b.bar = bar; b.x = xb_xcc_id(); b.st = st;
    if (threadIdx.x == 0) (void)xb_add(&bar[XB_XCNT(b.x)], 1u);
    return b;
}
__device__ __forceinline__ void xcd_barrier_complete(unsigned* bar, unsigned x, unsigned& nloc, unsigned& nx) {
    const unsigned Gd = gridDim.x * gridDim.y * gridDim.z;
    unsigned sum, cnt, mine, sp = 0u;
    for (;;) {
        sum = 0u; cnt = 0u; mine = 0u;
#pragma unroll
        for (unsigned j = 0; j < 16; ++j) { const unsigned c = xb_ld(&bar[XB_XCNT(j)]); sum += c; cnt += (c > 0u) ? 1u : 0u; mine = (j == x) ? c : mine; }
        if (sum == Gd) break;
        __builtin_amdgcn_s_sleep(1);
        if ((++sp & 255u) == 0u) { if (xb_ld(&bar[XB_TMO])) break; if (sp > XB_SPIN_CAP) { atomicAdd(&bar[XB_TMO], 1u); break; } }
    }
    nloc = mine > 0u ? mine : 1u; nx = cnt > 0u ? cnt : 1u;
}
__device__ __forceinline__ void xcd_barrier(const XcdBarrier& b) {
    asm volatile("s_waitcnt vmcnt(0)" ::: "memory");
    __syncthreads();
    if (threadIdx.x == 0) {
        unsigned* bar = b.bar;
        unsigned bx = b.x; asm volatile("" : "+s"(bx));
        __builtin_amdgcn_s_waitcnt(0);
        unsigned nloc = b.st[0], nx = b.st[1];
        if (nloc == 0u) { xcd_barrier_complete(bar, bx, nloc, nx); b.st[0] = nloc; b.st[1] = nx; }
        const unsigned old = xb_add(&bar[XB_XSUB(bx)], 1u);
        const unsigned gen = old / nloc;
        if (old + 1u == (gen + 1u) * nloc) {
            __builtin_amdgcn_fence(__ATOMIC_RELEASE, "agent");
            asm volatile("s_waitcnt vmcnt(0)" ::: "memory");
            const unsigned og = xb_add(&bar[XB_TOP], 1u);
            const unsigned tg = og / nx;
            if (og + 1u == (tg + 1u) * nx) xb_add(&bar[XB_TOPGEN], 1u);
            else XB_SPIN(xb_ld(&bar[XB_TOPGEN]) == tg, bar);
            __builtin_amdgcn_fence(__ATOMIC_ACQUIRE, "agent");
            xb_add(&bar[XB_XGEN(bx)], 1u);
            asm volatile("s_waitcnt vmcnt(0)" ::: "memory");
        } else {
            XB_SPIN(xb_ld(&bar[XB_XGEN(bx)]) == gen, bar);
            __builtin_amdgcn_fence(__ATOMIC_ACQUIRE, "agent");
            asm volatile("s_waitcnt vmcnt(0)" ::: "memory");
        }
    }
    __syncthreads();
}
#endif

constexpr int BK = 64, HALF = 128, HT_BYTES = HALF * BK * 2;
DEV int lds_byte(int r, int c) { int st = (r >> 4) * 2 + (c >> 5), rr = r & 15, cc = c & 31, ob = rr * 64 + cc * 2; return st * 1024 + (ob ^ (((ob >> 9) & 1) << 5)); }
DEV void stage_rc(int b, int& Rr, int& Cc) { int st = b / 1024, sb = b % 1024, swz = sb ^ (((sb >> 9) & 1) << 5); Rr = (st >> 1) * 16 + swz / 64; Cc = (st & 1) * 32 + (swz % 64) / 2; }
DEV int perm32(int rho) { const int n = rho >> 4, i = rho & 15; return 8 * (i >> 2) + 4 * n + (i & 3); }

DEV bool tile_from_L(int L, int nM, int nN, int& pm, int& pn) {
    const int nwg = nM * nN; if (L >= nwg) return false;
    int wgid = L; { const int q = nwg / 8, r = nwg % 8, xcd = wgid % 8, off = wgid / 8; wgid = (xcd < r ? xcd * (q + 1) : r * (q + 1) + (xcd - r) * q) + off; }
    const int nig = 8 * nN, gid = wgid / nig, fm = gid * 8, gsz = (nM - fm) < 8 ? (nM - fm) : 8;
    pm = fm + ((wgid % nig) % gsz); pn = (wgid % nig) / gsz; return true;
}
DEV bool tile_order(int i, int nM, int nN, int& pm, int& pn) { return tile_from_L(i * (int)gridDim.x + (int)blockIdx.x, nM, nN, pm, pn); }
#ifdef CPU_EMU
#define GLDS16(src, dst) __builtin_amdgcn_global_load_lds((const unsigned*)(src), (unsigned*)((dst) + (TID() & 63) * 16), 16, 0, 0)
#else
#define GLDS16(src, dst) __builtin_amdgcn_global_load_lds((const unsigned*)(src), (unsigned*)(dst), 16, 0, 0)
#endif

#define BAR __builtin_amdgcn_s_barrier()
#define SCHED __builtin_amdgcn_sched_barrier(0)
struct GUnit { int pm, pn, aux; };
template <class T> struct is_void_ { static constexpr bool v = false; };
template <> struct is_void_<void> { static constexpr bool v = true; };
template <class Epi> DEV bool call_epi(const Epi& e, const GUnit& u, f32x4 (&acc)[2][2][4][2], int r0, int c0) {
    if constexpr (is_void_<decltype(e(u, acc, r0, c0))>::v) { e(u, acc, r0, c0); return false; } else return e(u, acc, r0, c0);
}
template <bool GATHER, int LDA_, int LDB_, int K_, bool F8 = false, class Sched, class Epi>
DEV void gemm_stream(char* shm, const Sched& S, const Epi& epi) {
#define SA(b, h) (shm + ((b) * 2 + (h)) * HT_BYTES)
#define SB(b, h) (shm + (4 + (b) * 2 + (h)) * HT_BYTES)
#define STG_B(P, bp) do { GLDS16((bp) + voffB, (P) + ldsb0); GLDS16((bp) + voffB + 64 * LDB_, (P) + ldsb0 + 8192); } while (0)
#define STG_A(P, ap, h, gv) do { if (GATHER) { GLDS16((ap) + gv[h][0], (P) + ldsb0); GLDS16((ap) + gv[h][1], (P) + ldsb0 + 8192); } \
    else { GLDS16((ap) + voffA + (h) * 128 * LDA_, (P) + ldsb0); GLDS16((ap) + voffA + ((h) * 128 + 64) * LDA_, (P) + ldsb0 + 8192); } } while (0)
#define LDA(dst, b, h) _Pragma("unroll") for (int m = 0; m < 4; ++m) _Pragma("unroll") for (int k = 0; k < 2; ++k) \
    dst[m][k] = *reinterpret_cast<const bf16x8*>(SA(b, h) + aoff + m * 2048 + k * 1024)
#define LDB(dst, b, h) _Pragma("unroll") for (int n = 0; n < 2; ++n) _Pragma("unroll") for (int k = 0; k < 2; ++k) \
    dst[n][k] = *reinterpret_cast<const bf16x8*>(SB(b, h) + boff + n * 2048 + k * 1024)
#define MMA(ai, bj, At_, Bx_) do { __builtin_amdgcn_s_setprio(1); \
    if constexpr (F8) { _Pragma("unroll") for (int m = 0; m < 4; ++m) _Pragma("unroll") for (int n = 0; n < 2; ++n) \
      acc[ai][bj][m][n] = mfma_f8(Bx_[n][0], Bx_[n][1], At_[m][0], At_[m][1], acc[ai][bj][m][n]); } \
    else { _Pragma("unroll") for (int m = 0; m < 4; ++m) _Pragma("unroll") for (int n = 0; n < 2; ++n) _Pragma("unroll") for (int k = 0; k < 2; ++k) \
      acc[ai][bj][m][n] = mfma16(Bx_[n][k], At_[m][k], acc[ai][bj][m][n]); } \
    __builtin_amdgcn_s_setprio(0); } while (0)
    constexpr int nt = K_ / BK;
    const int tid = TID();
    const int wid = __builtin_amdgcn_readfirstlane(tid >> 6), lane = tid & 63, wr = wid >> 2, wc = wid & 3, fr = lane & 15, fq = lane >> 4;
    const int ldsb0 = wid * 1024;
    int Rr0, Cc0; stage_rc(tid * 16, Rr0, Cc0);
    const int voffA = Rr0 * LDA_ + Cc0;
    const int voffB = ((Rr0 & ~31) + perm32(Rr0 & 31)) * LDB_ + Cc0;
    const int aoff = lds_byte(wr * 64 + fr, fq * 8), boff = lds_byte(wc * 32 + fr, fq * 8);
    GUnit cur, nxt; int ui = 0;
    if (!S.next(0, cur)) return;
    int gc[2][2] = {{0, 0}, {0, 0}};
    int* gtab = (int*)(shm + 131072 + 256);
    if (GATHER) {
        __syncthreads();
        { GUnit u; for (int i = 0; i < GT_MAXU && S.next(i, u); ++i) { if (tid < 256) gtab[i * 256 + tid] = S.grow(u, tid) * LDA_; } }
        __syncthreads();
#pragma unroll
        for (int h = 0; h < 2; ++h)
#pragma unroll
            for (int i = 0; i < 2; ++i) gc[h][i] = gtab[h * 128 + i * 64 + Rr0] + Cc0;
    }
    f32x4 acc[2][2][4][2];
#pragma unroll
    for (int a = 0; a < 2; ++a)
#pragma unroll
        for (int b = 0; b < 2; ++b)
#pragma unroll
            for (int m = 0; m < 4; ++m)
#pragma unroll
                for (int n = 0; n < 2; ++n) acc[a][b][m][n] = (f32x4){0.f, 0.f, 0.f, 0.f};
    bf16x8 At[4][2], B0[2][2], B1[2][2];
    const bf16_t* cA = S.a_base(cur); const bf16_t* cB = S.b_base(cur);
    STG_B(SB(0, 0), cB); STG_A(SA(0, 0), cA, 0, gc); STG_B(SB(0, 1), cB + 128 * LDB_); STG_A(SA(0, 1), cA, 1, gc);
    if (wr == 1) BAR;
    WAIT_V(4); BAR;
    STG_B(SB(1, 0), cB + BK); STG_A(SA(1, 0), cA + BK, 0, gc); STG_B(SB(1, 1), cB + 128 * LDB_ + BK);
    WAIT_V(6); BAR;
    for (;;) {
        const bool has_next = S.next(ui + 1, nxt);
        const bf16_t* nA = has_next ? S.a_base(nxt) : cA; const bf16_t* nB = has_next ? S.b_base(nxt) : cB;
#pragma unroll 1
        for (int t = 0; t < nt; t += 2) {
            const bool last = (t == nt - 2);
            const bf16_t* a1 = cA + (t + 1) * BK;
            const bf16_t* a2 = last ? nA : cA + (t + 2) * BK; const bf16_t* b2 = last ? nB : cB + (t + 2) * BK;
            const bf16_t* a3 = a2 + BK; const bf16_t* b3 = b2 + BK;
            LDB(B0, 0, 0); SCHED; LDA(At, 0, 0); STG_A(SA(1, 1), a1, 1, gc);
            if (GATHER && last && has_next) {
#pragma unroll
                for (int h = 0; h < 2; ++h)
#pragma unroll
                    for (int i = 0; i < 2; ++i) gc[h][i] = gtab[(ui + 1) * 256 + h * 128 + i * 64 + Rr0] + Cc0; }
            WAIT_L(8); BAR; WAIT_L(0); MMA(0, 0, At, B0); BAR; SCHED;
            LDB(B1, 0, 1); STG_B(SB(0, 0), b2);
            BAR; WAIT_L(0); MMA(0, 1, At, B1); BAR;
            LDA(At, 0, 1); STG_A(SA(0, 0), a2, 0, gc);
            BAR; WAIT_L(0); MMA(1, 0, At, B0); BAR; SCHED;
            STG_B(SB(0, 1), b2 + 128 * LDB_);
            WAIT_V(6); BAR; MMA(1, 1, At, B1); BAR;
            LDB(B0, 1, 0); SCHED; LDA(At, 1, 0); STG_A(SA(0, 1), a2, 1, gc);
            WAIT_L(8); BAR; WAIT_L(0); MMA(0, 0, At, B0); BAR; SCHED;
            LDB(B1, 1, 1); STG_B(SB(1, 0), b3);
            BAR; WAIT_L(0); MMA(0, 1, At, B1); BAR;
            LDA(At, 1, 1); STG_A(SA(1, 0), a3, 0, gc);
            BAR; WAIT_L(0); MMA(1, 0, At, B0); BAR; SCHED;
            STG_B(SB(1, 1), b3 + 128 * LDB_);
            WAIT_V(6); BAR; MMA(1, 1, At, B1); BAR;
        }
        bool keep = false;
        {
            const int tz = TID(); const int wz = tz >> 6, lz = tz & 63, wrz = wz >> 2, wcz = wz & 3, frz = lz & 15, fqz = lz >> 4;
            keep = call_epi(epi, cur, acc, wrz * 64 + frz, wcz * 32 + 8 * fqz);
        }
        if (!has_next) break;
        if (!keep) {
#pragma unroll
            for (int a = 0; a < 2; ++a)
#pragma unroll
                for (int b = 0; b < 2; ++b)
#pragma unroll
                    for (int m = 0; m < 4; ++m)
#pragma unroll
                        for (int n = 0; n < 2; ++n) acc[a][b][m][n] = (f32x4){0.f, 0.f, 0.f, 0.f};
        }
        cur = nxt; cA = nA; cB = nB; ++ui;
    }
    WAIT_V(0);
    if (wr == 0) BAR;
    BAR;
#undef SA
#undef SB
#undef STG_A
#undef STG_B
#undef LDA
#undef LDB
#undef MMA
}

constexpr int J_IN = 16 * 27, J_WB = 2 * 8 * 4, J_WO = 16 * 4, J_GU = 16 * 2 * 64, J_DN = 16 * 64, J_FOLD = 8 * 16, J_PAD = 1;
constexpr int N_MODJOBS = 2 * 96;

constexpr int J_BIG = J_IN + J_WB + J_WO + J_GU + J_DN;
struct WJob { const float* src; bf16_t* dst; int ldsrc, lddst, nvalid, k0, n0, mode, gu_which, f8; };
DEV WJob wjob_decode(const Params& p, int l, int j) {
    WJob w; w.ldsrc = 1024; w.lddst = 1024; w.nvalid = 256; w.mode = 0; w.gu_which = 0; w.f8 = 0;
    if (j < J_IN) { const int kt = j / 27, nb = j % 27; w.k0 = kt * 64; w.n0 = nb * 256; w.src = p.w_in + (size_t)l * 1024 * PWSRC; w.ldsrc = PWSRC; w.nvalid = PWSRC - w.n0; w.dst = p.WinT() + (size_t)l * PWT * 1024; w.mode = 3; }
    else if ((j -= J_IN) < J_WB) { const int bi = (j / 32) * 2, jj = j % 32, kt = jj / 4, nb = jj % 4; w.k0 = kt * 64; w.n0 = nb * 256;
        w.src = p.w_branch + ((size_t)l * 3 + bi) * 512 * 1024; w.dst = p.WbT() + ((size_t)l * 3 + bi) * 1024 * 512; w.lddst = 512; }
    else if ((j -= J_WB) < J_WO) { const int kt = j / 4, nb = j % 4; w.k0 = kt * 64; w.n0 = nb * 256; w.src = p.w_out + (size_t)l * 1024 * 1024; w.dst = p.WoT() + (size_t)l * 1024 * 1024; }
    else if ((j -= J_WO) < J_GU) { const int e = j / 128, jj = j % 128; w.gu_which = jj / 64; const int j3 = jj % 64, kt = j3 / 4, nb = j3 % 4; w.k0 = kt * 64; w.n0 = nb * 256;
        w.src = (w.gu_which ? p.w_up : p.w_gate) + ((size_t)l * 16 + e) * 1024 * 1024; w.dst = p.WguT() + ((size_t)l * 16 + e) * 2048 * 512; w.mode = 1; w.f8 = 1; }
    else { j -= J_GU; const int e = j / 64, jj = j % 64, kt = jj / 4, nb = jj % 4; w.k0 = kt * 64; w.n0 = nb * 256;
        w.src = p.w_down + ((size_t)l * 16 + e) * 1024 * 1024; w.dst = p.WdT() + ((size_t)l * 16 + e) * 1024 * 512; w.f8 = 1; }
    return w;
}
constexpr int WT_LD = 260;
DEV void wjob_load(const WJob& w, int tid, f32x4 (&vv)[8]) {
#pragma unroll
    for (int i = 0; i < 8; ++i) { const int idx = i * 512 + tid, r = idx >> 6, c = (idx & 63) * 4; int col = w.n0 + c; col = col > w.ldsrc - 4 ? w.ldsrc - 4 : col;
        vv[i] = ldg((const f32x4*)(w.src + (size_t)(w.k0 + r) * w.ldsrc + col)); }
}
DEV void wjob_finish(const WJob& w, int tid, const f32x4 (&vv)[8], float* tile) {
    __syncthreads();
#pragma unroll
    for (int i = 0; i < 8; ++i) { const int idx = i * 512 + tid, r = idx >> 6, c = (idx & 63) * 4; *(f32x4*)(tile + r * 256 + (c ^ (((r >> 3) & 7) << 2))) = vv[i]; }
    __syncthreads();
#pragma unroll
    for (int q = 0; q < 4; ++q) {
        const int item = q * 512 + tid, nrow = item >> 3, kc = (item & 7) * 8;
        float v[8];
#pragma unroll
        for (int jj = 0; jj < 8; ++jj) v[jj] = tile[(kc + jj) * 256 + (nrow ^ ((item & 7) << 2))];
        const int n = w.n0 + nrow;
        int drow = n; bool f8 = w.f8 != 0; size_t f8base = 0;
        if (w.mode == 1) drow = (n >> 7) * 256 + w.gu_which * 128 + (n & 127);
        if (w.mode == 3) {
            if (n >= C_SPLIT) { f8 = true; f8base = (size_t)PWA * 2048; drow = n - C_SPLIT; }
            else { drow = proj_col(n); if (drow >= C_F8) { f8 = true; f8base = (size_t)C_F8 * 2048; drow -= C_F8; } } }
        if (f8) { const u32x2 o = {f8pack4(v[0] * F8_WSCALE, v[1] * F8_WSCALE, v[2] * F8_WSCALE, v[3] * F8_WSCALE), f8pack4(v[4] * F8_WSCALE, v[5] * F8_WSCALE, v[6] * F8_WSCALE, v[7] * F8_WSCALE)};
            if (nrow < w.nvalid) stg((u32x2*)((unsigned char*)w.dst + f8base + (size_t)drow * 1024 + w.k0 + kc), o); }
        else if (nrow < w.nvalid) { u32x4 o = {pack2(v[0], v[1]), pack2(v[2], v[3]), pack2(v[4], v[5]), pack2(v[6], v[7])};
            stg((u32x4*)(w.dst + (size_t)drow * w.lddst + w.k0 + kc), o); }
    }
}
DEV void pro_small_job(const Params& p, int l, int j, char* shm) {
    float* tile = (float*)shm;
    const int tid = TID();
    if (j < J_FOLD) {
        const int kt = j / 16, ntl = j % 16, k0 = kt * 64, n0 = ntl * 64; const int fg = k0 / 128;
        const float* wb1 = p.w_branch + ((size_t)l * 3 + 1) * 512 * 1024;
        const float* pw = p.pool_w + ((size_t)l * 4 + fg) * 128 * 128; const float* ps = p.pool_scale + (size_t)l * 512 + fg * 128;
        const int c = tid & 63, rq = tid >> 6;
        float accv[8];
#pragma unroll
        for (int i = 0; i < 8; ++i) accv[i] = 0.f;
        for (int d = 0; d < 128; ++d) { const float wv = ldg(wb1 + (size_t)(fg * 128 + d) * 1024 + n0 + c) * ldg(ps + d);
#pragma unroll
            for (int i = 0; i < 8; ++i) accv[i] += ldg(pw + (size_t)(k0 - fg * 128 + rq * 8 + i) * 128 + d) * wv; }
        __syncthreads();
#pragma unroll
        for (int i = 0; i < 8; ++i) tile[(rq * 8 + i) * WT_LD + c] = accv[i];
        __syncthreads();
        const int nrow = tid >> 3, kc = (tid & 7) * 8; float v[8];
#pragma unroll
        for (int jj = 0; jj < 8; ++jj) v[jj] = tile[(kc + jj) * WT_LD + nrow];
        u32x4 o = {pack2(v[0], v[1]), pack2(v[2], v[3]), pack2(v[4], v[5]), pack2(v[6], v[7])};
        stg((u32x4*)(p.WbT() + ((size_t)l * 3 + 1) * 1024 * 512 + (size_t)(n0 + nrow) * 512 + k0 + kc), o);
    } else {
        bf16_t* d0 = p.WinT() + (size_t)l * PWT * 1024 + (size_t)C_PADA * 1024;
        for (int i = tid; i < (C_F8 - C_PADA) * 1024 / 8; i += NTHREADS) stg((u32x4*)(d0 + (size_t)i * 8), (u32x4){0u, 0u, 0u, 0u});
    }
}

DEV void pro_mod_job(const Params& p, int job, char* shm) {
    float* sv = (float*)shm;
    const int tid = TID(), l = job / 96, col0 = (job % 96) * 64;
    const int c = tid & 63, kp = tid >> 6;
    float acc[NB + 1];
#pragma unroll
    for (int v = 0; v <= NB; ++v) acc[v] = 0.f;
    for (int half = 0; half < 2; ++half) {
        __syncthreads();
        for (int idx = tid; idx < (NB + 1) * 512; idx += 512) { const int v = idx >> 9, k = idx & 511;
            const float s = (v < NB) ? ldg(p.c + (size_t)v * 1024 + half * 512 + k) : ldg(p.c_ctx + half * 512 + k);
            sv[idx] = s * sigmoidf_(s); }
        __syncthreads();
        for (int kk = 0; kk < 64; ++kk) { const int k = kp * 64 + kk;
            const float w = ldg(p.ada_w + ((size_t)l * 1024 + half * 512 + k) * 6144 + col0 + c);
#pragma unroll
            for (int v = 0; v <= NB; ++v) acc[v] += sv[v * 512 + k] * w; }
    }
    __syncthreads();
    float* red = (float*)shm;
#pragma unroll
    for (int v = 0; v <= NB; ++v) red[(kp * (NB + 1) + v) * 64 + c] = acc[v];
    __syncthreads();
    for (int idx = tid; idx < (NB + 1) * 64; idx += 512) { const int v = idx >> 6, cc = idx & 63; float s = 0.f;
#pragma unroll
        for (int q = 0; q < 8; ++q) s += red[(q * (NB + 1) + v) * 64 + cc];
        stg(p.mod() + ((size_t)l * (NB + 1) + v) * 6144 + col0 + cc, s + ldg(p.ada_b + (size_t)l * 6144 + col0 + cc)); }
}

DEV void phase_prologue(const Params& p, char* shm) {
    const int tid = TID();
    const int nsmall = N_MODJOBS + 1 + 2 * (J_FOLD + J_PAD);
    for (int job = blockIdx.x; job < nsmall; job += gridDim.x) {
        if (job < N_MODJOBS) pro_mod_job(p, job, shm);
        else if (job == N_MODJOBS) {
            for (int idx = tid; idx < (ROWS + 64) * 16; idx += NTHREADS) { const int pos = idx >> 4, i = idx & 15;
                const float pv = (float)(pos < ROWS ? pos : pos - ROWS);
                const float inv = powf(10000.0f, -(float)(2 * i) / 32.0f);
                const float a = pv * inv; stg(p.rope() + idx * 2, cosf(a)); stg(p.rope() + idx * 2 + 1, sinf(a)); }
        } else { const int sj = job - N_MODJOBS - 1; pro_small_job(p, sj / (J_FOLD + J_PAD), sj % (J_FOLD + J_PAD), shm); }
    }
    float* tile = (float*)shm;
    const int nbig = 2 * J_BIG;
    int job = blockIdx.x;
    if (job >= nbig) return;
    const int G_ = (int)gridDim.x;
    WJob wc = wjob_decode(p, job / J_BIG, job % J_BIG), wn = wc, wm = wc;
    f32x4 vc[8], vn[8], vm[8];
    wjob_load(wc, tid, vc);
    if (job + G_ < nbig) { wn = wjob_decode(p, (job + G_) / J_BIG, (job + G_) % J_BIG); wjob_load(wn, tid, vn); }
    for (; job < nbig; job += G_) {
        const int jm = job + 2 * G_;
        if (jm < nbig) { wm = wjob_decode(p, jm / J_BIG, jm % J_BIG); wjob_load(wm, tid, vm); }
        wjob_finish(wc, tid, vc, tile);
        wc = wn; wn = wm;
#pragma unroll
        for (int i = 0; i < 8; ++i) { vc[i] = vn[i]; vn[i] = vm[i]; }
    }
}

DEV const float* xin_f32(const Params& p, const SetDesc& sd) { return (sd.is_ctx ? p.ctx : p.x) + (((size_t)sd.samp0) << sd.lgseq) * 1024; }
DEV bf16_t* xbf_base(const Params& p, const SetDesc& sd) { return (sd.is_ctx ? p.ctxs() : p.xb()) + (((size_t)sd.samp0) << sd.lgseq) * 1024; }
DEV float* xout_f32(const Params& p, const SetDesc& sd) { return p.out + (((size_t)sd.samp0) << sd.lgseq) * 1024; }
template <bool BF> struct XRow;
template <> struct XRow<false> { f32x4 v[4];
    DEV void load(const void* b, size_t row, int lane) { const float* q = (const float*)b + row * 1024 + lane * 8;
#pragma unroll
        for (int i = 0; i < 4; ++i) v[i] = ldg((const f32x4*)(q + (i >> 1) * 512 + (i & 1) * 4)); }
    DEV f32x4 get(int i) const { return v[i]; } };
template <> struct XRow<true> { u32x4 v[2];
    DEV void load(const void* b, size_t row, int lane) { const bf16_t* q = (const bf16_t*)b + row * 1024 + lane * 8;
#pragma unroll
        for (int h = 0; h < 2; ++h) v[h] = ldg((const u32x4*)(q + h * 512)); }
    DEV f32x4 get(int i) const { const u32x4 m = v[i >> 1]; return (i & 1) ? (f32x4){lo16(m.z), hi16(m.z), lo16(m.w), hi16(m.w)} : (f32x4){lo16(m.x), hi16(m.x), lo16(m.y), hi16(m.y)}; } };
template <bool BF> DEV void xrow_store8(void* b, size_t row, int c0, f32x4 a, f32x4 c) {
    if constexpr (BF) store8bf((bf16_t*)b + row * 1024 + c0, a, c);
    else { float* q = (float*)b + row * 1024 + c0; stg((f32x4*)q, a); stg((f32x4*)(q + 4), c); }
}
DEV const float* mod_row(const Params& p, const SetDesc& sd, int layer, int row) {
    return p.mod() + ((size_t)layer * (NB + 1) + (sd.is_ctx ? NB : sd.samp0 + (row >> sd.lgseq))) * 6144;
}
DEV bf16_t* proj_buf(const Params& p, const SetDesc& sd) { return sd.is_ctx ? p.PROJc() : p.PROJa(); }

DEV void stage_params(float* par, const float* v0, const float* v1, const float* v2, const float* v3, const float* v4) {
    const int tid = TID();
    const float* src[5] = {v0, v1, v2, v3, v4};
#pragma unroll
    for (int k = 0; k < 5; ++k) if (src[k]) { for (int i = tid; i < 1024; i += NTHREADS) par[k * 1024 + i] = ldg(src[k] + i); }
}
template <bool SRC_BF> DEV void phase_norm1(const Params& p, const SetDesc& sd, int layer, char* shm) {
    const int tid = TID(), lane = tid & 63, wv = tid >> 6;
    const float* g0 = p.norm_gain + ((size_t)layer * 4 + 0) * 1024;
    const void* xb = SRC_BF ? (const void*)xbf_base(p, sd) : (const void*)xin_f32(p, sd);
    const int stride = 8; const int rpb_ = (sd.nrows + (int)gridDim.x - 1) / (int)gridDim.x; const int row_end = min(sd.nrows, ((int)blockIdx.x + 1) * rpb_);
    int row = (int)blockIdx.x * rpb_ + wv;
    float* par = (float*)shm;
    __syncthreads();
    { const float* mdb = mod_row(p, sd, layer, min((int)blockIdx.x * rpb_, sd.nrows - 1)); stage_params(par, g0, mdb, mdb + 1024, nullptr, nullptr); }
    __syncthreads();
    XRow<SRC_BF> curr, nxtr;
    if (row < row_end) curr.load(xb, row, lane);
    for (; row < row_end; row += stride) {
        const int rn = row + stride;
        if (rn < row_end) nxtr.load(xb, rn, lane);
        f32x4 cur[4];
#pragma unroll
        for (int i = 0; i < 4; ++i) cur[i] = curr.get(i);
        float ss = 0.f;
#pragma unroll
        for (int i = 0; i < 4; ++i)
#pragma unroll
            for (int j = 0; j < 4; ++j) ss += cur[i][j] * cur[i][j];
        ss = wave_sum(ss);
        const float rstd = rsqrtf(ss * (1.0f / 1024.0f) + RMS_EPS);
#pragma unroll
        for (int hlf = 0; hlf < 2; ++hlf) { const int c0 = hlf * 512 + lane * 8; float o[8];
#pragma unroll
            for (int j = 0; j < 8; ++j) o[j] = cur[hlf * 2 + (j >> 2)][j & 3] * rstd * par[c0 + j] * (1.0f + par[2048 + c0 + j]) + par[1024 + c0 + j];
            u32x4 ov = {pack2(o[0], o[1]), pack2(o[2], o[3]), pack2(o[4], o[5]), pack2(o[6], o[7])};
            stg((u32x4*)(p.H() + (size_t)row * 1024 + c0), ov);
            const u32x2 o8 = {f8pack4(o[0], o[1], o[2], o[3]), f8pack4(o[4], o[5], o[6], o[7])};
            stg((u32x2*)(p.H8() + (size_t)row * 1024 + c0), o8); }
        curr = nxtr;
    }
}

struct SchedPlain {
    const bf16_t* A; const bf16_t* Bt; int nM, nN, lda256, ldb256; int kv_only = 0;
    DEV bool next(int i, GUnit& u) const { u.aux = 0; if (!tile_order(i, nM, nN, u.pm, u.pn)) return false; if (kv_only) u.pn = u.pn == 0 ? 1 : 4; return true; }
    DEV const bf16_t* a_base(const GUnit& u) const { return A + (size_t)u.pm * lda256; }
    DEV const bf16_t* b_base(const GUnit& u) const { return Bt + (size_t)u.pn * ldb256; }
    DEV int grow(const GUnit&, int) const { return 0; }
};
struct SchedPlainT : SchedPlain {
    int split_base = -1;
    DEV bool next(int i, GUnit& u) const { u.aux = 0; const int G_ = (int)gridDim.x, b = (int)blockIdx.x; int L = i * G_ + b;
        if (split_base >= 0 && i >= split_base) { if (b < G_ / 2 || i >= split_base + 2) return false; L = split_base * G_ + (i - split_base) * (G_ / 2) + (b - G_ / 2); }
        if (!tile_from_L(L, nM, nN, u.pm, u.pn)) return false; if (kv_only) u.pn = u.pn < 4 ? u.pn + 2 : u.pn + 4; return true; }
    DEV const bf16_t* a_base(const GUnit&) const { return A; }
    DEV int grow(const GUnit& u, int i) const { return u.pm * 256 + i; }
};
struct SchedProjF8 : SchedPlainT {
    const bf16_t* Bt2; int na8;
    DEV const bf16_t* b_base(const GUnit& u) const { return u.pn < na8 ? Bt + (size_t)u.pn * ldb256 : Bt2 + (size_t)(u.pn - na8) * ldb256; }
};
DEV unsigned gate4u8(f32x4 v) {
    unsigned w = 0;
#pragma unroll
    for (int j = 0; j < 4; ++j) w |= (unsigned)fmaxf(sigmoidf_(v[j] * F8_WINV) * 255.0f + 0.5f, 1.0f) << (8 * j);
    return w;
}
DEV float u8f(unsigned w, int j) { return (float)((w >> (8 * j)) & 0xFFu); }
DEV void phase_proj_a(const Params& p, const SetDesc& sd, int layer, char* shm) {
    const bool kv_only = sd.is_ctx && layer == 1;
    bf16_t* pb = proj_buf(p, sd);
    {
        SchedPlain S; S.A = p.H(); S.Bt = p.WinT() + (size_t)layer * PWT * 1024; S.nM = sd.nrows / 256; S.nN = C_F8 / 256; S.lda256 = 256 * 1024; S.ldb256 = 256 * 1024;
        if (kv_only) { S.kv_only = 1; S.nN = 2; }
        gemm_stream<false, 1024, 1024, 1024>(shm, S, [=](const GUnit& u, const f32x4 (&acc)[2][2][4][2], int r0, int c0) {
#pragma unroll
            for (int ai = 0; ai < 2; ++ai)
#pragma unroll
                for (int m = 0; m < 4; ++m) { bf16_t* o = pb + ((size_t)u.pm * 256 + r0 + ai * 128 + m * 16) * PWA + u.pn * 256 + c0;
                    if (u.pn * 256 + c0 < C_PADA) store8bf(o, acc[ai][0][m][0], acc[ai][0][m][1]);
                    if (u.pn * 256 + 128 < C_PADA) store8bf(o + 128, acc[ai][1][m][0], acc[ai][1][m][1]); } });
    }
    {
        constexpr int NA8 = (PWA - C_F8) / 256;
        SchedProjF8 S; S.A = (const bf16_t*)p.H8(); S.Bt = p.WinT() + (size_t)layer * PWT * 1024 + (size_t)C_F8 * 1024; S.Bt2 = p.WinT() + (size_t)layer * PWT * 1024 + (size_t)PWA * 1024; S.na8 = NA8;
        S.nM = sd.nrows / 256; S.nN = NA8 + NBG / 256; S.lda256 = 256 * 512; S.ldb256 = 256 * 512;
        if (kv_only) { S.kv_only = 1; S.nN = 6; }
        { const int G_ = (int)gridDim.x, T1 = S.nM * (kv_only ? 2 : C_F8 / 256), T2 = S.nM * S.nN; if ((G_ & 1) == 0 && (T1 % G_) * 2 == G_ && T2 % G_ == 0 && T2 / G_ >= 1) S.split_base = T2 / G_ - 1; }
        unsigned char* bg = p.BG();
        gemm_stream<true, 512, 512, 512, true>(shm, S, [=](const GUnit& u, const f32x4 (&acc)[2][2][4][2], int r0, int c0) {
            if (u.pn < NA8) {
#pragma unroll
                for (int ai = 0; ai < 2; ++ai)
#pragma unroll
                    for (int m = 0; m < 4; ++m) { bf16_t* o = pb + ((size_t)u.pm * 256 + r0 + ai * 128 + m * 16) * PWA + C_F8 + u.pn * 256 + c0;
                        store8bf(o, acc[ai][0][m][0] * F8_WINV, acc[ai][0][m][1] * F8_WINV); store8bf(o + 128, acc[ai][1][m][0] * F8_WINV, acc[ai][1][m][1] * F8_WINV); }
            } else {
#pragma unroll
                for (int ai = 0; ai < 2; ++ai)
#pragma unroll
                    for (int m = 0; m < 4; ++m) { unsigned char* o = bg + ((size_t)u.pm * 256 + r0 + ai * 128 + m * 16) * NBG + (u.pn - NA8) * 256 + c0;
#pragma unroll
                        for (int hf = 0; hf < 2; ++hf) { const u32x2 gv = {gate4u8(acc[ai][hf][m][0]), gate4u8(acc[ai][hf][m][1])}; stg((u32x2*)(o + hf * 128), gv); } }
            } });
    }
}
DEV f32x4 sig4(f32x4 v) { f32x4 r; r[0] = sigmoidf_(v[0]); r[1] = sigmoidf_(v[1]); r[2] = sigmoidf_(v[2]); r[3] = sigmoidf_(v[3]); return r; }
DEV void gate_scan(const bf16_t* prow, int h, const float* gbias, float* ga, float* gb, float* gpm, float* gtot, float* tmp) {
    const int tid = TID(), lane = tid & 63, w = tid >> 6;
    float b = 0.f, a = 0.f, pm = 0.f; int d = 0, tok = 0;
    if (tid < 256) {
        d = tid >> 7; const int i = tid & 127; tok = d ? 127 - i : i;
        const float gi = bf2f(ldg(prow + (size_t)tok * PWA + C_GM + (2 * d) * 4 + h)) + ldg(gbias + (2 * d) * 4 + h);
        const float gf = bf2f(ldg(prow + (size_t)tok * PWA + C_GM + (2 * d + 1) * 4 + h)) + ldg(gbias + (2 * d + 1) * 4 + h);
        b = logsigmoidf_(gf);
#pragma unroll
        for (int o = 1; o < 64; o <<= 1) { const float t = __shfl_up(b, o); if (lane >= o) b += t; }
        if (lane == 63) tmp[w] = b;
        a = gi;
    }
    __syncthreads();
    if (tid < 256) {
        if (w & 1) b += tmp[w - 1];
        a -= b; pm = a;
#pragma unroll
        for (int o = 1; o < 64; o <<= 1) { const float t = __shfl_up(pm, o); if (lane >= o) pm = fmaxf(pm, t); }
        if (lane == 63) tmp[8 + w] = pm;
    }
    __syncthreads();
    if (tid < 256) {
        if (w & 1) pm = fmaxf(pm, tmp[8 + w - 1]);
        ga[d * 128 + tok] = a; gb[d * 128 + tok] = b; gpm[d * 128 + tok] = pm;
        if ((tid & 127) == 127) { gtot[d * 2] = b; gtot[d * 2 + 1] = pm; }
    }
    __syncthreads();
}

struct RopeRaw { u32x4 m, q; f32x4 rt[4]; };
DEV void rope_issue(RopeRaw& r, const bf16_t* hp, int cidx, bool latent, int tl, const float* rope) {
    r.m = ldg((const u32x4*)(hp + cidx * 8));
    if (latent) {
        r.q = ldg((const u32x4*)(hp + (cidx ^ 2) * 8));
        const int pos = (cidx < 4) ? (tl >> 6) : (ROWS + (tl & 63));
        const float* tb = rope + ((size_t)pos * 16 + (cidx & 1) * 8) * 2;
#pragma unroll
        for (int i = 0; i < 4; ++i) r.rt[i] = ldg((const f32x4*)(tb + i * 4));
    }
}
DEV void rope_apply(const RopeRaw& r, int cidx, bool latent, float scale, float* o) {
    const u32x4 m = r.m;
    float x[8] = {lo16(m.x), hi16(m.x), lo16(m.y), hi16(m.y), lo16(m.z), hi16(m.z), lo16(m.w), hi16(m.w)};
    if (latent) {
        const u32x4 q = r.q;
        const float y[8] = {lo16(q.x), hi16(q.x), lo16(q.y), hi16(q.y), lo16(q.z), hi16(q.z), lo16(q.w), hi16(q.w)};
        const bool first = (cidx & 2) == 0;
#pragma unroll
        for (int j = 0; j < 8; ++j) { const float cs = r.rt[j >> 1][(j & 1) * 2], sn = r.rt[j >> 1][(j & 1) * 2 + 1];
            x[j] = first ? (x[j] * cs - y[j] * sn) : (x[j] * cs + y[j] * sn); }
    }
#pragma unroll
    for (int j = 0; j < 8; ++j) o[j] = x[j] * scale;
}

DEV int st_index(const SetDesc& sd, int sl, int h, int dir, int tb) { return ((sl * 4 + h) * 2 + dir) * sd.ntb + tb; }

constexpr int V_LD = 144, K_LD = 72, KS_LD = 80;
struct PrefA { RopeRaw rk1, rk2; u32x4 vreg[4]; };
DEV void stepA_issue(PrefA& f, const Params& p, const SetDesc& sd, int task) {
    const int tid = TID();
    const int tb = task % sd.ntb, h = (task / sd.ntb) & 3, sl = task / (sd.ntb * 4);
    const int row0 = (sl << sd.lgseq) + tb * 128; const bool latent = !sd.is_ctx; const int tl0 = tb * 128;
    const bf16_t* prow = proj_buf(p, sd) + (size_t)row0 * PWA;
    { const int s = tid & 127, cpi = tid >> 7, cp = (cpi & 1) + (cpi >> 1) * 4; const bf16_t* hp = prow + (size_t)s * PWA + C_KM + h * 64;
      rope_issue(f.rk1, hp, cp, latent, tl0 + s, p.rope()); rope_issue(f.rk2, hp, cp + 2, latent, tl0 + s, p.rope()); }
#pragma unroll
    for (int it = 0; it < 4; ++it) { const int item = tid + it * 512, s = item >> 4, ch = item & 15; f.vreg[it] = ldg((const u32x4*)(prow + (size_t)s * PWA + C_VM + h * 128 + ch * 8)); }
}
DEV void mlstm_stepA_task(const Params& p, const SetDesc& sd, int layer, int task, int next_task, PrefA& f, char* shm) {
    const int tid = TID(), lane = tid & 63, w = tid >> 6, fr = lane & 15, fq = lane >> 4, tq4 = (lane & 15) >> 2, tp4 = lane & 3;
    const int tb = task % sd.ntb, h = (task / sd.ntb) & 3, sl = task / (sd.ntb * 4);
    const int row0 = (sl << sd.lgseq) + tb * 128; const bool latent = !sd.is_ctx;
    bf16_t* Vs = (bf16_t*)shm;
    bf16_t* Ksc = (bf16_t*)(shm + 128 * V_LD * 2);
    float* ga = (float*)(shm + 128 * V_LD * 2 + 2 * 128 * KS_LD * 2); float* gb = ga + 256; float* gpm = gb + 256; float* gtot = gpm + 256; float* tmp = gtot + 8;
    const bf16_t* prow = proj_buf(p, sd) + (size_t)row0 * PWA;
    __syncthreads();
    gate_scan(prow, h, p.gate_bias + (size_t)layer * 16, ga, gb, gpm, gtot, tmp);
    {
        const int s = tid & 127, cpi = tid >> 7, cp = (cpi & 1) + (cpi >> 1) * 4;
        float k1[8], k2[8];
        rope_apply(f.rk1, cp, latent, 1.0f, k1);
        rope_apply(f.rk2, cp + 2, latent, 1.0f, k2);
#pragma unroll
        for (int dir = 0; dir < 2; ++dir) { const float ws = __expf(ga[dir * 128 + s] - gtot[dir * 2 + 1]);
            u32x4 o1 = {pack2(k1[0] * ws, k1[1] * ws), pack2(k1[2] * ws, k1[3] * ws), pack2(k1[4] * ws, k1[5] * ws), pack2(k1[6] * ws, k1[7] * ws)};
            u32x4 o2 = {pack2(k2[0] * ws, k2[1] * ws), pack2(k2[2] * ws, k2[3] * ws), pack2(k2[4] * ws, k2[5] * ws), pack2(k2[6] * ws, k2[7] * ws)};
            *(u32x4*)(Ksc + (dir * 128 + s) * KS_LD + cp * 8) = o1; *(u32x4*)(Ksc + (dir * 128 + s) * KS_LD + (cp + 2) * 8) = o2; }
    }
#pragma unroll
    for (int it = 0; it < 4; ++it) { const int item = tid + it * 512, s = item >> 4, ch = item & 15; *(u32x4*)(Vs + s * V_LD + ch * 8) = f.vreg[it]; }
    if (next_task >= 0) stepA_issue(f, p, sd, next_task);
    __syncthreads();
    f32x4 acc[2][4];
#pragma unroll
    for (int dir = 0; dir < 2; ++dir)
#pragma unroll
        for (int n = 0; n < 4; ++n) acc[dir][n] = (f32x4){0.f, 0.f, 0.f, 0.f};
#pragma unroll
    for (int ks = 0; ks < 4; ++ks) {
        const bf16_t* vp = Vs + (32 * ks + 4 * fq + tq4) * V_LD + w * 16 + 4 * tp4;
        const bf16x8 af = mk8(TR16(vp), TR16(vp + 16 * V_LD));
#pragma unroll
        for (int dir = 0; dir < 2; ++dir)
#pragma unroll
            for (int n = 0; n < 4; ++n) { const bf16_t* kp = Ksc + (dir * 128 + 32 * ks + 4 * fq + tq4) * KS_LD + n * 16 + 4 * tp4;
                const bf16x8 bfv = mk8(TR16(kp), TR16(kp + 16 * KS_LD));
                acc[dir][n] = mfma16(bfv, af, acc[dir][n]); }
    }
#pragma unroll
    for (int dir = 0; dir < 2; ++dir) { float* So = p.Sst() + (size_t)st_index(sd, sl, h, dir, tb) * 8192;
#pragma unroll
        for (int n = 0; n < 4; ++n) stg((f32x4*)(So + (w * 16 + fr) * 64 + n * 16 + fq * 4), acc[dir][n]); }
    if (tid < 128) { const int dir = tid >> 6, dd = tid & 63; float sm = 0.f;
        for (int i = 0; i < 128; ++i) sm += bf2f(Ksc[(dir * 128 + i) * KS_LD + dd]);
        stg(p.Sn() + (size_t)st_index(sd, sl, h, dir, tb) * 64 + dd, sm); }
    if (tid < 2) { float* sc = p.Ssc() + (size_t)st_index(sd, sl, h, tid, tb) * 4; stg(sc, gtot[tid * 2]); stg(sc + 1, gtot[tid * 2] + gtot[tid * 2 + 1]); }
}

template <int GI> DEV void pool_group(const Params& p, const SetDesc& sd, const bf16_t* pb) {
    constexpr int W = 2 << GI;
    const int nitems = sd.nrows * 16; const int T = 1 << sd.lgseq;
    for (int item = blockIdx.x * NTHREADS + TID(); item < nitems; item += gridDim.x * NTHREADS) {
        const int row = item >> 4, ch = GI * 128 + (item & 15) * 8;
        const int tt = row & (T - 1);
        u32x4 mv[W]; int cnt = 0; bool okv[W];
#pragma unroll
        for (int q = 0; q < W; ++q) { const int t2 = tt - W / 2 + q; const bool ok = (t2 >= 0) && (t2 < T); cnt += ok ? 1 : 0; okv[q] = ok;
            mv[q] = ldg((const u32x4*)(pb + (size_t)(ok ? (row - W / 2 + q) : row) * PWA + C_PU + ch)); }
        float s[8];
#pragma unroll
        for (int j = 0; j < 8; ++j) s[j] = 0.f;
#pragma unroll
        for (int q = 0; q < W; ++q) { u32x4 m = mv[q]; if (!okv[q]) m = (u32x4){0u, 0u, 0u, 0u};
            s[0] += lo16(m.x); s[1] += hi16(m.x); s[2] += lo16(m.y); s[3] += hi16(m.y); s[4] += lo16(m.z); s[5] += hi16(m.z); s[6] += lo16(m.w); s[7] += hi16(m.w); }
        const float inv = frcp((float)cnt);
        const u32x4 m = mv[W / 2];
        const float u[8] = {lo16(m.x), hi16(m.x), lo16(m.y), hi16(m.y), lo16(m.z), hi16(m.z), lo16(m.w), hi16(m.w)};
        u32x4 o = {pack2(s[0] * inv - u[0], s[1] * inv - u[1]), pack2(s[2] * inv - u[2], s[3] * inv - u[3]), pack2(s[4] * inv - u[4], s[5] * inv - u[5]), pack2(s[6] * inv - u[6], s[7] * inv - u[7])};
        stg((u32x4*)(p.Pb() + (size_t)row * 512 + ch), o);
    }
}
DEV void phase_pool(const Params& p, const SetDesc& sd) {
    const bf16_t* pb = proj_buf(p, sd);
    pool_group<0>(p, sd, pb); pool_group<1>(p, sd, pb); pool_group<2>(p, sd, pb); pool_group<3>(p, sd, pb);
}

template <int NC> DEV void mlstm_stepB_run(const Params& p, const SetDesc& sd, int task) {
    const int tid = TID();
    const int q = task & 3, dir = (task >> 2) & 1, h = (task >> 3) & 3, sl = task >> 5;
    const int ci = ((sd.samp0 + sl) * 4 + h) * 2 + dir;
    const int eoff = q * 2048 + tid * 4;
    float zr = 0.f; HIDE(zr);
    f32x4 C = {zr, zr, zr, zr}; float nv = 0.f; float m = -1e30f;
    f32x4 Sv[NC]; float blv[NC], mlv[NC], snv[NC];
#pragma unroll
    for (int c = 0; c < NC; ++c) { const int tb = dir ? NC - 1 - c : c; const size_t si = st_index(sd, sl, h, dir, tb);
        Sv[c] = ldg((const f32x4*)(p.Sst() + si * 8192 + eoff)); blv[c] = ldg(p.Ssc() + si * 4); mlv[c] = ldg(p.Ssc() + si * 4 + 1);
        snv[c] = (q == 0 && tid < 64) ? ldg(p.Sn() + si * 64 + tid) : 0.f; }
    if (!sd.is_ctx) { C = ldg((const f32x4*)(p.CiC() + (size_t)ci * 8192 + eoff)); if (q == 0 && tid < 64) nv = ldg(p.Cin_() + (size_t)ci * 64 + tid); m = ldg(p.Cim() + (size_t)ci * 4); }
#pragma unroll
    for (int c = 0; c < NC; ++c) {
        const int tb = dir ? NC - 1 - c : c; const size_t si = st_index(sd, sl, h, dir, tb);
        u32x2 o = {pack2(C[0], C[1]), pack2(C[2], C[3])};
        stg((u32x2*)(p.Cin() + si * 8192 + eoff), o);
        if (q == 0 && tid < 64) stg(p.Cn() + si * 64 + tid, nv);
        if (q == 0 && tid == 0) stg(p.Cm() + si * 4, m);
        const float mn = fmaxf(blv[c] + m, mlv[c]);
        const float dc = __expf(blv[c] + m - mn), wsn = __expf(mlv[c] - mn);
        C = C * dc + Sv[c] * wsn;
        nv = nv * dc + snv[c] * wsn;
        m = mn;
    }
    if (sd.is_ctx) { stg((f32x4*)(p.CiC() + (size_t)ci * 8192 + eoff), C); if (q == 0 && tid < 64) stg(p.Cin_() + (size_t)ci * 64 + tid, nv); if (q == 0 && tid == 0) stg(p.Cim() + (size_t)ci * 4, m); }
}
DEV void mlstm_stepB_task(const Params& p, const SetDesc& sd, int task) {
    if (sd.is_ctx) mlstm_stepB_run<NTBC>(p, sd, task); else mlstm_stepB_run<NTBL>(p, sd, task);
}

constexpr int NA_KLD = 136, NA_VLD = 144;
DEV void na_task(const Params& p, const SetDesc& sd, int layer, int sl, int rq2  , int hp, char* shm) {
    const int tid = TID(), lane = tid & 63, w = tid >> 6, tq = lane & 15, fq = lane >> 4, tq4 = (lane & 15) >> 2, tp4 = lane & 3;
    const int hh = w >> 2, g = w & 3, head = hp * 2 + hh;
    const bool ctxq = sd.is_ctx;
    bf16_t* Ks = (bf16_t*)shm;
    bf16_t* Vs = (bf16_t*)(shm + 128 * NA_KLD * 2);
    float* rpbs = (float*)(shm + 128 * NA_KLD * 2 + 128 * NA_VLD * 2);
    const int sample = sd.samp0 + sl;
    const bf16_t* pq = proj_buf(p, sd) + ((size_t)sl << sd.lgseq) * PWA;
    const bf16_t* pc = p.PROJc() + (size_t)sample * CTX * PWA;
    const int qcol = g * 16 + tq;
    int rqv[2], rsv[2], qtok[2];
#pragma unroll
    for (int u = 0; u < 2; ++u) { rqv[u] = 2 * rq2 + u; qtok[u] = rqv[u] * 64 + qcol; int r_ = rqv[u] - 4; rsv[u] = r_ < 0 ? 0 : (r_ > ROWS - 8 ? ROWS - 8 : r_); }
    const int nloc = ctxq ? 0 : (rsv[1] + 8 - rsv[0]);
    const int nstage = nloc + CTX / 64;
    __syncthreads();
    if (!ctxq) for (int i = tid; i < 2 * 465; i += NTHREADS) rpbs[i] = ldg(p.rpb + ((size_t)layer * 8 + hp * 2 + i / 465) * 465 + i % 465);
    bf16x8 qf[2][2];
#pragma unroll
    for (int u = 0; u < 2; ++u)
#pragma unroll
        for (int ks = 0; ks < 2; ++ks) qf[u][ks] = mk8(ldg((const u32x4*)(pq + (size_t)qtok[u] * PWA + C_QN + head * 64 + ks * 32 + fq * 8)));
    float m_run[2] = {-1e30f, -1e30f}, l_run[2] = {0.f, 0.f};
    f32x4 acc[2][4];
#pragma unroll
    for (int u = 0; u < 2; ++u)
#pragma unroll
        for (int mt = 0; mt < 4; ++mt) acc[u][mt] = (f32x4){0.f, 0.f, 0.f, 0.f};
    int cs = qcol - 8; cs = cs < 0 ? 0 : (cs > 48 ? 48 : cs);
    const int kc0 = (g == 0) ? 0 : (g == 1) ? 8 : (g == 2) ? 24 : 32;
    const int npair = (nstage + 1) >> 1;
    u32x4 kreg[4], vreg[4];
#define NA_SRC_ROWS(stg) (((stg) < nloc) ? (pq + (size_t)((rsv[0] + (stg)) * 64) * PWA) : (pc + (size_t)((((stg) < nstage ? (stg) : nstage - 1) - nloc) * 64) * PWA))
#define NA_FETCH(sp_) do { _Pragma("unroll") for (int it = 0; it < 4; ++it) { const int item = tid + it * 512, key2 = item >> 4, ch = item & 15; \
        const bf16_t* kb_ = NA_SRC_ROWS(2 * (sp_) + (key2 >> 6)); const bf16_t* src = kb_ + (size_t)(key2 & 63) * PWA + hp * 128 + ch * 8; \
        kreg[it] = ldg((const u32x4*)(src + C_KN)); vreg[it] = ldg((const u32x4*)(src + C_VN)); } } while (0)
    NA_FETCH(0);
    for (int sp = 0; sp < npair; ++sp) {
        __syncthreads();
#pragma unroll
        for (int it = 0; it < 4; ++it) { const int item = tid + it * 512, key2 = item >> 4, ch = item & 15;
            *(u32x4*)(Ks + key2 * NA_KLD + ch * 8) = kreg[it]; *(u32x4*)(Vs + key2 * NA_VLD + ch * 8) = vreg[it]; }
        if (sp + 1 < npair) NA_FETCH(sp + 1);
        __syncthreads();
#pragma unroll
        for (int sub = 0; sub < 2; ++sub) {
        const int st = 2 * sp + sub;
        if (st >= nstage) continue;
        const bool local = st < nloc;
        const bf16_t* Ksb = Ks + sub * 64 * NA_KLD; const bf16_t* Vsb = Vs + sub * 64 * NA_VLD;
        if (local) {
            const int kr = rsv[0] + st;
            f32x4 sa[2][2];
#pragma unroll
            for (int kt = 0; kt < 2; ++kt) { sa[0][kt] = (f32x4){0.f, 0.f, 0.f, 0.f}; sa[1][kt] = (f32x4){0.f, 0.f, 0.f, 0.f};
#pragma unroll
                for (int ks = 0; ks < 2; ++ks) { const bf16x8 kf = *(const bf16x8*)(Ksb + (kc0 + kt * 16 + tq) * NA_KLD + hh * 64 + ks * 32 + fq * 8);
                    sa[0][kt] = mfma16(kf, qf[0][ks], sa[0][kt]); sa[1][kt] = mfma16(kf, qf[1][ks], sa[1][kt]); } }
            float alpha[2]; bf16x8 pf[2];
#pragma unroll
            for (int u = 0; u < 2; ++u) {
                const bool act = (kr >= rsv[u]) && (kr < rsv[u] + 8);
                if (!act) { alpha[u] = 1.0f; pf[u] = mk8((u32x4){0u, 0u, 0u, 0u}); continue; }
                const int dr = kr - rqv[u] + 7;
                float sc[8]; float mx = -1e30f; float bs[8];
#pragma unroll
                for (int kt = 0; kt < 2; ++kt)
#pragma unroll
                    for (int r = 0; r < 4; ++r) { const int kcol = kc0 + kt * 16 + fq * 4 + r; int dc = kcol - qcol + 15; dc = dc < 0 ? 0 : (dc > 30 ? 30 : dc);
                        bs[kt * 4 + r] = rpbs[hh * 465 + dr * 31 + dc]; }
#ifndef CPU_EMU
                asm volatile("" : "+v"(bs[0]), "+v"(bs[1]), "+v"(bs[2]), "+v"(bs[3]), "+v"(bs[4]), "+v"(bs[5]), "+v"(bs[6]), "+v"(bs[7]));
#endif
#pragma unroll
                for (int kt = 0; kt < 2; ++kt)
#pragma unroll
                    for (int r = 0; r < 4; ++r) { const int kcol = kc0 + kt * 16 + fq * 4 + r; const bool valid = (kcol >= cs) && (kcol < cs + 16);
                        const float v = valid ? (sa[u][kt][r] * 0.125f + bs[kt * 4 + r]) : -1e30f; sc[kt * 4 + r] = v; mx = fmaxf(mx, v); }
                mx = fmaxf(mx, shx<16>(mx)); mx = fmaxf(mx, shx<32>(mx));
                const float mn = fmaxf(m_run[u], mx); alpha[u] = __expf(m_run[u] - mn); m_run[u] = mn;
                float ps = 0.f; float pv[8];
#pragma unroll
                for (int j = 0; j < 8; ++j) { pv[j] = __expf(sc[j] - mn); ps += pv[j]; }
                ps += shx<16>(ps); ps += shx<32>(ps);
                l_run[u] = l_run[u] * alpha[u] + ps;
                u32x4 pk = {pack2(pv[0], pv[1]), pack2(pv[2], pv[3]), pack2(pv[4], pv[5]), pack2(pv[6], pv[7])};
                pf[u] = mk8(pk);
            }
#pragma unroll
            for (int mt = 0; mt < 4; ++mt) {
                const bf16_t* vp = Vsb + (kc0 + 4 * fq + tq4) * NA_VLD + hh * 64 + mt * 16 + 4 * tp4;
                const bf16x8 vf = mk8(TR16(vp), TR16(vp + 16 * NA_VLD));
                acc[0][mt] = mfma16(vf, pf[0], acc[0][mt] * alpha[0]); acc[1][mt] = mfma16(vf, pf[1], acc[1][mt] * alpha[1]); }
        } else {
            f32x4 sa[2][4];
#pragma unroll
            for (int kt = 0; kt < 4; ++kt) { sa[0][kt] = (f32x4){0.f, 0.f, 0.f, 0.f}; sa[1][kt] = (f32x4){0.f, 0.f, 0.f, 0.f};
#pragma unroll
                for (int ks = 0; ks < 2; ++ks) { const bf16x8 kf = *(const bf16x8*)(Ksb + (kt * 16 + tq) * NA_KLD + hh * 64 + ks * 32 + fq * 8);
                    sa[0][kt] = mfma16(kf, qf[0][ks], sa[0][kt]); sa[1][kt] = mfma16(kf, qf[1][ks], sa[1][kt]); } }
            float alpha[2]; bf16x8 pf[2][2];
#pragma unroll
            for (int u = 0; u < 2; ++u) {
                float mx = -1e30f;
#pragma unroll
                for (int kt = 0; kt < 4; ++kt)
#pragma unroll
                    for (int r = 0; r < 4; ++r) { sa[u][kt][r] *= 0.125f; mx = fmaxf(mx, sa[u][kt][r]); }
                mx = fmaxf(mx, shx<16>(mx)); mx = fmaxf(mx, shx<32>(mx));
                const float mn = fmaxf(m_run[u], mx); alpha[u] = __expf(m_run[u] - mn); m_run[u] = mn;
                float ps = 0.f;
#pragma unroll
                for (int kt = 0; kt < 4; ++kt)
#pragma unroll
                    for (int r = 0; r < 4; ++r) { sa[u][kt][r] = __expf(sa[u][kt][r] - mn); ps += sa[u][kt][r]; }
                ps += shx<16>(ps); ps += shx<32>(ps);
                l_run[u] = l_run[u] * alpha[u] + ps;
#pragma unroll
                for (int h2 = 0; h2 < 2; ++h2) {
                    u32x4 pk = {pack2(sa[u][2 * h2][0], sa[u][2 * h2][1]), pack2(sa[u][2 * h2][2], sa[u][2 * h2][3]), pack2(sa[u][2 * h2 + 1][0], sa[u][2 * h2 + 1][1]), pack2(sa[u][2 * h2 + 1][2], sa[u][2 * h2 + 1][3])};
                    pf[u][h2] = mk8(pk); }
            }
#pragma unroll
            for (int mt = 0; mt < 4; ++mt) { acc[0][mt] = acc[0][mt] * alpha[0]; acc[1][mt] = acc[1][mt] * alpha[1]; }
#pragma unroll
            for (int h2 = 0; h2 < 2; ++h2)
#pragma unroll
                for (int mt = 0; mt < 4; ++mt) { const bf16_t* vp = Vsb + (32 * h2 + 4 * fq + tq4) * NA_VLD + hh * 64 + mt * 16 + 4 * tp4;
                    const bf16x8 vf = mk8(TR16(vp), TR16(vp + 16 * NA_VLD));
                    acc[0][mt] = mfma16(vf, pf[0][h2], acc[0][mt]); acc[1][mt] = mfma16(vf, pf[1][h2], acc[1][mt]); }
        }
        }
    }
#undef NA_FETCH
#undef NA_SRC_ROWS
#pragma unroll
    for (int u = 0; u < 2; ++u) {
        const float il = frcp(l_run[u]);
        const size_t orow = ((size_t)sl << sd.lgseq) + qtok[u];
#pragma unroll
        for (int mt = 0; mt < 4; ++mt) { u32x2 o = {pack2(acc[u][mt][0] * il, acc[u][mt][1] * il), pack2(acc[u][mt][2] * il, acc[u][mt][3] * il)};
            stg((u32x2*)(p.Nb() + orow * 512 + head * 64 + mt * 16 + fq * 4), o); }
    }
}

struct PrefC { RopeRaw rk1, rk2; u32x4 vreg[4], creg[4]; };
DEV void stepC_issue(PrefC& f, const Params& p, const SetDesc& sd, int task) {
    const int tid = TID();
    const int tb = task % sd.ntb, h = (task / sd.ntb) & 3, sl = task / (sd.ntb * 4);
    const int row0 = (sl << sd.lgseq) + tb * 128; const bool latent = !sd.is_ctx; const int tl0 = tb * 128;
    const bf16_t* prow = proj_buf(p, sd) + (size_t)row0 * PWA;
    { const int s = tid & 127, cpi = tid >> 7, cp = (cpi & 1) + (cpi >> 1) * 4; const bf16_t* hp = prow + (size_t)s * PWA + C_KM + h * 64;
      rope_issue(f.rk1, hp, cp, latent, tl0 + s, p.rope()); rope_issue(f.rk2, hp, cp + 2, latent, tl0 + s, p.rope()); }
#pragma unroll
    for (int it = 0; it < 4; ++it) { const int item = tid + it * 512, s = item >> 4, ch = item & 15; f.vreg[it] = ldg((const u32x4*)(prow + (size_t)s * PWA + C_VM + h * 128 + ch * 8)); }
#pragma unroll
    for (int it = 0; it < 4; ++it) { const int item = tid + it * 512, dir = item >> 10, rem = item & 1023, v = rem >> 3, ch = rem & 7;
        f.creg[it] = ldg((const u32x4*)(p.Cin() + (size_t)st_index(sd, sl, h, dir, tb) * 8192 + v * 64 + ch * 8)); }
}
DEV void mlstm_stepC_task(const Params& p, const SetDesc& sd, int layer, int task, int next_task, PrefC& f, char* shm) {
    const int tid = TID(), lane = tid & 63, w = tid >> 6, tq = lane & 15, fq = lane >> 4, tq4 = (lane & 15) >> 2, tp4 = lane & 3;
    const int tb = task % sd.ntb, h = (task / sd.ntb) & 3, sl = task / (sd.ntb * 4);
    const int row0 = (sl << sd.lgseq) + tb * 128; const bool latent = !sd.is_ctx; const int tl0 = tb * 128;
    bf16_t* Ks = (bf16_t*)shm;
    bf16_t* Vs = (bf16_t*)(shm + 128 * K_LD * 2);
    bf16_t* Cs = (bf16_t*)(shm + 128 * K_LD * 2 + 128 * V_LD * 2);
    float* ga = (float*)(shm + 128 * K_LD * 2 * 3 + 128 * V_LD * 2); float* gb = ga + 256; float* gpm = gb + 256; float* gtot = gpm + 256; float* tmp = gtot + 8;
    float* nvs = tmp + 16;
    float* cms = nvs + 128;
    const bf16_t* prow = proj_buf(p, sd) + (size_t)row0 * PWA;
    RopeRaw rq[2];
    { const int t_ = w * 16 + tq; const bf16_t* hp = prow + (size_t)t_ * PWA + C_QM + h * 64;
#pragma unroll
      for (int ks = 0; ks < 2; ++ks) rope_issue(rq[ks], hp, ks * 4 + fq, latent, tl0 + t_, p.rope()); }
    __syncthreads();
    gate_scan(prow, h, p.gate_bias + (size_t)layer * 16, ga, gb, gpm, gtot, tmp);
    {
        const int s = tid & 127, cpi = tid >> 7, cp = (cpi & 1) + (cpi >> 1) * 4;
        float k1[8], k2[8];
        rope_apply(f.rk1, cp, latent, 1.0f, k1);
        rope_apply(f.rk2, cp + 2, latent, 1.0f, k2);
        u32x4 o1 = {pack2(k1[0], k1[1]), pack2(k1[2], k1[3]), pack2(k1[4], k1[5]), pack2(k1[6], k1[7])};
        u32x4 o2 = {pack2(k2[0], k2[1]), pack2(k2[2], k2[3]), pack2(k2[4], k2[5]), pack2(k2[6], k2[7])};
        *(u32x4*)(Ks + s * K_LD + cp * 8) = o1; *(u32x4*)(Ks + s * K_LD + (cp + 2) * 8) = o2;
    }
#pragma unroll
    for (int it = 0; it < 4; ++it) { const int item = tid + it * 512, s = item >> 4, ch = item & 15; *(u32x4*)(Vs + s * V_LD + ch * 8) = f.vreg[it]; }
#pragma unroll
    for (int it = 0; it < 4; ++it) { const int item = tid + it * 512, dir = item >> 10, rem = item & 1023, v = rem >> 3, ch = rem & 7; *(u32x4*)(Cs + (dir * 128 + v) * K_LD + ch * 8) = f.creg[it]; }
    if (tid < 128) nvs[tid] = ldg(p.Cn() + (size_t)st_index(sd, sl, h, tid >> 6, tb) * 64 + (tid & 63));
    if (tid < 2) cms[tid] = ldg(p.Cm() + (size_t)st_index(sd, sl, h, tid, tb) * 4);
    bf16x8 qf[2]; float qv[2][8];
    {
#pragma unroll
        for (int ks = 0; ks < 2; ++ks) { rope_apply(rq[ks], ks * 4 + fq, latent, 0.125f, qv[ks]);
            u32x4 o = {pack2(qv[ks][0], qv[ks][1]), pack2(qv[ks][2], qv[ks][3]), pack2(qv[ks][4], qv[ks][5]), pack2(qv[ks][6], qv[ks][7])}; qf[ks] = mk8(o); }
    }
    if (next_task >= 0) stepC_issue(f, p, sd, next_task);
    __syncthreads();
    const int t = w * 16 + tq;
    f32x4 hsum[8];
#pragma unroll
    for (int mt = 0; mt < 8; ++mt) hsum[mt] = (f32x4){0.f, 0.f, 0.f, 0.f};
#pragma unroll
    for (int dir = 0; dir < 2; ++dir) {
        const float m_in = cms[dir];
        const float Mt = fmaxf(m_in, gpm[dir * 128 + t]);
        const float inter = __expf(m_in - Mt);
        const float mtot = gb[dir * 128 + t] + Mt;
        f32x4 acc[8];
#pragma unroll
        for (int mt = 0; mt < 8; ++mt) { acc[mt] = (f32x4){0.f, 0.f, 0.f, 0.f};
#pragma unroll
            for (int ks = 0; ks < 2; ++ks) { const bf16x8 cf = *(const bf16x8*)(Cs + (dir * 128 + mt * 16 + tq) * K_LD + ks * 32 + fq * 8);
                acc[mt] = mfma16(cf, qf[ks], acc[mt]); }
            acc[mt] = acc[mt] * inter; }
        float qn = 0.f;
#pragma unroll
        for (int ks = 0; ks < 2; ++ks)
#pragma unroll
            for (int j = 0; j < 8; ++j) qn += bf2f(f2bf(qv[ks][j])) * nvs[dir * 64 + ks * 32 + fq * 8 + j];
        qn += shx<16>(qn); qn += shx<32>(qn);
        float den = inter * qn;
        const int u_lo = dir == 0 ? 0 : (w >> 1), u_hi = dir == 0 ? (w >> 1) : 3;
        float rsum = 0.f;
        for (int u = u_lo; u <= u_hi; ++u) {
            unsigned pk[4];
#pragma unroll
            for (int kt = 0; kt < 2; ++kt) { f32x4 sa = {0.f, 0.f, 0.f, 0.f}; const int sb = 32 * u + 16 * kt;
#pragma unroll
                for (int ks = 0; ks < 2; ++ks) { const bf16x8 kf = *(const bf16x8*)(Ks + (sb + tq) * K_LD + ks * 32 + fq * 8); sa = mfma16(kf, qf[ks], sa); }
                float pv[4]; float gv4[4];
#pragma unroll
                for (int r = 0; r < 4; ++r) gv4[r] = ga[dir * 128 + sb + fq * 4 + r];
#ifndef CPU_EMU
                asm volatile("" : "+v"(gv4[0]), "+v"(gv4[1]), "+v"(gv4[2]), "+v"(gv4[3]));
#endif
#pragma unroll
                for (int r = 0; r < 4; ++r) { const int s = sb + fq * 4 + r; const bool valid = dir == 0 ? (s <= t) : (s >= t);
                    pv[r] = valid ? sa[r] * __expf(gv4[r] - Mt) : 0.f; pv[r] = bf2f(f2bf(pv[r])); rsum += pv[r]; }
                pk[kt * 2] = pack2(pv[0], pv[1]); pk[kt * 2 + 1] = pack2(pv[2], pv[3]); }
            u32x4 pkv = {pk[0], pk[1], pk[2], pk[3]}; const bf16x8 pf = mk8(pkv);
#pragma unroll
            for (int mt = 0; mt < 8; ++mt) { const bf16_t* vp = Vs + (32 * u + 4 * fq + tq4) * V_LD + mt * 16 + 4 * tp4;
                const bf16x8 vf = mk8(TR16(vp), TR16(vp + 16 * V_LD));
                acc[mt] = mfma16(vf, pf, acc[mt]); }
        }
        rsum += shx<16>(rsum); rsum += shx<32>(rsum);
        den += rsum;
        const float dn = frcp(fmaxf(fabsf(den), __expf(-mtot)));
#pragma unroll
        for (int mt = 0; mt < 8; ++mt) hsum[mt] = hsum[mt] + acc[mt] * dn;
    }
    float ss = 0.f;
#pragma unroll
    for (int mt = 0; mt < 8; ++mt)
#pragma unroll
        for (int r = 0; r < 4; ++r) ss += hsum[mt][r] * hsum[mt][r];
    ss += shx<16>(ss); ss += shx<32>(ss);
    const float rstd = rsqrtf(ss * (1.0f / 128.0f) + RMS_EPS);
#pragma unroll
    for (int mt = 0; mt < 8; ++mt) { const int v = mt * 16 + fq * 4;
        const u32x2 om = ldg((const u32x2*)(prow + (size_t)t * PWA + C_OM + h * 128 + v));
        u32x2 o = {pack2(hsum[mt][0] * rstd * sigmoidf_(lo16(om.x)), hsum[mt][1] * rstd * sigmoidf_(hi16(om.x))),
                   pack2(hsum[mt][2] * rstd * sigmoidf_(lo16(om.y)), hsum[mt][3] * rstd * sigmoidf_(hi16(om.y)))};
        stg((u32x2*)(p.Mb() + (size_t)(row0 + t) * 512 + h * 128 + v), o); }
}

struct SchedMerge {
    const bf16_t* Mb; const bf16_t* Pb; const bf16_t* Nb; const bf16_t* Wb; int nM;
    DEV bool next(int i, GUnit& u) const { u.aux = i % 3; return tile_order(i / 3, nM, 4, u.pm, u.pn); }
    DEV const bf16_t* a_base(const GUnit& u) const { return (u.aux == 0 ? Mb : (u.aux == 1 ? Pb : Nb)) + (size_t)u.pm * 256 * 512; }
    DEV const bf16_t* b_base(const GUnit& u) const { return Wb + ((size_t)u.aux * 1024 + u.pn * 256) * 512; }
    DEV int grow(const GUnit&, int) const { return 0; }
};
DEV void phase_merge(const Params& p, const SetDesc& sd, int layer, char* shm) {
    SchedMerge S; S.Mb = p.Mb(); S.Pb = p.Pb(); S.Nb = p.Nb(); S.Wb = p.WbT() + (size_t)layer * 3 * 1024 * 512; S.nM = sd.nrows / 256;
    const unsigned char* bgb = p.BG(); bf16_t* mgb = p.MERGED();
    gemm_stream<false, 512, 512, 512>(shm, S, [=](const GUnit& u, f32x4 (&acc)[2][2][4][2], int r0, int c0) -> bool {
        if (u.aux < 2) {
            u32x2 ga[2][4][2], gb[2][4][2];
#pragma unroll
            for (int ai = 0; ai < 2; ++ai)
#pragma unroll
                for (int m = 0; m < 4; ++m)
#pragma unroll
                    for (int hf = 0; hf < 2; ++hf) { const unsigned char* gp = bgb + ((size_t)u.pm * 256 + r0 + ai * 128 + m * 16) * NBG + u.aux * 1024 + u.pn * 256 + c0 + hf * 128;
                        ga[ai][m][hf] = ldg((const u32x2*)gp); gb[ai][m][hf] = ldg((const u32x2*)(gp + 1024)); }
#pragma unroll
            for (int ai = 0; ai < 2; ++ai)
#pragma unroll
                for (int m = 0; m < 4; ++m)
#pragma unroll
                    for (int hf = 0; hf < 2; ++hf) {
#pragma unroll
                        for (int j = 0; j < 4; ++j) { acc[ai][hf][m][0][j] *= u8f(ga[ai][m][hf].x, j) * frcp(u8f(gb[ai][m][hf].x, j)); acc[ai][hf][m][1][j] *= u8f(ga[ai][m][hf].y, j) * frcp(u8f(gb[ai][m][hf].y, j)); } }
            return true;
        }
        u32x2 gm2[2][4][2];
#pragma unroll
        for (int ai = 0; ai < 2; ++ai)
#pragma unroll
            for (int m = 0; m < 4; ++m)
#pragma unroll
                for (int hf = 0; hf < 2; ++hf) gm2[ai][m][hf] = ldg((const u32x2*)(bgb + ((size_t)u.pm * 256 + r0 + ai * 128 + m * 16) * NBG + 2048 + u.pn * 256 + c0 + hf * 128));
#pragma unroll
        for (int ai = 0; ai < 2; ++ai) {
#pragma unroll
            for (int m = 0; m < 4; ++m)
#pragma unroll
                for (int hf = 0; hf < 2; ++hf) { const size_t r = (size_t)u.pm * 256 + r0 + ai * 128 + m * 16;
                    const f32x4 x0 = acc[ai][hf][m][0] * (1.0f / 255.0f), x1 = acc[ai][hf][m][1] * (1.0f / 255.0f); const u32x2 g = gm2[ai][m][hf];
                    u32x4 ov = {pack2(x0[0] * u8f(g.x, 0), x0[1] * u8f(g.x, 1)), pack2(x0[2] * u8f(g.x, 2), x0[3] * u8f(g.x, 3)),
                                pack2(x1[0] * u8f(g.y, 0), x1[1] * u8f(g.y, 1)), pack2(x1[2] * u8f(g.y, 2), x1[3] * u8f(g.y, 3))};
                    stg((u32x4*)(mgb + r * 1024 + u.pn * 256 + c0 + hf * 128), ov); }
        }
        return false; });
}
DEV void phase_outproj(const Params& p, const SetDesc& sd, int layer, char* shm) {
    SchedPlain S; S.A = p.MERGED(); S.Bt = p.WoT() + (size_t)layer * 1024 * 1024; S.nM = sd.nrows / 256; S.nN = 4; S.lda256 = 256 * 1024; S.ldb256 = 256 * 1024;
    bf16_t* yb = p.Y();
    gemm_stream<false, 1024, 1024, 1024>(shm, S, [=](const GUnit& u, const f32x4 (&acc)[2][2][4][2], int r0, int c0) {
#pragma unroll
        for (int ai = 0; ai < 2; ++ai)
#pragma unroll
            for (int m = 0; m < 4; ++m) { bf16_t* o = yb + ((size_t)u.pm * 256 + r0 + ai * 128 + m * 16) * 1024 + u.pn * 256 + c0;
                store8bf(o, acc[ai][0][m][0], acc[ai][0][m][1]); store8bf(o + 128, acc[ai][1][m][0], acc[ai][1][m][1]); } });
}

template <bool SRC_BF> DEV void phase_postmix(const Params& p, const SetDesc& sd, int layer, char* shm) {
    const int tid = TID(), lane = tid & 63, wv = tid >> 6;
    float* wr_s = (float*)shm;
    __syncthreads();
    for (int i = tid; i < 1024 * 16; i += NTHREADS) { const int c = i >> 4, e = i & 15, ln = (c & 511) >> 3, j = c & 7, hf = c >> 9;
        wr_s[((((hf * 8 + j) * 4 + (e >> 2)) * 64 + ln) << 2) + (e & 3)] = ldg(p.router_w + (size_t)layer * 1024 * 16 + i); }
    __syncthreads();
    const float* g1 = p.norm_gain + ((size_t)layer * 4 + 1) * 1024; const float* g2 = p.norm_gain + ((size_t)layer * 4 + 2) * 1024;
    float* par = (float*)(shm + 65536);
    { const int rpb0_ = (sd.nrows + (int)gridDim.x - 1) / (int)gridDim.x; const float* mdb = mod_row(p, sd, layer, min((int)blockIdx.x * rpb0_, sd.nrows - 1));
      stage_params(par, g1, g2, mdb + 2048, mdb + 3072, mdb + 4096); }
    __syncthreads();
    const void* xb = SRC_BF ? (const void*)xbf_base(p, sd) : (const void*)xin_f32(p, sd); bf16_t* xdb = xbf_base(p, sd);
    const int stride = 8; const int rpb_ = (sd.nrows + (int)gridDim.x - 1) / (int)gridDim.x; const int row_end = min(sd.nrows, ((int)blockIdx.x + 1) * rpb_);
    int row = (int)blockIdx.x * rpb_ + wv;
    u32x4 ycur[2], ynxt[2]; XRow<SRC_BF> xcur, xnxt;
    if (row < row_end) {
#pragma unroll
        for (int i = 0; i < 2; ++i) ycur[i] = ldg((const u32x4*)(p.Y() + (size_t)row * 1024 + i * 512 + lane * 8));
        xcur.load(xb, row, lane); }
    for (; row < row_end; row += stride) {
        int ln = lane; HIDE(ln);
        const int rn = row + stride;
        if (rn < row_end) {
#pragma unroll
            for (int i = 0; i < 2; ++i) ynxt[i] = ldg((const u32x4*)(p.Y() + (size_t)rn * 1024 + i * 512 + ln * 8));
            xnxt.load(xb, rn, ln); }
        float y[16]; float ss = 0.f;
#pragma unroll
        for (int hlf = 0; hlf < 2; ++hlf) { const u32x4 m = ycur[hlf];
            const float t8[8] = {lo16(m.x), hi16(m.x), lo16(m.y), hi16(m.y), lo16(m.z), hi16(m.z), lo16(m.w), hi16(m.w)};
#pragma unroll
            for (int j = 0; j < 8; ++j) { y[hlf * 8 + j] = t8[j]; ss += t8[j] * t8[j]; } }
        ss = wave_sum(ss);
        const float rstd = rsqrtf(ss * (1.0f / 1024.0f) + RMS_EPS);
        float xn[16]; float ss2 = 0.f;
#pragma unroll
        for (int hlf = 0; hlf < 2; ++hlf) { f32x4 xw[2];
#pragma unroll
            for (int q = 0; q < 2; ++q) { const int c0 = hlf * 512 + ln * 8 + q * 4; const f32x4 xo = xcur.get(hlf * 2 + q);
#pragma unroll
                for (int j = 0; j < 4; ++j) { const float v = xo[j] + par[2048 + c0 + j] * (y[hlf * 8 + q * 4 + j] * rstd * par[c0 + j]); xw[q][j] = v; xn[hlf * 8 + q * 4 + j] = v; ss2 += v * v; } }
            xrow_store8<true>(xdb, row, hlf * 512 + ln * 8, xw[0], xw[1]); }
        ss2 = wave_sum(ss2);
        const float rstd2 = rsqrtf(ss2 * (1.0f / 1024.0f) + RMS_EPS);
        float lg[16];
#pragma unroll
        for (int e = 0; e < 16; ++e) lg[e] = 0.f;
#pragma unroll
        for (int hlf = 0; hlf < 2; ++hlf) { const int c0 = hlf * 512 + ln * 8; float o[8];
#pragma unroll
            for (int j = 0; j < 8; ++j) { o[j] = xn[hlf * 8 + j] * rstd2 * par[1024 + c0 + j] * (1.0f + par[4096 + c0 + j]) + par[3072 + c0 + j];
#pragma unroll
                for (int eq = 0; eq < 4; ++eq) { const f32x4 w4 = *(const f32x4*)(wr_s + ((((hlf * 8 + j) * 4 + eq) * 64 + ln) << 2));
#pragma unroll
                    for (int e = 0; e < 4; ++e) lg[eq * 4 + e] += o[j] * w4[e]; } }
            const u32x2 ov = {f8pack4(o[0], o[1], o[2], o[3]), f8pack4(o[4], o[5], o[6], o[7])};
            stg((u32x2*)((unsigned char*)p.H() + (size_t)row * 1024 + c0), ov); }
        float r8[8], r4[4], r2[2], r1;
        { const bool b = (lane & 32) != 0;
#pragma unroll
          for (int i = 0; i < 8; ++i) { const float keep = b ? lg[i + 8] : lg[i], send = b ? lg[i] : lg[i + 8]; r8[i] = keep + shx<32>(send); } }
        { const bool b = (lane & 16) != 0;
#pragma unroll
          for (int i = 0; i < 4; ++i) { const float keep = b ? r8[i + 4] : r8[i], send = b ? r8[i] : r8[i + 4]; r4[i] = keep + shx<16>(send); } }
        { const bool b = (lane & 8) != 0;
#pragma unroll
          for (int i = 0; i < 2; ++i) { const float keep = b ? r4[i + 2] : r4[i], send = b ? r4[i] : r4[i + 2]; r2[i] = keep + shx<8>(send); } }
        { const bool b = (lane & 4) != 0; const float keep = b ? r2[1] : r2[0], send = b ? r2[0] : r2[1]; r1 = keep + shx<4>(send); }
        r1 += shx<2>(r1); r1 += shx<1>(r1);
        float mx = r1;
        mx = fmaxf(mx, shx<4>(mx)); mx = fmaxf(mx, shx<8>(mx)); mx = fmaxf(mx, shx<16>(mx)); mx = fmaxf(mx, shx<32>(mx));
        const float ex = __expf(r1 - mx);
        float se = ex;
        se += shx<4>(se); se += shx<8>(se); se += shx<16>(se); se += shx<32>(se);
        if ((lane & 3) == 0) { const int e = ((lane >> 5) & 1) * 8 + ((lane >> 4) & 1) * 4 + ((lane >> 3) & 1) * 2 + ((lane >> 2) & 1);
            stg(p.aff() + (size_t)row * 16 + e, ex * frcp(se)); }
#pragma unroll
        for (int i = 0; i < 2; ++i) ycur[i] = ynxt[i];
        xcur = xnxt;
    }
}

DEV unsigned shxu(unsigned v, int m) {
    const float f = __uint_as_float(v); float r;
    switch (m) { case 1: r = shx<1>(f); break; case 2: r = shx<2>(f); break; case 4: r = shx<4>(f); break; case 8: r = shx<8>(f); break; case 16: r = shx<16>(f); break; default: r = shx<32>(f); break; }
    return __float_as_uint(r);
}
#define TK_CX(a_, b_, desc_) do { const unsigned long long x_ = key[a_], y_ = key[b_]; const bool sw_ = (desc_) ? (x_ < y_) : (x_ > y_); key[a_] = sw_ ? y_ : x_; key[b_] = sw_ ? x_ : y_; } while (0)
template <int TJ> DEV void tk_step_sh(unsigned long long (&key)[4], int tid, bool desc4) {
    unsigned long long pk[4];
#pragma unroll
    for (int m = 0; m < 4; ++m) { const unsigned lo = __float_as_uint(shx<TJ>(__uint_as_float((unsigned)key[m]))), hi = __float_as_uint(shx<TJ>(__uint_as_float((unsigned)(key[m] >> 32))));
        pk[m] = ((unsigned long long)hi << 32) | lo; }
    const bool takemax = desc4 == ((tid & TJ) == 0);
#pragma unroll
    for (int m = 0; m < 4; ++m) { const unsigned long long x = key[m], y = pk[m]; key[m] = takemax ? (x > y ? x : y) : (x < y ? x : y); }
}
DEV void tk_step_lds(unsigned long long (&key)[4], unsigned long long* buf, int tid, int tj, bool active, bool desc4) {
    unsigned long long pk[4];
    __syncthreads();
    if (active) {
#pragma unroll
        for (int m = 0; m < 4; ++m) buf[tid * 4 + m] = key[m]; }
    __syncthreads();
#pragma unroll
    for (int m = 0; m < 4; ++m) pk[m] = active ? buf[(tid ^ tj) * 4 + m] : 0ull;
    const bool takemax = desc4 == ((tid & tj) == 0);
#pragma unroll
    for (int m = 0; m < 4; ++m) { const unsigned long long x = key[m], y = pk[m]; key[m] = takemax ? (x > y ? x : y) : (x < y ? x : y); }
}
DEV void topk_task(const Params& p, const SetDesc& sd, int task, char* shm) {
    const int tid = TID();
    const int e = task & 15, sl = task >> 4;
    unsigned long long* buf = (unsigned long long*)shm;
    const int T = 1 << sd.lgseq, cap = sd.cap;
    const int rbase = sl << sd.lgseq;
    const bool active = tid * 4 < T;
    unsigned long long key[4];
    __syncthreads();
#pragma unroll
    for (int m = 0; m < 4; ++m) { const int i = tid * 4 + m; const float a = active ? ldg(p.aff() + (size_t)(rbase + i) * 16 + e) : 0.f;
        key[m] = ((unsigned long long)__float_as_uint(a) << 32) | (unsigned)(0xFFFFFFFFu - (unsigned)i); }
    for (int k = 2; k <= T; k <<= 1) {
        const bool desc4 = ((tid * 4) & k) == 0;
        for (int j = k >> 1; j >= 256; j >>= 1) tk_step_lds(key, buf, tid, j >> 2, active, desc4);
        if (k >= 256) tk_step_sh<32>(key, tid, desc4);
        if (k >= 128) tk_step_sh<16>(key, tid, desc4);
        if (k >= 64) tk_step_sh<8>(key, tid, desc4);
        if (k >= 32) tk_step_sh<4>(key, tid, desc4);
        if (k >= 16) tk_step_sh<2>(key, tid, desc4);
        if (k >= 8) tk_step_sh<1>(key, tid, desc4);
        if (k >= 4) { TK_CX(0, 2, desc4); TK_CX(1, 3, desc4); TK_CX(0, 1, desc4); TK_CX(2, 3, desc4); }
        else { TK_CX(0, 1, true); TK_CX(2, 3, false); }
    }
    const int sbase = e * sd.rpe + sl * cap;
    if (active) {
#pragma unroll
        for (int m = 0; m < 4; ++m) { const int i = tid * 4 + m; const unsigned long long kv = key[m]; const int tok = (int)(0xFFFFFFFFu - (unsigned)(kv & 0xFFFFFFFFu));
            const int row = rbase + tok;
            if (i < cap) { stg(p.slot_token() + sbase + i, row); stg(p.slot_gate() + sbase + i, __uint_as_float((unsigned)(kv >> 32))); stg(p.token_slots() + (size_t)row * 16 + e, sbase + i); }
            else stg(p.token_slots() + (size_t)row * 16 + e, -1); } }
    if (sl == 0) { const int used = sd.nsamp * cap;
        for (int i = used + tid; i < sd.rpe; i += NTHREADS) { stg(p.slot_token() + e * sd.rpe + i, 0); stg(p.slot_gate() + e * sd.rpe + i, 0.f); } }
}
#undef TK_CX

struct SchedMoe {
    const bf16_t* A; const int* st; const bf16_t* W; int nRT, rpe, nN, wstride;
    DEV bool next(int i, GUnit& u) const { int pmx, pn; if (!tile_order(i, 16 * nRT, nN, pmx, pn)) return false; u.pm = pmx % nRT; u.aux = pmx / nRT; u.pn = pn; return true; }
    DEV int slot0(const GUnit& u) const { return u.aux * rpe + u.pm * 256; }
    DEV const bf16_t* a_base(const GUnit&) const { return A; }
    DEV int grow(const GUnit& u, int i) const { return st ? ldg(st + slot0(u) + i) : slot0(u) + i; }
    DEV const bf16_t* b_base(const GUnit& u) const { return W + (size_t)u.aux * wstride + (size_t)u.pn * 256 * 512; }
};
DEV void phase_moe_gu(const Params& p, const SetDesc& sd, int layer, char* shm) {
    SchedMoe S; S.A = p.H(); S.st = p.slot_token(); S.W = p.WguT() + (size_t)layer * 16 * 2048 * 512; S.nRT = sd.rpe / 256; S.rpe = sd.rpe; S.nN = 8; S.wstride = 2048 * 512;
    unsigned char* hb = (unsigned char*)p.HID();
    gemm_stream<true, 512, 512, 512, true>(shm, S, [=](const GUnit& u, const f32x4 (&acc)[2][2][4][2], int r0, int c0) {
#pragma unroll
        for (int ai = 0; ai < 2; ++ai)
#pragma unroll
            for (int m = 0; m < 4; ++m) { f32x4 h0, h1; const f32x4 a0 = acc[ai][0][m][0] * F8_WINV, a1 = acc[ai][0][m][1] * F8_WINV, b0 = acc[ai][1][m][0] * F8_WINV, b1 = acc[ai][1][m][1] * F8_WINV;
#pragma unroll
                for (int j = 0; j < 4; ++j) { h0[j] = a0[j] * sigmoidf_(a0[j]) * b0[j]; h1[j] = a1[j] * sigmoidf_(a1[j]) * b1[j]; }
                const u32x2 hv = {f8pack4(h0[0], h0[1], h0[2], h0[3]), f8pack4(h1[0], h1[1], h1[2], h1[3])};
                stg((u32x2*)(hb + ((size_t)S.slot0(u) + r0 + ai * 128 + m * 16) * 1024 + u.pn * 128 + c0), hv); } });
}
DEV void phase_moe_down(const Params& p, const SetDesc& sd, int layer, char* shm) {
    SchedMoe S; S.A = p.HID(); S.st = nullptr; S.W = p.WdT() + (size_t)layer * 16 * 1024 * 512; S.nRT = sd.rpe / 256; S.rpe = sd.rpe; S.nN = 4; S.wstride = 1024 * 512;
    unsigned char* yb = (unsigned char*)p.YE(); const float* gt = p.slot_gate();
    gemm_stream<true, 512, 512, 512, true>(shm, S, [=](const GUnit& u, const f32x4 (&acc)[2][2][4][2], int r0, int c0) {
#pragma unroll
        for (int ai = 0; ai < 2; ++ai) {
            float gv[4];
#pragma unroll
            for (int m = 0; m < 4; ++m) gv[m] = ldg(gt + (size_t)S.slot0(u) + r0 + ai * 128 + m * 16) * (F8_WINV * YE_SCALE);
#pragma unroll
            for (int m = 0; m < 4; ++m) { const size_t sl = (size_t)S.slot0(u) + r0 + ai * 128 + m * 16; const float g = gv[m];
                unsigned char* o = yb + sl * 1024 + u.pn * 256 + c0;
#pragma unroll
                for (int hf = 0; hf < 2; ++hf) { const f32x4 a = acc[ai][hf][m][0] * g, b = acc[ai][hf][m][1] * g;
                    const u32x2 ov = {f8pack4(a[0], a[1], a[2], a[3]), f8pack4(b[0], b[1], b[2], b[3])}; stg((u32x2*)(o + hf * 128), ov); } } } });
}

DEV void compact4(const int (&sl)[16], int (&c)[4], int& n) {
    n = 0; c[0] = -1; c[1] = -1; c[2] = -1; c[3] = -1;
#pragma unroll
    for (int e = 0; e < 16; ++e) if (sl[e] >= 0) { c[0] = (n == 0) ? sl[e] : c[0]; c[1] = (n == 1) ? sl[e] : c[1]; c[2] = (n == 2) ? sl[e] : c[2]; c[3] = (n == 3) ? sl[e] : c[3]; ++n; }
}
template <bool DST_F32> DEV void phase_combine(const Params& p, const SetDesc& sd, int layer, char* shm) {
    const int tid = TID(), lane = tid & 63, wv = tid >> 6;
    const float* g3 = p.norm_gain + ((size_t)layer * 4 + 3) * 1024;
    const bf16_t* xsb = xbf_base(p, sd); void* xdb = DST_F32 ? (void*)xout_f32(p, sd) : (void*)xbf_base(p, sd);
    const int stride = 8; const int rpb_ = (sd.nrows + (int)gridDim.x - 1) / (int)gridDim.x; const int row_end = min(sd.nrows, ((int)blockIdx.x + 1) * rpb_);
    int row = __builtin_amdgcn_readfirstlane((int)blockIdx.x * rpb_ + wv);
    float* par = (float*)shm;
    __syncthreads();
    { const float* mdb = mod_row(p, sd, layer, min((int)blockIdx.x * rpb_, sd.nrows - 1)); stage_params(par, g3, mdb + 5120, nullptr, nullptr, nullptr); }
    __syncthreads();
    int raw[16]; int cc[4], cn[4]; int nc = 0, nn = 0;
    u32x2 mc[4][2], mn[4][2]; XRow<true> xc, xn;
#define CMB_SLOTS(r_) do { _Pragma("unroll") for (int e = 0; e < 16; ++e) raw[e] = ldg(p.token_slots() + (size_t)(r_) * 16 + e); } while (0)
#define CMB_DATA(r_, c_, n_, m_, x_) do { _Pragma("unroll") for (int k = 0; k < 4; ++k) { \
            if (k < (n_)) { const unsigned char* yr = (const unsigned char*)p.YE() + (size_t)(c_)[k] * 1024 + lane * 8; (m_)[k][0] = ldg((const u32x2*)yr); (m_)[k][1] = ldg((const u32x2*)(yr + 512)); } \
            else { (m_)[k][0] = (u32x2){0u, 0u}; (m_)[k][1] = (u32x2){0u, 0u}; } } \
        (x_).load(xsb, (r_), lane); } while (0)
    if (row < row_end) { CMB_SLOTS(row); compact4(raw, cc, nc); CMB_DATA(row, cc, nc, mc, xc); if (row + stride < row_end) CMB_SLOTS(row + stride); }
    for (; row < row_end; row += stride) {
        const int rn = row + stride;
        if (rn < row_end) { compact4(raw, cn, nn); CMB_DATA(rn, cn, nn, mn, xn); if (rn + stride < row_end) CMB_SLOTS(rn + stride); }
        float y[16];
#pragma unroll
        for (int j = 0; j < 16; ++j) y[j] = 0.f;
        if (nc <= 4) {
#pragma unroll
            for (int k = 0; k < 4; ++k)
                if (k < nc) {
#pragma unroll
                    for (int hlf = 0; hlf < 2; ++hlf) { const f32x4 a = f8x4_f32(mc[k][hlf].x), b = f8x4_f32(mc[k][hlf].y);
#pragma unroll
                        for (int j = 0; j < 4; ++j) { y[hlf * 8 + j] += a[j]; y[hlf * 8 + 4 + j] += b[j]; } } }
        } else {
            for (int e = 0; e < 16; ++e) { const int sl_ = ldg(p.token_slots() + (size_t)row * 16 + e);
                if (sl_ >= 0) { const unsigned char* yr = (const unsigned char*)p.YE() + (size_t)sl_ * 1024 + lane * 8;
#pragma unroll
                    for (int hlf = 0; hlf < 2; ++hlf) { const u32x2 m = ldg((const u32x2*)(yr + hlf * 512)); const f32x4 a = f8x4_f32(m.x), b = f8x4_f32(m.y);
#pragma unroll
                        for (int j = 0; j < 4; ++j) { y[hlf * 8 + j] += a[j]; y[hlf * 8 + 4 + j] += b[j]; } } } }
        }
        float ss = 0.f;
#pragma unroll
        for (int j = 0; j < 16; ++j) ss += y[j] * y[j];
        ss = wave_sum(ss);
        const float rstd = rsqrtf(ss * (YE_INV * YE_INV / 1024.0f) + RMS_EPS) * YE_INV;
#pragma unroll
        for (int hlf = 0; hlf < 2; ++hlf) { f32x4 xv[2];
#pragma unroll
            for (int q = 0; q < 2; ++q) { const int c0 = hlf * 512 + lane * 8 + q * 4; xv[q] = xc.get(hlf * 2 + q);
#pragma unroll
                for (int j = 0; j < 4; ++j) xv[q][j] += par[1024 + c0 + j] * (y[hlf * 8 + q * 4 + j] * rstd * par[c0 + j]); }
            xrow_store8<!DST_F32>(xdb, row, hlf * 512 + lane * 8, xv[0], xv[1]); }
        nc = nn;
#pragma unroll
        for (int k = 0; k < 4; ++k) { cc[k] = cn[k]; mc[k][0] = mn[k][0]; mc[k][1] = mn[k][1]; }
        xc = xn;
    }
#undef CMB_SLOTS
#undef CMB_DATA
}

constexpr int WQ_WORD0 = 4096;
template <class F> DEV void wq_run(const Params& p, int qidx, int ntasks, char* shm, F&& task) {
    unsigned* ctr = p.bar() + WQ_WORD0 + 64 * qidx;
    volatile int* slot = (volatile int*)(shm + 131072 + 64);
    const int tid = TID();
    int cur = blockIdx.x;
    while (cur < ntasks) {
        unsigned pend = 0u;
        if (tid == 0) pend = atomicAdd(ctr, 1u);
        task(cur);
        __syncthreads();
        if (tid == 0) *slot = (int)gridDim.x + (int)pend;
        __syncthreads();
        cur = *slot;
    }
}

template <int PH> DEV void do_phase(const Params& p, int layer, int is_ctx, int grp, char* shm) {
    const SetDesc sd = make_set(is_ctx, grp);
    if constexpr (PH == -1) phase_prologue(p, shm);
    if constexpr (PH == 0) { if (layer == 0) phase_norm1<false>(p, sd, layer, shm); else phase_norm1<true>(p, sd, layer, shm); }
    if constexpr (PH == 1) phase_proj_a(p, sd, layer, shm);
    const int qbase = ((layer * 3 + (is_ctx ? 0 : grp + 1)) * 13 + (PH < 0 ? 0 : PH)) * 2;
    if constexpr (PH == 2) {
        { const int nt = sd.nsamp * 4 * sd.ntb, G_ = (int)gridDim.x; int t = blockIdx.x;
          if (t < nt) { PrefA f; stepA_issue(f, p, sd, t); for (; t < nt; t += G_) mlstm_stepA_task(p, sd, layer, t, t + G_ < nt ? t + G_ : -1, f, shm); } }
        if (!(is_ctx && layer == 1)) phase_pool(p, sd); }
    if constexpr (PH == 3) {
        for (int t = blockIdx.x; t < sd.nsamp * 32; t += gridDim.x) mlstm_stepB_task(p, sd, t);
        if (!(is_ctx && layer == 1)) {
            const int nq = (is_ctx ? (CTX / 64) : ROWS) / 2;
            wq_run(p, qbase, sd.nsamp * nq * 4, shm, [&](int t) { na_task(p, sd, layer, t / (nq * 4), (t >> 2) % nq, t & 3, shm); });
        }
    }
    if constexpr (PH == 4) { const int nt = sd.nsamp * 4 * sd.ntb, G_ = (int)gridDim.x; int t = blockIdx.x;
        if (t < nt) { PrefC f; stepC_issue(f, p, sd, t); for (; t < nt; t += G_) mlstm_stepC_task(p, sd, layer, t, t + G_ < nt ? t + G_ : -1, f, shm); } }
    if constexpr (PH == 6) phase_merge(p, sd, layer, shm);
    if constexpr (PH == 7) phase_outproj(p, sd, layer, shm);
    if constexpr (PH == 8) { if (layer == 0) phase_postmix<false>(p, sd, layer, shm); else phase_postmix<true>(p, sd, layer, shm); }
    if constexpr (PH == 9) { for (int t = blockIdx.x; t < sd.nsamp * 16; t += gridDim.x) topk_task(p, sd, t, shm); }
    if constexpr (PH == 10) phase_moe_gu(p, sd, layer, shm);
    if constexpr (PH == 11) phase_moe_down(p, sd, layer, shm);
    if constexpr (PH == 12) { if (layer == 0) phase_combine<false>(p, sd, layer, shm); else phase_combine<true>(p, sd, layer, shm); }
}

#ifndef CPU_EMU
template <int PH> __global__ void __launch_bounds__(NTHREADS, 2) k_phase(Params p, int layer, int is_ctx, int grp) {
    DYN_LDS(shm);
    do_phase<PH>(p, layer, is_ctx, grp, shm);
}
#ifndef DBL_MASK
#define DBL_MASK 0
#endif
#define RUNPH(PH) do { do_phase<PH>(p, layer, is_ctx, grp, shm); xcd_barrier(bar); if ((DBL_MASK >> (PH)) & 1) { do_phase<PH>(p, layer, is_ctx, grp, shm); xcd_barrier(bar); } } while (0)
__global__ void __launch_bounds__(NTHREADS, 2) k_mega(Params p) {
    DYN_LDS(shm);
    uint4* xbw = (uint4*)(shm + 131072);
    if (threadIdx.x == 0) *xbw = make_uint4(0u, 0u, 0u, 0u);
    __syncthreads();
    XcdBarrier bar = xcd_barrier_post(p.bar(), (volatile LAS unsigned*)xbw);
    do_phase<-1>(p, 0, 0, 0, shm);
    xcd_barrier(bar);
    for (int layer = 0; layer < 2; ++layer)
        for (int si = 0; si <= NG; ++si) {
            const int is_ctx = si == 0 ? 1 : 0, grp = si == 0 ? 0 : si - 1;
            RUNPH(0); RUNPH(1); RUNPH(2);
            if (is_ctx && layer == 1) { do_phase<3>(p, layer, is_ctx, grp, shm); continue; }
            RUNPH(3); RUNPH(4); RUNPH(6); RUNPH(7); RUNPH(8); RUNPH(9); RUNPH(10); RUNPH(11);
            do_phase<12>(p, layer, is_ctx, grp, shm);
        }
}
#endif
}

static Params make_params(void* const* d_in, void* d_out, void* d_ws) {
    Params p{};
    p.x = (const float*)d_in[0]; p.c = (const float*)d_in[1]; p.ctx = (const float*)d_in[2]; p.c_ctx = (const float*)d_in[3];
    p.norm_gain = (const float*)d_in[4]; p.ada_w = (const float*)d_in[5]; p.ada_b = (const float*)d_in[6]; p.w_in = (const float*)d_in[7];
    p.gate_bias = (const float*)d_in[8]; p.pool_w = (const float*)d_in[9]; p.pool_scale = (const float*)d_in[10]; p.rpb = (const float*)d_in[11];
    p.w_branch = (const float*)d_in[12]; p.w_out = (const float*)d_in[13]; p.router_w = (const float*)d_in[14];
    p.w_gate = (const float*)d_in[15]; p.w_up = (const float*)d_in[16]; p.w_down = (const float*)d_in[17];
    p.out = (float*)d_out; p.ws = (char*)d_ws;
    return p;
}

#ifdef CPU_EMU
int emu_cfg_B = CFG_B, emu_cfg_ROWS = CFG_ROWS, emu_cfg_CTX = CFG_CTX;
const char* g_dumpdir = "data";
static void* g_ws = nullptr;
static void dump_buf(const char* name, int layer, int is_ctx, int grp, const void* ptr, size_t bytes) {
    char nm[512]; snprintf(nm, sizeof nm, "%s/d_L%d_%s%d_%s.bin", g_dumpdir, layer, is_ctx ? "c" : "g", grp, name);
    FILE* f = fopen(nm, "wb"); fwrite(ptr, 1, bytes, f); fclose(f);
}
static void emu_hook(const Params& p, int layer, int is_ctx, int grp, int ph) {
    const size_t Rn = is_ctx ? RC : RL;
    if (ph == 0) dump_buf("H", layer, is_ctx, grp, p.H(), Rn * 1024 * 2);
    if (ph == 1) dump_buf("PROJ", layer, is_ctx, grp, is_ctx ? p.PROJc() : p.PROJa(), Rn * PWA * 2);
    if (ph == 2) dump_buf("Pb", layer, is_ctx, grp, p.Pb(), Rn * 512 * 2);
    if (ph == 3) dump_buf("Nb", layer, is_ctx, grp, p.Nb(), Rn * 512 * 2);
    if (ph == 4) dump_buf("Mb", layer, is_ctx, grp, p.Mb(), Rn * 512 * 2);
    if (ph == 1) dump_buf("BG", layer, is_ctx, grp, p.BG(), Rn * NBG);
    if (ph == 6) dump_buf("MERGED", layer, is_ctx, grp, p.MERGED(), Rn * 1024 * 2);
    if (ph == 7) dump_buf("Y", layer, is_ctx, grp, p.Y(), Rn * 1024 * 2);
    if (ph == 8) { dump_buf("H2", layer, is_ctx, grp, p.H(), Rn * 1024 * 2); dump_buf("aff", layer, is_ctx, grp, p.aff(), Rn * 16 * 4); }
}
void emu_dump(const char* dir) {
    char nm[512]; snprintf(nm, sizeof nm, "%s/d_mod.bin", dir);
    FILE* f = fopen(nm, "wb"); fwrite((char*)g_ws + WSL.mod, 1, (size_t)2 * (NB + 1) * 6144 * 4, f); fclose(f);
    snprintf(nm, sizeof nm, "%s/d_ctxs.bin", dir);
    f = fopen(nm, "wb"); fwrite((char*)g_ws + WSL.ctxs, 1, (size_t)NB * CTX * 1024 * 2, f); fclose(f);
}
template <int PH> static void emu_run_phase(const Params& p, int layer, int is_ctx, int grp, int nblocks) {
    emu_launch_lambda([=]() { do_phase<PH>(p, layer, is_ctx, grp, emu_blk->smem); }, nblocks, NTHREADS, LDS_BYTES);
    if (PH >= 0) emu_hook(p, layer, is_ctx, grp, PH);
    printf("phase %d layer %d ctx %d grp %d done\n", PH, layer, is_ctx, grp); fflush(stdout);
}
#define LAUNCH_PHASE(PH) emu_run_phase<PH>(p, layer, is_ctx, grp, nblocks)
#else
#define LAUNCH_PHASE(PH) hipLaunchKernelGGL((k_phase<PH>), dim3(nblocks), dim3(NTHREADS), LDS_BYTES, stream, p, layer, is_ctx, grp)
#define SETATTR(PH) (void)hipFuncSetAttribute((const void*)k_phase<PH>, hipFuncAttributeMaxDynamicSharedMemorySize, LDS_BYTES)
#endif

extern "C" void kernel_launch(void* const* d_in, const int* in_sizes, int n_in, void* d_out, int out_size, void* d_ws, size_t ws_size, hipStream_t stream) {
    (void)in_sizes; (void)n_in; (void)out_size;
    if (ws_size < WSL.total) return;
    Params p = make_params(d_in, d_out, d_ws);
#ifdef CPU_EMU
    g_ws = d_ws;
    memset(d_ws, 0xFF, WSL.total);
    memset((char*)d_ws + WSL.bar, 0, 65536);
    const int nblocks = 16;
#else
    const int nblocks = 256;
#if MK_ONE_LAUNCH
    static int grid = 0;
    if (!grid) {
        (void)hipFuncSetAttribute((const void*)k_mega, hipFuncAttributeMaxDynamicSharedMemorySize, LDS_BYTES);
        int dev = 0, cus = 0, per_cu = 0;
        (void)hipGetDevice(&dev);
        (void)hipDeviceGetAttribute(&cus, hipDeviceAttributeMultiprocessorCount, dev);
        (void)hipOccupancyMaxActiveBlocksPerMultiprocessor(&per_cu, (const void*)k_mega, NTHREADS, LDS_BYTES);
        if (per_cu > 1) per_cu = 1;
        grid = cus * per_cu;
        if (grid > 256) grid = 256;
    }
    if (grid <= 0) return;
    (void)hipMemsetAsync(p.bar(), 0, 65536, stream);
    hipLaunchKernelGGL(k_mega, dim3(grid), dim3(NTHREADS), LDS_BYTES, stream, p);
    return;
#else
    static bool attr_done = false;
    if (!attr_done) { SETATTR(-1); SETATTR(0); SETATTR(1); SETATTR(2); SETATTR(3); SETATTR(4); SETATTR(5); SETATTR(6); SETATTR(7); SETATTR(8); SETATTR(9); SETATTR(10); SETATTR(11); SETATTR(12); attr_done = true; }
#endif
#endif
    { const int layer = 0, is_ctx = 0, grp = 0; LAUNCH_PHASE(-1); }
    for (int layer = 0; layer < 2; ++layer)
        for (int si = 0; si <= NG; ++si) {
            const int is_ctx = si == 0 ? 1 : 0, grp = si == 0 ? 0 : si - 1;
            LAUNCH_PHASE(0); LAUNCH_PHASE(1); LAUNCH_PHASE(2); LAUNCH_PHASE(3);
            if (is_ctx && layer == 1) continue;
            LAUNCH_PHASE(4); LAUNCH_PHASE(6); LAUNCH_PHASE(7); LAUNCH_PHASE(8); LAUNCH_PHASE(9); LAUNCH_PHASE(10); LAUNCH_PHASE(11); LAUNCH_PHASE(12);
        }
}
```
